# Optimizing an MI355X kernel written in HIP

```python
import math
import jax
import jax.numpy as jnp
from jax import lax
import numpy as np

D_MODEL = 1024
BATCH = 8
SEQ = 2048
DEPTH = 2

GRID_W = 64
CTX_LEN = 256
Q_BLOCK = 128
ROPE_BASE = 10000.0
EPS = 1e-6
DA_HEADS = 4
DA_DIM = 32
DA_VDIM = 64
S5_GROUPS = 16
S5_CH = 16
S5_STATE = 64
S5_WIDTH = S5_GROUPS * S5_CH
MLA_HEADS = 4
MLA_NOPE = 32
MLA_ROPE = 16
MLA_VDIM = 64
MLA_Q_RANK = 192
MLA_KV_RANK = 128
RW_HEADS = 4
RW_DIM = 64
RW_WIDTH = RW_HEADS * RW_DIM
RW_DECAY_RANK = 32
RW_ICL_RANK = 32
RW_GATE_RANK = 64
RW_LN_EPS = 64e-5
N_BRANCH = 4
BRANCH_WIDTH = 256
N_EXPERTS = 16
N_GROUPS = 4
EXPERTS_PER_GROUP = N_EXPERTS // N_GROUPS
TOP_K = 2
D_FF = 512

IN_SIZES = (2 * DA_HEADS * DA_DIM, 2 * DA_HEADS * DA_DIM, DA_HEADS * DA_VDIM, S5_WIDTH,
            MLA_Q_RANK, MLA_KV_RANK, MLA_ROPE, RW_WIDTH, RW_WIDTH, RW_WIDTH, RW_WIDTH,
            N_BRANCH * D_MODEL)
IN_OFFSETS = tuple(int(o) for o in np.cumsum(IN_SIZES)[:-1])
N_IN = int(sum(IN_SIZES))

kernel_name = 'hybrid_prefix_dit_block'


def rms_norm(x, g, eps=EPS):
    xf = x.astype(jnp.float32)
    xf = xf * lax.rsqrt(jnp.mean(jnp.square(xf), axis=-1, keepdims=True) + eps)
    return (xf * g.astype(jnp.float32)).astype(x.dtype)


def modulate(x, g, shift, scale):
    return rms_norm(x, g) * (1 + scale) + shift


def axial_rope_tables(n_tokens, rot_dim):
    rows = n_tokens // GRID_W
    row = jnp.repeat(jnp.arange(rows, dtype=jnp.float32), GRID_W)
    col = jnp.tile(jnp.arange(GRID_W, dtype=jnp.float32), rows)
    n_freq = rot_dim // 4
    inv_freq = ROPE_BASE ** (-jnp.arange(n_freq, dtype=jnp.float32) / n_freq)
    ang = jnp.concatenate([row[:, None] * inv_freq, col[:, None] * inv_freq], axis=-1)
    return jnp.cos(ang), jnp.sin(ang)


def apply_rope(x, cos, sin):
    half = x.shape[-1] // 2
    x1, x2 = x[..., :half], x[..., half:]
    c = cos[:, None, :].astype(x.dtype)
    s = sin[:, None, :].astype(x.dtype)
    return jnp.concatenate([x1 * c - x2 * s, x2 * c + x1 * s], axis=-1)


def attend(q, k, v, scale):
    b, m, h, lq, d = q.shape
    nb = lq // Q_BLOCK
    qb = jnp.moveaxis(q.reshape(b, m, h, nb, Q_BLOCK, d), 3, 0)

    def block(qi):
        s = jnp.einsum('bmhqd,bmhkd->bmhqk', qi, k).astype(jnp.float32) * scale
        p = jax.nn.softmax(s, axis=-1).astype(v.dtype)
        return jnp.einsum('bmhqk,bhkd->bmhqd', p, v)

    o = lax.map(block, qb)
    return jnp.moveaxis(o, 0, 3).reshape(b, m, h, lq, v.shape[-1])


def diff_attention(q_l, k_l, v_l, q_c, k_c, v_c, cos, sin, qk_g, lam, subln_g, lambda_init, need_ctx):
    def prep(q, k, v, rotate):
        b, n, _ = q.shape
        q = rms_norm(q.reshape(b, n, 2 * DA_HEADS, DA_DIM), qk_g[0])
        k = rms_norm(k.reshape(b, n, 2 * DA_HEADS, DA_DIM), qk_g[1])
        if rotate:
            q, k = apply_rope(q, cos, sin), apply_rope(k, cos, sin)
        q = q.reshape(b, n, DA_HEADS, 2, DA_DIM).transpose(0, 3, 2, 1, 4)
        k = k.reshape(b, n, DA_HEADS, 2, DA_DIM).transpose(0, 3, 2, 1, 4)
        v = v.reshape(b, n, DA_HEADS, DA_VDIM).transpose(0, 2, 1, 3)
        return q, k, v

    ql, kl, vl = prep(q_l, k_l, v_l, True)
    qc, kc, vc = prep(q_c, k_c, v_c, False)
    lam32 = lam.astype(jnp.float32)
    lmbda = jnp.exp(jnp.sum(lam32[0] * lam32[1])) - jnp.exp(jnp.sum(lam32[2] * lam32[3])) + lambda_init
    scale = DA_DIM ** -0.5

    def combine(o):
        o = o[:, 0] - lmbda.astype(o.dtype) * o[:, 1]
        o = rms_norm(o, subln_g) * (1 - lambda_init)
        b, h, n, dv = o.shape
        return o.transpose(0, 2, 1, 3).reshape(b, n, h * dv)

    k_all = jnp.concatenate([kl, kc], axis=3)
    v_all = jnp.concatenate([vl, vc], axis=2)
    y_lat = combine(attend(ql, k_all, v_all, scale))
    y_ctx = combine(attend(qc, kc, vc, scale)) if need_ctx else None
    return y_lat, y_ctx


def _linear_combine(e1, e2):
    a1, b1 = e1
    a2, b2 = e2
    return a2 * a1, a2 * b1 + b2


def s5_scan(u, lam_re, lam_im, log_dt, b_re, b_im, h0, reverse):
    lam = lax.complex(lam_re.astype(jnp.float32), lam_im.astype(jnp.float32))
    dt = jnp.exp(log_dt.astype(jnp.float32))[:, None]
    a_bar = jnp.exp(lam * dt)
    b_mat = lax.complex(b_re.astype(jnp.float32), b_im.astype(jnp.float32))
    b_bar = ((a_bar - 1.0) / lam)[..., None] * b_mat
    bu = jnp.einsum('bngc,gpc->bngp', u.astype(jnp.complex64), b_bar)
    if h0 is not None:
        edge = -1 if reverse else 0
        bu = bu.at[:, edge].add(a_bar * h0)
    a = jnp.broadcast_to(a_bar, bu.shape)
    _, h = lax.associative_scan(_linear_combine, (a, bu), reverse=reverse, axis=1)
    return h


def s5_readout(h, c_re, c_im):
    return (jnp.einsum('bngp,gcp->bngc', h.real, c_re.astype(jnp.float32))
            - jnp.einsum('bngp,gcp->bngc', h.imag, c_im.astype(jnp.float32)))


def s5_mixer(u_l, u_c, lam_re, lam_im, log_dt, b_re, b_im, c_re, c_im, d, w_glu, b_glu, need_ctx):
    out_dtype = u_l.dtype

    def groups(u):
        return u.astype(jnp.float32).reshape(u.shape[0], u.shape[1], S5_GROUPS, S5_CH)

    ul, uc = groups(u_l), groups(u_c)
    ys_l = [d * ul]
    ys_c = [d * uc]
    for dr in range(2):
        rev = dr == 1
        prm = (lam_re[dr], lam_im[dr], log_dt[dr], b_re[dr], b_im[dr])
        h_c = s5_scan(uc, *prm, None, rev)
        h_final = h_c[:, 0] if rev else h_c[:, -1]
        h_l = s5_scan(ul, *prm, h_final, rev)
        ys_l.append(s5_readout(h_l, c_re[dr], c_im[dr]))
        if need_ctx:
            ys_c.append(s5_readout(h_c, c_re[dr], c_im[dr]))

    def glu(ys):
        y = sum(ys)
        b, n = y.shape[:2]
        z = jax.nn.gelu(y.reshape(b, n, S5_WIDTH))
        return (z * jax.nn.sigmoid(z @ w_glu + b_glu)).astype(out_dtype)

    return glu(ys_l), (glu(ys_c) if need_ctx else None)


def mla(cq_l, ckv_l, kr_l, cq_c, ckv_c, kr_c, cos, sin, cq_g, ckv_g, w_uq, w_ukv, qk_g, need_ctx):
    def prep(cq, ckv, kr, rotate):
        b, n, _ = cq.shape
        q = (rms_norm(cq, cq_g) @ w_uq).reshape(b, n, MLA_HEADS, MLA_NOPE + MLA_ROPE)
        kv = (rms_norm(ckv, ckv_g) @ w_ukv).reshape(b, n, MLA_HEADS, MLA_NOPE + MLA_VDIM)
        k_nope, v = kv[..., :MLA_NOPE], kv[..., MLA_NOPE:]
        k_rope = jnp.broadcast_to(kr[:, :, None, :], (b, n, MLA_HEADS, MLA_ROPE))
        k = jnp.concatenate([k_nope, k_rope], axis=-1)
        q = rms_norm(q, qk_g[0])
        k = rms_norm(k, qk_g[1])
        if rotate:
            q = jnp.concatenate([q[..., :MLA_NOPE], apply_rope(q[..., MLA_NOPE:], cos, sin)], axis=-1)
            k = jnp.concatenate([k[..., :MLA_NOPE], apply_rope(k[..., MLA_NOPE:], cos, sin)], axis=-1)
        return (q.transpose(0, 2, 1, 3)[:, None], k.transpose(0, 2, 1, 3)[:, None],
                v.transpose(0, 2, 1, 3))

    ql, kl, vl = prep(cq_l, ckv_l, kr_l, True)
    qc, kc, vc = prep(cq_c, ckv_c, kr_c, False)
    scale = (MLA_NOPE + MLA_ROPE) ** -0.5

    def heads_out(o):
        o = o[:, 0]
        b, h, n, dv = o.shape
        return o.transpose(0, 2, 1, 3).reshape(b, n, h * dv)

    k_all = jnp.concatenate([kl, kc], axis=3)
    v_all = jnp.concatenate([vl, vc], axis=2)
    y_lat = heads_out(attend(ql, k_all, v_all, scale))
    y_ctx = heads_out(attend(qc, kc, vc, scale)) if need_ctx else None
    return y_lat, y_ctx


def centred_shift(x):
    pad = jnp.pad(x, ((0, 0), (1, 1), (0, 0)))
    return 0.5 * (pad[:, :-2] + pad[:, 2:])


def rwkv_direction(xd, k, w0, w1, w2, a0, a1, a2, k_a):
    w_raw = w0 + jnp.tanh(xd @ w1) @ w2
    decay = jnp.exp(-jnp.exp(-jax.nn.softplus(-w_raw) - 0.5))
    a = jax.nn.sigmoid(a0 + (xd @ a1) @ a2)
    k_mod = k * (1 + (a - 1) * k_a)
    return decay, a, k_mod


def rwkv_scan(s0, r, w, k, v, kk, a, reverse):
    xs = tuple(jnp.moveaxis(t, 1, 0) for t in (r, w, k, v, kk, a))

    def step(s, inp):
        r_t, w_t, k_t, v_t, kk_t, a_t = inp
        sa = jnp.einsum('bhvk,bhk->bhv', s, -kk_t)
        s = (s * w_t[:, :, None, :] + sa[..., None] * (kk_t * a_t)[:, :, None, :]
             + v_t[..., None] * k_t[:, :, None, :])
        return s, jnp.einsum('bhvk,bhk->bhv', s, r_t)

    s_final, ys = lax.scan(step, s0, xs, reverse=reverse)
    return s_final, jnp.moveaxis(ys, 0, 1)


def rwkv_bonus(r, k, v, r_k):
    return jnp.sum(r * k * r_k, axis=-1, keepdims=True) * v


def rwkv_mixer(r_l, k_l, v_l, d_l, r_c, k_c, v_c, d_c, mu, w0, w1, w2, a0, a1, a2, g1, g2,
               k_k, k_a, r_k, ln_g, ln_b, need_ctx):
    out_dtype = r_l.dtype

    def streams(*ss):
        return [(s + (centred_shift(s) - s) * mu[i]).astype(jnp.float32) for i, s in enumerate(ss)]

    def heads(t):
        return t.reshape(t.shape[0], t.shape[1], RW_HEADS, RW_DIM)

    def removal_key(k):
        kk = heads(k * k_k)
        return kk / jnp.maximum(jnp.sqrt(jnp.sum(kk * kk, axis=-1, keepdims=True)), 1e-12)

    rl, kl, vl, xl = streams(r_l, k_l, v_l, d_l)
    rc, kc, vc, xc = streams(r_c, k_c, v_c, d_c)
    kk_l, kk_c = removal_key(kl), removal_key(kc)
    s0 = jnp.zeros((rc.shape[0], RW_HEADS, RW_DIM, RW_DIM), jnp.float32)
    ys_l, bon_l, ys_c, bon_c = [], [], [], []
    for dr in range(2):
        rev = dr == 1
        prm = (w0[dr], w1[dr], w2[dr], a0[dr], a1[dr], a2[dr], k_a)
        dec_c, a_c, km_c = rwkv_direction(xc, kc, *prm)
        s_c, y_c = rwkv_scan(s0, heads(rc), heads(dec_c), heads(km_c), heads(vc), kk_c, heads(a_c), rev)
        dec_l, a_l, km_l = rwkv_direction(xl, kl, *prm)
        _, y_l = rwkv_scan(s_c, heads(rl), heads(dec_l), heads(km_l), heads(vl), kk_l, heads(a_l), rev)
        ys_l.append(y_l)
        bon_l.append(rwkv_bonus(heads(rl), heads(km_l), heads(vl), r_k))
        if need_ctx:
            ys_c.append(y_c)
            bon_c.append(rwkv_bonus(heads(rc), heads(km_c), heads(vc), r_k))

    def finish(ys, bons, xd):
        y = sum(ys)
        mean = jnp.mean(y, axis=-1, keepdims=True)
        var = jnp.mean(jnp.square(y - mean), axis=-1, keepdims=True)
        y = (y - mean) * lax.rsqrt(var + RW_LN_EPS)
        b, n = y.shape[:2]
        y = y.reshape(b, n, RW_WIDTH) * ln_g + ln_b + sum(bons).reshape(b, n, RW_WIDTH)
        g = jax.nn.sigmoid(xd @ g1) @ g2
        return (y * g).astype(out_dtype)

    y_lat = finish(ys_l, bon_l, xl)
    y_ctx = finish(ys_c, bon_c, xc) if need_ctx else None
    return y_lat, y_ctx


def merge_branches(branches, gate_cols, w_branch_l, w_out_l):
    b, n, _ = gate_cols.shape
    gates = jax.nn.sigmoid(gate_cols.reshape(b, n, N_BRANCH, D_MODEL))
    merged = sum(gates[:, :, i] * (y @ w_branch_l[i]) for i, y in enumerate(branches))
    return merged @ w_out_l


def moe(h, router_w, router_bias, w_gate, w_up, w_down):
    t = h.shape[0]
    scores = jax.nn.sigmoid((h @ router_w).astype(jnp.float32))
    biased = (scores + router_bias.astype(jnp.float32)).reshape(t, N_GROUPS, EXPERTS_PER_GROUP)
    group_score = jnp.sum(lax.top_k(biased, TOP_K)[0], axis=-1)
    in_group = jax.nn.one_hot(jnp.argmax(group_score, axis=-1), N_GROUPS, dtype=jnp.bool_)
    masked = jnp.where(in_group[..., None], biased, -jnp.inf).reshape(t, N_EXPERTS)
    _, idx = lax.top_k(masked, TOP_K)
    w = jnp.take_along_axis(scores, idx, axis=-1)
    w = w / jnp.sum(w, axis=-1, keepdims=True)
    combine = jnp.sum(jax.nn.one_hot(idx, N_EXPERTS, dtype=jnp.float32) * w[..., None], axis=1).astype(h.dtype)
    out = 0
    for e in range(N_EXPERTS):
        act = jax.nn.silu(h @ w_gate[e]) * (h @ w_up[e])
        out = out + combine[:, e:e + 1] * (act @ w_down[e])
    return out


def setup_inputs(seed: int = 0) -> dict:
    key = jax.random.key(seed)
    keys = iter(jax.random.split(key, 64))
    f32 = jnp.float32

    def nrm(shape, scale):
        return scale * jax.random.normal(next(keys), shape, f32)

    def unif(shape, lo, hi):
        return jax.random.uniform(next(keys), shape, f32, lo, hi)

    def gain(shape):
        return 1.0 + nrm(shape, 0.05)

    dm = D_MODEL
    g, p, ch = S5_GROUPS, S5_STATE, S5_CH
    e = N_EXPERTS
    n_idx = jnp.arange(p, dtype=f32)
    return {
        'x': nrm((BATCH, SEQ, dm), 1.0),
        'c': nrm((BATCH, dm), 1.0),
        'ctx': nrm((BATCH, CTX_LEN, dm), 1.0),
        'c_ctx': nrm((dm,), 1.0),
        'w_ada': nrm((DEPTH, dm, 6 * dm), 0.5 * dm ** -0.5),
        'b_ada': nrm((DEPTH, 6 * dm), 0.02),
        'norm_mix_g': gain((DEPTH, dm)),
        'norm_ffn_g': gain((DEPTH, dm)),
        'w_in': nrm((DEPTH, dm, N_IN), dm ** -0.5),
        'da_qk_norm_g': gain((DEPTH, 2, DA_DIM)),
        'da_lambda': nrm((DEPTH, 4, DA_DIM), 0.1),
        'da_subln_g': gain((DEPTH, DA_VDIM)),
        's5_lam_re': -0.5 + nrm((DEPTH, 2, g, p), 0.01),
        's5_lam_im': jnp.broadcast_to(math.pi * n_idx, (DEPTH, 2, g, p)),
        's5_log_dt': unif((DEPTH, 2, g), math.log(1e-3), math.log(1e-1)),
        's5_b_re': nrm((DEPTH, 2, g, p, ch), (2 * ch) ** -0.5),
        's5_b_im': nrm((DEPTH, 2, g, p, ch), (2 * ch) ** -0.5),
        's5_c_re': nrm((DEPTH, 2, g, ch, p), p ** -0.5),
        's5_c_im': nrm((DEPTH, 2, g, ch, p), p ** -0.5),
        's5_d': nrm((DEPTH, g, ch), 1.0),
        's5_w_glu': nrm((DEPTH, S5_WIDTH, S5_WIDTH), S5_WIDTH ** -0.5),
        's5_b_glu': nrm((DEPTH, S5_WIDTH), 0.02),
        'mla_cq_norm_g': gain((DEPTH, MLA_Q_RANK)),
        'mla_ckv_norm_g': gain((DEPTH, MLA_KV_RANK)),
        'mla_w_uq': nrm((DEPTH, MLA_Q_RANK, MLA_HEADS * (MLA_NOPE + MLA_ROPE)), MLA_Q_RANK ** -0.5),
        'mla_w_ukv': nrm((DEPTH, MLA_KV_RANK, MLA_HEADS * (MLA_NOPE + MLA_VDIM)), MLA_KV_RANK ** -0.5),
        'mla_qk_norm_g': gain((DEPTH, 2, MLA_NOPE + MLA_ROPE)),
        'rw_mu': unif((DEPTH, 4, RW_WIDTH), 0.0, 1.0),
        'rw_w0': nrm((DEPTH, 2, RW_WIDTH), 1.0),
        'rw_w1': nrm((DEPTH, 2, RW_WIDTH, RW_DECAY_RANK), RW_WIDTH ** -0.5),
        'rw_w2': nrm((DEPTH, 2, RW_DECAY_RANK, RW_WIDTH), 0.1 * RW_DECAY_RANK ** -0.5),
        'rw_a0': nrm((DEPTH, 2, RW_WIDTH), 0.5),
        'rw_a1': nrm((DEPTH, 2, RW_WIDTH, RW_ICL_RANK), RW_WIDTH ** -0.5),
        'rw_a2': nrm((DEPTH, 2, RW_ICL_RANK, RW_WIDTH), 0.1 * RW_ICL_RANK ** -0.5),
        'rw_g1': nrm((DEPTH, RW_WIDTH, RW_GATE_RANK), RW_WIDTH ** -0.5),
        'rw_g2': nrm((DEPTH, RW_GATE_RANK, RW_WIDTH), RW_GATE_RANK ** -0.5),
        'rw_k_k': 0.85 + nrm((DEPTH, RW_WIDTH), 0.05),
        'rw_k_a': gain((DEPTH, RW_WIDTH)),
        'rw_r_k': nrm((DEPTH, RW_HEADS, RW_DIM), 0.1),
        'rw_ln_g': gain((DEPTH, RW_WIDTH)),
        'rw_ln_b': nrm((DEPTH, RW_WIDTH), 0.02),
        'w_branch': nrm((DEPTH, N_BRANCH, BRANCH_WIDTH, dm), BRANCH_WIDTH ** -0.5),
        'w_out': nrm((DEPTH, dm, dm), dm ** -0.5),
        'router_w': nrm((dm, e), dm ** -0.5),
        'router_bias': nrm((e,), 0.01),
        'exp_w_gate': nrm((DEPTH, e, dm, D_FF), dm ** -0.5),
        'exp_w_up': nrm((DEPTH, e, dm, D_FF), dm ** -0.5),
        'exp_w_down': nrm((DEPTH, e, D_FF, dm), D_FF ** -0.5),
    }


def reference(x, c, ctx, c_ctx, w_ada, b_ada, norm_mix_g, norm_ffn_g, w_in,
              da_qk_norm_g, da_lambda, da_subln_g,
              s5_lam_re, s5_lam_im, s5_log_dt, s5_b_re, s5_b_im, s5_c_re, s5_c_im, s5_d, s5_w_glu, s5_b_glu,
              mla_cq_norm_g, mla_ckv_norm_g, mla_w_uq, mla_w_ukv, mla_qk_norm_g,
              rw_mu, rw_w0, rw_w1, rw_w2, rw_a0, rw_a1, rw_a2, rw_g1, rw_g2, rw_k_k, rw_k_a, rw_r_k,
              rw_ln_g, rw_ln_b,
              w_branch, w_out, router_w, router_bias, exp_w_gate, exp_w_up, exp_w_down):
    b, n_lat, _ = x.shape
    cos_da, sin_da = axial_rope_tables(n_lat, DA_DIM)
    cos_mla, sin_mla = axial_rope_tables(n_lat, MLA_ROPE)
    cx = ctx
    for l in range(DEPTH):
        need_ctx = l < DEPTH - 1
        lambda_init = 0.8 - 0.6 * math.exp(-0.3 * l)
        mod = (jax.nn.silu(c) @ w_ada[l] + b_ada[l]).reshape(b, 6, 1, D_MODEL)
        mod_c = (jax.nn.silu(c_ctx) @ w_ada[l] + b_ada[l]).reshape(6, D_MODEL)

        h_l = modulate(x, norm_mix_g[l], mod[:, 0], mod[:, 1])
        h_c = modulate(cx, norm_mix_g[l], mod_c[0], mod_c[1])
        p_l = jnp.split(h_l @ w_in[l], IN_OFFSETS, axis=-1)
        p_c = jnp.split(h_c @ w_in[l], IN_OFFSETS, axis=-1)
        ya_l, ya_c = diff_attention(p_l[0], p_l[1], p_l[2], p_c[0], p_c[1], p_c[2], cos_da, sin_da,
                                    da_qk_norm_g[l], da_lambda[l], da_subln_g[l], lambda_init, need_ctx)
        yb_l, yb_c = s5_mixer(p_l[3], p_c[3], s5_lam_re[l], s5_lam_im[l], s5_log_dt[l], s5_b_re[l],
                              s5_b_im[l], s5_c_re[l], s5_c_im[l], s5_d[l], s5_w_glu[l], s5_b_glu[l], need_ctx)
        yc_l, yc_c = mla(p_l[4], p_l[5], p_l[6], p_c[4], p_c[5], p_c[6], cos_mla, sin_mla,
                         mla_cq_norm_g[l], mla_ckv_norm_g[l], mla_w_uq[l], mla_w_ukv[l], mla_qk_norm_g[l],
                         need_ctx)
        yd_l, yd_c = rwkv_mixer(p_l[7], p_l[8], p_l[9], p_l[10], p_c[7], p_c[8], p_c[9], p_c[10],
                                rw_mu[l], rw_w0[l], rw_w1[l], rw_w2[l], rw_a0[l], rw_a1[l], rw_a2[l],
                                rw_g1[l], rw_g2[l], rw_k_k[l], rw_k_a[l], rw_r_k[l], rw_ln_g[l], rw_ln_b[l],
                                need_ctx)
        x = x + mod[:, 2] * merge_branches([ya_l, yb_l, yc_l, yd_l], p_l[11], w_branch[l], w_out[l])
        if need_ctx:
            cx = cx + mod_c[2] * merge_branches([ya_c, yb_c, yc_c, yd_c], p_c[11], w_branch[l], w_out[l])

        f_l = modulate(x, norm_ffn_g[l], mod[:, 3], mod[:, 4])
        if need_ctx:
            f_c = modulate(cx, norm_ffn_g[l], mod_c[3], mod_c[4])
            toks = jnp.concatenate([f_l.reshape(-1, D_MODEL), f_c.reshape(-1, D_MODEL)], axis=0)
            y = moe(toks, router_w, router_bias, exp_w_gate[l], exp_w_up[l], exp_w_down[l])
            x = x + mod[:, 5] * y[: b * n_lat].reshape(x.shape)
            cx = cx + mod_c[5] * y[b * n_lat:].reshape(cx.shape)
        else:
            y = moe(f_l.reshape(-1, D_MODEL), router_w, router_bias, exp_w_gate[l], exp_w_up[l], exp_w_down[l])
            x = x + mod[:, 5] * y.reshape(x.shape)
    return x
```

```cpp
#include <hip/hip_runtime.h>
#include <stdint.h>
#include <math.h>

#define DEV __device__ __forceinline__
#define LAS __attribute__((address_space(3)))
typedef unsigned short bf16_t;
typedef short bf16x8 __attribute__((ext_vector_type(8)));
typedef float f32x16 __attribute__((ext_vector_type(16)));
typedef float f32x4 __attribute__((ext_vector_type(4)));
typedef unsigned u32x4 __attribute__((ext_vector_type(4)));
typedef unsigned u32x2 __attribute__((ext_vector_type(2)));

constexpr int NT = 256;
constexpr int DM = 1024, NB = 8, SEQ = 2048, CTXL = 256, GRIDW = 64;
constexpr int TL = NB * SEQ, TC = NB * CTXL, TT = TL + TC;
constexpr int NIN = 6480, LDP = 2432, NINP = 6528, NGATE0 = 2432;
constexpr int C_DAQ = 0, C_DAK = 256, C_DAV = 512, C_S5 = 768, C_CQ = 1024, C_CKV = 1216, C_KR = 1344,
              C_RWR = 1360, C_RWK = 1616, C_RWV = 1872, C_RWD = 2128, C_PEND = 2384;
constexpr int NEXP = 16, DFF = 512;
constexpr float EPS = 1e-6f;
constexpr float LOG2E = 1.4426950408889634f;

constexpr size_t al256(size_t x) { return (x + 255) & ~(size_t)255; }
constexpr size_t OFF_BAR  = 0;
constexpr size_t OFF_CTR  = 16384;
constexpr size_t ZERO_BYTES = 20480;
constexpr size_t OFF_MOD  = 32768;
constexpr size_t SZ_MOD   = (size_t)2 * 9 * 6144 * 4;
constexpr int    MOD_KS   = 8;
constexpr size_t OFF_MODP = al256(OFF_MOD + SZ_MOD);
constexpr size_t OFF_S5ST = al256(OFF_MODP + MOD_KS * SZ_MOD);
constexpr size_t OFF_LTOK = al256(OFF_S5ST + (size_t)2 * 8 * 16 * 8 * 64 * 2 * 4);
constexpr size_t OFF_LW   = al256(OFF_LTOK + (size_t)NEXP * TT * 4);
constexpr size_t OFF_WSM  = al256(OFF_LW + (size_t)NEXP * TT * 4);
constexpr int WS_GLUT = 0, WS_UQT = WS_GLUT + 256 * 256, WS_UKVT = WS_UQT + 192 * 192, WS_W1C = WS_UKVT + 384 * 128,
              WS_W2 = WS_W1C + 192 * 256, WS_G2T = WS_W2 + 4 * 256 * 64, WS_PER_LAYER = WS_G2T + 256 * 64;
constexpr size_t OFF_WIN  = al256(OFF_WSM + (size_t)2 * WS_PER_LAYER * 2);
constexpr size_t OFF_WBR  = al256(OFF_WIN + (size_t)NINP * 1024 * 2);
constexpr size_t OFF_WOUT = al256(OFF_WBR + (size_t)4 * 1024 * 256 * 2);
constexpr size_t OFF_WG1  = al256(OFF_WOUT + (size_t)1024 * 1024 * 2);
constexpr size_t OFF_WDN  = al256(OFF_WG1 + (size_t)NEXP * 1024 * 1024 * 2);
constexpr size_t OFF_H    = al256(OFF_WDN + (size_t)NEXP * 1024 * 512 * 2);
constexpr size_t OFF_P    = al256(OFF_H + (size_t)TT * 1024 * 2);
constexpr size_t OFF_GATE = al256(OFF_P + (size_t)TT * LDP * 2);
constexpr size_t OFF_MLAQ = al256(OFF_GATE + (size_t)TT * 4096);
constexpr size_t OFF_MLAK = al256(OFF_MLAQ + (size_t)TT * 192 * 2);
constexpr size_t OFF_MLAV = al256(OFF_MLAK + (size_t)TT * 192 * 2);
constexpr size_t OFF_RWX  = al256(OFF_MLAV + (size_t)TT * 256 * 2);
constexpr size_t OFF_Y    = al256(OFF_RWX + (size_t)TT * 1024 * 2);
constexpr size_t OFF_CX   = al256(OFF_Y + (size_t)TT * 1024 * 2);
constexpr size_t WS_END   = al256(OFF_CX + (size_t)TC * 1024 * 4);
constexpr size_t OFF_QRAW = OFF_Y;
constexpr size_t OFF_KVRAW = OFF_QRAW + (size_t)TT * 192 * 2;
constexpr size_t OFF_LR   = OFF_KVRAW + (size_t)TT * 384 * 2;
constexpr size_t OFF_XL   = OFF_LR + (size_t)TT * 192 * 2;
static_assert(OFF_XL + (size_t)TT * 256 * 2 <= OFF_Y + (size_t)TT * 1024 * 2, "temps overflow Y");
constexpr size_t OFF_RWY  = OFF_H;

constexpr int CTR_MOE = 0;
constexpr int CTR_Q   = 64;

constexpr int SMEM_BYTES = 73728 + 256;

struct Params {
    const float* in[48];
    float* out;
    char* ws;
};
enum { I_X = 0, I_C, I_CTX, I_CCTX, I_WADA, I_BADA, I_NMG, I_NFG, I_WIN, I_DAQKG, I_DALAM, I_DASUB,
       I_S5LRE, I_S5LIM, I_S5LDT, I_S5BRE, I_S5BIM, I_S5CRE, I_S5CIM, I_S5D, I_S5WGLU, I_S5BGLU,
       I_MCQG, I_MCKVG, I_MWUQ, I_MWUKV, I_MQKG,
       I_RMU, I_RW0, I_RW1, I_RW2, I_RA0, I_RA1, I_RA2, I_RG1, I_RG2, I_RKK, I_RKA, I_RRK, I_RLNG, I_RLNB,
       I_WBR, I_WOUT, I_ROUTW, I_ROUTB, I_EWG, I_EWU, I_EWD };

DEV bf16_t f2bf(float f) { unsigned u = __float_as_uint(f); u += 0x7FFFu + ((u >> 16) & 1u); return (bf16_t)(u >> 16); }
DEV float bf2f(bf16_t h) { return __uint_as_float(((unsigned)h) << 16); }
DEV unsigned pack2(float lo, float hi) { return (unsigned)f2bf(lo) | ((unsigned)f2bf(hi) << 16); }
DEV float bflo(unsigned u) { return __uint_as_float(u << 16); }
DEV float bfhi(unsigned u) { return __uint_as_float(u & 0xFFFF0000u); }
DEV float sigmoidf_(float x) { return 1.f / (1.f + __expf(-x)); }
DEV float wave_sum(float v) {
#pragma unroll
    for (int o = 32; o >= 1; o >>= 1) v += __shfl_xor(v, o, 64);
    return v;
}
template <int W> DEV float group_sum(float v) {
#pragma unroll
    for (int o = W / 2; o >= 1; o >>= 1) v += __shfl_xor(v, o, 64);
    return v;
}
DEV int mod_row(int t) { return t < TL ? (t >> 11) : 8; }
DEV bf16_t* wsb(const Params& p, size_t off) { return (bf16_t*)(p.ws + off); }
DEV float* wsf(const Params& p, size_t off) { return (float*)(p.ws + off); }
DEV const float* modp(const Params& p, int l, int row, int which) { return (const float*)(p.ws + OFF_MOD) + ((size_t)(l * 9 + row) * 6 + which) * 1024; }
DEV void phase_mod_partial(const Params& p, char* smem) {
    float* sm = (float*)smem;
    const int tid = threadIdx.x;
    const int nitems = 2 * 24 * MOD_KS;
    for (int item = blockIdx.x; item < nitems; item += gridDim.x) {
        const int l = item / (24 * MOD_KS), rem = item % (24 * MOD_KS), jc = rem / MOD_KS, ks = rem % MOD_KS;
        __syncthreads();
        for (int i = tid; i < 9 * 128; i += NT) {
            const int r = i >> 7, k = ks * 128 + (i & 127);
            const float cv = r < 8 ? p.in[I_C][r * 1024 + k] : p.in[I_CCTX][k];
            sm[i] = cv / (1.f + __expf(-cv));
        }
        __syncthreads();
        const int j = jc * 256 + tid;
        float acc[9];
#pragma unroll
        for (int r = 0; r < 9; ++r) acc[r] = 0.f;
        const float* w = p.in[I_WADA] + (size_t)l * 1024 * 6144 + (size_t)(ks * 128) * 6144 + j;
#pragma unroll 8
        for (int k = 0; k < 128; ++k) {
            const float wv = w[(size_t)k * 6144];
#pragma unroll
            for (int r = 0; r < 9; ++r) acc[r] += sm[r * 128 + k] * wv;
        }
        float* dst = wsf(p, OFF_MODP);
#pragma unroll
        for (int r = 0; r < 9; ++r) dst[((size_t)(ks * 2 + l) * 9 + r) * 6144 + j] = acc[r];
    }
}
DEV void phase_mod_reduce(const Params& p) {
    const int n = 2 * 9 * 6144;
    float* mod = wsf(p, OFF_MOD);
    const float* part = wsf(p, OFF_MODP);
    for (int i = blockIdx.x * NT + threadIdx.x; i < n; i += gridDim.x * NT) {
        const int l = i / (9 * 6144), j = i % 6144;
        float s = p.in[I_BADA][l * 6144 + j];
#pragma unroll
        for (int ks = 0; ks < MOD_KS; ++ks) s += part[(size_t)ks * n + i];
        mod[i] = s;
    }
}

template <int MODE>
DEV void conv_tile(const float* src, int R, int C, int ld, bf16_t* dst, int ldd, int roff, int tr, int tc, float* sm) {
    const int r0 = tr * 64, c0 = tc * 64, tid = threadIdx.x;
    for (int i = tid; i < 64 * 16; i += NT) {
        const int r = i >> 4, c4 = (i & 15) * 4;
        float4 v = make_float4(0.f, 0.f, 0.f, 0.f);
        if (r0 + r < R) {
            const float* s = src + (size_t)(r0 + r) * ld + c0 + c4;
            if (c0 + c4 + 3 < C) v = *(const float4*)s;
            else { if (c0 + c4 < C) v.x = s[0]; if (c0 + c4 + 1 < C) v.y = s[1]; if (c0 + c4 + 2 < C) v.z = s[2]; }
        }
        float* d = sm + r * 65 + c4;
        d[0] = v.x; d[1] = v.y; d[2] = v.z; d[3] = v.w;
    }
    __syncthreads();
    for (int i = tid; i < 64 * 8; i += NT) {
        const int c = i >> 3, r8 = (i & 7) * 8;
        if (c0 + c < C && r0 + r8 < R) {
            const int cc = c0 + c;
            const int drow = (MODE == 0) ? (cc + roff) : ((cc >> 5) * 64 + (cc & 31) + roff);
            uint4 o;
            o.x = pack2(sm[(r8 + 0) * 65 + c], sm[(r8 + 1) * 65 + c]);
            o.y = pack2(sm[(r8 + 2) * 65 + c], sm[(r8 + 3) * 65 + c]);
            o.z = pack2(sm[(r8 + 4) * 65 + c], sm[(r8 + 5) * 65 + c]);
            o.w = pack2(sm[(r8 + 6) * 65 + c], sm[(r8 + 7) * 65 + c]);
            *(uint4*)(dst + (size_t)drow * ldd + r0 + r8) = o;
        }
    }
    __syncthreads();
}
template <int MODE>
DEV void conv_job(const float* src, int R, int C, int ld, bf16_t* dst, int ldd, int roff, int& rot, float* sm) {
    const int ntr = (R + 63) >> 6, ntc = (C + 63) >> 6, nt = ntr * ntc, G = gridDim.x;
    int first = ((int)blockIdx.x - (rot % G) + G) % G;
    for (int t = first; t < nt; t += G) conv_tile<MODE>(src, R, C, ld, dst, ldd, roff, t / ntc, t % ntc, sm);
    rot += nt;
}
DEV void phase_conv_layer(const Params& p, int l, char* smem) {
    float* sm = (float*)smem;
    int rot = 0;
    const float* win = p.in[I_WIN] + (size_t)l * 1024 * NIN;
    conv_job<0>(win, 1024, C_PEND, NIN, wsb(p, OFF_WIN), 1024, 0, rot, sm);
    conv_job<0>(win + C_PEND, 1024, 4096, NIN, wsb(p, OFF_WIN), 1024, NGATE0, rot, sm);
    {
        uint4* z = (uint4*)(wsb(p, OFF_WIN) + (size_t)C_PEND * 1024);
        const int n = (NGATE0 - C_PEND) * 1024 / 8;
        for (int i = blockIdx.x * NT + threadIdx.x; i < n; i += gridDim.x * NT) z[i] = make_uint4(0u, 0u, 0u, 0u);
    }
    for (int i = 0; i < 4; ++i)
        conv_job<0>(p.in[I_WBR] + (size_t)(l * 4 + i) * 256 * 1024, 256, 1024, 1024, wsb(p, OFF_WBR) + (size_t)i * 1024 * 256, 256, 0, rot, sm);
    conv_job<0>(p.in[I_WOUT] + (size_t)l * 1024 * 1024, 1024, 1024, 1024, wsb(p, OFF_WOUT), 1024, 0, rot, sm);
}
DEV void phase_conv_experts(const Params& p, int l, char* smem) {
    float* sm = (float*)smem;
    int rot = 0;
    for (int e = 0; e < NEXP; ++e) {
        conv_job<1>(p.in[I_EWG] + (size_t)(l * NEXP + e) * 1024 * DFF, 1024, DFF, DFF, wsb(p, OFF_WG1) + (size_t)e * 1024 * 1024, 1024, 0, rot, sm);
        conv_job<1>(p.in[I_EWU] + (size_t)(l * NEXP + e) * 1024 * DFF, 1024, DFF, DFF, wsb(p, OFF_WG1) + (size_t)e * 1024 * 1024, 1024, 32, rot, sm);
        conv_job<0>(p.in[I_EWD] + (size_t)(l * NEXP + e) * DFF * 1024, DFF, 1024, 1024, wsb(p, OFF_WDN) + (size_t)e * 1024 * DFF, DFF, 0, rot, sm);
    }
}
DEV void phase_conv_small(const Params& p, char* smem) {
    float* sm = (float*)smem;
    int rot = 0;
    for (int l = 0; l < 2; ++l) {
        bf16_t* w = wsb(p, OFF_WSM) + (size_t)l * WS_PER_LAYER;
        for (int i = blockIdx.x * NT + threadIdx.x; i < 4 * 256 * 4; i += gridDim.x * NT)
            *(u32x4*)(w + WS_W2 + (size_t)(i >> 2) * 64 + 32 + (i & 3) * 8) = (u32x4){0u, 0u, 0u, 0u};
        conv_job<0>(p.in[I_S5WGLU] + (size_t)l * 256 * 256, 256, 256, 256, w + WS_GLUT, 256, 0, rot, sm);
        conv_job<0>(p.in[I_MWUQ] + (size_t)l * 192 * 192, 192, 192, 192, w + WS_UQT, 192, 0, rot, sm);
        conv_job<0>(p.in[I_MWUKV] + (size_t)l * 128 * 384, 128, 384, 384, w + WS_UKVT, 128, 0, rot, sm);
        for (int d = 0; d < 2; ++d) {
            conv_job<0>(p.in[I_RW1] + (size_t)(l * 2 + d) * 256 * 32, 256, 32, 32, w + WS_W1C, 256, d * 32, rot, sm);
            conv_job<0>(p.in[I_RA1] + (size_t)(l * 2 + d) * 256 * 32, 256, 32, 32, w + WS_W1C, 256, 64 + d * 32, rot, sm);
            conv_job<0>(p.in[I_RW2] + (size_t)(l * 2 + d) * 32 * 256, 32, 256, 256, w + WS_W2 + (size_t)d * 256 * 64, 64, 0, rot, sm);
            conv_job<0>(p.in[I_RA2] + (size_t)(l * 2 + d) * 32 * 256, 32, 256, 256, w + WS_W2 + (size_t)(2 + d) * 256 * 64, 64, 0, rot, sm);
        }
        conv_job<0>(p.in[I_RG1] + (size_t)l * 256 * 64, 256, 64, 64, w + WS_W1C, 256, 128, rot, sm);
        conv_job<0>(p.in[I_RG2] + (size_t)l * 64 * 256, 64, 256, 256, w + WS_G2T, 64, 0, rot, sm);
    }
}

template <int WHICH>
DEV void phase_norm(const Params& p, int l, int nrows) {
    const int lane = threadIdx.x & 63, wave = threadIdx.x >> 6;
    const float* xs = (l == 0) ? p.in[I_X] : p.out;
    const float* cs = (l == 0) ? p.in[I_CTX] : wsf(p, OFF_CX);
    const float* g = p.in[WHICH == 1 ? I_NMG : I_NFG] + l * 1024;
    bf16_t* H = wsb(p, OFF_H);
    if (WHICH == 2) { xs = p.out; cs = wsf(p, OFF_CX); }
    for (int row = blockIdx.x * 4 + wave; row < nrows; row += gridDim.x * 4) {
        const float* src = row < TL ? xs + (size_t)row * 1024 : cs + (size_t)(row - TL) * 1024;
        const int mr = mod_row(row);
        const float* sh = modp(p, l, mr, WHICH == 1 ? 0 : 3);
        const float* sc = modp(p, l, mr, WHICH == 1 ? 1 : 4);
        float4 v[4];
        float ss = 0.f;
#pragma unroll
        for (int i = 0; i < 4; ++i) {
            v[i] = *(const float4*)(src + lane * 4 + i * 256);
            ss += v[i].x * v[i].x + v[i].y * v[i].y + v[i].z * v[i].z + v[i].w * v[i].w;
        }
        ss = wave_sum(ss);
        const float rstd = rsqrtf(ss * (1.f / 1024.f) + EPS);
        float hv[16];
#pragma unroll
        for (int i = 0; i < 4; ++i) {
            const int c = lane * 4 + i * 256;
            const float4 gg = *(const float4*)(g + c), s4 = *(const float4*)(sh + c), c4 = *(const float4*)(sc + c);
            hv[i * 4 + 0] = v[i].x * rstd * gg.x * (1.f + c4.x) + s4.x;
            hv[i * 4 + 1] = v[i].y * rstd * gg.y * (1.f + c4.y) + s4.y;
            hv[i * 4 + 2] = v[i].z * rstd * gg.z * (1.f + c4.z) + s4.z;
            hv[i * 4 + 3] = v[i].w * rstd * gg.w * (1.f + c4.w) + s4.w;
            u32x2 o; o.x = pack2(hv[i * 4 + 0], hv[i * 4 + 1]); o.y = pack2(hv[i * 4 + 2], hv[i * 4 + 3]);
            *(u32x2*)(H + (size_t)row * 1024 + c) = o;
        }
        if (WHICH == 2) {
            float lg[16];
#pragma unroll
            for (int e = 0; e < 16; ++e) lg[e] = 0.f;
            const float* rw = p.in[I_ROUTW];
#pragma unroll
            for (int i = 0; i < 4; ++i)
#pragma unroll
                for (int j = 0; j < 4; ++j) {
                    const int c = lane * 4 + i * 256 + j;
                    const float hvv = hv[i * 4 + j];
#pragma unroll
                    for (int q = 0; q < 4; ++q) {
                        const float4 w4 = *(const float4*)(rw + (size_t)c * 16 + q * 4);
                        lg[q * 4 + 0] += hvv * w4.x; lg[q * 4 + 1] += hvv * w4.y; lg[q * 4 + 2] += hvv * w4.z; lg[q * 4 + 3] += hvv * w4.w;
                    }
                }
#pragma unroll
            for (int e = 0; e < 16; ++e) lg[e] = wave_sum(lg[e]);
            float sc16[16], bs[16];
#pragma unroll
            for (int e = 0; e < 16; ++e) { sc16[e] = sigmoidf_(lg[e]); bs[e] = sc16[e] + p.in[I_ROUTB][e]; }
            int bestg = 0; float bestv = -INFINITY;
#pragma unroll
            for (int gi = 0; gi < 4; ++gi) {
                float m1 = -INFINITY, m2 = -INFINITY;
#pragma unroll
                for (int k = 0; k < 4; ++k) { const float x = bs[gi * 4 + k]; if (x > m1) { m2 = m1; m1 = x; } else if (x > m2) m2 = x; }
                const float gs = m1 + m2;
                if (gs > bestv) { bestv = gs; bestg = gi; }
            }
            int i0 = 0, i1 = 0; float v0 = -INFINITY, v1 = -INFINITY, s0 = 0.f, s1 = 0.f;
#pragma unroll
            for (int e = 0; e < 16; ++e) { const bool in = (e >> 2) == bestg; if (in && bs[e] > v0) { v0 = bs[e]; i0 = e; s0 = sc16[e]; } }
#pragma unroll
            for (int e = 0; e < 16; ++e) { const bool in = (e >> 2) == bestg && e != i0; if (in && bs[e] > v1) { v1 = bs[e]; i1 = e; s1 = sc16[e]; } }
            const float inv = 1.f / (s0 + s1);
            if (lane == 0) {
                int* cnt = (int*)(p.ws + OFF_CTR) + CTR_MOE + l * 16;
                int* ltok = (int*)(p.ws + OFF_LTOK);
                float* lw = (float*)(p.ws + OFF_LW);
                const int p0 = atomicAdd(cnt + i0, 1);
                ltok[(size_t)i0 * TT + p0] = row; lw[(size_t)i0 * TT + p0] = s0 * inv;
                const int p1 = atomicAdd(cnt + i1, 1);
                ltok[(size_t)i1 * TT + p1] = row; lw[(size_t)i1 * TT + p1] = s1 * inv;
            }
        }
    }
}
constexpr int GLD = 72;
constexpr int GSTAGE = 128 * GLD;
template <class AF, class BF>
DEV void gemm_mainloop(f32x16 (&acc)[2][2], AF arow, BF brow, int K, bf16_t* sm) {
    const int tid = threadIdx.x, lane = tid & 63, wave = tid >> 6, wm = wave >> 1, wn = wave & 1;
    bf16_t* As = sm;
    bf16_t* Bs = sm + 2 * GSTAGE;
    const bf16_t* ap[4]; const bf16_t* bp[4];
#pragma unroll
    for (int i = 0; i < 4; ++i) { const int q = tid + i * NT; ap[i] = arow(q >> 3) + (q & 7) * 8; bp[i] = brow(q >> 3) + (q & 7) * 8; }
    u32x4 ra[4], rb[4];
    const int nk = K >> 6;
#pragma unroll
    for (int i = 0; i < 4; ++i) { ra[i] = *(const u32x4*)ap[i]; rb[i] = *(const u32x4*)bp[i]; }
    __syncthreads();
#pragma unroll
    for (int i = 0; i < 4; ++i) { const int q = tid + i * NT; *(u32x4*)(As + (q >> 3) * GLD + (q & 7) * 8) = ra[i]; *(u32x4*)(Bs + (q >> 3) * GLD + (q & 7) * 8) = rb[i]; }
    __syncthreads();
    const int arow0 = (wm * 64 + (lane & 31)) * GLD + (lane >> 5) * 8;
    const int brow0 = (wn * 64 + (lane & 31)) * GLD + (lane >> 5) * 8;
    for (int kt = 0; kt < nk; ++kt) {
        const int cur = kt & 1;
        if (kt + 1 < nk) {
            const int k0 = (kt + 1) * 64;
#pragma unroll
            for (int i = 0; i < 4; ++i) { ra[i] = *(const u32x4*)(ap[i] + k0); rb[i] = *(const u32x4*)(bp[i] + k0); }
        }
        const bf16_t* a_s = As + cur * GSTAGE + arow0;
        const bf16_t* b_s = Bs + cur * GSTAGE + brow0;
#pragma unroll
        for (int ks = 0; ks < 4; ++ks) {
            const bf16x8 a0 = *(const bf16x8*)(a_s + ks * 16);
            const bf16x8 a1 = *(const bf16x8*)(a_s + 32 * GLD + ks * 16);
            const bf16x8 b0 = *(const bf16x8*)(b_s + ks * 16);
            const bf16x8 b1 = *(const bf16x8*)(b_s + 32 * GLD + ks * 16);
            acc[0][0] = __builtin_amdgcn_mfma_f32_32x32x16_bf16(a0, b0, acc[0][0], 0, 0, 0);
            acc[0][1] = __builtin_amdgcn_mfma_f32_32x32x16_bf16(a0, b1, acc[0][1], 0, 0, 0);
            acc[1][0] = __builtin_amdgcn_mfma_f32_32x32x16_bf16(a1, b0, acc[1][0], 0, 0, 0);
            acc[1][1] = __builtin_amdgcn_mfma_f32_32x32x16_bf16(a1, b1, acc[1][1], 0, 0, 0);
        }
        if (kt + 1 < nk) {
            const int nx = cur ^ 1;
#pragma unroll
            for (int i = 0; i < 4; ++i) { const int q = tid + i * NT; *(u32x4*)(As + nx * GSTAGE + (q >> 3) * GLD + (q & 7) * 8) = ra[i]; *(u32x4*)(Bs + nx * GSTAGE + (q >> 3) * GLD + (q & 7) * 8) = rb[i]; }
        }
        __syncthreads();
    }
}
DEV void acc_zero(f32x16 (&acc)[2][2]) {
#pragma unroll
    for (int i = 0; i < 2; ++i)
#pragma unroll
        for (int j = 0; j < 2; ++j)
#pragma unroll
            for (int r = 0; r < 16; ++r) acc[i][j][r] = 0.f;
}
#define EPI_FOREACH(acc, ...)                                                                           \
    {                                                                                                    \
        const int _lane = threadIdx.x & 63, _wave = threadIdx.x >> 6, _wm = _wave >> 1, _wn = _wave & 1; \
        _Pragma("unroll") for (int _i = 0; _i < 2; ++_i)                                                 \
        _Pragma("unroll") for (int _j = 0; _j < 2; ++_j)                                                 \
        _Pragma("unroll") for (int _r = 0; _r < 16; ++_r) {                                              \
            const int er = _wm * 64 + _i * 32 + (_r & 3) + 8 * (_r >> 2) + 4 * (_lane >> 5);             \
            const int ec = _wn * 64 + _j * 32 + (_lane & 31);                                            \
            const float ev = acc[_i][_j][_r];                                                            \
            __VA_ARGS__                                                                                  \
        }                                                                                                \
    }

DEV void tile_mn(int item, int nMt, int nNt, int& mt, int& nt) {
    constexpr int GM = 16;
    const int per = GM * nNt, g = item / per, rem = item % per;
    const int m0 = g * GM, gsz = (nMt - m0) < GM ? (nMt - m0) : GM;
    mt = m0 + rem % gsz; nt = rem / gsz;
}

DEV void phase_inproj(const Params& p, int l, char* smem) {
    bf16_t* sm = (bf16_t*)smem;
    const bf16_t* H = wsb(p, OFF_H);
    const bf16_t* W = wsb(p, OFF_WIN);
    bf16_t* P = wsb(p, OFF_P);
    unsigned char* G = (unsigned char*)(p.ws + OFF_GATE);
    const int nMt = TT / 128, nNt = NINP / 128;
    for (int item = blockIdx.x; item < nMt * nNt; item += gridDim.x) {
        int mt, nt; tile_mn(item, nMt, nNt, mt, nt);
        const int m0 = mt * 128, n0 = nt * 128;
        if (l == 1 && m0 >= TL && n0 >= NGATE0) continue;
        f32x16 acc[2][2]; acc_zero(acc);
        gemm_mainloop(acc, [&](int r) { return H + (size_t)(m0 + r) * 1024; }, [&](int r) { return W + (size_t)(n0 + r) * 1024; }, 1024, sm);
        if (n0 < NGATE0) {
            EPI_FOREACH(acc, { const int col = n0 + ec; if (col < C_PEND) P[(size_t)(m0 + er) * LDP + col] = f2bf(ev); })
        } else {
            EPI_FOREACH(acc, { const int col = n0 + ec - NGATE0; const float s = sigmoidf_(ev); G[(size_t)(m0 + er) * 4096 + col] = (unsigned char)__float2int_rn(s * 255.f); })
        }
    }
}

template <class EF>
DEV void gemm_generic(const bf16_t* A, int lda, int M, const bf16_t* Bt, int ldb, int N, int K, EF ef, char* smem, int rot) {
    bf16_t* sm = (bf16_t*)smem;
    const int nMt = (M + 127) / 128, nNt = (N + 127) / 128, G = gridDim.x;
    const int first = ((int)blockIdx.x - (rot % G) + G) % G;
    for (int item = first; item < nMt * nNt; item += G) {
        const int mt = item / nNt, nt = item % nNt, m0 = mt * 128, n0 = nt * 128;
        f32x16 acc[2][2]; acc_zero(acc);
        gemm_mainloop(acc, [&](int r) { int rr = m0 + r; rr = rr < M ? rr : M - 1; return A + (size_t)rr * lda; },
                      [&](int r) { int rr = n0 + r; rr = rr < N ? rr : N - 1; return Bt + (size_t)rr * ldb; }, K, sm);
        EPI_FOREACH(acc, { const int row = m0 + er, col = n0 + ec; if (row < M && col < N) ef(row, col, ev); })
    }
}

DEV void phase_merge(const Params& p, int l, int M, char* smem) {
    bf16_t* sm = (bf16_t*)smem;
    const bf16_t* Y = wsb(p, OFF_Y);
    const bf16_t* W = wsb(p, OFF_WBR);
    const unsigned char* G = (const unsigned char*)(p.ws + OFF_GATE);
    bf16_t* MG = wsb(p, OFF_H);
    const int nMt = M / 128, nNt = 8;
    for (int item = blockIdx.x; item < nMt * nNt; item += gridDim.x) {
        const int mt = item / nNt, nt = item % nNt, m0 = mt * 128, n0 = nt * 128;
        f32x16 tot[2][2]; acc_zero(tot);
        for (int i = 0; i < 4; ++i) {
            f32x16 acc[2][2]; acc_zero(acc);
            gemm_mainloop(acc, [&](int r) { return Y + (size_t)(m0 + r) * 1024 + i * 256; }, [&](int r) { return W + ((size_t)i * 1024 + n0 + r) * 256; }, 256, sm);
            const int lane = threadIdx.x & 63, wave = threadIdx.x >> 6, wm = wave >> 1, wn = wave & 1;
#pragma unroll
            for (int a = 0; a < 2; ++a)
#pragma unroll
                for (int b = 0; b < 2; ++b)
#pragma unroll
                    for (int r = 0; r < 16; ++r) {
                        const int er = wm * 64 + a * 32 + (r & 3) + 8 * (r >> 2) + 4 * (lane >> 5), ec = wn * 64 + b * 32 + (lane & 31);
                        const float g = (float)G[(size_t)(m0 + er) * 4096 + i * 1024 + n0 + ec] * (1.f / 255.f);
                        tot[a][b][r] += g * acc[a][b][r];
                    }
        }
        EPI_FOREACH(tot, { MG[(size_t)(m0 + er) * 1024 + n0 + ec] = f2bf(ev); })
    }
}

DEV void phase_outproj(const Params& p, int l, int M, char* smem) {
    bf16_t* sm = (bf16_t*)smem;
    const bf16_t* MG = wsb(p, OFF_H);
    const bf16_t* W = wsb(p, OFF_WOUT);
    const float* xs = (l == 0) ? p.in[I_X] : p.out;
    const float* cs = (l == 0) ? p.in[I_CTX] : wsf(p, OFF_CX);
    float* cxd = wsf(p, OFF_CX);
    const int nMt = M / 128, nNt = 8;
    for (int item = blockIdx.x; item < nMt * nNt; item += gridDim.x) {
        const int mt = item / nNt, nt = item % nNt, m0 = mt * 128, n0 = nt * 128;
        f32x16 acc[2][2]; acc_zero(acc);
        gemm_mainloop(acc, [&](int r) { return MG + (size_t)(m0 + r) * 1024; }, [&](int r) { return W + (size_t)(n0 + r) * 1024; }, 1024, sm);
        const float* g1 = modp(p, l, mod_row(m0), 2);
        if (m0 < TL) {
            EPI_FOREACH(acc, { const size_t o = (size_t)(m0 + er) * 1024 + n0 + ec; p.out[o] = xs[o] + g1[n0 + ec] * ev; })
        } else {
            EPI_FOREACH(acc, { const size_t o = (size_t)(m0 - TL + er) * 1024 + n0 + ec; cxd[o] = cs[o] + g1[n0 + ec] * ev; })
        }
    }
}

constexpr int MOE_MAP_OFF = 73728;
DEV void moe_map(const Params& p, int l, char* smem) {
    int* mm = (int*)(smem + MOE_MAP_OFF);
    __syncthreads();
    if (threadIdx.x == 0) {
        const int* cnt = (const int*)(p.ws + OFF_CTR) + CTR_MOE + l * 16;
        int b = 0, t = 0;
        for (int e = 0; e < 16; ++e) { const int c = cnt[e]; mm[e] = c; mm[16 + e] = b; mm[32 + e] = t; b += c; t += (c + 127) >> 7; }
        mm[48] = t;
    }
    __syncthreads();
}
DEV void phase_moe1(const Params& p, int l, char* smem) {
    bf16_t* sm = (bf16_t*)smem;
    const bf16_t* F = wsb(p, OFF_H);
    const bf16_t* W = wsb(p, OFF_WG1);
    bf16_t* ACT = wsb(p, OFF_P);
    const int* ltok = (const int*)(p.ws + OFF_LTOK);
    moe_map(p, l, smem); const int* mm = (const int*)(smem + MOE_MAP_OFF);
    const int nNt = 8, total = mm[48] * nNt;
    for (int item = blockIdx.x; item < total; item += gridDim.x) {
        const int mtg = item / nNt, nt = item % nNt;
        int e = 0;
        for (int q = 1; q < 16; ++q) if (mtg >= mm[32 + q]) e = q;
        const int m0 = (mtg - mm[32 + e]) * 128, n0 = nt * 128, ce = mm[e];
        const int* lt = ltok + (size_t)e * TT;
        f32x16 acc[2][2]; acc_zero(acc);
        gemm_mainloop(acc, [&](int r) { int idx = m0 + r; idx = idx < ce ? idx : ce - 1; return F + (size_t)lt[idx] * 1024; },
                      [&](int r) { return W + ((size_t)e * 1024 + n0 + r) * 1024; }, 1024, sm);
        const int lane = threadIdx.x & 63, wave = threadIdx.x >> 6, wm = wave >> 1, wn = wave & 1;
        const int jcol = ((n0 >> 6) + wn) * 32 + (lane & 31);
#pragma unroll
        for (int a = 0; a < 2; ++a)
#pragma unroll
            for (int r = 0; r < 16; ++r) {
                const int idx = m0 + wm * 64 + a * 32 + (r & 3) + 8 * (r >> 2) + 4 * (lane >> 5);
                if (idx < ce) {
                    const float g = acc[a][0][r], u = acc[a][1][r];
                    ACT[(size_t)(mm[16 + e] + idx) * DFF + jcol] = f2bf(g * sigmoidf_(g) * u);
                }
            }
    }
}
DEV void phase_moe2(const Params& p, int l, char* smem) {
    bf16_t* sm = (bf16_t*)smem;
    const bf16_t* ACT = wsb(p, OFF_P);
    const bf16_t* W = wsb(p, OFF_WDN);
    const int* ltok = (const int*)(p.ws + OFF_LTOK);
    const float* lw = (const float*)(p.ws + OFF_LW);
    float* cxd = wsf(p, OFF_CX);
    moe_map(p, l, smem); const int* mm = (const int*)(smem + MOE_MAP_OFF);
    const int nNt = 8, total = mm[48] * nNt;
    for (int item = blockIdx.x; item < total; item += gridDim.x) {
        const int mtg = item / nNt, nt = item % nNt;
        int e = 0;
        for (int q = 1; q < 16; ++q) if (mtg >= mm[32 + q]) e = q;
        const int m0 = (mtg - mm[32 + e]) * 128, n0 = nt * 128, ce = mm[e];
        f32x16 acc[2][2]; acc_zero(acc);
        gemm_mainloop(acc, [&](int r) { int idx = m0 + r; idx = idx < ce ? idx : ce - 1; return ACT + (size_t)(mm[16 + e] + idx) * DFF; },
                      [&](int r) { return W + ((size_t)e * 1024 + n0 + r) * DFF; }, DFF, sm);
        EPI_FOREACH(acc, {
            const int idx = m0 + er;
            if (idx < ce) {
                const int tok = ltok[(size_t)e * TT + idx];
                const float w = lw[(size_t)e * TT + idx];
                const int col = n0 + ec;
                const float g2 = modp(p, l, mod_row(tok), 5)[col];
                float* dst = tok < TL ? p.out + (size_t)tok * 1024 + col : cxd + (size_t)(tok - TL) * 1024 + col;
                atomicAdd(dst, g2 * w * ev);
            }
        })
    }
}
DEV void tok_seq(int t, int& base, int& n, int& len) {
    if (t < TL) { base = t & ~(SEQ - 1); n = t & (SEQ - 1); len = SEQ; } else { const int u = t - TL; base = TL + (u & ~(CTXL - 1)); n = u & (CTXL - 1); len = CTXL; }
}
DEV void phase_prep1(const Params& p, int l) {
    const int lane = threadIdx.x & 63, wave = threadIdx.x >> 6;
    bf16_t* P = wsb(p, OFF_P);
    bf16_t* XL = wsb(p, OFF_XL);
    const float* qkg = p.in[I_DAQKG] + l * 64;
    const float* cqg = p.in[I_MCQG] + l * 192;
    const float* ckvg = p.in[I_MCKVG] + l * 128;
    const float* mu3 = p.in[I_RMU] + (l * 4 + 3) * 256;
    for (int t = blockIdx.x * 4 + wave; t < TT; t += gridDim.x * 4) {
        bf16_t* row = P + (size_t)t * LDP;
        int base, n, len; tok_seq(t, base, n, len);
        {
            const int d0 = (lane & 7) * 4;
            float cs[4], sn[4];
            const bool rot = t < TL;
            if (rot) {
                const float fr = (float)(n >> 6), fc = (float)(n & 63);
#pragma unroll
                for (int j = 0; j < 4; ++j) {
                    const int i = (d0 + j) & 15;
                    const float inv = exp2f(-(float)(i & 7) * (13.287712379549449f / 8.f));
                    const float ang = (i < 8 ? fr : fc) * inv;
                    cs[j] = cosf(ang); sn[j] = sinf(ang);
                }
            }
#pragma unroll
            for (int which = 0; which < 2; ++which) {
                bf16_t* ptr = row + (which ? C_DAK : C_DAQ) + lane * 4;
                const u32x2 raw = *(const u32x2*)ptr;
                float v[4] = { bflo(raw.x), bfhi(raw.x), bflo(raw.y), bfhi(raw.y) };
                float ss = v[0] * v[0] + v[1] * v[1] + v[2] * v[2] + v[3] * v[3];
                ss = group_sum<8>(ss);
                const float rstd = rsqrtf(ss * (1.f / 32.f) + EPS);
                const float* g = qkg + which * 32 + d0;
#pragma unroll
                for (int j = 0; j < 4; ++j) v[j] = v[j] * rstd * g[j];
                if (rot) {
#pragma unroll
                    for (int j = 0; j < 4; ++j) {
                        const float o = __shfl_xor(v[j], 4, 64);
                        v[j] = (d0 < 16) ? (v[j] * cs[j] - o * sn[j]) : (v[j] * cs[j] + o * sn[j]);
                    }
                }
                if (which == 0) {
                    const float qs = 0.17677669529663687f * LOG2E;
#pragma unroll
                    for (int j = 0; j < 4; ++j) v[j] *= qs;
                }
                u32x2 o; o.x = pack2(v[0], v[1]); o.y = pack2(v[2], v[3]);
                *(u32x2*)ptr = o;
            }
        }
        {
            float v[3]; float ss = 0.f;
#pragma unroll
            for (int j = 0; j < 3; ++j) { v[j] = bf2f(row[C_CQ + lane + j * 64]); ss += v[j] * v[j]; }
            ss = wave_sum(ss);
            const float rstd = rsqrtf(ss * (1.f / 192.f) + EPS);
#pragma unroll
            for (int j = 0; j < 3; ++j) row[C_CQ + lane + j * 64] = f2bf(v[j] * rstd * cqg[lane + j * 64]);
            float w[2]; float s2 = 0.f;
#pragma unroll
            for (int j = 0; j < 2; ++j) { w[j] = bf2f(row[C_CKV + lane + j * 64]); s2 += w[j] * w[j]; }
            s2 = wave_sum(s2);
            const float r2 = rsqrtf(s2 * (1.f / 128.f) + EPS);
#pragma unroll
            for (int j = 0; j < 2; ++j) row[C_CKV + lane + j * 64] = f2bf(w[j] * r2 * ckvg[lane + j * 64]);
        }
        {
            const int c = lane * 4;
            const u32x2 cur = *(const u32x2*)(row + C_RWD + c);
            u32x2 pv = (u32x2){0u, 0u}, nx = (u32x2){0u, 0u};
            if (n > 0) pv = *(const u32x2*)(row - LDP + C_RWD + c);
            if (n + 1 < len) nx = *(const u32x2*)(row + LDP + C_RWD + c);
            const float4 m = *(const float4*)(mu3 + c);
            float o[4];
            { const float x = bflo(cur.x); o[0] = x + (0.5f * (bflo(pv.x) + bflo(nx.x)) - x) * m.x; }
            { const float x = bfhi(cur.x); o[1] = x + (0.5f * (bfhi(pv.x) + bfhi(nx.x)) - x) * m.y; }
            { const float x = bflo(cur.y); o[2] = x + (0.5f * (bflo(pv.y) + bflo(nx.y)) - x) * m.z; }
            { const float x = bfhi(cur.y); o[3] = x + (0.5f * (bfhi(pv.y) + bfhi(nx.y)) - x) * m.w; }
            u32x2 ov; ov.x = pack2(o[0], o[1]); ov.y = pack2(o[2], o[3]);
            *(u32x2*)(XL + (size_t)t * 256 + c) = ov;
        }
    }
}

DEV void phase_prep_gemm1(const Params& p, int l, char* smem) {
    const bf16_t* P = wsb(p, OFF_P);
    const bf16_t* w = wsb(p, OFF_WSM) + (size_t)l * WS_PER_LAYER;
    bf16_t* QRAW = wsb(p, OFF_QRAW); bf16_t* KVRAW = wsb(p, OFF_KVRAW); bf16_t* LR = wsb(p, OFF_LR);
    int rot = 0;
    gemm_generic(P + C_CQ, LDP, TT, w + WS_UQT, 192, 192, 192, [&](int r, int c, float v) { QRAW[(size_t)r * 192 + c] = f2bf(v); }, smem, rot);
    rot += (TT / 128) * 2;
    gemm_generic(P + C_CKV, LDP, TT, w + WS_UKVT, 128, 384, 128, [&](int r, int c, float v) { KVRAW[(size_t)r * 384 + c] = f2bf(v); }, smem, rot);
    rot += (TT / 128) * 3;
    gemm_generic(wsb(p, OFF_XL), 256, TT, w + WS_W1C, 256, 192, 256,
                 [&](int r, int c, float v) { const float o = c < 64 ? tanhf(v) : (c < 128 ? v : sigmoidf_(v)); LR[(size_t)r * 192 + c] = f2bf(o); }, smem, rot);
}
DEV void phase_prep_gemm2(const Params& p, int l, char* smem) {
    const bf16_t* w = wsb(p, OFF_WSM) + (size_t)l * WS_PER_LAYER;
    const bf16_t* LR = wsb(p, OFF_LR);
    bf16_t* RWX = wsb(p, OFF_RWX);
    bf16_t* P = wsb(p, OFF_P);
    int rot = 0;
    for (int d = 0; d < 2; ++d) {
        const float* w0 = p.in[I_RW0] + (l * 2 + d) * 256;
        gemm_generic(LR + d * 32, 192, TT, w + WS_W2 + (size_t)d * 256 * 64, 64, 256, 64,
                     [&](int r, int c, float v) { RWX[(size_t)r * 1024 + d * 256 + c] = f2bf(0.6065306597126334f * sigmoidf_(w0[c] + v)); }, smem, rot);
        rot += (TT / 128) * 2;
        const float* a0 = p.in[I_RA0] + (l * 2 + d) * 256;
        gemm_generic(LR + 64 + d * 32, 192, TT, w + WS_W2 + (size_t)(2 + d) * 256 * 64, 64, 256, 64,
                     [&](int r, int c, float v) { RWX[(size_t)r * 1024 + 512 + d * 256 + c] = f2bf(sigmoidf_(a0[c] + v)); }, smem, rot);
        rot += (TT / 128) * 2;
    }
    gemm_generic(LR + 128, 192, TT, w + WS_G2T, 64, 256, 64, [&](int r, int c, float v) { P[(size_t)r * LDP + C_RWD + c] = f2bf(v); }, smem, rot);
}

DEV void phase_prep2(const Params& p, int l) {
    const int lane = threadIdx.x & 63, wave = threadIdx.x >> 6;
    const bf16_t* P = wsb(p, OFF_P);
    const bf16_t* QRAW = wsb(p, OFF_QRAW); const bf16_t* KVRAW = wsb(p, OFF_KVRAW);
    bf16_t* MQ = wsb(p, OFF_MLAQ); bf16_t* MK = wsb(p, OFF_MLAK); bf16_t* MV = wsb(p, OFF_MLAV);
    const float* qkg = p.in[I_MQKG] + l * 96;
    for (int t = blockIdx.x * 4 + wave; t < TT; t += gridDim.x * 4) {
        int base, n, len; tok_seq(t, base, n, len);
        const int h = lane >> 4, j = lane & 15;
        const bool rot = t < TL;
        float cs = 1.f, sn = 0.f;
        if (rot) {
            const int i = j & 7;
            const float inv = exp2f(-(float)(i & 3) * (13.287712379549449f / 4.f));
            const float ang = (i < 4 ? (float)(n >> 6) : (float)(n & 63)) * inv;
            cs = cosf(ang); sn = sinf(ang);
        }
        {
            float v[3]; float ss = 0.f;
#pragma unroll
            for (int k = 0; k < 3; ++k) { v[k] = bf2f(QRAW[(size_t)t * 192 + h * 48 + j + k * 16]); ss += v[k] * v[k]; }
            ss = group_sum<16>(ss);
            const float rstd = rsqrtf(ss * (1.f / 48.f) + EPS);
#pragma unroll
            for (int k = 0; k < 3; ++k) v[k] = v[k] * rstd * qkg[j + k * 16];
            if (rot) { const float o = __shfl_xor(v[2], 8, 64); v[2] = (j < 8) ? (v[2] * cs - o * sn) : (v[2] * cs + o * sn); }
            const float qs = 0.14433756729740643f * LOG2E;
#pragma unroll
            for (int k = 0; k < 3; ++k) MQ[(size_t)t * 192 + h * 48 + j + k * 16] = f2bf(v[k] * qs);
        }
        {
            float v[3]; float ss = 0.f;
            v[0] = bf2f(KVRAW[(size_t)t * 384 + h * 96 + j]);
            v[1] = bf2f(KVRAW[(size_t)t * 384 + h * 96 + 16 + j]);
            v[2] = bf2f(P[(size_t)t * LDP + C_KR + j]);
#pragma unroll
            for (int k = 0; k < 3; ++k) ss += v[k] * v[k];
            ss = group_sum<16>(ss);
            const float rstd = rsqrtf(ss * (1.f / 48.f) + EPS);
#pragma unroll
            for (int k = 0; k < 3; ++k) v[k] = v[k] * rstd * qkg[48 + j + k * 16];
            if (rot) { const float o = __shfl_xor(v[2], 8, 64); v[2] = (j < 8) ? (v[2] * cs - o * sn) : (v[2] * cs + o * sn); }
#pragma unroll
            for (int k = 0; k < 3; ++k) MK[(size_t)t * 192 + h * 48 + j + k * 16] = f2bf(v[k]);
        }
#pragma unroll
        for (int k = 0; k < 4; ++k) MV[(size_t)t * 256 + h * 64 + j + k * 16] = KVRAW[(size_t)t * 384 + h * 96 + 32 + j + k * 16];
    }
}
template <int NC, int DK>
struct AttnCfg {
    static constexpr int DKROW = NC * DK, KLD = DKROW + 8, VLD = 68;
    static constexpr int KSTAGE = 64 * KLD, VSTAGE = 64 * VLD;
    static constexpr int KCH = 64 * DKROW / 8;
};
template <int NC, int DK, class EPI>
DEV void attn_item(const bf16_t* Q, int ldq, const bf16_t* Kl, const bf16_t* Kc, int ldk, const bf16_t* Vl, const bf16_t* Vc, int ldv,
                   int q0, int nlat_tiles, int nctx_tiles, EPI epi, char* smem) {
    using C = AttnCfg<NC, DK>;
    constexpr int KS = DK / 16;
    const int tid = threadIdx.x, lane = tid & 63, wave = tid >> 6, ql = lane & 31, hh = lane >> 5;
    bf16_t* Ks = (bf16_t*)smem;
    bf16_t* Vt = Ks + 2 * C::KSTAGE;
    bf16x8 qf[NC][KS];
    {
        const bf16_t* qp = Q + (size_t)(q0 + wave * 32 + ql) * ldq + hh * 8;
#pragma unroll
        for (int c = 0; c < NC; ++c)
#pragma unroll
            for (int ks = 0; ks < KS; ++ks) qf[c][ks] = *(const bf16x8*)(qp + c * DK + ks * 16);
    }
    f32x16 O[NC][2];
    float mrun[NC], lrun[NC];
#pragma unroll
    for (int c = 0; c < NC; ++c) {
        mrun[c] = -1e30f; lrun[c] = 0.f;
#pragma unroll
        for (int d = 0; d < 2; ++d)
#pragma unroll
            for (int r = 0; r < 16; ++r) O[c][d][r] = 0.f;
    }
    const int ntiles = nlat_tiles + nctx_tiles;
    constexpr int KPT = (C::KCH + NT - 1) / NT;
    u32x4 rk[KPT], rv[2];
    auto load_tile = [&](int tile) {
        const bf16_t* kb = tile < nlat_tiles ? Kl + (size_t)tile * 64 * ldk : Kc + (size_t)(tile - nlat_tiles) * 64 * ldk;
        const bf16_t* vb = tile < nlat_tiles ? Vl + (size_t)tile * 64 * ldv : Vc + (size_t)(tile - nlat_tiles) * 64 * ldv;
#pragma unroll
        for (int i = 0; i < KPT; ++i) {
            int q = tid + i * NT; q = q < C::KCH ? q : C::KCH - 1;
            { const int key = q / (C::DKROW / 8), ch = q % (C::DKROW / 8); rk[i] = *(const u32x4*)(kb + (size_t)key * ldk + ch * 8); }
        }
#pragma unroll
        for (int i = 0; i < 2; ++i) { const int q = tid + i * NT; const int key = q >> 3, ch = q & 7; rv[i] = *(const u32x4*)(vb + (size_t)key * ldv + ch * 8); }
    };
    auto store_tile = [&](int st) {
#pragma unroll
        for (int i = 0; i < KPT; ++i) {
            const int q = tid + i * NT;
            if (q < C::KCH) { const int key = q / (C::DKROW / 8), ch = q % (C::DKROW / 8); *(u32x4*)(Ks + st * C::KSTAGE + key * C::KLD + ch * 8) = rk[i]; }
        }
#pragma unroll
        for (int i = 0; i < 2; ++i) {
            const int q = tid + i * NT; const int key = q >> 3, dv0 = (q & 7) * 8;
            bf16_t* vd = Vt + st * C::VSTAGE + dv0 * C::VLD + key;
            const unsigned w[4] = { rv[i][0], rv[i][1], rv[i][2], rv[i][3] };
#pragma unroll
            for (int j = 0; j < 4; ++j) { vd[(2 * j) * C::VLD] = (bf16_t)(w[j] & 0xFFFFu); vd[(2 * j + 1) * C::VLD] = (bf16_t)(w[j] >> 16); }
        }
    };
    load_tile(0);
    __syncthreads();
    store_tile(0);
    __syncthreads();
    for (int tile = 0; tile < ntiles; ++tile) {
        const int cur = tile & 1;
        if (tile + 1 < ntiles) load_tile(tile + 1);
        const bf16_t* ks_ = Ks + cur * C::KSTAGE;
        const bf16_t* vt_ = Vt + cur * C::VSTAGE;
#pragma unroll
        for (int c = 0; c < NC; ++c) {
            f32x16 S[2];
#pragma unroll
            for (int kb = 0; kb < 2; ++kb) {
#pragma unroll
                for (int r = 0; r < 16; ++r) S[kb][r] = 0.f;
#pragma unroll
                for (int ks = 0; ks < KS; ++ks) {
                    const bf16x8 kf = *(const bf16x8*)(ks_ + (kb * 32 + ql) * C::KLD + c * DK + ks * 16 + hh * 8);
                    S[kb] = __builtin_amdgcn_mfma_f32_32x32x16_bf16(kf, qf[c][ks], S[kb], 0, 0, 0);
                }
            }
            float mx = S[0][0];
#pragma unroll
            for (int kb = 0; kb < 2; ++kb)
#pragma unroll
                for (int r = 0; r < 16; ++r) mx = fmaxf(mx, S[kb][r]);
            mx = fmaxf(mx, __shfl_xor(mx, 32, 64));
            const float mnew = fmaxf(mrun[c], mx);
            const float alpha = __builtin_amdgcn_exp2f(mrun[c] - mnew);
            mrun[c] = mnew;
            float ls = 0.f;
#pragma unroll
            for (int kb = 0; kb < 2; ++kb)
#pragma unroll
                for (int r = 0; r < 16; ++r) { const float e = __builtin_amdgcn_exp2f(S[kb][r] - mnew); S[kb][r] = e; ls += e; }
            lrun[c] = lrun[c] * alpha + ls;
#pragma unroll
            for (int d = 0; d < 2; ++d)
#pragma unroll
                for (int r = 0; r < 16; ++r) O[c][d][r] *= alpha;
#pragma unroll
            for (int s = 0; s < 4; ++s) {
                const int kb = s >> 1, s2 = s & 1;
                const u32x4 pu = (u32x4){pack2(S[kb][8 * s2 + 0], S[kb][8 * s2 + 1]), pack2(S[kb][8 * s2 + 2], S[kb][8 * s2 + 3]),
                                         pack2(S[kb][8 * s2 + 4], S[kb][8 * s2 + 5]), pack2(S[kb][8 * s2 + 6], S[kb][8 * s2 + 7])};
                const bf16x8 pf = __builtin_bit_cast(bf16x8, pu);
                const int keyo = kb * 32 + 16 * s2 + 4 * hh;
#pragma unroll
                for (int d = 0; d < 2; ++d) {
                    const bf16_t* vp = vt_ + (d * 32 + ql) * C::VLD + keyo;
                    const u32x2 lo = *(const u32x2*)vp, hi = *(const u32x2*)(vp + 8);
                    const u32x4 vv = (u32x4){lo[0], lo[1], hi[0], hi[1]};
                    const bf16x8 vf = __builtin_bit_cast(bf16x8, vv);
                    O[c][d] = __builtin_amdgcn_mfma_f32_32x32x16_bf16(vf, pf, O[c][d], 0, 0, 0);
                }
            }
        }
        if (tile + 1 < ntiles) store_tile(cur ^ 1);
        __syncthreads();
    }
    float inv[NC];
#pragma unroll
    for (int c = 0; c < NC; ++c) { const float lt = lrun[c] + __shfl_xor(lrun[c], 32, 64); inv[c] = 1.f / lt; }
    epi(O, inv, q0 + wave * 32 + ql, hh);
}

DEV void da_item(const Params& p, int l, int item, char* smem) {
    const bf16_t* P = wsb(p, OFF_P);
    bf16_t* Y = wsb(p, OFF_Y);
    const float linit = 0.8f - 0.6f * __expf(-0.3f * (float)l);
    float lam;
    {
        const float* la = p.in[I_DALAM] + l * 128;
        const int lane = threadIdx.x & 63;
        float a = lane < 32 ? la[lane] * la[32 + lane] : 0.f, b = lane < 32 ? la[64 + lane] * la[96 + lane] : 0.f;
        a = wave_sum(a); b = wave_sum(b);
        lam = __expf(a) - __expf(b) + linit;
    }
    const float* sg = p.in[I_DASUB] + l * 64;
    int b, h, qt; bool isctx;
    if (item < 512) { isctx = false; b = item >> 6; h = (item >> 4) & 3; qt = item & 15; }
    else { const int it = item - 512; isctx = true; b = it >> 3; h = (it >> 1) & 3; qt = it & 1; }
    const size_t lat0 = (size_t)b * SEQ, ctx0 = (size_t)TL + (size_t)b * CTXL;
    const size_t qrow0 = isctx ? ctx0 : lat0;
    float o1[2][16];
    auto epi0 = [&](f32x16 (&O)[1][2], float (&inv)[1], int qrow, int hh) {
#pragma unroll
        for (int d = 0; d < 2; ++d)
#pragma unroll
            for (int r = 0; r < 16; ++r) o1[d][r] = O[0][d][r] * inv[0];
    };
    auto epi1 = [&](f32x16 (&O)[1][2], float (&inv)[1], int qrow, int hh) {
        float v[2][16]; float ss = 0.f;
#pragma unroll
        for (int d = 0; d < 2; ++d)
#pragma unroll
            for (int r = 0; r < 16; ++r) { const float o = o1[d][r] - lam * O[0][d][r] * inv[0]; v[d][r] = o; ss += o * o; }
        ss += __shfl_xor(ss, 32, 64);
        const float rstd = rsqrtf(ss * (1.f / 64.f) + EPS) * (1.f - linit);
        bf16_t* yo = Y + (qrow0 + qrow) * 1024 + h * 64;
#pragma unroll
        for (int d = 0; d < 2; ++d)
#pragma unroll
            for (int g = 0; g < 4; ++g) {
                const int dv = d * 32 + 8 * g + 4 * hh;
                u32x2 o;
                o.x = pack2(v[d][4 * g + 0] * rstd * sg[dv + 0], v[d][4 * g + 1] * rstd * sg[dv + 1]);
                o.y = pack2(v[d][4 * g + 2] * rstd * sg[dv + 2], v[d][4 * g + 3] * rstd * sg[dv + 3]);
                *(u32x2*)(yo + dv) = o;
            }
    };
    const bf16_t* Qp = P + qrow0 * LDP + C_DAQ + h * 64;
    const bf16_t* Kl = P + lat0 * LDP + C_DAK + h * 64;
    const bf16_t* Kc = P + ctx0 * LDP + C_DAK + h * 64;
    const bf16_t* Vl = P + lat0 * LDP + C_DAV + h * 64;
    const bf16_t* Vc = P + ctx0 * LDP + C_DAV + h * 64;
    const int nlat = isctx ? 0 : SEQ / 64;
    attn_item<1, 32>(Qp, LDP, Kl, Kc, LDP, Vl, Vc, LDP, qt * 128, nlat, CTXL / 64, epi0, smem);
    attn_item<1, 32>(Qp + 32, LDP, Kl + 32, Kc + 32, LDP, Vl, Vc, LDP, qt * 128, nlat, CTXL / 64, epi1, smem);
}
DEV void mla_item(const Params& p, int l, int item, char* smem) {
    const bf16_t* MQ = wsb(p, OFF_MLAQ); const bf16_t* MK = wsb(p, OFF_MLAK); const bf16_t* MV = wsb(p, OFF_MLAV);
    bf16_t* Y = wsb(p, OFF_Y);
    int b, h, qt; bool isctx;
    if (item < 512) { isctx = false; b = item >> 6; h = (item >> 4) & 3; qt = item & 15; }
    else { const int it = item - 512; isctx = true; b = it >> 3; h = (it >> 1) & 3; qt = it & 1; }
    const size_t lat0 = (size_t)b * SEQ, ctx0 = (size_t)TL + (size_t)b * CTXL;
    const size_t qrow0 = isctx ? ctx0 : lat0;
    auto epi = [&](f32x16 (&O)[1][2], float (&inv)[1], int qrow, int hh) {
        bf16_t* yo = Y + (qrow0 + qrow) * 1024 + 512 + h * 64;
#pragma unroll
        for (int d = 0; d < 2; ++d)
#pragma unroll
            for (int g = 0; g < 4; ++g) {
                const int dv = d * 32 + 8 * g + 4 * hh;
                u32x2 o;
                o.x = pack2(O[0][d][4 * g + 0] * inv[0], O[0][d][4 * g + 1] * inv[0]);
                o.y = pack2(O[0][d][4 * g + 2] * inv[0], O[0][d][4 * g + 3] * inv[0]);
                *(u32x2*)(yo + dv) = o;
            }
    };
    const bf16_t* Qp = MQ + qrow0 * 192 + h * 48;
    const bf16_t* Kl = MK + lat0 * 192 + h * 48;
    const bf16_t* Kc = MK + ctx0 * 192 + h * 48;
    const bf16_t* Vl = MV + lat0 * 256 + h * 64;
    const bf16_t* Vc = MV + ctx0 * 256 + h * 64;
    attn_item<1, 48>(Qp, 192, Kl, Kc, 192, Vl, Vc, 256, qt * 128, isctx ? 0 : SEQ / 64, CTXL / 64, epi, smem);
}
DEV void phase_attn(const Params& p, int l, char* smem) {
    const int nda = (l == 0) ? 512 + 64 : 512;
    for (int item = blockIdx.x; item < 2 * nda; item += gridDim.x) {
        if (item < nda) da_item(p, l, item, smem); else mla_item(p, l, item - nda, smem);
    }
}
DEV int s5_token(int b, int tb, int n) { return tb == 0 ? TL + b * CTXL + n : b * SEQ + (tb - 1) * 256 + n; }
struct S5Lane { float are, aim; float bre[16], bim[16]; };
DEV void s5_setup(const Params& p, int l, int d, int g, int pl, S5Lane& s) {
    const int gi = ((l * 2 + d) * 16 + g);
    const float lre = p.in[I_S5LRE][gi * 64 + pl], lim = p.in[I_S5LIM][gi * 64 + pl];
    const float dt = __expf(p.in[I_S5LDT][gi]);
    const float mag = __expf(lre * dt);
    s.are = mag * cosf(lim * dt); s.aim = mag * sinf(lim * dt);
    const float nr = s.are - 1.f, ni = s.aim, den = 1.f / (lre * lre + lim * lim);
    const float cr = (nr * lre + ni * lim) * den, ci = (ni * lre - nr * lim) * den;
    const float* br = p.in[I_S5BRE] + ((size_t)gi * 64 + pl) * 16;
    const float* bi = p.in[I_S5BIM] + ((size_t)gi * 64 + pl) * 16;
#pragma unroll
    for (int c = 0; c < 16; ++c) { const float x = br[c], y = bi[c]; s.bre[c] = cr * x - ci * y; s.bim[c] = cr * y + ci * x; }
}
template <bool DUMP>
DEV void s5_scan32(const S5Lane& s, float& hre, float& him, const float* ub, bf16_t* hb, int pl, bool rev) {
    for (int j = 0; j < 32; ++j) {
        const int rowi = rev ? 31 - j : j;
        const float4* u4 = (const float4*)(ub + rowi * 16);
        float bur = 0.f, bui = 0.f;
#pragma unroll
        for (int q = 0; q < 4; ++q) {
            const float4 u = u4[q];
            bur += u.x * s.bre[q * 4 + 0] + u.y * s.bre[q * 4 + 1] + u.z * s.bre[q * 4 + 2] + u.w * s.bre[q * 4 + 3];
            bui += u.x * s.bim[q * 4 + 0] + u.y * s.bim[q * 4 + 1] + u.z * s.bim[q * 4 + 2] + u.w * s.bim[q * 4 + 3];
        }
        const float nre = s.are * hre - s.aim * him + bur;
        const float nim = s.are * him + s.aim * hre + bui;
        hre = nre; him = nim;
        if (DUMP) { hb[rowi * 136 + pl] = f2bf(hre); hb[rowi * 136 + 64 + pl] = f2bf(him); }
    }
}
DEV void s5_load_u(const bf16_t* P, int b, int tb, int g, int sc, float* ub, int lane) {
    if (lane < 32) {
        const int t = s5_token(b, tb, sc * 32 + lane);
        const uint4* src = (const uint4*)(P + (size_t)t * LDP + C_S5 + g * 16);
        const uint4 a = src[0], c = src[1];
        float4* d = (float4*)(ub + lane * 16);
        d[0] = make_float4(bflo(a.x), bfhi(a.x), bflo(a.y), bfhi(a.y));
        d[1] = make_float4(bflo(a.z), bfhi(a.z), bflo(a.w), bfhi(a.w));
        d[2] = make_float4(bflo(c.x), bfhi(c.x), bflo(c.y), bfhi(c.y));
        d[3] = make_float4(bflo(c.z), bfhi(c.z), bflo(c.w), bfhi(c.w));
    }
}
DEV void phase_s5_pass1(const Params& p, int l, char* smem) {
    const int lane = threadIdx.x & 63, wave = threadIdx.x >> 6;
    float* ub = (float*)smem + wave * 512;
    const bf16_t* P = wsb(p, OFF_P);
    float* st = wsf(p, OFF_S5ST);
    const int nitems = 2 * 8 * 16 * 8;
    for (int it0 = blockIdx.x * 4; it0 < nitems; it0 += gridDim.x * 4) {
        const int it = it0 + wave;
        const int seg = it & 7, g = (it >> 3) & 15, b = (it >> 7) & 7, d = it >> 10;
        const int tb = seg == 0 ? 0 : (d == 0 ? seg : 9 - seg);
        S5Lane s; s5_setup(p, l, d, g, lane, s);
        float hre = 0.f, him = 0.f;
        for (int k = 0; k < 8; ++k) {
            const int sc = d == 0 ? k : 7 - k;
            __syncthreads();
            s5_load_u(P, b, tb, g, sc, ub, lane);
            __syncthreads();
            s5_scan32<false>(s, hre, him, ub, nullptr, lane, d == 1);
        }
        float* o = st + ((((size_t)d * 8 + b) * 16 + g) * 8 + seg) * 128;
        o[lane] = hre; o[64 + lane] = him;
    }
}
DEV void phase_s5_pass2(const Params& p, int l, int tb0, char* smem) {
    const int lane = threadIdx.x & 63, wave = threadIdx.x >> 6;
    float* ub = (float*)smem + wave * 512;
    bf16_t* hb = (bf16_t*)(smem + 8192) + wave * (32 * 136);
    bf16_t* P = wsb(p, OFF_P);
    const float* st = wsf(p, OFF_S5ST);
    const int nitems = 8 * 16 * (9 - tb0);
    for (int it0 = blockIdx.x * 4; it0 < nitems; it0 += gridDim.x * 4) {
        const int it = it0 + wave;
        const int g = it & 15, b = (it >> 4) & 7, tb = (it >> 7) + tb0;
        f32x4 yacc[16];
#pragma unroll
        for (int i = 0; i < 16; ++i) yacc[i] = (f32x4){0.f, 0.f, 0.f, 0.f};
#pragma unroll
        for (int d = 0; d < 2; ++d) {
            S5Lane s; s5_setup(p, l, d, g, lane, s);
            bf16x8 cf[4];
            {
                const int gi = ((l * 2 + d) * 16 + g), c = lane & 15, kq = lane >> 4;
                const float* cre = p.in[I_S5CRE] + ((size_t)gi * 16 + c) * 64;
                const float* cim = p.in[I_S5CIM] + ((size_t)gi * 16 + c) * 64;
#pragma unroll
                for (int ks = 0; ks < 4; ++ks)
#pragma unroll
                    for (int j = 0; j < 8; ++j) {
                        const int k = ks * 32 + kq * 8 + j;
                        const float v = k < 64 ? cre[k] : -cim[k - 64];
                        cf[ks][j] = (short)f2bf(v);
                    }
            }
            const int seg = tb == 0 ? 0 : (d == 0 ? tb : 9 - tb);
            float hre = 0.f, him = 0.f;
            {
                float pr = s.are, pi = s.aim;
#pragma unroll
                for (int q = 0; q < 8; ++q) { const float nr = pr * pr - pi * pi, ni = 2.f * pr * pi; pr = nr; pi = ni; }
                const float* hs = st + (((size_t)d * 8 + b) * 16 + g) * 8 * 128;
                for (int i = 0; i < seg; ++i) {
                    const float er = hs[i * 128 + lane], ei = hs[i * 128 + 64 + lane];
                    const float nr = pr * hre - pi * him + er, ni = pr * him + pi * hre + ei;
                    hre = nr; him = ni;
                }
            }
#pragma unroll
            for (int k = 0; k < 8; ++k) {
                const int sc = d == 0 ? k : 7 - k;
                __syncthreads();
                s5_load_u(P, b, tb, g, sc, ub, lane);
                __syncthreads();
                s5_scan32<true>(s, hre, him, ub, hb, lane, d == 1);
                __syncthreads();
#pragma unroll
                for (int mt = 0; mt < 2; ++mt)
#pragma unroll
                    for (int ks = 0; ks < 4; ++ks) {
                        const bf16x8 af = *(const bf16x8*)(hb + (mt * 16 + (lane & 15)) * 136 + ks * 32 + (lane >> 4) * 8);
                        yacc[sc * 2 + mt] = __builtin_amdgcn_mfma_f32_16x16x32_bf16(af, cf[ks], yacc[sc * 2 + mt], 0, 0, 0);
                    }
            }
        }
        {
            const int c = lane & 15;
            const float dd = p.in[I_S5D][(l * 16 + g) * 16 + c];
#pragma unroll
            for (int tile = 0; tile < 16; ++tile)
#pragma unroll
                for (int r = 0; r < 4; ++r) {
                    const int n = tile * 16 + (lane >> 4) * 4 + r;
                    bf16_t* up = P + (size_t)s5_token(b, tb, n) * LDP + C_S5 + g * 16 + c;
                    const float y = dd * bf2f(*up) + yacc[tile][r];
                    const float z = 0.5f * y * (1.f + tanhf(0.7978845608028654f * (y + 0.044715f * y * y * y)));
                    *up = f2bf(z);
                }
        }
    }
}

DEV float row16_sum(float v) {
    v += __int_as_float(__builtin_amdgcn_mov_dpp(__float_as_int(v), 0x128, 0xf, 0xf, true));
    v += __int_as_float(__builtin_amdgcn_mov_dpp(__float_as_int(v), 0x124, 0xf, 0xf, true));
    v += __int_as_float(__builtin_amdgcn_mov_dpp(__float_as_int(v), 0x122, 0xf, 0xf, true));
    v += __int_as_float(__builtin_amdgcn_mov_dpp(__float_as_int(v), 0x121, 0xf, 0xf, true));
    return v;
}
constexpr int RW_CT = 16;
struct RwRaw { u32x2 r[3], k[3], v[3], sd, a; };
DEV void rw_item(const Params& p, int l, int item, char* smem) {
    const int tid = threadIdx.x, li = tid >> 4, lc = tid & 15;
    const int ch = item >> 2, rg = item & 3, dir = ch >> 5, b = (ch >> 2) & 7, head = ch & 3;
    float* buf = (float*)smem;
    float* ybuf = buf + 2 * RW_CT * 384;
    const bf16_t* P = wsb(p, OFF_P);
    const bf16_t* RWX = wsb(p, OFF_RWX);
    bf16_t* RWY = wsb(p, OFF_RWY) + (size_t)dir * TT * 256;
    const int hc = head * 64 + lc * 4;
    const float4 mur = *(const float4*)(p.in[I_RMU] + (l * 4 + 0) * 256 + hc);
    const float4 muk = *(const float4*)(p.in[I_RMU] + (l * 4 + 1) * 256 + hc);
    const float4 muv = *(const float4*)(p.in[I_RMU] + (l * 4 + 2) * 256 + hc);
    const float4 kk4 = *(const float4*)(p.in[I_RKK] + l * 256 + hc);
    const float4 ka4 = *(const float4*)(p.in[I_RKA] + l * 256 + hc);
    const int NCH = (CTXL + SEQ) / RW_CT;
    auto tok_of = [&](int cidx, int i, int& n, int& len) -> int {
        if (cidx < CTXL / RW_CT) { const int pos = cidx * RW_CT + i; len = CTXL; n = dir == 0 ? pos : CTXL - 1 - pos; return TL + b * CTXL + n; }
        const int pos = (cidx - CTXL / RW_CT) * RW_CT + i; len = SEQ; n = dir == 0 ? pos : SEQ - 1 - pos; return b * SEQ + n;
    };
    RwRaw raw;
    auto load_raw = [&](int cidx) {
        int n, len; const int t = tok_of(cidx, li, n, len);
        const bf16_t* row = P + (size_t)t * LDP;
        const u32x2 z = (u32x2){0u, 0u};
        const bool hp = n > 0, hn = n + 1 < len;
        raw.r[1] = *(const u32x2*)(row + C_RWR + hc); raw.k[1] = *(const u32x2*)(row + C_RWK + hc); raw.v[1] = *(const u32x2*)(row + C_RWV + hc);
        raw.r[0] = hp ? *(const u32x2*)(row - LDP + C_RWR + hc) : z; raw.k[0] = hp ? *(const u32x2*)(row - LDP + C_RWK + hc) : z; raw.v[0] = hp ? *(const u32x2*)(row - LDP + C_RWV + hc) : z;
        raw.r[2] = hn ? *(const u32x2*)(row + LDP + C_RWR + hc) : z; raw.k[2] = hn ? *(const u32x2*)(row + LDP + C_RWK + hc) : z; raw.v[2] = hn ? *(const u32x2*)(row + LDP + C_RWV + hc) : z;
        raw.sd = *(const u32x2*)(RWX + (size_t)t * 1024 + dir * 256 + hc);
        raw.a = *(const u32x2*)(RWX + (size_t)t * 1024 + 512 + dir * 256 + hc);
    };
    auto mix4 = [&](const u32x2 (&s)[3], const float4& mu, float (&o)[4]) {
        { const float x = bflo(s[1].x); o[0] = x + (0.5f * (bflo(s[0].x) + bflo(s[2].x)) - x) * mu.x; }
        { const float x = bfhi(s[1].x); o[1] = x + (0.5f * (bfhi(s[0].x) + bfhi(s[2].x)) - x) * mu.y; }
        { const float x = bflo(s[1].y); o[2] = x + (0.5f * (bflo(s[0].y) + bflo(s[2].y)) - x) * mu.z; }
        { const float x = bfhi(s[1].y); o[3] = x + (0.5f * (bfhi(s[0].y) + bfhi(s[2].y)) - x) * mu.w; }
    };
    auto stage = [&](int st) {
        float r4[4], k4[4], v4[4];
        mix4(raw.r, mur, r4); mix4(raw.k, muk, k4); mix4(raw.v, muv, v4);
        const float kkr[4] = { k4[0] * kk4.x, k4[1] * kk4.y, k4[2] * kk4.z, k4[3] * kk4.w };
        float nn = kkr[0] * kkr[0] + kkr[1] * kkr[1] + kkr[2] * kkr[2] + kkr[3] * kkr[3];
        nn = row16_sum(nn);
        const float rn = 1.f / fmaxf(sqrtf(nn), 1e-12f);
        const float a[4] = { bflo(raw.a.x), bfhi(raw.a.x), bflo(raw.a.y), bfhi(raw.a.y) };
        const float sd[4] = { bflo(raw.sd.x), bfhi(raw.sd.x), bflo(raw.sd.y), bfhi(raw.sd.y) };
        const float kav[4] = { ka4.x, ka4.y, ka4.z, ka4.w };
        float* d = buf + (st * RW_CT + li) * 384 + lc * 4;
        float wp[4], kp[4], bp[4], mp[4];
#pragma unroll
        for (int j = 0; j < 4; ++j) {
            wp[j] = __expf(-sd[j]);
            kp[j] = kkr[j] * rn;
            bp[j] = kp[j] * a[j];
            mp[j] = k4[j] * (1.f + (a[j] - 1.f) * kav[j]);
        }
        *(float4*)(d + 0) = make_float4(wp[0], wp[1], wp[2], wp[3]); *(float4*)(d + 64) = make_float4(kp[0], kp[1], kp[2], kp[3]);
        *(float4*)(d + 128) = make_float4(bp[0], bp[1], bp[2], bp[3]); *(float4*)(d + 192) = make_float4(mp[0], mp[1], mp[2], mp[3]);
        *(float4*)(d + 256) = make_float4(r4[0], r4[1], r4[2], r4[3]);
        *(float4*)(d + 320) = make_float4(v4[0], v4[1], v4[2], v4[3]);
    };
    float S0 = 0.f, S1 = 0.f, S2 = 0.f, S3 = 0.f;
    __syncthreads();
    load_raw(0);
    stage(0);
    __syncthreads();
    for (int cidx = 0; cidx < NCH; ++cidx) {
        const int cur = cidx & 1;
        if (cidx + 1 < NCH) load_raw(cidx + 1);
        const float* cb = buf + cur * RW_CT * 384;
        float* yb = ybuf + cur * 256;
#pragma unroll 4
        for (int j = 0; j < RW_CT; ++j) {
            const float* tb_ = cb + j * 384 + lc * 4;
            const float4 w = *(const float4*)(tb_), kk = *(const float4*)(tb_ + 64), bb = *(const float4*)(tb_ + 128), km = *(const float4*)(tb_ + 192), r = *(const float4*)(tb_ + 256);
            const float vv = cb[j * 384 + 320 + rg * 16 + li];
            float sa = S0 * kk.x + S1 * kk.y + S2 * kk.z + S3 * kk.w;
            sa = -row16_sum(sa);
            S0 = S0 * w.x + sa * bb.x + vv * km.x;
            S1 = S1 * w.y + sa * bb.y + vv * km.y;
            S2 = S2 * w.z + sa * bb.z + vv * km.z;
            S3 = S3 * w.w + sa * bb.w + vv * km.w;
            float y = S0 * r.x + S1 * r.y + S2 * r.z + S3 * r.w;
            y = row16_sum(y);
            if (lc == 0) yb[j * 16 + li] = y;
        }
        if (cidx + 1 < NCH) stage(cur ^ 1);
        __syncthreads();
        {
            int n, len; const int t = tok_of(cidx, li, n, len);
            RWY[(size_t)t * 256 + head * 64 + rg * 16 + lc] = f2bf(yb[li * 16 + lc]);
        }
    }
}
DEV void phase_rwkv(const Params& p, int l, char* smem) {
    for (int item = blockIdx.x; item < 256; item += gridDim.x) rw_item(p, l, item, smem);
}
DEV void phase_s5_glu(const Params& p, int l, int M, char* smem) {
    const bf16_t* P = wsb(p, OFF_P);
    const bf16_t* w = wsb(p, OFF_WSM) + (size_t)l * WS_PER_LAYER + WS_GLUT;
    bf16_t* Y = wsb(p, OFF_Y);
    const float* bg = p.in[I_S5BGLU] + l * 256;
    gemm_generic(P + C_S5, LDP, M, w, 256, 256, 256,
                 [&](int r, int c, float v) { const float z = bf2f(P[(size_t)r * LDP + C_S5 + c]); Y[(size_t)r * 1024 + 256 + c] = f2bf(z * sigmoidf_(v + bg[c])); }, smem, 0);
}
DEV void phase_rw_finish(const Params& p, int l, int M) {
    const int lane = threadIdx.x & 63, wave = threadIdx.x >> 6;
    const bf16_t* P = wsb(p, OFF_P);
    const bf16_t* RWX = wsb(p, OFF_RWX);
    const bf16_t* RWY = wsb(p, OFF_RWY);
    bf16_t* Y = wsb(p, OFF_Y);
    const int c = lane * 4;
    const float4 mur = *(const float4*)(p.in[I_RMU] + (l * 4 + 0) * 256 + c);
    const float4 muk = *(const float4*)(p.in[I_RMU] + (l * 4 + 1) * 256 + c);
    const float4 muv = *(const float4*)(p.in[I_RMU] + (l * 4 + 2) * 256 + c);
    const float4 ka4 = *(const float4*)(p.in[I_RKA] + l * 256 + c);
    const float4 rk4 = *(const float4*)(p.in[I_RRK] + l * 256 + c);
    const float4 lg4 = *(const float4*)(p.in[I_RLNG] + l * 256 + c);
    const float4 lb4 = *(const float4*)(p.in[I_RLNB] + l * 256 + c);
    const float mr_[4] = { mur.x, mur.y, mur.z, mur.w }, mk_[4] = { muk.x, muk.y, muk.z, muk.w }, mv_[4] = { muv.x, muv.y, muv.z, muv.w };
    const float ka_[4] = { ka4.x, ka4.y, ka4.z, ka4.w }, rk_[4] = { rk4.x, rk4.y, rk4.z, rk4.w }, lg_[4] = { lg4.x, lg4.y, lg4.z, lg4.w }, lb_[4] = { lb4.x, lb4.y, lb4.z, lb4.w };
    for (int t = blockIdx.x * 4 + wave; t < M; t += gridDim.x * 4) {
        int base, n, len; tok_seq(t, base, n, len);
        const bf16_t* row = P + (size_t)t * LDP;
        const bool hp = n > 0, hn = n + 1 < len;
        const u32x2 z = (u32x2){0u, 0u};
        float r4[4], k4[4], v4[4];
        {
            const u32x2 cu = *(const u32x2*)(row + C_RWR + c), pv = hp ? *(const u32x2*)(row - LDP + C_RWR + c) : z, nx = hn ? *(const u32x2*)(row + LDP + C_RWR + c) : z;
            const float x[4] = { bflo(cu.x), bfhi(cu.x), bflo(cu.y), bfhi(cu.y) }, a[4] = { bflo(pv.x), bfhi(pv.x), bflo(pv.y), bfhi(pv.y) }, b[4] = { bflo(nx.x), bfhi(nx.x), bflo(nx.y), bfhi(nx.y) };
#pragma unroll
            for (int j = 0; j < 4; ++j) r4[j] = x[j] + (0.5f * (a[j] + b[j]) - x[j]) * mr_[j];
        }
        {
            const u32x2 cu = *(const u32x2*)(row + C_RWK + c), pv = hp ? *(const u32x2*)(row - LDP + C_RWK + c) : z, nx = hn ? *(const u32x2*)(row + LDP + C_RWK + c) : z;
            const float x[4] = { bflo(cu.x), bfhi(cu.x), bflo(cu.y), bfhi(cu.y) }, a[4] = { bflo(pv.x), bfhi(pv.x), bflo(pv.y), bfhi(pv.y) }, b[4] = { bflo(nx.x), bfhi(nx.x), bflo(nx.y), bfhi(nx.y) };
#pragma unroll
            for (int j = 0; j < 4; ++j) k4[j] = x[j] + (0.5f * (a[j] + b[j]) - x[j]) * mk_[j];
        }
        {
            const u32x2 cu = *(const u32x2*)(row + C_RWV + c), pv = hp ? *(const u32x2*)(row - LDP + C_RWV + c) : z, nx = hn ? *(const u32x2*)(row + LDP + C_RWV + c) : z;
            const float x[4] = { bflo(cu.x), bfhi(cu.x), bflo(cu.y), bfhi(cu.y) }, a[4] = { bflo(pv.x), bfhi(pv.x), bflo(pv.y), bfhi(pv.y) }, b[4] = { bflo(nx.x), bfhi(nx.x), bflo(nx.y), bfhi(nx.y) };
#pragma unroll
            for (int j = 0; j < 4; ++j) v4[j] = x[j] + (0.5f * (a[j] + b[j]) - x[j]) * mv_[j];
        }
        const u32x2 af = *(const u32x2*)(RWX + (size_t)t * 1024 + 512 + c), ab = *(const u32x2*)(RWX + (size_t)t * 1024 + 768 + c);
        const float a0[4] = { bflo(af.x), bfhi(af.x), bflo(af.y), bfhi(af.y) }, a1[4] = { bflo(ab.x), bfhi(ab.x), bflo(ab.y), bfhi(ab.y) };
        const u32x2 yf = *(const u32x2*)(RWY + (size_t)t * 256 + c), yb = *(const u32x2*)(RWY + (size_t)TT * 256 + (size_t)t * 256 + c);
        float y[4] = { bflo(yf.x) + bflo(yb.x), bfhi(yf.x) + bfhi(yb.x), bflo(yf.y) + bflo(yb.y), bfhi(yf.y) + bfhi(yb.y) };
        float s = y[0] + y[1] + y[2] + y[3];
        s = group_sum<16>(s);
        const float mean = s * (1.f / 64.f);
        float q = 0.f, bon = 0.f;
#pragma unroll
        for (int j = 0; j < 4; ++j) {
            const float dlt = y[j] - mean; q += dlt * dlt;
            const float kmsum = k4[j] * (2.f + (a0[j] + a1[j] - 2.f) * ka_[j]);
            bon += r4[j] * kmsum * rk_[j];
        }
        q = group_sum<16>(q); bon = group_sum<16>(bon);
        const float rstd = rsqrtf(q * (1.f / 64.f) + 64e-5f);
        const u32x2 gg = *(const u32x2*)(row + C_RWD + c);
        const float g[4] = { bflo(gg.x), bfhi(gg.x), bflo(gg.y), bfhi(gg.y) };
        float o[4];
#pragma unroll
        for (int j = 0; j < 4; ++j) o[j] = ((y[j] - mean) * rstd * lg_[j] + lb_[j] + bon * v4[j]) * g[j];
        u32x2 ov; ov.x = pack2(o[0], o[1]); ov.y = pack2(o[2], o[3]);
        *(u32x2*)(Y + (size_t)t * 1024 + 768 + c) = ov;
    }
}
#ifndef MEGA
#define MEGA 0
#endif
constexpr int NPHASE = 15;
template <int PH>
DEV void run_phase(const Params& p, int l, char* smem) {
    const bool need_ctx = (l == 0);
    const int M = need_ctx ? TT : TL;
    if constexpr (PH == 0) { phase_mod_partial(p, smem); __syncthreads(); phase_conv_small(p, smem); phase_conv_layer(p, 0, smem); phase_conv_experts(p, 0, smem); }
    if constexpr (PH == 1) { phase_mod_reduce(p); }
    if constexpr (PH == 2) { phase_norm<1>(p, l, TT); if (l == 1) { phase_conv_layer(p, 1, smem); phase_conv_experts(p, 1, smem); } }
    if constexpr (PH == 3) { phase_inproj(p, l, smem); }
    if constexpr (PH == 4) { phase_prep1(p, l); phase_s5_pass1(p, l, smem); }
    if constexpr (PH == 5) { phase_prep_gemm1(p, l, smem); }
    if constexpr (PH == 6) { phase_prep_gemm2(p, l, smem); phase_prep2(p, l); }
    if constexpr (PH == 7) { phase_rwkv(p, l, smem); }
    if constexpr (PH == 14) { phase_attn(p, l, smem); }
    if constexpr (PH == 15) { phase_s5_pass2(p, l, need_ctx ? 0 : 1, smem); }
    if constexpr (PH == 8) { phase_s5_glu(p, l, M, smem); phase_rw_finish(p, l, M); }
    if constexpr (PH == 9) { phase_merge(p, l, M, smem); }
    if constexpr (PH == 10) { phase_outproj(p, l, M, smem); }
    if constexpr (PH == 11) { phase_norm<2>(p, l, M); }
    if constexpr (PH == 12) { phase_moe1(p, l, smem); }
    if constexpr (PH == 13) { phase_moe2(p, l, smem); }
}

#if !MEGA
template <int PH>
__global__ void __launch_bounds__(NT, 2) k_phase(Params p, int l) {
    extern __shared__ __attribute__((aligned(16))) char smem[];
    run_phase<PH>(p, l, smem);
}
#endif
__global__ void __launch_bounds__(NT) k_fail(float* out, int n) {
    for (int i = blockIdx.x * NT + threadIdx.x; i < n; i += gridDim.x * NT) out[i] = __int_as_float(0x7fc00000);
}

template <int PH>
static void launch_phase(const Params& p, int l, int grid, hipStream_t stream) {
#if !MEGA
    static bool attr = false;
    if (!attr) { (void)hipFuncSetAttribute((const void*)k_phase<PH>, hipFuncAttributeMaxDynamicSharedMemorySize, SMEM_BYTES); attr = true; }
    hipLaunchKernelGGL(k_phase<PH>, dim3(grid), dim3(NT), SMEM_BYTES, stream, p, l);
#endif
}

extern "C" void kernel_launch(void* const* d_in, const int* in_sizes, int n_in, void* d_out, int out_size, void* d_ws, size_t ws_size, hipStream_t stream) {
    if (n_in != 48 || out_size != TL * DM || ws_size < WS_END) {
        hipLaunchKernelGGL(k_fail, dim3(256), dim3(NT), 0, stream, (float*)d_out, out_size);
        return;
    }
    Params p{};
    for (int i = 0; i < 48; ++i) p.in[i] = (const float*)d_in[i];
    p.out = (float*)d_out; p.ws = (char*)d_ws;
    (void)hipMemsetAsync(d_ws, 0, ZERO_BYTES, stream);
    const int grid = 512;
#if !MEGA
    launch_phase<0>(p, 0, grid, stream);
    launch_phase<1>(p, 0, grid, stream);
    for (int l = 0; l < 2; ++l) {
        launch_phase<2>(p, l, grid, stream);
        launch_phase<3>(p, l, grid, stream);
        launch_phase<4>(p, l, grid, stream);
        launch_phase<5>(p, l, grid, stream);
        launch_phase<6>(p, l, grid, stream);
        launch_phase<7>(p, l, grid, stream);
        launch_phase<14>(p, l, grid, stream);
        launch_phase<15>(p, l, grid, stream);
        launch_phase<8>(p, l, grid, stream);
        launch_phase<9>(p, l, grid, stream);
        launch_phase<10>(p, l, grid, stream);
        launch_phase<11>(p, l, grid, stream);
        launch_phase<12>(p, l, grid, stream);
        launch_phase<13>(p, l, grid, stream);
    }
#endif
}
```

```cpp
#define MEGA 1
#include <hip/hip_runtime.h>
#include <stdint.h>
#include <math.h>

#define DEV __device__ __forceinline__
#define LAS __attribute__((address_space(3)))
typedef unsigned short bf16_t;
typedef short bf16x8 __attribute__((ext_vector_type(8)));
typedef float f32x16 __attribute__((ext_vector_type(16)));
typedef float f32x4 __attribute__((ext_vector_type(4)));
typedef unsigned u32x4 __attribute__((ext_vector_type(4)));
typedef unsigned u32x2 __attribute__((ext_vector_type(2)));

constexpr int NT = 256;
constexpr int DM = 1024, NB = 8, SEQ = 2048, CTXL = 256, GRIDW = 64;
constexpr int TL = NB * SEQ, TC = NB * CTXL, TT = TL + TC;
constexpr int NIN = 6480, LDP = 2432, NINP = 6528, NGATE0 = 2432;
constexpr int C_DAQ = 0, C_DAK = 256, C_DAV = 512, C_S5 = 768, C_CQ = 1024, C_CKV = 1216, C_KR = 1344,
              C_RWR = 1360, C_RWK = 1616, C_RWV = 1872, C_RWD = 2128, C_PEND = 2384;
constexpr int NEXP = 16, DFF = 512;
constexpr float EPS = 1e-6f;
constexpr float LOG2E = 1.4426950408889634f;

constexpr size_t al256(size_t x) { return (x + 255) & ~(size_t)255; }
constexpr size_t OFF_BAR  = 0;
constexpr size_t OFF_CTR  = 16384;
constexpr size_t ZERO_BYTES = 20480;
constexpr size_t OFF_MOD  = 32768;
constexpr size_t SZ_MOD   = (size_t)2 * 9 * 6144 * 4;
constexpr int    MOD_KS   = 8;
constexpr size_t OFF_MODP = al256(OFF_MOD + SZ_MOD);
constexpr size_t OFF_S5ST = al256(OFF_MODP + MOD_KS * SZ_MOD);
constexpr size_t OFF_LTOK = al256(OFF_S5ST + (size_t)2 * 8 * 16 * 8 * 64 * 2 * 4);
constexpr size_t OFF_LW   = al256(OFF_LTOK + (size_t)NEXP * TT * 4);
constexpr size_t OFF_WSM  = al256(OFF_LW + (size_t)NEXP * TT * 4);
constexpr int WS_GLUT = 0, WS_UQT = WS_GLUT + 256 * 256, WS_UKVT = WS_UQT + 192 * 192, WS_W1C = WS_UKVT + 384 * 128,
              WS_W2 = WS_W1C + 192 * 256, WS_G2T = WS_W2 + 4 * 256 * 64, WS_PER_LAYER = WS_G2T + 256 * 64;
constexpr size_t OFF_WIN  = al256(OFF_WSM + (size_t)2 * WS_PER_LAYER * 2);
constexpr size_t OFF_WBR  = al256(OFF_WIN + (size_t)NINP * 1024 * 2);
constexpr size_t OFF_WOUT = al256(OFF_WBR + (size_t)4 * 1024 * 256 * 2);
constexpr size_t OFF_WG1  = al256(OFF_WOUT + (size_t)1024 * 1024 * 2);
constexpr size_t OFF_WDN  = al256(OFF_WG1 + (size_t)NEXP * 1024 * 1024 * 2);
constexpr size_t OFF_H    = al256(OFF_WDN + (size_t)NEXP * 1024 * 512 * 2);
constexpr size_t OFF_P    = al256(OFF_H + (size_t)TT * 1024 * 2);
constexpr size_t OFF_GATE = al256(OFF_P + (size_t)TT * LDP * 2);
constexpr size_t OFF_MLAQ = al256(OFF_GATE + (size_t)TT * 4096);
constexpr size_t OFF_MLAK = al256(OFF_MLAQ + (size_t)TT * 192 * 2);
constexpr size_t OFF_MLAV = al256(OFF_MLAK + (size_t)TT * 192 * 2);
constexpr size_t OFF_RWX  = al256(OFF_MLAV + (size_t)TT * 256 * 2);
constexpr size_t OFF_Y    = al256(OFF_RWX + (size_t)TT * 1024 * 2);
constexpr size_t OFF_CX   = al256(OFF_Y + (size_t)TT * 1024 * 2);
constexpr size_t WS_END   = al256(OFF_CX + (size_t)TC * 1024 * 4);
constexpr size_t OFF_QRAW = OFF_Y;
constexpr size_t OFF_KVRAW = OFF_QRAW + (size_t)TT * 192 * 2;
constexpr size_t OFF_LR   = OFF_KVRAW + (size_t)TT * 384 * 2;
constexpr size_t OFF_XL   = OFF_LR + (size_t)TT * 192 * 2;
static_assert(OFF_XL + (size_t)TT * 256 * 2 <= OFF_Y + (size_t)TT * 1024 * 2, "temps overflow Y");
constexpr size_t OFF_RWY  = OFF_H;

constexpr int CTR_MOE = 0;
constexpr int CTR_Q   = 64;

constexpr int SMEM_BYTES = 73728 + 256;

struct Params {
    const float* in[48];
    float* out;
    char* ws;
};
enum { I_X = 0, I_C, I_CTX, I_CCTX, I_WADA, I_BADA, I_NMG, I_NFG, I_WIN, I_DAQKG, I_DALAM, I_DASUB,
       I_S5LRE, I_S5LIM, I_S5LDT, I_S5BRE, I_S5BIM, I_S5CRE, I_S5CIM, I_S5D, I_S5WGLU, I_S5BGLU,
       I_MCQG, I_MCKVG, I_MWUQ, I_MWUKV, I_MQKG,
       I_RMU, I_RW0, I_RW1, I_RW2, I_RA0, I_RA1, I_RA2, I_RG1, I_RG2, I_RKK, I_RKA, I_RRK, I_RLNG, I_RLNB,
       I_WBR, I_WOUT, I_ROUTW, I_ROUTB, I_EWG, I_EWU, I_EWD };

DEV int tidx() { int t = threadIdx.x; asm volatile("" : "+v"(t)); return t; }
DEV int bidx() { int b = blockIdx.x; asm volatile("" : "+s"(b)); return b; }
DEV bf16_t f2bf(float f) { unsigned u = __float_as_uint(f); u += 0x7FFFu + ((u >> 16) & 1u); return (bf16_t)(u >> 16); }
DEV float bf2f(bf16_t h) { return __uint_as_float(((unsigned)h) << 16); }
DEV unsigned pack2(float lo, float hi) { return (unsigned)f2bf(lo) | ((unsigned)f2bf(hi) << 16); }
DEV float bflo(unsigned u) { return __uint_as_float(u << 16); }
DEV float bfhi(unsigned u) { return __uint_as_float(u & 0xFFFF0000u); }
DEV float sigmoidf_(float x) { return 1.f / (1.f + __expf(-x)); }
DEV float wave_sum(float v) {
#pragma unroll
    for (int o = 32; o >= 1; o >>= 1) v += __shfl_xor(v, o, 64);
    return v;
}
template <int W> DEV float group_sum(float v) {
#pragma unroll
    for (int o = W / 2; o >= 1; o >>= 1) v += __shfl_xor(v, o, 64);
    return v;
}
DEV int mod_row(int t) { return t < TL ? (t >> 11) : 8; }
DEV bf16_t* wsb(const Params& p, size_t off) { return (bf16_t*)(p.ws + off); }
DEV float* wsf(const Params& p, size_t off) { return (float*)(p.ws + off); }
DEV const float* modp(const Params& p, int l, int row, int which) { return (const float*)(p.ws + OFF_MOD) + ((size_t)(l * 9 + row) * 6 + which) * 1024; }
#define XB_TMO      128
#define XB_XCNT(j)  (256  + 64 * (j))
#define XB_XSUB(j)  (1280 + 64 * (j))
#define XB_XGEN(j)  (2304 + 64 * (j))
#define XB_TOP      3328
#define XB_TOPGEN   3392
#define XCD_BAR_WORDS 3456
#define XB_SPIN_CAP (1u << 18)

__device__ __forceinline__ unsigned xb_ld(unsigned* p)              { return __hip_atomic_load(p, __ATOMIC_RELAXED, __HIP_MEMORY_SCOPE_AGENT); }
__device__ __forceinline__ unsigned xb_add(unsigned* p, unsigned v) { return __hip_atomic_fetch_add(p, v, __ATOMIC_RELAXED, __HIP_MEMORY_SCOPE_AGENT); }
__device__ __forceinline__ unsigned xb_xcc_id() { return (unsigned)__builtin_amdgcn_s_getreg((3 << 11) | 20) & 0xFu; }
#define XB_SPIN(cond, bar) do { unsigned _sp = 0; while (cond) { __builtin_amdgcn_s_sleep(1); \
    if ((++_sp & 255u) == 0u) { if (xb_ld(&(bar)[XB_TMO])) break; if (_sp > XB_SPIN_CAP) { atomicAdd(&(bar)[XB_TMO], 1u); break; } } } } while (0)

struct XcdBarrier {
    unsigned* bar; unsigned x;
    volatile LAS unsigned* st;
};

__device__ __forceinline__ XcdBarrier xcd_barrier_post(unsigned* bar, volatile LAS unsigned* st) {
    XcdBarrier b; b.bar = bar; b.x = xb_xcc_id(); b.st = st;
    if (threadIdx.x == 0) (void)xb_add(&bar[XB_XCNT(b.x)], 1u);
    return b;
}
__device__ __forceinline__ void xcd_barrier_complete(unsigned* bar, unsigned x, unsigned& nloc, unsigned& nx) {
    const unsigned G = gridDim.x * gridDim.y * gridDim.z;
    unsigned sum, cnt, mine, sp = 0u;
    for (;;) {
        sum = 0u; cnt = 0u; mine = 0u;
#pragma unroll
        for (unsigned j = 0; j < 16; ++j) { const unsigned c = xb_ld(&bar[XB_XCNT(j)]); sum += c; cnt += (c > 0u) ? 1u : 0u; mine = (j == x) ? c : mine; }
        if (sum == G) break;
        __builtin_amdgcn_s_sleep(1);
        if ((++sp & 255u) == 0u) { if (xb_ld(&bar[XB_TMO])) break; if (sp > XB_SPIN_CAP) { atomicAdd(&bar[XB_TMO], 1u); break; } }
    }
    nloc = mine > 0u ? mine : 1u; nx = cnt > 0u ? cnt : 1u;
}

__device__ __forceinline__ void xcd_barrier(const XcdBarrier& b) {
    asm volatile("s_waitcnt vmcnt(0)" ::: "memory");
    __syncthreads();
    if (threadIdx.x == 0) {
        unsigned* bar = b.bar;
        __builtin_amdgcn_s_waitcnt(0);
        unsigned nloc = b.st[0], nx = b.st[1];
        if (nloc == 0u) { xcd_barrier_complete(bar, b.x, nloc, nx); b.st[0] = nloc; b.st[1] = nx; }
        const unsigned old = xb_add(&bar[XB_XSUB(b.x)], 1u);
        const unsigned gen = old / nloc;
        if (old + 1u == (gen + 1u) * nloc) {
            __builtin_amdgcn_fence(__ATOMIC_RELEASE, "agent");
            asm volatile("s_waitcnt vmcnt(0)" ::: "memory");
            const unsigned og = xb_add(&bar[XB_TOP], 1u);
            const unsigned tg = og / nx;
            if (og + 1u == (tg + 1u) * nx) xb_add(&bar[XB_TOPGEN], 1u);
            else XB_SPIN(xb_ld(&bar[XB_TOPGEN]) == tg, bar);
            __builtin_amdgcn_fence(__ATOMIC_ACQUIRE, "agent");
            xb_add(&bar[XB_XGEN(b.x)], 1u);
            asm volatile("s_waitcnt vmcnt(0)" ::: "memory");
        } else {
            XB_SPIN(xb_ld(&bar[XB_XGEN(b.x)]) == gen, bar);
            __builtin_amdgcn_fence(__ATOMIC_ACQUIRE, "agent");
            asm volatile("s_waitcnt vmcnt(0)" ::: "memory");
        }
    }
    __syncthreads();
}

DEV void phase_mod_partial(const Params& p, char* smem) {
    float* sm = (float*)smem;
    const int tid = tidx();
    const int nitems = 2 * 24 * MOD_KS;
    for (int item = bidx(); item < nitems; item += gridDim.x) {
        const int l = item / (24 * MOD_KS), rem = item % (24 * MOD_KS), jc = rem / MOD_KS, ks = rem % MOD_KS;
        __syncthreads();
        for (int i = tid; i < 9 * 128; i += NT) {
            const int r = i >> 7, k = ks * 128 + (i & 127);
            const float cv = r < 8 ? p.in[I_C][r * 1024 + k] : p.in[I_CCTX][k];
            sm[i] = cv / (1.f + __expf(-cv));
        }
        __syncthreads();
        const int j = jc * 256 + tid;
        float acc[9];
#pragma unroll
        for (int r = 0; r < 9; ++r) acc[r] = 0.f;
        const float* w = p.in[I_WADA] + (size_t)l * 1024 * 6144 + (size_t)(ks * 128) * 6144 + j;
#pragma unroll 8
        for (int k = 0; k < 128; ++k) {
            const float wv = w[(size_t)k * 6144];
#pragma unroll
            for (int r = 0; r < 9; ++r) acc[r] += sm[r * 128 + k] * wv;
        }
        float* dst = wsf(p, OFF_MODP);
#pragma unroll
        for (int r = 0; r < 9; ++r) dst[((size_t)(ks * 2 + l) * 9 + r) * 6144 + j] = acc[r];
    }
}
DEV void phase_mod_reduce(const Params& p) {
    const int n = 2 * 9 * 6144;
    float* mod = wsf(p, OFF_MOD);
    const float* part = wsf(p, OFF_MODP);
    for (int i = bidx() * NT + tidx(); i < n; i += gridDim.x * NT) {
        const int l = i / (9 * 6144), j = i % 6144;
        float s = p.in[I_BADA][l * 6144 + j];
#pragma unroll
        for (int ks = 0; ks < MOD_KS; ++ks) s += part[(size_t)ks * n + i];
        mod[i] = s;
    }
}

template <int MODE>
DEV void conv_tile(const float* src, int R, int C, int ld, bf16_t* dst, int ldd, int roff, int tr, int tc, float* sm) {
    const int r0 = tr * 64, c0 = tc * 64, tid = tidx();
    for (int i = tid; i < 64 * 16; i += NT) {
        const int r = i >> 4, c4 = (i & 15) * 4;
        float4 v = make_float4(0.f, 0.f, 0.f, 0.f);
        if (r0 + r < R) {
            const float* s = src + (size_t)(r0 + r) * ld + c0 + c4;
            if (c0 + c4 + 3 < C) v = *(const float4*)s;
            else { if (c0 + c4 < C) v.x = s[0]; if (c0 + c4 + 1 < C) v.y = s[1]; if (c0 + c4 + 2 < C) v.z = s[2]; }
        }
        float* d = sm + r * 65 + c4;
        d[0] = v.x; d[1] = v.y; d[2] = v.z; d[3] = v.w;
    }
    __syncthreads();
    for (int i = tid; i < 64 * 8; i += NT) {
        const int c = i >> 3, r8 = (i & 7) * 8;
        if (c0 + c < C && r0 + r8 < R) {
            const int cc = c0 + c;
            const int drow = (MODE == 0) ? (cc + roff) : ((cc >> 5) * 64 + (cc & 31) + roff);
            uint4 o;
            o.x = pack2(sm[(r8 + 0) * 65 + c], sm[(r8 + 1) * 65 + c]);
            o.y = pack2(sm[(r8 + 2) * 65 + c], sm[(r8 + 3) * 65 + c]);
            o.z = pack2(sm[(r8 + 4) * 65 + c], sm[(r8 + 5) * 65 + c]);
            o.w = pack2(sm[(r8 + 6) * 65 + c], sm[(r8 + 7) * 65 + c]);
            *(uint4*)(dst + (size_t)drow * ldd + r0 + r8) = o;
        }
    }
    __syncthreads();
}
template <int MODE>
DEV void conv_job(const float* src, int R, int C, int ld, bf16_t* dst, int ldd, int roff, int& rot, float* sm) {
    const int ntr = (R + 63) >> 6, ntc = (C + 63) >> 6, nt = ntr * ntc, G = gridDim.x;
    int first = (bidx() - (rot % G) + G) % G;
    for (int t = first; t < nt; t += G) conv_tile<MODE>(src, R, C, ld, dst, ldd, roff, t / ntc, t % ntc, sm);
    rot += nt;
}
DEV void phase_conv_layer(const Params& p, int l, char* smem) {
    float* sm = (float*)smem;
    int rot = 0;
    const float* win = p.in[I_WIN] + (size_t)l * 1024 * NIN;
    conv_job<0>(win, 1024, C_PEND, NIN, wsb(p, OFF_WIN), 1024, 0, rot, sm);
    conv_job<0>(win + C_PEND, 1024, 4096, NIN, wsb(p, OFF_WIN), 1024, NGATE0, rot, sm);
    {
        uint4* z = (uint4*)(wsb(p, OFF_WIN) + (size_t)C_PEND * 1024);
        const int n = (NGATE0 - C_PEND) * 1024 / 8;
        for (int i = bidx() * NT + tidx(); i < n; i += gridDim.x * NT) z[i] = make_uint4(0u, 0u, 0u, 0u);
    }
    for (int i = 0; i < 4; ++i)
        conv_job<0>(p.in[I_WBR] + (size_t)(l * 4 + i) * 256 * 1024, 256, 1024, 1024, wsb(p, OFF_WBR) + (size_t)i * 1024 * 256, 256, 0, rot, sm);
    conv_job<0>(p.in[I_WOUT] + (size_t)l * 1024 * 1024, 1024, 1024, 1024, wsb(p, OFF_WOUT), 1024, 0, rot, sm);
}
DEV void phase_conv_experts(const Params& p, int l, char* smem) {
    float* sm = (float*)smem;
    int rot = 0;
    for (int e = 0; e < NEXP; ++e) {
        conv_job<1>(p.in[I_EWG] + (size_t)(l * NEXP + e) * 1024 * DFF, 1024, DFF, DFF, wsb(p, OFF_WG1) + (size_t)e * 1024 * 1024, 1024, 0, rot, sm);
        conv_job<1>(p.in[I_EWU] + (size_t)(l * NEXP + e) * 1024 * DFF, 1024, DFF, DFF, wsb(p, OFF_WG1) + (size_t)e * 1024 * 1024, 1024, 32, rot, sm);
        conv_job<0>(p.in[I_EWD] + (size_t)(l * NEXP + e) * DFF * 1024, DFF, 1024, 1024, wsb(p, OFF_WDN) + (size_t)e * 1024 * DFF, DFF, 0, rot, sm);
    }
}
DEV void phase_conv_small(const Params& p, char* smem) {
    float* sm = (float*)smem;
    int rot = 0;
    for (int l = 0; l < 2; ++l) {
        bf16_t* w = wsb(p, OFF_WSM) + (size_t)l * WS_PER_LAYER;
        for (int i = bidx() * NT + tidx(); i < 4 * 256 * 4; i += gridDim.x * NT)
            *(u32x4*)(w + WS_W2 + (size_t)(i >> 2) * 64 + 32 + (i & 3) * 8) = (u32x4){0u, 0u, 0u, 0u};
        conv_job<0>(p.in[I_S5WGLU] + (size_t)l * 256 * 256, 256, 256, 256, w + WS_GLUT, 256, 0, rot, sm);
        conv_job<0>(p.in[I_MWUQ] + (size_t)l * 192 * 192, 192, 192, 192, w + WS_UQT, 192, 0, rot, sm);
        conv_job<0>(p.in[I_MWUKV] + (size_t)l * 128 * 384, 128, 384, 384, w + WS_UKVT, 128, 0, rot, sm);
        for (int d = 0; d < 2; ++d) {
            conv_job<0>(p.in[I_RW1] + (size_t)(l * 2 + d) * 256 * 32, 256, 32, 32, w + WS_W1C, 256, d * 32, rot, sm);
            conv_job<0>(p.in[I_RA1] + (size_t)(l * 2 + d) * 256 * 32, 256, 32, 32, w + WS_W1C, 256, 64 + d * 32, rot, sm);
            conv_job<0>(p.in[I_RW2] + (size_t)(l * 2 + d) * 32 * 256, 32, 256, 256, w + WS_W2 + (size_t)d * 256 * 64, 64, 0, rot, sm);
            conv_job<0>(p.in[I_RA2] + (size_t)(l * 2 + d) * 32 * 256, 32, 256, 256, w + WS_W2 + (size_t)(2 + d) * 256 * 64, 64, 0, rot, sm);
        }
        conv_job<0>(p.in[I_RG1] + (size_t)l * 256 * 64, 256, 64, 64, w + WS_W1C, 256, 128, rot, sm);
        conv_job<0>(p.in[I_RG2] + (size_t)l * 64 * 256, 64, 256, 256, w + WS_G2T, 64, 0, rot, sm);
    }
}

template <int WHICH>
DEV void phase_norm(const Params& p, int l, int nrows) {
    const int lane = tidx() & 63, wave = tidx() >> 6;
    const float* xs = (l == 0) ? p.in[I_X] : p.out;
    const float* cs = (l == 0) ? p.in[I_CTX] : wsf(p, OFF_CX);
    const float* g = p.in[WHICH == 1 ? I_NMG : I_NFG] + l * 1024;
    bf16_t* H = wsb(p, OFF_H);
    if (WHICH == 2) { xs = p.out; cs = wsf(p, OFF_CX); }
    for (int row = bidx() * 4 + wave; row < nrows; row += gridDim.x * 4) {
        const float* src = row < TL ? xs + (size_t)row * 1024 : cs + (size_t)(row - TL) * 1024;
        const int mr = mod_row(row);
        const float* sh = modp(p, l, mr, WHICH == 1 ? 0 : 3);
        const float* sc = modp(p, l, mr, WHICH == 1 ? 1 : 4);
        float4 v[4];
        float ss = 0.f;
#pragma unroll
        for (int i = 0; i < 4; ++i) {
            v[i] = *(const float4*)(src + lane * 4 + i * 256);
            ss += v[i].x * v[i].x + v[i].y * v[i].y + v[i].z * v[i].z + v[i].w * v[i].w;
        }
        ss = wave_sum(ss);
        const float rstd = rsqrtf(ss * (1.f / 1024.f) + EPS);
        float hv[16];
#pragma unroll
        for (int i = 0; i < 4; ++i) {
            const int c = lane * 4 + i * 256;
            const float4 gg = *(const float4*)(g + c), s4 = *(const float4*)(sh + c), c4 = *(const float4*)(sc + c);
            hv[i * 4 + 0] = v[i].x * rstd * gg.x * (1.f + c4.x) + s4.x;
            hv[i * 4 + 1] = v[i].y * rstd * gg.y * (1.f + c4.y) + s4.y;
            hv[i * 4 + 2] = v[i].z * rstd * gg.z * (1.f + c4.z) + s4.z;
            hv[i * 4 + 3] = v[i].w * rstd * gg.w * (1.f + c4.w) + s4.w;
            u32x2 o; o.x = pack2(hv[i * 4 + 0], hv[i * 4 + 1]); o.y = pack2(hv[i * 4 + 2], hv[i * 4 + 3]);
            *(u32x2*)(H + (size_t)row * 1024 + c) = o;
        }
        if (WHICH == 2) {
            float lg[16];
#pragma unroll
            for (int e = 0; e < 16; ++e) lg[e] = 0.f;
            const float* rw = p.in[I_ROUTW];
#pragma unroll
            for (int i = 0; i < 4; ++i)
#pragma unroll
                for (int j = 0; j < 4; ++j) {
                    const int c = lane * 4 + i * 256 + j;
                    const float hvv = hv[i * 4 + j];
#pragma unroll
                    for (int q = 0; q < 4; ++q) {
                        const float4 w4 = *(const float4*)(rw + (size_t)c * 16 + q * 4);
                        lg[q * 4 + 0] += hvv * w4.x; lg[q * 4 + 1] += hvv * w4.y; lg[q * 4 + 2] += hvv * w4.z; lg[q * 4 + 3] += hvv * w4.w;
                    }
                }
#pragma unroll
            for (int e = 0; e < 16; ++e) lg[e] = wave_sum(lg[e]);
            float sc16[16], bs[16];
#pragma unroll
            for (int e = 0; e < 16; ++e) { sc16[e] = sigmoidf_(lg[e]); bs[e] = sc16[e] + p.in[I_ROUTB][e]; }
            int bestg = 0; float bestv = -INFINITY;
#pragma unroll
            for (int gi = 0; gi < 4; ++gi) {
                float m1 = -INFINITY, m2 = -INFINITY;
#pragma unroll
                for (int k = 0; k < 4; ++k) { const float x = bs[gi * 4 + k]; if (x > m1) { m2 = m1; m1 = x; } else if (x > m2) m2 = x; }
                const float gs = m1 + m2;
                if (gs > bestv) { bestv = gs; bestg = gi; }
            }
            int i0 = 0, i1 = 0; float v0 = -INFINITY, v1 = -INFINITY, s0 = 0.f, s1 = 0.f;
#pragma unroll
            for (int e = 0; e < 16; ++e) { const bool in = (e >> 2) == bestg; if (in && bs[e] > v0) { v0 = bs[e]; i0 = e; s0 = sc16[e]; } }
#pragma unroll
            for (int e = 0; e < 16; ++e) { const bool in = (e >> 2) == bestg && e != i0; if (in && bs[e] > v1) { v1 = bs[e]; i1 = e; s1 = sc16[e]; } }
            const float inv = 1.f / (s0 + s1);
            if (lane == 0) {
                int* cnt = (int*)(p.ws + OFF_CTR) + CTR_MOE + l * 16;
                int* ltok = (int*)(p.ws + OFF_LTOK);
                float* lw = (float*)(p.ws + OFF_LW);
                const int p0 = atomicAdd(cnt + i0, 1);
                ltok[(size_t)i0 * TT + p0] = row; lw[(size_t)i0 * TT + p0] = s0 * inv;
                const int p1 = atomicAdd(cnt + i1, 1);
                ltok[(size_t)i1 * TT + p1] = row; lw[(size_t)i1 * TT + p1] = s1 * inv;
            }
        }
    }
}
constexpr int GLD = 72;
constexpr int GSTAGE = 128 * GLD;
template <class AF, class BF>
DEV void gemm_mainloop(f32x16 (&acc)[2][2], AF arow, BF brow, int K, bf16_t* sm) {
    const int tid = tidx(), lane = tid & 63, wave = tid >> 6, wm = wave >> 1, wn = wave & 1;
    bf16_t* As = sm;
    bf16_t* Bs = sm + 2 * GSTAGE;
    const bf16_t* ap[4]; const bf16_t* bp[4];
#pragma unroll
    for (int i = 0; i < 4; ++i) { const int q = tid + i * NT; ap[i] = arow(q >> 3) + (q & 7) * 8; bp[i] = brow(q >> 3) + (q & 7) * 8; }
    u32x4 ra[4], rb[4];
    const int nk = K >> 6;
#pragma unroll
    for (int i = 0; i < 4; ++i) { ra[i] = *(const u32x4*)ap[i]; rb[i] = *(const u32x4*)bp[i]; }
    __syncthreads();
#pragma unroll
    for (int i = 0; i < 4; ++i) { const int q = tid + i * NT; *(u32x4*)(As + (q >> 3) * GLD + (q & 7) * 8) = ra[i]; *(u32x4*)(Bs + (q >> 3) * GLD + (q & 7) * 8) = rb[i]; }
    __syncthreads();
    const int arow0 = (wm * 64 + (lane & 31)) * GLD + (lane >> 5) * 8;
    const int brow0 = (wn * 64 + (lane & 31)) * GLD + (lane >> 5) * 8;
    for (int kt = 0; kt < nk; ++kt) {
        const int cur = kt & 1;
        if (kt + 1 < nk) {
            const int k0 = (kt + 1) * 64;
#pragma unroll
            for (int i = 0; i < 4; ++i) { ra[i] = *(const u32x4*)(ap[i] + k0); rb[i] = *(const u32x4*)(bp[i] + k0); }
        }
        const bf16_t* a_s = As + cur * GSTAGE + arow0;
        const bf16_t* b_s = Bs + cur * GSTAGE + brow0;
#pragma unroll
        for (int ks = 0; ks < 4; ++ks) {
            const bf16x8 a0 = *(const bf16x8*)(a_s + ks * 16);
            const bf16x8 a1 = *(const bf16x8*)(a_s + 32 * GLD + ks * 16);
            const bf16x8 b0 = *(const bf16x8*)(b_s + ks * 16);
            const bf16x8 b1 = *(const bf16x8*)(b_s + 32 * GLD + ks * 16);
            acc[0][0] = __builtin_amdgcn_mfma_f32_32x32x16_bf16(a0, b0, acc[0][0], 0, 0, 0);
            acc[0][1] = __builtin_amdgcn_mfma_f32_32x32x16_bf16(a0, b1, acc[0][1], 0, 0, 0);
            acc[1][0] = __builtin_amdgcn_mfma_f32_32x32x16_bf16(a1, b0, acc[1][0], 0, 0, 0);
            acc[1][1] = __builtin_amdgcn_mfma_f32_32x32x16_bf16(a1, b1, acc[1][1], 0, 0, 0);
        }
        if (kt + 1 < nk) {
            const int nx = cur ^ 1;
#pragma unroll
            for (int i = 0; i < 4; ++i) { const int q = tid + i * NT; *(u32x4*)(As + nx * GSTAGE + (q >> 3) * GLD + (q & 7) * 8) = ra[i]; *(u32x4*)(Bs + nx * GSTAGE + (q >> 3) * GLD + (q & 7) * 8) = rb[i]; }
        }
        __syncthreads();
    }
}
DEV void acc_zero(f32x16 (&acc)[2][2]) {
#pragma unroll
    for (int i = 0; i < 2; ++i)
#pragma unroll
        for (int j = 0; j < 2; ++j)
#pragma unroll
            for (int r = 0; r < 16; ++r) acc[i][j][r] = 0.f;
}
#define EPI_FOREACH(acc, ...)                                                                           \
    {                                                                                                    \
        const int _lane = tidx() & 63, _wave = tidx() >> 6, _wm = _wave >> 1, _wn = _wave & 1; \
        _Pragma("unroll") for (int _i = 0; _i < 2; ++_i)                                                 \
        _Pragma("unroll") for (int _j = 0; _j < 2; ++_j)                                                 \
        _Pragma("unroll") for (int _r = 0; _r < 16; ++_r) {                                              \
            const int er = _wm * 64 + _i * 32 + (_r & 3) + 8 * (_r >> 2) + 4 * (_lane >> 5);             \
            const int ec = _wn * 64 + _j * 32 + (_lane & 31);                                            \
            const float ev = acc[_i][_j][_r];                                                            \
            __VA_ARGS__                                                                                  \
        }                                                                                                \
    }

DEV void tile_mn(int item, int nMt, int nNt, int& mt, int& nt) {
    constexpr int GM = 16;
    const int per = GM * nNt, g = item / per, rem = item % per;
    const int m0 = g * GM, gsz = (nMt - m0) < GM ? (nMt - m0) : GM;
    mt = m0 + rem % gsz; nt = rem / gsz;
}

DEV void phase_inproj(const Params& p, int l, char* smem) {
    bf16_t* sm = (bf16_t*)smem;
    const bf16_t* H = wsb(p, OFF_H);
    const bf16_t* W = wsb(p, OFF_WIN);
    bf16_t* P = wsb(p, OFF_P);
    unsigned char* G = (unsigned char*)(p.ws + OFF_GATE);
    const int nMt = TT / 128, nNt = NINP / 128;
    for (int item = bidx(); item < nMt * nNt; item += gridDim.x) {
        int mt, nt; tile_mn(item, nMt, nNt, mt, nt);
        const int m0 = mt * 128, n0 = nt * 128;
        if (l == 1 && m0 >= TL && n0 >= NGATE0) continue;
        f32x16 acc[2][2]; acc_zero(acc);
        gemm_mainloop(acc, [&](int r) { return H + (size_t)(m0 + r) * 1024; }, [&](int r) { return W + (size_t)(n0 + r) * 1024; }, 1024, sm);
        if (n0 < NGATE0) {
            EPI_FOREACH(acc, { const int col = n0 + ec; if (col < C_PEND) P[(size_t)(m0 + er) * LDP + col] = f2bf(ev); })
        } else {
            EPI_FOREACH(acc, { const int col = n0 + ec - NGATE0; const float s = sigmoidf_(ev); G[(size_t)(m0 + er) * 4096 + col] = (unsigned char)__float2int_rn(s * 255.f); })
        }
    }
}

template <class EF>
DEV void gemm_generic(const bf16_t* A, int lda, int M, const bf16_t* Bt, int ldb, int N, int K, EF ef, char* smem, int rot) {
    bf16_t* sm = (bf16_t*)smem;
    const int nMt = (M + 127) / 128, nNt = (N + 127) / 128, G = gridDim.x;
    const int first = (bidx() - (rot % G) + G) % G;
    for (int item = first; item < nMt * nNt; item += G) {
        const int mt = item / nNt, nt = item % nNt, m0 = mt * 128, n0 = nt * 128;
        f32x16 acc[2][2]; acc_zero(acc);
        gemm_mainloop(acc, [&](int r) { int rr = m0 + r; rr = rr < M ? rr : M - 1; return A + (size_t)rr * lda; },
                      [&](int r) { int rr = n0 + r; rr = rr < N ? rr : N - 1; return Bt + (size_t)rr * ldb; }, K, sm);
        EPI_FOREACH(acc, { const int row = m0 + er, col = n0 + ec; if (row < M && col < N) ef(row, col, ev); })
    }
}

DEV void phase_merge(const Params& p, int l, int M, char* smem) {
    bf16_t* sm = (bf16_t*)smem;
    const bf16_t* Y = wsb(p, OFF_Y);
    const bf16_t* W = wsb(p, OFF_WBR);
    const unsigned char* G = (const unsigned char*)(p.ws + OFF_GATE);
    bf16_t* MG = wsb(p, OFF_H);
    const int nMt = M / 128, nNt = 8;
    for (int item = bidx(); item < nMt * nNt; item += gridDim.x) {
        const int mt = item / nNt, nt = item % nNt, m0 = mt * 128, n0 = nt * 128;
        f32x16 tot[2][2]; acc_zero(tot);
        for (int i = 0; i < 4; ++i) {
            f32x16 acc[2][2]; acc_zero(acc);
            gemm_mainloop(acc, [&](int r) { return Y + (size_t)(m0 + r) * 1024 + i * 256; }, [&](int r) { return W + ((size_t)i * 1024 + n0 + r) * 256; }, 256, sm);
            const int lane = tidx() & 63, wave = tidx() >> 6, wm = wave >> 1, wn = wave & 1;
#pragma unroll
            for (int a = 0; a < 2; ++a)
#pragma unroll
                for (int b = 0; b < 2; ++b)
#pragma unroll
                    for (int r = 0; r < 16; ++r) {
                        const int er = wm * 64 + a * 32 + (r & 3) + 8 * (r >> 2) + 4 * (lane >> 5), ec = wn * 64 + b * 32 + (lane & 31);
                        const float g = (float)G[(size_t)(m0 + er) * 4096 + i * 1024 + n0 + ec] * (1.f / 255.f);
                        tot[a][b][r] += g * acc[a][b][r];
                    }
        }
        EPI_FOREACH(tot, { MG[(size_t)(m0 + er) * 1024 + n0 + ec] = f2bf(ev); })
    }
}

DEV void phase_outproj(const Params& p, int l, int M, char* smem) {
    bf16_t* sm = (bf16_t*)smem;
    const bf16_t* MG = wsb(p, OFF_H);
    const bf16_t* W = wsb(p, OFF_WOUT);
    const float* xs = (l == 0) ? p.in[I_X] : p.out;
    const float* cs = (l == 0) ? p.in[I_CTX] : wsf(p, OFF_CX);
    float* cxd = wsf(p, OFF_CX);
    const int nMt = M / 128, nNt = 8;
    for (int item = bidx(); item < nMt * nNt; item += gridDim.x) {
        const int mt = item / nNt, nt = item % nNt, m0 = mt * 128, n0 = nt * 128;
        f32x16 acc[2][2]; acc_zero(acc);
        gemm_mainloop(acc, [&](int r) { return MG + (size_t)(m0 + r) * 1024; }, [&](int r) { return W + (size_t)(n0 + r) * 1024; }, 1024, sm);
        const float* g1 = modp(p, l, mod_row(m0), 2);
        if (m0 < TL) {
            EPI_FOREACH(acc, { const size_t o = (size_t)(m0 + er) * 1024 + n0 + ec; p.out[o] = xs[o] + g1[n0 + ec] * ev; })
        } else {
            EPI_FOREACH(acc, { const size_t o = (size_t)(m0 - TL + er) * 1024 + n0 + ec; cxd[o] = cs[o] + g1[n0 + ec] * ev; })
        }
    }
}

constexpr int MOE_MAP_OFF = 73728;
DEV void moe_map(const Params& p, int l, char* smem) {
    int* mm = (int*)(smem + MOE_MAP_OFF);
    __syncthreads();
    if (tidx() == 0) {
        const int* cnt = (const int*)(p.ws + OFF_CTR) + CTR_MOE + l * 16;
        int b = 0, t = 0;
        for (int e = 0; e < 16; ++e) { const int c = cnt[e]; mm[e] = c; mm[16 + e] = b; mm[32 + e] = t; b += c; t += (c + 127) >> 7; }
        mm[48] = t;
    }
    __syncthreads();
}
DEV void phase_moe1(const Params& p, int l, char* smem) {
    bf16_t* sm = (bf16_t*)smem;
    const bf16_t* F = wsb(p, OFF_H);
    const bf16_t* W = wsb(p, OFF_WG1);
    bf16_t* ACT = wsb(p, OFF_P);
    const int* ltok = (const int*)(p.ws + OFF_LTOK);
    moe_map(p, l, smem); const int* mm = (const int*)(smem + MOE_MAP_OFF);
    const int nNt = 8, total = mm[48] * nNt;
    for (int item = bidx(); item < total; item += gridDim.x) {
        const int mtg = item / nNt, nt = item % nNt;
        int e = 0;
        for (int q = 1; q < 16; ++q) if (mtg >= mm[32 + q]) e = q;
        const int m0 = (mtg - mm[32 + e]) * 128, n0 = nt * 128, ce = mm[e];
        const int* lt = ltok + (size_t)e * TT;
        f32x16 acc[2][2]; acc_zero(acc);
        gemm_mainloop(acc, [&](int r) { int idx = m0 + r; idx = idx < ce ? idx : ce - 1; return F + (size_t)lt[idx] * 1024; },
                      [&](int r) { return W + ((size_t)e * 1024 + n0 + r) * 1024; }, 1024, sm);
        const int lane = tidx() & 63, wave = tidx() >> 6, wm = wave >> 1, wn = wave & 1;
        const int jcol = ((n0 >> 6) + wn) * 32 + (lane & 31);
#pragma unroll
        for (int a = 0; a < 2; ++a)
#pragma unroll
            for (int r = 0; r < 16; ++r) {
                const int idx = m0 + wm * 64 + a * 32 + (r & 3) + 8 * (r >> 2) + 4 * (lane >> 5);
                if (idx < ce) {
                    const float g = acc[a][0][r], u = acc[a][1][r];
                    ACT[(size_t)(mm[16 + e] + idx) * DFF + jcol] = f2bf(g * sigmoidf_(g) * u);
                }
            }
    }
}
DEV void phase_moe2(const Params& p, int l, char* smem) {
    bf16_t* sm = (bf16_t*)smem;
    const bf16_t* ACT = wsb(p, OFF_P);
    const bf16_t* W = wsb(p, OFF_WDN);
    const int* ltok = (const int*)(p.ws + OFF_LTOK);
    const float* lw = (const float*)(p.ws + OFF_LW);
    float* cxd = wsf(p, OFF_CX);
    moe_map(p, l, smem); const int* mm = (const int*)(smem + MOE_MAP_OFF);
    const int nNt = 8, total = mm[48] * nNt;
    for (int item = bidx(); item < total; item += gridDim.x) {
        const int mtg = item / nNt, nt = item % nNt;
        int e = 0;
        for (int q = 1; q < 16; ++q) if (mtg >= mm[32 + q]) e = q;
        const int m0 = (mtg - mm[32 + e]) * 128, n0 = nt * 128, ce = mm[e];
        f32x16 acc[2][2]; acc_zero(acc);
        gemm_mainloop(acc, [&](int r) { int idx = m0 + r; idx = idx < ce ? idx : ce - 1; return ACT + (size_t)(mm[16 + e] + idx) * DFF; },
                      [&](int r) { return W + ((size_t)e * 1024 + n0 + r) * DFF; }, DFF, sm);
        EPI_FOREACH(acc, {
            const int idx = m0 + er;
            if (idx < ce) {
                const int tok = ltok[(size_t)e * TT + idx];
                const float w = lw[(size_t)e * TT + idx];
                const int col = n0 + ec;
                const float g2 = modp(p, l, mod_row(tok), 5)[col];
                float* dst = tok < TL ? p.out + (size_t)tok * 1024 + col : cxd + (size_t)(tok - TL) * 1024 + col;
                atomicAdd(dst, g2 * w * ev);
            }
        })
    }
}
DEV void tok_seq(int t, int& base, int& n, int& len) {
    if (t < TL) { base = t & ~(SEQ - 1); n = t & (SEQ - 1); len = SEQ; } else { const int u = t - TL; base = TL + (u & ~(CTXL - 1)); n = u & (CTXL - 1); len = CTXL; }
}
DEV void phase_prep1(const Params& p, int l) {
    const int lane = tidx() & 63, wave = tidx() >> 6;
    bf16_t* P = wsb(p, OFF_P);
    bf16_t* XL = wsb(p, OFF_XL);
    const float* qkg = p.in[I_DAQKG] + l * 64;
    const float* cqg = p.in[I_MCQG] + l * 192;
    const float* ckvg = p.in[I_MCKVG] + l * 128;
    const float* mu3 = p.in[I_RMU] + (l * 4 + 3) * 256;
    for (int t = bidx() * 4 + wave; t < TT; t += gridDim.x * 4) {
        bf16_t* row = P + (size_t)t * LDP;
        int base, n, len; tok_seq(t, base, n, len);
        {
            const int d0 = (lane & 7) * 4;
            float cs[4], sn[4];
            const bool rot = t < TL;
            if (rot) {
                const float fr = (float)(n >> 6), fc = (float)(n & 63);
#pragma unroll
                for (int j = 0; j < 4; ++j) {
                    const int i = (d0 + j) & 15;
                    const float inv = exp2f(-(float)(i & 7) * (13.287712379549449f / 8.f));
                    const float ang = (i < 8 ? fr : fc) * inv;
                    cs[j] = cosf(ang); sn[j] = sinf(ang);
                }
            }
#pragma unroll
            for (int which = 0; which < 2; ++which) {
                bf16_t* ptr = row + (which ? C_DAK : C_DAQ) + lane * 4;
                const u32x2 raw = *(const u32x2*)ptr;
                float v[4] = { bflo(raw.x), bfhi(raw.x), bflo(raw.y), bfhi(raw.y) };
                float ss = v[0] * v[0] + v[1] * v[1] + v[2] * v[2] + v[3] * v[3];
                ss = group_sum<8>(ss);
                const float rstd = rsqrtf(ss * (1.f / 32.f) + EPS);
                const float* g = qkg + which * 32 + d0;
#pragma unroll
                for (int j = 0; j < 4; ++j) v[j] = v[j] * rstd * g[j];
                if (rot) {
#pragma unroll
                    for (int j = 0; j < 4; ++j) {
                        const float o = __shfl_xor(v[j], 4, 64);
                        v[j] = (d0 < 16) ? (v[j] * cs[j] - o * sn[j]) : (v[j] * cs[j] + o * sn[j]);
                    }
                }
                if (which == 0) {
                    const float qs = 0.17677669529663687f * LOG2E;
#pragma unroll
                    for (int j = 0; j < 4; ++j) v[j] *= qs;
                }
                u32x2 o; o.x = pack2(v[0], v[1]); o.y = pack2(v[2], v[3]);
                *(u32x2*)ptr = o;
            }
        }
        {
            float v[3]; float ss = 0.f;
#pragma unroll
            for (int j = 0; j < 3; ++j) { v[j] = bf2f(row[C_CQ + lane + j * 64]); ss += v[j] * v[j]; }
            ss = wave_sum(ss);
            const float rstd = rsqrtf(ss * (1.f / 192.f) + EPS);
#pragma unroll
            for (int j = 0; j < 3; ++j) row[C_CQ + lane + j * 64] = f2bf(v[j] * rstd * cqg[lane + j * 64]);
            float w[2]; float s2 = 0.f;
#pragma unroll
            for (int j = 0; j < 2; ++j) { w[j] = bf2f(row[C_CKV + lane + j * 64]); s2 += w[j] * w[j]; }
            s2 = wave_sum(s2);
            const float r2 = rsqrtf(s2 * (1.f / 128.f) + EPS);
#pragma unroll
            for (int j = 0; j < 2; ++j) row[C_CKV + lane + j * 64] = f2bf(w[j] * r2 * ckvg[lane + j * 64]);
        }
        {
            const int c = lane * 4;
            const u32x2 cur = *(const u32x2*)(row + C_RWD + c);
            u32x2 pv = (u32x2){0u, 0u}, nx = (u32x2){0u, 0u};
            if (n > 0) pv = *(const u32x2*)(row - LDP + C_RWD + c);
            if (n + 1 < len) nx = *(const u32x2*)(row + LDP + C_RWD + c);
            const float4 m = *(const float4*)(mu3 + c);
            float o[4];
            { const float x = bflo(cur.x); o[0] = x + (0.5f * (bflo(pv.x) + bflo(nx.x)) - x) * m.x; }
            { const float x = bfhi(cur.x); o[1] = x + (0.5f * (bfhi(pv.x) + bfhi(nx.x)) - x) * m.y; }
            { const float x = bflo(cur.y); o[2] = x + (0.5f * (bflo(pv.y) + bflo(nx.y)) - x) * m.z; }
            { const float x = bfhi(cur.y); o[3] = x + (0.5f * (bfhi(pv.y) + bfhi(nx.y)) - x) * m.w; }
            u32x2 ov; ov.x = pack2(o[0], o[1]); ov.y = pack2(o[2], o[3]);
            *(u32x2*)(XL + (size_t)t * 256 + c) = ov;
        }
    }
}

DEV void phase_prep_gemm1(const Params& p, int l, char* smem) {
    const bf16_t* P = wsb(p, OFF_P);
    const bf16_t* w = wsb(p, OFF_WSM) + (size_t)l * WS_PER_LAYER;
    bf16_t* QRAW = wsb(p, OFF_QRAW); bf16_t* KVRAW = wsb(p, OFF_KVRAW); bf16_t* LR = wsb(p, OFF_LR);
    int rot = 0;
    gemm_generic(P + C_CQ, LDP, TT, w + WS_UQT, 192, 192, 192, [&](int r, int c, float v) { QRAW[(size_t)r * 192 + c] = f2bf(v); }, smem, rot);
    rot += (TT / 128) * 2;
    gemm_generic(P + C_CKV, LDP, TT, w + WS_UKVT, 128, 384, 128, [&](int r, int c, float v) { KVRAW[(size_t)r * 384 + c] = f2bf(v); }, smem, rot);
    rot += (TT / 128) * 3;
    gemm_generic(wsb(p, OFF_XL), 256, TT, w + WS_W1C, 256, 192, 256,
                 [&](int r, int c, float v) { const float o = c < 64 ? tanhf(v) : (c < 128 ? v : sigmoidf_(v)); LR[(size_t)r * 192 + c] = f2bf(o); }, smem, rot);
}
DEV void phase_prep_gemm2(const Params& p, int l, char* smem) {
    const bf16_t* w = wsb(p, OFF_WSM) + (size_t)l * WS_PER_LAYER;
    const bf16_t* LR = wsb(p, OFF_LR);
    bf16_t* RWX = wsb(p, OFF_RWX);
    bf16_t* P = wsb(p, OFF_P);
    int rot = 0;
    for (int d = 0; d < 2; ++d) {
        const float* w0 = p.in[I_RW0] + (l * 2 + d) * 256;
        gemm_generic(LR + d * 32, 192, TT, w + WS_W2 + (size_t)d * 256 * 64, 64, 256, 64,
                     [&](int r, int c, float v) { RWX[(size_t)r * 1024 + d * 256 + c] = f2bf(0.6065306597126334f * sigmoidf_(w0[c] + v)); }, smem, rot);
        rot += (TT / 128) * 2;
        const float* a0 = p.in[I_RA0] + (l * 2 + d) * 256;
        gemm_generic(LR + 64 + d * 32, 192, TT, w + WS_W2 + (size_t)(2 + d) * 256 * 64, 64, 256, 64,
                     [&](int r, int c, float v) { RWX[(size_t)r * 1024 + 512 + d * 256 + c] = f2bf(sigmoidf_(a0[c] + v)); }, smem, rot);
        rot += (TT / 128) * 2;
    }
    gemm_generic(LR + 128, 192, TT, w + WS_G2T, 64, 256, 64, [&](int r, int c, float v) { P[(size_t)r * LDP + C_RWD + c] = f2bf(v); }, smem, rot);
}

DEV void phase_prep2(const Params& p, int l) {
    const int lane = tidx() & 63, wave = tidx() >> 6;
    const bf16_t* P = wsb(p, OFF_P);
    const bf16_t* QRAW = wsb(p, OFF_QRAW); const bf16_t* KVRAW = wsb(p, OFF_KVRAW);
    bf16_t* MQ = wsb(p, OFF_MLAQ); bf16_t* MK = wsb(p, OFF_MLAK); bf16_t* MV = wsb(p, OFF_MLAV);
    const float* qkg = p.in[I_MQKG] + l * 96;
    for (int t = bidx() * 4 + wave; t < TT; t += gridDim.x * 4) {
        int base, n, len; tok_seq(t, base, n, len);
        const int h = lane >> 4, j = lane & 15;
        const bool rot = t < TL;
        float cs = 1.f, sn = 0.f;
        if (rot) {
            const int i = j & 7;
            const float inv = exp2f(-(float)(i & 3) * (13.287712379549449f / 4.f));
            const float ang = (i < 4 ? (float)(n >> 6) : (float)(n & 63)) * inv;
            cs = cosf(ang); sn = sinf(ang);
        }
        {
            float v[3]; float ss = 0.f;
#pragma unroll
            for (int k = 0; k < 3; ++k) { v[k] = bf2f(QRAW[(size_t)t * 192 + h * 48 + j + k * 16]); ss += v[k] * v[k]; }
            ss = group_sum<16>(ss);
            const float rstd = rsqrtf(ss * (1.f / 48.f) + EPS);
#pragma unroll
            for (int k = 0; k < 3; ++k) v[k] = v[k] * rstd * qkg[j + k * 16];
            if (rot) { const float o = __shfl_xor(v[2], 8, 64); v[2] = (j < 8) ? (v[2] * cs - o * sn) : (v[2] * cs + o * sn); }
            const float qs = 0.14433756729740643f * LOG2E;
#pragma unroll
            for (int k = 0; k < 3; ++k) MQ[(size_t)t * 192 + h * 48 + j + k * 16] = f2bf(v[k] * qs);
        }
        {
            float v[3]; float ss = 0.f;
            v[0] = bf2f(KVRAW[(size_t)t * 384 + h * 96 + j]);
            v[1] = bf2f(KVRAW[(size_t)t * 384 + h * 96 + 16 + j]);
            v[2] = bf2f(P[(size_t)t * LDP + C_KR + j]);
#pragma unroll
            for (int k = 0; k < 3; ++k) ss += v[k] * v[k];
            ss = group_sum<16>(ss);
            const float rstd = rsqrtf(ss * (1.f / 48.f) + EPS);
#pragma unroll
            for (int k = 0; k < 3; ++k) v[k] = v[k] * rstd * qkg[48 + j + k * 16];
            if (rot) { const float o = __shfl_xor(v[2], 8, 64); v[2] = (j < 8) ? (v[2] * cs - o * sn) : (v[2] * cs + o * sn); }
#pragma unroll
            for (int k = 0; k < 3; ++k) MK[(size_t)t * 192 + h * 48 + j + k * 16] = f2bf(v[k]);
        }
#pragma unroll
        for (int k = 0; k < 4; ++k) MV[(size_t)t * 256 + h * 64 + j + k * 16] = KVRAW[(size_t)t * 384 + h * 96 + 32 + j + k * 16];
    }
}
template <int NC, int DK>
struct AttnCfg {
    static constexpr int DKROW = NC * DK, KLD = DKROW + 8, VLD = 68;
    static constexpr int KSTAGE = 64 * KLD, VSTAGE = 64 * VLD;
    static constexpr int KCH = 64 * DKROW / 8;
};
template <int NC, int DK, class EPI>
DEV void attn_item(const bf16_t* Q, int ldq, const bf16_t* Kl, const bf16_t* Kc, int ldk, const bf16_t* Vl, const bf16_t* Vc, int ldv,
                   int q0, int nlat_tiles, int nctx_tiles, EPI epi, char* smem) {
    using C = AttnCfg<NC, DK>;
    constexpr int KS = DK / 16;
    const int tid = tidx(), lane = tid & 63, wave = tid >> 6, ql = lane & 31, hh = lane >> 5;
    bf16_t* Ks = (bf16_t*)smem;
    bf16_t* Vt = Ks + 2 * C::KSTAGE;
    bf16x8 qf[NC][KS];
    {
        const bf16_t* qp = Q + (size_t)(q0 + wave * 32 + ql) * ldq + hh * 8;
#pragma unroll
        for (int c = 0; c < NC; ++c)
#pragma unroll
            for (int ks = 0; ks < KS; ++ks) qf[c][ks] = *(const bf16x8*)(qp + c * DK + ks * 16);
    }
    f32x16 O[NC][2];
    float mrun[NC], lrun[NC];
#pragma unroll
    for (int c = 0; c < NC; ++c) {
        mrun[c] = -1e30f; lrun[c] = 0.f;
#pragma unroll
        for (int d = 0; d < 2; ++d)
#pragma unroll
            for (int r = 0; r < 16; ++r) O[c][d][r] = 0.f;
    }
    const int ntiles = nlat_tiles + nctx_tiles;
    constexpr int KPT = (C::KCH + NT - 1) / NT;
    u32x4 rk[KPT], rv[2];
    auto load_tile = [&](int tile) {
        const bf16_t* kb = tile < nlat_tiles ? Kl + (size_t)tile * 64 * ldk : Kc + (size_t)(tile - nlat_tiles) * 64 * ldk;
        const bf16_t* vb = tile < nlat_tiles ? Vl + (size_t)tile * 64 * ldv : Vc + (size_t)(tile - nlat_tiles) * 64 * ldv;
#pragma unroll
        for (int i = 0; i < KPT; ++i) {
            int q = tid + i * NT; q = q < C::KCH ? q : C::KCH - 1;
            { const int key = q / (C::DKROW / 8), ch = q % (C::DKROW / 8); rk[i] = *(const u32x4*)(kb + (size_t)key * ldk + ch * 8); }
        }
#pragma unroll
        for (int i = 0; i < 2; ++i) { const int q = tid + i * NT; const int key = q >> 3, ch = q & 7; rv[i] = *(const u32x4*)(vb + (size_t)key * ldv + ch * 8); }
    };
    auto store_tile = [&](int st) {
#pragma unroll
        for (int i = 0; i < KPT; ++i) {
            const int q = tid + i * NT;
            if (q < C::KCH) { const int key = q / (C::DKROW / 8), ch = q % (C::DKROW / 8); *(u32x4*)(Ks + st * C::KSTAGE + key * C::KLD + ch * 8) = rk[i]; }
        }
#pragma unroll
        for (int i = 0; i < 2; ++i) {
            const int q = tid + i * NT; const int key = q >> 3, dv0 = (q & 7) * 8;
            bf16_t* vd = Vt + st * C::VSTAGE + dv0 * C::VLD + key;
            const unsigned w[4] = { rv[i][0], rv[i][1], rv[i][2], rv[i][3] };
#pragma unroll
            for (int j = 0; j < 4; ++j) { vd[(2 * j) * C::VLD] = (bf16_t)(w[j] & 0xFFFFu); vd[(2 * j + 1) * C::VLD] = (bf16_t)(w[j] >> 16); }
        }
    };
    load_tile(0);
    __syncthreads();
    store_tile(0);
    __syncthreads();
    for (int tile = 0; tile < ntiles; ++tile) {
        const int cur = tile & 1;
        if (tile + 1 < ntiles) load_tile(tile + 1);
        const bf16_t* ks_ = Ks + cur * C::KSTAGE;
        const bf16_t* vt_ = Vt + cur * C::VSTAGE;
#pragma unroll
        for (int c = 0; c < NC; ++c) {
            f32x16 S[2];
#pragma unroll
            for (int kb = 0; kb < 2; ++kb) {
#pragma unroll
                for (int r = 0; r < 16; ++r) S[kb][r] = 0.f;
#pragma unroll
                for (int ks = 0; ks < KS; ++ks) {
                    const bf16x8 kf = *(const bf16x8*)(ks_ + (kb * 32 + ql) * C::KLD + c * DK + ks * 16 + hh * 8);
                    S[kb] = __builtin_amdgcn_mfma_f32_32x32x16_bf16(kf, qf[c][ks], S[kb], 0, 0, 0);
                }
            }
            float mx = S[0][0];
#pragma unroll
            for (int kb = 0; kb < 2; ++kb)
#pragma unroll
                for (int r = 0; r < 16; ++r) mx = fmaxf(mx, S[kb][r]);
            mx = fmaxf(mx, __shfl_xor(mx, 32, 64));
            const float mnew = fmaxf(mrun[c], mx);
            const float alpha = __builtin_amdgcn_exp2f(mrun[c] - mnew);
            mrun[c] = mnew;
            float ls = 0.f;
#pragma unroll
            for (int kb = 0; kb < 2; ++kb)
#pragma unroll
                for (int r = 0; r < 16; ++r) { const float e = __builtin_amdgcn_exp2f(S[kb][r] - mnew); S[kb][r] = e; ls += e; }
            lrun[c] = lrun[c] * alpha + ls;
#pragma unroll
            for (int d = 0; d < 2; ++d)
#pragma unroll
                for (int r = 0; r < 16; ++r) O[c][d][r] *= alpha;
#pragma unroll
            for (int s = 0; s < 4; ++s) {
                const int kb = s >> 1, s2 = s & 1;
                const u32x4 pu = (u32x4){pack2(S[kb][8 * s2 + 0], S[kb][8 * s2 + 1]), pack2(S[kb][8 * s2 + 2], S[kb][8 * s2 + 3]),
                                         pack2(S[kb][8 * s2 + 4], S[kb][8 * s2 + 5]), pack2(S[kb][8 * s2 + 6], S[kb][8 * s2 + 7])};
                const bf16x8 pf = __builtin_bit_cast(bf16x8, pu);
                const int keyo = kb * 32 + 16 * s2 + 4 * hh;
#pragma unroll
                for (int d = 0; d < 2; ++d) {
                    const bf16_t* vp = vt_ + (d * 32 + ql) * C::VLD + keyo;
                    const u32x2 lo = *(const u32x2*)vp, hi = *(const u32x2*)(vp + 8);
                    const u32x4 vv = (u32x4){lo[0], lo[1], hi[0], hi[1]};
                    const bf16x8 vf = __builtin_bit_cast(bf16x8, vv);
                    O[c][d] = __builtin_amdgcn_mfma_f32_32x32x16_bf16(vf, pf, O[c][d], 0, 0, 0);
                }
            }
        }
        if (tile + 1 < ntiles) store_tile(cur ^ 1);
        __syncthreads();
    }
    float inv[NC];
#pragma unroll
    for (int c = 0; c < NC; ++c) { const float lt = lrun[c] + __shfl_xor(lrun[c], 32, 64); inv[c] = 1.f / lt; }
    epi(O, inv, q0 + wave * 32 + ql, hh);
}

DEV void da_item(const Params& p, int l, int item, char* smem) {
    const bf16_t* P = wsb(p, OFF_P);
    bf16_t* Y = wsb(p, OFF_Y);
    const float linit = 0.8f - 0.6f * __expf(-0.3f * (float)l);
    float lam;
    {
        const float* la = p.in[I_DALAM] + l * 128;
        const int lane = tidx() & 63;
        float a = lane < 32 ? la[lane] * la[32 + lane] : 0.f, b = lane < 32 ? la[64 + lane] * la[96 + lane] : 0.f;
        a = wave_sum(a); b = wave_sum(b);
        lam = __expf(a) - __expf(b) + linit;
    }
    const float* sg = p.in[I_DASUB] + l * 64;
    int b, h, qt; bool isctx;
    if (item < 512) { isctx = false; b = item >> 6; h = (item >> 4) & 3; qt = item & 15; }
    else { const int it = item - 512; isctx = true; b = it >> 3; h = (it >> 1) & 3; qt = it & 1; }
    const size_t lat0 = (size_t)b * SEQ, ctx0 = (size_t)TL + (size_t)b * CTXL;
    const size_t qrow0 = isctx ? ctx0 : lat0;
    float o1[2][16];
    auto epi0 = [&](f32x16 (&O)[1][2], float (&inv)[1], int qrow, int hh) {
#pragma unroll
        for (int d = 0; d < 2; ++d)
#pragma unroll
            for (int r = 0; r < 16; ++r) o1[d][r] = O[0][d][r] * inv[0];
    };
    auto epi1 = [&](f32x16 (&O)[1][2], float (&inv)[1], int qrow, int hh) {
        float v[2][16]; float ss = 0.f;
#pragma unroll
        for (int d = 0; d < 2; ++d)
#pragma unroll
            for (int r = 0; r < 16; ++r) { const float o = o1[d][r] - lam * O[0][d][r] * inv[0]; v[d][r] = o; ss += o * o; }
        ss += __shfl_xor(ss, 32, 64);
        const float rstd = rsqrtf(ss * (1.f / 64.f) + EPS) * (1.f - linit);
        bf16_t* yo = Y + (qrow0 + qrow) * 1024 + h * 64;
#pragma unroll
        for (int d = 0; d < 2; ++d)
#pragma unroll
            for (int g = 0; g < 4; ++g) {
                const int dv = d * 32 + 8 * g + 4 * hh;
                u32x2 o;
                o.x = pack2(v[d][4 * g + 0] * rstd * sg[dv + 0], v[d][4 * g + 1] * rstd * sg[dv + 1]);
                o.y = pack2(v[d][4 * g + 2] * rstd * sg[dv + 2], v[d][4 * g + 3] * rstd * sg[dv + 3]);
                *(u32x2*)(yo + dv) = o;
            }
    };
    const bf16_t* Qp = P + qrow0 * LDP + C_DAQ + h * 64;
    const bf16_t* Kl = P + lat0 * LDP + C_DAK + h * 64;
    const bf16_t* Kc = P + ctx0 * LDP + C_DAK + h * 64;
    const bf16_t* Vl = P + lat0 * LDP + C_DAV + h * 64;
    const bf16_t* Vc = P + ctx0 * LDP + C_DAV + h * 64;
    const int nlat = isctx ? 0 : SEQ / 64;
    attn_item<1, 32>(Qp, LDP, Kl, Kc, LDP, Vl, Vc, LDP, qt * 128, nlat, CTXL / 64, epi0, smem);
    attn_item<1, 32>(Qp + 32, LDP, Kl + 32, Kc + 32, LDP, Vl, Vc, LDP, qt * 128, nlat, CTXL / 64, epi1, smem);
}
DEV void mla_item(const Params& p, int l, int item, char* smem) {
    const bf16_t* MQ = wsb(p, OFF_MLAQ); const bf16_t* MK = wsb(p, OFF_MLAK); const bf16_t* MV = wsb(p, OFF_MLAV);
    bf16_t* Y = wsb(p, OFF_Y);
    int b, h, qt; bool isctx;
    if (item < 512) { isctx = false; b = item >> 6; h = (item >> 4) & 3; qt = item & 15; }
    else { const int it = item - 512; isctx = true; b = it >> 3; h = (it >> 1) & 3; qt = it & 1; }
    const size_t lat0 = (size_t)b * SEQ, ctx0 = (size_t)TL + (size_t)b * CTXL;
    const size_t qrow0 = isctx ? ctx0 : lat0;
    auto epi = [&](f32x16 (&O)[1][2], float (&inv)[1], int qrow, int hh) {
        bf16_t* yo = Y + (qrow0 + qrow) * 1024 + 512 + h * 64;
#pragma unroll
        for (int d = 0; d < 2; ++d)
#pragma unroll
            for (int g = 0; g < 4; ++g) {
                const int dv = d * 32 + 8 * g + 4 * hh;
                u32x2 o;
                o.x = pack2(O[0][d][4 * g + 0] * inv[0], O[0][d][4 * g + 1] * inv[0]);
                o.y = pack2(O[0][d][4 * g + 2] * inv[0], O[0][d][4 * g + 3] * inv[0]);
                *(u32x2*)(yo + dv) = o;
            }
    };
    const bf16_t* Qp = MQ + qrow0 * 192 + h * 48;
    const bf16_t* Kl = MK + lat0 * 192 + h * 48;
    const bf16_t* Kc = MK + ctx0 * 192 + h * 48;
    const bf16_t* Vl = MV + lat0 * 256 + h * 64;
    const bf16_t* Vc = MV + ctx0 * 256 + h * 64;
    attn_item<1, 48>(Qp, 192, Kl, Kc, 192, Vl, Vc, 256, qt * 128, isctx ? 0 : SEQ / 64, CTXL / 64, epi, smem);
}
DEV int s5_token(int b, int tb, int n) { return tb == 0 ? TL + b * CTXL + n : b * SEQ + (tb - 1) * 256 + n; }
struct S5Lane { float are, aim; float bre[16], bim[16]; };
DEV void s5_setup(const Params& p, int l, int d, int g, int pl, S5Lane& s) {
    const int gi = ((l * 2 + d) * 16 + g);
    const float lre = p.in[I_S5LRE][gi * 64 + pl], lim = p.in[I_S5LIM][gi * 64 + pl];
    const float dt = __expf(p.in[I_S5LDT][gi]);
    const float mag = __expf(lre * dt);
    s.are = mag * cosf(lim * dt); s.aim = mag * sinf(lim * dt);
    const float nr = s.are - 1.f, ni = s.aim, den = 1.f / (lre * lre + lim * lim);
    const float cr = (nr * lre + ni * lim) * den, ci = (ni * lre - nr * lim) * den;
    const float* br = p.in[I_S5BRE] + ((size_t)gi * 64 + pl) * 16;
    const float* bi = p.in[I_S5BIM] + ((size_t)gi * 64 + pl) * 16;
#pragma unroll
    for (int c = 0; c < 16; ++c) { const float x = br[c], y = bi[c]; s.bre[c] = cr * x - ci * y; s.bim[c] = cr * y + ci * x; }
}
template <bool DUMP>
DEV void s5_scan32(const S5Lane& s, float& hre, float& him, const float* ub, bf16_t* hb, int pl, bool rev) {
    for (int j = 0; j < 32; ++j) {
        const int rowi = rev ? 31 - j : j;
        const float4* u4 = (const float4*)(ub + rowi * 16);
        float bur = 0.f, bui = 0.f;
#pragma unroll
        for (int q = 0; q < 4; ++q) {
            const float4 u = u4[q];
            bur += u.x * s.bre[q * 4 + 0] + u.y * s.bre[q * 4 + 1] + u.z * s.bre[q * 4 + 2] + u.w * s.bre[q * 4 + 3];
            bui += u.x * s.bim[q * 4 + 0] + u.y * s.bim[q * 4 + 1] + u.z * s.bim[q * 4 + 2] + u.w * s.bim[q * 4 + 3];
        }
        const float nre = s.are * hre - s.aim * him + bur;
        const float nim = s.are * him + s.aim * hre + bui;
        hre = nre; him = nim;
        if (DUMP) { hb[rowi * 136 + pl] = f2bf(hre); hb[rowi * 136 + 64 + pl] = f2bf(him); }
    }
}
DEV void s5_load_u(const bf16_t* P, int b, int tb, int g, int sc, float* ub, int lane) {
    if (lane < 32) {
        const int t = s5_token(b, tb, sc * 32 + lane);
        const uint4* src = (const uint4*)(P + (size_t)t * LDP + C_S5 + g * 16);
        const uint4 a = src[0], c = src[1];
        float4* d = (float4*)(ub + lane * 16);
        d[0] = make_float4(bflo(a.x), bfhi(a.x), bflo(a.y), bfhi(a.y));
        d[1] = make_float4(bflo(a.z), bfhi(a.z), bflo(a.w), bfhi(a.w));
        d[2] = make_float4(bflo(c.x), bfhi(c.x), bflo(c.y), bfhi(c.y));
        d[3] = make_float4(bflo(c.z), bfhi(c.z), bflo(c.w), bfhi(c.w));
    }
}
DEV void phase_s5_pass1(const Params& p, int l, char* smem) {
    const int lane = tidx() & 63, wave = tidx() >> 6;
    float* ub = (float*)smem + wave * 512;
    const bf16_t* P = wsb(p, OFF_P);
    float* st = wsf(p, OFF_S5ST);
    const int nitems = 2 * 8 * 16 * 8;
    for (int it0 = bidx() * 4; it0 < nitems; it0 += gridDim.x * 4) {
        const int it = it0 + wave;
        const int seg = it & 7, g = (it >> 3) & 15, b = (it >> 7) & 7, d = it >> 10;
        const int tb = seg == 0 ? 0 : (d == 0 ? seg : 9 - seg);
        S5Lane s; s5_setup(p, l, d, g, lane, s);
        float hre = 0.f, him = 0.f;
        for (int k = 0; k < 8; ++k) {
            const int sc = d == 0 ? k : 7 - k;
            __syncthreads();
            s5_load_u(P, b, tb, g, sc, ub, lane);
            __syncthreads();
            s5_scan32<false>(s, hre, him, ub, nullptr, lane, d == 1);
        }
        float* o = st + ((((size_t)d * 8 + b) * 16 + g) * 8 + seg) * 128;
        o[lane] = hre; o[64 + lane] = him;
    }
}
DEV void s5_pass2_item(const Params& p, int l, int tb0, int bitem, char* smem) {
    const int lane = tidx() & 63, wave = tidx() >> 6;
    float* ub = (float*)smem + wave * 512;
    bf16_t* hb = (bf16_t*)(smem + 8192) + wave * (32 * 136);
    bf16_t* P = wsb(p, OFF_P);
    const float* st = wsf(p, OFF_S5ST);
    {
        const int it = bitem * 4 + wave;
        const int g = it & 15, b = (it >> 4) & 7, tb = (it >> 7) + tb0;
        f32x4 yacc[16];
#pragma unroll
        for (int i = 0; i < 16; ++i) yacc[i] = (f32x4){0.f, 0.f, 0.f, 0.f};
#pragma unroll
        for (int d = 0; d < 2; ++d) {
            S5Lane s; s5_setup(p, l, d, g, lane, s);
            bf16x8 cf[4];
            {
                const int gi = ((l * 2 + d) * 16 + g), c = lane & 15, kq = lane >> 4;
                const float* cre = p.in[I_S5CRE] + ((size_t)gi * 16 + c) * 64;
                const float* cim = p.in[I_S5CIM] + ((size_t)gi * 16 + c) * 64;
#pragma unroll
                for (int ks = 0; ks < 4; ++ks)
#pragma unroll
                    for (int j = 0; j < 8; ++j) {
                        const int k = ks * 32 + kq * 8 + j;
                        const float v = k < 64 ? cre[k] : -cim[k - 64];
                        cf[ks][j] = (short)f2bf(v);
                    }
            }
            const int seg = tb == 0 ? 0 : (d == 0 ? tb : 9 - tb);
            float hre = 0.f, him = 0.f;
            {
                float pr = s.are, pi = s.aim;
#pragma unroll
                for (int q = 0; q < 8; ++q) { const float nr = pr * pr - pi * pi, ni = 2.f * pr * pi; pr = nr; pi = ni; }
                const float* hs = st + (((size_t)d * 8 + b) * 16 + g) * 8 * 128;
                for (int i = 0; i < seg; ++i) {
                    const float er = hs[i * 128 + lane], ei = hs[i * 128 + 64 + lane];
                    const float nr = pr * hre - pi * him + er, ni = pr * him + pi * hre + ei;
                    hre = nr; him = ni;
                }
            }
#pragma unroll
            for (int k = 0; k < 8; ++k) {
                const int sc = d == 0 ? k : 7 - k;
                __syncthreads();
                s5_load_u(P, b, tb, g, sc, ub, lane);
                __syncthreads();
                s5_scan32<true>(s, hre, him, ub, hb, lane, d == 1);
                __syncthreads();
#pragma unroll
                for (int mt = 0; mt < 2; ++mt)
#pragma unroll
                    for (int ks = 0; ks < 4; ++ks) {
                        const bf16x8 af = *(const bf16x8*)(hb + (mt * 16 + (lane & 15)) * 136 + ks * 32 + (lane >> 4) * 8);
                        yacc[sc * 2 + mt] = __builtin_amdgcn_mfma_f32_16x16x32_bf16(af, cf[ks], yacc[sc * 2 + mt], 0, 0, 0);
                    }
            }
        }
        {
            const int c = lane & 15;
            const float dd = p.in[I_S5D][(l * 16 + g) * 16 + c];
#pragma unroll
            for (int tile = 0; tile < 16; ++tile)
#pragma unroll
                for (int r = 0; r < 4; ++r) {
                    const int n = tile * 16 + (lane >> 4) * 4 + r;
                    bf16_t* up = P + (size_t)s5_token(b, tb, n) * LDP + C_S5 + g * 16 + c;
                    const float y = dd * bf2f(*up) + yacc[tile][r];
                    const float z = 0.5f * y * (1.f + tanhf(0.7978845608028654f * (y + 0.044715f * y * y * y)));
                    *up = f2bf(z);
                }
        }
    }
}

DEV float row16_sum(float v) {
    v += __int_as_float(__builtin_amdgcn_mov_dpp(__float_as_int(v), 0x128, 0xf, 0xf, true));
    v += __int_as_float(__builtin_amdgcn_mov_dpp(__float_as_int(v), 0x124, 0xf, 0xf, true));
    v += __int_as_float(__builtin_amdgcn_mov_dpp(__float_as_int(v), 0x122, 0xf, 0xf, true));
    v += __int_as_float(__builtin_amdgcn_mov_dpp(__float_as_int(v), 0x121, 0xf, 0xf, true));
    return v;
}
constexpr int RW_CT = 16;
struct RwRaw { u32x2 r[3], k[3], v[3], sd, a; };
DEV void rw_item(const Params& p, int l, int item, char* smem) {
    const int tid = tidx(), li = tid >> 4, lc = tid & 15;
    const int ch = item >> 2, rg = item & 3, dir = ch >> 5, b = (ch >> 2) & 7, head = ch & 3;
    float* buf = (float*)smem;
    float* ybuf = buf + 2 * RW_CT * 384;
    const bf16_t* P = wsb(p, OFF_P);
    const bf16_t* RWX = wsb(p, OFF_RWX);
    bf16_t* RWY = wsb(p, OFF_RWY) + (size_t)dir * TT * 256;
    const int hc = head * 64 + lc * 4;
    const float4 mur = *(const float4*)(p.in[I_RMU] + (l * 4 + 0) * 256 + hc);
    const float4 muk = *(const float4*)(p.in[I_RMU] + (l * 4 + 1) * 256 + hc);
    const float4 muv = *(const float4*)(p.in[I_RMU] + (l * 4 + 2) * 256 + hc);
    const float4 kk4 = *(const float4*)(p.in[I_RKK] + l * 256 + hc);
    const float4 ka4 = *(const float4*)(p.in[I_RKA] + l * 256 + hc);
    const int NCH = (CTXL + SEQ) / RW_CT;
    auto tok_of = [&](int cidx, int i, int& n, int& len) -> int {
        if (cidx < CTXL / RW_CT) { const int pos = cidx * RW_CT + i; len = CTXL; n = dir == 0 ? pos : CTXL - 1 - pos; return TL + b * CTXL + n; }
        const int pos = (cidx - CTXL / RW_CT) * RW_CT + i; len = SEQ; n = dir == 0 ? pos : SEQ - 1 - pos; return b * SEQ + n;
    };
    RwRaw raw;
    auto load_raw = [&](int cidx) {
        int n, len; const int t = tok_of(cidx, li, n, len);
        const bf16_t* row = P + (size_t)t * LDP;
        const u32x2 z = (u32x2){0u, 0u};
        const bool hp = n > 0, hn = n + 1 < len;
        raw.r[1] = *(const u32x2*)(row + C_RWR + hc); raw.k[1] = *(const u32x2*)(row + C_RWK + hc); raw.v[1] = *(const u32x2*)(row + C_RWV + hc);
        raw.r[0] = hp ? *(const u32x2*)(row - LDP + C_RWR + hc) : z; raw.k[0] = hp ? *(const u32x2*)(row - LDP + C_RWK + hc) : z; raw.v[0] = hp ? *(const u32x2*)(row - LDP + C_RWV + hc) : z;
        raw.r[2] = hn ? *(const u32x2*)(row + LDP + C_RWR + hc) : z; raw.k[2] = hn ? *(const u32x2*)(row + LDP + C_RWK + hc) : z; raw.v[2] = hn ? *(const u32x2*)(row + LDP + C_RWV + hc) : z;
        raw.sd = *(const u32x2*)(RWX + (size_t)t * 1024 + dir * 256 + hc);
        raw.a = *(const u32x2*)(RWX + (size_t)t * 1024 + 512 + dir * 256 + hc);
    };
    auto mix4 = [&](const u32x2 (&s)[3], const float4& mu, float (&o)[4]) {
        { const float x = bflo(s[1].x); o[0] = x + (0.5f * (bflo(s[0].x) + bflo(s[2].x)) - x) * mu.x; }
        { const float x = bfhi(s[1].x); o[1] = x + (0.5f * (bfhi(s[0].x) + bfhi(s[2].x)) - x) * mu.y; }
        { const float x = bflo(s[1].y); o[2] = x + (0.5f * (bflo(s[0].y) + bflo(s[2].y)) - x) * mu.z; }
        { const float x = bfhi(s[1].y); o[3] = x + (0.5f * (bfhi(s[0].y) + bfhi(s[2].y)) - x) * mu.w; }
    };
    auto stage = [&](int st) {
        float r4[4], k4[4], v4[4];
        mix4(raw.r, mur, r4); mix4(raw.k, muk, k4); mix4(raw.v, muv, v4);
        const float kkr[4] = { k4[0] * kk4.x, k4[1] * kk4.y, k4[2] * kk4.z, k4[3] * kk4.w };
        float nn = kkr[0] * kkr[0] + kkr[1] * kkr[1] + kkr[2] * kkr[2] + kkr[3] * kkr[3];
        nn = row16_sum(nn);
        const float rn = 1.f / fmaxf(sqrtf(nn), 1e-12f);
        const float a[4] = { bflo(raw.a.x), bfhi(raw.a.x), bflo(raw.a.y), bfhi(raw.a.y) };
        const float sd[4] = { bflo(raw.sd.x), bfhi(raw.sd.x), bflo(raw.sd.y), bfhi(raw.sd.y) };
        const float kav[4] = { ka4.x, ka4.y, ka4.z, ka4.w };
        float* d = buf + (st * RW_CT + li) * 384 + lc * 4;
        float wp[4], kp[4], bp[4], mp[4];
#pragma unroll
        for (int j = 0; j < 4; ++j) {
            wp[j] = __expf(-sd[j]);
            kp[j] = kkr[j] * rn;
            bp[j] = kp[j] * a[j];
            mp[j] = k4[j] * (1.f + (a[j] - 1.f) * kav[j]);
        }
        *(float4*)(d + 0) = make_float4(wp[0], wp[1], wp[2], wp[3]); *(float4*)(d + 64) = make_float4(kp[0], kp[1], kp[2], kp[3]);
        *(float4*)(d + 128) = make_float4(bp[0], bp[1], bp[2], bp[3]); *(float4*)(d + 192) = make_float4(mp[0], mp[1], mp[2], mp[3]);
        *(float4*)(d + 256) = make_float4(r4[0], r4[1], r4[2], r4[3]);
        *(float4*)(d + 320) = make_float4(v4[0], v4[1], v4[2], v4[3]);
    };
    float S0 = 0.f, S1 = 0.f, S2 = 0.f, S3 = 0.f;
    __syncthreads();
    load_raw(0);
    stage(0);
    __syncthreads();
    for (int cidx = 0; cidx < NCH; ++cidx) {
        const int cur = cidx & 1;
        if (cidx + 1 < NCH) load_raw(cidx + 1);
        const float* cb = buf + cur * RW_CT * 384;
        float* yb = ybuf + cur * 256;
#pragma unroll 4
        for (int j = 0; j < RW_CT; ++j) {
            const float* tb_ = cb + j * 384 + lc * 4;
            const float4 w = *(const float4*)(tb_), kk = *(const float4*)(tb_ + 64), bb = *(const float4*)(tb_ + 128), km = *(const float4*)(tb_ + 192), r = *(const float4*)(tb_ + 256);
            const float vv = cb[j * 384 + 320 + rg * 16 + li];
            float sa = S0 * kk.x + S1 * kk.y + S2 * kk.z + S3 * kk.w;
            sa = -row16_sum(sa);
            S0 = S0 * w.x + sa * bb.x + vv * km.x;
            S1 = S1 * w.y + sa * bb.y + vv * km.y;
            S2 = S2 * w.z + sa * bb.z + vv * km.z;
            S3 = S3 * w.w + sa * bb.w + vv * km.w;
            float y = S0 * r.x + S1 * r.y + S2 * r.z + S3 * r.w;
            y = row16_sum(y);
            if (lc == 0) yb[j * 16 + li] = y;
        }
        if (cidx + 1 < NCH) stage(cur ^ 1);
        __syncthreads();
        {
            int n, len; const int t = tok_of(cidx, li, n, len);
            RWY[(size_t)t * 256 + head * 64 + rg * 16 + lc] = f2bf(yb[li * 16 + lc]);
        }
    }
}
DEV void phase_s5_glu(const Params& p, int l, int M, char* smem) {
    const bf16_t* P = wsb(p, OFF_P);
    const bf16_t* w = wsb(p, OFF_WSM) + (size_t)l * WS_PER_LAYER + WS_GLUT;
    bf16_t* Y = wsb(p, OFF_Y);
    const float* bg = p.in[I_S5BGLU] + l * 256;
    gemm_generic(P + C_S5, LDP, M, w, 256, 256, 256,
                 [&](int r, int c, float v) { const float z = bf2f(P[(size_t)r * LDP + C_S5 + c]); Y[(size_t)r * 1024 + 256 + c] = f2bf(z * sigmoidf_(v + bg[c])); }, smem, 0);
}
DEV void phase_rw_finish(const Params& p, int l, int M) {
    const int lane = tidx() & 63, wave = tidx() >> 6;
    const bf16_t* P = wsb(p, OFF_P);
    const bf16_t* RWX = wsb(p, OFF_RWX);
    const bf16_t* RWY = wsb(p, OFF_RWY);
    bf16_t* Y = wsb(p, OFF_Y);
    const int c = lane * 4;
    const float4 mur = *(const float4*)(p.in[I_RMU] + (l * 4 + 0) * 256 + c);
    const float4 muk = *(const float4*)(p.in[I_RMU] + (l * 4 + 1) * 256 + c);
    const float4 muv = *(const float4*)(p.in[I_RMU] + (l * 4 + 2) * 256 + c);
    const float4 ka4 = *(const float4*)(p.in[I_RKA] + l * 256 + c);
    const float4 rk4 = *(const float4*)(p.in[I_RRK] + l * 256 + c);
    const float4 lg4 = *(const float4*)(p.in[I_RLNG] + l * 256 + c);
    const float4 lb4 = *(const float4*)(p.in[I_RLNB] + l * 256 + c);
    const float mr_[4] = { mur.x, mur.y, mur.z, mur.w }, mk_[4] = { muk.x, muk.y, muk.z, muk.w }, mv_[4] = { muv.x, muv.y, muv.z, muv.w };
    const float ka_[4] = { ka4.x, ka4.y, ka4.z, ka4.w }, rk_[4] = { rk4.x, rk4.y, rk4.z, rk4.w }, lg_[4] = { lg4.x, lg4.y, lg4.z, lg4.w }, lb_[4] = { lb4.x, lb4.y, lb4.z, lb4.w };
    for (int t = bidx() * 4 + wave; t < M; t += gridDim.x * 4) {
        int base, n, len; tok_seq(t, base, n, len);
        const bf16_t* row = P + (size_t)t * LDP;
        const bool hp = n > 0, hn = n + 1 < len;
        const u32x2 z = (u32x2){0u, 0u};
        float r4[4], k4[4], v4[4];
        {
            const u32x2 cu = *(const u32x2*)(row + C_RWR + c), pv = hp ? *(const u32x2*)(row - LDP + C_RWR + c) : z, nx = hn ? *(const u32x2*)(row + LDP + C_RWR + c) : z;
            const float x[4] = { bflo(cu.x), bfhi(cu.x), bflo(cu.y), bfhi(cu.y) }, a[4] = { bflo(pv.x), bfhi(pv.x), bflo(pv.y), bfhi(pv.y) }, b[4] = { bflo(nx.x), bfhi(nx.x), bflo(nx.y), bfhi(nx.y) };
#pragma unroll
            for (int j = 0; j < 4; ++j) r4[j] = x[j] + (0.5f * (a[j] + b[j]) - x[j]) * mr_[j];
        }
        {
            const u32x2 cu = *(const u32x2*)(row + C_RWK + c), pv = hp ? *(const u32x2*)(row - LDP + C_RWK + c) : z, nx = hn ? *(const u32x2*)(row + LDP + C_RWK + c) : z;
            const float x[4] = { bflo(cu.x), bfhi(cu.x), bflo(cu.y), bfhi(cu.y) }, a[4] = { bflo(pv.x), bfhi(pv.x), bflo(pv.y), bfhi(pv.y) }, b[4] = { bflo(nx.x), bfhi(nx.x), bflo(nx.y), bfhi(nx.y) };
#pragma unroll
            for (int j = 0; j < 4; ++j) k4[j] = x[j] + (0.5f * (a[j] + b[j]) - x[j]) * mk_[j];
        }
        {
            const u32x2 cu = *(const u32x2*)(row + C_RWV + c), pv = hp ? *(const u32x2*)(row - LDP + C_RWV + c) : z, nx = hn ? *(const u32x2*)(row + LDP + C_RWV + c) : z;
            const float x[4] = { bflo(cu.x), bfhi(cu.x), bflo(cu.y), bfhi(cu.y) }, a[4] = { bflo(pv.x), bfhi(pv.x), bflo(pv.y), bfhi(pv.y) }, b[4] = { bflo(nx.x), bfhi(nx.x), bflo(nx.y), bfhi(nx.y) };
#pragma unroll
            for (int j = 0; j < 4; ++j) v4[j] = x[j] + (0.5f * (a[j] + b[j]) - x[j]) * mv_[j];
        }
        const u32x2 af = *(const u32x2*)(RWX + (size_t)t * 1024 + 512 + c), ab = *(const u32x2*)(RWX + (size_t)t * 1024 + 768 + c);
        const float a0[4] = { bflo(af.x), bfhi(af.x), bflo(af.y), bfhi(af.y) }, a1[4] = { bflo(ab.x), bfhi(ab.x), bflo(ab.y), bfhi(ab.y) };
        const u32x2 yf = *(const u32x2*)(RWY + (size_t)t * 256 + c), yb = *(const u32x2*)(RWY + (size_t)TT * 256 + (size_t)t * 256 + c);
        float y[4] = { bflo(yf.x) + bflo(yb.x), bfhi(yf.x) + bfhi(yb.x), bflo(yf.y) + bflo(yb.y), bfhi(yf.y) + bfhi(yb.y) };
        float s = y[0] + y[1] + y[2] + y[3];
        s = group_sum<16>(s);
        const float mean = s * (1.f / 64.f);
        float q = 0.f, bon = 0.f;
#pragma unroll
        for (int j = 0; j < 4; ++j) {
            const float dlt = y[j] - mean; q += dlt * dlt;
            const float kmsum = k4[j] * (2.f + (a0[j] + a1[j] - 2.f) * ka_[j]);
            bon += r4[j] * kmsum * rk_[j];
        }
        q = group_sum<16>(q); bon = group_sum<16>(bon);
        const float rstd = rsqrtf(q * (1.f / 64.f) + 64e-5f);
        const u32x2 gg = *(const u32x2*)(row + C_RWD + c);
        const float g[4] = { bflo(gg.x), bfhi(gg.x), bflo(gg.y), bfhi(gg.y) };
        float o[4];
#pragma unroll
        for (int j = 0; j < 4; ++j) o[j] = ((y[j] - mean) * rstd * lg_[j] + lb_[j] + bon * v4[j]) * g[j];
        u32x2 ov; ov.x = pack2(o[0], o[1]); ov.y = pack2(o[2], o[3]);
        *(u32x2*)(Y + (size_t)t * 1024 + 768 + c) = ov;
    }
}

DEV int queue_next(int* ctr, char* smem) {
    int* slot = (int*)(smem + MOE_MAP_OFF + 208);
    __syncthreads();
    if (tidx() == 0) *slot = atomicAdd(ctr, 1);
    __syncthreads();
    return *slot;
}
DEV void phase_mixers(const Params& p, int l, char* smem) {
    const bool need_ctx = (l == 0);
    const int nrw = 256, nda = need_ctx ? 576 : 512, ns5 = 32 * (need_ctx ? 9 : 8);
    const int total = nrw + 2 * nda + ns5;
    int* ctr = (int*)(p.ws + OFF_CTR) + CTR_Q + l * 16;
    for (;;) {
        const int item = queue_next(ctr, smem);
        if (item >= total) break;
        if (item < nrw) rw_item(p, l, item, smem);
        else if (item < nrw + nda) da_item(p, l, item - nrw, smem);
        else if (item < nrw + 2 * nda) mla_item(p, l, item - nrw - nda, smem);
        else s5_pass2_item(p, l, need_ctx ? 0 : 1, item - nrw - 2 * nda, smem);
    }
}
#ifndef MEGA
#define MEGA 0
#endif
constexpr int NPHASE = 15;
template <int PH>
DEV void run_phase(const Params& p, int l, char* smem) {
    const bool need_ctx = (l == 0);
    const int M = need_ctx ? TT : TL;
    if constexpr (PH == 0) { phase_mod_partial(p, smem); __syncthreads(); phase_conv_small(p, smem); phase_conv_layer(p, 0, smem); phase_conv_experts(p, 0, smem); }
    if constexpr (PH == 1) { phase_mod_reduce(p); }
    if constexpr (PH == 2) { phase_norm<1>(p, l, TT); if (l == 1) { phase_conv_layer(p, 1, smem); phase_conv_experts(p, 1, smem); } }
    if constexpr (PH == 3) { phase_inproj(p, l, smem); }
    if constexpr (PH == 4) { phase_prep1(p, l); phase_s5_pass1(p, l, smem); }
    if constexpr (PH == 5) { phase_prep_gemm1(p, l, smem); }
    if constexpr (PH == 6) { phase_prep_gemm2(p, l, smem); phase_prep2(p, l); }
    if constexpr (PH == 7) { phase_mixers(p, l, smem); }
    if constexpr (PH == 8) { phase_s5_glu(p, l, M, smem); phase_rw_finish(p, l, M); }
    if constexpr (PH == 9) { phase_merge(p, l, M, smem); }
    if constexpr (PH == 10) { phase_outproj(p, l, M, smem); }
    if constexpr (PH == 11) { phase_norm<2>(p, l, M); }
    if constexpr (PH == 12) { phase_moe1(p, l, smem); }
    if constexpr (PH == 13) { phase_moe2(p, l, smem); }
}

#if !MEGA
template <int PH>
__global__ void __launch_bounds__(NT, 2) k_phase(Params p, int l) {
    extern __shared__ __attribute__((aligned(16))) char smem[];
    run_phase<PH>(p, l, smem);
}
#endif
#if MEGA
__global__ void __launch_bounds__(NT, 2) k_mega(Params p) {
    extern __shared__ __attribute__((aligned(16))) char smem[];
    uint4* xbw = (uint4*)(smem + MOE_MAP_OFF + 240);
    if (threadIdx.x == 0) *xbw = make_uint4(0u, 0u, 0u, 0u);
    __syncthreads();
    XcdBarrier bar = xcd_barrier_post((unsigned*)(p.ws + OFF_BAR), (volatile LAS unsigned*)xbw);
    run_phase<0>(p, 0, smem); xcd_barrier(bar);
    run_phase<1>(p, 0, smem); xcd_barrier(bar);
    for (int l = 0; l < 2; ++l) {
        run_phase<2>(p, l, smem); xcd_barrier(bar);
        run_phase<3>(p, l, smem); xcd_barrier(bar);
        run_phase<4>(p, l, smem); xcd_barrier(bar);
        run_phase<5>(p, l, smem); xcd_barrier(bar);
        run_phase<6>(p, l, smem); xcd_barrier(bar);
        run_phase<7>(p, l, smem); xcd_barrier(bar);
        run_phase<8>(p, l, smem); xcd_barrier(bar);
        run_phase<9>(p, l, smem); xcd_barrier(bar);
        run_phase<10>(p, l, smem); xcd_barrier(bar);
        run_phase<11>(p, l, smem); xcd_barrier(bar);
        run_phase<12>(p, l, smem); xcd_barrier(bar);
        run_phase<13>(p, l, smem); if (l == 0) xcd_barrier(bar);
    }
}
#endif
__global__ void __launch_bounds__(NT) k_fail(float* out, int n) {
    for (int i = blockIdx.x * NT + threadIdx.x; i < n; i += gridDim.x * NT) out[i] = __int_as_float(0x7fc00000);
}

template <int PH>
static void launch_phase(const Params& p, int l, int grid, hipStream_t stream) {
#if !MEGA
    static bool attr = false;
    if (!attr) { (void)hipFuncSetAttribute((const void*)k_phase<PH>, hipFuncAttributeMaxDynamicSharedMemorySize, SMEM_BYTES); attr = true; }
    hipLaunchKernelGGL(k_phase<PH>, dim3(grid), dim3(NT), SMEM_BYTES, stream, p, l);
#endif
}

extern "C" void kernel_launch(void* const* d_in, const int* in_sizes, int n_in, void* d_out, int out_size, void* d_ws, size_t ws_size, hipStream_t stream) {
    if (n_in != 48 || out_size != TL * DM || ws_size < WS_END) {
        hipLaunchKernelGGL(k_fail, dim3(256), dim3(NT), 0, stream, (float*)d_out, out_size);
        return;
    }
    Params p{};
    for (int i = 0; i < 48; ++i) p.in[i] = (const float*)d_in[i];
    p.out = (float*)d_out; p.ws = (char*)d_ws;
    (void)hipMemsetAsync(d_ws, 0, ZERO_BYTES, stream);
#if MEGA
    static int grid = 0;
    if (grid == 0) {
        int dev = 0, cus = 0, per_cu = 0;
        (void)hipGetDevice(&dev);
        (void)hipDeviceGetAttribute(&cus, hipDeviceAttributeMultiprocessorCount, dev);
        (void)hipFuncSetAttribute((const void*)k_mega, hipFuncAttributeMaxDynamicSharedMemorySize, SMEM_BYTES);
        if (hipOccupancyMaxActiveBlocksPerMultiprocessor(&per_cu, (const void*)k_mega, NT, SMEM_BYTES) != hipSuccess || per_cu < 1) per_cu = 1;
        (void)hipGetLastError();
        if (cus <= 0) cus = 256;
        grid = cus * (per_cu < 2 ? per_cu : 2);
    }
    hipLaunchKernelGGL(k_mega, dim3(grid), dim3(NT), SMEM_BYTES, stream, p);
#else
    const int grid = 512;
    launch_phase<0>(p, 0, grid, stream);
    launch_phase<1>(p, 0, grid, stream);
    for (int l = 0; l < 2; ++l) {
        launch_phase<2>(p, l, grid, stream);
        launch_phase<3>(p, l, grid, stream);
        launch_phase<4>(p, l, grid, stream);
        launch_phase<5>(p, l, grid, stream);
        launch_phase<6>(p, l, grid, stream);
        launch_phase<7>(p, l, grid, stream);
        launch_phase<8>(p, l, grid, stream);
        launch_phase<9>(p, l, grid, stream);
        launch_phase<10>(p, l, grid, stream);
        launch_phase<11>(p, l, grid, stream);
        launch_phase<12>(p, l, grid, stream);
        launch_phase<13>(p, l, grid, stream);
    }
#endif
}
```

```cpp
#define MEGA 1
#include <hip/hip_runtime.h>
#include <stdint.h>
#include <math.h>

#define DEV __device__ __forceinline__
#define LAS __attribute__((address_space(3)))
typedef unsigned short bf16_t;
typedef short bf16x8 __attribute__((ext_vector_type(8)));
typedef float f32x16 __attribute__((ext_vector_type(16)));
typedef float f32x4 __attribute__((ext_vector_type(4)));
typedef unsigned u32x4 __attribute__((ext_vector_type(4)));
typedef unsigned u32x2 __attribute__((ext_vector_type(2)));

constexpr int NT = 256;
constexpr int DM = 1024, NB = 8, SEQ = 2048, CTXL = 256, GRIDW = 64;
constexpr int TL = NB * SEQ, TC = NB * CTXL, TT = TL + TC;
constexpr int NIN = 6480, LDP = 2432, NINP = 6528, NGATE0 = 2432;
constexpr int C_DAQ = 0, C_DAK = 256, C_DAV = 512, C_S5 = 768, C_CQ = 1024, C_CKV = 1216, C_KR = 1344,
              C_RWR = 1360, C_RWK = 1616, C_RWV = 1872, C_RWD = 2128, C_PEND = 2384;
constexpr int NEXP = 16, DFF = 512;
constexpr float EPS = 1e-6f;
constexpr float LOG2E = 1.4426950408889634f;

constexpr size_t al256(size_t x) { return (x + 255) & ~(size_t)255; }
constexpr size_t OFF_BAR  = 0;
constexpr size_t OFF_CTR  = 16384;
constexpr size_t ZERO_BYTES = 20480;
constexpr size_t OFF_MOD  = 32768;
constexpr size_t SZ_MOD   = (size_t)2 * 9 * 6144 * 4;
constexpr int    MOD_KS   = 8;
constexpr size_t OFF_MODP = al256(OFF_MOD + SZ_MOD);
constexpr size_t OFF_S5ST = al256(OFF_MODP + MOD_KS * SZ_MOD);
constexpr size_t OFF_LTOK = al256(OFF_S5ST + (size_t)2 * 8 * 16 * 8 * 64 * 2 * 4);
constexpr size_t OFF_LW   = al256(OFF_LTOK + (size_t)NEXP * TT * 4);
constexpr size_t OFF_TOKI = al256(OFF_LW + (size_t)NEXP * TT * 4);
constexpr size_t OFF_TOKW = al256(OFF_TOKI + (size_t)TT * 16);
constexpr size_t OFF_CNTB = al256(OFF_TOKW + (size_t)TT * 8);
constexpr size_t OFF_WSM  = al256(OFF_CNTB + (size_t)1024 * 16 * 4);
constexpr int WS_GLUT = 0, WS_UQT = WS_GLUT + 256 * 256, WS_UKVT = WS_UQT + 192 * 192, WS_W1C = WS_UKVT + 384 * 128,
              WS_W2 = WS_W1C + 192 * 256, WS_G2T = WS_W2 + 4 * 256 * 64, WS_PER_LAYER = WS_G2T + 256 * 64;
constexpr size_t OFF_WIN  = al256(OFF_WSM + (size_t)2 * WS_PER_LAYER * 2);
constexpr size_t OFF_WBR  = al256(OFF_WIN + (size_t)NINP * 1024 * 2);
constexpr size_t OFF_WOUT = al256(OFF_WBR + (size_t)4 * 1024 * 256 * 2);
constexpr size_t OFF_WG1  = al256(OFF_WOUT + (size_t)1024 * 1024 * 2);
constexpr size_t OFF_WDN  = al256(OFF_WG1 + (size_t)NEXP * 1024 * 1024 * 2);
constexpr size_t OFF_H    = al256(OFF_WDN + (size_t)NEXP * 1024 * 512 * 2);
constexpr size_t OFF_P    = al256(OFF_H + (size_t)TT * 1024 * 2);
constexpr size_t OFF_GATE = al256(OFF_P + (size_t)TT * LDP * 2);
constexpr size_t OFF_MLAQ = al256(OFF_GATE + (size_t)TT * 4096);
constexpr size_t OFF_MLAK = al256(OFF_MLAQ + (size_t)TT * 192 * 2);
constexpr size_t OFF_MLAV = al256(OFF_MLAK + (size_t)TT * 192 * 2);
constexpr size_t OFF_RWX  = al256(OFF_MLAV + (size_t)TT * 256 * 2);
constexpr size_t OFF_Y    = al256(OFF_RWX + (size_t)TT * 1024 * 2);
constexpr size_t OFF_CX   = al256(OFF_Y + (size_t)TT * 1024 * 2);
constexpr size_t WS_END   = al256(OFF_CX + (size_t)TC * 1024 * 4);
constexpr size_t OFF_QRAW = OFF_Y;
constexpr size_t OFF_KVRAW = OFF_QRAW + (size_t)TT * 192 * 2;
constexpr size_t OFF_LR   = OFF_KVRAW + (size_t)TT * 384 * 2;
constexpr size_t OFF_XL   = OFF_LR + (size_t)TT * 192 * 2;
constexpr size_t OFF_Z    = OFF_GATE;
static_assert(OFF_XL + (size_t)TT * 256 * 2 <= OFF_Y + (size_t)TT * 1024 * 2, "temps overflow Y");
constexpr size_t OFF_RWY  = OFF_H;

constexpr int CTR_MOE = 0;
constexpr int CTR_Q   = 64;

constexpr int SMEM_BYTES = 73728 + 256;

struct Params {
    const float* in[48];
    float* out;
    char* ws;
};
enum { I_X = 0, I_C, I_CTX, I_CCTX, I_WADA, I_BADA, I_NMG, I_NFG, I_WIN, I_DAQKG, I_DALAM, I_DASUB,
       I_S5LRE, I_S5LIM, I_S5LDT, I_S5BRE, I_S5BIM, I_S5CRE, I_S5CIM, I_S5D, I_S5WGLU, I_S5BGLU,
       I_MCQG, I_MCKVG, I_MWUQ, I_MWUKV, I_MQKG,
       I_RMU, I_RW0, I_RW1, I_RW2, I_RA0, I_RA1, I_RA2, I_RG1, I_RG2, I_RKK, I_RKA, I_RRK, I_RLNG, I_RLNB,
       I_WBR, I_WOUT, I_ROUTW, I_ROUTB, I_EWG, I_EWU, I_EWD };

DEV int tidx() { int t = threadIdx.x; asm volatile("" : "+v"(t)); return t; }
DEV int bidx() { int b = blockIdx.x; asm volatile("" : "+s"(b)); return b; }
DEV unsigned cvt_pk_bf16(float lo, float hi) { unsigned r; asm("v_cvt_pk_bf16_f32 %0, %1, %2" : "=v"(r) : "v"(lo), "v"(hi)); return r; }
DEV bf16_t f2bf(float f) { return (bf16_t)(cvt_pk_bf16(f, 0.f) & 0xFFFFu); }
DEV float bf2f(bf16_t h) { return __uint_as_float(((unsigned)h) << 16); }
DEV unsigned pack2(float lo, float hi) { return cvt_pk_bf16(lo, hi); }
DEV float bflo(unsigned u) { return __uint_as_float(u << 16); }
DEV float bfhi(unsigned u) { return __uint_as_float(u & 0xFFFF0000u); }
DEV float sigmoidf_(float x) { return 1.f / (1.f + __expf(-x)); }
DEV float wave_sum(float v) {
#pragma unroll
    for (int o = 32; o >= 1; o >>= 1) v += __shfl_xor(v, o, 64);
    return v;
}
template <int W> DEV float group_sum(float v) {
#pragma unroll
    for (int o = W / 2; o >= 1; o >>= 1) v += __shfl_xor(v, o, 64);
    return v;
}
DEV int mod_row(int t) { return t < TL ? (t >> 11) : 8; }
DEV bf16_t* wsb(const Params& p, size_t off) { return (bf16_t*)(p.ws + off); }
DEV float* wsf(const Params& p, size_t off) { return (float*)(p.ws + off); }
DEV const float* modp(const Params& p, int l, int row, int which) { return (const float*)(p.ws + OFF_MOD) + ((size_t)(l * 9 + row) * 6 + which) * 1024; }
#define XB_TMO      128
#define XB_XCNT(j)  (256  + 64 * (j))
#define XB_XSUB(j)  (1280 + 64 * (j))
#define XB_XGEN(j)  (2304 + 64 * (j))
#define XB_TOP      3328
#define XB_TOPGEN   3392
#define XCD_BAR_WORDS 3456
#define XB_SPIN_CAP (1u << 18)

__device__ __forceinline__ unsigned xb_ld(unsigned* p)              { return __hip_atomic_load(p, __ATOMIC_RELAXED, __HIP_MEMORY_SCOPE_AGENT); }
__device__ __forceinline__ unsigned xb_add(unsigned* p, unsigned v) { return __hip_atomic_fetch_add(p, v, __ATOMIC_RELAXED, __HIP_MEMORY_SCOPE_AGENT); }
__device__ __forceinline__ unsigned xb_xcc_id() { return (unsigned)__builtin_amdgcn_s_getreg((3 << 11) | 20) & 0xFu; }
#define XB_SPIN(cond, bar) do { unsigned _sp = 0; while (cond) { __builtin_amdgcn_s_sleep(1); \
    if ((++_sp & 255u) == 0u) { if (xb_ld(&(bar)[XB_TMO])) break; if (_sp > XB_SPIN_CAP) { atomicAdd(&(bar)[XB_TMO], 1u); break; } } } } while (0)

struct XcdBarrier {
    unsigned* bar; unsigned x;
    volatile LAS unsigned* st;
};

__device__ __forceinline__ XcdBarrier xcd_barrier_post(unsigned* bar, volatile LAS unsigned* st) {
    XcdBarrier b; b.bar = bar; b.x = xb_xcc_id(); b.st = st;
    if (threadIdx.x == 0) (void)xb_add(&bar[XB_XCNT(b.x)], 1u);
    return b;
}
__device__ __forceinline__ void xcd_barrier_complete(unsigned* bar, unsigned x, unsigned& nloc, unsigned& nx) {
    const unsigned G = gridDim.x * gridDim.y * gridDim.z;
    unsigned sum, cnt, mine, sp = 0u;
    for (;;) {
        sum = 0u; cnt = 0u; mine = 0u;
#pragma unroll
        for (unsigned j = 0; j < 16; ++j) { const unsigned c = xb_ld(&bar[XB_XCNT(j)]); sum += c; cnt += (c > 0u) ? 1u : 0u; mine = (j == x) ? c : mine; }
        if (sum == G) break;
        __builtin_amdgcn_s_sleep(1);
        if ((++sp & 255u) == 0u) { if (xb_ld(&bar[XB_TMO])) break; if (sp > XB_SPIN_CAP) { atomicAdd(&bar[XB_TMO], 1u); break; } }
    }
    nloc = mine > 0u ? mine : 1u; nx = cnt > 0u ? cnt : 1u;
}

__device__ __forceinline__ void xcd_barrier(const XcdBarrier& b) {
    asm volatile("s_waitcnt vmcnt(0)" ::: "memory");
    __syncthreads();
    if (threadIdx.x == 0) {
        unsigned* bar = b.bar;
        __builtin_amdgcn_s_waitcnt(0);
        unsigned nloc = b.st[0], nx = b.st[1];
        if (nloc == 0u) { xcd_barrier_complete(bar, b.x, nloc, nx); b.st[0] = nloc; b.st[1] = nx; }
        const unsigned old = xb_add(&bar[XB_XSUB(b.x)], 1u);
        const unsigned gen = old / nloc;
        if (old + 1u == (gen + 1u) * nloc) {
            __builtin_amdgcn_fence(__ATOMIC_RELEASE, "agent");
            asm volatile("s_waitcnt vmcnt(0)" ::: "memory");
            const unsigned og = xb_add(&bar[XB_TOP], 1u);
            const unsigned tg = og / nx;
            if (og + 1u == (tg + 1u) * nx) xb_add(&bar[XB_TOPGEN], 1u);
            else XB_SPIN(xb_ld(&bar[XB_TOPGEN]) == tg, bar);
            __builtin_amdgcn_fence(__ATOMIC_ACQUIRE, "agent");
            xb_add(&bar[XB_XGEN(b.x)], 1u);
            asm volatile("s_waitcnt vmcnt(0)" ::: "memory");
        } else {
            XB_SPIN(xb_ld(&bar[XB_XGEN(b.x)]) == gen, bar);
            __builtin_amdgcn_fence(__ATOMIC_ACQUIRE, "agent");
            asm volatile("s_waitcnt vmcnt(0)" ::: "memory");
        }
    }
    __syncthreads();
}

DEV void phase_mod_partial(const Params& p, char* smem) {
    float* sm = (float*)smem;
    const int tid = tidx();
    const int nitems = 2 * 24 * MOD_KS;
    for (int item = bidx(); item < nitems; item += gridDim.x) {
        const int l = item / (24 * MOD_KS), rem = item % (24 * MOD_KS), jc = rem / MOD_KS, ks = rem % MOD_KS;
        __syncthreads();
        for (int i = tid; i < 9 * 128; i += NT) {
            const int r = i >> 7, k = ks * 128 + (i & 127);
            const float cv = r < 8 ? p.in[I_C][r * 1024 + k] : p.in[I_CCTX][k];
            sm[i] = cv / (1.f + __expf(-cv));
        }
        __syncthreads();
        const int j = jc * 256 + tid;
        float acc[9];
#pragma unroll
        for (int r = 0; r < 9; ++r) acc[r] = 0.f;
        const float* w = p.in[I_WADA] + (size_t)l * 1024 * 6144 + (size_t)(ks * 128) * 6144 + j;
#pragma unroll 8
        for (int k = 0; k < 128; ++k) {
            const float wv = w[(size_t)k * 6144];
#pragma unroll
            for (int r = 0; r < 9; ++r) acc[r] += sm[r * 128 + k] * wv;
        }
        float* dst = wsf(p, OFF_MODP);
#pragma unroll
        for (int r = 0; r < 9; ++r) dst[((size_t)(ks * 2 + l) * 9 + r) * 6144 + j] = acc[r];
    }
}
DEV void phase_mod_reduce(const Params& p) {
    const int n = 2 * 9 * 6144;
    float* mod = wsf(p, OFF_MOD);
    const float* part = wsf(p, OFF_MODP);
    for (int i = bidx() * NT + tidx(); i < n; i += gridDim.x * NT) {
        const int l = i / (9 * 6144), j = i % 6144;
        float s = p.in[I_BADA][l * 6144 + j];
#pragma unroll
        for (int ks = 0; ks < MOD_KS; ++ks) s += part[(size_t)ks * n + i];
        mod[i] = s;
    }
}

template <int MODE>
DEV void conv_tile(const float* src, int R, int C, int ld, bf16_t* dst, int ldd, int roff, int tr, int tc, float* sm) {
    const int r0 = tr * 64, c0 = tc * 64, tid = tidx();
    for (int i = tid; i < 64 * 16; i += NT) {
        const int r = i >> 4, c4 = (i & 15) * 4;
        float4 v = make_float4(0.f, 0.f, 0.f, 0.f);
        if (r0 + r < R) {
            const float* s = src + (size_t)(r0 + r) * ld + c0 + c4;
            if (c0 + c4 + 3 < C) v = *(const float4*)s;
            else { if (c0 + c4 < C) v.x = s[0]; if (c0 + c4 + 1 < C) v.y = s[1]; if (c0 + c4 + 2 < C) v.z = s[2]; }
        }
        float* d = sm + r * 65 + c4;
        d[0] = v.x; d[1] = v.y; d[2] = v.z; d[3] = v.w;
    }
    __syncthreads();
    for (int i = tid; i < 64 * 8; i += NT) {
        const int c = i >> 3, r8 = (i & 7) * 8;
        if (c0 + c < C && r0 + r8 < R) {
            const int cc = c0 + c;
            const int drow = (MODE == 0) ? (cc + roff) : ((cc >> 5) * 64 + (cc & 31) + roff);
            uint4 o;
            o.x = pack2(sm[(r8 + 0) * 65 + c], sm[(r8 + 1) * 65 + c]);
            o.y = pack2(sm[(r8 + 2) * 65 + c], sm[(r8 + 3) * 65 + c]);
            o.z = pack2(sm[(r8 + 4) * 65 + c], sm[(r8 + 5) * 65 + c]);
            o.w = pack2(sm[(r8 + 6) * 65 + c], sm[(r8 + 7) * 65 + c]);
            *(uint4*)(dst + (size_t)drow * ldd + r0 + r8) = o;
        }
    }
    __syncthreads();
}
template <int MODE>
DEV void conv_job(const float* src, int R, int C, int ld, bf16_t* dst, int ldd, int roff, int& rot, float* sm) {
    const int ntr = (R + 63) >> 6, ntc = (C + 63) >> 6, nt = ntr * ntc, G = gridDim.x;
    int first = (bidx() - (rot % G) + G) % G;
    for (int t = first; t < nt; t += G) conv_tile<MODE>(src, R, C, ld, dst, ldd, roff, t / ntc, t % ntc, sm);
    rot += nt;
}
DEV void phase_conv_layer(const Params& p, int l, char* smem) {
    float* sm = (float*)smem;
    int rot = 0;
    const float* win = p.in[I_WIN] + (size_t)l * 1024 * NIN;
    conv_job<0>(win, 1024, C_PEND, NIN, wsb(p, OFF_WIN), 1024, 0, rot, sm);
    conv_job<0>(win + C_PEND, 1024, 4096, NIN, wsb(p, OFF_WIN), 1024, NGATE0, rot, sm);
    {
        uint4* z = (uint4*)(wsb(p, OFF_WIN) + (size_t)C_PEND * 1024);
        const int n = (NGATE0 - C_PEND) * 1024 / 8;
        for (int i = bidx() * NT + tidx(); i < n; i += gridDim.x * NT) z[i] = make_uint4(0u, 0u, 0u, 0u);
    }
    for (int i = 0; i < 4; ++i)
        conv_job<0>(p.in[I_WBR] + (size_t)(l * 4 + i) * 256 * 1024, 256, 1024, 1024, wsb(p, OFF_WBR) + (size_t)i * 1024 * 256, 256, 0, rot, sm);
    conv_job<0>(p.in[I_WOUT] + (size_t)l * 1024 * 1024, 1024, 1024, 1024, wsb(p, OFF_WOUT), 1024, 0, rot, sm);
}
DEV void phase_conv_experts(const Params& p, int l, char* smem) {
    float* sm = (float*)smem;
    int rot = 0;
    for (int e = 0; e < NEXP; ++e) {
        conv_job<1>(p.in[I_EWG] + (size_t)(l * NEXP + e) * 1024 * DFF, 1024, DFF, DFF, wsb(p, OFF_WG1) + (size_t)e * 1024 * 1024, 1024, 0, rot, sm);
        conv_job<1>(p.in[I_EWU] + (size_t)(l * NEXP + e) * 1024 * DFF, 1024, DFF, DFF, wsb(p, OFF_WG1) + (size_t)e * 1024 * 1024, 1024, 32, rot, sm);
        conv_job<0>(p.in[I_EWD] + (size_t)(l * NEXP + e) * DFF * 1024, DFF, 1024, 1024, wsb(p, OFF_WDN) + (size_t)e * 1024 * DFF, DFF, 0, rot, sm);
    }
}
DEV void phase_conv_small(const Params& p, char* smem) {
    float* sm = (float*)smem;
    int rot = 0;
    for (int l = 0; l < 2; ++l) {
        bf16_t* w = wsb(p, OFF_WSM) + (size_t)l * WS_PER_LAYER;
        for (int i = bidx() * NT + tidx(); i < 4 * 256 * 4; i += gridDim.x * NT)
            *(u32x4*)(w + WS_W2 + (size_t)(i >> 2) * 64 + 32 + (i & 3) * 8) = (u32x4){0u, 0u, 0u, 0u};
        conv_job<0>(p.in[I_S5WGLU] + (size_t)l * 256 * 256, 256, 256, 256, w + WS_GLUT, 256, 0, rot, sm);
        conv_job<0>(p.in[I_MWUQ] + (size_t)l * 192 * 192, 192, 192, 192, w + WS_UQT, 192, 0, rot, sm);
        conv_job<0>(p.in[I_MWUKV] + (size_t)l * 128 * 384, 128, 384, 384, w + WS_UKVT, 128, 0, rot, sm);
        for (int d = 0; d < 2; ++d) {
            conv_job<0>(p.in[I_RW1] + (size_t)(l * 2 + d) * 256 * 32, 256, 32, 32, w + WS_W1C, 256, d * 32, rot, sm);
            conv_job<0>(p.in[I_RA1] + (size_t)(l * 2 + d) * 256 * 32, 256, 32, 32, w + WS_W1C, 256, 64 + d * 32, rot, sm);
            conv_job<0>(p.in[I_RW2] + (size_t)(l * 2 + d) * 32 * 256, 32, 256, 256, w + WS_W2 + (size_t)d * 256 * 64, 64, 0, rot, sm);
            conv_job<0>(p.in[I_RA2] + (size_t)(l * 2 + d) * 32 * 256, 32, 256, 256, w + WS_W2 + (size_t)(2 + d) * 256 * 64, 64, 0, rot, sm);
        }
        conv_job<0>(p.in[I_RG1] + (size_t)l * 256 * 64, 256, 64, 64, w + WS_W1C, 256, 128, rot, sm);
        conv_job<0>(p.in[I_RG2] + (size_t)l * 64 * 256, 64, 256, 256, w + WS_G2T, 64, 0, rot, sm);
    }
}

template <int WHICH>
DEV void phase_norm(const Params& p, int l, int nrows, char* smem) {
    const int lane = tidx() & 63, wave = tidx() >> 6;
    const float* xs = (l == 0) ? p.in[I_X] : p.out;
    const float* cs = (l == 0) ? p.in[I_CTX] : wsf(p, OFF_CX);
    const float* g = p.in[WHICH == 1 ? I_NMG : I_NFG] + l * 1024;
    bf16_t* H = wsb(p, OFF_H);
    if (WHICH == 2) { xs = p.out; cs = wsf(p, OFF_CX); }
    const int tpb = (nrows + (int)gridDim.x - 1) / (int)gridDim.x;
    const int rbeg = WHICH == 2 ? bidx() * tpb + wave : bidx() * 4 + wave;
    const int rend = WHICH == 2 ? min(nrows, (bidx() + 1) * tpb) : nrows;
    const int rstep = WHICH == 2 ? 4 : (int)gridDim.x * 4;
    int* sel = (int*)smem;
    for (int row = rbeg; row < rend; row += rstep) {
        const float* src = row < TL ? xs + (size_t)row * 1024 : cs + (size_t)(row - TL) * 1024;
        const int mr = mod_row(row);
        const float* sh = modp(p, l, mr, WHICH == 1 ? 0 : 3);
        const float* sc = modp(p, l, mr, WHICH == 1 ? 1 : 4);
        float4 v[4];
        float ss = 0.f;
#pragma unroll
        for (int i = 0; i < 4; ++i) {
            v[i] = *(const float4*)(src + lane * 4 + i * 256);
            ss += v[i].x * v[i].x + v[i].y * v[i].y + v[i].z * v[i].z + v[i].w * v[i].w;
        }
        ss = wave_sum(ss);
        const float rstd = rsqrtf(ss * (1.f / 1024.f) + EPS);
        float hv[16];
#pragma unroll
        for (int i = 0; i < 4; ++i) {
            const int c = lane * 4 + i * 256;
            const float4 gg = *(const float4*)(g + c), s4 = *(const float4*)(sh + c), c4 = *(const float4*)(sc + c);
            hv[i * 4 + 0] = v[i].x * rstd * gg.x * (1.f + c4.x) + s4.x;
            hv[i * 4 + 1] = v[i].y * rstd * gg.y * (1.f + c4.y) + s4.y;
            hv[i * 4 + 2] = v[i].z * rstd * gg.z * (1.f + c4.z) + s4.z;
            hv[i * 4 + 3] = v[i].w * rstd * gg.w * (1.f + c4.w) + s4.w;
            u32x2 o; o.x = pack2(hv[i * 4 + 0], hv[i * 4 + 1]); o.y = pack2(hv[i * 4 + 2], hv[i * 4 + 3]);
            *(u32x2*)(H + (size_t)row * 1024 + c) = o;
        }
        if (WHICH == 2) {
            float lg[16];
#pragma unroll
            for (int e = 0; e < 16; ++e) lg[e] = 0.f;
            const float* rw = p.in[I_ROUTW];
#pragma unroll
            for (int i = 0; i < 4; ++i)
#pragma unroll
                for (int j = 0; j < 4; ++j) {
                    const int c = lane * 4 + i * 256 + j;
                    const float hvv = hv[i * 4 + j];
#pragma unroll
                    for (int q = 0; q < 4; ++q) {
                        const float4 w4 = *(const float4*)(rw + (size_t)c * 16 + q * 4);
                        lg[q * 4 + 0] += hvv * w4.x; lg[q * 4 + 1] += hvv * w4.y; lg[q * 4 + 2] += hvv * w4.z; lg[q * 4 + 3] += hvv * w4.w;
                    }
                }
#pragma unroll
            for (int e = 0; e < 16; ++e) lg[e] = wave_sum(lg[e]);
            float sc16[16], bs[16];
#pragma unroll
            for (int e = 0; e < 16; ++e) { sc16[e] = sigmoidf_(lg[e]); bs[e] = sc16[e] + p.in[I_ROUTB][e]; }
            int bestg = 0; float bestv = -INFINITY;
#pragma unroll
            for (int gi = 0; gi < 4; ++gi) {
                float m1 = -INFINITY, m2 = -INFINITY;
#pragma unroll
                for (int k = 0; k < 4; ++k) { const float x = bs[gi * 4 + k]; if (x > m1) { m2 = m1; m1 = x; } else if (x > m2) m2 = x; }
                const float gs = m1 + m2;
                if (gs > bestv) { bestv = gs; bestg = gi; }
            }
            int i0 = 0, i1 = 0; float v0 = -INFINITY, v1 = -INFINITY, s0 = 0.f, s1 = 0.f;
#pragma unroll
            for (int e = 0; e < 16; ++e) { const bool in = (e >> 2) == bestg; if (in && bs[e] > v0) { v0 = bs[e]; i0 = e; s0 = sc16[e]; } }
#pragma unroll
            for (int e = 0; e < 16; ++e) { const bool in = (e >> 2) == bestg && e != i0; if (in && bs[e] > v1) { v1 = bs[e]; i1 = e; s1 = sc16[e]; } }
            const float inv = 1.f / (s0 + s1);
            if (lane == 0) {
                const int lt = row - bidx() * tpb;
                sel[lt * 2 + 0] = i0; sel[lt * 2 + 1] = i1;
                float* tw = (float*)(p.ws + OFF_TOKW) + (size_t)row * 2;
                tw[0] = s0 * inv; tw[1] = s1 * inv;
            }
        }
    }
    if (WHICH == 2) {
        __syncthreads();
        const int t0 = bidx() * tpb, nt = max(0, min(nrows, t0 + tpb) - t0);
        int* rank = sel + 2 * tpb;
        if (tidx() < 16) {
            const int e = tidx(); int c = 0;
            for (int i = 0; i < 2 * nt; ++i) if (sel[i] == e) { rank[i] = c; ++c; }
            ((int*)(p.ws + OFF_CNTB))[(size_t)bidx() * 16 + e] = c;
        }
        __syncthreads();
        int* toki = (int*)(p.ws + OFF_TOKI);
        for (int i = tidx(); i < nt; i += NT) {
            int4 r; r.x = sel[2 * i]; r.y = sel[2 * i + 1]; r.z = rank[2 * i]; r.w = rank[2 * i + 1];
            *(int4*)(toki + (size_t)(t0 + i) * 4) = r;
        }
        __syncthreads();
    }
}
DEV void phase_route(const Params& p, int l, int nrows, char* smem) {
    int* sm = (int*)smem;
    const int tid = tidx(), e = tid & 15, part = tid >> 4, G = gridDim.x, b = bidx();
    const int* cntb = (const int*)(p.ws + OFF_CNTB);
    int pre = 0, tot = 0;
    for (int bb = part; bb < G; bb += 16) { const int c = cntb[(size_t)bb * 16 + e]; tot += c; if (bb < b) pre += c; }
    __syncthreads();
    sm[part * 16 + e] = pre; sm[256 + part * 16 + e] = tot;
    __syncthreads();
    if (tid < 16) {
        int a = 0, t = 0;
        for (int q = 0; q < 16; ++q) { a += sm[q * 16 + tid]; t += sm[256 + q * 16 + tid]; }
        sm[512 + tid] = a; sm[528 + tid] = t;
    }
    __syncthreads();
    if (tid == 0) {
        int a = 0;
        for (int q = 0; q < 16; ++q) { sm[544 + q] = a; a += sm[528 + q]; }
    }
    __syncthreads();
    if (b == 0 && tid < 16) ((int*)(p.ws + OFF_CTR))[CTR_MOE + l * 16 + tid] = sm[528 + tid];
    const int tpb = (nrows + G - 1) / G, t0 = b * tpb, nt = max(0, min(nrows, t0 + tpb) - t0);
    int* toki = (int*)(p.ws + OFF_TOKI);
    const float* tokw = (const float*)(p.ws + OFF_TOKW);
    int* ltok = (int*)(p.ws + OFF_LTOK);
    float* lw = (float*)(p.ws + OFF_LW);
    for (int i = tid; i < 2 * nt; i += NT) {
        const int t = t0 + (i >> 1), j = i & 1;
        const int ee = toki[(size_t)t * 4 + j], rk = toki[(size_t)t * 4 + 2 + j];
        const int pos = sm[512 + ee] + rk;
        ltok[(size_t)ee * TT + pos] = t;
        lw[(size_t)ee * TT + pos] = tokw[(size_t)t * 2 + j];
        toki[(size_t)t * 4 + 2 + j] = sm[544 + ee] + pos;
    }
}
DEV void phase_combine(const Params& p, int l, int nrows) {
    const int lane = tidx() & 63, wave = tidx() >> 6;
    const bf16_t* Z = wsb(p, OFF_Z);
    const int* toki = (const int*)(p.ws + OFF_TOKI);
    const float* tokw = (const float*)(p.ws + OFF_TOKW);
    for (int row = bidx() * 4 + wave; row < nrows; row += gridDim.x * 4) {
        float* dst = row < TL ? p.out + (size_t)row * 1024 : wsf(p, OFF_CX) + (size_t)(row - TL) * 1024;
        const float* g2 = modp(p, l, mod_row(row), 5);
        const int r0 = toki[(size_t)row * 4 + 2], r1 = toki[(size_t)row * 4 + 3];
        const float w0 = tokw[(size_t)row * 2], w1 = tokw[(size_t)row * 2 + 1];
#pragma unroll
        for (int i = 0; i < 4; ++i) {
            const int c = lane * 4 + i * 256;
            const u32x2 a = *(const u32x2*)(Z + (size_t)r0 * 1024 + c), b = *(const u32x2*)(Z + (size_t)r1 * 1024 + c);
            const float4 gg = *(const float4*)(g2 + c);
            float4 x = *(float4*)(dst + c);
            x.x += gg.x * (w0 * bflo(a.x) + w1 * bflo(b.x));
            x.y += gg.y * (w0 * bfhi(a.x) + w1 * bfhi(b.x));
            x.z += gg.z * (w0 * bflo(a.y) + w1 * bflo(b.y));
            x.w += gg.w * (w0 * bfhi(a.y) + w1 * bfhi(b.y));
            *(float4*)(dst + c) = x;
        }
    }
}
constexpr int GLD = 72;
constexpr int GSTAGE = 128 * GLD;
template <bool DEEP = true, class AF, class BF>
DEV void gemm_mainloop(f32x16 (&acc)[2][2], AF arow, BF brow, int K, bf16_t* sm) {
    const int tid = tidx(), lane = tid & 63, wave = tid >> 6, wm = wave >> 1, wn = wave & 1;
    bf16_t* As = sm;
    bf16_t* Bs = sm + 2 * GSTAGE;
    const bf16_t* ap[4]; const bf16_t* bp[4];
#pragma unroll
    for (int i = 0; i < 4; ++i) { const int q = tid + i * NT; ap[i] = arow(q >> 3) + (q & 7) * 8; bp[i] = brow(q >> 3) + (q & 7) * 8; }
    const int soff = (tid >> 3) * GLD + (tid & 7) * 8;
    u32x4 ra0[4], rb0[4], ra1[4], rb1[4];
    const int nk = K >> 6;
#pragma unroll
    for (int i = 0; i < 4; ++i) { ra0[i] = *(const u32x4*)ap[i]; rb0[i] = *(const u32x4*)bp[i]; }
    if (DEEP && nk > 1) {
#pragma unroll
        for (int i = 0; i < 4; ++i) { ra1[i] = *(const u32x4*)(ap[i] + 64); rb1[i] = *(const u32x4*)(bp[i] + 64); }
    }
    __syncthreads();
#pragma unroll
    for (int i = 0; i < 4; ++i) { *(u32x4*)(As + soff + i * 32 * GLD) = ra0[i]; *(u32x4*)(Bs + soff + i * 32 * GLD) = rb0[i]; }
    __syncthreads();
    const int arow0 = (wm * 64 + (lane & 31)) * GLD + (lane >> 5) * 8;
    const int brow0 = (wn * 64 + (lane & 31)) * GLD + (lane >> 5) * 8;
    auto compute = [&](int cur) {
        const bf16_t* a_s = As + cur * GSTAGE + arow0;
        const bf16_t* b_s = Bs + cur * GSTAGE + brow0;
#pragma unroll
        for (int ks = 0; ks < 4; ++ks) {
            const bf16x8 a0 = *(const bf16x8*)(a_s + ks * 16);
            const bf16x8 a1 = *(const bf16x8*)(a_s + 32 * GLD + ks * 16);
            const bf16x8 b0 = *(const bf16x8*)(b_s + ks * 16);
            const bf16x8 b1 = *(const bf16x8*)(b_s + 32 * GLD + ks * 16);
            acc[0][0] = __builtin_amdgcn_mfma_f32_32x32x16_bf16(a0, b0, acc[0][0], 0, 0, 0);
            acc[0][1] = __builtin_amdgcn_mfma_f32_32x32x16_bf16(a0, b1, acc[0][1], 0, 0, 0);
            acc[1][0] = __builtin_amdgcn_mfma_f32_32x32x16_bf16(a1, b0, acc[1][0], 0, 0, 0);
            acc[1][1] = __builtin_amdgcn_mfma_f32_32x32x16_bf16(a1, b1, acc[1][1], 0, 0, 0);
        }
    };
    for (int kt = 0; kt < nk; kt += 2) {
        if (!DEEP && kt > 0 && kt + 1 < nk) {
            const int k0 = (kt + 1) * 64;
#pragma unroll
            for (int i = 0; i < 4; ++i) { ra1[i] = *(const u32x4*)(ap[i] + k0); rb1[i] = *(const u32x4*)(bp[i] + k0); }
        }
        if (!DEEP && kt == 0 && nk > 1) {
#pragma unroll
            for (int i = 0; i < 4; ++i) { ra1[i] = *(const u32x4*)(ap[i] + 64); rb1[i] = *(const u32x4*)(bp[i] + 64); }
        }
        if (DEEP && kt + 2 < nk) {
            const int k0 = (kt + 2) * 64;
#pragma unroll
            for (int i = 0; i < 4; ++i) { ra0[i] = *(const u32x4*)(ap[i] + k0); rb0[i] = *(const u32x4*)(bp[i] + k0); }
        }
        compute(0);
        if (kt + 1 < nk) {
#pragma unroll
            for (int i = 0; i < 4; ++i) { *(u32x4*)(As + GSTAGE + soff + i * 32 * GLD) = ra1[i]; *(u32x4*)(Bs + GSTAGE + soff + i * 32 * GLD) = rb1[i]; }
        }
        __syncthreads();
        if (kt + 1 >= nk) break;
        if (!DEEP && kt + 2 < nk) {
            const int k0 = (kt + 2) * 64;
#pragma unroll
            for (int i = 0; i < 4; ++i) { ra0[i] = *(const u32x4*)(ap[i] + k0); rb0[i] = *(const u32x4*)(bp[i] + k0); }
        }
        if (DEEP && kt + 3 < nk) {
            const int k0 = (kt + 3) * 64;
#pragma unroll
            for (int i = 0; i < 4; ++i) { ra1[i] = *(const u32x4*)(ap[i] + k0); rb1[i] = *(const u32x4*)(bp[i] + k0); }
        }
        compute(1);
        if (kt + 2 < nk) {
#pragma unroll
            for (int i = 0; i < 4; ++i) { *(u32x4*)(As + soff + i * 32 * GLD) = ra0[i]; *(u32x4*)(Bs + soff + i * 32 * GLD) = rb0[i]; }
        }
        __syncthreads();
    }
}
DEV void acc_zero(f32x16 (&acc)[2][2]) {
#pragma unroll
    for (int i = 0; i < 2; ++i)
#pragma unroll
        for (int j = 0; j < 2; ++j)
#pragma unroll
            for (int r = 0; r < 16; ++r) acc[i][j][r] = 0.f;
}
#define EPI_FOREACH(acc, ...)                                                                           \
    {                                                                                                    \
        const int _lane = tidx() & 63, _wave = tidx() >> 6, _wm = _wave >> 1, _wn = _wave & 1; \
        _Pragma("unroll") for (int _i = 0; _i < 2; ++_i)                                                 \
        _Pragma("unroll") for (int _j = 0; _j < 2; ++_j)                                                 \
        _Pragma("unroll") for (int _r = 0; _r < 16; ++_r) {                                              \
            const int er = _wm * 64 + _i * 32 + (_r & 3) + 8 * (_r >> 2) + 4 * (_lane >> 5);             \
            const int ec = _wn * 64 + _j * 32 + (_lane & 31);                                            \
            const float ev = acc[_i][_j][_r];                                                            \
            __VA_ARGS__                                                                                  \
        }                                                                                                \
    }

DEV void tile_mn(int item, int nMt, int nNt, int& mt, int& nt) {
    constexpr int GM = 16;
    const int per = GM * nNt, g = item / per, rem = item % per;
    const int m0 = g * GM, gsz = (nMt - m0) < GM ? (nMt - m0) : GM;
    mt = m0 + rem % gsz; nt = rem / gsz;
}

DEV void phase_inproj(const Params& p, int l, char* smem) {
    bf16_t* sm = (bf16_t*)smem;
    const bf16_t* H = wsb(p, OFF_H);
    const bf16_t* W = wsb(p, OFF_WIN);
    bf16_t* P = wsb(p, OFF_P);
    unsigned char* G = (unsigned char*)(p.ws + OFF_GATE);
    const int nMt = TT / 128, nNt = NINP / 128;
    for (int item = bidx(); item < nMt * nNt; item += gridDim.x) {
        int mt, nt; tile_mn(item, nMt, nNt, mt, nt);
        const int m0 = mt * 128, n0 = nt * 128;
        if (l == 1 && m0 >= TL && n0 >= NGATE0) continue;
        f32x16 acc[2][2]; acc_zero(acc);
        gemm_mainloop(acc, [&](int r) { return H + (size_t)(m0 + r) * 1024; }, [&](int r) { return W + (size_t)(n0 + r) * 1024; }, 1024, sm);
        if (n0 < NGATE0) {
            EPI_FOREACH(acc, { const int col = n0 + ec; if (col < C_PEND) P[(size_t)(m0 + er) * LDP + col] = f2bf(ev); })
        } else {
            EPI_FOREACH(acc, { const int col = n0 + ec - NGATE0; const float s = sigmoidf_(ev); G[(size_t)(m0 + er) * 4096 + col] = (unsigned char)__float2int_rn(s * 255.f); })
        }
    }
}

template <class EF>
DEV void gemm_generic(const bf16_t* A, int lda, int M, const bf16_t* Bt, int ldb, int N, int K, EF ef, char* smem, int rot) {
    bf16_t* sm = (bf16_t*)smem;
    const int nMt = (M + 127) / 128, nNt = (N + 127) / 128, G = gridDim.x;
    const int first = (bidx() - (rot % G) + G) % G;
    for (int item = first; item < nMt * nNt; item += G) {
        const int mt = item / nNt, nt = item % nNt, m0 = mt * 128, n0 = nt * 128;
        f32x16 acc[2][2]; acc_zero(acc);
        gemm_mainloop(acc, [&](int r) { int rr = m0 + r; rr = rr < M ? rr : M - 1; return A + (size_t)rr * lda; },
                      [&](int r) { int rr = n0 + r; rr = rr < N ? rr : N - 1; return Bt + (size_t)rr * ldb; }, K, sm);
        EPI_FOREACH(acc, { const int row = m0 + er, col = n0 + ec; if (row < M && col < N) ef(row, col, ev); })
    }
}

DEV void phase_merge(const Params& p, int l, int M, char* smem) {
    bf16_t* sm = (bf16_t*)smem;
    const bf16_t* Y = wsb(p, OFF_Y);
    const bf16_t* W = wsb(p, OFF_WBR);
    const unsigned char* G = (const unsigned char*)(p.ws + OFF_GATE);
    bf16_t* MG = wsb(p, OFF_H);
    const int nMt = M / 128, nNt = 8;
    for (int item = bidx(); item < nMt * nNt; item += gridDim.x) {
        const int mt = item / nNt, nt = item % nNt, m0 = mt * 128, n0 = nt * 128;
        f32x16 tot[2][2]; acc_zero(tot);
        for (int i = 0; i < 4; ++i) {
            f32x16 acc[2][2]; acc_zero(acc);
            gemm_mainloop<false>(acc, [&](int r) { return Y + (size_t)(m0 + r) * 1024 + i * 256; }, [&](int r) { return W + ((size_t)i * 1024 + n0 + r) * 256; }, 256, sm);
            const int lane = tidx() & 63, wave = tidx() >> 6, wm = wave >> 1, wn = wave & 1;
#pragma unroll
            for (int a = 0; a < 2; ++a)
#pragma unroll
                for (int b = 0; b < 2; ++b)
#pragma unroll
                    for (int r = 0; r < 16; ++r) {
                        const int er = wm * 64 + a * 32 + (r & 3) + 8 * (r >> 2) + 4 * (lane >> 5), ec = wn * 64 + b * 32 + (lane & 31);
                        const float g = (float)G[(size_t)(m0 + er) * 4096 + i * 1024 + n0 + ec] * (1.f / 255.f);
                        tot[a][b][r] += g * acc[a][b][r];
                    }
        }
        EPI_FOREACH(tot, { MG[(size_t)(m0 + er) * 1024 + n0 + ec] = f2bf(ev); })
    }
}

DEV void phase_outproj(const Params& p, int l, int M, char* smem) {
    bf16_t* sm = (bf16_t*)smem;
    const bf16_t* MG = wsb(p, OFF_H);
    const bf16_t* W = wsb(p, OFF_WOUT);
    const float* xs = (l == 0) ? p.in[I_X] : p.out;
    const float* cs = (l == 0) ? p.in[I_CTX] : wsf(p, OFF_CX);
    float* cxd = wsf(p, OFF_CX);
    float* outd = p.out;
    const int nMt = M / 128, nNt = 8;
    for (int item = bidx(); item < nMt * nNt; item += gridDim.x) {
        const int mt = item / nNt, nt = item % nNt, m0 = mt * 128, n0 = nt * 128;
        f32x16 acc[2][2]; acc_zero(acc);
        gemm_mainloop(acc, [&](int r) { return MG + (size_t)(m0 + r) * 1024; }, [&](int r) { return W + (size_t)(n0 + r) * 1024; }, 1024, sm);
        const float* g1 = modp(p, l, mod_row(m0), 2);
        if (m0 < TL) {
            EPI_FOREACH(acc, { const size_t o = (size_t)(m0 + er) * 1024 + n0 + ec; outd[o] = xs[o] + g1[n0 + ec] * ev; })
        } else {
            EPI_FOREACH(acc, { const size_t o = (size_t)(m0 - TL + er) * 1024 + n0 + ec; cxd[o] = cs[o] + g1[n0 + ec] * ev; })
        }
    }
}

constexpr int MOE_MAP_OFF = 73728;
DEV void moe_map(const Params& p, int l, char* smem) {
    int* mm = (int*)(smem + MOE_MAP_OFF);
    __syncthreads();
    if (tidx() == 0) {
        const int* cnt = (const int*)(p.ws + OFF_CTR) + CTR_MOE + l * 16;
        int b = 0, t = 0;
        for (int e = 0; e < 16; ++e) { const int c = cnt[e]; mm[e] = c; mm[16 + e] = b; mm[32 + e] = t; b += c; t += (c + 127) >> 7; }
        mm[48] = t;
    }
    __syncthreads();
}
DEV void phase_moe1(const Params& p, int l, char* smem) {
    bf16_t* sm = (bf16_t*)smem;
    const bf16_t* F = wsb(p, OFF_H);
    const bf16_t* W = wsb(p, OFF_WG1);
    bf16_t* ACT = wsb(p, OFF_P);
    const int* ltok = (const int*)(p.ws + OFF_LTOK);
    moe_map(p, l, smem); const int* mm = (const int*)(smem + MOE_MAP_OFF);
    const int nNt = 8, total = mm[48] * nNt;
    for (int item = bidx(); item < total; item += gridDim.x) {
        const int mtg = item / nNt, nt = item % nNt;
        int e = 0;
        for (int q = 1; q < 16; ++q) if (mtg >= mm[32 + q]) e = q;
        const int m0 = (mtg - mm[32 + e]) * 128, n0 = nt * 128, ce = mm[e];
        const int* lt = ltok + (size_t)e * TT;
        f32x16 acc[2][2]; acc_zero(acc);
        gemm_mainloop(acc, [&](int r) { int idx = m0 + r; idx = idx < ce ? idx : ce - 1; return F + (size_t)lt[idx] * 1024; },
                      [&](int r) { return W + ((size_t)e * 1024 + n0 + r) * 1024; }, 1024, sm);
        const int lane = tidx() & 63, wave = tidx() >> 6, wm = wave >> 1, wn = wave & 1;
        const int jcol = ((n0 >> 6) + wn) * 32 + (lane & 31);
#pragma unroll
        for (int a = 0; a < 2; ++a)
#pragma unroll
            for (int r = 0; r < 16; ++r) {
                const int idx = m0 + wm * 64 + a * 32 + (r & 3) + 8 * (r >> 2) + 4 * (lane >> 5);
                if (idx < ce) {
                    const float g = acc[a][0][r], u = acc[a][1][r];
                    ACT[(size_t)(mm[16 + e] + idx) * DFF + jcol] = f2bf(g * sigmoidf_(g) * u);
                }
            }
    }
}
DEV void phase_moe2(const Params& p, int l, char* smem) {
    bf16_t* sm = (bf16_t*)smem;
    const bf16_t* ACT = wsb(p, OFF_P);
    const bf16_t* W = wsb(p, OFF_WDN);
    bf16_t* Z = wsb(p, OFF_Z);
    moe_map(p, l, smem); const int* mm = (const int*)(smem + MOE_MAP_OFF);
    const int nNt = 8, total = mm[48] * nNt;
    for (int item = bidx(); item < total; item += gridDim.x) {
        const int mtg = item / nNt, nt = item % nNt;
        int e = 0;
        for (int q = 1; q < 16; ++q) if (mtg >= mm[32 + q]) e = q;
        const int m0 = (mtg - mm[32 + e]) * 128, n0 = nt * 128, ce = mm[e];
        f32x16 acc[2][2]; acc_zero(acc);
        gemm_mainloop(acc, [&](int r) { int idx = m0 + r; idx = idx < ce ? idx : ce - 1; return ACT + (size_t)(mm[16 + e] + idx) * DFF; },
                      [&](int r) { return W + ((size_t)e * 1024 + n0 + r) * DFF; }, DFF, sm);
        bf16_t* zb = Z + (size_t)mm[16 + e] * 1024;
        EPI_FOREACH(acc, { const int idx = m0 + er; if (idx < ce) zb[(size_t)idx * 1024 + n0 + ec] = f2bf(ev); })
    }
}
DEV void tok_seq(int t, int& base, int& n, int& len) {
    if (t < TL) { base = t & ~(SEQ - 1); n = t & (SEQ - 1); len = SEQ; } else { const int u = t - TL; base = TL + (u & ~(CTXL - 1)); n = u & (CTXL - 1); len = CTXL; }
}
DEV void phase_prep1(const Params& p, int l) {
    const int lane = tidx() & 63, wave = tidx() >> 6;
    bf16_t* P = wsb(p, OFF_P);
    bf16_t* XL = wsb(p, OFF_XL);
    const float* qkg = p.in[I_DAQKG] + l * 64;
    const float* cqg = p.in[I_MCQG] + l * 192;
    const float* ckvg = p.in[I_MCKVG] + l * 128;
    const float* mu3 = p.in[I_RMU] + (l * 4 + 3) * 256;
    for (int t = bidx() * 4 + wave; t < TT; t += gridDim.x * 4) {
        bf16_t* row = P + (size_t)t * LDP;
        int base, n, len; tok_seq(t, base, n, len);
        {
            const int d0 = (lane & 7) * 4;
            float cs[4], sn[4];
            const bool rot = t < TL;
            if (rot) {
                const float fr = (float)(n >> 6), fc = (float)(n & 63);
#pragma unroll
                for (int j = 0; j < 4; ++j) {
                    const int i = (d0 + j) & 15;
                    const float inv = exp2f(-(float)(i & 7) * (13.287712379549449f / 8.f));
                    const float ang = (i < 8 ? fr : fc) * inv;
                    cs[j] = cosf(ang); sn[j] = sinf(ang);
                }
            }
#pragma unroll
            for (int which = 0; which < 2; ++which) {
                bf16_t* ptr = row + (which ? C_DAK : C_DAQ) + lane * 4;
                const u32x2 raw = *(const u32x2*)ptr;
                float v[4] = { bflo(raw.x), bfhi(raw.x), bflo(raw.y), bfhi(raw.y) };
                float ss = v[0] * v[0] + v[1] * v[1] + v[2] * v[2] + v[3] * v[3];
                ss = group_sum<8>(ss);
                const float rstd = rsqrtf(ss * (1.f / 32.f) + EPS);
                const float* g = qkg + which * 32 + d0;
#pragma unroll
                for (int j = 0; j < 4; ++j) v[j] = v[j] * rstd * g[j];
                if (rot) {
#pragma unroll
                    for (int j = 0; j < 4; ++j) {
                        const float o = __shfl_xor(v[j], 4, 64);
                        v[j] = (d0 < 16) ? (v[j] * cs[j] - o * sn[j]) : (v[j] * cs[j] + o * sn[j]);
                    }
                }
                if (which == 0) {
                    const float qs = 0.17677669529663687f * LOG2E;
#pragma unroll
                    for (int j = 0; j < 4; ++j) v[j] *= qs;
                }
                u32x2 o; o.x = pack2(v[0], v[1]); o.y = pack2(v[2], v[3]);
                *(u32x2*)ptr = o;
            }
        }
        {
            float v[3]; float ss = 0.f;
#pragma unroll
            for (int j = 0; j < 3; ++j) { v[j] = bf2f(row[C_CQ + lane + j * 64]); ss += v[j] * v[j]; }
            ss = wave_sum(ss);
            const float rstd = rsqrtf(ss * (1.f / 192.f) + EPS);
#pragma unroll
            for (int j = 0; j < 3; ++j) row[C_CQ + lane + j * 64] = f2bf(v[j] * rstd * cqg[lane + j * 64]);
            float w[2]; float s2 = 0.f;
#pragma unroll
            for (int j = 0; j < 2; ++j) { w[j] = bf2f(row[C_CKV + lane + j * 64]); s2 += w[j] * w[j]; }
            s2 = wave_sum(s2);
            const float r2 = rsqrtf(s2 * (1.f / 128.f) + EPS);
#pragma unroll
            for (int j = 0; j < 2; ++j) row[C_CKV + lane + j * 64] = f2bf(w[j] * r2 * ckvg[lane + j * 64]);
        }
        {
            const int c = lane * 4;
            const u32x2 cur = *(const u32x2*)(row + C_RWD + c);
            u32x2 pv = (u32x2){0u, 0u}, nx = (u32x2){0u, 0u};
            if (n > 0) pv = *(const u32x2*)(row - LDP + C_RWD + c);
            if (n + 1 < len) nx = *(const u32x2*)(row + LDP + C_RWD + c);
            const float4 m = *(const float4*)(mu3 + c);
            float o[4];
            { const float x = bflo(cur.x); o[0] = x + (0.5f * (bflo(pv.x) + bflo(nx.x)) - x) * m.x; }
            { const float x = bfhi(cur.x); o[1] = x + (0.5f * (bfhi(pv.x) + bfhi(nx.x)) - x) * m.y; }
            { const float x = bflo(cur.y); o[2] = x + (0.5f * (bflo(pv.y) + bflo(nx.y)) - x) * m.z; }
            { const float x = bfhi(cur.y); o[3] = x + (0.5f * (bfhi(pv.y) + bfhi(nx.y)) - x) * m.w; }
            u32x2 ov; ov.x = pack2(o[0], o[1]); ov.y = pack2(o[2], o[3]);
            *(u32x2*)(XL + (size_t)t * 256 + c) = ov;
        }
    }
}

DEV void phase_prep_gemm1(const Params& p, int l, char* smem) {
    const bf16_t* P = wsb(p, OFF_P);
    const bf16_t* w = wsb(p, OFF_WSM) + (size_t)l * WS_PER_LAYER;
    bf16_t* QRAW = wsb(p, OFF_QRAW); bf16_t* KVRAW = wsb(p, OFF_KVRAW); bf16_t* LR = wsb(p, OFF_LR);
    int rot = 0;
    gemm_generic(P + C_CQ, LDP, TT, w + WS_UQT, 192, 192, 192, [&](int r, int c, float v) { QRAW[(size_t)r * 192 + c] = f2bf(v); }, smem, rot);
    rot += (TT / 128) * 2;
    gemm_generic(P + C_CKV, LDP, TT, w + WS_UKVT, 128, 384, 128, [&](int r, int c, float v) { KVRAW[(size_t)r * 384 + c] = f2bf(v); }, smem, rot);
    rot += (TT / 128) * 3;
    gemm_generic(wsb(p, OFF_XL), 256, TT, w + WS_W1C, 256, 192, 256,
                 [&](int r, int c, float v) { const float o = c < 64 ? tanhf(v) : (c < 128 ? v : sigmoidf_(v)); LR[(size_t)r * 192 + c] = f2bf(o); }, smem, rot);
}
DEV void phase_prep_gemm2(const Params& p, int l, char* smem) {
    const bf16_t* w = wsb(p, OFF_WSM) + (size_t)l * WS_PER_LAYER;
    const bf16_t* LR = wsb(p, OFF_LR);
    bf16_t* RWX = wsb(p, OFF_RWX);
    bf16_t* P = wsb(p, OFF_P);
    int rot = 0;
    for (int d = 0; d < 2; ++d) {
        const float* w0 = p.in[I_RW0] + (l * 2 + d) * 256;
        gemm_generic(LR + d * 32, 192, TT, w + WS_W2 + (size_t)d * 256 * 64, 64, 256, 64,
                     [&](int r, int c, float v) { RWX[(size_t)r * 1024 + d * 256 + c] = f2bf(0.6065306597126334f * sigmoidf_(w0[c] + v)); }, smem, rot);
        rot += (TT / 128) * 2;
        const float* a0 = p.in[I_RA0] + (l * 2 + d) * 256;
        gemm_generic(LR + 64 + d * 32, 192, TT, w + WS_W2 + (size_t)(2 + d) * 256 * 64, 64, 256, 64,
                     [&](int r, int c, float v) { RWX[(size_t)r * 1024 + 512 + d * 256 + c] = f2bf(sigmoidf_(a0[c] + v)); }, smem, rot);
        rot += (TT / 128) * 2;
    }
    gemm_generic(LR + 128, 192, TT, w + WS_G2T, 64, 256, 64, [&](int r, int c, float v) { P[(size_t)r * LDP + C_RWD + c] = f2bf(v); }, smem, rot);
}

DEV void phase_prep2(const Params& p, int l) {
    const int lane = tidx() & 63, wave = tidx() >> 6;
    const bf16_t* P = wsb(p, OFF_P);
    const bf16_t* QRAW = wsb(p, OFF_QRAW); const bf16_t* KVRAW = wsb(p, OFF_KVRAW);
    bf16_t* MQ = wsb(p, OFF_MLAQ); bf16_t* MK = wsb(p, OFF_MLAK); bf16_t* MV = wsb(p, OFF_MLAV);
    const float* qkg = p.in[I_MQKG] + l * 96;
    for (int t = bidx() * 4 + wave; t < TT; t += gridDim.x * 4) {
        int base, n, len; tok_seq(t, base, n, len);
        const int h = lane >> 4, j = lane & 15;
        const bool rot = t < TL;
        float cs = 1.f, sn = 0.f;
        if (rot) {
            const int i = j & 7;
            const float inv = exp2f(-(float)(i & 3) * (13.287712379549449f / 4.f));
            const float ang = (i < 4 ? (float)(n >> 6) : (float)(n & 63)) * inv;
            cs = cosf(ang); sn = sinf(ang);
        }
        {
            float v[3]; float ss = 0.f;
#pragma unroll
            for (int k = 0; k < 3; ++k) { v[k] = bf2f(QRAW[(size_t)t * 192 + h * 48 + j + k * 16]); ss += v[k] * v[k]; }
            ss = group_sum<16>(ss);
            const float rstd = rsqrtf(ss * (1.f / 48.f) + EPS);
#pragma unroll
            for (int k = 0; k < 3; ++k) v[k] = v[k] * rstd * qkg[j + k * 16];
            if (rot) { const float o = __shfl_xor(v[2], 8, 64); v[2] = (j < 8) ? (v[2] * cs - o * sn) : (v[2] * cs + o * sn); }
            const float qs = 0.14433756729740643f * LOG2E;
#pragma unroll
            for (int k = 0; k < 3; ++k) MQ[(size_t)t * 192 + h * 48 + j + k * 16] = f2bf(v[k] * qs);
        }
        {
            float v[3]; float ss = 0.f;
            v[0] = bf2f(KVRAW[(size_t)t * 384 + h * 96 + j]);
            v[1] = bf2f(KVRAW[(size_t)t * 384 + h * 96 + 16 + j]);
            v[2] = bf2f(P[(size_t)t * LDP + C_KR + j]);
#pragma unroll
            for (int k = 0; k < 3; ++k) ss += v[k] * v[k];
            ss = group_sum<16>(ss);
            const float rstd = rsqrtf(ss * (1.f / 48.f) + EPS);
#pragma unroll
            for (int k = 0; k < 3; ++k) v[k] = v[k] * rstd * qkg[48 + j + k * 16];
            if (rot) { const float o = __shfl_xor(v[2], 8, 64); v[2] = (j < 8) ? (v[2] * cs - o * sn) : (v[2] * cs + o * sn); }
#pragma unroll
            for (int k = 0; k < 3; ++k) MK[(size_t)t * 192 + h * 48 + j + k * 16] = f2bf(v[k]);
        }
#pragma unroll
        for (int k = 0; k < 4; ++k) MV[(size_t)t * 256 + h * 64 + j + k * 16] = KVRAW[(size_t)t * 384 + h * 96 + 32 + j + k * 16];
    }
}
template <int NC, int DK>
struct AttnCfg {
    static constexpr int DKROW = NC * DK, KLD = DKROW + 8, VLD = 68;
    static constexpr int KSTAGE = 64 * KLD, VSTAGE = 64 * VLD;
    static constexpr int KCH = 64 * DKROW / 8;
};
template <int NC, int DK, class EPI>
DEV void attn_item(const bf16_t* Q, int ldq, const bf16_t* Kl, const bf16_t* Kc, int ldk, const bf16_t* Vl, const bf16_t* Vc, int ldv,
                   int q0, int nlat_tiles, int nctx_tiles, EPI epi, char* smem) {
    using C = AttnCfg<NC, DK>;
    constexpr int KS = DK / 16;
    const int tid = tidx(), lane = tid & 63, wave = tid >> 6, ql = lane & 31, hh = lane >> 5;
    bf16_t* Ks = (bf16_t*)smem;
    bf16_t* Vt = Ks + 2 * C::KSTAGE;
    bf16x8 qf[NC][KS];
    {
        const bf16_t* qp = Q + (size_t)(q0 + wave * 32 + ql) * ldq + hh * 8;
#pragma unroll
        for (int c = 0; c < NC; ++c)
#pragma unroll
            for (int ks = 0; ks < KS; ++ks) qf[c][ks] = *(const bf16x8*)(qp + c * DK + ks * 16);
    }
    f32x16 O[NC][2];
    float mrun[NC], lrun[NC];
#pragma unroll
    for (int c = 0; c < NC; ++c) {
        mrun[c] = -1e30f; lrun[c] = 0.f;
#pragma unroll
        for (int d = 0; d < 2; ++d)
#pragma unroll
            for (int r = 0; r < 16; ++r) O[c][d][r] = 0.f;
    }
    const int ntiles = nlat_tiles + nctx_tiles;
    constexpr int KPT = (C::KCH + NT - 1) / NT;
    u32x4 rk[KPT], rv[2];
    auto load_tile = [&](int tile) {
        const bf16_t* kb = tile < nlat_tiles ? Kl + (size_t)tile * 64 * ldk : Kc + (size_t)(tile - nlat_tiles) * 64 * ldk;
        const bf16_t* vb = tile < nlat_tiles ? Vl + (size_t)tile * 64 * ldv : Vc + (size_t)(tile - nlat_tiles) * 64 * ldv;
#pragma unroll
        for (int i = 0; i < KPT; ++i) {
            int q = tid + i * NT; q = q < C::KCH ? q : C::KCH - 1;
            { const int key = q / (C::DKROW / 8), ch = q % (C::DKROW / 8); rk[i] = *(const u32x4*)(kb + (size_t)key * ldk + ch * 8); }
        }
#pragma unroll
        for (int i = 0; i < 2; ++i) { const int q = tid + i * NT; const int key = q >> 3, ch = q & 7; rv[i] = *(const u32x4*)(vb + (size_t)key * ldv + ch * 8); }
    };
    auto store_tile = [&](int st) {
#pragma unroll
        for (int i = 0; i < KPT; ++i) {
            const int q = tid + i * NT;
            if (q < C::KCH) { const int key = q / (C::DKROW / 8), ch = q % (C::DKROW / 8); *(u32x4*)(Ks + st * C::KSTAGE + key * C::KLD + ch * 8) = rk[i]; }
        }
#pragma unroll
        for (int i = 0; i < 2; ++i) {
            const int q = tid + i * NT; const int key = q >> 3, dv0 = (q & 7) * 8;
            bf16_t* vd = Vt + st * C::VSTAGE + dv0 * C::VLD + key;
            const unsigned w[4] = { rv[i][0], rv[i][1], rv[i][2], rv[i][3] };
#pragma unroll
            for (int j = 0; j < 4; ++j) { vd[(2 * j) * C::VLD] = (bf16_t)(w[j] & 0xFFFFu); vd[(2 * j + 1) * C::VLD] = (bf16_t)(w[j] >> 16); }
        }
    };
    load_tile(0);
    __syncthreads();
    store_tile(0);
    __syncthreads();
    for (int tile = 0; tile < ntiles; ++tile) {
        const int cur = tile & 1;
        if (tile + 1 < ntiles) load_tile(tile + 1);
        const bf16_t* ks_ = Ks + cur * C::KSTAGE;
        const bf16_t* vt_ = Vt + cur * C::VSTAGE;
#pragma unroll
        for (int c = 0; c < NC; ++c) {
            f32x16 S[2];
#pragma unroll
            for (int kb = 0; kb < 2; ++kb) {
#pragma unroll
                for (int r = 0; r < 16; ++r) S[kb][r] = 0.f;
#pragma unroll
                for (int ks = 0; ks < KS; ++ks) {
                    const bf16x8 kf = *(const bf16x8*)(ks_ + (kb * 32 + ql) * C::KLD + c * DK + ks * 16 + hh * 8);
                    S[kb] = __builtin_amdgcn_mfma_f32_32x32x16_bf16(kf, qf[c][ks], S[kb], 0, 0, 0);
                }
            }
            float mx = S[0][0];
#pragma unroll
            for (int kb = 0; kb < 2; ++kb)
#pragma unroll
                for (int r = 0; r < 16; ++r) mx = fmaxf(mx, S[kb][r]);
            mx = fmaxf(mx, __shfl_xor(mx, 32, 64));
            const float mnew = fmaxf(mrun[c], mx);
            const float alpha = __builtin_amdgcn_exp2f(mrun[c] - mnew);
            mrun[c] = mnew;
            float ls = 0.f;
#pragma unroll
            for (int kb = 0; kb < 2; ++kb)
#pragma unroll
                for (int r = 0; r < 16; ++r) { const float e = __builtin_amdgcn_exp2f(S[kb][r] - mnew); S[kb][r] = e; ls += e; }
            lrun[c] = lrun[c] * alpha + ls;
#pragma unroll
            for (int d = 0; d < 2; ++d)
#pragma unroll
                for (int r = 0; r < 16; ++r) O[c][d][r] *= alpha;
#pragma unroll
            for (int s = 0; s < 4; ++s) {
                const int kb = s >> 1, s2 = s & 1;
                const u32x4 pu = (u32x4){pack2(S[kb][8 * s2 + 0], S[kb][8 * s2 + 1]), pack2(S[kb][8 * s2 + 2], S[kb][8 * s2 + 3]),
                                         pack2(S[kb][8 * s2 + 4], S[kb][8 * s2 + 5]), pack2(S[kb][8 * s2 + 6], S[kb][8 * s2 + 7])};
                const bf16x8 pf = __builtin_bit_cast(bf16x8, pu);
                const int keyo = kb * 32 + 16 * s2 + 4 * hh;
#pragma unroll
                for (int d = 0; d < 2; ++d) {
                    const bf16_t* vp = vt_ + (d * 32 + ql) * C::VLD + keyo;
                    const u32x2 lo = *(const u32x2*)vp, hi = *(const u32x2*)(vp + 8);
                    const u32x4 vv = (u32x4){lo[0], lo[1], hi[0], hi[1]};
                    const bf16x8 vf = __builtin_bit_cast(bf16x8, vv);
                    O[c][d] = __builtin_amdgcn_mfma_f32_32x32x16_bf16(vf, pf, O[c][d], 0, 0, 0);
                }
            }
        }
        if (tile + 1 < ntiles) store_tile(cur ^ 1);
        __syncthreads();
    }
    float inv[NC];
#pragma unroll
    for (int c = 0; c < NC; ++c) { const float lt = lrun[c] + __shfl_xor(lrun[c], 32, 64); inv[c] = 1.f / lt; }
    epi(O, inv, q0 + wave * 32 + ql, hh);
}

DEV void da_item(const Params& p, int l, int item, char* smem) {
    const bf16_t* P = wsb(p, OFF_P);
    bf16_t* Y = wsb(p, OFF_Y);
    const float linit = 0.8f - 0.6f * __expf(-0.3f * (float)l);
    float lam;
    {
        const float* la = p.in[I_DALAM] + l * 128;
        const int lane = tidx() & 63;
        float a = lane < 32 ? la[lane] * la[32 + lane] : 0.f, b = lane < 32 ? la[64 + lane] * la[96 + lane] : 0.f;
        a = wave_sum(a); b = wave_sum(b);
        lam = __expf(a) - __expf(b) + linit;
    }
    const float* sg = p.in[I_DASUB] + l * 64;
    int b, h, qt; bool isctx;
    if (item < 512) { isctx = false; b = item >> 6; h = (item >> 4) & 3; qt = item & 15; }
    else { const int it = item - 512; isctx = true; b = it >> 3; h = (it >> 1) & 3; qt = it & 1; }
    const size_t lat0 = (size_t)b * SEQ, ctx0 = (size_t)TL + (size_t)b * CTXL;
    const size_t qrow0 = isctx ? ctx0 : lat0;
    float o1[2][16];
    auto epi0 = [&](f32x16 (&O)[1][2], float (&inv)[1], int qrow, int hh) {
#pragma unroll
        for (int d = 0; d < 2; ++d)
#pragma unroll
            for (int r = 0; r < 16; ++r) o1[d][r] = O[0][d][r] * inv[0];
    };
    auto epi1 = [&](f32x16 (&O)[1][2], float (&inv)[1], int qrow, int hh) {
        float v[2][16]; float ss = 0.f;
#pragma unroll
        for (int d = 0; d < 2; ++d)
#pragma unroll
            for (int r = 0; r < 16; ++r) { const float o = o1[d][r] - lam * O[0][d][r] * inv[0]; v[d][r] = o; ss += o * o; }
        ss += __shfl_xor(ss, 32, 64);
        const float rstd = rsqrtf(ss * (1.f / 64.f) + EPS) * (1.f - linit);
        bf16_t* yo = Y + (qrow0 + qrow) * 1024 + h * 64;
#pragma unroll
        for (int d = 0; d < 2; ++d)
#pragma unroll
            for (int g = 0; g < 4; ++g) {
                const int dv = d * 32 + 8 * g + 4 * hh;
                u32x2 o;
                o.x = pack2(v[d][4 * g + 0] * rstd * sg[dv + 0], v[d][4 * g + 1] * rstd * sg[dv + 1]);
                o.y = pack2(v[d][4 * g + 2] * rstd * sg[dv + 2], v[d][4 * g + 3] * rstd * sg[dv + 3]);
                *(u32x2*)(yo + dv) = o;
            }
    };
    const bf16_t* Qp = P + qrow0 * LDP + C_DAQ + h * 64;
    const bf16_t* Kl = P + lat0 * LDP + C_DAK + h * 64;
    const bf16_t* Kc = P + ctx0 * LDP + C_DAK + h * 64;
    const bf16_t* Vl = P + lat0 * LDP + C_DAV + h * 64;
    const bf16_t* Vc = P + ctx0 * LDP + C_DAV + h * 64;
    const int nlat = isctx ? 0 : SEQ / 64;
    attn_item<1, 32>(Qp, LDP, Kl, Kc, LDP, Vl, Vc, LDP, qt * 128, nlat, CTXL / 64, epi0, smem);
    attn_item<1, 32>(Qp + 32, LDP, Kl + 32, Kc + 32, LDP, Vl, Vc, LDP, qt * 128, nlat, CTXL / 64, epi1, smem);
}
DEV void mla_item(const Params& p, int l, int item, char* smem) {
    const bf16_t* MQ = wsb(p, OFF_MLAQ); const bf16_t* MK = wsb(p, OFF_MLAK); const bf16_t* MV = wsb(p, OFF_MLAV);
    bf16_t* Y = wsb(p, OFF_Y);
    int b, h, qt; bool isctx;
    if (item < 512) { isctx = false; b = item >> 6; h = (item >> 4) & 3; qt = item & 15; }
    else { const int it = item - 512; isctx = true; b = it >> 3; h = (it >> 1) & 3; qt = it & 1; }
    const size_t lat0 = (size_t)b * SEQ, ctx0 = (size_t)TL + (size_t)b * CTXL;
    const size_t qrow0 = isctx ? ctx0 : lat0;
    auto epi = [&](f32x16 (&O)[1][2], float (&inv)[1], int qrow, int hh) {
        bf16_t* yo = Y + (qrow0 + qrow) * 1024 + 512 + h * 64;
#pragma unroll
        for (int d = 0; d < 2; ++d)
#pragma unroll
            for (int g = 0; g < 4; ++g) {
                const int dv = d * 32 + 8 * g + 4 * hh;
                u32x2 o;
                o.x = pack2(O[0][d][4 * g + 0] * inv[0], O[0][d][4 * g + 1] * inv[0]);
                o.y = pack2(O[0][d][4 * g + 2] * inv[0], O[0][d][4 * g + 3] * inv[0]);
                *(u32x2*)(yo + dv) = o;
            }
    };
    const bf16_t* Qp = MQ + qrow0 * 192 + h * 48;
    const bf16_t* Kl = MK + lat0 * 192 + h * 48;
    const bf16_t* Kc = MK + ctx0 * 192 + h * 48;
    const bf16_t* Vl = MV + lat0 * 256 + h * 64;
    const bf16_t* Vc = MV + ctx0 * 256 + h * 64;
    attn_item<1, 48>(Qp, 192, Kl, Kc, 192, Vl, Vc, 256, qt * 128, isctx ? 0 : SEQ / 64, CTXL / 64, epi, smem);
}
DEV int s5_token(int b, int tb, int n) { return tb == 0 ? TL + b * CTXL + n : b * SEQ + (tb - 1) * 256 + n; }
struct S5Lane { float are, aim; float bre[16], bim[16]; };
DEV void s5_setup(const Params& p, int l, int d, int g, int pl, S5Lane& s) {
    const int gi = ((l * 2 + d) * 16 + g);
    const float lre = p.in[I_S5LRE][gi * 64 + pl], lim = p.in[I_S5LIM][gi * 64 + pl];
    const float dt = __expf(p.in[I_S5LDT][gi]);
    const float mag = __expf(lre * dt);
    s.are = mag * cosf(lim * dt); s.aim = mag * sinf(lim * dt);
    const float nr = s.are - 1.f, ni = s.aim, den = 1.f / (lre * lre + lim * lim);
    const float cr = (nr * lre + ni * lim) * den, ci = (ni * lre - nr * lim) * den;
    const float* br = p.in[I_S5BRE] + ((size_t)gi * 64 + pl) * 16;
    const float* bi = p.in[I_S5BIM] + ((size_t)gi * 64 + pl) * 16;
#pragma unroll
    for (int c = 0; c < 16; ++c) { const float x = br[c], y = bi[c]; s.bre[c] = cr * x - ci * y; s.bim[c] = cr * y + ci * x; }
}
template <bool DUMP>
DEV void s5_scan32(const S5Lane& s, float& hre, float& him, const float* ub, bf16_t* hb, int pl, bool rev) {
    for (int j = 0; j < 32; ++j) {
        const int rowi = rev ? 31 - j : j;
        const float4* u4 = (const float4*)(ub + rowi * 16);
        float bur = 0.f, bui = 0.f;
#pragma unroll
        for (int q = 0; q < 4; ++q) {
            const float4 u = u4[q];
            bur += u.x * s.bre[q * 4 + 0] + u.y * s.bre[q * 4 + 1] + u.z * s.bre[q * 4 + 2] + u.w * s.bre[q * 4 + 3];
            bui += u.x * s.bim[q * 4 + 0] + u.y * s.bim[q * 4 + 1] + u.z * s.bim[q * 4 + 2] + u.w * s.bim[q * 4 + 3];
        }
        const float nre = s.are * hre - s.aim * him + bur;
        const float nim = s.are * him + s.aim * hre + bui;
        hre = nre; him = nim;
        if (DUMP) { hb[rowi * 136 + pl] = f2bf(hre); hb[rowi * 136 + 64 + pl] = f2bf(him); }
    }
}
DEV void s5_load_u(const bf16_t* P, int b, int tb, int g, int sc, float* ub, int lane) {
    if (lane < 32) {
        const int t = s5_token(b, tb, sc * 32 + lane);
        const uint4* src = (const uint4*)(P + (size_t)t * LDP + C_S5 + g * 16);
        const uint4 a = src[0], c = src[1];
        float4* d = (float4*)(ub + lane * 16);
        d[0] = make_float4(bflo(a.x), bfhi(a.x), bflo(a.y), bfhi(a.y));
        d[1] = make_float4(bflo(a.z), bfhi(a.z), bflo(a.w), bfhi(a.w));
        d[2] = make_float4(bflo(c.x), bfhi(c.x), bflo(c.y), bfhi(c.y));
        d[3] = make_float4(bflo(c.z), bfhi(c.z), bflo(c.w), bfhi(c.w));
    }
}
DEV void phase_s5_pass1(const Params& p, int l, char* smem) {
    const int lane = tidx() & 63, wave = tidx() >> 6;
    float* ub = (float*)smem + wave * 512;
    const bf16_t* P = wsb(p, OFF_P);
    float* st = wsf(p, OFF_S5ST);
    const int nitems = 2 * 8 * 16 * 8;
    for (int it0 = bidx() * 4; it0 < nitems; it0 += gridDim.x * 4) {
        const int it = it0 + wave;
        const int seg = it & 7, g = (it >> 3) & 15, b = (it >> 7) & 7, d = it >> 10;
        const int tb = seg == 0 ? 0 : (d == 0 ? seg : 9 - seg);
        S5Lane s; s5_setup(p, l, d, g, lane, s);
        float hre = 0.f, him = 0.f;
        for (int k = 0; k < 8; ++k) {
            const int sc = d == 0 ? k : 7 - k;
            __syncthreads();
            s5_load_u(P, b, tb, g, sc, ub, lane);
            __syncthreads();
            s5_scan32<false>(s, hre, him, ub, nullptr, lane, d == 1);
        }
        float* o = st + ((((size_t)d * 8 + b) * 16 + g) * 8 + seg) * 128;
        o[lane] = hre; o[64 + lane] = him;
    }
}
DEV void s5_pass2_item(const Params& p, int l, int tb0, int bitem, char* smem) {
    const int lane = tidx() & 63, wave = tidx() >> 6;
    float* ub = (float*)smem + wave * 512;
    bf16_t* hb = (bf16_t*)(smem + 8192) + wave * (32 * 136);
    bf16_t* P = wsb(p, OFF_P);
    const float* st = wsf(p, OFF_S5ST);
    {
        const int it = bitem * 4 + wave;
        const int g = it & 15, b = (it >> 4) & 7, tb = (it >> 7) + tb0;
        f32x4 yacc[16];
#pragma unroll
        for (int i = 0; i < 16; ++i) yacc[i] = (f32x4){0.f, 0.f, 0.f, 0.f};
#pragma unroll
        for (int d = 0; d < 2; ++d) {
            S5Lane s; s5_setup(p, l, d, g, lane, s);
            bf16x8 cf[4];
            {
                const int gi = ((l * 2 + d) * 16 + g), c = lane & 15, kq = lane >> 4;
                const float* cre = p.in[I_S5CRE] + ((size_t)gi * 16 + c) * 64;
                const float* cim = p.in[I_S5CIM] + ((size_t)gi * 16 + c) * 64;
#pragma unroll
                for (int ks = 0; ks < 4; ++ks)
#pragma unroll
                    for (int j = 0; j < 8; ++j) {
                        const int k = ks * 32 + kq * 8 + j;
                        const float v = k < 64 ? cre[k] : -cim[k - 64];
                        cf[ks][j] = (short)f2bf(v);
                    }
            }
            const int seg = tb == 0 ? 0 : (d == 0 ? tb : 9 - tb);
            float hre = 0.f, him = 0.f;
            {
                float pr = s.are, pi = s.aim;
#pragma unroll
                for (int q = 0; q < 8; ++q) { const float nr = pr * pr - pi * pi, ni = 2.f * pr * pi; pr = nr; pi = ni; }
                const float* hs = st + (((size_t)d * 8 + b) * 16 + g) * 8 * 128;
                for (int i = 0; i < seg; ++i) {
                    const float er = hs[i * 128 + lane], ei = hs[i * 128 + 64 + lane];
                    const float nr = pr * hre - pi * him + er, ni = pr * him + pi * hre + ei;
                    hre = nr; him = ni;
                }
            }
#pragma unroll
            for (int k = 0; k < 8; ++k) {
                const int sc = d == 0 ? k : 7 - k;
                __syncthreads();
                s5_load_u(P, b, tb, g, sc, ub, lane);
                __syncthreads();
                s5_scan32<true>(s, hre, him, ub, hb, lane, d == 1);
                __syncthreads();
#pragma unroll
                for (int mt = 0; mt < 2; ++mt)
#pragma unroll
                    for (int ks = 0; ks < 4; ++ks) {
                        const bf16x8 af = *(const bf16x8*)(hb + (mt * 16 + (lane & 15)) * 136 + ks * 32 + (lane >> 4) * 8);
                        yacc[sc * 2 + mt] = __builtin_amdgcn_mfma_f32_16x16x32_bf16(af, cf[ks], yacc[sc * 2 + mt], 0, 0, 0);
                    }
            }
        }
        {
            const int c = lane & 15;
            const float dd = p.in[I_S5D][(l * 16 + g) * 16 + c];
#pragma unroll
            for (int tile = 0; tile < 16; ++tile)
#pragma unroll
                for (int r = 0; r < 4; ++r) {
                    const int n = tile * 16 + (lane >> 4) * 4 + r;
                    bf16_t* up = P + (size_t)s5_token(b, tb, n) * LDP + C_S5 + g * 16 + c;
                    const float y = dd * bf2f(*up) + yacc[tile][r];
                    const float z = 0.5f * y * (1.f + tanhf(0.7978845608028654f * (y + 0.044715f * y * y * y)));
                    *up = f2bf(z);
                }
        }
    }
}

DEV float row16_sum(float v) {
    v += __int_as_float(__builtin_amdgcn_mov_dpp(__float_as_int(v), 0x128, 0xf, 0xf, true));
    v += __int_as_float(__builtin_amdgcn_mov_dpp(__float_as_int(v), 0x124, 0xf, 0xf, true));
    v += __int_as_float(__builtin_amdgcn_mov_dpp(__float_as_int(v), 0x122, 0xf, 0xf, true));
    v += __int_as_float(__builtin_amdgcn_mov_dpp(__float_as_int(v), 0x121, 0xf, 0xf, true));
    return v;
}
constexpr int RW_CT = 16;
struct RwRaw { u32x2 r[3], k[3], v[3], sd, a; };
DEV void rw_item(const Params& p, int l, int item, char* smem) {
    const int tid = tidx(), li = tid >> 4, lc = tid & 15;
    const int ch = item >> 2, rg = item & 3, dir = ch >> 5, b = (ch >> 2) & 7, head = ch & 3;
    float* buf = (float*)smem;
    float* ybuf = buf + 2 * RW_CT * 384;
    const bf16_t* P = wsb(p, OFF_P);
    const bf16_t* RWX = wsb(p, OFF_RWX);
    bf16_t* RWY = wsb(p, OFF_RWY) + (size_t)dir * TT * 256;
    const int hc = head * 64 + lc * 4;
    const float4 mur = *(const float4*)(p.in[I_RMU] + (l * 4 + 0) * 256 + hc);
    const float4 muk = *(const float4*)(p.in[I_RMU] + (l * 4 + 1) * 256 + hc);
    const float4 muv = *(const float4*)(p.in[I_RMU] + (l * 4 + 2) * 256 + hc);
    const float4 kk4 = *(const float4*)(p.in[I_RKK] + l * 256 + hc);
    const float4 ka4 = *(const float4*)(p.in[I_RKA] + l * 256 + hc);
    const int NCH = (CTXL + SEQ) / RW_CT;
    auto tok_of = [&](int cidx, int i, int& n, int& len) -> int {
        if (cidx < CTXL / RW_CT) { const int pos = cidx * RW_CT + i; len = CTXL; n = dir == 0 ? pos : CTXL - 1 - pos; return TL + b * CTXL + n; }
        const int pos = (cidx - CTXL / RW_CT) * RW_CT + i; len = SEQ; n = dir == 0 ? pos : SEQ - 1 - pos; return b * SEQ + n;
    };
    auto load_raw = [&](int cidx, RwRaw& raw) {
        int n, len; const int t = tok_of(cidx, li, n, len);
        const bf16_t* row = P + (size_t)t * LDP;
        const u32x2 z = (u32x2){0u, 0u};
        const bool hp = n > 0, hn = n + 1 < len;
        raw.r[1] = *(const u32x2*)(row + C_RWR + hc); raw.k[1] = *(const u32x2*)(row + C_RWK + hc); raw.v[1] = *(const u32x2*)(row + C_RWV + hc);
        raw.r[0] = hp ? *(const u32x2*)(row - LDP + C_RWR + hc) : z; raw.k[0] = hp ? *(const u32x2*)(row - LDP + C_RWK + hc) : z; raw.v[0] = hp ? *(const u32x2*)(row - LDP + C_RWV + hc) : z;
        raw.r[2] = hn ? *(const u32x2*)(row + LDP + C_RWR + hc) : z; raw.k[2] = hn ? *(const u32x2*)(row + LDP + C_RWK + hc) : z; raw.v[2] = hn ? *(const u32x2*)(row + LDP + C_RWV + hc) : z;
        raw.sd = *(const u32x2*)(RWX + (size_t)t * 1024 + dir * 256 + hc);
        raw.a = *(const u32x2*)(RWX + (size_t)t * 1024 + 512 + dir * 256 + hc);
    };
    auto mix4 = [&](const u32x2 (&s)[3], const float4& mu, float (&o)[4]) {
        { const float x = bflo(s[1].x); o[0] = x + (0.5f * (bflo(s[0].x) + bflo(s[2].x)) - x) * mu.x; }
        { const float x = bfhi(s[1].x); o[1] = x + (0.5f * (bfhi(s[0].x) + bfhi(s[2].x)) - x) * mu.y; }
        { const float x = bflo(s[1].y); o[2] = x + (0.5f * (bflo(s[0].y) + bflo(s[2].y)) - x) * mu.z; }
        { const float x = bfhi(s[1].y); o[3] = x + (0.5f * (bfhi(s[0].y) + bfhi(s[2].y)) - x) * mu.w; }
    };
    auto stage = [&](int st, const RwRaw& raw) {
        float r4[4], k4[4], v4[4];
        mix4(raw.r, mur, r4); mix4(raw.k, muk, k4); mix4(raw.v, muv, v4);
        const float kkr[4] = { k4[0] * kk4.x, k4[1] * kk4.y, k4[2] * kk4.z, k4[3] * kk4.w };
        float nn = kkr[0] * kkr[0] + kkr[1] * kkr[1] + kkr[2] * kkr[2] + kkr[3] * kkr[3];
        nn = row16_sum(nn);
        const float rn = 1.f / fmaxf(sqrtf(nn), 1e-12f);
        const float a[4] = { bflo(raw.a.x), bfhi(raw.a.x), bflo(raw.a.y), bfhi(raw.a.y) };
        const float sd[4] = { bflo(raw.sd.x), bfhi(raw.sd.x), bflo(raw.sd.y), bfhi(raw.sd.y) };
        const float kav[4] = { ka4.x, ka4.y, ka4.z, ka4.w };
        float* d = buf + (st * RW_CT + li) * 384 + lc * 4;
        float wp[4], kp[4], bp[4], mp[4];
#pragma unroll
        for (int j = 0; j < 4; ++j) {
            wp[j] = __expf(-sd[j]);
            kp[j] = kkr[j] * rn;
            bp[j] = kp[j] * a[j];
            mp[j] = k4[j] * (1.f + (a[j] - 1.f) * kav[j]);
        }
        *(float4*)(d + 0) = make_float4(wp[0], wp[1], wp[2], wp[3]); *(float4*)(d + 64) = make_float4(kp[0], kp[1], kp[2], kp[3]);
        *(float4*)(d + 128) = make_float4(bp[0], bp[1], bp[2], bp[3]); *(float4*)(d + 192) = make_float4(mp[0], mp[1], mp[2], mp[3]);
        *(float4*)(d + 256) = make_float4(r4[0], r4[1], r4[2], r4[3]);
        *(float4*)(d + 320) = make_float4(v4[0], v4[1], v4[2], v4[3]);
    };
    float S0 = 0.f, S1 = 0.f, S2 = 0.f, S3 = 0.f;
    auto compute = [&](int cidx, int cur) {
        const float* cb = buf + cur * RW_CT * 384 + lc * 4;
        const float* vb = buf + cur * RW_CT * 384 + 320 + rg * 16 + li;
        float ykeep = 0.f;
        float4 w = *(const float4*)(cb), kk = *(const float4*)(cb + 64), bb = *(const float4*)(cb + 128), km = *(const float4*)(cb + 192), r = *(const float4*)(cb + 256);
        float vv = vb[0];
#pragma unroll
        for (int j = 0; j < RW_CT; ++j) {
            float4 nw = w, nkk = kk, nbb = bb, nkm = km, nr = r; float nvv = vv;
            if (j + 1 < RW_CT) {
                const float* nb = cb + (j + 1) * 384;
                nw = *(const float4*)(nb); nkk = *(const float4*)(nb + 64); nbb = *(const float4*)(nb + 128); nkm = *(const float4*)(nb + 192); nr = *(const float4*)(nb + 256);
                nvv = vb[(j + 1) * 384];
            }
            float sa = (S0 * kk.x + S1 * kk.y) + (S2 * kk.z + S3 * kk.w);
            const float t0 = S0 * w.x + vv * km.x, t1 = S1 * w.y + vv * km.y, t2 = S2 * w.z + vv * km.z, t3 = S3 * w.w + vv * km.w;
            sa = -row16_sum(sa);
            S0 = t0 + sa * bb.x; S1 = t1 + sa * bb.y; S2 = t2 + sa * bb.z; S3 = t3 + sa * bb.w;
            float y = (S0 * r.x + S1 * r.y) + (S2 * r.z + S3 * r.w);
            y = row16_sum(y);
            ykeep = (lc == j) ? y : ykeep;
            w = nw; kk = nkk; bb = nbb; km = nkm; r = nr; vv = nvv;
        }
        {
            int n, len; const int t = tok_of(cidx, lc, n, len);
            RWY[(size_t)t * 256 + head * 64 + rg * 16 + li] = f2bf(ykeep);
        }
    };
    RwRaw rawA, rawB;
    __syncthreads();
    load_raw(0, rawA);
    load_raw(1, rawB);
    stage(0, rawA);
    __syncthreads();
    for (int cidx = 0; cidx < NCH; cidx += 2) {
        if (cidx + 2 < NCH) load_raw(cidx + 2, rawA);
        compute(cidx, 0);
        stage(1, rawB);
        __syncthreads();
        if (cidx + 3 < NCH) load_raw(cidx + 3, rawB);
        compute(cidx + 1, 1);
        if (cidx + 2 < NCH) stage(0, rawA);
        __syncthreads();
    }
}
DEV void phase_s5_glu(const Params& p, int l, int M, char* smem) {
    const bf16_t* P = wsb(p, OFF_P);
    const bf16_t* w = wsb(p, OFF_WSM) + (size_t)l * WS_PER_LAYER + WS_GLUT;
    bf16_t* Y = wsb(p, OFF_Y);
    const float* bg = p.in[I_S5BGLU] + l * 256;
    gemm_generic(P + C_S5, LDP, M, w, 256, 256, 256,
                 [&](int r, int c, float v) { const float z = bf2f(P[(size_t)r * LDP + C_S5 + c]); Y[(size_t)r * 1024 + 256 + c] = f2bf(z * sigmoidf_(v + bg[c])); }, smem, 0);
}
DEV void phase_rw_finish(const Params& p, int l, int M) {
    const int lane = tidx() & 63, wave = tidx() >> 6;
    const bf16_t* P = wsb(p, OFF_P);
    const bf16_t* RWX = wsb(p, OFF_RWX);
    const bf16_t* RWY = wsb(p, OFF_RWY);
    bf16_t* Y = wsb(p, OFF_Y);
    const int c = lane * 4;
    const float4 mur = *(const float4*)(p.in[I_RMU] + (l * 4 + 0) * 256 + c);
    const float4 muk = *(const float4*)(p.in[I_RMU] + (l * 4 + 1) * 256 + c);
    const float4 muv = *(const float4*)(p.in[I_RMU] + (l * 4 + 2) * 256 + c);
    const float4 ka4 = *(const float4*)(p.in[I_RKA] + l * 256 + c);
    const float4 rk4 = *(const float4*)(p.in[I_RRK] + l * 256 + c);
    const float4 lg4 = *(const float4*)(p.in[I_RLNG] + l * 256 + c);
    const float4 lb4 = *(const float4*)(p.in[I_RLNB] + l * 256 + c);
    const float mr_[4] = { mur.x, mur.y, mur.z, mur.w }, mk_[4] = { muk.x, muk.y, muk.z, muk.w }, mv_[4] = { muv.x, muv.y, muv.z, muv.w };
    const float ka_[4] = { ka4.x, ka4.y, ka4.z, ka4.w }, rk_[4] = { rk4.x, rk4.y, rk4.z, rk4.w }, lg_[4] = { lg4.x, lg4.y, lg4.z, lg4.w }, lb_[4] = { lb4.x, lb4.y, lb4.z, lb4.w };
    for (int t = bidx() * 4 + wave; t < M; t += gridDim.x * 4) {
        int base, n, len; tok_seq(t, base, n, len);
        const bf16_t* row = P + (size_t)t * LDP;
        const bool hp = n > 0, hn = n + 1 < len;
        const u32x2 z = (u32x2){0u, 0u};
        float r4[4], k4[4], v4[4];
        {
            const u32x2 cu = *(const u32x2*)(row + C_RWR + c), pv = hp ? *(const u32x2*)(row - LDP + C_RWR + c) : z, nx = hn ? *(const u32x2*)(row + LDP + C_RWR + c) : z;
            const float x[4] = { bflo(cu.x), bfhi(cu.x), bflo(cu.y), bfhi(cu.y) }, a[4] = { bflo(pv.x), bfhi(pv.x), bflo(pv.y), bfhi(pv.y) }, b[4] = { bflo(nx.x), bfhi(nx.x), bflo(nx.y), bfhi(nx.y) };
#pragma unroll
            for (int j = 0; j < 4; ++j) r4[j] = x[j] + (0.5f * (a[j] + b[j]) - x[j]) * mr_[j];
        }
        {
            const u32x2 cu = *(const u32x2*)(row + C_RWK + c), pv = hp ? *(const u32x2*)(row - LDP + C_RWK + c) : z, nx = hn ? *(const u32x2*)(row + LDP + C_RWK + c) : z;
            const float x[4] = { bflo(cu.x), bfhi(cu.x), bflo(cu.y), bfhi(cu.y) }, a[4] = { bflo(pv.x), bfhi(pv.x), bflo(pv.y), bfhi(pv.y) }, b[4] = { bflo(nx.x), bfhi(nx.x), bflo(nx.y), bfhi(nx.y) };
#pragma unroll
            for (int j = 0; j < 4; ++j) k4[j] = x[j] + (0.5f * (a[j] + b[j]) - x[j]) * mk_[j];
        }
        {
            const u32x2 cu = *(const u32x2*)(row + C_RWV + c), pv = hp ? *(const u32x2*)(row - LDP + C_RWV + c) : z, nx = hn ? *(const u32x2*)(row + LDP + C_RWV + c) : z;
            const float x[4] = { bflo(cu.x), bfhi(cu.x), bflo(cu.y), bfhi(cu.y) }, a[4] = { bflo(pv.x), bfhi(pv.x), bflo(pv.y), bfhi(pv.y) }, b[4] = { bflo(nx.x), bfhi(nx.x), bflo(nx.y), bfhi(nx.y) };
#pragma unroll
            for (int j = 0; j < 4; ++j) v4[j] = x[j] + (0.5f * (a[j] + b[j]) - x[j]) * mv_[j];
        }
        const u32x2 af = *(const u32x2*)(RWX + (size_t)t * 1024 + 512 + c), ab = *(const u32x2*)(RWX + (size_t)t * 1024 + 768 + c);
        const float a0[4] = { bflo(af.x), bfhi(af.x), bflo(af.y), bfhi(af.y) }, a1[4] = { bflo(ab.x), bfhi(ab.x), bflo(ab.y), bfhi(ab.y) };
        const u32x2 yf = *(const u32x2*)(RWY + (size_t)t * 256 + c), yb = *(const u32x2*)(RWY + (size_t)TT * 256 + (size_t)t * 256 + c);
        float y[4] = { bflo(yf.x) + bflo(yb.x), bfhi(yf.x) + bfhi(yb.x), bflo(yf.y) + bflo(yb.y), bfhi(yf.y) + bfhi(yb.y) };
        float s = y[0] + y[1] + y[2] + y[3];
        s = group_sum<16>(s);
        const float mean = s * (1.f / 64.f);
        float q = 0.f, bon = 0.f;
#pragma unroll
        for (int j = 0; j < 4; ++j) {
            const float dlt = y[j] - mean; q += dlt * dlt;
            const float kmsum = k4[j] * (2.f + (a0[j] + a1[j] - 2.f) * ka_[j]);
            bon += r4[j] * kmsum * rk_[j];
        }
        q = group_sum<16>(q); bon = group_sum<16>(bon);
        const float rstd = rsqrtf(q * (1.f / 64.f) + 64e-5f);
        const u32x2 gg = *(const u32x2*)(row + C_RWD + c);
        const float g[4] = { bflo(gg.x), bfhi(gg.x), bflo(gg.y), bfhi(gg.y) };
        float o[4];
#pragma unroll
        for (int j = 0; j < 4; ++j) o[j] = ((y[j] - mean) * rstd * lg_[j] + lb_[j] + bon * v4[j]) * g[j];
        u32x2 ov; ov.x = pack2(o[0], o[1]); ov.y = pack2(o[2], o[3]);
        *(u32x2*)(Y + (size_t)t * 1024 + 768 + c) = ov;
    }
}

DEV int queue_next(int* ctr, char* smem) {
    int* slot = (int*)(smem + MOE_MAP_OFF + 208);
    __syncthreads();
    if (tidx() == 0) *slot = atomicAdd(ctr, 1);
    __syncthreads();
    return *slot;
}
DEV void phase_mixers(const Params& p, int l, int rep, char* smem) {
    const bool need_ctx = (l == 0);
    const int nrw = 256, nda = need_ctx ? 576 : 512, ns5 = 32 * (need_ctx ? 9 : 8);
    const int total = nrw + 2 * nda + (rep == 0 ? ns5 : 0);
    int* ctr = (int*)(p.ws + OFF_CTR) + CTR_Q + l * 16 + rep * 4;
    for (;;) {
        const int item = queue_next(ctr, smem);
        if (item >= total) break;
#ifndef PROBE7
#define PROBE7 0
#endif
        if (rep > 0 && PROBE7 == 1 && item >= nrw) break;
        if (rep > 0 && PROBE7 == 2 && item < nrw) continue;
        if (rep > 0 && PROBE7 == 3 && (item < nrw || item >= nrw + nda)) continue;
        if (item < nrw) rw_item(p, l, item, smem);
        else if (item < nrw + nda) da_item(p, l, item - nrw, smem);
        else if (item < nrw + 2 * nda) mla_item(p, l, item - nrw - nda, smem);
        else s5_pass2_item(p, l, need_ctx ? 0 : 1, item - nrw - 2 * nda, smem);
    }
}
#ifndef MEGA
#define MEGA 0
#endif
constexpr int NPHASE = 15;
template <int PH>
DEV void run_phase(const Params& p, int l, char* smem) {
    const bool need_ctx = (l == 0);
    const int M = need_ctx ? TT : TL;
    if constexpr (PH == 0) { phase_mod_partial(p, smem); __syncthreads(); phase_conv_small(p, smem); phase_conv_layer(p, 0, smem); phase_conv_experts(p, 0, smem); }
    if constexpr (PH == 1) { phase_mod_reduce(p); }
    if constexpr (PH == 2) { phase_norm<1>(p, l, TT, smem); if (l == 1) { phase_conv_layer(p, 1, smem); phase_conv_experts(p, 1, smem); } }
    if constexpr (PH == 3) { phase_inproj(p, l, smem); }
    if constexpr (PH == 4) { phase_prep1(p, l); phase_s5_pass1(p, l, smem); }
    if constexpr (PH == 5) { phase_prep_gemm1(p, l, smem); }
    if constexpr (PH == 6) { phase_prep_gemm2(p, l, smem); phase_prep2(p, l); }
    if constexpr (PH == 7) { phase_mixers(p, l, 0, smem); }
    if constexpr (PH == 8) { phase_s5_glu(p, l, M, smem); phase_rw_finish(p, l, M); }
    if constexpr (PH == 9) { phase_merge(p, l, M, smem); }
    if constexpr (PH == 10) { phase_outproj(p, l, M, smem); }
    if constexpr (PH == 11) { phase_norm<2>(p, l, M, smem); }
    if constexpr (PH == 14) { phase_route(p, l, M, smem); }
    if constexpr (PH == 15) { phase_combine(p, l, M); }
    if constexpr (PH == 12) { phase_moe1(p, l, smem); }
    if constexpr (PH == 13) { phase_moe2(p, l, smem); }
}

#if !MEGA
template <int PH>
__global__ void __launch_bounds__(NT, 2) k_phase(Params p, int l) {
    extern __shared__ __attribute__((aligned(16))) char smem[];
    run_phase<PH>(p, l, smem);
}
#endif
#ifndef REP0
#define REP0 1
#endif
#ifndef REP2
#define REP2 1
#endif
#ifndef REP3
#define REP3 1
#endif
#ifndef REP5
#define REP5 1
#endif
#ifndef REP6
#define REP6 1
#endif
#ifndef REP7
#define REP7 1
#endif
#ifndef REP8
#define REP8 1
#endif
#ifndef REP9
#define REP9 1
#endif
#ifndef REP12
#define REP12 1
#endif
#if MEGA
__global__ void __launch_bounds__(NT, 2) k_mega(Params p) {
    extern __shared__ __attribute__((aligned(16))) char smem[];
    uint4* xbw = (uint4*)(smem + MOE_MAP_OFF + 240);
    if (threadIdx.x == 0) *xbw = make_uint4(0u, 0u, 0u, 0u);
    __syncthreads();
    XcdBarrier bar = xcd_barrier_post((unsigned*)(p.ws + OFF_BAR), (volatile LAS unsigned*)xbw);
    for (int r = 0; r < REP0; ++r) { run_phase<0>(p, 0, smem); xcd_barrier(bar); }
    run_phase<1>(p, 0, smem); xcd_barrier(bar);
    for (int l = 0; l < 2; ++l) {
        for (int r = 0; r < REP2; ++r) { run_phase<2>(p, l, smem); xcd_barrier(bar); }
        for (int r = 0; r < REP3; ++r) { run_phase<3>(p, l, smem); xcd_barrier(bar); }
        run_phase<4>(p, l, smem); xcd_barrier(bar);
#ifdef PROBE_S5P1
        phase_s5_pass1(p, l, smem); xcd_barrier(bar);
#endif
#ifdef PROBE_BAR
        for (int r = 0; r < PROBE_BAR; ++r) xcd_barrier(bar);
#endif
        for (int r = 0; r < REP5; ++r) { run_phase<5>(p, l, smem); xcd_barrier(bar); }
        for (int r = 0; r < REP6; ++r) { run_phase<6>(p, l, smem); xcd_barrier(bar); }
        for (int r = 0; r < REP7; ++r) { phase_mixers(p, l, r, smem); xcd_barrier(bar); }
        for (int r = 0; r < REP8; ++r) { run_phase<8>(p, l, smem); xcd_barrier(bar); }
        for (int r = 0; r < REP9; ++r) { run_phase<9>(p, l, smem); xcd_barrier(bar); }
        run_phase<10>(p, l, smem); xcd_barrier(bar);

        run_phase<11>(p, l, smem); xcd_barrier(bar);
        run_phase<14>(p, l, smem); xcd_barrier(bar);
        for (int r = 0; r < REP12; ++r) { run_phase<12>(p, l, smem); xcd_barrier(bar); }
        run_phase<13>(p, l, smem); xcd_barrier(bar);
        run_phase<15>(p, l, smem); if (l == 0) xcd_barrier(bar);
    }
}
#endif
__global__ void __launch_bounds__(NT) k_fail(float* out, int n) {
    for (int i = blockIdx.x * NT + threadIdx.x; i < n; i += gridDim.x * NT) out[i] = __int_as_float(0x7fc00000);
}

template <int PH>
static void launch_phase(const Params& p, int l, int grid, hipStream_t stream) {
#if !MEGA
    static bool attr = false;
    if (!attr) { (void)hipFuncSetAttribute((const void*)k_phase<PH>, hipFuncAttributeMaxDynamicSharedMemorySize, SMEM_BYTES); attr = true; }
    hipLaunchKernelGGL(k_phase<PH>, dim3(grid), dim3(NT), SMEM_BYTES, stream, p, l);
#endif
}

extern "C" void kernel_launch(void* const* d_in, const int* in_sizes, int n_in, void* d_out, int out_size, void* d_ws, size_t ws_size, hipStream_t stream) {
    if (n_in != 48 || out_size != TL * DM || ws_size < WS_END) {
        hipLaunchKernelGGL(k_fail, dim3(256), dim3(NT), 0, stream, (float*)d_out, out_size);
        return;
    }
    Params p{};
    for (int i = 0; i < 48; ++i) p.in[i] = (const float*)d_in[i];
    p.out = (float*)d_out; p.ws = (char*)d_ws;
    (void)hipMemsetAsync(d_ws, 0, ZERO_BYTES, stream);
#if MEGA
    static int grid = 0;
    if (grid == 0) {
        int dev = 0, cus = 0, per_cu = 0;
        (void)hipGetDevice(&dev);
        (void)hipDeviceGetAttribute(&cus, hipDeviceAttributeMultiprocessorCount, dev);
        (void)hipFuncSetAttribute((const void*)k_mega, hipFuncAttributeMaxDynamicSharedMemorySize, SMEM_BYTES);
        if (hipOccupancyMaxActiveBlocksPerMultiprocessor(&per_cu, (const void*)k_mega, NT, SMEM_BYTES) != hipSuccess || per_cu < 1) per_cu = 1;
        (void)hipGetLastError();
        if (cus <= 0) cus = 256;
        grid = cus * (per_cu < 2 ? per_cu : 2);
    }
    hipLaunchKernelGGL(k_mega, dim3(grid), dim3(NT), SMEM_BYTES, stream, p);
#else
    const int grid = 512;
    launch_phase<0>(p, 0, grid, stream);
    launch_phase<1>(p, 0, grid, stream);
    for (int l = 0; l < 2; ++l) {
        launch_phase<2>(p, l, grid, stream);
        launch_phase<3>(p, l, grid, stream);
        launch_phase<4>(p, l, grid, stream);
        launch_phase<5>(p, l, grid, stream);
        launch_phase<6>(p, l, grid, stream);
        launch_phase<7>(p, l, grid, stream);
        launch_phase<8>(p, l, grid, stream);
        launch_phase<9>(p, l, grid, stream);
        launch_phase<10>(p, l, grid, stream);
        launch_phase<11>(p, l, grid, stream);
        launch_phase<14>(p, l, grid, stream);
        launch_phase<12>(p, l, grid, stream);
        launch_phase<13>(p, l, grid, stream);
        launch_phase<15>(p, l, grid, stream);
    }
#endif
}
```

```cpp
#define MEGA 1
#include <hip/hip_runtime.h>
#include <stdint.h>
#include <math.h>

#define DEV __device__ __forceinline__
#define LAS __attribute__((address_space(3)))
typedef unsigned short bf16_t;
typedef short bf16x8 __attribute__((ext_vector_type(8)));
typedef float f32x16 __attribute__((ext_vector_type(16)));
typedef float f32x4 __attribute__((ext_vector_type(4)));
typedef unsigned u32x4 __attribute__((ext_vector_type(4)));
typedef unsigned u32x2 __attribute__((ext_vector_type(2)));

constexpr int NT = 256;
constexpr int DM = 1024, NB = 8, SEQ = 2048, CTXL = 256, GRIDW = 64;
constexpr int TL = NB * SEQ, TC = NB * CTXL, TT = TL + TC;
constexpr int NIN = 6480, LDP = 2432, NINP = 6528, NGATE0 = 2432;
constexpr int C_DAQ = 0, C_DAK = 256, C_DAV = 512, C_S5 = 768, C_CQ = 1024, C_CKV = 1216, C_KR = 1344,
              C_RWR = 1360, C_RWK = 1616, C_RWV = 1872, C_RWD = 2128, C_PEND = 2384;
constexpr int NEXP = 16, DFF = 512;
constexpr float EPS = 1e-6f;
constexpr float LOG2E = 1.4426950408889634f;

constexpr size_t al256(size_t x) { return (x + 255) & ~(size_t)255; }
constexpr size_t OFF_BAR  = 0;
constexpr size_t OFF_CTR  = 16384;
constexpr size_t ZERO_BYTES = 20480;
constexpr size_t OFF_MOD  = 32768;
constexpr size_t SZ_MOD   = (size_t)2 * 9 * 6144 * 4;
constexpr int    MOD_KS   = 8;
constexpr size_t OFF_MODP = al256(OFF_MOD + SZ_MOD);
constexpr size_t OFF_S5ST = al256(OFF_MODP + MOD_KS * SZ_MOD);
constexpr size_t OFF_LTOK = al256(OFF_S5ST + (size_t)2 * 8 * 16 * 8 * 64 * 2 * 4);
constexpr size_t OFF_LW   = al256(OFF_LTOK + (size_t)NEXP * TT * 4);
constexpr size_t OFF_TOKI = al256(OFF_LW + (size_t)NEXP * TT * 4);
constexpr size_t OFF_TOKW = al256(OFF_TOKI + (size_t)TT * 16);
constexpr size_t OFF_CNTB = al256(OFF_TOKW + (size_t)TT * 8);
constexpr size_t OFF_WSM  = al256(OFF_CNTB + (size_t)1024 * 16 * 4);
constexpr int WS_GLUT = 0, WS_UQT = WS_GLUT + 256 * 256, WS_UKVT = WS_UQT + 192 * 192, WS_W1C = WS_UKVT + 384 * 128,
              WS_W2 = WS_W1C + 192 * 256, WS_G2T = WS_W2 + 4 * 256 * 64, WS_PER_LAYER = WS_G2T + 256 * 64;
constexpr size_t OFF_WIN  = al256(OFF_WSM + (size_t)2 * WS_PER_LAYER * 2);
constexpr size_t OFF_WBR  = al256(OFF_WIN + (size_t)NINP * 1024 * 2);
constexpr size_t OFF_WOUT = al256(OFF_WBR + (size_t)4 * 1024 * 256 * 2);
constexpr size_t OFF_WG1  = al256(OFF_WOUT + (size_t)1024 * 1024 * 2);
constexpr size_t OFF_WDN  = al256(OFF_WG1 + (size_t)NEXP * 1024 * 1024 * 2);
constexpr size_t OFF_H    = al256(OFF_WDN + (size_t)NEXP * 1024 * 512 * 2);
constexpr size_t OFF_P    = al256(OFF_H + (size_t)TT * 1024 * 2);
constexpr size_t OFF_GATE = al256(OFF_P + (size_t)TT * LDP * 2);
constexpr size_t OFF_MLAQ = al256(OFF_GATE + (size_t)TT * 4096);
constexpr size_t OFF_MLAK = al256(OFF_MLAQ + (size_t)TT * 192 * 2);
constexpr size_t OFF_MLAV = al256(OFF_MLAK + (size_t)TT * 192 * 2);
constexpr size_t OFF_RWX  = al256(OFF_MLAV + (size_t)TT * 256 * 2);
constexpr size_t OFF_Y    = al256(OFF_RWX + (size_t)TT * 1024 * 2);
constexpr size_t OFF_CX   = al256(OFF_Y + (size_t)TT * 1024 * 2);
constexpr size_t WS_END   = al256(OFF_CX + (size_t)TC * 1024 * 4);
constexpr size_t OFF_QRAW = OFF_Y;
constexpr size_t OFF_KVRAW = OFF_QRAW + (size_t)TT * 192 * 2;
constexpr size_t OFF_LR   = OFF_KVRAW + (size_t)TT * 384 * 2;
constexpr size_t OFF_XL   = OFF_LR + (size_t)TT * 192 * 2;
constexpr size_t OFF_Z    = OFF_GATE;
static_assert(OFF_XL + (size_t)TT * 256 * 2 <= OFF_Y + (size_t)TT * 1024 * 2, "temps overflow Y");
constexpr size_t OFF_RWY  = OFF_H;

constexpr int CTR_MOE = 0;
constexpr int CTR_Q   = 64;

constexpr int SMEM_BYTES = 73728 + 256;

struct Params {
    const float* in[48];
    float* out;
    char* ws;
};
enum { I_X = 0, I_C, I_CTX, I_CCTX, I_WADA, I_BADA, I_NMG, I_NFG, I_WIN, I_DAQKG, I_DALAM, I_DASUB,
       I_S5LRE, I_S5LIM, I_S5LDT, I_S5BRE, I_S5BIM, I_S5CRE, I_S5CIM, I_S5D, I_S5WGLU, I_S5BGLU,
       I_MCQG, I_MCKVG, I_MWUQ, I_MWUKV, I_MQKG,
       I_RMU, I_RW0, I_RW1, I_RW2, I_RA0, I_RA1, I_RA2, I_RG1, I_RG2, I_RKK, I_RKA, I_RRK, I_RLNG, I_RLNB,
       I_WBR, I_WOUT, I_ROUTW, I_ROUTB, I_EWG, I_EWU, I_EWD };

DEV int tidx() { int t = threadIdx.x; asm volatile("" : "+v"(t)); return t; }
DEV int bidx() { int b = blockIdx.x; asm volatile("" : "+s"(b)); return b; }
typedef float f32x2_ __attribute__((ext_vector_type(2)));
typedef __bf16 bf16x2_ __attribute__((ext_vector_type(2)));
DEV unsigned cvt_pk_bf16(float lo, float hi) { const f32x2_ v = {lo, hi}; const bf16x2_ b = __builtin_convertvector(v, bf16x2_); return __builtin_bit_cast(unsigned, b); }
DEV bf16_t f2bf(float f) { return (bf16_t)(cvt_pk_bf16(f, 0.f) & 0xFFFFu); }
DEV float bf2f(bf16_t h) { return __uint_as_float(((unsigned)h) << 16); }
DEV unsigned pack2(float lo, float hi) { return cvt_pk_bf16(lo, hi); }
DEV float bflo(unsigned u) { return __uint_as_float(u << 16); }
DEV float bfhi(unsigned u) { return __uint_as_float(u & 0xFFFF0000u); }
DEV float sigmoidf_(float x) { return 1.f / (1.f + __expf(-x)); }
DEV float wave_sum(float v) {
#pragma unroll
    for (int o = 32; o >= 1; o >>= 1) v += __shfl_xor(v, o, 64);
    return v;
}
template <int W> DEV float group_sum(float v) {
#pragma unroll
    for (int o = W / 2; o >= 1; o >>= 1) v += __shfl_xor(v, o, 64);
    return v;
}
DEV int mod_row(int t) { return t < TL ? (t >> 11) : 8; }
DEV bf16_t* wsb(const Params& p, size_t off) { return (bf16_t*)(p.ws + off); }
DEV float* wsf(const Params& p, size_t off) { return (float*)(p.ws + off); }
DEV const float* modp(const Params& p, int l, int row, int which) { return (const float*)(p.ws + OFF_MOD) + ((size_t)(l * 9 + row) * 6 + which) * 1024; }
#define XB_TMO      128
#define XB_XCNT(j)  (256  + 64 * (j))
#define XB_XSUB(j)  (1280 + 64 * (j))
#define XB_XGEN(j)  (2304 + 64 * (j))
#define XB_TOP      3328
#define XB_TOPGEN   3392
#define XCD_BAR_WORDS 3456
#define XB_SPIN_CAP (1u << 18)

__device__ __forceinline__ unsigned xb_ld(unsigned* p)              { return __hip_atomic_load(p, __ATOMIC_RELAXED, __HIP_MEMORY_SCOPE_AGENT); }
__device__ __forceinline__ unsigned xb_add(unsigned* p, unsigned v) { return __hip_atomic_fetch_add(p, v, __ATOMIC_RELAXED, __HIP_MEMORY_SCOPE_AGENT); }
__device__ __forceinline__ unsigned xb_xcc_id() { return (unsigned)__builtin_amdgcn_s_getreg((3 << 11) | 20) & 0xFu; }
#define XB_SPIN(cond, bar) do { unsigned _sp = 0; while (cond) { __builtin_amdgcn_s_sleep(1); \
    if ((++_sp & 255u) == 0u) { if (xb_ld(&(bar)[XB_TMO])) break; if (_sp > XB_SPIN_CAP) { atomicAdd(&(bar)[XB_TMO], 1u); break; } } } } while (0)

struct XcdBarrier {
    unsigned* bar; unsigned x;
    volatile LAS unsigned* st;
};

__device__ __forceinline__ XcdBarrier xcd_barrier_post(unsigned* bar, volatile LAS unsigned* st) {
    XcdBarrier b; b.bar = bar; b.x = xb_xcc_id(); b.st = st;
    if (threadIdx.x == 0) (void)xb_add(&bar[XB_XCNT(b.x)], 1u);
    return b;
}
__device__ __forceinline__ void xcd_barrier_complete(unsigned* bar, unsigned x, unsigned& nloc, unsigned& nx) {
    const unsigned G = gridDim.x * gridDim.y * gridDim.z;
    unsigned sum, cnt, mine, sp = 0u;
    for (;;) {
        sum = 0u; cnt = 0u; mine = 0u;
#pragma unroll
        for (unsigned j = 0; j < 16; ++j) { const unsigned c = xb_ld(&bar[XB_XCNT(j)]); sum += c; cnt += (c > 0u) ? 1u : 0u; mine = (j == x) ? c : mine; }
        if (sum == G) break;
        __builtin_amdgcn_s_sleep(1);
        if ((++sp & 255u) == 0u) { if (xb_ld(&bar[XB_TMO])) break; if (sp > XB_SPIN_CAP) { atomicAdd(&bar[XB_TMO], 1u); break; } }
    }
    nloc = mine > 0u ? mine : 1u; nx = cnt > 0u ? cnt : 1u;
}

__device__ __forceinline__ void xcd_barrier(const XcdBarrier& b) {
    asm volatile("s_waitcnt vmcnt(0)" ::: "memory");
    __syncthreads();
    if (threadIdx.x == 0) {
        unsigned* bar = b.bar;
        __builtin_amdgcn_s_waitcnt(0);
        unsigned nloc = b.st[0], nx = b.st[1];
        if (nloc == 0u) { xcd_barrier_complete(bar, b.x, nloc, nx); b.st[0] = nloc; b.st[1] = nx; }
        const unsigned old = xb_add(&bar[XB_XSUB(b.x)], 1u);
        const unsigned gen = old / nloc;
        if (old + 1u == (gen + 1u) * nloc) {
            __builtin_amdgcn_fence(__ATOMIC_RELEASE, "agent");
            asm volatile("s_waitcnt vmcnt(0)" ::: "memory");
            const unsigned og = xb_add(&bar[XB_TOP], 1u);
            const unsigned tg = og / nx;
            if (og + 1u == (tg + 1u) * nx) xb_add(&bar[XB_TOPGEN], 1u);
            else XB_SPIN(xb_ld(&bar[XB_TOPGEN]) == tg, bar);
            __builtin_amdgcn_fence(__ATOMIC_ACQUIRE, "agent");
            xb_add(&bar[XB_XGEN(b.x)], 1u);
            asm volatile("s_waitcnt vmcnt(0)" ::: "memory");
        } else {
            XB_SPIN(xb_ld(&bar[XB_XGEN(b.x)]) == gen, bar);
            __builtin_amdgcn_fence(__ATOMIC_ACQUIRE, "agent");
            asm volatile("s_waitcnt vmcnt(0)" ::: "memory");
        }
    }
    __syncthreads();
}

DEV void phase_mod_partial(const Params& p, char* smem) {
    float* sm = (float*)smem;
    const int tid = tidx();
    const int nitems = 2 * 24 * MOD_KS;
    for (int item = bidx(); item < nitems; item += gridDim.x) {
        const int l = item / (24 * MOD_KS), rem = item % (24 * MOD_KS), jc = rem / MOD_KS, ks = rem % MOD_KS;
        __syncthreads();
        for (int i = tid; i < 9 * 128; i += NT) {
            const int r = i >> 7, k = ks * 128 + (i & 127);
            const float cv = r < 8 ? p.in[I_C][r * 1024 + k] : p.in[I_CCTX][k];
            sm[i] = cv / (1.f + __expf(-cv));
        }
        __syncthreads();
        const int j = jc * 256 + tid;
        float acc[9];
#pragma unroll
        for (int r = 0; r < 9; ++r) acc[r] = 0.f;
        const float* w = p.in[I_WADA] + (size_t)l * 1024 * 6144 + (size_t)(ks * 128) * 6144 + j;
#pragma unroll 8
        for (int k = 0; k < 128; ++k) {
            const float wv = w[(size_t)k * 6144];
#pragma unroll
            for (int r = 0; r < 9; ++r) acc[r] += sm[r * 128 + k] * wv;
        }
        float* dst = wsf(p, OFF_MODP);
#pragma unroll
        for (int r = 0; r < 9; ++r) dst[((size_t)(ks * 2 + l) * 9 + r) * 6144 + j] = acc[r];
    }
}
DEV void phase_mod_reduce(const Params& p) {
    const int n = 2 * 9 * 6144;
    float* mod = wsf(p, OFF_MOD);
    const float* part = wsf(p, OFF_MODP);
    for (int i = bidx() * NT + tidx(); i < n; i += gridDim.x * NT) {
        const int l = i / (9 * 6144), j = i % 6144;
        float s = p.in[I_BADA][l * 6144 + j];
#pragma unroll
        for (int ks = 0; ks < MOD_KS; ++ks) s += part[(size_t)ks * n + i];
        mod[i] = s;
    }
}

template <int MODE>
DEV void conv_tile(const float* src, int R, int C, int ld, bf16_t* dst, int ldd, int roff, int tr, int tc, float* sm) {
    const int r0 = tr * 64, c0 = tc * 64, tid = tidx();
    for (int i = tid; i < 64 * 16; i += NT) {
        const int r = i >> 4, c4 = (i & 15) * 4;
        float4 v = make_float4(0.f, 0.f, 0.f, 0.f);
        if (r0 + r < R) {
            const float* s = src + (size_t)(r0 + r) * ld + c0 + c4;
            if (c0 + c4 + 3 < C) v = *(const float4*)s;
            else { if (c0 + c4 < C) v.x = s[0]; if (c0 + c4 + 1 < C) v.y = s[1]; if (c0 + c4 + 2 < C) v.z = s[2]; }
        }
        float* d = sm + r * 65 + c4;
        d[0] = v.x; d[1] = v.y; d[2] = v.z; d[3] = v.w;
    }
    __syncthreads();
    for (int i = tid; i < 64 * 8; i += NT) {
        const int c = i >> 3, r8 = (i & 7) * 8;
        if (c0 + c < C && r0 + r8 < R) {
            const int cc = c0 + c;
            const int drow = (MODE == 0) ? (cc + roff) : ((cc >> 5) * 64 + (cc & 31) + roff);
            uint4 o;
            o.x = pack2(sm[(r8 + 0) * 65 + c], sm[(r8 + 1) * 65 + c]);
            o.y = pack2(sm[(r8 + 2) * 65 + c], sm[(r8 + 3) * 65 + c]);
            o.z = pack2(sm[(r8 + 4) * 65 + c], sm[(r8 + 5) * 65 + c]);
            o.w = pack2(sm[(r8 + 6) * 65 + c], sm[(r8 + 7) * 65 + c]);
            *(uint4*)(dst + (size_t)drow * ldd + r0 + r8) = o;
        }
    }
    __syncthreads();
}
template <int MODE>
DEV void conv_job(const float* src, int R, int C, int ld, bf16_t* dst, int ldd, int roff, int& rot, float* sm) {
    const int ntr = (R + 63) >> 6, ntc = (C + 63) >> 6, nt = ntr * ntc, G = gridDim.x;
    int first = (bidx() - (rot % G) + G) % G;
    for (int t = first; t < nt; t += G) conv_tile<MODE>(src, R, C, ld, dst, ldd, roff, t / ntc, t % ntc, sm);
    rot += nt;
}
DEV void phase_conv_layer(const Params& p, int l, char* smem) {
    float* sm = (float*)smem;
    int rot = 0;
    const float* win = p.in[I_WIN] + (size_t)l * 1024 * NIN;
    conv_job<0>(win, 1024, C_PEND, NIN, wsb(p, OFF_WIN), 1024, 0, rot, sm);
    conv_job<0>(win + C_PEND, 1024, 4096, NIN, wsb(p, OFF_WIN), 1024, NGATE0, rot, sm);
    {
        uint4* z = (uint4*)(wsb(p, OFF_WIN) + (size_t)C_PEND * 1024);
        const int n = (NGATE0 - C_PEND) * 1024 / 8;
        for (int i = bidx() * NT + tidx(); i < n; i += gridDim.x * NT) z[i] = make_uint4(0u, 0u, 0u, 0u);
    }
    for (int i = 0; i < 4; ++i)
        conv_job<0>(p.in[I_WBR] + (size_t)(l * 4 + i) * 256 * 1024, 256, 1024, 1024, wsb(p, OFF_WBR) + (size_t)i * 1024 * 256, 256, 0, rot, sm);
    conv_job<0>(p.in[I_WOUT] + (size_t)l * 1024 * 1024, 1024, 1024, 1024, wsb(p, OFF_WOUT), 1024, 0, rot, sm);
}
DEV void phase_conv_experts(const Params& p, int l, char* smem) {
    float* sm = (float*)smem;
    int rot = 0;
    for (int e = 0; e < NEXP; ++e) {
        conv_job<1>(p.in[I_EWG] + (size_t)(l * NEXP + e) * 1024 * DFF, 1024, DFF, DFF, wsb(p, OFF_WG1) + (size_t)e * 1024 * 1024, 1024, 0, rot, sm);
        conv_job<1>(p.in[I_EWU] + (size_t)(l * NEXP + e) * 1024 * DFF, 1024, DFF, DFF, wsb(p, OFF_WG1) + (size_t)e * 1024 * 1024, 1024, 32, rot, sm);
        conv_job<0>(p.in[I_EWD] + (size_t)(l * NEXP + e) * DFF * 1024, DFF, 1024, 1024, wsb(p, OFF_WDN) + (size_t)e * 1024 * DFF, DFF, 0, rot, sm);
    }
}
DEV void phase_conv_small(const Params& p, char* smem) {
    float* sm = (float*)smem;
    int rot = 0;
    for (int l = 0; l < 2; ++l) {
        bf16_t* w = wsb(p, OFF_WSM) + (size_t)l * WS_PER_LAYER;
        for (int i = bidx() * NT + tidx(); i < 4 * 256 * 4; i += gridDim.x * NT)
            *(u32x4*)(w + WS_W2 + (size_t)(i >> 2) * 64 + 32 + (i & 3) * 8) = (u32x4){0u, 0u, 0u, 0u};
        conv_job<0>(p.in[I_S5WGLU] + (size_t)l * 256 * 256, 256, 256, 256, w + WS_GLUT, 256, 0, rot, sm);
        conv_job<0>(p.in[I_MWUQ] + (size_t)l * 192 * 192, 192, 192, 192, w + WS_UQT, 192, 0, rot, sm);
        conv_job<0>(p.in[I_MWUKV] + (size_t)l * 128 * 384, 128, 384, 384, w + WS_UKVT, 128, 0, rot, sm);
        for (int d = 0; d < 2; ++d) {
            conv_job<0>(p.in[I_RW1] + (size_t)(l * 2 + d) * 256 * 32, 256, 32, 32, w + WS_W1C, 256, d * 32, rot, sm);
            conv_job<0>(p.in[I_RA1] + (size_t)(l * 2 + d) * 256 * 32, 256, 32, 32, w + WS_W1C, 256, 64 + d * 32, rot, sm);
            conv_job<0>(p.in[I_RW2] + (size_t)(l * 2 + d) * 32 * 256, 32, 256, 256, w + WS_W2 + (size_t)d * 256 * 64, 64, 0, rot, sm);
            conv_job<0>(p.in[I_RA2] + (size_t)(l * 2 + d) * 32 * 256, 32, 256, 256, w + WS_W2 + (size_t)(2 + d) * 256 * 64, 64, 0, rot, sm);
        }
        conv_job<0>(p.in[I_RG1] + (size_t)l * 256 * 64, 256, 64, 64, w + WS_W1C, 256, 128, rot, sm);
        conv_job<0>(p.in[I_RG2] + (size_t)l * 64 * 256, 64, 256, 256, w + WS_G2T, 64, 0, rot, sm);
    }
}

template <int WHICH>
DEV void phase_norm(const Params& p, int l, int nrows, char* smem) {
    const int lane = tidx() & 63, wave = tidx() >> 6;
    const float* xs = (l == 0) ? p.in[I_X] : p.out;
    const float* cs = (l == 0) ? p.in[I_CTX] : wsf(p, OFF_CX);
    const float* g = p.in[WHICH == 1 ? I_NMG : I_NFG] + l * 1024;
    bf16_t* H = wsb(p, OFF_H);
    if (WHICH == 2) { xs = p.out; cs = wsf(p, OFF_CX); }
    const int tpb = (nrows + (int)gridDim.x - 1) / (int)gridDim.x;
    const int rbeg = WHICH == 2 ? bidx() * tpb + wave : bidx() * 4 + wave;
    const int rend = WHICH == 2 ? min(nrows, (bidx() + 1) * tpb) : nrows;
    const int rstep = WHICH == 2 ? 4 : (int)gridDim.x * 4;
    int* sel = (int*)smem;
    for (int row = rbeg; row < rend; row += rstep) {
        const float* src = row < TL ? xs + (size_t)row * 1024 : cs + (size_t)(row - TL) * 1024;
        const int mr = mod_row(row);
        const float* sh = modp(p, l, mr, WHICH == 1 ? 0 : 3);
        const float* sc = modp(p, l, mr, WHICH == 1 ? 1 : 4);
        float4 v[4];
        float ss = 0.f;
#pragma unroll
        for (int i = 0; i < 4; ++i) {
            v[i] = *(const float4*)(src + lane * 4 + i * 256);
            ss += v[i].x * v[i].x + v[i].y * v[i].y + v[i].z * v[i].z + v[i].w * v[i].w;
        }
        ss = wave_sum(ss);
        const float rstd = rsqrtf(ss * (1.f / 1024.f) + EPS);
        float hv[16];
#pragma unroll
        for (int i = 0; i < 4; ++i) {
            const int c = lane * 4 + i * 256;
            const float4 gg = *(const float4*)(g + c), s4 = *(const float4*)(sh + c), c4 = *(const float4*)(sc + c);
            hv[i * 4 + 0] = v[i].x * rstd * gg.x * (1.f + c4.x) + s4.x;
            hv[i * 4 + 1] = v[i].y * rstd * gg.y * (1.f + c4.y) + s4.y;
            hv[i * 4 + 2] = v[i].z * rstd * gg.z * (1.f + c4.z) + s4.z;
            hv[i * 4 + 3] = v[i].w * rstd * gg.w * (1.f + c4.w) + s4.w;
            u32x2 o; o.x = pack2(hv[i * 4 + 0], hv[i * 4 + 1]); o.y = pack2(hv[i * 4 + 2], hv[i * 4 + 3]);
            *(u32x2*)(H + (size_t)row * 1024 + c) = o;
        }
        if (WHICH == 2) {
            float lg[16];
#pragma unroll
            for (int e = 0; e < 16; ++e) lg[e] = 0.f;
            const float* rw = p.in[I_ROUTW];
#pragma unroll
            for (int i = 0; i < 4; ++i)
#pragma unroll
                for (int j = 0; j < 4; ++j) {
                    const int c = lane * 4 + i * 256 + j;
                    const float hvv = hv[i * 4 + j];
#pragma unroll
                    for (int q = 0; q < 4; ++q) {
                        const float4 w4 = *(const float4*)(rw + (size_t)c * 16 + q * 4);
                        lg[q * 4 + 0] += hvv * w4.x; lg[q * 4 + 1] += hvv * w4.y; lg[q * 4 + 2] += hvv * w4.z; lg[q * 4 + 3] += hvv * w4.w;
                    }
                }
#pragma unroll
            for (int e = 0; e < 16; ++e) lg[e] = wave_sum(lg[e]);
            float sc16[16], bs[16];
#pragma unroll
            for (int e = 0; e < 16; ++e) { sc16[e] = sigmoidf_(lg[e]); bs[e] = sc16[e] + p.in[I_ROUTB][e]; }
            int bestg = 0; float bestv = -INFINITY;
#pragma unroll
            for (int gi = 0; gi < 4; ++gi) {
                float m1 = -INFINITY, m2 = -INFINITY;
#pragma unroll
                for (int k = 0; k < 4; ++k) { const float x = bs[gi * 4 + k]; if (x > m1) { m2 = m1; m1 = x; } else if (x > m2) m2 = x; }
                const float gs = m1 + m2;
                if (gs > bestv) { bestv = gs; bestg = gi; }
            }
            int i0 = 0, i1 = 0; float v0 = -INFINITY, v1 = -INFINITY, s0 = 0.f, s1 = 0.f;
#pragma unroll
            for (int e = 0; e < 16; ++e) { const bool in = (e >> 2) == bestg; if (in && bs[e] > v0) { v0 = bs[e]; i0 = e; s0 = sc16[e]; } }
#pragma unroll
            for (int e = 0; e < 16; ++e) { const bool in = (e >> 2) == bestg && e != i0; if (in && bs[e] > v1) { v1 = bs[e]; i1 = e; s1 = sc16[e]; } }
            const float inv = 1.f / (s0 + s1);
            if (lane == 0) {
                const int lt = row - bidx() * tpb;
                sel[lt * 2 + 0] = i0; sel[lt * 2 + 1] = i1;
                float* tw = (float*)(p.ws + OFF_TOKW) + (size_t)row * 2;
                tw[0] = s0 * inv; tw[1] = s1 * inv;
            }
        }
    }
    if (WHICH == 2) {
        __syncthreads();
        const int t0 = bidx() * tpb, nt = max(0, min(nrows, t0 + tpb) - t0);
        int* rank = sel + 2 * tpb;
        if (tidx() < 16) {
            const int e = tidx(); int c = 0;
            for (int i = 0; i < 2 * nt; ++i) if (sel[i] == e) { rank[i] = c; ++c; }
            ((int*)(p.ws + OFF_CNTB))[(size_t)bidx() * 16 + e] = c;
        }
        __syncthreads();
        int* toki = (int*)(p.ws + OFF_TOKI);
        for (int i = tidx(); i < nt; i += NT) {
            int4 r; r.x = sel[2 * i]; r.y = sel[2 * i + 1]; r.z = rank[2 * i]; r.w = rank[2 * i + 1];
            *(int4*)(toki + (size_t)(t0 + i) * 4) = r;
        }
        __syncthreads();
    }
}
DEV void phase_route(const Params& p, int l, int nrows, char* smem) {
    int* sm = (int*)smem;
    const int tid = tidx(), e = tid & 15, part = tid >> 4, G = gridDim.x, b = bidx();
    const int* cntb = (const int*)(p.ws + OFF_CNTB);
    int pre = 0, tot = 0;
    for (int bb = part; bb < G; bb += 16) { const int c = cntb[(size_t)bb * 16 + e]; tot += c; if (bb < b) pre += c; }
    __syncthreads();
    sm[part * 16 + e] = pre; sm[256 + part * 16 + e] = tot;
    __syncthreads();
    if (tid < 16) {
        int a = 0, t = 0;
        for (int q = 0; q < 16; ++q) { a += sm[q * 16 + tid]; t += sm[256 + q * 16 + tid]; }
        sm[512 + tid] = a; sm[528 + tid] = t;
    }
    __syncthreads();
    if (tid == 0) {
        int a = 0;
        for (int q = 0; q < 16; ++q) { sm[544 + q] = a; a += sm[528 + q]; }
    }
    __syncthreads();
    if (b == 0 && tid < 16) ((int*)(p.ws + OFF_CTR))[CTR_MOE + l * 16 + tid] = sm[528 + tid];
    const int tpb = (nrows + G - 1) / G, t0 = b * tpb, nt = max(0, min(nrows, t0 + tpb) - t0);
    int* toki = (int*)(p.ws + OFF_TOKI);
    const float* tokw = (const float*)(p.ws + OFF_TOKW);
    int* ltok = (int*)(p.ws + OFF_LTOK);
    float* lw = (float*)(p.ws + OFF_LW);
    for (int i = tid; i < 2 * nt; i += NT) {
        const int t = t0 + (i >> 1), j = i & 1;
        const int ee = toki[(size_t)t * 4 + j], rk = toki[(size_t)t * 4 + 2 + j];
        const int pos = sm[512 + ee] + rk;
        ltok[(size_t)ee * TT + pos] = t;
        lw[(size_t)ee * TT + pos] = tokw[(size_t)t * 2 + j];
        toki[(size_t)t * 4 + 2 + j] = sm[544 + ee] + pos;
    }
}
DEV void phase_combine(const Params& p, int l, int nrows) {
    const int lane = tidx() & 63, wave = tidx() >> 6;
    const bf16_t* Z = wsb(p, OFF_Z);
    const int* toki = (const int*)(p.ws + OFF_TOKI);
    const float* tokw = (const float*)(p.ws + OFF_TOKW);
    for (int row = bidx() * 4 + wave; row < nrows; row += gridDim.x * 4) {
        float* dst = row < TL ? p.out + (size_t)row * 1024 : wsf(p, OFF_CX) + (size_t)(row - TL) * 1024;
        const float* g2 = modp(p, l, mod_row(row), 5);
        const int r0 = toki[(size_t)row * 4 + 2], r1 = toki[(size_t)row * 4 + 3];
        const float w0 = tokw[(size_t)row * 2], w1 = tokw[(size_t)row * 2 + 1];
#pragma unroll
        for (int i = 0; i < 4; ++i) {
            const int c = lane * 4 + i * 256;
            const u32x2 a = *(const u32x2*)(Z + (size_t)r0 * 1024 + c), b = *(const u32x2*)(Z + (size_t)r1 * 1024 + c);
            const float4 gg = *(const float4*)(g2 + c);
            float4 x = *(float4*)(dst + c);
            x.x += gg.x * (w0 * bflo(a.x) + w1 * bflo(b.x));
            x.y += gg.y * (w0 * bfhi(a.x) + w1 * bfhi(b.x));
            x.z += gg.z * (w0 * bflo(a.y) + w1 * bflo(b.y));
            x.w += gg.w * (w0 * bfhi(a.y) + w1 * bfhi(b.y));
            *(float4*)(dst + c) = x;
        }
    }
}
constexpr int GLD = 72;
constexpr int GSTAGE = 128 * GLD;
template <bool DEEP = true, int TN = 2, class AF, class BF>
DEV void gemm_mainloop(f32x16 (&acc)[2][TN], AF arow, BF brow, int K, bf16_t* sm) {
    const int tid = tidx(), lane = tid & 63, wave = tid >> 6, wm = wave >> 1, wn = wave & 1;
    bf16_t* As = sm;
    bf16_t* Bs = sm + 2 * GSTAGE;
    constexpr int NB = 2 * TN;
    const bf16_t* ap[4]; const bf16_t* bp[NB];
#pragma unroll
    for (int i = 0; i < 4; ++i) { const int q = tid + i * NT; ap[i] = arow(q >> 3) + (q & 7) * 8; }
#pragma unroll
    for (int i = 0; i < NB; ++i) { const int q = tid + i * NT; bp[i] = brow(q >> 3) + (q & 7) * 8; }
    const int soff = (tid >> 3) * GLD + (tid & 7) * 8;
    u32x4 ra0[4], rb0[NB], ra1[4], rb1[NB];
    const int nk = K >> 6;
#pragma unroll
    for (int i = 0; i < 4; ++i) ra0[i] = *(const u32x4*)ap[i];
#pragma unroll
    for (int i = 0; i < NB; ++i) rb0[i] = *(const u32x4*)bp[i];
    if (DEEP && nk > 1) {
#pragma unroll
        for (int i = 0; i < 4; ++i) ra1[i] = *(const u32x4*)(ap[i] + 64);
#pragma unroll
        for (int i = 0; i < NB; ++i) rb1[i] = *(const u32x4*)(bp[i] + 64);
    }
    __syncthreads();
#pragma unroll
    for (int i = 0; i < 4; ++i) *(u32x4*)(As + soff + i * 32 * GLD) = ra0[i];
#pragma unroll
    for (int i = 0; i < NB; ++i) *(u32x4*)(Bs + soff + i * 32 * GLD) = rb0[i];
    __syncthreads();
    const int arow0 = (wm * 64 + (lane & 31)) * GLD + (lane >> 5) * 8;
    const int brow0 = (wn * 32 * TN + (lane & 31)) * GLD + (lane >> 5) * 8;
    auto compute = [&](int cur) {
        const bf16_t* a_s = As + cur * GSTAGE + arow0;
        const bf16_t* b_s = Bs + cur * GSTAGE + brow0;
#pragma unroll
        for (int ks = 0; ks < 4; ++ks) {
            const bf16x8 a0 = *(const bf16x8*)(a_s + ks * 16);
            const bf16x8 a1 = *(const bf16x8*)(a_s + 32 * GLD + ks * 16);
#pragma unroll
            for (int j = 0; j < TN; ++j) {
                const bf16x8 bj = *(const bf16x8*)(b_s + j * 32 * GLD + ks * 16);
                acc[0][j] = __builtin_amdgcn_mfma_f32_32x32x16_bf16(a0, bj, acc[0][j], 0, 0, 0);
                acc[1][j] = __builtin_amdgcn_mfma_f32_32x32x16_bf16(a1, bj, acc[1][j], 0, 0, 0);
            }
        }
    };
    auto gload = [&](u32x4 (&ra)[4], u32x4 (&rb)[NB], int kt) {
        const int k0 = kt * 64;
#pragma unroll
        for (int i = 0; i < 4; ++i) ra[i] = *(const u32x4*)(ap[i] + k0);
#pragma unroll
        for (int i = 0; i < NB; ++i) rb[i] = *(const u32x4*)(bp[i] + k0);
    };
    auto lstore = [&](const u32x4 (&ra)[4], const u32x4 (&rb)[NB], int st) {
#pragma unroll
        for (int i = 0; i < 4; ++i) *(u32x4*)(As + st * GSTAGE + soff + i * 32 * GLD) = ra[i];
#pragma unroll
        for (int i = 0; i < NB; ++i) *(u32x4*)(Bs + st * GSTAGE + soff + i * 32 * GLD) = rb[i];
    };
    for (int kt = 0; kt < nk; kt += 2) {
        if (!DEEP && kt + 1 < nk) gload(ra1, rb1, kt + 1);
        if (DEEP && kt + 2 < nk) gload(ra0, rb0, kt + 2);
        compute(0);
        if (kt + 1 < nk) lstore(ra1, rb1, 1);
        __syncthreads();
        if (kt + 1 >= nk) break;
        if (!DEEP && kt + 2 < nk) gload(ra0, rb0, kt + 2);
        if (DEEP && kt + 3 < nk) gload(ra1, rb1, kt + 3);
        compute(1);
        if (kt + 2 < nk) lstore(ra0, rb0, 0);
        __syncthreads();
    }
}
template <int TN>
DEV void acc_zero(f32x16 (&acc)[2][TN]) {
#pragma unroll
    for (int i = 0; i < 2; ++i)
#pragma unroll
        for (int j = 0; j < TN; ++j)
#pragma unroll
            for (int r = 0; r < 16; ++r) acc[i][j][r] = 0.f;
}
#define EPI_FOREACH(acc, ...)                                                                           \
    {                                                                                                    \
        const int _lane = tidx() & 63, _wave = tidx() >> 6, _wm = _wave >> 1, _wn = _wave & 1; \
        _Pragma("unroll") for (int _i = 0; _i < 2; ++_i)                                                 \
        _Pragma("unroll") for (int _j = 0; _j < 2; ++_j)                                                 \
        _Pragma("unroll") for (int _r = 0; _r < 16; ++_r) {                                              \
            const int er = _wm * 64 + _i * 32 + (_r & 3) + 8 * (_r >> 2) + 4 * (_lane >> 5);             \
            const int ec = _wn * 64 + _j * 32 + (_lane & 31);                                            \
            const float ev = acc[_i][_j][_r];                                                            \
            __VA_ARGS__                                                                                  \
        }                                                                                                \
    }

DEV void tile_mn(int item, int nMt, int nNt, int& mt, int& nt) {
    constexpr int GM = 16;
    const int per = GM * nNt, g = item / per, rem = item % per;
    const int m0 = g * GM, gsz = (nMt - m0) < GM ? (nMt - m0) : GM;
    mt = m0 + rem % gsz; nt = rem / gsz;
}

DEV void phase_inproj(const Params& p, int l, char* smem) {
    bf16_t* sm = (bf16_t*)smem;
    const bf16_t* H = wsb(p, OFF_H);
    const bf16_t* W = wsb(p, OFF_WIN);
    bf16_t* P = wsb(p, OFF_P);
    unsigned char* G = (unsigned char*)(p.ws + OFF_GATE);
    const int nMt = TT / 128, nNt = NINP / 128;
    for (int item = bidx(); item < nMt * nNt; item += gridDim.x) {
        int mt, nt; tile_mn(item, nMt, nNt, mt, nt);
        const int m0 = mt * 128, n0 = nt * 128;
        if (l == 1 && m0 >= TL && n0 >= NGATE0) continue;
        f32x16 acc[2][2]; acc_zero<2>(acc);
        gemm_mainloop(acc, [&](int r) { return H + (size_t)(m0 + r) * 1024; }, [&](int r) { return W + (size_t)(n0 + r) * 1024; }, 1024, sm);
        if (n0 < NGATE0) {
            EPI_FOREACH(acc, { const int col = n0 + ec; if (col < C_PEND) P[(size_t)(m0 + er) * LDP + col] = f2bf(ev); })
        } else {
            EPI_FOREACH(acc, { const int col = n0 + ec - NGATE0; const float s = sigmoidf_(ev); G[(size_t)(m0 + er) * 4096 + col] = (unsigned char)__float2int_rn(s * 255.f); })
        }
    }
}

template <class EF>
DEV void gemm_generic(const bf16_t* A, int lda, int M, const bf16_t* Bt, int ldb, int N, int K, EF ef, char* smem, int rot) {
    bf16_t* sm = (bf16_t*)smem;
    const int nMt = (M + 127) / 128, nNt = (N + 127) / 128, G = gridDim.x;
    const int first = (bidx() - (rot % G) + G) % G;
    for (int item = first; item < nMt * nNt; item += G) {
        const int mt = item / nNt, nt = item % nNt, m0 = mt * 128, n0 = nt * 128;
        f32x16 acc[2][2]; acc_zero<2>(acc);
        gemm_mainloop(acc, [&](int r) { int rr = m0 + r; rr = rr < M ? rr : M - 1; return A + (size_t)rr * lda; },
                      [&](int r) { int rr = n0 + r; rr = rr < N ? rr : N - 1; return Bt + (size_t)rr * ldb; }, K, sm);
        EPI_FOREACH(acc, { const int row = m0 + er, col = n0 + ec; if (row < M && col < N) ef(row, col, ev); })
    }
}

DEV void phase_merge(const Params& p, int l, int M, char* smem) {
    bf16_t* sm = (bf16_t*)smem;
    const bf16_t* Y = wsb(p, OFF_Y);
    const bf16_t* W = wsb(p, OFF_WBR);
    const unsigned char* G = (const unsigned char*)(p.ws + OFF_GATE);
    bf16_t* MG = wsb(p, OFF_H);
    const int nMt = M / 128, nNt = 16;
    for (int item = bidx(); item < nMt * nNt; item += gridDim.x) {
        const int mt = item / nNt, nt = item % nNt, m0 = mt * 128, n0 = nt * 64;
        f32x16 tot[2][1]; acc_zero<1>(tot);
        const int lane = tidx() & 63, wave = tidx() >> 6, wm = wave >> 1, wn = wave & 1;
        for (int i = 0; i < 4; ++i) {
            f32x16 acc[2][1]; acc_zero<1>(acc);
            gemm_mainloop<true, 1>(acc, [&](int r) { return Y + (size_t)(m0 + r) * 1024 + i * 256; }, [&](int r) { return W + ((size_t)i * 1024 + n0 + r) * 256; }, 256, sm);
#pragma unroll
            for (int a = 0; a < 2; ++a)
#pragma unroll
                for (int r = 0; r < 16; ++r) {
                    const int er = wm * 64 + a * 32 + (r & 3) + 8 * (r >> 2) + 4 * (lane >> 5), ec = wn * 32 + (lane & 31);
                    const float g = (float)G[(size_t)(m0 + er) * 4096 + i * 1024 + n0 + ec] * (1.f / 255.f);
                    tot[a][0][r] += g * acc[a][0][r];
                }
        }
#pragma unroll
        for (int a = 0; a < 2; ++a)
#pragma unroll
            for (int r = 0; r < 16; ++r) {
                const int er = wm * 64 + a * 32 + (r & 3) + 8 * (r >> 2) + 4 * (lane >> 5), ec = wn * 32 + (lane & 31);
                MG[(size_t)(m0 + er) * 1024 + n0 + ec] = f2bf(tot[a][0][r]);
            }
    }
}

DEV void phase_outproj(const Params& p, int l, int M, char* smem) {
    bf16_t* sm = (bf16_t*)smem;
    const bf16_t* MG = wsb(p, OFF_H);
    const bf16_t* W = wsb(p, OFF_WOUT);
    const float* xs = (l == 0) ? p.in[I_X] : p.out;
    const float* cs = (l == 0) ? p.in[I_CTX] : wsf(p, OFF_CX);
    float* cxd = wsf(p, OFF_CX);
    float* outd = p.out;
    const int nMt = M / 128, nNt = 8;
    for (int item = bidx(); item < nMt * nNt; item += gridDim.x) {
        const int mt = item / nNt, nt = item % nNt, m0 = mt * 128, n0 = nt * 128;
        f32x16 acc[2][2]; acc_zero<2>(acc);
        gemm_mainloop(acc, [&](int r) { return MG + (size_t)(m0 + r) * 1024; }, [&](int r) { return W + (size_t)(n0 + r) * 1024; }, 1024, sm);
        const float* g1 = modp(p, l, mod_row(m0), 2);
        if (m0 < TL) {
            EPI_FOREACH(acc, { const size_t o = (size_t)(m0 + er) * 1024 + n0 + ec; outd[o] = xs[o] + g1[n0 + ec] * ev; })
        } else {
            EPI_FOREACH(acc, { const size_t o = (size_t)(m0 - TL + er) * 1024 + n0 + ec; cxd[o] = cs[o] + g1[n0 + ec] * ev; })
        }
    }
}

constexpr int MOE_MAP_OFF = 73728;
DEV void moe_map(const Params& p, int l, char* smem) {
    int* mm = (int*)(smem + MOE_MAP_OFF);
    __syncthreads();
    if (tidx() == 0) {
        const int* cnt = (const int*)(p.ws + OFF_CTR) + CTR_MOE + l * 16;
        int b = 0, t = 0;
        for (int e = 0; e < 16; ++e) { const int c = cnt[e]; mm[e] = c; mm[16 + e] = b; mm[32 + e] = t; b += c; t += (c + 127) >> 7; }
        mm[48] = t;
    }
    __syncthreads();
}
DEV void phase_moe1(const Params& p, int l, char* smem) {
    bf16_t* sm = (bf16_t*)smem;
    const bf16_t* F = wsb(p, OFF_H);
    const bf16_t* W = wsb(p, OFF_WG1);
    bf16_t* ACT = wsb(p, OFF_P);
    const int* ltok = (const int*)(p.ws + OFF_LTOK);
    moe_map(p, l, smem); const int* mm = (const int*)(smem + MOE_MAP_OFF);
    const int nNt = 8, total = mm[48] * nNt;
    for (int item = bidx(); item < total; item += gridDim.x) {
        const int mtg = item / nNt, nt = item % nNt;
        int e = 0;
        for (int q = 1; q < 16; ++q) if (mtg >= mm[32 + q]) e = q;
        const int m0 = (mtg - mm[32 + e]) * 128, n0 = nt * 128, ce = mm[e];
        const int* lt = ltok + (size_t)e * TT;
        f32x16 acc[2][2]; acc_zero<2>(acc);
        gemm_mainloop(acc, [&](int r) { int idx = m0 + r; idx = idx < ce ? idx : ce - 1; return F + (size_t)lt[idx] * 1024; },
                      [&](int r) { return W + ((size_t)e * 1024 + n0 + r) * 1024; }, 1024, sm);
        const int lane = tidx() & 63, wave = tidx() >> 6, wm = wave >> 1, wn = wave & 1;
        const int jcol = ((n0 >> 6) + wn) * 32 + (lane & 31);
#pragma unroll
        for (int a = 0; a < 2; ++a)
#pragma unroll
            for (int r = 0; r < 16; ++r) {
                const int idx = m0 + wm * 64 + a * 32 + (r & 3) + 8 * (r >> 2) + 4 * (lane >> 5);
                if (idx < ce) {
                    const float g = acc[a][0][r], u = acc[a][1][r];
                    ACT[(size_t)(mm[16 + e] + idx) * DFF + jcol] = f2bf(g * sigmoidf_(g) * u);
                }
            }
    }
}
DEV void phase_moe2(const Params& p, int l, char* smem) {
    bf16_t* sm = (bf16_t*)smem;
    const bf16_t* ACT = wsb(p, OFF_P);
    const bf16_t* W = wsb(p, OFF_WDN);
    bf16_t* Z = wsb(p, OFF_Z);
    moe_map(p, l, smem); const int* mm = (const int*)(smem + MOE_MAP_OFF);
    const int nNt = 8, total = mm[48] * nNt;
    for (int item = bidx(); item < total; item += gridDim.x) {
        const int mtg = item / nNt, nt = item % nNt;
        int e = 0;
        for (int q = 1; q < 16; ++q) if (mtg >= mm[32 + q]) e = q;
        const int m0 = (mtg - mm[32 + e]) * 128, n0 = nt * 128, ce = mm[e];
        f32x16 acc[2][2]; acc_zero<2>(acc);
        gemm_mainloop(acc, [&](int r) { int idx = m0 + r; idx = idx < ce ? idx : ce - 1; return ACT + (size_t)(mm[16 + e] + idx) * DFF; },
                      [&](int r) { return W + ((size_t)e * 1024 + n0 + r) * DFF; }, DFF, sm);
        bf16_t* zb = Z + (size_t)mm[16 + e] * 1024;
        EPI_FOREACH(acc, { const int idx = m0 + er; if (idx < ce) zb[(size_t)idx * 1024 + n0 + ec] = f2bf(ev); })
    }
}
DEV void tok_seq(int t, int& base, int& n, int& len) {
    if (t < TL) { base = t & ~(SEQ - 1); n = t & (SEQ - 1); len = SEQ; } else { const int u = t - TL; base = TL + (u & ~(CTXL - 1)); n = u & (CTXL - 1); len = CTXL; }
}
DEV void phase_prep1(const Params& p, int l) {
    const int lane = tidx() & 63, wave = tidx() >> 6;
    bf16_t* P = wsb(p, OFF_P);
    bf16_t* XL = wsb(p, OFF_XL);
    const float* qkg = p.in[I_DAQKG] + l * 64;
    const float* cqg = p.in[I_MCQG] + l * 192;
    const float* ckvg = p.in[I_MCKVG] + l * 128;
    const float* mu3 = p.in[I_RMU] + (l * 4 + 3) * 256;
    for (int t = bidx() * 4 + wave; t < TT; t += gridDim.x * 4) {
        bf16_t* row = P + (size_t)t * LDP;
        int base, n, len; tok_seq(t, base, n, len);
        {
            const int d0 = (lane & 7) * 4;
            float cs[4], sn[4];
            const bool rot = t < TL;
            if (rot) {
                const float fr = (float)(n >> 6), fc = (float)(n & 63);
#pragma unroll
                for (int j = 0; j < 4; ++j) {
                    const int i = (d0 + j) & 15;
                    const float inv = exp2f(-(float)(i & 7) * (13.287712379549449f / 8.f));
                    const float ang = (i < 8 ? fr : fc) * inv;
                    cs[j] = cosf(ang); sn[j] = sinf(ang);
                }
            }
#pragma unroll
            for (int which = 0; which < 2; ++which) {
                bf16_t* ptr = row + (which ? C_DAK : C_DAQ) + lane * 4;
                const u32x2 raw = *(const u32x2*)ptr;
                float v[4] = { bflo(raw.x), bfhi(raw.x), bflo(raw.y), bfhi(raw.y) };
                float ss = v[0] * v[0] + v[1] * v[1] + v[2] * v[2] + v[3] * v[3];
                ss = group_sum<8>(ss);
                const float rstd = rsqrtf(ss * (1.f / 32.f) + EPS);
                const float* g = qkg + which * 32 + d0;
#pragma unroll
                for (int j = 0; j < 4; ++j) v[j] = v[j] * rstd * g[j];
                if (rot) {
#pragma unroll
                    for (int j = 0; j < 4; ++j) {
                        const float o = __shfl_xor(v[j], 4, 64);
                        v[j] = (d0 < 16) ? (v[j] * cs[j] - o * sn[j]) : (v[j] * cs[j] + o * sn[j]);
                    }
                }
                if (which == 0) {
                    const float qs = 0.17677669529663687f * LOG2E;
#pragma unroll
                    for (int j = 0; j < 4; ++j) v[j] *= qs;
                }
                u32x2 o; o.x = pack2(v[0], v[1]); o.y = pack2(v[2], v[3]);
                *(u32x2*)ptr = o;
            }
        }
        {
            float v[3]; float ss = 0.f;
#pragma unroll
            for (int j = 0; j < 3; ++j) { v[j] = bf2f(row[C_CQ + lane + j * 64]); ss += v[j] * v[j]; }
            ss = wave_sum(ss);
            const float rstd = rsqrtf(ss * (1.f / 192.f) + EPS);
#pragma unroll
            for (int j = 0; j < 3; ++j) row[C_CQ + lane + j * 64] = f2bf(v[j] * rstd * cqg[lane + j * 64]);
            float w[2]; float s2 = 0.f;
#pragma unroll
            for (int j = 0; j < 2; ++j) { w[j] = bf2f(row[C_CKV + lane + j * 64]); s2 += w[j] * w[j]; }
            s2 = wave_sum(s2);
            const float r2 = rsqrtf(s2 * (1.f / 128.f) + EPS);
#pragma unroll
            for (int j = 0; j < 2; ++j) row[C_CKV + lane + j * 64] = f2bf(w[j] * r2 * ckvg[lane + j * 64]);
        }
        {
            const int c = lane * 4;
            const u32x2 cur = *(const u32x2*)(row + C_RWD + c);
            u32x2 pv = (u32x2){0u, 0u}, nx = (u32x2){0u, 0u};
            if (n > 0) pv = *(const u32x2*)(row - LDP + C_RWD + c);
            if (n + 1 < len) nx = *(const u32x2*)(row + LDP + C_RWD + c);
            const float4 m = *(const float4*)(mu3 + c);
            float o[4];
            { const float x = bflo(cur.x); o[0] = x + (0.5f * (bflo(pv.x) + bflo(nx.x)) - x) * m.x; }
            { const float x = bfhi(cur.x); o[1] = x + (0.5f * (bfhi(pv.x) + bfhi(nx.x)) - x) * m.y; }
            { const float x = bflo(cur.y); o[2] = x + (0.5f * (bflo(pv.y) + bflo(nx.y)) - x) * m.z; }
            { const float x = bfhi(cur.y); o[3] = x + (0.5f * (bfhi(pv.y) + bfhi(nx.y)) - x) * m.w; }
            u32x2 ov; ov.x = pack2(o[0], o[1]); ov.y = pack2(o[2], o[3]);
            *(u32x2*)(XL + (size_t)t * 256 + c) = ov;
        }
    }
}

DEV void phase_prep_gemm1(const Params& p, int l, char* smem) {
    const bf16_t* P = wsb(p, OFF_P);
    const bf16_t* w = wsb(p, OFF_WSM) + (size_t)l * WS_PER_LAYER;
    bf16_t* QRAW = wsb(p, OFF_QRAW); bf16_t* KVRAW = wsb(p, OFF_KVRAW); bf16_t* LR = wsb(p, OFF_LR);
    int rot = 0;
    gemm_generic(P + C_CQ, LDP, TT, w + WS_UQT, 192, 192, 192, [&](int r, int c, float v) { QRAW[(size_t)r * 192 + c] = f2bf(v); }, smem, rot);
    rot += (TT / 128) * 2;
    gemm_generic(P + C_CKV, LDP, TT, w + WS_UKVT, 128, 384, 128, [&](int r, int c, float v) { KVRAW[(size_t)r * 384 + c] = f2bf(v); }, smem, rot);
    rot += (TT / 128) * 3;
    gemm_generic(wsb(p, OFF_XL), 256, TT, w + WS_W1C, 256, 192, 256,
                 [&](int r, int c, float v) { const float o = c < 64 ? tanhf(v) : (c < 128 ? v : sigmoidf_(v)); LR[(size_t)r * 192 + c] = f2bf(o); }, smem, rot);
}
DEV void phase_prep_gemm2(const Params& p, int l, char* smem) {
    const bf16_t* w = wsb(p, OFF_WSM) + (size_t)l * WS_PER_LAYER;
    const bf16_t* LR = wsb(p, OFF_LR);
    bf16_t* RWX = wsb(p, OFF_RWX);
    bf16_t* P = wsb(p, OFF_P);
    int rot = 0;
    for (int d = 0; d < 2; ++d) {
        const float* w0 = p.in[I_RW0] + (l * 2 + d) * 256;
        gemm_generic(LR + d * 32, 192, TT, w + WS_W2 + (size_t)d * 256 * 64, 64, 256, 64,
                     [&](int r, int c, float v) { RWX[(size_t)r * 1024 + d * 256 + c] = f2bf(0.6065306597126334f * sigmoidf_(w0[c] + v)); }, smem, rot);
        rot += (TT / 128) * 2;
        const float* a0 = p.in[I_RA0] + (l * 2 + d) * 256;
        gemm_generic(LR + 64 + d * 32, 192, TT, w + WS_W2 + (size_t)(2 + d) * 256 * 64, 64, 256, 64,
                     [&](int r, int c, float v) { RWX[(size_t)r * 1024 + 512 + d * 256 + c] = f2bf(sigmoidf_(a0[c] + v)); }, smem, rot);
        rot += (TT / 128) * 2;
    }
    gemm_generic(LR + 128, 192, TT, w + WS_G2T, 64, 256, 64, [&](int r, int c, float v) { P[(size_t)r * LDP + C_RWD + c] = f2bf(v); }, smem, rot);
}

DEV void phase_prep2(const Params& p, int l) {
    const int lane = tidx() & 63, wave = tidx() >> 6;
    const bf16_t* P = wsb(p, OFF_P);
    const bf16_t* QRAW = wsb(p, OFF_QRAW); const bf16_t* KVRAW = wsb(p, OFF_KVRAW);
    bf16_t* MQ = wsb(p, OFF_MLAQ); bf16_t* MK = wsb(p, OFF_MLAK); bf16_t* MV = wsb(p, OFF_MLAV);
    const float* qkg = p.in[I_MQKG] + l * 96;
    for (int t = bidx() * 4 + wave; t < TT; t += gridDim.x * 4) {
        int base, n, len; tok_seq(t, base, n, len);
        const int h = lane >> 4, j = lane & 15;
        const bool rot = t < TL;
        float cs = 1.f, sn = 0.f;
        if (rot) {
            const int i = j & 7;
            const float inv = exp2f(-(float)(i & 3) * (13.287712379549449f / 4.f));
            const float ang = (i < 4 ? (float)(n >> 6) : (float)(n & 63)) * inv;
            cs = cosf(ang); sn = sinf(ang);
        }
        {
            float v[3]; float ss = 0.f;
#pragma unroll
            for (int k = 0; k < 3; ++k) { v[k] = bf2f(QRAW[(size_t)t * 192 + h * 48 + j + k * 16]); ss += v[k] * v[k]; }
            ss = group_sum<16>(ss);
            const float rstd = rsqrtf(ss * (1.f / 48.f) + EPS);
#pragma unroll
            for (int k = 0; k < 3; ++k) v[k] = v[k] * rstd * qkg[j + k * 16];
            if (rot) { const float o = __shfl_xor(v[2], 8, 64); v[2] = (j < 8) ? (v[2] * cs - o * sn) : (v[2] * cs + o * sn); }
            const float qs = 0.14433756729740643f * LOG2E;
#pragma unroll
            for (int k = 0; k < 3; ++k) MQ[(size_t)t * 192 + h * 48 + j + k * 16] = f2bf(v[k] * qs);
        }
        {
            float v[3]; float ss = 0.f;
            v[0] = bf2f(KVRAW[(size_t)t * 384 + h * 96 + j]);
            v[1] = bf2f(KVRAW[(size_t)t * 384 + h * 96 + 16 + j]);
            v[2] = bf2f(P[(size_t)t * LDP + C_KR + j]);
#pragma unroll
            for (int k = 0; k < 3; ++k) ss += v[k] * v[k];
            ss = group_sum<16>(ss);
            const float rstd = rsqrtf(ss * (1.f / 48.f) + EPS);
#pragma unroll
            for (int k = 0; k < 3; ++k) v[k] = v[k] * rstd * qkg[48 + j + k * 16];
            if (rot) { const float o = __shfl_xor(v[2], 8, 64); v[2] = (j < 8) ? (v[2] * cs - o * sn) : (v[2] * cs + o * sn); }
#pragma unroll
            for (int k = 0; k < 3; ++k) MK[(size_t)t * 192 + h * 48 + j + k * 16] = f2bf(v[k]);
        }
#pragma unroll
        for (int k = 0; k < 4; ++k) MV[(size_t)t * 256 + h * 64 + j + k * 16] = KVRAW[(size_t)t * 384 + h * 96 + 32 + j + k * 16];
    }
}
template <int NC, int DK>
struct AttnCfg {
    static constexpr int DKROW = NC * DK, KLD = DKROW + 8, VLD = 68;
    static constexpr int KSTAGE = 64 * KLD, VSTAGE = 64 * VLD;
    static constexpr int KCH = 64 * DKROW / 8;
};
template <int NC, int DK, class EPI>
DEV void attn_item(const bf16_t* Q, int ldq, const bf16_t* Kl, const bf16_t* Kc, int ldk, const bf16_t* Vl, const bf16_t* Vc, int ldv,
                   int q0, int nlat_tiles, int nctx_tiles, EPI epi, char* smem) {
    using C = AttnCfg<NC, DK>;
    constexpr int KS = DK / 16;
    const int tid = tidx(), lane = tid & 63, wave = tid >> 6, ql = lane & 31, hh = lane >> 5;
    bf16_t* Ks = (bf16_t*)smem;
    bf16_t* Vt = Ks + 2 * C::KSTAGE;
    bf16x8 qf[NC][KS];
    {
        const bf16_t* qp = Q + (size_t)(q0 + wave * 32 + ql) * ldq + hh * 8;
#pragma unroll
        for (int c = 0; c < NC; ++c)
#pragma unroll
            for (int ks = 0; ks < KS; ++ks) qf[c][ks] = *(const bf16x8*)(qp + c * DK + ks * 16);
    }
    f32x16 O[NC][2];
    float mrun[NC], lrun[NC];
#pragma unroll
    for (int c = 0; c < NC; ++c) {
        mrun[c] = -1e30f; lrun[c] = 0.f;
#pragma unroll
        for (int d = 0; d < 2; ++d)
#pragma unroll
            for (int r = 0; r < 16; ++r) O[c][d][r] = 0.f;
    }
    const int ntiles = nlat_tiles + nctx_tiles;
    constexpr int KPT = (C::KCH + NT - 1) / NT;
    u32x4 rk[KPT], rv[2];
    auto load_tile = [&](int tile) {
        const bf16_t* kb = tile < nlat_tiles ? Kl + (size_t)tile * 64 * ldk : Kc + (size_t)(tile - nlat_tiles) * 64 * ldk;
        const bf16_t* vb = tile < nlat_tiles ? Vl + (size_t)tile * 64 * ldv : Vc + (size_t)(tile - nlat_tiles) * 64 * ldv;
#pragma unroll
        for (int i = 0; i < KPT; ++i) {
            int q = tid + i * NT; q = q < C::KCH ? q : C::KCH - 1;
            { const int key = q / (C::DKROW / 8), ch = q % (C::DKROW / 8); rk[i] = *(const u32x4*)(kb + (size_t)key * ldk + ch * 8); }
        }
#pragma unroll
        for (int i = 0; i < 2; ++i) { const int q = tid + i * NT; const int key = q >> 3, ch = q & 7; rv[i] = *(const u32x4*)(vb + (size_t)key * ldv + ch * 8); }
    };
    auto store_tile = [&](int st) {
#pragma unroll
        for (int i = 0; i < KPT; ++i) {
            const int q = tid + i * NT;
            if (q < C::KCH) { const int key = q / (C::DKROW / 8), ch = q % (C::DKROW / 8); *(u32x4*)(Ks + st * C::KSTAGE + key * C::KLD + ch * 8) = rk[i]; }
        }
#pragma unroll
        for (int i = 0; i < 2; ++i) {
            const int q = tid + i * NT; const int key = q >> 3, dv0 = (q & 7) * 8;
            bf16_t* vd = Vt + st * C::VSTAGE + dv0 * C::VLD + key;
            const unsigned w[4] = { rv[i][0], rv[i][1], rv[i][2], rv[i][3] };
#pragma unroll
            for (int j = 0; j < 4; ++j) { vd[(2 * j) * C::VLD] = (bf16_t)(w[j] & 0xFFFFu); vd[(2 * j + 1) * C::VLD] = (bf16_t)(w[j] >> 16); }
        }
    };
    load_tile(0);
    __syncthreads();
    store_tile(0);
    __syncthreads();
    for (int tile = 0; tile < ntiles; ++tile) {
        const int cur = tile & 1;
        if (tile + 1 < ntiles) load_tile(tile + 1);
        const bf16_t* ks_ = Ks + cur * C::KSTAGE;
        const bf16_t* vt_ = Vt + cur * C::VSTAGE;
#pragma unroll
        for (int c = 0; c < NC; ++c) {
            f32x16 S[2];
#pragma unroll
            for (int kb = 0; kb < 2; ++kb) {
#pragma unroll
                for (int r = 0; r < 16; ++r) S[kb][r] = 0.f;
#pragma unroll
                for (int ks = 0; ks < KS; ++ks) {
                    const bf16x8 kf = *(const bf16x8*)(ks_ + (kb * 32 + ql) * C::KLD + c * DK + ks * 16 + hh * 8);
                    S[kb] = __builtin_amdgcn_mfma_f32_32x32x16_bf16(kf, qf[c][ks], S[kb], 0, 0, 0);
                }
            }
            float mx = S[0][0];
#pragma unroll
            for (int kb = 0; kb < 2; ++kb)
#pragma unroll
                for (int r = 0; r < 16; ++r) mx = fmaxf(mx, S[kb][r]);
            mx = fmaxf(mx, __shfl_xor(mx, 32, 64));
            const float mnew = fmaxf(mrun[c], mx);
            const float alpha = __builtin_amdgcn_exp2f(mrun[c] - mnew);
            mrun[c] = mnew;
            float ls = 0.f;
#pragma unroll
            for (int kb = 0; kb < 2; ++kb)
#pragma unroll
                for (int r = 0; r < 16; ++r) { const float e = __builtin_amdgcn_exp2f(S[kb][r] - mnew); S[kb][r] = e; ls += e; }
            lrun[c] = lrun[c] * alpha + ls;
#pragma unroll
            for (int d = 0; d < 2; ++d)
#pragma unroll
                for (int r = 0; r < 16; ++r) O[c][d][r] *= alpha;
#pragma unroll
            for (int s = 0; s < 4; ++s) {
                const int kb = s >> 1, s2 = s & 1;
                const u32x4 pu = (u32x4){pack2(S[kb][8 * s2 + 0], S[kb][8 * s2 + 1]), pack2(S[kb][8 * s2 + 2], S[kb][8 * s2 + 3]),
                                         pack2(S[kb][8 * s2 + 4], S[kb][8 * s2 + 5]), pack2(S[kb][8 * s2 + 6], S[kb][8 * s2 + 7])};
                const bf16x8 pf = __builtin_bit_cast(bf16x8, pu);
                const int keyo = kb * 32 + 16 * s2 + 4 * hh;
#pragma unroll
                for (int d = 0; d < 2; ++d) {
                    const bf16_t* vp = vt_ + (d * 32 + ql) * C::VLD + keyo;
                    const u32x2 lo = *(const u32x2*)vp, hi = *(const u32x2*)(vp + 8);
                    const u32x4 vv = (u32x4){lo[0], lo[1], hi[0], hi[1]};
                    const bf16x8 vf = __builtin_bit_cast(bf16x8, vv);
                    O[c][d] = __builtin_amdgcn_mfma_f32_32x32x16_bf16(vf, pf, O[c][d], 0, 0, 0);
                }
            }
        }
        if (tile + 1 < ntiles) store_tile(cur ^ 1);
        __syncthreads();
    }
    float inv[NC];
#pragma unroll
    for (int c = 0; c < NC; ++c) { const float lt = lrun[c] + __shfl_xor(lrun[c], 32, 64); inv[c] = 1.f / lt; }
    epi(O, inv, q0 + wave * 32 + ql, hh);
}

DEV void da_item(const Params& p, int l, int item, char* smem) {
    const bf16_t* P = wsb(p, OFF_P);
    bf16_t* Y = wsb(p, OFF_Y);
    const float linit = 0.8f - 0.6f * __expf(-0.3f * (float)l);
    float lam;
    {
        const float* la = p.in[I_DALAM] + l * 128;
        const int lane = tidx() & 63;
        float a = lane < 32 ? la[lane] * la[32 + lane] : 0.f, b = lane < 32 ? la[64 + lane] * la[96 + lane] : 0.f;
        a = wave_sum(a); b = wave_sum(b);
        lam = __expf(a) - __expf(b) + linit;
    }
    const float* sg = p.in[I_DASUB] + l * 64;
    int b, h, qt; bool isctx;
    if (item < 512) { isctx = false; b = item >> 6; h = (item >> 4) & 3; qt = item & 15; }
    else { const int it = item - 512; isctx = true; b = it >> 3; h = (it >> 1) & 3; qt = it & 1; }
    const size_t lat0 = (size_t)b * SEQ, ctx0 = (size_t)TL + (size_t)b * CTXL;
    const size_t qrow0 = isctx ? ctx0 : lat0;
    float o1[2][16];
    auto epi0 = [&](f32x16 (&O)[1][2], float (&inv)[1], int qrow, int hh) {
#pragma unroll
        for (int d = 0; d < 2; ++d)
#pragma unroll
            for (int r = 0; r < 16; ++r) o1[d][r] = O[0][d][r] * inv[0];
    };
    auto epi1 = [&](f32x16 (&O)[1][2], float (&inv)[1], int qrow, int hh) {
        float v[2][16]; float ss = 0.f;
#pragma unroll
        for (int d = 0; d < 2; ++d)
#pragma unroll
            for (int r = 0; r < 16; ++r) { const float o = o1[d][r] - lam * O[0][d][r] * inv[0]; v[d][r] = o; ss += o * o; }
        ss += __shfl_xor(ss, 32, 64);
        const float rstd = rsqrtf(ss * (1.f / 64.f) + EPS) * (1.f - linit);
        bf16_t* yo = Y + (qrow0 + qrow) * 1024 + h * 64;
#pragma unroll
        for (int d = 0; d < 2; ++d)
#pragma unroll
            for (int g = 0; g < 4; ++g) {
                const int dv = d * 32 + 8 * g + 4 * hh;
                u32x2 o;
                o.x = pack2(v[d][4 * g + 0] * rstd * sg[dv + 0], v[d][4 * g + 1] * rstd * sg[dv + 1]);
                o.y = pack2(v[d][4 * g + 2] * rstd * sg[dv + 2], v[d][4 * g + 3] * rstd * sg[dv + 3]);
                *(u32x2*)(yo + dv) = o;
            }
    };
    const bf16_t* Qp = P + qrow0 * LDP + C_DAQ + h * 64;
    const bf16_t* Kl = P + lat0 * LDP + C_DAK + h * 64;
    const bf16_t* Kc = P + ctx0 * LDP + C_DAK + h * 64;
    const bf16_t* Vl = P + lat0 * LDP + C_DAV + h * 64;
    const bf16_t* Vc = P + ctx0 * LDP + C_DAV + h * 64;
    const int nlat = isctx ? 0 : SEQ / 64;
    attn_item<1, 32>(Qp, LDP, Kl, Kc, LDP, Vl, Vc, LDP, qt * 128, nlat, CTXL / 64, epi0, smem);
    attn_item<1, 32>(Qp + 32, LDP, Kl + 32, Kc + 32, LDP, Vl, Vc, LDP, qt * 128, nlat, CTXL / 64, epi1, smem);
}
DEV void mla_item(const Params& p, int l, int item, char* smem) {
    const bf16_t* MQ = wsb(p, OFF_MLAQ); const bf16_t* MK = wsb(p, OFF_MLAK); const bf16_t* MV = wsb(p, OFF_MLAV);
    bf16_t* Y = wsb(p, OFF_Y);
    int b, h, qt; bool isctx;
    if (item < 512) { isctx = false; b = item >> 6; h = (item >> 4) & 3; qt = item & 15; }
    else { const int it = item - 512; isctx = true; b = it >> 3; h = (it >> 1) & 3; qt = it & 1; }
    const size_t lat0 = (size_t)b * SEQ, ctx0 = (size_t)TL + (size_t)b * CTXL;
    const size_t qrow0 = isctx ? ctx0 : lat0;
    auto epi = [&](f32x16 (&O)[1][2], float (&inv)[1], int qrow, int hh) {
        bf16_t* yo = Y + (qrow0 + qrow) * 1024 + 512 + h * 64;
#pragma unroll
        for (int d = 0; d < 2; ++d)
#pragma unroll
            for (int g = 0; g < 4; ++g) {
                const int dv = d * 32 + 8 * g + 4 * hh;
                u32x2 o;
                o.x = pack2(O[0][d][4 * g + 0] * inv[0], O[0][d][4 * g + 1] * inv[0]);
                o.y = pack2(O[0][d][4 * g + 2] * inv[0], O[0][d][4 * g + 3] * inv[0]);
                *(u32x2*)(yo + dv) = o;
            }
    };
    const bf16_t* Qp = MQ + qrow0 * 192 + h * 48;
    const bf16_t* Kl = MK + lat0 * 192 + h * 48;
    const bf16_t* Kc = MK + ctx0 * 192 + h * 48;
    const bf16_t* Vl = MV + lat0 * 256 + h * 64;
    const bf16_t* Vc = MV + ctx0 * 256 + h * 64;
    attn_item<1, 48>(Qp, 192, Kl, Kc, 192, Vl, Vc, 256, qt * 128, isctx ? 0 : SEQ / 64, CTXL / 64, epi, smem);
}
DEV int s5_token(int b, int tb, int n) { return tb == 0 ? TL + b * CTXL + n : b * SEQ + (tb - 1) * 256 + n; }
struct S5Lane { float are, aim; float bre[16], bim[16]; };
DEV void s5_setup(const Params& p, int l, int d, int g, int pl, S5Lane& s) {
    const int gi = ((l * 2 + d) * 16 + g);
    const float lre = p.in[I_S5LRE][gi * 64 + pl], lim = p.in[I_S5LIM][gi * 64 + pl];
    const float dt = __expf(p.in[I_S5LDT][gi]);
    const float mag = __expf(lre * dt);
    s.are = mag * cosf(lim * dt); s.aim = mag * sinf(lim * dt);
    const float nr = s.are - 1.f, ni = s.aim, den = 1.f / (lre * lre + lim * lim);
    const float cr = (nr * lre + ni * lim) * den, ci = (ni * lre - nr * lim) * den;
    const float* br = p.in[I_S5BRE] + ((size_t)gi * 64 + pl) * 16;
    const float* bi = p.in[I_S5BIM] + ((size_t)gi * 64 + pl) * 16;
#pragma unroll
    for (int c = 0; c < 16; ++c) { const float x = br[c], y = bi[c]; s.bre[c] = cr * x - ci * y; s.bim[c] = cr * y + ci * x; }
}
template <bool DUMP>
DEV void s5_scan32(const S5Lane& s, float& hre, float& him, const float* ub, bf16_t* hb, int pl, bool rev) {
    for (int j = 0; j < 32; ++j) {
        const int rowi = rev ? 31 - j : j;
        const float4* u4 = (const float4*)(ub + rowi * 16);
        float bur = 0.f, bui = 0.f;
#pragma unroll
        for (int q = 0; q < 4; ++q) {
            const float4 u = u4[q];
            bur += u.x * s.bre[q * 4 + 0] + u.y * s.bre[q * 4 + 1] + u.z * s.bre[q * 4 + 2] + u.w * s.bre[q * 4 + 3];
            bui += u.x * s.bim[q * 4 + 0] + u.y * s.bim[q * 4 + 1] + u.z * s.bim[q * 4 + 2] + u.w * s.bim[q * 4 + 3];
        }
        const float nre = s.are * hre - s.aim * him + bur;
        const float nim = s.are * him + s.aim * hre + bui;
        hre = nre; him = nim;
        if (DUMP) { hb[rowi * 136 + pl] = f2bf(hre); hb[rowi * 136 + 64 + pl] = f2bf(him); }
    }
}
DEV void s5_load_u(const bf16_t* P, int b, int tb, int g, int sc, float* ub, int lane) {
    if (lane < 32) {
        const int t = s5_token(b, tb, sc * 32 + lane);
        const uint4* src = (const uint4*)(P + (size_t)t * LDP + C_S5 + g * 16);
        const uint4 a = src[0], c = src[1];
        float4* d = (float4*)(ub + lane * 16);
        d[0] = make_float4(bflo(a.x), bfhi(a.x), bflo(a.y), bfhi(a.y));
        d[1] = make_float4(bflo(a.z), bfhi(a.z), bflo(a.w), bfhi(a.w));
        d[2] = make_float4(bflo(c.x), bfhi(c.x), bflo(c.y), bfhi(c.y));
        d[3] = make_float4(bflo(c.z), bfhi(c.z), bflo(c.w), bfhi(c.w));
    }
}
DEV void phase_s5_pass1(const Params& p, int l, char* smem) {
    const int lane = tidx() & 63, wave = tidx() >> 6;
    float* ub = (float*)smem + wave * 512;
    const bf16_t* P = wsb(p, OFF_P);
    float* st = wsf(p, OFF_S5ST);
    const int nitems = 2 * 8 * 16 * 8;
    for (int it0 = bidx() * 4; it0 < nitems; it0 += gridDim.x * 4) {
        const int it = it0 + wave;
        const int seg = it & 7, g = (it >> 3) & 15, b = (it >> 7) & 7, d = it >> 10;
        const int tb = seg == 0 ? 0 : (d == 0 ? seg : 9 - seg);
        S5Lane s; s5_setup(p, l, d, g, lane, s);
        float hre = 0.f, him = 0.f;
        for (int k = 0; k < 8; ++k) {
            const int sc = d == 0 ? k : 7 - k;
            __syncthreads();
            s5_load_u(P, b, tb, g, sc, ub, lane);
            __syncthreads();
            s5_scan32<false>(s, hre, him, ub, nullptr, lane, d == 1);
        }
        float* o = st + ((((size_t)d * 8 + b) * 16 + g) * 8 + seg) * 128;
        o[lane] = hre; o[64 + lane] = him;
    }
}
DEV void s5_pass2_item(const Params& p, int l, int tb0, int bitem, char* smem) {
    const int lane = tidx() & 63, wave = tidx() >> 6;
    float* ub = (float*)smem + wave * 512;
    bf16_t* hb = (bf16_t*)(smem + 8192) + wave * (32 * 136);
    bf16_t* P = wsb(p, OFF_P);
    const float* st = wsf(p, OFF_S5ST);
    {
        const int it = bitem * 4 + wave;
        const int g = it & 15, b = (it >> 4) & 7, tb = (it >> 7) + tb0;
        f32x4 yacc[16];
#pragma unroll
        for (int i = 0; i < 16; ++i) yacc[i] = (f32x4){0.f, 0.f, 0.f, 0.f};
#pragma unroll
        for (int d = 0; d < 2; ++d) {
            S5Lane s; s5_setup(p, l, d, g, lane, s);
            bf16x8 cf[4];
            {
                const int gi = ((l * 2 + d) * 16 + g), c = lane & 15, kq = lane >> 4;
                const float* cre = p.in[I_S5CRE] + ((size_t)gi * 16 + c) * 64;
                const float* cim = p.in[I_S5CIM] + ((size_t)gi * 16 + c) * 64;
#pragma unroll
                for (int ks = 0; ks < 4; ++ks)
#pragma unroll
                    for (int j = 0; j < 8; ++j) {
                        const int k = ks * 32 + kq * 8 + j;
                        const float v = k < 64 ? cre[k] : -cim[k - 64];
                        cf[ks][j] = (short)f2bf(v);
                    }
            }
            const int seg = tb == 0 ? 0 : (d == 0 ? tb : 9 - tb);
            float hre = 0.f, him = 0.f;
            {
                float pr = s.are, pi = s.aim;
#pragma unroll
                for (int q = 0; q < 8; ++q) { const float nr = pr * pr - pi * pi, ni = 2.f * pr * pi; pr = nr; pi = ni; }
                const float* hs = st + (((size_t)d * 8 + b) * 16 + g) * 8 * 128;
                for (int i = 0; i < seg; ++i) {
                    const float er = hs[i * 128 + lane], ei = hs[i * 128 + 64 + lane];
                    const float nr = pr * hre - pi * him + er, ni = pr * him + pi * hre + ei;
                    hre = nr; him = ni;
                }
            }
#pragma unroll
            for (int k = 0; k < 8; ++k) {
                const int sc = d == 0 ? k : 7 - k;
                __syncthreads();
                s5_load_u(P, b, tb, g, sc, ub, lane);
                __syncthreads();
                s5_scan32<true>(s, hre, him, ub, hb, lane, d == 1);
                __syncthreads();
#pragma unroll
                for (int mt = 0; mt < 2; ++mt)
#pragma unroll
                    for (int ks = 0; ks < 4; ++ks) {
                        const bf16x8 af = *(const bf16x8*)(hb + (mt * 16 + (lane & 15)) * 136 + ks * 32 + (lane >> 4) * 8);
                        yacc[sc * 2 + mt] = __builtin_amdgcn_mfma_f32_16x16x32_bf16(af, cf[ks], yacc[sc * 2 + mt], 0, 0, 0);
                    }
            }
        }
        {
            const int c = lane & 15;
            const float dd = p.in[I_S5D][(l * 16 + g) * 16 + c];
#pragma unroll
            for (int tile = 0; tile < 16; ++tile)
#pragma unroll
                for (int r = 0; r < 4; ++r) {
                    const int n = tile * 16 + (lane >> 4) * 4 + r;
                    bf16_t* up = P + (size_t)s5_token(b, tb, n) * LDP + C_S5 + g * 16 + c;
                    const float y = dd * bf2f(*up) + yacc[tile][r];
                    const float z = 0.5f * y * (1.f + tanhf(0.7978845608028654f * (y + 0.044715f * y * y * y)));
                    *up = f2bf(z);
                }
        }
    }
}

DEV float row16_sum(float v) {
    v += __int_as_float(__builtin_amdgcn_mov_dpp(__float_as_int(v), 0x128, 0xf, 0xf, true));
    v += __int_as_float(__builtin_amdgcn_mov_dpp(__float_as_int(v), 0x124, 0xf, 0xf, true));
    v += __int_as_float(__builtin_amdgcn_mov_dpp(__float_as_int(v), 0x122, 0xf, 0xf, true));
    v += __int_as_float(__builtin_amdgcn_mov_dpp(__float_as_int(v), 0x121, 0xf, 0xf, true));
    return v;
}
DEV float fmul_(float a, float b) { return a * b; }
DEV float fadd_(float a, float b) { return a + b; }
DEV float ffma_(float a, float b, float c) { return __builtin_fmaf(a, b, c); }
DEV float fnma_(float a, float b, float c) { return __builtin_fmaf(-a, b, c); }
DEV float row8_sum(float v) {
    v += __int_as_float(__builtin_amdgcn_mov_dpp(__float_as_int(v), 0x141, 0xf, 0xf, true));
    v += __int_as_float(__builtin_amdgcn_mov_dpp(__float_as_int(v), 0xB1, 0xf, 0xf, true));
    v += __int_as_float(__builtin_amdgcn_mov_dpp(__float_as_int(v), 0x4E, 0xf, 0xf, true));
    return v;
}
DEV float row16_sum1(float v) { v += __int_as_float(__builtin_amdgcn_mov_dpp(__float_as_int(v), 0x128, 0xf, 0xf, true)); return v; }
constexpr int RW_CT = 16;
struct RwRaw { u32x2 r[3], k[3], v[3], sd, a; float fp, fn; };
#ifndef RWVAR
#define RWVAR 0
#endif
template <int var>
DEV void rw_item_t(const Params& p, int l, int item, char* smem, int rep) {
    const int tid = tidx(), li = tid >> 4, lc = tid & 15;
    const int ch = item >> 2, rg = item & 3, dir = ch >> 5, b = (ch >> 2) & 7, head = ch & 3;
    float* buf = (float*)smem;
    float* ybuf = buf + 2 * RW_CT * 384;
    const bf16_t* P = wsb(p, OFF_P);
    const bf16_t* RWX = wsb(p, OFF_RWX);
    bf16_t* RWY = wsb(p, OFF_RWY) + (size_t)dir * TT * 256 + (rep > 0 ? (size_t)2 * TT * 256 : 0);
    const int hc = head * 64 + lc * 4;
    const float4 mur = *(const float4*)(p.in[I_RMU] + (l * 4 + 0) * 256 + hc);
    const float4 muk = *(const float4*)(p.in[I_RMU] + (l * 4 + 1) * 256 + hc);
    const float4 muv = *(const float4*)(p.in[I_RMU] + (l * 4 + 2) * 256 + hc);
    const float4 kk4 = *(const float4*)(p.in[I_RKK] + l * 256 + hc);
    const float4 ka4 = *(const float4*)(p.in[I_RKA] + l * 256 + hc);
    const int NCH = (CTXL + SEQ) / RW_CT;
    auto tok_of = [&](int cidx, int i, int& n, int& len) -> int {
        if (cidx < CTXL / RW_CT) { const int pos = cidx * RW_CT + i; len = CTXL; n = dir == 0 ? pos : CTXL - 1 - pos; return TL + b * CTXL + n; }
        const int pos = (cidx - CTXL / RW_CT) * RW_CT + i; len = SEQ; n = dir == 0 ? pos : SEQ - 1 - pos; return b * SEQ + n;
    };
    auto load_raw = [&](int cidx, RwRaw& raw) {
        int n, len; const int t = tok_of(cidx, li, n, len);
        const bf16_t* row = P + (size_t)t * LDP;
        const bool hp = n > 0, hn = n + 1 < len;
        const bf16_t* rp = hp ? row - LDP : row;
        const bf16_t* rn = hn ? row + LDP : row;
        raw.fp = hp ? 0.5f : 0.f; raw.fn = hn ? 0.5f : 0.f;
        raw.r[1] = *(const u32x2*)(row + C_RWR + hc); raw.k[1] = *(const u32x2*)(row + C_RWK + hc); raw.v[1] = *(const u32x2*)(row + C_RWV + hc);
        raw.r[0] = *(const u32x2*)(rp + C_RWR + hc); raw.k[0] = *(const u32x2*)(rp + C_RWK + hc); raw.v[0] = *(const u32x2*)(rp + C_RWV + hc);
        raw.r[2] = *(const u32x2*)(rn + C_RWR + hc); raw.k[2] = *(const u32x2*)(rn + C_RWK + hc); raw.v[2] = *(const u32x2*)(rn + C_RWV + hc);
        raw.sd = *(const u32x2*)(RWX + (size_t)t * 1024 + dir * 256 + hc);
        raw.a = *(const u32x2*)(RWX + (size_t)t * 1024 + 512 + dir * 256 + hc);
    };
    auto mix4 = [&](const u32x2 (&s)[3], const float4& mu, float fp, float fn, float (&o)[4]) {
        { const float x = bflo(s[1].x); o[0] = x + ((fp * bflo(s[0].x) + fn * bflo(s[2].x)) - x) * mu.x; }
        { const float x = bfhi(s[1].x); o[1] = x + ((fp * bfhi(s[0].x) + fn * bfhi(s[2].x)) - x) * mu.y; }
        { const float x = bflo(s[1].y); o[2] = x + ((fp * bflo(s[0].y) + fn * bflo(s[2].y)) - x) * mu.z; }
        { const float x = bfhi(s[1].y); o[3] = x + ((fp * bfhi(s[0].y) + fn * bfhi(s[2].y)) - x) * mu.w; }
    };
    auto stage = [&](int st, const RwRaw& raw) {
        float r4[4], k4[4], v4[4];
        mix4(raw.r, mur, raw.fp, raw.fn, r4); mix4(raw.k, muk, raw.fp, raw.fn, k4); mix4(raw.v, muv, raw.fp, raw.fn, v4);
        const float kkr[4] = { k4[0] * kk4.x, k4[1] * kk4.y, k4[2] * kk4.z, k4[3] * kk4.w };
        float nn = kkr[0] * kkr[0] + kkr[1] * kkr[1] + kkr[2] * kkr[2] + kkr[3] * kkr[3];
        nn = row16_sum(nn);
        const float rn = 1.f / fmaxf(sqrtf(nn), 1e-12f);
        const float a[4] = { bflo(raw.a.x), bfhi(raw.a.x), bflo(raw.a.y), bfhi(raw.a.y) };
        const float sd[4] = { bflo(raw.sd.x), bfhi(raw.sd.x), bflo(raw.sd.y), bfhi(raw.sd.y) };
        const float kav[4] = { ka4.x, ka4.y, ka4.z, ka4.w };
        float* d = buf + (st * RW_CT + li) * 384 + lc * 4;
        float wp[4], kp[4], bp[4], mp[4];
#pragma unroll
        for (int j = 0; j < 4; ++j) {
            wp[j] = __expf(-sd[j]);
            kp[j] = kkr[j] * rn;
            bp[j] = kp[j] * a[j];
            mp[j] = k4[j] * (1.f + (a[j] - 1.f) * kav[j]);
        }
        *(float4*)(d + 0) = make_float4(wp[0], wp[1], wp[2], wp[3]); *(float4*)(d + 64) = make_float4(kp[0], kp[1], kp[2], kp[3]);
        *(float4*)(d + 128) = make_float4(bp[0], bp[1], bp[2], bp[3]); *(float4*)(d + 192) = make_float4(mp[0], mp[1], mp[2], mp[3]);
        *(float4*)(d + 256) = make_float4(r4[0], r4[1], r4[2], r4[3]);
        *(float4*)(d + 320) = make_float4(v4[0], v4[1], v4[2], v4[3]);
    };
    float S0 = 0.f, S1 = 0.f, S2 = 0.f, S3 = 0.f;
    auto compute = [&](int cidx, int cur) {
        const float* cb = buf + cur * RW_CT * 384 + lc * 4;
        const float* vb = buf + cur * RW_CT * 384 + 320 + rg * 16 + li;
        float ykeep = 0.f;
        f32x4 w[3], kk[3], bb[3], km[3], rr[3]; float vv[3];
#pragma unroll
        for (int q = 0; q < 2; ++q) {
            const float* nb = cb + q * 384;
            w[q] = *(const f32x4*)(nb); kk[q] = *(const f32x4*)(nb + 64); bb[q] = *(const f32x4*)(nb + 128); km[q] = *(const f32x4*)(nb + 192); rr[q] = *(const f32x4*)(nb + 256);
            vv[q] = vb[q * 384];
        }
#pragma unroll
        for (int j = 0; j < RW_CT; ++j) {
            const int c0 = j % 3, c2 = (j + 2) % 3;
            if (j + 2 < RW_CT) {
                const float* nb = cb + (j + 2) * 384;
                w[c2] = *(const f32x4*)(nb); kk[c2] = *(const f32x4*)(nb + 64); bb[c2] = *(const f32x4*)(nb + 128); km[c2] = *(const f32x4*)(nb + 192); rr[c2] = *(const f32x4*)(nb + 256);
                vv[c2] = vb[(j + 2) * 384];
            }
            const float v_ = vv[c0];
            float sa = fadd_(ffma_(S1, kk[c0][1], fmul_(S0, kk[c0][0])), ffma_(S3, kk[c0][3], fmul_(S2, kk[c0][2])));
            const float t0 = ffma_(S0, w[c0][0], fmul_(v_, km[c0][0])), t1 = ffma_(S1, w[c0][1], fmul_(v_, km[c0][1]));
            const float t2 = ffma_(S2, w[c0][2], fmul_(v_, km[c0][2])), t3 = ffma_(S3, w[c0][3], fmul_(v_, km[c0][3]));
            sa = row16_sum(sa);
            S0 = fnma_(sa, bb[c0][0], t0); S1 = fnma_(sa, bb[c0][1], t1); S2 = fnma_(sa, bb[c0][2], t2); S3 = fnma_(sa, bb[c0][3], t3);
            float y = fadd_(ffma_(S1, rr[c0][1], fmul_(S0, rr[c0][0])), ffma_(S3, rr[c0][3], fmul_(S2, rr[c0][2])));
            y = row16_sum(y);
            ykeep = (lc == j) ? y : ykeep;
        }
        {
            int n, len; const int t = tok_of(cidx, lc, n, len);
            RWY[(size_t)t * 256 + head * 64 + rg * 16 + li] = f2bf(ykeep);
        }
    };
    RwRaw rawA, rawB;
    __syncthreads();
    load_raw(0, rawA);
    load_raw(1, rawB);
    stage(0, rawA);
    __syncthreads();
    for (int cidx = 0; cidx < NCH; cidx += 2) {
        if (var != 1) load_raw(min(cidx + 2, NCH - 1), rawA);
        if (var != 2) compute(cidx, 0);
        if (var != 1 && var != 3) stage(1, rawB);
        if (var != 4) __syncthreads();
        if (var != 1) load_raw(min(cidx + 3, NCH - 1), rawB);
        if (var != 2) compute(cidx + 1, 1);
        if (var != 1 && var != 3) { if (cidx + 2 < NCH) stage(0, rawA); }
        if (var != 4) __syncthreads();
    }
}

DEV void rw_item(const Params& p, int l, int item, char* smem, int rep = 0) {
    rw_item_t<RWVAR>(p, l, item, smem, rep);
}
constexpr int RC = 32, SK = 72, ST = 40;
constexpr int L_K1 = 0, L_R1 = L_K1 + RC * SK, L_B1 = L_R1 + RC * SK, L_M1 = L_B1 + RC * SK,
              L_VT = L_M1 + RC * SK, L_B2T = L_VT + 64 * ST, L_M2T = L_B2T + 64 * ST,
              L_X = L_M2T + 64 * ST, L_XT = L_X + RC * ST, L_PA = L_XT + RC * ST, L_BM = L_PA + RC * ST, L_AR = L_BM + RC * ST, L_BR = L_AR + RC * ST,
              L_ET = L_BR + RC * ST, L_ZT = L_ET + 64 * ST, L_S = L_ZT + 64 * ST, L_RWEND = L_S + 64 * SK;
static_assert(L_RWEND * 2 + 256 <= 73728, "RWKV chunk LDS");
DEV bf16x8 ldfrag(const bf16_t* m, int stride, int row0, int k0, int lane) { return *(const bf16x8*)(m + (row0 + (lane & 15)) * stride + k0 + (lane >> 4) * 8); }
DEV f32x4 mfma16(bf16x8 a, bf16x8 b, f32x4 c) { return __builtin_amdgcn_mfma_f32_16x16x32_bf16(a, b, c, 0, 0, 0); }
#ifndef RWC_CLAMP
#define RWC_CLAMP 0
#endif
DEV void st4(bf16_t* dst, f32x4 v) {
    if (RWC_CLAMP) { for (int i = 0; i < 4; ++i) v[i] = fminf(fmaxf(v[i], -8.f), 8.f); } u32x2 o; o.x = pack2(v[0], v[1]); o.y = pack2(v[2], v[3]); *(u32x2*)dst = o; }
DEV void unpack8(const u32x4 u, float (&o)[8]) {
    o[0] = bflo(u[0]); o[1] = bfhi(u[0]); o[2] = bflo(u[1]); o[3] = bfhi(u[1]); o[4] = bflo(u[2]); o[5] = bfhi(u[2]); o[6] = bflo(u[3]); o[7] = bfhi(u[3]);
}
DEV u32x4 pack8(const float (&v)[8]) { return (u32x4){pack2(v[0], v[1]), pack2(v[2], v[3]), pack2(v[4], v[5]), pack2(v[6], v[7])}; }
struct RwcRaw { u32x4 r[3], k[3], v[3], sd, a; float fp, fn; };
#ifndef RWC_STOP
#define RWC_STOP 99
#endif
#ifndef RWC_DUMMY
#define RWC_DUMMY 0
#endif
#ifdef RWC_NOINLINE
__device__ __attribute__((noinline)) void rwc_item(const Params& p, int l, int chain, char* smem) {
#else
DEV void rwc_item(const Params& p, int l, int chain, char* smem) {
#endif
    const int tid = tidx(), lane = tid & 63, wave = __builtin_amdgcn_readfirstlane(tid >> 6), c16 = lane & 15, q4 = lane >> 4;
    const int dir = chain >> 5, b = (chain >> 2) & 7, head = chain & 3;
    bf16_t* L = (bf16_t*)smem;
    float* PC = (float*)(smem + L_RWEND * 2);
    float* CS = (float*)(L + L_ET);
    const bf16_t* P = wsb(p, OFF_P);
    const bf16_t* RWX = wsb(p, OFF_RWX);
    bf16_t* RWY = wsb(p, OFF_RWY) + (size_t)dir * TT * 256 + (RWC_DUMMY ? (size_t)2 * TT * 256 : 0);
    const int li = tid >> 3, c8 = (tid & 7) * 8, hc = head * 64 + c8;
    const int NCHK = (CTXL + SEQ) / RC;
    auto tok_of = [&](int c, int i, int& n, int& len) -> int {
        if (c < CTXL / RC) { const int pos = c * RC + i; len = CTXL; n = dir == 0 ? pos : CTXL - 1 - pos; return TL + b * CTXL + n; }
        const int pos = (c - CTXL / RC) * RC + i; len = SEQ; n = dir == 0 ? pos : SEQ - 1 - pos; return b * SEQ + n;
    };
    RwcRaw raw;
    auto load_raw = [&](int c) {
        int n, len; const int t = tok_of(c, li, n, len);
        const bf16_t* row = P + (size_t)t * LDP;
        const bool hp = n > 0, hn = n + 1 < len;
        const bf16_t* rp = hp ? row - LDP : row;
        const bf16_t* rn = hn ? row + LDP : row;
        raw.fp = hp ? 0.5f : 0.f; raw.fn = hn ? 0.5f : 0.f;
        raw.r[1] = *(const u32x4*)(row + C_RWR + hc); raw.k[1] = *(const u32x4*)(row + C_RWK + hc); raw.v[1] = *(const u32x4*)(row + C_RWV + hc);
        raw.r[0] = *(const u32x4*)(rp + C_RWR + hc); raw.k[0] = *(const u32x4*)(rp + C_RWK + hc); raw.v[0] = *(const u32x4*)(rp + C_RWV + hc);
        raw.r[2] = *(const u32x4*)(rn + C_RWR + hc); raw.k[2] = *(const u32x4*)(rn + C_RWK + hc); raw.v[2] = *(const u32x4*)(rn + C_RWV + hc);
        raw.sd = *(const u32x4*)(RWX + (size_t)t * 1024 + dir * 256 + hc);
        raw.a = *(const u32x4*)(RWX + (size_t)t * 1024 + 512 + dir * 256 + hc);
    };
    auto mix8 = [&](const u32x4 (&s)[3], const float* mu, float (&o)[8]) {
        float x[8], pv[8], nx[8]; unpack8(s[1], x); unpack8(s[0], pv); unpack8(s[2], nx);
        const float4 m0 = *(const float4*)mu, m1 = *(const float4*)(mu + 4);
        const float m[8] = { m0.x, m0.y, m0.z, m0.w, m1.x, m1.y, m1.z, m1.w };
#pragma unroll
        for (int j = 0; j < 8; ++j) o[j] = x[j] + ((raw.fp * pv[j] + raw.fn * nx[j]) - x[j]) * m[j];
    };
    f32x4 Wt[4];
#pragma unroll
    for (int j = 0; j < 4; ++j) Wt[j] = (f32x4){0.f, 0.f, 0.f, 0.f};
    __syncthreads();
    for (int i = tid; i < 64 * SK / 2; i += NT) ((unsigned*)(L + L_S))[i] = 0u;
    load_raw(0);
    for (int c = 0; c < (RWC_STOP == 0 ? 0 : NCHK); ++c) {
        {
            float r8[8], k8[8], v8[8], a8[8], sd8[8];
            mix8(raw.r, p.in[I_RMU] + (l * 4 + 0) * 256 + hc, r8);
            mix8(raw.k, p.in[I_RMU] + (l * 4 + 1) * 256 + hc, k8);
            mix8(raw.v, p.in[I_RMU] + (l * 4 + 2) * 256 + hc, v8);
            unpack8(raw.a, a8); unpack8(raw.sd, sd8);
            if (c + 1 < NCHK) load_raw(c + 1);
            const float4 kk0 = *(const float4*)(p.in[I_RKK] + l * 256 + hc), kk1 = *(const float4*)(p.in[I_RKK] + l * 256 + hc + 4);
            const float4 ka0 = *(const float4*)(p.in[I_RKA] + l * 256 + hc), ka1 = *(const float4*)(p.in[I_RKA] + l * 256 + hc + 4);
            const float kkc[8] = { kk0.x, kk0.y, kk0.z, kk0.w, kk1.x, kk1.y, kk1.z, kk1.w };
            const float kac[8] = { ka0.x, ka0.y, ka0.z, ka0.w, ka1.x, ka1.y, ka1.z, ka1.w };
            float kkv[8], bbv[8], kmv[8]; float n2 = 0.f;
#pragma unroll
            for (int j = 0; j < 8; ++j) { kkv[j] = k8[j] * kkc[j]; n2 += kkv[j] * kkv[j]; }
            n2 = row8_sum(n2);
            const float rn = 1.f / fmaxf(sqrtf(n2), 1e-12f);
#pragma unroll
            for (int j = 0; j < 8; ++j) { kkv[j] *= rn; bbv[j] = kkv[j] * a8[j]; kmv[j] = k8[j] * (1.f + (a8[j] - 1.f) * kac[j]); }
            *(float4*)(CS + li * 64 + c8) = make_float4(sd8[0], sd8[1], sd8[2], sd8[3]);
            *(float4*)(CS + li * 64 + c8 + 4) = make_float4(sd8[4], sd8[5], sd8[6], sd8[7]);
            __syncthreads();
            if (tid < 64) { float run = 0.f; for (int i = 0; i < RC; ++i) { run += CS[i * 64 + tid]; CS[i * 64 + tid] = run; } }
            __syncthreads();
            float cs[8], tot[8];
            { const float4 a0 = *(const float4*)(CS + li * 64 + c8), a1 = *(const float4*)(CS + li * 64 + c8 + 4);
              const float4 t0 = *(const float4*)(CS + (RC - 1) * 64 + c8), t1 = *(const float4*)(CS + (RC - 1) * 64 + c8 + 4);
              cs[0] = a0.x; cs[1] = a0.y; cs[2] = a0.z; cs[3] = a0.w; cs[4] = a1.x; cs[5] = a1.y; cs[6] = a1.z; cs[7] = a1.w;
              tot[0] = t0.x; tot[1] = t0.y; tot[2] = t0.z; tot[3] = t0.w; tot[4] = t1.x; tot[5] = t1.y; tot[6] = t1.z; tot[7] = t1.w; }
            float k1[8], r1[8], b1[8], m1[8], b2[8], m2[8];
#pragma unroll
            for (int j = 0; j < 8; ++j) {
                const float pinc = __expf(-cs[j]), pexc = __expf(sd8[j] - cs[j]), einv = __expf(cs[j]), ec = __expf(cs[j] - tot[j]);
                k1[j] = kkv[j] * pexc; r1[j] = r8[j] * pinc; b1[j] = bbv[j] * einv; m1[j] = kmv[j] * einv; b2[j] = bbv[j] * ec; m2[j] = kmv[j] * ec;
            }
            __syncthreads();
            *(u32x4*)(L + L_K1 + li * SK + c8) = pack8(k1); *(u32x4*)(L + L_R1 + li * SK + c8) = pack8(r1);
            *(u32x4*)(L + L_B1 + li * SK + c8) = pack8(b1); *(u32x4*)(L + L_M1 + li * SK + c8) = pack8(m1);
#pragma unroll
            for (int j = 0; j < 8; ++j) {
                L[L_VT + (c8 + j) * ST + li] = f2bf(v8[j]); L[L_B2T + (c8 + j) * ST + li] = f2bf(b2[j]); L[L_M2T + (c8 + j) * ST + li] = f2bf(m2[j]);
            }
            if (li == RC - 1) {
#pragma unroll
                for (int j = 0; j < 8; ++j) PC[c8 + j] = __expf(-tot[j]);
            }
            __syncthreads();
        }
        if (RWC_STOP <= 1) continue;
        {
            const int i0 = wave >> 1, j0 = wave & 1;
            const f32x4 z4 = (f32x4){0.f, 0.f, 0.f, 0.f};
            f32x4 aS = z4, aU = z4, bm = z4, ar = z4, br = z4;
#pragma unroll
            for (int kk2 = 0; kk2 < 2; ++kk2) {
                const bf16x8 k1i = ldfrag(L + L_K1, SK, i0 * 16, kk2 * 32, lane), k1j = ldfrag(L + L_K1, SK, j0 * 16, kk2 * 32, lane);
                const bf16x8 b1i = ldfrag(L + L_B1, SK, i0 * 16, kk2 * 32, lane), b1j = ldfrag(L + L_B1, SK, j0 * 16, kk2 * 32, lane);
                const bf16x8 m1i = ldfrag(L + L_M1, SK, i0 * 16, kk2 * 32, lane), r1j = ldfrag(L + L_R1, SK, j0 * 16, kk2 * 32, lane);
                aS = mfma16(b1i, k1j, aS);
                aU = mfma16(k1i, b1j, aU);
                bm = mfma16(m1i, k1j, bm);
                ar = mfma16(b1i, r1j, ar);
                br = mfma16(m1i, r1j, br);
            }
#ifdef RWC_WAIT
            __builtin_amdgcn_sched_barrier(0); __builtin_amdgcn_s_sleep(2); __builtin_amdgcn_sched_barrier(0);
#endif
            {
                const int t = j0 * 16 + c16, s0 = i0 * 16 + q4 * 4;
                f32x4 x, pa, o1, o2, o3;
#pragma unroll
                for (int r = 0; r < 4; ++r) {
                    const bool lt = s0 + r < t, le = s0 + r <= t;
                    x[r] = lt ? -aS[r] : 0.f; pa[r] = x[r] + ((s0 + r == t) ? 1.f : 0.f);
                    o1[r] = lt ? bm[r] : 0.f; o2[r] = le ? ar[r] : 0.f; o3[r] = le ? br[r] : 0.f;
                }
#ifdef RWC_GSTORE
                { bf16_t* gd = wsb(p, OFF_RWY) + (size_t)2 * TT * 256 + (size_t)(bidx() * 256 + tid) * 32;
                  st4(gd, x); st4(gd + 4, pa); st4(gd + 8, o1); st4(gd + 12, o2); st4(gd + 16, o3); }
#else
                st4(L + L_X + t * ST + s0, x); st4(L + L_PA + t * ST + s0, pa);
                st4(L + L_BM + t * ST + s0, o1); st4(L + L_AR + t * ST + s0, o2); st4(L + L_BR + t * ST + s0, o3);
#endif
            }
            {
                const int s = j0 * 16 + c16, t0 = i0 * 16 + q4 * 4;
                f32x4 o;
#pragma unroll
                for (int r = 0; r < 4; ++r) o[r] = (s < t0 + r) ? -aU[r] : 0.f;
#ifdef RWC_GSTORE
                st4(wsb(p, OFF_RWY) + (size_t)2 * TT * 256 + (size_t)(bidx() * 256 + tid) * 32 + 20, o);
#else
                st4(L + L_XT + s * ST + t0, o);
#endif
            }
            __syncthreads();
        }
        if (RWC_STOP <= 2) continue;
#pragma unroll 1
        for (int rd = 1; rd <= 5; ++rd) {
            const bool sq = rd <= 4, up = rd >= 2;
            const int i0 = wave >> 1, j0 = wave & 1;
            const bf16x8 xti = ldfrag(L + L_XT, ST, i0 * 16, 0, lane), xtj = ldfrag(L + L_XT, ST, j0 * 16, 0, lane);
            const bf16x8 xi = ldfrag(L + L_X, ST, i0 * 16, 0, lane), xj = ldfrag(L + L_X, ST, j0 * 16, 0, lane);
            const bf16x8 paj = ldfrag(L + L_PA, ST, j0 * 16, 0, lane);
            const u32x2 old = *(const u32x2*)(L + L_PA + (j0 * 16 + c16) * ST + i0 * 16 + q4 * 4);
            __syncthreads();
            const f32x4 z4 = (f32x4){0.f, 0.f, 0.f, 0.f};
            if (sq) {
                const f32x4 nx = mfma16(xti, xj, z4);
                const f32x4 nxt = mfma16(xi, xtj, z4);
                st4(L + L_X + (j0 * 16 + c16) * ST + i0 * 16 + q4 * 4, nx);
                st4(L + L_XT + (j0 * 16 + c16) * ST + i0 * 16 + q4 * 4, nxt);
            }
            if (up) {
                f32x4 acc = (f32x4){bflo(old.x), bfhi(old.x), bflo(old.y), bfhi(old.y)};
                acc = mfma16(xti, paj, acc);
                st4(L + L_PA + (j0 * 16 + c16) * ST + i0 * 16 + q4 * 4, acc);
            }
            __syncthreads();
        }
        if (RWC_STOP <= 3) continue;
        {
            const int vj = wave;
#pragma unroll
            for (int ti = 0; ti < 2; ++ti) {
                f32x4 acc = mfma16(ldfrag(L + L_BM, ST, ti * 16, 0, lane), ldfrag(L + L_VT, ST, vj * 16, 0, lane), (f32x4){0.f, 0.f, 0.f, 0.f});
#pragma unroll
                for (int kk2 = 0; kk2 < 2; ++kk2) acc = mfma16(ldfrag(L + L_K1, SK, ti * 16, kk2 * 32, lane), ldfrag(L + L_S, SK, vj * 16, kk2 * 32, lane), acc);
                st4(L + L_ET + (vj * 16 + c16) * ST + ti * 16 + q4 * 4, acc);
            }
            __syncthreads();
#pragma unroll
            for (int ti = 0; ti < 2; ++ti) {
                const f32x4 acc = mfma16(ldfrag(L + L_PA, ST, ti * 16, 0, lane), ldfrag(L + L_ET, ST, vj * 16, 0, lane), (f32x4){0.f, 0.f, 0.f, 0.f});
                st4(L + L_ZT + (vj * 16 + c16) * ST + ti * 16 + q4 * 4, -acc);
            }
            __syncthreads();
        }
        if (RWC_STOP <= 4) continue;
        {
            const int vi = wave;
#pragma unroll
            for (int tj = 0; tj < 2; ++tj) {
                f32x4 acc = (f32x4){0.f, 0.f, 0.f, 0.f};
#pragma unroll
                for (int kk2 = 0; kk2 < 2; ++kk2) acc = mfma16(ldfrag(L + L_S, SK, vi * 16, kk2 * 32, lane), ldfrag(L + L_R1, SK, tj * 16, kk2 * 32, lane), acc);
                acc = mfma16(ldfrag(L + L_ZT, ST, vi * 16, 0, lane), ldfrag(L + L_AR, ST, tj * 16, 0, lane), acc);
                acc = mfma16(ldfrag(L + L_VT, ST, vi * 16, 0, lane), ldfrag(L + L_BR, ST, tj * 16, 0, lane), acc);
                int n, len; const int t = tok_of(c, tj * 16 + c16, n, len);
                u32x2 o; o.x = pack2(acc[0], acc[1]); o.y = pack2(acc[2], acc[3]);
#ifndef RWC_NOYSTORE
                *(u32x2*)(RWY + (size_t)t * 256 + head * 64 + vi * 16 + q4 * 4) = o;
#else
                asm volatile("" :: "v"(o), "v"(t));
#endif
            }
            const float4 pc = *(const float4*)(PC + wave * 16 + q4 * 4);
            const bf16x8 fb2 = ldfrag(L + L_B2T, ST, wave * 16, 0, lane), fm2 = ldfrag(L + L_M2T, ST, wave * 16, 0, lane);
#pragma unroll
            for (int vj = 0; vj < 4; ++vj) {
                f32x4 acc = Wt[vj];
                acc[0] *= pc.x; acc[1] *= pc.y; acc[2] *= pc.z; acc[3] *= pc.w;
                acc = mfma16(fb2, ldfrag(L + L_ZT, ST, vj * 16, 0, lane), acc);
                acc = mfma16(fm2, ldfrag(L + L_VT, ST, vj * 16, 0, lane), acc);
                Wt[vj] = acc;
            }
            __syncthreads();
#pragma unroll
            for (int vj = 0; vj < 4; ++vj) st4(L + L_S + (vj * 16 + c16) * SK + wave * 16 + q4 * 4, Wt[vj]);
        }
    }
    __syncthreads();
#ifdef RWC_ZERO_LDS
    for (int i = tid; i < 73728 / 4; i += NT) ((unsigned*)smem)[i] = 0u;
    __syncthreads();
#endif
}
DEV void phase_s5_glu(const Params& p, int l, int M, char* smem) {
    const bf16_t* P = wsb(p, OFF_P);
    const bf16_t* w = wsb(p, OFF_WSM) + (size_t)l * WS_PER_LAYER + WS_GLUT;
    bf16_t* Y = wsb(p, OFF_Y);
    const float* bg = p.in[I_S5BGLU] + l * 256;
    gemm_generic(P + C_S5, LDP, M, w, 256, 256, 256,
                 [&](int r, int c, float v) { const float z = bf2f(P[(size_t)r * LDP + C_S5 + c]); Y[(size_t)r * 1024 + 256 + c] = f2bf(z * sigmoidf_(v + bg[c])); }, smem, 0);
}
DEV void phase_rw_finish(const Params& p, int l, int M) {
    const int lane = tidx() & 63, wave = tidx() >> 6;
    const bf16_t* P = wsb(p, OFF_P);
    const bf16_t* RWX = wsb(p, OFF_RWX);
    const bf16_t* RWY = wsb(p, OFF_RWY);
    bf16_t* Y = wsb(p, OFF_Y);
    const int c = lane * 4;
    const float4 mur = *(const float4*)(p.in[I_RMU] + (l * 4 + 0) * 256 + c);
    const float4 muk = *(const float4*)(p.in[I_RMU] + (l * 4 + 1) * 256 + c);
    const float4 muv = *(const float4*)(p.in[I_RMU] + (l * 4 + 2) * 256 + c);
    const float4 ka4 = *(const float4*)(p.in[I_RKA] + l * 256 + c);
    const float4 rk4 = *(const float4*)(p.in[I_RRK] + l * 256 + c);
    const float4 lg4 = *(const float4*)(p.in[I_RLNG] + l * 256 + c);
    const float4 lb4 = *(const float4*)(p.in[I_RLNB] + l * 256 + c);
    const float mr_[4] = { mur.x, mur.y, mur.z, mur.w }, mk_[4] = { muk.x, muk.y, muk.z, muk.w }, mv_[4] = { muv.x, muv.y, muv.z, muv.w };
    const float ka_[4] = { ka4.x, ka4.y, ka4.z, ka4.w }, rk_[4] = { rk4.x, rk4.y, rk4.z, rk4.w }, lg_[4] = { lg4.x, lg4.y, lg4.z, lg4.w }, lb_[4] = { lb4.x, lb4.y, lb4.z, lb4.w };
    for (int t = bidx() * 4 + wave; t < M; t += gridDim.x * 4) {
        int base, n, len; tok_seq(t, base, n, len);
        const bf16_t* row = P + (size_t)t * LDP;
        const bool hp = n > 0, hn = n + 1 < len;
        const u32x2 z = (u32x2){0u, 0u};
        float r4[4], k4[4], v4[4];
        {
            const u32x2 cu = *(const u32x2*)(row + C_RWR + c), pv = hp ? *(const u32x2*)(row - LDP + C_RWR + c) : z, nx = hn ? *(const u32x2*)(row + LDP + C_RWR + c) : z;
            const float x[4] = { bflo(cu.x), bfhi(cu.x), bflo(cu.y), bfhi(cu.y) }, a[4] = { bflo(pv.x), bfhi(pv.x), bflo(pv.y), bfhi(pv.y) }, b[4] = { bflo(nx.x), bfhi(nx.x), bflo(nx.y), bfhi(nx.y) };
#pragma unroll
            for (int j = 0; j < 4; ++j) r4[j] = x[j] + (0.5f * (a[j] + b[j]) - x[j]) * mr_[j];
        }
        {
            const u32x2 cu = *(const u32x2*)(row + C_RWK + c), pv = hp ? *(const u32x2*)(row - LDP + C_RWK + c) : z, nx = hn ? *(const u32x2*)(row + LDP + C_RWK + c) : z;
            const float x[4] = { bflo(cu.x), bfhi(cu.x), bflo(cu.y), bfhi(cu.y) }, a[4] = { bflo(pv.x), bfhi(pv.x), bflo(pv.y), bfhi(pv.y) }, b[4] = { bflo(nx.x), bfhi(nx.x), bflo(nx.y), bfhi(nx.y) };
#pragma unroll
            for (int j = 0; j < 4; ++j) k4[j] = x[j] + (0.5f * (a[j] + b[j]) - x[j]) * mk_[j];
        }
        {
            const u32x2 cu = *(const u32x2*)(row + C_RWV + c), pv = hp ? *(const u32x2*)(row - LDP + C_RWV + c) : z, nx = hn ? *(const u32x2*)(row + LDP + C_RWV + c) : z;
            const float x[4] = { bflo(cu.x), bfhi(cu.x), bflo(cu.y), bfhi(cu.y) }, a[4] = { bflo(pv.x), bfhi(pv.x), bflo(pv.y), bfhi(pv.y) }, b[4] = { bflo(nx.x), bfhi(nx.x), bflo(nx.y), bfhi(nx.y) };
#pragma unroll
            for (int j = 0; j < 4; ++j) v4[j] = x[j] + (0.5f * (a[j] + b[j]) - x[j]) * mv_[j];
        }
        const u32x2 af = *(const u32x2*)(RWX + (size_t)t * 1024 + 512 + c), ab = *(const u32x2*)(RWX + (size_t)t * 1024 + 768 + c);
        const float a0[4] = { bflo(af.x), bfhi(af.x), bflo(af.y), bfhi(af.y) }, a1[4] = { bflo(ab.x), bfhi(ab.x), bflo(ab.y), bfhi(ab.y) };
        const u32x2 yf = *(const u32x2*)(RWY + (size_t)t * 256 + c), yb = *(const u32x2*)(RWY + (size_t)TT * 256 + (size_t)t * 256 + c);
        float y[4] = { bflo(yf.x) + bflo(yb.x), bfhi(yf.x) + bfhi(yb.x), bflo(yf.y) + bflo(yb.y), bfhi(yf.y) + bfhi(yb.y) };
        float s = y[0] + y[1] + y[2] + y[3];
        s = group_sum<16>(s);
        const float mean = s * (1.f / 64.f);
        float q = 0.f, bon = 0.f;
#pragma unroll
        for (int j = 0; j < 4; ++j) {
            const float dlt = y[j] - mean; q += dlt * dlt;
            const float kmsum = k4[j] * (2.f + (a0[j] + a1[j] - 2.f) * ka_[j]);
            bon += r4[j] * kmsum * rk_[j];
        }
        q = group_sum<16>(q); bon = group_sum<16>(bon);
        const float rstd = rsqrtf(q * (1.f / 64.f) + 64e-5f);
        const u32x2 gg = *(const u32x2*)(row + C_RWD + c);
        const float g[4] = { bflo(gg.x), bfhi(gg.x), bflo(gg.y), bfhi(gg.y) };
        float o[4];
#pragma unroll
        for (int j = 0; j < 4; ++j) o[j] = ((y[j] - mean) * rstd * lg_[j] + lb_[j] + bon * v4[j]) * g[j];
        u32x2 ov; ov.x = pack2(o[0], o[1]); ov.y = pack2(o[2], o[3]);
        *(u32x2*)(Y + (size_t)t * 1024 + 768 + c) = ov;
    }
}

DEV int queue_next(int* ctr, char* smem) {
    int* slot = (int*)(smem + MOE_MAP_OFF + 208);
    __syncthreads();
    if (tidx() == 0) *slot = atomicAdd(ctr, 1);
    __syncthreads();
    return __builtin_amdgcn_readfirstlane(*slot);
}
DEV void phase_mixers(const Params& p, int l, int rep, char* smem) {
    const bool need_ctx = (l == 0);
#ifndef RWMODE
#define RWMODE 2
#endif
    const int nrw = RWMODE == 0 ? 64 : (RWMODE == 1 ? 256 + 64 : 256), nda = need_ctx ? 576 : 512, ns5 = 32 * (need_ctx ? 9 : 8);
    const int total = nrw + 2 * nda + (rep == 0 ? ns5 : 0);
    int* ctr = (int*)(p.ws + OFF_CTR) + CTR_Q + l * 16 + rep * 4;
    for (;;) {
        const int item = queue_next(ctr, smem);
        if (item >= total) break;
#ifndef PROBE7
#define PROBE7 0
#endif
        if (rep > 0 && PROBE7 == 1 && item >= nrw) break;
        if (rep > 0 && PROBE7 == 2 && item < nrw) continue;
        if (rep > 0 && PROBE7 == 3 && (item < nrw || item >= nrw + nda)) continue;
        if (item < nrw) { if (RWMODE == 0) rwc_item(p, l, item, smem); else if (item < 256) rw_item(p, l, item, smem, 0); else {
#ifdef RWC_NEVER
            if (p.out == nullptr)
#endif
            rwc_item(p, l, item - 256, smem); } }
        else if (item < nrw + nda) da_item(p, l, item - nrw, smem);
        else if (item < nrw + 2 * nda) mla_item(p, l, item - nrw - nda, smem);
        else s5_pass2_item(p, l, need_ctx ? 0 : 1, item - nrw - 2 * nda, smem);
    }
}
#ifndef MEGA
#define MEGA 0
#endif
constexpr int NPHASE = 15;
template <int PH>
DEV void run_phase(const Params& p, int l, char* smem) {
    const bool need_ctx = (l == 0);
    const int M = need_ctx ? TT : TL;
    if constexpr (PH == 0) { phase_mod_partial(p, smem); __syncthreads(); phase_conv_small(p, smem); phase_conv_layer(p, 0, smem); phase_conv_experts(p, 0, smem); }
    if constexpr (PH == 1) { phase_mod_reduce(p); }
    if constexpr (PH == 2) { phase_norm<1>(p, l, TT, smem); if (l == 1) { phase_conv_layer(p, 1, smem); phase_conv_experts(p, 1, smem); } }
    if constexpr (PH == 3) { phase_inproj(p, l, smem); }
    if constexpr (PH == 4) { phase_prep1(p, l); phase_s5_pass1(p, l, smem); }
    if constexpr (PH == 5) { phase_prep_gemm1(p, l, smem); }
    if constexpr (PH == 6) { phase_prep_gemm2(p, l, smem); phase_prep2(p, l); }
    if constexpr (PH == 7) { phase_mixers(p, l, 0, smem); }
    if constexpr (PH == 8) { phase_s5_glu(p, l, M, smem); phase_rw_finish(p, l, M); }
    if constexpr (PH == 9) { phase_merge(p, l, M, smem); }
    if constexpr (PH == 10) { phase_outproj(p, l, M, smem); }
    if constexpr (PH == 11) { phase_norm<2>(p, l, M, smem); }
    if constexpr (PH == 14) { phase_route(p, l, M, smem); }
    if constexpr (PH == 15) { phase_combine(p, l, M); }
    if constexpr (PH == 12) { phase_moe1(p, l, smem); }
    if constexpr (PH == 13) { phase_moe2(p, l, smem); }
}

#if !MEGA
template <int PH>
__global__ void __launch_bounds__(NT, 2) k_phase(Params p, int l) {
    extern __shared__ __attribute__((aligned(16))) char smem[];
    run_phase<PH>(p, l, smem);
}
#endif
#ifndef REP0
#define REP0 1
#endif
#ifndef REP2
#define REP2 1
#endif
#ifndef REP3
#define REP3 1
#endif
#ifndef REP5
#define REP5 1
#endif
#ifndef REP6
#define REP6 1
#endif
#ifndef REP7
#define REP7 1
#endif
#ifndef REP8
#define REP8 1
#endif
#ifndef REP9
#define REP9 1
#endif
#ifndef REP12
#define REP12 1
#endif
#if MEGA
__global__ void __launch_bounds__(NT, 2) k_mega(Params p) {
    extern __shared__ __attribute__((aligned(16))) char smem[];
    uint4* xbw = (uint4*)(smem + MOE_MAP_OFF + 240);
    if (threadIdx.x == 0) *xbw = make_uint4(0u, 0u, 0u, 0u);
    __syncthreads();
    XcdBarrier bar = xcd_barrier_post((unsigned*)(p.ws + OFF_BAR), (volatile LAS unsigned*)xbw);
    for (int r = 0; r < REP0; ++r) { run_phase<0>(p, 0, smem); xcd_barrier(bar); }
    run_phase<1>(p, 0, smem); xcd_barrier(bar);
    for (int l = 0; l < 2; ++l) {
        for (int r = 0; r < REP2; ++r) { run_phase<2>(p, l, smem); xcd_barrier(bar); }
        for (int r = 0; r < REP3; ++r) { run_phase<3>(p, l, smem); xcd_barrier(bar); }
        run_phase<4>(p, l, smem); xcd_barrier(bar);
#ifdef PROBE_S5P1
        phase_s5_pass1(p, l, smem); xcd_barrier(bar);
#endif
#ifdef PROBE_BAR
        for (int r = 0; r < PROBE_BAR; ++r) xcd_barrier(bar);
#endif
        for (int r = 0; r < REP5; ++r) { run_phase<5>(p, l, smem); xcd_barrier(bar); }
        for (int r = 0; r < REP6; ++r) { run_phase<6>(p, l, smem); xcd_barrier(bar); }
#ifdef RWC_PRE
        if (bidx() < 64) rwc_item(p, l, bidx(), smem);
#endif
#ifdef RWC_PRE_NOJOIN
        if (bidx() >= 64)
#endif
        for (int r = 0; r < REP7; ++r) { phase_mixers(p, l, r, smem); }
        xcd_barrier(bar);
#ifdef RWC_SEP
        for (int item = bidx(); item < 64; item += gridDim.x) rwc_item(p, l, item, smem);
        xcd_barrier(bar);
#endif
        for (int r = 0; r < REP8; ++r) { run_phase<8>(p, l, smem); xcd_barrier(bar); }
        for (int r = 0; r < REP9; ++r) { run_phase<9>(p, l, smem); xcd_barrier(bar); }
        run_phase<10>(p, l, smem); xcd_barrier(bar);

        run_phase<11>(p, l, smem); xcd_barrier(bar);
        run_phase<14>(p, l, smem); xcd_barrier(bar);
        for (int r = 0; r < REP12; ++r) { run_phase<12>(p, l, smem); xcd_barrier(bar); }
        run_phase<13>(p, l, smem); xcd_barrier(bar);
        run_phase<15>(p, l, smem); if (l == 0) xcd_barrier(bar);
    }
}
#endif
__global__ void __launch_bounds__(NT) k_fail(float* out, int n) {
    for (int i = blockIdx.x * NT + threadIdx.x; i < n; i += gridDim.x * NT) out[i] = __int_as_float(0x7fc00000);
}

template <int PH>
static void launch_phase(const Params& p, int l, int grid, hipStream_t stream) {
#if !MEGA
    static bool attr = false;
    if (!attr) { (void)hipFuncSetAttribute((const void*)k_phase<PH>, hipFuncAttributeMaxDynamicSharedMemorySize, SMEM_BYTES); attr = true; }
    hipLaunchKernelGGL(k_phase<PH>, dim3(grid), dim3(NT), SMEM_BYTES, stream, p, l);
#endif
}

extern "C" void kernel_launch(void* const* d_in, const int* in_sizes, int n_in, void* d_out, int out_size, void* d_ws, size_t ws_size, hipStream_t stream) {
    if (n_in != 48 || out_size != TL * DM || ws_size < WS_END) {
        hipLaunchKernelGGL(k_fail, dim3(256), dim3(NT), 0, stream, (float*)d_out, out_size);
        return;
    }
    Params p{};
    for (int i = 0; i < 48; ++i) p.in[i] = (const float*)d_in[i];
    p.out = (float*)d_out; p.ws = (char*)d_ws;
    (void)hipMemsetAsync(d_ws, 0, ZERO_BYTES, stream);
#if MEGA
    static int grid = 0;
    if (grid == 0) {
        int dev = 0, cus = 0, per_cu = 0;
        (void)hipGetDevice(&dev);
        (void)hipDeviceGetAttribute(&cus, hipDeviceAttributeMultiprocessorCount, dev);
        (void)hipFuncSetAttribute((const void*)k_mega, hipFuncAttributeMaxDynamicSharedMemorySize, SMEM_BYTES);
        if (hipOccupancyMaxActiveBlocksPerMultiprocessor(&per_cu, (const void*)k_mega, NT, SMEM_BYTES) != hipSuccess || per_cu < 1) per_cu = 1;
        (void)hipGetLastError();
        if (cus <= 0) cus = 256;
        grid = cus * (per_cu < 2 ? per_cu : 2);
    }
    hipLaunchKernelGGL(k_mega, dim3(grid), dim3(NT), SMEM_BYTES, stream, p);
#else
    const int grid = 512;
    launch_phase<0>(p, 0, grid, stream);
    launch_phase<1>(p, 0, grid, stream);
    for (int l = 0; l < 2; ++l) {
        launch_phase<2>(p, l, grid, stream);
        launch_phase<3>(p, l, grid, stream);
        launch_phase<4>(p, l, grid, stream);
        launch_phase<5>(p, l, grid, stream);
        launch_phase<6>(p, l, grid, stream);
        launch_phase<7>(p, l, grid, stream);
        launch_phase<8>(p, l, grid, stream);
        launch_phase<9>(p, l, grid, stream);
        launch_phase<10>(p, l, grid, stream);
        launch_phase<11>(p, l, grid, stream);
        launch_phase<14>(p, l, grid, stream);
        launch_phase<12>(p, l, grid, stream);
        launch_phase<13>(p, l, grid, stream);
        launch_phase<15>(p, l, grid, stream);
    }
#endif
}
```

```cpp
#define MEGA 1
#include <hip/hip_runtime.h>
#include <stdint.h>
#include <math.h>

#define DEV __device__ __forceinline__
#define LAS __attribute__((address_space(3)))
typedef unsigned short bf16_t;
typedef short bf16x8 __attribute__((ext_vector_type(8)));
typedef float f32x16 __attribute__((ext_vector_type(16)));
typedef float f32x4 __attribute__((ext_vector_type(4)));
typedef unsigned u32x4 __attribute__((ext_vector_type(4)));
typedef unsigned u32x2 __attribute__((ext_vector_type(2)));

constexpr int NT = 256;
constexpr int DM = 1024, NB = 8, SEQ = 2048, CTXL = 256, GRIDW = 64;
constexpr int TL = NB * SEQ, TC = NB * CTXL, TT = TL + TC;
constexpr int NIN = 6480, LDP = 2432, NINP = 6528, NGATE0 = 2432;
constexpr int C_DAQ = 0, C_DAK = 256, C_DAV = 512, C_S5 = 768, C_CQ = 1024, C_CKV = 1216, C_KR = 1344,
              C_RWR = 1360, C_RWK = 1616, C_RWV = 1872, C_RWD = 2128, C_PEND = 2384;
constexpr int NEXP = 16, DFF = 512;
constexpr float EPS = 1e-6f;
constexpr float LOG2E = 1.4426950408889634f;

constexpr size_t al256(size_t x) { return (x + 255) & ~(size_t)255; }
constexpr size_t OFF_BAR  = 0;
constexpr size_t OFF_CTR  = 16384;
constexpr size_t ZERO_BYTES = 20480;
constexpr size_t OFF_MOD  = 32768;
constexpr size_t SZ_MOD   = (size_t)2 * 9 * 6144 * 4;
constexpr int    MOD_KS   = 8;
constexpr size_t OFF_MODP = al256(OFF_MOD + SZ_MOD);
constexpr size_t OFF_S5ST = al256(OFF_MODP + MOD_KS * SZ_MOD);
constexpr size_t OFF_LTOK = al256(OFF_S5ST + (size_t)2 * 8 * 16 * 8 * 64 * 2 * 4);
constexpr size_t OFF_LW   = al256(OFF_LTOK + (size_t)NEXP * TT * 4);
constexpr size_t OFF_TOKI = al256(OFF_LW + (size_t)NEXP * TT * 4);
constexpr size_t OFF_TOKW = al256(OFF_TOKI + (size_t)TT * 16);
constexpr size_t OFF_CNTB = al256(OFF_TOKW + (size_t)TT * 8);
constexpr size_t OFF_WSM  = al256(OFF_CNTB + (size_t)1024 * 16 * 4);
constexpr int WS_GLUT = 0, WS_UQT = WS_GLUT + 256 * 256, WS_UKVT = WS_UQT + 192 * 192, WS_W1C = WS_UKVT + 384 * 128,
              WS_W2 = WS_W1C + 192 * 256, WS_G2T = WS_W2 + 4 * 256 * 64, WS_PER_LAYER = WS_G2T + 256 * 64;
constexpr size_t OFF_WIN  = al256(OFF_WSM + (size_t)2 * WS_PER_LAYER * 2);
constexpr size_t OFF_WBR  = al256(OFF_WIN + (size_t)NINP * 1024 * 2);
constexpr size_t OFF_WOUT = al256(OFF_WBR + (size_t)4 * 1024 * 256 * 2);
constexpr size_t OFF_WG1  = al256(OFF_WOUT + (size_t)1024 * 1024 * 2);
constexpr size_t OFF_WDN  = al256(OFF_WG1 + (size_t)NEXP * 1024 * 1024 * 2);
constexpr size_t OFF_H    = al256(OFF_WDN + (size_t)NEXP * 1024 * 512 * 2);
constexpr size_t OFF_P    = al256(OFF_H + (size_t)TT * 1024 * 2);
constexpr size_t OFF_GATE = al256(OFF_P + (size_t)TT * LDP * 2);
constexpr size_t OFF_MLAQ = al256(OFF_GATE + (size_t)TT * 4096);
constexpr size_t OFF_MLAK = al256(OFF_MLAQ + (size_t)TT * 192 * 2);
constexpr size_t OFF_MLAV = al256(OFF_MLAK + (size_t)TT * 192 * 2);
constexpr size_t OFF_RWX  = al256(OFF_MLAV + (size_t)TT * 256 * 2);
constexpr size_t OFF_Y    = al256(OFF_RWX + (size_t)TT * 1024 * 2);
constexpr size_t OFF_CX   = al256(OFF_Y + (size_t)TT * 1024 * 2);
constexpr size_t WS_END   = al256(OFF_CX + (size_t)TC * 1024 * 4);
constexpr size_t OFF_QRAW = OFF_Y;
constexpr size_t OFF_KVRAW = OFF_QRAW + (size_t)TT * 192 * 2;
constexpr size_t OFF_LR   = OFF_KVRAW + (size_t)TT * 384 * 2;
constexpr size_t OFF_XL   = OFF_LR + (size_t)TT * 192 * 2;
constexpr size_t OFF_Z    = OFF_GATE;
static_assert(OFF_XL + (size_t)TT * 256 * 2 <= OFF_Y + (size_t)TT * 1024 * 2, "temps overflow Y");
constexpr size_t OFF_RWY  = OFF_H;

constexpr int CTR_MOE = 0;
constexpr int CTR_Q   = 64;

constexpr int SMEM_BYTES = 73728 + 256;

struct Params {
    const float* in[48];
    float* out;
    char* ws;
};
enum { I_X = 0, I_C, I_CTX, I_CCTX, I_WADA, I_BADA, I_NMG, I_NFG, I_WIN, I_DAQKG, I_DALAM, I_DASUB,
       I_S5LRE, I_S5LIM, I_S5LDT, I_S5BRE, I_S5BIM, I_S5CRE, I_S5CIM, I_S5D, I_S5WGLU, I_S5BGLU,
       I_MCQG, I_MCKVG, I_MWUQ, I_MWUKV, I_MQKG,
       I_RMU, I_RW0, I_RW1, I_RW2, I_RA0, I_RA1, I_RA2, I_RG1, I_RG2, I_RKK, I_RKA, I_RRK, I_RLNG, I_RLNB,
       I_WBR, I_WOUT, I_ROUTW, I_ROUTB, I_EWG, I_EWU, I_EWD };

DEV int tidx() { int t = threadIdx.x; asm volatile("" : "+v"(t)); return t; }
DEV int bidx() { int b = blockIdx.x; asm volatile("" : "+s"(b)); return b; }
typedef float f32x2_ __attribute__((ext_vector_type(2)));
typedef __bf16 bf16x2_ __attribute__((ext_vector_type(2)));
DEV unsigned cvt_pk_bf16(float lo, float hi) { const f32x2_ v = {lo, hi}; const bf16x2_ b = __builtin_convertvector(v, bf16x2_); return __builtin_bit_cast(unsigned, b); }
DEV bf16_t f2bf(float f) { return (bf16_t)(cvt_pk_bf16(f, 0.f) & 0xFFFFu); }
DEV float bf2f(bf16_t h) { return __uint_as_float(((unsigned)h) << 16); }
DEV unsigned pack2(float lo, float hi) { return cvt_pk_bf16(lo, hi); }
DEV float bflo(unsigned u) { return __uint_as_float(u << 16); }
DEV float bfhi(unsigned u) { return __uint_as_float(u & 0xFFFF0000u); }
DEV float sigmoidf_(float x) { return 1.f / (1.f + __expf(-x)); }
DEV float wave_sum(float v) {
#pragma unroll
    for (int o = 32; o >= 1; o >>= 1) v += __shfl_xor(v, o, 64);
    return v;
}
template <int W> DEV float group_sum(float v) {
#pragma unroll
    for (int o = W / 2; o >= 1; o >>= 1) v += __shfl_xor(v, o, 64);
    return v;
}
DEV int mod_row(int t) { return t < TL ? (t >> 11) : 8; }
DEV bf16_t* wsb(const Params& p, size_t off) { return (bf16_t*)(p.ws + off); }
DEV float* wsf(const Params& p, size_t off) { return (float*)(p.ws + off); }
DEV const float* modp(const Params& p, int l, int row, int which) { return (const float*)(p.ws + OFF_MOD) + ((size_t)(l * 9 + row) * 6 + which) * 1024; }
#define XB_TMO      128
#define XB_XCNT(j)  (256  + 64 * (j))
#define XB_XSUB(j)  (1280 + 64 * (j))
#define XB_XGEN(j)  (2304 + 64 * (j))
#define XB_TOP      3328
#define XB_TOPGEN   3392
#define XCD_BAR_WORDS 3456
#define XB_SPIN_CAP (1u << 18)

__device__ __forceinline__ unsigned xb_ld(unsigned* p)              { return __hip_atomic_load(p, __ATOMIC_RELAXED, __HIP_MEMORY_SCOPE_AGENT); }
__device__ __forceinline__ unsigned xb_add(unsigned* p, unsigned v) { return __hip_atomic_fetch_add(p, v, __ATOMIC_RELAXED, __HIP_MEMORY_SCOPE_AGENT); }
__device__ __forceinline__ unsigned xb_xcc_id() { return (unsigned)__builtin_amdgcn_s_getreg((3 << 11) | 20) & 0xFu; }
#define XB_SPIN(cond, bar) do { unsigned _sp = 0; while (cond) { __builtin_amdgcn_s_sleep(1); \
    if ((++_sp & 255u) == 0u) { if (xb_ld(&(bar)[XB_TMO])) break; if (_sp > XB_SPIN_CAP) { atomicAdd(&(bar)[XB_TMO], 1u); break; } } } } while (0)

struct XcdBarrier {
    unsigned* bar; unsigned x;
    volatile LAS unsigned* st;
};

__device__ __forceinline__ XcdBarrier xcd_barrier_post(unsigned* bar, volatile LAS unsigned* st) {
    XcdBarrier b; b.bar = bar; b.x = xb_xcc_id(); b.st = st;
    if (threadIdx.x == 0) (void)xb_add(&bar[XB_XCNT(b.x)], 1u);
    return b;
}
__device__ __forceinline__ void xcd_barrier_complete(unsigned* bar, unsigned x, unsigned& nloc, unsigned& nx) {
    const unsigned G = gridDim.x * gridDim.y * gridDim.z;
    unsigned sum, cnt, mine, sp = 0u;
    for (;;) {
        sum = 0u; cnt = 0u; mine = 0u;
#pragma unroll
        for (unsigned j = 0; j < 16; ++j) { const unsigned c = xb_ld(&bar[XB_XCNT(j)]); sum += c; cnt += (c > 0u) ? 1u : 0u; mine = (j == x) ? c : mine; }
        if (sum == G) break;
        __builtin_amdgcn_s_sleep(1);
        if ((++sp & 255u) == 0u) { if (xb_ld(&bar[XB_TMO])) break; if (sp > XB_SPIN_CAP) { atomicAdd(&bar[XB_TMO], 1u); break; } }
    }
    nloc = mine > 0u ? mine : 1u; nx = cnt > 0u ? cnt : 1u;
}

__device__ __forceinline__ void xcd_barrier(const XcdBarrier& b) {
    asm volatile("s_waitcnt vmcnt(0)" ::: "memory");
    __syncthreads();
    if (threadIdx.x == 0) {
        unsigned* bar = b.bar;
        __builtin_amdgcn_s_waitcnt(0);
        unsigned nloc = b.st[0], nx = b.st[1];
        if (nloc == 0u) { xcd_barrier_complete(bar, b.x, nloc, nx); b.st[0] = nloc; b.st[1] = nx; }
        const unsigned old = xb_add(&bar[XB_XSUB(b.x)], 1u);
        const unsigned gen = old / nloc;
        if (old + 1u == (gen + 1u) * nloc) {
            __builtin_amdgcn_fence(__ATOMIC_RELEASE, "agent");
            asm volatile("s_waitcnt vmcnt(0)" ::: "memory");
            const unsigned og = xb_add(&bar[XB_TOP], 1u);
            const unsigned tg = og / nx;
            if (og + 1u == (tg + 1u) * nx) xb_add(&bar[XB_TOPGEN], 1u);
            else XB_SPIN(xb_ld(&bar[XB_TOPGEN]) == tg, bar);
            __builtin_amdgcn_fence(__ATOMIC_ACQUIRE, "agent");
            xb_add(&bar[XB_XGEN(b.x)], 1u);
            asm volatile("s_waitcnt vmcnt(0)" ::: "memory");
        } else {
            XB_SPIN(xb_ld(&bar[XB_XGEN(b.x)]) == gen, bar);
            __builtin_amdgcn_fence(__ATOMIC_ACQUIRE, "agent");
            asm volatile("s_waitcnt vmcnt(0)" ::: "memory");
        }
    }
    __syncthreads();
}

DEV void phase_mod_partial(const Params& p, char* smem) {
    float* sm = (float*)smem;
    const int tid = tidx();
    const int nitems = 2 * 24 * MOD_KS;
    for (int item = bidx(); item < nitems; item += gridDim.x) {
        const int l = item / (24 * MOD_KS), rem = item % (24 * MOD_KS), jc = rem / MOD_KS, ks = rem % MOD_KS;
        __syncthreads();
        for (int i = tid; i < 9 * 128; i += NT) {
            const int r = i >> 7, k = ks * 128 + (i & 127);
            const float cv = r < 8 ? p.in[I_C][r * 1024 + k] : p.in[I_CCTX][k];
            sm[i] = cv / (1.f + __expf(-cv));
        }
        __syncthreads();
        const int j = jc * 256 + tid;
        float acc[9];
#pragma unroll
        for (int r = 0; r < 9; ++r) acc[r] = 0.f;
        const float* w = p.in[I_WADA] + (size_t)l * 1024 * 6144 + (size_t)(ks * 128) * 6144 + j;
#pragma unroll 8
        for (int k = 0; k < 128; ++k) {
            const float wv = w[(size_t)k * 6144];
#pragma unroll
            for (int r = 0; r < 9; ++r) acc[r] += sm[r * 128 + k] * wv;
        }
        float* dst = wsf(p, OFF_MODP);
#pragma unroll
        for (int r = 0; r < 9; ++r) dst[((size_t)(ks * 2 + l) * 9 + r) * 6144 + j] = acc[r];
    }
}
DEV void phase_mod_reduce(const Params& p) {
    const int n = 2 * 9 * 6144;
    float* mod = wsf(p, OFF_MOD);
    const float* part = wsf(p, OFF_MODP);
    for (int i = bidx() * NT + tidx(); i < n; i += gridDim.x * NT) {
        const int l = i / (9 * 6144), j = i % 6144;
        float s = p.in[I_BADA][l * 6144 + j];
#pragma unroll
        for (int ks = 0; ks < MOD_KS; ++ks) s += part[(size_t)ks * n + i];
        mod[i] = s;
    }
}

template <int MODE>
DEV void conv_tile(const float* src, int R, int C, int ld, bf16_t* dst, int ldd, int roff, int tr, int tc, float* sm) {
    const int r0 = tr * 64, c0 = tc * 64, tid = tidx();
    for (int i = tid; i < 64 * 16; i += NT) {
        const int r = i >> 4, c4 = (i & 15) * 4;
        float4 v = make_float4(0.f, 0.f, 0.f, 0.f);
        if (r0 + r < R) {
            const float* s = src + (size_t)(r0 + r) * ld + c0 + c4;
            if (c0 + c4 + 3 < C) v = *(const float4*)s;
            else { if (c0 + c4 < C) v.x = s[0]; if (c0 + c4 + 1 < C) v.y = s[1]; if (c0 + c4 + 2 < C) v.z = s[2]; }
        }
        float* d = sm + r * 65 + c4;
        d[0] = v.x; d[1] = v.y; d[2] = v.z; d[3] = v.w;
    }
    __syncthreads();
    for (int i = tid; i < 64 * 8; i += NT) {
        const int c = i >> 3, r8 = (i & 7) * 8;
        if (c0 + c < C && r0 + r8 < R) {
            const int cc = c0 + c;
            const int drow = (MODE == 0) ? (cc + roff) : ((cc >> 5) * 64 + (cc & 31) + roff);
            uint4 o;
            o.x = pack2(sm[(r8 + 0) * 65 + c], sm[(r8 + 1) * 65 + c]);
            o.y = pack2(sm[(r8 + 2) * 65 + c], sm[(r8 + 3) * 65 + c]);
            o.z = pack2(sm[(r8 + 4) * 65 + c], sm[(r8 + 5) * 65 + c]);
            o.w = pack2(sm[(r8 + 6) * 65 + c], sm[(r8 + 7) * 65 + c]);
            *(uint4*)(dst + (size_t)drow * ldd + r0 + r8) = o;
        }
    }
    __syncthreads();
}
template <int MODE>
DEV void conv_job(const float* src, int R, int C, int ld, bf16_t* dst, int ldd, int roff, int& rot, float* sm) {
    const int ntr = (R + 63) >> 6, ntc = (C + 63) >> 6, nt = ntr * ntc, G = gridDim.x;
    int first = (bidx() - (rot % G) + G) % G;
    for (int t = first; t < nt; t += G) conv_tile<MODE>(src, R, C, ld, dst, ldd, roff, t / ntc, t % ntc, sm);
    rot += nt;
}
DEV void phase_conv_layer(const Params& p, int l, char* smem) {
    float* sm = (float*)smem;
    int rot = 0;
    const float* win = p.in[I_WIN] + (size_t)l * 1024 * NIN;
    conv_job<0>(win, 1024, C_PEND, NIN, wsb(p, OFF_WIN), 1024, 0, rot, sm);
    conv_job<0>(win + C_PEND, 1024, 4096, NIN, wsb(p, OFF_WIN), 1024, NGATE0, rot, sm);
    {
        uint4* z = (uint4*)(wsb(p, OFF_WIN) + (size_t)C_PEND * 1024);
        const int n = (NGATE0 - C_PEND) * 1024 / 8;
        for (int i = bidx() * NT + tidx(); i < n; i += gridDim.x * NT) z[i] = make_uint4(0u, 0u, 0u, 0u);
    }
    for (int i = 0; i < 4; ++i)
        conv_job<0>(p.in[I_WBR] + (size_t)(l * 4 + i) * 256 * 1024, 256, 1024, 1024, wsb(p, OFF_WBR) + (size_t)i * 1024 * 256, 256, 0, rot, sm);
    conv_job<0>(p.in[I_WOUT] + (size_t)l * 1024 * 1024, 1024, 1024, 1024, wsb(p, OFF_WOUT), 1024, 0, rot, sm);
}
DEV void phase_conv_experts(const Params& p, int l, char* smem) {
    float* sm = (float*)smem;
    int rot = 0;
    for (int e = 0; e < NEXP; ++e) {
        conv_job<1>(p.in[I_EWG] + (size_t)(l * NEXP + e) * 1024 * DFF, 1024, DFF, DFF, wsb(p, OFF_WG1) + (size_t)e * 1024 * 1024, 1024, 0, rot, sm);
        conv_job<1>(p.in[I_EWU] + (size_t)(l * NEXP + e) * 1024 * DFF, 1024, DFF, DFF, wsb(p, OFF_WG1) + (size_t)e * 1024 * 1024, 1024, 32, rot, sm);
        conv_job<0>(p.in[I_EWD] + (size_t)(l * NEXP + e) * DFF * 1024, DFF, 1024, 1024, wsb(p, OFF_WDN) + (size_t)e * 1024 * DFF, DFF, 0, rot, sm);
    }
}
DEV void phase_conv_small(const Params& p, char* smem) {
    float* sm = (float*)smem;
    int rot = 0;
    for (int l = 0; l < 2; ++l) {
        bf16_t* w = wsb(p, OFF_WSM) + (size_t)l * WS_PER_LAYER;
        for (int i = bidx() * NT + tidx(); i < 4 * 256 * 4; i += gridDim.x * NT)
            *(u32x4*)(w + WS_W2 + (size_t)(i >> 2) * 64 + 32 + (i & 3) * 8) = (u32x4){0u, 0u, 0u, 0u};
        conv_job<0>(p.in[I_S5WGLU] + (size_t)l * 256 * 256, 256, 256, 256, w + WS_GLUT, 256, 0, rot, sm);
        conv_job<0>(p.in[I_MWUQ] + (size_t)l * 192 * 192, 192, 192, 192, w + WS_UQT, 192, 0, rot, sm);
        conv_job<0>(p.in[I_MWUKV] + (size_t)l * 128 * 384, 128, 384, 384, w + WS_UKVT, 128, 0, rot, sm);
        for (int d = 0; d < 2; ++d) {
            conv_job<0>(p.in[I_RW1] + (size_t)(l * 2 + d) * 256 * 32, 256, 32, 32, w + WS_W1C, 256, d * 32, rot, sm);
            conv_job<0>(p.in[I_RA1] + (size_t)(l * 2 + d) * 256 * 32, 256, 32, 32, w + WS_W1C, 256, 64 + d * 32, rot, sm);
            conv_job<0>(p.in[I_RW2] + (size_t)(l * 2 + d) * 32 * 256, 32, 256, 256, w + WS_W2 + (size_t)d * 256 * 64, 64, 0, rot, sm);
            conv_job<0>(p.in[I_RA2] + (size_t)(l * 2 + d) * 32 * 256, 32, 256, 256, w + WS_W2 + (size_t)(2 + d) * 256 * 64, 64, 0, rot, sm);
        }
        conv_job<0>(p.in[I_RG1] + (size_t)l * 256 * 64, 256, 64, 64, w + WS_W1C, 256, 128, rot, sm);
        conv_job<0>(p.in[I_RG2] + (size_t)l * 64 * 256, 64, 256, 256, w + WS_G2T, 64, 0, rot, sm);
    }
}

template <int WHICH>
DEV void phase_norm(const Params& p, int l, int nrows, char* smem) {
    const int lane = tidx() & 63, wave = tidx() >> 6;
    const float* xs = (l == 0) ? p.in[I_X] : p.out;
    const float* cs = (l == 0) ? p.in[I_CTX] : wsf(p, OFF_CX);
    const float* g = p.in[WHICH == 1 ? I_NMG : I_NFG] + l * 1024;
    bf16_t* H = wsb(p, OFF_H);
    if (WHICH == 2) { xs = p.out; cs = wsf(p, OFF_CX); }
    const int tpb = (nrows + (int)gridDim.x - 1) / (int)gridDim.x;
    const int rbeg = WHICH == 2 ? bidx() * tpb + wave : bidx() * 4 + wave;
    const int rend = WHICH == 2 ? min(nrows, (bidx() + 1) * tpb) : nrows;
    const int rstep = WHICH == 2 ? 4 : (int)gridDim.x * 4;
    int* sel = (int*)smem;
    for (int row = rbeg; row < rend; row += rstep) {
        const float* src = row < TL ? xs + (size_t)row * 1024 : cs + (size_t)(row - TL) * 1024;
        const int mr = mod_row(row);
        const float* sh = modp(p, l, mr, WHICH == 1 ? 0 : 3);
        const float* sc = modp(p, l, mr, WHICH == 1 ? 1 : 4);
        float4 v[4];
        float ss = 0.f;
#pragma unroll
        for (int i = 0; i < 4; ++i) {
            v[i] = *(const float4*)(src + lane * 4 + i * 256);
            ss += v[i].x * v[i].x + v[i].y * v[i].y + v[i].z * v[i].z + v[i].w * v[i].w;
        }
        ss = wave_sum(ss);
        const float rstd = rsqrtf(ss * (1.f / 1024.f) + EPS);
        float hv[16];
#pragma unroll
        for (int i = 0; i < 4; ++i) {
            const int c = lane * 4 + i * 256;
            const float4 gg = *(const float4*)(g + c), s4 = *(const float4*)(sh + c), c4 = *(const float4*)(sc + c);
            hv[i * 4 + 0] = v[i].x * rstd * gg.x * (1.f + c4.x) + s4.x;
            hv[i * 4 + 1] = v[i].y * rstd * gg.y * (1.f + c4.y) + s4.y;
            hv[i * 4 + 2] = v[i].z * rstd * gg.z * (1.f + c4.z) + s4.z;
            hv[i * 4 + 3] = v[i].w * rstd * gg.w * (1.f + c4.w) + s4.w;
            u32x2 o; o.x = pack2(hv[i * 4 + 0], hv[i * 4 + 1]); o.y = pack2(hv[i * 4 + 2], hv[i * 4 + 3]);
            *(u32x2*)(H + (size_t)row * 1024 + c) = o;
        }
        if (WHICH == 2) {
            float lg[16];
#pragma unroll
            for (int e = 0; e < 16; ++e) lg[e] = 0.f;
            const float* rw = p.in[I_ROUTW];
#pragma unroll
            for (int i = 0; i < 4; ++i)
#pragma unroll
                for (int j = 0; j < 4; ++j) {
                    const int c = lane * 4 + i * 256 + j;
                    const float hvv = hv[i * 4 + j];
#pragma unroll
                    for (int q = 0; q < 4; ++q) {
                        const float4 w4 = *(const float4*)(rw + (size_t)c * 16 + q * 4);
                        lg[q * 4 + 0] += hvv * w4.x; lg[q * 4 + 1] += hvv * w4.y; lg[q * 4 + 2] += hvv * w4.z; lg[q * 4 + 3] += hvv * w4.w;
                    }
                }
#pragma unroll
            for (int e = 0; e < 16; ++e) lg[e] = wave_sum(lg[e]);
            float sc16[16], bs[16];
#pragma unroll
            for (int e = 0; e < 16; ++e) { sc16[e] = sigmoidf_(lg[e]); bs[e] = sc16[e] + p.in[I_ROUTB][e]; }
            int bestg = 0; float bestv = -INFINITY;
#pragma unroll
            for (int gi = 0; gi < 4; ++gi) {
                float m1 = -INFINITY, m2 = -INFINITY;
#pragma unroll
                for (int k = 0; k < 4; ++k) { const float x = bs[gi * 4 + k]; if (x > m1) { m2 = m1; m1 = x; } else if (x > m2) m2 = x; }
                const float gs = m1 + m2;
                if (gs > bestv) { bestv = gs; bestg = gi; }
            }
            int i0 = 0, i1 = 0; float v0 = -INFINITY, v1 = -INFINITY, s0 = 0.f, s1 = 0.f;
#pragma unroll
            for (int e = 0; e < 16; ++e) { const bool in = (e >> 2) == bestg; if (in && bs[e] > v0) { v0 = bs[e]; i0 = e; s0 = sc16[e]; } }
#pragma unroll
            for (int e = 0; e < 16; ++e) { const bool in = (e >> 2) == bestg && e != i0; if (in && bs[e] > v1) { v1 = bs[e]; i1 = e; s1 = sc16[e]; } }
            const float inv = 1.f / (s0 + s1);
            if (lane == 0) {
                const int lt = row - bidx() * tpb;
                sel[lt * 2 + 0] = i0; sel[lt * 2 + 1] = i1;
                float* tw = (float*)(p.ws + OFF_TOKW) + (size_t)row * 2;
                tw[0] = s0 * inv; tw[1] = s1 * inv;
            }
        }
    }
    if (WHICH == 2) {
        __syncthreads();
        const int t0 = bidx() * tpb, nt = max(0, min(nrows, t0 + tpb) - t0);
        int* rank = sel + 2 * tpb;
        if (tidx() < 16) {
            const int e = tidx(); int c = 0;
            for (int i = 0; i < 2 * nt; ++i) if (sel[i] == e) { rank[i] = c; ++c; }
            ((int*)(p.ws + OFF_CNTB))[(size_t)bidx() * 16 + e] = c;
        }
        __syncthreads();
        int* toki = (int*)(p.ws + OFF_TOKI);
        for (int i = tidx(); i < nt; i += NT) {
            int4 r; r.x = sel[2 * i]; r.y = sel[2 * i + 1]; r.z = rank[2 * i]; r.w = rank[2 * i + 1];
            *(int4*)(toki + (size_t)(t0 + i) * 4) = r;
        }
        __syncthreads();
    }
}
DEV void phase_route(const Params& p, int l, int nrows, char* smem) {
    int* sm = (int*)smem;
    const int tid = tidx(), e = tid & 15, part = tid >> 4, G = gridDim.x, b = bidx();
    const int* cntb = (const int*)(p.ws + OFF_CNTB);
    int pre = 0, tot = 0;
    for (int bb = part; bb < G; bb += 16) { const int c = cntb[(size_t)bb * 16 + e]; tot += c; if (bb < b) pre += c; }
    __syncthreads();
    sm[part * 16 + e] = pre; sm[256 + part * 16 + e] = tot;
    __syncthreads();
    if (tid < 16) {
        int a = 0, t = 0;
        for (int q = 0; q < 16; ++q) { a += sm[q * 16 + tid]; t += sm[256 + q * 16 + tid]; }
        sm[512 + tid] = a; sm[528 + tid] = t;
    }
    __syncthreads();
    if (tid == 0) {
        int a = 0;
        for (int q = 0; q < 16; ++q) { sm[544 + q] = a; a += sm[528 + q]; }
    }
    __syncthreads();
    if (b == 0 && tid < 16) ((int*)(p.ws + OFF_CTR))[CTR_MOE + l * 16 + tid] = sm[528 + tid];
    const int tpb = (nrows + G - 1) / G, t0 = b * tpb, nt = max(0, min(nrows, t0 + tpb) - t0);
    int* toki = (int*)(p.ws + OFF_TOKI);
    const float* tokw = (const float*)(p.ws + OFF_TOKW);
    int* ltok = (int*)(p.ws + OFF_LTOK);
    float* lw = (float*)(p.ws + OFF_LW);
    for (int i = tid; i < 2 * nt; i += NT) {
        const int t = t0 + (i >> 1), j = i & 1;
        const int ee = toki[(size_t)t * 4 + j], rk = toki[(size_t)t * 4 + 2 + j];
        const int pos = sm[512 + ee] + rk;
        ltok[(size_t)ee * TT + pos] = t;
        lw[(size_t)ee * TT + pos] = tokw[(size_t)t * 2 + j];
        toki[(size_t)t * 4 + 2 + j] = sm[544 + ee] + pos;
    }
}
DEV void phase_combine(const Params& p, int l, int nrows) {
    const int lane = tidx() & 63, wave = tidx() >> 6;
    const bf16_t* Z = wsb(p, OFF_Z);
    const int* toki = (const int*)(p.ws + OFF_TOKI);
    const float* tokw = (const float*)(p.ws + OFF_TOKW);
    for (int row = bidx() * 4 + wave; row < nrows; row += gridDim.x * 4) {
        float* dst = row < TL ? p.out + (size_t)row * 1024 : wsf(p, OFF_CX) + (size_t)(row - TL) * 1024;
        const float* g2 = modp(p, l, mod_row(row), 5);
        const int r0 = toki[(size_t)row * 4 + 2], r1 = toki[(size_t)row * 4 + 3];
        const float w0 = tokw[(size_t)row * 2], w1 = tokw[(size_t)row * 2 + 1];
#pragma unroll
        for (int i = 0; i < 4; ++i) {
            const int c = lane * 4 + i * 256;
            const u32x2 a = *(const u32x2*)(Z + (size_t)r0 * 1024 + c), b = *(const u32x2*)(Z + (size_t)r1 * 1024 + c);
            const float4 gg = *(const float4*)(g2 + c);
            float4 x = *(float4*)(dst + c);
            x.x += gg.x * (w0 * bflo(a.x) + w1 * bflo(b.x));
            x.y += gg.y * (w0 * bfhi(a.x) + w1 * bfhi(b.x));
            x.z += gg.z * (w0 * bflo(a.y) + w1 * bflo(b.y));
            x.w += gg.w * (w0 * bfhi(a.y) + w1 * bfhi(b.y));
            *(float4*)(dst + c) = x;
        }
    }
}
constexpr int GLD = 72;
constexpr int GSTAGE = 128 * GLD;
template <bool DEEP = true, int TN = 2, class AF, class BF>
DEV void gemm_mainloop(f32x16 (&acc)[2][TN], AF arow, BF brow, int K, bf16_t* sm) {
    const int tid = tidx(), lane = tid & 63, wave = tid >> 6, wm = wave >> 1, wn = wave & 1;
    bf16_t* As = sm;
    bf16_t* Bs = sm + 2 * GSTAGE;
    constexpr int NB = 2 * TN;
    const bf16_t* ap[4]; const bf16_t* bp[NB];
#pragma unroll
    for (int i = 0; i < 4; ++i) { const int q = tid + i * NT; ap[i] = arow(q >> 3) + (q & 7) * 8; }
#pragma unroll
    for (int i = 0; i < NB; ++i) { const int q = tid + i * NT; bp[i] = brow(q >> 3) + (q & 7) * 8; }
    const int soff = (tid >> 3) * GLD + (tid & 7) * 8;
    u32x4 ra0[4], rb0[NB], ra1[4], rb1[NB];
    const int nk = K >> 6;
#pragma unroll
    for (int i = 0; i < 4; ++i) ra0[i] = *(const u32x4*)ap[i];
#pragma unroll
    for (int i = 0; i < NB; ++i) rb0[i] = *(const u32x4*)bp[i];
    if (DEEP && nk > 1) {
#pragma unroll
        for (int i = 0; i < 4; ++i) ra1[i] = *(const u32x4*)(ap[i] + 64);
#pragma unroll
        for (int i = 0; i < NB; ++i) rb1[i] = *(const u32x4*)(bp[i] + 64);
    }
    __syncthreads();
#pragma unroll
    for (int i = 0; i < 4; ++i) *(u32x4*)(As + soff + i * 32 * GLD) = ra0[i];
#pragma unroll
    for (int i = 0; i < NB; ++i) *(u32x4*)(Bs + soff + i * 32 * GLD) = rb0[i];
    __syncthreads();
    const int arow0 = (wm * 64 + (lane & 31)) * GLD + (lane >> 5) * 8;
    const int brow0 = (wn * 32 * TN + (lane & 31)) * GLD + (lane >> 5) * 8;
    auto compute = [&](int cur) {
        const bf16_t* a_s = As + cur * GSTAGE + arow0;
        const bf16_t* b_s = Bs + cur * GSTAGE + brow0;
#pragma unroll
        for (int ks = 0; ks < 4; ++ks) {
            const bf16x8 a0 = *(const bf16x8*)(a_s + ks * 16);
            const bf16x8 a1 = *(const bf16x8*)(a_s + 32 * GLD + ks * 16);
#pragma unroll
            for (int j = 0; j < TN; ++j) {
                const bf16x8 bj = *(const bf16x8*)(b_s + j * 32 * GLD + ks * 16);
                acc[0][j] = __builtin_amdgcn_mfma_f32_32x32x16_bf16(a0, bj, acc[0][j], 0, 0, 0);
                acc[1][j] = __builtin_amdgcn_mfma_f32_32x32x16_bf16(a1, bj, acc[1][j], 0, 0, 0);
            }
        }
    };
    auto gload = [&](u32x4 (&ra)[4], u32x4 (&rb)[NB], int kt) {
        const int k0 = kt * 64;
#pragma unroll
        for (int i = 0; i < 4; ++i) ra[i] = *(const u32x4*)(ap[i] + k0);
#pragma unroll
        for (int i = 0; i < NB; ++i) rb[i] = *(const u32x4*)(bp[i] + k0);
    };
    auto lstore = [&](const u32x4 (&ra)[4], const u32x4 (&rb)[NB], int st) {
#pragma unroll
        for (int i = 0; i < 4; ++i) *(u32x4*)(As + st * GSTAGE + soff + i * 32 * GLD) = ra[i];
#pragma unroll
        for (int i = 0; i < NB; ++i) *(u32x4*)(Bs + st * GSTAGE + soff + i * 32 * GLD) = rb[i];
    };
    for (int kt = 0; kt < nk; kt += 2) {
        if (!DEEP && kt + 1 < nk) gload(ra1, rb1, kt + 1);
        if (DEEP && kt + 2 < nk) gload(ra0, rb0, kt + 2);
        compute(0);
        if (kt + 1 < nk) lstore(ra1, rb1, 1);
        __syncthreads();
        if (kt + 1 >= nk) break;
        if (!DEEP && kt + 2 < nk) gload(ra0, rb0, kt + 2);
        if (DEEP && kt + 3 < nk) gload(ra1, rb1, kt + 3);
        compute(1);
        if (kt + 2 < nk) lstore(ra0, rb0, 0);
        __syncthreads();
    }
}
template <int TN>
DEV void acc_zero(f32x16 (&acc)[2][TN]) {
#pragma unroll
    for (int i = 0; i < 2; ++i)
#pragma unroll
        for (int j = 0; j < TN; ++j)
#pragma unroll
            for (int r = 0; r < 16; ++r) acc[i][j][r] = 0.f;
}
#define EPI_FOREACH(acc, ...)                                                                           \
    {                                                                                                    \
        const int _lane = tidx() & 63, _wave = tidx() >> 6, _wm = _wave >> 1, _wn = _wave & 1; \
        _Pragma("unroll") for (int _i = 0; _i < 2; ++_i)                                                 \
        _Pragma("unroll") for (int _j = 0; _j < 2; ++_j)                                                 \
        _Pragma("unroll") for (int _r = 0; _r < 16; ++_r) {                                              \
            const int er = _wm * 64 + _i * 32 + (_r & 3) + 8 * (_r >> 2) + 4 * (_lane >> 5);             \
            const int ec = _wn * 64 + _j * 32 + (_lane & 31);                                            \
            const float ev = acc[_i][_j][_r];                                                            \
            __VA_ARGS__                                                                                  \
        }                                                                                                \
    }

DEV void tile_mn(int item, int nMt, int nNt, int& mt, int& nt) {
    constexpr int GM = 16;
    const int per = GM * nNt, g = item / per, rem = item % per;
    const int m0 = g * GM, gsz = (nMt - m0) < GM ? (nMt - m0) : GM;
    mt = m0 + rem % gsz; nt = rem / gsz;
}

DEV void phase_inproj(const Params& p, int l, char* smem) {
    bf16_t* sm = (bf16_t*)smem;
    const bf16_t* H = wsb(p, OFF_H);
    const bf16_t* W = wsb(p, OFF_WIN);
    bf16_t* P = wsb(p, OFF_P);
    unsigned char* G = (unsigned char*)(p.ws + OFF_GATE);
    const int nMt = TT / 128, nNt = NINP / 128;
    for (int item = bidx(); item < nMt * nNt; item += gridDim.x) {
        int mt, nt; tile_mn(item, nMt, nNt, mt, nt);
        const int m0 = mt * 128, n0 = nt * 128;
        if (l == 1 && m0 >= TL && n0 >= NGATE0) continue;
        f32x16 acc[2][2]; acc_zero<2>(acc);
        gemm_mainloop(acc, [&](int r) { return H + (size_t)(m0 + r) * 1024; }, [&](int r) { return W + (size_t)(n0 + r) * 1024; }, 1024, sm);
        if (n0 < NGATE0) {
            EPI_FOREACH(acc, { const int col = n0 + ec; if (col < C_PEND) P[(size_t)(m0 + er) * LDP + col] = f2bf(ev); })
        } else {
            EPI_FOREACH(acc, { const int col = n0 + ec - NGATE0; const float s = sigmoidf_(ev); G[(size_t)(m0 + er) * 4096 + col] = (unsigned char)__float2int_rn(s * 255.f); })
        }
    }
}

template <class EF>
DEV void gemm_generic(const bf16_t* A, int lda, int M, const bf16_t* Bt, int ldb, int N, int K, EF ef, char* smem, int rot) {
    bf16_t* sm = (bf16_t*)smem;
    const int nMt = (M + 127) / 128, nNt = (N + 127) / 128, G = gridDim.x;
    const int first = (bidx() - (rot % G) + G) % G;
    for (int item = first; item < nMt * nNt; item += G) {
        const int mt = item / nNt, nt = item % nNt, m0 = mt * 128, n0 = nt * 128;
        f32x16 acc[2][2]; acc_zero<2>(acc);
        gemm_mainloop(acc, [&](int r) { int rr = m0 + r; rr = rr < M ? rr : M - 1; return A + (size_t)rr * lda; },
                      [&](int r) { int rr = n0 + r; rr = rr < N ? rr : N - 1; return Bt + (size_t)rr * ldb; }, K, sm);
        EPI_FOREACH(acc, { const int row = m0 + er, col = n0 + ec; if (row < M && col < N) ef(row, col, ev); })
    }
}

DEV void phase_merge(const Params& p, int l, int M, char* smem) {
    bf16_t* sm = (bf16_t*)smem;
    const bf16_t* Y = wsb(p, OFF_Y);
    const bf16_t* W = wsb(p, OFF_WBR);
    const unsigned char* G = (const unsigned char*)(p.ws + OFF_GATE);
    bf16_t* MG = wsb(p, OFF_H);
    bf16_t* As = sm;
    bf16_t* Bs = sm + 2 * GSTAGE;
    unsigned char* Gs = (unsigned char*)(sm + 2 * GSTAGE + 2 * 64 * GLD);
    const int tid = tidx(), lane = tid & 63, wave = tid >> 6, wm = wave >> 1, wn = wave & 1;
    const int soff = (tid >> 3) * GLD + (tid & 7) * 8;
    const int arow0 = (wm * 64 + (lane & 31)) * GLD + (lane >> 5) * 8;
    const int brow0 = (wn * 32 + (lane & 31)) * GLD + (lane >> 5) * 8;
    const int nMt = M / 128, nNt = 16;
    for (int item = bidx(); item < nMt * nNt; item += gridDim.x) {
        const int mt = item / nNt, nt = item % nNt, m0 = mt * 128, n0 = nt * 64;
        const bf16_t* ap[4]; const bf16_t* bp[2]; const unsigned char* gp[2];
#pragma unroll
        for (int i = 0; i < 4; ++i) { const int q = tid + i * NT; ap[i] = Y + (size_t)(m0 + (q >> 3)) * 1024 + (q & 7) * 8; }
#pragma unroll
        for (int i = 0; i < 2; ++i) { const int q = tid + i * NT; bp[i] = W + (size_t)(n0 + (q >> 3)) * 256 + (q & 7) * 8;
                                      gp[i] = G + (size_t)(m0 + (q >> 2)) * 4096 + n0 + (q & 3) * 16; }
        f32x16 tot[2], acc[2];
#pragma unroll
        for (int a = 0; a < 2; ++a)
#pragma unroll
            for (int r = 0; r < 16; ++r) { tot[a][r] = 0.f; acc[a][r] = 0.f; }
        u32x4 ra[4], rb[2], rg[2];
#pragma unroll
        for (int i = 0; i < 4; ++i) ra[i] = *(const u32x4*)ap[i];
#pragma unroll
        for (int i = 0; i < 2; ++i) rb[i] = *(const u32x4*)bp[i];
        __syncthreads();
#pragma unroll
        for (int i = 0; i < 4; ++i) *(u32x4*)(As + soff + i * 32 * GLD) = ra[i];
#pragma unroll
        for (int i = 0; i < 2; ++i) *(u32x4*)(Bs + soff + i * 32 * GLD) = rb[i];
        __syncthreads();
#pragma unroll
        for (int kt = 0; kt < 16; ++kt) {
            const int cur = kt & 1, seg = kt >> 2;
            if (kt + 1 < 16) {
                const int k1 = kt + 1;
#pragma unroll
                for (int i = 0; i < 4; ++i) ra[i] = *(const u32x4*)(ap[i] + k1 * 64);
#pragma unroll
                for (int i = 0; i < 2; ++i) rb[i] = *(const u32x4*)(bp[i] + (size_t)(k1 >> 2) * (1024 * 256) + (k1 & 3) * 64);
            }
            if ((kt & 3) == 0) {
#pragma unroll
                for (int i = 0; i < 2; ++i) rg[i] = *(const u32x4*)(gp[i] + seg * 1024);
            }
            const bf16_t* a_s = As + cur * GSTAGE + arow0;
            const bf16_t* b_s = Bs + cur * (64 * GLD) + brow0;
#pragma unroll
            for (int ks = 0; ks < 4; ++ks) {
                const bf16x8 a0 = *(const bf16x8*)(a_s + ks * 16), a1 = *(const bf16x8*)(a_s + 32 * GLD + ks * 16), b0 = *(const bf16x8*)(b_s + ks * 16);
                acc[0] = __builtin_amdgcn_mfma_f32_32x32x16_bf16(a0, b0, acc[0], 0, 0, 0);
                acc[1] = __builtin_amdgcn_mfma_f32_32x32x16_bf16(a1, b0, acc[1], 0, 0, 0);
            }
            if (kt + 1 < 16) {
                const int nx = cur ^ 1;
#pragma unroll
                for (int i = 0; i < 4; ++i) *(u32x4*)(As + nx * GSTAGE + soff + i * 32 * GLD) = ra[i];
#pragma unroll
                for (int i = 0; i < 2; ++i) *(u32x4*)(Bs + nx * (64 * GLD) + soff + i * 32 * GLD) = rb[i];
            }
            if ((kt & 3) == 3) {
#pragma unroll
                for (int i = 0; i < 2; ++i) { const int q = tid + i * NT; *(u32x4*)(Gs + (q >> 2) * 64 + (q & 3) * 16) = rg[i]; }
            }
            __syncthreads();
            if ((kt & 3) == 3) {
#pragma unroll
                for (int a = 0; a < 2; ++a)
#pragma unroll
                    for (int r = 0; r < 16; ++r) {
                        const int er = wm * 64 + a * 32 + (r & 3) + 8 * (r >> 2) + 4 * (lane >> 5), ec = wn * 32 + (lane & 31);
                        tot[a][r] += (float)Gs[er * 64 + ec] * (1.f / 255.f) * acc[a][r];
                        acc[a][r] = 0.f;
                    }
            }
        }
#pragma unroll
        for (int a = 0; a < 2; ++a)
#pragma unroll
            for (int r = 0; r < 16; ++r) {
                const int er = wm * 64 + a * 32 + (r & 3) + 8 * (r >> 2) + 4 * (lane >> 5), ec = wn * 32 + (lane & 31);
                MG[(size_t)(m0 + er) * 1024 + n0 + ec] = f2bf(tot[a][r]);
            }
    }
}

DEV void phase_outproj(const Params& p, int l, int M, char* smem) {
    bf16_t* sm = (bf16_t*)smem;
    const bf16_t* MG = wsb(p, OFF_H);
    const bf16_t* W = wsb(p, OFF_WOUT);
    const float* xs = (l == 0) ? p.in[I_X] : p.out;
    const float* cs = (l == 0) ? p.in[I_CTX] : wsf(p, OFF_CX);
    float* cxd = wsf(p, OFF_CX);
    float* outd = p.out;
    const int nMt = M / 128, nNt = 8;
    for (int item = bidx(); item < nMt * nNt; item += gridDim.x) {
        const int mt = item / nNt, nt = item % nNt, m0 = mt * 128, n0 = nt * 128;
        f32x16 acc[2][2]; acc_zero<2>(acc);
        gemm_mainloop(acc, [&](int r) { return MG + (size_t)(m0 + r) * 1024; }, [&](int r) { return W + (size_t)(n0 + r) * 1024; }, 1024, sm);
        const float* g1 = modp(p, l, mod_row(m0), 2);
        if (m0 < TL) {
            EPI_FOREACH(acc, { const size_t o = (size_t)(m0 + er) * 1024 + n0 + ec; outd[o] = xs[o] + g1[n0 + ec] * ev; })
        } else {
            EPI_FOREACH(acc, { const size_t o = (size_t)(m0 - TL + er) * 1024 + n0 + ec; cxd[o] = cs[o] + g1[n0 + ec] * ev; })
        }
    }
}

constexpr int MOE_MAP_OFF = 73728;
DEV void moe_map(const Params& p, int l, char* smem) {
    int* mm = (int*)(smem + MOE_MAP_OFF);
    __syncthreads();
    if (tidx() == 0) {
        const int* cnt = (const int*)(p.ws + OFF_CTR) + CTR_MOE + l * 16;
        int b = 0, t = 0;
        for (int e = 0; e < 16; ++e) { const int c = cnt[e]; mm[e] = c; mm[16 + e] = b; mm[32 + e] = t; b += c; t += (c + 127) >> 7; }
        mm[48] = t;
    }
    __syncthreads();
}
DEV void phase_moe1(const Params& p, int l, char* smem) {
    bf16_t* sm = (bf16_t*)smem;
    const bf16_t* F = wsb(p, OFF_H);
    const bf16_t* W = wsb(p, OFF_WG1);
    bf16_t* ACT = wsb(p, OFF_P);
    const int* ltok = (const int*)(p.ws + OFF_LTOK);
    moe_map(p, l, smem); const int* mm = (const int*)(smem + MOE_MAP_OFF);
    const int nNt = 8, total = mm[48] * nNt;
    for (int item = bidx(); item < total; item += gridDim.x) {
        const int mtg = item / nNt, nt = item % nNt;
        int e = 0;
        for (int q = 1; q < 16; ++q) if (mtg >= mm[32 + q]) e = q;
        const int m0 = (mtg - mm[32 + e]) * 128, n0 = nt * 128, ce = mm[e];
        const int* lt = ltok + (size_t)e * TT;
        f32x16 acc[2][2]; acc_zero<2>(acc);
        gemm_mainloop(acc, [&](int r) { int idx = m0 + r; idx = idx < ce ? idx : ce - 1; return F + (size_t)lt[idx] * 1024; },
                      [&](int r) { return W + ((size_t)e * 1024 + n0 + r) * 1024; }, 1024, sm);
        const int lane = tidx() & 63, wave = tidx() >> 6, wm = wave >> 1, wn = wave & 1;
        const int jcol = ((n0 >> 6) + wn) * 32 + (lane & 31);
#pragma unroll
        for (int a = 0; a < 2; ++a)
#pragma unroll
            for (int r = 0; r < 16; ++r) {
                const int idx = m0 + wm * 64 + a * 32 + (r & 3) + 8 * (r >> 2) + 4 * (lane >> 5);
                if (idx < ce) {
                    const float g = acc[a][0][r], u = acc[a][1][r];
                    ACT[(size_t)(mm[16 + e] + idx) * DFF + jcol] = f2bf(g * sigmoidf_(g) * u);
                }
            }
    }
}
DEV void phase_moe2(const Params& p, int l, char* smem) {
    bf16_t* sm = (bf16_t*)smem;
    const bf16_t* ACT = wsb(p, OFF_P);
    const bf16_t* W = wsb(p, OFF_WDN);
    bf16_t* Z = wsb(p, OFF_Z);
    moe_map(p, l, smem); const int* mm = (const int*)(smem + MOE_MAP_OFF);
    const int nNt = 8, total = mm[48] * nNt;
    for (int item = bidx(); item < total; item += gridDim.x) {
        const int mtg = item / nNt, nt = item % nNt;
        int e = 0;
        for (int q = 1; q < 16; ++q) if (mtg >= mm[32 + q]) e = q;
        const int m0 = (mtg - mm[32 + e]) * 128, n0 = nt * 128, ce = mm[e];
        f32x16 acc[2][2]; acc_zero<2>(acc);
        gemm_mainloop(acc, [&](int r) { int idx = m0 + r; idx = idx < ce ? idx : ce - 1; return ACT + (size_t)(mm[16 + e] + idx) * DFF; },
                      [&](int r) { return W + ((size_t)e * 1024 + n0 + r) * DFF; }, DFF, sm);
        bf16_t* zb = Z + (size_t)mm[16 + e] * 1024;
        EPI_FOREACH(acc, { const int idx = m0 + er; if (idx < ce) zb[(size_t)idx * 1024 + n0 + ec] = f2bf(ev); })
    }
}
DEV void tok_seq(int t, int& base, int& n, int& len) {
    if (t < TL) { base = t & ~(SEQ - 1); n = t & (SEQ - 1); len = SEQ; } else { const int u = t - TL; base = TL + (u & ~(CTXL - 1)); n = u & (CTXL - 1); len = CTXL; }
}
DEV void phase_prep1(const Params& p, int l) {
    const int lane = tidx() & 63, wave = tidx() >> 6;
    bf16_t* P = wsb(p, OFF_P);
    bf16_t* XL = wsb(p, OFF_XL);
    const float* qkg = p.in[I_DAQKG] + l * 64;
    const float* cqg = p.in[I_MCQG] + l * 192;
    const float* ckvg = p.in[I_MCKVG] + l * 128;
    const float* mu3 = p.in[I_RMU] + (l * 4 + 3) * 256;
    for (int t = bidx() * 4 + wave; t < TT; t += gridDim.x * 4) {
        bf16_t* row = P + (size_t)t * LDP;
        int base, n, len; tok_seq(t, base, n, len);
        {
            const int d0 = (lane & 7) * 4;
            float cs[4], sn[4];
            const bool rot = t < TL;
            if (rot) {
                const float fr = (float)(n >> 6), fc = (float)(n & 63);
#pragma unroll
                for (int j = 0; j < 4; ++j) {
                    const int i = (d0 + j) & 15;
                    const float inv = exp2f(-(float)(i & 7) * (13.287712379549449f / 8.f));
                    const float ang = (i < 8 ? fr : fc) * inv;
                    cs[j] = cosf(ang); sn[j] = sinf(ang);
                }
            }
#pragma unroll
            for (int which = 0; which < 2; ++which) {
                bf16_t* ptr = row + (which ? C_DAK : C_DAQ) + lane * 4;
                const u32x2 raw = *(const u32x2*)ptr;
                float v[4] = { bflo(raw.x), bfhi(raw.x), bflo(raw.y), bfhi(raw.y) };
                float ss = v[0] * v[0] + v[1] * v[1] + v[2] * v[2] + v[3] * v[3];
                ss = group_sum<8>(ss);
                const float rstd = rsqrtf(ss * (1.f / 32.f) + EPS);
                const float* g = qkg + which * 32 + d0;
#pragma unroll
                for (int j = 0; j < 4; ++j) v[j] = v[j] * rstd * g[j];
                if (rot) {
#pragma unroll
                    for (int j = 0; j < 4; ++j) {
                        const float o = __shfl_xor(v[j], 4, 64);
                        v[j] = (d0 < 16) ? (v[j] * cs[j] - o * sn[j]) : (v[j] * cs[j] + o * sn[j]);
                    }
                }
                if (which == 0) {
                    const float qs = 0.17677669529663687f * LOG2E;
#pragma unroll
                    for (int j = 0; j < 4; ++j) v[j] *= qs;
                }
                u32x2 o; o.x = pack2(v[0], v[1]); o.y = pack2(v[2], v[3]);
                *(u32x2*)ptr = o;
            }
        }
        {
            float v[3]; float ss = 0.f;
#pragma unroll
            for (int j = 0; j < 3; ++j) { v[j] = bf2f(row[C_CQ + lane + j * 64]); ss += v[j] * v[j]; }
            ss = wave_sum(ss);
            const float rstd = rsqrtf(ss * (1.f / 192.f) + EPS);
#pragma unroll
            for (int j = 0; j < 3; ++j) row[C_CQ + lane + j * 64] = f2bf(v[j] * rstd * cqg[lane + j * 64]);
            float w[2]; float s2 = 0.f;
#pragma unroll
            for (int j = 0; j < 2; ++j) { w[j] = bf2f(row[C_CKV + lane + j * 64]); s2 += w[j] * w[j]; }
            s2 = wave_sum(s2);
            const float r2 = rsqrtf(s2 * (1.f / 128.f) + EPS);
#pragma unroll
            for (int j = 0; j < 2; ++j) row[C_CKV + lane + j * 64] = f2bf(w[j] * r2 * ckvg[lane + j * 64]);
        }
        {
            const int c = lane * 4;
            const u32x2 cur = *(const u32x2*)(row + C_RWD + c);
            u32x2 pv = (u32x2){0u, 0u}, nx = (u32x2){0u, 0u};
            if (n > 0) pv = *(const u32x2*)(row - LDP + C_RWD + c);
            if (n + 1 < len) nx = *(const u32x2*)(row + LDP + C_RWD + c);
            const float4 m = *(const float4*)(mu3 + c);
            float o[4];
            { const float x = bflo(cur.x); o[0] = x + (0.5f * (bflo(pv.x) + bflo(nx.x)) - x) * m.x; }
            { const float x = bfhi(cur.x); o[1] = x + (0.5f * (bfhi(pv.x) + bfhi(nx.x)) - x) * m.y; }
            { const float x = bflo(cur.y); o[2] = x + (0.5f * (bflo(pv.y) + bflo(nx.y)) - x) * m.z; }
            { const float x = bfhi(cur.y); o[3] = x + (0.5f * (bfhi(pv.y) + bfhi(nx.y)) - x) * m.w; }
            u32x2 ov; ov.x = pack2(o[0], o[1]); ov.y = pack2(o[2], o[3]);
            *(u32x2*)(XL + (size_t)t * 256 + c) = ov;
        }
    }
}

DEV void phase_prep_gemm1(const Params& p, int l, char* smem) {
    const bf16_t* P = wsb(p, OFF_P);
    const bf16_t* w = wsb(p, OFF_WSM) + (size_t)l * WS_PER_LAYER;
    bf16_t* QRAW = wsb(p, OFF_QRAW); bf16_t* KVRAW = wsb(p, OFF_KVRAW); bf16_t* LR = wsb(p, OFF_LR);
    int rot = 0;
    gemm_generic(P + C_CQ, LDP, TT, w + WS_UQT, 192, 192, 192, [&](int r, int c, float v) { QRAW[(size_t)r * 192 + c] = f2bf(v); }, smem, rot);
    rot += (TT / 128) * 2;
    gemm_generic(P + C_CKV, LDP, TT, w + WS_UKVT, 128, 384, 128, [&](int r, int c, float v) { KVRAW[(size_t)r * 384 + c] = f2bf(v); }, smem, rot);
    rot += (TT / 128) * 3;
    gemm_generic(wsb(p, OFF_XL), 256, TT, w + WS_W1C, 256, 192, 256,
                 [&](int r, int c, float v) { const float o = c < 64 ? tanhf(v) : (c < 128 ? v : sigmoidf_(v)); LR[(size_t)r * 192 + c] = f2bf(o); }, smem, rot);
}
DEV void phase_prep_gemm2(const Params& p, int l, char* smem) {
    const bf16_t* w = wsb(p, OFF_WSM) + (size_t)l * WS_PER_LAYER;
    const bf16_t* LR = wsb(p, OFF_LR);
    bf16_t* RWX = wsb(p, OFF_RWX);
    bf16_t* P = wsb(p, OFF_P);
    int rot = 0;
    for (int d = 0; d < 2; ++d) {
        const float* w0 = p.in[I_RW0] + (l * 2 + d) * 256;
        gemm_generic(LR + d * 32, 192, TT, w + WS_W2 + (size_t)d * 256 * 64, 64, 256, 64,
                     [&](int r, int c, float v) { RWX[(size_t)r * 1024 + d * 256 + c] = f2bf(0.6065306597126334f * sigmoidf_(w0[c] + v)); }, smem, rot);
        rot += (TT / 128) * 2;
        const float* a0 = p.in[I_RA0] + (l * 2 + d) * 256;
        gemm_generic(LR + 64 + d * 32, 192, TT, w + WS_W2 + (size_t)(2 + d) * 256 * 64, 64, 256, 64,
                     [&](int r, int c, float v) { RWX[(size_t)r * 1024 + 512 + d * 256 + c] = f2bf(sigmoidf_(a0[c] + v)); }, smem, rot);
        rot += (TT / 128) * 2;
    }
    gemm_generic(LR + 128, 192, TT, w + WS_G2T, 64, 256, 64, [&](int r, int c, float v) { P[(size_t)r * LDP + C_RWD + c] = f2bf(v); }, smem, rot);
}

DEV void phase_prep2(const Params& p, int l) {
    const int lane = tidx() & 63, wave = tidx() >> 6;
    const bf16_t* P = wsb(p, OFF_P);
    const bf16_t* QRAW = wsb(p, OFF_QRAW); const bf16_t* KVRAW = wsb(p, OFF_KVRAW);
    bf16_t* MQ = wsb(p, OFF_MLAQ); bf16_t* MK = wsb(p, OFF_MLAK); bf16_t* MV = wsb(p, OFF_MLAV);
    const float* qkg = p.in[I_MQKG] + l * 96;
    for (int t = bidx() * 4 + wave; t < TT; t += gridDim.x * 4) {
        int base, n, len; tok_seq(t, base, n, len);
        const int h = lane >> 4, j = lane & 15;
        const bool rot = t < TL;
        float cs = 1.f, sn = 0.f;
        if (rot) {
            const int i = j & 7;
            const float inv = exp2f(-(float)(i & 3) * (13.287712379549449f / 4.f));
            const float ang = (i < 4 ? (float)(n >> 6) : (float)(n & 63)) * inv;
            cs = cosf(ang); sn = sinf(ang);
        }
        {
            float v[3]; float ss = 0.f;
#pragma unroll
            for (int k = 0; k < 3; ++k) { v[k] = bf2f(QRAW[(size_t)t * 192 + h * 48 + j + k * 16]); ss += v[k] * v[k]; }
            ss = group_sum<16>(ss);
            const float rstd = rsqrtf(ss * (1.f / 48.f) + EPS);
#pragma unroll
            for (int k = 0; k < 3; ++k) v[k] = v[k] * rstd * qkg[j + k * 16];
            if (rot) { const float o = __shfl_xor(v[2], 8, 64); v[2] = (j < 8) ? (v[2] * cs - o * sn) : (v[2] * cs + o * sn); }
            const float qs = 0.14433756729740643f * LOG2E;
#pragma unroll
            for (int k = 0; k < 3; ++k) MQ[(size_t)t * 192 + h * 48 + j + k * 16] = f2bf(v[k] * qs);
        }
        {
            float v[3]; float ss = 0.f;
            v[0] = bf2f(KVRAW[(size_t)t * 384 + h * 96 + j]);
            v[1] = bf2f(KVRAW[(size_t)t * 384 + h * 96 + 16 + j]);
            v[2] = bf2f(P[(size_t)t * LDP + C_KR + j]);
#pragma unroll
            for (int k = 0; k < 3; ++k) ss += v[k] * v[k];
            ss = group_sum<16>(ss);
            const float rstd = rsqrtf(ss * (1.f / 48.f) + EPS);
#pragma unroll
            for (int k = 0; k < 3; ++k) v[k] = v[k] * rstd * qkg[48 + j + k * 16];
            if (rot) { const float o = __shfl_xor(v[2], 8, 64); v[2] = (j < 8) ? (v[2] * cs - o * sn) : (v[2] * cs + o * sn); }
#pragma unroll
            for (int k = 0; k < 3; ++k) MK[(size_t)t * 192 + h * 48 + j + k * 16] = f2bf(v[k]);
        }
#pragma unroll
        for (int k = 0; k < 4; ++k) MV[(size_t)t * 256 + h * 64 + j + k * 16] = KVRAW[(size_t)t * 384 + h * 96 + 32 + j + k * 16];
    }
}
template <int NC, int DK>
struct AttnCfg {
    static constexpr int DKROW = NC * DK, KLD = DKROW + 8, VLD = 68;
    static constexpr int KSTAGE = 64 * KLD, VSTAGE = 64 * VLD;
    static constexpr int KCH = 64 * DKROW / 8;
};
template <int NC, int DK, class EPI>
DEV void attn_item(const bf16_t* Q, int ldq, const bf16_t* Kl, const bf16_t* Kc, int ldk, const bf16_t* Vl, const bf16_t* Vc, int ldv,
                   int q0, int nlat_tiles, int nctx_tiles, EPI epi, char* smem) {
    using C = AttnCfg<NC, DK>;
    constexpr int KS = DK / 16;
    const int tid = tidx(), lane = tid & 63, wave = tid >> 6, ql = lane & 31, hh = lane >> 5;
    bf16_t* Ks = (bf16_t*)smem;
    bf16_t* Vt = Ks + 2 * C::KSTAGE;
    bf16x8 qf[NC][KS];
    {
        const bf16_t* qp = Q + (size_t)(q0 + wave * 32 + ql) * ldq + hh * 8;
#pragma unroll
        for (int c = 0; c < NC; ++c)
#pragma unroll
            for (int ks = 0; ks < KS; ++ks) qf[c][ks] = *(const bf16x8*)(qp + c * DK + ks * 16);
    }
    f32x16 O[NC][2];
    float mrun[NC], lrun[NC];
#pragma unroll
    for (int c = 0; c < NC; ++c) {
        mrun[c] = -1e30f; lrun[c] = 0.f;
#pragma unroll
        for (int d = 0; d < 2; ++d)
#pragma unroll
            for (int r = 0; r < 16; ++r) O[c][d][r] = 0.f;
    }
    const int ntiles = nlat_tiles + nctx_tiles;
    constexpr int KPT = (C::KCH + NT - 1) / NT;
    u32x4 rk[KPT], rv[2];
    auto load_tile = [&](int tile) {
        const bf16_t* kb = tile < nlat_tiles ? Kl + (size_t)tile * 64 * ldk : Kc + (size_t)(tile - nlat_tiles) * 64 * ldk;
        const bf16_t* vb = tile < nlat_tiles ? Vl + (size_t)tile * 64 * ldv : Vc + (size_t)(tile - nlat_tiles) * 64 * ldv;
#pragma unroll
        for (int i = 0; i < KPT; ++i) {
            int q = tid + i * NT; q = q < C::KCH ? q : C::KCH - 1;
            { const int key = q / (C::DKROW / 8), ch = q % (C::DKROW / 8); rk[i] = *(const u32x4*)(kb + (size_t)key * ldk + ch * 8); }
        }
#pragma unroll
        for (int i = 0; i < 2; ++i) { const int q = tid + i * NT; const int key = q >> 3, ch = q & 7; rv[i] = *(const u32x4*)(vb + (size_t)key * ldv + ch * 8); }
    };
    auto store_tile = [&](int st) {
#pragma unroll
        for (int i = 0; i < KPT; ++i) {
            const int q = tid + i * NT;
            if (q < C::KCH) { const int key = q / (C::DKROW / 8), ch = q % (C::DKROW / 8); *(u32x4*)(Ks + st * C::KSTAGE + key * C::KLD + ch * 8) = rk[i]; }
        }
#pragma unroll
        for (int i = 0; i < 2; ++i) {
            const int q = tid + i * NT; const int key = q >> 3, dv0 = (q & 7) * 8;
            bf16_t* vd = Vt + st * C::VSTAGE + dv0 * C::VLD + key;
            const unsigned w[4] = { rv[i][0], rv[i][1], rv[i][2], rv[i][3] };
#pragma unroll
            for (int j = 0; j < 4; ++j) { vd[(2 * j) * C::VLD] = (bf16_t)(w[j] & 0xFFFFu); vd[(2 * j + 1) * C::VLD] = (bf16_t)(w[j] >> 16); }
        }
    };
    load_tile(0);
    __syncthreads();
    store_tile(0);
    __syncthreads();
    for (int tile = 0; tile < ntiles; ++tile) {
        const int cur = tile & 1;
        if (tile + 1 < ntiles) load_tile(tile + 1);
        const bf16_t* ks_ = Ks + cur * C::KSTAGE;
        const bf16_t* vt_ = Vt + cur * C::VSTAGE;
#pragma unroll
        for (int c = 0; c < NC; ++c) {
            f32x16 S[2];
#pragma unroll
            for (int kb = 0; kb < 2; ++kb) {
#pragma unroll
                for (int r = 0; r < 16; ++r) S[kb][r] = 0.f;
#pragma unroll
                for (int ks = 0; ks < KS; ++ks) {
                    const bf16x8 kf = *(const bf16x8*)(ks_ + (kb * 32 + ql) * C::KLD + c * DK + ks * 16 + hh * 8);
                    S[kb] = __builtin_amdgcn_mfma_f32_32x32x16_bf16(kf, qf[c][ks], S[kb], 0, 0, 0);
                }
            }
            float mx = S[0][0];
#pragma unroll
            for (int kb = 0; kb < 2; ++kb)
#pragma unroll
                for (int r = 0; r < 16; ++r) mx = fmaxf(mx, S[kb][r]);
            mx = fmaxf(mx, __shfl_xor(mx, 32, 64));
            const float mnew = fmaxf(mrun[c], mx);
            const float alpha = __builtin_amdgcn_exp2f(mrun[c] - mnew);
            mrun[c] = mnew;
            float ls = 0.f;
#pragma unroll
            for (int kb = 0; kb < 2; ++kb)
#pragma unroll
                for (int r = 0; r < 16; ++r) { const float e = __builtin_amdgcn_exp2f(S[kb][r] - mnew); S[kb][r] = e; ls += e; }
            lrun[c] = lrun[c] * alpha + ls;
#pragma unroll
            for (int d = 0; d < 2; ++d)
#pragma unroll
                for (int r = 0; r < 16; ++r) O[c][d][r] *= alpha;
#pragma unroll
            for (int s = 0; s < 4; ++s) {
                const int kb = s >> 1, s2 = s & 1;
                const u32x4 pu = (u32x4){pack2(S[kb][8 * s2 + 0], S[kb][8 * s2 + 1]), pack2(S[kb][8 * s2 + 2], S[kb][8 * s2 + 3]),
                                         pack2(S[kb][8 * s2 + 4], S[kb][8 * s2 + 5]), pack2(S[kb][8 * s2 + 6], S[kb][8 * s2 + 7])};
                const bf16x8 pf = __builtin_bit_cast(bf16x8, pu);
                const int keyo = kb * 32 + 16 * s2 + 4 * hh;
#pragma unroll
                for (int d = 0; d < 2; ++d) {
                    const bf16_t* vp = vt_ + (d * 32 + ql) * C::VLD + keyo;
                    const u32x2 lo = *(const u32x2*)vp, hi = *(const u32x2*)(vp + 8);
                    const u32x4 vv = (u32x4){lo[0], lo[1], hi[0], hi[1]};
                    const bf16x8 vf = __builtin_bit_cast(bf16x8, vv);
                    O[c][d] = __builtin_amdgcn_mfma_f32_32x32x16_bf16(vf, pf, O[c][d], 0, 0, 0);
                }
            }
        }
        if (tile + 1 < ntiles) store_tile(cur ^ 1);
        __syncthreads();
    }
    float inv[NC];
#pragma unroll
    for (int c = 0; c < NC; ++c) { const float lt = lrun[c] + __shfl_xor(lrun[c], 32, 64); inv[c] = 1.f / lt; }
    epi(O, inv, q0 + wave * 32 + ql, hh);
}

DEV void da_item(const Params& p, int l, int item, char* smem) {
    const bf16_t* P = wsb(p, OFF_P);
    bf16_t* Y = wsb(p, OFF_Y);
    const float linit = 0.8f - 0.6f * __expf(-0.3f * (float)l);
    float lam;
    {
        const float* la = p.in[I_DALAM] + l * 128;
        const int lane = tidx() & 63;
        float a = lane < 32 ? la[lane] * la[32 + lane] : 0.f, b = lane < 32 ? la[64 + lane] * la[96 + lane] : 0.f;
        a = wave_sum(a); b = wave_sum(b);
        lam = __expf(a) - __expf(b) + linit;
    }
    const float* sg = p.in[I_DASUB] + l * 64;
    int b, h, qt; bool isctx;
    if (item < 512) { isctx = false; b = item >> 6; h = (item >> 4) & 3; qt = item & 15; }
    else { const int it = item - 512; isctx = true; b = it >> 3; h = (it >> 1) & 3; qt = it & 1; }
    const size_t lat0 = (size_t)b * SEQ, ctx0 = (size_t)TL + (size_t)b * CTXL;
    const size_t qrow0 = isctx ? ctx0 : lat0;
    float* o1s = (float*)(smem + 32768) + (tidx() >> 6) * (32 * 64) + (tidx() & 63);
    auto epi0 = [&](f32x16 (&O)[1][2], float (&inv)[1], int qrow, int hh) {
#pragma unroll
        for (int d = 0; d < 2; ++d)
#pragma unroll
            for (int r = 0; r < 16; ++r) o1s[(d * 16 + r) * 64] = O[0][d][r] * inv[0];
    };
    auto epi1 = [&](f32x16 (&O)[1][2], float (&inv)[1], int qrow, int hh) {
        float v[2][16]; float ss = 0.f;
#pragma unroll
        for (int d = 0; d < 2; ++d)
#pragma unroll
            for (int r = 0; r < 16; ++r) { const float o = o1s[(d * 16 + r) * 64] - lam * O[0][d][r] * inv[0]; v[d][r] = o; ss += o * o; }
        ss += __shfl_xor(ss, 32, 64);
        const float rstd = rsqrtf(ss * (1.f / 64.f) + EPS) * (1.f - linit);
        bf16_t* yo = Y + (qrow0 + qrow) * 1024 + h * 64;
#pragma unroll
        for (int d = 0; d < 2; ++d)
#pragma unroll
            for (int g = 0; g < 4; ++g) {
                const int dv = d * 32 + 8 * g + 4 * hh;
                u32x2 o;
                o.x = pack2(v[d][4 * g + 0] * rstd * sg[dv + 0], v[d][4 * g + 1] * rstd * sg[dv + 1]);
                o.y = pack2(v[d][4 * g + 2] * rstd * sg[dv + 2], v[d][4 * g + 3] * rstd * sg[dv + 3]);
                *(u32x2*)(yo + dv) = o;
            }
    };
    const bf16_t* Qp = P + qrow0 * LDP + C_DAQ + h * 64;
    const bf16_t* Kl = P + lat0 * LDP + C_DAK + h * 64;
    const bf16_t* Kc = P + ctx0 * LDP + C_DAK + h * 64;
    const bf16_t* Vl = P + lat0 * LDP + C_DAV + h * 64;
    const bf16_t* Vc = P + ctx0 * LDP + C_DAV + h * 64;
    const int nlat = isctx ? 0 : SEQ / 64;
    attn_item<1, 32>(Qp, LDP, Kl, Kc, LDP, Vl, Vc, LDP, qt * 128, nlat, CTXL / 64, epi0, smem);
    attn_item<1, 32>(Qp + 32, LDP, Kl + 32, Kc + 32, LDP, Vl, Vc, LDP, qt * 128, nlat, CTXL / 64, epi1, smem);
}
DEV void mla_item(const Params& p, int l, int item, char* smem) {
    const bf16_t* MQ = wsb(p, OFF_MLAQ); const bf16_t* MK = wsb(p, OFF_MLAK); const bf16_t* MV = wsb(p, OFF_MLAV);
    bf16_t* Y = wsb(p, OFF_Y);
    int b, h, qt; bool isctx;
    if (item < 512) { isctx = false; b = item >> 6; h = (item >> 4) & 3; qt = item & 15; }
    else { const int it = item - 512; isctx = true; b = it >> 3; h = (it >> 1) & 3; qt = it & 1; }
    const size_t lat0 = (size_t)b * SEQ, ctx0 = (size_t)TL + (size_t)b * CTXL;
    const size_t qrow0 = isctx ? ctx0 : lat0;
    auto epi = [&](f32x16 (&O)[1][2], float (&inv)[1], int qrow, int hh) {
        bf16_t* yo = Y + (qrow0 + qrow) * 1024 + 512 + h * 64;
#pragma unroll
        for (int d = 0; d < 2; ++d)
#pragma unroll
            for (int g = 0; g < 4; ++g) {
                const int dv = d * 32 + 8 * g + 4 * hh;
                u32x2 o;
                o.x = pack2(O[0][d][4 * g + 0] * inv[0], O[0][d][4 * g + 1] * inv[0]);
                o.y = pack2(O[0][d][4 * g + 2] * inv[0], O[0][d][4 * g + 3] * inv[0]);
                *(u32x2*)(yo + dv) = o;
            }
    };
    const bf16_t* Qp = MQ + qrow0 * 192 + h * 48;
    const bf16_t* Kl = MK + lat0 * 192 + h * 48;
    const bf16_t* Kc = MK + ctx0 * 192 + h * 48;
    const bf16_t* Vl = MV + lat0 * 256 + h * 64;
    const bf16_t* Vc = MV + ctx0 * 256 + h * 64;
    attn_item<1, 48>(Qp, 192, Kl, Kc, 192, Vl, Vc, 256, qt * 128, isctx ? 0 : SEQ / 64, CTXL / 64, epi, smem);
}
DEV int s5_token(int b, int tb, int n) { return tb == 0 ? TL + b * CTXL + n : b * SEQ + (tb - 1) * 256 + n; }
struct S5Lane { float are, aim; float bre[16], bim[16]; };
DEV void s5_setup(const Params& p, int l, int d, int g, int pl, S5Lane& s) {
    const int gi = ((l * 2 + d) * 16 + g);
    const float lre = p.in[I_S5LRE][gi * 64 + pl], lim = p.in[I_S5LIM][gi * 64 + pl];
    const float dt = __expf(p.in[I_S5LDT][gi]);
    const float mag = __expf(lre * dt);
    s.are = mag * cosf(lim * dt); s.aim = mag * sinf(lim * dt);
    const float nr = s.are - 1.f, ni = s.aim, den = 1.f / (lre * lre + lim * lim);
    const float cr = (nr * lre + ni * lim) * den, ci = (ni * lre - nr * lim) * den;
    const float* br = p.in[I_S5BRE] + ((size_t)gi * 64 + pl) * 16;
    const float* bi = p.in[I_S5BIM] + ((size_t)gi * 64 + pl) * 16;
#pragma unroll
    for (int c = 0; c < 16; ++c) { const float x = br[c], y = bi[c]; s.bre[c] = cr * x - ci * y; s.bim[c] = cr * y + ci * x; }
}
template <bool DUMP>
DEV void s5_scan32(const S5Lane& s, float& hre, float& him, const float* ub, bf16_t* hb, int pl, bool rev) {
    for (int j = 0; j < 32; ++j) {
        const int rowi = rev ? 31 - j : j;
        const float4* u4 = (const float4*)(ub + rowi * 16);
        float bur = 0.f, bui = 0.f;
#pragma unroll
        for (int q = 0; q < 4; ++q) {
            const float4 u = u4[q];
            bur += u.x * s.bre[q * 4 + 0] + u.y * s.bre[q * 4 + 1] + u.z * s.bre[q * 4 + 2] + u.w * s.bre[q * 4 + 3];
            bui += u.x * s.bim[q * 4 + 0] + u.y * s.bim[q * 4 + 1] + u.z * s.bim[q * 4 + 2] + u.w * s.bim[q * 4 + 3];
        }
        const float nre = s.are * hre - s.aim * him + bur;
        const float nim = s.are * him + s.aim * hre + bui;
        hre = nre; him = nim;
        if (DUMP) { hb[rowi * 136 + pl] = f2bf(hre); hb[rowi * 136 + 64 + pl] = f2bf(him); }
    }
}
DEV void s5_load_u(const bf16_t* P, int b, int tb, int g, int sc, float* ub, int lane) {
    if (lane < 32) {
        const int t = s5_token(b, tb, sc * 32 + lane);
        const uint4* src = (const uint4*)(P + (size_t)t * LDP + C_S5 + g * 16);
        const uint4 a = src[0], c = src[1];
        float4* d = (float4*)(ub + lane * 16);
        d[0] = make_float4(bflo(a.x), bfhi(a.x), bflo(a.y), bfhi(a.y));
        d[1] = make_float4(bflo(a.z), bfhi(a.z), bflo(a.w), bfhi(a.w));
        d[2] = make_float4(bflo(c.x), bfhi(c.x), bflo(c.y), bfhi(c.y));
        d[3] = make_float4(bflo(c.z), bfhi(c.z), bflo(c.w), bfhi(c.w));
    }
}
DEV void phase_s5_pass1(const Params& p, int l, char* smem) {
    const int lane = tidx() & 63, wave = tidx() >> 6;
    float* ub = (float*)smem + wave * 512;
    const bf16_t* P = wsb(p, OFF_P);
    float* st = wsf(p, OFF_S5ST);
    const int nitems = 2 * 8 * 16 * 8;
    for (int it0 = bidx() * 4; it0 < nitems; it0 += gridDim.x * 4) {
        const int it = it0 + wave;
        const int seg = it & 7, g = (it >> 3) & 15, b = (it >> 7) & 7, d = it >> 10;
        const int tb = seg == 0 ? 0 : (d == 0 ? seg : 9 - seg);
        S5Lane s; s5_setup(p, l, d, g, lane, s);
        float hre = 0.f, him = 0.f;
        for (int k = 0; k < 8; ++k) {
            const int sc = d == 0 ? k : 7 - k;
            __syncthreads();
            s5_load_u(P, b, tb, g, sc, ub, lane);
            __syncthreads();
            s5_scan32<false>(s, hre, him, ub, nullptr, lane, d == 1);
        }
        float* o = st + ((((size_t)d * 8 + b) * 16 + g) * 8 + seg) * 128;
        o[lane] = hre; o[64 + lane] = him;
    }
}
DEV void s5_pass2_item(const Params& p, int l, int tb0, int bitem, char* smem) {
    const int lane = tidx() & 63, wave = tidx() >> 6;
    float* ub = (float*)smem + wave * 512;
    bf16_t* hb = (bf16_t*)(smem + 8192) + wave * (32 * 136);
    bf16_t* P = wsb(p, OFF_P);
    const float* st = wsf(p, OFF_S5ST);
    {
        const int it = bitem * 4 + wave;
        const int g = it & 15, b = (it >> 4) & 7, tb = (it >> 7) + tb0;
        f32x4 yacc[16];
#pragma unroll
        for (int i = 0; i < 16; ++i) yacc[i] = (f32x4){0.f, 0.f, 0.f, 0.f};
#pragma unroll
        for (int d = 0; d < 2; ++d) {
            S5Lane s; s5_setup(p, l, d, g, lane, s);
            const float* cre = p.in[I_S5CRE] + ((size_t)((l * 2 + d) * 16 + g) * 16 + (lane & 15)) * 64 + (lane >> 4) * 8;
            const float* cim = p.in[I_S5CIM] + ((size_t)((l * 2 + d) * 16 + g) * 16 + (lane & 15)) * 64 + (lane >> 4) * 8;
            auto cfrag = [&](int ks) {
                const float* src = ks < 2 ? cre + ks * 32 : cim + (ks - 2) * 32;
                const float4 a = *(const float4*)src, b = *(const float4*)(src + 4);
                const float sg = ks < 2 ? 1.f : -1.f;
                const u32x4 u = (u32x4){pack2(sg * a.x, sg * a.y), pack2(sg * a.z, sg * a.w), pack2(sg * b.x, sg * b.y), pack2(sg * b.z, sg * b.w)};
                return __builtin_bit_cast(bf16x8, u);
            };
            const int seg = tb == 0 ? 0 : (d == 0 ? tb : 9 - tb);
            float hre = 0.f, him = 0.f;
            {
                float pr = s.are, pi = s.aim;
#pragma unroll
                for (int q = 0; q < 8; ++q) { const float nr = pr * pr - pi * pi, ni = 2.f * pr * pi; pr = nr; pi = ni; }
                const float* hs = st + (((size_t)d * 8 + b) * 16 + g) * 8 * 128;
                for (int i = 0; i < seg; ++i) {
                    const float er = hs[i * 128 + lane], ei = hs[i * 128 + 64 + lane];
                    const float nr = pr * hre - pi * him + er, ni = pr * him + pi * hre + ei;
                    hre = nr; him = ni;
                }
            }
#pragma unroll
            for (int k = 0; k < 8; ++k) {
                const int sc = d == 0 ? k : 7 - k;
                __syncthreads();
                s5_load_u(P, b, tb, g, sc, ub, lane);
                __syncthreads();
                s5_scan32<true>(s, hre, him, ub, hb, lane, d == 1);
                __syncthreads();
#pragma unroll
                for (int mt = 0; mt < 2; ++mt)
#pragma unroll
                    for (int ks = 0; ks < 4; ++ks) {
                        const bf16x8 af = *(const bf16x8*)(hb + (mt * 16 + (lane & 15)) * 136 + ks * 32 + (lane >> 4) * 8);
                        yacc[sc * 2 + mt] = __builtin_amdgcn_mfma_f32_16x16x32_bf16(af, cfrag(ks), yacc[sc * 2 + mt], 0, 0, 0);
                    }
            }
        }
        {
            const int c = lane & 15;
            const float dd = p.in[I_S5D][(l * 16 + g) * 16 + c];
#pragma unroll
            for (int tile = 0; tile < 16; ++tile)
#pragma unroll
                for (int r = 0; r < 4; ++r) {
                    const int n = tile * 16 + (lane >> 4) * 4 + r;
                    bf16_t* up = P + (size_t)s5_token(b, tb, n) * LDP + C_S5 + g * 16 + c;
                    const float y = dd * bf2f(*up) + yacc[tile][r];
                    const float z = 0.5f * y * (1.f + tanhf(0.7978845608028654f * (y + 0.044715f * y * y * y)));
                    *up = f2bf(z);
                }
        }
    }
}

DEV float row16_sum(float v) {
    v += __int_as_float(__builtin_amdgcn_mov_dpp(__float_as_int(v), 0x128, 0xf, 0xf, true));
    v += __int_as_float(__builtin_amdgcn_mov_dpp(__float_as_int(v), 0x124, 0xf, 0xf, true));
    v += __int_as_float(__builtin_amdgcn_mov_dpp(__float_as_int(v), 0x122, 0xf, 0xf, true));
    v += __int_as_float(__builtin_amdgcn_mov_dpp(__float_as_int(v), 0x121, 0xf, 0xf, true));
    return v;
}
DEV float fmul_(float a, float b) { return a * b; }
DEV float fadd_(float a, float b) { return a + b; }
DEV float ffma_(float a, float b, float c) { return __builtin_fmaf(a, b, c); }
DEV float fnma_(float a, float b, float c) { return __builtin_fmaf(-a, b, c); }
DEV float row8_sum(float v) {
    v += __int_as_float(__builtin_amdgcn_mov_dpp(__float_as_int(v), 0x141, 0xf, 0xf, true));
    v += __int_as_float(__builtin_amdgcn_mov_dpp(__float_as_int(v), 0xB1, 0xf, 0xf, true));
    v += __int_as_float(__builtin_amdgcn_mov_dpp(__float_as_int(v), 0x4E, 0xf, 0xf, true));
    return v;
}
DEV float row16_sum1(float v) { v += __int_as_float(__builtin_amdgcn_mov_dpp(__float_as_int(v), 0x128, 0xf, 0xf, true)); return v; }
constexpr int RW_CT = 16;
struct RwRaw { u32x2 r[3], k[3], v[3], sd, a; float fp, fn; };
#ifndef RWVAR
#define RWVAR 0
#endif
template <int var>
DEV void rw_item_t(const Params& p, int l, int item, char* smem, int rep) {
    const int tid = tidx(), li = tid >> 4, lc = tid & 15;
    const int ch = item >> 2, rg = item & 3, dir = ch >> 5, b = (ch >> 2) & 7, head = ch & 3;
    float* buf = (float*)smem;
    float* ybuf = buf + 2 * RW_CT * 384;
    const bf16_t* P = wsb(p, OFF_P);
    const bf16_t* RWX = wsb(p, OFF_RWX);
    bf16_t* RWY = wsb(p, OFF_RWY) + (size_t)dir * TT * 256 + (rep > 0 ? (size_t)2 * TT * 256 : 0);
    const int hc = head * 64 + lc * 4;
    const float4 mur = *(const float4*)(p.in[I_RMU] + (l * 4 + 0) * 256 + hc);
    const float4 muk = *(const float4*)(p.in[I_RMU] + (l * 4 + 1) * 256 + hc);
    const float4 muv = *(const float4*)(p.in[I_RMU] + (l * 4 + 2) * 256 + hc);
    const float4 kk4 = *(const float4*)(p.in[I_RKK] + l * 256 + hc);
    const float4 ka4 = *(const float4*)(p.in[I_RKA] + l * 256 + hc);
    const int NCH = (CTXL + SEQ) / RW_CT;
    auto tok_of = [&](int cidx, int i, int& n, int& len) -> int {
        if (cidx < CTXL / RW_CT) { const int pos = cidx * RW_CT + i; len = CTXL; n = dir == 0 ? pos : CTXL - 1 - pos; return TL + b * CTXL + n; }
        const int pos = (cidx - CTXL / RW_CT) * RW_CT + i; len = SEQ; n = dir == 0 ? pos : SEQ - 1 - pos; return b * SEQ + n;
    };
    auto load_raw = [&](int cidx, RwRaw& raw) {
        int n, len; const int t = tok_of(cidx, li, n, len);
        const bf16_t* row = P + (size_t)t * LDP;
        const bool hp = n > 0, hn = n + 1 < len;
        const bf16_t* rp = hp ? row - LDP : row;
        const bf16_t* rn = hn ? row + LDP : row;
        raw.fp = hp ? 0.5f : 0.f; raw.fn = hn ? 0.5f : 0.f;
        raw.r[1] = *(const u32x2*)(row + C_RWR + hc); raw.k[1] = *(const u32x2*)(row + C_RWK + hc); raw.v[1] = *(const u32x2*)(row + C_RWV + hc);
        raw.r[0] = *(const u32x2*)(rp + C_RWR + hc); raw.k[0] = *(const u32x2*)(rp + C_RWK + hc); raw.v[0] = *(const u32x2*)(rp + C_RWV + hc);
        raw.r[2] = *(const u32x2*)(rn + C_RWR + hc); raw.k[2] = *(const u32x2*)(rn + C_RWK + hc); raw.v[2] = *(const u32x2*)(rn + C_RWV + hc);
        raw.sd = *(const u32x2*)(RWX + (size_t)t * 1024 + dir * 256 + hc);
        raw.a = *(const u32x2*)(RWX + (size_t)t * 1024 + 512 + dir * 256 + hc);
    };
    auto mix4 = [&](const u32x2 (&s)[3], const float4& mu, float fp, float fn, float (&o)[4]) {
        { const float x = bflo(s[1].x); o[0] = x + ((fp * bflo(s[0].x) + fn * bflo(s[2].x)) - x) * mu.x; }
        { const float x = bfhi(s[1].x); o[1] = x + ((fp * bfhi(s[0].x) + fn * bfhi(s[2].x)) - x) * mu.y; }
        { const float x = bflo(s[1].y); o[2] = x + ((fp * bflo(s[0].y) + fn * bflo(s[2].y)) - x) * mu.z; }
        { const float x = bfhi(s[1].y); o[3] = x + ((fp * bfhi(s[0].y) + fn * bfhi(s[2].y)) - x) * mu.w; }
    };
    auto stage = [&](int st, const RwRaw& raw) {
        float r4[4], k4[4], v4[4];
        mix4(raw.r, mur, raw.fp, raw.fn, r4); mix4(raw.k, muk, raw.fp, raw.fn, k4); mix4(raw.v, muv, raw.fp, raw.fn, v4);
        const float kkr[4] = { k4[0] * kk4.x, k4[1] * kk4.y, k4[2] * kk4.z, k4[3] * kk4.w };
        float nn = kkr[0] * kkr[0] + kkr[1] * kkr[1] + kkr[2] * kkr[2] + kkr[3] * kkr[3];
        nn = row16_sum(nn);
        const float rn = 1.f / fmaxf(sqrtf(nn), 1e-12f);
        const float a[4] = { bflo(raw.a.x), bfhi(raw.a.x), bflo(raw.a.y), bfhi(raw.a.y) };
        const float sd[4] = { bflo(raw.sd.x), bfhi(raw.sd.x), bflo(raw.sd.y), bfhi(raw.sd.y) };
        const float kav[4] = { ka4.x, ka4.y, ka4.z, ka4.w };
        float* d = buf + (st * RW_CT + li) * 384 + lc * 4;
        float wp[4], kp[4], bp[4], mp[4];
#pragma unroll
        for (int j = 0; j < 4; ++j) {
            wp[j] = __expf(-sd[j]);
            kp[j] = kkr[j] * rn;
            bp[j] = kp[j] * a[j];
            mp[j] = k4[j] * (1.f + (a[j] - 1.f) * kav[j]);
        }
        *(float4*)(d + 0) = make_float4(wp[0], wp[1], wp[2], wp[3]); *(float4*)(d + 64) = make_float4(kp[0], kp[1], kp[2], kp[3]);
        *(float4*)(d + 128) = make_float4(bp[0], bp[1], bp[2], bp[3]); *(float4*)(d + 192) = make_float4(mp[0], mp[1], mp[2], mp[3]);
        *(float4*)(d + 256) = make_float4(r4[0], r4[1], r4[2], r4[3]);
        *(float4*)(d + 320) = make_float4(v4[0], v4[1], v4[2], v4[3]);
    };
    float S0 = 0.f, S1 = 0.f, S2 = 0.f, S3 = 0.f;
    auto compute = [&](int cidx, int cur) {
        const float* cb = buf + cur * RW_CT * 384 + lc * 4;
        const float* vb = buf + cur * RW_CT * 384 + 320 + rg * 16 + li;
        float ykeep = 0.f;
        f32x4 w[2], kk[2], bb[2], km[2], rr[2]; float vv[2];
        w[0] = *(const f32x4*)(cb); kk[0] = *(const f32x4*)(cb + 64); bb[0] = *(const f32x4*)(cb + 128); km[0] = *(const f32x4*)(cb + 192); rr[0] = *(const f32x4*)(cb + 256);
        vv[0] = vb[0];
#pragma unroll
        for (int j = 0; j < RW_CT; ++j) {
            const int c0 = j & 1, c2 = c0 ^ 1;
            if (j + 1 < RW_CT) {
                const float* nb = cb + (j + 1) * 384;
                w[c2] = *(const f32x4*)(nb); kk[c2] = *(const f32x4*)(nb + 64); bb[c2] = *(const f32x4*)(nb + 128); km[c2] = *(const f32x4*)(nb + 192); rr[c2] = *(const f32x4*)(nb + 256);
                vv[c2] = vb[(j + 1) * 384];
            }
            const float v_ = vv[c0];
            float sa = fadd_(ffma_(S1, kk[c0][1], fmul_(S0, kk[c0][0])), ffma_(S3, kk[c0][3], fmul_(S2, kk[c0][2])));
            const float t0 = ffma_(S0, w[c0][0], fmul_(v_, km[c0][0])), t1 = ffma_(S1, w[c0][1], fmul_(v_, km[c0][1]));
            const float t2 = ffma_(S2, w[c0][2], fmul_(v_, km[c0][2])), t3 = ffma_(S3, w[c0][3], fmul_(v_, km[c0][3]));
            sa = row16_sum(sa);
            S0 = fnma_(sa, bb[c0][0], t0); S1 = fnma_(sa, bb[c0][1], t1); S2 = fnma_(sa, bb[c0][2], t2); S3 = fnma_(sa, bb[c0][3], t3);
            float y = fadd_(ffma_(S1, rr[c0][1], fmul_(S0, rr[c0][0])), ffma_(S3, rr[c0][3], fmul_(S2, rr[c0][2])));
            y = row16_sum(y);
            ykeep = (lc == j) ? y : ykeep;
        }
        {
            int n, len; const int t = tok_of(cidx, lc, n, len);
            RWY[(size_t)t * 256 + head * 64 + rg * 16 + li] = f2bf(ykeep);
        }
    };
    RwRaw raw;
    __syncthreads();
    load_raw(0, raw);
    stage(0, raw);
    __syncthreads();
    for (int cidx = 0; cidx < NCH; ++cidx) {
        const int cur = cidx & 1;
        load_raw(min(cidx + 1, NCH - 1), raw);
        compute(cidx, cur);
        stage(cur ^ 1, raw);
        __syncthreads();
    }
}

DEV void rw_item(const Params& p, int l, int item, char* smem, int rep = 0) {
    rw_item_t<RWVAR>(p, l, item, smem, rep);
}
constexpr int RC = 32, SK = 72, ST = 40;
constexpr int L_K1 = 0, L_R1 = L_K1 + RC * SK, L_B1 = L_R1 + RC * SK, L_M1 = L_B1 + RC * SK,
              L_VT = L_M1 + RC * SK, L_B2T = L_VT + 64 * ST, L_M2T = L_B2T + 64 * ST,
              L_X = L_M2T + 64 * ST, L_XT = L_X + RC * ST, L_PA = L_XT + RC * ST, L_BM = L_PA + RC * ST, L_AR = L_BM + RC * ST, L_BR = L_AR + RC * ST,
              L_ET = L_BR + RC * ST, L_ZT = L_ET + 64 * ST, L_S = L_ZT + 64 * ST, L_RWEND = L_S + 64 * SK;
static_assert(L_RWEND * 2 + 256 <= 73728, "RWKV chunk LDS");
DEV bf16x8 ldfrag(const bf16_t* m, int stride, int row0, int k0, int lane) { return *(const bf16x8*)(m + (row0 + (lane & 15)) * stride + k0 + (lane >> 4) * 8); }
DEV f32x4 mfma16(bf16x8 a, bf16x8 b, f32x4 c) { return __builtin_amdgcn_mfma_f32_16x16x32_bf16(a, b, c, 0, 0, 0); }
#ifndef RWC_CLAMP
#define RWC_CLAMP 0
#endif
DEV void st4(bf16_t* dst, f32x4 v) {
    if (RWC_CLAMP) { for (int i = 0; i < 4; ++i) v[i] = fminf(fmaxf(v[i], -8.f), 8.f); } u32x2 o; o.x = pack2(v[0], v[1]); o.y = pack2(v[2], v[3]); *(u32x2*)dst = o; }
DEV void unpack8(const u32x4 u, float (&o)[8]) {
    o[0] = bflo(u[0]); o[1] = bfhi(u[0]); o[2] = bflo(u[1]); o[3] = bfhi(u[1]); o[4] = bflo(u[2]); o[5] = bfhi(u[2]); o[6] = bflo(u[3]); o[7] = bfhi(u[3]);
}
DEV u32x4 pack8(const float (&v)[8]) { return (u32x4){pack2(v[0], v[1]), pack2(v[2], v[3]), pack2(v[4], v[5]), pack2(v[6], v[7])}; }
struct RwcRaw { u32x4 r[3], k[3], v[3], sd, a; float fp, fn; };
#ifndef RWC_STOP
#define RWC_STOP 99
#endif
#ifndef RWC_DUMMY
#define RWC_DUMMY 0
#endif
#ifdef RWC_NOINLINE
__device__ __attribute__((noinline)) void rwc_item(const Params& p, int l, int chain, char* smem) {
#else
DEV void rwc_item(const Params& p, int l, int chain, char* smem) {
#endif
    const int tid = tidx(), lane = tid & 63, wave = __builtin_amdgcn_readfirstlane(tid >> 6), c16 = lane & 15, q4 = lane >> 4;
    const int dir = chain >> 5, b = (chain >> 2) & 7, head = chain & 3;
    bf16_t* L = (bf16_t*)smem;
    float* PC = (float*)(smem + L_RWEND * 2);
    float* CS = (float*)(L + L_ET);
    const bf16_t* P = wsb(p, OFF_P);
    const bf16_t* RWX = wsb(p, OFF_RWX);
    bf16_t* RWY = wsb(p, OFF_RWY) + (size_t)dir * TT * 256 + (RWC_DUMMY ? (size_t)2 * TT * 256 : 0);
    const int li = tid >> 3, c8 = (tid & 7) * 8, hc = head * 64 + c8;
    const int NCHK = (CTXL + SEQ) / RC;
    auto tok_of = [&](int c, int i, int& n, int& len) -> int {
        if (c < CTXL / RC) { const int pos = c * RC + i; len = CTXL; n = dir == 0 ? pos : CTXL - 1 - pos; return TL + b * CTXL + n; }
        const int pos = (c - CTXL / RC) * RC + i; len = SEQ; n = dir == 0 ? pos : SEQ - 1 - pos; return b * SEQ + n;
    };
    RwcRaw raw;
    auto load_raw = [&](int c) {
        int n, len; const int t = tok_of(c, li, n, len);
        const bf16_t* row = P + (size_t)t * LDP;
        const bool hp = n > 0, hn = n + 1 < len;
        const bf16_t* rp = hp ? row - LDP : row;
        const bf16_t* rn = hn ? row + LDP : row;
        raw.fp = hp ? 0.5f : 0.f; raw.fn = hn ? 0.5f : 0.f;
        raw.r[1] = *(const u32x4*)(row + C_RWR + hc); raw.k[1] = *(const u32x4*)(row + C_RWK + hc); raw.v[1] = *(const u32x4*)(row + C_RWV + hc);
        raw.r[0] = *(const u32x4*)(rp + C_RWR + hc); raw.k[0] = *(const u32x4*)(rp + C_RWK + hc); raw.v[0] = *(const u32x4*)(rp + C_RWV + hc);
        raw.r[2] = *(const u32x4*)(rn + C_RWR + hc); raw.k[2] = *(const u32x4*)(rn + C_RWK + hc); raw.v[2] = *(const u32x4*)(rn + C_RWV + hc);
        raw.sd = *(const u32x4*)(RWX + (size_t)t * 1024 + dir * 256 + hc);
        raw.a = *(const u32x4*)(RWX + (size_t)t * 1024 + 512 + dir * 256 + hc);
    };
    auto mix8 = [&](const u32x4 (&s)[3], const float* mu, float (&o)[8]) {
        float x[8], pv[8], nx[8]; unpack8(s[1], x); unpack8(s[0], pv); unpack8(s[2], nx);
        const float4 m0 = *(const float4*)mu, m1 = *(const float4*)(mu + 4);
        const float m[8] = { m0.x, m0.y, m0.z, m0.w, m1.x, m1.y, m1.z, m1.w };
#pragma unroll
        for (int j = 0; j < 8; ++j) o[j] = x[j] + ((raw.fp * pv[j] + raw.fn * nx[j]) - x[j]) * m[j];
    };
    f32x4 Wt[4];
#pragma unroll
    for (int j = 0; j < 4; ++j) Wt[j] = (f32x4){0.f, 0.f, 0.f, 0.f};
    __syncthreads();
    for (int i = tid; i < 64 * SK / 2; i += NT) ((unsigned*)(L + L_S))[i] = 0u;
    load_raw(0);
    for (int c = 0; c < (RWC_STOP == 0 ? 0 : NCHK); ++c) {
        {
            float r8[8], k8[8], v8[8], a8[8], sd8[8];
            mix8(raw.r, p.in[I_RMU] + (l * 4 + 0) * 256 + hc, r8);
            mix8(raw.k, p.in[I_RMU] + (l * 4 + 1) * 256 + hc, k8);
            mix8(raw.v, p.in[I_RMU] + (l * 4 + 2) * 256 + hc, v8);
            unpack8(raw.a, a8); unpack8(raw.sd, sd8);
            if (c + 1 < NCHK) load_raw(c + 1);
            const float4 kk0 = *(const float4*)(p.in[I_RKK] + l * 256 + hc), kk1 = *(const float4*)(p.in[I_RKK] + l * 256 + hc + 4);
            const float4 ka0 = *(const float4*)(p.in[I_RKA] + l * 256 + hc), ka1 = *(const float4*)(p.in[I_RKA] + l * 256 + hc + 4);
            const float kkc[8] = { kk0.x, kk0.y, kk0.z, kk0.w, kk1.x, kk1.y, kk1.z, kk1.w };
            const float kac[8] = { ka0.x, ka0.y, ka0.z, ka0.w, ka1.x, ka1.y, ka1.z, ka1.w };
            float kkv[8], bbv[8], kmv[8]; float n2 = 0.f;
#pragma unroll
            for (int j = 0; j < 8; ++j) { kkv[j] = k8[j] * kkc[j]; n2 += kkv[j] * kkv[j]; }
            n2 = row8_sum(n2);
            const float rn = 1.f / fmaxf(sqrtf(n2), 1e-12f);
#pragma unroll
            for (int j = 0; j < 8; ++j) { kkv[j] *= rn; bbv[j] = kkv[j] * a8[j]; kmv[j] = k8[j] * (1.f + (a8[j] - 1.f) * kac[j]); }
            *(float4*)(CS + li * 64 + c8) = make_float4(sd8[0], sd8[1], sd8[2], sd8[3]);
            *(float4*)(CS + li * 64 + c8 + 4) = make_float4(sd8[4], sd8[5], sd8[6], sd8[7]);
            __syncthreads();
            if (tid < 64) { float run = 0.f; for (int i = 0; i < RC; ++i) { run += CS[i * 64 + tid]; CS[i * 64 + tid] = run; } }
            __syncthreads();
            float cs[8], tot[8];
            { const float4 a0 = *(const float4*)(CS + li * 64 + c8), a1 = *(const float4*)(CS + li * 64 + c8 + 4);
              const float4 t0 = *(const float4*)(CS + (RC - 1) * 64 + c8), t1 = *(const float4*)(CS + (RC - 1) * 64 + c8 + 4);
              cs[0] = a0.x; cs[1] = a0.y; cs[2] = a0.z; cs[3] = a0.w; cs[4] = a1.x; cs[5] = a1.y; cs[6] = a1.z; cs[7] = a1.w;
              tot[0] = t0.x; tot[1] = t0.y; tot[2] = t0.z; tot[3] = t0.w; tot[4] = t1.x; tot[5] = t1.y; tot[6] = t1.z; tot[7] = t1.w; }
            float k1[8], r1[8], b1[8], m1[8], b2[8], m2[8];
#pragma unroll
            for (int j = 0; j < 8; ++j) {
                const float pinc = __expf(-cs[j]), pexc = __expf(sd8[j] - cs[j]), einv = __expf(cs[j]), ec = __expf(cs[j] - tot[j]);
                k1[j] = kkv[j] * pexc; r1[j] = r8[j] * pinc; b1[j] = bbv[j] * einv; m1[j] = kmv[j] * einv; b2[j] = bbv[j] * ec; m2[j] = kmv[j] * ec;
            }
            __syncthreads();
            *(u32x4*)(L + L_K1 + li * SK + c8) = pack8(k1); *(u32x4*)(L + L_R1 + li * SK + c8) = pack8(r1);
            *(u32x4*)(L + L_B1 + li * SK + c8) = pack8(b1); *(u32x4*)(L + L_M1 + li * SK + c8) = pack8(m1);
#pragma unroll
            for (int j = 0; j < 8; ++j) {
                L[L_VT + (c8 + j) * ST + li] = f2bf(v8[j]); L[L_B2T + (c8 + j) * ST + li] = f2bf(b2[j]); L[L_M2T + (c8 + j) * ST + li] = f2bf(m2[j]);
            }
            if (li == RC - 1) {
#pragma unroll
                for (int j = 0; j < 8; ++j) PC[c8 + j] = __expf(-tot[j]);
            }
            __syncthreads();
        }
        if (RWC_STOP <= 1) continue;
        {
            const int i0 = wave >> 1, j0 = wave & 1;
            const f32x4 z4 = (f32x4){0.f, 0.f, 0.f, 0.f};
            f32x4 aS = z4, aU = z4, bm = z4, ar = z4, br = z4;
#pragma unroll
            for (int kk2 = 0; kk2 < 2; ++kk2) {
                const bf16x8 k1i = ldfrag(L + L_K1, SK, i0 * 16, kk2 * 32, lane), k1j = ldfrag(L + L_K1, SK, j0 * 16, kk2 * 32, lane);
                const bf16x8 b1i = ldfrag(L + L_B1, SK, i0 * 16, kk2 * 32, lane), b1j = ldfrag(L + L_B1, SK, j0 * 16, kk2 * 32, lane);
                const bf16x8 m1i = ldfrag(L + L_M1, SK, i0 * 16, kk2 * 32, lane), r1j = ldfrag(L + L_R1, SK, j0 * 16, kk2 * 32, lane);
                aS = mfma16(b1i, k1j, aS);
                aU = mfma16(k1i, b1j, aU);
                bm = mfma16(m1i, k1j, bm);
                ar = mfma16(b1i, r1j, ar);
                br = mfma16(m1i, r1j, br);
            }
#ifdef RWC_WAIT
            __builtin_amdgcn_sched_barrier(0); __builtin_amdgcn_s_sleep(2); __builtin_amdgcn_sched_barrier(0);
#endif
            {
                const int t = j0 * 16 + c16, s0 = i0 * 16 + q4 * 4;
                f32x4 x, pa, o1, o2, o3;
#pragma unroll
                for (int r = 0; r < 4; ++r) {
                    const bool lt = s0 + r < t, le = s0 + r <= t;
                    x[r] = lt ? -aS[r] : 0.f; pa[r] = x[r] + ((s0 + r == t) ? 1.f : 0.f);
                    o1[r] = lt ? bm[r] : 0.f; o2[r] = le ? ar[r] : 0.f; o3[r] = le ? br[r] : 0.f;
                }
#ifdef RWC_GSTORE
                { bf16_t* gd = wsb(p, OFF_RWY) + (size_t)2 * TT * 256 + (size_t)(bidx() * 256 + tid) * 32;
                  st4(gd, x); st4(gd + 4, pa); st4(gd + 8, o1); st4(gd + 12, o2); st4(gd + 16, o3); }
#else
                st4(L + L_X + t * ST + s0, x); st4(L + L_PA + t * ST + s0, pa);
                st4(L + L_BM + t * ST + s0, o1); st4(L + L_AR + t * ST + s0, o2); st4(L + L_BR + t * ST + s0, o3);
#endif
            }
            {
                const int s = j0 * 16 + c16, t0 = i0 * 16 + q4 * 4;
                f32x4 o;
#pragma unroll
                for (int r = 0; r < 4; ++r) o[r] = (s < t0 + r) ? -aU[r] : 0.f;
#ifdef RWC_GSTORE
                st4(wsb(p, OFF_RWY) + (size_t)2 * TT * 256 + (size_t)(bidx() * 256 + tid) * 32 + 20, o);
#else
                st4(L + L_XT + s * ST + t0, o);
#endif
            }
            __syncthreads();
        }
        if (RWC_STOP <= 2) continue;
#pragma unroll 1
        for (int rd = 1; rd <= 5; ++rd) {
            const bool sq = rd <= 4, up = rd >= 2;
            const int i0 = wave >> 1, j0 = wave & 1;
            const bf16x8 xti = ldfrag(L + L_XT, ST, i0 * 16, 0, lane), xtj = ldfrag(L + L_XT, ST, j0 * 16, 0, lane);
            const bf16x8 xi = ldfrag(L + L_X, ST, i0 * 16, 0, lane), xj = ldfrag(L + L_X, ST, j0 * 16, 0, lane);
            const bf16x8 paj = ldfrag(L + L_PA, ST, j0 * 16, 0, lane);
            const u32x2 old = *(const u32x2*)(L + L_PA + (j0 * 16 + c16) * ST + i0 * 16 + q4 * 4);
            __syncthreads();
            const f32x4 z4 = (f32x4){0.f, 0.f, 0.f, 0.f};
            if (sq) {
                const f32x4 nx = mfma16(xti, xj, z4);
                const f32x4 nxt = mfma16(xi, xtj, z4);
                st4(L + L_X + (j0 * 16 + c16) * ST + i0 * 16 + q4 * 4, nx);
                st4(L + L_XT + (j0 * 16 + c16) * ST + i0 * 16 + q4 * 4, nxt);
            }
            if (up) {
                f32x4 acc = (f32x4){bflo(old.x), bfhi(old.x), bflo(old.y), bfhi(old.y)};
                acc = mfma16(xti, paj, acc);
                st4(L + L_PA + (j0 * 16 + c16) * ST + i0 * 16 + q4 * 4, acc);
            }
            __syncthreads();
        }
        if (RWC_STOP <= 3) continue;
        {
            const int vj = wave;
#pragma unroll
            for (int ti = 0; ti < 2; ++ti) {
                f32x4 acc = mfma16(ldfrag(L + L_BM, ST, ti * 16, 0, lane), ldfrag(L + L_VT, ST, vj * 16, 0, lane), (f32x4){0.f, 0.f, 0.f, 0.f});
#pragma unroll
                for (int kk2 = 0; kk2 < 2; ++kk2) acc = mfma16(ldfrag(L + L_K1, SK, ti * 16, kk2 * 32, lane), ldfrag(L + L_S, SK, vj * 16, kk2 * 32, lane), acc);
                st4(L + L_ET + (vj * 16 + c16) * ST + ti * 16 + q4 * 4, acc);
            }
            __syncthreads();
#pragma unroll
            for (int ti = 0; ti < 2; ++ti) {
                const f32x4 acc = mfma16(ldfrag(L + L_PA, ST, ti * 16, 0, lane), ldfrag(L + L_ET, ST, vj * 16, 0, lane), (f32x4){0.f, 0.f, 0.f, 0.f});
                st4(L + L_ZT + (vj * 16 + c16) * ST + ti * 16 + q4 * 4, -acc);
            }
            __syncthreads();
        }
        if (RWC_STOP <= 4) continue;
        {
            const int vi = wave;
#pragma unroll
            for (int tj = 0; tj < 2; ++tj) {
                f32x4 acc = (f32x4){0.f, 0.f, 0.f, 0.f};
#pragma unroll
                for (int kk2 = 0; kk2 < 2; ++kk2) acc = mfma16(ldfrag(L + L_S, SK, vi * 16, kk2 * 32, lane), ldfrag(L + L_R1, SK, tj * 16, kk2 * 32, lane), acc);
                acc = mfma16(ldfrag(L + L_ZT, ST, vi * 16, 0, lane), ldfrag(L + L_AR, ST, tj * 16, 0, lane), acc);
                acc = mfma16(ldfrag(L + L_VT, ST, vi * 16, 0, lane), ldfrag(L + L_BR, ST, tj * 16, 0, lane), acc);
                int n, len; const int t = tok_of(c, tj * 16 + c16, n, len);
                u32x2 o; o.x = pack2(acc[0], acc[1]); o.y = pack2(acc[2], acc[3]);
#ifndef RWC_NOYSTORE
                *(u32x2*)(RWY + (size_t)t * 256 + head * 64 + vi * 16 + q4 * 4) = o;
#else
                asm volatile("" :: "v"(o), "v"(t));
#endif
            }
            const float4 pc = *(const float4*)(PC + wave * 16 + q4 * 4);
            const bf16x8 fb2 = ldfrag(L + L_B2T, ST, wave * 16, 0, lane), fm2 = ldfrag(L + L_M2T, ST, wave * 16, 0, lane);
#pragma unroll
            for (int vj = 0; vj < 4; ++vj) {
                f32x4 acc = Wt[vj];
                acc[0] *= pc.x; acc[1] *= pc.y; acc[2] *= pc.z; acc[3] *= pc.w;
                acc = mfma16(fb2, ldfrag(L + L_ZT, ST, vj * 16, 0, lane), acc);
                acc = mfma16(fm2, ldfrag(L + L_VT, ST, vj * 16, 0, lane), acc);
                Wt[vj] = acc;
            }
            __syncthreads();
#pragma unroll
            for (int vj = 0; vj < 4; ++vj) st4(L + L_S + (vj * 16 + c16) * SK + wave * 16 + q4 * 4, Wt[vj]);
        }
    }
    __syncthreads();
#ifdef RWC_ZERO_LDS
    for (int i = tid; i < 73728 / 4; i += NT) ((unsigned*)smem)[i] = 0u;
    __syncthreads();
#endif
}
DEV void phase_s5_glu(const Params& p, int l, int M, char* smem) {
    const bf16_t* P = wsb(p, OFF_P);
    const bf16_t* w = wsb(p, OFF_WSM) + (size_t)l * WS_PER_LAYER + WS_GLUT;
    bf16_t* Y = wsb(p, OFF_Y);
    const float* bg = p.in[I_S5BGLU] + l * 256;
    gemm_generic(P + C_S5, LDP, M, w, 256, 256, 256,
                 [&](int r, int c, float v) { const float z = bf2f(P[(size_t)r * LDP + C_S5 + c]); Y[(size_t)r * 1024 + 256 + c] = f2bf(z * sigmoidf_(v + bg[c])); }, smem, 0);
}
DEV void phase_rw_finish(const Params& p, int l, int M) {
    const int lane = tidx() & 63, wave = tidx() >> 6;
    const bf16_t* P = wsb(p, OFF_P);
    const bf16_t* RWX = wsb(p, OFF_RWX);
    const bf16_t* RWY = wsb(p, OFF_RWY);
    bf16_t* Y = wsb(p, OFF_Y);
    const int c = lane * 4;
    const float4 mur = *(const float4*)(p.in[I_RMU] + (l * 4 + 0) * 256 + c);
    const float4 muk = *(const float4*)(p.in[I_RMU] + (l * 4 + 1) * 256 + c);
    const float4 muv = *(const float4*)(p.in[I_RMU] + (l * 4 + 2) * 256 + c);
    const float4 ka4 = *(const float4*)(p.in[I_RKA] + l * 256 + c);
    const float4 rk4 = *(const float4*)(p.in[I_RRK] + l * 256 + c);
    const float4 lg4 = *(const float4*)(p.in[I_RLNG] + l * 256 + c);
    const float4 lb4 = *(const float4*)(p.in[I_RLNB] + l * 256 + c);
    const float mr_[4] = { mur.x, mur.y, mur.z, mur.w }, mk_[4] = { muk.x, muk.y, muk.z, muk.w }, mv_[4] = { muv.x, muv.y, muv.z, muv.w };
    const float ka_[4] = { ka4.x, ka4.y, ka4.z, ka4.w }, rk_[4] = { rk4.x, rk4.y, rk4.z, rk4.w }, lg_[4] = { lg4.x, lg4.y, lg4.z, lg4.w }, lb_[4] = { lb4.x, lb4.y, lb4.z, lb4.w };
    for (int t = bidx() * 4 + wave; t < M; t += gridDim.x * 4) {
        int base, n, len; tok_seq(t, base, n, len);
        const bf16_t* row = P + (size_t)t * LDP;
        const bool hp = n > 0, hn = n + 1 < len;
        const u32x2 z = (u32x2){0u, 0u};
        float r4[4], k4[4], v4[4];
        {
            const u32x2 cu = *(const u32x2*)(row + C_RWR + c), pv = hp ? *(const u32x2*)(row - LDP + C_RWR + c) : z, nx = hn ? *(const u32x2*)(row + LDP + C_RWR + c) : z;
            const float x[4] = { bflo(cu.x), bfhi(cu.x), bflo(cu.y), bfhi(cu.y) }, a[4] = { bflo(pv.x), bfhi(pv.x), bflo(pv.y), bfhi(pv.y) }, b[4] = { bflo(nx.x), bfhi(nx.x), bflo(nx.y), bfhi(nx.y) };
#pragma unroll
            for (int j = 0; j < 4; ++j) r4[j] = x[j] + (0.5f * (a[j] + b[j]) - x[j]) * mr_[j];
        }
        {
            const u32x2 cu = *(const u32x2*)(row + C_RWK + c), pv = hp ? *(const u32x2*)(row - LDP + C_RWK + c) : z, nx = hn ? *(const u32x2*)(row + LDP + C_RWK + c) : z;
            const float x[4] = { bflo(cu.x), bfhi(cu.x), bflo(cu.y), bfhi(cu.y) }, a[4] = { bflo(pv.x), bfhi(pv.x), bflo(pv.y), bfhi(pv.y) }, b[4] = { bflo(nx.x), bfhi(nx.x), bflo(nx.y), bfhi(nx.y) };
#pragma unroll
            for (int j = 0; j < 4; ++j) k4[j] = x[j] + (0.5f * (a[j] + b[j]) - x[j]) * mk_[j];
        }
        {
            const u32x2 cu = *(const u32x2*)(row + C_RWV + c), pv = hp ? *(const u32x2*)(row - LDP + C_RWV + c) : z, nx = hn ? *(const u32x2*)(row + LDP + C_RWV + c) : z;
            const float x[4] = { bflo(cu.x), bfhi(cu.x), bflo(cu.y), bfhi(cu.y) }, a[4] = { bflo(pv.x), bfhi(pv.x), bflo(pv.y), bfhi(pv.y) }, b[4] = { bflo(nx.x), bfhi(nx.x), bflo(nx.y), bfhi(nx.y) };
#pragma unroll
            for (int j = 0; j < 4; ++j) v4[j] = x[j] + (0.5f * (a[j] + b[j]) - x[j]) * mv_[j];
        }
        const u32x2 af = *(const u32x2*)(RWX + (size_t)t * 1024 + 512 + c), ab = *(const u32x2*)(RWX + (size_t)t * 1024 + 768 + c);
        const float a0[4] = { bflo(af.x), bfhi(af.x), bflo(af.y), bfhi(af.y) }, a1[4] = { bflo(ab.x), bfhi(ab.x), bflo(ab.y), bfhi(ab.y) };
        const u32x2 yf = *(const u32x2*)(RWY + (size_t)t * 256 + c), yb = *(const u32x2*)(RWY + (size_t)TT * 256 + (size_t)t * 256 + c);
        float y[4] = { bflo(yf.x) + bflo(yb.x), bfhi(yf.x) + bfhi(yb.x), bflo(yf.y) + bflo(yb.y), bfhi(yf.y) + bfhi(yb.y) };
        float s = y[0] + y[1] + y[2] + y[3];
        s = group_sum<16>(s);
        const float mean = s * (1.f / 64.f);
        float q = 0.f, bon = 0.f;
#pragma unroll
        for (int j = 0; j < 4; ++j) {
            const float dlt = y[j] - mean; q += dlt * dlt;
            const float kmsum = k4[j] * (2.f + (a0[j] + a1[j] - 2.f) * ka_[j]);
            bon += r4[j] * kmsum * rk_[j];
        }
        q = group_sum<16>(q); bon = group_sum<16>(bon);
        const float rstd = rsqrtf(q * (1.f / 64.f) + 64e-5f);
        const u32x2 gg = *(const u32x2*)(row + C_RWD + c);
        const float g[4] = { bflo(gg.x), bfhi(gg.x), bflo(gg.y), bfhi(gg.y) };
        float o[4];
#pragma unroll
        for (int j = 0; j < 4; ++j) o[j] = ((y[j] - mean) * rstd * lg_[j] + lb_[j] + bon * v4[j]) * g[j];
        u32x2 ov; ov.x = pack2(o[0], o[1]); ov.y = pack2(o[2], o[3]);
        *(u32x2*)(Y + (size_t)t * 1024 + 768 + c) = ov;
    }
}

DEV int queue_next(int* ctr, char* smem) {
    int* slot = (int*)(smem + MOE_MAP_OFF + 208);
    __syncthreads();
    if (tidx() == 0) *slot = atomicAdd(ctr, 1);
    __syncthreads();
    return __builtin_amdgcn_readfirstlane(*slot);
}
DEV void phase_mixers(const Params& p, int l, int rep, char* smem) {
    const bool need_ctx = (l == 0);
#ifndef RWMODE
#define RWMODE 2
#endif
    const int nrw = RWMODE == 0 ? 64 : (RWMODE == 1 ? 256 + 64 : 256), nda = need_ctx ? 576 : 512, ns5 = 32 * (need_ctx ? 9 : 8);
    const int total = nrw + 2 * nda + (rep == 0 ? ns5 : 0);
    int* ctr = (int*)(p.ws + OFF_CTR) + CTR_Q + l * 16 + rep * 4;
    for (;;) {
        const int item = queue_next(ctr, smem);
        if (item >= total) break;
#ifndef PROBE7
#define PROBE7 0
#endif
        if (rep > 0 && PROBE7 == 1 && item >= nrw) break;
        if (rep > 0 && PROBE7 == 2 && item < nrw) continue;
        if (rep > 0 && PROBE7 == 3 && (item < nrw || item >= nrw + nda)) continue;
#if RWMODE == 2
        if (item < nrw) rw_item(p, l, item, smem, 0);
#elif RWMODE == 0
        if (item < nrw) rwc_item(p, l, item, smem);
#else
        if (item < nrw) { if (item < 256) rw_item(p, l, item, smem, 0); else rwc_item(p, l, item - 256, smem); }
#endif
        else if (item < nrw + nda) da_item(p, l, item - nrw, smem);
        else if (item < nrw + 2 * nda) mla_item(p, l, item - nrw - nda, smem);
        else s5_pass2_item(p, l, need_ctx ? 0 : 1, item - nrw - 2 * nda, smem);
    }
}
#ifndef MEGA
#define MEGA 0
#endif
constexpr int NPHASE = 15;
template <int PH>
DEV void run_phase(const Params& p, int l, char* smem) {
    const bool need_ctx = (l == 0);
    const int M = need_ctx ? TT : TL;
    if constexpr (PH == 0) { phase_mod_partial(p, smem); __syncthreads(); phase_conv_small(p, smem); phase_conv_layer(p, 0, smem); phase_conv_experts(p, 0, smem); }
    if constexpr (PH == 1) { phase_mod_reduce(p); }
    if constexpr (PH == 2) { phase_norm<1>(p, l, TT, smem); if (l == 1) { phase_conv_layer(p, 1, smem); phase_conv_experts(p, 1, smem); } }
    if constexpr (PH == 3) { phase_inproj(p, l, smem); }
    if constexpr (PH == 4) { phase_prep1(p, l); phase_s5_pass1(p, l, smem); }
    if constexpr (PH == 5) { phase_prep_gemm1(p, l, smem); }
    if constexpr (PH == 6) { phase_prep_gemm2(p, l, smem); phase_prep2(p, l); }
    if constexpr (PH == 7) { phase_mixers(p, l, 0, smem); }
    if constexpr (PH == 8) { phase_s5_glu(p, l, M, smem); phase_rw_finish(p, l, M); }
    if constexpr (PH == 9) { phase_merge(p, l, M, smem); }
    if constexpr (PH == 10) { phase_outproj(p, l, M, smem); }
    if constexpr (PH == 11) { phase_norm<2>(p, l, M, smem); }
    if constexpr (PH == 14) { phase_route(p, l, M, smem); }
    if constexpr (PH == 15) { phase_combine(p, l, M); }
    if constexpr (PH == 12) { phase_moe1(p, l, smem); }
    if constexpr (PH == 13) { phase_moe2(p, l, smem); }
}

#if !MEGA
template <int PH>
__global__ void __launch_bounds__(NT, 2) k_phase(Params p, int l) {
    extern __shared__ __attribute__((aligned(16))) char smem[];
    run_phase<PH>(p, l, smem);
}
#endif
#ifndef REP0
#define REP0 1
#endif
#ifndef REP2
#define REP2 1
#endif
#ifndef REP3
#define REP3 1
#endif
#ifndef REP5
#define REP5 1
#endif
#ifndef REP6
#define REP6 1
#endif
#ifndef REP7
#define REP7 1
#endif
#ifndef REP8
#define REP8 1
#endif
#ifndef REP9
#define REP9 1
#endif
#ifndef REP12
#define REP12 1
#endif
#if MEGA
__global__ void __launch_bounds__(NT, 2) k_mega(Params p) {
    extern __shared__ __attribute__((aligned(16))) char smem[];
    uint4* xbw = (uint4*)(smem + MOE_MAP_OFF + 240);
    if (threadIdx.x == 0) *xbw = make_uint4(0u, 0u, 0u, 0u);
    __syncthreads();
    XcdBarrier bar = xcd_barrier_post((unsigned*)(p.ws + OFF_BAR), (volatile LAS unsigned*)xbw);
    for (int r = 0; r < REP0; ++r) { run_phase<0>(p, 0, smem); xcd_barrier(bar); }
    run_phase<1>(p, 0, smem); xcd_barrier(bar);
    for (int l = 0; l < 2; ++l) {
        for (int r = 0; r < REP2; ++r) { run_phase<2>(p, l, smem); xcd_barrier(bar); }
        for (int r = 0; r < REP3; ++r) { run_phase<3>(p, l, smem); xcd_barrier(bar); }

        run_phase<4>(p, l, smem); xcd_barrier(bar);
#ifdef PROBE_S5P1
        phase_s5_pass1(p, l, smem); xcd_barrier(bar);
#endif
#ifdef PROBE_BAR
        for (int r = 0; r < PROBE_BAR; ++r) xcd_barrier(bar);
#endif
        for (int r = 0; r < REP5; ++r) { run_phase<5>(p, l, smem); xcd_barrier(bar); }
        for (int r = 0; r < REP6; ++r) { run_phase<6>(p, l, smem); xcd_barrier(bar); }
#ifdef RWC_PRE
        if (bidx() < 64) rwc_item(p, l, bidx(), smem);
#endif
        for (int r = 0; r < REP7; ++r) { phase_mixers(p, l, r, smem); xcd_barrier(bar); }
#ifdef RWC_SEP
        for (int item = bidx(); item < 64; item += gridDim.x) rwc_item(p, l, item, smem);
        xcd_barrier(bar);
#endif
        for (int r = 0; r < REP8; ++r) { run_phase<8>(p, l, smem); xcd_barrier(bar); }
        for (int r = 0; r < REP9; ++r) { run_phase<9>(p, l, smem); xcd_barrier(bar); }
        run_phase<10>(p, l, smem); xcd_barrier(bar);

        run_phase<11>(p, l, smem); xcd_barrier(bar);
        run_phase<14>(p, l, smem); xcd_barrier(bar);
        for (int r = 0; r < REP12; ++r) { run_phase<12>(p, l, smem); xcd_barrier(bar); }
        run_phase<13>(p, l, smem); xcd_barrier(bar);
        run_phase<15>(p, l, smem); if (l == 0) xcd_barrier(bar);
    }
}
#endif
__global__ void __launch_bounds__(NT) k_fail(float* out, int n) {
    for (int i = blockIdx.x * NT + threadIdx.x; i < n; i += gridDim.x * NT) out[i] = __int_as_float(0x7fc00000);
}

template <int PH>
static void launch_phase(const Params& p, int l, int grid, hipStream_t stream) {
#if !MEGA
    static bool attr = false;
    if (!attr) { (void)hipFuncSetAttribute((const void*)k_phase<PH>, hipFuncAttributeMaxDynamicSharedMemorySize, SMEM_BYTES); attr = true; }
    hipLaunchKernelGGL(k_phase<PH>, dim3(grid), dim3(NT), SMEM_BYTES, stream, p, l);
#endif
}

extern "C" void kernel_launch(void* const* d_in, const int* in_sizes, int n_in, void* d_out, int out_size, void* d_ws, size_t ws_size, hipStream_t stream) {
    if (n_in != 48 || out_size != TL * DM || ws_size < WS_END) {
        hipLaunchKernelGGL(k_fail, dim3(256), dim3(NT), 0, stream, (float*)d_out, out_size);
        return;
    }
    Params p{};
    for (int i = 0; i < 48; ++i) p.in[i] = (const float*)d_in[i];
    p.out = (float*)d_out; p.ws = (char*)d_ws;
    (void)hipMemsetAsync(d_ws, 0, ZERO_BYTES, stream);
#if MEGA
    static int grid = 0;
    if (grid == 0) {
        int dev = 0, cus = 0, per_cu = 0;
        (void)hipGetDevice(&dev);
        (void)hipDeviceGetAttribute(&cus, hipDeviceAttributeMultiprocessorCount, dev);
        (void)hipFuncSetAttribute((const void*)k_mega, hipFuncAttributeMaxDynamicSharedMemorySize, SMEM_BYTES);
        if (hipOccupancyMaxActiveBlocksPerMultiprocessor(&per_cu, (const void*)k_mega, NT, SMEM_BYTES) != hipSuccess || per_cu < 1) per_cu = 1;
        (void)hipGetLastError();
        if (cus <= 0) cus = 256;
        grid = cus * (per_cu < 2 ? per_cu : 2);
    }
    hipLaunchKernelGGL(k_mega, dim3(grid), dim3(NT), SMEM_BYTES, stream, p);
#else
    const int grid = 512;
    launch_phase<0>(p, 0, grid, stream);
    launch_phase<1>(p, 0, grid, stream);
    for (int l = 0; l < 2; ++l) {
        launch_phase<2>(p, l, grid, stream);
        launch_phase<3>(p, l, grid, stream);
        launch_phase<4>(p, l, grid, stream);
        launch_phase<5>(p, l, grid, stream);
        launch_phase<6>(p, l, grid, stream);
        launch_phase<7>(p, l, grid, stream);
        launch_phase<8>(p, l, grid, stream);
        launch_phase<9>(p, l, grid, stream);
        launch_phase<10>(p, l, grid, stream);
        launch_phase<11>(p, l, grid, stream);
        launch_phase<14>(p, l, grid, stream);
        launch_phase<12>(p, l, grid, stream);
        launch_phase<13>(p, l, grid, stream);
        launch_phase<15>(p, l, grid, stream);
    }
#endif
}
```

```cpp
#define MEGA 1
#include <hip/hip_runtime.h>
#include <stdint.h>
#include <math.h>

#define DEV __device__ __forceinline__
#define LAS __attribute__((address_space(3)))
typedef unsigned short bf16_t;
typedef short bf16x8 __attribute__((ext_vector_type(8)));
typedef float f32x16 __attribute__((ext_vector_type(16)));
typedef float f32x4 __attribute__((ext_vector_type(4)));
typedef unsigned u32x4 __attribute__((ext_vector_type(4)));
typedef unsigned u32x2 __attribute__((ext_vector_type(2)));

constexpr int NT = 256;
constexpr int DM = 1024, NB = 8, SEQ = 2048, CTXL = 256, GRIDW = 64;
constexpr int TL = NB * SEQ, TC = NB * CTXL, TT = TL + TC;
constexpr int NIN = 6480, LDP = 2432, NINP = 6528, NGATE0 = 2432;
constexpr int C_DAQ = 0, C_DAK = 256, C_DAV = 512, C_S5 = 768, C_CQ = 1024, C_CKV = 1216, C_KR = 1344,
              C_RWR = 1360, C_RWK = 1616, C_RWV = 1872, C_RWD = 2128, C_PEND = 2384;
constexpr int NEXP = 16, DFF = 512;
constexpr float EPS = 1e-6f;
constexpr float LOG2E = 1.4426950408889634f;

constexpr size_t al256(size_t x) { return (x + 255) & ~(size_t)255; }
constexpr size_t OFF_BAR  = 0;
constexpr size_t OFF_CTR  = 16384;
constexpr size_t ZERO_BYTES = 20480;
constexpr size_t OFF_MOD  = 32768;
constexpr size_t SZ_MOD   = (size_t)2 * 9 * 6144 * 4;
constexpr int    MOD_KS   = 8;
constexpr size_t OFF_MODP = al256(OFF_MOD + SZ_MOD);
constexpr size_t OFF_S5ST = al256(OFF_MODP + MOD_KS * SZ_MOD);
constexpr size_t OFF_LTOK = al256(OFF_S5ST + (size_t)2 * 8 * 16 * 8 * 64 * 2 * 4);
constexpr size_t OFF_LW   = al256(OFF_LTOK + (size_t)NEXP * TT * 4);
constexpr size_t OFF_TOKI = al256(OFF_LW + (size_t)NEXP * TT * 4);
constexpr size_t OFF_TOKW = al256(OFF_TOKI + (size_t)TT * 16);
constexpr size_t OFF_CNTB = al256(OFF_TOKW + (size_t)TT * 8);
constexpr size_t OFF_WSM  = al256(OFF_CNTB + (size_t)1024 * 16 * 4);
constexpr int WS_GLUT = 0, WS_UQT = WS_GLUT + 256 * 256, WS_UKVT = WS_UQT + 192 * 192, WS_W1C = WS_UKVT + 384 * 128,
              WS_W2 = WS_W1C + 192 * 256, WS_G2T = WS_W2 + 4 * 256 * 64, WS_PER_LAYER = WS_G2T + 256 * 64;
constexpr size_t OFF_WIN  = al256(OFF_WSM + (size_t)2 * WS_PER_LAYER * 2);
constexpr size_t OFF_WBR  = al256(OFF_WIN + (size_t)NINP * 1024 * 2);
constexpr size_t OFF_WOUT = al256(OFF_WBR + (size_t)4 * 1024 * 256 * 2);
constexpr size_t OFF_WG1  = al256(OFF_WOUT + (size_t)1024 * 1024 * 2);
constexpr size_t OFF_WDN  = al256(OFF_WG1 + (size_t)NEXP * 1024 * 1024 * 2);
constexpr size_t OFF_H    = al256(OFF_WDN + (size_t)NEXP * 1024 * 512 * 2);
constexpr size_t OFF_P    = al256(OFF_H + (size_t)TT * 1024 * 2);
constexpr size_t OFF_GATE = al256(OFF_P + (size_t)TT * LDP * 2);
constexpr size_t OFF_MLAQ = al256(OFF_GATE + (size_t)TT * 4096);
constexpr size_t OFF_MLAK = al256(OFF_MLAQ + (size_t)TT * 192 * 2);
constexpr size_t OFF_MLAV = al256(OFF_MLAK + (size_t)TT * 192 * 2);
constexpr size_t OFF_RWX  = al256(OFF_MLAV + (size_t)TT * 256 * 2);
constexpr size_t OFF_Y    = al256(OFF_RWX + (size_t)TT * 1024 * 2);
constexpr size_t OFF_CX   = al256(OFF_Y + (size_t)TT * 1024 * 2);
constexpr size_t WS_END   = al256(OFF_CX + (size_t)TC * 1024 * 4);
constexpr size_t OFF_QRAW = OFF_Y;
constexpr size_t OFF_KVRAW = OFF_QRAW + (size_t)TT * 192 * 2;
constexpr size_t OFF_LR   = OFF_KVRAW + (size_t)TT * 384 * 2;
constexpr size_t OFF_XL   = OFF_LR + (size_t)TT * 192 * 2;
constexpr size_t OFF_Z    = OFF_GATE;
static_assert(OFF_XL + (size_t)TT * 256 * 2 <= OFF_Y + (size_t)TT * 1024 * 2, "temps overflow Y");
constexpr size_t OFF_RWY  = OFF_H;

constexpr int CTR_MOE = 0;
constexpr int CTR_Q   = 64;

constexpr int SMEM_BYTES = 73728 + 256;

struct Params {
    const float* in[48];
    float* out;
    char* ws;
};
enum { I_X = 0, I_C, I_CTX, I_CCTX, I_WADA, I_BADA, I_NMG, I_NFG, I_WIN, I_DAQKG, I_DALAM, I_DASUB,
       I_S5LRE, I_S5LIM, I_S5LDT, I_S5BRE, I_S5BIM, I_S5CRE, I_S5CIM, I_S5D, I_S5WGLU, I_S5BGLU,
       I_MCQG, I_MCKVG, I_MWUQ, I_MWUKV, I_MQKG,
       I_RMU, I_RW0, I_RW1, I_RW2, I_RA0, I_RA1, I_RA2, I_RG1, I_RG2, I_RKK, I_RKA, I_RRK, I_RLNG, I_RLNB,
       I_WBR, I_WOUT, I_ROUTW, I_ROUTB, I_EWG, I_EWU, I_EWD };

DEV int tidx() { int t = threadIdx.x; asm volatile("" : "+v"(t)); return t; }
DEV int bidx() { int b = blockIdx.x; asm volatile("" : "+s"(b)); return b; }
typedef float f32x2_ __attribute__((ext_vector_type(2)));
typedef __bf16 bf16x2_ __attribute__((ext_vector_type(2)));
DEV unsigned cvt_pk_bf16(float lo, float hi) { const f32x2_ v = {lo, hi}; const bf16x2_ b = __builtin_convertvector(v, bf16x2_); return __builtin_bit_cast(unsigned, b); }
DEV bf16_t f2bf(float f) { return (bf16_t)(cvt_pk_bf16(f, 0.f) & 0xFFFFu); }
DEV float bf2f(bf16_t h) { return __uint_as_float(((unsigned)h) << 16); }
DEV unsigned pack2(float lo, float hi) { return cvt_pk_bf16(lo, hi); }
DEV float bflo(unsigned u) { return __uint_as_float(u << 16); }
DEV float bfhi(unsigned u) { return __uint_as_float(u & 0xFFFF0000u); }
DEV float sigmoidf_(float x) { return 1.f / (1.f + __expf(-x)); }
DEV float wave_sum(float v) {
#pragma unroll
    for (int o = 32; o >= 1; o >>= 1) v += __shfl_xor(v, o, 64);
    return v;
}
template <int W> DEV float group_sum(float v) {
#pragma unroll
    for (int o = W / 2; o >= 1; o >>= 1) v += __shfl_xor(v, o, 64);
    return v;
}
DEV int mod_row(int t) { return t < TL ? (t >> 11) : 8; }
DEV bf16_t* wsb(const Params& p, size_t off) { return (bf16_t*)(p.ws + off); }
DEV float* wsf(const Params& p, size_t off) { return (float*)(p.ws + off); }
DEV const float* modp(const Params& p, int l, int row, int which) { return (const float*)(p.ws + OFF_MOD) + ((size_t)(l * 9 + row) * 6 + which) * 1024; }
#define XB_TMO      128
#define XB_XCNT(j)  (256  + 64 * (j))
#define XB_XSUB(j)  (1280 + 64 * (j))
#define XB_XGEN(j)  (2304 + 64 * (j))
#define XB_TOP      3328
#define XB_TOPGEN   3392
#define XCD_BAR_WORDS 3456
#define XB_SPIN_CAP (1u << 18)

__device__ __forceinline__ unsigned xb_ld(unsigned* p)              { return __hip_atomic_load(p, __ATOMIC_RELAXED, __HIP_MEMORY_SCOPE_AGENT); }
__device__ __forceinline__ unsigned xb_add(unsigned* p, unsigned v) { return __hip_atomic_fetch_add(p, v, __ATOMIC_RELAXED, __HIP_MEMORY_SCOPE_AGENT); }
__device__ __forceinline__ unsigned xb_xcc_id() { return (unsigned)__builtin_amdgcn_s_getreg((3 << 11) | 20) & 0xFu; }
#define XB_SPIN(cond, bar) do { unsigned _sp = 0; while (cond) { __builtin_amdgcn_s_sleep(1); \
    if ((++_sp & 255u) == 0u) { if (xb_ld(&(bar)[XB_TMO])) break; if (_sp > XB_SPIN_CAP) { atomicAdd(&(bar)[XB_TMO], 1u); break; } } } } while (0)

struct XcdBarrier {
    unsigned* bar; unsigned x;
    volatile LAS unsigned* st;
};

__device__ __forceinline__ XcdBarrier xcd_barrier_post(unsigned* bar, volatile LAS unsigned* st) {
    XcdBarrier b; b.bar = bar; b.x = xb_xcc_id(); b.st = st;
    if (threadIdx.x == 0) (void)xb_add(&bar[XB_XCNT(b.x)], 1u);
    return b;
}
__device__ __forceinline__ void xcd_barrier_complete(unsigned* bar, unsigned x, unsigned& nloc, unsigned& nx) {
    const unsigned G = gridDim.x * gridDim.y * gridDim.z;
    unsigned sum, cnt, mine, sp = 0u;
    for (;;) {
        sum = 0u; cnt = 0u; mine = 0u;
#pragma unroll
        for (unsigned j = 0; j < 16; ++j) { const unsigned c = xb_ld(&bar[XB_XCNT(j)]); sum += c; cnt += (c > 0u) ? 1u : 0u; mine = (j == x) ? c : mine; }
        if (sum == G) break;
        __builtin_amdgcn_s_sleep(1);
        if ((++sp & 255u) == 0u) { if (xb_ld(&bar[XB_TMO])) break; if (sp > XB_SPIN_CAP) { atomicAdd(&bar[XB_TMO], 1u); break; } }
    }
    nloc = mine > 0u ? mine : 1u; nx = cnt > 0u ? cnt : 1u;
}

__device__ __forceinline__ void xcd_barrier(const XcdBarrier& b) {
    asm volatile("s_waitcnt vmcnt(0)" ::: "memory");
    __syncthreads();
    if (threadIdx.x == 0) {
        unsigned* bar = b.bar;
        __builtin_amdgcn_s_waitcnt(0);
        unsigned nloc = b.st[0], nx = b.st[1];
        if (nloc == 0u) { xcd_barrier_complete(bar, b.x, nloc, nx); b.st[0] = nloc; b.st[1] = nx; }
        const unsigned old = xb_add(&bar[XB_XSUB(b.x)], 1u);
        const unsigned gen = old / nloc;
        if (old + 1u == (gen + 1u) * nloc) {
            __builtin_amdgcn_fence(__ATOMIC_RELEASE, "agent");
            asm volatile("s_waitcnt vmcnt(0)" ::: "memory");
            const unsigned og = xb_add(&bar[XB_TOP], 1u);
            const unsigned tg = og / nx;
            if (og + 1u == (tg + 1u) * nx) xb_add(&bar[XB_TOPGEN], 1u);
            else XB_SPIN(xb_ld(&bar[XB_TOPGEN]) == tg, bar);
            __builtin_amdgcn_fence(__ATOMIC_ACQUIRE, "agent");
            xb_add(&bar[XB_XGEN(b.x)], 1u);
            asm volatile("s_waitcnt vmcnt(0)" ::: "memory");
        } else {
            XB_SPIN(xb_ld(&bar[XB_XGEN(b.x)]) == gen, bar);
            __builtin_amdgcn_fence(__ATOMIC_ACQUIRE, "agent");
            asm volatile("s_waitcnt vmcnt(0)" ::: "memory");
        }
    }
    __syncthreads();
}

DEV void phase_mod_partial(const Params& p, char* smem) {
    float* sm = (float*)smem;
    const int tid = tidx();
    const int nitems = 2 * 24 * MOD_KS;
    for (int item = bidx(); item < nitems; item += gridDim.x) {
        const int l = item / (24 * MOD_KS), rem = item % (24 * MOD_KS), jc = rem / MOD_KS, ks = rem % MOD_KS;
        __syncthreads();
        for (int i = tid; i < 9 * 128; i += NT) {
            const int r = i >> 7, k = ks * 128 + (i & 127);
            const float cv = r < 8 ? p.in[I_C][r * 1024 + k] : p.in[I_CCTX][k];
            sm[i] = cv / (1.f + __expf(-cv));
        }
        __syncthreads();
        const int j = jc * 256 + tid;
        float acc[9];
#pragma unroll
        for (int r = 0; r < 9; ++r) acc[r] = 0.f;
        const float* w = p.in[I_WADA] + (size_t)l * 1024 * 6144 + (size_t)(ks * 128) * 6144 + j;
#pragma unroll 8
        for (int k = 0; k < 128; ++k) {
            const float wv = w[(size_t)k * 6144];
#pragma unroll
            for (int r = 0; r < 9; ++r) acc[r] += sm[r * 128 + k] * wv;
        }
        float* dst = wsf(p, OFF_MODP);
#pragma unroll
        for (int r = 0; r < 9; ++r) dst[((size_t)(ks * 2 + l) * 9 + r) * 6144 + j] = acc[r];
    }
}
DEV void phase_mod_reduce(const Params& p) {
    const int n = 2 * 9 * 6144;
    float* mod = wsf(p, OFF_MOD);
    const float* part = wsf(p, OFF_MODP);
    for (int i = bidx() * NT + tidx(); i < n; i += gridDim.x * NT) {
        const int l = i / (9 * 6144), j = i % 6144;
        float s = p.in[I_BADA][l * 6144 + j];
#pragma unroll
        for (int ks = 0; ks < MOD_KS; ++ks) s += part[(size_t)ks * n + i];
        mod[i] = s;
    }
}

struct ConvRegs { float4 v[4]; };
DEV void conv_load(const float* src, int R, int C, int ld, int tr, int tc, ConvRegs& cr) {
    const int r0 = tr * 64, c0 = tc * 64, tid = tidx();
#pragma unroll
    for (int k = 0; k < 4; ++k) {
        const int i = tid + k * NT, r = i >> 4, c4 = (i & 15) * 4;
        float4 v = make_float4(0.f, 0.f, 0.f, 0.f);
        if (r0 + r < R) {
            const float* s = src + (size_t)(r0 + r) * ld + c0 + c4;
            if (c0 + c4 + 3 < C) v = *(const float4*)s;
            else { if (c0 + c4 < C) v.x = s[0]; if (c0 + c4 + 1 < C) v.y = s[1]; if (c0 + c4 + 2 < C) v.z = s[2]; }
        }
        cr.v[k] = v;
    }
}
template <int MODE>
DEV void conv_store(const ConvRegs& cr, int R, int C, bf16_t* dst, int ldd, int roff, int tr, int tc, float* sm) {
    const int r0 = tr * 64, c0 = tc * 64, tid = tidx();
    __syncthreads();
#pragma unroll
    for (int k = 0; k < 4; ++k) {
        const int i = tid + k * NT, r = i >> 4, c4 = (i & 15) * 4;
        float* d = sm + r * 65 + c4;
        d[0] = cr.v[k].x; d[1] = cr.v[k].y; d[2] = cr.v[k].z; d[3] = cr.v[k].w;
    }
    __syncthreads();
    for (int i = tid; i < 64 * 8; i += NT) {
        const int c = i >> 3, r8 = (i & 7) * 8;
        if (c0 + c < C && r0 + r8 < R) {
            const int cc = c0 + c;
            const int drow = (MODE == 0) ? (cc + roff) : ((cc >> 5) * 64 + (cc & 31) + roff);
            u32x4 o;
            o[0] = pack2(sm[(r8 + 0) * 65 + c], sm[(r8 + 1) * 65 + c]);
            o[1] = pack2(sm[(r8 + 2) * 65 + c], sm[(r8 + 3) * 65 + c]);
            o[2] = pack2(sm[(r8 + 4) * 65 + c], sm[(r8 + 5) * 65 + c]);
            o[3] = pack2(sm[(r8 + 6) * 65 + c], sm[(r8 + 7) * 65 + c]);
            *(u32x4*)(dst + (size_t)drow * ldd + r0 + r8) = o;
        }
    }
}
template <int MODE>
DEV void conv_job(const float* src, int R, int C, int ld, bf16_t* dst, int ldd, int roff, int& rot, float* sm) {
    const int ntr = (R + 63) >> 6, ntc = (C + 63) >> 6, nt = ntr * ntc, G = gridDim.x;
    const int first = (bidx() - (rot % G) + G) % G;
    ConvRegs cur;
    if (first < nt) conv_load(src, R, C, ld, first / ntc, first % ntc, cur);
    for (int t = first; t < nt; t += G) {
        ConvRegs nxt = cur;
        if (t + G < nt) conv_load(src, R, C, ld, (t + G) / ntc, (t + G) % ntc, nxt);
        conv_store<MODE>(cur, R, C, dst, ldd, roff, t / ntc, t % ntc, sm);
        cur = nxt;
    }
    rot += nt;
}
DEV void phase_conv_layer(const Params& p, int l, char* smem) {
    float* sm = (float*)smem;
    int rot = 0;
    const float* win = p.in[I_WIN] + (size_t)l * 1024 * NIN;
    conv_job<0>(win, 1024, C_PEND, NIN, wsb(p, OFF_WIN), 1024, 0, rot, sm);
    conv_job<0>(win + C_PEND, 1024, 4096, NIN, wsb(p, OFF_WIN), 1024, NGATE0, rot, sm);
    {
        uint4* z = (uint4*)(wsb(p, OFF_WIN) + (size_t)C_PEND * 1024);
        const int n = (NGATE0 - C_PEND) * 1024 / 8;
        for (int i = bidx() * NT + tidx(); i < n; i += gridDim.x * NT) z[i] = make_uint4(0u, 0u, 0u, 0u);
    }
    for (int i = 0; i < 4; ++i)
        conv_job<0>(p.in[I_WBR] + (size_t)(l * 4 + i) * 256 * 1024, 256, 1024, 1024, wsb(p, OFF_WBR) + (size_t)i * 1024 * 256, 256, 0, rot, sm);
    conv_job<0>(p.in[I_WOUT] + (size_t)l * 1024 * 1024, 1024, 1024, 1024, wsb(p, OFF_WOUT), 1024, 0, rot, sm);
}
DEV void phase_conv_experts(const Params& p, int l, char* smem) {
    float* sm = (float*)smem;
    int rot = 0;
    for (int e = 0; e < NEXP; ++e) {
        conv_job<1>(p.in[I_EWG] + (size_t)(l * NEXP + e) * 1024 * DFF, 1024, DFF, DFF, wsb(p, OFF_WG1) + (size_t)e * 1024 * 1024, 1024, 0, rot, sm);
        conv_job<1>(p.in[I_EWU] + (size_t)(l * NEXP + e) * 1024 * DFF, 1024, DFF, DFF, wsb(p, OFF_WG1) + (size_t)e * 1024 * 1024, 1024, 32, rot, sm);
        conv_job<0>(p.in[I_EWD] + (size_t)(l * NEXP + e) * DFF * 1024, DFF, 1024, 1024, wsb(p, OFF_WDN) + (size_t)e * 1024 * DFF, DFF, 0, rot, sm);
    }
}
DEV void phase_conv_small(const Params& p, char* smem) {
    float* sm = (float*)smem;
    int rot = 0;
    for (int l = 0; l < 2; ++l) {
        bf16_t* w = wsb(p, OFF_WSM) + (size_t)l * WS_PER_LAYER;
        for (int i = bidx() * NT + tidx(); i < 4 * 256 * 4; i += gridDim.x * NT)
            *(u32x4*)(w + WS_W2 + (size_t)(i >> 2) * 64 + 32 + (i & 3) * 8) = (u32x4){0u, 0u, 0u, 0u};
        conv_job<0>(p.in[I_S5WGLU] + (size_t)l * 256 * 256, 256, 256, 256, w + WS_GLUT, 256, 0, rot, sm);
        conv_job<0>(p.in[I_MWUQ] + (size_t)l * 192 * 192, 192, 192, 192, w + WS_UQT, 192, 0, rot, sm);
        conv_job<0>(p.in[I_MWUKV] + (size_t)l * 128 * 384, 128, 384, 384, w + WS_UKVT, 128, 0, rot, sm);
        for (int d = 0; d < 2; ++d) {
            conv_job<0>(p.in[I_RW1] + (size_t)(l * 2 + d) * 256 * 32, 256, 32, 32, w + WS_W1C, 256, d * 32, rot, sm);
            conv_job<0>(p.in[I_RA1] + (size_t)(l * 2 + d) * 256 * 32, 256, 32, 32, w + WS_W1C, 256, 64 + d * 32, rot, sm);
            conv_job<0>(p.in[I_RW2] + (size_t)(l * 2 + d) * 32 * 256, 32, 256, 256, w + WS_W2 + (size_t)d * 256 * 64, 64, 0, rot, sm);
            conv_job<0>(p.in[I_RA2] + (size_t)(l * 2 + d) * 32 * 256, 32, 256, 256, w + WS_W2 + (size_t)(2 + d) * 256 * 64, 64, 0, rot, sm);
        }
        conv_job<0>(p.in[I_RG1] + (size_t)l * 256 * 64, 256, 64, 64, w + WS_W1C, 256, 128, rot, sm);
        conv_job<0>(p.in[I_RG2] + (size_t)l * 64 * 256, 64, 256, 256, w + WS_G2T, 64, 0, rot, sm);
    }
}

template <int WHICH>
DEV void phase_norm(const Params& p, int l, int nrows, char* smem) {
    const int lane = tidx() & 63, wave = tidx() >> 6;
    const float* xs = (l == 0) ? p.in[I_X] : p.out;
    const float* cs = (l == 0) ? p.in[I_CTX] : wsf(p, OFF_CX);
    const float* g = p.in[WHICH == 1 ? I_NMG : I_NFG] + l * 1024;
    bf16_t* H = wsb(p, OFF_H);
    if (WHICH == 2) { xs = p.out; cs = wsf(p, OFF_CX); }
    const int tpb = (nrows + (int)gridDim.x - 1) / (int)gridDim.x;
    const int rbeg = WHICH == 2 ? bidx() * tpb + wave : bidx() * 4 + wave;
    const int rend = WHICH == 2 ? min(nrows, (bidx() + 1) * tpb) : nrows;
    const int rstep = WHICH == 2 ? 4 : (int)gridDim.x * 4;
    int* sel = (int*)smem;
    for (int row = rbeg; row < rend; row += rstep) {
        const float* src = row < TL ? xs + (size_t)row * 1024 : cs + (size_t)(row - TL) * 1024;
        const int mr = mod_row(row);
        const float* sh = modp(p, l, mr, WHICH == 1 ? 0 : 3);
        const float* sc = modp(p, l, mr, WHICH == 1 ? 1 : 4);
        float4 v[4];
        float ss = 0.f;
#pragma unroll
        for (int i = 0; i < 4; ++i) {
            v[i] = *(const float4*)(src + lane * 4 + i * 256);
            ss += v[i].x * v[i].x + v[i].y * v[i].y + v[i].z * v[i].z + v[i].w * v[i].w;
        }
        ss = wave_sum(ss);
        const float rstd = rsqrtf(ss * (1.f / 1024.f) + EPS);
        float hv[16];
#pragma unroll
        for (int i = 0; i < 4; ++i) {
            const int c = lane * 4 + i * 256;
            const float4 gg = *(const float4*)(g + c), s4 = *(const float4*)(sh + c), c4 = *(const float4*)(sc + c);
            hv[i * 4 + 0] = v[i].x * rstd * gg.x * (1.f + c4.x) + s4.x;
            hv[i * 4 + 1] = v[i].y * rstd * gg.y * (1.f + c4.y) + s4.y;
            hv[i * 4 + 2] = v[i].z * rstd * gg.z * (1.f + c4.z) + s4.z;
            hv[i * 4 + 3] = v[i].w * rstd * gg.w * (1.f + c4.w) + s4.w;
            u32x2 o; o.x = pack2(hv[i * 4 + 0], hv[i * 4 + 1]); o.y = pack2(hv[i * 4 + 2], hv[i * 4 + 3]);
            *(u32x2*)(H + (size_t)row * 1024 + c) = o;
        }
        if (WHICH == 2) {
            float lg[16];
#pragma unroll
            for (int e = 0; e < 16; ++e) lg[e] = 0.f;
            const float* rw = p.in[I_ROUTW];
#pragma unroll
            for (int i = 0; i < 4; ++i)
#pragma unroll
                for (int j = 0; j < 4; ++j) {
                    const int c = lane * 4 + i * 256 + j;
                    const float hvv = hv[i * 4 + j];
#pragma unroll
                    for (int q = 0; q < 4; ++q) {
                        const float4 w4 = *(const float4*)(rw + (size_t)c * 16 + q * 4);
                        lg[q * 4 + 0] += hvv * w4.x; lg[q * 4 + 1] += hvv * w4.y; lg[q * 4 + 2] += hvv * w4.z; lg[q * 4 + 3] += hvv * w4.w;
                    }
                }
#pragma unroll
            for (int e = 0; e < 16; ++e) lg[e] = wave_sum(lg[e]);
            float sc16[16], bs[16];
#pragma unroll
            for (int e = 0; e < 16; ++e) { sc16[e] = sigmoidf_(lg[e]); bs[e] = sc16[e] + p.in[I_ROUTB][e]; }
            int bestg = 0; float bestv = -INFINITY;
#pragma unroll
            for (int gi = 0; gi < 4; ++gi) {
                float m1 = -INFINITY, m2 = -INFINITY;
#pragma unroll
                for (int k = 0; k < 4; ++k) { const float x = bs[gi * 4 + k]; if (x > m1) { m2 = m1; m1 = x; } else if (x > m2) m2 = x; }
                const float gs = m1 + m2;
                if (gs > bestv) { bestv = gs; bestg = gi; }
            }
            int i0 = 0, i1 = 0; float v0 = -INFINITY, v1 = -INFINITY, s0 = 0.f, s1 = 0.f;
#pragma unroll
            for (int e = 0; e < 16; ++e) { const bool in = (e >> 2) == bestg; if (in && bs[e] > v0) { v0 = bs[e]; i0 = e; s0 = sc16[e]; } }
#pragma unroll
            for (int e = 0; e < 16; ++e) { const bool in = (e >> 2) == bestg && e != i0; if (in && bs[e] > v1) { v1 = bs[e]; i1 = e; s1 = sc16[e]; } }
            const float inv = 1.f / (s0 + s1);
            if (lane == 0) {
                const int lt = row - bidx() * tpb;
                sel[lt * 2 + 0] = i0; sel[lt * 2 + 1] = i1;
                float* tw = (float*)(p.ws + OFF_TOKW) + (size_t)row * 2;
                tw[0] = s0 * inv; tw[1] = s1 * inv;
            }
        }
    }
    if (WHICH == 2) {
        __syncthreads();
        const int t0 = bidx() * tpb, nt = max(0, min(nrows, t0 + tpb) - t0);
        int* rank = sel + 2 * tpb;
        if (tidx() < 16) {
            const int e = tidx(); int c = 0;
            for (int i = 0; i < 2 * nt; ++i) if (sel[i] == e) { rank[i] = c; ++c; }
            ((int*)(p.ws + OFF_CNTB))[(size_t)bidx() * 16 + e] = c;
        }
        __syncthreads();
        int* toki = (int*)(p.ws + OFF_TOKI);
        for (int i = tidx(); i < nt; i += NT) {
            int4 r; r.x = sel[2 * i]; r.y = sel[2 * i + 1]; r.z = rank[2 * i]; r.w = rank[2 * i + 1];
            *(int4*)(toki + (size_t)(t0 + i) * 4) = r;
        }
        __syncthreads();
    }
}
DEV void phase_route(const Params& p, int l, int nrows, char* smem) {
    int* sm = (int*)smem;
    const int tid = tidx(), e = tid & 15, part = tid >> 4, G = gridDim.x, b = bidx();
    const int* cntb = (const int*)(p.ws + OFF_CNTB);
    int pre = 0, tot = 0;
    for (int bb = part; bb < G; bb += 16) { const int c = cntb[(size_t)bb * 16 + e]; tot += c; if (bb < b) pre += c; }
    __syncthreads();
    sm[part * 16 + e] = pre; sm[256 + part * 16 + e] = tot;
    __syncthreads();
    if (tid < 16) {
        int a = 0, t = 0;
        for (int q = 0; q < 16; ++q) { a += sm[q * 16 + tid]; t += sm[256 + q * 16 + tid]; }
        sm[512 + tid] = a; sm[528 + tid] = t;
    }
    __syncthreads();
    if (tid == 0) {
        int a = 0;
        for (int q = 0; q < 16; ++q) { sm[544 + q] = a; a += sm[528 + q]; }
    }
    __syncthreads();
    if (b == 0 && tid < 16) ((int*)(p.ws + OFF_CTR))[CTR_MOE + l * 16 + tid] = sm[528 + tid];
    const int tpb = (nrows + G - 1) / G, t0 = b * tpb, nt = max(0, min(nrows, t0 + tpb) - t0);
    int* toki = (int*)(p.ws + OFF_TOKI);
    const float* tokw = (const float*)(p.ws + OFF_TOKW);
    int* ltok = (int*)(p.ws + OFF_LTOK);
    float* lw = (float*)(p.ws + OFF_LW);
    for (int i = tid; i < 2 * nt; i += NT) {
        const int t = t0 + (i >> 1), j = i & 1;
        const int ee = toki[(size_t)t * 4 + j], rk = toki[(size_t)t * 4 + 2 + j];
        const int pos = sm[512 + ee] + rk;
        ltok[(size_t)ee * TT + pos] = t;
        lw[(size_t)ee * TT + pos] = tokw[(size_t)t * 2 + j];
        toki[(size_t)t * 4 + 2 + j] = sm[544 + ee] + pos;
    }
}
DEV void phase_combine(const Params& p, int l, int nrows) {
    const int lane = tidx() & 63, wave = tidx() >> 6;
    const bf16_t* Z = wsb(p, OFF_Z);
    const int* toki = (const int*)(p.ws + OFF_TOKI);
    const float* tokw = (const float*)(p.ws + OFF_TOKW);
    for (int row = bidx() * 4 + wave; row < nrows; row += gridDim.x * 4) {
        float* dst = row < TL ? p.out + (size_t)row * 1024 : wsf(p, OFF_CX) + (size_t)(row - TL) * 1024;
        const float* g2 = modp(p, l, mod_row(row), 5);
        const int r0 = toki[(size_t)row * 4 + 2], r1 = toki[(size_t)row * 4 + 3];
        const float w0 = tokw[(size_t)row * 2], w1 = tokw[(size_t)row * 2 + 1];
#pragma unroll
        for (int i = 0; i < 4; ++i) {
            const int c = lane * 4 + i * 256;
            const u32x2 a = *(const u32x2*)(Z + (size_t)r0 * 1024 + c), b = *(const u32x2*)(Z + (size_t)r1 * 1024 + c);
            const float4 gg = *(const float4*)(g2 + c);
            float4 x = *(float4*)(dst + c);
            x.x += gg.x * (w0 * bflo(a.x) + w1 * bflo(b.x));
            x.y += gg.y * (w0 * bfhi(a.x) + w1 * bfhi(b.x));
            x.z += gg.z * (w0 * bflo(a.y) + w1 * bflo(b.y));
            x.w += gg.w * (w0 * bfhi(a.y) + w1 * bfhi(b.y));
            *(float4*)(dst + c) = x;
        }
    }
}
constexpr int GLD = 72;
constexpr int GSTAGE = 128 * GLD;
template <bool DEEP = true, int TN = 2, class AF, class BF>
DEV void gemm_mainloop(f32x16 (&acc)[2][TN], AF arow, BF brow, int K, bf16_t* sm) {
    const int tid = tidx(), lane = tid & 63, wave = tid >> 6, wm = wave >> 1, wn = wave & 1;
    bf16_t* As = sm;
    bf16_t* Bs = sm + 2 * GSTAGE;
    constexpr int NB = 2 * TN;
    const bf16_t* ap[4]; const bf16_t* bp[NB];
#pragma unroll
    for (int i = 0; i < 4; ++i) { const int q = tid + i * NT; ap[i] = arow(q >> 3) + (q & 7) * 8; }
#pragma unroll
    for (int i = 0; i < NB; ++i) { const int q = tid + i * NT; bp[i] = brow(q >> 3) + (q & 7) * 8; }
    const int soff = (tid >> 3) * GLD + (tid & 7) * 8;
    u32x4 ra0[4], rb0[NB], ra1[4], rb1[NB];
    const int nk = K >> 6;
#pragma unroll
    for (int i = 0; i < 4; ++i) ra0[i] = *(const u32x4*)ap[i];
#pragma unroll
    for (int i = 0; i < NB; ++i) rb0[i] = *(const u32x4*)bp[i];
    if (DEEP && nk > 1) {
#pragma unroll
        for (int i = 0; i < 4; ++i) ra1[i] = *(const u32x4*)(ap[i] + 64);
#pragma unroll
        for (int i = 0; i < NB; ++i) rb1[i] = *(const u32x4*)(bp[i] + 64);
    }
    __syncthreads();
#pragma unroll
    for (int i = 0; i < 4; ++i) *(u32x4*)(As + soff + i * 32 * GLD) = ra0[i];
#pragma unroll
    for (int i = 0; i < NB; ++i) *(u32x4*)(Bs + soff + i * 32 * GLD) = rb0[i];
    __syncthreads();
    const int arow0 = (wm * 64 + (lane & 31)) * GLD + (lane >> 5) * 8;
    const int brow0 = (wn * 32 * TN + (lane & 31)) * GLD + (lane >> 5) * 8;
    auto compute = [&](int cur) {
        const bf16_t* a_s = As + cur * GSTAGE + arow0;
        const bf16_t* b_s = Bs + cur * GSTAGE + brow0;
#pragma unroll
        for (int ks = 0; ks < 4; ++ks) {
            const bf16x8 a0 = *(const bf16x8*)(a_s + ks * 16);
            const bf16x8 a1 = *(const bf16x8*)(a_s + 32 * GLD + ks * 16);
#pragma unroll
            for (int j = 0; j < TN; ++j) {
                const bf16x8 bj = *(const bf16x8*)(b_s + j * 32 * GLD + ks * 16);
                acc[0][j] = __builtin_amdgcn_mfma_f32_32x32x16_bf16(a0, bj, acc[0][j], 0, 0, 0);
                acc[1][j] = __builtin_amdgcn_mfma_f32_32x32x16_bf16(a1, bj, acc[1][j], 0, 0, 0);
            }
        }
    };
    auto gload = [&](u32x4 (&ra)[4], u32x4 (&rb)[NB], int kt) {
        const int k0 = kt * 64;
#pragma unroll
        for (int i = 0; i < 4; ++i) ra[i] = *(const u32x4*)(ap[i] + k0);
#pragma unroll
        for (int i = 0; i < NB; ++i) rb[i] = *(const u32x4*)(bp[i] + k0);
    };
    auto lstore = [&](const u32x4 (&ra)[4], const u32x4 (&rb)[NB], int st) {
#pragma unroll
        for (int i = 0; i < 4; ++i) *(u32x4*)(As + st * GSTAGE + soff + i * 32 * GLD) = ra[i];
#pragma unroll
        for (int i = 0; i < NB; ++i) *(u32x4*)(Bs + st * GSTAGE + soff + i * 32 * GLD) = rb[i];
    };
    for (int kt = 0; kt < nk; kt += 2) {
        if (!DEEP && kt + 1 < nk) gload(ra1, rb1, kt + 1);
        if (DEEP && kt + 2 < nk) gload(ra0, rb0, kt + 2);
        compute(0);
        if (kt + 1 < nk) lstore(ra1, rb1, 1);
        __syncthreads();
        if (kt + 1 >= nk) break;
        if (!DEEP && kt + 2 < nk) gload(ra0, rb0, kt + 2);
        if (DEEP && kt + 3 < nk) gload(ra1, rb1, kt + 3);
        compute(1);
        if (kt + 2 < nk) lstore(ra0, rb0, 0);
        __syncthreads();
    }
}
template <int TN>
DEV void acc_zero(f32x16 (&acc)[2][TN]) {
#pragma unroll
    for (int i = 0; i < 2; ++i)
#pragma unroll
        for (int j = 0; j < TN; ++j)
#pragma unroll
            for (int r = 0; r < 16; ++r) acc[i][j][r] = 0.f;
}
#define EPI_FOREACH(acc, ...)                                                                           \
    {                                                                                                    \
        const int _lane = tidx() & 63, _wave = tidx() >> 6, _wm = _wave >> 1, _wn = _wave & 1; \
        _Pragma("unroll") for (int _i = 0; _i < 2; ++_i)                                                 \
        _Pragma("unroll") for (int _j = 0; _j < 2; ++_j)                                                 \
        _Pragma("unroll") for (int _r = 0; _r < 16; ++_r) {                                              \
            const int er = _wm * 64 + _i * 32 + (_r & 3) + 8 * (_r >> 2) + 4 * (_lane >> 5);             \
            const int ec = _wn * 64 + _j * 32 + (_lane & 31);                                            \
            const float ev = acc[_i][_j][_r];                                                            \
            __VA_ARGS__                                                                                  \
        }                                                                                                \
    }

DEV void tile_mn(int item, int nMt, int nNt, int& mt, int& nt) {
    constexpr int GM = 16;
    const int per = GM * nNt, g = item / per, rem = item % per;
    const int m0 = g * GM, gsz = (nMt - m0) < GM ? (nMt - m0) : GM;
    mt = m0 + rem % gsz; nt = rem / gsz;
}

DEV void phase_inproj(const Params& p, int l, char* smem) {
    bf16_t* sm = (bf16_t*)smem;
    const bf16_t* H = wsb(p, OFF_H);
    const bf16_t* W = wsb(p, OFF_WIN);
    bf16_t* P = wsb(p, OFF_P);
    unsigned char* G = (unsigned char*)(p.ws + OFF_GATE);
    const int nMt = TT / 128, nNt = NINP / 128;
    for (int item = bidx(); item < nMt * nNt; item += gridDim.x) {
        int mt, nt; tile_mn(item, nMt, nNt, mt, nt);
        const int m0 = mt * 128, n0 = nt * 128;
        if (l == 1 && m0 >= TL && n0 >= NGATE0) continue;
        f32x16 acc[2][2]; acc_zero<2>(acc);
        gemm_mainloop(acc, [&](int r) { return H + (size_t)(m0 + r) * 1024; }, [&](int r) { return W + (size_t)(n0 + r) * 1024; }, 1024, sm);
        if (n0 < NGATE0) {
            EPI_FOREACH(acc, { const int col = n0 + ec; if (col < C_PEND) P[(size_t)(m0 + er) * LDP + col] = f2bf(ev); })
        } else {
            EPI_FOREACH(acc, { const int col = n0 + ec - NGATE0; const float s = sigmoidf_(ev); G[(size_t)(m0 + er) * 4096 + col] = (unsigned char)__float2int_rn(s * 255.f); })
        }
    }
}

template <class EF>
DEV void gemm_generic(const bf16_t* A, int lda, int M, const bf16_t* Bt, int ldb, int N, int K, EF ef, char* smem, int rot) {
    bf16_t* sm = (bf16_t*)smem;
    const int nMt = (M + 127) / 128, nNt = (N + 127) / 128, G = gridDim.x;
    const int first = (bidx() - (rot % G) + G) % G;
    for (int item = first; item < nMt * nNt; item += G) {
        const int mt = item / nNt, nt = item % nNt, m0 = mt * 128, n0 = nt * 128;
        f32x16 acc[2][2]; acc_zero<2>(acc);
        gemm_mainloop(acc, [&](int r) { int rr = m0 + r; rr = rr < M ? rr : M - 1; return A + (size_t)rr * lda; },
                      [&](int r) { int rr = n0 + r; rr = rr < N ? rr : N - 1; return Bt + (size_t)rr * ldb; }, K, sm);
        EPI_FOREACH(acc, { const int row = m0 + er, col = n0 + ec; if (row < M && col < N) ef(row, col, ev); })
    }
}

DEV void phase_merge(const Params& p, int l, int M, char* smem) {
    bf16_t* sm = (bf16_t*)smem;
    const bf16_t* Y = wsb(p, OFF_Y);
    const bf16_t* W = wsb(p, OFF_WBR);
    const unsigned char* G = (const unsigned char*)(p.ws + OFF_GATE);
    bf16_t* MG = wsb(p, OFF_H);
    bf16_t* As = sm;
    bf16_t* Bs = sm + 2 * GSTAGE;
    unsigned char* Gs = (unsigned char*)(sm + 2 * GSTAGE + 2 * 64 * GLD);
    const int tid = tidx(), lane = tid & 63, wave = tid >> 6, wm = wave >> 1, wn = wave & 1;
    const int soff = (tid >> 3) * GLD + (tid & 7) * 8;
    const int arow0 = (wm * 64 + (lane & 31)) * GLD + (lane >> 5) * 8;
    const int brow0 = (wn * 32 + (lane & 31)) * GLD + (lane >> 5) * 8;
    const int nMt = M / 128, nNt = 16;
    for (int item = bidx(); item < nMt * nNt; item += gridDim.x) {
        const int mt = item / nNt, nt = item % nNt, m0 = mt * 128, n0 = nt * 64;
        const bf16_t* ap[4]; const bf16_t* bp[2]; const unsigned char* gp[2];
#pragma unroll
        for (int i = 0; i < 4; ++i) { const int q = tid + i * NT; ap[i] = Y + (size_t)(m0 + (q >> 3)) * 1024 + (q & 7) * 8; }
#pragma unroll
        for (int i = 0; i < 2; ++i) { const int q = tid + i * NT; bp[i] = W + (size_t)(n0 + (q >> 3)) * 256 + (q & 7) * 8;
                                      gp[i] = G + (size_t)(m0 + (q >> 2)) * 4096 + n0 + (q & 3) * 16; }
        f32x16 tot[2], acc[2];
#pragma unroll
        for (int a = 0; a < 2; ++a)
#pragma unroll
            for (int r = 0; r < 16; ++r) { tot[a][r] = 0.f; acc[a][r] = 0.f; }
        u32x4 ra[4], rb[2], rg[2];
#pragma unroll
        for (int i = 0; i < 4; ++i) ra[i] = *(const u32x4*)ap[i];
#pragma unroll
        for (int i = 0; i < 2; ++i) rb[i] = *(const u32x4*)bp[i];
        __syncthreads();
#pragma unroll
        for (int i = 0; i < 4; ++i) *(u32x4*)(As + soff + i * 32 * GLD) = ra[i];
#pragma unroll
        for (int i = 0; i < 2; ++i) *(u32x4*)(Bs + soff + i * 32 * GLD) = rb[i];
        __syncthreads();
#pragma unroll
        for (int kt = 0; kt < 16; ++kt) {
            const int cur = kt & 1, seg = kt >> 2;
            if (kt + 1 < 16) {
                const int k1 = kt + 1;
#pragma unroll
                for (int i = 0; i < 4; ++i) ra[i] = *(const u32x4*)(ap[i] + k1 * 64);
#pragma unroll
                for (int i = 0; i < 2; ++i) rb[i] = *(const u32x4*)(bp[i] + (size_t)(k1 >> 2) * (1024 * 256) + (k1 & 3) * 64);
            }
            if ((kt & 3) == 0) {
#pragma unroll
                for (int i = 0; i < 2; ++i) rg[i] = *(const u32x4*)(gp[i] + seg * 1024);
            }
            const bf16_t* a_s = As + cur * GSTAGE + arow0;
            const bf16_t* b_s = Bs + cur * (64 * GLD) + brow0;
#pragma unroll
            for (int ks = 0; ks < 4; ++ks) {
                const bf16x8 a0 = *(const bf16x8*)(a_s + ks * 16), a1 = *(const bf16x8*)(a_s + 32 * GLD + ks * 16), b0 = *(const bf16x8*)(b_s + ks * 16);
                acc[0] = __builtin_amdgcn_mfma_f32_32x32x16_bf16(a0, b0, acc[0], 0, 0, 0);
                acc[1] = __builtin_amdgcn_mfma_f32_32x32x16_bf16(a1, b0, acc[1], 0, 0, 0);
            }
            if (kt + 1 < 16) {
                const int nx = cur ^ 1;
#pragma unroll
                for (int i = 0; i < 4; ++i) *(u32x4*)(As + nx * GSTAGE + soff + i * 32 * GLD) = ra[i];
#pragma unroll
                for (int i = 0; i < 2; ++i) *(u32x4*)(Bs + nx * (64 * GLD) + soff + i * 32 * GLD) = rb[i];
            }
            if ((kt & 3) == 3) {
#pragma unroll
                for (int i = 0; i < 2; ++i) { const int q = tid + i * NT; *(u32x4*)(Gs + (q >> 2) * 64 + (q & 3) * 16) = rg[i]; }
            }
            __syncthreads();
            if ((kt & 3) == 3) {
#pragma unroll
                for (int a = 0; a < 2; ++a)
#pragma unroll
                    for (int r = 0; r < 16; ++r) {
                        const int er = wm * 64 + a * 32 + (r & 3) + 8 * (r >> 2) + 4 * (lane >> 5), ec = wn * 32 + (lane & 31);
                        tot[a][r] += (float)Gs[er * 64 + ec] * (1.f / 255.f) * acc[a][r];
                        acc[a][r] = 0.f;
                    }
            }
        }
#pragma unroll
        for (int a = 0; a < 2; ++a)
#pragma unroll
            for (int r = 0; r < 16; ++r) {
                const int er = wm * 64 + a * 32 + (r & 3) + 8 * (r >> 2) + 4 * (lane >> 5), ec = wn * 32 + (lane & 31);
                MG[(size_t)(m0 + er) * 1024 + n0 + ec] = f2bf(tot[a][r]);
            }
    }
}

DEV void phase_outproj(const Params& p, int l, int M, char* smem) {
    bf16_t* sm = (bf16_t*)smem;
    const bf16_t* MG = wsb(p, OFF_H);
    const bf16_t* W = wsb(p, OFF_WOUT);
    const float* xs = (l == 0) ? p.in[I_X] : p.out;
    const float* cs = (l == 0) ? p.in[I_CTX] : wsf(p, OFF_CX);
    float* cxd = wsf(p, OFF_CX);
    float* outd = p.out;
    const int nMt = M / 128, nNt = 8;
    for (int item = bidx(); item < nMt * nNt; item += gridDim.x) {
        const int mt = item / nNt, nt = item % nNt, m0 = mt * 128, n0 = nt * 128;
        f32x16 acc[2][2]; acc_zero<2>(acc);
        gemm_mainloop(acc, [&](int r) { return MG + (size_t)(m0 + r) * 1024; }, [&](int r) { return W + (size_t)(n0 + r) * 1024; }, 1024, sm);
        const float* g1 = modp(p, l, mod_row(m0), 2);
        if (m0 < TL) {
            EPI_FOREACH(acc, { const size_t o = (size_t)(m0 + er) * 1024 + n0 + ec; outd[o] = xs[o] + g1[n0 + ec] * ev; })
        } else {
            EPI_FOREACH(acc, { const size_t o = (size_t)(m0 - TL + er) * 1024 + n0 + ec; cxd[o] = cs[o] + g1[n0 + ec] * ev; })
        }
    }
}

constexpr int MOE_MAP_OFF = 73728;
DEV void moe_map(const Params& p, int l, char* smem) {
    int* mm = (int*)(smem + MOE_MAP_OFF);
    __syncthreads();
    if (tidx() == 0) {
        const int* cnt = (const int*)(p.ws + OFF_CTR) + CTR_MOE + l * 16;
        int b = 0, t = 0;
        for (int e = 0; e < 16; ++e) { const int c = cnt[e]; mm[e] = c; mm[16 + e] = b; mm[32 + e] = t; b += c; t += (c + 127) >> 7; }
        mm[48] = t;
    }
    __syncthreads();
}
DEV void phase_moe1(const Params& p, int l, char* smem) {
    bf16_t* sm = (bf16_t*)smem;
    const bf16_t* F = wsb(p, OFF_H);
    const bf16_t* W = wsb(p, OFF_WG1);
    bf16_t* ACT = wsb(p, OFF_P);
    const int* ltok = (const int*)(p.ws + OFF_LTOK);
    moe_map(p, l, smem); const int* mm = (const int*)(smem + MOE_MAP_OFF);
    const int nNt = 8, total = mm[48] * nNt;
    for (int item = bidx(); item < total; item += gridDim.x) {
        const int mtg = item / nNt, nt = item % nNt;
        int e = 0;
        for (int q = 1; q < 16; ++q) if (mtg >= mm[32 + q]) e = q;
        const int m0 = (mtg - mm[32 + e]) * 128, n0 = nt * 128, ce = mm[e];
        const int* lt = ltok + (size_t)e * TT;
        f32x16 acc[2][2]; acc_zero<2>(acc);
        gemm_mainloop(acc, [&](int r) { int idx = m0 + r; idx = idx < ce ? idx : ce - 1; return F + (size_t)lt[idx] * 1024; },
                      [&](int r) { return W + ((size_t)e * 1024 + n0 + r) * 1024; }, 1024, sm);
        const int lane = tidx() & 63, wave = tidx() >> 6, wm = wave >> 1, wn = wave & 1;
        const int jcol = ((n0 >> 6) + wn) * 32 + (lane & 31);
#pragma unroll
        for (int a = 0; a < 2; ++a)
#pragma unroll
            for (int r = 0; r < 16; ++r) {
                const int idx = m0 + wm * 64 + a * 32 + (r & 3) + 8 * (r >> 2) + 4 * (lane >> 5);
                if (idx < ce) {
                    const float g = acc[a][0][r], u = acc[a][1][r];
                    ACT[(size_t)(mm[16 + e] + idx) * DFF + jcol] = f2bf(g * sigmoidf_(g) * u);
                }
            }
    }
}
DEV void phase_moe2(const Params& p, int l, char* smem) {
    bf16_t* sm = (bf16_t*)smem;
    const bf16_t* ACT = wsb(p, OFF_P);
    const bf16_t* W = wsb(p, OFF_WDN);
    bf16_t* Z = wsb(p, OFF_Z);
    moe_map(p, l, smem); const int* mm = (const int*)(smem + MOE_MAP_OFF);
    const int nNt = 8, total = mm[48] * nNt;
    for (int item = bidx(); item < total; item += gridDim.x) {
        const int mtg = item / nNt, nt = item % nNt;
        int e = 0;
        for (int q = 1; q < 16; ++q) if (mtg >= mm[32 + q]) e = q;
        const int m0 = (mtg - mm[32 + e]) * 128, n0 = nt * 128, ce = mm[e];
        f32x16 acc[2][2]; acc_zero<2>(acc);
        gemm_mainloop(acc, [&](int r) { int idx = m0 + r; idx = idx < ce ? idx : ce - 1; return ACT + (size_t)(mm[16 + e] + idx) * DFF; },
                      [&](int r) { return W + ((size_t)e * 1024 + n0 + r) * DFF; }, DFF, sm);
        bf16_t* zb = Z + (size_t)mm[16 + e] * 1024;
        EPI_FOREACH(acc, { const int idx = m0 + er; if (idx < ce) zb[(size_t)idx * 1024 + n0 + ec] = f2bf(ev); })
    }
}
DEV void tok_seq(int t, int& base, int& n, int& len) {
    if (t < TL) { base = t & ~(SEQ - 1); n = t & (SEQ - 1); len = SEQ; } else { const int u = t - TL; base = TL + (u & ~(CTXL - 1)); n = u & (CTXL - 1); len = CTXL; }
}
DEV void phase_prep1(const Params& p, int l) {
    const int lane = tidx() & 63, wave = tidx() >> 6;
    bf16_t* P = wsb(p, OFF_P);
    bf16_t* XL = wsb(p, OFF_XL);
    const float* qkg = p.in[I_DAQKG] + l * 64;
    const float* cqg = p.in[I_MCQG] + l * 192;
    const float* ckvg = p.in[I_MCKVG] + l * 128;
    const float* mu3 = p.in[I_RMU] + (l * 4 + 3) * 256;
    for (int t = bidx() * 4 + wave; t < TT; t += gridDim.x * 4) {
        bf16_t* row = P + (size_t)t * LDP;
        int base, n, len; tok_seq(t, base, n, len);
        {
            const int d0 = (lane & 7) * 4;
            float cs[4], sn[4];
            const bool rot = t < TL;
            if (rot) {
                const float fr = (float)(n >> 6), fc = (float)(n & 63);
#pragma unroll
                for (int j = 0; j < 4; ++j) {
                    const int i = (d0 + j) & 15;
                    const float inv = exp2f(-(float)(i & 7) * (13.287712379549449f / 8.f));
                    const float ang = (i < 8 ? fr : fc) * inv;
                    cs[j] = cosf(ang); sn[j] = sinf(ang);
                }
            }
#pragma unroll
            for (int which = 0; which < 2; ++which) {
                bf16_t* ptr = row + (which ? C_DAK : C_DAQ) + lane * 4;
                const u32x2 raw = *(const u32x2*)ptr;
                float v[4] = { bflo(raw.x), bfhi(raw.x), bflo(raw.y), bfhi(raw.y) };
                float ss = v[0] * v[0] + v[1] * v[1] + v[2] * v[2] + v[3] * v[3];
                ss = group_sum<8>(ss);
                const float rstd = rsqrtf(ss * (1.f / 32.f) + EPS);
                const float* g = qkg + which * 32 + d0;
#pragma unroll
                for (int j = 0; j < 4; ++j) v[j] = v[j] * rstd * g[j];
                if (rot) {
#pragma unroll
                    for (int j = 0; j < 4; ++j) {
                        const float o = __shfl_xor(v[j], 4, 64);
                        v[j] = (d0 < 16) ? (v[j] * cs[j] - o * sn[j]) : (v[j] * cs[j] + o * sn[j]);
                    }
                }
                if (which == 0) {
                    const float qs = 0.17677669529663687f * LOG2E;
#pragma unroll
                    for (int j = 0; j < 4; ++j) v[j] *= qs;
                }
                u32x2 o; o.x = pack2(v[0], v[1]); o.y = pack2(v[2], v[3]);
                *(u32x2*)ptr = o;
            }
        }
        {
            float v[3]; float ss = 0.f;
#pragma unroll
            for (int j = 0; j < 3; ++j) { v[j] = bf2f(row[C_CQ + lane + j * 64]); ss += v[j] * v[j]; }
            ss = wave_sum(ss);
            const float rstd = rsqrtf(ss * (1.f / 192.f) + EPS);
#pragma unroll
            for (int j = 0; j < 3; ++j) row[C_CQ + lane + j * 64] = f2bf(v[j] * rstd * cqg[lane + j * 64]);
            float w[2]; float s2 = 0.f;
#pragma unroll
            for (int j = 0; j < 2; ++j) { w[j] = bf2f(row[C_CKV + lane + j * 64]); s2 += w[j] * w[j]; }
            s2 = wave_sum(s2);
            const float r2 = rsqrtf(s2 * (1.f / 128.f) + EPS);
#pragma unroll
            for (int j = 0; j < 2; ++j) row[C_CKV + lane + j * 64] = f2bf(w[j] * r2 * ckvg[lane + j * 64]);
        }
        {
            const int c = lane * 4;
            const u32x2 cur = *(const u32x2*)(row + C_RWD + c);
            u32x2 pv = (u32x2){0u, 0u}, nx = (u32x2){0u, 0u};
            if (n > 0) pv = *(const u32x2*)(row - LDP + C_RWD + c);
            if (n + 1 < len) nx = *(const u32x2*)(row + LDP + C_RWD + c);
            const float4 m = *(const float4*)(mu3 + c);
            float o[4];
            { const float x = bflo(cur.x); o[0] = x + (0.5f * (bflo(pv.x) + bflo(nx.x)) - x) * m.x; }
            { const float x = bfhi(cur.x); o[1] = x + (0.5f * (bfhi(pv.x) + bfhi(nx.x)) - x) * m.y; }
            { const float x = bflo(cur.y); o[2] = x + (0.5f * (bflo(pv.y) + bflo(nx.y)) - x) * m.z; }
            { const float x = bfhi(cur.y); o[3] = x + (0.5f * (bfhi(pv.y) + bfhi(nx.y)) - x) * m.w; }
            u32x2 ov; ov.x = pack2(o[0], o[1]); ov.y = pack2(o[2], o[3]);
            *(u32x2*)(XL + (size_t)t * 256 + c) = ov;
        }
    }
}

DEV void phase_prep_gemm1(const Params& p, int l, char* smem) {
    const bf16_t* P = wsb(p, OFF_P);
    const bf16_t* w = wsb(p, OFF_WSM) + (size_t)l * WS_PER_LAYER;
    bf16_t* QRAW = wsb(p, OFF_QRAW); bf16_t* KVRAW = wsb(p, OFF_KVRAW); bf16_t* LR = wsb(p, OFF_LR);
    int rot = 0;
    gemm_generic(P + C_CQ, LDP, TT, w + WS_UQT, 192, 192, 192, [&](int r, int c, float v) { QRAW[(size_t)r * 192 + c] = f2bf(v); }, smem, rot);
    rot += (TT / 128) * 2;
    gemm_generic(P + C_CKV, LDP, TT, w + WS_UKVT, 128, 384, 128, [&](int r, int c, float v) { KVRAW[(size_t)r * 384 + c] = f2bf(v); }, smem, rot);
    rot += (TT / 128) * 3;
    gemm_generic(wsb(p, OFF_XL), 256, TT, w + WS_W1C, 256, 192, 256,
                 [&](int r, int c, float v) { const float o = c < 64 ? tanhf(v) : (c < 128 ? v : sigmoidf_(v)); LR[(size_t)r * 192 + c] = f2bf(o); }, smem, rot);
}
DEV void phase_prep_gemm2(const Params& p, int l, char* smem) {
    const bf16_t* w = wsb(p, OFF_WSM) + (size_t)l * WS_PER_LAYER;
    const bf16_t* LR = wsb(p, OFF_LR);
    bf16_t* RWX = wsb(p, OFF_RWX);
    bf16_t* P = wsb(p, OFF_P);
    int rot = 0;
    for (int d = 0; d < 2; ++d) {
        const float* w0 = p.in[I_RW0] + (l * 2 + d) * 256;
        gemm_generic(LR + d * 32, 192, TT, w + WS_W2 + (size_t)d * 256 * 64, 64, 256, 64,
                     [&](int r, int c, float v) { RWX[(size_t)r * 1024 + d * 256 + c] = f2bf(0.6065306597126334f * sigmoidf_(w0[c] + v)); }, smem, rot);
        rot += (TT / 128) * 2;
        const float* a0 = p.in[I_RA0] + (l * 2 + d) * 256;
        gemm_generic(LR + 64 + d * 32, 192, TT, w + WS_W2 + (size_t)(2 + d) * 256 * 64, 64, 256, 64,
                     [&](int r, int c, float v) { RWX[(size_t)r * 1024 + 512 + d * 256 + c] = f2bf(sigmoidf_(a0[c] + v)); }, smem, rot);
        rot += (TT / 128) * 2;
    }
    gemm_generic(LR + 128, 192, TT, w + WS_G2T, 64, 256, 64, [&](int r, int c, float v) { P[(size_t)r * LDP + C_RWD + c] = f2bf(v); }, smem, rot);
}

DEV void phase_prep2(const Params& p, int l) {
    const int lane = tidx() & 63, wave = tidx() >> 6;
    const bf16_t* P = wsb(p, OFF_P);
    const bf16_t* QRAW = wsb(p, OFF_QRAW); const bf16_t* KVRAW = wsb(p, OFF_KVRAW);
    bf16_t* MQ = wsb(p, OFF_MLAQ); bf16_t* MK = wsb(p, OFF_MLAK); bf16_t* MV = wsb(p, OFF_MLAV);
    const float* qkg = p.in[I_MQKG] + l * 96;
    for (int t = bidx() * 4 + wave; t < TT; t += gridDim.x * 4) {
        int base, n, len; tok_seq(t, base, n, len);
        const int h = lane >> 4, j = lane & 15;
        const bool rot = t < TL;
        float cs = 1.f, sn = 0.f;
        if (rot) {
            const int i = j & 7;
            const float inv = exp2f(-(float)(i & 3) * (13.287712379549449f / 4.f));
            const float ang = (i < 4 ? (float)(n >> 6) : (float)(n & 63)) * inv;
            cs = cosf(ang); sn = sinf(ang);
        }
        {
            float v[3]; float ss = 0.f;
#pragma unroll
            for (int k = 0; k < 3; ++k) { v[k] = bf2f(QRAW[(size_t)t * 192 + h * 48 + j + k * 16]); ss += v[k] * v[k]; }
            ss = group_sum<16>(ss);
            const float rstd = rsqrtf(ss * (1.f / 48.f) + EPS);
#pragma unroll
            for (int k = 0; k < 3; ++k) v[k] = v[k] * rstd * qkg[j + k * 16];
            if (rot) { const float o = __shfl_xor(v[2], 8, 64); v[2] = (j < 8) ? (v[2] * cs - o * sn) : (v[2] * cs + o * sn); }
            const float qs = 0.14433756729740643f * LOG2E;
#pragma unroll
            for (int k = 0; k < 3; ++k) MQ[(size_t)t * 192 + h * 48 + j + k * 16] = f2bf(v[k] * qs);
        }
        {
            float v[3]; float ss = 0.f;
            v[0] = bf2f(KVRAW[(size_t)t * 384 + h * 96 + j]);
            v[1] = bf2f(KVRAW[(size_t)t * 384 + h * 96 + 16 + j]);
            v[2] = bf2f(P[(size_t)t * LDP + C_KR + j]);
#pragma unroll
            for (int k = 0; k < 3; ++k) ss += v[k] * v[k];
            ss = group_sum<16>(ss);
            const float rstd = rsqrtf(ss * (1.f / 48.f) + EPS);
#pragma unroll
            for (int k = 0; k < 3; ++k) v[k] = v[k] * rstd * qkg[48 + j + k * 16];
            if (rot) { const float o = __shfl_xor(v[2], 8, 64); v[2] = (j < 8) ? (v[2] * cs - o * sn) : (v[2] * cs + o * sn); }
#pragma unroll
            for (int k = 0; k < 3; ++k) MK[(size_t)t * 192 + h * 48 + j + k * 16] = f2bf(v[k]);
        }
#pragma unroll
        for (int k = 0; k < 4; ++k) MV[(size_t)t * 256 + h * 64 + j + k * 16] = KVRAW[(size_t)t * 384 + h * 96 + 32 + j + k * 16];
    }
}
template <int NC, int DK>
struct AttnCfg {
    static constexpr int DKROW = NC * DK, KLD = DKROW + 8, VLD = 68;
    static constexpr int KSTAGE = 64 * KLD, VSTAGE = 64 * VLD;
    static constexpr int KCH = 64 * DKROW / 8;
};
template <int NC, int DK, class EPI>
DEV void attn_item(const bf16_t* Q, int ldq, const bf16_t* Kl, const bf16_t* Kc, int ldk, const bf16_t* Vl, const bf16_t* Vc, int ldv,
                   int q0, int nlat_tiles, int nctx_tiles, EPI epi, char* smem) {
    using C = AttnCfg<NC, DK>;
    constexpr int KS = DK / 16;
    const int tid = tidx(), lane = tid & 63, wave = tid >> 6, ql = lane & 31, hh = lane >> 5;
    bf16_t* Ks = (bf16_t*)smem;
    bf16_t* Vt = Ks + 2 * C::KSTAGE;
    bf16x8 qf[NC][KS];
    {
        const bf16_t* qp = Q + (size_t)(q0 + wave * 32 + ql) * ldq + hh * 8;
#pragma unroll
        for (int c = 0; c < NC; ++c)
#pragma unroll
            for (int ks = 0; ks < KS; ++ks) qf[c][ks] = *(const bf16x8*)(qp + c * DK + ks * 16);
    }
    f32x16 O[NC][2];
    float mrun[NC], lrun[NC];
#pragma unroll
    for (int c = 0; c < NC; ++c) {
        mrun[c] = -1e30f; lrun[c] = 0.f;
#pragma unroll
        for (int d = 0; d < 2; ++d)
#pragma unroll
            for (int r = 0; r < 16; ++r) O[c][d][r] = 0.f;
    }
    const int ntiles = nlat_tiles + nctx_tiles;
    constexpr int KPT = (C::KCH + NT - 1) / NT;
    u32x4 rk[KPT], rv[2];
    auto load_tile = [&](int tile) {
        const bf16_t* kb = tile < nlat_tiles ? Kl + (size_t)tile * 64 * ldk : Kc + (size_t)(tile - nlat_tiles) * 64 * ldk;
        const bf16_t* vb = tile < nlat_tiles ? Vl + (size_t)tile * 64 * ldv : Vc + (size_t)(tile - nlat_tiles) * 64 * ldv;
#pragma unroll
        for (int i = 0; i < KPT; ++i) {
            int q = tid + i * NT; q = q < C::KCH ? q : C::KCH - 1;
            { const int key = q / (C::DKROW / 8), ch = q % (C::DKROW / 8); rk[i] = *(const u32x4*)(kb + (size_t)key * ldk + ch * 8); }
        }
#pragma unroll
        for (int i = 0; i < 2; ++i) { const int q = tid + i * NT; const int key = q >> 3, ch = q & 7; rv[i] = *(const u32x4*)(vb + (size_t)key * ldv + ch * 8); }
    };
    auto store_tile = [&](int st) {
#pragma unroll
        for (int i = 0; i < KPT; ++i) {
            const int q = tid + i * NT;
            if (q < C::KCH) { const int key = q / (C::DKROW / 8), ch = q % (C::DKROW / 8); *(u32x4*)(Ks + st * C::KSTAGE + key * C::KLD + ch * 8) = rk[i]; }
        }
#pragma unroll
        for (int i = 0; i < 2; ++i) {
            const int q = tid + i * NT; const int key = q >> 3, dv0 = (q & 7) * 8;
            bf16_t* vd = Vt + st * C::VSTAGE + dv0 * C::VLD + key;
            const unsigned w[4] = { rv[i][0], rv[i][1], rv[i][2], rv[i][3] };
#pragma unroll
            for (int j = 0; j < 4; ++j) { vd[(2 * j) * C::VLD] = (bf16_t)(w[j] & 0xFFFFu); vd[(2 * j + 1) * C::VLD] = (bf16_t)(w[j] >> 16); }
        }
    };
    load_tile(0);
    __syncthreads();
    store_tile(0);
    __syncthreads();
    for (int tile = 0; tile < ntiles; ++tile) {
        const int cur = tile & 1;
        if (tile + 1 < ntiles) load_tile(tile + 1);
        const bf16_t* ks_ = Ks + cur * C::KSTAGE;
        const bf16_t* vt_ = Vt + cur * C::VSTAGE;
#pragma unroll
        for (int c = 0; c < NC; ++c) {
            f32x16 S[2];
#pragma unroll
            for (int kb = 0; kb < 2; ++kb) {
#pragma unroll
                for (int r = 0; r < 16; ++r) S[kb][r] = 0.f;
#pragma unroll
                for (int ks = 0; ks < KS; ++ks) {
                    const bf16x8 kf = *(const bf16x8*)(ks_ + (kb * 32 + ql) * C::KLD + c * DK + ks * 16 + hh * 8);
                    S[kb] = __builtin_amdgcn_mfma_f32_32x32x16_bf16(kf, qf[c][ks], S[kb], 0, 0, 0);
                }
            }
            float mx = S[0][0];
#pragma unroll
            for (int kb = 0; kb < 2; ++kb)
#pragma unroll
                for (int r = 0; r < 16; ++r) mx = fmaxf(mx, S[kb][r]);
            mx = fmaxf(mx, __shfl_xor(mx, 32, 64));
            const float mnew = fmaxf(mrun[c], mx);
            const float alpha = __builtin_amdgcn_exp2f(mrun[c] - mnew);
            mrun[c] = mnew;
            float ls = 0.f;
#pragma unroll
            for (int kb = 0; kb < 2; ++kb)
#pragma unroll
                for (int r = 0; r < 16; ++r) { const float e = __builtin_amdgcn_exp2f(S[kb][r] - mnew); S[kb][r] = e; ls += e; }
            lrun[c] = lrun[c] * alpha + ls;
#pragma unroll
            for (int d = 0; d < 2; ++d)
#pragma unroll
                for (int r = 0; r < 16; ++r) O[c][d][r] *= alpha;
#pragma unroll
            for (int s = 0; s < 4; ++s) {
                const int kb = s >> 1, s2 = s & 1;
                const u32x4 pu = (u32x4){pack2(S[kb][8 * s2 + 0], S[kb][8 * s2 + 1]), pack2(S[kb][8 * s2 + 2], S[kb][8 * s2 + 3]),
                                         pack2(S[kb][8 * s2 + 4], S[kb][8 * s2 + 5]), pack2(S[kb][8 * s2 + 6], S[kb][8 * s2 + 7])};
                const bf16x8 pf = __builtin_bit_cast(bf16x8, pu);
                const int keyo = kb * 32 + 16 * s2 + 4 * hh;
#pragma unroll
                for (int d = 0; d < 2; ++d) {
                    const bf16_t* vp = vt_ + (d * 32 + ql) * C::VLD + keyo;
                    const u32x2 lo = *(const u32x2*)vp, hi = *(const u32x2*)(vp + 8);
                    const u32x4 vv = (u32x4){lo[0], lo[1], hi[0], hi[1]};
                    const bf16x8 vf = __builtin_bit_cast(bf16x8, vv);
                    O[c][d] = __builtin_amdgcn_mfma_f32_32x32x16_bf16(vf, pf, O[c][d], 0, 0, 0);
                }
            }
        }
        if (tile + 1 < ntiles) store_tile(cur ^ 1);
        __syncthreads();
    }
    float inv[NC];
#pragma unroll
    for (int c = 0; c < NC; ++c) { const float lt = lrun[c] + __shfl_xor(lrun[c], 32, 64); inv[c] = 1.f / lt; }
    epi(O, inv, q0 + wave * 32 + ql, hh);
}

DEV void da_item(const Params& p, int l, int item, char* smem) {
    const bf16_t* P = wsb(p, OFF_P);
    bf16_t* Y = wsb(p, OFF_Y);
    const float linit = 0.8f - 0.6f * __expf(-0.3f * (float)l);
    float lam;
    {
        const float* la = p.in[I_DALAM] + l * 128;
        const int lane = tidx() & 63;
        float a = lane < 32 ? la[lane] * la[32 + lane] : 0.f, b = lane < 32 ? la[64 + lane] * la[96 + lane] : 0.f;
        a = wave_sum(a); b = wave_sum(b);
        lam = __expf(a) - __expf(b) + linit;
    }
    const float* sg = p.in[I_DASUB] + l * 64;
    int b, h, qt; bool isctx;
    if (item < 512) { isctx = false; b = item >> 6; h = (item >> 4) & 3; qt = item & 15; }
    else { const int it = item - 512; isctx = true; b = it >> 3; h = (it >> 1) & 3; qt = it & 1; }
    const size_t lat0 = (size_t)b * SEQ, ctx0 = (size_t)TL + (size_t)b * CTXL;
    const size_t qrow0 = isctx ? ctx0 : lat0;
    float* o1s = (float*)(smem + 32768) + (tidx() >> 6) * (32 * 64) + (tidx() & 63);
    auto epi0 = [&](f32x16 (&O)[1][2], float (&inv)[1], int qrow, int hh) {
#pragma unroll
        for (int d = 0; d < 2; ++d)
#pragma unroll
            for (int r = 0; r < 16; ++r) o1s[(d * 16 + r) * 64] = O[0][d][r] * inv[0];
    };
    auto epi1 = [&](f32x16 (&O)[1][2], float (&inv)[1], int qrow, int hh) {
        float v[2][16]; float ss = 0.f;
#pragma unroll
        for (int d = 0; d < 2; ++d)
#pragma unroll
            for (int r = 0; r < 16; ++r) { const float o = o1s[(d * 16 + r) * 64] - lam * O[0][d][r] * inv[0]; v[d][r] = o; ss += o * o; }
        ss += __shfl_xor(ss, 32, 64);
        const float rstd = rsqrtf(ss * (1.f / 64.f) + EPS) * (1.f - linit);
        bf16_t* yo = Y + (qrow0 + qrow) * 1024 + h * 64;
#pragma unroll
        for (int d = 0; d < 2; ++d)
#pragma unroll
            for (int g = 0; g < 4; ++g) {
                const int dv = d * 32 + 8 * g + 4 * hh;
                u32x2 o;
                o.x = pack2(v[d][4 * g + 0] * rstd * sg[dv + 0], v[d][4 * g + 1] * rstd * sg[dv + 1]);
                o.y = pack2(v[d][4 * g + 2] * rstd * sg[dv + 2], v[d][4 * g + 3] * rstd * sg[dv + 3]);
                *(u32x2*)(yo + dv) = o;
            }
    };
    const bf16_t* Qp = P + qrow0 * LDP + C_DAQ + h * 64;
    const bf16_t* Kl = P + lat0 * LDP + C_DAK + h * 64;
    const bf16_t* Kc = P + ctx0 * LDP + C_DAK + h * 64;
    const bf16_t* Vl = P + lat0 * LDP + C_DAV + h * 64;
    const bf16_t* Vc = P + ctx0 * LDP + C_DAV + h * 64;
    const int nlat = isctx ? 0 : SEQ / 64;
    attn_item<1, 32>(Qp, LDP, Kl, Kc, LDP, Vl, Vc, LDP, qt * 128, nlat, CTXL / 64, epi0, smem);
    attn_item<1, 32>(Qp + 32, LDP, Kl + 32, Kc + 32, LDP, Vl, Vc, LDP, qt * 128, nlat, CTXL / 64, epi1, smem);
}
DEV void mla_item(const Params& p, int l, int item, char* smem) {
    const bf16_t* MQ = wsb(p, OFF_MLAQ); const bf16_t* MK = wsb(p, OFF_MLAK); const bf16_t* MV = wsb(p, OFF_MLAV);
    bf16_t* Y = wsb(p, OFF_Y);
    int b, h, qt; bool isctx;
    if (item < 512) { isctx = false; b = item >> 6; h = (item >> 4) & 3; qt = item & 15; }
    else { const int it = item - 512; isctx = true; b = it >> 3; h = (it >> 1) & 3; qt = it & 1; }
    const size_t lat0 = (size_t)b * SEQ, ctx0 = (size_t)TL + (size_t)b * CTXL;
    const size_t qrow0 = isctx ? ctx0 : lat0;
    auto epi = [&](f32x16 (&O)[1][2], float (&inv)[1], int qrow, int hh) {
        bf16_t* yo = Y + (qrow0 + qrow) * 1024 + 512 + h * 64;
#pragma unroll
        for (int d = 0; d < 2; ++d)
#pragma unroll
            for (int g = 0; g < 4; ++g) {
                const int dv = d * 32 + 8 * g + 4 * hh;
                u32x2 o;
                o.x = pack2(O[0][d][4 * g + 0] * inv[0], O[0][d][4 * g + 1] * inv[0]);
                o.y = pack2(O[0][d][4 * g + 2] * inv[0], O[0][d][4 * g + 3] * inv[0]);
                *(u32x2*)(yo + dv) = o;
            }
    };
    const bf16_t* Qp = MQ + qrow0 * 192 + h * 48;
    const bf16_t* Kl = MK + lat0 * 192 + h * 48;
    const bf16_t* Kc = MK + ctx0 * 192 + h * 48;
    const bf16_t* Vl = MV + lat0 * 256 + h * 64;
    const bf16_t* Vc = MV + ctx0 * 256 + h * 64;
    attn_item<1, 48>(Qp, 192, Kl, Kc, 192, Vl, Vc, 256, qt * 128, isctx ? 0 : SEQ / 64, CTXL / 64, epi, smem);
}
DEV int s5_token(int b, int tb, int n) { return tb == 0 ? TL + b * CTXL + n : b * SEQ + (tb - 1) * 256 + n; }
struct S5Lane { float are, aim; float bre[16], bim[16]; };
DEV void s5_setup(const Params& p, int l, int d, int g, int pl, S5Lane& s) {
    const int gi = ((l * 2 + d) * 16 + g);
    const float lre = p.in[I_S5LRE][gi * 64 + pl], lim = p.in[I_S5LIM][gi * 64 + pl];
    const float dt = __expf(p.in[I_S5LDT][gi]);
    const float mag = __expf(lre * dt);
    s.are = mag * cosf(lim * dt); s.aim = mag * sinf(lim * dt);
    const float nr = s.are - 1.f, ni = s.aim, den = 1.f / (lre * lre + lim * lim);
    const float cr = (nr * lre + ni * lim) * den, ci = (ni * lre - nr * lim) * den;
    const float* br = p.in[I_S5BRE] + ((size_t)gi * 64 + pl) * 16;
    const float* bi = p.in[I_S5BIM] + ((size_t)gi * 64 + pl) * 16;
#pragma unroll
    for (int c = 0; c < 16; ++c) { const float x = br[c], y = bi[c]; s.bre[c] = cr * x - ci * y; s.bim[c] = cr * y + ci * x; }
}
template <bool DUMP>
DEV void s5_scan32(const S5Lane& s, float& hre, float& him, const float* ub, bf16_t* hb, int pl, bool rev) {
    for (int j = 0; j < 32; ++j) {
        const int rowi = rev ? 31 - j : j;
        const float4* u4 = (const float4*)(ub + rowi * 16);
        float bur = 0.f, bui = 0.f;
#pragma unroll
        for (int q = 0; q < 4; ++q) {
            const float4 u = u4[q];
            bur += u.x * s.bre[q * 4 + 0] + u.y * s.bre[q * 4 + 1] + u.z * s.bre[q * 4 + 2] + u.w * s.bre[q * 4 + 3];
            bui += u.x * s.bim[q * 4 + 0] + u.y * s.bim[q * 4 + 1] + u.z * s.bim[q * 4 + 2] + u.w * s.bim[q * 4 + 3];
        }
        const float nre = s.are * hre - s.aim * him + bur;
        const float nim = s.are * him + s.aim * hre + bui;
        hre = nre; him = nim;
        if (DUMP) { hb[rowi * 136 + pl] = f2bf(hre); hb[rowi * 136 + 64 + pl] = f2bf(him); }
    }
}
DEV void s5_load_u(const bf16_t* P, int b, int tb, int g, int sc, float* ub, int lane) {
    if (lane < 32) {
        const int t = s5_token(b, tb, sc * 32 + lane);
        const uint4* src = (const uint4*)(P + (size_t)t * LDP + C_S5 + g * 16);
        const uint4 a = src[0], c = src[1];
        float4* d = (float4*)(ub + lane * 16);
        d[0] = make_float4(bflo(a.x), bfhi(a.x), bflo(a.y), bfhi(a.y));
        d[1] = make_float4(bflo(a.z), bfhi(a.z), bflo(a.w), bfhi(a.w));
        d[2] = make_float4(bflo(c.x), bfhi(c.x), bflo(c.y), bfhi(c.y));
        d[3] = make_float4(bflo(c.z), bfhi(c.z), bflo(c.w), bfhi(c.w));
    }
}
DEV void phase_s5_pass1(const Params& p, int l, char* smem) {
    const int lane = tidx() & 63, wave = tidx() >> 6;
    float* ub = (float*)smem + wave * 512;
    const bf16_t* P = wsb(p, OFF_P);
    float* st = wsf(p, OFF_S5ST);
    const int nitems = 2 * 8 * 16 * 8;
    for (int it0 = bidx() * 4; it0 < nitems; it0 += gridDim.x * 4) {
        const int it = it0 + wave;
        const int seg = it & 7, g = (it >> 3) & 15, b = (it >> 7) & 7, d = it >> 10;
        const int tb = seg == 0 ? 0 : (d == 0 ? seg : 9 - seg);
        S5Lane s; s5_setup(p, l, d, g, lane, s);
        float hre = 0.f, him = 0.f;
        for (int k = 0; k < 8; ++k) {
            const int sc = d == 0 ? k : 7 - k;
            __syncthreads();
            s5_load_u(P, b, tb, g, sc, ub, lane);
            __syncthreads();
            s5_scan32<false>(s, hre, him, ub, nullptr, lane, d == 1);
        }
        float* o = st + ((((size_t)d * 8 + b) * 16 + g) * 8 + seg) * 128;
        o[lane] = hre; o[64 + lane] = him;
    }
}
DEV void s5_pass2_item(const Params& p, int l, int tb0, int bitem, char* smem) {
    const int lane = tidx() & 63, wave = tidx() >> 6;
    float* ub = (float*)smem + wave * 512;
    bf16_t* hb = (bf16_t*)(smem + 8192) + wave * (32 * 136);
    bf16_t* P = wsb(p, OFF_P);
    const float* st = wsf(p, OFF_S5ST);
    {
        const int it = bitem * 4 + wave;
        const int g = it & 15, b = (it >> 4) & 7, tb = (it >> 7) + tb0;
        f32x4 yacc[16];
#pragma unroll
        for (int i = 0; i < 16; ++i) yacc[i] = (f32x4){0.f, 0.f, 0.f, 0.f};
#pragma unroll
        for (int d = 0; d < 2; ++d) {
            S5Lane s; s5_setup(p, l, d, g, lane, s);
            const float* cre = p.in[I_S5CRE] + ((size_t)((l * 2 + d) * 16 + g) * 16 + (lane & 15)) * 64 + (lane >> 4) * 8;
            const float* cim = p.in[I_S5CIM] + ((size_t)((l * 2 + d) * 16 + g) * 16 + (lane & 15)) * 64 + (lane >> 4) * 8;
            auto cfrag = [&](int ks) {
                const float* src = ks < 2 ? cre + ks * 32 : cim + (ks - 2) * 32;
                const float4 a = *(const float4*)src, b = *(const float4*)(src + 4);
                const float sg = ks < 2 ? 1.f : -1.f;
                const u32x4 u = (u32x4){pack2(sg * a.x, sg * a.y), pack2(sg * a.z, sg * a.w), pack2(sg * b.x, sg * b.y), pack2(sg * b.z, sg * b.w)};
                return __builtin_bit_cast(bf16x8, u);
            };
            const int seg = tb == 0 ? 0 : (d == 0 ? tb : 9 - tb);
            float hre = 0.f, him = 0.f;
            {
                float pr = s.are, pi = s.aim;
#pragma unroll
                for (int q = 0; q < 8; ++q) { const float nr = pr * pr - pi * pi, ni = 2.f * pr * pi; pr = nr; pi = ni; }
                const float* hs = st + (((size_t)d * 8 + b) * 16 + g) * 8 * 128;
                for (int i = 0; i < seg; ++i) {
                    const float er = hs[i * 128 + lane], ei = hs[i * 128 + 64 + lane];
                    const float nr = pr * hre - pi * him + er, ni = pr * him + pi * hre + ei;
                    hre = nr; him = ni;
                }
            }
#pragma unroll
            for (int k = 0; k < 8; ++k) {
                const int sc = d == 0 ? k : 7 - k;
                __syncthreads();
                s5_load_u(P, b, tb, g, sc, ub, lane);
                __syncthreads();
                s5_scan32<true>(s, hre, him, ub, hb, lane, d == 1);
                __syncthreads();
#pragma unroll
                for (int mt = 0; mt < 2; ++mt)
#pragma unroll
                    for (int ks = 0; ks < 4; ++ks) {
                        const bf16x8 af = *(const bf16x8*)(hb + (mt * 16 + (lane & 15)) * 136 + ks * 32 + (lane >> 4) * 8);
                        yacc[sc * 2 + mt] = __builtin_amdgcn_mfma_f32_16x16x32_bf16(af, cfrag(ks), yacc[sc * 2 + mt], 0, 0, 0);
                    }
            }
        }
        {
            const int c = lane & 15;
            const float dd = p.in[I_S5D][(l * 16 + g) * 16 + c];
#pragma unroll
            for (int tile = 0; tile < 16; ++tile)
#pragma unroll
                for (int r = 0; r < 4; ++r) {
                    const int n = tile * 16 + (lane >> 4) * 4 + r;
                    bf16_t* up = P + (size_t)s5_token(b, tb, n) * LDP + C_S5 + g * 16 + c;
                    const float y = dd * bf2f(*up) + yacc[tile][r];
                    const float z = 0.5f * y * (1.f + tanhf(0.7978845608028654f * (y + 0.044715f * y * y * y)));
                    *up = f2bf(z);
                }
        }
    }
}

DEV float row16_sum(float v) {
    v += __int_as_float(__builtin_amdgcn_mov_dpp(__float_as_int(v), 0x128, 0xf, 0xf, true));
    v += __int_as_float(__builtin_amdgcn_mov_dpp(__float_as_int(v), 0x124, 0xf, 0xf, true));
    v += __int_as_float(__builtin_amdgcn_mov_dpp(__float_as_int(v), 0x122, 0xf, 0xf, true));
    v += __int_as_float(__builtin_amdgcn_mov_dpp(__float_as_int(v), 0x121, 0xf, 0xf, true));
    return v;
}
DEV float fmul_(float a, float b) { return a * b; }
DEV float fadd_(float a, float b) { return a + b; }
DEV float ffma_(float a, float b, float c) { return __builtin_fmaf(a, b, c); }
DEV float fnma_(float a, float b, float c) { return __builtin_fmaf(-a, b, c); }
DEV float row8_sum(float v) {
    v += __int_as_float(__builtin_amdgcn_mov_dpp(__float_as_int(v), 0x141, 0xf, 0xf, true));
    v += __int_as_float(__builtin_amdgcn_mov_dpp(__float_as_int(v), 0xB1, 0xf, 0xf, true));
    v += __int_as_float(__builtin_amdgcn_mov_dpp(__float_as_int(v), 0x4E, 0xf, 0xf, true));
    return v;
}
DEV float row16_sum1(float v) { v += __int_as_float(__builtin_amdgcn_mov_dpp(__float_as_int(v), 0x128, 0xf, 0xf, true)); return v; }
constexpr int RW_CT = 16;
struct RwRaw { u32x2 r[3], k[3], v[3], sd, a; float fp, fn; };
#ifndef RWVAR
#define RWVAR 0
#endif
template <int var>
DEV void rw_item_t(const Params& p, int l, int item, char* smem, int rep) {
    const int tid = tidx(), li = tid >> 4, lc = tid & 15;
    const int ch = item >> 2, rg = item & 3, dir = ch >> 5, b = (ch >> 2) & 7, head = ch & 3;
    float* buf = (float*)smem;
    float* ybuf = buf + 2 * RW_CT * 384;
    const bf16_t* P = wsb(p, OFF_P);
    const bf16_t* RWX = wsb(p, OFF_RWX);
    bf16_t* RWY = wsb(p, OFF_RWY) + (size_t)dir * TT * 256 + (rep > 0 ? (size_t)2 * TT * 256 : 0);
    const int hc = head * 64 + lc * 4;
    const float4 mur = *(const float4*)(p.in[I_RMU] + (l * 4 + 0) * 256 + hc);
    const float4 muk = *(const float4*)(p.in[I_RMU] + (l * 4 + 1) * 256 + hc);
    const float4 muv = *(const float4*)(p.in[I_RMU] + (l * 4 + 2) * 256 + hc);
    const float4 kk4 = *(const float4*)(p.in[I_RKK] + l * 256 + hc);
    const float4 ka4 = *(const float4*)(p.in[I_RKA] + l * 256 + hc);
    const int NCH = (CTXL + SEQ) / RW_CT;
    auto tok_of = [&](int cidx, int i, int& n, int& len) -> int {
        if (cidx < CTXL / RW_CT) { const int pos = cidx * RW_CT + i; len = CTXL; n = dir == 0 ? pos : CTXL - 1 - pos; return TL + b * CTXL + n; }
        const int pos = (cidx - CTXL / RW_CT) * RW_CT + i; len = SEQ; n = dir == 0 ? pos : SEQ - 1 - pos; return b * SEQ + n;
    };
    auto load_raw = [&](int cidx, RwRaw& raw) {
        int n, len; const int t = tok_of(cidx, li, n, len);
        const bf16_t* row = P + (size_t)t * LDP;
        const bool hp = n > 0, hn = n + 1 < len;
        const bf16_t* rp = hp ? row - LDP : row;
        const bf16_t* rn = hn ? row + LDP : row;
        raw.fp = hp ? 0.5f : 0.f; raw.fn = hn ? 0.5f : 0.f;
        raw.r[1] = *(const u32x2*)(row + C_RWR + hc); raw.k[1] = *(const u32x2*)(row + C_RWK + hc); raw.v[1] = *(const u32x2*)(row + C_RWV + hc);
        raw.r[0] = *(const u32x2*)(rp + C_RWR + hc); raw.k[0] = *(const u32x2*)(rp + C_RWK + hc); raw.v[0] = *(const u32x2*)(rp + C_RWV + hc);
        raw.r[2] = *(const u32x2*)(rn + C_RWR + hc); raw.k[2] = *(const u32x2*)(rn + C_RWK + hc); raw.v[2] = *(const u32x2*)(rn + C_RWV + hc);
        raw.sd = *(const u32x2*)(RWX + (size_t)t * 1024 + dir * 256 + hc);
        raw.a = *(const u32x2*)(RWX + (size_t)t * 1024 + 512 + dir * 256 + hc);
    };
    auto mix4 = [&](const u32x2 (&s)[3], const float4& mu, float fp, float fn, float (&o)[4]) {
        { const float x = bflo(s[1].x); o[0] = x + ((fp * bflo(s[0].x) + fn * bflo(s[2].x)) - x) * mu.x; }
        { const float x = bfhi(s[1].x); o[1] = x + ((fp * bfhi(s[0].x) + fn * bfhi(s[2].x)) - x) * mu.y; }
        { const float x = bflo(s[1].y); o[2] = x + ((fp * bflo(s[0].y) + fn * bflo(s[2].y)) - x) * mu.z; }
        { const float x = bfhi(s[1].y); o[3] = x + ((fp * bfhi(s[0].y) + fn * bfhi(s[2].y)) - x) * mu.w; }
    };
    auto stage = [&](int st, const RwRaw& raw) {
        float r4[4], k4[4], v4[4];
        mix4(raw.r, mur, raw.fp, raw.fn, r4); mix4(raw.k, muk, raw.fp, raw.fn, k4); mix4(raw.v, muv, raw.fp, raw.fn, v4);
        const float kkr[4] = { k4[0] * kk4.x, k4[1] * kk4.y, k4[2] * kk4.z, k4[3] * kk4.w };
        float nn = kkr[0] * kkr[0] + kkr[1] * kkr[1] + kkr[2] * kkr[2] + kkr[3] * kkr[3];
        nn = row16_sum(nn);
        const float rn = 1.f / fmaxf(sqrtf(nn), 1e-12f);
        const float a[4] = { bflo(raw.a.x), bfhi(raw.a.x), bflo(raw.a.y), bfhi(raw.a.y) };
        const float sd[4] = { bflo(raw.sd.x), bfhi(raw.sd.x), bflo(raw.sd.y), bfhi(raw.sd.y) };
        const float kav[4] = { ka4.x, ka4.y, ka4.z, ka4.w };
        float* d = buf + (st * RW_CT + li) * 384 + lc * 4;
        float wp[4], kp[4], bp[4], mp[4];
#pragma unroll
        for (int j = 0; j < 4; ++j) {
            wp[j] = __expf(-sd[j]);
            kp[j] = kkr[j] * rn;
            bp[j] = kp[j] * a[j];
            mp[j] = k4[j] * (1.f + (a[j] - 1.f) * kav[j]);
        }
        *(float4*)(d + 0) = make_float4(wp[0], wp[1], wp[2], wp[3]); *(float4*)(d + 64) = make_float4(kp[0], kp[1], kp[2], kp[3]);
        *(float4*)(d + 128) = make_float4(bp[0], bp[1], bp[2], bp[3]); *(float4*)(d + 192) = make_float4(mp[0], mp[1], mp[2], mp[3]);
        *(float4*)(d + 256) = make_float4(r4[0], r4[1], r4[2], r4[3]);
        *(float4*)(d + 320) = make_float4(v4[0], v4[1], v4[2], v4[3]);
    };
    float S0 = 0.f, S1 = 0.f, S2 = 0.f, S3 = 0.f;
    auto compute = [&](int cidx, int cur, const RwRaw& rs, bool do_stage) {
        float sr4[4], sk4[4], sv4[4], skkr[4], srn = 0.f;
        const float* cb = buf + cur * RW_CT * 384 + lc * 4;
        const float* vb = buf + cur * RW_CT * 384 + 320 + rg * 16 + li;
        float ykeep = 0.f;
        f32x4 w[2], kk[2], bb[2], km[2], rr[2]; float vv[2];
        w[0] = *(const f32x4*)(cb); kk[0] = *(const f32x4*)(cb + 64); bb[0] = *(const f32x4*)(cb + 128); km[0] = *(const f32x4*)(cb + 192); rr[0] = *(const f32x4*)(cb + 256);
        vv[0] = vb[0];
#pragma unroll
        for (int j = 0; j < RW_CT; ++j) {
            const int c0 = j & 1, c2 = c0 ^ 1;
            if (j + 1 < RW_CT) {
                const float* nb = cb + (j + 1) * 384;
                w[c2] = *(const f32x4*)(nb); kk[c2] = *(const f32x4*)(nb + 64); bb[c2] = *(const f32x4*)(nb + 128); km[c2] = *(const f32x4*)(nb + 192); rr[c2] = *(const f32x4*)(nb + 256);
                vv[c2] = vb[(j + 1) * 384];
            }
            const float v_ = vv[c0];
            float sa = fadd_(ffma_(S1, kk[c0][1], fmul_(S0, kk[c0][0])), ffma_(S3, kk[c0][3], fmul_(S2, kk[c0][2])));
            const float t0 = ffma_(S0, w[c0][0], fmul_(v_, km[c0][0])), t1 = ffma_(S1, w[c0][1], fmul_(v_, km[c0][1]));
            const float t2 = ffma_(S2, w[c0][2], fmul_(v_, km[c0][2])), t3 = ffma_(S3, w[c0][3], fmul_(v_, km[c0][3]));
            sa = row16_sum(sa);
            S0 = fnma_(sa, bb[c0][0], t0); S1 = fnma_(sa, bb[c0][1], t1); S2 = fnma_(sa, bb[c0][2], t2); S3 = fnma_(sa, bb[c0][3], t3);
            float y = fadd_(ffma_(S1, rr[c0][1], fmul_(S0, rr[c0][0])), ffma_(S3, rr[c0][3], fmul_(S2, rr[c0][2])));
            y = row16_sum(y);
            ykeep = (lc == j) ? y : ykeep;
            if (j == 2) { mix4(rs.r, mur, rs.fp, rs.fn, sr4); }
            if (j == 5) { mix4(rs.k, muk, rs.fp, rs.fn, sk4); }
            if (j == 8) { mix4(rs.v, muv, rs.fp, rs.fn, sv4); }
            if (j == 11) {
                skkr[0] = sk4[0] * kk4.x; skkr[1] = sk4[1] * kk4.y; skkr[2] = sk4[2] * kk4.z; skkr[3] = sk4[3] * kk4.w;
                float nn = skkr[0] * skkr[0] + skkr[1] * skkr[1] + skkr[2] * skkr[2] + skkr[3] * skkr[3];
                nn = row16_sum(nn);
                srn = 1.f / fmaxf(sqrtf(nn), 1e-12f);
            }
        }
        if (do_stage) {
            const float a[4] = { bflo(rs.a.x), bfhi(rs.a.x), bflo(rs.a.y), bfhi(rs.a.y) };
            const float sd[4] = { bflo(rs.sd.x), bfhi(rs.sd.x), bflo(rs.sd.y), bfhi(rs.sd.y) };
            const float kav[4] = { ka4.x, ka4.y, ka4.z, ka4.w };
            float* d = buf + ((cur ^ 1) * RW_CT + li) * 384 + lc * 4;
            float wp[4], kp[4], bp[4], mp[4];
#pragma unroll
            for (int q = 0; q < 4; ++q) {
                wp[q] = __expf(-sd[q]);
                kp[q] = skkr[q] * srn;
                bp[q] = kp[q] * a[q];
                mp[q] = sk4[q] * (1.f + (a[q] - 1.f) * kav[q]);
            }
            *(float4*)(d + 0) = make_float4(wp[0], wp[1], wp[2], wp[3]); *(float4*)(d + 64) = make_float4(kp[0], kp[1], kp[2], kp[3]);
            *(float4*)(d + 128) = make_float4(bp[0], bp[1], bp[2], bp[3]); *(float4*)(d + 192) = make_float4(mp[0], mp[1], mp[2], mp[3]);
            *(float4*)(d + 256) = make_float4(sr4[0], sr4[1], sr4[2], sr4[3]);
            *(float4*)(d + 320) = make_float4(sv4[0], sv4[1], sv4[2], sv4[3]);
        }
        {
            int n, len; const int t = tok_of(cidx, lc, n, len);
            RWY[(size_t)t * 256 + head * 64 + rg * 16 + li] = f2bf(ykeep);
        }
    };
    RwRaw rawA, rawB;
    __syncthreads();
    load_raw(0, rawA);
    stage(0, rawA);
    load_raw(1, rawA);
    __syncthreads();
    for (int cidx = 0; cidx < NCH; cidx += 2) {
        load_raw(min(cidx + 2, NCH - 1), rawB);
        compute(cidx, 0, rawA, true);
        __syncthreads();
        load_raw(min(cidx + 3, NCH - 1), rawA);
        compute(cidx + 1, 1, rawB, cidx + 2 < NCH);
        __syncthreads();
    }
}

DEV void rw_item(const Params& p, int l, int item, char* smem, int rep = 0) {
    rw_item_t<RWVAR>(p, l, item, smem, rep);
}
constexpr int RC = 32, SK = 72, ST = 40;
constexpr int L_K1 = 0, L_R1 = L_K1 + RC * SK, L_B1 = L_R1 + RC * SK, L_M1 = L_B1 + RC * SK,
              L_VT = L_M1 + RC * SK, L_B2T = L_VT + 64 * ST, L_M2T = L_B2T + 64 * ST,
              L_X = L_M2T + 64 * ST, L_XT = L_X + RC * ST, L_PA = L_XT + RC * ST, L_BM = L_PA + RC * ST, L_AR = L_BM + RC * ST, L_BR = L_AR + RC * ST,
              L_ET = L_BR + RC * ST, L_ZT = L_ET + 64 * ST, L_S = L_ZT + 64 * ST, L_RWEND = L_S + 64 * SK;
static_assert(L_RWEND * 2 + 256 <= 73728, "RWKV chunk LDS");
DEV bf16x8 ldfrag(const bf16_t* m, int stride, int row0, int k0, int lane) { return *(const bf16x8*)(m + (row0 + (lane & 15)) * stride + k0 + (lane >> 4) * 8); }
DEV f32x4 mfma16(bf16x8 a, bf16x8 b, f32x4 c) { return __builtin_amdgcn_mfma_f32_16x16x32_bf16(a, b, c, 0, 0, 0); }
#ifndef RWC_CLAMP
#define RWC_CLAMP 0
#endif
DEV void st4(bf16_t* dst, f32x4 v) {
    if (RWC_CLAMP) { for (int i = 0; i < 4; ++i) v[i] = fminf(fmaxf(v[i], -8.f), 8.f); } u32x2 o; o.x = pack2(v[0], v[1]); o.y = pack2(v[2], v[3]); *(u32x2*)dst = o; }
DEV void unpack8(const u32x4 u, float (&o)[8]) {
    o[0] = bflo(u[0]); o[1] = bfhi(u[0]); o[2] = bflo(u[1]); o[3] = bfhi(u[1]); o[4] = bflo(u[2]); o[5] = bfhi(u[2]); o[6] = bflo(u[3]); o[7] = bfhi(u[3]);
}
DEV u32x4 pack8(const float (&v)[8]) { return (u32x4){pack2(v[0], v[1]), pack2(v[2], v[3]), pack2(v[4], v[5]), pack2(v[6], v[7])}; }
struct RwcRaw { u32x4 r[3], k[3], v[3], sd, a; float fp, fn; };
#ifndef RWC_STOP
#define RWC_STOP 99
#endif
#ifndef RWC_DUMMY
#define RWC_DUMMY 0
#endif
#ifdef RWC_NOINLINE
__device__ __attribute__((noinline)) void rwc_item(const Params& p, int l, int chain, char* smem) {
#else
DEV void rwc_item(const Params& p, int l, int chain, char* smem) {
#endif
    const int tid = tidx(), lane = tid & 63, wave = __builtin_amdgcn_readfirstlane(tid >> 6), c16 = lane & 15, q4 = lane >> 4;
    const int dir = chain >> 5, b = (chain >> 2) & 7, head = chain & 3;
    bf16_t* L = (bf16_t*)smem;
    float* PC = (float*)(smem + L_RWEND * 2);
    float* CS = (float*)(L + L_ET);
    const bf16_t* P = wsb(p, OFF_P);
    const bf16_t* RWX = wsb(p, OFF_RWX);
    bf16_t* RWY = wsb(p, OFF_RWY) + (size_t)dir * TT * 256 + (RWC_DUMMY ? (size_t)2 * TT * 256 : 0);
    const int li = tid >> 3, c8 = (tid & 7) * 8, hc = head * 64 + c8;
    const int NCHK = (CTXL + SEQ) / RC;
    auto tok_of = [&](int c, int i, int& n, int& len) -> int {
        if (c < CTXL / RC) { const int pos = c * RC + i; len = CTXL; n = dir == 0 ? pos : CTXL - 1 - pos; return TL + b * CTXL + n; }
        const int pos = (c - CTXL / RC) * RC + i; len = SEQ; n = dir == 0 ? pos : SEQ - 1 - pos; return b * SEQ + n;
    };
    RwcRaw raw;
    auto load_raw = [&](int c) {
        int n, len; const int t = tok_of(c, li, n, len);
        const bf16_t* row = P + (size_t)t * LDP;
        const bool hp = n > 0, hn = n + 1 < len;
        const bf16_t* rp = hp ? row - LDP : row;
        const bf16_t* rn = hn ? row + LDP : row;
        raw.fp = hp ? 0.5f : 0.f; raw.fn = hn ? 0.5f : 0.f;
        raw.r[1] = *(const u32x4*)(row + C_RWR + hc); raw.k[1] = *(const u32x4*)(row + C_RWK + hc); raw.v[1] = *(const u32x4*)(row + C_RWV + hc);
        raw.r[0] = *(const u32x4*)(rp + C_RWR + hc); raw.k[0] = *(const u32x4*)(rp + C_RWK + hc); raw.v[0] = *(const u32x4*)(rp + C_RWV + hc);
        raw.r[2] = *(const u32x4*)(rn + C_RWR + hc); raw.k[2] = *(const u32x4*)(rn + C_RWK + hc); raw.v[2] = *(const u32x4*)(rn + C_RWV + hc);
        raw.sd = *(const u32x4*)(RWX + (size_t)t * 1024 + dir * 256 + hc);
        raw.a = *(const u32x4*)(RWX + (size_t)t * 1024 + 512 + dir * 256 + hc);
    };
    auto mix8 = [&](const u32x4 (&s)[3], const float* mu, float (&o)[8]) {
        float x[8], pv[8], nx[8]; unpack8(s[1], x); unpack8(s[0], pv); unpack8(s[2], nx);
        const float4 m0 = *(const float4*)mu, m1 = *(const float4*)(mu + 4);
        const float m[8] = { m0.x, m0.y, m0.z, m0.w, m1.x, m1.y, m1.z, m1.w };
#pragma unroll
        for (int j = 0; j < 8; ++j) o[j] = x[j] + ((raw.fp * pv[j] + raw.fn * nx[j]) - x[j]) * m[j];
    };
    f32x4 Wt[4];
#pragma unroll
    for (int j = 0; j < 4; ++j) Wt[j] = (f32x4){0.f, 0.f, 0.f, 0.f};
    __syncthreads();
    for (int i = tid; i < 64 * SK / 2; i += NT) ((unsigned*)(L + L_S))[i] = 0u;
    load_raw(0);
    for (int c = 0; c < (RWC_STOP == 0 ? 0 : NCHK); ++c) {
        {
            float r8[8], k8[8], v8[8], a8[8], sd8[8];
            mix8(raw.r, p.in[I_RMU] + (l * 4 + 0) * 256 + hc, r8);
            mix8(raw.k, p.in[I_RMU] + (l * 4 + 1) * 256 + hc, k8);
            mix8(raw.v, p.in[I_RMU] + (l * 4 + 2) * 256 + hc, v8);
            unpack8(raw.a, a8); unpack8(raw.sd, sd8);
            if (c + 1 < NCHK) load_raw(c + 1);
            const float4 kk0 = *(const float4*)(p.in[I_RKK] + l * 256 + hc), kk1 = *(const float4*)(p.in[I_RKK] + l * 256 + hc + 4);
            const float4 ka0 = *(const float4*)(p.in[I_RKA] + l * 256 + hc), ka1 = *(const float4*)(p.in[I_RKA] + l * 256 + hc + 4);
            const float kkc[8] = { kk0.x, kk0.y, kk0.z, kk0.w, kk1.x, kk1.y, kk1.z, kk1.w };
            const float kac[8] = { ka0.x, ka0.y, ka0.z, ka0.w, ka1.x, ka1.y, ka1.z, ka1.w };
            float kkv[8], bbv[8], kmv[8]; float n2 = 0.f;
#pragma unroll
            for (int j = 0; j < 8; ++j) { kkv[j] = k8[j] * kkc[j]; n2 += kkv[j] * kkv[j]; }
            n2 = row8_sum(n2);
            const float rn = 1.f / fmaxf(sqrtf(n2), 1e-12f);
#pragma unroll
            for (int j = 0; j < 8; ++j) { kkv[j] *= rn; bbv[j] = kkv[j] * a8[j]; kmv[j] = k8[j] * (1.f + (a8[j] - 1.f) * kac[j]); }
            *(float4*)(CS + li * 64 + c8) = make_float4(sd8[0], sd8[1], sd8[2], sd8[3]);
            *(float4*)(CS + li * 64 + c8 + 4) = make_float4(sd8[4], sd8[5], sd8[6], sd8[7]);
            __syncthreads();
            if (tid < 64) { float run = 0.f; for (int i = 0; i < RC; ++i) { run += CS[i * 64 + tid]; CS[i * 64 + tid] = run; } }
            __syncthreads();
            float cs[8], tot[8];
            { const float4 a0 = *(const float4*)(CS + li * 64 + c8), a1 = *(const float4*)(CS + li * 64 + c8 + 4);
              const float4 t0 = *(const float4*)(CS + (RC - 1) * 64 + c8), t1 = *(const float4*)(CS + (RC - 1) * 64 + c8 + 4);
              cs[0] = a0.x; cs[1] = a0.y; cs[2] = a0.z; cs[3] = a0.w; cs[4] = a1.x; cs[5] = a1.y; cs[6] = a1.z; cs[7] = a1.w;
              tot[0] = t0.x; tot[1] = t0.y; tot[2] = t0.z; tot[3] = t0.w; tot[4] = t1.x; tot[5] = t1.y; tot[6] = t1.z; tot[7] = t1.w; }
            float k1[8], r1[8], b1[8], m1[8], b2[8], m2[8];
#pragma unroll
            for (int j = 0; j < 8; ++j) {
                const float pinc = __expf(-cs[j]), pexc = __expf(sd8[j] - cs[j]), einv = __expf(cs[j]), ec = __expf(cs[j] - tot[j]);
                k1[j] = kkv[j] * pexc; r1[j] = r8[j] * pinc; b1[j] = bbv[j] * einv; m1[j] = kmv[j] * einv; b2[j] = bbv[j] * ec; m2[j] = kmv[j] * ec;
            }
            __syncthreads();
            *(u32x4*)(L + L_K1 + li * SK + c8) = pack8(k1); *(u32x4*)(L + L_R1 + li * SK + c8) = pack8(r1);
            *(u32x4*)(L + L_B1 + li * SK + c8) = pack8(b1); *(u32x4*)(L + L_M1 + li * SK + c8) = pack8(m1);
#pragma unroll
            for (int j = 0; j < 8; ++j) {
                L[L_VT + (c8 + j) * ST + li] = f2bf(v8[j]); L[L_B2T + (c8 + j) * ST + li] = f2bf(b2[j]); L[L_M2T + (c8 + j) * ST + li] = f2bf(m2[j]);
            }
            if (li == RC - 1) {
#pragma unroll
                for (int j = 0; j < 8; ++j) PC[c8 + j] = __expf(-tot[j]);
            }
            __syncthreads();
        }
        if (RWC_STOP <= 1) continue;
        {
            const int i0 = wave >> 1, j0 = wave & 1;
            const f32x4 z4 = (f32x4){0.f, 0.f, 0.f, 0.f};
            f32x4 aS = z4, aU = z4, bm = z4, ar = z4, br = z4;
#pragma unroll
            for (int kk2 = 0; kk2 < 2; ++kk2) {
                const bf16x8 k1i = ldfrag(L + L_K1, SK, i0 * 16, kk2 * 32, lane), k1j = ldfrag(L + L_K1, SK, j0 * 16, kk2 * 32, lane);
                const bf16x8 b1i = ldfrag(L + L_B1, SK, i0 * 16, kk2 * 32, lane), b1j = ldfrag(L + L_B1, SK, j0 * 16, kk2 * 32, lane);
                const bf16x8 m1i = ldfrag(L + L_M1, SK, i0 * 16, kk2 * 32, lane), r1j = ldfrag(L + L_R1, SK, j0 * 16, kk2 * 32, lane);
                aS = mfma16(b1i, k1j, aS);
                aU = mfma16(k1i, b1j, aU);
                bm = mfma16(m1i, k1j, bm);
                ar = mfma16(b1i, r1j, ar);
                br = mfma16(m1i, r1j, br);
            }
#ifdef RWC_WAIT
            __builtin_amdgcn_sched_barrier(0); __builtin_amdgcn_s_sleep(2); __builtin_amdgcn_sched_barrier(0);
#endif
            {
                const int t = j0 * 16 + c16, s0 = i0 * 16 + q4 * 4;
                f32x4 x, pa, o1, o2, o3;
#pragma unroll
                for (int r = 0; r < 4; ++r) {
                    const bool lt = s0 + r < t, le = s0 + r <= t;
                    x[r] = lt ? -aS[r] : 0.f; pa[r] = x[r] + ((s0 + r == t) ? 1.f : 0.f);
                    o1[r] = lt ? bm[r] : 0.f; o2[r] = le ? ar[r] : 0.f; o3[r] = le ? br[r] : 0.f;
                }
#ifdef RWC_GSTORE
                { bf16_t* gd = wsb(p, OFF_RWY) + (size_t)2 * TT * 256 + (size_t)(bidx() * 256 + tid) * 32;
                  st4(gd, x); st4(gd + 4, pa); st4(gd + 8, o1); st4(gd + 12, o2); st4(gd + 16, o3); }
#else
                st4(L + L_X + t * ST + s0, x); st4(L + L_PA + t * ST + s0, pa);
                st4(L + L_BM + t * ST + s0, o1); st4(L + L_AR + t * ST + s0, o2); st4(L + L_BR + t * ST + s0, o3);
#endif
            }
            {
                const int s = j0 * 16 + c16, t0 = i0 * 16 + q4 * 4;
                f32x4 o;
#pragma unroll
                for (int r = 0; r < 4; ++r) o[r] = (s < t0 + r) ? -aU[r] : 0.f;
#ifdef RWC_GSTORE
                st4(wsb(p, OFF_RWY) + (size_t)2 * TT * 256 + (size_t)(bidx() * 256 + tid) * 32 + 20, o);
#else
                st4(L + L_XT + s * ST + t0, o);
#endif
            }
            __syncthreads();
        }
        if (RWC_STOP <= 2) continue;
#pragma unroll 1
        for (int rd = 1; rd <= 5; ++rd) {
            const bool sq = rd <= 4, up = rd >= 2;
            const int i0 = wave >> 1, j0 = wave & 1;
            const bf16x8 xti = ldfrag(L + L_XT, ST, i0 * 16, 0, lane), xtj = ldfrag(L + L_XT, ST, j0 * 16, 0, lane);
            const bf16x8 xi = ldfrag(L + L_X, ST, i0 * 16, 0, lane), xj = ldfrag(L + L_X, ST, j0 * 16, 0, lane);
            const bf16x8 paj = ldfrag(L + L_PA, ST, j0 * 16, 0, lane);
            const u32x2 old = *(const u32x2*)(L + L_PA + (j0 * 16 + c16) * ST + i0 * 16 + q4 * 4);
            __syncthreads();
            const f32x4 z4 = (f32x4){0.f, 0.f, 0.f, 0.f};
            if (sq) {
                const f32x4 nx = mfma16(xti, xj, z4);
                const f32x4 nxt = mfma16(xi, xtj, z4);
                st4(L + L_X + (j0 * 16 + c16) * ST + i0 * 16 + q4 * 4, nx);
                st4(L + L_XT + (j0 * 16 + c16) * ST + i0 * 16 + q4 * 4, nxt);
            }
            if (up) {
                f32x4 acc = (f32x4){bflo(old.x), bfhi(old.x), bflo(old.y), bfhi(old.y)};
                acc = mfma16(xti, paj, acc);
                st4(L + L_PA + (j0 * 16 + c16) * ST + i0 * 16 + q4 * 4, acc);
            }
            __syncthreads();
        }
        if (RWC_STOP <= 3) continue;
        {
            const int vj = wave;
#pragma unroll
            for (int ti = 0; ti < 2; ++ti) {
                f32x4 acc = mfma16(ldfrag(L + L_BM, ST, ti * 16, 0, lane), ldfrag(L + L_VT, ST, vj * 16, 0, lane), (f32x4){0.f, 0.f, 0.f, 0.f});
#pragma unroll
                for (int kk2 = 0; kk2 < 2; ++kk2) acc = mfma16(ldfrag(L + L_K1, SK, ti * 16, kk2 * 32, lane), ldfrag(L + L_S, SK, vj * 16, kk2 * 32, lane), acc);
                st4(L + L_ET + (vj * 16 + c16) * ST + ti * 16 + q4 * 4, acc);
            }
            __syncthreads();
#pragma unroll
            for (int ti = 0; ti < 2; ++ti) {
                const f32x4 acc = mfma16(ldfrag(L + L_PA, ST, ti * 16, 0, lane), ldfrag(L + L_ET, ST, vj * 16, 0, lane), (f32x4){0.f, 0.f, 0.f, 0.f});
                st4(L + L_ZT + (vj * 16 + c16) * ST + ti * 16 + q4 * 4, -acc);
            }
            __syncthreads();
        }
        if (RWC_STOP <= 4) continue;
        {
            const int vi = wave;
#pragma unroll
            for (int tj = 0; tj < 2; ++tj) {
                f32x4 acc = (f32x4){0.f, 0.f, 0.f, 0.f};
#pragma unroll
                for (int kk2 = 0; kk2 < 2; ++kk2) acc = mfma16(ldfrag(L + L_S, SK, vi * 16, kk2 * 32, lane), ldfrag(L + L_R1, SK, tj * 16, kk2 * 32, lane), acc);
                acc = mfma16(ldfrag(L + L_ZT, ST, vi * 16, 0, lane), ldfrag(L + L_AR, ST, tj * 16, 0, lane), acc);
                acc = mfma16(ldfrag(L + L_VT, ST, vi * 16, 0, lane), ldfrag(L + L_BR, ST, tj * 16, 0, lane), acc);
                int n, len; const int t = tok_of(c, tj * 16 + c16, n, len);
                u32x2 o; o.x = pack2(acc[0], acc[1]); o.y = pack2(acc[2], acc[3]);
#ifndef RWC_NOYSTORE
                *(u32x2*)(RWY + (size_t)t * 256 + head * 64 + vi * 16 + q4 * 4) = o;
#else
                asm volatile("" :: "v"(o), "v"(t));
#endif
            }
            const float4 pc = *(const float4*)(PC + wave * 16 + q4 * 4);
            const bf16x8 fb2 = ldfrag(L + L_B2T, ST, wave * 16, 0, lane), fm2 = ldfrag(L + L_M2T, ST, wave * 16, 0, lane);
#pragma unroll
            for (int vj = 0; vj < 4; ++vj) {
                f32x4 acc = Wt[vj];
                acc[0] *= pc.x; acc[1] *= pc.y; acc[2] *= pc.z; acc[3] *= pc.w;
                acc = mfma16(fb2, ldfrag(L + L_ZT, ST, vj * 16, 0, lane), acc);
                acc = mfma16(fm2, ldfrag(L + L_VT, ST, vj * 16, 0, lane), acc);
                Wt[vj] = acc;
            }
            __syncthreads();
#pragma unroll
            for (int vj = 0; vj < 4; ++vj) st4(L + L_S + (vj * 16 + c16) * SK + wave * 16 + q4 * 4, Wt[vj]);
        }
    }
    __syncthreads();
#ifdef RWC_ZERO_LDS
    for (int i = tid; i < 73728 / 4; i += NT) ((unsigned*)smem)[i] = 0u;
    __syncthreads();
#endif
}
DEV void phase_s5_glu(const Params& p, int l, int M, char* smem) {
    const bf16_t* P = wsb(p, OFF_P);
    const bf16_t* w = wsb(p, OFF_WSM) + (size_t)l * WS_PER_LAYER + WS_GLUT;
    bf16_t* Y = wsb(p, OFF_Y);
    const float* bg = p.in[I_S5BGLU] + l * 256;
    gemm_generic(P + C_S5, LDP, M, w, 256, 256, 256,
                 [&](int r, int c, float v) { const float z = bf2f(P[(size_t)r * LDP + C_S5 + c]); Y[(size_t)r * 1024 + 256 + c] = f2bf(z * sigmoidf_(v + bg[c])); }, smem, 0);
}
DEV void phase_rw_finish(const Params& p, int l, int M) {
    const int lane = tidx() & 63, wave = tidx() >> 6;
    const bf16_t* P = wsb(p, OFF_P);
    const bf16_t* RWX = wsb(p, OFF_RWX);
    const bf16_t* RWY = wsb(p, OFF_RWY);
    bf16_t* Y = wsb(p, OFF_Y);
    const int c = lane * 4;
    const float4 mur = *(const float4*)(p.in[I_RMU] + (l * 4 + 0) * 256 + c);
    const float4 muk = *(const float4*)(p.in[I_RMU] + (l * 4 + 1) * 256 + c);
    const float4 muv = *(const float4*)(p.in[I_RMU] + (l * 4 + 2) * 256 + c);
    const float4 ka4 = *(const float4*)(p.in[I_RKA] + l * 256 + c);
    const float4 rk4 = *(const float4*)(p.in[I_RRK] + l * 256 + c);
    const float4 lg4 = *(const float4*)(p.in[I_RLNG] + l * 256 + c);
    const float4 lb4 = *(const float4*)(p.in[I_RLNB] + l * 256 + c);
    const float mr_[4] = { mur.x, mur.y, mur.z, mur.w }, mk_[4] = { muk.x, muk.y, muk.z, muk.w }, mv_[4] = { muv.x, muv.y, muv.z, muv.w };
    const float ka_[4] = { ka4.x, ka4.y, ka4.z, ka4.w }, rk_[4] = { rk4.x, rk4.y, rk4.z, rk4.w }, lg_[4] = { lg4.x, lg4.y, lg4.z, lg4.w }, lb_[4] = { lb4.x, lb4.y, lb4.z, lb4.w };
    for (int t = bidx() * 4 + wave; t < M; t += gridDim.x * 4) {
        int base, n, len; tok_seq(t, base, n, len);
        const bf16_t* row = P + (size_t)t * LDP;
        const bool hp = n > 0, hn = n + 1 < len;
        const u32x2 z = (u32x2){0u, 0u};
        float r4[4], k4[4], v4[4];
        {
            const u32x2 cu = *(const u32x2*)(row + C_RWR + c), pv = hp ? *(const u32x2*)(row - LDP + C_RWR + c) : z, nx = hn ? *(const u32x2*)(row + LDP + C_RWR + c) : z;
            const float x[4] = { bflo(cu.x), bfhi(cu.x), bflo(cu.y), bfhi(cu.y) }, a[4] = { bflo(pv.x), bfhi(pv.x), bflo(pv.y), bfhi(pv.y) }, b[4] = { bflo(nx.x), bfhi(nx.x), bflo(nx.y), bfhi(nx.y) };
#pragma unroll
            for (int j = 0; j < 4; ++j) r4[j] = x[j] + (0.5f * (a[j] + b[j]) - x[j]) * mr_[j];
        }
        {
            const u32x2 cu = *(const u32x2*)(row + C_RWK + c), pv = hp ? *(const u32x2*)(row - LDP + C_RWK + c) : z, nx = hn ? *(const u32x2*)(row + LDP + C_RWK + c) : z;
            const float x[4] = { bflo(cu.x), bfhi(cu.x), bflo(cu.y), bfhi(cu.y) }, a[4] = { bflo(pv.x), bfhi(pv.x), bflo(pv.y), bfhi(pv.y) }, b[4] = { bflo(nx.x), bfhi(nx.x), bflo(nx.y), bfhi(nx.y) };
#pragma unroll
            for (int j = 0; j < 4; ++j) k4[j] = x[j] + (0.5f * (a[j] + b[j]) - x[j]) * mk_[j];
        }
        {
            const u32x2 cu = *(const u32x2*)(row + C_RWV + c), pv = hp ? *(const u32x2*)(row - LDP + C_RWV + c) : z, nx = hn ? *(const u32x2*)(row + LDP + C_RWV + c) : z;
            const float x[4] = { bflo(cu.x), bfhi(cu.x), bflo(cu.y), bfhi(cu.y) }, a[4] = { bflo(pv.x), bfhi(pv.x), bflo(pv.y), bfhi(pv.y) }, b[4] = { bflo(nx.x), bfhi(nx.x), bflo(nx.y), bfhi(nx.y) };
#pragma unroll
            for (int j = 0; j < 4; ++j) v4[j] = x[j] + (0.5f * (a[j] + b[j]) - x[j]) * mv_[j];
        }
        const u32x2 af = *(const u32x2*)(RWX + (size_t)t * 1024 + 512 + c), ab = *(const u32x2*)(RWX + (size_t)t * 1024 + 768 + c);
        const float a0[4] = { bflo(af.x), bfhi(af.x), bflo(af.y), bfhi(af.y) }, a1[4] = { bflo(ab.x), bfhi(ab.x), bflo(ab.y), bfhi(ab.y) };
        const u32x2 yf = *(const u32x2*)(RWY + (size_t)t * 256 + c), yb = *(const u32x2*)(RWY + (size_t)TT * 256 + (size_t)t * 256 + c);
        float y[4] = { bflo(yf.x) + bflo(yb.x), bfhi(yf.x) + bfhi(yb.x), bflo(yf.y) + bflo(yb.y), bfhi(yf.y) + bfhi(yb.y) };
        float s = y[0] + y[1] + y[2] + y[3];
        s = group_sum<16>(s);
        const float mean = s * (1.f / 64.f);
        float q = 0.f, bon = 0.f;
#pragma unroll
        for (int j = 0; j < 4; ++j) {
            const float dlt = y[j] - mean; q += dlt * dlt;
            const float kmsum = k4[j] * (2.f + (a0[j] + a1[j] - 2.f) * ka_[j]);
            bon += r4[j] * kmsum * rk_[j];
        }
        q = group_sum<16>(q); bon = group_sum<16>(bon);
        const float rstd = rsqrtf(q * (1.f / 64.f) + 64e-5f);
        const u32x2 gg = *(const u32x2*)(row + C_RWD + c);
        const float g[4] = { bflo(gg.x), bfhi(gg.x), bflo(gg.y), bfhi(gg.y) };
        float o[4];
#pragma unroll
        for (int j = 0; j < 4; ++j) o[j] = ((y[j] - mean) * rstd * lg_[j] + lb_[j] + bon * v4[j]) * g[j];
        u32x2 ov; ov.x = pack2(o[0], o[1]); ov.y = pack2(o[2], o[3]);
        *(u32x2*)(Y + (size_t)t * 1024 + 768 + c) = ov;
    }
}

DEV int queue_next(int* ctr, char* smem) {
    int* slot = (int*)(smem + MOE_MAP_OFF + 208);
    __syncthreads();
    if (tidx() == 0) *slot = atomicAdd(ctr, 1);
    __syncthreads();
    return __builtin_amdgcn_readfirstlane(*slot);
}
DEV void phase_mixers(const Params& p, int l, int rep, char* smem) {
    const bool need_ctx = (l == 0);
#ifndef RWMODE
#define RWMODE 2
#endif
    const int nrw = RWMODE == 0 ? 64 : (RWMODE == 1 ? 256 + 64 : 256), nda = need_ctx ? 576 : 512, ns5 = 32 * (need_ctx ? 9 : 8);
    const int total = nrw + 2 * nda + (rep == 0 ? ns5 : 0);
    int* ctr = (int*)(p.ws + OFF_CTR) + CTR_Q + l * 16 + rep * 4;
    for (;;) {
        const int item = queue_next(ctr, smem);
        if (item >= total) break;
#ifndef PROBE7
#define PROBE7 0
#endif
        if (rep > 0 && PROBE7 == 1 && item >= nrw) break;
        if (rep > 0 && PROBE7 == 2 && item < nrw) continue;
        if (rep > 0 && PROBE7 == 3 && (item < nrw || item >= nrw + nda)) continue;
#if RWMODE == 2
        if (item < nrw) rw_item(p, l, item, smem, 0);
#elif RWMODE == 0
        if (item < nrw) rwc_item(p, l, item, smem);
#else
        if (item < nrw) { if (item < 256) rw_item(p, l, item, smem, 0); else rwc_item(p, l, item - 256, smem); }
#endif
        else if (item < nrw + nda) da_item(p, l, item - nrw, smem);
        else if (item < nrw + 2 * nda) mla_item(p, l, item - nrw - nda, smem);
        else s5_pass2_item(p, l, need_ctx ? 0 : 1, item - nrw - 2 * nda, smem);
    }
}
#ifndef MEGA
#define MEGA 0
#endif
constexpr int NPHASE = 15;
template <int PH>
DEV void run_phase(const Params& p, int l, char* smem) {
    const bool need_ctx = (l == 0);
    const int M = need_ctx ? TT : TL;
    if constexpr (PH == 0) { phase_mod_partial(p, smem); __syncthreads(); phase_conv_small(p, smem); phase_conv_layer(p, 0, smem); phase_conv_experts(p, 0, smem); }
    if constexpr (PH == 1) { phase_mod_reduce(p); }
    if constexpr (PH == 2) { phase_norm<1>(p, l, TT, smem); if (l == 1) { phase_conv_layer(p, 1, smem); phase_conv_experts(p, 1, smem); } }
    if constexpr (PH == 3) { phase_inproj(p, l, smem); }
    if constexpr (PH == 4) { phase_prep1(p, l); phase_s5_pass1(p, l, smem); }
    if constexpr (PH == 5) { phase_prep_gemm1(p, l, smem); }
    if constexpr (PH == 6) { phase_prep_gemm2(p, l, smem); phase_prep2(p, l); }
    if constexpr (PH == 7) { phase_mixers(p, l, 0, smem); }
    if constexpr (PH == 8) { phase_s5_glu(p, l, M, smem); phase_rw_finish(p, l, M); }
    if constexpr (PH == 9) { phase_merge(p, l, M, smem); }
    if constexpr (PH == 10) { phase_outproj(p, l, M, smem); }
    if constexpr (PH == 11) { phase_norm<2>(p, l, M, smem); }
    if constexpr (PH == 14) { phase_route(p, l, M, smem); }
    if constexpr (PH == 15) { phase_combine(p, l, M); }
    if constexpr (PH == 12) { phase_moe1(p, l, smem); }
    if constexpr (PH == 13) { phase_moe2(p, l, smem); }
}

#if !MEGA
template <int PH>
__global__ void __launch_bounds__(NT, 2) k_phase(Params p, int l) {
    extern __shared__ __attribute__((aligned(16))) char smem[];
    run_phase<PH>(p, l, smem);
}
#endif
#ifndef REP0
#define REP0 1
#endif
#ifndef REP2
#define REP2 1
#endif
#ifndef REP3
#define REP3 1
#endif
#ifndef REP5
#define REP5 1
#endif
#ifndef REP6
#define REP6 1
#endif
#ifndef REP7
#define REP7 1
#endif
#ifndef REP8
#define REP8 1
#endif
#ifndef REP9
#define REP9 1
#endif
#ifndef REP12
#define REP12 1
#endif
#if MEGA
__global__ void __launch_bounds__(NT, 2) k_mega(Params p) {
    extern __shared__ __attribute__((aligned(16))) char smem[];
    uint4* xbw = (uint4*)(smem + MOE_MAP_OFF + 240);
    if (threadIdx.x == 0) *xbw = make_uint4(0u, 0u, 0u, 0u);
    __syncthreads();
    XcdBarrier bar = xcd_barrier_post((unsigned*)(p.ws + OFF_BAR), (volatile LAS unsigned*)xbw);
    for (int r = 0; r < REP0; ++r) { run_phase<0>(p, 0, smem); xcd_barrier(bar); }
    run_phase<1>(p, 0, smem); xcd_barrier(bar);
    for (int l = 0; l < 2; ++l) {
        for (int r = 0; r < REP2; ++r) { run_phase<2>(p, l, smem); xcd_barrier(bar); }
        for (int r = 0; r < REP3; ++r) { run_phase<3>(p, l, smem); xcd_barrier(bar); }

        run_phase<4>(p, l, smem); xcd_barrier(bar);
#ifdef PROBE_S5P1
        phase_s5_pass1(p, l, smem); xcd_barrier(bar);
#endif
#ifdef PROBE_BAR
        for (int r = 0; r < PROBE_BAR; ++r) xcd_barrier(bar);
#endif
        for (int r = 0; r < REP5; ++r) { run_phase<5>(p, l, smem); xcd_barrier(bar); }
        for (int r = 0; r < REP6; ++r) { run_phase<6>(p, l, smem); xcd_barrier(bar); }
#ifdef RWC_PRE
        if (bidx() < 64) rwc_item(p, l, bidx(), smem);
#endif
        for (int r = 0; r < REP7; ++r) { phase_mixers(p, l, r, smem); xcd_barrier(bar); }
#ifdef RWC_SEP
        for (int item = bidx(); item < 64; item += gridDim.x) rwc_item(p, l, item, smem);
        xcd_barrier(bar);
#endif
        for (int r = 0; r < REP8; ++r) { run_phase<8>(p, l, smem); xcd_barrier(bar); }
        for (int r = 0; r < REP9; ++r) { run_phase<9>(p, l, smem); xcd_barrier(bar); }
        run_phase<10>(p, l, smem); xcd_barrier(bar);
#ifdef PROBE_OUT2
        if (l == 0) { run_phase<10>(p, l, smem); xcd_barrier(bar); }
#endif

        run_phase<11>(p, l, smem); xcd_barrier(bar);
        run_phase<14>(p, l, smem); xcd_barrier(bar);
        for (int r = 0; r < REP12; ++r) { run_phase<12>(p, l, smem); xcd_barrier(bar); }
        run_phase<13>(p, l, smem); xcd_barrier(bar);
#ifdef PROBE_MOE2B
        run_phase<13>(p, l, smem); xcd_barrier(bar);
#endif
        run_phase<15>(p, l, smem); if (l == 0) xcd_barrier(bar);
    }
}
#endif
__global__ void __launch_bounds__(NT) k_fail(float* out, int n) {
    for (int i = blockIdx.x * NT + threadIdx.x; i < n; i += gridDim.x * NT) out[i] = __int_as_float(0x7fc00000);
}

template <int PH>
static void launch_phase(const Params& p, int l, int grid, hipStream_t stream) {
#if !MEGA
    static bool attr = false;
    if (!attr) { (void)hipFuncSetAttribute((const void*)k_phase<PH>, hipFuncAttributeMaxDynamicSharedMemorySize, SMEM_BYTES); attr = true; }
    hipLaunchKernelGGL(k_phase<PH>, dim3(grid), dim3(NT), SMEM_BYTES, stream, p, l);
#endif
}

extern "C" void kernel_launch(void* const* d_in, const int* in_sizes, int n_in, void* d_out, int out_size, void* d_ws, size_t ws_size, hipStream_t stream) {
    if (n_in != 48 || out_size != TL * DM || ws_size < WS_END) {
        hipLaunchKernelGGL(k_fail, dim3(256), dim3(NT), 0, stream, (float*)d_out, out_size);
        return;
    }
    Params p{};
    for (int i = 0; i < 48; ++i) p.in[i] = (const float*)d_in[i];
    p.out = (float*)d_out; p.ws = (char*)d_ws;
    (void)hipMemsetAsync(d_ws, 0, ZERO_BYTES, stream);
#if MEGA
    static int grid = 0;
    if (grid == 0) {
        int dev = 0, cus = 0, per_cu = 0;
        (void)hipGetDevice(&dev);
        (void)hipDeviceGetAttribute(&cus, hipDeviceAttributeMultiprocessorCount, dev);
        (void)hipFuncSetAttribute((const void*)k_mega, hipFuncAttributeMaxDynamicSharedMemorySize, SMEM_BYTES);
        if (hipOccupancyMaxActiveBlocksPerMultiprocessor(&per_cu, (const void*)k_mega, NT, SMEM_BYTES) != hipSuccess || per_cu < 1) per_cu = 1;
        (void)hipGetLastError();
        if (cus <= 0) cus = 256;
        grid = cus * (per_cu < 2 ? per_cu : 2);
    }
    hipLaunchKernelGGL(k_mega, dim3(grid), dim3(NT), SMEM_BYTES, stream, p);
#else
    const int grid = 512;
    launch_phase<0>(p, 0, grid, stream);
    launch_phase<1>(p, 0, grid, stream);
    for (int l = 0; l < 2; ++l) {
        launch_phase<2>(p, l, grid, stream);
        launch_phase<3>(p, l, grid, stream);
        launch_phase<4>(p, l, grid, stream);
        launch_phase<5>(p, l, grid, stream);
        launch_phase<6>(p, l, grid, stream);
        launch_phase<7>(p, l, grid, stream);
        launch_phase<8>(p, l, grid, stream);
        launch_phase<9>(p, l, grid, stream);
        launch_phase<10>(p, l, grid, stream);
        launch_phase<11>(p, l, grid, stream);
        launch_phase<14>(p, l, grid, stream);
        launch_phase<12>(p, l, grid, stream);
        launch_phase<13>(p, l, grid, stream);
        launch_phase<15>(p, l, grid, stream);
    }
#endif
}
```

```cpp
#define MEGA 1
#include <hip/hip_runtime.h>
#include <stdint.h>
#include <math.h>

#define DEV __device__ __forceinline__
#define LAS __attribute__((address_space(3)))
typedef unsigned short bf16_t;
typedef short bf16x8 __attribute__((ext_vector_type(8)));
typedef float f32x16 __attribute__((ext_vector_type(16)));
typedef float f32x4 __attribute__((ext_vector_type(4)));
typedef unsigned u32x4 __attribute__((ext_vector_type(4)));
typedef unsigned u32x2 __attribute__((ext_vector_type(2)));

constexpr int NT = 256;
constexpr int DM = 1024, NB = 8, SEQ = 2048, CTXL = 256, GRIDW = 64;
constexpr int TL = NB * SEQ, TC = NB * CTXL, TT = TL + TC;
constexpr int NIN = 6480, LDP = 2432, NINP = 6528, NGATE0 = 2432;
constexpr int C_DAQ = 0, C_DAK = 256, C_DAV = 512, C_S5 = 768, C_CQ = 1024, C_CKV = 1216, C_KR = 1344,
              C_RWR = 1360, C_RWK = 1616, C_RWV = 1872, C_RWD = 2128, C_PEND = 2384;
constexpr int NEXP = 16, DFF = 512;
constexpr float EPS = 1e-6f;
constexpr float LOG2E = 1.4426950408889634f;

constexpr size_t al256(size_t x) { return (x + 255) & ~(size_t)255; }
constexpr size_t OFF_BAR  = 0;
constexpr size_t OFF_CTR  = 16384;
constexpr size_t ZERO_BYTES = 20480;
constexpr size_t OFF_MOD  = 32768;
constexpr size_t SZ_MOD   = (size_t)2 * 9 * 6144 * 4;
constexpr int    MOD_KS   = 8;
constexpr size_t OFF_MODP = al256(OFF_MOD + SZ_MOD);
constexpr size_t OFF_S5ST = al256(OFF_MODP + MOD_KS * SZ_MOD);
constexpr size_t OFF_LTOK = al256(OFF_S5ST + (size_t)2 * 8 * 16 * 8 * 64 * 2 * 4);
constexpr size_t OFF_LW   = al256(OFF_LTOK + (size_t)NEXP * TT * 4);
constexpr size_t OFF_TOKI = al256(OFF_LW + (size_t)NEXP * TT * 4);
constexpr size_t OFF_TOKW = al256(OFF_TOKI + (size_t)TT * 16);
constexpr size_t OFF_CNTB = al256(OFF_TOKW + (size_t)TT * 8);
constexpr size_t OFF_WSM  = al256(OFF_CNTB + (size_t)1024 * 16 * 4);
constexpr int WS_GLUT = 0, WS_UQT = WS_GLUT + 256 * 256, WS_UKVT = WS_UQT + 192 * 192, WS_W1C = WS_UKVT + 384 * 128,
              WS_W2 = WS_W1C + 192 * 256, WS_G2T = WS_W2 + 4 * 256 * 64, WS_PER_LAYER = WS_G2T + 256 * 64;
constexpr size_t OFF_WIN  = al256(OFF_WSM + (size_t)2 * WS_PER_LAYER * 2);
constexpr size_t OFF_WBR  = al256(OFF_WIN + (size_t)NINP * 1024 * 2);
constexpr size_t OFF_WOUT = al256(OFF_WBR + (size_t)4 * 1024 * 256 * 2);
constexpr size_t OFF_WG1  = al256(OFF_WOUT + (size_t)1024 * 1024 * 2);
constexpr size_t OFF_WDN  = al256(OFF_WG1 + (size_t)NEXP * 1024 * 1024 * 2);
constexpr size_t OFF_H    = al256(OFF_WDN + (size_t)NEXP * 1024 * 512 * 2);
constexpr size_t OFF_P    = al256(OFF_H + (size_t)TT * 1024 * 2);
constexpr size_t OFF_GATE = al256(OFF_P + (size_t)TT * LDP * 2);
constexpr size_t OFF_MLAQ = al256(OFF_GATE + (size_t)TT * 4096);
constexpr size_t OFF_MLAK = al256(OFF_MLAQ + (size_t)TT * 192 * 2);
constexpr size_t OFF_MLAV = al256(OFF_MLAK + (size_t)TT * 192 * 2);
constexpr size_t OFF_RWX  = al256(OFF_MLAV + (size_t)TT * 256 * 2);
constexpr size_t OFF_Y    = al256(OFF_RWX + (size_t)TT * 1024 * 2);
constexpr size_t OFF_CX   = al256(OFF_Y + (size_t)TT * 1024 * 2);
constexpr size_t OFF_S5Y  = al256(OFF_CX + (size_t)TC * 1024 * 4);
constexpr size_t WS_END   = al256(OFF_S5Y + (size_t)TT * 256 * 2);
constexpr size_t OFF_QRAW = OFF_Y;
constexpr size_t OFF_KVRAW = OFF_QRAW + (size_t)TT * 192 * 2;
constexpr size_t OFF_LR   = OFF_KVRAW + (size_t)TT * 384 * 2;
constexpr size_t OFF_XL   = OFF_LR + (size_t)TT * 192 * 2;
constexpr size_t OFF_Z    = OFF_GATE;
static_assert(OFF_XL + (size_t)TT * 256 * 2 <= OFF_Y + (size_t)TT * 1024 * 2, "temps overflow Y");
constexpr size_t OFF_RWY  = OFF_H;

constexpr int CTR_MOE = 0;
constexpr int CTR_Q   = 64;

constexpr int SMEM_BYTES = 73728 + 256;

struct Params {
    const float* in[48];
    float* out;
    char* ws;
};
enum { I_X = 0, I_C, I_CTX, I_CCTX, I_WADA, I_BADA, I_NMG, I_NFG, I_WIN, I_DAQKG, I_DALAM, I_DASUB,
       I_S5LRE, I_S5LIM, I_S5LDT, I_S5BRE, I_S5BIM, I_S5CRE, I_S5CIM, I_S5D, I_S5WGLU, I_S5BGLU,
       I_MCQG, I_MCKVG, I_MWUQ, I_MWUKV, I_MQKG,
       I_RMU, I_RW0, I_RW1, I_RW2, I_RA0, I_RA1, I_RA2, I_RG1, I_RG2, I_RKK, I_RKA, I_RRK, I_RLNG, I_RLNB,
       I_WBR, I_WOUT, I_ROUTW, I_ROUTB, I_EWG, I_EWU, I_EWD };

DEV int tidx() { int t = threadIdx.x; asm volatile("" : "+v"(t)); return t; }
DEV int bidx() { int b = blockIdx.x; asm volatile("" : "+s"(b)); return b; }
typedef float f32x2_ __attribute__((ext_vector_type(2)));
typedef __bf16 bf16x2_ __attribute__((ext_vector_type(2)));
DEV unsigned cvt_pk_bf16(float lo, float hi) { const f32x2_ v = {lo, hi}; const bf16x2_ b = __builtin_convertvector(v, bf16x2_); return __builtin_bit_cast(unsigned, b); }
DEV bf16_t f2bf(float f) { return (bf16_t)(cvt_pk_bf16(f, 0.f) & 0xFFFFu); }
DEV float bf2f(bf16_t h) { return __uint_as_float(((unsigned)h) << 16); }
DEV unsigned pack2(float lo, float hi) { return cvt_pk_bf16(lo, hi); }
DEV float bflo(unsigned u) { return __uint_as_float(u << 16); }
DEV float bfhi(unsigned u) { return __uint_as_float(u & 0xFFFF0000u); }
DEV float sigmoidf_(float x) { return 1.f / (1.f + __expf(-x)); }
DEV float wave_sum(float v) {
#pragma unroll
    for (int o = 32; o >= 1; o >>= 1) v += __shfl_xor(v, o, 64);
    return v;
}
template <int W> DEV float group_sum(float v) {
#pragma unroll
    for (int o = W / 2; o >= 1; o >>= 1) v += __shfl_xor(v, o, 64);
    return v;
}
DEV int mod_row(int t) { return t < TL ? (t >> 11) : 8; }
DEV bf16_t* wsb(const Params& p, size_t off) { return (bf16_t*)(p.ws + off); }
DEV float* wsf(const Params& p, size_t off) { return (float*)(p.ws + off); }
DEV const float* modp(const Params& p, int l, int row, int which) { return (const float*)(p.ws + OFF_MOD) + ((size_t)(l * 9 + row) * 6 + which) * 1024; }
#define XB_TMO      128
#define XB_XCNT(j)  (256  + 64 * (j))
#define XB_XSUB(j)  (1280 + 64 * (j))
#define XB_XGEN(j)  (2304 + 64 * (j))
#define XB_TOP      3328
#define XB_TOPGEN   3392
#define XCD_BAR_WORDS 3456
#define XB_SPIN_CAP (1u << 18)

__device__ __forceinline__ unsigned xb_ld(unsigned* p)              { return __hip_atomic_load(p, __ATOMIC_RELAXED, __HIP_MEMORY_SCOPE_AGENT); }
__device__ __forceinline__ unsigned xb_add(unsigned* p, unsigned v) { return __hip_atomic_fetch_add(p, v, __ATOMIC_RELAXED, __HIP_MEMORY_SCOPE_AGENT); }
__device__ __forceinline__ unsigned xb_xcc_id() { return (unsigned)__builtin_amdgcn_s_getreg((3 << 11) | 20) & 0xFu; }
#define XB_SPIN(cond, bar) do { unsigned _sp = 0; while (cond) { __builtin_amdgcn_s_sleep(1); \
    if ((++_sp & 255u) == 0u) { if (xb_ld(&(bar)[XB_TMO])) break; if (_sp > XB_SPIN_CAP) { atomicAdd(&(bar)[XB_TMO], 1u); break; } } } } while (0)

struct XcdBarrier {
    unsigned* bar; unsigned x;
    volatile LAS unsigned* st;
};

__device__ __forceinline__ XcdBarrier xcd_barrier_post(unsigned* bar, volatile LAS unsigned* st) {
    XcdBarrier b; b.bar = bar; b.x = xb_xcc_id(); b.st = st;
    if (threadIdx.x == 0) (void)xb_add(&bar[XB_XCNT(b.x)], 1u);
    return b;
}
__device__ __forceinline__ void xcd_barrier_complete(unsigned* bar, unsigned x, unsigned& nloc, unsigned& nx) {
    const unsigned G = gridDim.x * gridDim.y * gridDim.z;
    unsigned sum, cnt, mine, sp = 0u;
    for (;;) {
        sum = 0u; cnt = 0u; mine = 0u;
#pragma unroll
        for (unsigned j = 0; j < 16; ++j) { const unsigned c = xb_ld(&bar[XB_XCNT(j)]); sum += c; cnt += (c > 0u) ? 1u : 0u; mine = (j == x) ? c : mine; }
        if (sum == G) break;
        __builtin_amdgcn_s_sleep(1);
        if ((++sp & 255u) == 0u) { if (xb_ld(&bar[XB_TMO])) break; if (sp > XB_SPIN_CAP) { atomicAdd(&bar[XB_TMO], 1u); break; } }
    }
    nloc = mine > 0u ? mine : 1u; nx = cnt > 0u ? cnt : 1u;
}

__device__ __forceinline__ void xcd_barrier(const XcdBarrier& b) {
    asm volatile("s_waitcnt vmcnt(0)" ::: "memory");
    __syncthreads();
    if (threadIdx.x == 0) {
        unsigned* bar = b.bar;
        __builtin_amdgcn_s_waitcnt(0);
        unsigned nloc = b.st[0], nx = b.st[1];
        if (nloc == 0u) { xcd_barrier_complete(bar, b.x, nloc, nx); b.st[0] = nloc; b.st[1] = nx; }
        const unsigned old = xb_add(&bar[XB_XSUB(b.x)], 1u);
        const unsigned gen = old / nloc;
        if (old + 1u == (gen + 1u) * nloc) {
            __builtin_amdgcn_fence(__ATOMIC_RELEASE, "agent");
            asm volatile("s_waitcnt vmcnt(0)" ::: "memory");
            const unsigned og = xb_add(&bar[XB_TOP], 1u);
            const unsigned tg = og / nx;
            if (og + 1u == (tg + 1u) * nx) xb_add(&bar[XB_TOPGEN], 1u);
            else XB_SPIN(xb_ld(&bar[XB_TOPGEN]) == tg, bar);
            __builtin_amdgcn_fence(__ATOMIC_ACQUIRE, "agent");
            xb_add(&bar[XB_XGEN(b.x)], 1u);
            asm volatile("s_waitcnt vmcnt(0)" ::: "memory");
        } else {
            XB_SPIN(xb_ld(&bar[XB_XGEN(b.x)]) == gen, bar);
            __builtin_amdgcn_fence(__ATOMIC_ACQUIRE, "agent");
            asm volatile("s_waitcnt vmcnt(0)" ::: "memory");
        }
    }
    __syncthreads();
}

DEV void phase_mod_partial(const Params& p, char* smem) {
    float* sm = (float*)smem;
    const int tid = tidx();
    const int nitems = 2 * 24 * MOD_KS;
    for (int item = bidx(); item < nitems; item += gridDim.x) {
        const int l = item / (24 * MOD_KS), rem = item % (24 * MOD_KS), jc = rem / MOD_KS, ks = rem % MOD_KS;
        __syncthreads();
        for (int i = tid; i < 9 * 128; i += NT) {
            const int r = i >> 7, k = ks * 128 + (i & 127);
            const float cv = r < 8 ? p.in[I_C][r * 1024 + k] : p.in[I_CCTX][k];
            sm[i] = cv / (1.f + __expf(-cv));
        }
        __syncthreads();
        const int j = jc * 256 + tid;
        float acc[9];
#pragma unroll
        for (int r = 0; r < 9; ++r) acc[r] = 0.f;
        const float* w = p.in[I_WADA] + (size_t)l * 1024 * 6144 + (size_t)(ks * 128) * 6144 + j;
#pragma unroll 8
        for (int k = 0; k < 128; ++k) {
            const float wv = w[(size_t)k * 6144];
#pragma unroll
            for (int r = 0; r < 9; ++r) acc[r] += sm[r * 128 + k] * wv;
        }
        float* dst = wsf(p, OFF_MODP);
#pragma unroll
        for (int r = 0; r < 9; ++r) dst[((size_t)(ks * 2 + l) * 9 + r) * 6144 + j] = acc[r];
    }
}
DEV void phase_mod_reduce(const Params& p) {
    const int n = 2 * 9 * 6144;
    float* mod = wsf(p, OFF_MOD);
    const float* part = wsf(p, OFF_MODP);
    for (int i = bidx() * NT + tidx(); i < n; i += gridDim.x * NT) {
        const int l = i / (9 * 6144), j = i % 6144;
        float s = p.in[I_BADA][l * 6144 + j];
#pragma unroll
        for (int ks = 0; ks < MOD_KS; ++ks) s += part[(size_t)ks * n + i];
        mod[i] = s;
    }
}

struct ConvRegs { float4 v[4]; };
DEV void conv_load(const float* src, int R, int C, int ld, int tr, int tc, ConvRegs& cr) {
    const int r0 = tr * 64, c0 = tc * 64, tid = tidx();
#pragma unroll
    for (int k = 0; k < 4; ++k) {
        const int i = tid + k * NT, r = i >> 4, c4 = (i & 15) * 4;
        float4 v = make_float4(0.f, 0.f, 0.f, 0.f);
        if (r0 + r < R) {
            const float* s = src + (size_t)(r0 + r) * ld + c0 + c4;
            if (c0 + c4 + 3 < C) v = *(const float4*)s;
            else { if (c0 + c4 < C) v.x = s[0]; if (c0 + c4 + 1 < C) v.y = s[1]; if (c0 + c4 + 2 < C) v.z = s[2]; }
        }
        cr.v[k] = v;
    }
}
template <int MODE>
DEV void conv_store(const ConvRegs& cr, int R, int C, bf16_t* dst, int ldd, int roff, int tr, int tc, float* sm) {
    const int r0 = tr * 64, c0 = tc * 64, tid = tidx();
    __syncthreads();
#pragma unroll
    for (int k = 0; k < 4; ++k) {
        const int i = tid + k * NT, r = i >> 4, c4 = (i & 15) * 4;
        float* d = sm + r * 65 + c4;
        d[0] = cr.v[k].x; d[1] = cr.v[k].y; d[2] = cr.v[k].z; d[3] = cr.v[k].w;
    }
    __syncthreads();
    for (int i = tid; i < 64 * 8; i += NT) {
        const int c = i >> 3, r8 = (i & 7) * 8;
        if (c0 + c < C && r0 + r8 < R) {
            const int cc = c0 + c;
            const int drow = (MODE == 0) ? (cc + roff) : ((cc >> 5) * 64 + (cc & 31) + roff);
            u32x4 o;
            o[0] = pack2(sm[(r8 + 0) * 65 + c], sm[(r8 + 1) * 65 + c]);
            o[1] = pack2(sm[(r8 + 2) * 65 + c], sm[(r8 + 3) * 65 + c]);
            o[2] = pack2(sm[(r8 + 4) * 65 + c], sm[(r8 + 5) * 65 + c]);
            o[3] = pack2(sm[(r8 + 6) * 65 + c], sm[(r8 + 7) * 65 + c]);
            *(u32x4*)(dst + (size_t)drow * ldd + r0 + r8) = o;
        }
    }
}
template <int MODE>
DEV void conv_job(const float* src, int R, int C, int ld, bf16_t* dst, int ldd, int roff, int& rot, float* sm) {
    const int ntr = (R + 63) >> 6, ntc = (C + 63) >> 6, nt = ntr * ntc, G = gridDim.x;
    const int first = (bidx() - (rot % G) + G) % G;
    ConvRegs cur;
    if (first < nt) conv_load(src, R, C, ld, first / ntc, first % ntc, cur);
    for (int t = first; t < nt; t += G) {
        ConvRegs nxt = cur;
        if (t + G < nt) conv_load(src, R, C, ld, (t + G) / ntc, (t + G) % ntc, nxt);
        conv_store<MODE>(cur, R, C, dst, ldd, roff, t / ntc, t % ntc, sm);
        cur = nxt;
    }
    rot += nt;
}
DEV void phase_conv_layer(const Params& p, int l, char* smem) {
    float* sm = (float*)smem;
    int rot = 0;
    const float* win = p.in[I_WIN] + (size_t)l * 1024 * NIN;
    conv_job<0>(win, 1024, C_PEND, NIN, wsb(p, OFF_WIN), 1024, 0, rot, sm);
    conv_job<0>(win + C_PEND, 1024, 4096, NIN, wsb(p, OFF_WIN), 1024, NGATE0, rot, sm);
    {
        uint4* z = (uint4*)(wsb(p, OFF_WIN) + (size_t)C_PEND * 1024);
        const int n = (NGATE0 - C_PEND) * 1024 / 8;
        for (int i = bidx() * NT + tidx(); i < n; i += gridDim.x * NT) z[i] = make_uint4(0u, 0u, 0u, 0u);
    }
    for (int i = 0; i < 4; ++i)
        conv_job<0>(p.in[I_WBR] + (size_t)(l * 4 + i) * 256 * 1024, 256, 1024, 1024, wsb(p, OFF_WBR) + (size_t)i * 1024 * 256, 256, 0, rot, sm);
    conv_job<0>(p.in[I_WOUT] + (size_t)l * 1024 * 1024, 1024, 1024, 1024, wsb(p, OFF_WOUT), 1024, 0, rot, sm);
}
DEV void phase_conv_experts(const Params& p, int l, char* smem) {
    float* sm = (float*)smem;
    int rot = 0;
    for (int e = 0; e < NEXP; ++e) {
        conv_job<1>(p.in[I_EWG] + (size_t)(l * NEXP + e) * 1024 * DFF, 1024, DFF, DFF, wsb(p, OFF_WG1) + (size_t)e * 1024 * 1024, 1024, 0, rot, sm);
        conv_job<1>(p.in[I_EWU] + (size_t)(l * NEXP + e) * 1024 * DFF, 1024, DFF, DFF, wsb(p, OFF_WG1) + (size_t)e * 1024 * 1024, 1024, 32, rot, sm);
        conv_job<0>(p.in[I_EWD] + (size_t)(l * NEXP + e) * DFF * 1024, DFF, 1024, 1024, wsb(p, OFF_WDN) + (size_t)e * 1024 * DFF, DFF, 0, rot, sm);
    }
}
DEV void phase_conv_small(const Params& p, char* smem) {
    float* sm = (float*)smem;
    int rot = 0;
    for (int l = 0; l < 2; ++l) {
        bf16_t* w = wsb(p, OFF_WSM) + (size_t)l * WS_PER_LAYER;
        for (int i = bidx() * NT + tidx(); i < 4 * 256 * 4; i += gridDim.x * NT)
            *(u32x4*)(w + WS_W2 + (size_t)(i >> 2) * 64 + 32 + (i & 3) * 8) = (u32x4){0u, 0u, 0u, 0u};
        conv_job<0>(p.in[I_S5WGLU] + (size_t)l * 256 * 256, 256, 256, 256, w + WS_GLUT, 256, 0, rot, sm);
        conv_job<0>(p.in[I_MWUQ] + (size_t)l * 192 * 192, 192, 192, 192, w + WS_UQT, 192, 0, rot, sm);
        conv_job<0>(p.in[I_MWUKV] + (size_t)l * 128 * 384, 128, 384, 384, w + WS_UKVT, 128, 0, rot, sm);
        for (int d = 0; d < 2; ++d) {
            conv_job<0>(p.in[I_RW1] + (size_t)(l * 2 + d) * 256 * 32, 256, 32, 32, w + WS_W1C, 256, d * 32, rot, sm);
            conv_job<0>(p.in[I_RA1] + (size_t)(l * 2 + d) * 256 * 32, 256, 32, 32, w + WS_W1C, 256, 64 + d * 32, rot, sm);
            conv_job<0>(p.in[I_RW2] + (size_t)(l * 2 + d) * 32 * 256, 32, 256, 256, w + WS_W2 + (size_t)d * 256 * 64, 64, 0, rot, sm);
            conv_job<0>(p.in[I_RA2] + (size_t)(l * 2 + d) * 32 * 256, 32, 256, 256, w + WS_W2 + (size_t)(2 + d) * 256 * 64, 64, 0, rot, sm);
        }
        conv_job<0>(p.in[I_RG1] + (size_t)l * 256 * 64, 256, 64, 64, w + WS_W1C, 256, 128, rot, sm);
        conv_job<0>(p.in[I_RG2] + (size_t)l * 64 * 256, 64, 256, 256, w + WS_G2T, 64, 0, rot, sm);
    }
}

template <int WHICH>
DEV void phase_norm(const Params& p, int l, int nrows, char* smem) {
    const int lane = tidx() & 63, wave = tidx() >> 6;
    const float* xs = (l == 0) ? p.in[I_X] : p.out;
    const float* cs = (l == 0) ? p.in[I_CTX] : wsf(p, OFF_CX);
    const float* g = p.in[WHICH == 1 ? I_NMG : I_NFG] + l * 1024;
    bf16_t* H = wsb(p, OFF_H);
    if (WHICH == 2) { xs = p.out; cs = wsf(p, OFF_CX); }
    const int tpb = (nrows + (int)gridDim.x - 1) / (int)gridDim.x;
    const int rbeg = WHICH == 2 ? bidx() * tpb + wave : bidx() * 4 + wave;
    const int rend = WHICH == 2 ? min(nrows, (bidx() + 1) * tpb) : nrows;
    const int rstep = WHICH == 2 ? 4 : (int)gridDim.x * 4;
    int* sel = (int*)smem;
    for (int row = rbeg; row < rend; row += rstep) {
        const float* src = row < TL ? xs + (size_t)row * 1024 : cs + (size_t)(row - TL) * 1024;
        const int mr = mod_row(row);
        const float* sh = modp(p, l, mr, WHICH == 1 ? 0 : 3);
        const float* sc = modp(p, l, mr, WHICH == 1 ? 1 : 4);
        float4 v[4];
        float ss = 0.f;
#pragma unroll
        for (int i = 0; i < 4; ++i) {
            v[i] = *(const float4*)(src + lane * 4 + i * 256);
            ss += v[i].x * v[i].x + v[i].y * v[i].y + v[i].z * v[i].z + v[i].w * v[i].w;
        }
        ss = wave_sum(ss);
        const float rstd = rsqrtf(ss * (1.f / 1024.f) + EPS);
        float hv[16];
#pragma unroll
        for (int i = 0; i < 4; ++i) {
            const int c = lane * 4 + i * 256;
            const float4 gg = *(const float4*)(g + c), s4 = *(const float4*)(sh + c), c4 = *(const float4*)(sc + c);
            hv[i * 4 + 0] = v[i].x * rstd * gg.x * (1.f + c4.x) + s4.x;
            hv[i * 4 + 1] = v[i].y * rstd * gg.y * (1.f + c4.y) + s4.y;
            hv[i * 4 + 2] = v[i].z * rstd * gg.z * (1.f + c4.z) + s4.z;
            hv[i * 4 + 3] = v[i].w * rstd * gg.w * (1.f + c4.w) + s4.w;
            u32x2 o; o.x = pack2(hv[i * 4 + 0], hv[i * 4 + 1]); o.y = pack2(hv[i * 4 + 2], hv[i * 4 + 3]);
            *(u32x2*)(H + (size_t)row * 1024 + c) = o;
        }
        if (WHICH == 2) {
            float lg[16];
#pragma unroll
            for (int e = 0; e < 16; ++e) lg[e] = 0.f;
            const float* rw = p.in[I_ROUTW];
#pragma unroll
            for (int i = 0; i < 4; ++i)
#pragma unroll
                for (int j = 0; j < 4; ++j) {
                    const int c = lane * 4 + i * 256 + j;
                    const float hvv = hv[i * 4 + j];
#pragma unroll
                    for (int q = 0; q < 4; ++q) {
                        const float4 w4 = *(const float4*)(rw + (size_t)c * 16 + q * 4);
                        lg[q * 4 + 0] += hvv * w4.x; lg[q * 4 + 1] += hvv * w4.y; lg[q * 4 + 2] += hvv * w4.z; lg[q * 4 + 3] += hvv * w4.w;
                    }
                }
#pragma unroll
            for (int e = 0; e < 16; ++e) lg[e] = wave_sum(lg[e]);
            float sc16[16], bs[16];
#pragma unroll
            for (int e = 0; e < 16; ++e) { sc16[e] = sigmoidf_(lg[e]); bs[e] = sc16[e] + p.in[I_ROUTB][e]; }
            int bestg = 0; float bestv = -INFINITY;
#pragma unroll
            for (int gi = 0; gi < 4; ++gi) {
                float m1 = -INFINITY, m2 = -INFINITY;
#pragma unroll
                for (int k = 0; k < 4; ++k) { const float x = bs[gi * 4 + k]; if (x > m1) { m2 = m1; m1 = x; } else if (x > m2) m2 = x; }
                const float gs = m1 + m2;
                if (gs > bestv) { bestv = gs; bestg = gi; }
            }
            int i0 = 0, i1 = 0; float v0 = -INFINITY, v1 = -INFINITY, s0 = 0.f, s1 = 0.f;
#pragma unroll
            for (int e = 0; e < 16; ++e) { const bool in = (e >> 2) == bestg; if (in && bs[e] > v0) { v0 = bs[e]; i0 = e; s0 = sc16[e]; } }
#pragma unroll
            for (int e = 0; e < 16; ++e) { const bool in = (e >> 2) == bestg && e != i0; if (in && bs[e] > v1) { v1 = bs[e]; i1 = e; s1 = sc16[e]; } }
            const float inv = 1.f / (s0 + s1);
            if (lane == 0) {
                const int lt = row - bidx() * tpb;
                sel[lt * 2 + 0] = i0; sel[lt * 2 + 1] = i1;
                float* tw = (float*)(p.ws + OFF_TOKW) + (size_t)row * 2;
                tw[0] = s0 * inv; tw[1] = s1 * inv;
            }
        }
    }
    if (WHICH == 2) {
        __syncthreads();
        const int t0 = bidx() * tpb, nt = max(0, min(nrows, t0 + tpb) - t0);
        int* rank = sel + 2 * tpb;
        if (tidx() < 16) {
            const int e = tidx(); int c = 0;
            for (int i = 0; i < 2 * nt; ++i) if (sel[i] == e) { rank[i] = c; ++c; }
            ((int*)(p.ws + OFF_CNTB))[(size_t)bidx() * 16 + e] = c;
        }
        __syncthreads();
        int* toki = (int*)(p.ws + OFF_TOKI);
        for (int i = tidx(); i < nt; i += NT) {
            int4 r; r.x = sel[2 * i]; r.y = sel[2 * i + 1]; r.z = rank[2 * i]; r.w = rank[2 * i + 1];
            *(int4*)(toki + (size_t)(t0 + i) * 4) = r;
        }
        __syncthreads();
    }
}
DEV void phase_route(const Params& p, int l, int nrows, char* smem) {
    int* sm = (int*)smem;
    const int tid = tidx(), e = tid & 15, part = tid >> 4, G = gridDim.x, b = bidx();
    const int* cntb = (const int*)(p.ws + OFF_CNTB);
    int pre = 0, tot = 0;
    for (int bb = part; bb < G; bb += 16) { const int c = cntb[(size_t)bb * 16 + e]; tot += c; if (bb < b) pre += c; }
    __syncthreads();
    sm[part * 16 + e] = pre; sm[256 + part * 16 + e] = tot;
    __syncthreads();
    if (tid < 16) {
        int a = 0, t = 0;
        for (int q = 0; q < 16; ++q) { a += sm[q * 16 + tid]; t += sm[256 + q * 16 + tid]; }
        sm[512 + tid] = a; sm[528 + tid] = t;
    }
    __syncthreads();
    if (tid == 0) {
        int a = 0;
        for (int q = 0; q < 16; ++q) { sm[544 + q] = a; a += sm[528 + q]; }
    }
    __syncthreads();
    if (b == 0 && tid < 16) ((int*)(p.ws + OFF_CTR))[CTR_MOE + l * 16 + tid] = sm[528 + tid];
    const int tpb = (nrows + G - 1) / G, t0 = b * tpb, nt = max(0, min(nrows, t0 + tpb) - t0);
    int* toki = (int*)(p.ws + OFF_TOKI);
    const float* tokw = (const float*)(p.ws + OFF_TOKW);
    int* ltok = (int*)(p.ws + OFF_LTOK);
    float* lw = (float*)(p.ws + OFF_LW);
    for (int i = tid; i < 2 * nt; i += NT) {
        const int t = t0 + (i >> 1), j = i & 1;
        const int ee = toki[(size_t)t * 4 + j], rk = toki[(size_t)t * 4 + 2 + j];
        const int pos = sm[512 + ee] + rk;
        ltok[(size_t)ee * TT + pos] = t;
        lw[(size_t)ee * TT + pos] = tokw[(size_t)t * 2 + j];
        toki[(size_t)t * 4 + 2 + j] = sm[544 + ee] + pos;
    }
}
DEV void phase_combine(const Params& p, int l, int nrows) {
    const int lane = tidx() & 63, wave = tidx() >> 6;
    const bf16_t* Z = wsb(p, OFF_Z);
    const int* toki = (const int*)(p.ws + OFF_TOKI);
    const float* tokw = (const float*)(p.ws + OFF_TOKW);
    for (int row = bidx() * 4 + wave; row < nrows; row += gridDim.x * 4) {
        float* dst = row < TL ? p.out + (size_t)row * 1024 : wsf(p, OFF_CX) + (size_t)(row - TL) * 1024;
        const float* g2 = modp(p, l, mod_row(row), 5);
        const int r0 = toki[(size_t)row * 4 + 2], r1 = toki[(size_t)row * 4 + 3];
        const float w0 = tokw[(size_t)row * 2], w1 = tokw[(size_t)row * 2 + 1];
#pragma unroll
        for (int i = 0; i < 4; ++i) {
            const int c = lane * 4 + i * 256;
            const u32x2 a = *(const u32x2*)(Z + (size_t)r0 * 1024 + c), b = *(const u32x2*)(Z + (size_t)r1 * 1024 + c);
            const float4 gg = *(const float4*)(g2 + c);
            float4 x = *(float4*)(dst + c);
            x.x += gg.x * (w0 * bflo(a.x) + w1 * bflo(b.x));
            x.y += gg.y * (w0 * bfhi(a.x) + w1 * bfhi(b.x));
            x.z += gg.z * (w0 * bflo(a.y) + w1 * bflo(b.y));
            x.w += gg.w * (w0 * bfhi(a.y) + w1 * bfhi(b.y));
            *(float4*)(dst + c) = x;
        }
    }
}
constexpr int GLD = 72;
constexpr int GSTAGE = 128 * GLD;
template <bool DEEP = true, int TN = 2, class AF, class BF>
DEV void gemm_mainloop(f32x16 (&acc)[2][TN], AF arow, BF brow, int K, bf16_t* sm) {
    const int tid = tidx(), lane = tid & 63, wave = tid >> 6, wm = wave >> 1, wn = wave & 1;
    bf16_t* As = sm;
    bf16_t* Bs = sm + 2 * GSTAGE;
    constexpr int NB = 2 * TN;
    const bf16_t* ap[4]; const bf16_t* bp[NB];
#pragma unroll
    for (int i = 0; i < 4; ++i) { const int q = tid + i * NT; ap[i] = arow(q >> 3) + (q & 7) * 8; }
#pragma unroll
    for (int i = 0; i < NB; ++i) { const int q = tid + i * NT; bp[i] = brow(q >> 3) + (q & 7) * 8; }
    const int soff = (tid >> 3) * GLD + (tid & 7) * 8;
    u32x4 ra0[4], rb0[NB], ra1[4], rb1[NB];
    const int nk = K >> 6;
#pragma unroll
    for (int i = 0; i < 4; ++i) ra0[i] = *(const u32x4*)ap[i];
#pragma unroll
    for (int i = 0; i < NB; ++i) rb0[i] = *(const u32x4*)bp[i];
    if (DEEP && nk > 1) {
#pragma unroll
        for (int i = 0; i < 4; ++i) ra1[i] = *(const u32x4*)(ap[i] + 64);
#pragma unroll
        for (int i = 0; i < NB; ++i) rb1[i] = *(const u32x4*)(bp[i] + 64);
    }
    __syncthreads();
#pragma unroll
    for (int i = 0; i < 4; ++i) *(u32x4*)(As + soff + i * 32 * GLD) = ra0[i];
#pragma unroll
    for (int i = 0; i < NB; ++i) *(u32x4*)(Bs + soff + i * 32 * GLD) = rb0[i];
    __syncthreads();
    const int arow0 = (wm * 64 + (lane & 31)) * GLD + (lane >> 5) * 8;
    const int brow0 = (wn * 32 * TN + (lane & 31)) * GLD + (lane >> 5) * 8;
    auto compute = [&](int cur) {
        const bf16_t* a_s = As + cur * GSTAGE + arow0;
        const bf16_t* b_s = Bs + cur * GSTAGE + brow0;
#pragma unroll
        for (int ks = 0; ks < 4; ++ks) {
            const bf16x8 a0 = *(const bf16x8*)(a_s + ks * 16);
            const bf16x8 a1 = *(const bf16x8*)(a_s + 32 * GLD + ks * 16);
#pragma unroll
            for (int j = 0; j < TN; ++j) {
                const bf16x8 bj = *(const bf16x8*)(b_s + j * 32 * GLD + ks * 16);
                acc[0][j] = __builtin_amdgcn_mfma_f32_32x32x16_bf16(a0, bj, acc[0][j], 0, 0, 0);
                acc[1][j] = __builtin_amdgcn_mfma_f32_32x32x16_bf16(a1, bj, acc[1][j], 0, 0, 0);
            }
        }
    };
    auto gload = [&](u32x4 (&ra)[4], u32x4 (&rb)[NB], int kt) {
        const int k0 = kt * 64;
#pragma unroll
        for (int i = 0; i < 4; ++i) ra[i] = *(const u32x4*)(ap[i] + k0);
#pragma unroll
        for (int i = 0; i < NB; ++i) rb[i] = *(const u32x4*)(bp[i] + k0);
    };
    auto lstore = [&](const u32x4 (&ra)[4], const u32x4 (&rb)[NB], int st) {
#pragma unroll
        for (int i = 0; i < 4; ++i) *(u32x4*)(As + st * GSTAGE + soff + i * 32 * GLD) = ra[i];
#pragma unroll
        for (int i = 0; i < NB; ++i) *(u32x4*)(Bs + st * GSTAGE + soff + i * 32 * GLD) = rb[i];
    };
    for (int kt = 0; kt < nk; kt += 2) {
        if (!DEEP && kt + 1 < nk) gload(ra1, rb1, kt + 1);
        if (DEEP && kt + 2 < nk) gload(ra0, rb0, kt + 2);
        compute(0);
        if (kt + 1 < nk) lstore(ra1, rb1, 1);
        __syncthreads();
        if (kt + 1 >= nk) break;
        if (!DEEP && kt + 2 < nk) gload(ra0, rb0, kt + 2);
        if (DEEP && kt + 3 < nk) gload(ra1, rb1, kt + 3);
        compute(1);
        if (kt + 2 < nk) lstore(ra0, rb0, 0);
        __syncthreads();
    }
}
template <int TN>
DEV void acc_zero(f32x16 (&acc)[2][TN]) {
#pragma unroll
    for (int i = 0; i < 2; ++i)
#pragma unroll
        for (int j = 0; j < TN; ++j)
#pragma unroll
            for (int r = 0; r < 16; ++r) acc[i][j][r] = 0.f;
}
#define EPI_FOREACH(acc, ...)                                                                           \
    {                                                                                                    \
        const int _lane = tidx() & 63, _wave = tidx() >> 6, _wm = _wave >> 1, _wn = _wave & 1; \
        _Pragma("unroll") for (int _i = 0; _i < 2; ++_i)                                                 \
        _Pragma("unroll") for (int _j = 0; _j < 2; ++_j)                                                 \
        _Pragma("unroll") for (int _r = 0; _r < 16; ++_r) {                                              \
            const int er = _wm * 64 + _i * 32 + (_r & 3) + 8 * (_r >> 2) + 4 * (_lane >> 5);             \
            const int ec = _wn * 64 + _j * 32 + (_lane & 31);                                            \
            const float ev = acc[_i][_j][_r];                                                            \
            __VA_ARGS__                                                                                  \
        }                                                                                                \
    }

DEV void tile_mn(int item, int nMt, int nNt, int& mt, int& nt) {
    constexpr int GM = 16;
    const int per = GM * nNt, g = item / per, rem = item % per;
    const int m0 = g * GM, gsz = (nMt - m0) < GM ? (nMt - m0) : GM;
    mt = m0 + rem % gsz; nt = rem / gsz;
}

DEV void phase_inproj(const Params& p, int l, char* smem) {
    bf16_t* sm = (bf16_t*)smem;
    const bf16_t* H = wsb(p, OFF_H);
    const bf16_t* W = wsb(p, OFF_WIN);
    bf16_t* P = wsb(p, OFF_P);
    unsigned char* G = (unsigned char*)(p.ws + OFF_GATE);
    const int nMt = TT / 128, nNt = NINP / 128;
    for (int item = bidx(); item < nMt * nNt; item += gridDim.x) {
        int mt, nt; tile_mn(item, nMt, nNt, mt, nt);
        const int m0 = mt * 128, n0 = nt * 128;
        if (l == 1 && m0 >= TL && n0 >= NGATE0) continue;
        f32x16 acc[2][2]; acc_zero<2>(acc);
        gemm_mainloop(acc, [&](int r) { return H + (size_t)(m0 + r) * 1024; }, [&](int r) { return W + (size_t)(n0 + r) * 1024; }, 1024, sm);
        if (n0 < NGATE0) {
            EPI_FOREACH(acc, { const int col = n0 + ec; if (col < C_PEND) P[(size_t)(m0 + er) * LDP + col] = f2bf(ev); })
        } else {
            EPI_FOREACH(acc, { const int col = n0 + ec - NGATE0; const float s = sigmoidf_(ev); G[(size_t)(m0 + er) * 4096 + col] = (unsigned char)__float2int_rn(s * 255.f); })
        }
    }
}

template <class EF>
DEV void gemm_generic(const bf16_t* A, int lda, int M, const bf16_t* Bt, int ldb, int N, int K, EF ef, char* smem, int rot) {
    bf16_t* sm = (bf16_t*)smem;
    const int nMt = (M + 127) / 128, nNt = (N + 127) / 128, G = gridDim.x;
    const int first = (bidx() - (rot % G) + G) % G;
    for (int item = first; item < nMt * nNt; item += G) {
        const int mt = item / nNt, nt = item % nNt, m0 = mt * 128, n0 = nt * 128;
        f32x16 acc[2][2]; acc_zero<2>(acc);
        gemm_mainloop(acc, [&](int r) { int rr = m0 + r; rr = rr < M ? rr : M - 1; return A + (size_t)rr * lda; },
                      [&](int r) { int rr = n0 + r; rr = rr < N ? rr : N - 1; return Bt + (size_t)rr * ldb; }, K, sm);
        EPI_FOREACH(acc, { const int row = m0 + er, col = n0 + ec; if (row < M && col < N) ef(row, col, ev); })
    }
}

DEV void phase_merge(const Params& p, int l, int M, char* smem) {
    bf16_t* sm = (bf16_t*)smem;
    const bf16_t* Y = wsb(p, OFF_Y);
    const bf16_t* W = wsb(p, OFF_WBR);
    const unsigned char* G = (const unsigned char*)(p.ws + OFF_GATE);
    bf16_t* MG = wsb(p, OFF_H);
    bf16_t* As = sm;
    bf16_t* Bs = sm + 2 * GSTAGE;
    unsigned char* Gs = (unsigned char*)(sm + 2 * GSTAGE + 2 * 64 * GLD);
    const int tid = tidx(), lane = tid & 63, wave = tid >> 6, wm = wave >> 1, wn = wave & 1;
    const int soff = (tid >> 3) * GLD + (tid & 7) * 8;
    const int arow0 = (wm * 64 + (lane & 31)) * GLD + (lane >> 5) * 8;
    const int brow0 = (wn * 32 + (lane & 31)) * GLD + (lane >> 5) * 8;
    const int nMt = M / 128, nNt = 16;
    for (int item = bidx(); item < nMt * nNt; item += gridDim.x) {
        const int mt = item / nNt, nt = item % nNt, m0 = mt * 128, n0 = nt * 64;
        const bf16_t* ap[4]; const bf16_t* bp[2]; const unsigned char* gp[2];
#pragma unroll
        for (int i = 0; i < 4; ++i) { const int q = tid + i * NT; ap[i] = Y + (size_t)(m0 + (q >> 3)) * 1024 + (q & 7) * 8; }
#pragma unroll
        for (int i = 0; i < 2; ++i) { const int q = tid + i * NT; bp[i] = W + (size_t)(n0 + (q >> 3)) * 256 + (q & 7) * 8;
                                      gp[i] = G + (size_t)(m0 + (q >> 2)) * 4096 + n0 + (q & 3) * 16; }
        f32x16 tot[2], acc[2];
#pragma unroll
        for (int a = 0; a < 2; ++a)
#pragma unroll
            for (int r = 0; r < 16; ++r) { tot[a][r] = 0.f; acc[a][r] = 0.f; }
        u32x4 ra[4], rb[2], rg[2];
#pragma unroll
        for (int i = 0; i < 4; ++i) ra[i] = *(const u32x4*)ap[i];
#pragma unroll
        for (int i = 0; i < 2; ++i) rb[i] = *(const u32x4*)bp[i];
        __syncthreads();
#pragma unroll
        for (int i = 0; i < 4; ++i) *(u32x4*)(As + soff + i * 32 * GLD) = ra[i];
#pragma unroll
        for (int i = 0; i < 2; ++i) *(u32x4*)(Bs + soff + i * 32 * GLD) = rb[i];
        __syncthreads();
#pragma unroll
        for (int kt = 0; kt < 16; ++kt) {
            const int cur = kt & 1, seg = kt >> 2;
            if (kt + 1 < 16) {
                const int k1 = kt + 1;
#pragma unroll
                for (int i = 0; i < 4; ++i) ra[i] = *(const u32x4*)(ap[i] + k1 * 64);
#pragma unroll
                for (int i = 0; i < 2; ++i) rb[i] = *(const u32x4*)(bp[i] + (size_t)(k1 >> 2) * (1024 * 256) + (k1 & 3) * 64);
            }
            if ((kt & 3) == 0) {
#pragma unroll
                for (int i = 0; i < 2; ++i) rg[i] = *(const u32x4*)(gp[i] + seg * 1024);
            }
            const bf16_t* a_s = As + cur * GSTAGE + arow0;
            const bf16_t* b_s = Bs + cur * (64 * GLD) + brow0;
#pragma unroll
            for (int ks = 0; ks < 4; ++ks) {
                const bf16x8 a0 = *(const bf16x8*)(a_s + ks * 16), a1 = *(const bf16x8*)(a_s + 32 * GLD + ks * 16), b0 = *(const bf16x8*)(b_s + ks * 16);
                acc[0] = __builtin_amdgcn_mfma_f32_32x32x16_bf16(a0, b0, acc[0], 0, 0, 0);
                acc[1] = __builtin_amdgcn_mfma_f32_32x32x16_bf16(a1, b0, acc[1], 0, 0, 0);
            }
            if (kt + 1 < 16) {
                const int nx = cur ^ 1;
#pragma unroll
                for (int i = 0; i < 4; ++i) *(u32x4*)(As + nx * GSTAGE + soff + i * 32 * GLD) = ra[i];
#pragma unroll
                for (int i = 0; i < 2; ++i) *(u32x4*)(Bs + nx * (64 * GLD) + soff + i * 32 * GLD) = rb[i];
            }
            if ((kt & 3) == 3) {
#pragma unroll
                for (int i = 0; i < 2; ++i) { const int q = tid + i * NT; *(u32x4*)(Gs + (q >> 2) * 64 + (q & 3) * 16) = rg[i]; }
            }
            __syncthreads();
            if ((kt & 3) == 3) {
#pragma unroll
                for (int a = 0; a < 2; ++a)
#pragma unroll
                    for (int r = 0; r < 16; ++r) {
                        const int er = wm * 64 + a * 32 + (r & 3) + 8 * (r >> 2) + 4 * (lane >> 5), ec = wn * 32 + (lane & 31);
                        tot[a][r] += (float)Gs[er * 64 + ec] * (1.f / 255.f) * acc[a][r];
                        acc[a][r] = 0.f;
                    }
            }
        }
#pragma unroll
        for (int a = 0; a < 2; ++a)
#pragma unroll
            for (int r = 0; r < 16; ++r) {
                const int er = wm * 64 + a * 32 + (r & 3) + 8 * (r >> 2) + 4 * (lane >> 5), ec = wn * 32 + (lane & 31);
                MG[(size_t)(m0 + er) * 1024 + n0 + ec] = f2bf(tot[a][r]);
            }
    }
}

DEV void phase_outproj(const Params& p, int l, int M, char* smem) {
    bf16_t* sm = (bf16_t*)smem;
    const bf16_t* MG = wsb(p, OFF_H);
    const bf16_t* W = wsb(p, OFF_WOUT);
    const float* xs = (l == 0) ? p.in[I_X] : p.out;
    const float* cs = (l == 0) ? p.in[I_CTX] : wsf(p, OFF_CX);
    float* cxd = wsf(p, OFF_CX);
    float* outd = p.out;
    const int nMt = M / 128, nNt = 8;
    for (int item = bidx(); item < nMt * nNt; item += gridDim.x) {
        const int mt = item / nNt, nt = item % nNt, m0 = mt * 128, n0 = nt * 128;
        f32x16 acc[2][2]; acc_zero<2>(acc);
        gemm_mainloop(acc, [&](int r) { return MG + (size_t)(m0 + r) * 1024; }, [&](int r) { return W + (size_t)(n0 + r) * 1024; }, 1024, sm);
        const float* g1 = modp(p, l, mod_row(m0), 2);
        if (m0 < TL) {
            EPI_FOREACH(acc, { const size_t o = (size_t)(m0 + er) * 1024 + n0 + ec; outd[o] = xs[o] + g1[n0 + ec] * ev; })
        } else {
            EPI_FOREACH(acc, { const size_t o = (size_t)(m0 - TL + er) * 1024 + n0 + ec; cxd[o] = cs[o] + g1[n0 + ec] * ev; })
        }
    }
}

constexpr int MOE_MAP_OFF = 73728;
DEV void moe_map(const Params& p, int l, char* smem) {
    int* mm = (int*)(smem + MOE_MAP_OFF);
    __syncthreads();
    if (tidx() == 0) {
        const int* cnt = (const int*)(p.ws + OFF_CTR) + CTR_MOE + l * 16;
        int b = 0, t = 0;
        for (int e = 0; e < 16; ++e) { const int c = cnt[e]; mm[e] = c; mm[16 + e] = b; mm[32 + e] = t; b += c; t += (c + 127) >> 7; }
        mm[48] = t;
    }
    __syncthreads();
}
DEV void phase_moe1(const Params& p, int l, char* smem) {
    bf16_t* sm = (bf16_t*)smem;
    const bf16_t* F = wsb(p, OFF_H);
    const bf16_t* W = wsb(p, OFF_WG1);
    bf16_t* ACT = wsb(p, OFF_P);
    const int* ltok = (const int*)(p.ws + OFF_LTOK);
    moe_map(p, l, smem); const int* mm = (const int*)(smem + MOE_MAP_OFF);
    const int nNt = 8, total = mm[48] * nNt;
    for (int item = bidx(); item < total; item += gridDim.x) {
        const int mtg = item / nNt, nt = item % nNt;
        int e = 0;
        for (int q = 1; q < 16; ++q) if (mtg >= mm[32 + q]) e = q;
        const int m0 = (mtg - mm[32 + e]) * 128, n0 = nt * 128, ce = mm[e];
        const int* lt = ltok + (size_t)e * TT;
        f32x16 acc[2][2]; acc_zero<2>(acc);
        gemm_mainloop(acc, [&](int r) { int idx = m0 + r; idx = idx < ce ? idx : ce - 1; return F + (size_t)lt[idx] * 1024; },
                      [&](int r) { return W + ((size_t)e * 1024 + n0 + r) * 1024; }, 1024, sm);
        const int lane = tidx() & 63, wave = tidx() >> 6, wm = wave >> 1, wn = wave & 1;
        const int jcol = ((n0 >> 6) + wn) * 32 + (lane & 31);
#pragma unroll
        for (int a = 0; a < 2; ++a)
#pragma unroll
            for (int r = 0; r < 16; ++r) {
                const int idx = m0 + wm * 64 + a * 32 + (r & 3) + 8 * (r >> 2) + 4 * (lane >> 5);
                if (idx < ce) {
                    const float g = acc[a][0][r], u = acc[a][1][r];
                    ACT[(size_t)(mm[16 + e] + idx) * DFF + jcol] = f2bf(g * sigmoidf_(g) * u);
                }
            }
    }
}
DEV void phase_moe2(const Params& p, int l, char* smem) {
    bf16_t* sm = (bf16_t*)smem;
    const bf16_t* ACT = wsb(p, OFF_P);
    const bf16_t* W = wsb(p, OFF_WDN);
    bf16_t* Z = wsb(p, OFF_Z);
    moe_map(p, l, smem); const int* mm = (const int*)(smem + MOE_MAP_OFF);
    const int nNt = 8, total = mm[48] * nNt;
    for (int item = bidx(); item < total; item += gridDim.x) {
        const int mtg = item / nNt, nt = item % nNt;
        int e = 0;
        for (int q = 1; q < 16; ++q) if (mtg >= mm[32 + q]) e = q;
        const int m0 = (mtg - mm[32 + e]) * 128, n0 = nt * 128, ce = mm[e];
        f32x16 acc[2][2]; acc_zero<2>(acc);
        gemm_mainloop(acc, [&](int r) { int idx = m0 + r; idx = idx < ce ? idx : ce - 1; return ACT + (size_t)(mm[16 + e] + idx) * DFF; },
                      [&](int r) { return W + ((size_t)e * 1024 + n0 + r) * DFF; }, DFF, sm);
        bf16_t* zb = Z + (size_t)mm[16 + e] * 1024;
        EPI_FOREACH(acc, { const int idx = m0 + er; if (idx < ce) zb[(size_t)idx * 1024 + n0 + ec] = f2bf(ev); })
    }
}
DEV void tok_seq(int t, int& base, int& n, int& len) {
    if (t < TL) { base = t & ~(SEQ - 1); n = t & (SEQ - 1); len = SEQ; } else { const int u = t - TL; base = TL + (u & ~(CTXL - 1)); n = u & (CTXL - 1); len = CTXL; }
}
DEV void phase_prep1(const Params& p, int l) {
    const int lane = tidx() & 63, wave = tidx() >> 6;
    bf16_t* P = wsb(p, OFF_P);
    bf16_t* XL = wsb(p, OFF_XL);
    const float* qkg = p.in[I_DAQKG] + l * 64;
    const float* cqg = p.in[I_MCQG] + l * 192;
    const float* ckvg = p.in[I_MCKVG] + l * 128;
    const float* mu3 = p.in[I_RMU] + (l * 4 + 3) * 256;
    for (int t = bidx() * 4 + wave; t < TT; t += gridDim.x * 4) {
        bf16_t* row = P + (size_t)t * LDP;
        int base, n, len; tok_seq(t, base, n, len);
        {
            const int d0 = (lane & 7) * 4;
            float cs[4], sn[4];
            const bool rot = t < TL;
            if (rot) {
                const float fr = (float)(n >> 6), fc = (float)(n & 63);
#pragma unroll
                for (int j = 0; j < 4; ++j) {
                    const int i = (d0 + j) & 15;
                    const float inv = exp2f(-(float)(i & 7) * (13.287712379549449f / 8.f));
                    const float ang = (i < 8 ? fr : fc) * inv;
                    cs[j] = cosf(ang); sn[j] = sinf(ang);
                }
            }
#pragma unroll
            for (int which = 0; which < 2; ++which) {
                bf16_t* ptr = row + (which ? C_DAK : C_DAQ) + lane * 4;
                const u32x2 raw = *(const u32x2*)ptr;
                float v[4] = { bflo(raw.x), bfhi(raw.x), bflo(raw.y), bfhi(raw.y) };
                float ss = v[0] * v[0] + v[1] * v[1] + v[2] * v[2] + v[3] * v[3];
                ss = group_sum<8>(ss);
                const float rstd = rsqrtf(ss * (1.f / 32.f) + EPS);
                const float* g = qkg + which * 32 + d0;
#pragma unroll
                for (int j = 0; j < 4; ++j) v[j] = v[j] * rstd * g[j];
                if (rot) {
#pragma unroll
                    for (int j = 0; j < 4; ++j) {
                        const float o = __shfl_xor(v[j], 4, 64);
                        v[j] = (d0 < 16) ? (v[j] * cs[j] - o * sn[j]) : (v[j] * cs[j] + o * sn[j]);
                    }
                }
                if (which == 0) {
                    const float qs = 0.17677669529663687f * LOG2E;
#pragma unroll
                    for (int j = 0; j < 4; ++j) v[j] *= qs;
                }
                u32x2 o; o.x = pack2(v[0], v[1]); o.y = pack2(v[2], v[3]);
                *(u32x2*)ptr = o;
            }
        }
        {
            float v[3]; float ss = 0.f;
#pragma unroll
            for (int j = 0; j < 3; ++j) { v[j] = bf2f(row[C_CQ + lane + j * 64]); ss += v[j] * v[j]; }
            ss = wave_sum(ss);
            const float rstd = rsqrtf(ss * (1.f / 192.f) + EPS);
#pragma unroll
            for (int j = 0; j < 3; ++j) row[C_CQ + lane + j * 64] = f2bf(v[j] * rstd * cqg[lane + j * 64]);
            float w[2]; float s2 = 0.f;
#pragma unroll
            for (int j = 0; j < 2; ++j) { w[j] = bf2f(row[C_CKV + lane + j * 64]); s2 += w[j] * w[j]; }
            s2 = wave_sum(s2);
            const float r2 = rsqrtf(s2 * (1.f / 128.f) + EPS);
#pragma unroll
            for (int j = 0; j < 2; ++j) row[C_CKV + lane + j * 64] = f2bf(w[j] * r2 * ckvg[lane + j * 64]);
        }
        {
            const int c = lane * 4;
            const u32x2 cur = *(const u32x2*)(row + C_RWD + c);
            u32x2 pv = (u32x2){0u, 0u}, nx = (u32x2){0u, 0u};
            if (n > 0) pv = *(const u32x2*)(row - LDP + C_RWD + c);
            if (n + 1 < len) nx = *(const u32x2*)(row + LDP + C_RWD + c);
            const float4 m = *(const float4*)(mu3 + c);
            float o[4];
            { const float x = bflo(cur.x); o[0] = x + (0.5f * (bflo(pv.x) + bflo(nx.x)) - x) * m.x; }
            { const float x = bfhi(cur.x); o[1] = x + (0.5f * (bfhi(pv.x) + bfhi(nx.x)) - x) * m.y; }
            { const float x = bflo(cur.y); o[2] = x + (0.5f * (bflo(pv.y) + bflo(nx.y)) - x) * m.z; }
            { const float x = bfhi(cur.y); o[3] = x + (0.5f * (bfhi(pv.y) + bfhi(nx.y)) - x) * m.w; }
            u32x2 ov; ov.x = pack2(o[0], o[1]); ov.y = pack2(o[2], o[3]);
            *(u32x2*)(XL + (size_t)t * 256 + c) = ov;
        }
    }
}

DEV void phase_prep_gemm1(const Params& p, int l, char* smem) {
    const bf16_t* P = wsb(p, OFF_P);
    const bf16_t* w = wsb(p, OFF_WSM) + (size_t)l * WS_PER_LAYER;
    bf16_t* QRAW = wsb(p, OFF_QRAW); bf16_t* KVRAW = wsb(p, OFF_KVRAW); bf16_t* LR = wsb(p, OFF_LR);
    int rot = 0;
    gemm_generic(P + C_CQ, LDP, TT, w + WS_UQT, 192, 192, 192, [&](int r, int c, float v) { QRAW[(size_t)r * 192 + c] = f2bf(v); }, smem, rot);
    rot += (TT / 128) * 2;
    gemm_generic(P + C_CKV, LDP, TT, w + WS_UKVT, 128, 384, 128, [&](int r, int c, float v) { KVRAW[(size_t)r * 384 + c] = f2bf(v); }, smem, rot);
    rot += (TT / 128) * 3;
    gemm_generic(wsb(p, OFF_XL), 256, TT, w + WS_W1C, 256, 192, 256,
                 [&](int r, int c, float v) { const float o = c < 64 ? tanhf(v) : (c < 128 ? v : sigmoidf_(v)); LR[(size_t)r * 192 + c] = f2bf(o); }, smem, rot);
}
DEV void phase_prep_gemm2(const Params& p, int l, char* smem) {
    const bf16_t* w = wsb(p, OFF_WSM) + (size_t)l * WS_PER_LAYER;
    const bf16_t* LR = wsb(p, OFF_LR);
    bf16_t* RWX = wsb(p, OFF_RWX);
    bf16_t* P = wsb(p, OFF_P);
    int rot = 0;
    for (int d = 0; d < 2; ++d) {
        const float* w0 = p.in[I_RW0] + (l * 2 + d) * 256;
        gemm_generic(LR + d * 32, 192, TT, w + WS_W2 + (size_t)d * 256 * 64, 64, 256, 64,
                     [&](int r, int c, float v) { RWX[(size_t)r * 1024 + d * 256 + c] = f2bf(0.6065306597126334f * sigmoidf_(w0[c] + v)); }, smem, rot);
        rot += (TT / 128) * 2;
        const float* a0 = p.in[I_RA0] + (l * 2 + d) * 256;
        gemm_generic(LR + 64 + d * 32, 192, TT, w + WS_W2 + (size_t)(2 + d) * 256 * 64, 64, 256, 64,
                     [&](int r, int c, float v) { RWX[(size_t)r * 1024 + 512 + d * 256 + c] = f2bf(sigmoidf_(a0[c] + v)); }, smem, rot);
        rot += (TT / 128) * 2;
    }
    gemm_generic(LR + 128, 192, TT, w + WS_G2T, 64, 256, 64, [&](int r, int c, float v) { P[(size_t)r * LDP + C_RWD + c] = f2bf(v); }, smem, rot);
}

DEV void phase_prep2(const Params& p, int l) {
    const int lane = tidx() & 63, wave = tidx() >> 6;
    const bf16_t* P = wsb(p, OFF_P);
    const bf16_t* QRAW = wsb(p, OFF_QRAW); const bf16_t* KVRAW = wsb(p, OFF_KVRAW);
    bf16_t* MQ = wsb(p, OFF_MLAQ); bf16_t* MK = wsb(p, OFF_MLAK); bf16_t* MV = wsb(p, OFF_MLAV);
    const float* qkg = p.in[I_MQKG] + l * 96;
    for (int t = bidx() * 4 + wave; t < TT; t += gridDim.x * 4) {
        int base, n, len; tok_seq(t, base, n, len);
        const int h = lane >> 4, j = lane & 15;
        const bool rot = t < TL;
        float cs = 1.f, sn = 0.f;
        if (rot) {
            const int i = j & 7;
            const float inv = exp2f(-(float)(i & 3) * (13.287712379549449f / 4.f));
            const float ang = (i < 4 ? (float)(n >> 6) : (float)(n & 63)) * inv;
            cs = cosf(ang); sn = sinf(ang);
        }
        {
            float v[3]; float ss = 0.f;
#pragma unroll
            for (int k = 0; k < 3; ++k) { v[k] = bf2f(QRAW[(size_t)t * 192 + h * 48 + j + k * 16]); ss += v[k] * v[k]; }
            ss = group_sum<16>(ss);
            const float rstd = rsqrtf(ss * (1.f / 48.f) + EPS);
#pragma unroll
            for (int k = 0; k < 3; ++k) v[k] = v[k] * rstd * qkg[j + k * 16];
            if (rot) { const float o = __shfl_xor(v[2], 8, 64); v[2] = (j < 8) ? (v[2] * cs - o * sn) : (v[2] * cs + o * sn); }
            const float qs = 0.14433756729740643f * LOG2E;
#pragma unroll
            for (int k = 0; k < 3; ++k) MQ[(size_t)t * 192 + h * 48 + j + k * 16] = f2bf(v[k] * qs);
        }
        {
            float v[3]; float ss = 0.f;
            v[0] = bf2f(KVRAW[(size_t)t * 384 + h * 96 + j]);
            v[1] = bf2f(KVRAW[(size_t)t * 384 + h * 96 + 16 + j]);
            v[2] = bf2f(P[(size_t)t * LDP + C_KR + j]);
#pragma unroll
            for (int k = 0; k < 3; ++k) ss += v[k] * v[k];
            ss = group_sum<16>(ss);
            const float rstd = rsqrtf(ss * (1.f / 48.f) + EPS);
#pragma unroll
            for (int k = 0; k < 3; ++k) v[k] = v[k] * rstd * qkg[48 + j + k * 16];
            if (rot) { const float o = __shfl_xor(v[2], 8, 64); v[2] = (j < 8) ? (v[2] * cs - o * sn) : (v[2] * cs + o * sn); }
#pragma unroll
            for (int k = 0; k < 3; ++k) MK[(size_t)t * 192 + h * 48 + j + k * 16] = f2bf(v[k]);
        }
#pragma unroll
        for (int k = 0; k < 4; ++k) MV[(size_t)t * 256 + h * 64 + j + k * 16] = KVRAW[(size_t)t * 384 + h * 96 + 32 + j + k * 16];
    }
}
template <int NC, int DK>
struct AttnCfg {
    static constexpr int DKROW = NC * DK, KLD = DKROW + 8, VLD = 68;
    static constexpr int KSTAGE = 64 * KLD, VSTAGE = 64 * VLD;
    static constexpr int KCH = 64 * DKROW / 8;
};
template <int NC, int DK, class EPI>
DEV void attn_item(const bf16_t* Q, int ldq, const bf16_t* Kl, const bf16_t* Kc, int ldk, const bf16_t* Vl, const bf16_t* Vc, int ldv,
                   int q0, int nlat_tiles, int nctx_tiles, EPI epi, char* smem) {
    using C = AttnCfg<NC, DK>;
    constexpr int KS = DK / 16;
    const int tid = tidx(), lane = tid & 63, wave = tid >> 6, ql = lane & 31, hh = lane >> 5;
    bf16_t* Ks = (bf16_t*)smem;
    bf16_t* Vt = Ks + 2 * C::KSTAGE;
    bf16x8 qf[NC][KS];
    {
        const bf16_t* qp = Q + (size_t)(q0 + wave * 32 + ql) * ldq + hh * 8;
#pragma unroll
        for (int c = 0; c < NC; ++c)
#pragma unroll
            for (int ks = 0; ks < KS; ++ks) qf[c][ks] = *(const bf16x8*)(qp + c * DK + ks * 16);
    }
    f32x16 O[NC][2];
    float mrun[NC], lrun[NC];
#pragma unroll
    for (int c = 0; c < NC; ++c) {
        mrun[c] = -1e30f; lrun[c] = 0.f;
#pragma unroll
        for (int d = 0; d < 2; ++d)
#pragma unroll
            for (int r = 0; r < 16; ++r) O[c][d][r] = 0.f;
    }
    const int ntiles = nlat_tiles + nctx_tiles;
    constexpr int KPT = (C::KCH + NT - 1) / NT;
    u32x4 rk[KPT], rv[2];
    auto load_tile = [&](int tile) {
        const bf16_t* kb = tile < nlat_tiles ? Kl + (size_t)tile * 64 * ldk : Kc + (size_t)(tile - nlat_tiles) * 64 * ldk;
        const bf16_t* vb = tile < nlat_tiles ? Vl + (size_t)tile * 64 * ldv : Vc + (size_t)(tile - nlat_tiles) * 64 * ldv;
#pragma unroll
        for (int i = 0; i < KPT; ++i) {
            int q = tid + i * NT; q = q < C::KCH ? q : C::KCH - 1;
            { const int key = q / (C::DKROW / 8), ch = q % (C::DKROW / 8); rk[i] = *(const u32x4*)(kb + (size_t)key * ldk + ch * 8); }
        }
#pragma unroll
        for (int i = 0; i < 2; ++i) { const int q = tid + i * NT; const int key = q >> 3, ch = q & 7; rv[i] = *(const u32x4*)(vb + (size_t)key * ldv + ch * 8); }
    };
    auto store_tile = [&](int st) {
#pragma unroll
        for (int i = 0; i < KPT; ++i) {
            const int q = tid + i * NT;
            if (q < C::KCH) { const int key = q / (C::DKROW / 8), ch = q % (C::DKROW / 8); *(u32x4*)(Ks + st * C::KSTAGE + key * C::KLD + ch * 8) = rk[i]; }
        }
#pragma unroll
        for (int i = 0; i < 2; ++i) {
            const int q = tid + i * NT; const int key = q >> 3, dv0 = (q & 7) * 8;
            bf16_t* vd = Vt + st * C::VSTAGE + dv0 * C::VLD + key;
            const unsigned w[4] = { rv[i][0], rv[i][1], rv[i][2], rv[i][3] };
#pragma unroll
            for (int j = 0; j < 4; ++j) { vd[(2 * j) * C::VLD] = (bf16_t)(w[j] & 0xFFFFu); vd[(2 * j + 1) * C::VLD] = (bf16_t)(w[j] >> 16); }
        }
    };
    load_tile(0);
    __syncthreads();
    store_tile(0);
    __syncthreads();
    for (int tile = 0; tile < ntiles; ++tile) {
        const int cur = tile & 1;
        if (tile + 1 < ntiles) load_tile(tile + 1);
        const bf16_t* ks_ = Ks + cur * C::KSTAGE;
        const bf16_t* vt_ = Vt + cur * C::VSTAGE;
#pragma unroll
        for (int c = 0; c < NC; ++c) {
            f32x16 S[2];
#pragma unroll
            for (int kb = 0; kb < 2; ++kb) {
#pragma unroll
                for (int r = 0; r < 16; ++r) S[kb][r] = 0.f;
#pragma unroll
                for (int ks = 0; ks < KS; ++ks) {
                    const bf16x8 kf = *(const bf16x8*)(ks_ + (kb * 32 + ql) * C::KLD + c * DK + ks * 16 + hh * 8);
                    S[kb] = __builtin_amdgcn_mfma_f32_32x32x16_bf16(kf, qf[c][ks], S[kb], 0, 0, 0);
                }
            }
            float mx = S[0][0];
#pragma unroll
            for (int kb = 0; kb < 2; ++kb)
#pragma unroll
                for (int r = 0; r < 16; ++r) mx = fmaxf(mx, S[kb][r]);
            mx = fmaxf(mx, __shfl_xor(mx, 32, 64));
            const float mnew = fmaxf(mrun[c], mx);
            const float alpha = __builtin_amdgcn_exp2f(mrun[c] - mnew);
            mrun[c] = mnew;
            float ls = 0.f;
#pragma unroll
            for (int kb = 0; kb < 2; ++kb)
#pragma unroll
                for (int r = 0; r < 16; ++r) { const float e = __builtin_amdgcn_exp2f(S[kb][r] - mnew); S[kb][r] = e; ls += e; }
            lrun[c] = lrun[c] * alpha + ls;
#pragma unroll
            for (int d = 0; d < 2; ++d)
#pragma unroll
                for (int r = 0; r < 16; ++r) O[c][d][r] *= alpha;
#pragma unroll
            for (int s = 0; s < 4; ++s) {
                const int kb = s >> 1, s2 = s & 1;
                const u32x4 pu = (u32x4){pack2(S[kb][8 * s2 + 0], S[kb][8 * s2 + 1]), pack2(S[kb][8 * s2 + 2], S[kb][8 * s2 + 3]),
                                         pack2(S[kb][8 * s2 + 4], S[kb][8 * s2 + 5]), pack2(S[kb][8 * s2 + 6], S[kb][8 * s2 + 7])};
                const bf16x8 pf = __builtin_bit_cast(bf16x8, pu);
                const int keyo = kb * 32 + 16 * s2 + 4 * hh;
#pragma unroll
                for (int d = 0; d < 2; ++d) {
                    const bf16_t* vp = vt_ + (d * 32 + ql) * C::VLD + keyo;
                    const u32x2 lo = *(const u32x2*)vp, hi = *(const u32x2*)(vp + 8);
                    const u32x4 vv = (u32x4){lo[0], lo[1], hi[0], hi[1]};
                    const bf16x8 vf = __builtin_bit_cast(bf16x8, vv);
                    O[c][d] = __builtin_amdgcn_mfma_f32_32x32x16_bf16(vf, pf, O[c][d], 0, 0, 0);
                }
            }
        }
        if (tile + 1 < ntiles) store_tile(cur ^ 1);
        __syncthreads();
    }
    float inv[NC];
#pragma unroll
    for (int c = 0; c < NC; ++c) { const float lt = lrun[c] + __shfl_xor(lrun[c], 32, 64); inv[c] = 1.f / lt; }
    epi(O, inv, q0 + wave * 32 + ql, hh);
}

DEV void da_item(const Params& p, int l, int item, char* smem) {
    const bf16_t* P = wsb(p, OFF_P);
    bf16_t* Y = wsb(p, OFF_Y);
    const float linit = 0.8f - 0.6f * __expf(-0.3f * (float)l);
    float lam;
    {
        const float* la = p.in[I_DALAM] + l * 128;
        const int lane = tidx() & 63;
        float a = lane < 32 ? la[lane] * la[32 + lane] : 0.f, b = lane < 32 ? la[64 + lane] * la[96 + lane] : 0.f;
        a = wave_sum(a); b = wave_sum(b);
        lam = __expf(a) - __expf(b) + linit;
    }
    const float* sg = p.in[I_DASUB] + l * 64;
    int b, h, qt; bool isctx;
    if (item < 512) { isctx = false; b = item >> 6; h = (item >> 4) & 3; qt = item & 15; }
    else { const int it = item - 512; isctx = true; b = it >> 3; h = (it >> 1) & 3; qt = it & 1; }
    const size_t lat0 = (size_t)b * SEQ, ctx0 = (size_t)TL + (size_t)b * CTXL;
    const size_t qrow0 = isctx ? ctx0 : lat0;
    float* o1s = (float*)(smem + 32768) + (tidx() >> 6) * (32 * 64) + (tidx() & 63);
    auto epi0 = [&](f32x16 (&O)[1][2], float (&inv)[1], int qrow, int hh) {
#pragma unroll
        for (int d = 0; d < 2; ++d)
#pragma unroll
            for (int r = 0; r < 16; ++r) o1s[(d * 16 + r) * 64] = O[0][d][r] * inv[0];
    };
    auto epi1 = [&](f32x16 (&O)[1][2], float (&inv)[1], int qrow, int hh) {
        float v[2][16]; float ss = 0.f;
#pragma unroll
        for (int d = 0; d < 2; ++d)
#pragma unroll
            for (int r = 0; r < 16; ++r) { const float o = o1s[(d * 16 + r) * 64] - lam * O[0][d][r] * inv[0]; v[d][r] = o; ss += o * o; }
        ss += __shfl_xor(ss, 32, 64);
        const float rstd = rsqrtf(ss * (1.f / 64.f) + EPS) * (1.f - linit);
        bf16_t* yo = Y + (qrow0 + qrow) * 1024 + h * 64;
#pragma unroll
        for (int d = 0; d < 2; ++d)
#pragma unroll
            for (int g = 0; g < 4; ++g) {
                const int dv = d * 32 + 8 * g + 4 * hh;
                u32x2 o;
                o.x = pack2(v[d][4 * g + 0] * rstd * sg[dv + 0], v[d][4 * g + 1] * rstd * sg[dv + 1]);
                o.y = pack2(v[d][4 * g + 2] * rstd * sg[dv + 2], v[d][4 * g + 3] * rstd * sg[dv + 3]);
                *(u32x2*)(yo + dv) = o;
            }
    };
    const bf16_t* Qp = P + qrow0 * LDP + C_DAQ + h * 64;
    const bf16_t* Kl = P + lat0 * LDP + C_DAK + h * 64;
    const bf16_t* Kc = P + ctx0 * LDP + C_DAK + h * 64;
    const bf16_t* Vl = P + lat0 * LDP + C_DAV + h * 64;
    const bf16_t* Vc = P + ctx0 * LDP + C_DAV + h * 64;
    const int nlat = isctx ? 0 : SEQ / 64;
    attn_item<1, 32>(Qp, LDP, Kl, Kc, LDP, Vl, Vc, LDP, qt * 128, nlat, CTXL / 64, epi0, smem);
    attn_item<1, 32>(Qp + 32, LDP, Kl + 32, Kc + 32, LDP, Vl, Vc, LDP, qt * 128, nlat, CTXL / 64, epi1, smem);
}
DEV void mla_item(const Params& p, int l, int item, char* smem) {
    const bf16_t* MQ = wsb(p, OFF_MLAQ); const bf16_t* MK = wsb(p, OFF_MLAK); const bf16_t* MV = wsb(p, OFF_MLAV);
    bf16_t* Y = wsb(p, OFF_Y);
    int b, h, qt; bool isctx;
    if (item < 512) { isctx = false; b = item >> 6; h = (item >> 4) & 3; qt = item & 15; }
    else { const int it = item - 512; isctx = true; b = it >> 3; h = (it >> 1) & 3; qt = it & 1; }
    const size_t lat0 = (size_t)b * SEQ, ctx0 = (size_t)TL + (size_t)b * CTXL;
    const size_t qrow0 = isctx ? ctx0 : lat0;
    auto epi = [&](f32x16 (&O)[1][2], float (&inv)[1], int qrow, int hh) {
        bf16_t* yo = Y + (qrow0 + qrow) * 1024 + 512 + h * 64;
#pragma unroll
        for (int d = 0; d < 2; ++d)
#pragma unroll
            for (int g = 0; g < 4; ++g) {
                const int dv = d * 32 + 8 * g + 4 * hh;
                u32x2 o;
                o.x = pack2(O[0][d][4 * g + 0] * inv[0], O[0][d][4 * g + 1] * inv[0]);
                o.y = pack2(O[0][d][4 * g + 2] * inv[0], O[0][d][4 * g + 3] * inv[0]);
                *(u32x2*)(yo + dv) = o;
            }
    };
    const bf16_t* Qp = MQ + qrow0 * 192 + h * 48;
    const bf16_t* Kl = MK + lat0 * 192 + h * 48;
    const bf16_t* Kc = MK + ctx0 * 192 + h * 48;
    const bf16_t* Vl = MV + lat0 * 256 + h * 64;
    const bf16_t* Vc = MV + ctx0 * 256 + h * 64;
    attn_item<1, 48>(Qp, 192, Kl, Kc, 192, Vl, Vc, 256, qt * 128, isctx ? 0 : SEQ / 64, CTXL / 64, epi, smem);
}
DEV int s5_token(int b, int tb, int n) { return tb == 0 ? TL + b * CTXL + n : b * SEQ + (tb - 1) * 256 + n; }
struct S5M { float are, aim; bf16x8* bfl; };
DEV void s5_coef(const Params& p, int gi, int pl, float& are, float& aim, float& cr, float& ci) {
    const float lre = p.in[I_S5LRE][gi * 64 + pl], lim = p.in[I_S5LIM][gi * 64 + pl];
    const float dt = __expf(p.in[I_S5LDT][gi]);
    const float mag = __expf(lre * dt);
    are = mag * __cosf(lim * dt); aim = mag * __sinf(lim * dt);
    const float nr = are - 1.f, ni = aim, den = 1.f / (lre * lre + lim * lim);
    cr = (nr * lre + ni * lim) * den; ci = (ni * lre - nr * lim) * den;
}
DEV void s5_setup(const Params& p, int l, int d, int g, int lane, S5M& s, bf16x8* bfl) {
    s.bfl = bfl;
    const int gi = ((l * 2 + d) * 16 + g), c16 = lane & 15, kq = lane >> 4;
    float cr, ci;
    s5_coef(p, gi, lane, s.are, s.aim, cr, ci);
#pragma unroll
    for (int nt = 0; nt < 4; ++nt) {
        const int pp = nt * 16 + c16;
        float a0, a1; s5_coef(p, gi, pp, a0, a1, cr, ci);
        float re[8], im[8];
        const float* br = p.in[I_S5BRE] + ((size_t)gi * 64 + pp) * 16 + (kq & 1) * 8;
        const float* bi = p.in[I_S5BIM] + ((size_t)gi * 64 + pp) * 16 + (kq & 1) * 8;
#pragma unroll
        for (int j = 0; j < 8; ++j) { const float x = br[j], y = bi[j]; const bool on = kq < 2; re[j] = on ? cr * x - ci * y : 0.f; im[j] = on ? cr * y + ci * x : 0.f; }
        bfl[nt * 64 + lane] = __builtin_bit_cast(bf16x8, (u32x4){pack2(re[0], re[1]), pack2(re[2], re[3]), pack2(re[4], re[5]), pack2(re[6], re[7])});
        bfl[(nt + 4) * 64 + lane] = __builtin_bit_cast(bf16x8, (u32x4){pack2(im[0], im[1]), pack2(im[2], im[3]), pack2(im[4], im[5]), pack2(im[6], im[7])});
    }
}
DEV void s5_bu32(const S5M& s, const bf16_t* P, int b, int tb, int g, int sc, bf16_t* hb, int lane) {
    asm volatile("" : "+v"(sc));
    const int c16 = lane & 15, kq = lane >> 4;
    bf16x8 uf[2];
#pragma unroll
    for (int mt = 0; mt < 2; ++mt) {
        const int t = s5_token(b, tb, sc * 32 + mt * 16 + c16);
        const u32x4 raw = *(const u32x4*)(P + (size_t)t * LDP + C_S5 + g * 16 + (kq & 1) * 8);
        const u32x4 z = (u32x4){0u, 0u, 0u, 0u};
        uf[mt] = __builtin_bit_cast(bf16x8, kq < 2 ? raw : z);
    }
#pragma unroll
    for (int nt = 0; nt < 8; ++nt)
#pragma unroll
        for (int mt = 0; mt < 2; ++mt) {
            const f32x4 acc = __builtin_amdgcn_mfma_f32_16x16x32_bf16(s.bfl[nt * 64 + lane], uf[mt], (f32x4){0.f, 0.f, 0.f, 0.f}, 0, 0, 0);
            u32x2 o; o.x = pack2(acc[0], acc[1]); o.y = pack2(acc[2], acc[3]);
            *(u32x2*)(hb + (mt * 16 + c16) * 136 + nt * 16 + kq * 4) = o;
            if (mt == 1 && (nt & 1)) __builtin_amdgcn_sched_barrier(0);
        }
}
template <bool DUMP>
DEV void s5_scan32(const S5M& s, float& hre, float& him, bf16_t* hb, int pl, bool rev) {
#pragma unroll 4
    for (int j = 0; j < 32; ++j) {
        const int rowi = rev ? 31 - j : j;
        const float bur = bf2f(hb[rowi * 136 + pl]), bui = bf2f(hb[rowi * 136 + 64 + pl]);
        const float nre = s.are * hre - s.aim * him + bur;
        const float nim = s.are * him + s.aim * hre + bui;
        hre = nre; him = nim;
        if (DUMP) { hb[rowi * 136 + pl] = f2bf(hre); hb[rowi * 136 + 64 + pl] = f2bf(him); }
    }
}
DEV void phase_s5_pass1(const Params& p, int l, char* smem) {
    const int lane = tidx() & 63, wave = tidx() >> 6;
    bf16_t* hb = (bf16_t*)smem + wave * (32 * 136);
    const bf16_t* P = wsb(p, OFF_P);
    float* st = wsf(p, OFF_S5ST);
    const int nitems = 2 * 8 * 16 * 8;
    for (int it0 = bidx() * 4; it0 < nitems; it0 += gridDim.x * 4) {
        const int it = it0 + wave;
        const int seg = it & 7, g = (it >> 3) & 15, b = (it >> 7) & 7, d = it >> 10;
        const int tb = seg == 0 ? 0 : (d == 0 ? seg : 9 - seg);
        __syncthreads();
        S5M s; s5_setup(p, l, d, g, lane, s, (bf16x8*)(smem + 36864) + wave * 512);
        float hre = 0.f, him = 0.f;
        for (int k = 0; k < 8; ++k) {
            const int sc = d == 0 ? k : 7 - k;
            __syncthreads();
            s5_bu32(s, P, b, tb, g, sc, hb, lane);
            __syncthreads();
            s5_scan32<false>(s, hre, him, hb, lane, d == 1);
        }
        float* o = st + ((((size_t)d * 8 + b) * 16 + g) * 8 + seg) * 128;
        o[lane] = hre; o[64 + lane] = him;
    }
}
DEV void s5_pass2_item(const Params& p, int l, int tb0, int bitem, char* smem) {
    const int lane = tidx() & 63, wave = tidx() >> 6;
    bf16_t* hb = (bf16_t*)smem + wave * (32 * 136);
    bf16_t* P = wsb(p, OFF_P);
    bf16_t* S5Y = wsb(p, OFF_S5Y);
    const float* st = wsf(p, OFF_S5ST);
    const int it = bitem * 4 + wave;
    const int g = it & 15, b = (it >> 4) & 7, tb = (it >> 7) + tb0;
    const int c = lane & 15;
    const float dd = p.in[I_S5D][(l * 16 + g) * 16 + c];
#pragma unroll 1
    for (int d = 0; d < 2; ++d) {
        __syncthreads();
        S5M s; s5_setup(p, l, d, g, lane, s, (bf16x8*)(smem + 36864) + wave * 512);
        bf16x8 cf[4];
        {
            const float* cre = p.in[I_S5CRE] + ((size_t)((l * 2 + d) * 16 + g) * 16 + c) * 64 + (lane >> 4) * 8;
            const float* cim = p.in[I_S5CIM] + ((size_t)((l * 2 + d) * 16 + g) * 16 + c) * 64 + (lane >> 4) * 8;
#pragma unroll
            for (int ks = 0; ks < 4; ++ks) {
                const float* src = ks < 2 ? cre + ks * 32 : cim + (ks - 2) * 32;
                const float4 a = *(const float4*)src, b4 = *(const float4*)(src + 4);
                const float sg = ks < 2 ? 1.f : -1.f;
                cf[ks] = __builtin_bit_cast(bf16x8, (u32x4){pack2(sg * a.x, sg * a.y), pack2(sg * a.z, sg * a.w), pack2(sg * b4.x, sg * b4.y), pack2(sg * b4.z, sg * b4.w)});
            }
        }
        const int seg = tb == 0 ? 0 : (d == 0 ? tb : 9 - tb);
        float hre = 0.f, him = 0.f;
        {
            float pr = s.are, pi = s.aim;
#pragma unroll
            for (int q = 0; q < 8; ++q) { const float nr = pr * pr - pi * pi, ni = 2.f * pr * pi; pr = nr; pi = ni; }
            const float* hs = st + (((size_t)d * 8 + b) * 16 + g) * 8 * 128;
            for (int i = 0; i < seg; ++i) {
                const float er = hs[i * 128 + lane], ei = hs[i * 128 + 64 + lane];
                const float nr = pr * hre - pi * him + er, ni = pr * him + pi * hre + ei;
                hre = nr; him = ni;
            }
        }
#pragma unroll 1
        for (int k = 0; k < 8; ++k) {
            const int sc = d == 0 ? k : 7 - k;
            __syncthreads();
            s5_bu32(s, P, b, tb, g, sc, hb, lane);
            __syncthreads();
            s5_scan32<true>(s, hre, him, hb, lane, d == 1);
            __syncthreads();
#pragma unroll
            for (int mt = 0; mt < 2; ++mt) {
                f32x4 y = (f32x4){0.f, 0.f, 0.f, 0.f};
#pragma unroll
                for (int ks = 0; ks < 4; ++ks) {
                    const bf16x8 af = *(const bf16x8*)(hb + (mt * 16 + (lane & 15)) * 136 + ks * 32 + (lane >> 4) * 8);
                    y = __builtin_amdgcn_mfma_f32_16x16x32_bf16(af, cf[ks], y, 0, 0, 0);
                }
#pragma unroll
                for (int r = 0; r < 4; ++r) {
                    const int n = sc * 32 + mt * 16 + (lane >> 4) * 4 + r;
                    const size_t t = (size_t)s5_token(b, tb, n);
                    if (d == 0) S5Y[t * 256 + g * 16 + c] = f2bf(y[r]);
                    else {
                        bf16_t* up = P + t * LDP + C_S5 + g * 16 + c;
                        const float yy = dd * bf2f(*up) + bf2f(S5Y[t * 256 + g * 16 + c]) + y[r];
                        *up = f2bf(0.5f * yy * (1.f + tanhf(0.7978845608028654f * (yy + 0.044715f * yy * yy * yy))));
                    }
                }
            }
        }
    }
}

DEV float row16_sum(float v) {
    v += __int_as_float(__builtin_amdgcn_mov_dpp(__float_as_int(v), 0x128, 0xf, 0xf, true));
    v += __int_as_float(__builtin_amdgcn_mov_dpp(__float_as_int(v), 0x124, 0xf, 0xf, true));
    v += __int_as_float(__builtin_amdgcn_mov_dpp(__float_as_int(v), 0x122, 0xf, 0xf, true));
    v += __int_as_float(__builtin_amdgcn_mov_dpp(__float_as_int(v), 0x121, 0xf, 0xf, true));
    return v;
}
DEV float fmul_(float a, float b) { return a * b; }
DEV float fadd_(float a, float b) { return a + b; }
DEV float ffma_(float a, float b, float c) { return __builtin_fmaf(a, b, c); }
DEV float fnma_(float a, float b, float c) { return __builtin_fmaf(-a, b, c); }
DEV float row8_sum(float v) {
    v += __int_as_float(__builtin_amdgcn_mov_dpp(__float_as_int(v), 0x141, 0xf, 0xf, true));
    v += __int_as_float(__builtin_amdgcn_mov_dpp(__float_as_int(v), 0xB1, 0xf, 0xf, true));
    v += __int_as_float(__builtin_amdgcn_mov_dpp(__float_as_int(v), 0x4E, 0xf, 0xf, true));
    return v;
}
DEV float row16_sum1(float v) { v += __int_as_float(__builtin_amdgcn_mov_dpp(__float_as_int(v), 0x128, 0xf, 0xf, true)); return v; }
constexpr int RW_CT = 16;
struct RwRaw { u32x2 r[3], k[3], v[3], sd, a; float fp, fn; };
#ifndef RWVAR
#define RWVAR 0
#endif
template <int var>
DEV void rw_item_t(const Params& p, int l, int item, char* smem, int rep) {
    const int tid = tidx(), li = tid >> 4, lc = tid & 15;
    const int ch = item >> 2, rg = item & 3, dir = ch >> 5, b = (ch >> 2) & 7, head = ch & 3;
    float* buf = (float*)smem;
    float* ybuf = buf + 2 * RW_CT * 384;
    const bf16_t* P = wsb(p, OFF_P);
    const bf16_t* RWX = wsb(p, OFF_RWX);
    bf16_t* RWY = wsb(p, OFF_RWY) + (size_t)dir * TT * 256 + (rep > 0 ? (size_t)2 * TT * 256 : 0);
    const int hc = head * 64 + lc * 4;
    const float4 mur = *(const float4*)(p.in[I_RMU] + (l * 4 + 0) * 256 + hc);
    const float4 muk = *(const float4*)(p.in[I_RMU] + (l * 4 + 1) * 256 + hc);
    const float4 muv = *(const float4*)(p.in[I_RMU] + (l * 4 + 2) * 256 + hc);
    const float4 kk4 = *(const float4*)(p.in[I_RKK] + l * 256 + hc);
    const float4 ka4 = *(const float4*)(p.in[I_RKA] + l * 256 + hc);
    const int NCH = (CTXL + SEQ) / RW_CT;
    auto tok_of = [&](int cidx, int i, int& n, int& len) -> int {
        if (cidx < CTXL / RW_CT) { const int pos = cidx * RW_CT + i; len = CTXL; n = dir == 0 ? pos : CTXL - 1 - pos; return TL + b * CTXL + n; }
        const int pos = (cidx - CTXL / RW_CT) * RW_CT + i; len = SEQ; n = dir == 0 ? pos : SEQ - 1 - pos; return b * SEQ + n;
    };
    auto load_raw = [&](int cidx, RwRaw& raw) {
        int n, len; const int t = tok_of(cidx, li, n, len);
        const bf16_t* row = P + (size_t)t * LDP;
        const bool hp = n > 0, hn = n + 1 < len;
        const bf16_t* rp = hp ? row - LDP : row;
        const bf16_t* rn = hn ? row + LDP : row;
        raw.fp = hp ? 0.5f : 0.f; raw.fn = hn ? 0.5f : 0.f;
        raw.r[1] = *(const u32x2*)(row + C_RWR + hc); raw.k[1] = *(const u32x2*)(row + C_RWK + hc); raw.v[1] = *(const u32x2*)(row + C_RWV + hc);
        raw.r[0] = *(const u32x2*)(rp + C_RWR + hc); raw.k[0] = *(const u32x2*)(rp + C_RWK + hc); raw.v[0] = *(const u32x2*)(rp + C_RWV + hc);
        raw.r[2] = *(const u32x2*)(rn + C_RWR + hc); raw.k[2] = *(const u32x2*)(rn + C_RWK + hc); raw.v[2] = *(const u32x2*)(rn + C_RWV + hc);
        raw.sd = *(const u32x2*)(RWX + (size_t)t * 1024 + dir * 256 + hc);
        raw.a = *(const u32x2*)(RWX + (size_t)t * 1024 + 512 + dir * 256 + hc);
    };
    auto mix4 = [&](const u32x2 (&s)[3], const float4& mu, float fp, float fn, float (&o)[4]) {
        { const float x = bflo(s[1].x); o[0] = x + ((fp * bflo(s[0].x) + fn * bflo(s[2].x)) - x) * mu.x; }
        { const float x = bfhi(s[1].x); o[1] = x + ((fp * bfhi(s[0].x) + fn * bfhi(s[2].x)) - x) * mu.y; }
        { const float x = bflo(s[1].y); o[2] = x + ((fp * bflo(s[0].y) + fn * bflo(s[2].y)) - x) * mu.z; }
        { const float x = bfhi(s[1].y); o[3] = x + ((fp * bfhi(s[0].y) + fn * bfhi(s[2].y)) - x) * mu.w; }
    };
    auto stage = [&](int st, const RwRaw& raw) {
        float r4[4], k4[4], v4[4];
        mix4(raw.r, mur, raw.fp, raw.fn, r4); mix4(raw.k, muk, raw.fp, raw.fn, k4); mix4(raw.v, muv, raw.fp, raw.fn, v4);
        const float kkr[4] = { k4[0] * kk4.x, k4[1] * kk4.y, k4[2] * kk4.z, k4[3] * kk4.w };
        float nn = kkr[0] * kkr[0] + kkr[1] * kkr[1] + kkr[2] * kkr[2] + kkr[3] * kkr[3];
        nn = row16_sum(nn);
        const float rn = 1.f / fmaxf(sqrtf(nn), 1e-12f);
        const float a[4] = { bflo(raw.a.x), bfhi(raw.a.x), bflo(raw.a.y), bfhi(raw.a.y) };
        const float sd[4] = { bflo(raw.sd.x), bfhi(raw.sd.x), bflo(raw.sd.y), bfhi(raw.sd.y) };
        const float kav[4] = { ka4.x, ka4.y, ka4.z, ka4.w };
        float* d = buf + (st * RW_CT + li) * 384 + lc * 4;
        float wp[4], kp[4], bp[4], mp[4];
#pragma unroll
        for (int j = 0; j < 4; ++j) {
            wp[j] = __expf(-sd[j]);
            kp[j] = kkr[j] * rn;
            bp[j] = kp[j] * a[j];
            mp[j] = k4[j] * (1.f + (a[j] - 1.f) * kav[j]);
        }
        *(float4*)(d + 0) = make_float4(wp[0], wp[1], wp[2], wp[3]); *(float4*)(d + 64) = make_float4(kp[0], kp[1], kp[2], kp[3]);
        *(float4*)(d + 128) = make_float4(bp[0], bp[1], bp[2], bp[3]); *(float4*)(d + 192) = make_float4(mp[0], mp[1], mp[2], mp[3]);
        *(float4*)(d + 256) = make_float4(r4[0], r4[1], r4[2], r4[3]);
        *(float4*)(d + 320) = make_float4(v4[0], v4[1], v4[2], v4[3]);
    };
    float S0 = 0.f, S1 = 0.f, S2 = 0.f, S3 = 0.f;
    auto compute = [&](int cidx, int cur, const RwRaw& rs, bool do_stage) {
        float sr4[4], sk4[4], sv4[4], skkr[4], srn = 0.f;
        const float* cb = buf + cur * RW_CT * 384 + lc * 4;
        const float* vb = buf + cur * RW_CT * 384 + 320 + rg * 16 + li;
        float ykeep = 0.f;
        f32x4 w[2], kk[2], bb[2], km[2], rr[2]; float vv[2];
        w[0] = *(const f32x4*)(cb); kk[0] = *(const f32x4*)(cb + 64); bb[0] = *(const f32x4*)(cb + 128); km[0] = *(const f32x4*)(cb + 192); rr[0] = *(const f32x4*)(cb + 256);
        vv[0] = vb[0];
#pragma unroll
        for (int j = 0; j < RW_CT; ++j) {
            const int c0 = j & 1, c2 = c0 ^ 1;
            if (j + 1 < RW_CT) {
                const float* nb = cb + (j + 1) * 384;
                w[c2] = *(const f32x4*)(nb); kk[c2] = *(const f32x4*)(nb + 64); bb[c2] = *(const f32x4*)(nb + 128); km[c2] = *(const f32x4*)(nb + 192); rr[c2] = *(const f32x4*)(nb + 256);
                vv[c2] = vb[(j + 1) * 384];
            }
            const float v_ = vv[c0];
            float sa = fadd_(ffma_(S1, kk[c0][1], fmul_(S0, kk[c0][0])), ffma_(S3, kk[c0][3], fmul_(S2, kk[c0][2])));
            const float t0 = ffma_(S0, w[c0][0], fmul_(v_, km[c0][0])), t1 = ffma_(S1, w[c0][1], fmul_(v_, km[c0][1]));
            const float t2 = ffma_(S2, w[c0][2], fmul_(v_, km[c0][2])), t3 = ffma_(S3, w[c0][3], fmul_(v_, km[c0][3]));
            sa = row16_sum(sa);
            S0 = fnma_(sa, bb[c0][0], t0); S1 = fnma_(sa, bb[c0][1], t1); S2 = fnma_(sa, bb[c0][2], t2); S3 = fnma_(sa, bb[c0][3], t3);
            float y = fadd_(ffma_(S1, rr[c0][1], fmul_(S0, rr[c0][0])), ffma_(S3, rr[c0][3], fmul_(S2, rr[c0][2])));
            y = row16_sum(y);
            ykeep = (lc == j) ? y : ykeep;
            if (j == 2) { mix4(rs.r, mur, rs.fp, rs.fn, sr4); }
            if (j == 5) { mix4(rs.k, muk, rs.fp, rs.fn, sk4); }
            if (j == 8) { mix4(rs.v, muv, rs.fp, rs.fn, sv4); }
            if (j == 11) {
                skkr[0] = sk4[0] * kk4.x; skkr[1] = sk4[1] * kk4.y; skkr[2] = sk4[2] * kk4.z; skkr[3] = sk4[3] * kk4.w;
                float nn = skkr[0] * skkr[0] + skkr[1] * skkr[1] + skkr[2] * skkr[2] + skkr[3] * skkr[3];
                nn = row16_sum(nn);
                srn = 1.f / fmaxf(sqrtf(nn), 1e-12f);
            }
        }
        if (do_stage) {
            const float a[4] = { bflo(rs.a.x), bfhi(rs.a.x), bflo(rs.a.y), bfhi(rs.a.y) };
            const float sd[4] = { bflo(rs.sd.x), bfhi(rs.sd.x), bflo(rs.sd.y), bfhi(rs.sd.y) };
            const float kav[4] = { ka4.x, ka4.y, ka4.z, ka4.w };
            float* d = buf + ((cur ^ 1) * RW_CT + li) * 384 + lc * 4;
            float wp[4], kp[4], bp[4], mp[4];
#pragma unroll
            for (int q = 0; q < 4; ++q) {
                wp[q] = __expf(-sd[q]);
                kp[q] = skkr[q] * srn;
                bp[q] = kp[q] * a[q];
                mp[q] = sk4[q] * (1.f + (a[q] - 1.f) * kav[q]);
            }
            *(float4*)(d + 0) = make_float4(wp[0], wp[1], wp[2], wp[3]); *(float4*)(d + 64) = make_float4(kp[0], kp[1], kp[2], kp[3]);
            *(float4*)(d + 128) = make_float4(bp[0], bp[1], bp[2], bp[3]); *(float4*)(d + 192) = make_float4(mp[0], mp[1], mp[2], mp[3]);
            *(float4*)(d + 256) = make_float4(sr4[0], sr4[1], sr4[2], sr4[3]);
            *(float4*)(d + 320) = make_float4(sv4[0], sv4[1], sv4[2], sv4[3]);
        }
        {
            int n, len; const int t = tok_of(cidx, lc, n, len);
            RWY[(size_t)t * 256 + head * 64 + rg * 16 + li] = f2bf(ykeep);
        }
    };
    RwRaw rawA, rawB;
    __syncthreads();
    load_raw(0, rawA);
    stage(0, rawA);
    load_raw(1, rawA);
    __syncthreads();
    for (int cidx = 0; cidx < NCH; cidx += 2) {
        load_raw(min(cidx + 2, NCH - 1), rawB);
        compute(cidx, 0, rawA, true);
        __syncthreads();
        load_raw(min(cidx + 3, NCH - 1), rawA);
        compute(cidx + 1, 1, rawB, cidx + 2 < NCH);
        __syncthreads();
    }
}

DEV void rw_item(const Params& p, int l, int item, char* smem, int rep = 0) {
    rw_item_t<RWVAR>(p, l, item, smem, rep);
}
constexpr int RC = 32, SK = 72, ST = 40;
constexpr int L_K1 = 0, L_R1 = L_K1 + RC * SK, L_B1 = L_R1 + RC * SK, L_M1 = L_B1 + RC * SK,
              L_VT = L_M1 + RC * SK, L_B2T = L_VT + 64 * ST, L_M2T = L_B2T + 64 * ST,
              L_X = L_M2T + 64 * ST, L_XT = L_X + RC * ST, L_PA = L_XT + RC * ST, L_BM = L_PA + RC * ST, L_AR = L_BM + RC * ST, L_BR = L_AR + RC * ST,
              L_ET = L_BR + RC * ST, L_ZT = L_ET + 64 * ST, L_S = L_ZT + 64 * ST, L_RWEND = L_S + 64 * SK;
static_assert(L_RWEND * 2 + 256 <= 73728, "RWKV chunk LDS");
DEV bf16x8 ldfrag(const bf16_t* m, int stride, int row0, int k0, int lane) { return *(const bf16x8*)(m + (row0 + (lane & 15)) * stride + k0 + (lane >> 4) * 8); }
DEV f32x4 mfma16(bf16x8 a, bf16x8 b, f32x4 c) { return __builtin_amdgcn_mfma_f32_16x16x32_bf16(a, b, c, 0, 0, 0); }
#ifndef RWC_CLAMP
#define RWC_CLAMP 0
#endif
DEV void st4(bf16_t* dst, f32x4 v) {
    if (RWC_CLAMP) { for (int i = 0; i < 4; ++i) v[i] = fminf(fmaxf(v[i], -8.f), 8.f); } u32x2 o; o.x = pack2(v[0], v[1]); o.y = pack2(v[2], v[3]); *(u32x2*)dst = o; }
DEV void unpack8(const u32x4 u, float (&o)[8]) {
    o[0] = bflo(u[0]); o[1] = bfhi(u[0]); o[2] = bflo(u[1]); o[3] = bfhi(u[1]); o[4] = bflo(u[2]); o[5] = bfhi(u[2]); o[6] = bflo(u[3]); o[7] = bfhi(u[3]);
}
DEV u32x4 pack8(const float (&v)[8]) { return (u32x4){pack2(v[0], v[1]), pack2(v[2], v[3]), pack2(v[4], v[5]), pack2(v[6], v[7])}; }
struct RwcRaw { u32x4 r[3], k[3], v[3], sd, a; float fp, fn; };
#ifndef RWC_STOP
#define RWC_STOP 99
#endif
#ifndef RWC_DUMMY
#define RWC_DUMMY 0
#endif
#ifdef RWC_NOINLINE
__device__ __attribute__((noinline)) void rwc_item(const Params& p, int l, int chain, char* smem) {
#else
DEV void rwc_item(const Params& p, int l, int chain, char* smem) {
#endif
    const int tid = tidx(), lane = tid & 63, wave = __builtin_amdgcn_readfirstlane(tid >> 6), c16 = lane & 15, q4 = lane >> 4;
    const int dir = chain >> 5, b = (chain >> 2) & 7, head = chain & 3;
    bf16_t* L = (bf16_t*)smem;
    float* PC = (float*)(smem + L_RWEND * 2);
    float* CS = (float*)(L + L_ET);
    const bf16_t* P = wsb(p, OFF_P);
    const bf16_t* RWX = wsb(p, OFF_RWX);
    bf16_t* RWY = wsb(p, OFF_RWY) + (size_t)dir * TT * 256 + (RWC_DUMMY ? (size_t)2 * TT * 256 : 0);
    const int li = tid >> 3, c8 = (tid & 7) * 8, hc = head * 64 + c8;
    const int NCHK = (CTXL + SEQ) / RC;
    auto tok_of = [&](int c, int i, int& n, int& len) -> int {
        if (c < CTXL / RC) { const int pos = c * RC + i; len = CTXL; n = dir == 0 ? pos : CTXL - 1 - pos; return TL + b * CTXL + n; }
        const int pos = (c - CTXL / RC) * RC + i; len = SEQ; n = dir == 0 ? pos : SEQ - 1 - pos; return b * SEQ + n;
    };
    RwcRaw raw;
    auto load_raw = [&](int c) {
        int n, len; const int t = tok_of(c, li, n, len);
        const bf16_t* row = P + (size_t)t * LDP;
        const bool hp = n > 0, hn = n + 1 < len;
        const bf16_t* rp = hp ? row - LDP : row;
        const bf16_t* rn = hn ? row + LDP : row;
        raw.fp = hp ? 0.5f : 0.f; raw.fn = hn ? 0.5f : 0.f;
        raw.r[1] = *(const u32x4*)(row + C_RWR + hc); raw.k[1] = *(const u32x4*)(row + C_RWK + hc); raw.v[1] = *(const u32x4*)(row + C_RWV + hc);
        raw.r[0] = *(const u32x4*)(rp + C_RWR + hc); raw.k[0] = *(const u32x4*)(rp + C_RWK + hc); raw.v[0] = *(const u32x4*)(rp + C_RWV + hc);
        raw.r[2] = *(const u32x4*)(rn + C_RWR + hc); raw.k[2] = *(const u32x4*)(rn + C_RWK + hc); raw.v[2] = *(const u32x4*)(rn + C_RWV + hc);
        raw.sd = *(const u32x4*)(RWX + (size_t)t * 1024 + dir * 256 + hc);
        raw.a = *(const u32x4*)(RWX + (size_t)t * 1024 + 512 + dir * 256 + hc);
    };
    auto mix8 = [&](const u32x4 (&s)[3], const float* mu, float (&o)[8]) {
        float x[8], pv[8], nx[8]; unpack8(s[1], x); unpack8(s[0], pv); unpack8(s[2], nx);
        const float4 m0 = *(const float4*)mu, m1 = *(const float4*)(mu + 4);
        const float m[8] = { m0.x, m0.y, m0.z, m0.w, m1.x, m1.y, m1.z, m1.w };
#pragma unroll
        for (int j = 0; j < 8; ++j) o[j] = x[j] + ((raw.fp * pv[j] + raw.fn * nx[j]) - x[j]) * m[j];
    };
    f32x4 Wt[4];
#pragma unroll
    for (int j = 0; j < 4; ++j) Wt[j] = (f32x4){0.f, 0.f, 0.f, 0.f};
    __syncthreads();
    for (int i = tid; i < 64 * SK / 2; i += NT) ((unsigned*)(L + L_S))[i] = 0u;
    load_raw(0);
    for (int c = 0; c < (RWC_STOP == 0 ? 0 : NCHK); ++c) {
        {
            float r8[8], k8[8], v8[8], a8[8], sd8[8];
            mix8(raw.r, p.in[I_RMU] + (l * 4 + 0) * 256 + hc, r8);
            mix8(raw.k, p.in[I_RMU] + (l * 4 + 1) * 256 + hc, k8);
            mix8(raw.v, p.in[I_RMU] + (l * 4 + 2) * 256 + hc, v8);
            unpack8(raw.a, a8); unpack8(raw.sd, sd8);
            if (c + 1 < NCHK) load_raw(c + 1);
            const float4 kk0 = *(const float4*)(p.in[I_RKK] + l * 256 + hc), kk1 = *(const float4*)(p.in[I_RKK] + l * 256 + hc + 4);
            const float4 ka0 = *(const float4*)(p.in[I_RKA] + l * 256 + hc), ka1 = *(const float4*)(p.in[I_RKA] + l * 256 + hc + 4);
            const float kkc[8] = { kk0.x, kk0.y, kk0.z, kk0.w, kk1.x, kk1.y, kk1.z, kk1.w };
            const float kac[8] = { ka0.x, ka0.y, ka0.z, ka0.w, ka1.x, ka1.y, ka1.z, ka1.w };
            float kkv[8], bbv[8], kmv[8]; float n2 = 0.f;
#pragma unroll
            for (int j = 0; j < 8; ++j) { kkv[j] = k8[j] * kkc[j]; n2 += kkv[j] * kkv[j]; }
            n2 = row8_sum(n2);
            const float rn = 1.f / fmaxf(sqrtf(n2), 1e-12f);
#pragma unroll
            for (int j = 0; j < 8; ++j) { kkv[j] *= rn; bbv[j] = kkv[j] * a8[j]; kmv[j] = k8[j] * (1.f + (a8[j] - 1.f) * kac[j]); }
            *(float4*)(CS + li * 64 + c8) = make_float4(sd8[0], sd8[1], sd8[2], sd8[3]);
            *(float4*)(CS + li * 64 + c8 + 4) = make_float4(sd8[4], sd8[5], sd8[6], sd8[7]);
            __syncthreads();
            if (tid < 64) { float run = 0.f; for (int i = 0; i < RC; ++i) { run += CS[i * 64 + tid]; CS[i * 64 + tid] = run; } }
            __syncthreads();
            float cs[8], tot[8];
            { const float4 a0 = *(const float4*)(CS + li * 64 + c8), a1 = *(const float4*)(CS + li * 64 + c8 + 4);
              const float4 t0 = *(const float4*)(CS + (RC - 1) * 64 + c8), t1 = *(const float4*)(CS + (RC - 1) * 64 + c8 + 4);
              cs[0] = a0.x; cs[1] = a0.y; cs[2] = a0.z; cs[3] = a0.w; cs[4] = a1.x; cs[5] = a1.y; cs[6] = a1.z; cs[7] = a1.w;
              tot[0] = t0.x; tot[1] = t0.y; tot[2] = t0.z; tot[3] = t0.w; tot[4] = t1.x; tot[5] = t1.y; tot[6] = t1.z; tot[7] = t1.w; }
            float k1[8], r1[8], b1[8], m1[8], b2[8], m2[8];
#pragma unroll
            for (int j = 0; j < 8; ++j) {
                const float pinc = __expf(-cs[j]), pexc = __expf(sd8[j] - cs[j]), einv = __expf(cs[j]), ec = __expf(cs[j] - tot[j]);
                k1[j] = kkv[j] * pexc; r1[j] = r8[j] * pinc; b1[j] = bbv[j] * einv; m1[j] = kmv[j] * einv; b2[j] = bbv[j] * ec; m2[j] = kmv[j] * ec;
            }
            __syncthreads();
            *(u32x4*)(L + L_K1 + li * SK + c8) = pack8(k1); *(u32x4*)(L + L_R1 + li * SK + c8) = pack8(r1);
            *(u32x4*)(L + L_B1 + li * SK + c8) = pack8(b1); *(u32x4*)(L + L_M1 + li * SK + c8) = pack8(m1);
#pragma unroll
            for (int j = 0; j < 8; ++j) {
                L[L_VT + (c8 + j) * ST + li] = f2bf(v8[j]); L[L_B2T + (c8 + j) * ST + li] = f2bf(b2[j]); L[L_M2T + (c8 + j) * ST + li] = f2bf(m2[j]);
            }
            if (li == RC - 1) {
#pragma unroll
                for (int j = 0; j < 8; ++j) PC[c8 + j] = __expf(-tot[j]);
            }
            __syncthreads();
        }
        if (RWC_STOP <= 1) continue;
        {
            const int i0 = wave >> 1, j0 = wave & 1;
            const f32x4 z4 = (f32x4){0.f, 0.f, 0.f, 0.f};
            f32x4 aS = z4, aU = z4, bm = z4, ar = z4, br = z4;
#pragma unroll
            for (int kk2 = 0; kk2 < 2; ++kk2) {
                const bf16x8 k1i = ldfrag(L + L_K1, SK, i0 * 16, kk2 * 32, lane), k1j = ldfrag(L + L_K1, SK, j0 * 16, kk2 * 32, lane);
                const bf16x8 b1i = ldfrag(L + L_B1, SK, i0 * 16, kk2 * 32, lane), b1j = ldfrag(L + L_B1, SK, j0 * 16, kk2 * 32, lane);
                const bf16x8 m1i = ldfrag(L + L_M1, SK, i0 * 16, kk2 * 32, lane), r1j = ldfrag(L + L_R1, SK, j0 * 16, kk2 * 32, lane);
                aS = mfma16(b1i, k1j, aS);
                aU = mfma16(k1i, b1j, aU);
                bm = mfma16(m1i, k1j, bm);
                ar = mfma16(b1i, r1j, ar);
                br = mfma16(m1i, r1j, br);
            }
#ifdef RWC_WAIT
            __builtin_amdgcn_sched_barrier(0); __builtin_amdgcn_s_sleep(2); __builtin_amdgcn_sched_barrier(0);
#endif
            {
                const int t = j0 * 16 + c16, s0 = i0 * 16 + q4 * 4;
                f32x4 x, pa, o1, o2, o3;
#pragma unroll
                for (int r = 0; r < 4; ++r) {
                    const bool lt = s0 + r < t, le = s0 + r <= t;
                    x[r] = lt ? -aS[r] : 0.f; pa[r] = x[r] + ((s0 + r == t) ? 1.f : 0.f);
                    o1[r] = lt ? bm[r] : 0.f; o2[r] = le ? ar[r] : 0.f; o3[r] = le ? br[r] : 0.f;
                }
#ifdef RWC_GSTORE
                { bf16_t* gd = wsb(p, OFF_RWY) + (size_t)2 * TT * 256 + (size_t)(bidx() * 256 + tid) * 32;
                  st4(gd, x); st4(gd + 4, pa); st4(gd + 8, o1); st4(gd + 12, o2); st4(gd + 16, o3); }
#else
                st4(L + L_X + t * ST + s0, x); st4(L + L_PA + t * ST + s0, pa);
                st4(L + L_BM + t * ST + s0, o1); st4(L + L_AR + t * ST + s0, o2); st4(L + L_BR + t * ST + s0, o3);
#endif
            }
            {
                const int s = j0 * 16 + c16, t0 = i0 * 16 + q4 * 4;
                f32x4 o;
#pragma unroll
                for (int r = 0; r < 4; ++r) o[r] = (s < t0 + r) ? -aU[r] : 0.f;
#ifdef RWC_GSTORE
                st4(wsb(p, OFF_RWY) + (size_t)2 * TT * 256 + (size_t)(bidx() * 256 + tid) * 32 + 20, o);
#else
                st4(L + L_XT + s * ST + t0, o);
#endif
            }
            __syncthreads();
        }
        if (RWC_STOP <= 2) continue;
#pragma unroll 1
        for (int rd = 1; rd <= 5; ++rd) {
            const bool sq = rd <= 4, up = rd >= 2;
            const int i0 = wave >> 1, j0 = wave & 1;
            const bf16x8 xti = ldfrag(L + L_XT, ST, i0 * 16, 0, lane), xtj = ldfrag(L + L_XT, ST, j0 * 16, 0, lane);
            const bf16x8 xi = ldfrag(L + L_X, ST, i0 * 16, 0, lane), xj = ldfrag(L + L_X, ST, j0 * 16, 0, lane);
            const bf16x8 paj = ldfrag(L + L_PA, ST, j0 * 16, 0, lane);
            const u32x2 old = *(const u32x2*)(L + L_PA + (j0 * 16 + c16) * ST + i0 * 16 + q4 * 4);
            __syncthreads();
            const f32x4 z4 = (f32x4){0.f, 0.f, 0.f, 0.f};
            if (sq) {
                const f32x4 nx = mfma16(xti, xj, z4);
                const f32x4 nxt = mfma16(xi, xtj, z4);
                st4(L + L_X + (j0 * 16 + c16) * ST + i0 * 16 + q4 * 4, nx);
                st4(L + L_XT + (j0 * 16 + c16) * ST + i0 * 16 + q4 * 4, nxt);
            }
            if (up) {
                f32x4 acc = (f32x4){bflo(old.x), bfhi(old.x), bflo(old.y), bfhi(old.y)};
                acc = mfma16(xti, paj, acc);
                st4(L + L_PA + (j0 * 16 + c16) * ST + i0 * 16 + q4 * 4, acc);
            }
            __syncthreads();
        }
        if (RWC_STOP <= 3) continue;
        {
            const int vj = wave;
#pragma unroll
            for (int ti = 0; ti < 2; ++ti) {
                f32x4 acc = mfma16(ldfrag(L + L_BM, ST, ti * 16, 0, lane), ldfrag(L + L_VT, ST, vj * 16, 0, lane), (f32x4){0.f, 0.f, 0.f, 0.f});
#pragma unroll
                for (int kk2 = 0; kk2 < 2; ++kk2) acc = mfma16(ldfrag(L + L_K1, SK, ti * 16, kk2 * 32, lane), ldfrag(L + L_S, SK, vj * 16, kk2 * 32, lane), acc);
                st4(L + L_ET + (vj * 16 + c16) * ST + ti * 16 + q4 * 4, acc);
            }
            __syncthreads();
#pragma unroll
            for (int ti = 0; ti < 2; ++ti) {
                const f32x4 acc = mfma16(ldfrag(L + L_PA, ST, ti * 16, 0, lane), ldfrag(L + L_ET, ST, vj * 16, 0, lane), (f32x4){0.f, 0.f, 0.f, 0.f});
                st4(L + L_ZT + (vj * 16 + c16) * ST + ti * 16 + q4 * 4, -acc);
            }
            __syncthreads();
        }
        if (RWC_STOP <= 4) continue;
        {
            const int vi = wave;
#pragma unroll
            for (int tj = 0; tj < 2; ++tj) {
                f32x4 acc = (f32x4){0.f, 0.f, 0.f, 0.f};
#pragma unroll
                for (int kk2 = 0; kk2 < 2; ++kk2) acc = mfma16(ldfrag(L + L_S, SK, vi * 16, kk2 * 32, lane), ldfrag(L + L_R1, SK, tj * 16, kk2 * 32, lane), acc);
                acc = mfma16(ldfrag(L + L_ZT, ST, vi * 16, 0, lane), ldfrag(L + L_AR, ST, tj * 16, 0, lane), acc);
                acc = mfma16(ldfrag(L + L_VT, ST, vi * 16, 0, lane), ldfrag(L + L_BR, ST, tj * 16, 0, lane), acc);
                int n, len; const int t = tok_of(c, tj * 16 + c16, n, len);
                u32x2 o; o.x = pack2(acc[0], acc[1]); o.y = pack2(acc[2], acc[3]);
#ifndef RWC_NOYSTORE
                *(u32x2*)(RWY + (size_t)t * 256 + head * 64 + vi * 16 + q4 * 4) = o;
#else
                asm volatile("" :: "v"(o), "v"(t));
#endif
            }
            const float4 pc = *(const float4*)(PC + wave * 16 + q4 * 4);
            const bf16x8 fb2 = ldfrag(L + L_B2T, ST, wave * 16, 0, lane), fm2 = ldfrag(L + L_M2T, ST, wave * 16, 0, lane);
#pragma unroll
            for (int vj = 0; vj < 4; ++vj) {
                f32x4 acc = Wt[vj];
                acc[0] *= pc.x; acc[1] *= pc.y; acc[2] *= pc.z; acc[3] *= pc.w;
                acc = mfma16(fb2, ldfrag(L + L_ZT, ST, vj * 16, 0, lane), acc);
                acc = mfma16(fm2, ldfrag(L + L_VT, ST, vj * 16, 0, lane), acc);
                Wt[vj] = acc;
            }
            __syncthreads();
#pragma unroll
            for (int vj = 0; vj < 4; ++vj) st4(L + L_S + (vj * 16 + c16) * SK + wave * 16 + q4 * 4, Wt[vj]);
        }
    }
    __syncthreads();
#ifdef RWC_ZERO_LDS
    for (int i = tid; i < 73728 / 4; i += NT) ((unsigned*)smem)[i] = 0u;
    __syncthreads();
#endif
}
DEV void phase_s5_glu(const Params& p, int l, int M, char* smem) {
    const bf16_t* P = wsb(p, OFF_P);
    const bf16_t* w = wsb(p, OFF_WSM) + (size_t)l * WS_PER_LAYER + WS_GLUT;
    bf16_t* Y = wsb(p, OFF_Y);
    const float* bg = p.in[I_S5BGLU] + l * 256;
    gemm_generic(P + C_S5, LDP, M, w, 256, 256, 256,
                 [&](int r, int c, float v) { const float z = bf2f(P[(size_t)r * LDP + C_S5 + c]); Y[(size_t)r * 1024 + 256 + c] = f2bf(z * sigmoidf_(v + bg[c])); }, smem, 0);
}
DEV void phase_rw_finish(const Params& p, int l, int M) {
    const int lane = tidx() & 63, wave = tidx() >> 6;
    const bf16_t* P = wsb(p, OFF_P);
    const bf16_t* RWX = wsb(p, OFF_RWX);
    const bf16_t* RWY = wsb(p, OFF_RWY);
    bf16_t* Y = wsb(p, OFF_Y);
    const int c = lane * 4;
    const float4 mur = *(const float4*)(p.in[I_RMU] + (l * 4 + 0) * 256 + c);
    const float4 muk = *(const float4*)(p.in[I_RMU] + (l * 4 + 1) * 256 + c);
    const float4 muv = *(const float4*)(p.in[I_RMU] + (l * 4 + 2) * 256 + c);
    const float4 ka4 = *(const float4*)(p.in[I_RKA] + l * 256 + c);
    const float4 rk4 = *(const float4*)(p.in[I_RRK] + l * 256 + c);
    const float4 lg4 = *(const float4*)(p.in[I_RLNG] + l * 256 + c);
    const float4 lb4 = *(const float4*)(p.in[I_RLNB] + l * 256 + c);
    const float mr_[4] = { mur.x, mur.y, mur.z, mur.w }, mk_[4] = { muk.x, muk.y, muk.z, muk.w }, mv_[4] = { muv.x, muv.y, muv.z, muv.w };
    const float ka_[4] = { ka4.x, ka4.y, ka4.z, ka4.w }, rk_[4] = { rk4.x, rk4.y, rk4.z, rk4.w }, lg_[4] = { lg4.x, lg4.y, lg4.z, lg4.w }, lb_[4] = { lb4.x, lb4.y, lb4.z, lb4.w };
    for (int t = bidx() * 4 + wave; t < M; t += gridDim.x * 4) {
        int base, n, len; tok_seq(t, base, n, len);
        const bf16_t* row = P + (size_t)t * LDP;
        const bool hp = n > 0, hn = n + 1 < len;
        const u32x2 z = (u32x2){0u, 0u};
        float r4[4], k4[4], v4[4];
        {
            const u32x2 cu = *(const u32x2*)(row + C_RWR + c), pv = hp ? *(const u32x2*)(row - LDP + C_RWR + c) : z, nx = hn ? *(const u32x2*)(row + LDP + C_RWR + c) : z;
            const float x[4] = { bflo(cu.x), bfhi(cu.x), bflo(cu.y), bfhi(cu.y) }, a[4] = { bflo(pv.x), bfhi(pv.x), bflo(pv.y), bfhi(pv.y) }, b[4] = { bflo(nx.x), bfhi(nx.x), bflo(nx.y), bfhi(nx.y) };
#pragma unroll
            for (int j = 0; j < 4; ++j) r4[j] = x[j] + (0.5f * (a[j] + b[j]) - x[j]) * mr_[j];
        }
        {
            const u32x2 cu = *(const u32x2*)(row + C_RWK + c), pv = hp ? *(const u32x2*)(row - LDP + C_RWK + c) : z, nx = hn ? *(const u32x2*)(row + LDP + C_RWK + c) : z;
            const float x[4] = { bflo(cu.x), bfhi(cu.x), bflo(cu.y), bfhi(cu.y) }, a[4] = { bflo(pv.x), bfhi(pv.x), bflo(pv.y), bfhi(pv.y) }, b[4] = { bflo(nx.x), bfhi(nx.x), bflo(nx.y), bfhi(nx.y) };
#pragma unroll
            for (int j = 0; j < 4; ++j) k4[j] = x[j] + (0.5f * (a[j] + b[j]) - x[j]) * mk_[j];
        }
        {
            const u32x2 cu = *(const u32x2*)(row + C_RWV + c), pv = hp ? *(const u32x2*)(row - LDP + C_RWV + c) : z, nx = hn ? *(const u32x2*)(row + LDP + C_RWV + c) : z;
            const float x[4] = { bflo(cu.x), bfhi(cu.x), bflo(cu.y), bfhi(cu.y) }, a[4] = { bflo(pv.x), bfhi(pv.x), bflo(pv.y), bfhi(pv.y) }, b[4] = { bflo(nx.x), bfhi(nx.x), bflo(nx.y), bfhi(nx.y) };
#pragma unroll
            for (int j = 0; j < 4; ++j) v4[j] = x[j] + (0.5f * (a[j] + b[j]) - x[j]) * mv_[j];
        }
        const u32x2 af = *(const u32x2*)(RWX + (size_t)t * 1024 + 512 + c), ab = *(const u32x2*)(RWX + (size_t)t * 1024 + 768 + c);
        const float a0[4] = { bflo(af.x), bfhi(af.x), bflo(af.y), bfhi(af.y) }, a1[4] = { bflo(ab.x), bfhi(ab.x), bflo(ab.y), bfhi(ab.y) };
        const u32x2 yf = *(const u32x2*)(RWY + (size_t)t * 256 + c), yb = *(const u32x2*)(RWY + (size_t)TT * 256 + (size_t)t * 256 + c);
        float y[4] = { bflo(yf.x) + bflo(yb.x), bfhi(yf.x) + bfhi(yb.x), bflo(yf.y) + bflo(yb.y), bfhi(yf.y) + bfhi(yb.y) };
        float s = y[0] + y[1] + y[2] + y[3];
        s = group_sum<16>(s);
        const float mean = s * (1.f / 64.f);
        float q = 0.f, bon = 0.f;
#pragma unroll
        for (int j = 0; j < 4; ++j) {
            const float dlt = y[j] - mean; q += dlt * dlt;
            const float kmsum = k4[j] * (2.f + (a0[j] + a1[j] - 2.f) * ka_[j]);
            bon += r4[j] * kmsum * rk_[j];
        }
        q = group_sum<16>(q); bon = group_sum<16>(bon);
        const float rstd = rsqrtf(q * (1.f / 64.f) + 64e-5f);
        const u32x2 gg = *(const u32x2*)(row + C_RWD + c);
        const float g[4] = { bflo(gg.x), bfhi(gg.x), bflo(gg.y), bfhi(gg.y) };
        float o[4];
#pragma unroll
        for (int j = 0; j < 4; ++j) o[j] = ((y[j] - mean) * rstd * lg_[j] + lb_[j] + bon * v4[j]) * g[j];
        u32x2 ov; ov.x = pack2(o[0], o[1]); ov.y = pack2(o[2], o[3]);
        *(u32x2*)(Y + (size_t)t * 1024 + 768 + c) = ov;
    }
}

DEV int queue_next(int* ctr, char* smem) {
    int* slot = (int*)(smem + MOE_MAP_OFF + 208);
    __syncthreads();
    if (tidx() == 0) *slot = atomicAdd(ctr, 1);
    __syncthreads();
    return __builtin_amdgcn_readfirstlane(*slot);
}
DEV void phase_mixers(const Params& p, int l, int rep, char* smem) {
    const bool need_ctx = (l == 0);
#ifndef RWMODE
#define RWMODE 2
#endif
    const int nrw = RWMODE == 0 ? 64 : (RWMODE == 1 ? 256 + 64 : 256), nda = need_ctx ? 576 : 512, ns5 = 32 * (need_ctx ? 9 : 8);
    const int total = nrw + 2 * nda + (rep == 0 ? ns5 : 0);
    int* ctr = (int*)(p.ws + OFF_CTR) + CTR_Q + l * 16 + rep * 4;
    for (;;) {
        const int item = queue_next(ctr, smem);
        if (item >= total) break;
#ifndef PROBE7
#define PROBE7 0
#endif
        if (rep > 0 && PROBE7 == 1 && item >= nrw) break;
        if (rep > 0 && PROBE7 == 2 && item < nrw) continue;
        if (rep > 0 && PROBE7 == 3 && (item < nrw || item >= nrw + nda)) continue;
#if RWMODE == 2
        if (item < nrw) rw_item(p, l, item, smem, 0);
#elif RWMODE == 0
        if (item < nrw) rwc_item(p, l, item, smem);
#else
        if (item < nrw) { if (item < 256) rw_item(p, l, item, smem, 0); else rwc_item(p, l, item - 256, smem); }
#endif
        else if (item < nrw + nda) da_item(p, l, item - nrw, smem);
        else if (item < nrw + 2 * nda) mla_item(p, l, item - nrw - nda, smem);
        else s5_pass2_item(p, l, need_ctx ? 0 : 1, item - nrw - 2 * nda, smem);
    }
}
#ifndef MEGA
#define MEGA 0
#endif
constexpr int NPHASE = 15;
template <int PH>
DEV void run_phase(const Params& p, int l, char* smem) {
    const bool need_ctx = (l == 0);
    const int M = need_ctx ? TT : TL;
    if constexpr (PH == 0) { phase_mod_partial(p, smem); __syncthreads(); phase_conv_small(p, smem); phase_conv_layer(p, 0, smem); phase_conv_experts(p, 0, smem); }
    if constexpr (PH == 1) { phase_mod_reduce(p); }
    if constexpr (PH == 2) { phase_norm<1>(p, l, TT, smem); if (l == 1) { phase_conv_layer(p, 1, smem); phase_conv_experts(p, 1, smem); } }
    if constexpr (PH == 3) { phase_inproj(p, l, smem); }
    if constexpr (PH == 4) { phase_prep1(p, l); phase_s5_pass1(p, l, smem); }
    if constexpr (PH == 5) { phase_prep_gemm1(p, l, smem); }
    if constexpr (PH == 6) { phase_prep_gemm2(p, l, smem); phase_prep2(p, l); }
    if constexpr (PH == 7) { phase_mixers(p, l, 0, smem); }
    if constexpr (PH == 8) { phase_s5_glu(p, l, M, smem); phase_rw_finish(p, l, M); }
    if constexpr (PH == 9) { phase_merge(p, l, M, smem); }
    if constexpr (PH == 10) { phase_outproj(p, l, M, smem); }
    if constexpr (PH == 11) { phase_norm<2>(p, l, M, smem); }
    if constexpr (PH == 14) { phase_route(p, l, M, smem); }
    if constexpr (PH == 15) { phase_combine(p, l, M); }
    if constexpr (PH == 12) { phase_moe1(p, l, smem); }
    if constexpr (PH == 13) { phase_moe2(p, l, smem); }
}

#if !MEGA
template <int PH>
__global__ void __launch_bounds__(NT, 2) k_phase(Params p, int l) {
    extern __shared__ __attribute__((aligned(16))) char smem[];
    run_phase<PH>(p, l, smem);
}
#endif
#ifndef REP0
#define REP0 1
#endif
#ifndef REP2
#define REP2 1
#endif
#ifndef REP3
#define REP3 1
#endif
#ifndef REP5
#define REP5 1
#endif
#ifndef REP6
#define REP6 1
#endif
#ifndef REP7
#define REP7 1
#endif
#ifndef REP8
#define REP8 1
#endif
#ifndef REP9
#define REP9 1
#endif
#ifndef REP12
#define REP12 1
#endif
#if MEGA
__global__ void __launch_bounds__(NT, 2) k_mega(Params p) {
    extern __shared__ __attribute__((aligned(16))) char smem[];
    uint4* xbw = (uint4*)(smem + MOE_MAP_OFF + 240);
    if (threadIdx.x == 0) *xbw = make_uint4(0u, 0u, 0u, 0u);
    __syncthreads();
    XcdBarrier bar = xcd_barrier_post((unsigned*)(p.ws + OFF_BAR), (volatile LAS unsigned*)xbw);
    for (int r = 0; r < REP0; ++r) { run_phase<0>(p, 0, smem); xcd_barrier(bar); }
    run_phase<1>(p, 0, smem); xcd_barrier(bar);
    for (int l = 0; l < 2; ++l) {
        for (int r = 0; r < REP2; ++r) { run_phase<2>(p, l, smem); xcd_barrier(bar); }
        for (int r = 0; r < REP3; ++r) { run_phase<3>(p, l, smem); xcd_barrier(bar); }

        run_phase<4>(p, l, smem); xcd_barrier(bar);
#ifdef PROBE_S5P1
        phase_s5_pass1(p, l, smem); xcd_barrier(bar);
#endif
#ifdef PROBE_BAR
        for (int r = 0; r < PROBE_BAR; ++r) xcd_barrier(bar);
#endif
        for (int r = 0; r < REP5; ++r) { run_phase<5>(p, l, smem); xcd_barrier(bar); }
        for (int r = 0; r < REP6; ++r) { run_phase<6>(p, l, smem); xcd_barrier(bar); }
#ifdef RWC_PRE
        if (bidx() < 64) rwc_item(p, l, bidx(), smem);
#endif
        for (int r = 0; r < REP7; ++r) { int l7 = l; asm volatile("" : "+s"(l7)); phase_mixers(p, l7, r, smem); xcd_barrier(bar); }
#ifdef RWC_SEP
        for (int item = bidx(); item < 64; item += gridDim.x) rwc_item(p, l, item, smem);
        xcd_barrier(bar);
#endif
        for (int r = 0; r < REP8; ++r) { run_phase<8>(p, l, smem); xcd_barrier(bar); }
        for (int r = 0; r < REP9; ++r) { run_phase<9>(p, l, smem); xcd_barrier(bar); }
        run_phase<10>(p, l, smem); xcd_barrier(bar);
#ifdef PROBE_OUT2
        if (l == 0) { run_phase<10>(p, l, smem); xcd_barrier(bar); }
#endif

        run_phase<11>(p, l, smem); xcd_barrier(bar);
        run_phase<14>(p, l, smem); xcd_barrier(bar);
        for (int r = 0; r < REP12; ++r) { run_phase<12>(p, l, smem); xcd_barrier(bar); }
        run_phase<13>(p, l, smem); xcd_barrier(bar);
#ifdef PROBE_MOE2B
        run_phase<13>(p, l, smem); xcd_barrier(bar);
#endif
        run_phase<15>(p, l, smem); if (l == 0) xcd_barrier(bar);
    }
}
#endif
__global__ void __launch_bounds__(NT) k_fail(float* out, int n) {
    for (int i = blockIdx.x * NT + threadIdx.x; i < n; i += gridDim.x * NT) out[i] = __int_as_float(0x7fc00000);
}

template <int PH>
static void launch_phase(const Params& p, int l, int grid, hipStream_t stream) {
#if !MEGA
    static bool attr = false;
    if (!attr) { (void)hipFuncSetAttribute((const void*)k_phase<PH>, hipFuncAttributeMaxDynamicSharedMemorySize, SMEM_BYTES); attr = true; }
    hipLaunchKernelGGL(k_phase<PH>, dim3(grid), dim3(NT), SMEM_BYTES, stream, p, l);
#endif
}

extern "C" void kernel_launch(void* const* d_in, const int* in_sizes, int n_in, void* d_out, int out_size, void* d_ws, size_t ws_size, hipStream_t stream) {
    if (n_in != 48 || out_size != TL * DM || ws_size < WS_END) {
        hipLaunchKernelGGL(k_fail, dim3(256), dim3(NT), 0, stream, (float*)d_out, out_size);
        return;
    }
    Params p{};
    for (int i = 0; i < 48; ++i) p.in[i] = (const float*)d_in[i];
    p.out = (float*)d_out; p.ws = (char*)d_ws;
    (void)hipMemsetAsync(d_ws, 0, ZERO_BYTES, stream);
#if MEGA
    static int grid = 0;
    if (grid == 0) {
        int dev = 0, cus = 0, per_cu = 0;
        (void)hipGetDevice(&dev);
        (void)hipDeviceGetAttribute(&cus, hipDeviceAttributeMultiprocessorCount, dev);
        (void)hipFuncSetAttribute((const void*)k_mega, hipFuncAttributeMaxDynamicSharedMemorySize, SMEM_BYTES);
        if (hipOccupancyMaxActiveBlocksPerMultiprocessor(&per_cu, (const void*)k_mega, NT, SMEM_BYTES) != hipSuccess || per_cu < 1) per_cu = 1;
        (void)hipGetLastError();
        if (cus <= 0) cus = 256;
        grid = cus * (per_cu < 2 ? per_cu : 2);
    }
    hipLaunchKernelGGL(k_mega, dim3(grid), dim3(NT), SMEM_BYTES, stream, p);
#else
    const int grid = 512;
    launch_phase<0>(p, 0, grid, stream);
    launch_phase<1>(p, 0, grid, stream);
    for (int l = 0; l < 2; ++l) {
        launch_phase<2>(p, l, grid, stream);
        launch_phase<3>(p, l, grid, stream);
        launch_phase<4>(p, l, grid, stream);
        launch_phase<5>(p, l, grid, stream);
        launch_phase<6>(p, l, grid, stream);
        launch_phase<7>(p, l, grid, stream);
        launch_phase<8>(p, l, grid, stream);
        launch_phase<9>(p, l, grid, stream);
        launch_phase<10>(p, l, grid, stream);
        launch_phase<11>(p, l, grid, stream);
        launch_phase<14>(p, l, grid, stream);
        launch_phase<12>(p, l, grid, stream);
        launch_phase<13>(p, l, grid, stream);
        launch_phase<15>(p, l, grid, stream);
    }
#endif
}
```

```cpp
#define MEGA 1
#include <hip/hip_runtime.h>
#include <stdint.h>
#include <math.h>

#define DEV __device__ __forceinline__
#define LAS __attribute__((address_space(3)))
typedef unsigned short bf16_t;
typedef short bf16x8 __attribute__((ext_vector_type(8)));
typedef float f32x16 __attribute__((ext_vector_type(16)));
typedef float f32x4 __attribute__((ext_vector_type(4)));
typedef unsigned u32x4 __attribute__((ext_vector_type(4)));
typedef unsigned u32x2 __attribute__((ext_vector_type(2)));

constexpr int NT = 256;
constexpr int DM = 1024, NB = 8, SEQ = 2048, CTXL = 256, GRIDW = 64;
constexpr int TL = NB * SEQ, TC = NB * CTXL, TT = TL + TC;
constexpr int NIN = 6480, LDP = 2432, NINP = 6528, NGATE0 = 2432;
constexpr int C_DAQ = 0, C_DAK = 256, C_DAV = 512, C_S5 = 768, C_CQ = 1024, C_CKV = 1216, C_KR = 1344,
              C_RWR = 1360, C_RWK = 1616, C_RWV = 1872, C_RWD = 2128, C_PEND = 2384;
constexpr int NEXP = 16, DFF = 512;
constexpr float EPS = 1e-6f;
constexpr float LOG2E = 1.4426950408889634f;

constexpr size_t al256(size_t x) { return (x + 255) & ~(size_t)255; }
constexpr size_t OFF_BAR  = 0;
constexpr size_t OFF_CTR  = 16384;
constexpr size_t ZERO_BYTES = 20480;
constexpr size_t OFF_MOD  = 32768;
constexpr size_t SZ_MOD   = (size_t)2 * 9 * 6144 * 4;
constexpr int    MOD_KS   = 8;
constexpr size_t OFF_MODP = al256(OFF_MOD + SZ_MOD);
constexpr size_t OFF_S5ST = al256(OFF_MODP + MOD_KS * SZ_MOD);
constexpr size_t OFF_LTOK = al256(OFF_S5ST + (size_t)2 * 8 * 16 * 8 * 64 * 2 * 4);
constexpr size_t OFF_LW   = al256(OFF_LTOK + (size_t)NEXP * TT * 4);
constexpr size_t OFF_TOKI = al256(OFF_LW + (size_t)NEXP * TT * 4);
constexpr size_t OFF_TOKW = al256(OFF_TOKI + (size_t)TT * 16);
constexpr size_t OFF_CNTB = al256(OFF_TOKW + (size_t)TT * 8);
constexpr size_t OFF_WSM  = al256(OFF_CNTB + (size_t)1024 * 16 * 4);
constexpr int WS_GLUT = 0, WS_UQT = WS_GLUT + 256 * 256, WS_UKVT = WS_UQT + 192 * 192, WS_W1C = WS_UKVT + 384 * 128,
              WS_W2 = WS_W1C + 192 * 256, WS_G2T = WS_W2 + 4 * 256 * 64, WS_PER_LAYER = WS_G2T + 256 * 64;
constexpr size_t OFF_WIN  = al256(OFF_WSM + (size_t)2 * WS_PER_LAYER * 2);
constexpr size_t OFF_WBR  = al256(OFF_WIN + (size_t)NINP * 1024 * 2);
constexpr size_t OFF_WOUT = al256(OFF_WBR + (size_t)4 * 1024 * 256 * 2);
constexpr size_t OFF_WG1  = al256(OFF_WOUT + (size_t)1024 * 1024 * 2);
constexpr size_t OFF_WDN  = al256(OFF_WG1 + (size_t)NEXP * 1024 * 1024 * 2);
constexpr size_t OFF_H    = al256(OFF_WDN + (size_t)NEXP * 1024 * 512 * 2);
constexpr size_t OFF_P    = al256(OFF_H + (size_t)TT * 1024 * 2);
constexpr size_t OFF_GATE = al256(OFF_P + (size_t)TT * LDP * 2);
constexpr size_t OFF_MLAQ = al256(OFF_GATE + (size_t)TT * 4096);
constexpr size_t OFF_MLAK = al256(OFF_MLAQ + (size_t)TT * 192 * 2);
constexpr size_t OFF_MLAV = al256(OFF_MLAK + (size_t)TT * 192 * 2);
constexpr size_t OFF_RWX  = al256(OFF_MLAV + (size_t)TT * 256 * 2);
constexpr size_t OFF_Y    = al256(OFF_RWX + (size_t)TT * 1024 * 2);
constexpr size_t OFF_CX   = al256(OFF_Y + (size_t)TT * 1024 * 2);
constexpr size_t OFF_S5Y  = al256(OFF_CX + (size_t)TC * 1024 * 4);
constexpr size_t WS_END   = al256(OFF_S5Y + (size_t)TT * 256 * 2);
constexpr size_t OFF_QRAW = OFF_Y;
constexpr size_t OFF_KVRAW = OFF_QRAW + (size_t)TT * 192 * 2;
constexpr size_t OFF_LR   = OFF_KVRAW + (size_t)TT * 384 * 2;
constexpr size_t OFF_XL   = OFF_LR + (size_t)TT * 192 * 2;
constexpr size_t OFF_Z    = OFF_GATE;
static_assert(OFF_XL + (size_t)TT * 256 * 2 <= OFF_Y + (size_t)TT * 1024 * 2, "temps overflow Y");
constexpr size_t OFF_RWY  = OFF_H;

constexpr int CTR_MOE = 0;
constexpr int CTR_Q   = 64;

constexpr int SMEM_BYTES = 73728 + 256;

struct Params {
    const float* in[48];
    float* out;
    char* ws;
};
enum { I_X = 0, I_C, I_CTX, I_CCTX, I_WADA, I_BADA, I_NMG, I_NFG, I_WIN, I_DAQKG, I_DALAM, I_DASUB,
       I_S5LRE, I_S5LIM, I_S5LDT, I_S5BRE, I_S5BIM, I_S5CRE, I_S5CIM, I_S5D, I_S5WGLU, I_S5BGLU,
       I_MCQG, I_MCKVG, I_MWUQ, I_MWUKV, I_MQKG,
       I_RMU, I_RW0, I_RW1, I_RW2, I_RA0, I_RA1, I_RA2, I_RG1, I_RG2, I_RKK, I_RKA, I_RRK, I_RLNG, I_RLNB,
       I_WBR, I_WOUT, I_ROUTW, I_ROUTB, I_EWG, I_EWU, I_EWD };

DEV int tidx() { int t = threadIdx.x; asm volatile("" : "+v"(t)); return t; }
DEV int bidx() { int b = blockIdx.x; asm volatile("" : "+s"(b)); return b; }
typedef float f32x2_ __attribute__((ext_vector_type(2)));
typedef __bf16 bf16x2_ __attribute__((ext_vector_type(2)));
DEV unsigned cvt_pk_bf16(float lo, float hi) { const f32x2_ v = {lo, hi}; const bf16x2_ b = __builtin_convertvector(v, bf16x2_); return __builtin_bit_cast(unsigned, b); }
DEV bf16_t f2bf(float f) { return (bf16_t)(cvt_pk_bf16(f, 0.f) & 0xFFFFu); }
DEV float bf2f(bf16_t h) { return __uint_as_float(((unsigned)h) << 16); }
DEV unsigned pack2(float lo, float hi) { return cvt_pk_bf16(lo, hi); }
DEV float bflo(unsigned u) { return __uint_as_float(u << 16); }
DEV float bfhi(unsigned u) { return __uint_as_float(u & 0xFFFF0000u); }
DEV float sigmoidf_(float x) { return 1.f / (1.f + __expf(-x)); }
DEV float wave_sum(float v) {
#pragma unroll
    for (int o = 32; o >= 1; o >>= 1) v += __shfl_xor(v, o, 64);
    return v;
}
template <int W> DEV float group_sum(float v) {
#pragma unroll
    for (int o = W / 2; o >= 1; o >>= 1) v += __shfl_xor(v, o, 64);
    return v;
}
DEV int mod_row(int t) { return t < TL ? (t >> 11) : 8; }
DEV bf16_t* wsb(const Params& p, size_t off) { return (bf16_t*)(p.ws + off); }
DEV float* wsf(const Params& p, size_t off) { return (float*)(p.ws + off); }
DEV const float* modp(const Params& p, int l, int row, int which) { return (const float*)(p.ws + OFF_MOD) + ((size_t)(l * 9 + row) * 6 + which) * 1024; }
#define XB_TMO      128
#define XB_XCNT(j)  (256  + 64 * (j))
#define XB_XSUB(j)  (1280 + 64 * (j))
#define XB_XGEN(j)  (2304 + 64 * (j))
#define XB_TOP      3328
#define XB_TOPGEN   3392
#define XCD_BAR_WORDS 3456
#define XB_SPIN_CAP (1u << 18)

__device__ __forceinline__ unsigned xb_ld(unsigned* p)              { return __hip_atomic_load(p, __ATOMIC_RELAXED, __HIP_MEMORY_SCOPE_AGENT); }
__device__ __forceinline__ unsigned xb_add(unsigned* p, unsigned v) { return __hip_atomic_fetch_add(p, v, __ATOMIC_RELAXED, __HIP_MEMORY_SCOPE_AGENT); }
__device__ __forceinline__ unsigned xb_xcc_id() { return (unsigned)__builtin_amdgcn_s_getreg((3 << 11) | 20) & 0xFu; }
#define XB_SPIN(cond, bar) do { unsigned _sp = 0; while (cond) { __builtin_amdgcn_s_sleep(1); \
    if ((++_sp & 255u) == 0u) { if (xb_ld(&(bar)[XB_TMO])) break; if (_sp > XB_SPIN_CAP) { atomicAdd(&(bar)[XB_TMO], 1u); break; } } } } while (0)

struct XcdBarrier {
    unsigned* bar; unsigned x;
    volatile LAS unsigned* st;
};

__device__ __forceinline__ XcdBarrier xcd_barrier_post(unsigned* bar, volatile LAS unsigned* st) {
    XcdBarrier b; b.bar = bar; b.x = xb_xcc_id(); b.st = st;
    if (threadIdx.x == 0) (void)xb_add(&bar[XB_XCNT(b.x)], 1u);
    return b;
}
__device__ __forceinline__ void xcd_barrier_complete(unsigned* bar, unsigned x, unsigned& nloc, unsigned& nx) {
    const unsigned G = gridDim.x * gridDim.y * gridDim.z;
    unsigned sum, cnt, mine, sp = 0u;
    for (;;) {
        sum = 0u; cnt = 0u; mine = 0u;
#pragma unroll
        for (unsigned j = 0; j < 16; ++j) { const unsigned c = xb_ld(&bar[XB_XCNT(j)]); sum += c; cnt += (c > 0u) ? 1u : 0u; mine = (j == x) ? c : mine; }
        if (sum == G) break;
        __builtin_amdgcn_s_sleep(1);
        if ((++sp & 255u) == 0u) { if (xb_ld(&bar[XB_TMO])) break; if (sp > XB_SPIN_CAP) { atomicAdd(&bar[XB_TMO], 1u); break; } }
    }
    nloc = mine > 0u ? mine : 1u; nx = cnt > 0u ? cnt : 1u;
}

__device__ __forceinline__ void xcd_barrier(const XcdBarrier& b) {
    asm volatile("s_waitcnt vmcnt(0)" ::: "memory");
    __syncthreads();
    if (threadIdx.x == 0) {
        unsigned* bar = b.bar;
        __builtin_amdgcn_s_waitcnt(0);
        unsigned nloc = b.st[0], nx = b.st[1];
        if (nloc == 0u) { xcd_barrier_complete(bar, b.x, nloc, nx); b.st[0] = nloc; b.st[1] = nx; }
        const unsigned old = xb_add(&bar[XB_XSUB(b.x)], 1u);
        const unsigned gen = old / nloc;
        if (old + 1u == (gen + 1u) * nloc) {
            __builtin_amdgcn_fence(__ATOMIC_RELEASE, "agent");
            asm volatile("s_waitcnt vmcnt(0)" ::: "memory");
            const unsigned og = xb_add(&bar[XB_TOP], 1u);
            const unsigned tg = og / nx;
            if (og + 1u == (tg + 1u) * nx) xb_add(&bar[XB_TOPGEN], 1u);
            else XB_SPIN(xb_ld(&bar[XB_TOPGEN]) == tg, bar);
            __builtin_amdgcn_fence(__ATOMIC_ACQUIRE, "agent");
            xb_add(&bar[XB_XGEN(b.x)], 1u);
            asm volatile("s_waitcnt vmcnt(0)" ::: "memory");
        } else {
            XB_SPIN(xb_ld(&bar[XB_XGEN(b.x)]) == gen, bar);
            __builtin_amdgcn_fence(__ATOMIC_ACQUIRE, "agent");
            asm volatile("s_waitcnt vmcnt(0)" ::: "memory");
        }
    }
    __syncthreads();
}

DEV void phase_mod_partial(const Params& p, char* smem) {
    float* sm = (float*)smem;
    const int tid = tidx();
    const int nitems = 2 * 24 * MOD_KS;
    for (int item = bidx(); item < nitems; item += gridDim.x) {
        const int l = item / (24 * MOD_KS), rem = item % (24 * MOD_KS), jc = rem / MOD_KS, ks = rem % MOD_KS;
        __syncthreads();
        for (int i = tid; i < 9 * 128; i += NT) {
            const int r = i >> 7, k = ks * 128 + (i & 127);
            const float cv = r < 8 ? p.in[I_C][r * 1024 + k] : p.in[I_CCTX][k];
            sm[i] = cv / (1.f + __expf(-cv));
        }
        __syncthreads();
        const int j = jc * 256 + tid;
        float acc[9];
#pragma unroll
        for (int r = 0; r < 9; ++r) acc[r] = 0.f;
        const float* w = p.in[I_WADA] + (size_t)l * 1024 * 6144 + (size_t)(ks * 128) * 6144 + j;
#pragma unroll 8
        for (int k = 0; k < 128; ++k) {
            const float wv = w[(size_t)k * 6144];
#pragma unroll
            for (int r = 0; r < 9; ++r) acc[r] += sm[r * 128 + k] * wv;
        }
        float* dst = wsf(p, OFF_MODP);
#pragma unroll
        for (int r = 0; r < 9; ++r) dst[((size_t)(ks * 2 + l) * 9 + r) * 6144 + j] = acc[r];
    }
}
DEV void phase_mod_reduce(const Params& p) {
    const int n = 2 * 9 * 6144;
    float* mod = wsf(p, OFF_MOD);
    const float* part = wsf(p, OFF_MODP);
    for (int i = bidx() * NT + tidx(); i < n; i += gridDim.x * NT) {
        const int l = i / (9 * 6144), j = i % 6144;
        float s = p.in[I_BADA][l * 6144 + j];
#pragma unroll
        for (int ks = 0; ks < MOD_KS; ++ks) s += part[(size_t)ks * n + i];
        mod[i] = s;
    }
}

struct ConvRegs { float4 v[4]; };
DEV void conv_load(const float* src, int R, int C, int ld, int tr, int tc, ConvRegs& cr) {
    const int r0 = tr * 64, c0 = tc * 64, tid = tidx();
#pragma unroll
    for (int k = 0; k < 4; ++k) {
        const int i = tid + k * NT, r = i >> 4, c4 = (i & 15) * 4;
        float4 v = make_float4(0.f, 0.f, 0.f, 0.f);
        if (r0 + r < R) {
            const float* s = src + (size_t)(r0 + r) * ld + c0 + c4;
            if (c0 + c4 + 3 < C) v = *(const float4*)s;
            else { if (c0 + c4 < C) v.x = s[0]; if (c0 + c4 + 1 < C) v.y = s[1]; if (c0 + c4 + 2 < C) v.z = s[2]; }
        }
        cr.v[k] = v;
    }
}
template <int MODE>
DEV void conv_store(const ConvRegs& cr, int R, int C, bf16_t* dst, int ldd, int roff, int tr, int tc, float* sm) {
    const int r0 = tr * 64, c0 = tc * 64, tid = tidx();
    __syncthreads();
#pragma unroll
    for (int k = 0; k < 4; ++k) {
        const int i = tid + k * NT, r = i >> 4, c4 = (i & 15) * 4;
        float* d = sm + r * 65 + c4;
        d[0] = cr.v[k].x; d[1] = cr.v[k].y; d[2] = cr.v[k].z; d[3] = cr.v[k].w;
    }
    __syncthreads();
    for (int i = tid; i < 64 * 8; i += NT) {
        const int c = i >> 3, r8 = (i & 7) * 8;
        if (c0 + c < C && r0 + r8 < R) {
            const int cc = c0 + c;
            const int drow = (MODE == 0) ? (cc + roff) : ((cc >> 5) * 64 + (cc & 31) + roff);
            u32x4 o;
            o[0] = pack2(sm[(r8 + 0) * 65 + c], sm[(r8 + 1) * 65 + c]);
            o[1] = pack2(sm[(r8 + 2) * 65 + c], sm[(r8 + 3) * 65 + c]);
            o[2] = pack2(sm[(r8 + 4) * 65 + c], sm[(r8 + 5) * 65 + c]);
            o[3] = pack2(sm[(r8 + 6) * 65 + c], sm[(r8 + 7) * 65 + c]);
            *(u32x4*)(dst + (size_t)drow * ldd + r0 + r8) = o;
        }
    }
}
template <int MODE>
DEV void conv_job(const float* src, int R, int C, int ld, bf16_t* dst, int ldd, int roff, int& rot, float* sm) {
    const int ntr = (R + 63) >> 6, ntc = (C + 63) >> 6, nt = ntr * ntc, G = gridDim.x;
    const int first = (bidx() - (rot % G) + G) % G;
    ConvRegs cur;
    if (first < nt) conv_load(src, R, C, ld, first / ntc, first % ntc, cur);
    for (int t = first; t < nt; t += G) {
        ConvRegs nxt = cur;
        if (t + G < nt) conv_load(src, R, C, ld, (t + G) / ntc, (t + G) % ntc, nxt);
        conv_store<MODE>(cur, R, C, dst, ldd, roff, t / ntc, t % ntc, sm);
        cur = nxt;
    }
    rot += nt;
}
DEV void phase_conv_layer(const Params& p, int l, char* smem) {
    float* sm = (float*)smem;
    int rot = 0;
    const float* win = p.in[I_WIN] + (size_t)l * 1024 * NIN;
    conv_job<0>(win, 1024, C_PEND, NIN, wsb(p, OFF_WIN), 1024, 0, rot, sm);
    conv_job<0>(win + C_PEND, 1024, 4096, NIN, wsb(p, OFF_WIN), 1024, NGATE0, rot, sm);
    {
        uint4* z = (uint4*)(wsb(p, OFF_WIN) + (size_t)C_PEND * 1024);
        const int n = (NGATE0 - C_PEND) * 1024 / 8;
        for (int i = bidx() * NT + tidx(); i < n; i += gridDim.x * NT) z[i] = make_uint4(0u, 0u, 0u, 0u);
    }
    for (int i = 0; i < 4; ++i)
        conv_job<0>(p.in[I_WBR] + (size_t)(l * 4 + i) * 256 * 1024, 256, 1024, 1024, wsb(p, OFF_WBR) + (size_t)i * 1024 * 256, 256, 0, rot, sm);
    conv_job<0>(p.in[I_WOUT] + (size_t)l * 1024 * 1024, 1024, 1024, 1024, wsb(p, OFF_WOUT), 1024, 0, rot, sm);
}
DEV void phase_conv_experts(const Params& p, int l, char* smem) {
    float* sm = (float*)smem;
    int rot = 0;
    for (int e = 0; e < NEXP; ++e) {
        conv_job<1>(p.in[I_EWG] + (size_t)(l * NEXP + e) * 1024 * DFF, 1024, DFF, DFF, wsb(p, OFF_WG1) + (size_t)e * 1024 * 1024, 1024, 0, rot, sm);
        conv_job<1>(p.in[I_EWU] + (size_t)(l * NEXP + e) * 1024 * DFF, 1024, DFF, DFF, wsb(p, OFF_WG1) + (size_t)e * 1024 * 1024, 1024, 32, rot, sm);
        conv_job<0>(p.in[I_EWD] + (size_t)(l * NEXP + e) * DFF * 1024, DFF, 1024, 1024, wsb(p, OFF_WDN) + (size_t)e * 1024 * DFF, DFF, 0, rot, sm);
    }
}
DEV void phase_conv_small(const Params& p, char* smem) {
    float* sm = (float*)smem;
    int rot = 0;
    for (int l = 0; l < 2; ++l) {
        bf16_t* w = wsb(p, OFF_WSM) + (size_t)l * WS_PER_LAYER;
        for (int i = bidx() * NT + tidx(); i < 4 * 256 * 4; i += gridDim.x * NT)
            *(u32x4*)(w + WS_W2 + (size_t)(i >> 2) * 64 + 32 + (i & 3) * 8) = (u32x4){0u, 0u, 0u, 0u};
        conv_job<0>(p.in[I_S5WGLU] + (size_t)l * 256 * 256, 256, 256, 256, w + WS_GLUT, 256, 0, rot, sm);
        conv_job<0>(p.in[I_MWUQ] + (size_t)l * 192 * 192, 192, 192, 192, w + WS_UQT, 192, 0, rot, sm);
        conv_job<0>(p.in[I_MWUKV] + (size_t)l * 128 * 384, 128, 384, 384, w + WS_UKVT, 128, 0, rot, sm);
        for (int d = 0; d < 2; ++d) {
            conv_job<0>(p.in[I_RW1] + (size_t)(l * 2 + d) * 256 * 32, 256, 32, 32, w + WS_W1C, 256, d * 32, rot, sm);
            conv_job<0>(p.in[I_RA1] + (size_t)(l * 2 + d) * 256 * 32, 256, 32, 32, w + WS_W1C, 256, 64 + d * 32, rot, sm);
            conv_job<0>(p.in[I_RW2] + (size_t)(l * 2 + d) * 32 * 256, 32, 256, 256, w + WS_W2 + (size_t)d * 256 * 64, 64, 0, rot, sm);
            conv_job<0>(p.in[I_RA2] + (size_t)(l * 2 + d) * 32 * 256, 32, 256, 256, w + WS_W2 + (size_t)(2 + d) * 256 * 64, 64, 0, rot, sm);
        }
        conv_job<0>(p.in[I_RG1] + (size_t)l * 256 * 64, 256, 64, 64, w + WS_W1C, 256, 128, rot, sm);
        conv_job<0>(p.in[I_RG2] + (size_t)l * 64 * 256, 64, 256, 256, w + WS_G2T, 64, 0, rot, sm);
    }
}

template <int WHICH>
DEV void phase_norm(const Params& p, int l, int nrows, char* smem, bool fuse_combine = false) {
    const int lane = tidx() & 63, wave = tidx() >> 6;
    const float* xs = (l == 0) ? p.in[I_X] : p.out;
    const float* cs = (l == 0) ? p.in[I_CTX] : wsf(p, OFF_CX);
    const float* g = p.in[WHICH == 1 ? I_NMG : I_NFG] + l * 1024;
    bf16_t* H = wsb(p, OFF_H);
    if (WHICH == 2) { xs = p.out; cs = wsf(p, OFF_CX); }
    const int tpb = (nrows + (int)gridDim.x - 1) / (int)gridDim.x;
    const int rbeg = WHICH == 2 ? bidx() * tpb + wave : bidx() * 4 + wave;
    const int rend = WHICH == 2 ? min(nrows, (bidx() + 1) * tpb) : nrows;
    const int rstep = WHICH == 2 ? 4 : (int)gridDim.x * 4;
    int* sel = (int*)smem;
    for (int row = rbeg; row < rend; row += rstep) {
        const float* src = row < TL ? xs + (size_t)row * 1024 : cs + (size_t)(row - TL) * 1024;
        const int mr = mod_row(row);
        const float* sh = modp(p, l, mr, WHICH == 1 ? 0 : 3);
        const float* sc = modp(p, l, mr, WHICH == 1 ? 1 : 4);
        float4 v[4];
        float ss = 0.f;
#pragma unroll
        for (int i = 0; i < 4; ++i) v[i] = *(const float4*)(src + lane * 4 + i * 256);
        if (WHICH == 1 && fuse_combine) {
            const bf16_t* Z = wsb(p, OFF_Z);
            const int* toki = (const int*)(p.ws + OFF_TOKI);
            const float* tokw = (const float*)(p.ws + OFF_TOKW);
            const float* g2 = modp(p, l - 1, mr, 5);
            const int r0 = toki[(size_t)row * 4 + 2], r1 = toki[(size_t)row * 4 + 3];
            const float w0 = tokw[(size_t)row * 2], w1 = tokw[(size_t)row * 2 + 1];
            float* dst = row < TL ? p.out + (size_t)row * 1024 : wsf(p, OFF_CX) + (size_t)(row - TL) * 1024;
#pragma unroll
            for (int i = 0; i < 4; ++i) {
                const int c = lane * 4 + i * 256;
                const u32x2 a = *(const u32x2*)(Z + (size_t)r0 * 1024 + c), b = *(const u32x2*)(Z + (size_t)r1 * 1024 + c);
                const float4 gg = *(const float4*)(g2 + c);
                v[i].x += gg.x * (w0 * bflo(a.x) + w1 * bflo(b.x));
                v[i].y += gg.y * (w0 * bfhi(a.x) + w1 * bfhi(b.x));
                v[i].z += gg.z * (w0 * bflo(a.y) + w1 * bflo(b.y));
                v[i].w += gg.w * (w0 * bfhi(a.y) + w1 * bfhi(b.y));
                *(float4*)(dst + c) = v[i];
            }
        }
#pragma unroll
        for (int i = 0; i < 4; ++i) ss += v[i].x * v[i].x + v[i].y * v[i].y + v[i].z * v[i].z + v[i].w * v[i].w;
        ss = wave_sum(ss);
        const float rstd = rsqrtf(ss * (1.f / 1024.f) + EPS);
        float hv[16];
#pragma unroll
        for (int i = 0; i < 4; ++i) {
            const int c = lane * 4 + i * 256;
            const float4 gg = *(const float4*)(g + c), s4 = *(const float4*)(sh + c), c4 = *(const float4*)(sc + c);
            hv[i * 4 + 0] = v[i].x * rstd * gg.x * (1.f + c4.x) + s4.x;
            hv[i * 4 + 1] = v[i].y * rstd * gg.y * (1.f + c4.y) + s4.y;
            hv[i * 4 + 2] = v[i].z * rstd * gg.z * (1.f + c4.z) + s4.z;
            hv[i * 4 + 3] = v[i].w * rstd * gg.w * (1.f + c4.w) + s4.w;
            u32x2 o; o.x = pack2(hv[i * 4 + 0], hv[i * 4 + 1]); o.y = pack2(hv[i * 4 + 2], hv[i * 4 + 3]);
            *(u32x2*)(H + (size_t)row * 1024 + c) = o;
        }
        if (WHICH == 2) {
            float lg[16];
#pragma unroll
            for (int e = 0; e < 16; ++e) lg[e] = 0.f;
            const float* rw = p.in[I_ROUTW];
#pragma unroll
            for (int i = 0; i < 4; ++i)
#pragma unroll
                for (int j = 0; j < 4; ++j) {
                    const int c = lane * 4 + i * 256 + j;
                    const float hvv = hv[i * 4 + j];
#pragma unroll
                    for (int q = 0; q < 4; ++q) {
                        const float4 w4 = *(const float4*)(rw + (size_t)c * 16 + q * 4);
                        lg[q * 4 + 0] += hvv * w4.x; lg[q * 4 + 1] += hvv * w4.y; lg[q * 4 + 2] += hvv * w4.z; lg[q * 4 + 3] += hvv * w4.w;
                    }
                }
#pragma unroll
            for (int e = 0; e < 16; ++e) lg[e] = wave_sum(lg[e]);
            float sc16[16], bs[16];
#pragma unroll
            for (int e = 0; e < 16; ++e) { sc16[e] = sigmoidf_(lg[e]); bs[e] = sc16[e] + p.in[I_ROUTB][e]; }
            int bestg = 0; float bestv = -INFINITY;
#pragma unroll
            for (int gi = 0; gi < 4; ++gi) {
                float m1 = -INFINITY, m2 = -INFINITY;
#pragma unroll
                for (int k = 0; k < 4; ++k) { const float x = bs[gi * 4 + k]; if (x > m1) { m2 = m1; m1 = x; } else if (x > m2) m2 = x; }
                const float gs = m1 + m2;
                if (gs > bestv) { bestv = gs; bestg = gi; }
            }
            int i0 = 0, i1 = 0; float v0 = -INFINITY, v1 = -INFINITY, s0 = 0.f, s1 = 0.f;
#pragma unroll
            for (int e = 0; e < 16; ++e) { const bool in = (e >> 2) == bestg; if (in && bs[e] > v0) { v0 = bs[e]; i0 = e; s0 = sc16[e]; } }
#pragma unroll
            for (int e = 0; e < 16; ++e) { const bool in = (e >> 2) == bestg && e != i0; if (in && bs[e] > v1) { v1 = bs[e]; i1 = e; s1 = sc16[e]; } }
            const float inv = 1.f / (s0 + s1);
            if (lane == 0) {
                const int lt = row - bidx() * tpb;
                sel[lt * 2 + 0] = i0; sel[lt * 2 + 1] = i1;
                float* tw = (float*)(p.ws + OFF_TOKW) + (size_t)row * 2;
                tw[0] = s0 * inv; tw[1] = s1 * inv;
            }
        }
    }
    if (WHICH == 2) {
        __syncthreads();
        const int t0 = bidx() * tpb, nt = max(0, min(nrows, t0 + tpb) - t0);
        int* rank = sel + 2 * tpb;
        if (tidx() < 16) {
            const int e = tidx(); int c = 0;
            for (int i = 0; i < 2 * nt; ++i) if (sel[i] == e) { rank[i] = c; ++c; }
            ((int*)(p.ws + OFF_CNTB))[(size_t)bidx() * 16 + e] = c;
        }
        __syncthreads();
        int* toki = (int*)(p.ws + OFF_TOKI);
        for (int i = tidx(); i < nt; i += NT) {
            int4 r; r.x = sel[2 * i]; r.y = sel[2 * i + 1]; r.z = rank[2 * i]; r.w = rank[2 * i + 1];
            *(int4*)(toki + (size_t)(t0 + i) * 4) = r;
        }
        __syncthreads();
    }
}
DEV void phase_route(const Params& p, int l, int nrows, char* smem) {
    int* sm = (int*)smem;
    const int tid = tidx(), e = tid & 15, part = tid >> 4, G = gridDim.x, b = bidx();
    const int* cntb = (const int*)(p.ws + OFF_CNTB);
    int pre = 0, tot = 0;
    for (int bb = part; bb < G; bb += 16) { const int c = cntb[(size_t)bb * 16 + e]; tot += c; if (bb < b) pre += c; }
    __syncthreads();
    sm[part * 16 + e] = pre; sm[256 + part * 16 + e] = tot;
    __syncthreads();
    if (tid < 16) {
        int a = 0, t = 0;
        for (int q = 0; q < 16; ++q) { a += sm[q * 16 + tid]; t += sm[256 + q * 16 + tid]; }
        sm[512 + tid] = a; sm[528 + tid] = t;
    }
    __syncthreads();
    if (tid == 0) {
        int a = 0;
        for (int q = 0; q < 16; ++q) { sm[544 + q] = a; a += sm[528 + q]; }
    }
    __syncthreads();
    if (b == 0 && tid < 16) ((int*)(p.ws + OFF_CTR))[CTR_MOE + l * 16 + tid] = sm[528 + tid];
    const int tpb = (nrows + G - 1) / G, t0 = b * tpb, nt = max(0, min(nrows, t0 + tpb) - t0);
    int* toki = (int*)(p.ws + OFF_TOKI);
    const float* tokw = (const float*)(p.ws + OFF_TOKW);
    int* ltok = (int*)(p.ws + OFF_LTOK);
    float* lw = (float*)(p.ws + OFF_LW);
    for (int i = tid; i < 2 * nt; i += NT) {
        const int t = t0 + (i >> 1), j = i & 1;
        const int ee = toki[(size_t)t * 4 + j], rk = toki[(size_t)t * 4 + 2 + j];
        const int pos = sm[512 + ee] + rk;
        ltok[(size_t)ee * TT + pos] = t;
        lw[(size_t)ee * TT + pos] = tokw[(size_t)t * 2 + j];
        toki[(size_t)t * 4 + 2 + j] = sm[544 + ee] + pos;
    }
}
DEV void phase_combine(const Params& p, int l, int nrows) {
    const int lane = tidx() & 63, wave = tidx() >> 6;
    const bf16_t* Z = wsb(p, OFF_Z);
    const int* toki = (const int*)(p.ws + OFF_TOKI);
    const float* tokw = (const float*)(p.ws + OFF_TOKW);
    for (int row = bidx() * 4 + wave; row < nrows; row += gridDim.x * 4) {
        float* dst = row < TL ? p.out + (size_t)row * 1024 : wsf(p, OFF_CX) + (size_t)(row - TL) * 1024;
        const float* g2 = modp(p, l, mod_row(row), 5);
        const int r0 = toki[(size_t)row * 4 + 2], r1 = toki[(size_t)row * 4 + 3];
        const float w0 = tokw[(size_t)row * 2], w1 = tokw[(size_t)row * 2 + 1];
#pragma unroll
        for (int i = 0; i < 4; ++i) {
            const int c = lane * 4 + i * 256;
            const u32x2 a = *(const u32x2*)(Z + (size_t)r0 * 1024 + c), b = *(const u32x2*)(Z + (size_t)r1 * 1024 + c);
            const float4 gg = *(const float4*)(g2 + c);
            float4 x = *(float4*)(dst + c);
            x.x += gg.x * (w0 * bflo(a.x) + w1 * bflo(b.x));
            x.y += gg.y * (w0 * bfhi(a.x) + w1 * bfhi(b.x));
            x.z += gg.z * (w0 * bflo(a.y) + w1 * bflo(b.y));
            x.w += gg.w * (w0 * bfhi(a.y) + w1 * bfhi(b.y));
            *(float4*)(dst + c) = x;
        }
    }
}
constexpr int GLD = 72;
constexpr int GSTAGE = 128 * GLD;
template <bool DEEP = true, int TN = 2, class AF, class BF>
DEV void gemm_mainloop(f32x16 (&acc)[2][TN], AF arow, BF brow, int K, bf16_t* sm) {
    const int tid = tidx(), lane = tid & 63, wave = tid >> 6, wm = wave >> 1, wn = wave & 1;
    bf16_t* As = sm;
    bf16_t* Bs = sm + 2 * GSTAGE;
    constexpr int NB = 2 * TN;
    const bf16_t* ap[4]; const bf16_t* bp[NB];
#pragma unroll
    for (int i = 0; i < 4; ++i) { const int q = tid + i * NT; ap[i] = arow(q >> 3) + (q & 7) * 8; }
#pragma unroll
    for (int i = 0; i < NB; ++i) { const int q = tid + i * NT; bp[i] = brow(q >> 3) + (q & 7) * 8; }
    const int soff = (tid >> 3) * GLD + (tid & 7) * 8;
    u32x4 ra0[4], rb0[NB], ra1[4], rb1[NB];
    const int nk = K >> 6;
#pragma unroll
    for (int i = 0; i < 4; ++i) ra0[i] = *(const u32x4*)ap[i];
#pragma unroll
    for (int i = 0; i < NB; ++i) rb0[i] = *(const u32x4*)bp[i];
    if (DEEP && nk > 1) {
#pragma unroll
        for (int i = 0; i < 4; ++i) ra1[i] = *(const u32x4*)(ap[i] + 64);
#pragma unroll
        for (int i = 0; i < NB; ++i) rb1[i] = *(const u32x4*)(bp[i] + 64);
    }
    __syncthreads();
#pragma unroll
    for (int i = 0; i < 4; ++i) *(u32x4*)(As + soff + i * 32 * GLD) = ra0[i];
#pragma unroll
    for (int i = 0; i < NB; ++i) *(u32x4*)(Bs + soff + i * 32 * GLD) = rb0[i];
    __syncthreads();
    const int arow0 = (wm * 64 + (lane & 31)) * GLD + (lane >> 5) * 8;
    const int brow0 = (wn * 32 * TN + (lane & 31)) * GLD + (lane >> 5) * 8;
    auto compute = [&](int cur) {
        const bf16_t* a_s = As + cur * GSTAGE + arow0;
        const bf16_t* b_s = Bs + cur * GSTAGE + brow0;
#pragma unroll
        for (int ks = 0; ks < 4; ++ks) {
            const bf16x8 a0 = *(const bf16x8*)(a_s + ks * 16);
            const bf16x8 a1 = *(const bf16x8*)(a_s + 32 * GLD + ks * 16);
#pragma unroll
            for (int j = 0; j < TN; ++j) {
                const bf16x8 bj = *(const bf16x8*)(b_s + j * 32 * GLD + ks * 16);
                acc[0][j] = __builtin_amdgcn_mfma_f32_32x32x16_bf16(a0, bj, acc[0][j], 0, 0, 0);
                acc[1][j] = __builtin_amdgcn_mfma_f32_32x32x16_bf16(a1, bj, acc[1][j], 0, 0, 0);
            }
        }
    };
    auto gload = [&](u32x4 (&ra)[4], u32x4 (&rb)[NB], int kt) {
        const int k0 = kt * 64;
#pragma unroll
        for (int i = 0; i < 4; ++i) ra[i] = *(const u32x4*)(ap[i] + k0);
#pragma unroll
        for (int i = 0; i < NB; ++i) rb[i] = *(const u32x4*)(bp[i] + k0);
    };
    auto lstore = [&](const u32x4 (&ra)[4], const u32x4 (&rb)[NB], int st) {
#pragma unroll
        for (int i = 0; i < 4; ++i) *(u32x4*)(As + st * GSTAGE + soff + i * 32 * GLD) = ra[i];
#pragma unroll
        for (int i = 0; i < NB; ++i) *(u32x4*)(Bs + st * GSTAGE + soff + i * 32 * GLD) = rb[i];
    };
    for (int kt = 0; kt < nk; kt += 2) {
        if (!DEEP && kt + 1 < nk) gload(ra1, rb1, kt + 1);
        if (DEEP && kt + 2 < nk) gload(ra0, rb0, kt + 2);
        compute(0);
        if (kt + 1 < nk) lstore(ra1, rb1, 1);
        __syncthreads();
        if (kt + 1 >= nk) break;
        if (!DEEP && kt + 2 < nk) gload(ra0, rb0, kt + 2);
        if (DEEP && kt + 3 < nk) gload(ra1, rb1, kt + 3);
        compute(1);
        if (kt + 2 < nk) lstore(ra0, rb0, 0);
        __syncthreads();
    }
}
template <int TN>
DEV void acc_zero(f32x16 (&acc)[2][TN]) {
#pragma unroll
    for (int i = 0; i < 2; ++i)
#pragma unroll
        for (int j = 0; j < TN; ++j)
#pragma unroll
            for (int r = 0; r < 16; ++r) acc[i][j][r] = 0.f;
}
#define EPI_FOREACH(acc, ...)                                                                           \
    {                                                                                                    \
        const int _lane = tidx() & 63, _wave = tidx() >> 6, _wm = _wave >> 1, _wn = _wave & 1; \
        _Pragma("unroll") for (int _i = 0; _i < 2; ++_i)                                                 \
        _Pragma("unroll") for (int _j = 0; _j < 2; ++_j)                                                 \
        _Pragma("unroll") for (int _r = 0; _r < 16; ++_r) {                                              \
            const int er = _wm * 64 + _i * 32 + (_r & 3) + 8 * (_r >> 2) + 4 * (_lane >> 5);             \
            const int ec = _wn * 64 + _j * 32 + (_lane & 31);                                            \
            const float ev = acc[_i][_j][_r];                                                            \
            __VA_ARGS__                                                                                  \
        }                                                                                                \
    }

DEV void tile_mn(int item, int nMt, int nNt, int& mt, int& nt) {
    constexpr int GM = 16;
    const int per = GM * nNt, g = item / per, rem = item % per;
    const int m0 = g * GM, gsz = (nMt - m0) < GM ? (nMt - m0) : GM;
    mt = m0 + rem % gsz; nt = rem / gsz;
}

DEV void phase_inproj(const Params& p, int l, char* smem) {
    bf16_t* sm = (bf16_t*)smem;
    const bf16_t* H = wsb(p, OFF_H);
    const bf16_t* W = wsb(p, OFF_WIN);
    bf16_t* P = wsb(p, OFF_P);
    unsigned char* G = (unsigned char*)(p.ws + OFF_GATE);
    const int nMt = TT / 128, nNt = NINP / 128;
    for (int item = bidx(); item < nMt * nNt; item += gridDim.x) {
        int mt, nt; tile_mn(item, nMt, nNt, mt, nt);
        const int m0 = mt * 128, n0 = nt * 128;
        if (l == 1 && m0 >= TL && n0 >= NGATE0) continue;
        f32x16 acc[2][2]; acc_zero<2>(acc);
        gemm_mainloop(acc, [&](int r) { return H + (size_t)(m0 + r) * 1024; }, [&](int r) { return W + (size_t)(n0 + r) * 1024; }, 1024, sm);
        if (n0 < NGATE0) {
            EPI_FOREACH(acc, { const int col = n0 + ec; if (col < C_PEND) P[(size_t)(m0 + er) * LDP + col] = f2bf(ev); })
        } else {
            EPI_FOREACH(acc, { const int col = n0 + ec - NGATE0; const float s = sigmoidf_(ev); G[(size_t)(m0 + er) * 4096 + col] = (unsigned char)__float2int_rn(s * 255.f); })
        }
    }
}

template <class EF>
DEV void gemm_generic(const bf16_t* A, int lda, int M, const bf16_t* Bt, int ldb, int N, int K, EF ef, char* smem, int rot) {
    bf16_t* sm = (bf16_t*)smem;
    const int nMt = (M + 127) / 128, nNt = (N + 127) / 128, G = gridDim.x;
    const int first = (bidx() - (rot % G) + G) % G;
    for (int item = first; item < nMt * nNt; item += G) {
        const int mt = item / nNt, nt = item % nNt, m0 = mt * 128, n0 = nt * 128;
        f32x16 acc[2][2]; acc_zero<2>(acc);
        gemm_mainloop(acc, [&](int r) { int rr = m0 + r; rr = rr < M ? rr : M - 1; return A + (size_t)rr * lda; },
                      [&](int r) { int rr = n0 + r; rr = rr < N ? rr : N - 1; return Bt + (size_t)rr * ldb; }, K, sm);
        EPI_FOREACH(acc, { const int row = m0 + er, col = n0 + ec; if (row < M && col < N) ef(row, col, ev); })
    }
}

DEV void phase_merge(const Params& p, int l, int M, char* smem) {
    bf16_t* sm = (bf16_t*)smem;
    const bf16_t* Y = wsb(p, OFF_Y);
    const bf16_t* W = wsb(p, OFF_WBR);
    const unsigned char* G = (const unsigned char*)(p.ws + OFF_GATE);
    bf16_t* MG = wsb(p, OFF_H);
    bf16_t* As = sm;
    bf16_t* Bs = sm + 2 * GSTAGE;
    unsigned char* Gs = (unsigned char*)(sm + 2 * GSTAGE + 2 * 64 * GLD);
    const int tid = tidx(), lane = tid & 63, wave = tid >> 6, wm = wave >> 1, wn = wave & 1;
    const int soff = (tid >> 3) * GLD + (tid & 7) * 8;
    const int arow0 = (wm * 64 + (lane & 31)) * GLD + (lane >> 5) * 8;
    const int brow0 = (wn * 32 + (lane & 31)) * GLD + (lane >> 5) * 8;
    const int nMt = M / 128, nNt = 16;
    for (int item = bidx(); item < nMt * nNt; item += gridDim.x) {
        const int mt = item / nNt, nt = item % nNt, m0 = mt * 128, n0 = nt * 64;
        const bf16_t* ap[4]; const bf16_t* bp[2]; const unsigned char* gp[2];
#pragma unroll
        for (int i = 0; i < 4; ++i) { const int q = tid + i * NT; ap[i] = Y + (size_t)(m0 + (q >> 3)) * 1024 + (q & 7) * 8; }
#pragma unroll
        for (int i = 0; i < 2; ++i) { const int q = tid + i * NT; bp[i] = W + (size_t)(n0 + (q >> 3)) * 256 + (q & 7) * 8;
                                      gp[i] = G + (size_t)(m0 + (q >> 2)) * 4096 + n0 + (q & 3) * 16; }
        f32x16 tot[2], acc[2];
#pragma unroll
        for (int a = 0; a < 2; ++a)
#pragma unroll
            for (int r = 0; r < 16; ++r) { tot[a][r] = 0.f; acc[a][r] = 0.f; }
        u32x4 ra[4], rb[2], rg[2];
#pragma unroll
        for (int i = 0; i < 4; ++i) ra[i] = *(const u32x4*)ap[i];
#pragma unroll
        for (int i = 0; i < 2; ++i) rb[i] = *(const u32x4*)bp[i];
        __syncthreads();
#pragma unroll
        for (int i = 0; i < 4; ++i) *(u32x4*)(As + soff + i * 32 * GLD) = ra[i];
#pragma unroll
        for (int i = 0; i < 2; ++i) *(u32x4*)(Bs + soff + i * 32 * GLD) = rb[i];
        __syncthreads();
#pragma unroll
        for (int kt = 0; kt < 16; ++kt) {
            const int cur = kt & 1, seg = kt >> 2;
            if (kt + 1 < 16) {
                const int k1 = kt + 1;
#pragma unroll
                for (int i = 0; i < 4; ++i) ra[i] = *(const u32x4*)(ap[i] + k1 * 64);
#pragma unroll
                for (int i = 0; i < 2; ++i) rb[i] = *(const u32x4*)(bp[i] + (size_t)(k1 >> 2) * (1024 * 256) + (k1 & 3) * 64);
            }
            if ((kt & 3) == 0) {
#pragma unroll
                for (int i = 0; i < 2; ++i) rg[i] = *(const u32x4*)(gp[i] + seg * 1024);
            }
            const bf16_t* a_s = As + cur * GSTAGE + arow0;
            const bf16_t* b_s = Bs + cur * (64 * GLD) + brow0;
#pragma unroll
            for (int ks = 0; ks < 4; ++ks) {
                const bf16x8 a0 = *(const bf16x8*)(a_s + ks * 16), a1 = *(const bf16x8*)(a_s + 32 * GLD + ks * 16), b0 = *(const bf16x8*)(b_s + ks * 16);
                acc[0] = __builtin_amdgcn_mfma_f32_32x32x16_bf16(a0, b0, acc[0], 0, 0, 0);
                acc[1] = __builtin_amdgcn_mfma_f32_32x32x16_bf16(a1, b0, acc[1], 0, 0, 0);
            }
            if (kt + 1 < 16) {
                const int nx = cur ^ 1;
#pragma unroll
                for (int i = 0; i < 4; ++i) *(u32x4*)(As + nx * GSTAGE + soff + i * 32 * GLD) = ra[i];
#pragma unroll
                for (int i = 0; i < 2; ++i) *(u32x4*)(Bs + nx * (64 * GLD) + soff + i * 32 * GLD) = rb[i];
            }
            if ((kt & 3) == 3) {
#pragma unroll
                for (int i = 0; i < 2; ++i) { const int q = tid + i * NT; *(u32x4*)(Gs + (q >> 2) * 64 + (q & 3) * 16) = rg[i]; }
            }
            __syncthreads();
            if ((kt & 3) == 3) {
#pragma unroll
                for (int a = 0; a < 2; ++a)
#pragma unroll
                    for (int r = 0; r < 16; ++r) {
                        const int er = wm * 64 + a * 32 + (r & 3) + 8 * (r >> 2) + 4 * (lane >> 5), ec = wn * 32 + (lane & 31);
                        tot[a][r] += (float)Gs[er * 64 + ec] * (1.f / 255.f) * acc[a][r];
                        acc[a][r] = 0.f;
                    }
            }
        }
#pragma unroll
        for (int a = 0; a < 2; ++a)
#pragma unroll
            for (int r = 0; r < 16; ++r) {
                const int er = wm * 64 + a * 32 + (r & 3) + 8 * (r >> 2) + 4 * (lane >> 5), ec = wn * 32 + (lane & 31);
                MG[(size_t)(m0 + er) * 1024 + n0 + ec] = f2bf(tot[a][r]);
            }
    }
}

DEV void phase_outproj(const Params& p, int l, int M, char* smem) {
    bf16_t* sm = (bf16_t*)smem;
    const bf16_t* MG = wsb(p, OFF_H);
    const bf16_t* W = wsb(p, OFF_WOUT);
    const float* xs = (l == 0) ? p.in[I_X] : p.out;
    const float* cs = (l == 0) ? p.in[I_CTX] : wsf(p, OFF_CX);
    float* cxd = wsf(p, OFF_CX);
    float* outd = p.out;
    const int nMt = M / 128, nNt = 8;
    for (int item = bidx(); item < nMt * nNt; item += gridDim.x) {
        const int mt = item / nNt, nt = item % nNt, m0 = mt * 128, n0 = nt * 128;
        f32x16 acc[2][2]; acc_zero<2>(acc);
        gemm_mainloop(acc, [&](int r) { return MG + (size_t)(m0 + r) * 1024; }, [&](int r) { return W + (size_t)(n0 + r) * 1024; }, 1024, sm);
        const float* g1 = modp(p, l, mod_row(m0), 2);
        if (m0 < TL) {
            EPI_FOREACH(acc, { const size_t o = (size_t)(m0 + er) * 1024 + n0 + ec; outd[o] = xs[o] + g1[n0 + ec] * ev; })
        } else {
            EPI_FOREACH(acc, { const size_t o = (size_t)(m0 - TL + er) * 1024 + n0 + ec; cxd[o] = cs[o] + g1[n0 + ec] * ev; })
        }
    }
}

constexpr int MOE_MAP_OFF = 73728;
DEV void moe_map(const Params& p, int l, char* smem) {
    int* mm = (int*)(smem + MOE_MAP_OFF);
    __syncthreads();
    if (tidx() == 0) {
        const int* cnt = (const int*)(p.ws + OFF_CTR) + CTR_MOE + l * 16;
        int b = 0, t = 0;
        for (int e = 0; e < 16; ++e) { const int c = cnt[e]; mm[e] = c; mm[16 + e] = b; mm[32 + e] = t; b += c; t += (c + 127) >> 7; }
        mm[48] = t;
    }
    __syncthreads();
}
DEV void phase_moe1(const Params& p, int l, char* smem) {
    bf16_t* sm = (bf16_t*)smem;
    const bf16_t* F = wsb(p, OFF_H);
    const bf16_t* W = wsb(p, OFF_WG1);
    bf16_t* ACT = wsb(p, OFF_P);
    const int* ltok = (const int*)(p.ws + OFF_LTOK);
    moe_map(p, l, smem); const int* mm = (const int*)(smem + MOE_MAP_OFF);
    const int nNt = 8, total = mm[48] * nNt;
    for (int item = bidx(); item < total; item += gridDim.x) {
        const int mtg = item / nNt, nt = item % nNt;
        int e = 0;
        for (int q = 1; q < 16; ++q) if (mtg >= mm[32 + q]) e = q;
        const int m0 = (mtg - mm[32 + e]) * 128, n0 = nt * 128, ce = mm[e];
        const int* lt = ltok + (size_t)e * TT;
        f32x16 acc[2][2]; acc_zero<2>(acc);
        gemm_mainloop(acc, [&](int r) { int idx = m0 + r; idx = idx < ce ? idx : ce - 1; return F + (size_t)lt[idx] * 1024; },
                      [&](int r) { return W + ((size_t)e * 1024 + n0 + r) * 1024; }, 1024, sm);
        const int lane = tidx() & 63, wave = tidx() >> 6, wm = wave >> 1, wn = wave & 1;
        const int jcol = ((n0 >> 6) + wn) * 32 + (lane & 31);
#pragma unroll
        for (int a = 0; a < 2; ++a)
#pragma unroll
            for (int r = 0; r < 16; ++r) {
                const int idx = m0 + wm * 64 + a * 32 + (r & 3) + 8 * (r >> 2) + 4 * (lane >> 5);
                if (idx < ce) {
                    const float g = acc[a][0][r], u = acc[a][1][r];
                    ACT[(size_t)(mm[16 + e] + idx) * DFF + jcol] = f2bf(g * sigmoidf_(g) * u);
                }
            }
    }
}
DEV void phase_moe2(const Params& p, int l, char* smem) {
    bf16_t* sm = (bf16_t*)smem;
    const bf16_t* ACT = wsb(p, OFF_P);
    const bf16_t* W = wsb(p, OFF_WDN);
    bf16_t* Z = wsb(p, OFF_Z);
    moe_map(p, l, smem); const int* mm = (const int*)(smem + MOE_MAP_OFF);
    const int nNt = 8, total = mm[48] * nNt;
    for (int item = bidx(); item < total; item += gridDim.x) {
        const int mtg = item / nNt, nt = item % nNt;
        int e = 0;
        for (int q = 1; q < 16; ++q) if (mtg >= mm[32 + q]) e = q;
        const int m0 = (mtg - mm[32 + e]) * 128, n0 = nt * 128, ce = mm[e];
        f32x16 acc[2][2]; acc_zero<2>(acc);
        gemm_mainloop(acc, [&](int r) { int idx = m0 + r; idx = idx < ce ? idx : ce - 1; return ACT + (size_t)(mm[16 + e] + idx) * DFF; },
                      [&](int r) { return W + ((size_t)e * 1024 + n0 + r) * DFF; }, DFF, sm);
        bf16_t* zb = Z + (size_t)mm[16 + e] * 1024;
        EPI_FOREACH(acc, { const int idx = m0 + er; if (idx < ce) zb[(size_t)idx * 1024 + n0 + ec] = f2bf(ev); })
    }
}
DEV void tok_seq(int t, int& base, int& n, int& len) {
    if (t < TL) { base = t & ~(SEQ - 1); n = t & (SEQ - 1); len = SEQ; } else { const int u = t - TL; base = TL + (u & ~(CTXL - 1)); n = u & (CTXL - 1); len = CTXL; }
}
DEV void phase_prep1(const Params& p, int l) {
    const int lane = tidx() & 63, wave = tidx() >> 6;
    bf16_t* P = wsb(p, OFF_P);
    bf16_t* XL = wsb(p, OFF_XL);
    const float* qkg = p.in[I_DAQKG] + l * 64;
    const float* cqg = p.in[I_MCQG] + l * 192;
    const float* ckvg = p.in[I_MCKVG] + l * 128;
    const float* mu3 = p.in[I_RMU] + (l * 4 + 3) * 256;
    for (int t = bidx() * 4 + wave; t < TT; t += gridDim.x * 4) {
        bf16_t* row = P + (size_t)t * LDP;
        int base, n, len; tok_seq(t, base, n, len);
        {
            const int d0 = (lane & 7) * 4;
            float cs[4], sn[4];
            const bool rot = t < TL;
            if (rot) {
                const float fr = (float)(n >> 6), fc = (float)(n & 63);
#pragma unroll
                for (int j = 0; j < 4; ++j) {
                    const int i = (d0 + j) & 15;
                    const float inv = exp2f(-(float)(i & 7) * (13.287712379549449f / 8.f));
                    const float ang = (i < 8 ? fr : fc) * inv;
                    cs[j] = __cosf(ang); sn[j] = __sinf(ang);
                }
            }
#pragma unroll
            for (int which = 0; which < 2; ++which) {
                bf16_t* ptr = row + (which ? C_DAK : C_DAQ) + lane * 4;
                const u32x2 raw = *(const u32x2*)ptr;
                float v[4] = { bflo(raw.x), bfhi(raw.x), bflo(raw.y), bfhi(raw.y) };
                float ss = v[0] * v[0] + v[1] * v[1] + v[2] * v[2] + v[3] * v[3];
                ss = group_sum<8>(ss);
                const float rstd = rsqrtf(ss * (1.f / 32.f) + EPS);
                const float* g = qkg + which * 32 + d0;
#pragma unroll
                for (int j = 0; j < 4; ++j) v[j] = v[j] * rstd * g[j];
                if (rot) {
#pragma unroll
                    for (int j = 0; j < 4; ++j) {
                        const float o = __shfl_xor(v[j], 4, 64);
                        v[j] = (d0 < 16) ? (v[j] * cs[j] - o * sn[j]) : (v[j] * cs[j] + o * sn[j]);
                    }
                }
                if (which == 0) {
                    const float qs = 0.17677669529663687f * LOG2E;
#pragma unroll
                    for (int j = 0; j < 4; ++j) v[j] *= qs;
                }
                u32x2 o; o.x = pack2(v[0], v[1]); o.y = pack2(v[2], v[3]);
                *(u32x2*)ptr = o;
            }
        }
        {
            float v[3]; float ss = 0.f;
#pragma unroll
            for (int j = 0; j < 3; ++j) { v[j] = bf2f(row[C_CQ + lane + j * 64]); ss += v[j] * v[j]; }
            ss = wave_sum(ss);
            const float rstd = rsqrtf(ss * (1.f / 192.f) + EPS);
#pragma unroll
            for (int j = 0; j < 3; ++j) row[C_CQ + lane + j * 64] = f2bf(v[j] * rstd * cqg[lane + j * 64]);
            float w[2]; float s2 = 0.f;
#pragma unroll
            for (int j = 0; j < 2; ++j) { w[j] = bf2f(row[C_CKV + lane + j * 64]); s2 += w[j] * w[j]; }
            s2 = wave_sum(s2);
            const float r2 = rsqrtf(s2 * (1.f / 128.f) + EPS);
#pragma unroll
            for (int j = 0; j < 2; ++j) row[C_CKV + lane + j * 64] = f2bf(w[j] * r2 * ckvg[lane + j * 64]);
        }
        {
            const int c = lane * 4;
            const u32x2 cur = *(const u32x2*)(row + C_RWD + c);
            u32x2 pv = (u32x2){0u, 0u}, nx = (u32x2){0u, 0u};
            if (n > 0) pv = *(const u32x2*)(row - LDP + C_RWD + c);
            if (n + 1 < len) nx = *(const u32x2*)(row + LDP + C_RWD + c);
            const float4 m = *(const float4*)(mu3 + c);
            float o[4];
            { const float x = bflo(cur.x); o[0] = x + (0.5f * (bflo(pv.x) + bflo(nx.x)) - x) * m.x; }
            { const float x = bfhi(cur.x); o[1] = x + (0.5f * (bfhi(pv.x) + bfhi(nx.x)) - x) * m.y; }
            { const float x = bflo(cur.y); o[2] = x + (0.5f * (bflo(pv.y) + bflo(nx.y)) - x) * m.z; }
            { const float x = bfhi(cur.y); o[3] = x + (0.5f * (bfhi(pv.y) + bfhi(nx.y)) - x) * m.w; }
            u32x2 ov; ov.x = pack2(o[0], o[1]); ov.y = pack2(o[2], o[3]);
            *(u32x2*)(XL + (size_t)t * 256 + c) = ov;
        }
    }
}

DEV void phase_prep_gemm1(const Params& p, int l, char* smem) {
    const bf16_t* P = wsb(p, OFF_P);
    const bf16_t* w = wsb(p, OFF_WSM) + (size_t)l * WS_PER_LAYER;
    bf16_t* QRAW = wsb(p, OFF_QRAW); bf16_t* KVRAW = wsb(p, OFF_KVRAW); bf16_t* LR = wsb(p, OFF_LR);
    int rot = 0;
    gemm_generic(P + C_CQ, LDP, TT, w + WS_UQT, 192, 192, 192, [&](int r, int c, float v) { QRAW[(size_t)r * 192 + c] = f2bf(v); }, smem, rot);
    rot += (TT / 128) * 2;
    gemm_generic(P + C_CKV, LDP, TT, w + WS_UKVT, 128, 384, 128, [&](int r, int c, float v) { KVRAW[(size_t)r * 384 + c] = f2bf(v); }, smem, rot);
    rot += (TT / 128) * 3;
    gemm_generic(wsb(p, OFF_XL), 256, TT, w + WS_W1C, 256, 192, 256,
                 [&](int r, int c, float v) { const float o = c < 64 ? (1.f - 2.f / (__expf(2.f * v) + 1.f)) : (c < 128 ? v : sigmoidf_(v)); LR[(size_t)r * 192 + c] = f2bf(o); }, smem, rot);
}
DEV void phase_prep_gemm2(const Params& p, int l, char* smem) {
    const bf16_t* w = wsb(p, OFF_WSM) + (size_t)l * WS_PER_LAYER;
    const bf16_t* LR = wsb(p, OFF_LR);
    bf16_t* RWX = wsb(p, OFF_RWX);
    bf16_t* P = wsb(p, OFF_P);
    int rot = 0;
    for (int d = 0; d < 2; ++d) {
        const float* w0 = p.in[I_RW0] + (l * 2 + d) * 256;
        gemm_generic(LR + d * 32, 192, TT, w + WS_W2 + (size_t)d * 256 * 64, 64, 256, 64,
                     [&](int r, int c, float v) { RWX[(size_t)r * 1024 + d * 256 + c] = f2bf(0.6065306597126334f * sigmoidf_(w0[c] + v)); }, smem, rot);
        rot += (TT / 128) * 2;
        const float* a0 = p.in[I_RA0] + (l * 2 + d) * 256;
        gemm_generic(LR + 64 + d * 32, 192, TT, w + WS_W2 + (size_t)(2 + d) * 256 * 64, 64, 256, 64,
                     [&](int r, int c, float v) { RWX[(size_t)r * 1024 + 512 + d * 256 + c] = f2bf(sigmoidf_(a0[c] + v)); }, smem, rot);
        rot += (TT / 128) * 2;
    }
    gemm_generic(LR + 128, 192, TT, w + WS_G2T, 64, 256, 64, [&](int r, int c, float v) { P[(size_t)r * LDP + C_RWD + c] = f2bf(v); }, smem, rot);
}

DEV void phase_prep2(const Params& p, int l) {
    const int lane = tidx() & 63, wave = tidx() >> 6;
    const bf16_t* P = wsb(p, OFF_P);
    const bf16_t* QRAW = wsb(p, OFF_QRAW); const bf16_t* KVRAW = wsb(p, OFF_KVRAW);
    bf16_t* MQ = wsb(p, OFF_MLAQ); bf16_t* MK = wsb(p, OFF_MLAK); bf16_t* MV = wsb(p, OFF_MLAV);
    const float* qkg = p.in[I_MQKG] + l * 96;
    for (int t = bidx() * 4 + wave; t < TT; t += gridDim.x * 4) {
        int base, n, len; tok_seq(t, base, n, len);
        const int h = lane >> 4, j = lane & 15;
        const bool rot = t < TL;
        float cs = 1.f, sn = 0.f;
        if (rot) {
            const int i = j & 7;
            const float inv = exp2f(-(float)(i & 3) * (13.287712379549449f / 4.f));
            const float ang = (i < 4 ? (float)(n >> 6) : (float)(n & 63)) * inv;
            cs = __cosf(ang); sn = __sinf(ang);
        }
        {
            float v[3]; float ss = 0.f;
#pragma unroll
            for (int k = 0; k < 3; ++k) { v[k] = bf2f(QRAW[(size_t)t * 192 + h * 48 + j + k * 16]); ss += v[k] * v[k]; }
            ss = group_sum<16>(ss);
            const float rstd = rsqrtf(ss * (1.f / 48.f) + EPS);
#pragma unroll
            for (int k = 0; k < 3; ++k) v[k] = v[k] * rstd * qkg[j + k * 16];
            if (rot) { const float o = __shfl_xor(v[2], 8, 64); v[2] = (j < 8) ? (v[2] * cs - o * sn) : (v[2] * cs + o * sn); }
            const float qs = 0.14433756729740643f * LOG2E;
#pragma unroll
            for (int k = 0; k < 3; ++k) MQ[(size_t)t * 192 + h * 48 + j + k * 16] = f2bf(v[k] * qs);
        }
        {
            float v[3]; float ss = 0.f;
            v[0] = bf2f(KVRAW[(size_t)t * 384 + h * 96 + j]);
            v[1] = bf2f(KVRAW[(size_t)t * 384 + h * 96 + 16 + j]);
            v[2] = bf2f(P[(size_t)t * LDP + C_KR + j]);
#pragma unroll
            for (int k = 0; k < 3; ++k) ss += v[k] * v[k];
            ss = group_sum<16>(ss);
            const float rstd = rsqrtf(ss * (1.f / 48.f) + EPS);
#pragma unroll
            for (int k = 0; k < 3; ++k) v[k] = v[k] * rstd * qkg[48 + j + k * 16];
            if (rot) { const float o = __shfl_xor(v[2], 8, 64); v[2] = (j < 8) ? (v[2] * cs - o * sn) : (v[2] * cs + o * sn); }
#pragma unroll
            for (int k = 0; k < 3; ++k) MK[(size_t)t * 192 + h * 48 + j + k * 16] = f2bf(v[k]);
        }
#pragma unroll
        for (int k = 0; k < 4; ++k) MV[(size_t)t * 256 + h * 64 + j + k * 16] = KVRAW[(size_t)t * 384 + h * 96 + 32 + j + k * 16];
    }
}
template <int NC, int DK>
struct AttnCfg {
    static constexpr int DKROW = NC * DK, KLD = DKROW + 8, VLD = 68;
    static constexpr int KSTAGE = 64 * KLD, VSTAGE = 64 * VLD;
    static constexpr int KCH = 64 * DKROW / 8;
};
template <int NC, int DK, class EPI>
DEV void attn_item(const bf16_t* Q, int ldq, const bf16_t* Kl, const bf16_t* Kc, int ldk, const bf16_t* Vl, const bf16_t* Vc, int ldv,
                   int q0, int nlat_tiles, int nctx_tiles, EPI epi, char* smem) {
    using C = AttnCfg<NC, DK>;
    constexpr int KS = DK / 16;
    const int tid = tidx(), lane = tid & 63, wave = tid >> 6, ql = lane & 31, hh = lane >> 5;
    bf16_t* Ks = (bf16_t*)smem;
    bf16_t* Vt = Ks + 2 * C::KSTAGE;
    bf16x8 qf[NC][KS];
    {
        const bf16_t* qp = Q + (size_t)(q0 + wave * 32 + ql) * ldq + hh * 8;
#pragma unroll
        for (int c = 0; c < NC; ++c)
#pragma unroll
            for (int ks = 0; ks < KS; ++ks) qf[c][ks] = *(const bf16x8*)(qp + c * DK + ks * 16);
    }
    f32x16 O[NC][2];
    float mrun[NC], lrun[NC];
#pragma unroll
    for (int c = 0; c < NC; ++c) {
        mrun[c] = -1e30f; lrun[c] = 0.f;
#pragma unroll
        for (int d = 0; d < 2; ++d)
#pragma unroll
            for (int r = 0; r < 16; ++r) O[c][d][r] = 0.f;
    }
    const int ntiles = nlat_tiles + nctx_tiles;
    constexpr int KPT = (C::KCH + NT - 1) / NT;
    u32x4 rk[KPT], rv[2];
    auto load_tile = [&](int tile) {
        const bf16_t* kb = tile < nlat_tiles ? Kl + (size_t)tile * 64 * ldk : Kc + (size_t)(tile - nlat_tiles) * 64 * ldk;
        const bf16_t* vb = tile < nlat_tiles ? Vl + (size_t)tile * 64 * ldv : Vc + (size_t)(tile - nlat_tiles) * 64 * ldv;
#pragma unroll
        for (int i = 0; i < KPT; ++i) {
            int q = tid + i * NT; q = q < C::KCH ? q : C::KCH - 1;
            { const int key = q / (C::DKROW / 8), ch = q % (C::DKROW / 8); rk[i] = *(const u32x4*)(kb + (size_t)key * ldk + ch * 8); }
        }
#pragma unroll
        for (int i = 0; i < 2; ++i) { const int q = tid + i * NT; const int key = q >> 3, ch = q & 7; rv[i] = *(const u32x4*)(vb + (size_t)key * ldv + ch * 8); }
    };
    auto store_tile = [&](int st) {
#pragma unroll
        for (int i = 0; i < KPT; ++i) {
            const int q = tid + i * NT;
            if (q < C::KCH) { const int key = q / (C::DKROW / 8), ch = q % (C::DKROW / 8); *(u32x4*)(Ks + st * C::KSTAGE + key * C::KLD + ch * 8) = rk[i]; }
        }
#pragma unroll
        for (int i = 0; i < 2; ++i) {
            const int q = tid + i * NT; const int key = q >> 3, dv0 = (q & 7) * 8;
            bf16_t* vd = Vt + st * C::VSTAGE + dv0 * C::VLD + key;
            const unsigned w[4] = { rv[i][0], rv[i][1], rv[i][2], rv[i][3] };
#pragma unroll
            for (int j = 0; j < 4; ++j) { vd[(2 * j) * C::VLD] = (bf16_t)(w[j] & 0xFFFFu); vd[(2 * j + 1) * C::VLD] = (bf16_t)(w[j] >> 16); }
        }
    };
    load_tile(0);
    __syncthreads();
    store_tile(0);
    __syncthreads();
    for (int tile = 0; tile < ntiles; ++tile) {
        const int cur = tile & 1;
        if (tile + 1 < ntiles) load_tile(tile + 1);
        const bf16_t* ks_ = Ks + cur * C::KSTAGE;
        const bf16_t* vt_ = Vt + cur * C::VSTAGE;
#pragma unroll
        for (int c = 0; c < NC; ++c) {
            f32x16 S[2];
#pragma unroll
            for (int kb = 0; kb < 2; ++kb) {
#pragma unroll
                for (int r = 0; r < 16; ++r) S[kb][r] = 0.f;
#pragma unroll
                for (int ks = 0; ks < KS; ++ks) {
                    const bf16x8 kf = *(const bf16x8*)(ks_ + (kb * 32 + ql) * C::KLD + c * DK + ks * 16 + hh * 8);
                    S[kb] = __builtin_amdgcn_mfma_f32_32x32x16_bf16(kf, qf[c][ks], S[kb], 0, 0, 0);
                }
            }
            float mx = S[0][0];
#pragma unroll
            for (int kb = 0; kb < 2; ++kb)
#pragma unroll
                for (int r = 0; r < 16; ++r) mx = fmaxf(mx, S[kb][r]);
            mx = fmaxf(mx, __shfl_xor(mx, 32, 64));
            const float mnew = fmaxf(mrun[c], mx);
            const float alpha = __builtin_amdgcn_exp2f(mrun[c] - mnew);
            mrun[c] = mnew;
            float ls = 0.f;
#pragma unroll
            for (int kb = 0; kb < 2; ++kb)
#pragma unroll
                for (int r = 0; r < 16; ++r) { const float e = __builtin_amdgcn_exp2f(S[kb][r] - mnew); S[kb][r] = e; ls += e; }
            lrun[c] = lrun[c] * alpha + ls;
#pragma unroll
            for (int d = 0; d < 2; ++d)
#pragma unroll
                for (int r = 0; r < 16; ++r) O[c][d][r] *= alpha;
#pragma unroll
            for (int s = 0; s < 4; ++s) {
                const int kb = s >> 1, s2 = s & 1;
                const u32x4 pu = (u32x4){pack2(S[kb][8 * s2 + 0], S[kb][8 * s2 + 1]), pack2(S[kb][8 * s2 + 2], S[kb][8 * s2 + 3]),
                                         pack2(S[kb][8 * s2 + 4], S[kb][8 * s2 + 5]), pack2(S[kb][8 * s2 + 6], S[kb][8 * s2 + 7])};
                const bf16x8 pf = __builtin_bit_cast(bf16x8, pu);
                const int keyo = kb * 32 + 16 * s2 + 4 * hh;
#pragma unroll
                for (int d = 0; d < 2; ++d) {
                    const bf16_t* vp = vt_ + (d * 32 + ql) * C::VLD + keyo;
                    const u32x2 lo = *(const u32x2*)vp, hi = *(const u32x2*)(vp + 8);
                    const u32x4 vv = (u32x4){lo[0], lo[1], hi[0], hi[1]};
                    const bf16x8 vf = __builtin_bit_cast(bf16x8, vv);
                    O[c][d] = __builtin_amdgcn_mfma_f32_32x32x16_bf16(vf, pf, O[c][d], 0, 0, 0);
                }
            }
        }
        if (tile + 1 < ntiles) store_tile(cur ^ 1);
        __syncthreads();
    }
    float inv[NC];
#pragma unroll
    for (int c = 0; c < NC; ++c) { const float lt = lrun[c] + __shfl_xor(lrun[c], 32, 64); inv[c] = 1.f / lt; }
    epi(O, inv, q0 + wave * 32 + ql, hh);
}

DEV void da_item(const Params& p, int l, int item, char* smem) {
    const bf16_t* P = wsb(p, OFF_P);
    bf16_t* Y = wsb(p, OFF_Y);
    const float linit = 0.8f - 0.6f * __expf(-0.3f * (float)l);
    float lam;
    {
        const float* la = p.in[I_DALAM] + l * 128;
        const int lane = tidx() & 63;
        float a = lane < 32 ? la[lane] * la[32 + lane] : 0.f, b = lane < 32 ? la[64 + lane] * la[96 + lane] : 0.f;
        a = wave_sum(a); b = wave_sum(b);
        lam = __expf(a) - __expf(b) + linit;
    }
    const float* sg = p.in[I_DASUB] + l * 64;
    int b, h, qt; bool isctx;
    if (item < 512) { isctx = false; b = item >> 6; h = (item >> 4) & 3; qt = item & 15; }
    else { const int it = item - 512; isctx = true; b = it >> 3; h = (it >> 1) & 3; qt = it & 1; }
    const size_t lat0 = (size_t)b * SEQ, ctx0 = (size_t)TL + (size_t)b * CTXL;
    const size_t qrow0 = isctx ? ctx0 : lat0;
    float* o1s = (float*)(smem + 32768) + (tidx() >> 6) * (32 * 64) + (tidx() & 63);
    auto epi0 = [&](f32x16 (&O)[1][2], float (&inv)[1], int qrow, int hh) {
#pragma unroll
        for (int d = 0; d < 2; ++d)
#pragma unroll
            for (int r = 0; r < 16; ++r) o1s[(d * 16 + r) * 64] = O[0][d][r] * inv[0];
    };
    auto epi1 = [&](f32x16 (&O)[1][2], float (&inv)[1], int qrow, int hh) {
        float v[2][16]; float ss = 0.f;
#pragma unroll
        for (int d = 0; d < 2; ++d)
#pragma unroll
            for (int r = 0; r < 16; ++r) { const float o = o1s[(d * 16 + r) * 64] - lam * O[0][d][r] * inv[0]; v[d][r] = o; ss += o * o; }
        ss += __shfl_xor(ss, 32, 64);
        const float rstd = rsqrtf(ss * (1.f / 64.f) + EPS) * (1.f - linit);
        bf16_t* yo = Y + (qrow0 + qrow) * 1024 + h * 64;
#pragma unroll
        for (int d = 0; d < 2; ++d)
#pragma unroll
            for (int g = 0; g < 4; ++g) {
                const int dv = d * 32 + 8 * g + 4 * hh;
                u32x2 o;
                o.x = pack2(v[d][4 * g + 0] * rstd * sg[dv + 0], v[d][4 * g + 1] * rstd * sg[dv + 1]);
                o.y = pack2(v[d][4 * g + 2] * rstd * sg[dv + 2], v[d][4 * g + 3] * rstd * sg[dv + 3]);
                *(u32x2*)(yo + dv) = o;
            }
    };
    const bf16_t* Qp = P + qrow0 * LDP + C_DAQ + h * 64;
    const bf16_t* Kl = P + lat0 * LDP + C_DAK + h * 64;
    const bf16_t* Kc = P + ctx0 * LDP + C_DAK + h * 64;
    const bf16_t* Vl = P + lat0 * LDP + C_DAV + h * 64;
    const bf16_t* Vc = P + ctx0 * LDP + C_DAV + h * 64;
    const int nlat = isctx ? 0 : SEQ / 64;
    attn_item<1, 32>(Qp, LDP, Kl, Kc, LDP, Vl, Vc, LDP, qt * 128, nlat, CTXL / 64, epi0, smem);
    attn_item<1, 32>(Qp + 32, LDP, Kl + 32, Kc + 32, LDP, Vl, Vc, LDP, qt * 128, nlat, CTXL / 64, epi1, smem);
}
DEV void mla_item(const Params& p, int l, int item, char* smem) {
    const bf16_t* MQ = wsb(p, OFF_MLAQ); const bf16_t* MK = wsb(p, OFF_MLAK); const bf16_t* MV = wsb(p, OFF_MLAV);
    bf16_t* Y = wsb(p, OFF_Y);
    int b, h, qt; bool isctx;
    if (item < 512) { isctx = false; b = item >> 6; h = (item >> 4) & 3; qt = item & 15; }
    else { const int it = item - 512; isctx = true; b = it >> 3; h = (it >> 1) & 3; qt = it & 1; }
    const size_t lat0 = (size_t)b * SEQ, ctx0 = (size_t)TL + (size_t)b * CTXL;
    const size_t qrow0 = isctx ? ctx0 : lat0;
    auto epi = [&](f32x16 (&O)[1][2], float (&inv)[1], int qrow, int hh) {
        bf16_t* yo = Y + (qrow0 + qrow) * 1024 + 512 + h * 64;
#pragma unroll
        for (int d = 0; d < 2; ++d)
#pragma unroll
            for (int g = 0; g < 4; ++g) {
                const int dv = d * 32 + 8 * g + 4 * hh;
                u32x2 o;
                o.x = pack2(O[0][d][4 * g + 0] * inv[0], O[0][d][4 * g + 1] * inv[0]);
                o.y = pack2(O[0][d][4 * g + 2] * inv[0], O[0][d][4 * g + 3] * inv[0]);
                *(u32x2*)(yo + dv) = o;
            }
    };
    const bf16_t* Qp = MQ + qrow0 * 192 + h * 48;
    const bf16_t* Kl = MK + lat0 * 192 + h * 48;
    const bf16_t* Kc = MK + ctx0 * 192 + h * 48;
    const bf16_t* Vl = MV + lat0 * 256 + h * 64;
    const bf16_t* Vc = MV + ctx0 * 256 + h * 64;
    attn_item<1, 48>(Qp, 192, Kl, Kc, 192, Vl, Vc, 256, qt * 128, isctx ? 0 : SEQ / 64, CTXL / 64, epi, smem);
}
DEV int s5_token(int b, int tb, int n) { return tb == 0 ? TL + b * CTXL + n : b * SEQ + (tb - 1) * 256 + n; }
struct S5M { float are, aim; bf16x8* bfl; };
DEV void s5_coef(const Params& p, int gi, int pl, float& are, float& aim, float& cr, float& ci) {
    const float lre = p.in[I_S5LRE][gi * 64 + pl], lim = p.in[I_S5LIM][gi * 64 + pl];
    const float dt = __expf(p.in[I_S5LDT][gi]);
    const float mag = __expf(lre * dt);
    are = mag * __cosf(lim * dt); aim = mag * __sinf(lim * dt);
    const float nr = are - 1.f, ni = aim, den = 1.f / (lre * lre + lim * lim);
    cr = (nr * lre + ni * lim) * den; ci = (ni * lre - nr * lim) * den;
}
DEV void s5_setup(const Params& p, int l, int d, int g, int lane, S5M& s, bf16x8* bfl) {
    s.bfl = bfl;
    const int gi = ((l * 2 + d) * 16 + g), c16 = lane & 15, kq = lane >> 4;
    float cr, ci;
    s5_coef(p, gi, lane, s.are, s.aim, cr, ci);
#pragma unroll
    for (int nt = 0; nt < 4; ++nt) {
        const int pp = nt * 16 + c16;
        float a0, a1; s5_coef(p, gi, pp, a0, a1, cr, ci);
        float re[8], im[8];
        const float* br = p.in[I_S5BRE] + ((size_t)gi * 64 + pp) * 16 + (kq & 1) * 8;
        const float* bi = p.in[I_S5BIM] + ((size_t)gi * 64 + pp) * 16 + (kq & 1) * 8;
#pragma unroll
        for (int j = 0; j < 8; ++j) { const float x = br[j], y = bi[j]; const bool on = kq < 2; re[j] = on ? cr * x - ci * y : 0.f; im[j] = on ? cr * y + ci * x : 0.f; }
        bfl[nt * 64 + lane] = __builtin_bit_cast(bf16x8, (u32x4){pack2(re[0], re[1]), pack2(re[2], re[3]), pack2(re[4], re[5]), pack2(re[6], re[7])});
        bfl[(nt + 4) * 64 + lane] = __builtin_bit_cast(bf16x8, (u32x4){pack2(im[0], im[1]), pack2(im[2], im[3]), pack2(im[4], im[5]), pack2(im[6], im[7])});
    }
}
DEV void s5_bu32(const S5M& s, const bf16_t* P, int b, int tb, int g, int sc, bf16_t* hb, int lane) {
    asm volatile("" : "+v"(sc));
    const int c16 = lane & 15, kq = lane >> 4;
    bf16x8 uf[2];
#pragma unroll
    for (int mt = 0; mt < 2; ++mt) {
        const int t = s5_token(b, tb, sc * 32 + mt * 16 + c16);
        const u32x4 raw = *(const u32x4*)(P + (size_t)t * LDP + C_S5 + g * 16 + (kq & 1) * 8);
        const u32x4 z = (u32x4){0u, 0u, 0u, 0u};
        uf[mt] = __builtin_bit_cast(bf16x8, kq < 2 ? raw : z);
    }
#pragma unroll
    for (int nt = 0; nt < 8; ++nt)
#pragma unroll
        for (int mt = 0; mt < 2; ++mt) {
            const f32x4 acc = __builtin_amdgcn_mfma_f32_16x16x32_bf16(s.bfl[nt * 64 + lane], uf[mt], (f32x4){0.f, 0.f, 0.f, 0.f}, 0, 0, 0);
            u32x2 o; o.x = pack2(acc[0], acc[1]); o.y = pack2(acc[2], acc[3]);
            *(u32x2*)(hb + (mt * 16 + c16) * 136 + nt * 16 + kq * 4) = o;
            if (mt == 1 && (nt & 1)) __builtin_amdgcn_sched_barrier(0);
        }
}
template <bool DUMP>
DEV void s5_scan32(const S5M& s, float& hre, float& him, bf16_t* hb, int pl, bool rev) {
#pragma unroll 4
    for (int j = 0; j < 32; ++j) {
        const int rowi = rev ? 31 - j : j;
        const float bur = bf2f(hb[rowi * 136 + pl]), bui = bf2f(hb[rowi * 136 + 64 + pl]);
        const float nre = s.are * hre - s.aim * him + bur;
        const float nim = s.are * him + s.aim * hre + bui;
        hre = nre; him = nim;
        if (DUMP) { hb[rowi * 136 + pl] = f2bf(hre); hb[rowi * 136 + 64 + pl] = f2bf(him); }
    }
}
DEV void phase_s5_pass1(const Params& p, int l, char* smem) {
    const int lane = tidx() & 63, wave = tidx() >> 6;
    bf16_t* hb = (bf16_t*)smem + wave * (32 * 136);
    const bf16_t* P = wsb(p, OFF_P);
    float* st = wsf(p, OFF_S5ST);
    const int nitems = 2 * 8 * 16 * 8;
    for (int it0 = bidx() * 4; it0 < nitems; it0 += gridDim.x * 4) {
        const int it = it0 + wave;
        const int seg = it & 7, g = (it >> 3) & 15, b = (it >> 7) & 7, d = it >> 10;
        const int tb = seg == 0 ? 0 : (d == 0 ? seg : 9 - seg);
        __syncthreads();
        S5M s; s5_setup(p, l, d, g, lane, s, (bf16x8*)(smem + 36864) + wave * 512);
        float hre = 0.f, him = 0.f;
        for (int k = 0; k < 8; ++k) {
            const int sc = d == 0 ? k : 7 - k;
            __syncthreads();
            s5_bu32(s, P, b, tb, g, sc, hb, lane);
            __syncthreads();
            s5_scan32<false>(s, hre, him, hb, lane, d == 1);
        }
        float* o = st + ((((size_t)d * 8 + b) * 16 + g) * 8 + seg) * 128;
        o[lane] = hre; o[64 + lane] = him;
    }
}
DEV void s5_pass2_item(const Params& p, int l, int tb0, int bitem, char* smem) {
    const int lane = tidx() & 63, wave = tidx() >> 6;
    bf16_t* hb = (bf16_t*)smem + wave * (32 * 136);
    bf16_t* P = wsb(p, OFF_P);
    bf16_t* S5Y = wsb(p, OFF_S5Y);
    const float* st = wsf(p, OFF_S5ST);
    const int it = bitem * 4 + wave;
    const int g = it & 15, b = (it >> 4) & 7, tb = (it >> 7) + tb0;
    const int c = lane & 15;
    const float dd = p.in[I_S5D][(l * 16 + g) * 16 + c];
#pragma unroll 1
    for (int d = 0; d < 2; ++d) {
        __syncthreads();
        S5M s; s5_setup(p, l, d, g, lane, s, (bf16x8*)(smem + 36864) + wave * 512);
        bf16x8 cf[4];
        {
            const float* cre = p.in[I_S5CRE] + ((size_t)((l * 2 + d) * 16 + g) * 16 + c) * 64 + (lane >> 4) * 8;
            const float* cim = p.in[I_S5CIM] + ((size_t)((l * 2 + d) * 16 + g) * 16 + c) * 64 + (lane >> 4) * 8;
#pragma unroll
            for (int ks = 0; ks < 4; ++ks) {
                const float* src = ks < 2 ? cre + ks * 32 : cim + (ks - 2) * 32;
                const float4 a = *(const float4*)src, b4 = *(const float4*)(src + 4);
                const float sg = ks < 2 ? 1.f : -1.f;
                cf[ks] = __builtin_bit_cast(bf16x8, (u32x4){pack2(sg * a.x, sg * a.y), pack2(sg * a.z, sg * a.w), pack2(sg * b4.x, sg * b4.y), pack2(sg * b4.z, sg * b4.w)});
            }
        }
        const int seg = tb == 0 ? 0 : (d == 0 ? tb : 9 - tb);
        float hre = 0.f, him = 0.f;
        {
            float pr = s.are, pi = s.aim;
#pragma unroll
            for (int q = 0; q < 8; ++q) { const float nr = pr * pr - pi * pi, ni = 2.f * pr * pi; pr = nr; pi = ni; }
            const float* hs = st + (((size_t)d * 8 + b) * 16 + g) * 8 * 128;
            for (int i = 0; i < seg; ++i) {
                const float er = hs[i * 128 + lane], ei = hs[i * 128 + 64 + lane];
                const float nr = pr * hre - pi * him + er, ni = pr * him + pi * hre + ei;
                hre = nr; him = ni;
            }
        }
#pragma unroll 1
        for (int k = 0; k < 8; ++k) {
            const int sc = d == 0 ? k : 7 - k;
            __syncthreads();
            s5_bu32(s, P, b, tb, g, sc, hb, lane);
            __syncthreads();
            s5_scan32<true>(s, hre, him, hb, lane, d == 1);
            __syncthreads();
#pragma unroll
            for (int mt = 0; mt < 2; ++mt) {
                f32x4 y = (f32x4){0.f, 0.f, 0.f, 0.f};
#pragma unroll
                for (int ks = 0; ks < 4; ++ks) {
                    const bf16x8 af = *(const bf16x8*)(hb + (mt * 16 + (lane & 15)) * 136 + ks * 32 + (lane >> 4) * 8);
                    y = __builtin_amdgcn_mfma_f32_16x16x32_bf16(af, cf[ks], y, 0, 0, 0);
                }
#pragma unroll
                for (int r = 0; r < 4; ++r) {
                    const int n = sc * 32 + mt * 16 + (lane >> 4) * 4 + r;
                    const size_t t = (size_t)s5_token(b, tb, n);
                    if (d == 0) S5Y[t * 256 + g * 16 + c] = f2bf(y[r]);
                    else {
                        bf16_t* up = P + t * LDP + C_S5 + g * 16 + c;
                        const float yy = dd * bf2f(*up) + bf2f(S5Y[t * 256 + g * 16 + c]) + y[r];
                        *up = f2bf(0.5f * yy * (1.f + tanhf(0.7978845608028654f * (yy + 0.044715f * yy * yy * yy))));
                    }
                }
            }
        }
    }
}

DEV float row16_sum(float v) {
    v += __int_as_float(__builtin_amdgcn_mov_dpp(__float_as_int(v), 0x128, 0xf, 0xf, true));
    v += __int_as_float(__builtin_amdgcn_mov_dpp(__float_as_int(v), 0x124, 0xf, 0xf, true));
    v += __int_as_float(__builtin_amdgcn_mov_dpp(__float_as_int(v), 0x122, 0xf, 0xf, true));
    v += __int_as_float(__builtin_amdgcn_mov_dpp(__float_as_int(v), 0x121, 0xf, 0xf, true));
    return v;
}
DEV float fmul_(float a, float b) { return a * b; }
DEV float fadd_(float a, float b) { return a + b; }
DEV float ffma_(float a, float b, float c) { return __builtin_fmaf(a, b, c); }
DEV float fnma_(float a, float b, float c) { return __builtin_fmaf(-a, b, c); }
DEV float row8_sum(float v) {
    v += __int_as_float(__builtin_amdgcn_mov_dpp(__float_as_int(v), 0x141, 0xf, 0xf, true));
    v += __int_as_float(__builtin_amdgcn_mov_dpp(__float_as_int(v), 0xB1, 0xf, 0xf, true));
    v += __int_as_float(__builtin_amdgcn_mov_dpp(__float_as_int(v), 0x4E, 0xf, 0xf, true));
    return v;
}
DEV float row16_sum1(float v) { v += __int_as_float(__builtin_amdgcn_mov_dpp(__float_as_int(v), 0x128, 0xf, 0xf, true)); return v; }
constexpr int RW_CT = 16;
struct RwRaw { u32x2 r[3], k[3], v[3], sd, a; float fp, fn; };
#ifndef RWVAR
#define RWVAR 0
#endif
template <int var>
DEV void rw_item_t(const Params& p, int l, int item, char* smem, int rep) {
    const int tid = tidx(), li = tid >> 4, lc = tid & 15;
    const int ch = item >> 2, rg = item & 3, dir = ch >> 5, b = (ch >> 2) & 7, head = ch & 3;
    float* buf = (float*)smem;
    float* ybuf = buf + 2 * RW_CT * 384;
    const bf16_t* P = wsb(p, OFF_P);
    const bf16_t* RWX = wsb(p, OFF_RWX);
    bf16_t* RWY = wsb(p, OFF_RWY) + (size_t)dir * TT * 256 + (rep > 0 ? (size_t)2 * TT * 256 : 0);
    const int hc = head * 64 + lc * 4;
    const float4 mur = *(const float4*)(p.in[I_RMU] + (l * 4 + 0) * 256 + hc);
    const float4 muk = *(const float4*)(p.in[I_RMU] + (l * 4 + 1) * 256 + hc);
    const float4 muv = *(const float4*)(p.in[I_RMU] + (l * 4 + 2) * 256 + hc);
    const float4 kk4 = *(const float4*)(p.in[I_RKK] + l * 256 + hc);
    const float4 ka4 = *(const float4*)(p.in[I_RKA] + l * 256 + hc);
    const int NCH = (CTXL + SEQ) / RW_CT;
    auto tok_of = [&](int cidx, int i, int& n, int& len) -> int {
        if (cidx < CTXL / RW_CT) { const int pos = cidx * RW_CT + i; len = CTXL; n = dir == 0 ? pos : CTXL - 1 - pos; return TL + b * CTXL + n; }
        const int pos = (cidx - CTXL / RW_CT) * RW_CT + i; len = SEQ; n = dir == 0 ? pos : SEQ - 1 - pos; return b * SEQ + n;
    };
    auto load_raw = [&](int cidx, RwRaw& raw) {
        int n, len; const int t = tok_of(cidx, li, n, len);
        const bf16_t* row = P + (size_t)t * LDP;
        const bool hp = n > 0, hn = n + 1 < len;
        const bf16_t* rp = hp ? row - LDP : row;
        const bf16_t* rn = hn ? row + LDP : row;
        raw.fp = hp ? 0.5f : 0.f; raw.fn = hn ? 0.5f : 0.f;
        raw.r[1] = *(const u32x2*)(row + C_RWR + hc); raw.k[1] = *(const u32x2*)(row + C_RWK + hc); raw.v[1] = *(const u32x2*)(row + C_RWV + hc);
        raw.r[0] = *(const u32x2*)(rp + C_RWR + hc); raw.k[0] = *(const u32x2*)(rp + C_RWK + hc); raw.v[0] = *(const u32x2*)(rp + C_RWV + hc);
        raw.r[2] = *(const u32x2*)(rn + C_RWR + hc); raw.k[2] = *(const u32x2*)(rn + C_RWK + hc); raw.v[2] = *(const u32x2*)(rn + C_RWV + hc);
        raw.sd = *(const u32x2*)(RWX + (size_t)t * 1024 + dir * 256 + hc);
        raw.a = *(const u32x2*)(RWX + (size_t)t * 1024 + 512 + dir * 256 + hc);
    };
    auto mix4 = [&](const u32x2 (&s)[3], const float4& mu, float fp, float fn, float (&o)[4]) {
        { const float x = bflo(s[1].x); o[0] = x + ((fp * bflo(s[0].x) + fn * bflo(s[2].x)) - x) * mu.x; }
        { const float x = bfhi(s[1].x); o[1] = x + ((fp * bfhi(s[0].x) + fn * bfhi(s[2].x)) - x) * mu.y; }
        { const float x = bflo(s[1].y); o[2] = x + ((fp * bflo(s[0].y) + fn * bflo(s[2].y)) - x) * mu.z; }
        { const float x = bfhi(s[1].y); o[3] = x + ((fp * bfhi(s[0].y) + fn * bfhi(s[2].y)) - x) * mu.w; }
    };
    auto stage = [&](int st, const RwRaw& raw) {
        float r4[4], k4[4], v4[4];
        mix4(raw.r, mur, raw.fp, raw.fn, r4); mix4(raw.k, muk, raw.fp, raw.fn, k4); mix4(raw.v, muv, raw.fp, raw.fn, v4);
        const float kkr[4] = { k4[0] * kk4.x, k4[1] * kk4.y, k4[2] * kk4.z, k4[3] * kk4.w };
        float nn = kkr[0] * kkr[0] + kkr[1] * kkr[1] + kkr[2] * kkr[2] + kkr[3] * kkr[3];
        nn = row16_sum(nn);
        const float rn = 1.f / fmaxf(sqrtf(nn), 1e-12f);
        const float a[4] = { bflo(raw.a.x), bfhi(raw.a.x), bflo(raw.a.y), bfhi(raw.a.y) };
        const float sd[4] = { bflo(raw.sd.x), bfhi(raw.sd.x), bflo(raw.sd.y), bfhi(raw.sd.y) };
        const float kav[4] = { ka4.x, ka4.y, ka4.z, ka4.w };
        float* d = buf + (st * RW_CT + li) * 384 + lc * 4;
        float wp[4], kp[4], bp[4], mp[4];
#pragma unroll
        for (int j = 0; j < 4; ++j) {
            wp[j] = __expf(-sd[j]);
            kp[j] = kkr[j] * rn;
            bp[j] = kp[j] * a[j];
            mp[j] = k4[j] * (1.f + (a[j] - 1.f) * kav[j]);
        }
        *(float4*)(d + 0) = make_float4(wp[0], wp[1], wp[2], wp[3]); *(float4*)(d + 64) = make_float4(kp[0], kp[1], kp[2], kp[3]);
        *(float4*)(d + 128) = make_float4(bp[0], bp[1], bp[2], bp[3]); *(float4*)(d + 192) = make_float4(mp[0], mp[1], mp[2], mp[3]);
        *(float4*)(d + 256) = make_float4(r4[0], r4[1], r4[2], r4[3]);
        *(float4*)(d + 320) = make_float4(v4[0], v4[1], v4[2], v4[3]);
    };
    float S0 = 0.f, S1 = 0.f, S2 = 0.f, S3 = 0.f;
    auto compute = [&](int cidx, int cur, const RwRaw& rs, bool do_stage) {
        float sr4[4], sk4[4], sv4[4], skkr[4], srn = 0.f;
        const float* cb = buf + cur * RW_CT * 384 + lc * 4;
        const float* vb = buf + cur * RW_CT * 384 + 320 + rg * 16 + li;
        float ykeep = 0.f;
        f32x4 w[2], kk[2], bb[2], km[2], rr[2]; float vv[2];
        w[0] = *(const f32x4*)(cb); kk[0] = *(const f32x4*)(cb + 64); bb[0] = *(const f32x4*)(cb + 128); km[0] = *(const f32x4*)(cb + 192); rr[0] = *(const f32x4*)(cb + 256);
        vv[0] = vb[0];
#pragma unroll
        for (int j = 0; j < RW_CT; ++j) {
            const int c0 = j & 1, c2 = c0 ^ 1;
            if (j + 1 < RW_CT) {
                const float* nb = cb + (j + 1) * 384;
                w[c2] = *(const f32x4*)(nb); kk[c2] = *(const f32x4*)(nb + 64); bb[c2] = *(const f32x4*)(nb + 128); km[c2] = *(const f32x4*)(nb + 192); rr[c2] = *(const f32x4*)(nb + 256);
                vv[c2] = vb[(j + 1) * 384];
            }
            const float v_ = vv[c0];
            float sa = fadd_(ffma_(S1, kk[c0][1], fmul_(S0, kk[c0][0])), ffma_(S3, kk[c0][3], fmul_(S2, kk[c0][2])));
            const float t0 = ffma_(S0, w[c0][0], fmul_(v_, km[c0][0])), t1 = ffma_(S1, w[c0][1], fmul_(v_, km[c0][1]));
            const float t2 = ffma_(S2, w[c0][2], fmul_(v_, km[c0][2])), t3 = ffma_(S3, w[c0][3], fmul_(v_, km[c0][3]));
            sa = row16_sum(sa);
            S0 = fnma_(sa, bb[c0][0], t0); S1 = fnma_(sa, bb[c0][1], t1); S2 = fnma_(sa, bb[c0][2], t2); S3 = fnma_(sa, bb[c0][3], t3);
            float y = fadd_(ffma_(S1, rr[c0][1], fmul_(S0, rr[c0][0])), ffma_(S3, rr[c0][3], fmul_(S2, rr[c0][2])));
            y = row16_sum(y);
            ykeep = (lc == j) ? y : ykeep;
            if (j == 2) { mix4(rs.r, mur, rs.fp, rs.fn, sr4); }
            if (j == 5) { mix4(rs.k, muk, rs.fp, rs.fn, sk4); }
            if (j == 8) { mix4(rs.v, muv, rs.fp, rs.fn, sv4); }
            if (j == 11) {
                skkr[0] = sk4[0] * kk4.x; skkr[1] = sk4[1] * kk4.y; skkr[2] = sk4[2] * kk4.z; skkr[3] = sk4[3] * kk4.w;
                float nn = skkr[0] * skkr[0] + skkr[1] * skkr[1] + skkr[2] * skkr[2] + skkr[3] * skkr[3];
                nn = row16_sum(nn);
                srn = 1.f / fmaxf(sqrtf(nn), 1e-12f);
            }
        }
        if (do_stage) {
            const float a[4] = { bflo(rs.a.x), bfhi(rs.a.x), bflo(rs.a.y), bfhi(rs.a.y) };
            const float sd[4] = { bflo(rs.sd.x), bfhi(rs.sd.x), bflo(rs.sd.y), bfhi(rs.sd.y) };
            const float kav[4] = { ka4.x, ka4.y, ka4.z, ka4.w };
            float* d = buf + ((cur ^ 1) * RW_CT + li) * 384 + lc * 4;
            float wp[4], kp[4], bp[4], mp[4];
#pragma unroll
            for (int q = 0; q < 4; ++q) {
                wp[q] = __expf(-sd[q]);
                kp[q] = skkr[q] * srn;
                bp[q] = kp[q] * a[q];
                mp[q] = sk4[q] * (1.f + (a[q] - 1.f) * kav[q]);
            }
            *(float4*)(d + 0) = make_float4(wp[0], wp[1], wp[2], wp[3]); *(float4*)(d + 64) = make_float4(kp[0], kp[1], kp[2], kp[3]);
            *(float4*)(d + 128) = make_float4(bp[0], bp[1], bp[2], bp[3]); *(float4*)(d + 192) = make_float4(mp[0], mp[1], mp[2], mp[3]);
            *(float4*)(d + 256) = make_float4(sr4[0], sr4[1], sr4[2], sr4[3]);
            *(float4*)(d + 320) = make_float4(sv4[0], sv4[1], sv4[2], sv4[3]);
        }
        {
            int n, len; const int t = tok_of(cidx, lc, n, len);
            RWY[(size_t)t * 256 + head * 64 + rg * 16 + li] = f2bf(ykeep);
        }
    };
    RwRaw rawA, rawB;
    __syncthreads();
    load_raw(0, rawA);
    stage(0, rawA);
    load_raw(1, rawA);
    __syncthreads();
    for (int cidx = 0; cidx < NCH; cidx += 2) {
        load_raw(min(cidx + 2, NCH - 1), rawB);
        compute(cidx, 0, rawA, true);
        __syncthreads();
        load_raw(min(cidx + 3, NCH - 1), rawA);
        compute(cidx + 1, 1, rawB, cidx + 2 < NCH);
        __syncthreads();
    }
}

DEV void rw_item(const Params& p, int l, int item, char* smem, int rep = 0) {
    rw_item_t<RWVAR>(p, l, item, smem, rep);
}
constexpr int RC = 32, SK = 72, ST = 40;
constexpr int L_K1 = 0, L_R1 = L_K1 + RC * SK, L_B1 = L_R1 + RC * SK, L_M1 = L_B1 + RC * SK,
              L_VT = L_M1 + RC * SK, L_B2T = L_VT + 64 * ST, L_M2T = L_B2T + 64 * ST,
              L_X = L_M2T + 64 * ST, L_XT = L_X + RC * ST, L_PA = L_XT + RC * ST, L_BM = L_PA + RC * ST, L_AR = L_BM + RC * ST, L_BR = L_AR + RC * ST,
              L_ET = L_BR + RC * ST, L_ZT = L_ET + 64 * ST, L_S = L_ZT + 64 * ST, L_RWEND = L_S + 64 * SK;
static_assert(L_RWEND * 2 + 256 <= 73728, "RWKV chunk LDS");
DEV bf16x8 ldfrag(const bf16_t* m, int stride, int row0, int k0, int lane) { return *(const bf16x8*)(m + (row0 + (lane & 15)) * stride + k0 + (lane >> 4) * 8); }
DEV f32x4 mfma16(bf16x8 a, bf16x8 b, f32x4 c) { return __builtin_amdgcn_mfma_f32_16x16x32_bf16(a, b, c, 0, 0, 0); }
#ifndef RWC_CLAMP
#define RWC_CLAMP 0
#endif
DEV void st4(bf16_t* dst, f32x4 v) {
    if (RWC_CLAMP) { for (int i = 0; i < 4; ++i) v[i] = fminf(fmaxf(v[i], -8.f), 8.f); } u32x2 o; o.x = pack2(v[0], v[1]); o.y = pack2(v[2], v[3]); *(u32x2*)dst = o; }
DEV void unpack8(const u32x4 u, float (&o)[8]) {
    o[0] = bflo(u[0]); o[1] = bfhi(u[0]); o[2] = bflo(u[1]); o[3] = bfhi(u[1]); o[4] = bflo(u[2]); o[5] = bfhi(u[2]); o[6] = bflo(u[3]); o[7] = bfhi(u[3]);
}
DEV u32x4 pack8(const float (&v)[8]) { return (u32x4){pack2(v[0], v[1]), pack2(v[2], v[3]), pack2(v[4], v[5]), pack2(v[6], v[7])}; }
struct RwcRaw { u32x4 r[3], k[3], v[3], sd, a; float fp, fn; };
#ifndef RWC_STOP
#define RWC_STOP 99
#endif
#ifndef RWC_DUMMY
#define RWC_DUMMY 0
#endif
#ifdef RWC_NOINLINE
__device__ __attribute__((noinline)) void rwc_item(const Params& p, int l, int chain, char* smem) {
#else
DEV void rwc_item(const Params& p, int l, int chain, char* smem) {
#endif
    const int tid = tidx(), lane = tid & 63, wave = __builtin_amdgcn_readfirstlane(tid >> 6), c16 = lane & 15, q4 = lane >> 4;
    const int dir = chain >> 5, b = (chain >> 2) & 7, head = chain & 3;
    bf16_t* L = (bf16_t*)smem;
    float* PC = (float*)(smem + L_RWEND * 2);
    float* CS = (float*)(L + L_ET);
    const bf16_t* P = wsb(p, OFF_P);
    const bf16_t* RWX = wsb(p, OFF_RWX);
    bf16_t* RWY = wsb(p, OFF_RWY) + (size_t)dir * TT * 256 + (RWC_DUMMY ? (size_t)2 * TT * 256 : 0);
    const int li = tid >> 3, c8 = (tid & 7) * 8, hc = head * 64 + c8;
    const int NCHK = (CTXL + SEQ) / RC;
    auto tok_of = [&](int c, int i, int& n, int& len) -> int {
        if (c < CTXL / RC) { const int pos = c * RC + i; len = CTXL; n = dir == 0 ? pos : CTXL - 1 - pos; return TL + b * CTXL + n; }
        const int pos = (c - CTXL / RC) * RC + i; len = SEQ; n = dir == 0 ? pos : SEQ - 1 - pos; return b * SEQ + n;
    };
    RwcRaw raw;
    auto load_raw = [&](int c) {
        int n, len; const int t = tok_of(c, li, n, len);
        const bf16_t* row = P + (size_t)t * LDP;
        const bool hp = n > 0, hn = n + 1 < len;
        const bf16_t* rp = hp ? row - LDP : row;
        const bf16_t* rn = hn ? row + LDP : row;
        raw.fp = hp ? 0.5f : 0.f; raw.fn = hn ? 0.5f : 0.f;
        raw.r[1] = *(const u32x4*)(row + C_RWR + hc); raw.k[1] = *(const u32x4*)(row + C_RWK + hc); raw.v[1] = *(const u32x4*)(row + C_RWV + hc);
        raw.r[0] = *(const u32x4*)(rp + C_RWR + hc); raw.k[0] = *(const u32x4*)(rp + C_RWK + hc); raw.v[0] = *(const u32x4*)(rp + C_RWV + hc);
        raw.r[2] = *(const u32x4*)(rn + C_RWR + hc); raw.k[2] = *(const u32x4*)(rn + C_RWK + hc); raw.v[2] = *(const u32x4*)(rn + C_RWV + hc);
        raw.sd = *(const u32x4*)(RWX + (size_t)t * 1024 + dir * 256 + hc);
        raw.a = *(const u32x4*)(RWX + (size_t)t * 1024 + 512 + dir * 256 + hc);
    };
    auto mix8 = [&](const u32x4 (&s)[3], const float* mu, float (&o)[8]) {
        float x[8], pv[8], nx[8]; unpack8(s[1], x); unpack8(s[0], pv); unpack8(s[2], nx);
        const float4 m0 = *(const float4*)mu, m1 = *(const float4*)(mu + 4);
        const float m[8] = { m0.x, m0.y, m0.z, m0.w, m1.x, m1.y, m1.z, m1.w };
#pragma unroll
        for (int j = 0; j < 8; ++j) o[j] = x[j] + ((raw.fp * pv[j] + raw.fn * nx[j]) - x[j]) * m[j];
    };
    f32x4 Wt[4];
#pragma unroll
    for (int j = 0; j < 4; ++j) Wt[j] = (f32x4){0.f, 0.f, 0.f, 0.f};
    __syncthreads();
    for (int i = tid; i < 64 * SK / 2; i += NT) ((unsigned*)(L + L_S))[i] = 0u;
    load_raw(0);
    for (int c = 0; c < (RWC_STOP == 0 ? 0 : NCHK); ++c) {
        {
            float r8[8], k8[8], v8[8], a8[8], sd8[8];
            mix8(raw.r, p.in[I_RMU] + (l * 4 + 0) * 256 + hc, r8);
            mix8(raw.k, p.in[I_RMU] + (l * 4 + 1) * 256 + hc, k8);
            mix8(raw.v, p.in[I_RMU] + (l * 4 + 2) * 256 + hc, v8);
            unpack8(raw.a, a8); unpack8(raw.sd, sd8);
            if (c + 1 < NCHK) load_raw(c + 1);
            const float4 kk0 = *(const float4*)(p.in[I_RKK] + l * 256 + hc), kk1 = *(const float4*)(p.in[I_RKK] + l * 256 + hc + 4);
            const float4 ka0 = *(const float4*)(p.in[I_RKA] + l * 256 + hc), ka1 = *(const float4*)(p.in[I_RKA] + l * 256 + hc + 4);
            const float kkc[8] = { kk0.x, kk0.y, kk0.z, kk0.w, kk1.x, kk1.y, kk1.z, kk1.w };
            const float kac[8] = { ka0.x, ka0.y, ka0.z, ka0.w, ka1.x, ka1.y, ka1.z, ka1.w };
            float kkv[8], bbv[8], kmv[8]; float n2 = 0.f;
#pragma unroll
            for (int j = 0; j < 8; ++j) { kkv[j] = k8[j] * kkc[j]; n2 += kkv[j] * kkv[j]; }
            n2 = row8_sum(n2);
            const float rn = 1.f / fmaxf(sqrtf(n2), 1e-12f);
#pragma unroll
            for (int j = 0; j < 8; ++j) { kkv[j] *= rn; bbv[j] = kkv[j] * a8[j]; kmv[j] = k8[j] * (1.f + (a8[j] - 1.f) * kac[j]); }
            *(float4*)(CS + li * 64 + c8) = make_float4(sd8[0], sd8[1], sd8[2], sd8[3]);
            *(float4*)(CS + li * 64 + c8 + 4) = make_float4(sd8[4], sd8[5], sd8[6], sd8[7]);
            __syncthreads();
            if (tid < 64) { float run = 0.f; for (int i = 0; i < RC; ++i) { run += CS[i * 64 + tid]; CS[i * 64 + tid] = run; } }
            __syncthreads();
            float cs[8], tot[8];
            { const float4 a0 = *(const float4*)(CS + li * 64 + c8), a1 = *(const float4*)(CS + li * 64 + c8 + 4);
              const float4 t0 = *(const float4*)(CS + (RC - 1) * 64 + c8), t1 = *(const float4*)(CS + (RC - 1) * 64 + c8 + 4);
              cs[0] = a0.x; cs[1] = a0.y; cs[2] = a0.z; cs[3] = a0.w; cs[4] = a1.x; cs[5] = a1.y; cs[6] = a1.z; cs[7] = a1.w;
              tot[0] = t0.x; tot[1] = t0.y; tot[2] = t0.z; tot[3] = t0.w; tot[4] = t1.x; tot[5] = t1.y; tot[6] = t1.z; tot[7] = t1.w; }
            float k1[8], r1[8], b1[8], m1[8], b2[8], m2[8];
#pragma unroll
            for (int j = 0; j < 8; ++j) {
                const float pinc = __expf(-cs[j]), pexc = __expf(sd8[j] - cs[j]), einv = __expf(cs[j]), ec = __expf(cs[j] - tot[j]);
                k1[j] = kkv[j] * pexc; r1[j] = r8[j] * pinc; b1[j] = bbv[j] * einv; m1[j] = kmv[j] * einv; b2[j] = bbv[j] * ec; m2[j] = kmv[j] * ec;
            }
            __syncthreads();
            *(u32x4*)(L + L_K1 + li * SK + c8) = pack8(k1); *(u32x4*)(L + L_R1 + li * SK + c8) = pack8(r1);
            *(u32x4*)(L + L_B1 + li * SK + c8) = pack8(b1); *(u32x4*)(L + L_M1 + li * SK + c8) = pack8(m1);
#pragma unroll
            for (int j = 0; j < 8; ++j) {
                L[L_VT + (c8 + j) * ST + li] = f2bf(v8[j]); L[L_B2T + (c8 + j) * ST + li] = f2bf(b2[j]); L[L_M2T + (c8 + j) * ST + li] = f2bf(m2[j]);
            }
            if (li == RC - 1) {
#pragma unroll
                for (int j = 0; j < 8; ++j) PC[c8 + j] = __expf(-tot[j]);
            }
            __syncthreads();
        }
        if (RWC_STOP <= 1) continue;
        {
            const int i0 = wave >> 1, j0 = wave & 1;
            const f32x4 z4 = (f32x4){0.f, 0.f, 0.f, 0.f};
            f32x4 aS = z4, aU = z4, bm = z4, ar = z4, br = z4;
#pragma unroll
            for (int kk2 = 0; kk2 < 2; ++kk2) {
                const bf16x8 k1i = ldfrag(L + L_K1, SK, i0 * 16, kk2 * 32, lane), k1j = ldfrag(L + L_K1, SK, j0 * 16, kk2 * 32, lane);
                const bf16x8 b1i = ldfrag(L + L_B1, SK, i0 * 16, kk2 * 32, lane), b1j = ldfrag(L + L_B1, SK, j0 * 16, kk2 * 32, lane);
                const bf16x8 m1i = ldfrag(L + L_M1, SK, i0 * 16, kk2 * 32, lane), r1j = ldfrag(L + L_R1, SK, j0 * 16, kk2 * 32, lane);
                aS = mfma16(b1i, k1j, aS);
                aU = mfma16(k1i, b1j, aU);
                bm = mfma16(m1i, k1j, bm);
                ar = mfma16(b1i, r1j, ar);
                br = mfma16(m1i, r1j, br);
            }
#ifdef RWC_WAIT
            __builtin_amdgcn_sched_barrier(0); __builtin_amdgcn_s_sleep(2); __builtin_amdgcn_sched_barrier(0);
#endif
            {
                const int t = j0 * 16 + c16, s0 = i0 * 16 + q4 * 4;
                f32x4 x, pa, o1, o2, o3;
#pragma unroll
                for (int r = 0; r < 4; ++r) {
                    const bool lt = s0 + r < t, le = s0 + r <= t;
                    x[r] = lt ? -aS[r] : 0.f; pa[r] = x[r] + ((s0 + r == t) ? 1.f : 0.f);
                    o1[r] = lt ? bm[r] : 0.f; o2[r] = le ? ar[r] : 0.f; o3[r] = le ? br[r] : 0.f;
                }
#ifdef RWC_GSTORE
                { bf16_t* gd = wsb(p, OFF_RWY) + (size_t)2 * TT * 256 + (size_t)(bidx() * 256 + tid) * 32;
                  st4(gd, x); st4(gd + 4, pa); st4(gd + 8, o1); st4(gd + 12, o2); st4(gd + 16, o3); }
#else
                st4(L + L_X + t * ST + s0, x); st4(L + L_PA + t * ST + s0, pa);
                st4(L + L_BM + t * ST + s0, o1); st4(L + L_AR + t * ST + s0, o2); st4(L + L_BR + t * ST + s0, o3);
#endif
            }
            {
                const int s = j0 * 16 + c16, t0 = i0 * 16 + q4 * 4;
                f32x4 o;
#pragma unroll
                for (int r = 0; r < 4; ++r) o[r] = (s < t0 + r) ? -aU[r] : 0.f;
#ifdef RWC_GSTORE
                st4(wsb(p, OFF_RWY) + (size_t)2 * TT * 256 + (size_t)(bidx() * 256 + tid) * 32 + 20, o);
#else
                st4(L + L_XT + s * ST + t0, o);
#endif
            }
            __syncthreads();
        }
        if (RWC_STOP <= 2) continue;
#pragma unroll 1
        for (int rd = 1; rd <= 5; ++rd) {
            const bool sq = rd <= 4, up = rd >= 2;
            const int i0 = wave >> 1, j0 = wave & 1;
            const bf16x8 xti = ldfrag(L + L_XT, ST, i0 * 16, 0, lane), xtj = ldfrag(L + L_XT, ST, j0 * 16, 0, lane);
            const bf16x8 xi = ldfrag(L + L_X, ST, i0 * 16, 0, lane), xj = ldfrag(L + L_X, ST, j0 * 16, 0, lane);
            const bf16x8 paj = ldfrag(L + L_PA, ST, j0 * 16, 0, lane);
            const u32x2 old = *(const u32x2*)(L + L_PA + (j0 * 16 + c16) * ST + i0 * 16 + q4 * 4);
            __syncthreads();
            const f32x4 z4 = (f32x4){0.f, 0.f, 0.f, 0.f};
            if (sq) {
                const f32x4 nx = mfma16(xti, xj, z4);
                const f32x4 nxt = mfma16(xi, xtj, z4);
                st4(L + L_X + (j0 * 16 + c16) * ST + i0 * 16 + q4 * 4, nx);
                st4(L + L_XT + (j0 * 16 + c16) * ST + i0 * 16 + q4 * 4, nxt);
            }
            if (up) {
                f32x4 acc = (f32x4){bflo(old.x), bfhi(old.x), bflo(old.y), bfhi(old.y)};
                acc = mfma16(xti, paj, acc);
                st4(L + L_PA + (j0 * 16 + c16) * ST + i0 * 16 + q4 * 4, acc);
            }
            __syncthreads();
        }
        if (RWC_STOP <= 3) continue;
        {
            const int vj = wave;
#pragma unroll
            for (int ti = 0; ti < 2; ++ti) {
                f32x4 acc = mfma16(ldfrag(L + L_BM, ST, ti * 16, 0, lane), ldfrag(L + L_VT, ST, vj * 16, 0, lane), (f32x4){0.f, 0.f, 0.f, 0.f});
#pragma unroll
                for (int kk2 = 0; kk2 < 2; ++kk2) acc = mfma16(ldfrag(L + L_K1, SK, ti * 16, kk2 * 32, lane), ldfrag(L + L_S, SK, vj * 16, kk2 * 32, lane), acc);
                st4(L + L_ET + (vj * 16 + c16) * ST + ti * 16 + q4 * 4, acc);
            }
            __syncthreads();
#pragma unroll
            for (int ti = 0; ti < 2; ++ti) {
                const f32x4 acc = mfma16(ldfrag(L + L_PA, ST, ti * 16, 0, lane), ldfrag(L + L_ET, ST, vj * 16, 0, lane), (f32x4){0.f, 0.f, 0.f, 0.f});
                st4(L + L_ZT + (vj * 16 + c16) * ST + ti * 16 + q4 * 4, -acc);
            }
            __syncthreads();
        }
        if (RWC_STOP <= 4) continue;
        {
            const int vi = wave;
#pragma unroll
            for (int tj = 0; tj < 2; ++tj) {
                f32x4 acc = (f32x4){0.f, 0.f, 0.f, 0.f};
#pragma unroll
                for (int kk2 = 0; kk2 < 2; ++kk2) acc = mfma16(ldfrag(L + L_S, SK, vi * 16, kk2 * 32, lane), ldfrag(L + L_R1, SK, tj * 16, kk2 * 32, lane), acc);
                acc = mfma16(ldfrag(L + L_ZT, ST, vi * 16, 0, lane), ldfrag(L + L_AR, ST, tj * 16, 0, lane), acc);
                acc = mfma16(ldfrag(L + L_VT, ST, vi * 16, 0, lane), ldfrag(L + L_BR, ST, tj * 16, 0, lane), acc);
                int n, len; const int t = tok_of(c, tj * 16 + c16, n, len);
                u32x2 o; o.x = pack2(acc[0], acc[1]); o.y = pack2(acc[2], acc[3]);
#ifndef RWC_NOYSTORE
                *(u32x2*)(RWY + (size_t)t * 256 + head * 64 + vi * 16 + q4 * 4) = o;
#else
                asm volatile("" :: "v"(o), "v"(t));
#endif
            }
            const float4 pc = *(const float4*)(PC + wave * 16 + q4 * 4);
            const bf16x8 fb2 = ldfrag(L + L_B2T, ST, wave * 16, 0, lane), fm2 = ldfrag(L + L_M2T, ST, wave * 16, 0, lane);
#pragma unroll
            for (int vj = 0; vj < 4; ++vj) {
                f32x4 acc = Wt[vj];
                acc[0] *= pc.x; acc[1] *= pc.y; acc[2] *= pc.z; acc[3] *= pc.w;
                acc = mfma16(fb2, ldfrag(L + L_ZT, ST, vj * 16, 0, lane), acc);
                acc = mfma16(fm2, ldfrag(L + L_VT, ST, vj * 16, 0, lane), acc);
                Wt[vj] = acc;
            }
            __syncthreads();
#pragma unroll
            for (int vj = 0; vj < 4; ++vj) st4(L + L_S + (vj * 16 + c16) * SK + wave * 16 + q4 * 4, Wt[vj]);
        }
    }
    __syncthreads();
#ifdef RWC_ZERO_LDS
    for (int i = tid; i < 73728 / 4; i += NT) ((unsigned*)smem)[i] = 0u;
    __syncthreads();
#endif
}
DEV void phase_s5_glu(const Params& p, int l, int M, char* smem) {
    const bf16_t* P = wsb(p, OFF_P);
    const bf16_t* w = wsb(p, OFF_WSM) + (size_t)l * WS_PER_LAYER + WS_GLUT;
    bf16_t* Y = wsb(p, OFF_Y);
    const float* bg = p.in[I_S5BGLU] + l * 256;
    gemm_generic(P + C_S5, LDP, M, w, 256, 256, 256,
                 [&](int r, int c, float v) { const float z = bf2f(P[(size_t)r * LDP + C_S5 + c]); Y[(size_t)r * 1024 + 256 + c] = f2bf(z * sigmoidf_(v + bg[c])); }, smem, 0);
}
DEV void phase_rw_finish(const Params& p, int l, int M) {
    const int lane = tidx() & 63, wave = tidx() >> 6;
    const bf16_t* P = wsb(p, OFF_P);
    const bf16_t* RWX = wsb(p, OFF_RWX);
    const bf16_t* RWY = wsb(p, OFF_RWY);
    bf16_t* Y = wsb(p, OFF_Y);
    const int c = lane * 4;
    const float4 mur = *(const float4*)(p.in[I_RMU] + (l * 4 + 0) * 256 + c);
    const float4 muk = *(const float4*)(p.in[I_RMU] + (l * 4 + 1) * 256 + c);
    const float4 muv = *(const float4*)(p.in[I_RMU] + (l * 4 + 2) * 256 + c);
    const float4 ka4 = *(const float4*)(p.in[I_RKA] + l * 256 + c);
    const float4 rk4 = *(const float4*)(p.in[I_RRK] + l * 256 + c);
    const float4 lg4 = *(const float4*)(p.in[I_RLNG] + l * 256 + c);
    const float4 lb4 = *(const float4*)(p.in[I_RLNB] + l * 256 + c);
    const float mr_[4] = { mur.x, mur.y, mur.z, mur.w }, mk_[4] = { muk.x, muk.y, muk.z, muk.w }, mv_[4] = { muv.x, muv.y, muv.z, muv.w };
    const float ka_[4] = { ka4.x, ka4.y, ka4.z, ka4.w }, rk_[4] = { rk4.x, rk4.y, rk4.z, rk4.w }, lg_[4] = { lg4.x, lg4.y, lg4.z, lg4.w }, lb_[4] = { lb4.x, lb4.y, lb4.z, lb4.w };
    for (int t = bidx() * 4 + wave; t < M; t += gridDim.x * 4) {
        int base, n, len; tok_seq(t, base, n, len);
        const bf16_t* row = P + (size_t)t * LDP;
        const bool hp = n > 0, hn = n + 1 < len;
        const u32x2 z = (u32x2){0u, 0u};
        float r4[4], k4[4], v4[4];
        {
            const u32x2 cu = *(const u32x2*)(row + C_RWR + c), pv = hp ? *(const u32x2*)(row - LDP + C_RWR + c) : z, nx = hn ? *(const u32x2*)(row + LDP + C_RWR + c) : z;
            const float x[4] = { bflo(cu.x), bfhi(cu.x), bflo(cu.y), bfhi(cu.y) }, a[4] = { bflo(pv.x), bfhi(pv.x), bflo(pv.y), bfhi(pv.y) }, b[4] = { bflo(nx.x), bfhi(nx.x), bflo(nx.y), bfhi(nx.y) };
#pragma unroll
            for (int j = 0; j < 4; ++j) r4[j] = x[j] + (0.5f * (a[j] + b[j]) - x[j]) * mr_[j];
        }
        {
            const u32x2 cu = *(const u32x2*)(row + C_RWK + c), pv = hp ? *(const u32x2*)(row - LDP + C_RWK + c) : z, nx = hn ? *(const u32x2*)(row + LDP + C_RWK + c) : z;
            const float x[4] = { bflo(cu.x), bfhi(cu.x), bflo(cu.y), bfhi(cu.y) }, a[4] = { bflo(pv.x), bfhi(pv.x), bflo(pv.y), bfhi(pv.y) }, b[4] = { bflo(nx.x), bfhi(nx.x), bflo(nx.y), bfhi(nx.y) };
#pragma unroll
            for (int j = 0; j < 4; ++j) k4[j] = x[j] + (0.5f * (a[j] + b[j]) - x[j]) * mk_[j];
        }
        {
            const u32x2 cu = *(const u32x2*)(row + C_RWV + c), pv = hp ? *(const u32x2*)(row - LDP + C_RWV + c) : z, nx = hn ? *(const u32x2*)(row + LDP + C_RWV + c) : z;
            const float x[4] = { bflo(cu.x), bfhi(cu.x), bflo(cu.y), bfhi(cu.y) }, a[4] = { bflo(pv.x), bfhi(pv.x), bflo(pv.y), bfhi(pv.y) }, b[4] = { bflo(nx.x), bfhi(nx.x), bflo(nx.y), bfhi(nx.y) };
#pragma unroll
            for (int j = 0; j < 4; ++j) v4[j] = x[j] + (0.5f * (a[j] + b[j]) - x[j]) * mv_[j];
        }
        const u32x2 af = *(const u32x2*)(RWX + (size_t)t * 1024 + 512 + c), ab = *(const u32x2*)(RWX + (size_t)t * 1024 + 768 + c);
        const float a0[4] = { bflo(af.x), bfhi(af.x), bflo(af.y), bfhi(af.y) }, a1[4] = { bflo(ab.x), bfhi(ab.x), bflo(ab.y), bfhi(ab.y) };
        const u32x2 yf = *(const u32x2*)(RWY + (size_t)t * 256 + c), yb = *(const u32x2*)(RWY + (size_t)TT * 256 + (size_t)t * 256 + c);
        float y[4] = { bflo(yf.x) + bflo(yb.x), bfhi(yf.x) + bfhi(yb.x), bflo(yf.y) + bflo(yb.y), bfhi(yf.y) + bfhi(yb.y) };
        float s = y[0] + y[1] + y[2] + y[3];
        s = group_sum<16>(s);
        const float mean = s * (1.f / 64.f);
        float q = 0.f, bon = 0.f;
#pragma unroll
        for (int j = 0; j < 4; ++j) {
            const float dlt = y[j] - mean; q += dlt * dlt;
            const float kmsum = k4[j] * (2.f + (a0[j] + a1[j] - 2.f) * ka_[j]);
            bon += r4[j] * kmsum * rk_[j];
        }
        q = group_sum<16>(q); bon = group_sum<16>(bon);
        const float rstd = rsqrtf(q * (1.f / 64.f) + 64e-5f);
        const u32x2 gg = *(const u32x2*)(row + C_RWD + c);
        const float g[4] = { bflo(gg.x), bfhi(gg.x), bflo(gg.y), bfhi(gg.y) };
        float o[4];
#pragma unroll
        for (int j = 0; j < 4; ++j) o[j] = ((y[j] - mean) * rstd * lg_[j] + lb_[j] + bon * v4[j]) * g[j];
        u32x2 ov; ov.x = pack2(o[0], o[1]); ov.y = pack2(o[2], o[3]);
        *(u32x2*)(Y + (size_t)t * 1024 + 768 + c) = ov;
    }
}

DEV int queue_next(int* ctr, char* smem) {
    int* slot = (int*)(smem + MOE_MAP_OFF + 208);
    __syncthreads();
    if (tidx() == 0) *slot = atomicAdd(ctr, 1);
    __syncthreads();
    return __builtin_amdgcn_readfirstlane(*slot);
}
DEV void phase_mixers(const Params& p, int l, int rep, char* smem) {
    const bool need_ctx = (l == 0);
#ifndef RWMODE
#define RWMODE 2
#endif
    const int nrw = RWMODE == 0 ? 64 : (RWMODE == 1 ? 256 + 64 : 256), nda = need_ctx ? 576 : 512, ns5 = 32 * (need_ctx ? 9 : 8);
    const int total = nrw + 2 * nda + (rep == 0 ? ns5 : 0);
    int* ctr = (int*)(p.ws + OFF_CTR) + CTR_Q + l * 16 + rep * 4;
    for (;;) {
        const int item = queue_next(ctr, smem);
        if (item >= total) break;
#ifndef PROBE7
#define PROBE7 0
#endif
        if (rep > 0 && PROBE7 == 1 && item >= nrw) break;
        if (rep > 0 && PROBE7 == 2 && item < nrw) continue;
        if (rep > 0 && PROBE7 == 3 && (item < nrw || item >= nrw + nda)) continue;
#if RWMODE == 2
        if (item < nrw) rw_item(p, l, item, smem, 0);
#elif RWMODE == 0
        if (item < nrw) rwc_item(p, l, item, smem);
#else
        if (item < nrw) { if (item < 256) rw_item(p, l, item, smem, 0); else rwc_item(p, l, item - 256, smem); }
#endif
        else if (item < nrw + nda) da_item(p, l, item - nrw, smem);
        else if (item < nrw + 2 * nda) mla_item(p, l, item - nrw - nda, smem);
        else s5_pass2_item(p, l, need_ctx ? 0 : 1, item - nrw - 2 * nda, smem);
    }
}
#ifndef MEGA
#define MEGA 0
#endif
constexpr int NPHASE = 15;
template <int PH>
DEV void run_phase(const Params& p, int l, char* smem) {
    asm volatile("" : "+s"(l));
    const bool need_ctx = (l == 0);
    const int M = need_ctx ? TT : TL;
    if constexpr (PH == 0) { phase_mod_partial(p, smem); __syncthreads(); phase_conv_small(p, smem); phase_conv_layer(p, 0, smem); phase_conv_experts(p, 0, smem); }
    if constexpr (PH == 1) { phase_mod_reduce(p); }
    if constexpr (PH == 2) { phase_norm<1>(p, l, TT, smem, l == 1); if (l == 1) { phase_conv_layer(p, 1, smem); phase_conv_experts(p, 1, smem); } }
    if constexpr (PH == 3) { phase_inproj(p, l, smem); }
    if constexpr (PH == 4) { phase_prep1(p, l); phase_s5_pass1(p, l, smem); }
    if constexpr (PH == 5) { phase_prep_gemm1(p, l, smem); }
    if constexpr (PH == 6) { phase_prep_gemm2(p, l, smem); phase_prep2(p, l); }
    if constexpr (PH == 7) { phase_mixers(p, l, 0, smem); }
    if constexpr (PH == 8) { phase_s5_glu(p, l, M, smem); phase_rw_finish(p, l, M); }
    if constexpr (PH == 9) { phase_merge(p, l, M, smem); }
    if constexpr (PH == 10) { phase_outproj(p, l, M, smem); }
    if constexpr (PH == 11) { phase_norm<2>(p, l, M, smem); }
    if constexpr (PH == 14) { phase_route(p, l, M, smem); }
    if constexpr (PH == 15) { phase_combine(p, l, M); }
    if constexpr (PH == 12) { phase_moe1(p, l, smem); }
    if constexpr (PH == 13) { phase_moe2(p, l, smem); }
}

#if !MEGA
template <int PH>
__global__ void __launch_bounds__(NT, 2) k_phase(Params p, int l) {
    extern __shared__ __attribute__((aligned(16))) char smem[];
    run_phase<PH>(p, l, smem);
}
#endif
#ifndef REP0
#define REP0 1
#endif
#ifndef REP2
#define REP2 1
#endif
#ifndef REP3
#define REP3 1
#endif
#ifndef REP5
#define REP5 1
#endif
#ifndef REP6
#define REP6 1
#endif
#ifndef REP7
#define REP7 1
#endif
#ifndef REP8
#define REP8 1
#endif
#ifndef REP9
#define REP9 1
#endif
#ifndef REP12
#define REP12 1
#endif
#if MEGA
__global__ void __launch_bounds__(NT, 2) k_mega(Params p) {
    extern __shared__ __attribute__((aligned(16))) char smem[];
    uint4* xbw = (uint4*)(smem + MOE_MAP_OFF + 240);
    if (threadIdx.x == 0) *xbw = make_uint4(0u, 0u, 0u, 0u);
    __syncthreads();
    XcdBarrier bar = xcd_barrier_post((unsigned*)(p.ws + OFF_BAR), (volatile LAS unsigned*)xbw);
    for (int r = 0; r < REP0; ++r) { run_phase<0>(p, 0, smem); xcd_barrier(bar); }
    run_phase<1>(p, 0, smem); xcd_barrier(bar);
    for (int l = 0; l < 2; ++l) {
        for (int r = 0; r < REP2; ++r) { run_phase<2>(p, l, smem); xcd_barrier(bar); }
        for (int r = 0; r < REP3; ++r) { run_phase<3>(p, l, smem); xcd_barrier(bar); }

        run_phase<4>(p, l, smem); xcd_barrier(bar);
#ifdef PROBE_S5P1
        phase_s5_pass1(p, l, smem); xcd_barrier(bar);
#endif
#ifdef PROBE_BAR
        for (int r = 0; r < PROBE_BAR; ++r) xcd_barrier(bar);
#endif
        for (int r = 0; r < REP5; ++r) { run_phase<5>(p, l, smem); xcd_barrier(bar); }
        for (int r = 0; r < REP6; ++r) { run_phase<6>(p, l, smem); xcd_barrier(bar); }
#ifdef RWC_PRE
        if (bidx() < 64) rwc_item(p, l, bidx(), smem);
#endif
        for (int r = 0; r < REP7; ++r) { int l7 = l; asm volatile("" : "+s"(l7)); phase_mixers(p, l7, r, smem); xcd_barrier(bar); }
#ifdef RWC_SEP
        for (int item = bidx(); item < 64; item += gridDim.x) rwc_item(p, l, item, smem);
        xcd_barrier(bar);
#endif
        for (int r = 0; r < REP8; ++r) { run_phase<8>(p, l, smem); xcd_barrier(bar); }
        for (int r = 0; r < REP9; ++r) { run_phase<9>(p, l, smem); xcd_barrier(bar); }
        run_phase<10>(p, l, smem); xcd_barrier(bar);
#ifdef PROBE_OUT2
        if (l == 0) { run_phase<10>(p, l, smem); xcd_barrier(bar); }
#endif

        run_phase<11>(p, l, smem); xcd_barrier(bar);
        run_phase<14>(p, l, smem); xcd_barrier(bar);
        for (int r = 0; r < REP12; ++r) { run_phase<12>(p, l, smem); xcd_barrier(bar); }
        run_phase<13>(p, l, smem); xcd_barrier(bar);
#ifdef PROBE_MOE2B
        run_phase<13>(p, l, smem); xcd_barrier(bar);
#endif
        if (l == 1) run_phase<15>(p, l, smem);
    }
}
#endif
__global__ void __launch_bounds__(NT) k_fail(float* out, int n) {
    for (int i = blockIdx.x * NT + threadIdx.x; i < n; i += gridDim.x * NT) out[i] = __int_as_float(0x7fc00000);
}

template <int PH>
static void launch_phase(const Params& p, int l, int grid, hipStream_t stream) {
#if !MEGA
    static bool attr = false;
    if (!attr) { (void)hipFuncSetAttribute((const void*)k_phase<PH>, hipFuncAttributeMaxDynamicSharedMemorySize, SMEM_BYTES); attr = true; }
    hipLaunchKernelGGL(k_phase<PH>, dim3(grid), dim3(NT), SMEM_BYTES, stream, p, l);
#endif
}

extern "C" void kernel_launch(void* const* d_in, const int* in_sizes, int n_in, void* d_out, int out_size, void* d_ws, size_t ws_size, hipStream_t stream) {
    if (n_in != 48 || out_size != TL * DM || ws_size < WS_END) {
        hipLaunchKernelGGL(k_fail, dim3(256), dim3(NT), 0, stream, (float*)d_out, out_size);
        return;
    }
    Params p{};
    for (int i = 0; i < 48; ++i) p.in[i] = (const float*)d_in[i];
    p.out = (float*)d_out; p.ws = (char*)d_ws;
    (void)hipMemsetAsync(d_ws, 0, ZERO_BYTES, stream);
#if MEGA
    static int grid = 0;
    if (grid == 0) {
        int dev = 0, cus = 0, per_cu = 0;
        (void)hipGetDevice(&dev);
        (void)hipDeviceGetAttribute(&cus, hipDeviceAttributeMultiprocessorCount, dev);
        (void)hipFuncSetAttribute((const void*)k_mega, hipFuncAttributeMaxDynamicSharedMemorySize, SMEM_BYTES);
        if (hipOccupancyMaxActiveBlocksPerMultiprocessor(&per_cu, (const void*)k_mega, NT, SMEM_BYTES) != hipSuccess || per_cu < 1) per_cu = 1;
        (void)hipGetLastError();
        if (cus <= 0) cus = 256;
        grid = cus * (per_cu < 2 ? per_cu : 2);
    }
    hipLaunchKernelGGL(k_mega, dim3(grid), dim3(NT), SMEM_BYTES, stream, p);
#else
    const int grid = 512;
    launch_phase<0>(p, 0, grid, stream);
    launch_phase<1>(p, 0, grid, stream);
    for (int l = 0; l < 2; ++l) {
        launch_phase<2>(p, l, grid, stream);
        launch_phase<3>(p, l, grid, stream);
        launch_phase<4>(p, l, grid, stream);
        launch_phase<5>(p, l, grid, stream);
        launch_phase<6>(p, l, grid, stream);
        launch_phase<7>(p, l, grid, stream);
        launch_phase<8>(p, l, grid, stream);
        launch_phase<9>(p, l, grid, stream);
        launch_phase<10>(p, l, grid, stream);
        launch_phase<11>(p, l, grid, stream);
        launch_phase<14>(p, l, grid, stream);
        launch_phase<12>(p, l, grid, stream);
        launch_phase<13>(p, l, grid, stream);
        launch_phase<15>(p, l, grid, stream);
    }
#endif
}
```

```cpp
#define MEGA 1
#include <hip/hip_runtime.h>
#include <stdint.h>
#include <math.h>

#define DEV __device__ __forceinline__
#define LAS __attribute__((address_space(3)))
typedef unsigned short bf16_t;
typedef short bf16x8 __attribute__((ext_vector_type(8)));
typedef float f32x16 __attribute__((ext_vector_type(16)));
typedef float f32x4 __attribute__((ext_vector_type(4)));
typedef unsigned u32x4 __attribute__((ext_vector_type(4)));
typedef unsigned u32x2 __attribute__((ext_vector_type(2)));

constexpr int NT = 256;
constexpr int DM = 1024, NB = 8, SEQ = 2048, CTXL = 256, GRIDW = 64;
constexpr int TL = NB * SEQ, TC = NB * CTXL, TT = TL + TC;
constexpr int NIN = 6480, LDP = 2432, NINP = 6528, NGATE0 = 2432;
constexpr int C_DAQ = 0, C_DAK = 256, C_DAV = 512, C_S5 = 768, C_CQ = 1024, C_CKV = 1216, C_KR = 1344,
              C_RWR = 1360, C_RWK = 1616, C_RWV = 1872, C_RWD = 2128, C_PEND = 2384;
constexpr int NEXP = 16, DFF = 512;
constexpr float EPS = 1e-6f;
constexpr float LOG2E = 1.4426950408889634f;

constexpr size_t al256(size_t x) { return (x + 255) & ~(size_t)255; }
constexpr size_t OFF_BAR  = 0;
constexpr size_t OFF_CTR  = 16384;
constexpr size_t ZERO_BYTES = 20480;
constexpr size_t OFF_MOD  = 32768;
constexpr size_t SZ_MOD   = (size_t)2 * 9 * 6144 * 4;
constexpr int    MOD_KS   = 8;
constexpr size_t OFF_MODP = al256(OFF_MOD + SZ_MOD);
constexpr size_t OFF_S5ST = al256(OFF_MODP + MOD_KS * SZ_MOD);
constexpr size_t OFF_LTOK = al256(OFF_S5ST + (size_t)2 * 8 * 16 * 8 * 64 * 2 * 4);
constexpr size_t OFF_LW   = al256(OFF_LTOK + (size_t)NEXP * TT * 4);
constexpr size_t OFF_TOKI = al256(OFF_LW + (size_t)NEXP * TT * 4);
constexpr size_t OFF_TOKW = al256(OFF_TOKI + (size_t)TT * 16);
constexpr size_t OFF_CNTB = al256(OFF_TOKW + (size_t)TT * 8);
constexpr size_t OFF_WSM  = al256(OFF_CNTB + (size_t)1024 * 16 * 4);
constexpr int WS_GLUT = 0, WS_UQT = WS_GLUT + 256 * 256, WS_UKVT = WS_UQT + 192 * 192, WS_W1C = WS_UKVT + 384 * 128,
              WS_W2 = WS_W1C + 192 * 256, WS_G2T = WS_W2 + 4 * 256 * 64, WS_PER_LAYER = WS_G2T + 256 * 64;
constexpr size_t OFF_WIN  = al256(OFF_WSM + (size_t)2 * WS_PER_LAYER * 2);
constexpr size_t OFF_WBR  = al256(OFF_WIN + (size_t)NINP * 1024 * 2);
constexpr size_t OFF_WOUT = al256(OFF_WBR + (size_t)4 * 1024 * 256 * 2);
constexpr size_t OFF_WG1  = al256(OFF_WOUT + (size_t)1024 * 1024 * 2);
constexpr size_t OFF_WDN  = al256(OFF_WG1 + (size_t)NEXP * 1024 * 1024 * 2);
constexpr size_t OFF_H    = al256(OFF_WDN + (size_t)NEXP * 1024 * 512 * 2);
constexpr size_t OFF_P    = al256(OFF_H + (size_t)TT * 1024 * 2);
constexpr size_t OFF_GATE = al256(OFF_P + (size_t)TT * LDP * 2);
constexpr size_t OFF_MLAQ = al256(OFF_GATE + (size_t)TT * 4096);
constexpr size_t OFF_MLAK = al256(OFF_MLAQ + (size_t)TT * 192 * 2);
constexpr size_t OFF_MLAV = al256(OFF_MLAK + (size_t)TT * 192 * 2);
constexpr size_t OFF_RWX  = al256(OFF_MLAV + (size_t)TT * 256 * 2);
constexpr size_t OFF_Y    = al256(OFF_RWX + (size_t)TT * 1024 * 2);
constexpr size_t OFF_CX   = al256(OFF_Y + (size_t)TT * 1024 * 2);
constexpr size_t OFF_S5Y  = al256(OFF_CX + (size_t)TC * 1024 * 4);
constexpr size_t WS_END   = al256(OFF_S5Y + (size_t)TT * 256 * 2);
constexpr size_t OFF_QRAW = OFF_Y;
constexpr size_t OFF_KVRAW = OFF_QRAW + (size_t)TT * 192 * 2;
constexpr size_t OFF_LR   = OFF_KVRAW + (size_t)TT * 384 * 2;
constexpr size_t OFF_XL   = OFF_LR + (size_t)TT * 192 * 2;
constexpr size_t OFF_Z    = OFF_GATE;
static_assert(OFF_XL + (size_t)TT * 256 * 2 <= OFF_Y + (size_t)TT * 1024 * 2, "temps overflow Y");
constexpr size_t OFF_RWY  = OFF_H;

constexpr int CTR_MOE = 0;
constexpr int CTR_Q   = 64;

constexpr int SMEM_BYTES = 73728 + 256;

struct Params {
    const float* in[48];
    float* out;
    char* ws;
};
enum { I_X = 0, I_C, I_CTX, I_CCTX, I_WADA, I_BADA, I_NMG, I_NFG, I_WIN, I_DAQKG, I_DALAM, I_DASUB,
       I_S5LRE, I_S5LIM, I_S5LDT, I_S5BRE, I_S5BIM, I_S5CRE, I_S5CIM, I_S5D, I_S5WGLU, I_S5BGLU,
       I_MCQG, I_MCKVG, I_MWUQ, I_MWUKV, I_MQKG,
       I_RMU, I_RW0, I_RW1, I_RW2, I_RA0, I_RA1, I_RA2, I_RG1, I_RG2, I_RKK, I_RKA, I_RRK, I_RLNG, I_RLNB,
       I_WBR, I_WOUT, I_ROUTW, I_ROUTB, I_EWG, I_EWU, I_EWD };

DEV int tidx() { int t = threadIdx.x; asm volatile("" : "+v"(t)); return t; }
DEV int bidx() { int b = blockIdx.x; asm volatile("" : "+s"(b)); return b; }
typedef float f32x2_ __attribute__((ext_vector_type(2)));
typedef __bf16 bf16x2_ __attribute__((ext_vector_type(2)));
DEV unsigned cvt_pk_bf16(float lo, float hi) { const f32x2_ v = {lo, hi}; const bf16x2_ b = __builtin_convertvector(v, bf16x2_); return __builtin_bit_cast(unsigned, b); }
DEV bf16_t f2bf(float f) { return (bf16_t)(cvt_pk_bf16(f, 0.f) & 0xFFFFu); }
DEV float bf2f(bf16_t h) { return __uint_as_float(((unsigned)h) << 16); }
DEV unsigned pack2(float lo, float hi) { return cvt_pk_bf16(lo, hi); }
DEV float bflo(unsigned u) { return __uint_as_float(u << 16); }
DEV float bfhi(unsigned u) { return __uint_as_float(u & 0xFFFF0000u); }
DEV float sigmoidf_(float x) { return 1.f / (1.f + __expf(-x)); }
DEV float wave_sum(float v) {
#pragma unroll
    for (int o = 32; o >= 1; o >>= 1) v += __shfl_xor(v, o, 64);
    return v;
}
template <int W> DEV float group_sum(float v) {
#pragma unroll
    for (int o = W / 2; o >= 1; o >>= 1) v += __shfl_xor(v, o, 64);
    return v;
}
DEV int mod_row(int t) { return t < TL ? (t >> 11) : 8; }
typedef const float* cfp_t;
DEV cfp_t inp(const Params&, int i) {
    const __attribute__((address_space(4))) cfp_t* ka = (const __attribute__((address_space(4))) cfp_t*)__builtin_amdgcn_kernarg_segment_ptr();
    asm volatile("" : "+s"(ka));
    return ka[i];
}
DEV char* wsp(const Params&) {
    char* const __attribute__((address_space(4)))* ka = (char* const __attribute__((address_space(4)))*)__builtin_amdgcn_kernarg_segment_ptr();
    asm volatile("" : "+s"(ka));
    return ka[49];
}
DEV bf16_t* wsb(const Params& p, size_t off) { return (bf16_t*)(wsp(p) + off); }
DEV float* wsf(const Params& p, size_t off) { return (float*)(wsp(p) + off); }
DEV const float* modp(const Params& p, int l, int row, int which) { return (const float*)(wsp(p) + OFF_MOD) + ((size_t)(l * 9 + row) * 6 + which) * 1024; }
#define XB_TMO      128
#define XB_XCNT(j)  (256  + 64 * (j))
#define XB_XSUB(j)  (1280 + 64 * (j))
#define XB_XGEN(j)  (2304 + 64 * (j))
#define XB_TOP      3328
#define XB_TOPGEN   3392
#define XCD_BAR_WORDS 3456
#define XB_SPIN_CAP (1u << 18)

__device__ __forceinline__ unsigned xb_ld(unsigned* p)              { return __hip_atomic_load(p, __ATOMIC_RELAXED, __HIP_MEMORY_SCOPE_AGENT); }
__device__ __forceinline__ unsigned xb_add(unsigned* p, unsigned v) { return __hip_atomic_fetch_add(p, v, __ATOMIC_RELAXED, __HIP_MEMORY_SCOPE_AGENT); }
__device__ __forceinline__ unsigned xb_xcc_id() { return (unsigned)__builtin_amdgcn_s_getreg((3 << 11) | 20) & 0xFu; }
#define XB_SPIN(cond, bar) do { unsigned _sp = 0; while (cond) { __builtin_amdgcn_s_sleep(1); \
    if ((++_sp & 255u) == 0u) { if (xb_ld(&(bar)[XB_TMO])) break; if (_sp > XB_SPIN_CAP) { atomicAdd(&(bar)[XB_TMO], 1u); break; } } } } while (0)

struct XcdBarrier {
    unsigned* bar; unsigned x;
    volatile LAS unsigned* st;
};

__device__ __forceinline__ XcdBarrier xcd_barrier_post(unsigned* bar, volatile LAS unsigned* st) {
    XcdBarrier b; b.bar = bar; b.x = xb_xcc_id(); b.st = st;
    if (threadIdx.x == 0) (void)xb_add(&bar[XB_XCNT(b.x)], 1u);
    return b;
}
__device__ __forceinline__ void xcd_barrier_complete(unsigned* bar, unsigned x, unsigned& nloc, unsigned& nx) {
    const unsigned G = gridDim.x * gridDim.y * gridDim.z;
    unsigned sum, cnt, mine, sp = 0u;
    for (;;) {
        sum = 0u; cnt = 0u; mine = 0u;
#pragma unroll
        for (unsigned j = 0; j < 16; ++j) { const unsigned c = xb_ld(&bar[XB_XCNT(j)]); sum += c; cnt += (c > 0u) ? 1u : 0u; mine = (j == x) ? c : mine; }
        if (sum == G) break;
        __builtin_amdgcn_s_sleep(1);
        if ((++sp & 255u) == 0u) { if (xb_ld(&bar[XB_TMO])) break; if (sp > XB_SPIN_CAP) { atomicAdd(&bar[XB_TMO], 1u); break; } }
    }
    nloc = mine > 0u ? mine : 1u; nx = cnt > 0u ? cnt : 1u;
}

__device__ __forceinline__ void xcd_barrier(const XcdBarrier& b) {
    asm volatile("s_waitcnt vmcnt(0)" ::: "memory");
    __syncthreads();
    if (threadIdx.x == 0) {
        unsigned* bar = b.bar;
        __builtin_amdgcn_s_waitcnt(0);
        unsigned nloc = b.st[0], nx = b.st[1];
        if (nloc == 0u) { xcd_barrier_complete(bar, b.x, nloc, nx); b.st[0] = nloc; b.st[1] = nx; }
        const unsigned old = xb_add(&bar[XB_XSUB(b.x)], 1u);
        const unsigned gen = old / nloc;
        if (old + 1u == (gen + 1u) * nloc) {
            __builtin_amdgcn_fence(__ATOMIC_RELEASE, "agent");
            asm volatile("s_waitcnt vmcnt(0)" ::: "memory");
            const unsigned og = xb_add(&bar[XB_TOP], 1u);
            const unsigned tg = og / nx;
            if (og + 1u == (tg + 1u) * nx) xb_add(&bar[XB_TOPGEN], 1u);
            else XB_SPIN(xb_ld(&bar[XB_TOPGEN]) == tg, bar);
            __builtin_amdgcn_fence(__ATOMIC_ACQUIRE, "agent");
            xb_add(&bar[XB_XGEN(b.x)], 1u);
            asm volatile("s_waitcnt vmcnt(0)" ::: "memory");
        } else {
            XB_SPIN(xb_ld(&bar[XB_XGEN(b.x)]) == gen, bar);
            __builtin_amdgcn_fence(__ATOMIC_ACQUIRE, "agent");
            asm volatile("s_waitcnt vmcnt(0)" ::: "memory");
        }
    }
    __syncthreads();
}

DEV void phase_mod_partial(const Params& p, char* smem) {
    float* sm = (float*)smem;
    const int tid = tidx();
    const int nitems = 2 * 24 * MOD_KS;
    for (int item = bidx(); item < nitems; item += gridDim.x) {
        const int l = item / (24 * MOD_KS), rem = item % (24 * MOD_KS), jc = rem / MOD_KS, ks = rem % MOD_KS;
        __syncthreads();
        for (int i = tid; i < 9 * 128; i += NT) {
            const int r = i >> 7, k = ks * 128 + (i & 127);
            const float cv = r < 8 ? inp(p, I_C)[r * 1024 + k] : inp(p, I_CCTX)[k];
            sm[i] = cv / (1.f + __expf(-cv));
        }
        __syncthreads();
        const int j = jc * 256 + tid;
        float acc[9];
#pragma unroll
        for (int r = 0; r < 9; ++r) acc[r] = 0.f;
        const float* w = inp(p, I_WADA) + (size_t)l * 1024 * 6144 + (size_t)(ks * 128) * 6144 + j;
#pragma unroll 8
        for (int k = 0; k < 128; ++k) {
            const float wv = w[(size_t)k * 6144];
#pragma unroll
            for (int r = 0; r < 9; ++r) acc[r] += sm[r * 128 + k] * wv;
        }
        float* dst = wsf(p, OFF_MODP);
#pragma unroll
        for (int r = 0; r < 9; ++r) dst[((size_t)(ks * 2 + l) * 9 + r) * 6144 + j] = acc[r];
    }
}
DEV void phase_mod_reduce(const Params& p) {
    const int n = 2 * 9 * 6144;
    float* mod = wsf(p, OFF_MOD);
    const float* part = wsf(p, OFF_MODP);
    for (int i = bidx() * NT + tidx(); i < n; i += gridDim.x * NT) {
        const int l = i / (9 * 6144), j = i % 6144;
        float s = inp(p, I_BADA)[l * 6144 + j];
#pragma unroll
        for (int ks = 0; ks < MOD_KS; ++ks) s += part[(size_t)ks * n + i];
        mod[i] = s;
    }
}

struct ConvRegs { float4 v[4]; };
DEV void conv_load(const float* src, int R, int C, int ld, int tr, int tc, ConvRegs& cr) {
    const int r0 = tr * 64, c0 = tc * 64, tid = tidx();
#pragma unroll
    for (int k = 0; k < 4; ++k) {
        const int i = tid + k * NT, r = i >> 4, c4 = (i & 15) * 4;
        float4 v = make_float4(0.f, 0.f, 0.f, 0.f);
        if (r0 + r < R) {
            const float* s = src + (size_t)(r0 + r) * ld + c0 + c4;
            if (c0 + c4 + 3 < C) v = *(const float4*)s;
            else { if (c0 + c4 < C) v.x = s[0]; if (c0 + c4 + 1 < C) v.y = s[1]; if (c0 + c4 + 2 < C) v.z = s[2]; }
        }
        cr.v[k] = v;
    }
}
template <int MODE>
DEV void conv_store(const ConvRegs& cr, int R, int C, bf16_t* dst, int ldd, int roff, int tr, int tc, float* sm) {
    const int r0 = tr * 64, c0 = tc * 64, tid = tidx();
    __syncthreads();
#pragma unroll
    for (int k = 0; k < 4; ++k) {
        const int i = tid + k * NT, r = i >> 4, c4 = (i & 15) * 4;
        float* d = sm + r * 65 + c4;
        d[0] = cr.v[k].x; d[1] = cr.v[k].y; d[2] = cr.v[k].z; d[3] = cr.v[k].w;
    }
    __syncthreads();
    for (int i = tid; i < 64 * 8; i += NT) {
        const int c = i >> 3, r8 = (i & 7) * 8;
        if (c0 + c < C && r0 + r8 < R) {
            const int cc = c0 + c;
            const int drow = (MODE == 0) ? (cc + roff) : ((cc >> 5) * 64 + (cc & 31) + roff);
            u32x4 o;
            o[0] = pack2(sm[(r8 + 0) * 65 + c], sm[(r8 + 1) * 65 + c]);
            o[1] = pack2(sm[(r8 + 2) * 65 + c], sm[(r8 + 3) * 65 + c]);
            o[2] = pack2(sm[(r8 + 4) * 65 + c], sm[(r8 + 5) * 65 + c]);
            o[3] = pack2(sm[(r8 + 6) * 65 + c], sm[(r8 + 7) * 65 + c]);
            *(u32x4*)(dst + (size_t)drow * ldd + r0 + r8) = o;
        }
    }
}
template <int MODE>
DEV void conv_job(const float* src, int R, int C, int ld, bf16_t* dst, int ldd, int roff, int& rot, float* sm) {
    const int ntr = (R + 63) >> 6, ntc = (C + 63) >> 6, nt = ntr * ntc, G = gridDim.x;
    const int first = (bidx() - (rot % G) + G) % G;
    ConvRegs cur;
    if (first < nt) conv_load(src, R, C, ld, first / ntc, first % ntc, cur);
    for (int t = first; t < nt; t += G) {
        ConvRegs nxt = cur;
        if (t + G < nt) conv_load(src, R, C, ld, (t + G) / ntc, (t + G) % ntc, nxt);
        conv_store<MODE>(cur, R, C, dst, ldd, roff, t / ntc, t % ntc, sm);
        cur = nxt;
    }
    rot += nt;
}
DEV void phase_conv_layer(const Params& p, int l, char* smem) {
    float* sm = (float*)smem;
    int rot = 0;
    const float* win = inp(p, I_WIN) + (size_t)l * 1024 * NIN;
    conv_job<0>(win, 1024, C_PEND, NIN, wsb(p, OFF_WIN), 1024, 0, rot, sm);
    conv_job<0>(win + C_PEND, 1024, 4096, NIN, wsb(p, OFF_WIN), 1024, NGATE0, rot, sm);
    {
        uint4* z = (uint4*)(wsb(p, OFF_WIN) + (size_t)C_PEND * 1024);
        const int n = (NGATE0 - C_PEND) * 1024 / 8;
        for (int i = bidx() * NT + tidx(); i < n; i += gridDim.x * NT) z[i] = make_uint4(0u, 0u, 0u, 0u);
    }
    for (int i = 0; i < 4; ++i)
        conv_job<0>(inp(p, I_WBR) + (size_t)(l * 4 + i) * 256 * 1024, 256, 1024, 1024, wsb(p, OFF_WBR) + (size_t)i * 1024 * 256, 256, 0, rot, sm);
    conv_job<0>(inp(p, I_WOUT) + (size_t)l * 1024 * 1024, 1024, 1024, 1024, wsb(p, OFF_WOUT), 1024, 0, rot, sm);
}
DEV void phase_conv_experts(const Params& p, int l, char* smem) {
    float* sm = (float*)smem;
    int rot = 0;
    for (int e = 0; e < NEXP; ++e) {
        conv_job<1>(inp(p, I_EWG) + (size_t)(l * NEXP + e) * 1024 * DFF, 1024, DFF, DFF, wsb(p, OFF_WG1) + (size_t)e * 1024 * 1024, 1024, 0, rot, sm);
        conv_job<1>(inp(p, I_EWU) + (size_t)(l * NEXP + e) * 1024 * DFF, 1024, DFF, DFF, wsb(p, OFF_WG1) + (size_t)e * 1024 * 1024, 1024, 32, rot, sm);
        conv_job<0>(inp(p, I_EWD) + (size_t)(l * NEXP + e) * DFF * 1024, DFF, 1024, 1024, wsb(p, OFF_WDN) + (size_t)e * 1024 * DFF, DFF, 0, rot, sm);
    }
}
DEV void phase_conv_small(const Params& p, char* smem) {
    float* sm = (float*)smem;
    int rot = 0;
    for (int l = 0; l < 2; ++l) {
        bf16_t* w = wsb(p, OFF_WSM) + (size_t)l * WS_PER_LAYER;
        for (int i = bidx() * NT + tidx(); i < 4 * 256 * 4; i += gridDim.x * NT)
            *(u32x4*)(w + WS_W2 + (size_t)(i >> 2) * 64 + 32 + (i & 3) * 8) = (u32x4){0u, 0u, 0u, 0u};
        conv_job<0>(inp(p, I_S5WGLU) + (size_t)l * 256 * 256, 256, 256, 256, w + WS_GLUT, 256, 0, rot, sm);
        conv_job<0>(inp(p, I_MWUQ) + (size_t)l * 192 * 192, 192, 192, 192, w + WS_UQT, 192, 0, rot, sm);
        conv_job<0>(inp(p, I_MWUKV) + (size_t)l * 128 * 384, 128, 384, 384, w + WS_UKVT, 128, 0, rot, sm);
        for (int d = 0; d < 2; ++d) {
            conv_job<0>(inp(p, I_RW1) + (size_t)(l * 2 + d) * 256 * 32, 256, 32, 32, w + WS_W1C, 256, d * 32, rot, sm);
            conv_job<0>(inp(p, I_RA1) + (size_t)(l * 2 + d) * 256 * 32, 256, 32, 32, w + WS_W1C, 256, 64 + d * 32, rot, sm);
            conv_job<0>(inp(p, I_RW2) + (size_t)(l * 2 + d) * 32 * 256, 32, 256, 256, w + WS_W2 + (size_t)d * 256 * 64, 64, 0, rot, sm);
            conv_job<0>(inp(p, I_RA2) + (size_t)(l * 2 + d) * 32 * 256, 32, 256, 256, w + WS_W2 + (size_t)(2 + d) * 256 * 64, 64, 0, rot, sm);
        }
        conv_job<0>(inp(p, I_RG1) + (size_t)l * 256 * 64, 256, 64, 64, w + WS_W1C, 256, 128, rot, sm);
        conv_job<0>(inp(p, I_RG2) + (size_t)l * 64 * 256, 64, 256, 256, w + WS_G2T, 64, 0, rot, sm);
    }
}

template <int WHICH>
DEV void phase_norm(const Params& p, int l, int nrows, char* smem, bool fuse_combine = false) {
    const int lane = tidx() & 63, wave = tidx() >> 6;
    const float* xs = (l == 0) ? inp(p, I_X) : p.out;
    const float* cs = (l == 0) ? inp(p, I_CTX) : wsf(p, OFF_CX);
    const float* g = inp(p, WHICH == 1 ? I_NMG : I_NFG) + l * 1024;
    bf16_t* H = wsb(p, OFF_H);
    if (WHICH == 2) { xs = p.out; cs = wsf(p, OFF_CX); }
    const int tpb = (nrows + (int)gridDim.x - 1) / (int)gridDim.x;
    const int rbeg = WHICH == 2 ? bidx() * tpb + wave : bidx() * 4 + wave;
    const int rend = WHICH == 2 ? min(nrows, (bidx() + 1) * tpb) : nrows;
    const int rstep = WHICH == 2 ? 4 : (int)gridDim.x * 4;
    int* sel = (int*)smem;
    for (int row = rbeg; row < rend; row += rstep) {
        const float* src = row < TL ? xs + (size_t)row * 1024 : cs + (size_t)(row - TL) * 1024;
        const int mr = mod_row(row);
        const float* sh = modp(p, l, mr, WHICH == 1 ? 0 : 3);
        const float* sc = modp(p, l, mr, WHICH == 1 ? 1 : 4);
        float4 v[4];
        float ss = 0.f;
#pragma unroll
        for (int i = 0; i < 4; ++i) v[i] = *(const float4*)(src + lane * 4 + i * 256);
        if (WHICH == 1 && fuse_combine) {
            const bf16_t* Z = wsb(p, OFF_Z);
            const int* toki = (const int*)(wsp(p) + OFF_TOKI);
            const float* tokw = (const float*)(wsp(p) + OFF_TOKW);
            const float* g2 = modp(p, l - 1, mr, 5);
            const int r0 = toki[(size_t)row * 4 + 2], r1 = toki[(size_t)row * 4 + 3];
            const float w0 = tokw[(size_t)row * 2], w1 = tokw[(size_t)row * 2 + 1];
            float* dst = row < TL ? p.out + (size_t)row * 1024 : wsf(p, OFF_CX) + (size_t)(row - TL) * 1024;
#pragma unroll
            for (int i = 0; i < 4; ++i) {
                const int c = lane * 4 + i * 256;
                const u32x2 a = *(const u32x2*)(Z + (size_t)r0 * 1024 + c), b = *(const u32x2*)(Z + (size_t)r1 * 1024 + c);
                const float4 gg = *(const float4*)(g2 + c);
                v[i].x += gg.x * (w0 * bflo(a.x) + w1 * bflo(b.x));
                v[i].y += gg.y * (w0 * bfhi(a.x) + w1 * bfhi(b.x));
                v[i].z += gg.z * (w0 * bflo(a.y) + w1 * bflo(b.y));
                v[i].w += gg.w * (w0 * bfhi(a.y) + w1 * bfhi(b.y));
                *(float4*)(dst + c) = v[i];
            }
        }
#pragma unroll
        for (int i = 0; i < 4; ++i) ss += v[i].x * v[i].x + v[i].y * v[i].y + v[i].z * v[i].z + v[i].w * v[i].w;
        ss = wave_sum(ss);
        const float rstd = rsqrtf(ss * (1.f / 1024.f) + EPS);
        float hv[16];
#pragma unroll
        for (int i = 0; i < 4; ++i) {
            const int c = lane * 4 + i * 256;
            const float4 gg = *(const float4*)(g + c), s4 = *(const float4*)(sh + c), c4 = *(const float4*)(sc + c);
            hv[i * 4 + 0] = v[i].x * rstd * gg.x * (1.f + c4.x) + s4.x;
            hv[i * 4 + 1] = v[i].y * rstd * gg.y * (1.f + c4.y) + s4.y;
            hv[i * 4 + 2] = v[i].z * rstd * gg.z * (1.f + c4.z) + s4.z;
            hv[i * 4 + 3] = v[i].w * rstd * gg.w * (1.f + c4.w) + s4.w;
            u32x2 o; o.x = pack2(hv[i * 4 + 0], hv[i * 4 + 1]); o.y = pack2(hv[i * 4 + 2], hv[i * 4 + 3]);
            *(u32x2*)(H + (size_t)row * 1024 + c) = o;
        }
        if (WHICH == 2) {
            float lg[16];
#pragma unroll
            for (int e = 0; e < 16; ++e) lg[e] = 0.f;
            const float* rw = inp(p, I_ROUTW);
#pragma unroll
            for (int i = 0; i < 4; ++i)
#pragma unroll
                for (int j = 0; j < 4; ++j) {
                    const int c = lane * 4 + i * 256 + j;
                    const float hvv = hv[i * 4 + j];
#pragma unroll
                    for (int q = 0; q < 4; ++q) {
                        const float4 w4 = *(const float4*)(rw + (size_t)c * 16 + q * 4);
                        lg[q * 4 + 0] += hvv * w4.x; lg[q * 4 + 1] += hvv * w4.y; lg[q * 4 + 2] += hvv * w4.z; lg[q * 4 + 3] += hvv * w4.w;
                    }
                }
#pragma unroll
            for (int e = 0; e < 16; ++e) lg[e] = wave_sum(lg[e]);
            float sc16[16], bs[16];
#pragma unroll
            for (int e = 0; e < 16; ++e) { sc16[e] = sigmoidf_(lg[e]); bs[e] = sc16[e] + inp(p, I_ROUTB)[e]; }
            int bestg = 0; float bestv = -INFINITY;
#pragma unroll
            for (int gi = 0; gi < 4; ++gi) {
                float m1 = -INFINITY, m2 = -INFINITY;
#pragma unroll
                for (int k = 0; k < 4; ++k) { const float x = bs[gi * 4 + k]; if (x > m1) { m2 = m1; m1 = x; } else if (x > m2) m2 = x; }
                const float gs = m1 + m2;
                if (gs > bestv) { bestv = gs; bestg = gi; }
            }
            int i0 = 0, i1 = 0; float v0 = -INFINITY, v1 = -INFINITY, s0 = 0.f, s1 = 0.f;
#pragma unroll
            for (int e = 0; e < 16; ++e) { const bool in = (e >> 2) == bestg; if (in && bs[e] > v0) { v0 = bs[e]; i0 = e; s0 = sc16[e]; } }
#pragma unroll
            for (int e = 0; e < 16; ++e) { const bool in = (e >> 2) == bestg && e != i0; if (in && bs[e] > v1) { v1 = bs[e]; i1 = e; s1 = sc16[e]; } }
            const float inv = 1.f / (s0 + s1);
            if (lane == 0) {
                const int lt = row - bidx() * tpb;
                sel[lt * 2 + 0] = i0; sel[lt * 2 + 1] = i1;
                float* tw = (float*)(wsp(p) + OFF_TOKW) + (size_t)row * 2;
                tw[0] = s0 * inv; tw[1] = s1 * inv;
            }
        }
    }
    if (WHICH == 2) {
        __syncthreads();
        const int t0 = bidx() * tpb, nt = max(0, min(nrows, t0 + tpb) - t0);
        int* rank = sel + 2 * tpb;
        if (tidx() < 16) {
            const int e = tidx(); int c = 0;
            for (int i = 0; i < 2 * nt; ++i) if (sel[i] == e) { rank[i] = c; ++c; }
            ((int*)(wsp(p) + OFF_CNTB))[(size_t)bidx() * 16 + e] = c;
        }
        __syncthreads();
        int* toki = (int*)(wsp(p) + OFF_TOKI);
        for (int i = tidx(); i < nt; i += NT) {
            int4 r; r.x = sel[2 * i]; r.y = sel[2 * i + 1]; r.z = rank[2 * i]; r.w = rank[2 * i + 1];
            *(int4*)(toki + (size_t)(t0 + i) * 4) = r;
        }
        __syncthreads();
    }
}
DEV void phase_route(const Params& p, int l, int nrows, char* smem) {
    int* sm = (int*)smem;
    const int tid = tidx(), e = tid & 15, part = tid >> 4, G = gridDim.x, b = bidx();
    const int* cntb = (const int*)(wsp(p) + OFF_CNTB);
    int pre = 0, tot = 0;
    for (int bb = part; bb < G; bb += 16) { const int c = cntb[(size_t)bb * 16 + e]; tot += c; if (bb < b) pre += c; }
    __syncthreads();
    sm[part * 16 + e] = pre; sm[256 + part * 16 + e] = tot;
    __syncthreads();
    if (tid < 16) {
        int a = 0, t = 0;
        for (int q = 0; q < 16; ++q) { a += sm[q * 16 + tid]; t += sm[256 + q * 16 + tid]; }
        sm[512 + tid] = a; sm[528 + tid] = t;
    }
    __syncthreads();
    if (tid == 0) {
        int a = 0;
        for (int q = 0; q < 16; ++q) { sm[544 + q] = a; a += sm[528 + q]; }
    }
    __syncthreads();
    if (b == 0 && tid < 16) ((int*)(wsp(p) + OFF_CTR))[CTR_MOE + l * 16 + tid] = sm[528 + tid];
    const int tpb = (nrows + G - 1) / G, t0 = b * tpb, nt = max(0, min(nrows, t0 + tpb) - t0);
    int* toki = (int*)(wsp(p) + OFF_TOKI);
    const float* tokw = (const float*)(wsp(p) + OFF_TOKW);
    int* ltok = (int*)(wsp(p) + OFF_LTOK);
    float* lw = (float*)(wsp(p) + OFF_LW);
    for (int i = tid; i < 2 * nt; i += NT) {
        const int t = t0 + (i >> 1), j = i & 1;
        const int ee = toki[(size_t)t * 4 + j], rk = toki[(size_t)t * 4 + 2 + j];
        const int pos = sm[512 + ee] + rk;
        ltok[(size_t)ee * TT + pos] = t;
        lw[(size_t)ee * TT + pos] = tokw[(size_t)t * 2 + j];
        toki[(size_t)t * 4 + 2 + j] = sm[544 + ee] + pos;
    }
}
DEV void phase_combine(const Params& p, int l, int nrows) {
    const int lane = tidx() & 63, wave = tidx() >> 6;
    const bf16_t* Z = wsb(p, OFF_Z);
    const int* toki = (const int*)(wsp(p) + OFF_TOKI);
    const float* tokw = (const float*)(wsp(p) + OFF_TOKW);
    for (int row = bidx() * 4 + wave; row < nrows; row += gridDim.x * 4) {
        float* dst = row < TL ? p.out + (size_t)row * 1024 : wsf(p, OFF_CX) + (size_t)(row - TL) * 1024;
        const float* g2 = modp(p, l, mod_row(row), 5);
        const int r0 = toki[(size_t)row * 4 + 2], r1 = toki[(size_t)row * 4 + 3];
        const float w0 = tokw[(size_t)row * 2], w1 = tokw[(size_t)row * 2 + 1];
#pragma unroll
        for (int i = 0; i < 4; ++i) {
            const int c = lane * 4 + i * 256;
            const u32x2 a = *(const u32x2*)(Z + (size_t)r0 * 1024 + c), b = *(const u32x2*)(Z + (size_t)r1 * 1024 + c);
            const float4 gg = *(const float4*)(g2 + c);
            float4 x = *(float4*)(dst + c);
            x.x += gg.x * (w0 * bflo(a.x) + w1 * bflo(b.x));
            x.y += gg.y * (w0 * bfhi(a.x) + w1 * bfhi(b.x));
            x.z += gg.z * (w0 * bflo(a.y) + w1 * bflo(b.y));
            x.w += gg.w * (w0 * bfhi(a.y) + w1 * bfhi(b.y));
            *(float4*)(dst + c) = x;
        }
    }
}
constexpr int GLD = 72;
constexpr int GSTAGE = 128 * GLD;
template <bool DEEP = true, int TN = 2, class AF, class BF>
DEV void gemm_mainloop(f32x16 (&acc)[2][TN], AF arow, BF brow, int K, bf16_t* sm) {
    const int tid = tidx(), lane = tid & 63, wave = tid >> 6, wm = wave >> 1, wn = wave & 1;
    bf16_t* As = sm;
    bf16_t* Bs = sm + 2 * GSTAGE;
    constexpr int NB = 2 * TN;
    const bf16_t* ap[4]; const bf16_t* bp[NB];
#pragma unroll
    for (int i = 0; i < 4; ++i) { const int q = tid + i * NT; ap[i] = arow(q >> 3) + (q & 7) * 8; }
#pragma unroll
    for (int i = 0; i < NB; ++i) { const int q = tid + i * NT; bp[i] = brow(q >> 3) + (q & 7) * 8; }
    const int soff = (tid >> 3) * GLD + (tid & 7) * 8;
    u32x4 ra0[4], rb0[NB], ra1[4], rb1[NB];
    const int nk = K >> 6;
#pragma unroll
    for (int i = 0; i < 4; ++i) ra0[i] = *(const u32x4*)ap[i];
#pragma unroll
    for (int i = 0; i < NB; ++i) rb0[i] = *(const u32x4*)bp[i];
    if (DEEP && nk > 1) {
#pragma unroll
        for (int i = 0; i < 4; ++i) ra1[i] = *(const u32x4*)(ap[i] + 64);
#pragma unroll
        for (int i = 0; i < NB; ++i) rb1[i] = *(const u32x4*)(bp[i] + 64);
    }
    __syncthreads();
#pragma unroll
    for (int i = 0; i < 4; ++i) *(u32x4*)(As + soff + i * 32 * GLD) = ra0[i];
#pragma unroll
    for (int i = 0; i < NB; ++i) *(u32x4*)(Bs + soff + i * 32 * GLD) = rb0[i];
    __syncthreads();
    const int arow0 = (wm * 64 + (lane & 31)) * GLD + (lane >> 5) * 8;
    const int brow0 = (wn * 32 * TN + (lane & 31)) * GLD + (lane >> 5) * 8;
    auto compute = [&](int cur) {
        const bf16_t* a_s = As + cur * GSTAGE + arow0;
        const bf16_t* b_s = Bs + cur * GSTAGE + brow0;
#pragma unroll
        for (int ks = 0; ks < 4; ++ks) {
            const bf16x8 a0 = *(const bf16x8*)(a_s + ks * 16);
            const bf16x8 a1 = *(const bf16x8*)(a_s + 32 * GLD + ks * 16);
#pragma unroll
            for (int j = 0; j < TN; ++j) {
                const bf16x8 bj = *(const bf16x8*)(b_s + j * 32 * GLD + ks * 16);
                acc[0][j] = __builtin_amdgcn_mfma_f32_32x32x16_bf16(a0, bj, acc[0][j], 0, 0, 0);
                acc[1][j] = __builtin_amdgcn_mfma_f32_32x32x16_bf16(a1, bj, acc[1][j], 0, 0, 0);
            }
        }
    };
    auto gload = [&](u32x4 (&ra)[4], u32x4 (&rb)[NB], int kt) {
        const int k0 = kt * 64;
#pragma unroll
        for (int i = 0; i < 4; ++i) ra[i] = *(const u32x4*)(ap[i] + k0);
#pragma unroll
        for (int i = 0; i < NB; ++i) rb[i] = *(const u32x4*)(bp[i] + k0);
    };
    auto lstore = [&](const u32x4 (&ra)[4], const u32x4 (&rb)[NB], int st) {
#pragma unroll
        for (int i = 0; i < 4; ++i) *(u32x4*)(As + st * GSTAGE + soff + i * 32 * GLD) = ra[i];
#pragma unroll
        for (int i = 0; i < NB; ++i) *(u32x4*)(Bs + st * GSTAGE + soff + i * 32 * GLD) = rb[i];
    };
    for (int kt = 0; kt < nk; kt += 2) {
        if (!DEEP && kt + 1 < nk) gload(ra1, rb1, kt + 1);
        if (DEEP && kt + 2 < nk) gload(ra0, rb0, kt + 2);
        compute(0);
        if (kt + 1 < nk) lstore(ra1, rb1, 1);
        __syncthreads();
        if (kt + 1 >= nk) break;
        if (!DEEP && kt + 2 < nk) gload(ra0, rb0, kt + 2);
        if (DEEP && kt + 3 < nk) gload(ra1, rb1, kt + 3);
        compute(1);
        if (kt + 2 < nk) lstore(ra0, rb0, 0);
        __syncthreads();
    }
}
template <int TN>
DEV void acc_zero(f32x16 (&acc)[2][TN]) {
#pragma unroll
    for (int i = 0; i < 2; ++i)
#pragma unroll
        for (int j = 0; j < TN; ++j)
#pragma unroll
            for (int r = 0; r < 16; ++r) acc[i][j][r] = 0.f;
}
#define EPI_FOREACH(acc, ...)                                                                           \
    {                                                                                                    \
        const int _lane = tidx() & 63, _wave = tidx() >> 6, _wm = _wave >> 1, _wn = _wave & 1; \
        _Pragma("unroll") for (int _i = 0; _i < 2; ++_i)                                                 \
        _Pragma("unroll") for (int _j = 0; _j < 2; ++_j)                                                 \
        _Pragma("unroll") for (int _r = 0; _r < 16; ++_r) {                                              \
            const int er = _wm * 64 + _i * 32 + (_r & 3) + 8 * (_r >> 2) + 4 * (_lane >> 5);             \
            const int ec = _wn * 64 + _j * 32 + (_lane & 31);                                            \
            const float ev = acc[_i][_j][_r];                                                            \
            __VA_ARGS__                                                                                  \
        }                                                                                                \
    }

DEV void tile_mn(int item, int nMt, int nNt, int& mt, int& nt) {
    constexpr int GM = 16;
    const int per = GM * nNt, g = item / per, rem = item % per;
    const int m0 = g * GM, gsz = (nMt - m0) < GM ? (nMt - m0) : GM;
    mt = m0 + rem % gsz; nt = rem / gsz;
}

DEV void phase_inproj(const Params& p, int l, char* smem) {
    bf16_t* sm = (bf16_t*)smem;
    const bf16_t* H = wsb(p, OFF_H);
    const bf16_t* W = wsb(p, OFF_WIN);
    bf16_t* P = wsb(p, OFF_P);
    unsigned char* G = (unsigned char*)(wsp(p) + OFF_GATE);
    const int nMt = TT / 128, nNt = NINP / 128;
    for (int item = bidx(); item < nMt * nNt; item += gridDim.x) {
        int mt, nt; tile_mn(item, nMt, nNt, mt, nt);
        const int m0 = mt * 128, n0 = nt * 128;
        if (l == 1 && m0 >= TL && n0 >= NGATE0) continue;
        f32x16 acc[2][2]; acc_zero<2>(acc);
        gemm_mainloop(acc, [&](int r) { return H + (size_t)(m0 + r) * 1024; }, [&](int r) { return W + (size_t)(n0 + r) * 1024; }, 1024, sm);
        if (n0 < NGATE0) {
            EPI_FOREACH(acc, { const int col = n0 + ec; if (col < C_PEND) P[(size_t)(m0 + er) * LDP + col] = f2bf(ev); })
        } else {
            EPI_FOREACH(acc, { const int col = n0 + ec - NGATE0; const float s = sigmoidf_(ev); G[(size_t)(m0 + er) * 4096 + col] = (unsigned char)__float2int_rn(s * 255.f); })
        }
    }
}

template <class EF>
DEV void gemm_generic(const bf16_t* A, int lda, int M, const bf16_t* Bt, int ldb, int N, int K, EF ef, char* smem, int rot) {
    bf16_t* sm = (bf16_t*)smem;
    const int nMt = (M + 127) / 128, nNt = (N + 127) / 128, G = gridDim.x;
    const int first = (bidx() - (rot % G) + G) % G;
    for (int item = first; item < nMt * nNt; item += G) {
        const int mt = item / nNt, nt = item % nNt, m0 = mt * 128, n0 = nt * 128;
        f32x16 acc[2][2]; acc_zero<2>(acc);
        gemm_mainloop(acc, [&](int r) { int rr = m0 + r; rr = rr < M ? rr : M - 1; return A + (size_t)rr * lda; },
                      [&](int r) { int rr = n0 + r; rr = rr < N ? rr : N - 1; return Bt + (size_t)rr * ldb; }, K, sm);
        EPI_FOREACH(acc, { const int row = m0 + er, col = n0 + ec; if (row < M && col < N) ef(row, col, ev); })
    }
}

DEV void phase_merge(const Params& p, int l, int M, char* smem) {
    bf16_t* sm = (bf16_t*)smem;
    const bf16_t* Y = wsb(p, OFF_Y);
    const bf16_t* W = wsb(p, OFF_WBR);
    const unsigned char* G = (const unsigned char*)(wsp(p) + OFF_GATE);
    bf16_t* MG = wsb(p, OFF_H);
    bf16_t* As = sm;
    bf16_t* Bs = sm + 2 * GSTAGE;
    unsigned char* Gs = (unsigned char*)(sm + 2 * GSTAGE + 2 * 64 * GLD);
    const int tid = tidx(), lane = tid & 63, wave = tid >> 6, wm = wave >> 1, wn = wave & 1;
    const int soff = (tid >> 3) * GLD + (tid & 7) * 8;
    const int arow0 = (wm * 64 + (lane & 31)) * GLD + (lane >> 5) * 8;
    const int brow0 = (wn * 32 + (lane & 31)) * GLD + (lane >> 5) * 8;
    const int nMt = M / 128, nNt = 16;
    for (int item = bidx(); item < nMt * nNt; item += gridDim.x) {
        const int mt = item / nNt, nt = item % nNt, m0 = mt * 128, n0 = nt * 64;
        const bf16_t* ap[4]; const bf16_t* bp[2]; const unsigned char* gp[2];
#pragma unroll
        for (int i = 0; i < 4; ++i) { const int q = tid + i * NT; ap[i] = Y + (size_t)(m0 + (q >> 3)) * 1024 + (q & 7) * 8; }
#pragma unroll
        for (int i = 0; i < 2; ++i) { const int q = tid + i * NT; bp[i] = W + (size_t)(n0 + (q >> 3)) * 256 + (q & 7) * 8;
                                      gp[i] = G + (size_t)(m0 + (q >> 2)) * 4096 + n0 + (q & 3) * 16; }
        f32x16 tot[2], acc[2];
#pragma unroll
        for (int a = 0; a < 2; ++a)
#pragma unroll
            for (int r = 0; r < 16; ++r) { tot[a][r] = 0.f; acc[a][r] = 0.f; }
        u32x4 ra[4], rb[2], rg[2];
#pragma unroll
        for (int i = 0; i < 4; ++i) ra[i] = *(const u32x4*)ap[i];
#pragma unroll
        for (int i = 0; i < 2; ++i) rb[i] = *(const u32x4*)bp[i];
        __syncthreads();
#pragma unroll
        for (int i = 0; i < 4; ++i) *(u32x4*)(As + soff + i * 32 * GLD) = ra[i];
#pragma unroll
        for (int i = 0; i < 2; ++i) *(u32x4*)(Bs + soff + i * 32 * GLD) = rb[i];
        __syncthreads();
#pragma unroll
        for (int kt = 0; kt < 16; ++kt) {
            const int cur = kt & 1, seg = kt >> 2;
            if (kt + 1 < 16) {
                const int k1 = kt + 1;
#pragma unroll
                for (int i = 0; i < 4; ++i) ra[i] = *(const u32x4*)(ap[i] + k1 * 64);
#pragma unroll
                for (int i = 0; i < 2; ++i) rb[i] = *(const u32x4*)(bp[i] + (size_t)(k1 >> 2) * (1024 * 256) + (k1 & 3) * 64);
            }
            if ((kt & 3) == 0) {
#pragma unroll
                for (int i = 0; i < 2; ++i) rg[i] = *(const u32x4*)(gp[i] + seg * 1024);
            }
            const bf16_t* a_s = As + cur * GSTAGE + arow0;
            const bf16_t* b_s = Bs + cur * (64 * GLD) + brow0;
#pragma unroll
            for (int ks = 0; ks < 4; ++ks) {
                const bf16x8 a0 = *(const bf16x8*)(a_s + ks * 16), a1 = *(const bf16x8*)(a_s + 32 * GLD + ks * 16), b0 = *(const bf16x8*)(b_s + ks * 16);
                acc[0] = __builtin_amdgcn_mfma_f32_32x32x16_bf16(a0, b0, acc[0], 0, 0, 0);
                acc[1] = __builtin_amdgcn_mfma_f32_32x32x16_bf16(a1, b0, acc[1], 0, 0, 0);
            }
            if (kt + 1 < 16) {
                const int nx = cur ^ 1;
#pragma unroll
                for (int i = 0; i < 4; ++i) *(u32x4*)(As + nx * GSTAGE + soff + i * 32 * GLD) = ra[i];
#pragma unroll
                for (int i = 0; i < 2; ++i) *(u32x4*)(Bs + nx * (64 * GLD) + soff + i * 32 * GLD) = rb[i];
            }
            if ((kt & 3) == 3) {
#pragma unroll
                for (int i = 0; i < 2; ++i) { const int q = tid + i * NT; *(u32x4*)(Gs + (q >> 2) * 64 + (q & 3) * 16) = rg[i]; }
            }
            __syncthreads();
            if ((kt & 3) == 3) {
#pragma unroll
                for (int a = 0; a < 2; ++a)
#pragma unroll
                    for (int r = 0; r < 16; ++r) {
                        const int er = wm * 64 + a * 32 + (r & 3) + 8 * (r >> 2) + 4 * (lane >> 5), ec = wn * 32 + (lane & 31);
                        tot[a][r] += (float)Gs[er * 64 + ec] * (1.f / 255.f) * acc[a][r];
                        acc[a][r] = 0.f;
                    }
            }
        }
#pragma unroll
        for (int a = 0; a < 2; ++a)
#pragma unroll
            for (int r = 0; r < 16; ++r) {
                const int er = wm * 64 + a * 32 + (r & 3) + 8 * (r >> 2) + 4 * (lane >> 5), ec = wn * 32 + (lane & 31);
                MG[(size_t)(m0 + er) * 1024 + n0 + ec] = f2bf(tot[a][r]);
            }
    }
}

DEV void phase_outproj(const Params& p, int l, int M, char* smem) {
    bf16_t* sm = (bf16_t*)smem;
    const bf16_t* MG = wsb(p, OFF_H);
    const bf16_t* W = wsb(p, OFF_WOUT);
    const float* xs = (l == 0) ? inp(p, I_X) : p.out;
    const float* cs = (l == 0) ? inp(p, I_CTX) : wsf(p, OFF_CX);
    float* cxd = wsf(p, OFF_CX);
    float* outd = p.out;
    const int nMt = M / 128, nNt = 8;
    for (int item = bidx(); item < nMt * nNt; item += gridDim.x) {
        const int mt = item / nNt, nt = item % nNt, m0 = mt * 128, n0 = nt * 128;
        f32x16 acc[2][2]; acc_zero<2>(acc);
        gemm_mainloop(acc, [&](int r) { return MG + (size_t)(m0 + r) * 1024; }, [&](int r) { return W + (size_t)(n0 + r) * 1024; }, 1024, sm);
        const float* g1 = modp(p, l, mod_row(m0), 2);
        if (m0 < TL) {
            EPI_FOREACH(acc, { const size_t o = (size_t)(m0 + er) * 1024 + n0 + ec; outd[o] = xs[o] + g1[n0 + ec] * ev; })
        } else {
            EPI_FOREACH(acc, { const size_t o = (size_t)(m0 - TL + er) * 1024 + n0 + ec; cxd[o] = cs[o] + g1[n0 + ec] * ev; })
        }
    }
}

constexpr int MOE_MAP_OFF = 73728;
DEV void moe_map(const Params& p, int l, char* smem) {
    int* mm = (int*)(smem + MOE_MAP_OFF);
    __syncthreads();
    if (tidx() == 0) {
        const int* cnt = (const int*)(wsp(p) + OFF_CTR) + CTR_MOE + l * 16;
        int b = 0, t = 0;
        for (int e = 0; e < 16; ++e) { const int c = cnt[e]; mm[e] = c; mm[16 + e] = b; mm[32 + e] = t; b += c; t += (c + 127) >> 7; }
        mm[48] = t;
    }
    __syncthreads();
}
DEV void phase_moe1(const Params& p, int l, char* smem) {
    bf16_t* sm = (bf16_t*)smem;
    const bf16_t* F = wsb(p, OFF_H);
    const bf16_t* W = wsb(p, OFF_WG1);
    bf16_t* ACT = wsb(p, OFF_P);
    const int* ltok = (const int*)(wsp(p) + OFF_LTOK);
    moe_map(p, l, smem); const int* mm = (const int*)(smem + MOE_MAP_OFF);
    const int nNt = 8, total = mm[48] * nNt;
    for (int item = bidx(); item < total; item += gridDim.x) {
        const int mtg = item / nNt, nt = item % nNt;
        int e = 0;
        for (int q = 1; q < 16; ++q) if (mtg >= mm[32 + q]) e = q;
        const int m0 = (mtg - mm[32 + e]) * 128, n0 = nt * 128, ce = mm[e];
        const int* lt = ltok + (size_t)e * TT;
        f32x16 acc[2][2]; acc_zero<2>(acc);
        gemm_mainloop(acc, [&](int r) { int idx = m0 + r; idx = idx < ce ? idx : ce - 1; return F + (size_t)lt[idx] * 1024; },
                      [&](int r) { return W + ((size_t)e * 1024 + n0 + r) * 1024; }, 1024, sm);
        const int lane = tidx() & 63, wave = tidx() >> 6, wm = wave >> 1, wn = wave & 1;
        const int jcol = ((n0 >> 6) + wn) * 32 + (lane & 31);
#pragma unroll
        for (int a = 0; a < 2; ++a)
#pragma unroll
            for (int r = 0; r < 16; ++r) {
                const int idx = m0 + wm * 64 + a * 32 + (r & 3) + 8 * (r >> 2) + 4 * (lane >> 5);
                if (idx < ce) {
                    const float g = acc[a][0][r], u = acc[a][1][r];
                    ACT[(size_t)(mm[16 + e] + idx) * DFF + jcol] = f2bf(g * sigmoidf_(g) * u);
                }
            }
    }
}
DEV void phase_moe2(const Params& p, int l, char* smem) {
    bf16_t* sm = (bf16_t*)smem;
    const bf16_t* ACT = wsb(p, OFF_P);
    const bf16_t* W = wsb(p, OFF_WDN);
    bf16_t* Z = wsb(p, OFF_Z);
    moe_map(p, l, smem); const int* mm = (const int*)(smem + MOE_MAP_OFF);
    const int nNt = 8, total = mm[48] * nNt;
    for (int item = bidx(); item < total; item += gridDim.x) {
        const int mtg = item / nNt, nt = item % nNt;
        int e = 0;
        for (int q = 1; q < 16; ++q) if (mtg >= mm[32 + q]) e = q;
        const int m0 = (mtg - mm[32 + e]) * 128, n0 = nt * 128, ce = mm[e];
        f32x16 acc[2][2]; acc_zero<2>(acc);
        gemm_mainloop(acc, [&](int r) { int idx = m0 + r; idx = idx < ce ? idx : ce - 1; return ACT + (size_t)(mm[16 + e] + idx) * DFF; },
                      [&](int r) { return W + ((size_t)e * 1024 + n0 + r) * DFF; }, DFF, sm);
        bf16_t* zb = Z + (size_t)mm[16 + e] * 1024;
        EPI_FOREACH(acc, { const int idx = m0 + er; if (idx < ce) zb[(size_t)idx * 1024 + n0 + ec] = f2bf(ev); })
    }
}
DEV void tok_seq(int t, int& base, int& n, int& len) {
    if (t < TL) { base = t & ~(SEQ - 1); n = t & (SEQ - 1); len = SEQ; } else { const int u = t - TL; base = TL + (u & ~(CTXL - 1)); n = u & (CTXL - 1); len = CTXL; }
}
DEV void phase_prep1(const Params& p, int l) {
    const int lane = tidx() & 63, wave = tidx() >> 6;
    bf16_t* P = wsb(p, OFF_P);
    bf16_t* XL = wsb(p, OFF_XL);
    const float* qkg = inp(p, I_DAQKG) + l * 64;
    const float* cqg = inp(p, I_MCQG) + l * 192;
    const float* ckvg = inp(p, I_MCKVG) + l * 128;
    const float* mu3 = inp(p, I_RMU) + (l * 4 + 3) * 256;
    for (int t = bidx() * 4 + wave; t < TT; t += gridDim.x * 4) {
        bf16_t* row = P + (size_t)t * LDP;
        int base, n, len; tok_seq(t, base, n, len);
        {
            const int d0 = (lane & 7) * 4;
            float cs[4], sn[4];
            const bool rot = t < TL;
            if (rot) {
                const float fr = (float)(n >> 6), fc = (float)(n & 63);
#pragma unroll
                for (int j = 0; j < 4; ++j) {
                    const int i = (d0 + j) & 15;
                    const float inv = exp2f(-(float)(i & 7) * (13.287712379549449f / 8.f));
                    const float ang = (i < 8 ? fr : fc) * inv;
                    cs[j] = __cosf(ang); sn[j] = __sinf(ang);
                }
            }
#pragma unroll
            for (int which = 0; which < 2; ++which) {
                bf16_t* ptr = row + (which ? C_DAK : C_DAQ) + lane * 4;
                const u32x2 raw = *(const u32x2*)ptr;
                float v[4] = { bflo(raw.x), bfhi(raw.x), bflo(raw.y), bfhi(raw.y) };
                float ss = v[0] * v[0] + v[1] * v[1] + v[2] * v[2] + v[3] * v[3];
                ss = group_sum<8>(ss);
                const float rstd = rsqrtf(ss * (1.f / 32.f) + EPS);
                const float* g = qkg + which * 32 + d0;
#pragma unroll
                for (int j = 0; j < 4; ++j) v[j] = v[j] * rstd * g[j];
                if (rot) {
#pragma unroll
                    for (int j = 0; j < 4; ++j) {
                        const float o = __shfl_xor(v[j], 4, 64);
                        v[j] = (d0 < 16) ? (v[j] * cs[j] - o * sn[j]) : (v[j] * cs[j] + o * sn[j]);
                    }
                }
                if (which == 0) {
                    const float qs = 0.17677669529663687f * LOG2E;
#pragma unroll
                    for (int j = 0; j < 4; ++j) v[j] *= qs;
                }
                u32x2 o; o.x = pack2(v[0], v[1]); o.y = pack2(v[2], v[3]);
                *(u32x2*)ptr = o;
            }
        }
        {
            float v[3]; float ss = 0.f;
#pragma unroll
            for (int j = 0; j < 3; ++j) { v[j] = bf2f(row[C_CQ + lane + j * 64]); ss += v[j] * v[j]; }
            ss = wave_sum(ss);
            const float rstd = rsqrtf(ss * (1.f / 192.f) + EPS);
#pragma unroll
            for (int j = 0; j < 3; ++j) row[C_CQ + lane + j * 64] = f2bf(v[j] * rstd * cqg[lane + j * 64]);
            float w[2]; float s2 = 0.f;
#pragma unroll
            for (int j = 0; j < 2; ++j) { w[j] = bf2f(row[C_CKV + lane + j * 64]); s2 += w[j] * w[j]; }
            s2 = wave_sum(s2);
            const float r2 = rsqrtf(s2 * (1.f / 128.f) + EPS);
#pragma unroll
            for (int j = 0; j < 2; ++j) row[C_CKV + lane + j * 64] = f2bf(w[j] * r2 * ckvg[lane + j * 64]);
        }
        {
            const int c = lane * 4;
            const u32x2 cur = *(const u32x2*)(row + C_RWD + c);
            u32x2 pv = (u32x2){0u, 0u}, nx = (u32x2){0u, 0u};
            if (n > 0) pv = *(const u32x2*)(row - LDP + C_RWD + c);
            if (n + 1 < len) nx = *(const u32x2*)(row + LDP + C_RWD + c);
            const float4 m = *(const float4*)(mu3 + c);
            float o[4];
            { const float x = bflo(cur.x); o[0] = x + (0.5f * (bflo(pv.x) + bflo(nx.x)) - x) * m.x; }
            { const float x = bfhi(cur.x); o[1] = x + (0.5f * (bfhi(pv.x) + bfhi(nx.x)) - x) * m.y; }
            { const float x = bflo(cur.y); o[2] = x + (0.5f * (bflo(pv.y) + bflo(nx.y)) - x) * m.z; }
            { const float x = bfhi(cur.y); o[3] = x + (0.5f * (bfhi(pv.y) + bfhi(nx.y)) - x) * m.w; }
            u32x2 ov; ov.x = pack2(o[0], o[1]); ov.y = pack2(o[2], o[3]);
            *(u32x2*)(XL + (size_t)t * 256 + c) = ov;
        }
    }
}

DEV void phase_prep_gemm1(const Params& p, int l, char* smem) {
    const bf16_t* P = wsb(p, OFF_P);
    const bf16_t* w = wsb(p, OFF_WSM) + (size_t)l * WS_PER_LAYER;
    bf16_t* QRAW = wsb(p, OFF_QRAW); bf16_t* KVRAW = wsb(p, OFF_KVRAW); bf16_t* LR = wsb(p, OFF_LR);
    int rot = 0;
    gemm_generic(P + C_CQ, LDP, TT, w + WS_UQT, 192, 192, 192, [&](int r, int c, float v) { QRAW[(size_t)r * 192 + c] = f2bf(v); }, smem, rot);
    rot += (TT / 128) * 2;
    gemm_generic(P + C_CKV, LDP, TT, w + WS_UKVT, 128, 384, 128, [&](int r, int c, float v) { KVRAW[(size_t)r * 384 + c] = f2bf(v); }, smem, rot);
    rot += (TT / 128) * 3;
    gemm_generic(wsb(p, OFF_XL), 256, TT, w + WS_W1C, 256, 192, 256,
                 [&](int r, int c, float v) { const float o = c < 64 ? (1.f - 2.f / (__expf(2.f * v) + 1.f)) : (c < 128 ? v : sigmoidf_(v)); LR[(size_t)r * 192 + c] = f2bf(o); }, smem, rot);
}
DEV void phase_prep_gemm2(const Params& p, int l, char* smem) {
    const bf16_t* w = wsb(p, OFF_WSM) + (size_t)l * WS_PER_LAYER;
    const bf16_t* LR = wsb(p, OFF_LR);
    bf16_t* RWX = wsb(p, OFF_RWX);
    bf16_t* P = wsb(p, OFF_P);
    int rot = 0;
    for (int d = 0; d < 2; ++d) {
        const float* w0 = inp(p, I_RW0) + (l * 2 + d) * 256;
        gemm_generic(LR + d * 32, 192, TT, w + WS_W2 + (size_t)d * 256 * 64, 64, 256, 64,
                     [&](int r, int c, float v) { RWX[(size_t)r * 1024 + d * 256 + c] = f2bf(0.6065306597126334f * sigmoidf_(w0[c] + v)); }, smem, rot);
        rot += (TT / 128) * 2;
        const float* a0 = inp(p, I_RA0) + (l * 2 + d) * 256;
        gemm_generic(LR + 64 + d * 32, 192, TT, w + WS_W2 + (size_t)(2 + d) * 256 * 64, 64, 256, 64,
                     [&](int r, int c, float v) { RWX[(size_t)r * 1024 + 512 + d * 256 + c] = f2bf(sigmoidf_(a0[c] + v)); }, smem, rot);
        rot += (TT / 128) * 2;
    }
    gemm_generic(LR + 128, 192, TT, w + WS_G2T, 64, 256, 64, [&](int r, int c, float v) { P[(size_t)r * LDP + C_RWD + c] = f2bf(v); }, smem, rot);
}

DEV void phase_prep2(const Params& p, int l) {
    const int lane = tidx() & 63, wave = tidx() >> 6;
    const bf16_t* P = wsb(p, OFF_P);
    const bf16_t* QRAW = wsb(p, OFF_QRAW); const bf16_t* KVRAW = wsb(p, OFF_KVRAW);
    bf16_t* MQ = wsb(p, OFF_MLAQ); bf16_t* MK = wsb(p, OFF_MLAK); bf16_t* MV = wsb(p, OFF_MLAV);
    const float* qkg = inp(p, I_MQKG) + l * 96;
    for (int t = bidx() * 4 + wave; t < TT; t += gridDim.x * 4) {
        int base, n, len; tok_seq(t, base, n, len);
        const int h = lane >> 4, j = lane & 15;
        const bool rot = t < TL;
        float cs = 1.f, sn = 0.f;
        if (rot) {
            const int i = j & 7;
            const float inv = exp2f(-(float)(i & 3) * (13.287712379549449f / 4.f));
            const float ang = (i < 4 ? (float)(n >> 6) : (float)(n & 63)) * inv;
            cs = __cosf(ang); sn = __sinf(ang);
        }
        {
            float v[3]; float ss = 0.f;
#pragma unroll
            for (int k = 0; k < 3; ++k) { v[k] = bf2f(QRAW[(size_t)t * 192 + h * 48 + j + k * 16]); ss += v[k] * v[k]; }
            ss = group_sum<16>(ss);
            const float rstd = rsqrtf(ss * (1.f / 48.f) + EPS);
#pragma unroll
            for (int k = 0; k < 3; ++k) v[k] = v[k] * rstd * qkg[j + k * 16];
            if (rot) { const float o = __shfl_xor(v[2], 8, 64); v[2] = (j < 8) ? (v[2] * cs - o * sn) : (v[2] * cs + o * sn); }
            const float qs = 0.14433756729740643f * LOG2E;
#pragma unroll
            for (int k = 0; k < 3; ++k) MQ[(size_t)t * 192 + h * 48 + j + k * 16] = f2bf(v[k] * qs);
        }
        {
            float v[3]; float ss = 0.f;
            v[0] = bf2f(KVRAW[(size_t)t * 384 + h * 96 + j]);
            v[1] = bf2f(KVRAW[(size_t)t * 384 + h * 96 + 16 + j]);
            v[2] = bf2f(P[(size_t)t * LDP + C_KR + j]);
#pragma unroll
            for (int k = 0; k < 3; ++k) ss += v[k] * v[k];
            ss = group_sum<16>(ss);
            const float rstd = rsqrtf(ss * (1.f / 48.f) + EPS);
#pragma unroll
            for (int k = 0; k < 3; ++k) v[k] = v[k] * rstd * qkg[48 + j + k * 16];
            if (rot) { const float o = __shfl_xor(v[2], 8, 64); v[2] = (j < 8) ? (v[2] * cs - o * sn) : (v[2] * cs + o * sn); }
#pragma unroll
            for (int k = 0; k < 3; ++k) MK[(size_t)t * 192 + h * 48 + j + k * 16] = f2bf(v[k]);
        }
#pragma unroll
        for (int k = 0; k < 4; ++k) MV[(size_t)t * 256 + h * 64 + j + k * 16] = KVRAW[(size_t)t * 384 + h * 96 + 32 + j + k * 16];
    }
}
template <int NC, int DK>
struct AttnCfg {
    static constexpr int DKROW = NC * DK, KLD = DKROW + 8, VLD = 68;
    static constexpr int KSTAGE = 64 * KLD, VSTAGE = 64 * VLD;
    static constexpr int KCH = 64 * DKROW / 8;
};
template <int NC, int DK, class EPI>
DEV void attn_item(const bf16_t* Q, int ldq, const bf16_t* Kl, const bf16_t* Kc, int ldk, const bf16_t* Vl, const bf16_t* Vc, int ldv,
                   int q0, int nlat_tiles, int nctx_tiles, EPI epi, char* smem) {
    using C = AttnCfg<NC, DK>;
    constexpr int KS = DK / 16;
    const int tid = tidx(), lane = tid & 63, wave = tid >> 6, ql = lane & 31, hh = lane >> 5;
    bf16_t* Ks = (bf16_t*)smem;
    bf16_t* Vt = Ks + 2 * C::KSTAGE;
    bf16x8 qf[NC][KS];
    {
        const bf16_t* qp = Q + (size_t)(q0 + wave * 32 + ql) * ldq + hh * 8;
#pragma unroll
        for (int c = 0; c < NC; ++c)
#pragma unroll
            for (int ks = 0; ks < KS; ++ks) qf[c][ks] = *(const bf16x8*)(qp + c * DK + ks * 16);
    }
    f32x16 O[NC][2];
    float mrun[NC], lrun[NC];
#pragma unroll
    for (int c = 0; c < NC; ++c) {
        mrun[c] = -1e30f; lrun[c] = 0.f;
#pragma unroll
        for (int d = 0; d < 2; ++d)
#pragma unroll
            for (int r = 0; r < 16; ++r) O[c][d][r] = 0.f;
    }
    const int ntiles = nlat_tiles + nctx_tiles;
    constexpr int KPT = (C::KCH + NT - 1) / NT;
    constexpr bool KFULL = (C::KCH % NT) == 0;
    u32x4 rk[KPT], rv[2];
    auto load_tile = [&](int tile) {
        const bf16_t* kb = tile < nlat_tiles ? Kl + (size_t)tile * 64 * ldk : Kc + (size_t)(tile - nlat_tiles) * 64 * ldk;
        const bf16_t* vb = tile < nlat_tiles ? Vl + (size_t)tile * 64 * ldv : Vc + (size_t)(tile - nlat_tiles) * 64 * ldv;
#pragma unroll
        for (int i = 0; i < KPT; ++i) {
            int q = tid + i * NT; q = (KFULL || q < C::KCH) ? q : C::KCH - 1;
            { const int key = q / (C::DKROW / 8), ch = q % (C::DKROW / 8); rk[i] = *(const u32x4*)(kb + (size_t)key * ldk + ch * 8); }
        }
#pragma unroll
        for (int i = 0; i < 2; ++i) { const int q = tid + i * NT; const int key = q >> 3, ch = q & 7; rv[i] = *(const u32x4*)(vb + (size_t)key * ldv + ch * 8); }
    };
    auto store_tile = [&](int st) {
#pragma unroll
        for (int i = 0; i < KPT; ++i) {
            const int q = tid + i * NT;
            if (KFULL || q < C::KCH) { const int key = q / (C::DKROW / 8), ch = q % (C::DKROW / 8); *(u32x4*)(Ks + st * C::KSTAGE + key * C::KLD + ch * 8) = rk[i]; }
        }
#pragma unroll
        for (int i = 0; i < 2; ++i) {
            const int q = tid + i * NT; const int key = q >> 3, dv0 = (q & 7) * 8;
            bf16_t* vd = Vt + st * C::VSTAGE + dv0 * C::VLD + key;
            const unsigned w[4] = { rv[i][0], rv[i][1], rv[i][2], rv[i][3] };
#pragma unroll
            for (int j = 0; j < 4; ++j) { vd[(2 * j) * C::VLD] = (bf16_t)(w[j] & 0xFFFFu); vd[(2 * j + 1) * C::VLD] = (bf16_t)(w[j] >> 16); }
        }
    };
    load_tile(0);
    __syncthreads();
    store_tile(0);
    __syncthreads();
    for (int tile = 0; tile < ntiles; ++tile) {
        const int cur = tile & 1;
        if (tile + 1 < ntiles) load_tile(tile + 1);
        __builtin_amdgcn_sched_barrier(0);
        const bf16_t* ks_ = Ks + cur * C::KSTAGE;
        const bf16_t* vt_ = Vt + cur * C::VSTAGE;
#pragma unroll
        for (int c = 0; c < NC; ++c) {
            f32x16 S[2];
#pragma unroll
            for (int kb = 0; kb < 2; ++kb) {
#pragma unroll
                for (int r = 0; r < 16; ++r) S[kb][r] = 0.f;
#pragma unroll
                for (int ks = 0; ks < KS; ++ks) {
                    const bf16x8 kf = *(const bf16x8*)(ks_ + (kb * 32 + ql) * C::KLD + c * DK + ks * 16 + hh * 8);
                    S[kb] = __builtin_amdgcn_mfma_f32_32x32x16_bf16(kf, qf[c][ks], S[kb], 0, 0, 0);
                }
            }
            float mx = S[0][0];
#pragma unroll
            for (int kb = 0; kb < 2; ++kb)
#pragma unroll
                for (int r = 0; r < 16; ++r) mx = fmaxf(mx, S[kb][r]);
            mx = fmaxf(mx, __shfl_xor(mx, 32, 64));
            const float mnew = fmaxf(mrun[c], mx);
            const float alpha = __builtin_amdgcn_exp2f(mrun[c] - mnew);
            mrun[c] = mnew;
            float ls = 0.f;
#pragma unroll
            for (int kb = 0; kb < 2; ++kb)
#pragma unroll
                for (int r = 0; r < 16; ++r) { const float e = __builtin_amdgcn_exp2f(S[kb][r] - mnew); S[kb][r] = e; ls += e; }
            lrun[c] = lrun[c] * alpha + ls;
#pragma unroll
            for (int d = 0; d < 2; ++d)
#pragma unroll
                for (int r = 0; r < 16; ++r) O[c][d][r] *= alpha;
#pragma unroll
            for (int s = 0; s < 4; ++s) {
                const int kb = s >> 1, s2 = s & 1;
                const u32x4 pu = (u32x4){pack2(S[kb][8 * s2 + 0], S[kb][8 * s2 + 1]), pack2(S[kb][8 * s2 + 2], S[kb][8 * s2 + 3]),
                                         pack2(S[kb][8 * s2 + 4], S[kb][8 * s2 + 5]), pack2(S[kb][8 * s2 + 6], S[kb][8 * s2 + 7])};
                const bf16x8 pf = __builtin_bit_cast(bf16x8, pu);
                const int keyo = kb * 32 + 16 * s2 + 4 * hh;
#pragma unroll
                for (int d = 0; d < 2; ++d) {
                    const bf16_t* vp = vt_ + (d * 32 + ql) * C::VLD + keyo;
                    const u32x2 lo = *(const u32x2*)vp, hi = *(const u32x2*)(vp + 8);
                    const u32x4 vv = (u32x4){lo[0], lo[1], hi[0], hi[1]};
                    const bf16x8 vf = __builtin_bit_cast(bf16x8, vv);
                    O[c][d] = __builtin_amdgcn_mfma_f32_32x32x16_bf16(vf, pf, O[c][d], 0, 0, 0);
                }
            }
        }
        if (tile + 1 < ntiles) store_tile(cur ^ 1);
        __syncthreads();
    }
    float inv[NC];
#pragma unroll
    for (int c = 0; c < NC; ++c) { const float lt = lrun[c] + __shfl_xor(lrun[c], 32, 64); inv[c] = 1.f / lt; }
    epi(O, inv, q0 + wave * 32 + ql, hh);
}

DEV void da_item(const Params& p, int l, int item, char* smem) {
    const bf16_t* P = wsb(p, OFF_P);
    bf16_t* Y = wsb(p, OFF_Y);
    const float linit = 0.8f - 0.6f * __expf(-0.3f * (float)l);
    float lam;
    {
        const float* la = inp(p, I_DALAM) + l * 128;
        const int lane = tidx() & 63;
        float a = lane < 32 ? la[lane] * la[32 + lane] : 0.f, b = lane < 32 ? la[64 + lane] * la[96 + lane] : 0.f;
        a = wave_sum(a); b = wave_sum(b);
        lam = __expf(a) - __expf(b) + linit;
    }
    const float* sg = inp(p, I_DASUB) + l * 64;
    int b, h, qt; bool isctx;
    if (item < 512) { isctx = false; b = item >> 6; h = (item >> 4) & 3; qt = item & 15; }
    else { const int it = item - 512; isctx = true; b = it >> 3; h = (it >> 1) & 3; qt = it & 1; }
    const size_t lat0 = (size_t)b * SEQ, ctx0 = (size_t)TL + (size_t)b * CTXL;
    const size_t qrow0 = isctx ? ctx0 : lat0;
    float* o1s = (float*)(smem + 32768) + (tidx() >> 6) * (32 * 64) + (tidx() & 63);
    auto epi0 = [&](f32x16 (&O)[1][2], float (&inv)[1], int qrow, int hh) {
#pragma unroll
        for (int d = 0; d < 2; ++d)
#pragma unroll
            for (int r = 0; r < 16; ++r) o1s[(d * 16 + r) * 64] = O[0][d][r] * inv[0];
    };
    auto epi1 = [&](f32x16 (&O)[1][2], float (&inv)[1], int qrow, int hh) {
        float v[2][16]; float ss = 0.f;
#pragma unroll
        for (int d = 0; d < 2; ++d)
#pragma unroll
            for (int r = 0; r < 16; ++r) { const float o = o1s[(d * 16 + r) * 64] - lam * O[0][d][r] * inv[0]; v[d][r] = o; ss += o * o; }
        ss += __shfl_xor(ss, 32, 64);
        const float rstd = rsqrtf(ss * (1.f / 64.f) + EPS) * (1.f - linit);
        bf16_t* yo = Y + (qrow0 + qrow) * 1024 + h * 64;
#pragma unroll
        for (int d = 0; d < 2; ++d)
#pragma unroll
            for (int g = 0; g < 4; ++g) {
                const int dv = d * 32 + 8 * g + 4 * hh;
                u32x2 o;
                o.x = pack2(v[d][4 * g + 0] * rstd * sg[dv + 0], v[d][4 * g + 1] * rstd * sg[dv + 1]);
                o.y = pack2(v[d][4 * g + 2] * rstd * sg[dv + 2], v[d][4 * g + 3] * rstd * sg[dv + 3]);
                *(u32x2*)(yo + dv) = o;
            }
    };
    const bf16_t* Qp = P + qrow0 * LDP + C_DAQ + h * 64;
    const bf16_t* Kl = P + lat0 * LDP + C_DAK + h * 64;
    const bf16_t* Kc = P + ctx0 * LDP + C_DAK + h * 64;
    const bf16_t* Vl = P + lat0 * LDP + C_DAV + h * 64;
    const bf16_t* Vc = P + ctx0 * LDP + C_DAV + h * 64;
    const int nlat = isctx ? 0 : SEQ / 64;
    attn_item<1, 32>(Qp, LDP, Kl, Kc, LDP, Vl, Vc, LDP, qt * 128, nlat, CTXL / 64, epi0, smem);
    attn_item<1, 32>(Qp + 32, LDP, Kl + 32, Kc + 32, LDP, Vl, Vc, LDP, qt * 128, nlat, CTXL / 64, epi1, smem);
}
DEV void mla_item(const Params& p, int l, int item, char* smem) {
    const bf16_t* MQ = wsb(p, OFF_MLAQ); const bf16_t* MK = wsb(p, OFF_MLAK); const bf16_t* MV = wsb(p, OFF_MLAV);
    bf16_t* Y = wsb(p, OFF_Y);
    int b, h, qt; bool isctx;
    if (item < 512) { isctx = false; b = item >> 6; h = (item >> 4) & 3; qt = item & 15; }
    else { const int it = item - 512; isctx = true; b = it >> 3; h = (it >> 1) & 3; qt = it & 1; }
    const size_t lat0 = (size_t)b * SEQ, ctx0 = (size_t)TL + (size_t)b * CTXL;
    const size_t qrow0 = isctx ? ctx0 : lat0;
    auto epi = [&](f32x16 (&O)[1][2], float (&inv)[1], int qrow, int hh) {
        bf16_t* yo = Y + (qrow0 + qrow) * 1024 + 512 + h * 64;
#pragma unroll
        for (int d = 0; d < 2; ++d)
#pragma unroll
            for (int g = 0; g < 4; ++g) {
                const int dv = d * 32 + 8 * g + 4 * hh;
                u32x2 o;
                o.x = pack2(O[0][d][4 * g + 0] * inv[0], O[0][d][4 * g + 1] * inv[0]);
                o.y = pack2(O[0][d][4 * g + 2] * inv[0], O[0][d][4 * g + 3] * inv[0]);
                *(u32x2*)(yo + dv) = o;
            }
    };
    const bf16_t* Qp = MQ + qrow0 * 192 + h * 48;
    const bf16_t* Kl = MK + lat0 * 192 + h * 48;
    const bf16_t* Kc = MK + ctx0 * 192 + h * 48;
    const bf16_t* Vl = MV + lat0 * 256 + h * 64;
    const bf16_t* Vc = MV + ctx0 * 256 + h * 64;
    attn_item<1, 48>(Qp, 192, Kl, Kc, 192, Vl, Vc, 256, qt * 128, isctx ? 0 : SEQ / 64, CTXL / 64, epi, smem);
}
DEV int s5_token(int b, int tb, int n) { return tb == 0 ? TL + b * CTXL + n : b * SEQ + (tb - 1) * 256 + n; }
struct S5M { float are, aim; bf16x8* bfl; };
DEV void s5_coef(const Params& p, int gi, int pl, float& are, float& aim, float& cr, float& ci) {
    const float lre = inp(p, I_S5LRE)[gi * 64 + pl], lim = inp(p, I_S5LIM)[gi * 64 + pl];
    const float dt = __expf(inp(p, I_S5LDT)[gi]);
    const float mag = __expf(lre * dt);
    are = mag * __cosf(lim * dt); aim = mag * __sinf(lim * dt);
    const float nr = are - 1.f, ni = aim, den = 1.f / (lre * lre + lim * lim);
    cr = (nr * lre + ni * lim) * den; ci = (ni * lre - nr * lim) * den;
}
DEV void s5_setup(const Params& p, int l, int d, int g, int lane, S5M& s, bf16x8* bfl) {
    s.bfl = bfl;
    const int gi = ((l * 2 + d) * 16 + g), c16 = lane & 15, kq = lane >> 4;
    float cr, ci;
    s5_coef(p, gi, lane, s.are, s.aim, cr, ci);
#pragma unroll
    for (int nt = 0; nt < 4; ++nt) {
        const int pp = nt * 16 + c16;
        float a0, a1; s5_coef(p, gi, pp, a0, a1, cr, ci);
        float re[8], im[8];
        const float* br = inp(p, I_S5BRE) + ((size_t)gi * 64 + pp) * 16 + (kq & 1) * 8;
        const float* bi = inp(p, I_S5BIM) + ((size_t)gi * 64 + pp) * 16 + (kq & 1) * 8;
#pragma unroll
        for (int j = 0; j < 8; ++j) { const float x = br[j], y = bi[j]; const bool on = kq < 2; re[j] = on ? cr * x - ci * y : 0.f; im[j] = on ? cr * y + ci * x : 0.f; }
        bfl[nt * 64 + lane] = __builtin_bit_cast(bf16x8, (u32x4){pack2(re[0], re[1]), pack2(re[2], re[3]), pack2(re[4], re[5]), pack2(re[6], re[7])});
        bfl[(nt + 4) * 64 + lane] = __builtin_bit_cast(bf16x8, (u32x4){pack2(im[0], im[1]), pack2(im[2], im[3]), pack2(im[4], im[5]), pack2(im[6], im[7])});
    }
}
DEV void s5_bu32(const S5M& s, const bf16_t* P, int b, int tb, int g, int sc, bf16_t* hb, int lane) {
    asm volatile("" : "+v"(sc));
    const int c16 = lane & 15, kq = lane >> 4;
    bf16x8 uf[2];
#pragma unroll
    for (int mt = 0; mt < 2; ++mt) {
        const int t = s5_token(b, tb, sc * 32 + mt * 16 + c16);
        const u32x4 raw = *(const u32x4*)(P + (size_t)t * LDP + C_S5 + g * 16 + (kq & 1) * 8);
        const u32x4 z = (u32x4){0u, 0u, 0u, 0u};
        uf[mt] = __builtin_bit_cast(bf16x8, kq < 2 ? raw : z);
    }
#pragma unroll
    for (int nt = 0; nt < 8; ++nt)
#pragma unroll
        for (int mt = 0; mt < 2; ++mt) {
            const f32x4 acc = __builtin_amdgcn_mfma_f32_16x16x32_bf16(s.bfl[nt * 64 + lane], uf[mt], (f32x4){0.f, 0.f, 0.f, 0.f}, 0, 0, 0);
            u32x2 o; o.x = pack2(acc[0], acc[1]); o.y = pack2(acc[2], acc[3]);
            *(u32x2*)(hb + (mt * 16 + c16) * 136 + nt * 16 + kq * 4) = o;
            if (mt == 1 && (nt & 1)) __builtin_amdgcn_sched_barrier(0);
        }
}
template <bool DUMP>
DEV void s5_scan32(const S5M& s, float& hre, float& him, bf16_t* hb, int pl, bool rev) {
#pragma unroll 4
    for (int j = 0; j < 32; ++j) {
        const int rowi = rev ? 31 - j : j;
        const float bur = bf2f(hb[rowi * 136 + pl]), bui = bf2f(hb[rowi * 136 + 64 + pl]);
        const float nre = s.are * hre - s.aim * him + bur;
        const float nim = s.are * him + s.aim * hre + bui;
        hre = nre; him = nim;
        if (DUMP) { hb[rowi * 136 + pl] = f2bf(hre); hb[rowi * 136 + 64 + pl] = f2bf(him); }
    }
}
DEV void phase_s5_pass1(const Params& p, int l, char* smem) {
    const int lane = tidx() & 63, wave = tidx() >> 6;
    bf16_t* hb = (bf16_t*)smem + wave * (32 * 136);
    const bf16_t* P = wsb(p, OFF_P);
    float* st = wsf(p, OFF_S5ST);
    const int nitems = 2 * 8 * 16 * 8;
    for (int it0 = bidx() * 4; it0 < nitems; it0 += gridDim.x * 4) {
        const int it = it0 + wave;
        const int seg = it & 7, g = (it >> 3) & 15, b = (it >> 7) & 7, d = it >> 10;
        const int tb = seg == 0 ? 0 : (d == 0 ? seg : 9 - seg);
        __syncthreads();
        S5M s; s5_setup(p, l, d, g, lane, s, (bf16x8*)(smem + 36864) + wave * 512);
        float hre = 0.f, him = 0.f;
        for (int k = 0; k < 8; ++k) {
            const int sc = d == 0 ? k : 7 - k;
            __syncthreads();
            s5_bu32(s, P, b, tb, g, sc, hb, lane);
            __syncthreads();
            s5_scan32<false>(s, hre, him, hb, lane, d == 1);
        }
        float* o = st + ((((size_t)d * 8 + b) * 16 + g) * 8 + seg) * 128;
        o[lane] = hre; o[64 + lane] = him;
    }
}
DEV void s5_pass2_item(const Params& p, int l, int tb0, int bitem, char* smem) {
    const int lane = tidx() & 63, wave = tidx() >> 6;
    bf16_t* hb = (bf16_t*)smem + wave * (32 * 136);
    bf16_t* P = wsb(p, OFF_P);
    bf16_t* S5Y = wsb(p, OFF_S5Y);
    const float* st = wsf(p, OFF_S5ST);
    const int it = bitem * 4 + wave;
    const int g = it & 15, b = (it >> 4) & 7, tb = (it >> 7) + tb0;
    const int c = lane & 15;
    const float dd = inp(p, I_S5D)[(l * 16 + g) * 16 + c];
#pragma unroll 1
    for (int d = 0; d < 2; ++d) {
        __syncthreads();
        S5M s; s5_setup(p, l, d, g, lane, s, (bf16x8*)(smem + 36864) + wave * 512);
        bf16x8 cf[4];
        {
            const float* cre = inp(p, I_S5CRE) + ((size_t)((l * 2 + d) * 16 + g) * 16 + c) * 64 + (lane >> 4) * 8;
            const float* cim = inp(p, I_S5CIM) + ((size_t)((l * 2 + d) * 16 + g) * 16 + c) * 64 + (lane >> 4) * 8;
#pragma unroll
            for (int ks = 0; ks < 4; ++ks) {
                const float* src = ks < 2 ? cre + ks * 32 : cim + (ks - 2) * 32;
                const float4 a = *(const float4*)src, b4 = *(const float4*)(src + 4);
                const float sg = ks < 2 ? 1.f : -1.f;
                cf[ks] = __builtin_bit_cast(bf16x8, (u32x4){pack2(sg * a.x, sg * a.y), pack2(sg * a.z, sg * a.w), pack2(sg * b4.x, sg * b4.y), pack2(sg * b4.z, sg * b4.w)});
            }
        }
        const int seg = tb == 0 ? 0 : (d == 0 ? tb : 9 - tb);
        float hre = 0.f, him = 0.f;
        {
            float pr = s.are, pi = s.aim;
#pragma unroll
            for (int q = 0; q < 8; ++q) { const float nr = pr * pr - pi * pi, ni = 2.f * pr * pi; pr = nr; pi = ni; }
            const float* hs = st + (((size_t)d * 8 + b) * 16 + g) * 8 * 128;
            for (int i = 0; i < seg; ++i) {
                const float er = hs[i * 128 + lane], ei = hs[i * 128 + 64 + lane];
                const float nr = pr * hre - pi * him + er, ni = pr * him + pi * hre + ei;
                hre = nr; him = ni;
            }
        }
#pragma unroll 1
        for (int k = 0; k < 8; ++k) {
            const int sc = d == 0 ? k : 7 - k;
            __syncthreads();
            s5_bu32(s, P, b, tb, g, sc, hb, lane);
            __syncthreads();
            s5_scan32<true>(s, hre, him, hb, lane, d == 1);
            __syncthreads();
#pragma unroll
            for (int mt = 0; mt < 2; ++mt) {
                f32x4 y = (f32x4){0.f, 0.f, 0.f, 0.f};
#pragma unroll
                for (int ks = 0; ks < 4; ++ks) {
                    const bf16x8 af = *(const bf16x8*)(hb + (mt * 16 + (lane & 15)) * 136 + ks * 32 + (lane >> 4) * 8);
                    y = __builtin_amdgcn_mfma_f32_16x16x32_bf16(af, cf[ks], y, 0, 0, 0);
                }
#pragma unroll
                for (int r = 0; r < 4; ++r) {
                    const int n = sc * 32 + mt * 16 + (lane >> 4) * 4 + r;
                    const size_t t = (size_t)s5_token(b, tb, n);
                    if (d == 0) S5Y[t * 256 + g * 16 + c] = f2bf(y[r]);
                    else {
                        bf16_t* up = P + t * LDP + C_S5 + g * 16 + c;
                        const float yy = dd * bf2f(*up) + bf2f(S5Y[t * 256 + g * 16 + c]) + y[r];
                        *up = f2bf(0.5f * yy * (1.f + tanhf(0.7978845608028654f * (yy + 0.044715f * yy * yy * yy))));
                    }
                }
            }
        }
    }
}

DEV float row16_sum(float v) {
    v += __int_as_float(__builtin_amdgcn_mov_dpp(__float_as_int(v), 0x128, 0xf, 0xf, true));
    v += __int_as_float(__builtin_amdgcn_mov_dpp(__float_as_int(v), 0x124, 0xf, 0xf, true));
    v += __int_as_float(__builtin_amdgcn_mov_dpp(__float_as_int(v), 0x122, 0xf, 0xf, true));
    v += __int_as_float(__builtin_amdgcn_mov_dpp(__float_as_int(v), 0x121, 0xf, 0xf, true));
    return v;
}
DEV float fmul_(float a, float b) { return a * b; }
DEV float fadd_(float a, float b) { return a + b; }
DEV float ffma_(float a, float b, float c) { return __builtin_fmaf(a, b, c); }
DEV float fnma_(float a, float b, float c) { return __builtin_fmaf(-a, b, c); }
DEV float row8_sum(float v) {
    v += __int_as_float(__builtin_amdgcn_mov_dpp(__float_as_int(v), 0x141, 0xf, 0xf, true));
    v += __int_as_float(__builtin_amdgcn_mov_dpp(__float_as_int(v), 0xB1, 0xf, 0xf, true));
    v += __int_as_float(__builtin_amdgcn_mov_dpp(__float_as_int(v), 0x4E, 0xf, 0xf, true));
    return v;
}
DEV float row16_sum1(float v) { v += __int_as_float(__builtin_amdgcn_mov_dpp(__float_as_int(v), 0x128, 0xf, 0xf, true)); return v; }
constexpr int RW_CT = 16;
struct RwRaw { u32x2 r[3], k[3], v[3], sd, a; float fp, fn; };
#ifndef RWVAR
#define RWVAR 0
#endif
template <int var>
DEV void rw_item_t(const Params& p, int l, int item, char* smem, int rep) {
    const int tid = tidx(), li = tid >> 4, lc = tid & 15;
    const int ch = item >> 2, rg = item & 3, dir = ch >> 5, b = (ch >> 2) & 7, head = ch & 3;
    float* buf = (float*)smem;
    float* ybuf = buf + 2 * RW_CT * 384;
    const bf16_t* P = wsb(p, OFF_P);
    const bf16_t* RWX = wsb(p, OFF_RWX);
    bf16_t* RWY = wsb(p, OFF_RWY) + (size_t)dir * TT * 256 + (rep > 0 ? (size_t)2 * TT * 256 : 0);
    const int hc = head * 64 + lc * 4;
    const float4 mur = *(const float4*)(inp(p, I_RMU) + (l * 4 + 0) * 256 + hc);
    const float4 muk = *(const float4*)(inp(p, I_RMU) + (l * 4 + 1) * 256 + hc);
    const float4 muv = *(const float4*)(inp(p, I_RMU) + (l * 4 + 2) * 256 + hc);
    const float4 kk4 = *(const float4*)(inp(p, I_RKK) + l * 256 + hc);
    const float4 ka4 = *(const float4*)(inp(p, I_RKA) + l * 256 + hc);
    const int NCH = (CTXL + SEQ) / RW_CT;
    auto tok_of = [&](int cidx, int i, int& n, int& len) -> int {
        if (cidx < CTXL / RW_CT) { const int pos = cidx * RW_CT + i; len = CTXL; n = dir == 0 ? pos : CTXL - 1 - pos; return TL + b * CTXL + n; }
        const int pos = (cidx - CTXL / RW_CT) * RW_CT + i; len = SEQ; n = dir == 0 ? pos : SEQ - 1 - pos; return b * SEQ + n;
    };
    auto load_raw = [&](int cidx, RwRaw& raw) {
        int n, len; const int t = tok_of(cidx, li, n, len);
        const bf16_t* row = P + (size_t)t * LDP;
        const bool hp = n > 0, hn = n + 1 < len;
        const bf16_t* rp = hp ? row - LDP : row;
        const bf16_t* rn = hn ? row + LDP : row;
        raw.fp = hp ? 0.5f : 0.f; raw.fn = hn ? 0.5f : 0.f;
        raw.r[1] = *(const u32x2*)(row + C_RWR + hc); raw.k[1] = *(const u32x2*)(row + C_RWK + hc); raw.v[1] = *(const u32x2*)(row + C_RWV + hc);
        raw.r[0] = *(const u32x2*)(rp + C_RWR + hc); raw.k[0] = *(const u32x2*)(rp + C_RWK + hc); raw.v[0] = *(const u32x2*)(rp + C_RWV + hc);
        raw.r[2] = *(const u32x2*)(rn + C_RWR + hc); raw.k[2] = *(const u32x2*)(rn + C_RWK + hc); raw.v[2] = *(const u32x2*)(rn + C_RWV + hc);
        raw.sd = *(const u32x2*)(RWX + (size_t)t * 1024 + dir * 256 + hc);
        raw.a = *(const u32x2*)(RWX + (size_t)t * 1024 + 512 + dir * 256 + hc);
    };
    auto mix4 = [&](const u32x2 (&s)[3], const float4& mu, float fp, float fn, float (&o)[4]) {
        { const float x = bflo(s[1].x); o[0] = x + ((fp * bflo(s[0].x) + fn * bflo(s[2].x)) - x) * mu.x; }
        { const float x = bfhi(s[1].x); o[1] = x + ((fp * bfhi(s[0].x) + fn * bfhi(s[2].x)) - x) * mu.y; }
        { const float x = bflo(s[1].y); o[2] = x + ((fp * bflo(s[0].y) + fn * bflo(s[2].y)) - x) * mu.z; }
        { const float x = bfhi(s[1].y); o[3] = x + ((fp * bfhi(s[0].y) + fn * bfhi(s[2].y)) - x) * mu.w; }
    };
    auto stage = [&](int st, const RwRaw& raw) {
        float r4[4], k4[4], v4[4];
        mix4(raw.r, mur, raw.fp, raw.fn, r4); mix4(raw.k, muk, raw.fp, raw.fn, k4); mix4(raw.v, muv, raw.fp, raw.fn, v4);
        const float kkr[4] = { k4[0] * kk4.x, k4[1] * kk4.y, k4[2] * kk4.z, k4[3] * kk4.w };
        float nn = kkr[0] * kkr[0] + kkr[1] * kkr[1] + kkr[2] * kkr[2] + kkr[3] * kkr[3];
        nn = row16_sum(nn);
        const float rn = 1.f / fmaxf(sqrtf(nn), 1e-12f);
        const float a[4] = { bflo(raw.a.x), bfhi(raw.a.x), bflo(raw.a.y), bfhi(raw.a.y) };
        const float sd[4] = { bflo(raw.sd.x), bfhi(raw.sd.x), bflo(raw.sd.y), bfhi(raw.sd.y) };
        const float kav[4] = { ka4.x, ka4.y, ka4.z, ka4.w };
        float* d = buf + (st * RW_CT + li) * 384 + lc * 4;
        float wp[4], kp[4], bp[4], mp[4];
#pragma unroll
        for (int j = 0; j < 4; ++j) {
            wp[j] = __expf(-sd[j]);
            kp[j] = kkr[j] * rn;
            bp[j] = kp[j] * a[j];
            mp[j] = k4[j] * (1.f + (a[j] - 1.f) * kav[j]);
        }
        *(float4*)(d + 0) = make_float4(wp[0], wp[1], wp[2], wp[3]); *(float4*)(d + 64) = make_float4(kp[0], kp[1], kp[2], kp[3]);
        *(float4*)(d + 128) = make_float4(bp[0], bp[1], bp[2], bp[3]); *(float4*)(d + 192) = make_float4(mp[0], mp[1], mp[2], mp[3]);
        *(float4*)(d + 256) = make_float4(r4[0], r4[1], r4[2], r4[3]);
        *(float4*)(d + 320) = make_float4(v4[0], v4[1], v4[2], v4[3]);
    };
    f32x2_ Sa = (f32x2_){0.f, 0.f}, Sb = (f32x2_){0.f, 0.f};
    auto compute = [&](int cidx, int cur, const RwRaw& rs, bool do_stage) {
        float sr4[4], sk4[4], sv4[4], skkr[4], srn = 0.f;
        const float* cb = buf + cur * RW_CT * 384 + lc * 4;
        const float* vb = buf + cur * RW_CT * 384 + 320 + rg * 16 + li;
        const bool yb0 = (lc & 4) == 0, yb1 = (lc & 2) == 0, yb2 = (lc & 1) == 0, yb3 = (lc & 8) == 0;
        float yq0 = 0.f, yq1 = 0.f, yq2 = 0.f, yq3 = 0.f, ykeep = 0.f;
        f32x4 w[2], kk[2], bb[2], km[2], rr[2]; float vv[2];
        w[0] = *(const f32x4*)(cb); kk[0] = *(const f32x4*)(cb + 64); bb[0] = *(const f32x4*)(cb + 128); km[0] = *(const f32x4*)(cb + 192); rr[0] = *(const f32x4*)(cb + 256);
        vv[0] = vb[0];
#pragma unroll
        for (int j = 0; j < RW_CT; ++j) {
            const int c0 = j & 1, c2 = c0 ^ 1;
            if (j + 1 < RW_CT) {
                const float* nb = cb + (j + 1) * 384;
                w[c2] = *(const f32x4*)(nb); kk[c2] = *(const f32x4*)(nb + 64); bb[c2] = *(const f32x4*)(nb + 128); km[c2] = *(const f32x4*)(nb + 192); rr[c2] = *(const f32x4*)(nb + 256);
                vv[c2] = vb[(j + 1) * 384];
            }
            const f32x2_ v2 = (f32x2_){vv[c0], vv[c0]};
            const f32x2_ pa = __builtin_elementwise_fma(Sb, kk[c0].zw, Sa * kk[c0].xy);
            const f32x2_ ta = __builtin_elementwise_fma(Sa, w[c0].xy, v2 * km[c0].xy), tb = __builtin_elementwise_fma(Sb, w[c0].zw, v2 * km[c0].zw);
            const float sa = row16_sum(fadd_(pa.x, pa.y));
            const f32x2_ nsa = (f32x2_){-sa, -sa};
            Sa = __builtin_elementwise_fma(nsa, bb[c0].xy, ta); Sb = __builtin_elementwise_fma(nsa, bb[c0].zw, tb);
            const f32x2_ py = __builtin_elementwise_fma(Sb, rr[c0].zw, Sa * rr[c0].xy);
            {
                float c = fadd_(py.x, py.y);
                if (j & 1) {
                    { const float t = yb0 ? yq0 : c, u = yb0 ? c : yq0; c = t + __int_as_float(__builtin_amdgcn_mov_dpp(__float_as_int(u), 0x141, 0xf, 0xf, true)); }
                    if (j & 2) {
                        { const float t = yb1 ? yq1 : c, u = yb1 ? c : yq1; c = t + __int_as_float(__builtin_amdgcn_mov_dpp(__float_as_int(u), 0x4E, 0xf, 0xf, true)); }
                        if (j & 4) {
                            { const float t = yb2 ? yq2 : c, u = yb2 ? c : yq2; c = t + __int_as_float(__builtin_amdgcn_mov_dpp(__float_as_int(u), 0xB1, 0xf, 0xf, true)); }
                            if (j & 8) {
                                const float t = yb3 ? yq3 : c, u = yb3 ? c : yq3; ykeep = t + __int_as_float(__builtin_amdgcn_mov_dpp(__float_as_int(u), 0x128, 0xf, 0xf, true));
                            } else yq3 = c;
                        } else yq2 = c;
                    } else yq1 = c;
                } else yq0 = c;
            }
            if (j == 2) { mix4(rs.r, mur, rs.fp, rs.fn, sr4); }
            if (j == 5) { mix4(rs.k, muk, rs.fp, rs.fn, sk4); }
            if (j == 8) { mix4(rs.v, muv, rs.fp, rs.fn, sv4); }
            if (j == 11) {
                skkr[0] = sk4[0] * kk4.x; skkr[1] = sk4[1] * kk4.y; skkr[2] = sk4[2] * kk4.z; skkr[3] = sk4[3] * kk4.w;
                float nn = skkr[0] * skkr[0] + skkr[1] * skkr[1] + skkr[2] * skkr[2] + skkr[3] * skkr[3];
                nn = row16_sum(nn);
                srn = 1.f / fmaxf(sqrtf(nn), 1e-12f);
            }
        }
        if (do_stage) {
            const float a[4] = { bflo(rs.a.x), bfhi(rs.a.x), bflo(rs.a.y), bfhi(rs.a.y) };
            const float sd[4] = { bflo(rs.sd.x), bfhi(rs.sd.x), bflo(rs.sd.y), bfhi(rs.sd.y) };
            const float kav[4] = { ka4.x, ka4.y, ka4.z, ka4.w };
            float* d = buf + ((cur ^ 1) * RW_CT + li) * 384 + lc * 4;
            float wp[4], kp[4], bp[4], mp[4];
#pragma unroll
            for (int q = 0; q < 4; ++q) {
                wp[q] = __expf(-sd[q]);
                kp[q] = skkr[q] * srn;
                bp[q] = kp[q] * a[q];
                mp[q] = sk4[q] * (1.f + (a[q] - 1.f) * kav[q]);
            }
            *(float4*)(d + 0) = make_float4(wp[0], wp[1], wp[2], wp[3]); *(float4*)(d + 64) = make_float4(kp[0], kp[1], kp[2], kp[3]);
            *(float4*)(d + 128) = make_float4(bp[0], bp[1], bp[2], bp[3]); *(float4*)(d + 192) = make_float4(mp[0], mp[1], mp[2], mp[3]);
            *(float4*)(d + 256) = make_float4(sr4[0], sr4[1], sr4[2], sr4[3]);
            *(float4*)(d + 320) = make_float4(sv4[0], sv4[1], sv4[2], sv4[3]);
        }
        {
            const int ys = ((lc >> 2) & 1) | (lc & 2) | ((lc & 1) << 2) | (lc & 8);
            int n, len; const int t = tok_of(cidx, ys, n, len);
            RWY[(size_t)t * 256 + head * 64 + rg * 16 + li] = f2bf(ykeep);
        }
    };
    RwRaw rawA, rawB;
    __syncthreads();
    load_raw(0, rawA);
    stage(0, rawA);
    load_raw(1, rawA);
    __syncthreads();
    for (int cidx = 0; cidx < NCH; cidx += 2) {
        load_raw(min(cidx + 2, NCH - 1), rawB);
        compute(cidx, 0, rawA, true);
        __syncthreads();
        load_raw(min(cidx + 3, NCH - 1), rawA);
        compute(cidx + 1, 1, rawB, cidx + 2 < NCH);
        __syncthreads();
    }
}

DEV void rw_item(const Params& p, int l, int item, char* smem, int rep = 0) {
    rw_item_t<RWVAR>(p, l, item, smem, rep);
}
constexpr int RC = 32, SK = 72, ST = 40;
constexpr int L_K1 = 0, L_R1 = L_K1 + RC * SK, L_B1 = L_R1 + RC * SK, L_M1 = L_B1 + RC * SK,
              L_VT = L_M1 + RC * SK, L_B2T = L_VT + 64 * ST, L_M2T = L_B2T + 64 * ST,
              L_X = L_M2T + 64 * ST, L_XT = L_X + RC * ST, L_PA = L_XT + RC * ST, L_BM = L_PA + RC * ST, L_AR = L_BM + RC * ST, L_BR = L_AR + RC * ST,
              L_ET = L_BR + RC * ST, L_ZT = L_ET + 64 * ST, L_S = L_ZT + 64 * ST, L_RWEND = L_S + 64 * SK;
static_assert(L_RWEND * 2 + 256 <= 73728, "RWKV chunk LDS");
DEV bf16x8 ldfrag(const bf16_t* m, int stride, int row0, int k0, int lane) { return *(const bf16x8*)(m + (row0 + (lane & 15)) * stride + k0 + (lane >> 4) * 8); }
DEV f32x4 mfma16(bf16x8 a, bf16x8 b, f32x4 c) { return __builtin_amdgcn_mfma_f32_16x16x32_bf16(a, b, c, 0, 0, 0); }
#ifndef RWC_CLAMP
#define RWC_CLAMP 0
#endif
DEV void st4(bf16_t* dst, f32x4 v) {
    if (RWC_CLAMP) { for (int i = 0; i < 4; ++i) v[i] = fminf(fmaxf(v[i], -8.f), 8.f); } u32x2 o; o.x = pack2(v[0], v[1]); o.y = pack2(v[2], v[3]); *(u32x2*)dst = o; }
DEV void unpack8(const u32x4 u, float (&o)[8]) {
    o[0] = bflo(u[0]); o[1] = bfhi(u[0]); o[2] = bflo(u[1]); o[3] = bfhi(u[1]); o[4] = bflo(u[2]); o[5] = bfhi(u[2]); o[6] = bflo(u[3]); o[7] = bfhi(u[3]);
}
DEV u32x4 pack8(const float (&v)[8]) { return (u32x4){pack2(v[0], v[1]), pack2(v[2], v[3]), pack2(v[4], v[5]), pack2(v[6], v[7])}; }
struct RwcRaw { u32x4 r[3], k[3], v[3], sd, a; float fp, fn; };
#ifndef RWC_STOP
#define RWC_STOP 99
#endif
#ifndef RWC_DUMMY
#define RWC_DUMMY 0
#endif
#ifdef RWC_NOINLINE
__device__ __attribute__((noinline)) void rwc_item(const Params& p, int l, int chain, char* smem) {
#else
DEV void rwc_item(const Params& p, int l, int chain, char* smem) {
#endif
    const int tid = tidx(), lane = tid & 63, wave = __builtin_amdgcn_readfirstlane(tid >> 6), c16 = lane & 15, q4 = lane >> 4;
    const int dir = chain >> 5, b = (chain >> 2) & 7, head = chain & 3;
    bf16_t* L = (bf16_t*)smem;
    float* PC = (float*)(smem + L_RWEND * 2);
    float* CS = (float*)(L + L_ET);
    const bf16_t* P = wsb(p, OFF_P);
    const bf16_t* RWX = wsb(p, OFF_RWX);
    bf16_t* RWY = wsb(p, OFF_RWY) + (size_t)dir * TT * 256 + (RWC_DUMMY ? (size_t)2 * TT * 256 : 0);
    const int li = tid >> 3, c8 = (tid & 7) * 8, hc = head * 64 + c8;
    const int NCHK = (CTXL + SEQ) / RC;
    auto tok_of = [&](int c, int i, int& n, int& len) -> int {
        if (c < CTXL / RC) { const int pos = c * RC + i; len = CTXL; n = dir == 0 ? pos : CTXL - 1 - pos; return TL + b * CTXL + n; }
        const int pos = (c - CTXL / RC) * RC + i; len = SEQ; n = dir == 0 ? pos : SEQ - 1 - pos; return b * SEQ + n;
    };
    RwcRaw raw;
    auto load_raw = [&](int c) {
        int n, len; const int t = tok_of(c, li, n, len);
        const bf16_t* row = P + (size_t)t * LDP;
        const bool hp = n > 0, hn = n + 1 < len;
        const bf16_t* rp = hp ? row - LDP : row;
        const bf16_t* rn = hn ? row + LDP : row;
        raw.fp = hp ? 0.5f : 0.f; raw.fn = hn ? 0.5f : 0.f;
        raw.r[1] = *(const u32x4*)(row + C_RWR + hc); raw.k[1] = *(const u32x4*)(row + C_RWK + hc); raw.v[1] = *(const u32x4*)(row + C_RWV + hc);
        raw.r[0] = *(const u32x4*)(rp + C_RWR + hc); raw.k[0] = *(const u32x4*)(rp + C_RWK + hc); raw.v[0] = *(const u32x4*)(rp + C_RWV + hc);
        raw.r[2] = *(const u32x4*)(rn + C_RWR + hc); raw.k[2] = *(const u32x4*)(rn + C_RWK + hc); raw.v[2] = *(const u32x4*)(rn + C_RWV + hc);
        raw.sd = *(const u32x4*)(RWX + (size_t)t * 1024 + dir * 256 + hc);
        raw.a = *(const u32x4*)(RWX + (size_t)t * 1024 + 512 + dir * 256 + hc);
    };
    auto mix8 = [&](const u32x4 (&s)[3], const float* mu, float (&o)[8]) {
        float x[8], pv[8], nx[8]; unpack8(s[1], x); unpack8(s[0], pv); unpack8(s[2], nx);
        const float4 m0 = *(const float4*)mu, m1 = *(const float4*)(mu + 4);
        const float m[8] = { m0.x, m0.y, m0.z, m0.w, m1.x, m1.y, m1.z, m1.w };
#pragma unroll
        for (int j = 0; j < 8; ++j) o[j] = x[j] + ((raw.fp * pv[j] + raw.fn * nx[j]) - x[j]) * m[j];
    };
    f32x4 Wt[4];
#pragma unroll
    for (int j = 0; j < 4; ++j) Wt[j] = (f32x4){0.f, 0.f, 0.f, 0.f};
    __syncthreads();
    for (int i = tid; i < 64 * SK / 2; i += NT) ((unsigned*)(L + L_S))[i] = 0u;
    load_raw(0);
    for (int c = 0; c < (RWC_STOP == 0 ? 0 : NCHK); ++c) {
        {
            float r8[8], k8[8], v8[8], a8[8], sd8[8];
            mix8(raw.r, inp(p, I_RMU) + (l * 4 + 0) * 256 + hc, r8);
            mix8(raw.k, inp(p, I_RMU) + (l * 4 + 1) * 256 + hc, k8);
            mix8(raw.v, inp(p, I_RMU) + (l * 4 + 2) * 256 + hc, v8);
            unpack8(raw.a, a8); unpack8(raw.sd, sd8);
            if (c + 1 < NCHK) load_raw(c + 1);
            const float4 kk0 = *(const float4*)(inp(p, I_RKK) + l * 256 + hc), kk1 = *(const float4*)(inp(p, I_RKK) + l * 256 + hc + 4);
            const float4 ka0 = *(const float4*)(inp(p, I_RKA) + l * 256 + hc), ka1 = *(const float4*)(inp(p, I_RKA) + l * 256 + hc + 4);
            const float kkc[8] = { kk0.x, kk0.y, kk0.z, kk0.w, kk1.x, kk1.y, kk1.z, kk1.w };
            const float kac[8] = { ka0.x, ka0.y, ka0.z, ka0.w, ka1.x, ka1.y, ka1.z, ka1.w };
            float kkv[8], bbv[8], kmv[8]; float n2 = 0.f;
#pragma unroll
            for (int j = 0; j < 8; ++j) { kkv[j] = k8[j] * kkc[j]; n2 += kkv[j] * kkv[j]; }
            n2 = row8_sum(n2);
            const float rn = 1.f / fmaxf(sqrtf(n2), 1e-12f);
#pragma unroll
            for (int j = 0; j < 8; ++j) { kkv[j] *= rn; bbv[j] = kkv[j] * a8[j]; kmv[j] = k8[j] * (1.f + (a8[j] - 1.f) * kac[j]); }
            *(float4*)(CS + li * 64 + c8) = make_float4(sd8[0], sd8[1], sd8[2], sd8[3]);
            *(float4*)(CS + li * 64 + c8 + 4) = make_float4(sd8[4], sd8[5], sd8[6], sd8[7]);
            __syncthreads();
            if (tid < 64) { float run = 0.f; for (int i = 0; i < RC; ++i) { run += CS[i * 64 + tid]; CS[i * 64 + tid] = run; } }
            __syncthreads();
            float cs[8], tot[8];
            { const float4 a0 = *(const float4*)(CS + li * 64 + c8), a1 = *(const float4*)(CS + li * 64 + c8 + 4);
              const float4 t0 = *(const float4*)(CS + (RC - 1) * 64 + c8), t1 = *(const float4*)(CS + (RC - 1) * 64 + c8 + 4);
              cs[0] = a0.x; cs[1] = a0.y; cs[2] = a0.z; cs[3] = a0.w; cs[4] = a1.x; cs[5] = a1.y; cs[6] = a1.z; cs[7] = a1.w;
              tot[0] = t0.x; tot[1] = t0.y; tot[2] = t0.z; tot[3] = t0.w; tot[4] = t1.x; tot[5] = t1.y; tot[6] = t1.z; tot[7] = t1.w; }
            float k1[8], r1[8], b1[8], m1[8], b2[8], m2[8];
#pragma unroll
            for (int j = 0; j < 8; ++j) {
                const float pinc = __expf(-cs[j]), pexc = __expf(sd8[j] - cs[j]), einv = __expf(cs[j]), ec = __expf(cs[j] - tot[j]);
                k1[j] = kkv[j] * pexc; r1[j] = r8[j] * pinc; b1[j] = bbv[j] * einv; m1[j] = kmv[j] * einv; b2[j] = bbv[j] * ec; m2[j] = kmv[j] * ec;
            }
            __syncthreads();
            *(u32x4*)(L + L_K1 + li * SK + c8) = pack8(k1); *(u32x4*)(L + L_R1 + li * SK + c8) = pack8(r1);
            *(u32x4*)(L + L_B1 + li * SK + c8) = pack8(b1); *(u32x4*)(L + L_M1 + li * SK + c8) = pack8(m1);
#pragma unroll
            for (int j = 0; j < 8; ++j) {
                L[L_VT + (c8 + j) * ST + li] = f2bf(v8[j]); L[L_B2T + (c8 + j) * ST + li] = f2bf(b2[j]); L[L_M2T + (c8 + j) * ST + li] = f2bf(m2[j]);
            }
            if (li == RC - 1) {
#pragma unroll
                for (int j = 0; j < 8; ++j) PC[c8 + j] = __expf(-tot[j]);
            }
            __syncthreads();
        }
        if (RWC_STOP <= 1) continue;
        {
            const int i0 = wave >> 1, j0 = wave & 1;
            const f32x4 z4 = (f32x4){0.f, 0.f, 0.f, 0.f};
            f32x4 aS = z4, aU = z4, bm = z4, ar = z4, br = z4;
#pragma unroll
            for (int kk2 = 0; kk2 < 2; ++kk2) {
                const bf16x8 k1i = ldfrag(L + L_K1, SK, i0 * 16, kk2 * 32, lane), k1j = ldfrag(L + L_K1, SK, j0 * 16, kk2 * 32, lane);
                const bf16x8 b1i = ldfrag(L + L_B1, SK, i0 * 16, kk2 * 32, lane), b1j = ldfrag(L + L_B1, SK, j0 * 16, kk2 * 32, lane);
                const bf16x8 m1i = ldfrag(L + L_M1, SK, i0 * 16, kk2 * 32, lane), r1j = ldfrag(L + L_R1, SK, j0 * 16, kk2 * 32, lane);
                aS = mfma16(b1i, k1j, aS);
                aU = mfma16(k1i, b1j, aU);
                bm = mfma16(m1i, k1j, bm);
                ar = mfma16(b1i, r1j, ar);
                br = mfma16(m1i, r1j, br);
            }
#ifdef RWC_WAIT
            __builtin_amdgcn_sched_barrier(0); __builtin_amdgcn_s_sleep(2); __builtin_amdgcn_sched_barrier(0);
#endif
            {
                const int t = j0 * 16 + c16, s0 = i0 * 16 + q4 * 4;
                f32x4 x, pa, o1, o2, o3;
#pragma unroll
                for (int r = 0; r < 4; ++r) {
                    const bool lt = s0 + r < t, le = s0 + r <= t;
                    x[r] = lt ? -aS[r] : 0.f; pa[r] = x[r] + ((s0 + r == t) ? 1.f : 0.f);
                    o1[r] = lt ? bm[r] : 0.f; o2[r] = le ? ar[r] : 0.f; o3[r] = le ? br[r] : 0.f;
                }
#ifdef RWC_GSTORE
                { bf16_t* gd = wsb(p, OFF_RWY) + (size_t)2 * TT * 256 + (size_t)(bidx() * 256 + tid) * 32;
                  st4(gd, x); st4(gd + 4, pa); st4(gd + 8, o1); st4(gd + 12, o2); st4(gd + 16, o3); }
#else
                st4(L + L_X + t * ST + s0, x); st4(L + L_PA + t * ST + s0, pa);
                st4(L + L_BM + t * ST + s0, o1); st4(L + L_AR + t * ST + s0, o2); st4(L + L_BR + t * ST + s0, o3);
#endif
            }
            {
                const int s = j0 * 16 + c16, t0 = i0 * 16 + q4 * 4;
                f32x4 o;
#pragma unroll
                for (int r = 0; r < 4; ++r) o[r] = (s < t0 + r) ? -aU[r] : 0.f;
#ifdef RWC_GSTORE
                st4(wsb(p, OFF_RWY) + (size_t)2 * TT * 256 + (size_t)(bidx() * 256 + tid) * 32 + 20, o);
#else
                st4(L + L_XT + s * ST + t0, o);
#endif
            }
            __syncthreads();
        }
        if (RWC_STOP <= 2) continue;
#pragma unroll 1
        for (int rd = 1; rd <= 5; ++rd) {
            const bool sq = rd <= 4, up = rd >= 2;
            const int i0 = wave >> 1, j0 = wave & 1;
            const bf16x8 xti = ldfrag(L + L_XT, ST, i0 * 16, 0, lane), xtj = ldfrag(L + L_XT, ST, j0 * 16, 0, lane);
            const bf16x8 xi = ldfrag(L + L_X, ST, i0 * 16, 0, lane), xj = ldfrag(L + L_X, ST, j0 * 16, 0, lane);
            const bf16x8 paj = ldfrag(L + L_PA, ST, j0 * 16, 0, lane);
            const u32x2 old = *(const u32x2*)(L + L_PA + (j0 * 16 + c16) * ST + i0 * 16 + q4 * 4);
            __syncthreads();
            const f32x4 z4 = (f32x4){0.f, 0.f, 0.f, 0.f};
            if (sq) {
                const f32x4 nx = mfma16(xti, xj, z4);
                const f32x4 nxt = mfma16(xi, xtj, z4);
                st4(L + L_X + (j0 * 16 + c16) * ST + i0 * 16 + q4 * 4, nx);
                st4(L + L_XT + (j0 * 16 + c16) * ST + i0 * 16 + q4 * 4, nxt);
            }
            if (up) {
                f32x4 acc = (f32x4){bflo(old.x), bfhi(old.x), bflo(old.y), bfhi(old.y)};
                acc = mfma16(xti, paj, acc);
                st4(L + L_PA + (j0 * 16 + c16) * ST + i0 * 16 + q4 * 4, acc);
            }
            __syncthreads();
        }
        if (RWC_STOP <= 3) continue;
        {
            const int vj = wave;
#pragma unroll
            for (int ti = 0; ti < 2; ++ti) {
                f32x4 acc = mfma16(ldfrag(L + L_BM, ST, ti * 16, 0, lane), ldfrag(L + L_VT, ST, vj * 16, 0, lane), (f32x4){0.f, 0.f, 0.f, 0.f});
#pragma unroll
                for (int kk2 = 0; kk2 < 2; ++kk2) acc = mfma16(ldfrag(L + L_K1, SK, ti * 16, kk2 * 32, lane), ldfrag(L + L_S, SK, vj * 16, kk2 * 32, lane), acc);
                st4(L + L_ET + (vj * 16 + c16) * ST + ti * 16 + q4 * 4, acc);
            }
            __syncthreads();
#pragma unroll
            for (int ti = 0; ti < 2; ++ti) {
                const f32x4 acc = mfma16(ldfrag(L + L_PA, ST, ti * 16, 0, lane), ldfrag(L + L_ET, ST, vj * 16, 0, lane), (f32x4){0.f, 0.f, 0.f, 0.f});
                st4(L + L_ZT + (vj * 16 + c16) * ST + ti * 16 + q4 * 4, -acc);
            }
            __syncthreads();
        }
        if (RWC_STOP <= 4) continue;
        {
            const int vi = wave;
#pragma unroll
            for (int tj = 0; tj < 2; ++tj) {
                f32x4 acc = (f32x4){0.f, 0.f, 0.f, 0.f};
#pragma unroll
                for (int kk2 = 0; kk2 < 2; ++kk2) acc = mfma16(ldfrag(L + L_S, SK, vi * 16, kk2 * 32, lane), ldfrag(L + L_R1, SK, tj * 16, kk2 * 32, lane), acc);
                acc = mfma16(ldfrag(L + L_ZT, ST, vi * 16, 0, lane), ldfrag(L + L_AR, ST, tj * 16, 0, lane), acc);
                acc = mfma16(ldfrag(L + L_VT, ST, vi * 16, 0, lane), ldfrag(L + L_BR, ST, tj * 16, 0, lane), acc);
                int n, len; const int t = tok_of(c, tj * 16 + c16, n, len);
                u32x2 o; o.x = pack2(acc[0], acc[1]); o.y = pack2(acc[2], acc[3]);
#ifndef RWC_NOYSTORE
                *(u32x2*)(RWY + (size_t)t * 256 + head * 64 + vi * 16 + q4 * 4) = o;
#else
                asm volatile("" :: "v"(o), "v"(t));
#endif
            }
            const float4 pc = *(const float4*)(PC + wave * 16 + q4 * 4);
            const bf16x8 fb2 = ldfrag(L + L_B2T, ST, wave * 16, 0, lane), fm2 = ldfrag(L + L_M2T, ST, wave * 16, 0, lane);
#pragma unroll
            for (int vj = 0; vj < 4; ++vj) {
                f32x4 acc = Wt[vj];
                acc[0] *= pc.x; acc[1] *= pc.y; acc[2] *= pc.z; acc[3] *= pc.w;
                acc = mfma16(fb2, ldfrag(L + L_ZT, ST, vj * 16, 0, lane), acc);
                acc = mfma16(fm2, ldfrag(L + L_VT, ST, vj * 16, 0, lane), acc);
                Wt[vj] = acc;
            }
            __syncthreads();
#pragma unroll
            for (int vj = 0; vj < 4; ++vj) st4(L + L_S + (vj * 16 + c16) * SK + wave * 16 + q4 * 4, Wt[vj]);
        }
    }
    __syncthreads();
#ifdef RWC_ZERO_LDS
    for (int i = tid; i < 73728 / 4; i += NT) ((unsigned*)smem)[i] = 0u;
    __syncthreads();
#endif
}
DEV void phase_s5_glu(const Params& p, int l, int M, char* smem) {
    const bf16_t* P = wsb(p, OFF_P);
    const bf16_t* w = wsb(p, OFF_WSM) + (size_t)l * WS_PER_LAYER + WS_GLUT;
    bf16_t* Y = wsb(p, OFF_Y);
    const float* bg = inp(p, I_S5BGLU) + l * 256;
    gemm_generic(P + C_S5, LDP, M, w, 256, 256, 256,
                 [&](int r, int c, float v) { const float z = bf2f(P[(size_t)r * LDP + C_S5 + c]); Y[(size_t)r * 1024 + 256 + c] = f2bf(z * sigmoidf_(v + bg[c])); }, smem, 0);
}
DEV void phase_rw_finish(const Params& p, int l, int M) {
    const int lane = tidx() & 63, wave = tidx() >> 6;
    const bf16_t* P = wsb(p, OFF_P);
    const bf16_t* RWX = wsb(p, OFF_RWX);
    const bf16_t* RWY = wsb(p, OFF_RWY);
    bf16_t* Y = wsb(p, OFF_Y);
    const int c = lane * 4;
    const float4 mur = *(const float4*)(inp(p, I_RMU) + (l * 4 + 0) * 256 + c);
    const float4 muk = *(const float4*)(inp(p, I_RMU) + (l * 4 + 1) * 256 + c);
    const float4 muv = *(const float4*)(inp(p, I_RMU) + (l * 4 + 2) * 256 + c);
    const float4 ka4 = *(const float4*)(inp(p, I_RKA) + l * 256 + c);
    const float4 rk4 = *(const float4*)(inp(p, I_RRK) + l * 256 + c);
    const float4 lg4 = *(const float4*)(inp(p, I_RLNG) + l * 256 + c);
    const float4 lb4 = *(const float4*)(inp(p, I_RLNB) + l * 256 + c);
    const float mr_[4] = { mur.x, mur.y, mur.z, mur.w }, mk_[4] = { muk.x, muk.y, muk.z, muk.w }, mv_[4] = { muv.x, muv.y, muv.z, muv.w };
    const float ka_[4] = { ka4.x, ka4.y, ka4.z, ka4.w }, rk_[4] = { rk4.x, rk4.y, rk4.z, rk4.w }, lg_[4] = { lg4.x, lg4.y, lg4.z, lg4.w }, lb_[4] = { lb4.x, lb4.y, lb4.z, lb4.w };
    for (int t = bidx() * 4 + wave; t < M; t += gridDim.x * 4) {
        int base, n, len; tok_seq(t, base, n, len);
        const bf16_t* row = P + (size_t)t * LDP;
        const bool hp = n > 0, hn = n + 1 < len;
        const u32x2 z = (u32x2){0u, 0u};
        float r4[4], k4[4], v4[4];
        {
            const u32x2 cu = *(const u32x2*)(row + C_RWR + c), pv = hp ? *(const u32x2*)(row - LDP + C_RWR + c) : z, nx = hn ? *(const u32x2*)(row + LDP + C_RWR + c) : z;
            const float x[4] = { bflo(cu.x), bfhi(cu.x), bflo(cu.y), bfhi(cu.y) }, a[4] = { bflo(pv.x), bfhi(pv.x), bflo(pv.y), bfhi(pv.y) }, b[4] = { bflo(nx.x), bfhi(nx.x), bflo(nx.y), bfhi(nx.y) };
#pragma unroll
            for (int j = 0; j < 4; ++j) r4[j] = x[j] + (0.5f * (a[j] + b[j]) - x[j]) * mr_[j];
        }
        {
            const u32x2 cu = *(const u32x2*)(row + C_RWK + c), pv = hp ? *(const u32x2*)(row - LDP + C_RWK + c) : z, nx = hn ? *(const u32x2*)(row + LDP + C_RWK + c) : z;
            const float x[4] = { bflo(cu.x), bfhi(cu.x), bflo(cu.y), bfhi(cu.y) }, a[4] = { bflo(pv.x), bfhi(pv.x), bflo(pv.y), bfhi(pv.y) }, b[4] = { bflo(nx.x), bfhi(nx.x), bflo(nx.y), bfhi(nx.y) };
#pragma unroll
            for (int j = 0; j < 4; ++j) k4[j] = x[j] + (0.5f * (a[j] + b[j]) - x[j]) * mk_[j];
        }
        {
            const u32x2 cu = *(const u32x2*)(row + C_RWV + c), pv = hp ? *(const u32x2*)(row - LDP + C_RWV + c) : z, nx = hn ? *(const u32x2*)(row + LDP + C_RWV + c) : z;
            const float x[4] = { bflo(cu.x), bfhi(cu.x), bflo(cu.y), bfhi(cu.y) }, a[4] = { bflo(pv.x), bfhi(pv.x), bflo(pv.y), bfhi(pv.y) }, b[4] = { bflo(nx.x), bfhi(nx.x), bflo(nx.y), bfhi(nx.y) };
#pragma unroll
            for (int j = 0; j < 4; ++j) v4[j] = x[j] + (0.5f * (a[j] + b[j]) - x[j]) * mv_[j];
        }
        const u32x2 af = *(const u32x2*)(RWX + (size_t)t * 1024 + 512 + c), ab = *(const u32x2*)(RWX + (size_t)t * 1024 + 768 + c);
        const float a0[4] = { bflo(af.x), bfhi(af.x), bflo(af.y), bfhi(af.y) }, a1[4] = { bflo(ab.x), bfhi(ab.x), bflo(ab.y), bfhi(ab.y) };
        const u32x2 yf = *(const u32x2*)(RWY + (size_t)t * 256 + c), yb = *(const u32x2*)(RWY + (size_t)TT * 256 + (size_t)t * 256 + c);
        float y[4] = { bflo(yf.x) + bflo(yb.x), bfhi(yf.x) + bfhi(yb.x), bflo(yf.y) + bflo(yb.y), bfhi(yf.y) + bfhi(yb.y) };
        float s = y[0] + y[1] + y[2] + y[3];
        s = group_sum<16>(s);
        const float mean = s * (1.f / 64.f);
        float q = 0.f, bon = 0.f;
#pragma unroll
        for (int j = 0; j < 4; ++j) {
            const float dlt = y[j] - mean; q += dlt * dlt;
            const float kmsum = k4[j] * (2.f + (a0[j] + a1[j] - 2.f) * ka_[j]);
            bon += r4[j] * kmsum * rk_[j];
        }
        q = group_sum<16>(q); bon = group_sum<16>(bon);
        const float rstd = rsqrtf(q * (1.f / 64.f) + 64e-5f);
        const u32x2 gg = *(const u32x2*)(row + C_RWD + c);
        const float g[4] = { bflo(gg.x), bfhi(gg.x), bflo(gg.y), bfhi(gg.y) };
        float o[4];
#pragma unroll
        for (int j = 0; j < 4; ++j) o[j] = ((y[j] - mean) * rstd * lg_[j] + lb_[j] + bon * v4[j]) * g[j];
        u32x2 ov; ov.x = pack2(o[0], o[1]); ov.y = pack2(o[2], o[3]);
        *(u32x2*)(Y + (size_t)t * 1024 + 768 + c) = ov;
    }
}

DEV int queue_next(int* ctr, char* smem) {
    int* slot = (int*)(smem + MOE_MAP_OFF + 208);
    __syncthreads();
    if (tidx() == 0) *slot = atomicAdd(ctr, 1);
    __syncthreads();
    return __builtin_amdgcn_readfirstlane(*slot);
}
DEV void phase_mixers(const Params& p, int l, int rep, char* smem) {
    const bool need_ctx = (l == 0);
#ifndef RWMODE
#define RWMODE 2
#endif
    const int nrw = RWMODE == 0 ? 64 : (RWMODE == 1 ? 256 + 64 : 256), nda = need_ctx ? 576 : 512, ns5 = 32 * (need_ctx ? 9 : 8);
    const int total = nrw + 2 * nda + (rep == 0 ? ns5 : 0);
    int* ctr = (int*)(wsp(p) + OFF_CTR) + CTR_Q + l * 16 + rep * 4;
    for (;;) {
        const int item = queue_next(ctr, smem);
        if (item >= total) break;
#ifndef PROBE7
#define PROBE7 0
#endif
        if (rep > 0 && PROBE7 == 1 && item >= nrw) break;
        if (rep > 0 && PROBE7 == 2 && item < nrw) continue;
        if (rep > 0 && PROBE7 == 3 && (item < nrw || item >= nrw + nda)) continue;
#if RWMODE == 2
        if (item < nrw) rw_item(p, l, item, smem, 0);
#elif RWMODE == 0
        if (item < nrw) rwc_item(p, l, item, smem);
#else
        if (item < nrw) { if (item < 256) rw_item(p, l, item, smem, 0); else rwc_item(p, l, item - 256, smem); }
#endif
        else if (item < nrw + nda) da_item(p, l, item - nrw, smem);
        else if (item < nrw + 2 * nda) mla_item(p, l, item - nrw - nda, smem);
        else s5_pass2_item(p, l, need_ctx ? 0 : 1, item - nrw - 2 * nda, smem);
    }
}
#ifndef MEGA
#define MEGA 0
#endif
constexpr int NPHASE = 15;
template <int PH>
DEV void run_phase(const Params& p, int l, char* smem) {
    asm volatile("" : "+s"(l));
    const bool need_ctx = (l == 0);
    const int M = need_ctx ? TT : TL;
    if constexpr (PH == 0) { phase_mod_partial(p, smem); __syncthreads(); phase_conv_small(p, smem); phase_conv_layer(p, 0, smem); phase_conv_experts(p, 0, smem); }
    if constexpr (PH == 1) { phase_mod_reduce(p); }
    if constexpr (PH == 2) { phase_norm<1>(p, l, TT, smem, l == 1); if (l == 1) { phase_conv_layer(p, 1, smem); phase_conv_experts(p, 1, smem); } }
    if constexpr (PH == 3) { phase_inproj(p, l, smem); }
    if constexpr (PH == 4) { phase_prep1(p, l); phase_s5_pass1(p, l, smem); }
    if constexpr (PH == 5) { phase_prep_gemm1(p, l, smem); }
    if constexpr (PH == 6) { phase_prep_gemm2(p, l, smem); phase_prep2(p, l); }
    if constexpr (PH == 7) { phase_mixers(p, l, 0, smem); }
    if constexpr (PH == 8) { phase_s5_glu(p, l, M, smem); phase_rw_finish(p, l, M); }
    if constexpr (PH == 9) { phase_merge(p, l, M, smem); }
    if constexpr (PH == 10) { phase_outproj(p, l, M, smem); }
    if constexpr (PH == 11) { phase_norm<2>(p, l, M, smem); }
    if constexpr (PH == 14) { phase_route(p, l, M, smem); }
    if constexpr (PH == 15) { phase_combine(p, l, M); }
    if constexpr (PH == 12) { phase_moe1(p, l, smem); }
    if constexpr (PH == 13) { phase_moe2(p, l, smem); }
}

#if !MEGA
template <int PH>
__global__ void __launch_bounds__(NT, 2) k_phase(Params p, int l) {
    extern __shared__ __attribute__((aligned(16))) char smem[];
    run_phase<PH>(p, l, smem);
}
#endif
#ifndef REP0
#define REP0 1
#endif
#ifndef REP2
#define REP2 1
#endif
#ifndef REP3
#define REP3 1
#endif
#ifndef REP5
#define REP5 1
#endif
#ifndef REP6
#define REP6 1
#endif
#ifndef REP7
#define REP7 1
#endif
#ifndef REP8
#define REP8 1
#endif
#ifndef REP9
#define REP9 1
#endif
#ifndef REP12
#define REP12 1
#endif
#if MEGA
__global__ void __launch_bounds__(NT, 2) k_mega(Params p) {
    extern __shared__ __attribute__((aligned(16))) char smem[];
    uint4* xbw = (uint4*)(smem + MOE_MAP_OFF + 240);
    if (threadIdx.x == 0) *xbw = make_uint4(0u, 0u, 0u, 0u);
    __syncthreads();
    XcdBarrier bar = xcd_barrier_post((unsigned*)(p.ws + OFF_BAR), (volatile LAS unsigned*)xbw);
    for (int r = 0; r < REP0; ++r) { run_phase<0>(p, 0, smem); xcd_barrier(bar); }
    run_phase<1>(p, 0, smem); xcd_barrier(bar);
    for (int l = 0; l < 2; ++l) {
        for (int r = 0; r < REP2; ++r) { run_phase<2>(p, l, smem); xcd_barrier(bar); }
        for (int r = 0; r < REP3; ++r) { run_phase<3>(p, l, smem); xcd_barrier(bar); }

        run_phase<4>(p, l, smem); xcd_barrier(bar);
#ifdef PROBE_S5P1
        phase_s5_pass1(p, l, smem); xcd_barrier(bar);
#endif
#ifdef PROBE_BAR
        for (int r = 0; r < PROBE_BAR; ++r) xcd_barrier(bar);
#endif
        for (int r = 0; r < REP5; ++r) { run_phase<5>(p, l, smem); xcd_barrier(bar); }
        for (int r = 0; r < REP6; ++r) { run_phase<6>(p, l, smem); xcd_barrier(bar); }
#ifdef RWC_PRE
        if (bidx() < 64) rwc_item(p, l, bidx(), smem);
#endif
        for (int r = 0; r < REP7; ++r) { int l7 = l; asm volatile("" : "+s"(l7)); phase_mixers(p, l7, r, smem); xcd_barrier(bar); }
#ifdef RWC_SEP
        for (int item = bidx(); item < 64; item += gridDim.x) rwc_item(p, l, item, smem);
        xcd_barrier(bar);
#endif
        for (int r = 0; r < REP8; ++r) { run_phase<8>(p, l, smem); xcd_barrier(bar); }
        for (int r = 0; r < REP9; ++r) { run_phase<9>(p, l, smem); xcd_barrier(bar); }
        run_phase<10>(p, l, smem); xcd_barrier(bar);
#ifdef PROBE_OUT2
        if (l == 0) { run_phase<10>(p, l, smem); xcd_barrier(bar); }
#endif

        run_phase<11>(p, l, smem); xcd_barrier(bar);
        run_phase<14>(p, l, smem); xcd_barrier(bar);
        for (int r = 0; r < REP12; ++r) { run_phase<12>(p, l, smem); xcd_barrier(bar); }
        run_phase<13>(p, l, smem); xcd_barrier(bar);
#ifdef PROBE_MOE2B
        run_phase<13>(p, l, smem); xcd_barrier(bar);
#endif
        if (l == 1) run_phase<15>(p, l, smem);
    }
}
#endif
__global__ void __launch_bounds__(NT) k_fail(float* out, int n) {
    for (int i = blockIdx.x * NT + threadIdx.x; i < n; i += gridDim.x * NT) out[i] = __int_as_float(0x7fc00000);
}

template <int PH>
static void launch_phase(const Params& p, int l, int grid, hipStream_t stream) {
#if !MEGA
    static bool attr = false;
    if (!attr) { (void)hipFuncSetAttribute((const void*)k_phase<PH>, hipFuncAttributeMaxDynamicSharedMemorySize, SMEM_BYTES); attr = true; }
    hipLaunchKernelGGL(k_phase<PH>, dim3(grid), dim3(NT), SMEM_BYTES, stream, p, l);
#endif
}

extern "C" void kernel_launch(void* const* d_in, const int* in_sizes, int n_in, void* d_out, int out_size, void* d_ws, size_t ws_size, hipStream_t stream) {
    if (n_in != 48 || out_size != TL * DM || ws_size < WS_END) {
        hipLaunchKernelGGL(k_fail, dim3(256), dim3(NT), 0, stream, (float*)d_out, out_size);
        return;
    }
    Params p{};
    for (int i = 0; i < 48; ++i) p.in[i] = (const float*)d_in[i];
    p.out = (float*)d_out; p.ws = (char*)d_ws;
    (void)hipMemsetAsync(d_ws, 0, ZERO_BYTES, stream);
#if MEGA
    static int grid = 0;
    if (grid == 0) {
        int dev = 0, cus = 0, per_cu = 0;
        (void)hipGetDevice(&dev);
        (void)hipDeviceGetAttribute(&cus, hipDeviceAttributeMultiprocessorCount, dev);
        (void)hipFuncSetAttribute((const void*)k_mega, hipFuncAttributeMaxDynamicSharedMemorySize, SMEM_BYTES);
        if (hipOccupancyMaxActiveBlocksPerMultiprocessor(&per_cu, (const void*)k_mega, NT, SMEM_BYTES) != hipSuccess || per_cu < 1) per_cu = 1;
        (void)hipGetLastError();
        if (cus <= 0) cus = 256;
        grid = cus * (per_cu < 2 ? per_cu : 2);
    }
    hipLaunchKernelGGL(k_mega, dim3(grid), dim3(NT), SMEM_BYTES, stream, p);
#else
    const int grid = 512;
    launch_phase<0>(p, 0, grid, stream);
    launch_phase<1>(p, 0, grid, stream);
    for (int l = 0; l < 2; ++l) {
        launch_phase<2>(p, l, grid, stream);
        launch_phase<3>(p, l, grid, stream);
        launch_phase<4>(p, l, grid, stream);
        launch_phase<5>(p, l, grid, stream);
        launch_phase<6>(p, l, grid, stream);
        launch_phase<7>(p, l, grid, stream);
        launch_phase<8>(p, l, grid, stream);
        launch_phase<9>(p, l, grid, stream);
        launch_phase<10>(p, l, grid, stream);
        launch_phase<11>(p, l, grid, stream);
        launch_phase<14>(p, l, grid, stream);
        launch_phase<12>(p, l, grid, stream);
        launch_phase<13>(p, l, grid, stream);
        launch_phase<15>(p, l, grid, stream);
    }
#endif
}
```

```cpp
#define MEGA 1
#include <hip/hip_runtime.h>
#include <stdint.h>
#include <math.h>

#define DEV __device__ __forceinline__
#define LAS __attribute__((address_space(3)))
typedef unsigned short bf16_t;
typedef short bf16x8 __attribute__((ext_vector_type(8)));
typedef float f32x16 __attribute__((ext_vector_type(16)));
typedef float f32x4 __attribute__((ext_vector_type(4)));
typedef unsigned u32x4 __attribute__((ext_vector_type(4)));
typedef unsigned u32x2 __attribute__((ext_vector_type(2)));

constexpr int NT = 256;
constexpr int DM = 1024, NB = 8, SEQ = 2048, CTXL = 256, GRIDW = 64;
constexpr int TL = NB * SEQ, TC = NB * CTXL, TT = TL + TC;
constexpr int NIN = 6480, LDP = 2432, NINP = 6528, NGATE0 = 2432;
constexpr int C_DAQ = 0, C_DAK = 256, C_DAV = 512, C_S5 = 768, C_CQ = 1024, C_CKV = 1216, C_KR = 1344,
              C_RWR = 1360, C_RWK = 1616, C_RWV = 1872, C_RWD = 2128, C_PEND = 2384;
constexpr int NEXP = 16, DFF = 512;
constexpr float EPS = 1e-6f;
constexpr float LOG2E = 1.4426950408889634f;

constexpr size_t al256(size_t x) { return (x + 255) & ~(size_t)255; }
constexpr size_t OFF_BAR  = 0;
constexpr size_t OFF_CTR  = 16384;
constexpr size_t ZERO_BYTES = 20480;
constexpr size_t OFF_MOD  = 32768;
constexpr size_t SZ_MOD   = (size_t)2 * 9 * 6144 * 4;
constexpr int    MOD_KS   = 8;
constexpr size_t OFF_MODP = al256(OFF_MOD + SZ_MOD);
constexpr size_t OFF_S5ST = al256(OFF_MODP + MOD_KS * SZ_MOD);
constexpr size_t OFF_LTOK = al256(OFF_S5ST + (size_t)2 * 8 * 16 * 8 * 64 * 2 * 4);
constexpr size_t OFF_LW   = al256(OFF_LTOK + (size_t)NEXP * TT * 4);
constexpr size_t OFF_TOKI = al256(OFF_LW + (size_t)NEXP * TT * 4);
constexpr size_t OFF_TOKW = al256(OFF_TOKI + (size_t)TT * 16);
constexpr size_t OFF_CNTB = al256(OFF_TOKW + (size_t)TT * 8);
constexpr size_t OFF_WSM  = al256(OFF_CNTB + (size_t)1024 * 16 * 4);
constexpr int WS_GLUT = 0, WS_UQT = WS_GLUT + 256 * 256, WS_UKVT = WS_UQT + 192 * 192, WS_W1C = WS_UKVT + 384 * 128,
              WS_W2 = WS_W1C + 192 * 256, WS_G2T = WS_W2 + 4 * 256 * 64, WS_PER_LAYER = WS_G2T + 256 * 64;
constexpr size_t OFF_WIN  = al256(OFF_WSM + (size_t)2 * WS_PER_LAYER * 2);
constexpr size_t OFF_WBR  = al256(OFF_WIN + (size_t)NINP * 1024 * 2);
constexpr size_t OFF_WOUT = al256(OFF_WBR + (size_t)4 * 1024 * 256 * 2);
constexpr size_t OFF_WG1  = al256(OFF_WOUT + (size_t)1024 * 1024 * 2);
constexpr size_t OFF_WDN  = al256(OFF_WG1 + (size_t)NEXP * 1024 * 1024 * 2);
constexpr size_t OFF_H    = al256(OFF_WDN + (size_t)NEXP * 1024 * 512 * 2);
constexpr size_t OFF_P    = al256(OFF_H + (size_t)TT * 1024 * 2);
constexpr size_t OFF_GATE = al256(OFF_P + (size_t)TT * LDP * 2);
constexpr size_t OFF_MLAQ = al256(OFF_GATE + (size_t)TT * 4096);
constexpr size_t OFF_MLAK = al256(OFF_MLAQ + (size_t)TT * 192 * 2);
constexpr size_t OFF_MLAV = al256(OFF_MLAK + (size_t)TT * 192 * 2);
constexpr size_t OFF_RWX  = al256(OFF_MLAV + (size_t)TT * 256 * 2);
constexpr size_t OFF_Y    = al256(OFF_RWX + (size_t)TT * 1024 * 2);
constexpr size_t OFF_CX   = al256(OFF_Y + (size_t)TT * 1024 * 2);
constexpr size_t OFF_S5Y  = al256(OFF_CX + (size_t)TC * 1024 * 4);
constexpr size_t WS_END   = al256(OFF_S5Y + (size_t)TT * 256 * 2);
constexpr size_t OFF_QRAW = OFF_Y;
constexpr size_t OFF_KVRAW = OFF_QRAW + (size_t)TT * 192 * 2;
constexpr size_t OFF_LR   = OFF_KVRAW + (size_t)TT * 384 * 2;
constexpr size_t OFF_XL   = OFF_LR + (size_t)TT * 192 * 2;
constexpr size_t OFF_Z    = OFF_GATE;
static_assert(OFF_XL + (size_t)TT * 256 * 2 <= OFF_Y + (size_t)TT * 1024 * 2, "temps overflow Y");
constexpr size_t OFF_RWY  = OFF_H;

constexpr int CTR_MOE = 0;
constexpr int CTR_Q   = 64;

constexpr int SMEM_BYTES = 73728 + 256;

struct Params {
    const float* in[48];
    float* out;
    char* ws;
};
enum { I_X = 0, I_C, I_CTX, I_CCTX, I_WADA, I_BADA, I_NMG, I_NFG, I_WIN, I_DAQKG, I_DALAM, I_DASUB,
       I_S5LRE, I_S5LIM, I_S5LDT, I_S5BRE, I_S5BIM, I_S5CRE, I_S5CIM, I_S5D, I_S5WGLU, I_S5BGLU,
       I_MCQG, I_MCKVG, I_MWUQ, I_MWUKV, I_MQKG,
       I_RMU, I_RW0, I_RW1, I_RW2, I_RA0, I_RA1, I_RA2, I_RG1, I_RG2, I_RKK, I_RKA, I_RRK, I_RLNG, I_RLNB,
       I_WBR, I_WOUT, I_ROUTW, I_ROUTB, I_EWG, I_EWU, I_EWD };

DEV int tidx() { int t = threadIdx.x; asm volatile("" : "+v"(t)); return t; }
DEV int bidx() { int b = blockIdx.x; asm volatile("" : "+s"(b)); return b; }
typedef float f32x2_ __attribute__((ext_vector_type(2)));
typedef __bf16 bf16x2_ __attribute__((ext_vector_type(2)));
DEV unsigned cvt_pk_bf16(float lo, float hi) { const f32x2_ v = {lo, hi}; const bf16x2_ b = __builtin_convertvector(v, bf16x2_); return __builtin_bit_cast(unsigned, b); }
DEV bf16_t f2bf(float f) { return (bf16_t)(cvt_pk_bf16(f, 0.f) & 0xFFFFu); }
DEV float bf2f(bf16_t h) { return __uint_as_float(((unsigned)h) << 16); }
DEV unsigned pack2(float lo, float hi) { return cvt_pk_bf16(lo, hi); }
DEV float bflo(unsigned u) { return __uint_as_float(u << 16); }
DEV float bfhi(unsigned u) { return __uint_as_float(u & 0xFFFF0000u); }
DEV float sigmoidf_(float x) { return 1.f / (1.f + __expf(-x)); }
DEV float wave_sum(float v) {
#pragma unroll
    for (int o = 32; o >= 1; o >>= 1) v += __shfl_xor(v, o, 64);
    return v;
}
template <int W> DEV float group_sum(float v) {
#pragma unroll
    for (int o = W / 2; o >= 1; o >>= 1) v += __shfl_xor(v, o, 64);
    return v;
}
DEV int mod_row(int t) { return t < TL ? (t >> 11) : 8; }
typedef const float* cfp_t;
DEV cfp_t inp(const Params&, int i) {
    const __attribute__((address_space(4))) cfp_t* ka = (const __attribute__((address_space(4))) cfp_t*)__builtin_amdgcn_kernarg_segment_ptr();
    asm volatile("" : "+s"(ka));
    return ka[i];
}
DEV char* wsp(const Params&) {
    char* const __attribute__((address_space(4)))* ka = (char* const __attribute__((address_space(4)))*)__builtin_amdgcn_kernarg_segment_ptr();
    asm volatile("" : "+s"(ka));
    return ka[49];
}
DEV bf16_t* wsb(const Params& p, size_t off) { return (bf16_t*)(wsp(p) + off); }
DEV float* wsf(const Params& p, size_t off) { return (float*)(wsp(p) + off); }
DEV const float* modp(const Params& p, int l, int row, int which) { return (const float*)(wsp(p) + OFF_MOD) + ((size_t)(l * 9 + row) * 6 + which) * 1024; }
#define XB_TMO      128
#define XB_XCNT(j)  (256  + 64 * (j))
#define XB_XSUB(j)  (1280 + 64 * (j))
#define XB_XGEN(j)  (2304 + 64 * (j))
#define XB_TOP      3328
#define XB_TOPGEN   3392
#define XCD_BAR_WORDS 3456
#define XB_SPIN_CAP (1u << 18)

__device__ __forceinline__ unsigned xb_ld(unsigned* p)              { return __hip_atomic_load(p, __ATOMIC_RELAXED, __HIP_MEMORY_SCOPE_AGENT); }
__device__ __forceinline__ unsigned xb_add(unsigned* p, unsigned v) { return __hip_atomic_fetch_add(p, v, __ATOMIC_RELAXED, __HIP_MEMORY_SCOPE_AGENT); }
__device__ __forceinline__ unsigned xb_xcc_id() { return (unsigned)__builtin_amdgcn_s_getreg((3 << 11) | 20) & 0xFu; }
#define XB_SPIN(cond, bar) do { unsigned _sp = 0; while (cond) { __builtin_amdgcn_s_sleep(1); \
    if ((++_sp & 255u) == 0u) { if (xb_ld(&(bar)[XB_TMO])) break; if (_sp > XB_SPIN_CAP) { atomicAdd(&(bar)[XB_TMO], 1u); break; } } } } while (0)

struct XcdBarrier {
    unsigned* bar; unsigned x;
    volatile LAS unsigned* st;
};

__device__ __forceinline__ XcdBarrier xcd_barrier_post(unsigned* bar, volatile LAS unsigned* st) {
    XcdBarrier b; b.bar = bar; b.x = xb_xcc_id(); b.st = st;
    if (threadIdx.x == 0) (void)xb_add(&bar[XB_XCNT(b.x)], 1u);
    return b;
}
__device__ __forceinline__ void xcd_barrier_complete(unsigned* bar, unsigned x, unsigned& nloc, unsigned& nx) {
    const unsigned G = gridDim.x * gridDim.y * gridDim.z;
    unsigned sum, cnt, mine, sp = 0u;
    for (;;) {
        sum = 0u; cnt = 0u; mine = 0u;
#pragma unroll
        for (unsigned j = 0; j < 16; ++j) { const unsigned c = xb_ld(&bar[XB_XCNT(j)]); sum += c; cnt += (c > 0u) ? 1u : 0u; mine = (j == x) ? c : mine; }
        if (sum == G) break;
        __builtin_amdgcn_s_sleep(1);
        if ((++sp & 255u) == 0u) { if (xb_ld(&bar[XB_TMO])) break; if (sp > XB_SPIN_CAP) { atomicAdd(&bar[XB_TMO], 1u); break; } }
    }
    nloc = mine > 0u ? mine : 1u; nx = cnt > 0u ? cnt : 1u;
}

__device__ __forceinline__ void xcd_barrier(const XcdBarrier& b) {
    asm volatile("s_waitcnt vmcnt(0)" ::: "memory");
    __syncthreads();
    if (threadIdx.x == 0) {
        unsigned* bar = b.bar;
        __builtin_amdgcn_s_waitcnt(0);
        unsigned nloc = b.st[0], nx = b.st[1];
        if (nloc == 0u) { xcd_barrier_complete(bar, b.x, nloc, nx); b.st[0] = nloc; b.st[1] = nx; }
        const unsigned old = xb_add(&bar[XB_XSUB(b.x)], 1u);
        const unsigned gen = old / nloc;
        if (old + 1u == (gen + 1u) * nloc) {
            __builtin_amdgcn_fence(__ATOMIC_RELEASE, "agent");
            asm volatile("s_waitcnt vmcnt(0)" ::: "memory");
            const unsigned og = xb_add(&bar[XB_TOP], 1u);
            const unsigned tg = og / nx;
            if (og + 1u == (tg + 1u) * nx) xb_add(&bar[XB_TOPGEN], 1u);
            else XB_SPIN(xb_ld(&bar[XB_TOPGEN]) == tg, bar);
            __builtin_amdgcn_fence(__ATOMIC_ACQUIRE, "agent");
            xb_add(&bar[XB_XGEN(b.x)], 1u);
            asm volatile("s_waitcnt vmcnt(0)" ::: "memory");
        } else {
            XB_SPIN(xb_ld(&bar[XB_XGEN(b.x)]) == gen, bar);
            __builtin_amdgcn_fence(__ATOMIC_ACQUIRE, "agent");
            asm volatile("s_waitcnt vmcnt(0)" ::: "memory");
        }
    }
    __syncthreads();
}

DEV void phase_mod_partial(const Params& p, char* smem) {
    float* sm = (float*)smem;
    const int tid = tidx();
    const int nitems = 2 * 24 * MOD_KS;
    for (int item = bidx(); item < nitems; item += gridDim.x) {
        const int l = item / (24 * MOD_KS), rem = item % (24 * MOD_KS), jc = rem / MOD_KS, ks = rem % MOD_KS;
        __syncthreads();
        for (int i = tid; i < 9 * 128; i += NT) {
            const int r = i >> 7, k = ks * 128 + (i & 127);
            const float cv = r < 8 ? inp(p, I_C)[r * 1024 + k] : inp(p, I_CCTX)[k];
            sm[i] = cv / (1.f + __expf(-cv));
        }
        __syncthreads();
        const int j = jc * 256 + tid;
        float acc[9];
#pragma unroll
        for (int r = 0; r < 9; ++r) acc[r] = 0.f;
        const float* w = inp(p, I_WADA) + (size_t)l * 1024 * 6144 + (size_t)(ks * 128) * 6144 + j;
#pragma unroll 8
        for (int k = 0; k < 128; ++k) {
            const float wv = w[(size_t)k * 6144];
#pragma unroll
            for (int r = 0; r < 9; ++r) acc[r] += sm[r * 128 + k] * wv;
        }
        float* dst = wsf(p, OFF_MODP);
#pragma unroll
        for (int r = 0; r < 9; ++r) dst[((size_t)(ks * 2 + l) * 9 + r) * 6144 + j] = acc[r];
    }
}
DEV void phase_mod_reduce(const Params& p) {
    const int n = 2 * 9 * 6144;
    float* mod = wsf(p, OFF_MOD);
    const float* part = wsf(p, OFF_MODP);
    for (int i = bidx() * NT + tidx(); i < n; i += gridDim.x * NT) {
        const int l = i / (9 * 6144), j = i % 6144;
        float s = inp(p, I_BADA)[l * 6144 + j];
#pragma unroll
        for (int ks = 0; ks < MOD_KS; ++ks) s += part[(size_t)ks * n + i];
        mod[i] = s;
    }
}

struct ConvRegs { float4 v[4]; };
DEV void conv_load(const float* src, int R, int C, int ld, int tr, int tc, ConvRegs& cr) {
    const int r0 = tr * 64, c0 = tc * 64, tid = tidx();
#pragma unroll
    for (int k = 0; k < 4; ++k) {
        const int i = tid + k * NT, r = i >> 4, c4 = (i & 15) * 4;
        float4 v = make_float4(0.f, 0.f, 0.f, 0.f);
        if (r0 + r < R) {
            const float* s = src + (size_t)(r0 + r) * ld + c0 + c4;
            if (c0 + c4 + 3 < C) v = *(const float4*)s;
            else { if (c0 + c4 < C) v.x = s[0]; if (c0 + c4 + 1 < C) v.y = s[1]; if (c0 + c4 + 2 < C) v.z = s[2]; }
        }
        cr.v[k] = v;
    }
}
template <int MODE>
DEV void conv_store(const ConvRegs& cr, int R, int C, bf16_t* dst, int ldd, int roff, int tr, int tc, float* sm) {
    const int r0 = tr * 64, c0 = tc * 64, tid = tidx();
    __syncthreads();
#pragma unroll
    for (int k = 0; k < 4; ++k) {
        const int i = tid + k * NT, r = i >> 4, c4 = (i & 15) * 4;
        float* d = sm + r * 65 + c4;
        d[0] = cr.v[k].x; d[1] = cr.v[k].y; d[2] = cr.v[k].z; d[3] = cr.v[k].w;
    }
    __syncthreads();
    for (int i = tid; i < 64 * 8; i += NT) {
        const int c = i >> 3, r8 = (i & 7) * 8;
        if (c0 + c < C && r0 + r8 < R) {
            const int cc = c0 + c;
            const int drow = (MODE == 0) ? (cc + roff) : ((cc >> 5) * 64 + (cc & 31) + roff);
            u32x4 o;
            o[0] = pack2(sm[(r8 + 0) * 65 + c], sm[(r8 + 1) * 65 + c]);
            o[1] = pack2(sm[(r8 + 2) * 65 + c], sm[(r8 + 3) * 65 + c]);
            o[2] = pack2(sm[(r8 + 4) * 65 + c], sm[(r8 + 5) * 65 + c]);
            o[3] = pack2(sm[(r8 + 6) * 65 + c], sm[(r8 + 7) * 65 + c]);
            *(u32x4*)(dst + (size_t)drow * ldd + r0 + r8) = o;
        }
    }
}
template <int MODE>
DEV void conv_job(const float* src, int R, int C, int ld, bf16_t* dst, int ldd, int roff, int& rot, float* sm) {
    const int ntr = (R + 63) >> 6, ntc = (C + 63) >> 6, nt = ntr * ntc, G = gridDim.x;
    const int first = (bidx() - (rot % G) + G) % G;
    ConvRegs cur;
    if (first < nt) conv_load(src, R, C, ld, first / ntc, first % ntc, cur);
    for (int t = first; t < nt; t += G) {
        ConvRegs nxt = cur;
        if (t + G < nt) conv_load(src, R, C, ld, (t + G) / ntc, (t + G) % ntc, nxt);
        conv_store<MODE>(cur, R, C, dst, ldd, roff, t / ntc, t % ntc, sm);
        cur = nxt;
    }
    rot += nt;
}
DEV void phase_conv_layer(const Params& p, int l, char* smem) {
    float* sm = (float*)smem;
    int rot = 0;
    const float* win = inp(p, I_WIN) + (size_t)l * 1024 * NIN;
    conv_job<0>(win, 1024, C_PEND, NIN, wsb(p, OFF_WIN), 1024, 0, rot, sm);
    conv_job<0>(win + C_PEND, 1024, 4096, NIN, wsb(p, OFF_WIN), 1024, NGATE0, rot, sm);
    {
        uint4* z = (uint4*)(wsb(p, OFF_WIN) + (size_t)C_PEND * 1024);
        const int n = (NGATE0 - C_PEND) * 1024 / 8;
        unsigned zz = 0u; asm volatile("" : "+v"(zz));
        for (int i = bidx() * NT + tidx(); i < n; i += gridDim.x * NT) z[i] = make_uint4(zz, zz, zz, zz);
    }
    for (int i = 0; i < 4; ++i)
        conv_job<0>(inp(p, I_WBR) + (size_t)(l * 4 + i) * 256 * 1024, 256, 1024, 1024, wsb(p, OFF_WBR) + (size_t)i * 1024 * 256, 256, 0, rot, sm);
    conv_job<0>(inp(p, I_WOUT) + (size_t)l * 1024 * 1024, 1024, 1024, 1024, wsb(p, OFF_WOUT), 1024, 0, rot, sm);
}
DEV void phase_conv_experts(const Params& p, int l, char* smem) {
    float* sm = (float*)smem;
    int rot = 0;
    for (int e = 0; e < NEXP; ++e) {
        conv_job<1>(inp(p, I_EWG) + (size_t)(l * NEXP + e) * 1024 * DFF, 1024, DFF, DFF, wsb(p, OFF_WG1) + (size_t)e * 1024 * 1024, 1024, 0, rot, sm);
        conv_job<1>(inp(p, I_EWU) + (size_t)(l * NEXP + e) * 1024 * DFF, 1024, DFF, DFF, wsb(p, OFF_WG1) + (size_t)e * 1024 * 1024, 1024, 32, rot, sm);
        conv_job<0>(inp(p, I_EWD) + (size_t)(l * NEXP + e) * DFF * 1024, DFF, 1024, 1024, wsb(p, OFF_WDN) + (size_t)e * 1024 * DFF, DFF, 0, rot, sm);
    }
}
DEV void phase_conv_small(const Params& p, char* smem) {
    float* sm = (float*)smem;
    int rot = 0;
    for (int l = 0; l < 2; ++l) {
        bf16_t* w = wsb(p, OFF_WSM) + (size_t)l * WS_PER_LAYER;
        for (int i = bidx() * NT + tidx(); i < 4 * 256 * 4; i += gridDim.x * NT)
            *(u32x4*)(w + WS_W2 + (size_t)(i >> 2) * 64 + 32 + (i & 3) * 8) = (u32x4){0u, 0u, 0u, 0u};
        conv_job<0>(inp(p, I_S5WGLU) + (size_t)l * 256 * 256, 256, 256, 256, w + WS_GLUT, 256, 0, rot, sm);
        conv_job<0>(inp(p, I_MWUQ) + (size_t)l * 192 * 192, 192, 192, 192, w + WS_UQT, 192, 0, rot, sm);
        conv_job<0>(inp(p, I_MWUKV) + (size_t)l * 128 * 384, 128, 384, 384, w + WS_UKVT, 128, 0, rot, sm);
        for (int d = 0; d < 2; ++d) {
            conv_job<0>(inp(p, I_RW1) + (size_t)(l * 2 + d) * 256 * 32, 256, 32, 32, w + WS_W1C, 256, d * 32, rot, sm);
            conv_job<0>(inp(p, I_RA1) + (size_t)(l * 2 + d) * 256 * 32, 256, 32, 32, w + WS_W1C, 256, 64 + d * 32, rot, sm);
            conv_job<0>(inp(p, I_RW2) + (size_t)(l * 2 + d) * 32 * 256, 32, 256, 256, w + WS_W2 + (size_t)d * 256 * 64, 64, 0, rot, sm);
            conv_job<0>(inp(p, I_RA2) + (size_t)(l * 2 + d) * 32 * 256, 32, 256, 256, w + WS_W2 + (size_t)(2 + d) * 256 * 64, 64, 0, rot, sm);
        }
        conv_job<0>(inp(p, I_RG1) + (size_t)l * 256 * 64, 256, 64, 64, w + WS_W1C, 256, 128, rot, sm);
        conv_job<0>(inp(p, I_RG2) + (size_t)l * 64 * 256, 64, 256, 256, w + WS_G2T, 64, 0, rot, sm);
    }
}

template <int WHICH>
DEV void phase_norm(const Params& p, int l, int nrows, char* smem, bool fuse_combine = false) {
    const int lane = tidx() & 63, wave = tidx() >> 6;
    const float* xs = (l == 0) ? inp(p, I_X) : p.out;
    const float* cs = (l == 0) ? inp(p, I_CTX) : wsf(p, OFF_CX);
    const float* g = inp(p, WHICH == 1 ? I_NMG : I_NFG) + l * 1024;
    bf16_t* H = wsb(p, OFF_H);
    if (WHICH == 2) { xs = p.out; cs = wsf(p, OFF_CX); }
    const int tpb = (nrows + (int)gridDim.x - 1) / (int)gridDim.x;
    const int rbeg = WHICH == 2 ? bidx() * tpb + wave : bidx() * 4 + wave;
    const int rend = WHICH == 2 ? min(nrows, (bidx() + 1) * tpb) : nrows;
    const int rstep = WHICH == 2 ? 4 : (int)gridDim.x * 4;
    int* sel = (int*)smem;
    for (int row = rbeg; row < rend; row += rstep) {
        const float* src = row < TL ? xs + (size_t)row * 1024 : cs + (size_t)(row - TL) * 1024;
        const int mr = mod_row(row);
        const float* sh = modp(p, l, mr, WHICH == 1 ? 0 : 3);
        const float* sc = modp(p, l, mr, WHICH == 1 ? 1 : 4);
        float4 v[4];
        float ss = 0.f;
#pragma unroll
        for (int i = 0; i < 4; ++i) v[i] = *(const float4*)(src + lane * 4 + i * 256);
        if (WHICH == 1 && fuse_combine) {
            const bf16_t* Z = wsb(p, OFF_Z);
            const int* toki = (const int*)(wsp(p) + OFF_TOKI);
            const float* tokw = (const float*)(wsp(p) + OFF_TOKW);
            const float* g2 = modp(p, l - 1, mr, 5);
            const int r0 = toki[(size_t)row * 4 + 2], r1 = toki[(size_t)row * 4 + 3];
            const float w0 = tokw[(size_t)row * 2], w1 = tokw[(size_t)row * 2 + 1];
            float* dst = row < TL ? p.out + (size_t)row * 1024 : wsf(p, OFF_CX) + (size_t)(row - TL) * 1024;
#pragma unroll
            for (int i = 0; i < 4; ++i) {
                const int c = lane * 4 + i * 256;
                const u32x2 a = *(const u32x2*)(Z + (size_t)r0 * 1024 + c), b = *(const u32x2*)(Z + (size_t)r1 * 1024 + c);
                const float4 gg = *(const float4*)(g2 + c);
                v[i].x += gg.x * (w0 * bflo(a.x) + w1 * bflo(b.x));
                v[i].y += gg.y * (w0 * bfhi(a.x) + w1 * bfhi(b.x));
                v[i].z += gg.z * (w0 * bflo(a.y) + w1 * bflo(b.y));
                v[i].w += gg.w * (w0 * bfhi(a.y) + w1 * bfhi(b.y));
                *(float4*)(dst + c) = v[i];
            }
        }
#pragma unroll
        for (int i = 0; i < 4; ++i) ss += v[i].x * v[i].x + v[i].y * v[i].y + v[i].z * v[i].z + v[i].w * v[i].w;
        ss = wave_sum(ss);
        const float rstd = rsqrtf(ss * (1.f / 1024.f) + EPS);
        float hv[16];
#pragma unroll
        for (int i = 0; i < 4; ++i) {
            const int c = lane * 4 + i * 256;
            const float4 gg = *(const float4*)(g + c), s4 = *(const float4*)(sh + c), c4 = *(const float4*)(sc + c);
            hv[i * 4 + 0] = v[i].x * rstd * gg.x * (1.f + c4.x) + s4.x;
            hv[i * 4 + 1] = v[i].y * rstd * gg.y * (1.f + c4.y) + s4.y;
            hv[i * 4 + 2] = v[i].z * rstd * gg.z * (1.f + c4.z) + s4.z;
            hv[i * 4 + 3] = v[i].w * rstd * gg.w * (1.f + c4.w) + s4.w;
            u32x2 o; o.x = pack2(hv[i * 4 + 0], hv[i * 4 + 1]); o.y = pack2(hv[i * 4 + 2], hv[i * 4 + 3]);
            *(u32x2*)(H + (size_t)row * 1024 + c) = o;
        }
        if (WHICH == 2) {
            float lg[16];
#pragma unroll
            for (int e = 0; e < 16; ++e) lg[e] = 0.f;
            const float* rw = inp(p, I_ROUTW);
#pragma unroll
            for (int i = 0; i < 4; ++i)
#pragma unroll
                for (int j = 0; j < 4; ++j) {
                    const int c = lane * 4 + i * 256 + j;
                    const float hvv = hv[i * 4 + j];
#pragma unroll
                    for (int q = 0; q < 4; ++q) {
                        const float4 w4 = *(const float4*)(rw + (size_t)c * 16 + q * 4);
                        lg[q * 4 + 0] += hvv * w4.x; lg[q * 4 + 1] += hvv * w4.y; lg[q * 4 + 2] += hvv * w4.z; lg[q * 4 + 3] += hvv * w4.w;
                    }
                }
#pragma unroll
            for (int e = 0; e < 16; ++e) lg[e] = wave_sum(lg[e]);
            float sc16[16], bs[16];
#pragma unroll
            for (int e = 0; e < 16; ++e) { sc16[e] = sigmoidf_(lg[e]); bs[e] = sc16[e] + inp(p, I_ROUTB)[e]; }
            int bestg = 0; float bestv = -INFINITY;
#pragma unroll
            for (int gi = 0; gi < 4; ++gi) {
                float m1 = -INFINITY, m2 = -INFINITY;
#pragma unroll
                for (int k = 0; k < 4; ++k) { const float x = bs[gi * 4 + k]; if (x > m1) { m2 = m1; m1 = x; } else if (x > m2) m2 = x; }
                const float gs = m1 + m2;
                if (gs > bestv) { bestv = gs; bestg = gi; }
            }
            int i0 = 0, i1 = 0; float v0 = -INFINITY, v1 = -INFINITY, s0 = 0.f, s1 = 0.f;
#pragma unroll
            for (int e = 0; e < 16; ++e) { const bool in = (e >> 2) == bestg; if (in && bs[e] > v0) { v0 = bs[e]; i0 = e; s0 = sc16[e]; } }
#pragma unroll
            for (int e = 0; e < 16; ++e) { const bool in = (e >> 2) == bestg && e != i0; if (in && bs[e] > v1) { v1 = bs[e]; i1 = e; s1 = sc16[e]; } }
            const float inv = 1.f / (s0 + s1);
            if (lane == 0) {
                const int lt = row - bidx() * tpb;
                sel[lt * 2 + 0] = i0; sel[lt * 2 + 1] = i1;
                float* tw = (float*)(wsp(p) + OFF_TOKW) + (size_t)row * 2;
                tw[0] = s0 * inv; tw[1] = s1 * inv;
            }
        }
    }
    if (WHICH == 2) {
        __syncthreads();
        const int t0 = bidx() * tpb, nt = max(0, min(nrows, t0 + tpb) - t0);
        int* rank = sel + 2 * tpb;
        if (tidx() < 16) {
            const int e = tidx(); int c = 0;
            for (int i = 0; i < 2 * nt; ++i) if (sel[i] == e) { rank[i] = c; ++c; }
            ((int*)(wsp(p) + OFF_CNTB))[(size_t)bidx() * 16 + e] = c;
        }
        __syncthreads();
        int* toki = (int*)(wsp(p) + OFF_TOKI);
        for (int i = tidx(); i < nt; i += NT) {
            int4 r; r.x = sel[2 * i]; r.y = sel[2 * i + 1]; r.z = rank[2 * i]; r.w = rank[2 * i + 1];
            *(int4*)(toki + (size_t)(t0 + i) * 4) = r;
        }
        __syncthreads();
    }
}
DEV void phase_route(const Params& p, int l, int nrows, char* smem) {
    int* sm = (int*)smem;
    const int tid = tidx(), e = tid & 15, part = tid >> 4, G = gridDim.x, b = bidx();
    const int* cntb = (const int*)(wsp(p) + OFF_CNTB);
    int pre = 0, tot = 0;
    for (int bb = part; bb < G; bb += 16) { const int c = cntb[(size_t)bb * 16 + e]; tot += c; if (bb < b) pre += c; }
    __syncthreads();
    sm[part * 16 + e] = pre; sm[256 + part * 16 + e] = tot;
    __syncthreads();
    if (tid < 16) {
        int a = 0, t = 0;
        for (int q = 0; q < 16; ++q) { a += sm[q * 16 + tid]; t += sm[256 + q * 16 + tid]; }
        sm[512 + tid] = a; sm[528 + tid] = t;
    }
    __syncthreads();
    if (tid == 0) {
        int a = 0;
        for (int q = 0; q < 16; ++q) { sm[544 + q] = a; a += sm[528 + q]; }
    }
    __syncthreads();
    if (b == 0 && tid < 16) ((int*)(wsp(p) + OFF_CTR))[CTR_MOE + l * 16 + tid] = sm[528 + tid];
    const int tpb = (nrows + G - 1) / G, t0 = b * tpb, nt = max(0, min(nrows, t0 + tpb) - t0);
    int* toki = (int*)(wsp(p) + OFF_TOKI);
    const float* tokw = (const float*)(wsp(p) + OFF_TOKW);
    int* ltok = (int*)(wsp(p) + OFF_LTOK);
    float* lw = (float*)(wsp(p) + OFF_LW);
    for (int i = tid; i < 2 * nt; i += NT) {
        const int t = t0 + (i >> 1), j = i & 1;
        const int ee = toki[(size_t)t * 4 + j], rk = toki[(size_t)t * 4 + 2 + j];
        const int pos = sm[512 + ee] + rk;
        ltok[(size_t)ee * TT + pos] = t;
        lw[(size_t)ee * TT + pos] = tokw[(size_t)t * 2 + j];
        toki[(size_t)t * 4 + 2 + j] = sm[544 + ee] + pos;
    }
}
DEV void phase_combine(const Params& p, int l, int nrows) {
    const int lane = tidx() & 63, wave = tidx() >> 6;
    const bf16_t* Z = wsb(p, OFF_Z);
    const int* toki = (const int*)(wsp(p) + OFF_TOKI);
    const float* tokw = (const float*)(wsp(p) + OFF_TOKW);
    for (int row = bidx() * 4 + wave; row < nrows; row += gridDim.x * 4) {
        float* dst = row < TL ? p.out + (size_t)row * 1024 : wsf(p, OFF_CX) + (size_t)(row - TL) * 1024;
        const float* g2 = modp(p, l, mod_row(row), 5);
        const int r0 = toki[(size_t)row * 4 + 2], r1 = toki[(size_t)row * 4 + 3];
        const float w0 = tokw[(size_t)row * 2], w1 = tokw[(size_t)row * 2 + 1];
#pragma unroll
        for (int i = 0; i < 4; ++i) {
            const int c = lane * 4 + i * 256;
            const u32x2 a = *(const u32x2*)(Z + (size_t)r0 * 1024 + c), b = *(const u32x2*)(Z + (size_t)r1 * 1024 + c);
            const float4 gg = *(const float4*)(g2 + c);
            float4 x = *(float4*)(dst + c);
            x.x += gg.x * (w0 * bflo(a.x) + w1 * bflo(b.x));
            x.y += gg.y * (w0 * bfhi(a.x) + w1 * bfhi(b.x));
            x.z += gg.z * (w0 * bflo(a.y) + w1 * bflo(b.y));
            x.w += gg.w * (w0 * bfhi(a.y) + w1 * bfhi(b.y));
            *(float4*)(dst + c) = x;
        }
    }
}
constexpr int GLD = 72;
constexpr int GSTAGE = 128 * GLD;
template <bool DEEP = true, int TN = 2, class AF, class BF>
DEV void gemm_mainloop(f32x16 (&acc)[2][TN], AF arow, BF brow, int K, bf16_t* sm) {
    const int tid = tidx(), lane = tid & 63, wave = tid >> 6, wm = wave >> 1, wn = wave & 1;
    bf16_t* As = sm;
    bf16_t* Bs = sm + 2 * GSTAGE;
    constexpr int NB = 2 * TN;
    const bf16_t* ap[4]; const bf16_t* bp[NB];
#pragma unroll
    for (int i = 0; i < 4; ++i) { const int q = tid + i * NT; ap[i] = arow(q >> 3) + (q & 7) * 8; }
#pragma unroll
    for (int i = 0; i < NB; ++i) { const int q = tid + i * NT; bp[i] = brow(q >> 3) + (q & 7) * 8; }
    const int soff = (tid >> 3) * GLD + (tid & 7) * 8;
    u32x4 ra0[4], rb0[NB], ra1[4], rb1[NB];
    const int nk = K >> 6;
#pragma unroll
    for (int i = 0; i < 4; ++i) ra0[i] = *(const u32x4*)ap[i];
#pragma unroll
    for (int i = 0; i < NB; ++i) rb0[i] = *(const u32x4*)bp[i];
    if (DEEP && nk > 1) {
#pragma unroll
        for (int i = 0; i < 4; ++i) ra1[i] = *(const u32x4*)(ap[i] + 64);
#pragma unroll
        for (int i = 0; i < NB; ++i) rb1[i] = *(const u32x4*)(bp[i] + 64);
    }
    __syncthreads();
#pragma unroll
    for (int i = 0; i < 4; ++i) *(u32x4*)(As + soff + i * 32 * GLD) = ra0[i];
#pragma unroll
    for (int i = 0; i < NB; ++i) *(u32x4*)(Bs + soff + i * 32 * GLD) = rb0[i];
    __syncthreads();
    const int arow0 = (wm * 64 + (lane & 31)) * GLD + (lane >> 5) * 8;
    const int brow0 = (wn * 32 * TN + (lane & 31)) * GLD + (lane >> 5) * 8;
    auto compute = [&](int cur) {
        const bf16_t* a_s = As + cur * GSTAGE + arow0;
        const bf16_t* b_s = Bs + cur * GSTAGE + brow0;
#pragma unroll
        for (int ks = 0; ks < 4; ++ks) {
            const bf16x8 a0 = *(const bf16x8*)(a_s + ks * 16);
            const bf16x8 a1 = *(const bf16x8*)(a_s + 32 * GLD + ks * 16);
#pragma unroll
            for (int j = 0; j < TN; ++j) {
                const bf16x8 bj = *(const bf16x8*)(b_s + j * 32 * GLD + ks * 16);
                acc[0][j] = __builtin_amdgcn_mfma_f32_32x32x16_bf16(a0, bj, acc[0][j], 0, 0, 0);
                acc[1][j] = __builtin_amdgcn_mfma_f32_32x32x16_bf16(a1, bj, acc[1][j], 0, 0, 0);
            }
        }
    };
    auto gload = [&](u32x4 (&ra)[4], u32x4 (&rb)[NB], int kt) {
        const int k0 = kt * 64;
#pragma unroll
        for (int i = 0; i < 4; ++i) ra[i] = *(const u32x4*)(ap[i] + k0);
#pragma unroll
        for (int i = 0; i < NB; ++i) rb[i] = *(const u32x4*)(bp[i] + k0);
    };
    auto lstore = [&](const u32x4 (&ra)[4], const u32x4 (&rb)[NB], int st) {
#pragma unroll
        for (int i = 0; i < 4; ++i) *(u32x4*)(As + st * GSTAGE + soff + i * 32 * GLD) = ra[i];
#pragma unroll
        for (int i = 0; i < NB; ++i) *(u32x4*)(Bs + st * GSTAGE + soff + i * 32 * GLD) = rb[i];
    };
    for (int kt = 0; kt < nk; kt += 2) {
        if (!DEEP && kt + 1 < nk) gload(ra1, rb1, kt + 1);
        if (DEEP && kt + 2 < nk) gload(ra0, rb0, kt + 2);
        compute(0);
        if (kt + 1 < nk) lstore(ra1, rb1, 1);
        __syncthreads();
        if (kt + 1 >= nk) break;
        if (!DEEP && kt + 2 < nk) gload(ra0, rb0, kt + 2);
        if (DEEP && kt + 3 < nk) gload(ra1, rb1, kt + 3);
        compute(1);
        if (kt + 2 < nk) lstore(ra0, rb0, 0);
        __syncthreads();
    }
}
template <int TN>
DEV void acc_zero(f32x16 (&acc)[2][TN]) {
#pragma unroll
    for (int i = 0; i < 2; ++i)
#pragma unroll
        for (int j = 0; j < TN; ++j)
#pragma unroll
            for (int r = 0; r < 16; ++r) acc[i][j][r] = 0.f;
}
#define EPI_FOREACH(acc, ...)                                                                           \
    {                                                                                                    \
        const int _lane = tidx() & 63, _wave = tidx() >> 6, _wm = _wave >> 1, _wn = _wave & 1; \
        _Pragma("unroll") for (int _i = 0; _i < 2; ++_i)                                                 \
        _Pragma("unroll") for (int _j = 0; _j < 2; ++_j)                                                 \
        _Pragma("unroll") for (int _r = 0; _r < 16; ++_r) {                                              \
            const int er = _wm * 64 + _i * 32 + (_r & 3) + 8 * (_r >> 2) + 4 * (_lane >> 5);             \
            const int ec = _wn * 64 + _j * 32 + (_lane & 31);                                            \
            const float ev = acc[_i][_j][_r];                                                            \
            __VA_ARGS__                                                                                  \
        }                                                                                                \
    }

DEV void tile_mn(int item, int nMt, int nNt, int& mt, int& nt) {
    constexpr int GM = 16;
    const int per = GM * nNt, g = item / per, rem = item % per;
    const int m0 = g * GM, gsz = (nMt - m0) < GM ? (nMt - m0) : GM;
    mt = m0 + rem % gsz; nt = rem / gsz;
}

DEV void phase_inproj(const Params& p, int l, char* smem) {
    bf16_t* sm = (bf16_t*)smem;
    const bf16_t* H = wsb(p, OFF_H);
    const bf16_t* W = wsb(p, OFF_WIN);
    bf16_t* P = wsb(p, OFF_P);
    unsigned char* G = (unsigned char*)(wsp(p) + OFF_GATE);
    const int nMt = TT / 128, nNt = NINP / 128;
    for (int item = bidx(); item < nMt * nNt; item += gridDim.x) {
        int mt, nt; tile_mn(item, nMt, nNt, mt, nt);
        const int m0 = mt * 128, n0 = nt * 128;
        if (l == 1 && m0 >= TL && n0 >= NGATE0) continue;
        f32x16 acc[2][2]; acc_zero<2>(acc);
        gemm_mainloop(acc, [&](int r) { return H + (size_t)(m0 + r) * 1024; }, [&](int r) { return W + (size_t)(n0 + r) * 1024; }, 1024, sm);
        if (n0 < NGATE0) {
            EPI_FOREACH(acc, { const int col = n0 + ec; if (col < C_PEND) P[(size_t)(m0 + er) * LDP + col] = f2bf(ev); })
        } else {
            EPI_FOREACH(acc, { const int col = n0 + ec - NGATE0; const float s = sigmoidf_(ev); G[(size_t)(m0 + er) * 4096 + col] = (unsigned char)__float2int_rn(s * 255.f); })
        }
    }
}

template <class EF>
DEV void gemm_generic(const bf16_t* A, int lda, int M, const bf16_t* Bt, int ldb, int N, int K, EF ef, char* smem, int rot) {
    bf16_t* sm = (bf16_t*)smem;
    const int nMt = (M + 127) / 128, nNt = (N + 127) / 128, G = gridDim.x;
    const int first = (bidx() - (rot % G) + G) % G;
    for (int item = first; item < nMt * nNt; item += G) {
        const int mt = item / nNt, nt = item % nNt, m0 = mt * 128, n0 = nt * 128;
        f32x16 acc[2][2]; acc_zero<2>(acc);
        gemm_mainloop(acc, [&](int r) { int rr = m0 + r; rr = rr < M ? rr : M - 1; return A + (size_t)rr * lda; },
                      [&](int r) { int rr = n0 + r; rr = rr < N ? rr : N - 1; return Bt + (size_t)rr * ldb; }, K, sm);
        EPI_FOREACH(acc, { const int row = m0 + er, col = n0 + ec; if (row < M && col < N) ef(row, col, ev); })
    }
}

DEV void phase_merge(const Params& p, int l, int M, char* smem) {
    bf16_t* sm = (bf16_t*)smem;
    const bf16_t* Y = wsb(p, OFF_Y);
    const bf16_t* W = wsb(p, OFF_WBR);
    const unsigned char* G = (const unsigned char*)(wsp(p) + OFF_GATE);
    bf16_t* MG = wsb(p, OFF_H);
    bf16_t* As = sm;
    bf16_t* Bs = sm + 2 * GSTAGE;
    unsigned char* Gs = (unsigned char*)(sm + 2 * GSTAGE + 2 * 64 * GLD);
    const int tid = tidx(), lane = tid & 63, wave = tid >> 6, wm = wave >> 1, wn = wave & 1;
    const int soff = (tid >> 3) * GLD + (tid & 7) * 8;
    const int arow0 = (wm * 64 + (lane & 31)) * GLD + (lane >> 5) * 8;
    const int brow0 = (wn * 32 + (lane & 31)) * GLD + (lane >> 5) * 8;
    const int nMt = M / 128, nNt = 16;
    for (int item = bidx(); item < nMt * nNt; item += gridDim.x) {
        const int mt = item / nNt, nt = item % nNt, m0 = mt * 128, n0 = nt * 64;
        const bf16_t* ap[4]; const bf16_t* bp[2]; const unsigned char* gp[2];
#pragma unroll
        for (int i = 0; i < 4; ++i) { const int q = tid + i * NT; ap[i] = Y + (size_t)(m0 + (q >> 3)) * 1024 + (q & 7) * 8; }
#pragma unroll
        for (int i = 0; i < 2; ++i) { const int q = tid + i * NT; bp[i] = W + (size_t)(n0 + (q >> 3)) * 256 + (q & 7) * 8;
                                      gp[i] = G + (size_t)(m0 + (q >> 2)) * 4096 + n0 + (q & 3) * 16; }
        f32x16 tot[2], acc[2];
#pragma unroll
        for (int a = 0; a < 2; ++a)
#pragma unroll
            for (int r = 0; r < 16; ++r) { tot[a][r] = 0.f; acc[a][r] = 0.f; }
        u32x4 ra[4], rb[2], rg[2];
#pragma unroll
        for (int i = 0; i < 4; ++i) ra[i] = *(const u32x4*)ap[i];
#pragma unroll
        for (int i = 0; i < 2; ++i) rb[i] = *(const u32x4*)bp[i];
        __syncthreads();
#pragma unroll
        for (int i = 0; i < 4; ++i) *(u32x4*)(As + soff + i * 32 * GLD) = ra[i];
#pragma unroll
        for (int i = 0; i < 2; ++i) *(u32x4*)(Bs + soff + i * 32 * GLD) = rb[i];
        __syncthreads();
#pragma unroll
        for (int kt = 0; kt < 16; ++kt) {
            const int cur = kt & 1, seg = kt >> 2;
            if (kt + 1 < 16) {
                const int k1 = kt + 1;
#pragma unroll
                for (int i = 0; i < 4; ++i) ra[i] = *(const u32x4*)(ap[i] + k1 * 64);
#pragma unroll
                for (int i = 0; i < 2; ++i) rb[i] = *(const u32x4*)(bp[i] + (size_t)(k1 >> 2) * (1024 * 256) + (k1 & 3) * 64);
            }
            if ((kt & 3) == 0) {
#pragma unroll
                for (int i = 0; i < 2; ++i) rg[i] = *(const u32x4*)(gp[i] + seg * 1024);
            }
            const bf16_t* a_s = As + cur * GSTAGE + arow0;
            const bf16_t* b_s = Bs + cur * (64 * GLD) + brow0;
#pragma unroll
            for (int ks = 0; ks < 4; ++ks) {
                const bf16x8 a0 = *(const bf16x8*)(a_s + ks * 16), a1 = *(const bf16x8*)(a_s + 32 * GLD + ks * 16), b0 = *(const bf16x8*)(b_s + ks * 16);
                acc[0] = __builtin_amdgcn_mfma_f32_32x32x16_bf16(a0, b0, acc[0], 0, 0, 0);
                acc[1] = __builtin_amdgcn_mfma_f32_32x32x16_bf16(a1, b0, acc[1], 0, 0, 0);
            }
            if (kt + 1 < 16) {
                const int nx = cur ^ 1;
#pragma unroll
                for (int i = 0; i < 4; ++i) *(u32x4*)(As + nx * GSTAGE + soff + i * 32 * GLD) = ra[i];
#pragma unroll
                for (int i = 0; i < 2; ++i) *(u32x4*)(Bs + nx * (64 * GLD) + soff + i * 32 * GLD) = rb[i];
            }
            if ((kt & 3) == 3) {
#pragma unroll
                for (int i = 0; i < 2; ++i) { const int q = tid + i * NT; *(u32x4*)(Gs + (q >> 2) * 64 + (q & 3) * 16) = rg[i]; }
            }
            __syncthreads();
            if ((kt & 3) == 3) {
#pragma unroll
                for (int a = 0; a < 2; ++a)
#pragma unroll
                    for (int r = 0; r < 16; ++r) {
                        const int er = wm * 64 + a * 32 + (r & 3) + 8 * (r >> 2) + 4 * (lane >> 5), ec = wn * 32 + (lane & 31);
                        tot[a][r] += (float)Gs[er * 64 + ec] * (1.f / 255.f) * acc[a][r];
                        acc[a][r] = 0.f;
                    }
            }
        }
#pragma unroll
        for (int a = 0; a < 2; ++a)
#pragma unroll
            for (int r = 0; r < 16; ++r) {
                const int er = wm * 64 + a * 32 + (r & 3) + 8 * (r >> 2) + 4 * (lane >> 5), ec = wn * 32 + (lane & 31);
                MG[(size_t)(m0 + er) * 1024 + n0 + ec] = f2bf(tot[a][r]);
            }
    }
}

DEV void phase_outproj(const Params& p, int l, int M, char* smem) {
    bf16_t* sm = (bf16_t*)smem;
    const bf16_t* MG = wsb(p, OFF_H);
    const bf16_t* W = wsb(p, OFF_WOUT);
    const float* xs = (l == 0) ? inp(p, I_X) : p.out;
    const float* cs = (l == 0) ? inp(p, I_CTX) : wsf(p, OFF_CX);
    float* cxd = wsf(p, OFF_CX);
    float* outd = p.out;
    const int nMt = M / 128, nNt = 8;
    for (int item = bidx(); item < nMt * nNt; item += gridDim.x) {
        const int mt = item / nNt, nt = item % nNt, m0 = mt * 128, n0 = nt * 128;
        f32x16 acc[2][2]; acc_zero<2>(acc);
        gemm_mainloop(acc, [&](int r) { return MG + (size_t)(m0 + r) * 1024; }, [&](int r) { return W + (size_t)(n0 + r) * 1024; }, 1024, sm);
        const float* g1 = modp(p, l, mod_row(m0), 2);
        if (m0 < TL) {
            EPI_FOREACH(acc, { const size_t o = (size_t)(m0 + er) * 1024 + n0 + ec; outd[o] = xs[o] + g1[n0 + ec] * ev; })
        } else {
            EPI_FOREACH(acc, { const size_t o = (size_t)(m0 - TL + er) * 1024 + n0 + ec; cxd[o] = cs[o] + g1[n0 + ec] * ev; })
        }
    }
}

constexpr int MOE_MAP_OFF = 73728;
DEV void moe_map(const Params& p, int l, char* smem) {
    int* mm = (int*)(smem + MOE_MAP_OFF);
    __syncthreads();
    if (tidx() == 0) {
        const int* cnt = (const int*)(wsp(p) + OFF_CTR) + CTR_MOE + l * 16;
        int b = 0, t = 0;
        for (int e = 0; e < 16; ++e) { const int c = cnt[e]; mm[e] = c; mm[16 + e] = b; mm[32 + e] = t; b += c; t += (c + 127) >> 7; }
        mm[48] = t;
    }
    __syncthreads();
}
DEV void phase_moe1(const Params& p, int l, char* smem) {
    bf16_t* sm = (bf16_t*)smem;
    const bf16_t* F = wsb(p, OFF_H);
    const bf16_t* W = wsb(p, OFF_WG1);
    bf16_t* ACT = wsb(p, OFF_P);
    const int* ltok = (const int*)(wsp(p) + OFF_LTOK);
    moe_map(p, l, smem); const int* mm = (const int*)(smem + MOE_MAP_OFF);
    const int nNt = 8, total = mm[48] * nNt;
    for (int item = bidx(); item < total; item += gridDim.x) {
        const int mtg = item / nNt, nt = item % nNt;
        int e = 0;
        for (int q = 1; q < 16; ++q) if (mtg >= mm[32 + q]) e = q;
        const int m0 = (mtg - mm[32 + e]) * 128, n0 = nt * 128, ce = mm[e];
        const int* lt = ltok + (size_t)e * TT;
        f32x16 acc[2][2]; acc_zero<2>(acc);
        gemm_mainloop(acc, [&](int r) { int idx = m0 + r; idx = idx < ce ? idx : ce - 1; return F + (size_t)lt[idx] * 1024; },
                      [&](int r) { return W + ((size_t)e * 1024 + n0 + r) * 1024; }, 1024, sm);
        const int lane = tidx() & 63, wave = tidx() >> 6, wm = wave >> 1, wn = wave & 1;
        const int jcol = ((n0 >> 6) + wn) * 32 + (lane & 31);
#pragma unroll
        for (int a = 0; a < 2; ++a)
#pragma unroll
            for (int r = 0; r < 16; ++r) {
                const int idx = m0 + wm * 64 + a * 32 + (r & 3) + 8 * (r >> 2) + 4 * (lane >> 5);
                if (idx < ce) {
                    const float g = acc[a][0][r], u = acc[a][1][r];
                    ACT[(size_t)(mm[16 + e] + idx) * DFF + jcol] = f2bf(g * sigmoidf_(g) * u);
                }
            }
    }
}
DEV void phase_moe2(const Params& p, int l, char* smem) {
    bf16_t* sm = (bf16_t*)smem;
    const bf16_t* ACT = wsb(p, OFF_P);
    const bf16_t* W = wsb(p, OFF_WDN);
    bf16_t* Z = wsb(p, OFF_Z);
    moe_map(p, l, smem); const int* mm = (const int*)(smem + MOE_MAP_OFF);
    const int nNt = 8, total = mm[48] * nNt;
    for (int item = bidx(); item < total; item += gridDim.x) {
        const int mtg = item / nNt, nt = item % nNt;
        int e = 0;
        for (int q = 1; q < 16; ++q) if (mtg >= mm[32 + q]) e = q;
        const int m0 = (mtg - mm[32 + e]) * 128, n0 = nt * 128, ce = mm[e];
        f32x16 acc[2][2]; acc_zero<2>(acc);
        gemm_mainloop(acc, [&](int r) { int idx = m0 + r; idx = idx < ce ? idx : ce - 1; return ACT + (size_t)(mm[16 + e] + idx) * DFF; },
                      [&](int r) { return W + ((size_t)e * 1024 + n0 + r) * DFF; }, DFF, sm);
        bf16_t* zb = Z + (size_t)mm[16 + e] * 1024;
        EPI_FOREACH(acc, { const int idx = m0 + er; if (idx < ce) zb[(size_t)idx * 1024 + n0 + ec] = f2bf(ev); })
    }
}
DEV void tok_seq(int t, int& base, int& n, int& len) {
    if (t < TL) { base = t & ~(SEQ - 1); n = t & (SEQ - 1); len = SEQ; } else { const int u = t - TL; base = TL + (u & ~(CTXL - 1)); n = u & (CTXL - 1); len = CTXL; }
}
DEV void phase_prep1(const Params& p, int l) {
    const int lane = tidx() & 63, wave = tidx() >> 6;
    bf16_t* P = wsb(p, OFF_P);
    bf16_t* XL = wsb(p, OFF_XL);
    const float* qkg = inp(p, I_DAQKG) + l * 64;
    const float* cqg = inp(p, I_MCQG) + l * 192;
    const float* ckvg = inp(p, I_MCKVG) + l * 128;
    const float* mu3 = inp(p, I_RMU) + (l * 4 + 3) * 256;
    for (int t = bidx() * 4 + wave; t < TT; t += gridDim.x * 4) {
        bf16_t* row = P + (size_t)t * LDP;
        int base, n, len; tok_seq(t, base, n, len);
        {
            const int d0 = (lane & 7) * 4;
            float cs[4], sn[4];
            const bool rot = t < TL;
            if (rot) {
                const float fr = (float)(n >> 6), fc = (float)(n & 63);
#pragma unroll
                for (int j = 0; j < 4; ++j) {
                    const int i = (d0 + j) & 15;
                    const float inv = exp2f(-(float)(i & 7) * (13.287712379549449f / 8.f));
                    const float ang = (i < 8 ? fr : fc) * inv;
                    cs[j] = __cosf(ang); sn[j] = __sinf(ang);
                }
            }
#pragma unroll
            for (int which = 0; which < 2; ++which) {
                bf16_t* ptr = row + (which ? C_DAK : C_DAQ) + lane * 4;
                const u32x2 raw = *(const u32x2*)ptr;
                float v[4] = { bflo(raw.x), bfhi(raw.x), bflo(raw.y), bfhi(raw.y) };
                float ss = v[0] * v[0] + v[1] * v[1] + v[2] * v[2] + v[3] * v[3];
                ss = group_sum<8>(ss);
                const float rstd = rsqrtf(ss * (1.f / 32.f) + EPS);
                const float* g = qkg + which * 32 + d0;
#pragma unroll
                for (int j = 0; j < 4; ++j) v[j] = v[j] * rstd * g[j];
                if (rot) {
#pragma unroll
                    for (int j = 0; j < 4; ++j) {
                        const float o = __shfl_xor(v[j], 4, 64);
                        v[j] = (d0 < 16) ? (v[j] * cs[j] - o * sn[j]) : (v[j] * cs[j] + o * sn[j]);
                    }
                }
                if (which == 0) {
                    const float qs = 0.17677669529663687f * LOG2E;
#pragma unroll
                    for (int j = 0; j < 4; ++j) v[j] *= qs;
                }
                u32x2 o; o.x = pack2(v[0], v[1]); o.y = pack2(v[2], v[3]);
                *(u32x2*)ptr = o;
            }
        }
        {
            float v[3]; float ss = 0.f;
#pragma unroll
            for (int j = 0; j < 3; ++j) { v[j] = bf2f(row[C_CQ + lane + j * 64]); ss += v[j] * v[j]; }
            ss = wave_sum(ss);
            const float rstd = rsqrtf(ss * (1.f / 192.f) + EPS);
#pragma unroll
            for (int j = 0; j < 3; ++j) row[C_CQ + lane + j * 64] = f2bf(v[j] * rstd * cqg[lane + j * 64]);
            float w[2]; float s2 = 0.f;
#pragma unroll
            for (int j = 0; j < 2; ++j) { w[j] = bf2f(row[C_CKV + lane + j * 64]); s2 += w[j] * w[j]; }
            s2 = wave_sum(s2);
            const float r2 = rsqrtf(s2 * (1.f / 128.f) + EPS);
#pragma unroll
            for (int j = 0; j < 2; ++j) row[C_CKV + lane + j * 64] = f2bf(w[j] * r2 * ckvg[lane + j * 64]);
        }
        {
            const int c = lane * 4;
            const u32x2 cur = *(const u32x2*)(row + C_RWD + c);
            u32x2 pv = (u32x2){0u, 0u}, nx = (u32x2){0u, 0u};
            if (n > 0) pv = *(const u32x2*)(row - LDP + C_RWD + c);
            if (n + 1 < len) nx = *(const u32x2*)(row + LDP + C_RWD + c);
            const float4 m = *(const float4*)(mu3 + c);
            float o[4];
            { const float x = bflo(cur.x); o[0] = x + (0.5f * (bflo(pv.x) + bflo(nx.x)) - x) * m.x; }
            { const float x = bfhi(cur.x); o[1] = x + (0.5f * (bfhi(pv.x) + bfhi(nx.x)) - x) * m.y; }
            { const float x = bflo(cur.y); o[2] = x + (0.5f * (bflo(pv.y) + bflo(nx.y)) - x) * m.z; }
            { const float x = bfhi(cur.y); o[3] = x + (0.5f * (bfhi(pv.y) + bfhi(nx.y)) - x) * m.w; }
            u32x2 ov; ov.x = pack2(o[0], o[1]); ov.y = pack2(o[2], o[3]);
            *(u32x2*)(XL + (size_t)t * 256 + c) = ov;
        }
    }
}

DEV void phase_prep_gemm1(const Params& p, int l, char* smem) {
    const bf16_t* P = wsb(p, OFF_P);
    const bf16_t* w = wsb(p, OFF_WSM) + (size_t)l * WS_PER_LAYER;
    bf16_t* QRAW = wsb(p, OFF_QRAW); bf16_t* KVRAW = wsb(p, OFF_KVRAW); bf16_t* LR = wsb(p, OFF_LR);
    int rot = 0;
    gemm_generic(P + C_CQ, LDP, TT, w + WS_UQT, 192, 192, 192, [&](int r, int c, float v) { QRAW[(size_t)r * 192 + c] = f2bf(v); }, smem, rot);
    rot += (TT / 128) * 2;
    gemm_generic(P + C_CKV, LDP, TT, w + WS_UKVT, 128, 384, 128, [&](int r, int c, float v) { KVRAW[(size_t)r * 384 + c] = f2bf(v); }, smem, rot);
    rot += (TT / 128) * 3;
    gemm_generic(wsb(p, OFF_XL), 256, TT, w + WS_W1C, 256, 192, 256,
                 [&](int r, int c, float v) { const float o = c < 64 ? (1.f - 2.f / (__expf(2.f * v) + 1.f)) : (c < 128 ? v : sigmoidf_(v)); LR[(size_t)r * 192 + c] = f2bf(o); }, smem, rot);
}
DEV void phase_prep_gemm2(const Params& p, int l, char* smem) {
    const bf16_t* w = wsb(p, OFF_WSM) + (size_t)l * WS_PER_LAYER;
    const bf16_t* LR = wsb(p, OFF_LR);
    bf16_t* RWX = wsb(p, OFF_RWX);
    bf16_t* P = wsb(p, OFF_P);
    int rot = 0;
    for (int d = 0; d < 2; ++d) {
        const float* w0 = inp(p, I_RW0) + (l * 2 + d) * 256;
        gemm_generic(LR + d * 32, 192, TT, w + WS_W2 + (size_t)d * 256 * 64, 64, 256, 64,
                     [&](int r, int c, float v) { RWX[(size_t)r * 1024 + d * 256 + c] = f2bf(0.6065306597126334f * sigmoidf_(w0[c] + v)); }, smem, rot);
        rot += (TT / 128) * 2;
        const float* a0 = inp(p, I_RA0) + (l * 2 + d) * 256;
        gemm_generic(LR + 64 + d * 32, 192, TT, w + WS_W2 + (size_t)(2 + d) * 256 * 64, 64, 256, 64,
                     [&](int r, int c, float v) { RWX[(size_t)r * 1024 + 512 + d * 256 + c] = f2bf(sigmoidf_(a0[c] + v)); }, smem, rot);
        rot += (TT / 128) * 2;
    }
    gemm_generic(LR + 128, 192, TT, w + WS_G2T, 64, 256, 64, [&](int r, int c, float v) { P[(size_t)r * LDP + C_RWD + c] = f2bf(v); }, smem, rot);
}

DEV void phase_prep2(const Params& p, int l) {
    const int lane = tidx() & 63, wave = tidx() >> 6;
    const bf16_t* P = wsb(p, OFF_P);
    const bf16_t* QRAW = wsb(p, OFF_QRAW); const bf16_t* KVRAW = wsb(p, OFF_KVRAW);
    bf16_t* MQ = wsb(p, OFF_MLAQ); bf16_t* MK = wsb(p, OFF_MLAK); bf16_t* MV = wsb(p, OFF_MLAV);
    const float* qkg = inp(p, I_MQKG) + l * 96;
    for (int t = bidx() * 4 + wave; t < TT; t += gridDim.x * 4) {
        int base, n, len; tok_seq(t, base, n, len);
        const int h = lane >> 4, j = lane & 15;
        const bool rot = t < TL;
        float cs = 1.f, sn = 0.f;
        if (rot) {
            const int i = j & 7;
            const float inv = exp2f(-(float)(i & 3) * (13.287712379549449f / 4.f));
            const float ang = (i < 4 ? (float)(n >> 6) : (float)(n & 63)) * inv;
            cs = __cosf(ang); sn = __sinf(ang);
        }
        {
            float v[3]; float ss = 0.f;
#pragma unroll
            for (int k = 0; k < 3; ++k) { v[k] = bf2f(QRAW[(size_t)t * 192 + h * 48 + j + k * 16]); ss += v[k] * v[k]; }
            ss = group_sum<16>(ss);
            const float rstd = rsqrtf(ss * (1.f / 48.f) + EPS);
#pragma unroll
            for (int k = 0; k < 3; ++k) v[k] = v[k] * rstd * qkg[j + k * 16];
            if (rot) { const float o = __shfl_xor(v[2], 8, 64); v[2] = (j < 8) ? (v[2] * cs - o * sn) : (v[2] * cs + o * sn); }
            const float qs = 0.14433756729740643f * LOG2E;
#pragma unroll
            for (int k = 0; k < 3; ++k) MQ[(size_t)t * 192 + h * 48 + j + k * 16] = f2bf(v[k] * qs);
        }
        {
            float v[3]; float ss = 0.f;
            v[0] = bf2f(KVRAW[(size_t)t * 384 + h * 96 + j]);
            v[1] = bf2f(KVRAW[(size_t)t * 384 + h * 96 + 16 + j]);
            v[2] = bf2f(P[(size_t)t * LDP + C_KR + j]);
#pragma unroll
            for (int k = 0; k < 3; ++k) ss += v[k] * v[k];
            ss = group_sum<16>(ss);
            const float rstd = rsqrtf(ss * (1.f / 48.f) + EPS);
#pragma unroll
            for (int k = 0; k < 3; ++k) v[k] = v[k] * rstd * qkg[48 + j + k * 16];
            if (rot) { const float o = __shfl_xor(v[2], 8, 64); v[2] = (j < 8) ? (v[2] * cs - o * sn) : (v[2] * cs + o * sn); }
#pragma unroll
            for (int k = 0; k < 3; ++k) MK[(size_t)t * 192 + h * 48 + j + k * 16] = f2bf(v[k]);
        }
#pragma unroll
        for (int k = 0; k < 4; ++k) MV[(size_t)t * 256 + h * 64 + j + k * 16] = KVRAW[(size_t)t * 384 + h * 96 + 32 + j + k * 16];
    }
}
template <int NC, int DK>
struct AttnCfg {
    static constexpr int DKROW = NC * DK, KLD = DKROW + 8, VLD = 68;
    static constexpr int KSTAGE = 64 * KLD, VSTAGE = 64 * VLD;
    static constexpr int KCH = 64 * DKROW / 8;
};
template <int NC, int DK, class EPI>
DEV void attn_item(const bf16_t* Q, int ldq, const bf16_t* Kl, const bf16_t* Kc, int ldk, const bf16_t* Vl, const bf16_t* Vc, int ldv,
                   int q0, int nlat_tiles, int nctx_tiles, EPI epi, char* smem) {
    using C = AttnCfg<NC, DK>;
    constexpr int KS = DK / 16;
    const int tid = tidx(), lane = tid & 63, wave = tid >> 6, ql = lane & 31, hh = lane >> 5;
    bf16_t* Ks = (bf16_t*)smem;
    bf16_t* Vt = Ks + 2 * C::KSTAGE;
    bf16x8 qf[NC][KS];
    {
        const bf16_t* qp = Q + (size_t)(q0 + wave * 32 + ql) * ldq + hh * 8;
#pragma unroll
        for (int c = 0; c < NC; ++c)
#pragma unroll
            for (int ks = 0; ks < KS; ++ks) qf[c][ks] = *(const bf16x8*)(qp + c * DK + ks * 16);
    }
    bf16x8* qpark = (bf16x8*)(smem + 40960) + tid;
    if (NC > 1) {
#pragma unroll
        for (int c = 0; c < NC; ++c)
#pragma unroll
            for (int ks = 0; ks < KS; ++ks) qpark[(c * KS + ks) * NT] = qf[c][ks];
    }
    f32x16 O[NC][2];
    float mrun[NC], lrun[NC];
#pragma unroll
    for (int c = 0; c < NC; ++c) {
        mrun[c] = -1e30f; lrun[c] = 0.f;
#pragma unroll
        for (int d = 0; d < 2; ++d)
#pragma unroll
            for (int r = 0; r < 16; ++r) O[c][d][r] = 0.f;
    }
    const int ntiles = nlat_tiles + nctx_tiles;
    constexpr int KPT = (C::KCH + NT - 1) / NT;
    constexpr bool KFULL = (C::KCH % NT) == 0;
    u32x4 rk[KPT], rv[2];
    auto load_tile = [&](int tile) {
        const bf16_t* kb = tile < nlat_tiles ? Kl + (size_t)tile * 64 * ldk : Kc + (size_t)(tile - nlat_tiles) * 64 * ldk;
        const bf16_t* vb = tile < nlat_tiles ? Vl + (size_t)tile * 64 * ldv : Vc + (size_t)(tile - nlat_tiles) * 64 * ldv;
#pragma unroll
        for (int i = 0; i < KPT; ++i) {
            int q = tid + i * NT; q = (KFULL || q < C::KCH) ? q : C::KCH - 1;
            { const int key = q / (C::DKROW / 8), ch = q % (C::DKROW / 8); rk[i] = *(const u32x4*)(kb + (size_t)key * ldk + ch * 8); }
        }
#pragma unroll
        for (int i = 0; i < 2; ++i) { const int q = tid + i * NT; const int key = q >> 3, ch = q & 7; rv[i] = *(const u32x4*)(vb + (size_t)key * ldv + ch * 8); }
    };
    auto store_tile = [&](int st) {
#pragma unroll
        for (int i = 0; i < KPT; ++i) {
            const int q = tid + i * NT;
            if (KFULL || q < C::KCH) { const int key = q / (C::DKROW / 8), ch = q % (C::DKROW / 8); *(u32x4*)(Ks + st * C::KSTAGE + key * C::KLD + ch * 8) = rk[i]; }
        }
#pragma unroll
        for (int i = 0; i < 2; ++i) {
            const int q = tid + i * NT; const int key = q >> 3, dv0 = (q & 7) * 8;
            bf16_t* vd = Vt + st * C::VSTAGE + dv0 * C::VLD + key;
            const unsigned w[4] = { rv[i][0], rv[i][1], rv[i][2], rv[i][3] };
#pragma unroll
            for (int j = 0; j < 4; ++j) { vd[(2 * j) * C::VLD] = (bf16_t)(w[j] & 0xFFFFu); vd[(2 * j + 1) * C::VLD] = (bf16_t)(w[j] >> 16); }
        }
    };
    load_tile(0);
    __syncthreads();
    store_tile(0);
    __syncthreads();
#pragma unroll 1
    for (int tile = 0; tile < ntiles; ++tile) {
        const int cur = tile & 1;
        if (tile + 1 < ntiles) load_tile(tile + 1);
        __builtin_amdgcn_sched_barrier(0);
        const bf16_t* ks_ = Ks + cur * C::KSTAGE;
        const bf16_t* vt_ = Vt + cur * C::VSTAGE;
#pragma unroll
        for (int c = 0; c < NC; ++c) {
            f32x16 S[2];
#pragma unroll
            for (int kb = 0; kb < 2; ++kb) {
#pragma unroll
                for (int r = 0; r < 16; ++r) S[kb][r] = 0.f;
#pragma unroll
                for (int ks = 0; ks < KS; ++ks) {
                    const bf16x8 kf = *(const bf16x8*)(ks_ + (kb * 32 + ql) * C::KLD + c * DK + ks * 16 + hh * 8);
                    const bf16x8 qv = (NC > 1) ? qpark[(c * KS + ks) * NT] : qf[c][ks];
                    S[kb] = __builtin_amdgcn_mfma_f32_32x32x16_bf16(kf, qv, S[kb], 0, 0, 0);
                }
            }
            float mx = S[0][0];
#pragma unroll
            for (int kb = 0; kb < 2; ++kb)
#pragma unroll
                for (int r = 0; r < 16; ++r) mx = fmaxf(mx, S[kb][r]);
            mx = fmaxf(mx, __shfl_xor(mx, 32, 64));
            const float mnew = fmaxf(mrun[c], mx);
            const float alpha = __builtin_amdgcn_exp2f(mrun[c] - mnew);
            mrun[c] = mnew;
            float ls = 0.f;
#pragma unroll
            for (int kb = 0; kb < 2; ++kb)
#pragma unroll
                for (int r = 0; r < 16; ++r) { const float e = __builtin_amdgcn_exp2f(S[kb][r] - mnew); S[kb][r] = e; ls += e; }
            lrun[c] = lrun[c] * alpha + ls;
#pragma unroll
            for (int d = 0; d < 2; ++d)
#pragma unroll
                for (int r = 0; r < 16; ++r) O[c][d][r] *= alpha;
#pragma unroll
            for (int s = 0; s < 4; ++s) {
                const int kb = s >> 1, s2 = s & 1;
                const u32x4 pu = (u32x4){pack2(S[kb][8 * s2 + 0], S[kb][8 * s2 + 1]), pack2(S[kb][8 * s2 + 2], S[kb][8 * s2 + 3]),
                                         pack2(S[kb][8 * s2 + 4], S[kb][8 * s2 + 5]), pack2(S[kb][8 * s2 + 6], S[kb][8 * s2 + 7])};
                const bf16x8 pf = __builtin_bit_cast(bf16x8, pu);
                const int keyo = kb * 32 + 16 * s2 + 4 * hh;
#pragma unroll
                for (int d = 0; d < 2; ++d) {
                    const bf16_t* vp = vt_ + (d * 32 + ql) * C::VLD + keyo;
                    const u32x2 lo = *(const u32x2*)vp, hi = *(const u32x2*)(vp + 8);
                    const u32x4 vv = (u32x4){lo[0], lo[1], hi[0], hi[1]};
                    const bf16x8 vf = __builtin_bit_cast(bf16x8, vv);
                    O[c][d] = __builtin_amdgcn_mfma_f32_32x32x16_bf16(vf, pf, O[c][d], 0, 0, 0);
                }
            }
        }
        if (tile + 1 < ntiles) store_tile(cur ^ 1);
        __syncthreads();
    }
    float inv[NC];
#pragma unroll
    for (int c = 0; c < NC; ++c) { const float lt = lrun[c] + __shfl_xor(lrun[c], 32, 64); inv[c] = 1.f / lt; }
    epi(O, inv, q0 + wave * 32 + ql, hh);
}

DEV void da_item(const Params& p, int l, int item, char* smem) {
    const bf16_t* P = wsb(p, OFF_P);
    bf16_t* Y = wsb(p, OFF_Y);
    const float linit = 0.8f - 0.6f * __expf(-0.3f * (float)l);
    float lam;
    {
        const float* la = inp(p, I_DALAM) + l * 128;
        const int lane = tidx() & 63;
        float a = lane < 32 ? la[lane] * la[32 + lane] : 0.f, b = lane < 32 ? la[64 + lane] * la[96 + lane] : 0.f;
        a = wave_sum(a); b = wave_sum(b);
        lam = __expf(a) - __expf(b) + linit;
    }
    const float* sg = inp(p, I_DASUB) + l * 64;
    int b, h, qt; bool isctx;
    if (item < 512) { isctx = false; b = item >> 6; h = (item >> 4) & 3; qt = item & 15; }
    else { const int it = item - 512; isctx = true; b = it >> 3; h = (it >> 1) & 3; qt = it & 1; }
    const size_t lat0 = (size_t)b * SEQ, ctx0 = (size_t)TL + (size_t)b * CTXL;
    const size_t qrow0 = isctx ? ctx0 : lat0;
    auto epi2 = [&](f32x16 (&O)[2][2], float (&inv)[2], int qrow, int hh) {
        float v[2][16]; float ss = 0.f;
        const float li1 = lam * inv[1];
#pragma unroll
        for (int d = 0; d < 2; ++d)
#pragma unroll
            for (int r = 0; r < 16; ++r) { const float o = O[0][d][r] * inv[0] - li1 * O[1][d][r]; v[d][r] = o; ss += o * o; }
        ss += __shfl_xor(ss, 32, 64);
        const float rstd = rsqrtf(ss * (1.f / 64.f) + EPS) * (1.f - linit);
        bf16_t* yo = Y + (qrow0 + qrow) * 1024 + h * 64;
#pragma unroll
        for (int d = 0; d < 2; ++d)
#pragma unroll
            for (int g = 0; g < 4; ++g) {
                const int dv = d * 32 + 8 * g + 4 * hh;
                u32x2 o;
                o.x = pack2(v[d][4 * g + 0] * rstd * sg[dv + 0], v[d][4 * g + 1] * rstd * sg[dv + 1]);
                o.y = pack2(v[d][4 * g + 2] * rstd * sg[dv + 2], v[d][4 * g + 3] * rstd * sg[dv + 3]);
                *(u32x2*)(yo + dv) = o;
            }
    };
    const bf16_t* Qp = P + qrow0 * LDP + C_DAQ + h * 64;
    const bf16_t* Kl = P + lat0 * LDP + C_DAK + h * 64;
    const bf16_t* Kc = P + ctx0 * LDP + C_DAK + h * 64;
    const bf16_t* Vl = P + lat0 * LDP + C_DAV + h * 64;
    const bf16_t* Vc = P + ctx0 * LDP + C_DAV + h * 64;
    const int nlat = isctx ? 0 : SEQ / 64;
    attn_item<2, 32>(Qp, LDP, Kl, Kc, LDP, Vl, Vc, LDP, qt * 128, nlat, CTXL / 64, epi2, smem);
}
DEV void mla_item(const Params& p, int l, int item, char* smem) {
    const bf16_t* MQ = wsb(p, OFF_MLAQ); const bf16_t* MK = wsb(p, OFF_MLAK); const bf16_t* MV = wsb(p, OFF_MLAV);
    bf16_t* Y = wsb(p, OFF_Y);
    int b, h, qt; bool isctx;
    if (item < 512) { isctx = false; b = item >> 6; h = (item >> 4) & 3; qt = item & 15; }
    else { const int it = item - 512; isctx = true; b = it >> 3; h = (it >> 1) & 3; qt = it & 1; }
    const size_t lat0 = (size_t)b * SEQ, ctx0 = (size_t)TL + (size_t)b * CTXL;
    const size_t qrow0 = isctx ? ctx0 : lat0;
    auto epi = [&](f32x16 (&O)[1][2], float (&inv)[1], int qrow, int hh) {
        bf16_t* yo = Y + (qrow0 + qrow) * 1024 + 512 + h * 64;
#pragma unroll
        for (int d = 0; d < 2; ++d)
#pragma unroll
            for (int g = 0; g < 4; ++g) {
                const int dv = d * 32 + 8 * g + 4 * hh;
                u32x2 o;
                o.x = pack2(O[0][d][4 * g + 0] * inv[0], O[0][d][4 * g + 1] * inv[0]);
                o.y = pack2(O[0][d][4 * g + 2] * inv[0], O[0][d][4 * g + 3] * inv[0]);
                *(u32x2*)(yo + dv) = o;
            }
    };
    const bf16_t* Qp = MQ + qrow0 * 192 + h * 48;
    const bf16_t* Kl = MK + lat0 * 192 + h * 48;
    const bf16_t* Kc = MK + ctx0 * 192 + h * 48;
    const bf16_t* Vl = MV + lat0 * 256 + h * 64;
    const bf16_t* Vc = MV + ctx0 * 256 + h * 64;
    attn_item<1, 48>(Qp, 192, Kl, Kc, 192, Vl, Vc, 256, qt * 128, isctx ? 0 : SEQ / 64, CTXL / 64, epi, smem);
}
DEV int s5_token(int b, int tb, int n) { return tb == 0 ? TL + b * CTXL + n : b * SEQ + (tb - 1) * 256 + n; }
struct S5M { float are, aim; bf16x8* bfl; };
DEV void s5_coef(const Params& p, int gi, int pl, float& are, float& aim, float& cr, float& ci) {
    const float lre = inp(p, I_S5LRE)[gi * 64 + pl], lim = inp(p, I_S5LIM)[gi * 64 + pl];
    const float dt = __expf(inp(p, I_S5LDT)[gi]);
    const float mag = __expf(lre * dt);
    are = mag * __cosf(lim * dt); aim = mag * __sinf(lim * dt);
    const float nr = are - 1.f, ni = aim, den = 1.f / (lre * lre + lim * lim);
    cr = (nr * lre + ni * lim) * den; ci = (ni * lre - nr * lim) * den;
}
DEV void s5_setup(const Params& p, int l, int d, int g, int lane, S5M& s, bf16x8* bfl) {
    s.bfl = bfl;
    const int gi = ((l * 2 + d) * 16 + g), c16 = lane & 15, kq = lane >> 4;
    float cr, ci;
    s5_coef(p, gi, lane, s.are, s.aim, cr, ci);
#pragma unroll
    for (int nt = 0; nt < 4; ++nt) {
        const int pp = nt * 16 + c16;
        float a0, a1; s5_coef(p, gi, pp, a0, a1, cr, ci);
        float re[8], im[8];
        const float* br = inp(p, I_S5BRE) + ((size_t)gi * 64 + pp) * 16 + (kq & 1) * 8;
        const float* bi = inp(p, I_S5BIM) + ((size_t)gi * 64 + pp) * 16 + (kq & 1) * 8;
#pragma unroll
        for (int j = 0; j < 8; ++j) { const float x = br[j], y = bi[j]; const bool on = kq < 2; re[j] = on ? cr * x - ci * y : 0.f; im[j] = on ? cr * y + ci * x : 0.f; }
        bfl[nt * 64 + lane] = __builtin_bit_cast(bf16x8, (u32x4){pack2(re[0], re[1]), pack2(re[2], re[3]), pack2(re[4], re[5]), pack2(re[6], re[7])});
        bfl[(nt + 4) * 64 + lane] = __builtin_bit_cast(bf16x8, (u32x4){pack2(im[0], im[1]), pack2(im[2], im[3]), pack2(im[4], im[5]), pack2(im[6], im[7])});
    }
}
DEV void s5_bu32(const S5M& s, const bf16_t* P, int b, int tb, int g, int sc, bf16_t* hb, int lane) {
    asm volatile("" : "+v"(sc));
    const int c16 = lane & 15, kq = lane >> 4;
    bf16x8 uf[2];
#pragma unroll
    for (int mt = 0; mt < 2; ++mt) {
        const int t = s5_token(b, tb, sc * 32 + mt * 16 + c16);
        const u32x4 raw = *(const u32x4*)(P + (size_t)t * LDP + C_S5 + g * 16 + (kq & 1) * 8);
        const u32x4 z = (u32x4){0u, 0u, 0u, 0u};
        uf[mt] = __builtin_bit_cast(bf16x8, kq < 2 ? raw : z);
    }
#pragma unroll
    for (int nt = 0; nt < 8; ++nt)
#pragma unroll
        for (int mt = 0; mt < 2; ++mt) {
            const f32x4 acc = __builtin_amdgcn_mfma_f32_16x16x32_bf16(s.bfl[nt * 64 + lane], uf[mt], (f32x4){0.f, 0.f, 0.f, 0.f}, 0, 0, 0);
            u32x2 o; o.x = pack2(acc[0], acc[1]); o.y = pack2(acc[2], acc[3]);
            *(u32x2*)(hb + (mt * 16 + c16) * 136 + nt * 16 + kq * 4) = o;
            if (mt == 1 && (nt & 1)) __builtin_amdgcn_sched_barrier(0);
        }
}
template <bool DUMP>
DEV void s5_scan32(const S5M& s, float& hre, float& him, bf16_t* hb, int pl, bool rev) {
#pragma unroll 4
    for (int j = 0; j < 32; ++j) {
        const int rowi = rev ? 31 - j : j;
        const float bur = bf2f(hb[rowi * 136 + pl]), bui = bf2f(hb[rowi * 136 + 64 + pl]);
        const float nre = s.are * hre - s.aim * him + bur;
        const float nim = s.are * him + s.aim * hre + bui;
        hre = nre; him = nim;
        if (DUMP) { hb[rowi * 136 + pl] = f2bf(hre); hb[rowi * 136 + 64 + pl] = f2bf(him); }
    }
}
DEV void phase_s5_pass1(const Params& p, int l, char* smem) {
    const int lane = tidx() & 63, wave = tidx() >> 6;
    bf16_t* hb = (bf16_t*)smem + wave * (32 * 136);
    const bf16_t* P = wsb(p, OFF_P);
    float* st = wsf(p, OFF_S5ST);
    const int nitems = 2 * 8 * 16 * 8;
    for (int it0 = bidx() * 4; it0 < nitems; it0 += gridDim.x * 4) {
        const int it = it0 + wave;
        const int seg = it & 7, g = (it >> 3) & 15, b = (it >> 7) & 7, d = it >> 10;
        const int tb = seg == 0 ? 0 : (d == 0 ? seg : 9 - seg);
        __syncthreads();
        S5M s; s5_setup(p, l, d, g, lane, s, (bf16x8*)(smem + 36864) + wave * 512);
        float hre = 0.f, him = 0.f;
        for (int k = 0; k < 8; ++k) {
            const int sc = d == 0 ? k : 7 - k;
            __syncthreads();
            s5_bu32(s, P, b, tb, g, sc, hb, lane);
            __syncthreads();
            s5_scan32<false>(s, hre, him, hb, lane, d == 1);
        }
        float* o = st + ((((size_t)d * 8 + b) * 16 + g) * 8 + seg) * 128;
        o[lane] = hre; o[64 + lane] = him;
    }
}
DEV void s5_pass2_item(const Params& p, int l, int tb0, int bitem, char* smem) {
    const int lane = tidx() & 63, wave = tidx() >> 6;
    bf16_t* hb = (bf16_t*)smem + wave * (32 * 136);
    bf16_t* P = wsb(p, OFF_P);
    bf16_t* S5Y = wsb(p, OFF_S5Y);
    const float* st = wsf(p, OFF_S5ST);
    const int it = bitem * 4 + wave;
    const int g = it & 15, b = (it >> 4) & 7, tb = (it >> 7) + tb0;
    const int c = lane & 15;
    const float dd = inp(p, I_S5D)[(l * 16 + g) * 16 + c];
#pragma unroll 1
    for (int d = 0; d < 2; ++d) {
        __syncthreads();
        S5M s; s5_setup(p, l, d, g, lane, s, (bf16x8*)(smem + 36864) + wave * 512);
        bf16x8 cf[4];
        {
            const float* cre = inp(p, I_S5CRE) + ((size_t)((l * 2 + d) * 16 + g) * 16 + c) * 64 + (lane >> 4) * 8;
            const float* cim = inp(p, I_S5CIM) + ((size_t)((l * 2 + d) * 16 + g) * 16 + c) * 64 + (lane >> 4) * 8;
#pragma unroll
            for (int ks = 0; ks < 4; ++ks) {
                const float* src = ks < 2 ? cre + ks * 32 : cim + (ks - 2) * 32;
                const float4 a = *(const float4*)src, b4 = *(const float4*)(src + 4);
                const float sg = ks < 2 ? 1.f : -1.f;
                cf[ks] = __builtin_bit_cast(bf16x8, (u32x4){pack2(sg * a.x, sg * a.y), pack2(sg * a.z, sg * a.w), pack2(sg * b4.x, sg * b4.y), pack2(sg * b4.z, sg * b4.w)});
            }
        }
        const int seg = tb == 0 ? 0 : (d == 0 ? tb : 9 - tb);
        float hre = 0.f, him = 0.f;
        {
            float pr = s.are, pi = s.aim;
#pragma unroll
            for (int q = 0; q < 8; ++q) { const float nr = pr * pr - pi * pi, ni = 2.f * pr * pi; pr = nr; pi = ni; }
            const float* hs = st + (((size_t)d * 8 + b) * 16 + g) * 8 * 128;
            for (int i = 0; i < seg; ++i) {
                const float er = hs[i * 128 + lane], ei = hs[i * 128 + 64 + lane];
                const float nr = pr * hre - pi * him + er, ni = pr * him + pi * hre + ei;
                hre = nr; him = ni;
            }
        }
#pragma unroll 1
        for (int k = 0; k < 8; ++k) {
            const int sc = d == 0 ? k : 7 - k;
            __syncthreads();
            s5_bu32(s, P, b, tb, g, sc, hb, lane);
            __syncthreads();
            s5_scan32<true>(s, hre, him, hb, lane, d == 1);
            __syncthreads();
#pragma unroll
            for (int mt = 0; mt < 2; ++mt) {
                f32x4 y = (f32x4){0.f, 0.f, 0.f, 0.f};
#pragma unroll
                for (int ks = 0; ks < 4; ++ks) {
                    const bf16x8 af = *(const bf16x8*)(hb + (mt * 16 + (lane & 15)) * 136 + ks * 32 + (lane >> 4) * 8);
                    y = __builtin_amdgcn_mfma_f32_16x16x32_bf16(af, cf[ks], y, 0, 0, 0);
                }
#pragma unroll
                for (int r = 0; r < 4; ++r) {
                    const int n = sc * 32 + mt * 16 + (lane >> 4) * 4 + r;
                    const size_t t = (size_t)s5_token(b, tb, n);
                    if (d == 0) S5Y[t * 256 + g * 16 + c] = f2bf(y[r]);
                    else {
                        bf16_t* up = P + t * LDP + C_S5 + g * 16 + c;
                        const float yy = dd * bf2f(*up) + bf2f(S5Y[t * 256 + g * 16 + c]) + y[r];
                        *up = f2bf(0.5f * yy * (1.f + tanhf(0.7978845608028654f * (yy + 0.044715f * yy * yy * yy))));
                    }
                }
            }
        }
    }
}

DEV float row16_sum(float v) {
    v += __int_as_float(__builtin_amdgcn_mov_dpp(__float_as_int(v), 0x128, 0xf, 0xf, true));
    v += __int_as_float(__builtin_amdgcn_mov_dpp(__float_as_int(v), 0x124, 0xf, 0xf, true));
    v += __int_as_float(__builtin_amdgcn_mov_dpp(__float_as_int(v), 0x122, 0xf, 0xf, true));
    v += __int_as_float(__builtin_amdgcn_mov_dpp(__float_as_int(v), 0x121, 0xf, 0xf, true));
    return v;
}
DEV float fmul_(float a, float b) { return a * b; }
DEV float fadd_(float a, float b) { return a + b; }
DEV float ffma_(float a, float b, float c) { return __builtin_fmaf(a, b, c); }
DEV float fnma_(float a, float b, float c) { return __builtin_fmaf(-a, b, c); }
DEV float row8_sum(float v) {
    v += __int_as_float(__builtin_amdgcn_mov_dpp(__float_as_int(v), 0x141, 0xf, 0xf, true));
    v += __int_as_float(__builtin_amdgcn_mov_dpp(__float_as_int(v), 0xB1, 0xf, 0xf, true));
    v += __int_as_float(__builtin_amdgcn_mov_dpp(__float_as_int(v), 0x4E, 0xf, 0xf, true));
    return v;
}
DEV float row16_sum1(float v) { v += __int_as_float(__builtin_amdgcn_mov_dpp(__float_as_int(v), 0x128, 0xf, 0xf, true)); return v; }
constexpr int RW_CT = 16;
struct RwRaw { u32x2 r[3], k[3], v[3], sd, a; float fp, fn; };
#ifndef RWVAR
#define RWVAR 0
#endif
template <int var>
DEV void rw_item_t(const Params& p, int l, int item, char* smem, int rep) {
    const int tid = tidx(), li = tid >> 4, lc = tid & 15;
    const int ch = item >> 2, rg = item & 3, dir = ch >> 5, b = (ch >> 2) & 7, head = ch & 3;
    float* buf = (float*)smem;
    float* ybuf = buf + 2 * RW_CT * 384;
    const bf16_t* P = wsb(p, OFF_P);
    const bf16_t* RWX = wsb(p, OFF_RWX);
    bf16_t* RWY = wsb(p, OFF_RWY) + (size_t)dir * TT * 256 + (rep > 0 ? (size_t)2 * TT * 256 : 0);
    const int hc = head * 64 + lc * 4;
    const float4 mur = *(const float4*)(inp(p, I_RMU) + (l * 4 + 0) * 256 + hc);
    const float4 muk = *(const float4*)(inp(p, I_RMU) + (l * 4 + 1) * 256 + hc);
    const float4 muv = *(const float4*)(inp(p, I_RMU) + (l * 4 + 2) * 256 + hc);
    const float4 kk4 = *(const float4*)(inp(p, I_RKK) + l * 256 + hc);
    const float4 ka4 = *(const float4*)(inp(p, I_RKA) + l * 256 + hc);
    const int NCH = (CTXL + SEQ) / RW_CT;
    auto tok_of = [&](int cidx, int i, int& n, int& len) -> int {
        if (cidx < CTXL / RW_CT) { const int pos = cidx * RW_CT + i; len = CTXL; n = dir == 0 ? pos : CTXL - 1 - pos; return TL + b * CTXL + n; }
        const int pos = (cidx - CTXL / RW_CT) * RW_CT + i; len = SEQ; n = dir == 0 ? pos : SEQ - 1 - pos; return b * SEQ + n;
    };
    auto load_raw = [&](int cidx, RwRaw& raw) {
        int n, len; const int t = tok_of(cidx, li, n, len);
        const bf16_t* row = P + (size_t)t * LDP;
        const bool hp = n > 0, hn = n + 1 < len;
        const bf16_t* rp = hp ? row - LDP : row;
        const bf16_t* rn = hn ? row + LDP : row;
        raw.fp = hp ? 0.5f : 0.f; raw.fn = hn ? 0.5f : 0.f;
        raw.r[1] = *(const u32x2*)(row + C_RWR + hc); raw.k[1] = *(const u32x2*)(row + C_RWK + hc); raw.v[1] = *(const u32x2*)(row + C_RWV + hc);
        raw.r[0] = *(const u32x2*)(rp + C_RWR + hc); raw.k[0] = *(const u32x2*)(rp + C_RWK + hc); raw.v[0] = *(const u32x2*)(rp + C_RWV + hc);
        raw.r[2] = *(const u32x2*)(rn + C_RWR + hc); raw.k[2] = *(const u32x2*)(rn + C_RWK + hc); raw.v[2] = *(const u32x2*)(rn + C_RWV + hc);
        raw.sd = *(const u32x2*)(RWX + (size_t)t * 1024 + dir * 256 + hc);
        raw.a = *(const u32x2*)(RWX + (size_t)t * 1024 + 512 + dir * 256 + hc);
    };
    auto mix4 = [&](const u32x2 (&s)[3], const float4& mu, float fp, float fn, float (&o)[4]) {
        { const float x = bflo(s[1].x); o[0] = x + ((fp * bflo(s[0].x) + fn * bflo(s[2].x)) - x) * mu.x; }
        { const float x = bfhi(s[1].x); o[1] = x + ((fp * bfhi(s[0].x) + fn * bfhi(s[2].x)) - x) * mu.y; }
        { const float x = bflo(s[1].y); o[2] = x + ((fp * bflo(s[0].y) + fn * bflo(s[2].y)) - x) * mu.z; }
        { const float x = bfhi(s[1].y); o[3] = x + ((fp * bfhi(s[0].y) + fn * bfhi(s[2].y)) - x) * mu.w; }
    };
    auto stage = [&](int st, const RwRaw& raw) {
        float r4[4], k4[4], v4[4];
        mix4(raw.r, mur, raw.fp, raw.fn, r4); mix4(raw.k, muk, raw.fp, raw.fn, k4); mix4(raw.v, muv, raw.fp, raw.fn, v4);
        const float kkr[4] = { k4[0] * kk4.x, k4[1] * kk4.y, k4[2] * kk4.z, k4[3] * kk4.w };
        float nn = kkr[0] * kkr[0] + kkr[1] * kkr[1] + kkr[2] * kkr[2] + kkr[3] * kkr[3];
        nn = row16_sum(nn);
        const float rn = 1.f / fmaxf(sqrtf(nn), 1e-12f);
        const float a[4] = { bflo(raw.a.x), bfhi(raw.a.x), bflo(raw.a.y), bfhi(raw.a.y) };
        const float sd[4] = { bflo(raw.sd.x), bfhi(raw.sd.x), bflo(raw.sd.y), bfhi(raw.sd.y) };
        const float kav[4] = { ka4.x, ka4.y, ka4.z, ka4.w };
        float* d = buf + (st * RW_CT + li) * 384 + lc * 4;
        float wp[4], kp[4], bp[4], mp[4];
#pragma unroll
        for (int j = 0; j < 4; ++j) {
            wp[j] = __expf(-sd[j]);
            kp[j] = kkr[j] * rn;
            bp[j] = kp[j] * a[j];
            mp[j] = k4[j] * (1.f + (a[j] - 1.f) * kav[j]);
        }
        *(float4*)(d + 0) = make_float4(wp[0], wp[1], wp[2], wp[3]); *(float4*)(d + 64) = make_float4(kp[0], kp[1], kp[2], kp[3]);
        *(float4*)(d + 128) = make_float4(bp[0], bp[1], bp[2], bp[3]); *(float4*)(d + 192) = make_float4(mp[0], mp[1], mp[2], mp[3]);
        *(float4*)(d + 256) = make_float4(r4[0], r4[1], r4[2], r4[3]);
        *(float4*)(d + 320) = make_float4(v4[0], v4[1], v4[2], v4[3]);
    };
    f32x2_ Sa = (f32x2_){0.f, 0.f}, Sb = (f32x2_){0.f, 0.f};
    auto compute = [&](int cidx, int cur, const RwRaw& rs, bool do_stage) {
        float sr4[4], sk4[4], sv4[4], skkr[4], srn = 0.f;
        const float* cb = buf + cur * RW_CT * 384 + lc * 4;
        const float* vb = buf + cur * RW_CT * 384 + 320 + rg * 16 + li;
        const bool yb0 = (lc & 4) == 0, yb1 = (lc & 2) == 0, yb2 = (lc & 1) == 0, yb3 = (lc & 8) == 0;
        float yq0 = 0.f, yq1 = 0.f, yq2 = 0.f, yq3 = 0.f, ykeep = 0.f;
        f32x4 w[2], kk[2], bb[2], km[2], rr[2]; float vv[2];
        w[0] = *(const f32x4*)(cb); kk[0] = *(const f32x4*)(cb + 64); bb[0] = *(const f32x4*)(cb + 128); km[0] = *(const f32x4*)(cb + 192); rr[0] = *(const f32x4*)(cb + 256);
        vv[0] = vb[0];
#pragma unroll
        for (int j = 0; j < RW_CT; ++j) {
            const int c0 = j & 1, c2 = c0 ^ 1;
            if (j + 1 < RW_CT) {
                const float* nb = cb + (j + 1) * 384;
                w[c2] = *(const f32x4*)(nb); kk[c2] = *(const f32x4*)(nb + 64); bb[c2] = *(const f32x4*)(nb + 128); km[c2] = *(const f32x4*)(nb + 192); rr[c2] = *(const f32x4*)(nb + 256);
                vv[c2] = vb[(j + 1) * 384];
            }
            const f32x2_ v2 = (f32x2_){vv[c0], vv[c0]};
            const f32x2_ pa = __builtin_elementwise_fma(Sb, kk[c0].zw, Sa * kk[c0].xy);
            const f32x2_ ta = __builtin_elementwise_fma(Sa, w[c0].xy, v2 * km[c0].xy), tb = __builtin_elementwise_fma(Sb, w[c0].zw, v2 * km[c0].zw);
            const float sa = row16_sum(fadd_(pa.x, pa.y));
            const f32x2_ nsa = (f32x2_){-sa, -sa};
            Sa = __builtin_elementwise_fma(nsa, bb[c0].xy, ta); Sb = __builtin_elementwise_fma(nsa, bb[c0].zw, tb);
            const f32x2_ py = __builtin_elementwise_fma(Sb, rr[c0].zw, Sa * rr[c0].xy);
            {
                float c = fadd_(py.x, py.y);
                if (j & 1) {
                    { const float t = yb0 ? yq0 : c, u = yb0 ? c : yq0; c = t + __int_as_float(__builtin_amdgcn_mov_dpp(__float_as_int(u), 0x141, 0xf, 0xf, true)); }
                    if (j & 2) {
                        { const float t = yb1 ? yq1 : c, u = yb1 ? c : yq1; c = t + __int_as_float(__builtin_amdgcn_mov_dpp(__float_as_int(u), 0x4E, 0xf, 0xf, true)); }
                        if (j & 4) {
                            { const float t = yb2 ? yq2 : c, u = yb2 ? c : yq2; c = t + __int_as_float(__builtin_amdgcn_mov_dpp(__float_as_int(u), 0xB1, 0xf, 0xf, true)); }
                            if (j & 8) {
                                const float t = yb3 ? yq3 : c, u = yb3 ? c : yq3; ykeep = t + __int_as_float(__builtin_amdgcn_mov_dpp(__float_as_int(u), 0x128, 0xf, 0xf, true));
                            } else yq3 = c;
                        } else yq2 = c;
                    } else yq1 = c;
                } else yq0 = c;
            }
            if (j == 2) { mix4(rs.r, mur, rs.fp, rs.fn, sr4); }
            if (j == 5) { mix4(rs.k, muk, rs.fp, rs.fn, sk4); }
            if (j == 8) { mix4(rs.v, muv, rs.fp, rs.fn, sv4); }
            if (j == 11) {
                skkr[0] = sk4[0] * kk4.x; skkr[1] = sk4[1] * kk4.y; skkr[2] = sk4[2] * kk4.z; skkr[3] = sk4[3] * kk4.w;
                float nn = skkr[0] * skkr[0] + skkr[1] * skkr[1] + skkr[2] * skkr[2] + skkr[3] * skkr[3];
                nn = row16_sum(nn);
                srn = 1.f / fmaxf(sqrtf(nn), 1e-12f);
            }
        }
        if (do_stage) {
            const float a[4] = { bflo(rs.a.x), bfhi(rs.a.x), bflo(rs.a.y), bfhi(rs.a.y) };
            const float sd[4] = { bflo(rs.sd.x), bfhi(rs.sd.x), bflo(rs.sd.y), bfhi(rs.sd.y) };
            const float kav[4] = { ka4.x, ka4.y, ka4.z, ka4.w };
            float* d = buf + ((cur ^ 1) * RW_CT + li) * 384 + lc * 4;
            float wp[4], kp[4], bp[4], mp[4];
#pragma unroll
            for (int q = 0; q < 4; ++q) {
                wp[q] = __expf(-sd[q]);
                kp[q] = skkr[q] * srn;
                bp[q] = kp[q] * a[q];
                mp[q] = sk4[q] * (1.f + (a[q] - 1.f) * kav[q]);
            }
            *(float4*)(d + 0) = make_float4(wp[0], wp[1], wp[2], wp[3]); *(float4*)(d + 64) = make_float4(kp[0], kp[1], kp[2], kp[3]);
            *(float4*)(d + 128) = make_float4(bp[0], bp[1], bp[2], bp[3]); *(float4*)(d + 192) = make_float4(mp[0], mp[1], mp[2], mp[3]);
            *(float4*)(d + 256) = make_float4(sr4[0], sr4[1], sr4[2], sr4[3]);
            *(float4*)(d + 320) = make_float4(sv4[0], sv4[1], sv4[2], sv4[3]);
        }
        {
            const int ys = ((lc >> 2) & 1) | (lc & 2) | ((lc & 1) << 2) | (lc & 8);
            int n, len; const int t = tok_of(cidx, ys, n, len);
            RWY[(size_t)t * 256 + head * 64 + rg * 16 + li] = f2bf(ykeep);
        }
    };
    RwRaw rawA, rawB;
    __syncthreads();
    load_raw(0, rawA);
    stage(0, rawA);
    load_raw(1, rawA);
    __syncthreads();
    for (int cidx = 0; cidx < NCH; cidx += 2) {
        load_raw(min(cidx + 2, NCH - 1), rawB);
        compute(cidx, 0, rawA, true);
        __syncthreads();
        load_raw(min(cidx + 3, NCH - 1), rawA);
        compute(cidx + 1, 1, rawB, cidx + 2 < NCH);
        __syncthreads();
    }
}

DEV void rw_item(const Params& p, int l, int item, char* smem, int rep = 0) {
    rw_item_t<RWVAR>(p, l, item, smem, rep);
}
constexpr int RC = 32, SK = 72, ST = 40;
constexpr int L_K1 = 0, L_R1 = L_K1 + RC * SK, L_B1 = L_R1 + RC * SK, L_M1 = L_B1 + RC * SK,
              L_VT = L_M1 + RC * SK, L_B2T = L_VT + 64 * ST, L_M2T = L_B2T + 64 * ST,
              L_X = L_M2T + 64 * ST, L_XT = L_X + RC * ST, L_PA = L_XT + RC * ST, L_BM = L_PA + RC * ST, L_AR = L_BM + RC * ST, L_BR = L_AR + RC * ST,
              L_ET = L_BR + RC * ST, L_ZT = L_ET + 64 * ST, L_S = L_ZT + 64 * ST, L_RWEND = L_S + 64 * SK;
static_assert(L_RWEND * 2 + 256 <= 73728, "RWKV chunk LDS");
DEV bf16x8 ldfrag(const bf16_t* m, int stride, int row0, int k0, int lane) { return *(const bf16x8*)(m + (row0 + (lane & 15)) * stride + k0 + (lane >> 4) * 8); }
DEV f32x4 mfma16(bf16x8 a, bf16x8 b, f32x4 c) { return __builtin_amdgcn_mfma_f32_16x16x32_bf16(a, b, c, 0, 0, 0); }
#ifndef RWC_CLAMP
#define RWC_CLAMP 0
#endif
DEV void st4(bf16_t* dst, f32x4 v) {
    if (RWC_CLAMP) { for (int i = 0; i < 4; ++i) v[i] = fminf(fmaxf(v[i], -8.f), 8.f); } u32x2 o; o.x = pack2(v[0], v[1]); o.y = pack2(v[2], v[3]); *(u32x2*)dst = o; }
DEV void unpack8(const u32x4 u, float (&o)[8]) {
    o[0] = bflo(u[0]); o[1] = bfhi(u[0]); o[2] = bflo(u[1]); o[3] = bfhi(u[1]); o[4] = bflo(u[2]); o[5] = bfhi(u[2]); o[6] = bflo(u[3]); o[7] = bfhi(u[3]);
}
DEV u32x4 pack8(const float (&v)[8]) { return (u32x4){pack2(v[0], v[1]), pack2(v[2], v[3]), pack2(v[4], v[5]), pack2(v[6], v[7])}; }
struct RwcRaw { u32x4 r[3], k[3], v[3], sd, a; float fp, fn; };
#ifndef RWC_STOP
#define RWC_STOP 99
#endif
#ifndef RWC_DUMMY
#define RWC_DUMMY 0
#endif
#ifdef RWC_NOINLINE
__device__ __attribute__((noinline)) void rwc_item(const Params& p, int l, int chain, char* smem) {
#else
DEV void rwc_item(const Params& p, int l, int chain, char* smem) {
#endif
    const int tid = tidx(), lane = tid & 63, wave = __builtin_amdgcn_readfirstlane(tid >> 6), c16 = lane & 15, q4 = lane >> 4;
    const int dir = chain >> 5, b = (chain >> 2) & 7, head = chain & 3;
    bf16_t* L = (bf16_t*)smem;
    float* PC = (float*)(smem + L_RWEND * 2);
    float* CS = (float*)(L + L_ET);
    const bf16_t* P = wsb(p, OFF_P);
    const bf16_t* RWX = wsb(p, OFF_RWX);
    bf16_t* RWY = wsb(p, OFF_RWY) + (size_t)dir * TT * 256 + (RWC_DUMMY ? (size_t)2 * TT * 256 : 0);
    const int li = tid >> 3, c8 = (tid & 7) * 8, hc = head * 64 + c8;
    const int NCHK = (CTXL + SEQ) / RC;
    auto tok_of = [&](int c, int i, int& n, int& len) -> int {
        if (c < CTXL / RC) { const int pos = c * RC + i; len = CTXL; n = dir == 0 ? pos : CTXL - 1 - pos; return TL + b * CTXL + n; }
        const int pos = (c - CTXL / RC) * RC + i; len = SEQ; n = dir == 0 ? pos : SEQ - 1 - pos; return b * SEQ + n;
    };
    RwcRaw raw;
    auto load_raw = [&](int c) {
        int n, len; const int t = tok_of(c, li, n, len);
        const bf16_t* row = P + (size_t)t * LDP;
        const bool hp = n > 0, hn = n + 1 < len;
        const bf16_t* rp = hp ? row - LDP : row;
        const bf16_t* rn = hn ? row + LDP : row;
        raw.fp = hp ? 0.5f : 0.f; raw.fn = hn ? 0.5f : 0.f;
        raw.r[1] = *(const u32x4*)(row + C_RWR + hc); raw.k[1] = *(const u32x4*)(row + C_RWK + hc); raw.v[1] = *(const u32x4*)(row + C_RWV + hc);
        raw.r[0] = *(const u32x4*)(rp + C_RWR + hc); raw.k[0] = *(const u32x4*)(rp + C_RWK + hc); raw.v[0] = *(const u32x4*)(rp + C_RWV + hc);
        raw.r[2] = *(const u32x4*)(rn + C_RWR + hc); raw.k[2] = *(const u32x4*)(rn + C_RWK + hc); raw.v[2] = *(const u32x4*)(rn + C_RWV + hc);
        raw.sd = *(const u32x4*)(RWX + (size_t)t * 1024 + dir * 256 + hc);
        raw.a = *(const u32x4*)(RWX + (size_t)t * 1024 + 512 + dir * 256 + hc);
    };
    auto mix8 = [&](const u32x4 (&s)[3], const float* mu, float (&o)[8]) {
        float x[8], pv[8], nx[8]; unpack8(s[1], x); unpack8(s[0], pv); unpack8(s[2], nx);
        const float4 m0 = *(const float4*)mu, m1 = *(const float4*)(mu + 4);
        const float m[8] = { m0.x, m0.y, m0.z, m0.w, m1.x, m1.y, m1.z, m1.w };
#pragma unroll
        for (int j = 0; j < 8; ++j) o[j] = x[j] + ((raw.fp * pv[j] + raw.fn * nx[j]) - x[j]) * m[j];
    };
    f32x4 Wt[4];
#pragma unroll
    for (int j = 0; j < 4; ++j) Wt[j] = (f32x4){0.f, 0.f, 0.f, 0.f};
    __syncthreads();
    for (int i = tid; i < 64 * SK / 2; i += NT) ((unsigned*)(L + L_S))[i] = 0u;
    load_raw(0);
    for (int c = 0; c < (RWC_STOP == 0 ? 0 : NCHK); ++c) {
        {
            float r8[8], k8[8], v8[8], a8[8], sd8[8];
            mix8(raw.r, inp(p, I_RMU) + (l * 4 + 0) * 256 + hc, r8);
            mix8(raw.k, inp(p, I_RMU) + (l * 4 + 1) * 256 + hc, k8);
            mix8(raw.v, inp(p, I_RMU) + (l * 4 + 2) * 256 + hc, v8);
            unpack8(raw.a, a8); unpack8(raw.sd, sd8);
            if (c + 1 < NCHK) load_raw(c + 1);
            const float4 kk0 = *(const float4*)(inp(p, I_RKK) + l * 256 + hc), kk1 = *(const float4*)(inp(p, I_RKK) + l * 256 + hc + 4);
            const float4 ka0 = *(const float4*)(inp(p, I_RKA) + l * 256 + hc), ka1 = *(const float4*)(inp(p, I_RKA) + l * 256 + hc + 4);
            const float kkc[8] = { kk0.x, kk0.y, kk0.z, kk0.w, kk1.x, kk1.y, kk1.z, kk1.w };
            const float kac[8] = { ka0.x, ka0.y, ka0.z, ka0.w, ka1.x, ka1.y, ka1.z, ka1.w };
            float kkv[8], bbv[8], kmv[8]; float n2 = 0.f;
#pragma unroll
            for (int j = 0; j < 8; ++j) { kkv[j] = k8[j] * kkc[j]; n2 += kkv[j] * kkv[j]; }
            n2 = row8_sum(n2);
            const float rn = 1.f / fmaxf(sqrtf(n2), 1e-12f);
#pragma unroll
            for (int j = 0; j < 8; ++j) { kkv[j] *= rn; bbv[j] = kkv[j] * a8[j]; kmv[j] = k8[j] * (1.f + (a8[j] - 1.f) * kac[j]); }
            *(float4*)(CS + li * 64 + c8) = make_float4(sd8[0], sd8[1], sd8[2], sd8[3]);
            *(float4*)(CS + li * 64 + c8 + 4) = make_float4(sd8[4], sd8[5], sd8[6], sd8[7]);
            __syncthreads();
            if (tid < 64) { float run = 0.f; for (int i = 0; i < RC; ++i) { run += CS[i * 64 + tid]; CS[i * 64 + tid] = run; } }
            __syncthreads();
            float cs[8], tot[8];
            { const float4 a0 = *(const float4*)(CS + li * 64 + c8), a1 = *(const float4*)(CS + li * 64 + c8 + 4);
              const float4 t0 = *(const float4*)(CS + (RC - 1) * 64 + c8), t1 = *(const float4*)(CS + (RC - 1) * 64 + c8 + 4);
              cs[0] = a0.x; cs[1] = a0.y; cs[2] = a0.z; cs[3] = a0.w; cs[4] = a1.x; cs[5] = a1.y; cs[6] = a1.z; cs[7] = a1.w;
              tot[0] = t0.x; tot[1] = t0.y; tot[2] = t0.z; tot[3] = t0.w; tot[4] = t1.x; tot[5] = t1.y; tot[6] = t1.z; tot[7] = t1.w; }
            float k1[8], r1[8], b1[8], m1[8], b2[8], m2[8];
#pragma unroll
            for (int j = 0; j < 8; ++j) {
                const float pinc = __expf(-cs[j]), pexc = __expf(sd8[j] - cs[j]), einv = __expf(cs[j]), ec = __expf(cs[j] - tot[j]);
                k1[j] = kkv[j] * pexc; r1[j] = r8[j] * pinc; b1[j] = bbv[j] * einv; m1[j] = kmv[j] * einv; b2[j] = bbv[j] * ec; m2[j] = kmv[j] * ec;
            }
            __syncthreads();
            *(u32x4*)(L + L_K1 + li * SK + c8) = pack8(k1); *(u32x4*)(L + L_R1 + li * SK + c8) = pack8(r1);
            *(u32x4*)(L + L_B1 + li * SK + c8) = pack8(b1); *(u32x4*)(L + L_M1 + li * SK + c8) = pack8(m1);
#pragma unroll
            for (int j = 0; j < 8; ++j) {
                L[L_VT + (c8 + j) * ST + li] = f2bf(v8[j]); L[L_B2T + (c8 + j) * ST + li] = f2bf(b2[j]); L[L_M2T + (c8 + j) * ST + li] = f2bf(m2[j]);
            }
            if (li == RC - 1) {
#pragma unroll
                for (int j = 0; j < 8; ++j) PC[c8 + j] = __expf(-tot[j]);
            }
            __syncthreads();
        }
        if (RWC_STOP <= 1) continue;
        {
            const int i0 = wave >> 1, j0 = wave & 1;
            const f32x4 z4 = (f32x4){0.f, 0.f, 0.f, 0.f};
            f32x4 aS = z4, aU = z4, bm = z4, ar = z4, br = z4;
#pragma unroll
            for (int kk2 = 0; kk2 < 2; ++kk2) {
                const bf16x8 k1i = ldfrag(L + L_K1, SK, i0 * 16, kk2 * 32, lane), k1j = ldfrag(L + L_K1, SK, j0 * 16, kk2 * 32, lane);
                const bf16x8 b1i = ldfrag(L + L_B1, SK, i0 * 16, kk2 * 32, lane), b1j = ldfrag(L + L_B1, SK, j0 * 16, kk2 * 32, lane);
                const bf16x8 m1i = ldfrag(L + L_M1, SK, i0 * 16, kk2 * 32, lane), r1j = ldfrag(L + L_R1, SK, j0 * 16, kk2 * 32, lane);
                aS = mfma16(b1i, k1j, aS);
                aU = mfma16(k1i, b1j, aU);
                bm = mfma16(m1i, k1j, bm);
                ar = mfma16(b1i, r1j, ar);
                br = mfma16(m1i, r1j, br);
            }
#ifdef RWC_WAIT
            __builtin_amdgcn_sched_barrier(0); __builtin_amdgcn_s_sleep(2); __builtin_amdgcn_sched_barrier(0);
#endif
            {
                const int t = j0 * 16 + c16, s0 = i0 * 16 + q4 * 4;
                f32x4 x, pa, o1, o2, o3;
#pragma unroll
                for (int r = 0; r < 4; ++r) {
                    const bool lt = s0 + r < t, le = s0 + r <= t;
                    x[r] = lt ? -aS[r] : 0.f; pa[r] = x[r] + ((s0 + r == t) ? 1.f : 0.f);
                    o1[r] = lt ? bm[r] : 0.f; o2[r] = le ? ar[r] : 0.f; o3[r] = le ? br[r] : 0.f;
                }
#ifdef RWC_GSTORE
                { bf16_t* gd = wsb(p, OFF_RWY) + (size_t)2 * TT * 256 + (size_t)(bidx() * 256 + tid) * 32;
                  st4(gd, x); st4(gd + 4, pa); st4(gd + 8, o1); st4(gd + 12, o2); st4(gd + 16, o3); }
#else
                st4(L + L_X + t * ST + s0, x); st4(L + L_PA + t * ST + s0, pa);
                st4(L + L_BM + t * ST + s0, o1); st4(L + L_AR + t * ST + s0, o2); st4(L + L_BR + t * ST + s0, o3);
#endif
            }
            {
                const int s = j0 * 16 + c16, t0 = i0 * 16 + q4 * 4;
                f32x4 o;
#pragma unroll
                for (int r = 0; r < 4; ++r) o[r] = (s < t0 + r) ? -aU[r] : 0.f;
#ifdef RWC_GSTORE
                st4(wsb(p, OFF_RWY) + (size_t)2 * TT * 256 + (size_t)(bidx() * 256 + tid) * 32 + 20, o);
#else
                st4(L + L_XT + s * ST + t0, o);
#endif
            }
            __syncthreads();
        }
        if (RWC_STOP <= 2) continue;
#pragma unroll 1
        for (int rd = 1; rd <= 5; ++rd) {
            const bool sq = rd <= 4, up = rd >= 2;
            const int i0 = wave >> 1, j0 = wave & 1;
            const bf16x8 xti = ldfrag(L + L_XT, ST, i0 * 16, 0, lane), xtj = ldfrag(L + L_XT, ST, j0 * 16, 0, lane);
            const bf16x8 xi = ldfrag(L + L_X, ST, i0 * 16, 0, lane), xj = ldfrag(L + L_X, ST, j0 * 16, 0, lane);
            const bf16x8 paj = ldfrag(L + L_PA, ST, j0 * 16, 0, lane);
            const u32x2 old = *(const u32x2*)(L + L_PA + (j0 * 16 + c16) * ST + i0 * 16 + q4 * 4);
            __syncthreads();
            const f32x4 z4 = (f32x4){0.f, 0.f, 0.f, 0.f};
            if (sq) {
                const f32x4 nx = mfma16(xti, xj, z4);
                const f32x4 nxt = mfma16(xi, xtj, z4);
                st4(L + L_X + (j0 * 16 + c16) * ST + i0 * 16 + q4 * 4, nx);
                st4(L + L_XT + (j0 * 16 + c16) * ST + i0 * 16 + q4 * 4, nxt);
            }
            if (up) {
                f32x4 acc = (f32x4){bflo(old.x), bfhi(old.x), bflo(old.y), bfhi(old.y)};
                acc = mfma16(xti, paj, acc);
                st4(L + L_PA + (j0 * 16 + c16) * ST + i0 * 16 + q4 * 4, acc);
            }
            __syncthreads();
        }
        if (RWC_STOP <= 3) continue;
        {
            const int vj = wave;
#pragma unroll
            for (int ti = 0; ti < 2; ++ti) {
                f32x4 acc = mfma16(ldfrag(L + L_BM, ST, ti * 16, 0, lane), ldfrag(L + L_VT, ST, vj * 16, 0, lane), (f32x4){0.f, 0.f, 0.f, 0.f});
#pragma unroll
                for (int kk2 = 0; kk2 < 2; ++kk2) acc = mfma16(ldfrag(L + L_K1, SK, ti * 16, kk2 * 32, lane), ldfrag(L + L_S, SK, vj * 16, kk2 * 32, lane), acc);
                st4(L + L_ET + (vj * 16 + c16) * ST + ti * 16 + q4 * 4, acc);
            }
            __syncthreads();
#pragma unroll
            for (int ti = 0; ti < 2; ++ti) {
                const f32x4 acc = mfma16(ldfrag(L + L_PA, ST, ti * 16, 0, lane), ldfrag(L + L_ET, ST, vj * 16, 0, lane), (f32x4){0.f, 0.f, 0.f, 0.f});
                st4(L + L_ZT + (vj * 16 + c16) * ST + ti * 16 + q4 * 4, -acc);
            }
            __syncthreads();
        }
        if (RWC_STOP <= 4) continue;
        {
            const int vi = wave;
#pragma unroll
            for (int tj = 0; tj < 2; ++tj) {
                f32x4 acc = (f32x4){0.f, 0.f, 0.f, 0.f};
#pragma unroll
                for (int kk2 = 0; kk2 < 2; ++kk2) acc = mfma16(ldfrag(L + L_S, SK, vi * 16, kk2 * 32, lane), ldfrag(L + L_R1, SK, tj * 16, kk2 * 32, lane), acc);
                acc = mfma16(ldfrag(L + L_ZT, ST, vi * 16, 0, lane), ldfrag(L + L_AR, ST, tj * 16, 0, lane), acc);
                acc = mfma16(ldfrag(L + L_VT, ST, vi * 16, 0, lane), ldfrag(L + L_BR, ST, tj * 16, 0, lane), acc);
                int n, len; const int t = tok_of(c, tj * 16 + c16, n, len);
                u32x2 o; o.x = pack2(acc[0], acc[1]); o.y = pack2(acc[2], acc[3]);
#ifndef RWC_NOYSTORE
                *(u32x2*)(RWY + (size_t)t * 256 + head * 64 + vi * 16 + q4 * 4) = o;
#else
                asm volatile("" :: "v"(o), "v"(t));
#endif
            }
            const float4 pc = *(const float4*)(PC + wave * 16 + q4 * 4);
            const bf16x8 fb2 = ldfrag(L + L_B2T, ST, wave * 16, 0, lane), fm2 = ldfrag(L + L_M2T, ST, wave * 16, 0, lane);
#pragma unroll
            for (int vj = 0; vj < 4; ++vj) {
                f32x4 acc = Wt[vj];
                acc[0] *= pc.x; acc[1] *= pc.y; acc[2] *= pc.z; acc[3] *= pc.w;
                acc = mfma16(fb2, ldfrag(L + L_ZT, ST, vj * 16, 0, lane), acc);
                acc = mfma16(fm2, ldfrag(L + L_VT, ST, vj * 16, 0, lane), acc);
                Wt[vj] = acc;
            }
            __syncthreads();
#pragma unroll
            for (int vj = 0; vj < 4; ++vj) st4(L + L_S + (vj * 16 + c16) * SK + wave * 16 + q4 * 4, Wt[vj]);
        }
    }
    __syncthreads();
#ifdef RWC_ZERO_LDS
    for (int i = tid; i < 73728 / 4; i += NT) ((unsigned*)smem)[i] = 0u;
    __syncthreads();
#endif
}
DEV void phase_s5_glu(const Params& p, int l, int M, char* smem) {
    const bf16_t* P = wsb(p, OFF_P);
    const bf16_t* w = wsb(p, OFF_WSM) + (size_t)l * WS_PER_LAYER + WS_GLUT;
    bf16_t* Y = wsb(p, OFF_Y);
    const float* bg = inp(p, I_S5BGLU) + l * 256;
    gemm_generic(P + C_S5, LDP, M, w, 256, 256, 256,
                 [&](int r, int c, float v) { const float z = bf2f(P[(size_t)r * LDP + C_S5 + c]); Y[(size_t)r * 1024 + 256 + c] = f2bf(z * sigmoidf_(v + bg[c])); }, smem, 0);
}
DEV void phase_rw_finish(const Params& p, int l, int M) {
    const int lane = tidx() & 63, wave = tidx() >> 6;
    const bf16_t* P = wsb(p, OFF_P);
    const bf16_t* RWX = wsb(p, OFF_RWX);
    const bf16_t* RWY = wsb(p, OFF_RWY);
    bf16_t* Y = wsb(p, OFF_Y);
    const int c = lane * 4;
    const float4 mur = *(const float4*)(inp(p, I_RMU) + (l * 4 + 0) * 256 + c);
    const float4 muk = *(const float4*)(inp(p, I_RMU) + (l * 4 + 1) * 256 + c);
    const float4 muv = *(const float4*)(inp(p, I_RMU) + (l * 4 + 2) * 256 + c);
    const float4 ka4 = *(const float4*)(inp(p, I_RKA) + l * 256 + c);
    const float4 rk4 = *(const float4*)(inp(p, I_RRK) + l * 256 + c);
    const float4 lg4 = *(const float4*)(inp(p, I_RLNG) + l * 256 + c);
    const float4 lb4 = *(const float4*)(inp(p, I_RLNB) + l * 256 + c);
    const float mr_[4] = { mur.x, mur.y, mur.z, mur.w }, mk_[4] = { muk.x, muk.y, muk.z, muk.w }, mv_[4] = { muv.x, muv.y, muv.z, muv.w };
    const float ka_[4] = { ka4.x, ka4.y, ka4.z, ka4.w }, rk_[4] = { rk4.x, rk4.y, rk4.z, rk4.w }, lg_[4] = { lg4.x, lg4.y, lg4.z, lg4.w }, lb_[4] = { lb4.x, lb4.y, lb4.z, lb4.w };
    for (int t = bidx() * 4 + wave; t < M; t += gridDim.x * 4) {
        int base, n, len; tok_seq(t, base, n, len);
        const bf16_t* row = P + (size_t)t * LDP;
        const bool hp = n > 0, hn = n + 1 < len;
        const u32x2 z = (u32x2){0u, 0u};
        float r4[4], k4[4], v4[4];
        {
            const u32x2 cu = *(const u32x2*)(row + C_RWR + c), pv = hp ? *(const u32x2*)(row - LDP + C_RWR + c) : z, nx = hn ? *(const u32x2*)(row + LDP + C_RWR + c) : z;
            const float x[4] = { bflo(cu.x), bfhi(cu.x), bflo(cu.y), bfhi(cu.y) }, a[4] = { bflo(pv.x), bfhi(pv.x), bflo(pv.y), bfhi(pv.y) }, b[4] = { bflo(nx.x), bfhi(nx.x), bflo(nx.y), bfhi(nx.y) };
#pragma unroll
            for (int j = 0; j < 4; ++j) r4[j] = x[j] + (0.5f * (a[j] + b[j]) - x[j]) * mr_[j];
        }
        {
            const u32x2 cu = *(const u32x2*)(row + C_RWK + c), pv = hp ? *(const u32x2*)(row - LDP + C_RWK + c) : z, nx = hn ? *(const u32x2*)(row + LDP + C_RWK + c) : z;
            const float x[4] = { bflo(cu.x), bfhi(cu.x), bflo(cu.y), bfhi(cu.y) }, a[4] = { bflo(pv.x), bfhi(pv.x), bflo(pv.y), bfhi(pv.y) }, b[4] = { bflo(nx.x), bfhi(nx.x), bflo(nx.y), bfhi(nx.y) };
#pragma unroll
            for (int j = 0; j < 4; ++j) k4[j] = x[j] + (0.5f * (a[j] + b[j]) - x[j]) * mk_[j];
        }
        {
            const u32x2 cu = *(const u32x2*)(row + C_RWV + c), pv = hp ? *(const u32x2*)(row - LDP + C_RWV + c) : z, nx = hn ? *(const u32x2*)(row + LDP + C_RWV + c) : z;
            const float x[4] = { bflo(cu.x), bfhi(cu.x), bflo(cu.y), bfhi(cu.y) }, a[4] = { bflo(pv.x), bfhi(pv.x), bflo(pv.y), bfhi(pv.y) }, b[4] = { bflo(nx.x), bfhi(nx.x), bflo(nx.y), bfhi(nx.y) };
#pragma unroll
            for (int j = 0; j < 4; ++j) v4[j] = x[j] + (0.5f * (a[j] + b[j]) - x[j]) * mv_[j];
        }
        const u32x2 af = *(const u32x2*)(RWX + (size_t)t * 1024 + 512 + c), ab = *(const u32x2*)(RWX + (size_t)t * 1024 + 768 + c);
        const float a0[4] = { bflo(af.x), bfhi(af.x), bflo(af.y), bfhi(af.y) }, a1[4] = { bflo(ab.x), bfhi(ab.x), bflo(ab.y), bfhi(ab.y) };
        const u32x2 yf = *(const u32x2*)(RWY + (size_t)t * 256 + c), yb = *(const u32x2*)(RWY + (size_t)TT * 256 + (size_t)t * 256 + c);
        float y[4] = { bflo(yf.x) + bflo(yb.x), bfhi(yf.x) + bfhi(yb.x), bflo(yf.y) + bflo(yb.y), bfhi(yf.y) + bfhi(yb.y) };
        float s = y[0] + y[1] + y[2] + y[3];
        s = group_sum<16>(s);
        const float mean = s * (1.f / 64.f);
        float q = 0.f, bon = 0.f;
#pragma unroll
        for (int j = 0; j < 4; ++j) {
            const float dlt = y[j] - mean; q += dlt * dlt;
            const float kmsum = k4[j] * (2.f + (a0[j] + a1[j] - 2.f) * ka_[j]);
            bon += r4[j] * kmsum * rk_[j];
        }
        q = group_sum<16>(q); bon = group_sum<16>(bon);
        const float rstd = rsqrtf(q * (1.f / 64.f) + 64e-5f);
        const u32x2 gg = *(const u32x2*)(row + C_RWD + c);
        const float g[4] = { bflo(gg.x), bfhi(gg.x), bflo(gg.y), bfhi(gg.y) };
        float o[4];
#pragma unroll
        for (int j = 0; j < 4; ++j) o[j] = ((y[j] - mean) * rstd * lg_[j] + lb_[j] + bon * v4[j]) * g[j];
        u32x2 ov; ov.x = pack2(o[0], o[1]); ov.y = pack2(o[2], o[3]);
        *(u32x2*)(Y + (size_t)t * 1024 + 768 + c) = ov;
    }
}

DEV int queue_next(int* ctr, char* smem) {
    int* slot = (int*)(smem + MOE_MAP_OFF + 208);
    __syncthreads();
    if (tidx() == 0) *slot = atomicAdd(ctr, 1);
    __syncthreads();
    return __builtin_amdgcn_readfirstlane(*slot);
}
DEV void phase_mixers(const Params& p, int l, int rep, char* smem) {
    const bool need_ctx = (l == 0);
#ifndef RWMODE
#define RWMODE 2
#endif
    const int nrw = RWMODE == 0 ? 64 : (RWMODE == 1 ? 256 + 64 : 256), nda = need_ctx ? 576 : 512, ns5 = 32 * (need_ctx ? 9 : 8);
    const int total = nrw + 2 * nda + (rep == 0 ? ns5 : 0);
    int* ctr = (int*)(wsp(p) + OFF_CTR) + CTR_Q + l * 16 + rep * 4;
    for (;;) {
        const int item = queue_next(ctr, smem);
        if (item >= total) break;
#ifndef PROBE7
#define PROBE7 0
#endif
        if (rep > 0 && PROBE7 == 1 && item >= nrw) break;
        if (rep > 0 && PROBE7 == 2 && item < nrw) continue;
        if (rep > 0 && PROBE7 == 3 && (item < nrw || item >= nrw + nda)) continue;
#if RWMODE == 2
        if (item < nrw) rw_item(p, l, item, smem, 0);
#elif RWMODE == 0
        if (item < nrw) rwc_item(p, l, item, smem);
#else
        if (item < nrw) { if (item < 256) rw_item(p, l, item, smem, 0); else rwc_item(p, l, item - 256, smem); }
#endif
        else if (item < nrw + nda) da_item(p, l, item - nrw, smem);
        else if (item < nrw + 2 * nda) mla_item(p, l, item - nrw - nda, smem);
        else s5_pass2_item(p, l, need_ctx ? 0 : 1, item - nrw - 2 * nda, smem);
    }
}
#ifndef MEGA
#define MEGA 0
#endif
constexpr int NPHASE = 15;
template <int PH>
DEV void run_phase(const Params& p, int l, char* smem) {
    asm volatile("" : "+s"(l));
    const bool need_ctx = (l == 0);
    const int M = need_ctx ? TT : TL;
    if constexpr (PH == 0) { phase_mod_partial(p, smem); __syncthreads(); phase_conv_small(p, smem); phase_conv_layer(p, 0, smem); phase_conv_experts(p, 0, smem); }
    if constexpr (PH == 1) { phase_mod_reduce(p); }
    if constexpr (PH == 2) { phase_norm<1>(p, l, TT, smem, l == 1); if (l == 1) { phase_conv_layer(p, 1, smem); phase_conv_experts(p, 1, smem); } }
    if constexpr (PH == 3) { phase_inproj(p, l, smem); }
    if constexpr (PH == 4) { phase_prep1(p, l); phase_s5_pass1(p, l, smem); }
    if constexpr (PH == 5) { phase_prep_gemm1(p, l, smem); }
    if constexpr (PH == 6) { phase_prep_gemm2(p, l, smem); phase_prep2(p, l); }
    if constexpr (PH == 7) { phase_mixers(p, l, 0, smem); }
    if constexpr (PH == 8) { phase_s5_glu(p, l, M, smem); phase_rw_finish(p, l, M); }
    if constexpr (PH == 9) { phase_merge(p, l, M, smem); }
    if constexpr (PH == 10) { phase_outproj(p, l, M, smem); }
    if constexpr (PH == 11) { phase_norm<2>(p, l, M, smem); }
    if constexpr (PH == 14) { phase_route(p, l, M, smem); }
    if constexpr (PH == 15) { phase_combine(p, l, M); }
    if constexpr (PH == 12) { phase_moe1(p, l, smem); }
    if constexpr (PH == 13) { phase_moe2(p, l, smem); }
}

#if !MEGA
template <int PH>
__global__ void __launch_bounds__(NT, 2) k_phase(Params p, int l) {
    extern __shared__ __attribute__((aligned(16))) char smem[];
    run_phase<PH>(p, l, smem);
}
#endif
#ifndef REP0
#define REP0 1
#endif
#ifndef REP2
#define REP2 1
#endif
#ifndef REP3
#define REP3 1
#endif
#ifndef REP5
#define REP5 1
#endif
#ifndef REP6
#define REP6 1
#endif
#ifndef REP7
#define REP7 1
#endif
#ifndef REP8
#define REP8 1
#endif
#ifndef REP9
#define REP9 1
#endif
#ifndef REP12
#define REP12 1
#endif
#if MEGA
__global__ void __launch_bounds__(NT, 2) k_mega(Params p) {
    extern __shared__ __attribute__((aligned(16))) char smem[];
    uint4* xbw = (uint4*)(smem + MOE_MAP_OFF + 240);
    if (threadIdx.x == 0) *xbw = make_uint4(0u, 0u, 0u, 0u);
    __syncthreads();
    XcdBarrier bar = xcd_barrier_post((unsigned*)(p.ws + OFF_BAR), (volatile LAS unsigned*)xbw);
    for (int r = 0; r < REP0; ++r) { run_phase<0>(p, 0, smem); xcd_barrier(bar); }
    run_phase<1>(p, 0, smem); xcd_barrier(bar);
    for (int l = 0; l < 2; ++l) {
        for (int r = 0; r < REP2; ++r) { run_phase<2>(p, l, smem); xcd_barrier(bar); }
        for (int r = 0; r < REP3; ++r) { run_phase<3>(p, l, smem); xcd_barrier(bar); }

        run_phase<4>(p, l, smem); xcd_barrier(bar);
#ifdef PROBE_S5P1
        phase_s5_pass1(p, l, smem); xcd_barrier(bar);
#endif
#ifdef PROBE_BAR
        for (int r = 0; r < PROBE_BAR; ++r) xcd_barrier(bar);
#endif
        for (int r = 0; r < REP5; ++r) { run_phase<5>(p, l, smem); xcd_barrier(bar); }
        for (int r = 0; r < REP6; ++r) { run_phase<6>(p, l, smem); xcd_barrier(bar); }
#ifdef RWC_PRE
        if (bidx() < 64) rwc_item(p, l, bidx(), smem);
#endif
        for (int r = 0; r < REP7; ++r) { int l7 = l; asm volatile("" : "+s"(l7)); phase_mixers(p, l7, r, smem); xcd_barrier(bar); }
#ifdef RWC_SEP
        for (int item = bidx(); item < 64; item += gridDim.x) rwc_item(p, l, item, smem);
        xcd_barrier(bar);
#endif
        for (int r = 0; r < REP8; ++r) { run_phase<8>(p, l, smem); xcd_barrier(bar); }
        for (int r = 0; r < REP9; ++r) { run_phase<9>(p, l, smem); xcd_barrier(bar); }
        run_phase<10>(p, l, smem); xcd_barrier(bar);
#ifdef PROBE_OUT2
        if (l == 0) { run_phase<10>(p, l, smem); xcd_barrier(bar); }
#endif

        run_phase<11>(p, l, smem); xcd_barrier(bar);
        run_phase<14>(p, l, smem); xcd_barrier(bar);
        for (int r = 0; r < REP12; ++r) { run_phase<12>(p, l, smem); xcd_barrier(bar); }
        run_phase<13>(p, l, smem); xcd_barrier(bar);
#ifdef PROBE_MOE2B
        run_phase<13>(p, l, smem); xcd_barrier(bar);
#endif
        if (l == 1) run_phase<15>(p, l, smem);
    }
}
#endif
__global__ void __launch_bounds__(NT) k_fail(float* out, int n) {
    for (int i = blockIdx.x * NT + threadIdx.x; i < n; i += gridDim.x * NT) out[i] = __int_as_float(0x7fc00000);
}

template <int PH>
static void launch_phase(const Params& p, int l, int grid, hipStream_t stream) {
#if !MEGA
    static bool attr = false;
    if (!attr) { (void)hipFuncSetAttribute((const void*)k_phase<PH>, hipFuncAttributeMaxDynamicSharedMemorySize, SMEM_BYTES); attr = true; }
    hipLaunchKernelGGL(k_phase<PH>, dim3(grid), dim3(NT), SMEM_BYTES, stream, p, l);
#endif
}

extern "C" void kernel_launch(void* const* d_in, const int* in_sizes, int n_in, void* d_out, int out_size, void* d_ws, size_t ws_size, hipStream_t stream) {
    if (n_in != 48 || out_size != TL * DM || ws_size < WS_END) {
        hipLaunchKernelGGL(k_fail, dim3(256), dim3(NT), 0, stream, (float*)d_out, out_size);
        return;
    }
    Params p{};
    for (int i = 0; i < 48; ++i) p.in[i] = (const float*)d_in[i];
    p.out = (float*)d_out; p.ws = (char*)d_ws;
    (void)hipMemsetAsync(d_ws, 0, ZERO_BYTES, stream);
#if MEGA
    static int grid = 0;
    if (grid == 0) {
        int dev = 0, cus = 0, per_cu = 0;
        (void)hipGetDevice(&dev);
        (void)hipDeviceGetAttribute(&cus, hipDeviceAttributeMultiprocessorCount, dev);
        (void)hipFuncSetAttribute((const void*)k_mega, hipFuncAttributeMaxDynamicSharedMemorySize, SMEM_BYTES);
        if (hipOccupancyMaxActiveBlocksPerMultiprocessor(&per_cu, (const void*)k_mega, NT, SMEM_BYTES) != hipSuccess || per_cu < 1) per_cu = 1;
        (void)hipGetLastError();
        if (cus <= 0) cus = 256;
        grid = cus * (per_cu < 2 ? per_cu : 2);
    }
    hipLaunchKernelGGL(k_mega, dim3(grid), dim3(NT), SMEM_BYTES, stream, p);
#else
    const int grid = 512;
    launch_phase<0>(p, 0, grid, stream);
    launch_phase<1>(p, 0, grid, stream);
    for (int l = 0; l < 2; ++l) {
        launch_phase<2>(p, l, grid, stream);
        launch_phase<3>(p, l, grid, stream);
        launch_phase<4>(p, l, grid, stream);
        launch_phase<5>(p, l, grid, stream);
        launch_phase<6>(p, l, grid, stream);
        launch_phase<7>(p, l, grid, stream);
        launch_phase<8>(p, l, grid, stream);
        launch_phase<9>(p, l, grid, stream);
        launch_phase<10>(p, l, grid, stream);
        launch_phase<11>(p, l, grid, stream);
        launch_phase<14>(p, l, grid, stream);
        launch_phase<12>(p, l, grid, stream);
        launch_phase<13>(p, l, grid, stream);
        launch_phase<15>(p, l, grid, stream);
    }
#endif
}
```

```cpp
#define MEGA 1
#include <hip/hip_runtime.h>
#include <stdint.h>
#include <math.h>

#define DEV __device__ __forceinline__
#define LAS __attribute__((address_space(3)))
typedef unsigned short bf16_t;
typedef short bf16x8 __attribute__((ext_vector_type(8)));
typedef float f32x16 __attribute__((ext_vector_type(16)));
typedef float f32x4 __attribute__((ext_vector_type(4)));
typedef unsigned u32x4 __attribute__((ext_vector_type(4)));
typedef unsigned u32x2 __attribute__((ext_vector_type(2)));

constexpr int NT = 256;
constexpr int DM = 1024, NB = 8, SEQ = 2048, CTXL = 256, GRIDW = 64;
constexpr int TL = NB * SEQ, TC = NB * CTXL, TT = TL + TC;
constexpr int NIN = 6480, LDP = 2432, NINP = 6528, NGATE0 = 2432;
constexpr int C_DAQ = 0, C_DAK = 256, C_DAV = 512, C_S5 = 768, C_CQ = 1024, C_CKV = 1216, C_KR = 1344,
              C_RWR = 1360, C_RWK = 1616, C_RWV = 1872, C_RWD = 2128, C_PEND = 2384;
constexpr int NEXP = 16, DFF = 512;
constexpr float EPS = 1e-6f;
constexpr float LOG2E = 1.4426950408889634f;

constexpr size_t al256(size_t x) { return (x + 255) & ~(size_t)255; }
constexpr size_t OFF_BAR  = 0;
constexpr size_t OFF_CTR  = 16384;
constexpr size_t ZERO_BYTES = 20480;
constexpr size_t OFF_MOD  = 32768;
constexpr size_t SZ_MOD   = (size_t)2 * 9 * 6144 * 4;
constexpr int    MOD_KS   = 8;
constexpr size_t OFF_MODP = al256(OFF_MOD + SZ_MOD);
constexpr size_t OFF_S5ST = al256(OFF_MODP + MOD_KS * SZ_MOD);
constexpr size_t OFF_LTOK = al256(OFF_S5ST + (size_t)2 * 8 * 16 * 8 * 64 * 2 * 4);
constexpr size_t OFF_LW   = al256(OFF_LTOK + (size_t)NEXP * TT * 4);
constexpr size_t OFF_TOKI = al256(OFF_LW + (size_t)NEXP * TT * 4);
constexpr size_t OFF_TOKW = al256(OFF_TOKI + (size_t)TT * 16);
constexpr size_t OFF_CNTB = al256(OFF_TOKW + (size_t)TT * 8);
constexpr size_t OFF_WSM  = al256(OFF_CNTB + (size_t)1024 * 16 * 4);
constexpr int WS_GLUT = 0, WS_UQT = WS_GLUT + 256 * 256, WS_UKVT = WS_UQT + 192 * 192, WS_W1C = WS_UKVT + 384 * 128,
              WS_W2 = WS_W1C + 192 * 256, WS_G2T = WS_W2 + 4 * 256 * 64, WS_PER_LAYER = WS_G2T + 256 * 64;
constexpr size_t OFF_WIN  = al256(OFF_WSM + (size_t)2 * WS_PER_LAYER * 2);
constexpr size_t OFF_WBR  = al256(OFF_WIN + (size_t)NINP * 1024 * 2);
constexpr size_t OFF_WOUT = al256(OFF_WBR + (size_t)4 * 1024 * 256 * 2);
constexpr size_t OFF_WG1  = al256(OFF_WOUT + (size_t)1024 * 1024 * 2);
constexpr size_t OFF_WDN  = al256(OFF_WG1 + (size_t)NEXP * 1024 * 1024 * 2);
constexpr size_t OFF_H    = al256(OFF_WDN + (size_t)NEXP * 1024 * 512 * 2);
constexpr size_t OFF_P    = al256(OFF_H + (size_t)TT * 1024 * 2);
constexpr size_t OFF_GATE = al256(OFF_P + (size_t)TT * LDP * 2);
constexpr size_t OFF_MLAQ = al256(OFF_GATE + (size_t)TT * 4096);
constexpr size_t OFF_MLAK = al256(OFF_MLAQ + (size_t)TT * 192 * 2);
constexpr size_t OFF_MLAV = al256(OFF_MLAK + (size_t)TT * 192 * 2);
constexpr size_t OFF_RWX  = al256(OFF_MLAV + (size_t)TT * 256 * 2);
constexpr size_t OFF_Y    = al256(OFF_RWX + (size_t)TT * 1024 * 2);
constexpr size_t OFF_CX   = al256(OFF_Y + (size_t)TT * 1024 * 2);
constexpr size_t OFF_S5Y  = al256(OFF_CX + (size_t)TC * 1024 * 4);
constexpr size_t WS_END   = al256(OFF_S5Y + (size_t)TT * 256 * 2);
constexpr size_t OFF_QRAW = OFF_Y;
constexpr size_t OFF_KVRAW = OFF_QRAW + (size_t)TT * 192 * 2;
constexpr size_t OFF_LR   = OFF_KVRAW + (size_t)TT * 384 * 2;
constexpr size_t OFF_XL   = OFF_LR + (size_t)TT * 192 * 2;
constexpr size_t OFF_Z    = OFF_GATE;
static_assert(OFF_XL + (size_t)TT * 256 * 2 <= OFF_Y + (size_t)TT * 1024 * 2, "temps overflow Y");
constexpr size_t OFF_RWY  = OFF_H;

constexpr int CTR_MOE = 0;
constexpr int CTR_Q   = 64;

constexpr int SMEM_BYTES = 73728 + 256;

struct Params {
    const float* in[48];
    float* out;
    char* ws;
};
enum { I_X = 0, I_C, I_CTX, I_CCTX, I_WADA, I_BADA, I_NMG, I_NFG, I_WIN, I_DAQKG, I_DALAM, I_DASUB,
       I_S5LRE, I_S5LIM, I_S5LDT, I_S5BRE, I_S5BIM, I_S5CRE, I_S5CIM, I_S5D, I_S5WGLU, I_S5BGLU,
       I_MCQG, I_MCKVG, I_MWUQ, I_MWUKV, I_MQKG,
       I_RMU, I_RW0, I_RW1, I_RW2, I_RA0, I_RA1, I_RA2, I_RG1, I_RG2, I_RKK, I_RKA, I_RRK, I_RLNG, I_RLNB,
       I_WBR, I_WOUT, I_ROUTW, I_ROUTB, I_EWG, I_EWU, I_EWD };

DEV int tidx() { int t = threadIdx.x; asm volatile("" : "+v"(t)); return t; }
DEV int bidx() { int b = blockIdx.x; asm volatile("" : "+s"(b)); return b; }
typedef float f32x2_ __attribute__((ext_vector_type(2)));
typedef __bf16 bf16x2_ __attribute__((ext_vector_type(2)));
DEV unsigned cvt_pk_bf16(float lo, float hi) { const f32x2_ v = {lo, hi}; const bf16x2_ b = __builtin_convertvector(v, bf16x2_); return __builtin_bit_cast(unsigned, b); }
DEV bf16_t f2bf(float f) { return (bf16_t)(cvt_pk_bf16(f, 0.f) & 0xFFFFu); }
DEV float bf2f(bf16_t h) { return __uint_as_float(((unsigned)h) << 16); }
DEV unsigned pack2(float lo, float hi) { return cvt_pk_bf16(lo, hi); }
DEV float bflo(unsigned u) { return __uint_as_float(u << 16); }
DEV float bfhi(unsigned u) { return __uint_as_float(u & 0xFFFF0000u); }
DEV float sigmoidf_(float x) { return 1.f / (1.f + __expf(-x)); }
DEV float wave_sum(float v) {
#pragma unroll
    for (int o = 32; o >= 1; o >>= 1) v += __shfl_xor(v, o, 64);
    return v;
}
template <int W> DEV float group_sum(float v) {
#pragma unroll
    for (int o = W / 2; o >= 1; o >>= 1) v += __shfl_xor(v, o, 64);
    return v;
}
DEV int mod_row(int t) { return t < TL ? (t >> 11) : 8; }
typedef const float* cfp_t;
DEV cfp_t inp(const Params&, int i) {
    const __attribute__((address_space(4))) cfp_t* ka = (const __attribute__((address_space(4))) cfp_t*)__builtin_amdgcn_kernarg_segment_ptr();
    asm volatile("" : "+s"(ka));
    return ka[i];
}
DEV char* wsp(const Params&) {
    char* const __attribute__((address_space(4)))* ka = (char* const __attribute__((address_space(4)))*)__builtin_amdgcn_kernarg_segment_ptr();
    asm volatile("" : "+s"(ka));
    return ka[49];
}
DEV bf16_t* wsb(const Params& p, size_t off) { return (bf16_t*)(wsp(p) + off); }
DEV float* wsf(const Params& p, size_t off) { return (float*)(wsp(p) + off); }
DEV const float* modp(const Params& p, int l, int row, int which) { return (const float*)(wsp(p) + OFF_MOD) + ((size_t)(l * 9 + row) * 6 + which) * 1024; }
#define XB_TMO      128
#define XB_XCNT(j)  (256  + 64 * (j))
#define XB_XSUB(j)  (1280 + 64 * (j))
#define XB_XGEN(j)  (2304 + 64 * (j))
#define XB_TOP      3328
#define XB_TOPGEN   3392
#define XCD_BAR_WORDS 3456
#define XB_SPIN_CAP (1u << 18)

__device__ __forceinline__ unsigned xb_ld(unsigned* p)              { return __hip_atomic_load(p, __ATOMIC_RELAXED, __HIP_MEMORY_SCOPE_AGENT); }
__device__ __forceinline__ unsigned xb_add(unsigned* p, unsigned v) { return __hip_atomic_fetch_add(p, v, __ATOMIC_RELAXED, __HIP_MEMORY_SCOPE_AGENT); }
__device__ __forceinline__ unsigned xb_xcc_id() { return (unsigned)__builtin_amdgcn_s_getreg((3 << 11) | 20) & 0xFu; }
#define XB_SPIN(cond, bar) do { unsigned _sp = 0; while (cond) { __builtin_amdgcn_s_sleep(1); \
    if ((++_sp & 255u) == 0u) { if (xb_ld(&(bar)[XB_TMO])) break; if (_sp > XB_SPIN_CAP) { atomicAdd(&(bar)[XB_TMO], 1u); break; } } } } while (0)

struct XcdBarrier {
    unsigned* bar; unsigned x;
    volatile LAS unsigned* st;
};

__device__ __forceinline__ XcdBarrier xcd_barrier_post(unsigned* bar, volatile LAS unsigned* st) {
    XcdBarrier b; b.bar = bar; b.x = xb_xcc_id(); b.st = st;
    if (threadIdx.x == 0) (void)xb_add(&bar[XB_XCNT(b.x)], 1u);
    return b;
}
__device__ __forceinline__ void xcd_barrier_complete(unsigned* bar, unsigned x, unsigned& nloc, unsigned& nx) {
    const unsigned G = gridDim.x * gridDim.y * gridDim.z;
    unsigned sum, cnt, mine, sp = 0u;
    for (;;) {
        sum = 0u; cnt = 0u; mine = 0u;
#pragma unroll
        for (unsigned j = 0; j < 16; ++j) { const unsigned c = xb_ld(&bar[XB_XCNT(j)]); sum += c; cnt += (c > 0u) ? 1u : 0u; mine = (j == x) ? c : mine; }
        if (sum == G) break;
        __builtin_amdgcn_s_sleep(1);
        if ((++sp & 255u) == 0u) { if (xb_ld(&bar[XB_TMO])) break; if (sp > XB_SPIN_CAP) { atomicAdd(&bar[XB_TMO], 1u); break; } }
    }
    nloc = mine > 0u ? mine : 1u; nx = cnt > 0u ? cnt : 1u;
}

__device__ __forceinline__ void xcd_barrier(const XcdBarrier& b) {
    asm volatile("s_waitcnt vmcnt(0)" ::: "memory");
    __syncthreads();
    if (threadIdx.x == 0) {
        unsigned* bar = b.bar;
        __builtin_amdgcn_s_waitcnt(0);
        unsigned nloc = b.st[0], nx = b.st[1];
        if (nloc == 0u) { xcd_barrier_complete(bar, b.x, nloc, nx); b.st[0] = nloc; b.st[1] = nx; }
        const unsigned old = xb_add(&bar[XB_XSUB(b.x)], 1u);
        const unsigned gen = old / nloc;
        if (old + 1u == (gen + 1u) * nloc) {
            __builtin_amdgcn_fence(__ATOMIC_RELEASE, "agent");
            asm volatile("s_waitcnt vmcnt(0)" ::: "memory");
            const unsigned og = xb_add(&bar[XB_TOP], 1u);
            const unsigned tg = og / nx;
            if (og + 1u == (tg + 1u) * nx) xb_add(&bar[XB_TOPGEN], 1u);
            else XB_SPIN(xb_ld(&bar[XB_TOPGEN]) == tg, bar);
            __builtin_amdgcn_fence(__ATOMIC_ACQUIRE, "agent");
            xb_add(&bar[XB_XGEN(b.x)], 1u);
            asm volatile("s_waitcnt vmcnt(0)" ::: "memory");
        } else {
            XB_SPIN(xb_ld(&bar[XB_XGEN(b.x)]) == gen, bar);
            __builtin_amdgcn_fence(__ATOMIC_ACQUIRE, "agent");
            asm volatile("s_waitcnt vmcnt(0)" ::: "memory");
        }
    }
    __syncthreads();
}

DEV void phase_mod_partial(const Params& p, char* smem) {
    float* sm = (float*)smem;
    const int tid = tidx();
    const int nitems = 2 * 24 * MOD_KS;
    for (int item = bidx(); item < nitems; item += gridDim.x) {
        const int l = item / (24 * MOD_KS), rem = item % (24 * MOD_KS), jc = rem / MOD_KS, ks = rem % MOD_KS;
        __syncthreads();
        for (int i = tid; i < 9 * 128; i += NT) {
            const int r = i >> 7, k = ks * 128 + (i & 127);
            const float cv = r < 8 ? inp(p, I_C)[r * 1024 + k] : inp(p, I_CCTX)[k];
            sm[i] = cv / (1.f + __expf(-cv));
        }
        __syncthreads();
        const int j = jc * 256 + tid;
        float acc[9];
#pragma unroll
        for (int r = 0; r < 9; ++r) acc[r] = 0.f;
        const float* w = inp(p, I_WADA) + (size_t)l * 1024 * 6144 + (size_t)(ks * 128) * 6144 + j;
#pragma unroll 8
        for (int k = 0; k < 128; ++k) {
            const float wv = w[(size_t)k * 6144];
#pragma unroll
            for (int r = 0; r < 9; ++r) acc[r] += sm[r * 128 + k] * wv;
        }
        float* dst = wsf(p, OFF_MODP);
#pragma unroll
        for (int r = 0; r < 9; ++r) dst[((size_t)(ks * 2 + l) * 9 + r) * 6144 + j] = acc[r];
    }
}
DEV void phase_mod_reduce(const Params& p) {
    const int n = 2 * 9 * 6144;
    float* mod = wsf(p, OFF_MOD);
    const float* part = wsf(p, OFF_MODP);
    for (int i = bidx() * NT + tidx(); i < n; i += gridDim.x * NT) {
        const int l = i / (9 * 6144), j = i % 6144;
        float s = inp(p, I_BADA)[l * 6144 + j];
#pragma unroll
        for (int ks = 0; ks < MOD_KS; ++ks) s += part[(size_t)ks * n + i];
        mod[i] = s;
    }
}

struct ConvRegs { float4 v[4]; };
DEV void conv_load(const float* src, int R, int C, int ld, int tr, int tc, ConvRegs& cr) {
    const int r0 = tr * 64, c0 = tc * 64, tid = tidx();
#pragma unroll
    for (int k = 0; k < 4; ++k) {
        const int i = tid + k * NT, r = i >> 4, c4 = (i & 15) * 4;
        float4 v = make_float4(0.f, 0.f, 0.f, 0.f);
        if (r0 + r < R) {
            const float* s = src + (size_t)(r0 + r) * ld + c0 + c4;
            if (c0 + c4 + 3 < C) v = *(const float4*)s;
            else { if (c0 + c4 < C) v.x = s[0]; if (c0 + c4 + 1 < C) v.y = s[1]; if (c0 + c4 + 2 < C) v.z = s[2]; }
        }
        cr.v[k] = v;
    }
}
template <int MODE>
DEV void conv_store(const ConvRegs& cr, int R, int C, bf16_t* dst, int ldd, int roff, int tr, int tc, float* sm) {
    const int r0 = tr * 64, c0 = tc * 64, tid = tidx();
    __syncthreads();
#pragma unroll
    for (int k = 0; k < 4; ++k) {
        const int i = tid + k * NT, r = i >> 4, c4 = (i & 15) * 4;
        float* d = sm + r * 65 + c4;
        d[0] = cr.v[k].x; d[1] = cr.v[k].y; d[2] = cr.v[k].z; d[3] = cr.v[k].w;
    }
    __syncthreads();
    for (int i = tid; i < 64 * 8; i += NT) {
        const int c = i >> 3, r8 = (i & 7) * 8;
        if (c0 + c < C && r0 + r8 < R) {
            const int cc = c0 + c;
            const int drow = (MODE == 0) ? (cc + roff) : ((cc >> 5) * 64 + (cc & 31) + roff);
            u32x4 o;
            o[0] = pack2(sm[(r8 + 0) * 65 + c], sm[(r8 + 1) * 65 + c]);
            o[1] = pack2(sm[(r8 + 2) * 65 + c], sm[(r8 + 3) * 65 + c]);
            o[2] = pack2(sm[(r8 + 4) * 65 + c], sm[(r8 + 5) * 65 + c]);
            o[3] = pack2(sm[(r8 + 6) * 65 + c], sm[(r8 + 7) * 65 + c]);
            *(u32x4*)(dst + (size_t)drow * ldd + r0 + r8) = o;
        }
    }
}
template <int MODE>
DEV void conv_job(const float* src, int R, int C, int ld, bf16_t* dst, int ldd, int roff, int& rot, float* sm) {
    const int ntr = (R + 63) >> 6, ntc = (C + 63) >> 6, nt = ntr * ntc, G = gridDim.x;
    const int first = (bidx() - (rot % G) + G) % G;
    ConvRegs cur;
    if (first < nt) conv_load(src, R, C, ld, first / ntc, first % ntc, cur);
    for (int t = first; t < nt; t += G) {
        ConvRegs nxt = cur;
        if (t + G < nt) conv_load(src, R, C, ld, (t + G) / ntc, (t + G) % ntc, nxt);
        conv_store<MODE>(cur, R, C, dst, ldd, roff, t / ntc, t % ntc, sm);
        cur = nxt;
    }
    rot += nt;
}
DEV void phase_conv_layer(const Params& p, int l, char* smem) {
    float* sm = (float*)smem;
    int rot = 0;
    const float* win = inp(p, I_WIN) + (size_t)l * 1024 * NIN;
    conv_job<0>(win, 1024, C_PEND, NIN, wsb(p, OFF_WIN), 1024, 0, rot, sm);
    conv_job<0>(win + C_PEND, 1024, 4096, NIN, wsb(p, OFF_WIN), 1024, NGATE0, rot, sm);
    {
        uint4* z = (uint4*)(wsb(p, OFF_WIN) + (size_t)C_PEND * 1024);
        const int n = (NGATE0 - C_PEND) * 1024 / 8;
        unsigned zz = 0u; asm volatile("" : "+v"(zz));
        for (int i = bidx() * NT + tidx(); i < n; i += gridDim.x * NT) z[i] = make_uint4(zz, zz, zz, zz);
    }
    for (int i = 0; i < 4; ++i)
        conv_job<0>(inp(p, I_WBR) + (size_t)(l * 4 + i) * 256 * 1024, 256, 1024, 1024, wsb(p, OFF_WBR) + (size_t)i * 1024 * 256, 256, 0, rot, sm);
    conv_job<0>(inp(p, I_WOUT) + (size_t)l * 1024 * 1024, 1024, 1024, 1024, wsb(p, OFF_WOUT), 1024, 0, rot, sm);
}
DEV void phase_conv_experts(const Params& p, int l, char* smem) {
    float* sm = (float*)smem;
    int rot = 0;
    for (int e = 0; e < NEXP; ++e) {
        conv_job<1>(inp(p, I_EWG) + (size_t)(l * NEXP + e) * 1024 * DFF, 1024, DFF, DFF, wsb(p, OFF_WG1) + (size_t)e * 1024 * 1024, 1024, 0, rot, sm);
        conv_job<1>(inp(p, I_EWU) + (size_t)(l * NEXP + e) * 1024 * DFF, 1024, DFF, DFF, wsb(p, OFF_WG1) + (size_t)e * 1024 * 1024, 1024, 32, rot, sm);
        conv_job<0>(inp(p, I_EWD) + (size_t)(l * NEXP + e) * DFF * 1024, DFF, 1024, 1024, wsb(p, OFF_WDN) + (size_t)e * 1024 * DFF, DFF, 0, rot, sm);
    }
}
DEV void phase_conv_small(const Params& p, char* smem) {
    float* sm = (float*)smem;
    int rot = 0;
    for (int l = 0; l < 2; ++l) {
        bf16_t* w = wsb(p, OFF_WSM) + (size_t)l * WS_PER_LAYER;
        for (int i = bidx() * NT + tidx(); i < 4 * 256 * 4; i += gridDim.x * NT)
            *(u32x4*)(w + WS_W2 + (size_t)(i >> 2) * 64 + 32 + (i & 3) * 8) = (u32x4){0u, 0u, 0u, 0u};
        conv_job<0>(inp(p, I_S5WGLU) + (size_t)l * 256 * 256, 256, 256, 256, w + WS_GLUT, 256, 0, rot, sm);
        conv_job<0>(inp(p, I_MWUQ) + (size_t)l * 192 * 192, 192, 192, 192, w + WS_UQT, 192, 0, rot, sm);
        conv_job<0>(inp(p, I_MWUKV) + (size_t)l * 128 * 384, 128, 384, 384, w + WS_UKVT, 128, 0, rot, sm);
        for (int d = 0; d < 2; ++d) {
            conv_job<0>(inp(p, I_RW1) + (size_t)(l * 2 + d) * 256 * 32, 256, 32, 32, w + WS_W1C, 256, d * 32, rot, sm);
            conv_job<0>(inp(p, I_RA1) + (size_t)(l * 2 + d) * 256 * 32, 256, 32, 32, w + WS_W1C, 256, 64 + d * 32, rot, sm);
            conv_job<0>(inp(p, I_RW2) + (size_t)(l * 2 + d) * 32 * 256, 32, 256, 256, w + WS_W2 + (size_t)d * 256 * 64, 64, 0, rot, sm);
            conv_job<0>(inp(p, I_RA2) + (size_t)(l * 2 + d) * 32 * 256, 32, 256, 256, w + WS_W2 + (size_t)(2 + d) * 256 * 64, 64, 0, rot, sm);
        }
        conv_job<0>(inp(p, I_RG1) + (size_t)l * 256 * 64, 256, 64, 64, w + WS_W1C, 256, 128, rot, sm);
        conv_job<0>(inp(p, I_RG2) + (size_t)l * 64 * 256, 64, 256, 256, w + WS_G2T, 64, 0, rot, sm);
    }
}

template <int WHICH>
DEV void phase_norm(const Params& p, int l, int nrows, char* smem, bool fuse_combine = false) {
    const int lane = tidx() & 63, wave = tidx() >> 6;
    const float* xs = (l == 0) ? inp(p, I_X) : p.out;
    const float* cs = (l == 0) ? inp(p, I_CTX) : wsf(p, OFF_CX);
    const float* g = inp(p, WHICH == 1 ? I_NMG : I_NFG) + l * 1024;
    bf16_t* H = wsb(p, OFF_H);
    if (WHICH == 2) { xs = p.out; cs = wsf(p, OFF_CX); }
    const int tpb = (nrows + (int)gridDim.x - 1) / (int)gridDim.x;
    const int rbeg = WHICH == 2 ? bidx() * tpb + wave : bidx() * 4 + wave;
    const int rend = WHICH == 2 ? min(nrows, (bidx() + 1) * tpb) : nrows;
    const int rstep = WHICH == 2 ? 4 : (int)gridDim.x * 4;
    int* sel = (int*)smem;
    for (int row = rbeg; row < rend; row += rstep) {
        const float* src = row < TL ? xs + (size_t)row * 1024 : cs + (size_t)(row - TL) * 1024;
        const int mr = mod_row(row);
        const float* sh = modp(p, l, mr, WHICH == 1 ? 0 : 3);
        const float* sc = modp(p, l, mr, WHICH == 1 ? 1 : 4);
        float4 v[4];
        float ss = 0.f;
#pragma unroll
        for (int i = 0; i < 4; ++i) v[i] = *(const float4*)(src + lane * 4 + i * 256);
        if (WHICH == 1 && fuse_combine) {
            const bf16_t* Z = wsb(p, OFF_Z);
            const int* toki = (const int*)(wsp(p) + OFF_TOKI);
            const float* tokw = (const float*)(wsp(p) + OFF_TOKW);
            const float* g2 = modp(p, l - 1, mr, 5);
            const int r0 = toki[(size_t)row * 4 + 2], r1 = toki[(size_t)row * 4 + 3];
            const float w0 = tokw[(size_t)row * 2], w1 = tokw[(size_t)row * 2 + 1];
            float* dst = row < TL ? p.out + (size_t)row * 1024 : wsf(p, OFF_CX) + (size_t)(row - TL) * 1024;
#pragma unroll
            for (int i = 0; i < 4; ++i) {
                const int c = lane * 4 + i * 256;
                const u32x2 a = *(const u32x2*)(Z + (size_t)r0 * 1024 + c), b = *(const u32x2*)(Z + (size_t)r1 * 1024 + c);
                const float4 gg = *(const float4*)(g2 + c);
                v[i].x += gg.x * (w0 * bflo(a.x) + w1 * bflo(b.x));
                v[i].y += gg.y * (w0 * bfhi(a.x) + w1 * bfhi(b.x));
                v[i].z += gg.z * (w0 * bflo(a.y) + w1 * bflo(b.y));
                v[i].w += gg.w * (w0 * bfhi(a.y) + w1 * bfhi(b.y));
                *(float4*)(dst + c) = v[i];
            }
        }
#pragma unroll
        for (int i = 0; i < 4; ++i) ss += v[i].x * v[i].x + v[i].y * v[i].y + v[i].z * v[i].z + v[i].w * v[i].w;
        ss = wave_sum(ss);
        const float rstd = rsqrtf(ss * (1.f / 1024.f) + EPS);
        float hv[16];
#pragma unroll
        for (int i = 0; i < 4; ++i) {
            const int c = lane * 4 + i * 256;
            const float4 gg = *(const float4*)(g + c), s4 = *(const float4*)(sh + c), c4 = *(const float4*)(sc + c);
            hv[i * 4 + 0] = v[i].x * rstd * gg.x * (1.f + c4.x) + s4.x;
            hv[i * 4 + 1] = v[i].y * rstd * gg.y * (1.f + c4.y) + s4.y;
            hv[i * 4 + 2] = v[i].z * rstd * gg.z * (1.f + c4.z) + s4.z;
            hv[i * 4 + 3] = v[i].w * rstd * gg.w * (1.f + c4.w) + s4.w;
            u32x2 o; o.x = pack2(hv[i * 4 + 0], hv[i * 4 + 1]); o.y = pack2(hv[i * 4 + 2], hv[i * 4 + 3]);
            *(u32x2*)(H + (size_t)row * 1024 + c) = o;
        }
        if (WHICH == 2) {
            float lg[16];
#pragma unroll
            for (int e = 0; e < 16; ++e) lg[e] = 0.f;
            const float* rw = inp(p, I_ROUTW);
#pragma unroll
            for (int i = 0; i < 4; ++i)
#pragma unroll
                for (int j = 0; j < 4; ++j) {
                    const int c = lane * 4 + i * 256 + j;
                    const float hvv = hv[i * 4 + j];
#pragma unroll
                    for (int q = 0; q < 4; ++q) {
                        const float4 w4 = *(const float4*)(rw + (size_t)c * 16 + q * 4);
                        lg[q * 4 + 0] += hvv * w4.x; lg[q * 4 + 1] += hvv * w4.y; lg[q * 4 + 2] += hvv * w4.z; lg[q * 4 + 3] += hvv * w4.w;
                    }
                }
#pragma unroll
            for (int e = 0; e < 16; ++e) lg[e] = wave_sum(lg[e]);
            float sc16[16], bs[16];
#pragma unroll
            for (int e = 0; e < 16; ++e) { sc16[e] = sigmoidf_(lg[e]); bs[e] = sc16[e] + inp(p, I_ROUTB)[e]; }
            int bestg = 0; float bestv = -INFINITY;
#pragma unroll
            for (int gi = 0; gi < 4; ++gi) {
                float m1 = -INFINITY, m2 = -INFINITY;
#pragma unroll
                for (int k = 0; k < 4; ++k) { const float x = bs[gi * 4 + k]; if (x > m1) { m2 = m1; m1 = x; } else if (x > m2) m2 = x; }
                const float gs = m1 + m2;
                if (gs > bestv) { bestv = gs; bestg = gi; }
            }
            int i0 = 0, i1 = 0; float v0 = -INFINITY, v1 = -INFINITY, s0 = 0.f, s1 = 0.f;
#pragma unroll
            for (int e = 0; e < 16; ++e) { const bool in = (e >> 2) == bestg; if (in && bs[e] > v0) { v0 = bs[e]; i0 = e; s0 = sc16[e]; } }
#pragma unroll
            for (int e = 0; e < 16; ++e) { const bool in = (e >> 2) == bestg && e != i0; if (in && bs[e] > v1) { v1 = bs[e]; i1 = e; s1 = sc16[e]; } }
            const float inv = 1.f / (s0 + s1);
            if (lane == 0) {
                const int lt = row - bidx() * tpb;
                sel[lt * 2 + 0] = i0; sel[lt * 2 + 1] = i1;
                float* tw = (float*)(wsp(p) + OFF_TOKW) + (size_t)row * 2;
                tw[0] = s0 * inv; tw[1] = s1 * inv;
            }
        }
    }
    if (WHICH == 2) {
        __syncthreads();
        const int t0 = bidx() * tpb, nt = max(0, min(nrows, t0 + tpb) - t0);
        int* rank = sel + 2 * tpb;
        if (tidx() < 16) {
            const int e = tidx(); int c = 0;
            for (int i = 0; i < 2 * nt; ++i) if (sel[i] == e) { rank[i] = c; ++c; }
            ((int*)(wsp(p) + OFF_CNTB))[(size_t)bidx() * 16 + e] = c;
        }
        __syncthreads();
        int* toki = (int*)(wsp(p) + OFF_TOKI);
        for (int i = tidx(); i < nt; i += NT) {
            int4 r; r.x = sel[2 * i]; r.y = sel[2 * i + 1]; r.z = rank[2 * i]; r.w = rank[2 * i + 1];
            *(int4*)(toki + (size_t)(t0 + i) * 4) = r;
        }
        __syncthreads();
    }
}
DEV void phase_route(const Params& p, int l, int nrows, char* smem) {
    int* sm = (int*)smem;
    const int tid = tidx(), e = tid & 15, part = tid >> 4, G = gridDim.x, b = bidx();
    const int* cntb = (const int*)(wsp(p) + OFF_CNTB);
    int pre = 0, tot = 0;
    for (int bb = part; bb < G; bb += 16) { const int c = cntb[(size_t)bb * 16 + e]; tot += c; if (bb < b) pre += c; }
    __syncthreads();
    sm[part * 16 + e] = pre; sm[256 + part * 16 + e] = tot;
    __syncthreads();
    if (tid < 16) {
        int a = 0, t = 0;
        for (int q = 0; q < 16; ++q) { a += sm[q * 16 + tid]; t += sm[256 + q * 16 + tid]; }
        sm[512 + tid] = a; sm[528 + tid] = t;
    }
    __syncthreads();
    if (tid == 0) {
        int a = 0;
        for (int q = 0; q < 16; ++q) { sm[544 + q] = a; a += sm[528 + q]; }
    }
    __syncthreads();
    if (b == 0 && tid < 16) ((int*)(wsp(p) + OFF_CTR))[CTR_MOE + l * 16 + tid] = sm[528 + tid];
    const int tpb = (nrows + G - 1) / G, t0 = b * tpb, nt = max(0, min(nrows, t0 + tpb) - t0);
    int* toki = (int*)(wsp(p) + OFF_TOKI);
    const float* tokw = (const float*)(wsp(p) + OFF_TOKW);
    int* ltok = (int*)(wsp(p) + OFF_LTOK);
    float* lw = (float*)(wsp(p) + OFF_LW);
    for (int i = tid; i < 2 * nt; i += NT) {
        const int t = t0 + (i >> 1), j = i & 1;
        const int ee = toki[(size_t)t * 4 + j], rk = toki[(size_t)t * 4 + 2 + j];
        const int pos = sm[512 + ee] + rk;
        ltok[(size_t)ee * TT + pos] = t;
        lw[(size_t)ee * TT + pos] = tokw[(size_t)t * 2 + j];
        toki[(size_t)t * 4 + 2 + j] = sm[544 + ee] + pos;
    }
}
DEV void phase_combine(const Params& p, int l, int nrows) {
    const int lane = tidx() & 63, wave = tidx() >> 6;
    const bf16_t* Z = wsb(p, OFF_Z);
    const int* toki = (const int*)(wsp(p) + OFF_TOKI);
    const float* tokw = (const float*)(wsp(p) + OFF_TOKW);
    for (int row = bidx() * 4 + wave; row < nrows; row += gridDim.x * 4) {
        float* dst = row < TL ? p.out + (size_t)row * 1024 : wsf(p, OFF_CX) + (size_t)(row - TL) * 1024;
        const float* g2 = modp(p, l, mod_row(row), 5);
        const int r0 = toki[(size_t)row * 4 + 2], r1 = toki[(size_t)row * 4 + 3];
        const float w0 = tokw[(size_t)row * 2], w1 = tokw[(size_t)row * 2 + 1];
#pragma unroll
        for (int i = 0; i < 4; ++i) {
            const int c = lane * 4 + i * 256;
            const u32x2 a = *(const u32x2*)(Z + (size_t)r0 * 1024 + c), b = *(const u32x2*)(Z + (size_t)r1 * 1024 + c);
            const float4 gg = *(const float4*)(g2 + c);
            float4 x = *(float4*)(dst + c);
            x.x += gg.x * (w0 * bflo(a.x) + w1 * bflo(b.x));
            x.y += gg.y * (w0 * bfhi(a.x) + w1 * bfhi(b.x));
            x.z += gg.z * (w0 * bflo(a.y) + w1 * bflo(b.y));
            x.w += gg.w * (w0 * bfhi(a.y) + w1 * bfhi(b.y));
            *(float4*)(dst + c) = x;
        }
    }
}
constexpr int GLD = 72;
constexpr int GSTAGE = 128 * GLD;
template <bool DEEP = true, int TN = 2, class AF, class BF>
DEV void gemm_mainloop(f32x16 (&acc)[2][TN], AF arow, BF brow, int K, bf16_t* sm) {
    const int tid = tidx(), lane = tid & 63, wave = tid >> 6, wm = wave >> 1, wn = wave & 1;
    bf16_t* As = sm;
    bf16_t* Bs = sm + 2 * GSTAGE;
    constexpr int NB = 2 * TN;
    const bf16_t* ap[4]; const bf16_t* bp[NB];
#pragma unroll
    for (int i = 0; i < 4; ++i) { const int q = tid + i * NT; ap[i] = arow(q >> 3) + (q & 7) * 8; }
#pragma unroll
    for (int i = 0; i < NB; ++i) { const int q = tid + i * NT; bp[i] = brow(q >> 3) + (q & 7) * 8; }
    const int soff = (tid >> 3) * GLD + (tid & 7) * 8;
    u32x4 ra0[4], rb0[NB], ra1[4], rb1[NB];
    const int nk = K >> 6;
#pragma unroll
    for (int i = 0; i < 4; ++i) ra0[i] = *(const u32x4*)ap[i];
#pragma unroll
    for (int i = 0; i < NB; ++i) rb0[i] = *(const u32x4*)bp[i];
    if (DEEP && nk > 1) {
#pragma unroll
        for (int i = 0; i < 4; ++i) ra1[i] = *(const u32x4*)(ap[i] + 64);
#pragma unroll
        for (int i = 0; i < NB; ++i) rb1[i] = *(const u32x4*)(bp[i] + 64);
    }
    __syncthreads();
#pragma unroll
    for (int i = 0; i < 4; ++i) *(u32x4*)(As + soff + i * 32 * GLD) = ra0[i];
#pragma unroll
    for (int i = 0; i < NB; ++i) *(u32x4*)(Bs + soff + i * 32 * GLD) = rb0[i];
    __syncthreads();
    const int arow0 = (wm * 64 + (lane & 31)) * GLD + (lane >> 5) * 8;
    const int brow0 = (wn * 32 * TN + (lane & 31)) * GLD + (lane >> 5) * 8;
    auto compute = [&](int cur) {
        const bf16_t* a_s = As + cur * GSTAGE + arow0;
        const bf16_t* b_s = Bs + cur * GSTAGE + brow0;
#pragma unroll
        for (int ks = 0; ks < 4; ++ks) {
            const bf16x8 a0 = *(const bf16x8*)(a_s + ks * 16);
            const bf16x8 a1 = *(const bf16x8*)(a_s + 32 * GLD + ks * 16);
#pragma unroll
            for (int j = 0; j < TN; ++j) {
                const bf16x8 bj = *(const bf16x8*)(b_s + j * 32 * GLD + ks * 16);
                acc[0][j] = __builtin_amdgcn_mfma_f32_32x32x16_bf16(a0, bj, acc[0][j], 0, 0, 0);
                acc[1][j] = __builtin_amdgcn_mfma_f32_32x32x16_bf16(a1, bj, acc[1][j], 0, 0, 0);
            }
        }
    };
    auto gload = [&](u32x4 (&ra)[4], u32x4 (&rb)[NB], int kt) {
        const int k0 = kt * 64;
#pragma unroll
        for (int i = 0; i < 4; ++i) ra[i] = *(const u32x4*)(ap[i] + k0);
#pragma unroll
        for (int i = 0; i < NB; ++i) rb[i] = *(const u32x4*)(bp[i] + k0);
    };
    auto lstore = [&](const u32x4 (&ra)[4], const u32x4 (&rb)[NB], int st) {
#pragma unroll
        for (int i = 0; i < 4; ++i) *(u32x4*)(As + st * GSTAGE + soff + i * 32 * GLD) = ra[i];
#pragma unroll
        for (int i = 0; i < NB; ++i) *(u32x4*)(Bs + st * GSTAGE + soff + i * 32 * GLD) = rb[i];
    };
    for (int kt = 0; kt < nk; kt += 2) {
        if (!DEEP && kt + 1 < nk) gload(ra1, rb1, kt + 1);
        if (DEEP && kt + 2 < nk) gload(ra0, rb0, kt + 2);
        compute(0);
        if (kt + 1 < nk) lstore(ra1, rb1, 1);
        __syncthreads();
        if (kt + 1 >= nk) break;
        if (!DEEP && kt + 2 < nk) gload(ra0, rb0, kt + 2);
        if (DEEP && kt + 3 < nk) gload(ra1, rb1, kt + 3);
        compute(1);
        if (kt + 2 < nk) lstore(ra0, rb0, 0);
        __syncthreads();
    }
}
template <int TN>
DEV void acc_zero(f32x16 (&acc)[2][TN]) {
#pragma unroll
    for (int i = 0; i < 2; ++i)
#pragma unroll
        for (int j = 0; j < TN; ++j)
#pragma unroll
            for (int r = 0; r < 16; ++r) acc[i][j][r] = 0.f;
}
#define EPI_FOREACH(acc, ...)                                                                           \
    {                                                                                                    \
        const int _lane = tidx() & 63, _wave = tidx() >> 6, _wm = _wave >> 1, _wn = _wave & 1; \
        _Pragma("unroll") for (int _i = 0; _i < 2; ++_i)                                                 \
        _Pragma("unroll") for (int _j = 0; _j < 2; ++_j)                                                 \
        _Pragma("unroll") for (int _r = 0; _r < 16; ++_r) {                                              \
            const int er = _wm * 64 + _i * 32 + (_r & 3) + 8 * (_r >> 2) + 4 * (_lane >> 5);             \
            const int ec = _wn * 64 + _j * 32 + (_lane & 31);                                            \
            const float ev = acc[_i][_j][_r];                                                            \
            __VA_ARGS__                                                                                  \
        }                                                                                                \
    }

DEV void tile_mn(int item, int nMt, int nNt, int& mt, int& nt) {
    constexpr int GM = 16;
    const int per = GM * nNt, g = item / per, rem = item % per;
    const int m0 = g * GM, gsz = (nMt - m0) < GM ? (nMt - m0) : GM;
    mt = m0 + rem % gsz; nt = rem / gsz;
}

DEV void phase_inproj(const Params& p, int l, char* smem) {
    bf16_t* sm = (bf16_t*)smem;
    const bf16_t* H = wsb(p, OFF_H);
    const bf16_t* W = wsb(p, OFF_WIN);
    bf16_t* P = wsb(p, OFF_P);
    unsigned char* G = (unsigned char*)(wsp(p) + OFF_GATE);
    const int nMt = TT / 128, nNt = NINP / 128;
    for (int item = bidx(); item < nMt * nNt; item += gridDim.x) {
        int mt, nt; tile_mn(item, nMt, nNt, mt, nt);
        const int m0 = mt * 128, n0 = nt * 128;
        if (l == 1 && m0 >= TL && n0 >= NGATE0) continue;
        f32x16 acc[2][2]; acc_zero<2>(acc);
        gemm_mainloop(acc, [&](int r) { return H + (size_t)(m0 + r) * 1024; }, [&](int r) { return W + (size_t)(n0 + r) * 1024; }, 1024, sm);
        if (n0 < NGATE0) {
            EPI_FOREACH(acc, { const int col = n0 + ec; if (col < C_PEND) P[(size_t)(m0 + er) * LDP + col] = f2bf(ev); })
        } else {
            EPI_FOREACH(acc, { const int col = n0 + ec - NGATE0; const float s = sigmoidf_(ev); G[(size_t)(m0 + er) * 4096 + col] = (unsigned char)__float2int_rn(s * 255.f); })
        }
    }
}

template <class EF>
DEV void gemm_generic(const bf16_t* A, int lda, int M, const bf16_t* Bt, int ldb, int N, int K, EF ef, char* smem, int rot) {
    bf16_t* sm = (bf16_t*)smem;
    const int nMt = (M + 127) / 128, nNt = (N + 127) / 128, G = gridDim.x;
    const int first = (bidx() - (rot % G) + G) % G;
    for (int item = first; item < nMt * nNt; item += G) {
        const int mt = item / nNt, nt = item % nNt, m0 = mt * 128, n0 = nt * 128;
        f32x16 acc[2][2]; acc_zero<2>(acc);
        gemm_mainloop(acc, [&](int r) { int rr = m0 + r; rr = rr < M ? rr : M - 1; return A + (size_t)rr * lda; },
                      [&](int r) { int rr = n0 + r; rr = rr < N ? rr : N - 1; return Bt + (size_t)rr * ldb; }, K, sm);
        EPI_FOREACH(acc, { const int row = m0 + er, col = n0 + ec; if (row < M && col < N) ef(row, col, ev); })
    }
}

DEV void phase_merge(const Params& p, int l, int M, char* smem) {
    bf16_t* sm = (bf16_t*)smem;
    const bf16_t* Y = wsb(p, OFF_Y);
    const bf16_t* W = wsb(p, OFF_WBR);
    const unsigned char* G = (const unsigned char*)(wsp(p) + OFF_GATE);
    bf16_t* MG = wsb(p, OFF_H);
    bf16_t* As = sm;
    bf16_t* Bs = sm + 2 * GSTAGE;
    unsigned char* Gs = (unsigned char*)(sm + 2 * GSTAGE + 2 * 64 * GLD);
    const int tid = tidx(), lane = tid & 63, wave = tid >> 6, wm = wave >> 1, wn = wave & 1;
    const int soff = (tid >> 3) * GLD + (tid & 7) * 8;
    const int arow0 = (wm * 64 + (lane & 31)) * GLD + (lane >> 5) * 8;
    const int brow0 = (wn * 32 + (lane & 31)) * GLD + (lane >> 5) * 8;
    const int nMt = M / 128, nNt = 16;
    for (int item = bidx(); item < nMt * nNt; item += gridDim.x) {
        const int mt = item / nNt, nt = item % nNt, m0 = mt * 128, n0 = nt * 64;
        const bf16_t* ap[4]; const bf16_t* bp[2]; const unsigned char* gp[2];
#pragma unroll
        for (int i = 0; i < 4; ++i) { const int q = tid + i * NT; ap[i] = Y + (size_t)(m0 + (q >> 3)) * 1024 + (q & 7) * 8; }
#pragma unroll
        for (int i = 0; i < 2; ++i) { const int q = tid + i * NT; bp[i] = W + (size_t)(n0 + (q >> 3)) * 256 + (q & 7) * 8;
                                      gp[i] = G + (size_t)(m0 + (q >> 2)) * 4096 + n0 + (q & 3) * 16; }
        f32x16 tot[2], acc[2];
#pragma unroll
        for (int a = 0; a < 2; ++a)
#pragma unroll
            for (int r = 0; r < 16; ++r) { tot[a][r] = 0.f; acc[a][r] = 0.f; }
        u32x4 ra[4], rb[2], rg[2];
#pragma unroll
        for (int i = 0; i < 4; ++i) ra[i] = *(const u32x4*)ap[i];
#pragma unroll
        for (int i = 0; i < 2; ++i) rb[i] = *(const u32x4*)bp[i];
        __syncthreads();
#pragma unroll
        for (int i = 0; i < 4; ++i) *(u32x4*)(As + soff + i * 32 * GLD) = ra[i];
#pragma unroll
        for (int i = 0; i < 2; ++i) *(u32x4*)(Bs + soff + i * 32 * GLD) = rb[i];
        __syncthreads();
#pragma unroll
        for (int kt = 0; kt < 16; ++kt) {
            const int cur = kt & 1, seg = kt >> 2;
            if (kt + 1 < 16) {
                const int k1 = kt + 1;
#pragma unroll
                for (int i = 0; i < 4; ++i) ra[i] = *(const u32x4*)(ap[i] + k1 * 64);
#pragma unroll
                for (int i = 0; i < 2; ++i) rb[i] = *(const u32x4*)(bp[i] + (size_t)(k1 >> 2) * (1024 * 256) + (k1 & 3) * 64);
            }
            if ((kt & 3) == 0) {
#pragma unroll
                for (int i = 0; i < 2; ++i) rg[i] = *(const u32x4*)(gp[i] + seg * 1024);
            }
            const bf16_t* a_s = As + cur * GSTAGE + arow0;
            const bf16_t* b_s = Bs + cur * (64 * GLD) + brow0;
#pragma unroll
            for (int ks = 0; ks < 4; ++ks) {
                const bf16x8 a0 = *(const bf16x8*)(a_s + ks * 16), a1 = *(const bf16x8*)(a_s + 32 * GLD + ks * 16), b0 = *(const bf16x8*)(b_s + ks * 16);
                acc[0] = __builtin_amdgcn_mfma_f32_32x32x16_bf16(a0, b0, acc[0], 0, 0, 0);
                acc[1] = __builtin_amdgcn_mfma_f32_32x32x16_bf16(a1, b0, acc[1], 0, 0, 0);
            }
            if (kt + 1 < 16) {
                const int nx = cur ^ 1;
#pragma unroll
                for (int i = 0; i < 4; ++i) *(u32x4*)(As + nx * GSTAGE + soff + i * 32 * GLD) = ra[i];
#pragma unroll
                for (int i = 0; i < 2; ++i) *(u32x4*)(Bs + nx * (64 * GLD) + soff + i * 32 * GLD) = rb[i];
            }
            if ((kt & 3) == 3) {
#pragma unroll
                for (int i = 0; i < 2; ++i) { const int q = tid + i * NT; *(u32x4*)(Gs + (q >> 2) * 64 + (q & 3) * 16) = rg[i]; }
            }
            __syncthreads();
            if ((kt & 3) == 3) {
#pragma unroll
                for (int a = 0; a < 2; ++a)
#pragma unroll
                    for (int r = 0; r < 16; ++r) {
                        const int er = wm * 64 + a * 32 + (r & 3) + 8 * (r >> 2) + 4 * (lane >> 5), ec = wn * 32 + (lane & 31);
                        tot[a][r] += (float)Gs[er * 64 + ec] * (1.f / 255.f) * acc[a][r];
                        acc[a][r] = 0.f;
                    }
            }
        }
#pragma unroll
        for (int a = 0; a < 2; ++a)
#pragma unroll
            for (int r = 0; r < 16; ++r) {
                const int er = wm * 64 + a * 32 + (r & 3) + 8 * (r >> 2) + 4 * (lane >> 5), ec = wn * 32 + (lane & 31);
                MG[(size_t)(m0 + er) * 1024 + n0 + ec] = f2bf(tot[a][r]);
            }
    }
}

DEV void phase_outproj(const Params& p, int l, int M, char* smem) {
    bf16_t* sm = (bf16_t*)smem;
    const bf16_t* MG = wsb(p, OFF_H);
    const bf16_t* W = wsb(p, OFF_WOUT);
    const float* xs = (l == 0) ? inp(p, I_X) : p.out;
    const float* cs = (l == 0) ? inp(p, I_CTX) : wsf(p, OFF_CX);
    float* cxd = wsf(p, OFF_CX);
    float* outd = p.out;
    const int nMt = M / 128, nNt = 8;
    for (int item = bidx(); item < nMt * nNt; item += gridDim.x) {
        const int mt = item / nNt, nt = item % nNt, m0 = mt * 128, n0 = nt * 128;
        f32x16 acc[2][2]; acc_zero<2>(acc);
        gemm_mainloop(acc, [&](int r) { return MG + (size_t)(m0 + r) * 1024; }, [&](int r) { return W + (size_t)(n0 + r) * 1024; }, 1024, sm);
        const float* g1 = modp(p, l, mod_row(m0), 2);
        if (m0 < TL) {
            EPI_FOREACH(acc, { const size_t o = (size_t)(m0 + er) * 1024 + n0 + ec; outd[o] = xs[o] + g1[n0 + ec] * ev; })
        } else {
            EPI_FOREACH(acc, { const size_t o = (size_t)(m0 - TL + er) * 1024 + n0 + ec; cxd[o] = cs[o] + g1[n0 + ec] * ev; })
        }
    }
}

constexpr int MOE_MAP_OFF = 73728;
DEV void moe_map(const Params& p, int l, char* smem) {
    int* mm = (int*)(smem + MOE_MAP_OFF);
    __syncthreads();
    if (tidx() == 0) {
        const int* cnt = (const int*)(wsp(p) + OFF_CTR) + CTR_MOE + l * 16;
        int b = 0, t = 0;
        for (int e = 0; e < 16; ++e) { const int c = cnt[e]; mm[e] = c; mm[16 + e] = b; mm[32 + e] = t; b += c; t += (c + 127) >> 7; }
        mm[48] = t;
    }
    __syncthreads();
}
DEV void phase_moe1(const Params& p, int l, char* smem) {
    bf16_t* sm = (bf16_t*)smem;
    const bf16_t* F = wsb(p, OFF_H);
    const bf16_t* W = wsb(p, OFF_WG1);
    bf16_t* ACT = wsb(p, OFF_P);
    const int* ltok = (const int*)(wsp(p) + OFF_LTOK);
    moe_map(p, l, smem); const int* mm = (const int*)(smem + MOE_MAP_OFF);
    const int nNt = 8, total = mm[48] * nNt;
    for (int item = bidx(); item < total; item += gridDim.x) {
        const int mtg = item / nNt, nt = item % nNt;
        int e = 0;
        for (int q = 1; q < 16; ++q) if (mtg >= mm[32 + q]) e = q;
        const int m0 = (mtg - mm[32 + e]) * 128, n0 = nt * 128, ce = mm[e];
        const int* lt = ltok + (size_t)e * TT;
        f32x16 acc[2][2]; acc_zero<2>(acc);
        gemm_mainloop(acc, [&](int r) { int idx = m0 + r; idx = idx < ce ? idx : ce - 1; return F + (size_t)lt[idx] * 1024; },
                      [&](int r) { return W + ((size_t)e * 1024 + n0 + r) * 1024; }, 1024, sm);
        const int lane = tidx() & 63, wave = tidx() >> 6, wm = wave >> 1, wn = wave & 1;
        const int jcol = ((n0 >> 6) + wn) * 32 + (lane & 31);
#pragma unroll
        for (int a = 0; a < 2; ++a)
#pragma unroll
            for (int r = 0; r < 16; ++r) {
                const int idx = m0 + wm * 64 + a * 32 + (r & 3) + 8 * (r >> 2) + 4 * (lane >> 5);
                if (idx < ce) {
                    const float g = acc[a][0][r], u = acc[a][1][r];
                    ACT[(size_t)(mm[16 + e] + idx) * DFF + jcol] = f2bf(g * sigmoidf_(g) * u);
                }
            }
    }
}
DEV void phase_moe2(const Params& p, int l, char* smem) {
    bf16_t* sm = (bf16_t*)smem;
    const bf16_t* ACT = wsb(p, OFF_P);
    const bf16_t* W = wsb(p, OFF_WDN);
    bf16_t* Z = wsb(p, OFF_Z);
    moe_map(p, l, smem); const int* mm = (const int*)(smem + MOE_MAP_OFF);
    const int nNt = 8, total = mm[48] * nNt;
    for (int item = bidx(); item < total; item += gridDim.x) {
        const int mtg = item / nNt, nt = item % nNt;
        int e = 0;
        for (int q = 1; q < 16; ++q) if (mtg >= mm[32 + q]) e = q;
        const int m0 = (mtg - mm[32 + e]) * 128, n0 = nt * 128, ce = mm[e];
        f32x16 acc[2][2]; acc_zero<2>(acc);
        gemm_mainloop(acc, [&](int r) { int idx = m0 + r; idx = idx < ce ? idx : ce - 1; return ACT + (size_t)(mm[16 + e] + idx) * DFF; },
                      [&](int r) { return W + ((size_t)e * 1024 + n0 + r) * DFF; }, DFF, sm);
        bf16_t* zb = Z + (size_t)mm[16 + e] * 1024;
        EPI_FOREACH(acc, { const int idx = m0 + er; if (idx < ce) zb[(size_t)idx * 1024 + n0 + ec] = f2bf(ev); })
    }
}
DEV void tok_seq(int t, int& base, int& n, int& len) {
    if (t < TL) { base = t & ~(SEQ - 1); n = t & (SEQ - 1); len = SEQ; } else { const int u = t - TL; base = TL + (u & ~(CTXL - 1)); n = u & (CTXL - 1); len = CTXL; }
}
DEV void phase_prep1(const Params& p, int l) {
    const int lane = tidx() & 63, wave = tidx() >> 6;
    bf16_t* P = wsb(p, OFF_P);
    bf16_t* XL = wsb(p, OFF_XL);
    const float* qkg = inp(p, I_DAQKG) + l * 64;
    const float* cqg = inp(p, I_MCQG) + l * 192;
    const float* ckvg = inp(p, I_MCKVG) + l * 128;
    const float* mu3 = inp(p, I_RMU) + (l * 4 + 3) * 256;
    for (int t = bidx() * 4 + wave; t < TT; t += gridDim.x * 4) {
        bf16_t* row = P + (size_t)t * LDP;
        int base, n, len; tok_seq(t, base, n, len);
        {
            const int d0 = (lane & 7) * 4;
            float cs[4], sn[4];
            const bool rot = t < TL;
            if (rot) {
                const float fr = (float)(n >> 6), fc = (float)(n & 63);
#pragma unroll
                for (int j = 0; j < 4; ++j) {
                    const int i = (d0 + j) & 15;
                    const float inv = exp2f(-(float)(i & 7) * (13.287712379549449f / 8.f));
                    const float ang = (i < 8 ? fr : fc) * inv;
                    cs[j] = __cosf(ang); sn[j] = __sinf(ang);
                }
            }
#pragma unroll
            for (int which = 0; which < 2; ++which) {
                bf16_t* ptr = row + (which ? C_DAK : C_DAQ) + lane * 4;
                const u32x2 raw = *(const u32x2*)ptr;
                float v[4] = { bflo(raw.x), bfhi(raw.x), bflo(raw.y), bfhi(raw.y) };
                float ss = v[0] * v[0] + v[1] * v[1] + v[2] * v[2] + v[3] * v[3];
                ss = group_sum<8>(ss);
                const float rstd = rsqrtf(ss * (1.f / 32.f) + EPS);
                const float* g = qkg + which * 32 + d0;
#pragma unroll
                for (int j = 0; j < 4; ++j) v[j] = v[j] * rstd * g[j];
                if (rot) {
#pragma unroll
                    for (int j = 0; j < 4; ++j) {
                        const float o = __shfl_xor(v[j], 4, 64);
                        v[j] = (d0 < 16) ? (v[j] * cs[j] - o * sn[j]) : (v[j] * cs[j] + o * sn[j]);
                    }
                }
                if (which == 0) {
                    const float qs = 0.17677669529663687f * LOG2E;
#pragma unroll
                    for (int j = 0; j < 4; ++j) v[j] *= qs;
                }
                u32x2 o; o.x = pack2(v[0], v[1]); o.y = pack2(v[2], v[3]);
                *(u32x2*)ptr = o;
            }
        }
        {
            float v[3]; float ss = 0.f;
#pragma unroll
            for (int j = 0; j < 3; ++j) { v[j] = bf2f(row[C_CQ + lane + j * 64]); ss += v[j] * v[j]; }
            ss = wave_sum(ss);
            const float rstd = rsqrtf(ss * (1.f / 192.f) + EPS);
#pragma unroll
            for (int j = 0; j < 3; ++j) row[C_CQ + lane + j * 64] = f2bf(v[j] * rstd * cqg[lane + j * 64]);
            float w[2]; float s2 = 0.f;
#pragma unroll
            for (int j = 0; j < 2; ++j) { w[j] = bf2f(row[C_CKV + lane + j * 64]); s2 += w[j] * w[j]; }
            s2 = wave_sum(s2);
            const float r2 = rsqrtf(s2 * (1.f / 128.f) + EPS);
#pragma unroll
            for (int j = 0; j < 2; ++j) row[C_CKV + lane + j * 64] = f2bf(w[j] * r2 * ckvg[lane + j * 64]);
        }
        {
            const int c = lane * 4;
            const u32x2 cur = *(const u32x2*)(row + C_RWD + c);
            u32x2 pv = (u32x2){0u, 0u}, nx = (u32x2){0u, 0u};
            if (n > 0) pv = *(const u32x2*)(row - LDP + C_RWD + c);
            if (n + 1 < len) nx = *(const u32x2*)(row + LDP + C_RWD + c);
            const float4 m = *(const float4*)(mu3 + c);
            float o[4];
            { const float x = bflo(cur.x); o[0] = x + (0.5f * (bflo(pv.x) + bflo(nx.x)) - x) * m.x; }
            { const float x = bfhi(cur.x); o[1] = x + (0.5f * (bfhi(pv.x) + bfhi(nx.x)) - x) * m.y; }
            { const float x = bflo(cur.y); o[2] = x + (0.5f * (bflo(pv.y) + bflo(nx.y)) - x) * m.z; }
            { const float x = bfhi(cur.y); o[3] = x + (0.5f * (bfhi(pv.y) + bfhi(nx.y)) - x) * m.w; }
            u32x2 ov; ov.x = pack2(o[0], o[1]); ov.y = pack2(o[2], o[3]);
            *(u32x2*)(XL + (size_t)t * 256 + c) = ov;
        }
    }
}

DEV void phase_prep_gemm1(const Params& p, int l, char* smem) {
    const bf16_t* P = wsb(p, OFF_P);
    const bf16_t* w = wsb(p, OFF_WSM) + (size_t)l * WS_PER_LAYER;
    bf16_t* QRAW = wsb(p, OFF_QRAW); bf16_t* KVRAW = wsb(p, OFF_KVRAW); bf16_t* LR = wsb(p, OFF_LR);
    int rot = 0;
    gemm_generic(P + C_CQ, LDP, TT, w + WS_UQT, 192, 192, 192, [&](int r, int c, float v) { QRAW[(size_t)r * 192 + c] = f2bf(v); }, smem, rot);
    rot += (TT / 128) * 2;
    gemm_generic(P + C_CKV, LDP, TT, w + WS_UKVT, 128, 384, 128, [&](int r, int c, float v) { KVRAW[(size_t)r * 384 + c] = f2bf(v); }, smem, rot);
    rot += (TT / 128) * 3;
    gemm_generic(wsb(p, OFF_XL), 256, TT, w + WS_W1C, 256, 192, 256,
                 [&](int r, int c, float v) { const float o = c < 64 ? (1.f - 2.f / (__expf(2.f * v) + 1.f)) : (c < 128 ? v : sigmoidf_(v)); LR[(size_t)r * 192 + c] = f2bf(o); }, smem, rot);
}
DEV void phase_prep_gemm2(const Params& p, int l, char* smem) {
    const bf16_t* w = wsb(p, OFF_WSM) + (size_t)l * WS_PER_LAYER;
    const bf16_t* LR = wsb(p, OFF_LR);
    bf16_t* RWX = wsb(p, OFF_RWX);
    bf16_t* P = wsb(p, OFF_P);
    int rot = 0;
    for (int d = 0; d < 2; ++d) {
        const float* w0 = inp(p, I_RW0) + (l * 2 + d) * 256;
        gemm_generic(LR + d * 32, 192, TT, w + WS_W2 + (size_t)d * 256 * 64, 64, 256, 64,
                     [&](int r, int c, float v) { RWX[(size_t)r * 1024 + d * 256 + c] = f2bf(0.6065306597126334f * sigmoidf_(w0[c] + v)); }, smem, rot);
        rot += (TT / 128) * 2;
        const float* a0 = inp(p, I_RA0) + (l * 2 + d) * 256;
        gemm_generic(LR + 64 + d * 32, 192, TT, w + WS_W2 + (size_t)(2 + d) * 256 * 64, 64, 256, 64,
                     [&](int r, int c, float v) { RWX[(size_t)r * 1024 + 512 + d * 256 + c] = f2bf(sigmoidf_(a0[c] + v)); }, smem, rot);
        rot += (TT / 128) * 2;
    }
    gemm_generic(LR + 128, 192, TT, w + WS_G2T, 64, 256, 64, [&](int r, int c, float v) { P[(size_t)r * LDP + C_RWD + c] = f2bf(v); }, smem, rot);
}

DEV void phase_prep2(const Params& p, int l) {
    const int lane = tidx() & 63, wave = tidx() >> 6;
    const bf16_t* P = wsb(p, OFF_P);
    const bf16_t* QRAW = wsb(p, OFF_QRAW); const bf16_t* KVRAW = wsb(p, OFF_KVRAW);
    bf16_t* MQ = wsb(p, OFF_MLAQ); bf16_t* MK = wsb(p, OFF_MLAK); bf16_t* MV = wsb(p, OFF_MLAV);
    const float* qkg = inp(p, I_MQKG) + l * 96;
    for (int t = bidx() * 4 + wave; t < TT; t += gridDim.x * 4) {
        int base, n, len; tok_seq(t, base, n, len);
        const int h = lane >> 4, j = lane & 15;
        const bool rot = t < TL;
        float cs = 1.f, sn = 0.f;
        if (rot) {
            const int i = j & 7;
            const float inv = exp2f(-(float)(i & 3) * (13.287712379549449f / 4.f));
            const float ang = (i < 4 ? (float)(n >> 6) : (float)(n & 63)) * inv;
            cs = __cosf(ang); sn = __sinf(ang);
        }
        {
            float v[3]; float ss = 0.f;
#pragma unroll
            for (int k = 0; k < 3; ++k) { v[k] = bf2f(QRAW[(size_t)t * 192 + h * 48 + j + k * 16]); ss += v[k] * v[k]; }
            ss = group_sum<16>(ss);
            const float rstd = rsqrtf(ss * (1.f / 48.f) + EPS);
#pragma unroll
            for (int k = 0; k < 3; ++k) v[k] = v[k] * rstd * qkg[j + k * 16];
            if (rot) { const float o = __shfl_xor(v[2], 8, 64); v[2] = (j < 8) ? (v[2] * cs - o * sn) : (v[2] * cs + o * sn); }
            const float qs = 0.14433756729740643f * LOG2E;
#pragma unroll
            for (int k = 0; k < 3; ++k) MQ[(size_t)t * 192 + h * 48 + j + k * 16] = f2bf(v[k] * qs);
        }
        {
            float v[3]; float ss = 0.f;
            v[0] = bf2f(KVRAW[(size_t)t * 384 + h * 96 + j]);
            v[1] = bf2f(KVRAW[(size_t)t * 384 + h * 96 + 16 + j]);
            v[2] = bf2f(P[(size_t)t * LDP + C_KR + j]);
#pragma unroll
            for (int k = 0; k < 3; ++k) ss += v[k] * v[k];
            ss = group_sum<16>(ss);
            const float rstd = rsqrtf(ss * (1.f / 48.f) + EPS);
#pragma unroll
            for (int k = 0; k < 3; ++k) v[k] = v[k] * rstd * qkg[48 + j + k * 16];
            if (rot) { const float o = __shfl_xor(v[2], 8, 64); v[2] = (j < 8) ? (v[2] * cs - o * sn) : (v[2] * cs + o * sn); }
#pragma unroll
            for (int k = 0; k < 3; ++k) MK[(size_t)t * 192 + h * 48 + j + k * 16] = f2bf(v[k]);
        }
#pragma unroll
        for (int k = 0; k < 4; ++k) MV[(size_t)t * 256 + h * 64 + j + k * 16] = KVRAW[(size_t)t * 384 + h * 96 + 32 + j + k * 16];
    }
}
template <int NC, int DK>
struct AttnCfg {
    static constexpr int DKROW = NC * DK, KLD = DKROW + 8, VLD = 96;
    static constexpr int KSTAGE = 64 * KLD, VSTAGE = 64 * VLD;
    static constexpr int KCH = 64 * DKROW / 8;
};
template <int NC, int DK, class EPI>
DEV void attn_item(const bf16_t* Q, int ldq, const bf16_t* Kl, const bf16_t* Kc, int ldk, const bf16_t* Vl, const bf16_t* Vc, int ldv,
                   int q0, int nlat_tiles, int nctx_tiles, EPI epi, char* smem) {
    using C = AttnCfg<NC, DK>;
    constexpr int KS = DK / 16;
    const int tid = tidx(), lane = tid & 63, wave = tid >> 6, ql = lane & 31, hh = lane >> 5;
    bf16_t* Ks = (bf16_t*)smem;
    bf16_t* Vt = Ks + 2 * C::KSTAGE;
    bf16x8 qf[NC][KS];
    {
        const bf16_t* qp = Q + (size_t)(q0 + wave * 32 + ql) * ldq + hh * 8;
#pragma unroll
        for (int c = 0; c < NC; ++c)
#pragma unroll
            for (int ks = 0; ks < KS; ++ks) qf[c][ks] = *(const bf16x8*)(qp + c * DK + ks * 16);
    }
    bf16x8* qpark = (bf16x8*)(smem + 45056) + tid;
    if (NC > 1) {
#pragma unroll
        for (int c = 0; c < NC; ++c)
#pragma unroll
            for (int ks = 0; ks < KS; ++ks) qpark[(c * KS + ks) * NT] = qf[c][ks];
    }
    f32x16 O[NC][2];
    float mrun[NC], lrun[NC];
#pragma unroll
    for (int c = 0; c < NC; ++c) {
        mrun[c] = -1e30f; lrun[c] = 0.f;
#pragma unroll
        for (int d = 0; d < 2; ++d)
#pragma unroll
            for (int r = 0; r < 16; ++r) O[c][d][r] = 0.f;
    }
    const int ntiles = nlat_tiles + nctx_tiles;
    constexpr int KPT = (C::KCH + NT - 1) / NT;
    constexpr bool KFULL = (C::KCH % NT) == 0;
    u32x4 rk[KPT], rv[2];
    auto load_tile = [&](int tile) {
        const bf16_t* kb = tile < nlat_tiles ? Kl + (size_t)tile * 64 * ldk : Kc + (size_t)(tile - nlat_tiles) * 64 * ldk;
        const bf16_t* vb = tile < nlat_tiles ? Vl + (size_t)tile * 64 * ldv : Vc + (size_t)(tile - nlat_tiles) * 64 * ldv;
#pragma unroll
        for (int i = 0; i < KPT; ++i) {
            int q = tid + i * NT; q = (KFULL || q < C::KCH) ? q : C::KCH - 1;
            { const int key = q / (C::DKROW / 8), ch = q % (C::DKROW / 8); rk[i] = *(const u32x4*)(kb + (size_t)key * ldk + ch * 8); }
        }
#pragma unroll
        for (int i = 0; i < 2; ++i) { const int q = tid + i * NT; const int key = q >> 3, ch = q & 7; rv[i] = *(const u32x4*)(vb + (size_t)key * ldv + ch * 8); }
    };
    auto store_tile = [&](int st) {
#pragma unroll
        for (int i = 0; i < KPT; ++i) {
            const int q = tid + i * NT;
            if (KFULL || q < C::KCH) { const int key = q / (C::DKROW / 8), ch = q % (C::DKROW / 8); *(u32x4*)(Ks + st * C::KSTAGE + key * C::KLD + ch * 8) = rk[i]; }
        }
#pragma unroll
        for (int i = 0; i < 2; ++i) { const int q = tid + i * NT; const int key = q >> 3, ch = q & 7; *(u32x4*)(Vt + st * C::VSTAGE + key * C::VLD + ch * 8) = rv[i]; }
    };
    typedef short s16x4_ __attribute__((ext_vector_type(4)));
    typedef __attribute__((address_space(3))) s16x4_ lds_s16x4_;
    const int vrd_off = (4 * hh + ((lane & 15) >> 2)) * C::VLD + 16 * ((lane >> 4) & 1) + 4 * (lane & 3);
    load_tile(0);
    __syncthreads();
    store_tile(0);
    __syncthreads();
#pragma unroll 1
    for (int tile = 0; tile < ntiles; ++tile) {
        const int cur = tile & 1;
        if (tile + 1 < ntiles) load_tile(tile + 1);
        __builtin_amdgcn_sched_barrier(0);
        const bf16_t* ks_ = Ks + cur * C::KSTAGE;
        const bf16_t* vt_ = Vt + cur * C::VSTAGE;
#pragma unroll
        for (int c = 0; c < NC; ++c) {
            f32x16 S[2];
#pragma unroll
            for (int kb = 0; kb < 2; ++kb) {
#pragma unroll
                for (int r = 0; r < 16; ++r) S[kb][r] = 0.f;
#pragma unroll
                for (int ks = 0; ks < KS; ++ks) {
                    const bf16x8 kf = *(const bf16x8*)(ks_ + (kb * 32 + ql) * C::KLD + c * DK + ks * 16 + hh * 8);
                    const bf16x8 qv = (NC > 1) ? qpark[(c * KS + ks) * NT] : qf[c][ks];
                    S[kb] = __builtin_amdgcn_mfma_f32_32x32x16_bf16(kf, qv, S[kb], 0, 0, 0);
                }
            }
            float mx = S[0][0];
#pragma unroll
            for (int kb = 0; kb < 2; ++kb)
#pragma unroll
                for (int r = 0; r < 16; ++r) mx = fmaxf(mx, S[kb][r]);
            mx = fmaxf(mx, __shfl_xor(mx, 32, 64));
            const float mnew = fmaxf(mrun[c], mx);
            const float alpha = __builtin_amdgcn_exp2f(mrun[c] - mnew);
            mrun[c] = mnew;
            float ls = 0.f;
#pragma unroll
            for (int kb = 0; kb < 2; ++kb)
#pragma unroll
                for (int r = 0; r < 16; ++r) { const float e = __builtin_amdgcn_exp2f(S[kb][r] - mnew); S[kb][r] = e; ls += e; }
            lrun[c] = lrun[c] * alpha + ls;
#pragma unroll
            for (int d = 0; d < 2; ++d)
#pragma unroll
                for (int r = 0; r < 16; ++r) O[c][d][r] *= alpha;
#pragma unroll
            for (int s = 0; s < 4; ++s) {
                const int kb = s >> 1, s2 = s & 1;
                const u32x4 pu = (u32x4){pack2(S[kb][8 * s2 + 0], S[kb][8 * s2 + 1]), pack2(S[kb][8 * s2 + 2], S[kb][8 * s2 + 3]),
                                         pack2(S[kb][8 * s2 + 4], S[kb][8 * s2 + 5]), pack2(S[kb][8 * s2 + 6], S[kb][8 * s2 + 7])};
                const bf16x8 pf = __builtin_bit_cast(bf16x8, pu);
#pragma unroll
                for (int d = 0; d < 2; ++d) {
                    const bf16_t* vp = vt_ + vrd_off + (kb * 32 + 16 * s2) * C::VLD + d * 32;
                    const s16x4_ lo = __builtin_amdgcn_ds_read_tr16_b64_v4i16((lds_s16x4_*)vp), hi = __builtin_amdgcn_ds_read_tr16_b64_v4i16((lds_s16x4_*)(vp + 8 * C::VLD));
                    const bf16x8 vf = __builtin_shufflevector(lo, hi, 0, 1, 2, 3, 4, 5, 6, 7);
                    O[c][d] = __builtin_amdgcn_mfma_f32_32x32x16_bf16(vf, pf, O[c][d], 0, 0, 0);
                }
            }
        }
        if (tile + 1 < ntiles) store_tile(cur ^ 1);
        __syncthreads();
    }
    float inv[NC];
#pragma unroll
    for (int c = 0; c < NC; ++c) { const float lt = lrun[c] + __shfl_xor(lrun[c], 32, 64); inv[c] = 1.f / lt; }
    epi(O, inv, q0 + wave * 32 + ql, hh);
}

DEV void da_item(const Params& p, int l, int item, char* smem) {
    const bf16_t* P = wsb(p, OFF_P);
    bf16_t* Y = wsb(p, OFF_Y);
    const float linit = 0.8f - 0.6f * __expf(-0.3f * (float)l);
    float lam;
    {
        const float* la = inp(p, I_DALAM) + l * 128;
        const int lane = tidx() & 63;
        float a = lane < 32 ? la[lane] * la[32 + lane] : 0.f, b = lane < 32 ? la[64 + lane] * la[96 + lane] : 0.f;
        a = wave_sum(a); b = wave_sum(b);
        lam = __expf(a) - __expf(b) + linit;
    }
    const float* sg = inp(p, I_DASUB) + l * 64;
    int b, h, qt; bool isctx;
    if (item < 512) { isctx = false; b = item >> 6; h = (item >> 4) & 3; qt = item & 15; }
    else { const int it = item - 512; isctx = true; b = it >> 3; h = (it >> 1) & 3; qt = it & 1; }
    const size_t lat0 = (size_t)b * SEQ, ctx0 = (size_t)TL + (size_t)b * CTXL;
    const size_t qrow0 = isctx ? ctx0 : lat0;
    auto epi2 = [&](f32x16 (&O)[2][2], float (&inv)[2], int qrow, int hh) {
        float v[2][16]; float ss = 0.f;
        const float li1 = lam * inv[1];
#pragma unroll
        for (int d = 0; d < 2; ++d)
#pragma unroll
            for (int r = 0; r < 16; ++r) { const float o = O[0][d][r] * inv[0] - li1 * O[1][d][r]; v[d][r] = o; ss += o * o; }
        ss += __shfl_xor(ss, 32, 64);
        const float rstd = rsqrtf(ss * (1.f / 64.f) + EPS) * (1.f - linit);
        bf16_t* yo = Y + (qrow0 + qrow) * 1024 + h * 64;
#pragma unroll
        for (int d = 0; d < 2; ++d)
#pragma unroll
            for (int g = 0; g < 4; ++g) {
                const int dv = d * 32 + 8 * g + 4 * hh;
                u32x2 o;
                o.x = pack2(v[d][4 * g + 0] * rstd * sg[dv + 0], v[d][4 * g + 1] * rstd * sg[dv + 1]);
                o.y = pack2(v[d][4 * g + 2] * rstd * sg[dv + 2], v[d][4 * g + 3] * rstd * sg[dv + 3]);
                *(u32x2*)(yo + dv) = o;
            }
    };
    const bf16_t* Qp = P + qrow0 * LDP + C_DAQ + h * 64;
    const bf16_t* Kl = P + lat0 * LDP + C_DAK + h * 64;
    const bf16_t* Kc = P + ctx0 * LDP + C_DAK + h * 64;
    const bf16_t* Vl = P + lat0 * LDP + C_DAV + h * 64;
    const bf16_t* Vc = P + ctx0 * LDP + C_DAV + h * 64;
    const int nlat = isctx ? 0 : SEQ / 64;
    attn_item<2, 32>(Qp, LDP, Kl, Kc, LDP, Vl, Vc, LDP, qt * 128, nlat, CTXL / 64, epi2, smem);
}
DEV void mla_item(const Params& p, int l, int item, char* smem) {
    const bf16_t* MQ = wsb(p, OFF_MLAQ); const bf16_t* MK = wsb(p, OFF_MLAK); const bf16_t* MV = wsb(p, OFF_MLAV);
    bf16_t* Y = wsb(p, OFF_Y);
    int b, h, qt; bool isctx;
    if (item < 512) { isctx = false; b = item >> 6; h = (item >> 4) & 3; qt = item & 15; }
    else { const int it = item - 512; isctx = true; b = it >> 3; h = (it >> 1) & 3; qt = it & 1; }
    const size_t lat0 = (size_t)b * SEQ, ctx0 = (size_t)TL + (size_t)b * CTXL;
    const size_t qrow0 = isctx ? ctx0 : lat0;
    auto epi = [&](f32x16 (&O)[1][2], float (&inv)[1], int qrow, int hh) {
        bf16_t* yo = Y + (qrow0 + qrow) * 1024 + 512 + h * 64;
#pragma unroll
        for (int d = 0; d < 2; ++d)
#pragma unroll
            for (int g = 0; g < 4; ++g) {
                const int dv = d * 32 + 8 * g + 4 * hh;
                u32x2 o;
                o.x = pack2(O[0][d][4 * g + 0] * inv[0], O[0][d][4 * g + 1] * inv[0]);
                o.y = pack2(O[0][d][4 * g + 2] * inv[0], O[0][d][4 * g + 3] * inv[0]);
                *(u32x2*)(yo + dv) = o;
            }
    };
    const bf16_t* Qp = MQ + qrow0 * 192 + h * 48;
    const bf16_t* Kl = MK + lat0 * 192 + h * 48;
    const bf16_t* Kc = MK + ctx0 * 192 + h * 48;
    const bf16_t* Vl = MV + lat0 * 256 + h * 64;
    const bf16_t* Vc = MV + ctx0 * 256 + h * 64;
    attn_item<1, 48>(Qp, 192, Kl, Kc, 192, Vl, Vc, 256, qt * 128, isctx ? 0 : SEQ / 64, CTXL / 64, epi, smem);
}
DEV int s5_token(int b, int tb, int n) { return tb == 0 ? TL + b * CTXL + n : b * SEQ + (tb - 1) * 256 + n; }
struct S5M { float are, aim; bf16x8* bfl; };
DEV void s5_coef(const Params& p, int gi, int pl, float& are, float& aim, float& cr, float& ci) {
    const float lre = inp(p, I_S5LRE)[gi * 64 + pl], lim = inp(p, I_S5LIM)[gi * 64 + pl];
    const float dt = __expf(inp(p, I_S5LDT)[gi]);
    const float mag = __expf(lre * dt);
    are = mag * __cosf(lim * dt); aim = mag * __sinf(lim * dt);
    const float nr = are - 1.f, ni = aim, den = 1.f / (lre * lre + lim * lim);
    cr = (nr * lre + ni * lim) * den; ci = (ni * lre - nr * lim) * den;
}
DEV void s5_setup(const Params& p, int l, int d, int g, int lane, S5M& s, bf16x8* bfl) {
    s.bfl = bfl;
    const int gi = ((l * 2 + d) * 16 + g), c16 = lane & 15, kq = lane >> 4;
    float cr, ci;
    s5_coef(p, gi, lane, s.are, s.aim, cr, ci);
#pragma unroll
    for (int nt = 0; nt < 4; ++nt) {
        const int pp = nt * 16 + c16;
        float a0, a1; s5_coef(p, gi, pp, a0, a1, cr, ci);
        float re[8], im[8];
        const float* br = inp(p, I_S5BRE) + ((size_t)gi * 64 + pp) * 16 + (kq & 1) * 8;
        const float* bi = inp(p, I_S5BIM) + ((size_t)gi * 64 + pp) * 16 + (kq & 1) * 8;
#pragma unroll
        for (int j = 0; j < 8; ++j) { const float x = br[j], y = bi[j]; const bool on = kq < 2; re[j] = on ? cr * x - ci * y : 0.f; im[j] = on ? cr * y + ci * x : 0.f; }
        bfl[nt * 64 + lane] = __builtin_bit_cast(bf16x8, (u32x4){pack2(re[0], re[1]), pack2(re[2], re[3]), pack2(re[4], re[5]), pack2(re[6], re[7])});
        bfl[(nt + 4) * 64 + lane] = __builtin_bit_cast(bf16x8, (u32x4){pack2(im[0], im[1]), pack2(im[2], im[3]), pack2(im[4], im[5]), pack2(im[6], im[7])});
    }
}
DEV void s5_bu32(const S5M& s, const bf16_t* P, int b, int tb, int g, int sc, bf16_t* hb, int lane) {
    asm volatile("" : "+v"(sc));
    const int c16 = lane & 15, kq = lane >> 4;
    bf16x8 uf[2];
#pragma unroll
    for (int mt = 0; mt < 2; ++mt) {
        const int t = s5_token(b, tb, sc * 32 + mt * 16 + c16);
        const u32x4 raw = *(const u32x4*)(P + (size_t)t * LDP + C_S5 + g * 16 + (kq & 1) * 8);
        const u32x4 z = (u32x4){0u, 0u, 0u, 0u};
        uf[mt] = __builtin_bit_cast(bf16x8, kq < 2 ? raw : z);
    }
#pragma unroll
    for (int nt = 0; nt < 8; ++nt)
#pragma unroll
        for (int mt = 0; mt < 2; ++mt) {
            const f32x4 acc = __builtin_amdgcn_mfma_f32_16x16x32_bf16(s.bfl[nt * 64 + lane], uf[mt], (f32x4){0.f, 0.f, 0.f, 0.f}, 0, 0, 0);
            u32x2 o; o.x = pack2(acc[0], acc[1]); o.y = pack2(acc[2], acc[3]);
            *(u32x2*)(hb + (mt * 16 + c16) * 136 + nt * 16 + kq * 4) = o;
            if (mt == 1 && (nt & 1)) __builtin_amdgcn_sched_barrier(0);
        }
}
template <bool DUMP>
DEV void s5_scan32(const S5M& s, float& hre, float& him, bf16_t* hb, int pl, bool rev) {
#pragma unroll 4
    for (int j = 0; j < 32; ++j) {
        const int rowi = rev ? 31 - j : j;
        const float bur = bf2f(hb[rowi * 136 + pl]), bui = bf2f(hb[rowi * 136 + 64 + pl]);
        const float nre = s.are * hre - s.aim * him + bur;
        const float nim = s.are * him + s.aim * hre + bui;
        hre = nre; him = nim;
        if (DUMP) { hb[rowi * 136 + pl] = f2bf(hre); hb[rowi * 136 + 64 + pl] = f2bf(him); }
    }
}
DEV void phase_s5_pass1(const Params& p, int l, char* smem) {
    const int lane = tidx() & 63, wave = tidx() >> 6;
    bf16_t* hb = (bf16_t*)smem + wave * (32 * 136);
    const bf16_t* P = wsb(p, OFF_P);
    float* st = wsf(p, OFF_S5ST);
    const int nitems = 2 * 8 * 16 * 8;
    for (int it0 = bidx() * 4; it0 < nitems; it0 += gridDim.x * 4) {
        const int it = it0 + wave;
        const int seg = it & 7, g = (it >> 3) & 15, b = (it >> 7) & 7, d = it >> 10;
        const int tb = seg == 0 ? 0 : (d == 0 ? seg : 9 - seg);
        __syncthreads();
        S5M s; s5_setup(p, l, d, g, lane, s, (bf16x8*)(smem + 36864) + wave * 512);
        float hre = 0.f, him = 0.f;
        for (int k = 0; k < 8; ++k) {
            const int sc = d == 0 ? k : 7 - k;
            __syncthreads();
            s5_bu32(s, P, b, tb, g, sc, hb, lane);
            __syncthreads();
            s5_scan32<false>(s, hre, him, hb, lane, d == 1);
        }
        float* o = st + ((((size_t)d * 8 + b) * 16 + g) * 8 + seg) * 128;
        o[lane] = hre; o[64 + lane] = him;
    }
}
DEV void s5_pass2_item(const Params& p, int l, int tb0, int bitem, char* smem) {
    const int lane = tidx() & 63, wave = tidx() >> 6;
    bf16_t* hb = (bf16_t*)smem + wave * (32 * 136);
    bf16_t* P = wsb(p, OFF_P);
    bf16_t* S5Y = wsb(p, OFF_S5Y);
    const float* st = wsf(p, OFF_S5ST);
    const int it = bitem * 4 + wave;
    const int g = it & 15, b = (it >> 4) & 7, tb = (it >> 7) + tb0;
    const int c = lane & 15;
    const float dd = inp(p, I_S5D)[(l * 16 + g) * 16 + c];
#pragma unroll 1
    for (int d = 0; d < 2; ++d) {
        __syncthreads();
        S5M s; s5_setup(p, l, d, g, lane, s, (bf16x8*)(smem + 36864) + wave * 512);
        bf16x8 cf[4];
        {
            const float* cre = inp(p, I_S5CRE) + ((size_t)((l * 2 + d) * 16 + g) * 16 + c) * 64 + (lane >> 4) * 8;
            const float* cim = inp(p, I_S5CIM) + ((size_t)((l * 2 + d) * 16 + g) * 16 + c) * 64 + (lane >> 4) * 8;
#pragma unroll
            for (int ks = 0; ks < 4; ++ks) {
                const float* src = ks < 2 ? cre + ks * 32 : cim + (ks - 2) * 32;
                const float4 a = *(const float4*)src, b4 = *(const float4*)(src + 4);
                const float sg = ks < 2 ? 1.f : -1.f;
                cf[ks] = __builtin_bit_cast(bf16x8, (u32x4){pack2(sg * a.x, sg * a.y), pack2(sg * a.z, sg * a.w), pack2(sg * b4.x, sg * b4.y), pack2(sg * b4.z, sg * b4.w)});
            }
        }
        const int seg = tb == 0 ? 0 : (d == 0 ? tb : 9 - tb);
        float hre = 0.f, him = 0.f;
        {
            float pr = s.are, pi = s.aim;
#pragma unroll
            for (int q = 0; q < 8; ++q) { const float nr = pr * pr - pi * pi, ni = 2.f * pr * pi; pr = nr; pi = ni; }
            const float* hs = st + (((size_t)d * 8 + b) * 16 + g) * 8 * 128;
            for (int i = 0; i < seg; ++i) {
                const float er = hs[i * 128 + lane], ei = hs[i * 128 + 64 + lane];
                const float nr = pr * hre - pi * him + er, ni = pr * him + pi * hre + ei;
                hre = nr; him = ni;
            }
        }
#pragma unroll 1
        for (int k = 0; k < 8; ++k) {
            const int sc = d == 0 ? k : 7 - k;
            __syncthreads();
            s5_bu32(s, P, b, tb, g, sc, hb, lane);
            __syncthreads();
            s5_scan32<true>(s, hre, him, hb, lane, d == 1);
            __syncthreads();
#pragma unroll
            for (int mt = 0; mt < 2; ++mt) {
                f32x4 y = (f32x4){0.f, 0.f, 0.f, 0.f};
#pragma unroll
                for (int ks = 0; ks < 4; ++ks) {
                    const bf16x8 af = *(const bf16x8*)(hb + (mt * 16 + (lane & 15)) * 136 + ks * 32 + (lane >> 4) * 8);
                    y = __builtin_amdgcn_mfma_f32_16x16x32_bf16(af, cf[ks], y, 0, 0, 0);
                }
#pragma unroll
                for (int r = 0; r < 4; ++r) {
                    const int n = sc * 32 + mt * 16 + (lane >> 4) * 4 + r;
                    const size_t t = (size_t)s5_token(b, tb, n);
                    if (d == 0) S5Y[t * 256 + g * 16 + c] = f2bf(y[r]);
                    else {
                        bf16_t* up = P + t * LDP + C_S5 + g * 16 + c;
                        const float yy = dd * bf2f(*up) + bf2f(S5Y[t * 256 + g * 16 + c]) + y[r];
                        *up = f2bf(0.5f * yy * (1.f + tanhf(0.7978845608028654f * (yy + 0.044715f * yy * yy * yy))));
                    }
                }
            }
        }
    }
}

DEV float row16_sum(float v) {
    v += __int_as_float(__builtin_amdgcn_mov_dpp(__float_as_int(v), 0x128, 0xf, 0xf, true));
    v += __int_as_float(__builtin_amdgcn_mov_dpp(__float_as_int(v), 0x124, 0xf, 0xf, true));
    v += __int_as_float(__builtin_amdgcn_mov_dpp(__float_as_int(v), 0x122, 0xf, 0xf, true));
    v += __int_as_float(__builtin_amdgcn_mov_dpp(__float_as_int(v), 0x121, 0xf, 0xf, true));
    return v;
}
DEV float fmul_(float a, float b) { return a * b; }
DEV float fadd_(float a, float b) { return a + b; }
DEV float ffma_(float a, float b, float c) { return __builtin_fmaf(a, b, c); }
DEV float fnma_(float a, float b, float c) { return __builtin_fmaf(-a, b, c); }
DEV float row8_sum(float v) {
    v += __int_as_float(__builtin_amdgcn_mov_dpp(__float_as_int(v), 0x141, 0xf, 0xf, true));
    v += __int_as_float(__builtin_amdgcn_mov_dpp(__float_as_int(v), 0xB1, 0xf, 0xf, true));
    v += __int_as_float(__builtin_amdgcn_mov_dpp(__float_as_int(v), 0x4E, 0xf, 0xf, true));
    return v;
}
DEV float row16_sum1(float v) { v += __int_as_float(__builtin_amdgcn_mov_dpp(__float_as_int(v), 0x128, 0xf, 0xf, true)); return v; }
constexpr int RW_CT = 16;
struct RwRaw { u32x2 r[3], k[3], v[3], sd, a; float fp, fn; };
#ifndef RWVAR
#define RWVAR 0
#endif
template <int var>
DEV void rw_item_t(const Params& p, int l, int item, char* smem, int rep) {
    const int tid = tidx(), li = tid >> 4, lc = tid & 15;
    const int ch = item >> 2, rg = item & 3, dir = ch >> 5, b = (ch >> 2) & 7, head = ch & 3;
    float* buf = (float*)smem;
    float* ybuf = buf + 2 * RW_CT * 384;
    const bf16_t* P = wsb(p, OFF_P);
    const bf16_t* RWX = wsb(p, OFF_RWX);
    bf16_t* RWY = wsb(p, OFF_RWY) + (size_t)dir * TT * 256 + (rep > 0 ? (size_t)2 * TT * 256 : 0);
    const int hc = head * 64 + lc * 4;
    const float4 mur = *(const float4*)(inp(p, I_RMU) + (l * 4 + 0) * 256 + hc);
    const float4 muk = *(const float4*)(inp(p, I_RMU) + (l * 4 + 1) * 256 + hc);
    const float4 muv = *(const float4*)(inp(p, I_RMU) + (l * 4 + 2) * 256 + hc);
    const float4 kk4 = *(const float4*)(inp(p, I_RKK) + l * 256 + hc);
    const float4 ka4 = *(const float4*)(inp(p, I_RKA) + l * 256 + hc);
    const int NCH = (CTXL + SEQ) / RW_CT;
    auto tok_of = [&](int cidx, int i, int& n, int& len) -> int {
        if (cidx < CTXL / RW_CT) { const int pos = cidx * RW_CT + i; len = CTXL; n = dir == 0 ? pos : CTXL - 1 - pos; return TL + b * CTXL + n; }
        const int pos = (cidx - CTXL / RW_CT) * RW_CT + i; len = SEQ; n = dir == 0 ? pos : SEQ - 1 - pos; return b * SEQ + n;
    };
    auto load_raw = [&](int cidx, RwRaw& raw) {
        int n, len; const int t = tok_of(cidx, li, n, len);
        const bf16_t* row = P + (size_t)t * LDP;
        const bool hp = n > 0, hn = n + 1 < len;
        const bf16_t* rp = hp ? row - LDP : row;
        const bf16_t* rn = hn ? row + LDP : row;
        raw.fp = hp ? 0.5f : 0.f; raw.fn = hn ? 0.5f : 0.f;
        raw.r[1] = *(const u32x2*)(row + C_RWR + hc); raw.k[1] = *(const u32x2*)(row + C_RWK + hc); raw.v[1] = *(const u32x2*)(row + C_RWV + hc);
        raw.r[0] = *(const u32x2*)(rp + C_RWR + hc); raw.k[0] = *(const u32x2*)(rp + C_RWK + hc); raw.v[0] = *(const u32x2*)(rp + C_RWV + hc);
        raw.r[2] = *(const u32x2*)(rn + C_RWR + hc); raw.k[2] = *(const u32x2*)(rn + C_RWK + hc); raw.v[2] = *(const u32x2*)(rn + C_RWV + hc);
        raw.sd = *(const u32x2*)(RWX + (size_t)t * 1024 + dir * 256 + hc);
        raw.a = *(const u32x2*)(RWX + (size_t)t * 1024 + 512 + dir * 256 + hc);
    };
    auto mix4 = [&](const u32x2 (&s)[3], const float4& mu, float fp, float fn, float (&o)[4]) {
        { const float x = bflo(s[1].x); o[0] = x + ((fp * bflo(s[0].x) + fn * bflo(s[2].x)) - x) * mu.x; }
        { const float x = bfhi(s[1].x); o[1] = x + ((fp * bfhi(s[0].x) + fn * bfhi(s[2].x)) - x) * mu.y; }
        { const float x = bflo(s[1].y); o[2] = x + ((fp * bflo(s[0].y) + fn * bflo(s[2].y)) - x) * mu.z; }
        { const float x = bfhi(s[1].y); o[3] = x + ((fp * bfhi(s[0].y) + fn * bfhi(s[2].y)) - x) * mu.w; }
    };
    auto stage = [&](int st, const RwRaw& raw) {
        float r4[4], k4[4], v4[4];
        mix4(raw.r, mur, raw.fp, raw.fn, r4); mix4(raw.k, muk, raw.fp, raw.fn, k4); mix4(raw.v, muv, raw.fp, raw.fn, v4);
        const float kkr[4] = { k4[0] * kk4.x, k4[1] * kk4.y, k4[2] * kk4.z, k4[3] * kk4.w };
        float nn = kkr[0] * kkr[0] + kkr[1] * kkr[1] + kkr[2] * kkr[2] + kkr[3] * kkr[3];
        nn = row16_sum(nn);
        const float rn = 1.f / fmaxf(sqrtf(nn), 1e-12f);
        const float a[4] = { bflo(raw.a.x), bfhi(raw.a.x), bflo(raw.a.y), bfhi(raw.a.y) };
        const float sd[4] = { bflo(raw.sd.x), bfhi(raw.sd.x), bflo(raw.sd.y), bfhi(raw.sd.y) };
        const float kav[4] = { ka4.x, ka4.y, ka4.z, ka4.w };
        float* d = buf + (st * RW_CT + li) * 384 + lc * 4;
        float wp[4], kp[4], bp[4], mp[4];
#pragma unroll
        for (int j = 0; j < 4; ++j) {
            wp[j] = __expf(-sd[j]);
            kp[j] = kkr[j] * rn;
            bp[j] = kp[j] * a[j];
            mp[j] = k4[j] * (1.f + (a[j] - 1.f) * kav[j]);
        }
        *(float4*)(d + 0) = make_float4(wp[0], wp[1], wp[2], wp[3]); *(float4*)(d + 64) = make_float4(kp[0], kp[1], kp[2], kp[3]);
        *(float4*)(d + 128) = make_float4(bp[0], bp[1], bp[2], bp[3]); *(float4*)(d + 192) = make_float4(mp[0], mp[1], mp[2], mp[3]);
        *(float4*)(d + 256) = make_float4(r4[0], r4[1], r4[2], r4[3]);
        *(float4*)(d + 320) = make_float4(v4[0], v4[1], v4[2], v4[3]);
    };
    f32x2_ Sa = (f32x2_){0.f, 0.f}, Sb = (f32x2_){0.f, 0.f};
    auto compute = [&](int cidx, int cur, const RwRaw& rs, bool do_stage) {
        float sr4[4], sk4[4], sv4[4], skkr[4], srn = 0.f;
        const float* cb = buf + cur * RW_CT * 384 + lc * 4;
        const float* vb = buf + cur * RW_CT * 384 + 320 + rg * 16 + li;
        const bool yb0 = (lc & 4) == 0, yb1 = (lc & 2) == 0, yb2 = (lc & 1) == 0, yb3 = (lc & 8) == 0;
        float yq0 = 0.f, yq1 = 0.f, yq2 = 0.f, yq3 = 0.f, ykeep = 0.f;
        f32x4 w[2], kk[2], bb[2], km[2], rr[2]; float vv[2];
        w[0] = *(const f32x4*)(cb); kk[0] = *(const f32x4*)(cb + 64); bb[0] = *(const f32x4*)(cb + 128); km[0] = *(const f32x4*)(cb + 192); rr[0] = *(const f32x4*)(cb + 256);
        vv[0] = vb[0];
#pragma unroll
        for (int j = 0; j < RW_CT; ++j) {
            const int c0 = j & 1, c2 = c0 ^ 1;
            if (j + 1 < RW_CT) {
                const float* nb = cb + (j + 1) * 384;
                w[c2] = *(const f32x4*)(nb); kk[c2] = *(const f32x4*)(nb + 64); bb[c2] = *(const f32x4*)(nb + 128); km[c2] = *(const f32x4*)(nb + 192); rr[c2] = *(const f32x4*)(nb + 256);
                vv[c2] = vb[(j + 1) * 384];
            }
            const f32x2_ v2 = (f32x2_){vv[c0], vv[c0]};
            const f32x2_ pa = __builtin_elementwise_fma(Sb, kk[c0].zw, Sa * kk[c0].xy);
            const f32x2_ ta = __builtin_elementwise_fma(Sa, w[c0].xy, v2 * km[c0].xy), tb = __builtin_elementwise_fma(Sb, w[c0].zw, v2 * km[c0].zw);
            const float sa = row16_sum(fadd_(pa.x, pa.y));
            const f32x2_ nsa = (f32x2_){-sa, -sa};
            Sa = __builtin_elementwise_fma(nsa, bb[c0].xy, ta); Sb = __builtin_elementwise_fma(nsa, bb[c0].zw, tb);
            const f32x2_ py = __builtin_elementwise_fma(Sb, rr[c0].zw, Sa * rr[c0].xy);
            {
                float c = fadd_(py.x, py.y);
                if (j & 1) {
                    { const float t = yb0 ? yq0 : c, u = yb0 ? c : yq0; c = t + __int_as_float(__builtin_amdgcn_mov_dpp(__float_as_int(u), 0x141, 0xf, 0xf, true)); }
                    if (j & 2) {
                        { const float t = yb1 ? yq1 : c, u = yb1 ? c : yq1; c = t + __int_as_float(__builtin_amdgcn_mov_dpp(__float_as_int(u), 0x4E, 0xf, 0xf, true)); }
                        if (j & 4) {
                            { const float t = yb2 ? yq2 : c, u = yb2 ? c : yq2; c = t + __int_as_float(__builtin_amdgcn_mov_dpp(__float_as_int(u), 0xB1, 0xf, 0xf, true)); }
                            if (j & 8) {
                                const float t = yb3 ? yq3 : c, u = yb3 ? c : yq3; ykeep = t + __int_as_float(__builtin_amdgcn_mov_dpp(__float_as_int(u), 0x128, 0xf, 0xf, true));
                            } else yq3 = c;
                        } else yq2 = c;
                    } else yq1 = c;
                } else yq0 = c;
            }
            if (j == 2) { mix4(rs.r, mur, rs.fp, rs.fn, sr4); }
            if (j == 5) { mix4(rs.k, muk, rs.fp, rs.fn, sk4); }
            if (j == 8) { mix4(rs.v, muv, rs.fp, rs.fn, sv4); }
            if (j == 11) {
                skkr[0] = sk4[0] * kk4.x; skkr[1] = sk4[1] * kk4.y; skkr[2] = sk4[2] * kk4.z; skkr[3] = sk4[3] * kk4.w;
                float nn = skkr[0] * skkr[0] + skkr[1] * skkr[1] + skkr[2] * skkr[2] + skkr[3] * skkr[3];
                nn = row16_sum(nn);
                srn = 1.f / fmaxf(sqrtf(nn), 1e-12f);
            }
        }
        if (do_stage) {
            const float a[4] = { bflo(rs.a.x), bfhi(rs.a.x), bflo(rs.a.y), bfhi(rs.a.y) };
            const float sd[4] = { bflo(rs.sd.x), bfhi(rs.sd.x), bflo(rs.sd.y), bfhi(rs.sd.y) };
            const float kav[4] = { ka4.x, ka4.y, ka4.z, ka4.w };
            float* d = buf + ((cur ^ 1) * RW_CT + li) * 384 + lc * 4;
            float wp[4], kp[4], bp[4], mp[4];
#pragma unroll
            for (int q = 0; q < 4; ++q) {
                wp[q] = __expf(-sd[q]);
                kp[q] = skkr[q] * srn;
                bp[q] = kp[q] * a[q];
                mp[q] = sk4[q] * (1.f + (a[q] - 1.f) * kav[q]);
            }
            *(float4*)(d + 0) = make_float4(wp[0], wp[1], wp[2], wp[3]); *(float4*)(d + 64) = make_float4(kp[0], kp[1], kp[2], kp[3]);
            *(float4*)(d + 128) = make_float4(bp[0], bp[1], bp[2], bp[3]); *(float4*)(d + 192) = make_float4(mp[0], mp[1], mp[2], mp[3]);
            *(float4*)(d + 256) = make_float4(sr4[0], sr4[1], sr4[2], sr4[3]);
            *(float4*)(d + 320) = make_float4(sv4[0], sv4[1], sv4[2], sv4[3]);
        }
        {
            const int ys = ((lc >> 2) & 1) | (lc & 2) | ((lc & 1) << 2) | (lc & 8);
            int n, len; const int t = tok_of(cidx, ys, n, len);
            RWY[(size_t)t * 256 + head * 64 + rg * 16 + li] = f2bf(ykeep);
        }
    };
    RwRaw rawA, rawB;
    __syncthreads();
    load_raw(0, rawA);
    stage(0, rawA);
    load_raw(1, rawA);
    __syncthreads();
    for (int cidx = 0; cidx < NCH; cidx += 2) {
        load_raw(min(cidx + 2, NCH - 1), rawB);
        compute(cidx, 0, rawA, true);
        __syncthreads();
        load_raw(min(cidx + 3, NCH - 1), rawA);
        compute(cidx + 1, 1, rawB, cidx + 2 < NCH);
        __syncthreads();
    }
}

DEV void rw_item(const Params& p, int l, int item, char* smem, int rep = 0) {
    rw_item_t<RWVAR>(p, l, item, smem, rep);
}
constexpr int RC = 32, SK = 72, ST = 40;
constexpr int L_K1 = 0, L_R1 = L_K1 + RC * SK, L_B1 = L_R1 + RC * SK, L_M1 = L_B1 + RC * SK,
              L_VT = L_M1 + RC * SK, L_B2T = L_VT + 64 * ST, L_M2T = L_B2T + 64 * ST,
              L_X = L_M2T + 64 * ST, L_XT = L_X + RC * ST, L_PA = L_XT + RC * ST, L_BM = L_PA + RC * ST, L_AR = L_BM + RC * ST, L_BR = L_AR + RC * ST,
              L_ET = L_BR + RC * ST, L_ZT = L_ET + 64 * ST, L_S = L_ZT + 64 * ST, L_RWEND = L_S + 64 * SK;
static_assert(L_RWEND * 2 + 256 <= 73728, "RWKV chunk LDS");
DEV bf16x8 ldfrag(const bf16_t* m, int stride, int row0, int k0, int lane) { return *(const bf16x8*)(m + (row0 + (lane & 15)) * stride + k0 + (lane >> 4) * 8); }
DEV f32x4 mfma16(bf16x8 a, bf16x8 b, f32x4 c) { return __builtin_amdgcn_mfma_f32_16x16x32_bf16(a, b, c, 0, 0, 0); }
#ifndef RWC_CLAMP
#define RWC_CLAMP 0
#endif
DEV void st4(bf16_t* dst, f32x4 v) {
    if (RWC_CLAMP) { for (int i = 0; i < 4; ++i) v[i] = fminf(fmaxf(v[i], -8.f), 8.f); } u32x2 o; o.x = pack2(v[0], v[1]); o.y = pack2(v[2], v[3]); *(u32x2*)dst = o; }
DEV void unpack8(const u32x4 u, float (&o)[8]) {
    o[0] = bflo(u[0]); o[1] = bfhi(u[0]); o[2] = bflo(u[1]); o[3] = bfhi(u[1]); o[4] = bflo(u[2]); o[5] = bfhi(u[2]); o[6] = bflo(u[3]); o[7] = bfhi(u[3]);
}
DEV u32x4 pack8(const float (&v)[8]) { return (u32x4){pack2(v[0], v[1]), pack2(v[2], v[3]), pack2(v[4], v[5]), pack2(v[6], v[7])}; }
struct RwcRaw { u32x4 r[3], k[3], v[3], sd, a; float fp, fn; };
#ifndef RWC_STOP
#define RWC_STOP 99
#endif
#ifndef RWC_DUMMY
#define RWC_DUMMY 0
#endif
#ifdef RWC_NOINLINE
__device__ __attribute__((noinline)) void rwc_item(const Params& p, int l, int chain, char* smem) {
#else
DEV void rwc_item(const Params& p, int l, int chain, char* smem) {
#endif
    const int tid = tidx(), lane = tid & 63, wave = __builtin_amdgcn_readfirstlane(tid >> 6), c16 = lane & 15, q4 = lane >> 4;
    const int dir = chain >> 5, b = (chain >> 2) & 7, head = chain & 3;
    bf16_t* L = (bf16_t*)smem;
    float* PC = (float*)(smem + L_RWEND * 2);
    float* CS = (float*)(L + L_ET);
    const bf16_t* P = wsb(p, OFF_P);
    const bf16_t* RWX = wsb(p, OFF_RWX);
    bf16_t* RWY = wsb(p, OFF_RWY) + (size_t)dir * TT * 256 + (RWC_DUMMY ? (size_t)2 * TT * 256 : 0);
    const int li = tid >> 3, c8 = (tid & 7) * 8, hc = head * 64 + c8;
    const int NCHK = (CTXL + SEQ) / RC;
    auto tok_of = [&](int c, int i, int& n, int& len) -> int {
        if (c < CTXL / RC) { const int pos = c * RC + i; len = CTXL; n = dir == 0 ? pos : CTXL - 1 - pos; return TL + b * CTXL + n; }
        const int pos = (c - CTXL / RC) * RC + i; len = SEQ; n = dir == 0 ? pos : SEQ - 1 - pos; return b * SEQ + n;
    };
    RwcRaw raw;
    auto load_raw = [&](int c) {
        int n, len; const int t = tok_of(c, li, n, len);
        const bf16_t* row = P + (size_t)t * LDP;
        const bool hp = n > 0, hn = n + 1 < len;
        const bf16_t* rp = hp ? row - LDP : row;
        const bf16_t* rn = hn ? row + LDP : row;
        raw.fp = hp ? 0.5f : 0.f; raw.fn = hn ? 0.5f : 0.f;
        raw.r[1] = *(const u32x4*)(row + C_RWR + hc); raw.k[1] = *(const u32x4*)(row + C_RWK + hc); raw.v[1] = *(const u32x4*)(row + C_RWV + hc);
        raw.r[0] = *(const u32x4*)(rp + C_RWR + hc); raw.k[0] = *(const u32x4*)(rp + C_RWK + hc); raw.v[0] = *(const u32x4*)(rp + C_RWV + hc);
        raw.r[2] = *(const u32x4*)(rn + C_RWR + hc); raw.k[2] = *(const u32x4*)(rn + C_RWK + hc); raw.v[2] = *(const u32x4*)(rn + C_RWV + hc);
        raw.sd = *(const u32x4*)(RWX + (size_t)t * 1024 + dir * 256 + hc);
        raw.a = *(const u32x4*)(RWX + (size_t)t * 1024 + 512 + dir * 256 + hc);
    };
    auto mix8 = [&](const u32x4 (&s)[3], const float* mu, float (&o)[8]) {
        float x[8], pv[8], nx[8]; unpack8(s[1], x); unpack8(s[0], pv); unpack8(s[2], nx);
        const float4 m0 = *(const float4*)mu, m1 = *(const float4*)(mu + 4);
        const float m[8] = { m0.x, m0.y, m0.z, m0.w, m1.x, m1.y, m1.z, m1.w };
#pragma unroll
        for (int j = 0; j < 8; ++j) o[j] = x[j] + ((raw.fp * pv[j] + raw.fn * nx[j]) - x[j]) * m[j];
    };
    f32x4 Wt[4];
#pragma unroll
    for (int j = 0; j < 4; ++j) Wt[j] = (f32x4){0.f, 0.f, 0.f, 0.f};
    __syncthreads();
    for (int i = tid; i < 64 * SK / 2; i += NT) ((unsigned*)(L + L_S))[i] = 0u;
    load_raw(0);
    for (int c = 0; c < (RWC_STOP == 0 ? 0 : NCHK); ++c) {
        {
            float r8[8], k8[8], v8[8], a8[8], sd8[8];
            mix8(raw.r, inp(p, I_RMU) + (l * 4 + 0) * 256 + hc, r8);
            mix8(raw.k, inp(p, I_RMU) + (l * 4 + 1) * 256 + hc, k8);
            mix8(raw.v, inp(p, I_RMU) + (l * 4 + 2) * 256 + hc, v8);
            unpack8(raw.a, a8); unpack8(raw.sd, sd8);
            if (c + 1 < NCHK) load_raw(c + 1);
            const float4 kk0 = *(const float4*)(inp(p, I_RKK) + l * 256 + hc), kk1 = *(const float4*)(inp(p, I_RKK) + l * 256 + hc + 4);
            const float4 ka0 = *(const float4*)(inp(p, I_RKA) + l * 256 + hc), ka1 = *(const float4*)(inp(p, I_RKA) + l * 256 + hc + 4);
            const float kkc[8] = { kk0.x, kk0.y, kk0.z, kk0.w, kk1.x, kk1.y, kk1.z, kk1.w };
            const float kac[8] = { ka0.x, ka0.y, ka0.z, ka0.w, ka1.x, ka1.y, ka1.z, ka1.w };
            float kkv[8], bbv[8], kmv[8]; float n2 = 0.f;
#pragma unroll
            for (int j = 0; j < 8; ++j) { kkv[j] = k8[j] * kkc[j]; n2 += kkv[j] * kkv[j]; }
            n2 = row8_sum(n2);
            const float rn = 1.f / fmaxf(sqrtf(n2), 1e-12f);
#pragma unroll
            for (int j = 0; j < 8; ++j) { kkv[j] *= rn; bbv[j] = kkv[j] * a8[j]; kmv[j] = k8[j] * (1.f + (a8[j] - 1.f) * kac[j]); }
            *(float4*)(CS + li * 64 + c8) = make_float4(sd8[0], sd8[1], sd8[2], sd8[3]);
            *(float4*)(CS + li * 64 + c8 + 4) = make_float4(sd8[4], sd8[5], sd8[6], sd8[7]);
            __syncthreads();
            if (tid < 64) { float run = 0.f; for (int i = 0; i < RC; ++i) { run += CS[i * 64 + tid]; CS[i * 64 + tid] = run; } }
            __syncthreads();
            float cs[8], tot[8];
            { const float4 a0 = *(const float4*)(CS + li * 64 + c8), a1 = *(const float4*)(CS + li * 64 + c8 + 4);
              const float4 t0 = *(const float4*)(CS + (RC - 1) * 64 + c8), t1 = *(const float4*)(CS + (RC - 1) * 64 + c8 + 4);
              cs[0] = a0.x; cs[1] = a0.y; cs[2] = a0.z; cs[3] = a0.w; cs[4] = a1.x; cs[5] = a1.y; cs[6] = a1.z; cs[7] = a1.w;
              tot[0] = t0.x; tot[1] = t0.y; tot[2] = t0.z; tot[3] = t0.w; tot[4] = t1.x; tot[5] = t1.y; tot[6] = t1.z; tot[7] = t1.w; }
            float k1[8], r1[8], b1[8], m1[8], b2[8], m2[8];
#pragma unroll
            for (int j = 0; j < 8; ++j) {
                const float pinc = __expf(-cs[j]), pexc = __expf(sd8[j] - cs[j]), einv = __expf(cs[j]), ec = __expf(cs[j] - tot[j]);
                k1[j] = kkv[j] * pexc; r1[j] = r8[j] * pinc; b1[j] = bbv[j] * einv; m1[j] = kmv[j] * einv; b2[j] = bbv[j] * ec; m2[j] = kmv[j] * ec;
            }
            __syncthreads();
            *(u32x4*)(L + L_K1 + li * SK + c8) = pack8(k1); *(u32x4*)(L + L_R1 + li * SK + c8) = pack8(r1);
            *(u32x4*)(L + L_B1 + li * SK + c8) = pack8(b1); *(u32x4*)(L + L_M1 + li * SK + c8) = pack8(m1);
#pragma unroll
            for (int j = 0; j < 8; ++j) {
                L[L_VT + (c8 + j) * ST + li] = f2bf(v8[j]); L[L_B2T + (c8 + j) * ST + li] = f2bf(b2[j]); L[L_M2T + (c8 + j) * ST + li] = f2bf(m2[j]);
            }
            if (li == RC - 1) {
#pragma unroll
                for (int j = 0; j < 8; ++j) PC[c8 + j] = __expf(-tot[j]);
            }
            __syncthreads();
        }
        if (RWC_STOP <= 1) continue;
        {
            const int i0 = wave >> 1, j0 = wave & 1;
            const f32x4 z4 = (f32x4){0.f, 0.f, 0.f, 0.f};
            f32x4 aS = z4, aU = z4, bm = z4, ar = z4, br = z4;
#pragma unroll
            for (int kk2 = 0; kk2 < 2; ++kk2) {
                const bf16x8 k1i = ldfrag(L + L_K1, SK, i0 * 16, kk2 * 32, lane), k1j = ldfrag(L + L_K1, SK, j0 * 16, kk2 * 32, lane);
                const bf16x8 b1i = ldfrag(L + L_B1, SK, i0 * 16, kk2 * 32, lane), b1j = ldfrag(L + L_B1, SK, j0 * 16, kk2 * 32, lane);
                const bf16x8 m1i = ldfrag(L + L_M1, SK, i0 * 16, kk2 * 32, lane), r1j = ldfrag(L + L_R1, SK, j0 * 16, kk2 * 32, lane);
                aS = mfma16(b1i, k1j, aS);
                aU = mfma16(k1i, b1j, aU);
                bm = mfma16(m1i, k1j, bm);
                ar = mfma16(b1i, r1j, ar);
                br = mfma16(m1i, r1j, br);
            }
#ifdef RWC_WAIT
            __builtin_amdgcn_sched_barrier(0); __builtin_amdgcn_s_sleep(2); __builtin_amdgcn_sched_barrier(0);
#endif
            {
                const int t = j0 * 16 + c16, s0 = i0 * 16 + q4 * 4;
                f32x4 x, pa, o1, o2, o3;
#pragma unroll
                for (int r = 0; r < 4; ++r) {
                    const bool lt = s0 + r < t, le = s0 + r <= t;
                    x[r] = lt ? -aS[r] : 0.f; pa[r] = x[r] + ((s0 + r == t) ? 1.f : 0.f);
                    o1[r] = lt ? bm[r] : 0.f; o2[r] = le ? ar[r] : 0.f; o3[r] = le ? br[r] : 0.f;
                }
#ifdef RWC_GSTORE
                { bf16_t* gd = wsb(p, OFF_RWY) + (size_t)2 * TT * 256 + (size_t)(bidx() * 256 + tid) * 32;
                  st4(gd, x); st4(gd + 4, pa); st4(gd + 8, o1); st4(gd + 12, o2); st4(gd + 16, o3); }
#else
                st4(L + L_X + t * ST + s0, x); st4(L + L_PA + t * ST + s0, pa);
                st4(L + L_BM + t * ST + s0, o1); st4(L + L_AR + t * ST + s0, o2); st4(L + L_BR + t * ST + s0, o3);
#endif
            }
            {
                const int s = j0 * 16 + c16, t0 = i0 * 16 + q4 * 4;
                f32x4 o;
#pragma unroll
                for (int r = 0; r < 4; ++r) o[r] = (s < t0 + r) ? -aU[r] : 0.f;
#ifdef RWC_GSTORE
                st4(wsb(p, OFF_RWY) + (size_t)2 * TT * 256 + (size_t)(bidx() * 256 + tid) * 32 + 20, o);
#else
                st4(L + L_XT + s * ST + t0, o);
#endif
            }
            __syncthreads();
        }
        if (RWC_STOP <= 2) continue;
#pragma unroll 1
        for (int rd = 1; rd <= 5; ++rd) {
            const bool sq = rd <= 4, up = rd >= 2;
            const int i0 = wave >> 1, j0 = wave & 1;
            const bf16x8 xti = ldfrag(L + L_XT, ST, i0 * 16, 0, lane), xtj = ldfrag(L + L_XT, ST, j0 * 16, 0, lane);
            const bf16x8 xi = ldfrag(L + L_X, ST, i0 * 16, 0, lane), xj = ldfrag(L + L_X, ST, j0 * 16, 0, lane);
            const bf16x8 paj = ldfrag(L + L_PA, ST, j0 * 16, 0, lane);
            const u32x2 old = *(const u32x2*)(L + L_PA + (j0 * 16 + c16) * ST + i0 * 16 + q4 * 4);
            __syncthreads();
            const f32x4 z4 = (f32x4){0.f, 0.f, 0.f, 0.f};
            if (sq) {
                const f32x4 nx = mfma16(xti, xj, z4);
                const f32x4 nxt = mfma16(xi, xtj, z4);
                st4(L + L_X + (j0 * 16 + c16) * ST + i0 * 16 + q4 * 4, nx);
                st4(L + L_XT + (j0 * 16 + c16) * ST + i0 * 16 + q4 * 4, nxt);
            }
            if (up) {
                f32x4 acc = (f32x4){bflo(old.x), bfhi(old.x), bflo(old.y), bfhi(old.y)};
                acc = mfma16(xti, paj, acc);
                st4(L + L_PA + (j0 * 16 + c16) * ST + i0 * 16 + q4 * 4, acc);
            }
            __syncthreads();
        }
        if (RWC_STOP <= 3) continue;
        {
            const int vj = wave;
#pragma unroll
            for (int ti = 0; ti < 2; ++ti) {
                f32x4 acc = mfma16(ldfrag(L + L_BM, ST, ti * 16, 0, lane), ldfrag(L + L_VT, ST, vj * 16, 0, lane), (f32x4){0.f, 0.f, 0.f, 0.f});
#pragma unroll
                for (int kk2 = 0; kk2 < 2; ++kk2) acc = mfma16(ldfrag(L + L_K1, SK, ti * 16, kk2 * 32, lane), ldfrag(L + L_S, SK, vj * 16, kk2 * 32, lane), acc);
                st4(L + L_ET + (vj * 16 + c16) * ST + ti * 16 + q4 * 4, acc);
            }
            __syncthreads();
#pragma unroll
            for (int ti = 0; ti < 2; ++ti) {
                const f32x4 acc = mfma16(ldfrag(L + L_PA, ST, ti * 16, 0, lane), ldfrag(L + L_ET, ST, vj * 16, 0, lane), (f32x4){0.f, 0.f, 0.f, 0.f});
                st4(L + L_ZT + (vj * 16 + c16) * ST + ti * 16 + q4 * 4, -acc);
            }
            __syncthreads();
        }
        if (RWC_STOP <= 4) continue;
        {
            const int vi = wave;
#pragma unroll
            for (int tj = 0; tj < 2; ++tj) {
                f32x4 acc = (f32x4){0.f, 0.f, 0.f, 0.f};
#pragma unroll
                for (int kk2 = 0; kk2 < 2; ++kk2) acc = mfma16(ldfrag(L + L_S, SK, vi * 16, kk2 * 32, lane), ldfrag(L + L_R1, SK, tj * 16, kk2 * 32, lane), acc);
                acc = mfma16(ldfrag(L + L_ZT, ST, vi * 16, 0, lane), ldfrag(L + L_AR, ST, tj * 16, 0, lane), acc);
                acc = mfma16(ldfrag(L + L_VT, ST, vi * 16, 0, lane), ldfrag(L + L_BR, ST, tj * 16, 0, lane), acc);
                int n, len; const int t = tok_of(c, tj * 16 + c16, n, len);
                u32x2 o; o.x = pack2(acc[0], acc[1]); o.y = pack2(acc[2], acc[3]);
#ifndef RWC_NOYSTORE
                *(u32x2*)(RWY + (size_t)t * 256 + head * 64 + vi * 16 + q4 * 4) = o;
#else
                asm volatile("" :: "v"(o), "v"(t));
#endif
            }
            const float4 pc = *(const float4*)(PC + wave * 16 + q4 * 4);
            const bf16x8 fb2 = ldfrag(L + L_B2T, ST, wave * 16, 0, lane), fm2 = ldfrag(L + L_M2T, ST, wave * 16, 0, lane);
#pragma unroll
            for (int vj = 0; vj < 4; ++vj) {
                f32x4 acc = Wt[vj];
                acc[0] *= pc.x; acc[1] *= pc.y; acc[2] *= pc.z; acc[3] *= pc.w;
                acc = mfma16(fb2, ldfrag(L + L_ZT, ST, vj * 16, 0, lane), acc);
                acc = mfma16(fm2, ldfrag(L + L_VT, ST, vj * 16, 0, lane), acc);
                Wt[vj] = acc;
            }
            __syncthreads();
#pragma unroll
            for (int vj = 0; vj < 4; ++vj) st4(L + L_S + (vj * 16 + c16) * SK + wave * 16 + q4 * 4, Wt[vj]);
        }
    }
    __syncthreads();
#ifdef RWC_ZERO_LDS
    for (int i = tid; i < 73728 / 4; i += NT) ((unsigned*)smem)[i] = 0u;
    __syncthreads();
#endif
}
DEV void phase_s5_glu(const Params& p, int l, int M, char* smem) {
    const bf16_t* P = wsb(p, OFF_P);
    const bf16_t* w = wsb(p, OFF_WSM) + (size_t)l * WS_PER_LAYER + WS_GLUT;
    bf16_t* Y = wsb(p, OFF_Y);
    const float* bg = inp(p, I_S5BGLU) + l * 256;
    gemm_generic(P + C_S5, LDP, M, w, 256, 256, 256,
                 [&](int r, int c, float v) { const float z = bf2f(P[(size_t)r * LDP + C_S5 + c]); Y[(size_t)r * 1024 + 256 + c] = f2bf(z * sigmoidf_(v + bg[c])); }, smem, 0);
}
DEV void phase_rw_finish(const Params& p, int l, int M) {
    const int lane = tidx() & 63, wave = tidx() >> 6;
    const bf16_t* P = wsb(p, OFF_P);
    const bf16_t* RWX = wsb(p, OFF_RWX);
    const bf16_t* RWY = wsb(p, OFF_RWY);
    bf16_t* Y = wsb(p, OFF_Y);
    const int c = lane * 4;
    const float4 mur = *(const float4*)(inp(p, I_RMU) + (l * 4 + 0) * 256 + c);
    const float4 muk = *(const float4*)(inp(p, I_RMU) + (l * 4 + 1) * 256 + c);
    const float4 muv = *(const float4*)(inp(p, I_RMU) + (l * 4 + 2) * 256 + c);
    const float4 ka4 = *(const float4*)(inp(p, I_RKA) + l * 256 + c);
    const float4 rk4 = *(const float4*)(inp(p, I_RRK) + l * 256 + c);
    const float4 lg4 = *(const float4*)(inp(p, I_RLNG) + l * 256 + c);
    const float4 lb4 = *(const float4*)(inp(p, I_RLNB) + l * 256 + c);
    const float mr_[4] = { mur.x, mur.y, mur.z, mur.w }, mk_[4] = { muk.x, muk.y, muk.z, muk.w }, mv_[4] = { muv.x, muv.y, muv.z, muv.w };
    const float ka_[4] = { ka4.x, ka4.y, ka4.z, ka4.w }, rk_[4] = { rk4.x, rk4.y, rk4.z, rk4.w }, lg_[4] = { lg4.x, lg4.y, lg4.z, lg4.w }, lb_[4] = { lb4.x, lb4.y, lb4.z, lb4.w };
    for (int t = bidx() * 4 + wave; t < M; t += gridDim.x * 4) {
        int base, n, len; tok_seq(t, base, n, len);
        const bf16_t* row = P + (size_t)t * LDP;
        const bool hp = n > 0, hn = n + 1 < len;
        const u32x2 z = (u32x2){0u, 0u};
        float r4[4], k4[4], v4[4];
        {
            const u32x2 cu = *(const u32x2*)(row + C_RWR + c), pv = hp ? *(const u32x2*)(row - LDP + C_RWR + c) : z, nx = hn ? *(const u32x2*)(row + LDP + C_RWR + c) : z;
            const float x[4] = { bflo(cu.x), bfhi(cu.x), bflo(cu.y), bfhi(cu.y) }, a[4] = { bflo(pv.x), bfhi(pv.x), bflo(pv.y), bfhi(pv.y) }, b[4] = { bflo(nx.x), bfhi(nx.x), bflo(nx.y), bfhi(nx.y) };
#pragma unroll
            for (int j = 0; j < 4; ++j) r4[j] = x[j] + (0.5f * (a[j] + b[j]) - x[j]) * mr_[j];
        }
        {
            const u32x2 cu = *(const u32x2*)(row + C_RWK + c), pv = hp ? *(const u32x2*)(row - LDP + C_RWK + c) : z, nx = hn ? *(const u32x2*)(row + LDP + C_RWK + c) : z;
            const float x[4] = { bflo(cu.x), bfhi(cu.x), bflo(cu.y), bfhi(cu.y) }, a[4] = { bflo(pv.x), bfhi(pv.x), bflo(pv.y), bfhi(pv.y) }, b[4] = { bflo(nx.x), bfhi(nx.x), bflo(nx.y), bfhi(nx.y) };
#pragma unroll
            for (int j = 0; j < 4; ++j) k4[j] = x[j] + (0.5f * (a[j] + b[j]) - x[j]) * mk_[j];
        }
        {
            const u32x2 cu = *(const u32x2*)(row + C_RWV + c), pv = hp ? *(const u32x2*)(row - LDP + C_RWV + c) : z, nx = hn ? *(const u32x2*)(row + LDP + C_RWV + c) : z;
            const float x[4] = { bflo(cu.x), bfhi(cu.x), bflo(cu.y), bfhi(cu.y) }, a[4] = { bflo(pv.x), bfhi(pv.x), bflo(pv.y), bfhi(pv.y) }, b[4] = { bflo(nx.x), bfhi(nx.x), bflo(nx.y), bfhi(nx.y) };
#pragma unroll
            for (int j = 0; j < 4; ++j) v4[j] = x[j] + (0.5f * (a[j] + b[j]) - x[j]) * mv_[j];
        }
        const u32x2 af = *(const u32x2*)(RWX + (size_t)t * 1024 + 512 + c), ab = *(const u32x2*)(RWX + (size_t)t * 1024 + 768 + c);
        const float a0[4] = { bflo(af.x), bfhi(af.x), bflo(af.y), bfhi(af.y) }, a1[4] = { bflo(ab.x), bfhi(ab.x), bflo(ab.y), bfhi(ab.y) };
        const u32x2 yf = *(const u32x2*)(RWY + (size_t)t * 256 + c), yb = *(const u32x2*)(RWY + (size_t)TT * 256 + (size_t)t * 256 + c);
        float y[4] = { bflo(yf.x) + bflo(yb.x), bfhi(yf.x) + bfhi(yb.x), bflo(yf.y) + bflo(yb.y), bfhi(yf.y) + bfhi(yb.y) };
        float s = y[0] + y[1] + y[2] + y[3];
        s = group_sum<16>(s);
        const float mean = s * (1.f / 64.f);
        float q = 0.f, bon = 0.f;
#pragma unroll
        for (int j = 0; j < 4; ++j) {
            const float dlt = y[j] - mean; q += dlt * dlt;
            const float kmsum = k4[j] * (2.f + (a0[j] + a1[j] - 2.f) * ka_[j]);
            bon += r4[j] * kmsum * rk_[j];
        }
        q = group_sum<16>(q); bon = group_sum<16>(bon);
        const float rstd = rsqrtf(q * (1.f / 64.f) + 64e-5f);
        const u32x2 gg = *(const u32x2*)(row + C_RWD + c);
        const float g[4] = { bflo(gg.x), bfhi(gg.x), bflo(gg.y), bfhi(gg.y) };
        float o[4];
#pragma unroll
        for (int j = 0; j < 4; ++j) o[j] = ((y[j] - mean) * rstd * lg_[j] + lb_[j] + bon * v4[j]) * g[j];
        u32x2 ov; ov.x = pack2(o[0], o[1]); ov.y = pack2(o[2], o[3]);
        *(u32x2*)(Y + (size_t)t * 1024 + 768 + c) = ov;
    }
}

DEV int queue_next(int* ctr, char* smem) {
    int* slot = (int*)(smem + MOE_MAP_OFF + 208);
    __syncthreads();
    if (tidx() == 0) *slot = atomicAdd(ctr, 1);
    __syncthreads();
    return __builtin_amdgcn_readfirstlane(*slot);
}
DEV void phase_mixers(const Params& p, int l, int rep, char* smem) {
    const bool need_ctx = (l == 0);
#ifndef RWMODE
#define RWMODE 2
#endif
    const int nrw = RWMODE == 0 ? 64 : (RWMODE == 1 ? 256 + 64 : 256), nda = need_ctx ? 576 : 512, ns5 = 32 * (need_ctx ? 9 : 8);
    const int total = nrw + 2 * nda + (rep == 0 ? ns5 : 0);
    int* ctr = (int*)(wsp(p) + OFF_CTR) + CTR_Q + l * 16 + rep * 4;
    for (;;) {
        const int item = queue_next(ctr, smem);
        if (item >= total) break;
#ifndef PROBE7
#define PROBE7 0
#endif
        if (rep > 0 && PROBE7 == 1 && item >= nrw) break;
        if (rep > 0 && PROBE7 == 2 && item < nrw) continue;
        if (rep > 0 && PROBE7 == 3 && (item < nrw || item >= nrw + nda)) continue;
#if RWMODE == 2
        if (item < nrw) rw_item(p, l, item, smem, 0);
#elif RWMODE == 0
        if (item < nrw) rwc_item(p, l, item, smem);
#else
        if (item < nrw) { if (item < 256) rw_item(p, l, item, smem, 0); else rwc_item(p, l, item - 256, smem); }
#endif
        else if (item < nrw + nda) da_item(p, l, item - nrw, smem);
        else if (item < nrw + 2 * nda) mla_item(p, l, item - nrw - nda, smem);
        else s5_pass2_item(p, l, need_ctx ? 0 : 1, item - nrw - 2 * nda, smem);
    }
}
#ifndef MEGA
#define MEGA 0
#endif
constexpr int NPHASE = 15;
template <int PH>
DEV void run_phase(const Params& p, int l, char* smem) {
    asm volatile("" : "+s"(l));
    const bool need_ctx = (l == 0);
    const int M = need_ctx ? TT : TL;
    if constexpr (PH == 0) { phase_mod_partial(p, smem); __syncthreads(); phase_conv_small(p, smem); phase_conv_layer(p, 0, smem); phase_conv_experts(p, 0, smem); }
    if constexpr (PH == 1) { phase_mod_reduce(p); }
    if constexpr (PH == 2) { phase_norm<1>(p, l, TT, smem, l == 1); if (l == 1) { phase_conv_layer(p, 1, smem); phase_conv_experts(p, 1, smem); } }
    if constexpr (PH == 3) { phase_inproj(p, l, smem); }
    if constexpr (PH == 4) { phase_prep1(p, l); phase_s5_pass1(p, l, smem); }
    if constexpr (PH == 5) { phase_prep_gemm1(p, l, smem); }
    if constexpr (PH == 6) { phase_prep_gemm2(p, l, smem); phase_prep2(p, l); }
    if constexpr (PH == 7) { phase_mixers(p, l, 0, smem); }
    if constexpr (PH == 8) { phase_s5_glu(p, l, M, smem); phase_rw_finish(p, l, M); }
    if constexpr (PH == 9) { phase_merge(p, l, M, smem); }
    if constexpr (PH == 10) { phase_outproj(p, l, M, smem); }
    if constexpr (PH == 11) { phase_norm<2>(p, l, M, smem); }
    if constexpr (PH == 14) { phase_route(p, l, M, smem); }
    if constexpr (PH == 15) { phase_combine(p, l, M); }
    if constexpr (PH == 12) { phase_moe1(p, l, smem); }
    if constexpr (PH == 13) { phase_moe2(p, l, smem); }
}

#if !MEGA
template <int PH>
__global__ void __launch_bounds__(NT, 2) k_phase(Params p, int l) {
    extern __shared__ __attribute__((aligned(16))) char smem[];
    run_phase<PH>(p, l, smem);
}
#endif
#ifndef REP0
#define REP0 1
#endif
#ifndef REP2
#define REP2 1
#endif
#ifndef REP3
#define REP3 1
#endif
#ifndef REP5
#define REP5 1
#endif
#ifndef REP6
#define REP6 1
#endif
#ifndef REP7
#define REP7 1
#endif
#ifndef REP8
#define REP8 1
#endif
#ifndef REP9
#define REP9 1
#endif
#ifndef REP12
#define REP12 1
#endif
#if MEGA
__global__ void __launch_bounds__(NT, 2) k_mega(Params p) {
    extern __shared__ __attribute__((aligned(16))) char smem[];
    uint4* xbw = (uint4*)(smem + MOE_MAP_OFF + 240);
    if (threadIdx.x == 0) *xbw = make_uint4(0u, 0u, 0u, 0u);
    __syncthreads();
    XcdBarrier bar = xcd_barrier_post((unsigned*)(p.ws + OFF_BAR), (volatile LAS unsigned*)xbw);
    for (int r = 0; r < REP0; ++r) { run_phase<0>(p, 0, smem); xcd_barrier(bar); }
    run_phase<1>(p, 0, smem); xcd_barrier(bar);
    for (int l = 0; l < 2; ++l) {
        for (int r = 0; r < REP2; ++r) { run_phase<2>(p, l, smem); xcd_barrier(bar); }
        for (int r = 0; r < REP3; ++r) { run_phase<3>(p, l, smem); xcd_barrier(bar); }

        run_phase<4>(p, l, smem); xcd_barrier(bar);
#ifdef PROBE_S5P1
        phase_s5_pass1(p, l, smem); xcd_barrier(bar);
#endif
#ifdef PROBE_BAR
        for (int r = 0; r < PROBE_BAR; ++r) xcd_barrier(bar);
#endif
        for (int r = 0; r < REP5; ++r) { run_phase<5>(p, l, smem); xcd_barrier(bar); }
        for (int r = 0; r < REP6; ++r) { run_phase<6>(p, l, smem); xcd_barrier(bar); }
#ifdef RWC_PRE
        if (bidx() < 64) rwc_item(p, l, bidx(), smem);
#endif
        for (int r = 0; r < REP7; ++r) { int l7 = l; asm volatile("" : "+s"(l7)); phase_mixers(p, l7, r, smem); xcd_barrier(bar); }
#ifdef RWC_SEP
        for (int item = bidx(); item < 64; item += gridDim.x) rwc_item(p, l, item, smem);
        xcd_barrier(bar);
#endif
        for (int r = 0; r < REP8; ++r) { run_phase<8>(p, l, smem); xcd_barrier(bar); }
        for (int r = 0; r < REP9; ++r) { run_phase<9>(p, l, smem); xcd_barrier(bar); }
        run_phase<10>(p, l, smem); xcd_barrier(bar);
#ifdef PROBE_OUT2
        if (l == 0) { run_phase<10>(p, l, smem); xcd_barrier(bar); }
#endif

        run_phase<11>(p, l, smem); xcd_barrier(bar);
        run_phase<14>(p, l, smem); xcd_barrier(bar);
        for (int r = 0; r < REP12; ++r) { run_phase<12>(p, l, smem); xcd_barrier(bar); }
        run_phase<13>(p, l, smem); xcd_barrier(bar);
#ifdef PROBE_MOE2B
        run_phase<13>(p, l, smem); xcd_barrier(bar);
#endif
        if (l == 1) run_phase<15>(p, l, smem);
    }
}
#endif
__global__ void __launch_bounds__(NT) k_fail(float* out, int n) {
    for (int i = blockIdx.x * NT + threadIdx.x; i < n; i += gridDim.x * NT) out[i] = __int_as_float(0x7fc00000);
}

template <int PH>
static void launch_phase(const Params& p, int l, int grid, hipStream_t stream) {
#if !MEGA
    static bool attr = false;
    if (!attr) { (void)hipFuncSetAttribute((const void*)k_phase<PH>, hipFuncAttributeMaxDynamicSharedMemorySize, SMEM_BYTES); attr = true; }
    hipLaunchKernelGGL(k_phase<PH>, dim3(grid), dim3(NT), SMEM_BYTES, stream, p, l);
#endif
}

extern "C" void kernel_launch(void* const* d_in, const int* in_sizes, int n_in, void* d_out, int out_size, void* d_ws, size_t ws_size, hipStream_t stream) {
    if (n_in != 48 || out_size != TL * DM || ws_size < WS_END) {
        hipLaunchKernelGGL(k_fail, dim3(256), dim3(NT), 0, stream, (float*)d_out, out_size);
        return;
    }
    Params p{};
    for (int i = 0; i < 48; ++i) p.in[i] = (const float*)d_in[i];
    p.out = (float*)d_out; p.ws = (char*)d_ws;
    (void)hipMemsetAsync(d_ws, 0, ZERO_BYTES, stream);
#if MEGA
    static int grid = 0;
    if (grid == 0) {
        int dev = 0, cus = 0, per_cu = 0;
        (void)hipGetDevice(&dev);
        (void)hipDeviceGetAttribute(&cus, hipDeviceAttributeMultiprocessorCount, dev);
        (void)hipFuncSetAttribute((const void*)k_mega, hipFuncAttributeMaxDynamicSharedMemorySize, SMEM_BYTES);
        if (hipOccupancyMaxActiveBlocksPerMultiprocessor(&per_cu, (const void*)k_mega, NT, SMEM_BYTES) != hipSuccess || per_cu < 1) per_cu = 1;
        (void)hipGetLastError();
        if (cus <= 0) cus = 256;
        grid = cus * (per_cu < 2 ? per_cu : 2);
    }
    hipLaunchKernelGGL(k_mega, dim3(grid), dim3(NT), SMEM_BYTES, stream, p);
#else
    const int grid = 512;
    launch_phase<0>(p, 0, grid, stream);
    launch_phase<1>(p, 0, grid, stream);
    for (int l = 0; l < 2; ++l) {
        launch_phase<2>(p, l, grid, stream);
        launch_phase<3>(p, l, grid, stream);
        launch_phase<4>(p, l, grid, stream);
        launch_phase<5>(p, l, grid, stream);
        launch_phase<6>(p, l, grid, stream);
        launch_phase<7>(p, l, grid, stream);
        launch_phase<8>(p, l, grid, stream);
        launch_phase<9>(p, l, grid, stream);
        launch_phase<10>(p, l, grid, stream);
        launch_phase<11>(p, l, grid, stream);
        launch_phase<14>(p, l, grid, stream);
        launch_phase<12>(p, l, grid, stream);
        launch_phase<13>(p, l, grid, stream);
        launch_phase<15>(p, l, grid, stream);
    }
#endif
}
```

```cpp
#define MEGA 1
#include <hip/hip_runtime.h>
#include <stdint.h>
#include <math.h>

#define DEV __device__ __forceinline__
#define LAS __attribute__((address_space(3)))
typedef unsigned short bf16_t;
typedef short bf16x8 __attribute__((ext_vector_type(8)));
typedef float f32x16 __attribute__((ext_vector_type(16)));
typedef float f32x4 __attribute__((ext_vector_type(4)));
typedef unsigned u32x4 __attribute__((ext_vector_type(4)));
typedef unsigned u32x2 __attribute__((ext_vector_type(2)));

constexpr int NT = 256;
constexpr int DM = 1024, NB = 8, SEQ = 2048, CTXL = 256, GRIDW = 64;
constexpr int TL = NB * SEQ, TC = NB * CTXL, TT = TL + TC;
constexpr int NIN = 6480, LDP = 2432, NINP = 6528, NGATE0 = 2432;
constexpr int C_DAQ = 0, C_DAK = 256, C_DAV = 512, C_S5 = 768, C_CQ = 1024, C_CKV = 1216, C_KR = 1344,
              C_RWR = 1360, C_RWK = 1616, C_RWV = 1872, C_RWD = 2128, C_PEND = 2384;
constexpr int NEXP = 16, DFF = 512;
constexpr float EPS = 1e-6f;
constexpr float LOG2E = 1.4426950408889634f;

constexpr size_t al256(size_t x) { return (x + 255) & ~(size_t)255; }
constexpr size_t OFF_BAR  = 0;
constexpr size_t OFF_CTR  = 16384;
constexpr size_t ZERO_BYTES = 20480;
constexpr size_t OFF_MOD  = 32768;
constexpr size_t SZ_MOD   = (size_t)2 * 9 * 6144 * 4;
constexpr int    MOD_KS   = 8;
constexpr size_t OFF_MODP = al256(OFF_MOD + SZ_MOD);
constexpr size_t OFF_S5ST = al256(OFF_MODP + MOD_KS * SZ_MOD);
constexpr size_t OFF_LTOK = al256(OFF_S5ST + (size_t)2 * 8 * 16 * 8 * 64 * 2 * 4);
constexpr size_t OFF_LW   = al256(OFF_LTOK + (size_t)NEXP * TT * 4);
constexpr size_t OFF_TOKI = al256(OFF_LW + (size_t)NEXP * TT * 4);
constexpr size_t OFF_TOKW = al256(OFF_TOKI + (size_t)TT * 16);
constexpr size_t OFF_CNTB = al256(OFF_TOKW + (size_t)TT * 8);
constexpr size_t OFF_WSM  = al256(OFF_CNTB + (size_t)1024 * 16 * 4);
constexpr int WS_GLUT = 0, WS_UQT = WS_GLUT + 256 * 256, WS_UKVT = WS_UQT + 192 * 192, WS_W1C = WS_UKVT + 384 * 128,
              WS_W2 = WS_W1C + 192 * 256, WS_G2T = WS_W2 + 4 * 256 * 64, WS_PER_LAYER = WS_G2T + 256 * 64;
constexpr size_t OFF_WIN  = al256(OFF_WSM + (size_t)2 * WS_PER_LAYER * 2);
constexpr size_t OFF_WBR  = al256(OFF_WIN + (size_t)NINP * 1024 * 2);
constexpr size_t OFF_WOUT = al256(OFF_WBR + (size_t)4 * 1024 * 256 * 2);
constexpr size_t OFF_WG1  = al256(OFF_WOUT + (size_t)1024 * 1024 * 2);
constexpr size_t OFF_WDN  = al256(OFF_WG1 + (size_t)NEXP * 1024 * 1024 * 2);
constexpr size_t OFF_H    = al256(OFF_WDN + (size_t)NEXP * 1024 * 512 * 2);
constexpr size_t OFF_P    = al256(OFF_H + (size_t)TT * 1024 * 2);
constexpr size_t OFF_GATE = al256(OFF_P + (size_t)TT * LDP * 2);
constexpr size_t OFF_MLAQ = al256(OFF_GATE + (size_t)TT * 4096);
constexpr size_t OFF_MLAK = al256(OFF_MLAQ + (size_t)TT * 192 * 2);
constexpr size_t OFF_MLAV = al256(OFF_MLAK + (size_t)TT * 192 * 2);
constexpr size_t OFF_RWX  = al256(OFF_MLAV + (size_t)TT * 256 * 2);
constexpr size_t OFF_Y    = al256(OFF_RWX + (size_t)TT * 1024 * 2);
constexpr size_t OFF_CX   = al256(OFF_Y + (size_t)TT * 1024 * 2);
constexpr size_t OFF_S5Y  = al256(OFF_CX + (size_t)TC * 1024 * 4);
constexpr size_t WS_END   = al256(OFF_S5Y + (size_t)TT * 256 * 2);
constexpr size_t OFF_QRAW = OFF_Y;
constexpr size_t OFF_KVRAW = OFF_QRAW + (size_t)TT * 192 * 2;
constexpr size_t OFF_LR   = OFF_KVRAW + (size_t)TT * 384 * 2;
constexpr size_t OFF_XL   = OFF_LR + (size_t)TT * 192 * 2;
constexpr size_t OFF_Z    = OFF_GATE;
static_assert(OFF_XL + (size_t)TT * 256 * 2 <= OFF_Y + (size_t)TT * 1024 * 2, "temps overflow Y");
constexpr size_t OFF_RWY  = OFF_H;

constexpr int CTR_MOE = 0;
constexpr int CTR_Q   = 64;

constexpr int SMEM_BYTES = 73728 + 256;

struct Params {
    const float* in[48];
    float* out;
    char* ws;
};
enum { I_X = 0, I_C, I_CTX, I_CCTX, I_WADA, I_BADA, I_NMG, I_NFG, I_WIN, I_DAQKG, I_DALAM, I_DASUB,
       I_S5LRE, I_S5LIM, I_S5LDT, I_S5BRE, I_S5BIM, I_S5CRE, I_S5CIM, I_S5D, I_S5WGLU, I_S5BGLU,
       I_MCQG, I_MCKVG, I_MWUQ, I_MWUKV, I_MQKG,
       I_RMU, I_RW0, I_RW1, I_RW2, I_RA0, I_RA1, I_RA2, I_RG1, I_RG2, I_RKK, I_RKA, I_RRK, I_RLNG, I_RLNB,
       I_WBR, I_WOUT, I_ROUTW, I_ROUTB, I_EWG, I_EWU, I_EWD };

DEV int tidx() { int t = threadIdx.x; asm volatile("" : "+v"(t)); return t; }
DEV int bidx() { int b = blockIdx.x; asm volatile("" : "+s"(b)); return b; }
typedef float f32x2_ __attribute__((ext_vector_type(2)));
typedef __bf16 bf16x2_ __attribute__((ext_vector_type(2)));
DEV unsigned cvt_pk_bf16(float lo, float hi) { const f32x2_ v = {lo, hi}; const bf16x2_ b = __builtin_convertvector(v, bf16x2_); return __builtin_bit_cast(unsigned, b); }
DEV bf16_t f2bf(float f) { return (bf16_t)(cvt_pk_bf16(f, 0.f) & 0xFFFFu); }
DEV float bf2f(bf16_t h) { return __uint_as_float(((unsigned)h) << 16); }
DEV unsigned pack2(float lo, float hi) { return cvt_pk_bf16(lo, hi); }
DEV float bflo(unsigned u) { return __uint_as_float(u << 16); }
DEV float bfhi(unsigned u) { return __uint_as_float(u & 0xFFFF0000u); }
DEV float sigmoidf_(float x) { return 1.f / (1.f + __expf(-x)); }
DEV float wave_sum(float v) {
#pragma unroll
    for (int o = 32; o >= 1; o >>= 1) v += __shfl_xor(v, o, 64);
    return v;
}
template <int W> DEV float group_sum(float v) {
#pragma unroll
    for (int o = W / 2; o >= 1; o >>= 1) v += __shfl_xor(v, o, 64);
    return v;
}
DEV int mod_row(int t) { return t < TL ? (t >> 11) : 8; }
typedef const float* cfp_t;
DEV cfp_t inp(const Params&, int i) {
    const __attribute__((address_space(4))) cfp_t* ka = (const __attribute__((address_space(4))) cfp_t*)__builtin_amdgcn_kernarg_segment_ptr();
    asm volatile("" : "+s"(ka));
    return ka[i];
}
DEV char* wsp(const Params&) {
    char* const __attribute__((address_space(4)))* ka = (char* const __attribute__((address_space(4)))*)__builtin_amdgcn_kernarg_segment_ptr();
    asm volatile("" : "+s"(ka));
    return ka[49];
}
DEV bf16_t* wsb(const Params& p, size_t off) { return (bf16_t*)(wsp(p) + off); }
DEV float* wsf(const Params& p, size_t off) { return (float*)(wsp(p) + off); }
DEV const float* modp(const Params& p, int l, int row, int which) { return (const float*)(wsp(p) + OFF_MOD) + ((size_t)(l * 9 + row) * 6 + which) * 1024; }
#define XB_TMO      128
#define XB_XCNT(j)  (256  + 64 * (j))
#define XB_XSUB(j)  (1280 + 64 * (j))
#define XB_XGEN(j)  (2304 + 64 * (j))
#define XB_TOP      3328
#define XB_TOPGEN   3392
#define XCD_BAR_WORDS 3456
#define XB_SPIN_CAP (1u << 18)

__device__ __forceinline__ unsigned xb_ld(unsigned* p)              { return __hip_atomic_load(p, __ATOMIC_RELAXED, __HIP_MEMORY_SCOPE_AGENT); }
__device__ __forceinline__ unsigned xb_add(unsigned* p, unsigned v) { return __hip_atomic_fetch_add(p, v, __ATOMIC_RELAXED, __HIP_MEMORY_SCOPE_AGENT); }
__device__ __forceinline__ unsigned xb_xcc_id() { return (unsigned)__builtin_amdgcn_s_getreg((3 << 11) | 20) & 0xFu; }
#define XB_SPIN(cond, bar) do { unsigned _sp = 0; while (cond) { __builtin_amdgcn_s_sleep(1); \
    if ((++_sp & 255u) == 0u) { if (xb_ld(&(bar)[XB_TMO])) break; if (_sp > XB_SPIN_CAP) { atomicAdd(&(bar)[XB_TMO], 1u); break; } } } } while (0)

struct XcdBarrier {
    unsigned* bar; unsigned x;
    volatile LAS unsigned* st;
};

__device__ __forceinline__ XcdBarrier xcd_barrier_post(unsigned* bar, volatile LAS unsigned* st) {
    XcdBarrier b; b.bar = bar; b.x = xb_xcc_id(); b.st = st;
    if (threadIdx.x == 0) (void)xb_add(&bar[XB_XCNT(b.x)], 1u);
    return b;
}
__device__ __forceinline__ void xcd_barrier_complete(unsigned* bar, unsigned x, unsigned& nloc, unsigned& nx) {
    const unsigned G = gridDim.x * gridDim.y * gridDim.z;
    unsigned sum, cnt, mine, sp = 0u;
    for (;;) {
        sum = 0u; cnt = 0u; mine = 0u;
#pragma unroll
        for (unsigned j = 0; j < 16; ++j) { const unsigned c = xb_ld(&bar[XB_XCNT(j)]); sum += c; cnt += (c > 0u) ? 1u : 0u; mine = (j == x) ? c : mine; }
        if (sum == G) break;
        __builtin_amdgcn_s_sleep(1);
        if ((++sp & 255u) == 0u) { if (xb_ld(&bar[XB_TMO])) break; if (sp > XB_SPIN_CAP) { atomicAdd(&bar[XB_TMO], 1u); break; } }
    }
    nloc = mine > 0u ? mine : 1u; nx = cnt > 0u ? cnt : 1u;
}

__device__ __forceinline__ void xcd_barrier(const XcdBarrier& b) {
    asm volatile("s_waitcnt vmcnt(0)" ::: "memory");
    __syncthreads();
    if (threadIdx.x == 0) {
        unsigned* bar = b.bar;
        __builtin_amdgcn_s_waitcnt(0);
        unsigned nloc = b.st[0], nx = b.st[1];
        if (nloc == 0u) { xcd_barrier_complete(bar, b.x, nloc, nx); b.st[0] = nloc; b.st[1] = nx; }
        const unsigned old = xb_add(&bar[XB_XSUB(b.x)], 1u);
        const unsigned gen = old / nloc;
        if (old + 1u == (gen + 1u) * nloc) {
            __builtin_amdgcn_fence(__ATOMIC_RELEASE, "agent");
            asm volatile("s_waitcnt vmcnt(0)" ::: "memory");
            const unsigned og = xb_add(&bar[XB_TOP], 1u);
            const unsigned tg = og / nx;
            if (og + 1u == (tg + 1u) * nx) xb_add(&bar[XB_TOPGEN], 1u);
            else XB_SPIN(xb_ld(&bar[XB_TOPGEN]) == tg, bar);
            __builtin_amdgcn_fence(__ATOMIC_ACQUIRE, "agent");
            xb_add(&bar[XB_XGEN(b.x)], 1u);
            asm volatile("s_waitcnt vmcnt(0)" ::: "memory");
        } else {
            XB_SPIN(xb_ld(&bar[XB_XGEN(b.x)]) == gen, bar);
            __builtin_amdgcn_fence(__ATOMIC_ACQUIRE, "agent");
            asm volatile("s_waitcnt vmcnt(0)" ::: "memory");
        }
    }
    __syncthreads();
}

DEV void phase_mod_partial(const Params& p, char* smem) {
    float* sm = (float*)smem;
    const int tid = tidx();
    const int nitems = 2 * 24 * MOD_KS;
    for (int item = bidx(); item < nitems; item += gridDim.x) {
        const int l = item / (24 * MOD_KS), rem = item % (24 * MOD_KS), jc = rem / MOD_KS, ks = rem % MOD_KS;
        __syncthreads();
        for (int i = tid; i < 9 * 128; i += NT) {
            const int r = i >> 7, k = ks * 128 + (i & 127);
            const float cv = r < 8 ? inp(p, I_C)[r * 1024 + k] : inp(p, I_CCTX)[k];
            sm[i] = cv / (1.f + __expf(-cv));
        }
        __syncthreads();
        const int j = jc * 256 + tid;
        float acc[9];
#pragma unroll
        for (int r = 0; r < 9; ++r) acc[r] = 0.f;
        const float* w = inp(p, I_WADA) + (size_t)l * 1024 * 6144 + (size_t)(ks * 128) * 6144 + j;
#pragma unroll 8
        for (int k = 0; k < 128; ++k) {
            const float wv = w[(size_t)k * 6144];
#pragma unroll
            for (int r = 0; r < 9; ++r) acc[r] += sm[r * 128 + k] * wv;
        }
        float* dst = wsf(p, OFF_MODP);
#pragma unroll
        for (int r = 0; r < 9; ++r) dst[((size_t)(ks * 2 + l) * 9 + r) * 6144 + j] = acc[r];
    }
}
DEV void phase_mod_reduce(const Params& p) {
    const int n = 2 * 9 * 6144;
    float* mod = wsf(p, OFF_MOD);
    const float* part = wsf(p, OFF_MODP);
    for (int i = bidx() * NT + tidx(); i < n; i += gridDim.x * NT) {
        const int l = i / (9 * 6144), j = i % 6144;
        float s = inp(p, I_BADA)[l * 6144 + j];
#pragma unroll
        for (int ks = 0; ks < MOD_KS; ++ks) s += part[(size_t)ks * n + i];
        mod[i] = s;
    }
}

struct ConvRegs { float4 v[4]; };
DEV void conv_load(const float* src, int R, int C, int ld, int tr, int tc, ConvRegs& cr) {
    const int r0 = tr * 64, c0 = tc * 64, tid = tidx();
#pragma unroll
    for (int k = 0; k < 4; ++k) {
        const int i = tid + k * NT, r = i >> 4, c4 = (i & 15) * 4;
        float4 v = make_float4(0.f, 0.f, 0.f, 0.f);
        if (r0 + r < R) {
            const float* s = src + (size_t)(r0 + r) * ld + c0 + c4;
            if (c0 + c4 + 3 < C) v = *(const float4*)s;
            else { if (c0 + c4 < C) v.x = s[0]; if (c0 + c4 + 1 < C) v.y = s[1]; if (c0 + c4 + 2 < C) v.z = s[2]; }
        }
        cr.v[k] = v;
    }
}
template <int MODE>
DEV void conv_store(const ConvRegs& cr, int R, int C, bf16_t* dst, int ldd, int roff, int tr, int tc, float* sm) {
    const int r0 = tr * 64, c0 = tc * 64, tid = tidx();
    __syncthreads();
#pragma unroll
    for (int k = 0; k < 4; ++k) {
        const int i = tid + k * NT, r = i >> 4, c4 = (i & 15) * 4;
        float* d = sm + r * 65 + c4;
        d[0] = cr.v[k].x; d[1] = cr.v[k].y; d[2] = cr.v[k].z; d[3] = cr.v[k].w;
    }
    __syncthreads();
    for (int i = tid; i < 64 * 8; i += NT) {
        const int c = i >> 3, r8 = (i & 7) * 8;
        if (c0 + c < C && r0 + r8 < R) {
            const int cc = c0 + c;
            const int drow = (MODE == 0) ? (cc + roff) : ((cc >> 5) * 64 + (cc & 31) + roff);
            u32x4 o;
            o[0] = pack2(sm[(r8 + 0) * 65 + c], sm[(r8 + 1) * 65 + c]);
            o[1] = pack2(sm[(r8 + 2) * 65 + c], sm[(r8 + 3) * 65 + c]);
            o[2] = pack2(sm[(r8 + 4) * 65 + c], sm[(r8 + 5) * 65 + c]);
            o[3] = pack2(sm[(r8 + 6) * 65 + c], sm[(r8 + 7) * 65 + c]);
            *(u32x4*)(dst + (size_t)drow * ldd + r0 + r8) = o;
        }
    }
}
template <int MODE>
DEV void conv_job(const float* src, int R, int C, int ld, bf16_t* dst, int ldd, int roff, int& rot, float* sm) {
    const int ntr = (R + 63) >> 6, ntc = (C + 63) >> 6, nt = ntr * ntc, G = gridDim.x;
    const int first = (bidx() - (rot % G) + G) % G;
    ConvRegs cur;
    if (first < nt) conv_load(src, R, C, ld, first / ntc, first % ntc, cur);
    for (int t = first; t < nt; t += G) {
        ConvRegs nxt = cur;
        if (t + G < nt) conv_load(src, R, C, ld, (t + G) / ntc, (t + G) % ntc, nxt);
        conv_store<MODE>(cur, R, C, dst, ldd, roff, t / ntc, t % ntc, sm);
        cur = nxt;
    }
    rot += nt;
}
DEV void phase_conv_layer(const Params& p, int l, char* smem) {
    float* sm = (float*)smem;
    int rot = 0;
    const float* win = inp(p, I_WIN) + (size_t)l * 1024 * NIN;
    conv_job<0>(win, 1024, C_PEND, NIN, wsb(p, OFF_WIN), 1024, 0, rot, sm);
    conv_job<0>(win + C_PEND, 1024, 4096, NIN, wsb(p, OFF_WIN), 1024, NGATE0, rot, sm);
    {
        uint4* z = (uint4*)(wsb(p, OFF_WIN) + (size_t)C_PEND * 1024);
        const int n = (NGATE0 - C_PEND) * 1024 / 8;
        unsigned zz = 0u; asm volatile("" : "+v"(zz));
        for (int i = bidx() * NT + tidx(); i < n; i += gridDim.x * NT) z[i] = make_uint4(zz, zz, zz, zz);
    }
    for (int i = 0; i < 4; ++i)
        conv_job<0>(inp(p, I_WBR) + (size_t)(l * 4 + i) * 256 * 1024, 256, 1024, 1024, wsb(p, OFF_WBR) + (size_t)i * 1024 * 256, 256, 0, rot, sm);
    conv_job<0>(inp(p, I_WOUT) + (size_t)l * 1024 * 1024, 1024, 1024, 1024, wsb(p, OFF_WOUT), 1024, 0, rot, sm);
}
DEV void phase_conv_experts(const Params& p, int l, char* smem) {
    float* sm = (float*)smem;
    int rot = 0;
    for (int e = 0; e < NEXP; ++e) {
        conv_job<1>(inp(p, I_EWG) + (size_t)(l * NEXP + e) * 1024 * DFF, 1024, DFF, DFF, wsb(p, OFF_WG1) + (size_t)e * 1024 * 1024, 1024, 0, rot, sm);
        conv_job<1>(inp(p, I_EWU) + (size_t)(l * NEXP + e) * 1024 * DFF, 1024, DFF, DFF, wsb(p, OFF_WG1) + (size_t)e * 1024 * 1024, 1024, 32, rot, sm);
        conv_job<0>(inp(p, I_EWD) + (size_t)(l * NEXP + e) * DFF * 1024, DFF, 1024, 1024, wsb(p, OFF_WDN) + (size_t)e * 1024 * DFF, DFF, 0, rot, sm);
    }
}
DEV void phase_conv_small(const Params& p, char* smem) {
    float* sm = (float*)smem;
    int rot = 0;
    for (int l = 0; l < 2; ++l) {
        bf16_t* w = wsb(p, OFF_WSM) + (size_t)l * WS_PER_LAYER;
        for (int i = bidx() * NT + tidx(); i < 4 * 256 * 4; i += gridDim.x * NT)
            *(u32x4*)(w + WS_W2 + (size_t)(i >> 2) * 64 + 32 + (i & 3) * 8) = (u32x4){0u, 0u, 0u, 0u};
        conv_job<0>(inp(p, I_S5WGLU) + (size_t)l * 256 * 256, 256, 256, 256, w + WS_GLUT, 256, 0, rot, sm);
        conv_job<0>(inp(p, I_MWUQ) + (size_t)l * 192 * 192, 192, 192, 192, w + WS_UQT, 192, 0, rot, sm);
        conv_job<0>(inp(p, I_MWUKV) + (size_t)l * 128 * 384, 128, 384, 384, w + WS_UKVT, 128, 0, rot, sm);
        for (int d = 0; d < 2; ++d) {
            conv_job<0>(inp(p, I_RW1) + (size_t)(l * 2 + d) * 256 * 32, 256, 32, 32, w + WS_W1C, 256, d * 32, rot, sm);
            conv_job<0>(inp(p, I_RA1) + (size_t)(l * 2 + d) * 256 * 32, 256, 32, 32, w + WS_W1C, 256, 64 + d * 32, rot, sm);
            conv_job<0>(inp(p, I_RW2) + (size_t)(l * 2 + d) * 32 * 256, 32, 256, 256, w + WS_W2 + (size_t)d * 256 * 64, 64, 0, rot, sm);
            conv_job<0>(inp(p, I_RA2) + (size_t)(l * 2 + d) * 32 * 256, 32, 256, 256, w + WS_W2 + (size_t)(2 + d) * 256 * 64, 64, 0, rot, sm);
        }
        conv_job<0>(inp(p, I_RG1) + (size_t)l * 256 * 64, 256, 64, 64, w + WS_W1C, 256, 128, rot, sm);
        conv_job<0>(inp(p, I_RG2) + (size_t)l * 64 * 256, 64, 256, 256, w + WS_G2T, 64, 0, rot, sm);
    }
}

template <int WHICH>
DEV void phase_norm(const Params& p, int l, int nrows, char* smem, bool fuse_combine = false) {
    const int lane = tidx() & 63, wave = tidx() >> 6;
    const float* xs = (l == 0) ? inp(p, I_X) : p.out;
    const float* cs = (l == 0) ? inp(p, I_CTX) : wsf(p, OFF_CX);
    const float* g = inp(p, WHICH == 1 ? I_NMG : I_NFG) + l * 1024;
    bf16_t* H = wsb(p, OFF_H);
    if (WHICH == 2) { xs = p.out; cs = wsf(p, OFF_CX); }
    const int tpb = (nrows + (int)gridDim.x - 1) / (int)gridDim.x;
    const int rbeg = WHICH == 2 ? bidx() * tpb + wave : bidx() * 4 + wave;
    const int rend = WHICH == 2 ? min(nrows, (bidx() + 1) * tpb) : nrows;
    const int rstep = WHICH == 2 ? 4 : (int)gridDim.x * 4;
    int* sel = (int*)smem;
    for (int row = rbeg; row < rend; row += rstep) {
        const float* src = row < TL ? xs + (size_t)row * 1024 : cs + (size_t)(row - TL) * 1024;
        const int mr = mod_row(row);
        const float* sh = modp(p, l, mr, WHICH == 1 ? 0 : 3);
        const float* sc = modp(p, l, mr, WHICH == 1 ? 1 : 4);
        float4 v[4];
        float ss = 0.f;
#pragma unroll
        for (int i = 0; i < 4; ++i) v[i] = *(const float4*)(src + lane * 4 + i * 256);
        if (WHICH == 1 && fuse_combine) {
            const bf16_t* Z = wsb(p, OFF_Z);
            const int* toki = (const int*)(wsp(p) + OFF_TOKI);
            const float* tokw = (const float*)(wsp(p) + OFF_TOKW);
            const float* g2 = modp(p, l - 1, mr, 5);
            const int r0 = toki[(size_t)row * 4 + 2], r1 = toki[(size_t)row * 4 + 3];
            const float w0 = tokw[(size_t)row * 2], w1 = tokw[(size_t)row * 2 + 1];
            float* dst = row < TL ? p.out + (size_t)row * 1024 : wsf(p, OFF_CX) + (size_t)(row - TL) * 1024;
#pragma unroll
            for (int i = 0; i < 4; ++i) {
                const int c = lane * 4 + i * 256;
                const u32x2 a = *(const u32x2*)(Z + (size_t)r0 * 1024 + c), b = *(const u32x2*)(Z + (size_t)r1 * 1024 + c);
                const float4 gg = *(const float4*)(g2 + c);
                v[i].x += gg.x * (w0 * bflo(a.x) + w1 * bflo(b.x));
                v[i].y += gg.y * (w0 * bfhi(a.x) + w1 * bfhi(b.x));
                v[i].z += gg.z * (w0 * bflo(a.y) + w1 * bflo(b.y));
                v[i].w += gg.w * (w0 * bfhi(a.y) + w1 * bfhi(b.y));
                *(float4*)(dst + c) = v[i];
            }
        }
#pragma unroll
        for (int i = 0; i < 4; ++i) ss += v[i].x * v[i].x + v[i].y * v[i].y + v[i].z * v[i].z + v[i].w * v[i].w;
        ss = wave_sum(ss);
        const float rstd = rsqrtf(ss * (1.f / 1024.f) + EPS);
        float hv[16];
#pragma unroll
        for (int i = 0; i < 4; ++i) {
            const int c = lane * 4 + i * 256;
            const float4 gg = *(const float4*)(g + c), s4 = *(const float4*)(sh + c), c4 = *(const float4*)(sc + c);
            hv[i * 4 + 0] = v[i].x * rstd * gg.x * (1.f + c4.x) + s4.x;
            hv[i * 4 + 1] = v[i].y * rstd * gg.y * (1.f + c4.y) + s4.y;
            hv[i * 4 + 2] = v[i].z * rstd * gg.z * (1.f + c4.z) + s4.z;
            hv[i * 4 + 3] = v[i].w * rstd * gg.w * (1.f + c4.w) + s4.w;
            u32x2 o; o.x = pack2(hv[i * 4 + 0], hv[i * 4 + 1]); o.y = pack2(hv[i * 4 + 2], hv[i * 4 + 3]);
            *(u32x2*)(H + (size_t)row * 1024 + c) = o;
        }
        if (WHICH == 2) {
            float lg[16];
#pragma unroll
            for (int e = 0; e < 16; ++e) lg[e] = 0.f;
            const float* rw = inp(p, I_ROUTW);
#pragma unroll
            for (int i = 0; i < 4; ++i)
#pragma unroll
                for (int j = 0; j < 4; ++j) {
                    const int c = lane * 4 + i * 256 + j;
                    const float hvv = hv[i * 4 + j];
#pragma unroll
                    for (int q = 0; q < 4; ++q) {
                        const float4 w4 = *(const float4*)(rw + (size_t)c * 16 + q * 4);
                        lg[q * 4 + 0] += hvv * w4.x; lg[q * 4 + 1] += hvv * w4.y; lg[q * 4 + 2] += hvv * w4.z; lg[q * 4 + 3] += hvv * w4.w;
                    }
                }
#pragma unroll
            for (int e = 0; e < 16; ++e) lg[e] = wave_sum(lg[e]);
            float sc16[16], bs[16];
#pragma unroll
            for (int e = 0; e < 16; ++e) { sc16[e] = sigmoidf_(lg[e]); bs[e] = sc16[e] + inp(p, I_ROUTB)[e]; }
            int bestg = 0; float bestv = -INFINITY;
#pragma unroll
            for (int gi = 0; gi < 4; ++gi) {
                float m1 = -INFINITY, m2 = -INFINITY;
#pragma unroll
                for (int k = 0; k < 4; ++k) { const float x = bs[gi * 4 + k]; if (x > m1) { m2 = m1; m1 = x; } else if (x > m2) m2 = x; }
                const float gs = m1 + m2;
                if (gs > bestv) { bestv = gs; bestg = gi; }
            }
            int i0 = 0, i1 = 0; float v0 = -INFINITY, v1 = -INFINITY, s0 = 0.f, s1 = 0.f;
#pragma unroll
            for (int e = 0; e < 16; ++e) { const bool in = (e >> 2) == bestg; if (in && bs[e] > v0) { v0 = bs[e]; i0 = e; s0 = sc16[e]; } }
#pragma unroll
            for (int e = 0; e < 16; ++e) { const bool in = (e >> 2) == bestg && e != i0; if (in && bs[e] > v1) { v1 = bs[e]; i1 = e; s1 = sc16[e]; } }
            const float inv = 1.f / (s0 + s1);
            if (lane == 0) {
                const int lt = row - bidx() * tpb;
                sel[lt * 2 + 0] = i0; sel[lt * 2 + 1] = i1;
                float* tw = (float*)(wsp(p) + OFF_TOKW) + (size_t)row * 2;
                tw[0] = s0 * inv; tw[1] = s1 * inv;
            }
        }
    }
    if (WHICH == 2) {
        __syncthreads();
        const int t0 = bidx() * tpb, nt = max(0, min(nrows, t0 + tpb) - t0);
        int* rank = sel + 2 * tpb;
        if (tidx() < 16) {
            const int e = tidx(); int c = 0;
            for (int i = 0; i < 2 * nt; ++i) if (sel[i] == e) { rank[i] = c; ++c; }
            ((int*)(wsp(p) + OFF_CNTB))[(size_t)bidx() * 16 + e] = c;
        }
        __syncthreads();
        int* toki = (int*)(wsp(p) + OFF_TOKI);
        for (int i = tidx(); i < nt; i += NT) {
            int4 r; r.x = sel[2 * i]; r.y = sel[2 * i + 1]; r.z = rank[2 * i]; r.w = rank[2 * i + 1];
            *(int4*)(toki + (size_t)(t0 + i) * 4) = r;
        }
        __syncthreads();
    }
}
DEV void phase_route(const Params& p, int l, int nrows, char* smem) {
    int* sm = (int*)smem;
    const int tid = tidx(), e = tid & 15, part = tid >> 4, G = gridDim.x, b = bidx();
    const int* cntb = (const int*)(wsp(p) + OFF_CNTB);
    int pre = 0, tot = 0;
    for (int bb = part; bb < G; bb += 16) { const int c = cntb[(size_t)bb * 16 + e]; tot += c; if (bb < b) pre += c; }
    __syncthreads();
    sm[part * 16 + e] = pre; sm[256 + part * 16 + e] = tot;
    __syncthreads();
    if (tid < 16) {
        int a = 0, t = 0;
        for (int q = 0; q < 16; ++q) { a += sm[q * 16 + tid]; t += sm[256 + q * 16 + tid]; }
        sm[512 + tid] = a; sm[528 + tid] = t;
    }
    __syncthreads();
    if (tid == 0) {
        int a = 0;
        for (int q = 0; q < 16; ++q) { sm[544 + q] = a; a += sm[528 + q]; }
    }
    __syncthreads();
    if (b == 0 && tid < 16) ((int*)(wsp(p) + OFF_CTR))[CTR_MOE + l * 16 + tid] = sm[528 + tid];
    const int tpb = (nrows + G - 1) / G, t0 = b * tpb, nt = max(0, min(nrows, t0 + tpb) - t0);
    int* toki = (int*)(wsp(p) + OFF_TOKI);
    const float* tokw = (const float*)(wsp(p) + OFF_TOKW);
    int* ltok = (int*)(wsp(p) + OFF_LTOK);
    float* lw = (float*)(wsp(p) + OFF_LW);
    for (int i = tid; i < 2 * nt; i += NT) {
        const int t = t0 + (i >> 1), j = i & 1;
        const int ee = toki[(size_t)t * 4 + j], rk = toki[(size_t)t * 4 + 2 + j];
        const int pos = sm[512 + ee] + rk;
        ltok[(size_t)ee * TT + pos] = t;
        lw[(size_t)ee * TT + pos] = tokw[(size_t)t * 2 + j];
        toki[(size_t)t * 4 + 2 + j] = sm[544 + ee] + pos;
    }
}
DEV void phase_combine(const Params& p, int l, int nrows) {
    const int lane = tidx() & 63, wave = tidx() >> 6;
    const bf16_t* Z = wsb(p, OFF_Z);
    const int* toki = (const int*)(wsp(p) + OFF_TOKI);
    const float* tokw = (const float*)(wsp(p) + OFF_TOKW);
    for (int row = bidx() * 4 + wave; row < nrows; row += gridDim.x * 4) {
        float* dst = row < TL ? p.out + (size_t)row * 1024 : wsf(p, OFF_CX) + (size_t)(row - TL) * 1024;
        const float* g2 = modp(p, l, mod_row(row), 5);
        const int r0 = toki[(size_t)row * 4 + 2], r1 = toki[(size_t)row * 4 + 3];
        const float w0 = tokw[(size_t)row * 2], w1 = tokw[(size_t)row * 2 + 1];
#pragma unroll
        for (int i = 0; i < 4; ++i) {
            const int c = lane * 4 + i * 256;
            const u32x2 a = *(const u32x2*)(Z + (size_t)r0 * 1024 + c), b = *(const u32x2*)(Z + (size_t)r1 * 1024 + c);
            const float4 gg = *(const float4*)(g2 + c);
            float4 x = *(float4*)(dst + c);
            x.x += gg.x * (w0 * bflo(a.x) + w1 * bflo(b.x));
            x.y += gg.y * (w0 * bfhi(a.x) + w1 * bfhi(b.x));
            x.z += gg.z * (w0 * bflo(a.y) + w1 * bflo(b.y));
            x.w += gg.w * (w0 * bfhi(a.y) + w1 * bfhi(b.y));
            *(float4*)(dst + c) = x;
        }
    }
}
constexpr int GLD = 72;
constexpr int GSTAGE = 128 * GLD;
template <bool DEEP = true, int TN = 2, class AF, class BF>
DEV void gemm_mainloop(f32x16 (&acc)[2][TN], AF arow, BF brow, int K, bf16_t* sm) {
    const int tid = tidx(), lane = tid & 63, wave = tid >> 6, wm = wave >> 1, wn = wave & 1;
    bf16_t* As = sm;
    bf16_t* Bs = sm + 2 * GSTAGE;
    constexpr int NB = 2 * TN;
    const bf16_t* ap[4]; const bf16_t* bp[NB];
#pragma unroll
    for (int i = 0; i < 4; ++i) { const int q = tid + i * NT; ap[i] = arow(q >> 3) + (q & 7) * 8; }
#pragma unroll
    for (int i = 0; i < NB; ++i) { const int q = tid + i * NT; bp[i] = brow(q >> 3) + (q & 7) * 8; }
    const int soff = (tid >> 3) * GLD + (tid & 7) * 8;
    u32x4 ra0[4], rb0[NB], ra1[4], rb1[NB];
    const int nk = K >> 6;
#pragma unroll
    for (int i = 0; i < 4; ++i) ra0[i] = *(const u32x4*)ap[i];
#pragma unroll
    for (int i = 0; i < NB; ++i) rb0[i] = *(const u32x4*)bp[i];
    if (DEEP && nk > 1) {
#pragma unroll
        for (int i = 0; i < 4; ++i) ra1[i] = *(const u32x4*)(ap[i] + 64);
#pragma unroll
        for (int i = 0; i < NB; ++i) rb1[i] = *(const u32x4*)(bp[i] + 64);
    }
    __syncthreads();
#pragma unroll
    for (int i = 0; i < 4; ++i) *(u32x4*)(As + soff + i * 32 * GLD) = ra0[i];
#pragma unroll
    for (int i = 0; i < NB; ++i) *(u32x4*)(Bs + soff + i * 32 * GLD) = rb0[i];
    __syncthreads();
    const int arow0 = (wm * 64 + (lane & 31)) * GLD + (lane >> 5) * 8;
    const int brow0 = (wn * 32 * TN + (lane & 31)) * GLD + (lane >> 5) * 8;
    auto compute = [&](int cur) {
        const bf16_t* a_s = As + cur * GSTAGE + arow0;
        const bf16_t* b_s = Bs + cur * GSTAGE + brow0;
#pragma unroll
        for (int ks = 0; ks < 4; ++ks) {
            const bf16x8 a0 = *(const bf16x8*)(a_s + ks * 16);
            const bf16x8 a1 = *(const bf16x8*)(a_s + 32 * GLD + ks * 16);
#pragma unroll
            for (int j = 0; j < TN; ++j) {
                const bf16x8 bj = *(const bf16x8*)(b_s + j * 32 * GLD + ks * 16);
                acc[0][j] = __builtin_amdgcn_mfma_f32_32x32x16_bf16(a0, bj, acc[0][j], 0, 0, 0);
                acc[1][j] = __builtin_amdgcn_mfma_f32_32x32x16_bf16(a1, bj, acc[1][j], 0, 0, 0);
            }
        }
    };
    auto gload = [&](u32x4 (&ra)[4], u32x4 (&rb)[NB], int kt) {
        const int k0 = kt * 64;
#pragma unroll
        for (int i = 0; i < 4; ++i) ra[i] = *(const u32x4*)(ap[i] + k0);
#pragma unroll
        for (int i = 0; i < NB; ++i) rb[i] = *(const u32x4*)(bp[i] + k0);
    };
    auto lstore = [&](const u32x4 (&ra)[4], const u32x4 (&rb)[NB], int st) {
#pragma unroll
        for (int i = 0; i < 4; ++i) *(u32x4*)(As + st * GSTAGE + soff + i * 32 * GLD) = ra[i];
#pragma unroll
        for (int i = 0; i < NB; ++i) *(u32x4*)(Bs + st * GSTAGE + soff + i * 32 * GLD) = rb[i];
    };
    for (int kt = 0; kt < nk; kt += 2) {
        if (!DEEP && kt + 1 < nk) gload(ra1, rb1, kt + 1);
        if (DEEP && kt + 2 < nk) gload(ra0, rb0, kt + 2);
        compute(0);
        if (kt + 1 < nk) lstore(ra1, rb1, 1);
        __syncthreads();
        if (kt + 1 >= nk) break;
        if (!DEEP && kt + 2 < nk) gload(ra0, rb0, kt + 2);
        if (DEEP && kt + 3 < nk) gload(ra1, rb1, kt + 3);
        compute(1);
        if (kt + 2 < nk) lstore(ra0, rb0, 0);
        __syncthreads();
    }
}
template <int TN>
DEV void acc_zero(f32x16 (&acc)[2][TN]) {
#pragma unroll
    for (int i = 0; i < 2; ++i)
#pragma unroll
        for (int j = 0; j < TN; ++j)
#pragma unroll
            for (int r = 0; r < 16; ++r) acc[i][j][r] = 0.f;
}
#define EPI_FOREACH(acc, ...)                                                                           \
    {                                                                                                    \
        const int _lane = tidx() & 63, _wave = tidx() >> 6, _wm = _wave >> 1, _wn = _wave & 1; \
        _Pragma("unroll") for (int _i = 0; _i < 2; ++_i)                                                 \
        _Pragma("unroll") for (int _j = 0; _j < 2; ++_j)                                                 \
        _Pragma("unroll") for (int _r = 0; _r < 16; ++_r) {                                              \
            const int er = _wm * 64 + _i * 32 + (_r & 3) + 8 * (_r >> 2) + 4 * (_lane >> 5);             \
            const int ec = _wn * 64 + _j * 32 + (_lane & 31);                                            \
            const float ev = acc[_i][_j][_r];                                                            \
            __VA_ARGS__                                                                                  \
        }                                                                                                \
    }

DEV void tile_mn(int item, int nMt, int nNt, int& mt, int& nt) {
    constexpr int GM = 16;
    const int per = GM * nNt, g = item / per, rem = item % per;
    const int m0 = g * GM, gsz = (nMt - m0) < GM ? (nMt - m0) : GM;
    mt = m0 + rem % gsz; nt = rem / gsz;
}

DEV void phase_inproj(const Params& p, int l, char* smem) {
    bf16_t* sm = (bf16_t*)smem;
    const bf16_t* H = wsb(p, OFF_H);
    const bf16_t* W = wsb(p, OFF_WIN);
    bf16_t* P = wsb(p, OFF_P);
    unsigned char* G = (unsigned char*)(wsp(p) + OFF_GATE);
    const int nMt = TT / 128, nNt = NINP / 128;
    for (int item = bidx(); item < nMt * nNt; item += gridDim.x) {
        int mt, nt; tile_mn(item, nMt, nNt, mt, nt);
        const int m0 = mt * 128, n0 = nt * 128;
        if (l == 1 && m0 >= TL && n0 >= NGATE0) continue;
        f32x16 acc[2][2]; acc_zero<2>(acc);
        gemm_mainloop(acc, [&](int r) { return H + (size_t)(m0 + r) * 1024; }, [&](int r) { return W + (size_t)(n0 + r) * 1024; }, 1024, sm);
        if (n0 < NGATE0) {
            EPI_FOREACH(acc, { const int col = n0 + ec; if (col < C_PEND) P[(size_t)(m0 + er) * LDP + col] = f2bf(ev); })
        } else {
            EPI_FOREACH(acc, { const int col = n0 + ec - NGATE0; const float s = sigmoidf_(ev); G[(size_t)(m0 + er) * 4096 + col] = (unsigned char)__float2int_rn(s * 255.f); })
        }
    }
}

template <class EF>
DEV void gemm_generic(const bf16_t* A, int lda, int M, const bf16_t* Bt, int ldb, int N, int K, EF ef, char* smem, int rot) {
    bf16_t* sm = (bf16_t*)smem;
    const int nMt = (M + 127) / 128, nNt = (N + 127) / 128, G = gridDim.x;
    const int first = (bidx() - (rot % G) + G) % G;
    for (int item = first; item < nMt * nNt; item += G) {
        const int mt = item / nNt, nt = item % nNt, m0 = mt * 128, n0 = nt * 128;
        f32x16 acc[2][2]; acc_zero<2>(acc);
        gemm_mainloop(acc, [&](int r) { int rr = m0 + r; rr = rr < M ? rr : M - 1; return A + (size_t)rr * lda; },
                      [&](int r) { int rr = n0 + r; rr = rr < N ? rr : N - 1; return Bt + (size_t)rr * ldb; }, K, sm);
        EPI_FOREACH(acc, { const int row = m0 + er, col = n0 + ec; if (row < M && col < N) ef(row, col, ev); })
    }
}

DEV void phase_merge(const Params& p, int l, int M, char* smem) {
    bf16_t* sm = (bf16_t*)smem;
    const bf16_t* Y = wsb(p, OFF_Y);
    const bf16_t* W = wsb(p, OFF_WBR);
    const unsigned char* G = (const unsigned char*)(wsp(p) + OFF_GATE);
    bf16_t* MG = wsb(p, OFF_H);
    bf16_t* As = sm;
    bf16_t* Bs = sm + 2 * GSTAGE;
    unsigned char* Gs = (unsigned char*)(sm + 2 * GSTAGE + 2 * 64 * GLD);
    const int tid = tidx(), lane = tid & 63, wave = tid >> 6, wm = wave >> 1, wn = wave & 1;
    const int soff = (tid >> 3) * GLD + (tid & 7) * 8;
    const int arow0 = (wm * 64 + (lane & 31)) * GLD + (lane >> 5) * 8;
    const int brow0 = (wn * 32 + (lane & 31)) * GLD + (lane >> 5) * 8;
    const int nMt = M / 128, nNt = 16;
    for (int item = bidx(); item < nMt * nNt; item += gridDim.x) {
        const int mt = item / nNt, nt = item % nNt, m0 = mt * 128, n0 = nt * 64;
        const bf16_t* ap[4]; const bf16_t* bp[2]; const unsigned char* gp[2];
#pragma unroll
        for (int i = 0; i < 4; ++i) { const int q = tid + i * NT; ap[i] = Y + (size_t)(m0 + (q >> 3)) * 1024 + (q & 7) * 8; }
#pragma unroll
        for (int i = 0; i < 2; ++i) { const int q = tid + i * NT; bp[i] = W + (size_t)(n0 + (q >> 3)) * 256 + (q & 7) * 8;
                                      gp[i] = G + (size_t)(m0 + (q >> 2)) * 4096 + n0 + (q & 3) * 16; }
        f32x16 tot[2], acc[2];
#pragma unroll
        for (int a = 0; a < 2; ++a)
#pragma unroll
            for (int r = 0; r < 16; ++r) { tot[a][r] = 0.f; acc[a][r] = 0.f; }
        u32x4 ra[4], rb[2], rg[2];
#pragma unroll
        for (int i = 0; i < 4; ++i) ra[i] = *(const u32x4*)ap[i];
#pragma unroll
        for (int i = 0; i < 2; ++i) rb[i] = *(const u32x4*)bp[i];
        __syncthreads();
#pragma unroll
        for (int i = 0; i < 4; ++i) *(u32x4*)(As + soff + i * 32 * GLD) = ra[i];
#pragma unroll
        for (int i = 0; i < 2; ++i) *(u32x4*)(Bs + soff + i * 32 * GLD) = rb[i];
        __syncthreads();
#pragma unroll
        for (int kt = 0; kt < 16; ++kt) {
            const int cur = kt & 1, seg = kt >> 2;
            if (kt + 1 < 16) {
                const int k1 = kt + 1;
#pragma unroll
                for (int i = 0; i < 4; ++i) ra[i] = *(const u32x4*)(ap[i] + k1 * 64);
#pragma unroll
                for (int i = 0; i < 2; ++i) rb[i] = *(const u32x4*)(bp[i] + (size_t)(k1 >> 2) * (1024 * 256) + (k1 & 3) * 64);
            }
            if ((kt & 3) == 0) {
#pragma unroll
                for (int i = 0; i < 2; ++i) rg[i] = *(const u32x4*)(gp[i] + seg * 1024);
            }
            const bf16_t* a_s = As + cur * GSTAGE + arow0;
            const bf16_t* b_s = Bs + cur * (64 * GLD) + brow0;
#pragma unroll
            for (int ks = 0; ks < 4; ++ks) {
                const bf16x8 a0 = *(const bf16x8*)(a_s + ks * 16), a1 = *(const bf16x8*)(a_s + 32 * GLD + ks * 16), b0 = *(const bf16x8*)(b_s + ks * 16);
                acc[0] = __builtin_amdgcn_mfma_f32_32x32x16_bf16(a0, b0, acc[0], 0, 0, 0);
                acc[1] = __builtin_amdgcn_mfma_f32_32x32x16_bf16(a1, b0, acc[1], 0, 0, 0);
            }
            if (kt + 1 < 16) {
                const int nx = cur ^ 1;
#pragma unroll
                for (int i = 0; i < 4; ++i) *(u32x4*)(As + nx * GSTAGE + soff + i * 32 * GLD) = ra[i];
#pragma unroll
                for (int i = 0; i < 2; ++i) *(u32x4*)(Bs + nx * (64 * GLD) + soff + i * 32 * GLD) = rb[i];
            }
            if ((kt & 3) == 3) {
#pragma unroll
                for (int i = 0; i < 2; ++i) { const int q = tid + i * NT; *(u32x4*)(Gs + (q >> 2) * 64 + (q & 3) * 16) = rg[i]; }
            }
            __syncthreads();
            if ((kt & 3) == 3) {
#pragma unroll
                for (int a = 0; a < 2; ++a)
#pragma unroll
                    for (int r = 0; r < 16; ++r) {
                        const int er = wm * 64 + a * 32 + (r & 3) + 8 * (r >> 2) + 4 * (lane >> 5), ec = wn * 32 + (lane & 31);
                        tot[a][r] += (float)Gs[er * 64 + ec] * (1.f / 255.f) * acc[a][r];
                        acc[a][r] = 0.f;
                    }
            }
        }
#pragma unroll
        for (int a = 0; a < 2; ++a)
#pragma unroll
            for (int r = 0; r < 16; ++r) {
                const int er = wm * 64 + a * 32 + (r & 3) + 8 * (r >> 2) + 4 * (lane >> 5), ec = wn * 32 + (lane & 31);
                MG[(size_t)(m0 + er) * 1024 + n0 + ec] = f2bf(tot[a][r]);
            }
    }
}

DEV void phase_outproj(const Params& p, int l, int M, char* smem) {
    bf16_t* sm = (bf16_t*)smem;
    const bf16_t* MG = wsb(p, OFF_H);
    const bf16_t* W = wsb(p, OFF_WOUT);
    const float* xs = (l == 0) ? inp(p, I_X) : p.out;
    const float* cs = (l == 0) ? inp(p, I_CTX) : wsf(p, OFF_CX);
    float* cxd = wsf(p, OFF_CX);
    float* outd = p.out;
    const int nMt = M / 128, nNt = 8;
    for (int item = bidx(); item < nMt * nNt; item += gridDim.x) {
        const int mt = item / nNt, nt = item % nNt, m0 = mt * 128, n0 = nt * 128;
        f32x16 acc[2][2]; acc_zero<2>(acc);
        gemm_mainloop(acc, [&](int r) { return MG + (size_t)(m0 + r) * 1024; }, [&](int r) { return W + (size_t)(n0 + r) * 1024; }, 1024, sm);
        const float* g1 = modp(p, l, mod_row(m0), 2);
        if (m0 < TL) {
            EPI_FOREACH(acc, { const size_t o = (size_t)(m0 + er) * 1024 + n0 + ec; outd[o] = xs[o] + g1[n0 + ec] * ev; })
        } else {
            EPI_FOREACH(acc, { const size_t o = (size_t)(m0 - TL + er) * 1024 + n0 + ec; cxd[o] = cs[o] + g1[n0 + ec] * ev; })
        }
    }
}

constexpr int MOE_MAP_OFF = 73728;
DEV void moe_map(const Params& p, int l, char* smem) {
    int* mm = (int*)(smem + MOE_MAP_OFF);
    __syncthreads();
    if (tidx() == 0) {
        const int* cnt = (const int*)(wsp(p) + OFF_CTR) + CTR_MOE + l * 16;
        int b = 0, t = 0;
        for (int e = 0; e < 16; ++e) { const int c = cnt[e]; mm[e] = c; mm[16 + e] = b; mm[32 + e] = t; b += c; t += (c + 127) >> 7; }
        mm[48] = t;
    }
    __syncthreads();
}
DEV void phase_moe1(const Params& p, int l, char* smem) {
    bf16_t* sm = (bf16_t*)smem;
    const bf16_t* F = wsb(p, OFF_H);
    const bf16_t* W = wsb(p, OFF_WG1);
    bf16_t* ACT = wsb(p, OFF_P);
    const int* ltok = (const int*)(wsp(p) + OFF_LTOK);
    moe_map(p, l, smem); const int* mm = (const int*)(smem + MOE_MAP_OFF);
    const int nNt = 8, total = mm[48] * nNt;
    for (int item = bidx(); item < total; item += gridDim.x) {
        const int mtg = item / nNt, nt = item % nNt;
        int e = 0;
        for (int q = 1; q < 16; ++q) if (mtg >= mm[32 + q]) e = q;
        const int m0 = (mtg - mm[32 + e]) * 128, n0 = nt * 128, ce = mm[e];
        const int* lt = ltok + (size_t)e * TT;
        f32x16 acc[2][2]; acc_zero<2>(acc);
        gemm_mainloop(acc, [&](int r) { int idx = m0 + r; idx = idx < ce ? idx : ce - 1; return F + (size_t)lt[idx] * 1024; },
                      [&](int r) { return W + ((size_t)e * 1024 + n0 + r) * 1024; }, 1024, sm);
        const int lane = tidx() & 63, wave = tidx() >> 6, wm = wave >> 1, wn = wave & 1;
        const int jcol = ((n0 >> 6) + wn) * 32 + (lane & 31);
#pragma unroll
        for (int a = 0; a < 2; ++a)
#pragma unroll
            for (int r = 0; r < 16; ++r) {
                const int idx = m0 + wm * 64 + a * 32 + (r & 3) + 8 * (r >> 2) + 4 * (lane >> 5);
                if (idx < ce) {
                    const float g = acc[a][0][r], u = acc[a][1][r];
                    ACT[(size_t)(mm[16 + e] + idx) * DFF + jcol] = f2bf(g * sigmoidf_(g) * u);
                }
            }
    }
}
DEV void phase_moe2(const Params& p, int l, char* smem) {
    bf16_t* sm = (bf16_t*)smem;
    const bf16_t* ACT = wsb(p, OFF_P);
    const bf16_t* W = wsb(p, OFF_WDN);
    bf16_t* Z = wsb(p, OFF_Z);
    moe_map(p, l, smem); const int* mm = (const int*)(smem + MOE_MAP_OFF);
    const int nNt = 8, total = mm[48] * nNt;
    for (int item = bidx(); item < total; item += gridDim.x) {
        const int mtg = item / nNt, nt = item % nNt;
        int e = 0;
        for (int q = 1; q < 16; ++q) if (mtg >= mm[32 + q]) e = q;
        const int m0 = (mtg - mm[32 + e]) * 128, n0 = nt * 128, ce = mm[e];
        f32x16 acc[2][2]; acc_zero<2>(acc);
        gemm_mainloop(acc, [&](int r) { int idx = m0 + r; idx = idx < ce ? idx : ce - 1; return ACT + (size_t)(mm[16 + e] + idx) * DFF; },
                      [&](int r) { return W + ((size_t)e * 1024 + n0 + r) * DFF; }, DFF, sm);
        bf16_t* zb = Z + (size_t)mm[16 + e] * 1024;
        EPI_FOREACH(acc, { const int idx = m0 + er; if (idx < ce) zb[(size_t)idx * 1024 + n0 + ec] = f2bf(ev); })
    }
}
DEV void tok_seq(int t, int& base, int& n, int& len) {
    if (t < TL) { base = t & ~(SEQ - 1); n = t & (SEQ - 1); len = SEQ; } else { const int u = t - TL; base = TL + (u & ~(CTXL - 1)); n = u & (CTXL - 1); len = CTXL; }
}
DEV void phase_prep1(const Params& p, int l) {
    const int lane = tidx() & 63, wave = tidx() >> 6;
    bf16_t* P = wsb(p, OFF_P);
    bf16_t* XL = wsb(p, OFF_XL);
    const float* qkg = inp(p, I_DAQKG) + l * 64;
    const float* cqg = inp(p, I_MCQG) + l * 192;
    const float* ckvg = inp(p, I_MCKVG) + l * 128;
    const float* mu3 = inp(p, I_RMU) + (l * 4 + 3) * 256;
    for (int t = bidx() * 4 + wave; t < TT; t += gridDim.x * 4) {
        bf16_t* row = P + (size_t)t * LDP;
        int base, n, len; tok_seq(t, base, n, len);
        {
            const int d0 = (lane & 7) * 4;
            float cs[4], sn[4];
            const bool rot = t < TL;
            if (rot) {
                const float fr = (float)(n >> 6), fc = (float)(n & 63);
#pragma unroll
                for (int j = 0; j < 4; ++j) {
                    const int i = (d0 + j) & 15;
                    const float inv = exp2f(-(float)(i & 7) * (13.287712379549449f / 8.f));
                    const float ang = (i < 8 ? fr : fc) * inv;
                    cs[j] = __cosf(ang); sn[j] = __sinf(ang);
                }
            }
#pragma unroll
            for (int which = 0; which < 2; ++which) {
                bf16_t* ptr = row + (which ? C_DAK : C_DAQ) + lane * 4;
                const u32x2 raw = *(const u32x2*)ptr;
                float v[4] = { bflo(raw.x), bfhi(raw.x), bflo(raw.y), bfhi(raw.y) };
                float ss = v[0] * v[0] + v[1] * v[1] + v[2] * v[2] + v[3] * v[3];
                ss = group_sum<8>(ss);
                const float rstd = rsqrtf(ss * (1.f / 32.f) + EPS);
                const float* g = qkg + which * 32 + d0;
#pragma unroll
                for (int j = 0; j < 4; ++j) v[j] = v[j] * rstd * g[j];
                if (rot) {
#pragma unroll
                    for (int j = 0; j < 4; ++j) {
                        const float o = __shfl_xor(v[j], 4, 64);
                        v[j] = (d0 < 16) ? (v[j] * cs[j] - o * sn[j]) : (v[j] * cs[j] + o * sn[j]);
                    }
                }
                if (which == 0) {
                    const float qs = 0.17677669529663687f * LOG2E;
#pragma unroll
                    for (int j = 0; j < 4; ++j) v[j] *= qs;
                }
                u32x2 o; o.x = pack2(v[0], v[1]); o.y = pack2(v[2], v[3]);
                *(u32x2*)ptr = o;
            }
        }
        {
            float v[3]; float ss = 0.f;
#pragma unroll
            for (int j = 0; j < 3; ++j) { v[j] = bf2f(row[C_CQ + lane + j * 64]); ss += v[j] * v[j]; }
            ss = wave_sum(ss);
            const float rstd = rsqrtf(ss * (1.f / 192.f) + EPS);
#pragma unroll
            for (int j = 0; j < 3; ++j) row[C_CQ + lane + j * 64] = f2bf(v[j] * rstd * cqg[lane + j * 64]);
            float w[2]; float s2 = 0.f;
#pragma unroll
            for (int j = 0; j < 2; ++j) { w[j] = bf2f(row[C_CKV + lane + j * 64]); s2 += w[j] * w[j]; }
            s2 = wave_sum(s2);
            const float r2 = rsqrtf(s2 * (1.f / 128.f) + EPS);
#pragma unroll
            for (int j = 0; j < 2; ++j) row[C_CKV + lane + j * 64] = f2bf(w[j] * r2 * ckvg[lane + j * 64]);
        }
        {
            const int c = lane * 4;
            const u32x2 cur = *(const u32x2*)(row + C_RWD + c);
            u32x2 pv = (u32x2){0u, 0u}, nx = (u32x2){0u, 0u};
            if (n > 0) pv = *(const u32x2*)(row - LDP + C_RWD + c);
            if (n + 1 < len) nx = *(const u32x2*)(row + LDP + C_RWD + c);
            const float4 m = *(const float4*)(mu3 + c);
            float o[4];
            { const float x = bflo(cur.x); o[0] = x + (0.5f * (bflo(pv.x) + bflo(nx.x)) - x) * m.x; }
            { const float x = bfhi(cur.x); o[1] = x + (0.5f * (bfhi(pv.x) + bfhi(nx.x)) - x) * m.y; }
            { const float x = bflo(cur.y); o[2] = x + (0.5f * (bflo(pv.y) + bflo(nx.y)) - x) * m.z; }
            { const float x = bfhi(cur.y); o[3] = x + (0.5f * (bfhi(pv.y) + bfhi(nx.y)) - x) * m.w; }
            u32x2 ov; ov.x = pack2(o[0], o[1]); ov.y = pack2(o[2], o[3]);
            *(u32x2*)(XL + (size_t)t * 256 + c) = ov;
        }
    }
}

DEV void phase_prep_gemm1(const Params& p, int l, char* smem) {
    const bf16_t* P = wsb(p, OFF_P);
    const bf16_t* w = wsb(p, OFF_WSM) + (size_t)l * WS_PER_LAYER;
    bf16_t* QRAW = wsb(p, OFF_QRAW); bf16_t* KVRAW = wsb(p, OFF_KVRAW); bf16_t* LR = wsb(p, OFF_LR);
    int rot = 0;
    gemm_generic(P + C_CQ, LDP, TT, w + WS_UQT, 192, 192, 192, [&](int r, int c, float v) { QRAW[(size_t)r * 192 + c] = f2bf(v); }, smem, rot);
    rot += (TT / 128) * 2;
    gemm_generic(P + C_CKV, LDP, TT, w + WS_UKVT, 128, 384, 128, [&](int r, int c, float v) { KVRAW[(size_t)r * 384 + c] = f2bf(v); }, smem, rot);
    rot += (TT / 128) * 3;
    gemm_generic(wsb(p, OFF_XL), 256, TT, w + WS_W1C, 256, 192, 256,
                 [&](int r, int c, float v) { const float o = c < 64 ? (1.f - 2.f / (__expf(2.f * v) + 1.f)) : (c < 128 ? v : sigmoidf_(v)); LR[(size_t)r * 192 + c] = f2bf(o); }, smem, rot);
}
DEV void phase_prep_gemm2(const Params& p, int l, char* smem) {
    const bf16_t* w = wsb(p, OFF_WSM) + (size_t)l * WS_PER_LAYER;
    const bf16_t* LR = wsb(p, OFF_LR);
    bf16_t* RWX = wsb(p, OFF_RWX);
    bf16_t* P = wsb(p, OFF_P);
    int rot = 0;
    for (int d = 0; d < 2; ++d) {
        const float* w0 = inp(p, I_RW0) + (l * 2 + d) * 256;
        gemm_generic(LR + d * 32, 192, TT, w + WS_W2 + (size_t)d * 256 * 64, 64, 256, 64,
                     [&](int r, int c, float v) { RWX[(size_t)r * 1024 + d * 256 + c] = f2bf(0.6065306597126334f * sigmoidf_(w0[c] + v)); }, smem, rot);
        rot += (TT / 128) * 2;
        const float* a0 = inp(p, I_RA0) + (l * 2 + d) * 256;
        gemm_generic(LR + 64 + d * 32, 192, TT, w + WS_W2 + (size_t)(2 + d) * 256 * 64, 64, 256, 64,
                     [&](int r, int c, float v) { RWX[(size_t)r * 1024 + 512 + d * 256 + c] = f2bf(sigmoidf_(a0[c] + v)); }, smem, rot);
        rot += (TT / 128) * 2;
    }
    gemm_generic(LR + 128, 192, TT, w + WS_G2T, 64, 256, 64, [&](int r, int c, float v) { P[(size_t)r * LDP + C_RWD + c] = f2bf(v); }, smem, rot);
}

DEV void phase_prep2(const Params& p, int l) {
    const int lane = tidx() & 63, wave = tidx() >> 6;
    const bf16_t* P = wsb(p, OFF_P);
    const bf16_t* QRAW = wsb(p, OFF_QRAW); const bf16_t* KVRAW = wsb(p, OFF_KVRAW);
    bf16_t* MQ = wsb(p, OFF_MLAQ); bf16_t* MK = wsb(p, OFF_MLAK); bf16_t* MV = wsb(p, OFF_MLAV);
    const float* qkg = inp(p, I_MQKG) + l * 96;
    for (int t = bidx() * 4 + wave; t < TT; t += gridDim.x * 4) {
        int base, n, len; tok_seq(t, base, n, len);
        const int h = lane >> 4, j = lane & 15;
        const bool rot = t < TL;
        float cs = 1.f, sn = 0.f;
        if (rot) {
            const int i = j & 7;
            const float inv = exp2f(-(float)(i & 3) * (13.287712379549449f / 4.f));
            const float ang = (i < 4 ? (float)(n >> 6) : (float)(n & 63)) * inv;
            cs = __cosf(ang); sn = __sinf(ang);
        }
        {
            float v[3]; float ss = 0.f;
#pragma unroll
            for (int k = 0; k < 3; ++k) { v[k] = bf2f(QRAW[(size_t)t * 192 + h * 48 + j + k * 16]); ss += v[k] * v[k]; }
            ss = group_sum<16>(ss);
            const float rstd = rsqrtf(ss * (1.f / 48.f) + EPS);
#pragma unroll
            for (int k = 0; k < 3; ++k) v[k] = v[k] * rstd * qkg[j + k * 16];
            if (rot) { const float o = __shfl_xor(v[2], 8, 64); v[2] = (j < 8) ? (v[2] * cs - o * sn) : (v[2] * cs + o * sn); }
            const float qs = 0.14433756729740643f * LOG2E;
#pragma unroll
            for (int k = 0; k < 3; ++k) MQ[(size_t)t * 192 + h * 48 + j + k * 16] = f2bf(v[k] * qs);
        }
        {
            float v[3]; float ss = 0.f;
            v[0] = bf2f(KVRAW[(size_t)t * 384 + h * 96 + j]);
            v[1] = bf2f(KVRAW[(size_t)t * 384 + h * 96 + 16 + j]);
            v[2] = bf2f(P[(size_t)t * LDP + C_KR + j]);
#pragma unroll
            for (int k = 0; k < 3; ++k) ss += v[k] * v[k];
            ss = group_sum<16>(ss);
            const float rstd = rsqrtf(ss * (1.f / 48.f) + EPS);
#pragma unroll
            for (int k = 0; k < 3; ++k) v[k] = v[k] * rstd * qkg[48 + j + k * 16];
            if (rot) { const float o = __shfl_xor(v[2], 8, 64); v[2] = (j < 8) ? (v[2] * cs - o * sn) : (v[2] * cs + o * sn); }
#pragma unroll
            for (int k = 0; k < 3; ++k) MK[(size_t)t * 192 + h * 48 + j + k * 16] = f2bf(v[k]);
        }
#pragma unroll
        for (int k = 0; k < 4; ++k) MV[(size_t)t * 256 + h * 64 + j + k * 16] = KVRAW[(size_t)t * 384 + h * 96 + 32 + j + k * 16];
    }
}
template <int NC, int DK>
struct AttnCfg {
    static constexpr int DKROW = NC * DK, KLD = DKROW + 8, VLD = 96;
    static constexpr int KSTAGE = 64 * KLD, VSTAGE = 64 * VLD;
    static constexpr int KCH = 64 * DKROW / 8;
};
template <int NC, int DK, class EPI>
DEV void attn_item(const bf16_t* Q, int ldq, const bf16_t* Kl, const bf16_t* Kc, int ldk, const bf16_t* Vl, const bf16_t* Vc, int ldv,
                   int q0, int nlat_tiles, int nctx_tiles, EPI epi, char* smem) {
    using C = AttnCfg<NC, DK>;
    constexpr int KS = DK / 16;
    const int tid = tidx(), lane = tid & 63, wave = tid >> 6, ql = lane & 31, hh = lane >> 5;
    bf16_t* Ks = (bf16_t*)smem;
    bf16_t* Vt = Ks + 2 * C::KSTAGE;
    bf16x8 qf[NC][KS];
    {
        const bf16_t* qp = Q + (size_t)(q0 + wave * 32 + ql) * ldq + hh * 8;
#pragma unroll
        for (int c = 0; c < NC; ++c)
#pragma unroll
            for (int ks = 0; ks < KS; ++ks) qf[c][ks] = *(const bf16x8*)(qp + c * DK + ks * 16);
    }
    bf16x8* qpark = (bf16x8*)(smem + 45056) + tid;
    if (NC > 1) {
#pragma unroll
        for (int c = 0; c < NC; ++c)
#pragma unroll
            for (int ks = 0; ks < KS; ++ks) qpark[(c * KS + ks) * NT] = qf[c][ks];
    }
    f32x16 O[NC][2];
    float mrun[NC], lrun[NC];
#pragma unroll
    for (int c = 0; c < NC; ++c) {
        mrun[c] = -1e30f; lrun[c] = 0.f;
#pragma unroll
        for (int d = 0; d < 2; ++d)
#pragma unroll
            for (int r = 0; r < 16; ++r) O[c][d][r] = 0.f;
    }
    const int ntiles = nlat_tiles + nctx_tiles;
    constexpr int KPT = (C::KCH + NT - 1) / NT;
    constexpr bool KFULL = (C::KCH % NT) == 0;
    u32x4 rk[KPT], rv[2];
    auto load_tile = [&](int tile) {
        const bf16_t* kb = tile < nlat_tiles ? Kl + (size_t)tile * 64 * ldk : Kc + (size_t)(tile - nlat_tiles) * 64 * ldk;
        const bf16_t* vb = tile < nlat_tiles ? Vl + (size_t)tile * 64 * ldv : Vc + (size_t)(tile - nlat_tiles) * 64 * ldv;
#pragma unroll
        for (int i = 0; i < KPT; ++i) {
            int q = tid + i * NT; q = (KFULL || q < C::KCH) ? q : C::KCH - 1;
            { const int key = q / (C::DKROW / 8), ch = q % (C::DKROW / 8); rk[i] = *(const u32x4*)(kb + (size_t)key * ldk + ch * 8); }
        }
#pragma unroll
        for (int i = 0; i < 2; ++i) { const int q = tid + i * NT; const int key = q >> 3, ch = q & 7; rv[i] = *(const u32x4*)(vb + (size_t)key * ldv + ch * 8); }
    };
    auto store_tile = [&](int st) {
#pragma unroll
        for (int i = 0; i < KPT; ++i) {
            const int q = tid + i * NT;
            if (KFULL || q < C::KCH) { const int key = q / (C::DKROW / 8), ch = q % (C::DKROW / 8); *(u32x4*)(Ks + st * C::KSTAGE + key * C::KLD + ch * 8) = rk[i]; }
        }
#pragma unroll
        for (int i = 0; i < 2; ++i) { const int q = tid + i * NT; const int key = q >> 3, ch = q & 7; *(u32x4*)(Vt + st * C::VSTAGE + key * C::VLD + ch * 8) = rv[i]; }
    };
    typedef short s16x4_ __attribute__((ext_vector_type(4)));
    typedef __attribute__((address_space(3))) s16x4_ lds_s16x4_;
    const int vrd_off = (4 * hh + ((lane & 15) >> 2)) * C::VLD + 16 * ((lane >> 4) & 1) + 4 * (lane & 3);
    load_tile(0);
    __syncthreads();
    store_tile(0);
    __syncthreads();
#pragma unroll 1
    for (int tile = 0; tile < ntiles; ++tile) {
        const int cur = tile & 1;
        if (tile + 1 < ntiles) load_tile(tile + 1);
        __builtin_amdgcn_sched_barrier(0);
        const bf16_t* ks_ = Ks + cur * C::KSTAGE;
        const bf16_t* vt_ = Vt + cur * C::VSTAGE;
#pragma unroll
        for (int c = 0; c < NC; ++c) {
            f32x16 S[2];
#pragma unroll
            for (int kb = 0; kb < 2; ++kb) {
#pragma unroll
                for (int r = 0; r < 16; ++r) S[kb][r] = 0.f;
#pragma unroll
                for (int ks = 0; ks < KS; ++ks) {
                    const bf16x8 kf = *(const bf16x8*)(ks_ + (kb * 32 + ql) * C::KLD + c * DK + ks * 16 + hh * 8);
                    const bf16x8 qv = (NC > 1) ? qpark[(c * KS + ks) * NT] : qf[c][ks];
                    S[kb] = __builtin_amdgcn_mfma_f32_32x32x16_bf16(kf, qv, S[kb], 0, 0, 0);
                }
            }
            float mx = S[0][0];
#pragma unroll
            for (int kb = 0; kb < 2; ++kb)
#pragma unroll
                for (int r = 0; r < 16; ++r) mx = fmaxf(mx, S[kb][r]);
            mx = fmaxf(mx, __shfl_xor(mx, 32, 64));
            if (__builtin_amdgcn_ballot_w64(mx > mrun[c] + 8.f) != 0ull) {
                const float mnew = fmaxf(mrun[c], mx);
                const float alpha = __builtin_amdgcn_exp2f(mrun[c] - mnew);
                mrun[c] = mnew;
                lrun[c] *= alpha;
#pragma unroll
                for (int d = 0; d < 2; ++d)
#pragma unroll
                    for (int r = 0; r < 16; ++r) O[c][d][r] *= alpha;
            }
            const float mcur = mrun[c];
            float ls = 0.f;
#pragma unroll
            for (int kb = 0; kb < 2; ++kb)
#pragma unroll
                for (int r = 0; r < 16; ++r) { const float e = __builtin_amdgcn_exp2f(S[kb][r] - mcur); S[kb][r] = e; ls += e; }
            lrun[c] += ls;
#pragma unroll
            for (int s = 0; s < 4; ++s) {
                const int kb = s >> 1, s2 = s & 1;
                const u32x4 pu = (u32x4){pack2(S[kb][8 * s2 + 0], S[kb][8 * s2 + 1]), pack2(S[kb][8 * s2 + 2], S[kb][8 * s2 + 3]),
                                         pack2(S[kb][8 * s2 + 4], S[kb][8 * s2 + 5]), pack2(S[kb][8 * s2 + 6], S[kb][8 * s2 + 7])};
                const bf16x8 pf = __builtin_bit_cast(bf16x8, pu);
#pragma unroll
                for (int d = 0; d < 2; ++d) {
                    const bf16_t* vp = vt_ + vrd_off + (kb * 32 + 16 * s2) * C::VLD + d * 32;
                    const s16x4_ lo = __builtin_amdgcn_ds_read_tr16_b64_v4i16((lds_s16x4_*)vp), hi = __builtin_amdgcn_ds_read_tr16_b64_v4i16((lds_s16x4_*)(vp + 8 * C::VLD));
                    const bf16x8 vf = __builtin_shufflevector(lo, hi, 0, 1, 2, 3, 4, 5, 6, 7);
                    O[c][d] = __builtin_amdgcn_mfma_f32_32x32x16_bf16(vf, pf, O[c][d], 0, 0, 0);
                }
            }
        }
        if (tile + 1 < ntiles) store_tile(cur ^ 1);
        __syncthreads();
    }
    float inv[NC];
#pragma unroll
    for (int c = 0; c < NC; ++c) { const float lt = lrun[c] + __shfl_xor(lrun[c], 32, 64); inv[c] = 1.f / lt; }
    epi(O, inv, q0 + wave * 32 + ql, hh);
}

DEV void da_item(const Params& p, int l, int item, char* smem) {
    const bf16_t* P = wsb(p, OFF_P);
    bf16_t* Y = wsb(p, OFF_Y);
    const float linit = 0.8f - 0.6f * __expf(-0.3f * (float)l);
    float lam;
    {
        const float* la = inp(p, I_DALAM) + l * 128;
        const int lane = tidx() & 63;
        float a = lane < 32 ? la[lane] * la[32 + lane] : 0.f, b = lane < 32 ? la[64 + lane] * la[96 + lane] : 0.f;
        a = wave_sum(a); b = wave_sum(b);
        lam = __expf(a) - __expf(b) + linit;
    }
    const float* sg = inp(p, I_DASUB) + l * 64;
    int b, h, qt; bool isctx;
    if (item < 512) { isctx = false; b = item >> 6; h = (item >> 4) & 3; qt = item & 15; }
    else { const int it = item - 512; isctx = true; b = it >> 3; h = (it >> 1) & 3; qt = it & 1; }
    const size_t lat0 = (size_t)b * SEQ, ctx0 = (size_t)TL + (size_t)b * CTXL;
    const size_t qrow0 = isctx ? ctx0 : lat0;
    auto epi2 = [&](f32x16 (&O)[2][2], float (&inv)[2], int qrow, int hh) {
        float v[2][16]; float ss = 0.f;
        const float li1 = lam * inv[1];
#pragma unroll
        for (int d = 0; d < 2; ++d)
#pragma unroll
            for (int r = 0; r < 16; ++r) { const float o = O[0][d][r] * inv[0] - li1 * O[1][d][r]; v[d][r] = o; ss += o * o; }
        ss += __shfl_xor(ss, 32, 64);
        const float rstd = rsqrtf(ss * (1.f / 64.f) + EPS) * (1.f - linit);
        bf16_t* yo = Y + (qrow0 + qrow) * 1024 + h * 64;
#pragma unroll
        for (int d = 0; d < 2; ++d)
#pragma unroll
            for (int g = 0; g < 4; ++g) {
                const int dv = d * 32 + 8 * g + 4 * hh;
                u32x2 o;
                o.x = pack2(v[d][4 * g + 0] * rstd * sg[dv + 0], v[d][4 * g + 1] * rstd * sg[dv + 1]);
                o.y = pack2(v[d][4 * g + 2] * rstd * sg[dv + 2], v[d][4 * g + 3] * rstd * sg[dv + 3]);
                *(u32x2*)(yo + dv) = o;
            }
    };
    const bf16_t* Qp = P + qrow0 * LDP + C_DAQ + h * 64;
    const bf16_t* Kl = P + lat0 * LDP + C_DAK + h * 64;
    const bf16_t* Kc = P + ctx0 * LDP + C_DAK + h * 64;
    const bf16_t* Vl = P + lat0 * LDP + C_DAV + h * 64;
    const bf16_t* Vc = P + ctx0 * LDP + C_DAV + h * 64;
    const int nlat = isctx ? 0 : SEQ / 64;
    attn_item<2, 32>(Qp, LDP, Kl, Kc, LDP, Vl, Vc, LDP, qt * 128, nlat, CTXL / 64, epi2, smem);
}
DEV void mla_item(const Params& p, int l, int item, char* smem) {
    const bf16_t* MQ = wsb(p, OFF_MLAQ); const bf16_t* MK = wsb(p, OFF_MLAK); const bf16_t* MV = wsb(p, OFF_MLAV);
    bf16_t* Y = wsb(p, OFF_Y);
    int b, h, qt; bool isctx;
    if (item < 512) { isctx = false; b = item >> 6; h = (item >> 4) & 3; qt = item & 15; }
    else { const int it = item - 512; isctx = true; b = it >> 3; h = (it >> 1) & 3; qt = it & 1; }
    const size_t lat0 = (size_t)b * SEQ, ctx0 = (size_t)TL + (size_t)b * CTXL;
    const size_t qrow0 = isctx ? ctx0 : lat0;
    auto epi = [&](f32x16 (&O)[1][2], float (&inv)[1], int qrow, int hh) {
        bf16_t* yo = Y + (qrow0 + qrow) * 1024 + 512 + h * 64;
#pragma unroll
        for (int d = 0; d < 2; ++d)
#pragma unroll
            for (int g = 0; g < 4; ++g) {
                const int dv = d * 32 + 8 * g + 4 * hh;
                u32x2 o;
                o.x = pack2(O[0][d][4 * g + 0] * inv[0], O[0][d][4 * g + 1] * inv[0]);
                o.y = pack2(O[0][d][4 * g + 2] * inv[0], O[0][d][4 * g + 3] * inv[0]);
                *(u32x2*)(yo + dv) = o;
            }
    };
    const bf16_t* Qp = MQ + qrow0 * 192 + h * 48;
    const bf16_t* Kl = MK + lat0 * 192 + h * 48;
    const bf16_t* Kc = MK + ctx0 * 192 + h * 48;
    const bf16_t* Vl = MV + lat0 * 256 + h * 64;
    const bf16_t* Vc = MV + ctx0 * 256 + h * 64;
    attn_item<1, 48>(Qp, 192, Kl, Kc, 192, Vl, Vc, 256, qt * 128, isctx ? 0 : SEQ / 64, CTXL / 64, epi, smem);
}
DEV int s5_token(int b, int tb, int n) { return tb == 0 ? TL + b * CTXL + n : b * SEQ + (tb - 1) * 256 + n; }
struct S5M { float are, aim; bf16x8* bfl; };
DEV void s5_coef(const Params& p, int gi, int pl, float& are, float& aim, float& cr, float& ci) {
    const float lre = inp(p, I_S5LRE)[gi * 64 + pl], lim = inp(p, I_S5LIM)[gi * 64 + pl];
    const float dt = __expf(inp(p, I_S5LDT)[gi]);
    const float mag = __expf(lre * dt);
    are = mag * __cosf(lim * dt); aim = mag * __sinf(lim * dt);
    const float nr = are - 1.f, ni = aim, den = 1.f / (lre * lre + lim * lim);
    cr = (nr * lre + ni * lim) * den; ci = (ni * lre - nr * lim) * den;
}
DEV void s5_setup(const Params& p, int l, int d, int g, int lane, S5M& s, bf16x8* bfl) {
    s.bfl = bfl;
    const int gi = ((l * 2 + d) * 16 + g), c16 = lane & 15, kq = lane >> 4;
    float cr, ci;
    s5_coef(p, gi, lane, s.are, s.aim, cr, ci);
#pragma unroll
    for (int nt = 0; nt < 4; ++nt) {
        const int pp = nt * 16 + c16;
        float a0, a1; s5_coef(p, gi, pp, a0, a1, cr, ci);
        float re[8], im[8];
        const float* br = inp(p, I_S5BRE) + ((size_t)gi * 64 + pp) * 16 + (kq & 1) * 8;
        const float* bi = inp(p, I_S5BIM) + ((size_t)gi * 64 + pp) * 16 + (kq & 1) * 8;
#pragma unroll
        for (int j = 0; j < 8; ++j) { const float x = br[j], y = bi[j]; const bool on = kq < 2; re[j] = on ? cr * x - ci * y : 0.f; im[j] = on ? cr * y + ci * x : 0.f; }
        bfl[nt * 64 + lane] = __builtin_bit_cast(bf16x8, (u32x4){pack2(re[0], re[1]), pack2(re[2], re[3]), pack2(re[4], re[5]), pack2(re[6], re[7])});
        bfl[(nt + 4) * 64 + lane] = __builtin_bit_cast(bf16x8, (u32x4){pack2(im[0], im[1]), pack2(im[2], im[3]), pack2(im[4], im[5]), pack2(im[6], im[7])});
    }
}
DEV void s5_bu32(const S5M& s, const bf16_t* P, int b, int tb, int g, int sc, bf16_t* hb, int lane) {
    asm volatile("" : "+v"(sc));
    const int c16 = lane & 15, kq = lane >> 4;
    bf16x8 uf[2];
#pragma unroll
    for (int mt = 0; mt < 2; ++mt) {
        const int t = s5_token(b, tb, sc * 32 + mt * 16 + c16);
        const u32x4 raw = *(const u32x4*)(P + (size_t)t * LDP + C_S5 + g * 16 + (kq & 1) * 8);
        const u32x4 z = (u32x4){0u, 0u, 0u, 0u};
        uf[mt] = __builtin_bit_cast(bf16x8, kq < 2 ? raw : z);
    }
#pragma unroll
    for (int nt = 0; nt < 8; ++nt)
#pragma unroll
        for (int mt = 0; mt < 2; ++mt) {
            const f32x4 acc = __builtin_amdgcn_mfma_f32_16x16x32_bf16(s.bfl[nt * 64 + lane], uf[mt], (f32x4){0.f, 0.f, 0.f, 0.f}, 0, 0, 0);
            u32x2 o; o.x = pack2(acc[0], acc[1]); o.y = pack2(acc[2], acc[3]);
            *(u32x2*)(hb + (mt * 16 + c16) * 136 + nt * 16 + kq * 4) = o;
            if (mt == 1 && (nt & 1)) __builtin_amdgcn_sched_barrier(0);
        }
}
template <bool DUMP>
DEV void s5_scan32(const S5M& s, float& hre, float& him, bf16_t* hb, int pl, bool rev) {
#pragma unroll 4
    for (int j = 0; j < 32; ++j) {
        const int rowi = rev ? 31 - j : j;
        const float bur = bf2f(hb[rowi * 136 + pl]), bui = bf2f(hb[rowi * 136 + 64 + pl]);
        const float nre = s.are * hre - s.aim * him + bur;
        const float nim = s.are * him + s.aim * hre + bui;
        hre = nre; him = nim;
        if (DUMP) { hb[rowi * 136 + pl] = f2bf(hre); hb[rowi * 136 + 64 + pl] = f2bf(him); }
    }
}
DEV void phase_s5_pass1(const Params& p, int l, char* smem) {
    const int lane = tidx() & 63, wave = tidx() >> 6;
    bf16_t* hb = (bf16_t*)smem + wave * (32 * 136);
    const bf16_t* P = wsb(p, OFF_P);
    float* st = wsf(p, OFF_S5ST);
    const int nitems = 2 * 8 * 16 * 8;
    for (int it0 = bidx() * 4; it0 < nitems; it0 += gridDim.x * 4) {
        const int it = it0 + wave;
        const int seg = it & 7, g = (it >> 3) & 15, b = (it >> 7) & 7, d = it >> 10;
        const int tb = seg == 0 ? 0 : (d == 0 ? seg : 9 - seg);
        __syncthreads();
        S5M s; s5_setup(p, l, d, g, lane, s, (bf16x8*)(smem + 36864) + wave * 512);
        float hre = 0.f, him = 0.f;
        for (int k = 0; k < 8; ++k) {
            const int sc = d == 0 ? k : 7 - k;
            __syncthreads();
            s5_bu32(s, P, b, tb, g, sc, hb, lane);
            __syncthreads();
            s5_scan32<false>(s, hre, him, hb, lane, d == 1);
        }
        float* o = st + ((((size_t)d * 8 + b) * 16 + g) * 8 + seg) * 128;
        o[lane] = hre; o[64 + lane] = him;
    }
}
DEV void s5_pass2_item(const Params& p, int l, int tb0, int bitem, char* smem) {
    const int lane = tidx() & 63, wave = tidx() >> 6;
    bf16_t* hb = (bf16_t*)smem + wave * (32 * 136);
    bf16_t* P = wsb(p, OFF_P);
    bf16_t* S5Y = wsb(p, OFF_S5Y);
    const float* st = wsf(p, OFF_S5ST);
    const int it = bitem * 4 + wave;
    const int g = it & 15, b = (it >> 4) & 7, tb = (it >> 7) + tb0;
    const int c = lane & 15;
    const float dd = inp(p, I_S5D)[(l * 16 + g) * 16 + c];
#pragma unroll 1
    for (int d = 0; d < 2; ++d) {
        __syncthreads();
        S5M s; s5_setup(p, l, d, g, lane, s, (bf16x8*)(smem + 36864) + wave * 512);
        bf16x8 cf[4];
        {
            const float* cre = inp(p, I_S5CRE) + ((size_t)((l * 2 + d) * 16 + g) * 16 + c) * 64 + (lane >> 4) * 8;
            const float* cim = inp(p, I_S5CIM) + ((size_t)((l * 2 + d) * 16 + g) * 16 + c) * 64 + (lane >> 4) * 8;
#pragma unroll
            for (int ks = 0; ks < 4; ++ks) {
                const float* src = ks < 2 ? cre + ks * 32 : cim + (ks - 2) * 32;
                const float4 a = *(const float4*)src, b4 = *(const float4*)(src + 4);
                const float sg = ks < 2 ? 1.f : -1.f;
                cf[ks] = __builtin_bit_cast(bf16x8, (u32x4){pack2(sg * a.x, sg * a.y), pack2(sg * a.z, sg * a.w), pack2(sg * b4.x, sg * b4.y), pack2(sg * b4.z, sg * b4.w)});
            }
        }
        const int seg = tb == 0 ? 0 : (d == 0 ? tb : 9 - tb);
        float hre = 0.f, him = 0.f;
        {
            float pr = s.are, pi = s.aim;
#pragma unroll
            for (int q = 0; q < 8; ++q) { const float nr = pr * pr - pi * pi, ni = 2.f * pr * pi; pr = nr; pi = ni; }
            const float* hs = st + (((size_t)d * 8 + b) * 16 + g) * 8 * 128;
            for (int i = 0; i < seg; ++i) {
                const float er = hs[i * 128 + lane], ei = hs[i * 128 + 64 + lane];
                const float nr = pr * hre - pi * him + er, ni = pr * him + pi * hre + ei;
                hre = nr; him = ni;
            }
        }
#pragma unroll 1
        for (int k = 0; k < 8; ++k) {
            const int sc = d == 0 ? k : 7 - k;
            __syncthreads();
            s5_bu32(s, P, b, tb, g, sc, hb, lane);
            __syncthreads();
            s5_scan32<true>(s, hre, him, hb, lane, d == 1);
            __syncthreads();
#pragma unroll
            for (int mt = 0; mt < 2; ++mt) {
                f32x4 y = (f32x4){0.f, 0.f, 0.f, 0.f};
#pragma unroll
                for (int ks = 0; ks < 4; ++ks) {
                    const bf16x8 af = *(const bf16x8*)(hb + (mt * 16 + (lane & 15)) * 136 + ks * 32 + (lane >> 4) * 8);
                    y = __builtin_amdgcn_mfma_f32_16x16x32_bf16(af, cf[ks], y, 0, 0, 0);
                }
#pragma unroll
                for (int r = 0; r < 4; ++r) {
                    const int n = sc * 32 + mt * 16 + (lane >> 4) * 4 + r;
                    const size_t t = (size_t)s5_token(b, tb, n);
                    if (d == 0) S5Y[t * 256 + g * 16 + c] = f2bf(y[r]);
                    else {
                        bf16_t* up = P + t * LDP + C_S5 + g * 16 + c;
                        const float yy = dd * bf2f(*up) + bf2f(S5Y[t * 256 + g * 16 + c]) + y[r];
                        *up = f2bf(0.5f * yy * (1.f + tanhf(0.7978845608028654f * (yy + 0.044715f * yy * yy * yy))));
                    }
                }
            }
        }
    }
}

DEV float row16_sum(float v) {
    v += __int_as_float(__builtin_amdgcn_mov_dpp(__float_as_int(v), 0x128, 0xf, 0xf, true));
    v += __int_as_float(__builtin_amdgcn_mov_dpp(__float_as_int(v), 0x124, 0xf, 0xf, true));
    v += __int_as_float(__builtin_amdgcn_mov_dpp(__float_as_int(v), 0x122, 0xf, 0xf, true));
    v += __int_as_float(__builtin_amdgcn_mov_dpp(__float_as_int(v), 0x121, 0xf, 0xf, true));
    return v;
}
DEV float fmul_(float a, float b) { return a * b; }
DEV float fadd_(float a, float b) { return a + b; }
DEV float ffma_(float a, float b, float c) { return __builtin_fmaf(a, b, c); }
DEV float fnma_(float a, float b, float c) { return __builtin_fmaf(-a, b, c); }
DEV float row8_sum(float v) {
    v += __int_as_float(__builtin_amdgcn_mov_dpp(__float_as_int(v), 0x141, 0xf, 0xf, true));
    v += __int_as_float(__builtin_amdgcn_mov_dpp(__float_as_int(v), 0xB1, 0xf, 0xf, true));
    v += __int_as_float(__builtin_amdgcn_mov_dpp(__float_as_int(v), 0x4E, 0xf, 0xf, true));
    return v;
}
DEV float row16_sum1(float v) { v += __int_as_float(__builtin_amdgcn_mov_dpp(__float_as_int(v), 0x128, 0xf, 0xf, true)); return v; }
constexpr int RW_CT = 16;
struct RwRaw { u32x2 r[3], k[3], v[3], sd, a; float fp, fn; };
#ifndef RWVAR
#define RWVAR 0
#endif
template <int var>
DEV void rw_item_t(const Params& p, int l, int item, char* smem, int rep) {
    const int tid = tidx(), li = tid >> 4, lc = tid & 15;
    const int ch = item >> 2, rg = item & 3, dir = ch >> 5, b = (ch >> 2) & 7, head = ch & 3;
    float* buf = (float*)smem;
    float* ybuf = buf + 2 * RW_CT * 384;
    const bf16_t* P = wsb(p, OFF_P);
    const bf16_t* RWX = wsb(p, OFF_RWX);
    bf16_t* RWY = wsb(p, OFF_RWY) + (size_t)dir * TT * 256 + (rep > 0 ? (size_t)2 * TT * 256 : 0);
    const int hc = head * 64 + lc * 4;
    const float4 mur = *(const float4*)(inp(p, I_RMU) + (l * 4 + 0) * 256 + hc);
    const float4 muk = *(const float4*)(inp(p, I_RMU) + (l * 4 + 1) * 256 + hc);
    const float4 muv = *(const float4*)(inp(p, I_RMU) + (l * 4 + 2) * 256 + hc);
    const float4 kk4 = *(const float4*)(inp(p, I_RKK) + l * 256 + hc);
    const float4 ka4 = *(const float4*)(inp(p, I_RKA) + l * 256 + hc);
    const int NCH = (CTXL + SEQ) / RW_CT;
    auto tok_of = [&](int cidx, int i, int& n, int& len) -> int {
        if (cidx < CTXL / RW_CT) { const int pos = cidx * RW_CT + i; len = CTXL; n = dir == 0 ? pos : CTXL - 1 - pos; return TL + b * CTXL + n; }
        const int pos = (cidx - CTXL / RW_CT) * RW_CT + i; len = SEQ; n = dir == 0 ? pos : SEQ - 1 - pos; return b * SEQ + n;
    };
    auto load_raw = [&](int cidx, RwRaw& raw) {
        int n, len; const int t = tok_of(cidx, li, n, len);
        const bf16_t* row = P + (size_t)t * LDP;
        const bool hp = n > 0, hn = n + 1 < len;
        const bf16_t* rp = hp ? row - LDP : row;
        const bf16_t* rn = hn ? row + LDP : row;
        raw.fp = hp ? 0.5f : 0.f; raw.fn = hn ? 0.5f : 0.f;
        raw.r[1] = *(const u32x2*)(row + C_RWR + hc); raw.k[1] = *(const u32x2*)(row + C_RWK + hc); raw.v[1] = *(const u32x2*)(row + C_RWV + hc);
        raw.r[0] = *(const u32x2*)(rp + C_RWR + hc); raw.k[0] = *(const u32x2*)(rp + C_RWK + hc); raw.v[0] = *(const u32x2*)(rp + C_RWV + hc);
        raw.r[2] = *(const u32x2*)(rn + C_RWR + hc); raw.k[2] = *(const u32x2*)(rn + C_RWK + hc); raw.v[2] = *(const u32x2*)(rn + C_RWV + hc);
        raw.sd = *(const u32x2*)(RWX + (size_t)t * 1024 + dir * 256 + hc);
        raw.a = *(const u32x2*)(RWX + (size_t)t * 1024 + 512 + dir * 256 + hc);
    };
    auto mix4 = [&](const u32x2 (&s)[3], const float4& mu, float fp, float fn, float (&o)[4]) {
        { const float x = bflo(s[1].x); o[0] = x + ((fp * bflo(s[0].x) + fn * bflo(s[2].x)) - x) * mu.x; }
        { const float x = bfhi(s[1].x); o[1] = x + ((fp * bfhi(s[0].x) + fn * bfhi(s[2].x)) - x) * mu.y; }
        { const float x = bflo(s[1].y); o[2] = x + ((fp * bflo(s[0].y) + fn * bflo(s[2].y)) - x) * mu.z; }
        { const float x = bfhi(s[1].y); o[3] = x + ((fp * bfhi(s[0].y) + fn * bfhi(s[2].y)) - x) * mu.w; }
    };
    auto stage = [&](int st, const RwRaw& raw) {
        float r4[4], k4[4], v4[4];
        mix4(raw.r, mur, raw.fp, raw.fn, r4); mix4(raw.k, muk, raw.fp, raw.fn, k4); mix4(raw.v, muv, raw.fp, raw.fn, v4);
        const float kkr[4] = { k4[0] * kk4.x, k4[1] * kk4.y, k4[2] * kk4.z, k4[3] * kk4.w };
        float nn = kkr[0] * kkr[0] + kkr[1] * kkr[1] + kkr[2] * kkr[2] + kkr[3] * kkr[3];
        nn = row16_sum(nn);
        const float rn = 1.f / fmaxf(sqrtf(nn), 1e-12f);
        const float a[4] = { bflo(raw.a.x), bfhi(raw.a.x), bflo(raw.a.y), bfhi(raw.a.y) };
        const float sd[4] = { bflo(raw.sd.x), bfhi(raw.sd.x), bflo(raw.sd.y), bfhi(raw.sd.y) };
        const float kav[4] = { ka4.x, ka4.y, ka4.z, ka4.w };
        float* d = buf + (st * RW_CT + li) * 384 + lc * 4;
        float wp[4], kp[4], bp[4], mp[4];
#pragma unroll
        for (int j = 0; j < 4; ++j) {
            wp[j] = __expf(-sd[j]);
            kp[j] = kkr[j] * rn;
            bp[j] = kp[j] * a[j];
            mp[j] = k4[j] * (1.f + (a[j] - 1.f) * kav[j]);
        }
        *(float4*)(d + 0) = make_float4(wp[0], wp[1], wp[2], wp[3]); *(float4*)(d + 64) = make_float4(kp[0], kp[1], kp[2], kp[3]);
        *(float4*)(d + 128) = make_float4(bp[0], bp[1], bp[2], bp[3]); *(float4*)(d + 192) = make_float4(mp[0], mp[1], mp[2], mp[3]);
        *(float4*)(d + 256) = make_float4(r4[0], r4[1], r4[2], r4[3]);
        *(float4*)(d + 320) = make_float4(v4[0], v4[1], v4[2], v4[3]);
    };
    f32x2_ Sa = (f32x2_){0.f, 0.f}, Sb = (f32x2_){0.f, 0.f};
    auto compute = [&](int cidx, int cur, const RwRaw& rs, bool do_stage) {
        float sr4[4], sk4[4], sv4[4], skkr[4], srn = 0.f;
        const float* cb = buf + cur * RW_CT * 384 + lc * 4;
        const float* vb = buf + cur * RW_CT * 384 + 320 + rg * 16 + li;
        const bool yb0 = (lc & 4) == 0, yb1 = (lc & 2) == 0, yb2 = (lc & 1) == 0, yb3 = (lc & 8) == 0;
        float yq0 = 0.f, yq1 = 0.f, yq2 = 0.f, yq3 = 0.f, ykeep = 0.f;
        f32x4 w[2], kk[2], bb[2], km[2], rr[2]; float vv[2];
        w[0] = *(const f32x4*)(cb); kk[0] = *(const f32x4*)(cb + 64); bb[0] = *(const f32x4*)(cb + 128); km[0] = *(const f32x4*)(cb + 192); rr[0] = *(const f32x4*)(cb + 256);
        vv[0] = vb[0];
#pragma unroll
        for (int j = 0; j < RW_CT; ++j) {
            const int c0 = j & 1, c2 = c0 ^ 1;
            if (j + 1 < RW_CT) {
                const float* nb = cb + (j + 1) * 384;
                w[c2] = *(const f32x4*)(nb); kk[c2] = *(const f32x4*)(nb + 64); bb[c2] = *(const f32x4*)(nb + 128); km[c2] = *(const f32x4*)(nb + 192); rr[c2] = *(const f32x4*)(nb + 256);
                vv[c2] = vb[(j + 1) * 384];
            }
            const f32x2_ v2 = (f32x2_){vv[c0], vv[c0]};
            const f32x2_ pa = __builtin_elementwise_fma(Sb, kk[c0].zw, Sa * kk[c0].xy);
            const f32x2_ ta = __builtin_elementwise_fma(Sa, w[c0].xy, v2 * km[c0].xy), tb = __builtin_elementwise_fma(Sb, w[c0].zw, v2 * km[c0].zw);
            const float sa = row16_sum(fadd_(pa.x, pa.y));
            const f32x2_ nsa = (f32x2_){-sa, -sa};
            Sa = __builtin_elementwise_fma(nsa, bb[c0].xy, ta); Sb = __builtin_elementwise_fma(nsa, bb[c0].zw, tb);
            const f32x2_ py = __builtin_elementwise_fma(Sb, rr[c0].zw, Sa * rr[c0].xy);
            {
                float c = fadd_(py.x, py.y);
                if (j & 1) {
                    { const float t = yb0 ? yq0 : c, u = yb0 ? c : yq0; c = t + __int_as_float(__builtin_amdgcn_mov_dpp(__float_as_int(u), 0x141, 0xf, 0xf, true)); }
                    if (j & 2) {
                        { const float t = yb1 ? yq1 : c, u = yb1 ? c : yq1; c = t + __int_as_float(__builtin_amdgcn_mov_dpp(__float_as_int(u), 0x4E, 0xf, 0xf, true)); }
                        if (j & 4) {
                            { const float t = yb2 ? yq2 : c, u = yb2 ? c : yq2; c = t + __int_as_float(__builtin_amdgcn_mov_dpp(__float_as_int(u), 0xB1, 0xf, 0xf, true)); }
                            if (j & 8) {
                                const float t = yb3 ? yq3 : c, u = yb3 ? c : yq3; ykeep = t + __int_as_float(__builtin_amdgcn_mov_dpp(__float_as_int(u), 0x128, 0xf, 0xf, true));
                            } else yq3 = c;
                        } else yq2 = c;
                    } else yq1 = c;
                } else yq0 = c;
            }
            if (j == 2) { mix4(rs.r, mur, rs.fp, rs.fn, sr4); }
            if (j == 5) { mix4(rs.k, muk, rs.fp, rs.fn, sk4); }
            if (j == 8) { mix4(rs.v, muv, rs.fp, rs.fn, sv4); }
            if (j == 11) {
                skkr[0] = sk4[0] * kk4.x; skkr[1] = sk4[1] * kk4.y; skkr[2] = sk4[2] * kk4.z; skkr[3] = sk4[3] * kk4.w;
                float nn = skkr[0] * skkr[0] + skkr[1] * skkr[1] + skkr[2] * skkr[2] + skkr[3] * skkr[3];
                nn = row16_sum(nn);
                srn = 1.f / fmaxf(sqrtf(nn), 1e-12f);
            }
        }
        if (do_stage) {
            const float a[4] = { bflo(rs.a.x), bfhi(rs.a.x), bflo(rs.a.y), bfhi(rs.a.y) };
            const float sd[4] = { bflo(rs.sd.x), bfhi(rs.sd.x), bflo(rs.sd.y), bfhi(rs.sd.y) };
            const float kav[4] = { ka4.x, ka4.y, ka4.z, ka4.w };
            float* d = buf + ((cur ^ 1) * RW_CT + li) * 384 + lc * 4;
            float wp[4], kp[4], bp[4], mp[4];
#pragma unroll
            for (int q = 0; q < 4; ++q) {
                wp[q] = __expf(-sd[q]);
                kp[q] = skkr[q] * srn;
                bp[q] = kp[q] * a[q];
                mp[q] = sk4[q] * (1.f + (a[q] - 1.f) * kav[q]);
            }
            *(float4*)(d + 0) = make_float4(wp[0], wp[1], wp[2], wp[3]); *(float4*)(d + 64) = make_float4(kp[0], kp[1], kp[2], kp[3]);
            *(float4*)(d + 128) = make_float4(bp[0], bp[1], bp[2], bp[3]); *(float4*)(d + 192) = make_float4(mp[0], mp[1], mp[2], mp[3]);
            *(float4*)(d + 256) = make_float4(sr4[0], sr4[1], sr4[2], sr4[3]);
            *(float4*)(d + 320) = make_float4(sv4[0], sv4[1], sv4[2], sv4[3]);
        }
        {
            const int ys = ((lc >> 2) & 1) | (lc & 2) | ((lc & 1) << 2) | (lc & 8);
            int n, len; const int t = tok_of(cidx, ys, n, len);
            RWY[(size_t)t * 256 + head * 64 + rg * 16 + li] = f2bf(ykeep);
        }
    };
    RwRaw rawA, rawB;
    __syncthreads();
    load_raw(0, rawA);
    stage(0, rawA);
    load_raw(1, rawA);
    __syncthreads();
    for (int cidx = 0; cidx < NCH; cidx += 2) {
        load_raw(min(cidx + 2, NCH - 1), rawB);
        compute(cidx, 0, rawA, true);
        __syncthreads();
        load_raw(min(cidx + 3, NCH - 1), rawA);
        compute(cidx + 1, 1, rawB, cidx + 2 < NCH);
        __syncthreads();
    }
}

DEV void rw_item(const Params& p, int l, int item, char* smem, int rep = 0) {
    rw_item_t<RWVAR>(p, l, item, smem, rep);
}
constexpr int RC = 32, SK = 72, ST = 40;
constexpr int L_K1 = 0, L_R1 = L_K1 + RC * SK, L_B1 = L_R1 + RC * SK, L_M1 = L_B1 + RC * SK,
              L_VT = L_M1 + RC * SK, L_B2T = L_VT + 64 * ST, L_M2T = L_B2T + 64 * ST,
              L_X = L_M2T + 64 * ST, L_XT = L_X + RC * ST, L_PA = L_XT + RC * ST, L_BM = L_PA + RC * ST, L_AR = L_BM + RC * ST, L_BR = L_AR + RC * ST,
              L_ET = L_BR + RC * ST, L_ZT = L_ET + 64 * ST, L_S = L_ZT + 64 * ST, L_RWEND = L_S + 64 * SK;
static_assert(L_RWEND * 2 + 256 <= 73728, "RWKV chunk LDS");
DEV bf16x8 ldfrag(const bf16_t* m, int stride, int row0, int k0, int lane) { return *(const bf16x8*)(m + (row0 + (lane & 15)) * stride + k0 + (lane >> 4) * 8); }
DEV f32x4 mfma16(bf16x8 a, bf16x8 b, f32x4 c) { return __builtin_amdgcn_mfma_f32_16x16x32_bf16(a, b, c, 0, 0, 0); }
#ifndef RWC_CLAMP
#define RWC_CLAMP 0
#endif
DEV void st4(bf16_t* dst, f32x4 v) {
    if (RWC_CLAMP) { for (int i = 0; i < 4; ++i) v[i] = fminf(fmaxf(v[i], -8.f), 8.f); } u32x2 o; o.x = pack2(v[0], v[1]); o.y = pack2(v[2], v[3]); *(u32x2*)dst = o; }
DEV void unpack8(const u32x4 u, float (&o)[8]) {
    o[0] = bflo(u[0]); o[1] = bfhi(u[0]); o[2] = bflo(u[1]); o[3] = bfhi(u[1]); o[4] = bflo(u[2]); o[5] = bfhi(u[2]); o[6] = bflo(u[3]); o[7] = bfhi(u[3]);
}
DEV u32x4 pack8(const float (&v)[8]) { return (u32x4){pack2(v[0], v[1]), pack2(v[2], v[3]), pack2(v[4], v[5]), pack2(v[6], v[7])}; }
struct RwcRaw { u32x4 r[3], k[3], v[3], sd, a; float fp, fn; };
#ifndef RWC_STOP
#define RWC_STOP 99
#endif
#ifndef RWC_DUMMY
#define RWC_DUMMY 0
#endif
#ifdef RWC_NOINLINE
__device__ __attribute__((noinline)) void rwc_item(const Params& p, int l, int chain, char* smem) {
#else
DEV void rwc_item(const Params& p, int l, int chain, char* smem) {
#endif
    const int tid = tidx(), lane = tid & 63, wave = __builtin_amdgcn_readfirstlane(tid >> 6), c16 = lane & 15, q4 = lane >> 4;
    const int dir = chain >> 5, b = (chain >> 2) & 7, head = chain & 3;
    bf16_t* L = (bf16_t*)smem;
    float* PC = (float*)(smem + L_RWEND * 2);
    float* CS = (float*)(L + L_ET);
    const bf16_t* P = wsb(p, OFF_P);
    const bf16_t* RWX = wsb(p, OFF_RWX);
    bf16_t* RWY = wsb(p, OFF_RWY) + (size_t)dir * TT * 256 + (RWC_DUMMY ? (size_t)2 * TT * 256 : 0);
    const int li = tid >> 3, c8 = (tid & 7) * 8, hc = head * 64 + c8;
    const int NCHK = (CTXL + SEQ) / RC;
    auto tok_of = [&](int c, int i, int& n, int& len) -> int {
        if (c < CTXL / RC) { const int pos = c * RC + i; len = CTXL; n = dir == 0 ? pos : CTXL - 1 - pos; return TL + b * CTXL + n; }
        const int pos = (c - CTXL / RC) * RC + i; len = SEQ; n = dir == 0 ? pos : SEQ - 1 - pos; return b * SEQ + n;
    };
    RwcRaw raw;
    auto load_raw = [&](int c) {
        int n, len; const int t = tok_of(c, li, n, len);
        const bf16_t* row = P + (size_t)t * LDP;
        const bool hp = n > 0, hn = n + 1 < len;
        const bf16_t* rp = hp ? row - LDP : row;
        const bf16_t* rn = hn ? row + LDP : row;
        raw.fp = hp ? 0.5f : 0.f; raw.fn = hn ? 0.5f : 0.f;
        raw.r[1] = *(const u32x4*)(row + C_RWR + hc); raw.k[1] = *(const u32x4*)(row + C_RWK + hc); raw.v[1] = *(const u32x4*)(row + C_RWV + hc);
        raw.r[0] = *(const u32x4*)(rp + C_RWR + hc); raw.k[0] = *(const u32x4*)(rp + C_RWK + hc); raw.v[0] = *(const u32x4*)(rp + C_RWV + hc);
        raw.r[2] = *(const u32x4*)(rn + C_RWR + hc); raw.k[2] = *(const u32x4*)(rn + C_RWK + hc); raw.v[2] = *(const u32x4*)(rn + C_RWV + hc);
        raw.sd = *(const u32x4*)(RWX + (size_t)t * 1024 + dir * 256 + hc);
        raw.a = *(const u32x4*)(RWX + (size_t)t * 1024 + 512 + dir * 256 + hc);
    };
    auto mix8 = [&](const u32x4 (&s)[3], const float* mu, float (&o)[8]) {
        float x[8], pv[8], nx[8]; unpack8(s[1], x); unpack8(s[0], pv); unpack8(s[2], nx);
        const float4 m0 = *(const float4*)mu, m1 = *(const float4*)(mu + 4);
        const float m[8] = { m0.x, m0.y, m0.z, m0.w, m1.x, m1.y, m1.z, m1.w };
#pragma unroll
        for (int j = 0; j < 8; ++j) o[j] = x[j] + ((raw.fp * pv[j] + raw.fn * nx[j]) - x[j]) * m[j];
    };
    f32x4 Wt[4];
#pragma unroll
    for (int j = 0; j < 4; ++j) Wt[j] = (f32x4){0.f, 0.f, 0.f, 0.f};
    __syncthreads();
    for (int i = tid; i < 64 * SK / 2; i += NT) ((unsigned*)(L + L_S))[i] = 0u;
    load_raw(0);
    for (int c = 0; c < (RWC_STOP == 0 ? 0 : NCHK); ++c) {
        {
            float r8[8], k8[8], v8[8], a8[8], sd8[8];
            mix8(raw.r, inp(p, I_RMU) + (l * 4 + 0) * 256 + hc, r8);
            mix8(raw.k, inp(p, I_RMU) + (l * 4 + 1) * 256 + hc, k8);
            mix8(raw.v, inp(p, I_RMU) + (l * 4 + 2) * 256 + hc, v8);
            unpack8(raw.a, a8); unpack8(raw.sd, sd8);
            if (c + 1 < NCHK) load_raw(c + 1);
            const float4 kk0 = *(const float4*)(inp(p, I_RKK) + l * 256 + hc), kk1 = *(const float4*)(inp(p, I_RKK) + l * 256 + hc + 4);
            const float4 ka0 = *(const float4*)(inp(p, I_RKA) + l * 256 + hc), ka1 = *(const float4*)(inp(p, I_RKA) + l * 256 + hc + 4);
            const float kkc[8] = { kk0.x, kk0.y, kk0.z, kk0.w, kk1.x, kk1.y, kk1.z, kk1.w };
            const float kac[8] = { ka0.x, ka0.y, ka0.z, ka0.w, ka1.x, ka1.y, ka1.z, ka1.w };
            float kkv[8], bbv[8], kmv[8]; float n2 = 0.f;
#pragma unroll
            for (int j = 0; j < 8; ++j) { kkv[j] = k8[j] * kkc[j]; n2 += kkv[j] * kkv[j]; }
            n2 = row8_sum(n2);
            const float rn = 1.f / fmaxf(sqrtf(n2), 1e-12f);
#pragma unroll
            for (int j = 0; j < 8; ++j) { kkv[j] *= rn; bbv[j] = kkv[j] * a8[j]; kmv[j] = k8[j] * (1.f + (a8[j] - 1.f) * kac[j]); }
            *(float4*)(CS + li * 64 + c8) = make_float4(sd8[0], sd8[1], sd8[2], sd8[3]);
            *(float4*)(CS + li * 64 + c8 + 4) = make_float4(sd8[4], sd8[5], sd8[6], sd8[7]);
            __syncthreads();
            if (tid < 64) { float run = 0.f; for (int i = 0; i < RC; ++i) { run += CS[i * 64 + tid]; CS[i * 64 + tid] = run; } }
            __syncthreads();
            float cs[8], tot[8];
            { const float4 a0 = *(const float4*)(CS + li * 64 + c8), a1 = *(const float4*)(CS + li * 64 + c8 + 4);
              const float4 t0 = *(const float4*)(CS + (RC - 1) * 64 + c8), t1 = *(const float4*)(CS + (RC - 1) * 64 + c8 + 4);
              cs[0] = a0.x; cs[1] = a0.y; cs[2] = a0.z; cs[3] = a0.w; cs[4] = a1.x; cs[5] = a1.y; cs[6] = a1.z; cs[7] = a1.w;
              tot[0] = t0.x; tot[1] = t0.y; tot[2] = t0.z; tot[3] = t0.w; tot[4] = t1.x; tot[5] = t1.y; tot[6] = t1.z; tot[7] = t1.w; }
            float k1[8], r1[8], b1[8], m1[8], b2[8], m2[8];
#pragma unroll
            for (int j = 0; j < 8; ++j) {
                const float pinc = __expf(-cs[j]), pexc = __expf(sd8[j] - cs[j]), einv = __expf(cs[j]), ec = __expf(cs[j] - tot[j]);
                k1[j] = kkv[j] * pexc; r1[j] = r8[j] * pinc; b1[j] = bbv[j] * einv; m1[j] = kmv[j] * einv; b2[j] = bbv[j] * ec; m2[j] = kmv[j] * ec;
            }
            __syncthreads();
            *(u32x4*)(L + L_K1 + li * SK + c8) = pack8(k1); *(u32x4*)(L + L_R1 + li * SK + c8) = pack8(r1);
            *(u32x4*)(L + L_B1 + li * SK + c8) = pack8(b1); *(u32x4*)(L + L_M1 + li * SK + c8) = pack8(m1);
#pragma unroll
            for (int j = 0; j < 8; ++j) {
                L[L_VT + (c8 + j) * ST + li] = f2bf(v8[j]); L[L_B2T + (c8 + j) * ST + li] = f2bf(b2[j]); L[L_M2T + (c8 + j) * ST + li] = f2bf(m2[j]);
            }
            if (li == RC - 1) {
#pragma unroll
                for (int j = 0; j < 8; ++j) PC[c8 + j] = __expf(-tot[j]);
            }
            __syncthreads();
        }
        if (RWC_STOP <= 1) continue;
        {
            const int i0 = wave >> 1, j0 = wave & 1;
            const f32x4 z4 = (f32x4){0.f, 0.f, 0.f, 0.f};
            f32x4 aS = z4, aU = z4, bm = z4, ar = z4, br = z4;
#pragma unroll
            for (int kk2 = 0; kk2 < 2; ++kk2) {
                const bf16x8 k1i = ldfrag(L + L_K1, SK, i0 * 16, kk2 * 32, lane), k1j = ldfrag(L + L_K1, SK, j0 * 16, kk2 * 32, lane);
                const bf16x8 b1i = ldfrag(L + L_B1, SK, i0 * 16, kk2 * 32, lane), b1j = ldfrag(L + L_B1, SK, j0 * 16, kk2 * 32, lane);
                const bf16x8 m1i = ldfrag(L + L_M1, SK, i0 * 16, kk2 * 32, lane), r1j = ldfrag(L + L_R1, SK, j0 * 16, kk2 * 32, lane);
                aS = mfma16(b1i, k1j, aS);
                aU = mfma16(k1i, b1j, aU);
                bm = mfma16(m1i, k1j, bm);
                ar = mfma16(b1i, r1j, ar);
                br = mfma16(m1i, r1j, br);
            }
#ifdef RWC_WAIT
            __builtin_amdgcn_sched_barrier(0); __builtin_amdgcn_s_sleep(2); __builtin_amdgcn_sched_barrier(0);
#endif
            {
                const int t = j0 * 16 + c16, s0 = i0 * 16 + q4 * 4;
                f32x4 x, pa, o1, o2, o3;
#pragma unroll
                for (int r = 0; r < 4; ++r) {
                    const bool lt = s0 + r < t, le = s0 + r <= t;
                    x[r] = lt ? -aS[r] : 0.f; pa[r] = x[r] + ((s0 + r == t) ? 1.f : 0.f);
                    o1[r] = lt ? bm[r] : 0.f; o2[r] = le ? ar[r] : 0.f; o3[r] = le ? br[r] : 0.f;
                }
#ifdef RWC_GSTORE
                { bf16_t* gd = wsb(p, OFF_RWY) + (size_t)2 * TT * 256 + (size_t)(bidx() * 256 + tid) * 32;
                  st4(gd, x); st4(gd + 4, pa); st4(gd + 8, o1); st4(gd + 12, o2); st4(gd + 16, o3); }
#else
                st4(L + L_X + t * ST + s0, x); st4(L + L_PA + t * ST + s0, pa);
                st4(L + L_BM + t * ST + s0, o1); st4(L + L_AR + t * ST + s0, o2); st4(L + L_BR + t * ST + s0, o3);
#endif
            }
            {
                const int s = j0 * 16 + c16, t0 = i0 * 16 + q4 * 4;
                f32x4 o;
#pragma unroll
                for (int r = 0; r < 4; ++r) o[r] = (s < t0 + r) ? -aU[r] : 0.f;
#ifdef RWC_GSTORE
                st4(wsb(p, OFF_RWY) + (size_t)2 * TT * 256 + (size_t)(bidx() * 256 + tid) * 32 + 20, o);
#else
                st4(L + L_XT + s * ST + t0, o);
#endif
            }
            __syncthreads();
        }
        if (RWC_STOP <= 2) continue;
#pragma unroll 1
        for (int rd = 1; rd <= 5; ++rd) {
            const bool sq = rd <= 4, up = rd >= 2;
            const int i0 = wave >> 1, j0 = wave & 1;
            const bf16x8 xti = ldfrag(L + L_XT, ST, i0 * 16, 0, lane), xtj = ldfrag(L + L_XT, ST, j0 * 16, 0, lane);
            const bf16x8 xi = ldfrag(L + L_X, ST, i0 * 16, 0, lane), xj = ldfrag(L + L_X, ST, j0 * 16, 0, lane);
            const bf16x8 paj = ldfrag(L + L_PA, ST, j0 * 16, 0, lane);
            const u32x2 old = *(const u32x2*)(L + L_PA + (j0 * 16 + c16) * ST + i0 * 16 + q4 * 4);
            __syncthreads();
            const f32x4 z4 = (f32x4){0.f, 0.f, 0.f, 0.f};
            if (sq) {
                const f32x4 nx = mfma16(xti, xj, z4);
                const f32x4 nxt = mfma16(xi, xtj, z4);
                st4(L + L_X + (j0 * 16 + c16) * ST + i0 * 16 + q4 * 4, nx);
                st4(L + L_XT + (j0 * 16 + c16) * ST + i0 * 16 + q4 * 4, nxt);
            }
            if (up) {
                f32x4 acc = (f32x4){bflo(old.x), bfhi(old.x), bflo(old.y), bfhi(old.y)};
                acc = mfma16(xti, paj, acc);
                st4(L + L_PA + (j0 * 16 + c16) * ST + i0 * 16 + q4 * 4, acc);
            }
            __syncthreads();
        }
        if (RWC_STOP <= 3) continue;
        {
            const int vj = wave;
#pragma unroll
            for (int ti = 0; ti < 2; ++ti) {
                f32x4 acc = mfma16(ldfrag(L + L_BM, ST, ti * 16, 0, lane), ldfrag(L + L_VT, ST, vj * 16, 0, lane), (f32x4){0.f, 0.f, 0.f, 0.f});
#pragma unroll
                for (int kk2 = 0; kk2 < 2; ++kk2) acc = mfma16(ldfrag(L + L_K1, SK, ti * 16, kk2 * 32, lane), ldfrag(L + L_S, SK, vj * 16, kk2 * 32, lane), acc);
                st4(L + L_ET + (vj * 16 + c16) * ST + ti * 16 + q4 * 4, acc);
            }
            __syncthreads();
#pragma unroll
            for (int ti = 0; ti < 2; ++ti) {
                const f32x4 acc = mfma16(ldfrag(L + L_PA, ST, ti * 16, 0, lane), ldfrag(L + L_ET, ST, vj * 16, 0, lane), (f32x4){0.f, 0.f, 0.f, 0.f});
                st4(L + L_ZT + (vj * 16 + c16) * ST + ti * 16 + q4 * 4, -acc);
            }
            __syncthreads();
        }
        if (RWC_STOP <= 4) continue;
        {
            const int vi = wave;
#pragma unroll
            for (int tj = 0; tj < 2; ++tj) {
                f32x4 acc = (f32x4){0.f, 0.f, 0.f, 0.f};
#pragma unroll
                for (int kk2 = 0; kk2 < 2; ++kk2) acc = mfma16(ldfrag(L + L_S, SK, vi * 16, kk2 * 32, lane), ldfrag(L + L_R1, SK, tj * 16, kk2 * 32, lane), acc);
                acc = mfma16(ldfrag(L + L_ZT, ST, vi * 16, 0, lane), ldfrag(L + L_AR, ST, tj * 16, 0, lane), acc);
                acc = mfma16(ldfrag(L + L_VT, ST, vi * 16, 0, lane), ldfrag(L + L_BR, ST, tj * 16, 0, lane), acc);
                int n, len; const int t = tok_of(c, tj * 16 + c16, n, len);
                u32x2 o; o.x = pack2(acc[0], acc[1]); o.y = pack2(acc[2], acc[3]);
#ifndef RWC_NOYSTORE
                *(u32x2*)(RWY + (size_t)t * 256 + head * 64 + vi * 16 + q4 * 4) = o;
#else
                asm volatile("" :: "v"(o), "v"(t));
#endif
            }
            const float4 pc = *(const float4*)(PC + wave * 16 + q4 * 4);
            const bf16x8 fb2 = ldfrag(L + L_B2T, ST, wave * 16, 0, lane), fm2 = ldfrag(L + L_M2T, ST, wave * 16, 0, lane);
#pragma unroll
            for (int vj = 0; vj < 4; ++vj) {
                f32x4 acc = Wt[vj];
                acc[0] *= pc.x; acc[1] *= pc.y; acc[2] *= pc.z; acc[3] *= pc.w;
                acc = mfma16(fb2, ldfrag(L + L_ZT, ST, vj * 16, 0, lane), acc);
                acc = mfma16(fm2, ldfrag(L + L_VT, ST, vj * 16, 0, lane), acc);
                Wt[vj] = acc;
            }
            __syncthreads();
#pragma unroll
            for (int vj = 0; vj < 4; ++vj) st4(L + L_S + (vj * 16 + c16) * SK + wave * 16 + q4 * 4, Wt[vj]);
        }
    }
    __syncthreads();
#ifdef RWC_ZERO_LDS
    for (int i = tid; i < 73728 / 4; i += NT) ((unsigned*)smem)[i] = 0u;
    __syncthreads();
#endif
}
DEV void phase_s5_glu(const Params& p, int l, int M, char* smem) {
    const bf16_t* P = wsb(p, OFF_P);
    const bf16_t* w = wsb(p, OFF_WSM) + (size_t)l * WS_PER_LAYER + WS_GLUT;
    bf16_t* Y = wsb(p, OFF_Y);
    const float* bg = inp(p, I_S5BGLU) + l * 256;
    gemm_generic(P + C_S5, LDP, M, w, 256, 256, 256,
                 [&](int r, int c, float v) { const float z = bf2f(P[(size_t)r * LDP + C_S5 + c]); Y[(size_t)r * 1024 + 256 + c] = f2bf(z * sigmoidf_(v + bg[c])); }, smem, 0);
}
DEV void phase_rw_finish(const Params& p, int l, int M) {
    const int lane = tidx() & 63, wave = tidx() >> 6;
    const bf16_t* P = wsb(p, OFF_P);
    const bf16_t* RWX = wsb(p, OFF_RWX);
    const bf16_t* RWY = wsb(p, OFF_RWY);
    bf16_t* Y = wsb(p, OFF_Y);
    const int c = lane * 4;
    const float4 mur = *(const float4*)(inp(p, I_RMU) + (l * 4 + 0) * 256 + c);
    const float4 muk = *(const float4*)(inp(p, I_RMU) + (l * 4 + 1) * 256 + c);
    const float4 muv = *(const float4*)(inp(p, I_RMU) + (l * 4 + 2) * 256 + c);
    const float4 ka4 = *(const float4*)(inp(p, I_RKA) + l * 256 + c);
    const float4 rk4 = *(const float4*)(inp(p, I_RRK) + l * 256 + c);
    const float4 lg4 = *(const float4*)(inp(p, I_RLNG) + l * 256 + c);
    const float4 lb4 = *(const float4*)(inp(p, I_RLNB) + l * 256 + c);
    const float mr_[4] = { mur.x, mur.y, mur.z, mur.w }, mk_[4] = { muk.x, muk.y, muk.z, muk.w }, mv_[4] = { muv.x, muv.y, muv.z, muv.w };
    const float ka_[4] = { ka4.x, ka4.y, ka4.z, ka4.w }, rk_[4] = { rk4.x, rk4.y, rk4.z, rk4.w }, lg_[4] = { lg4.x, lg4.y, lg4.z, lg4.w }, lb_[4] = { lb4.x, lb4.y, lb4.z, lb4.w };
    for (int t = bidx() * 4 + wave; t < M; t += gridDim.x * 4) {
        int base, n, len; tok_seq(t, base, n, len);
        const bf16_t* row = P + (size_t)t * LDP;
        const bool hp = n > 0, hn = n + 1 < len;
        const u32x2 z = (u32x2){0u, 0u};
        float r4[4], k4[4], v4[4];
        {
            const u32x2 cu = *(const u32x2*)(row + C_RWR + c), pv = hp ? *(const u32x2*)(row - LDP + C_RWR + c) : z, nx = hn ? *(const u32x2*)(row + LDP + C_RWR + c) : z;
            const float x[4] = { bflo(cu.x), bfhi(cu.x), bflo(cu.y), bfhi(cu.y) }, a[4] = { bflo(pv.x), bfhi(pv.x), bflo(pv.y), bfhi(pv.y) }, b[4] = { bflo(nx.x), bfhi(nx.x), bflo(nx.y), bfhi(nx.y) };
#pragma unroll
            for (int j = 0; j < 4; ++j) r4[j] = x[j] + (0.5f * (a[j] + b[j]) - x[j]) * mr_[j];
        }
        {
            const u32x2 cu = *(const u32x2*)(row + C_RWK + c), pv = hp ? *(const u32x2*)(row - LDP + C_RWK + c) : z, nx = hn ? *(const u32x2*)(row + LDP + C_RWK + c) : z;
            const float x[4] = { bflo(cu.x), bfhi(cu.x), bflo(cu.y), bfhi(cu.y) }, a[4] = { bflo(pv.x), bfhi(pv.x), bflo(pv.y), bfhi(pv.y) }, b[4] = { bflo(nx.x), bfhi(nx.x), bflo(nx.y), bfhi(nx.y) };
#pragma unroll
            for (int j = 0; j < 4; ++j) k4[j] = x[j] + (0.5f * (a[j] + b[j]) - x[j]) * mk_[j];
        }
        {
            const u32x2 cu = *(const u32x2*)(row + C_RWV + c), pv = hp ? *(const u32x2*)(row - LDP + C_RWV + c) : z, nx = hn ? *(const u32x2*)(row + LDP + C_RWV + c) : z;
            const float x[4] = { bflo(cu.x), bfhi(cu.x), bflo(cu.y), bfhi(cu.y) }, a[4] = { bflo(pv.x), bfhi(pv.x), bflo(pv.y), bfhi(pv.y) }, b[4] = { bflo(nx.x), bfhi(nx.x), bflo(nx.y), bfhi(nx.y) };
#pragma unroll
            for (int j = 0; j < 4; ++j) v4[j] = x[j] + (0.5f * (a[j] + b[j]) - x[j]) * mv_[j];
        }
        const u32x2 af = *(const u32x2*)(RWX + (size_t)t * 1024 + 512 + c), ab = *(const u32x2*)(RWX + (size_t)t * 1024 + 768 + c);
        const float a0[4] = { bflo(af.x), bfhi(af.x), bflo(af.y), bfhi(af.y) }, a1[4] = { bflo(ab.x), bfhi(ab.x), bflo(ab.y), bfhi(ab.y) };
        const u32x2 yf = *(const u32x2*)(RWY + (size_t)t * 256 + c), yb = *(const u32x2*)(RWY + (size_t)TT * 256 + (size_t)t * 256 + c);
        float y[4] = { bflo(yf.x) + bflo(yb.x), bfhi(yf.x) + bfhi(yb.x), bflo(yf.y) + bflo(yb.y), bfhi(yf.y) + bfhi(yb.y) };
        float s = y[0] + y[1] + y[2] + y[3];
        s = group_sum<16>(s);
        const float mean = s * (1.f / 64.f);
        float q = 0.f, bon = 0.f;
#pragma unroll
        for (int j = 0; j < 4; ++j) {
            const float dlt = y[j] - mean; q += dlt * dlt;
            const float kmsum = k4[j] * (2.f + (a0[j] + a1[j] - 2.f) * ka_[j]);
            bon += r4[j] * kmsum * rk_[j];
        }
        q = group_sum<16>(q); bon = group_sum<16>(bon);
        const float rstd = rsqrtf(q * (1.f / 64.f) + 64e-5f);
        const u32x2 gg = *(const u32x2*)(row + C_RWD + c);
        const float g[4] = { bflo(gg.x), bfhi(gg.x), bflo(gg.y), bfhi(gg.y) };
        float o[4];
#pragma unroll
        for (int j = 0; j < 4; ++j) o[j] = ((y[j] - mean) * rstd * lg_[j] + lb_[j] + bon * v4[j]) * g[j];
        u32x2 ov; ov.x = pack2(o[0], o[1]); ov.y = pack2(o[2], o[3]);
        *(u32x2*)(Y + (size_t)t * 1024 + 768 + c) = ov;
    }
}

DEV int queue_next(int* ctr, char* smem) {
    int* slot = (int*)(smem + MOE_MAP_OFF + 208);
    __syncthreads();
    if (tidx() == 0) *slot = atomicAdd(ctr, 1);
    __syncthreads();
    return __builtin_amdgcn_readfirstlane(*slot);
}
DEV void phase_mixers(const Params& p, int l, int rep, char* smem) {
    const bool need_ctx = (l == 0);
#ifndef RWMODE
#define RWMODE 2
#endif
    const int nrw = RWMODE == 0 ? 64 : (RWMODE == 1 ? 256 + 64 : 256), nda = need_ctx ? 576 : 512, ns5 = 32 * (need_ctx ? 9 : 8);
    const int total = nrw + 2 * nda + (rep == 0 ? ns5 : 0);
    int* ctr = (int*)(wsp(p) + OFF_CTR) + CTR_Q + l * 16 + rep * 4;
    for (;;) {
        const int item = queue_next(ctr, smem);
        if (item >= total) break;
#ifndef PROBE7
#define PROBE7 0
#endif
        if (rep > 0 && PROBE7 == 1 && item >= nrw) break;
        if (rep > 0 && PROBE7 == 2 && item < nrw) continue;
        if (rep > 0 && PROBE7 == 3 && (item < nrw || item >= nrw + nda)) continue;
#if RWMODE == 2
        if (item < nrw) rw_item(p, l, item, smem, 0);
#elif RWMODE == 0
        if (item < nrw) rwc_item(p, l, item, smem);
#else
        if (item < nrw) { if (item < 256) rw_item(p, l, item, smem, 0); else rwc_item(p, l, item - 256, smem); }
#endif
        else if (item < nrw + nda) da_item(p, l, item - nrw, smem);
        else if (item < nrw + 2 * nda) mla_item(p, l, item - nrw - nda, smem);
        else s5_pass2_item(p, l, need_ctx ? 0 : 1, item - nrw - 2 * nda, smem);
    }
}
#ifndef MEGA
#define MEGA 0
#endif
constexpr int NPHASE = 15;
template <int PH>
DEV void run_phase(const Params& p, int l, char* smem) {
    asm volatile("" : "+s"(l));
    const bool need_ctx = (l == 0);
    const int M = need_ctx ? TT : TL;
    if constexpr (PH == 0) { phase_mod_partial(p, smem); __syncthreads(); phase_conv_small(p, smem); phase_conv_layer(p, 0, smem); phase_conv_experts(p, 0, smem); }
    if constexpr (PH == 1) { phase_mod_reduce(p); }
    if constexpr (PH == 2) { phase_norm<1>(p, l, TT, smem, l == 1); if (l == 1) { phase_conv_layer(p, 1, smem); phase_conv_experts(p, 1, smem); } }
    if constexpr (PH == 3) { phase_inproj(p, l, smem); }
    if constexpr (PH == 4) { phase_prep1(p, l); phase_s5_pass1(p, l, smem); }
    if constexpr (PH == 5) { phase_prep_gemm1(p, l, smem); }
    if constexpr (PH == 6) { phase_prep_gemm2(p, l, smem); phase_prep2(p, l); }
    if constexpr (PH == 7) { phase_mixers(p, l, 0, smem); }
    if constexpr (PH == 8) { phase_s5_glu(p, l, M, smem); phase_rw_finish(p, l, M); }
    if constexpr (PH == 9) { phase_merge(p, l, M, smem); }
    if constexpr (PH == 10) { phase_outproj(p, l, M, smem); }
    if constexpr (PH == 11) { phase_norm<2>(p, l, M, smem); }
    if constexpr (PH == 14) { phase_route(p, l, M, smem); }
    if constexpr (PH == 15) { phase_combine(p, l, M); }
    if constexpr (PH == 12) { phase_moe1(p, l, smem); }
    if constexpr (PH == 13) { phase_moe2(p, l, smem); }
}

#if !MEGA
template <int PH>
__global__ void __launch_bounds__(NT, 2) k_phase(Params p, int l) {
    extern __shared__ __attribute__((aligned(16))) char smem[];
    run_phase<PH>(p, l, smem);
}
#endif
#ifndef REP0
#define REP0 1
#endif
#ifndef REP2
#define REP2 1
#endif
#ifndef REP3
#define REP3 1
#endif
#ifndef REP5
#define REP5 1
#endif
#ifndef REP6
#define REP6 1
#endif
#ifndef REP7
#define REP7 1
#endif
#ifndef REP8
#define REP8 1
#endif
#ifndef REP9
#define REP9 1
#endif
#ifndef REP12
#define REP12 1
#endif
#if MEGA
__global__ void __launch_bounds__(NT, 2) k_mega(Params p) {
    extern __shared__ __attribute__((aligned(16))) char smem[];
    uint4* xbw = (uint4*)(smem + MOE_MAP_OFF + 240);
    if (threadIdx.x == 0) *xbw = make_uint4(0u, 0u, 0u, 0u);
    __syncthreads();
    XcdBarrier bar = xcd_barrier_post((unsigned*)(p.ws + OFF_BAR), (volatile LAS unsigned*)xbw);
    for (int r = 0; r < REP0; ++r) { run_phase<0>(p, 0, smem); xcd_barrier(bar); }
    run_phase<1>(p, 0, smem); xcd_barrier(bar);
    for (int l = 0; l < 2; ++l) {
        for (int r = 0; r < REP2; ++r) { run_phase<2>(p, l, smem); xcd_barrier(bar); }
        for (int r = 0; r < REP3; ++r) { run_phase<3>(p, l, smem); xcd_barrier(bar); }

        run_phase<4>(p, l, smem); xcd_barrier(bar);
#ifdef PROBE_S5P1
        phase_s5_pass1(p, l, smem); xcd_barrier(bar);
#endif
#ifdef PROBE_BAR
        for (int r = 0; r < PROBE_BAR; ++r) xcd_barrier(bar);
#endif
        for (int r = 0; r < REP5; ++r) { run_phase<5>(p, l, smem); xcd_barrier(bar); }
        for (int r = 0; r < REP6; ++r) { run_phase<6>(p, l, smem); xcd_barrier(bar); }
#ifdef RWC_PRE
        if (bidx() < 64) rwc_item(p, l, bidx(), smem);
#endif
        for (int r = 0; r < REP7; ++r) { int l7 = l; asm volatile("" : "+s"(l7)); phase_mixers(p, l7, r, smem); xcd_barrier(bar); }
#ifdef RWC_SEP
        for (int item = bidx(); item < 64; item += gridDim.x) rwc_item(p, l, item, smem);
        xcd_barrier(bar);
#endif
        for (int r = 0; r < REP8; ++r) { run_phase<8>(p, l, smem); xcd_barrier(bar); }
        for (int r = 0; r < REP9; ++r) { run_phase<9>(p, l, smem); xcd_barrier(bar); }
        run_phase<10>(p, l, smem); xcd_barrier(bar);
#ifdef PROBE_OUT2
        if (l == 0) { run_phase<10>(p, l, smem); xcd_barrier(bar); }
#endif

        run_phase<11>(p, l, smem); xcd_barrier(bar);
        run_phase<14>(p, l, smem); xcd_barrier(bar);
        for (int r = 0; r < REP12; ++r) { run_phase<12>(p, l, smem); xcd_barrier(bar); }
        run_phase<13>(p, l, smem); xcd_barrier(bar);
#ifdef PROBE_MOE2B
        run_phase<13>(p, l, smem); xcd_barrier(bar);
#endif
        if (l == 1) run_phase<15>(p, l, smem);
    }
}
#endif
__global__ void __launch_bounds__(NT) k_fail(float* out, int n) {
    for (int i = blockIdx.x * NT + threadIdx.x; i < n; i += gridDim.x * NT) out[i] = __int_as_float(0x7fc00000);
}

template <int PH>
static void launch_phase(const Params& p, int l, int grid, hipStream_t stream) {
#if !MEGA
    static bool attr = false;
    if (!attr) { (void)hipFuncSetAttribute((const void*)k_phase<PH>, hipFuncAttributeMaxDynamicSharedMemorySize, SMEM_BYTES); attr = true; }
    hipLaunchKernelGGL(k_phase<PH>, dim3(grid), dim3(NT), SMEM_BYTES, stream, p, l);
#endif
}

extern "C" void kernel_launch(void* const* d_in, const int* in_sizes, int n_in, void* d_out, int out_size, void* d_ws, size_t ws_size, hipStream_t stream) {
    if (n_in != 48 || out_size != TL * DM || ws_size < WS_END) {
        hipLaunchKernelGGL(k_fail, dim3(256), dim3(NT), 0, stream, (float*)d_out, out_size);
        return;
    }
    Params p{};
    for (int i = 0; i < 48; ++i) p.in[i] = (const float*)d_in[i];
    p.out = (float*)d_out; p.ws = (char*)d_ws;
    (void)hipMemsetAsync(d_ws, 0, ZERO_BYTES, stream);
#if MEGA
    static int grid = 0;
    if (grid == 0) {
        int dev = 0, cus = 0, per_cu = 0;
        (void)hipGetDevice(&dev);
        (void)hipDeviceGetAttribute(&cus, hipDeviceAttributeMultiprocessorCount, dev);
        (void)hipFuncSetAttribute((const void*)k_mega, hipFuncAttributeMaxDynamicSharedMemorySize, SMEM_BYTES);
        if (hipOccupancyMaxActiveBlocksPerMultiprocessor(&per_cu, (const void*)k_mega, NT, SMEM_BYTES) != hipSuccess || per_cu < 1) per_cu = 1;
        (void)hipGetLastError();
        if (cus <= 0) cus = 256;
        grid = cus * (per_cu < 2 ? per_cu : 2);
    }
    hipLaunchKernelGGL(k_mega, dim3(grid), dim3(NT), SMEM_BYTES, stream, p);
#else
    const int grid = 512;
    launch_phase<0>(p, 0, grid, stream);
    launch_phase<1>(p, 0, grid, stream);
    for (int l = 0; l < 2; ++l) {
        launch_phase<2>(p, l, grid, stream);
        launch_phase<3>(p, l, grid, stream);
        launch_phase<4>(p, l, grid, stream);
        launch_phase<5>(p, l, grid, stream);
        launch_phase<6>(p, l, grid, stream);
        launch_phase<7>(p, l, grid, stream);
        launch_phase<8>(p, l, grid, stream);
        launch_phase<9>(p, l, grid, stream);
        launch_phase<10>(p, l, grid, stream);
        launch_phase<11>(p, l, grid, stream);
        launch_phase<14>(p, l, grid, stream);
        launch_phase<12>(p, l, grid, stream);
        launch_phase<13>(p, l, grid, stream);
        launch_phase<15>(p, l, grid, stream);
    }
#endif
}
```

```cpp
#define MEGA 1
#include <hip/hip_runtime.h>
#include <stdint.h>
#include <math.h>

#define DEV __device__ __forceinline__
#define LAS __attribute__((address_space(3)))
typedef unsigned short bf16_t;
typedef short bf16x8 __attribute__((ext_vector_type(8)));
typedef float f32x16 __attribute__((ext_vector_type(16)));
typedef float f32x4 __attribute__((ext_vector_type(4)));
typedef unsigned u32x4 __attribute__((ext_vector_type(4)));
typedef unsigned u32x2 __attribute__((ext_vector_type(2)));

constexpr int NT = 256;
constexpr int DM = 1024, NB = 8, SEQ = 2048, CTXL = 256, GRIDW = 64;
constexpr int TL = NB * SEQ, TC = NB * CTXL, TT = TL + TC;
constexpr int NIN = 6480, LDP = 2432, NINP = 6528, NGATE0 = 2432;
constexpr int C_DAQ = 0, C_DAK = 256, C_DAV = 512, C_S5 = 768, C_CQ = 1024, C_CKV = 1216, C_KR = 1344,
              C_RWR = 1360, C_RWK = 1616, C_RWV = 1872, C_RWD = 2128, C_PEND = 2384;
constexpr int NEXP = 16, DFF = 512;
constexpr float EPS = 1e-6f;
constexpr float LOG2E = 1.4426950408889634f;

constexpr size_t al256(size_t x) { return (x + 255) & ~(size_t)255; }
constexpr size_t OFF_BAR  = 0;
constexpr size_t OFF_CTR  = 16384;
constexpr size_t ZERO_BYTES = 20480;
constexpr size_t OFF_MOD  = 32768;
constexpr size_t SZ_MOD   = (size_t)2 * 9 * 6144 * 4;
constexpr int    MOD_KS   = 8;
constexpr size_t OFF_MODP = al256(OFF_MOD + SZ_MOD);
constexpr size_t OFF_S5ST = al256(OFF_MODP + MOD_KS * SZ_MOD);
constexpr size_t OFF_LTOK = al256(OFF_S5ST + (size_t)2 * 8 * 16 * 8 * 64 * 2 * 4);
constexpr size_t OFF_LW   = al256(OFF_LTOK + (size_t)NEXP * TT * 4);
constexpr size_t OFF_TOKI = al256(OFF_LW + (size_t)NEXP * TT * 4);
constexpr size_t OFF_TOKW = al256(OFF_TOKI + (size_t)TT * 16);
constexpr size_t OFF_CNTB = al256(OFF_TOKW + (size_t)TT * 8);
constexpr size_t OFF_WSM  = al256(OFF_CNTB + (size_t)1024 * 16 * 4);
constexpr int WS_GLUT = 0, WS_UQT = WS_GLUT + 256 * 256, WS_UKVT = WS_UQT + 192 * 192, WS_W1C = WS_UKVT + 384 * 128,
              WS_W2 = WS_W1C + 192 * 256, WS_G2T = WS_W2 + 4 * 256 * 64, WS_PER_LAYER = WS_G2T + 256 * 64;
constexpr size_t OFF_WIN  = al256(OFF_WSM + (size_t)2 * WS_PER_LAYER * 2);
constexpr size_t OFF_WBR  = al256(OFF_WIN + (size_t)NINP * 1024 * 2);
constexpr size_t OFF_WOUT = al256(OFF_WBR + (size_t)4 * 1024 * 256 * 2);
constexpr size_t OFF_WG1  = al256(OFF_WOUT + (size_t)1024 * 1024 * 2);
constexpr size_t OFF_WDN  = al256(OFF_WG1 + (size_t)NEXP * 1024 * 1024 * 2);
constexpr size_t OFF_H    = al256(OFF_WDN + (size_t)NEXP * 1024 * 512 * 2);
constexpr size_t OFF_P    = al256(OFF_H + (size_t)TT * 1024 * 2);
constexpr size_t OFF_GATE = al256(OFF_P + (size_t)TT * LDP * 2);
constexpr size_t OFF_MLAQ = al256(OFF_GATE + (size_t)TT * 4096);
constexpr size_t OFF_MLAK = al256(OFF_MLAQ + (size_t)TT * 192 * 2);
constexpr size_t OFF_MLAV = al256(OFF_MLAK + (size_t)TT * 192 * 2);
constexpr size_t OFF_RWX  = al256(OFF_MLAV + (size_t)TT * 256 * 2);
constexpr size_t OFF_Y    = al256(OFF_RWX + (size_t)TT * 1024 * 2);
constexpr size_t OFF_CX   = al256(OFF_Y + (size_t)TT * 1024 * 2);
constexpr size_t OFF_S5Y  = al256(OFF_CX + (size_t)TC * 1024 * 4);
constexpr size_t WS_END   = al256(OFF_S5Y + (size_t)TT * 256 * 2);
constexpr size_t OFF_QRAW = OFF_Y;
constexpr size_t OFF_KVRAW = OFF_QRAW + (size_t)TT * 192 * 2;
constexpr size_t OFF_LR   = OFF_KVRAW + (size_t)TT * 384 * 2;
constexpr size_t OFF_XL   = OFF_LR + (size_t)TT * 192 * 2;
constexpr size_t OFF_Z    = OFF_GATE;
static_assert(OFF_XL + (size_t)TT * 256 * 2 <= OFF_Y + (size_t)TT * 1024 * 2, "temps overflow Y");
constexpr size_t OFF_RWY  = OFF_H;

constexpr int CTR_MOE = 0;
constexpr int CTR_Q   = 64;

constexpr int SMEM_BYTES = 73728 + 256;

struct Params {
    const float* in[48];
    float* out;
    char* ws;
};
enum { I_X = 0, I_C, I_CTX, I_CCTX, I_WADA, I_BADA, I_NMG, I_NFG, I_WIN, I_DAQKG, I_DALAM, I_DASUB,
       I_S5LRE, I_S5LIM, I_S5LDT, I_S5BRE, I_S5BIM, I_S5CRE, I_S5CIM, I_S5D, I_S5WGLU, I_S5BGLU,
       I_MCQG, I_MCKVG, I_MWUQ, I_MWUKV, I_MQKG,
       I_RMU, I_RW0, I_RW1, I_RW2, I_RA0, I_RA1, I_RA2, I_RG1, I_RG2, I_RKK, I_RKA, I_RRK, I_RLNG, I_RLNB,
       I_WBR, I_WOUT, I_ROUTW, I_ROUTB, I_EWG, I_EWU, I_EWD };

DEV int tidx() { int t = threadIdx.x; asm volatile("" : "+v"(t)); return t; }
DEV int bidx() { int b = blockIdx.x; asm volatile("" : "+s"(b)); return b; }
typedef float f32x2_ __attribute__((ext_vector_type(2)));
typedef __bf16 bf16x2_ __attribute__((ext_vector_type(2)));
DEV unsigned cvt_pk_bf16(float lo, float hi) { const f32x2_ v = {lo, hi}; const bf16x2_ b = __builtin_convertvector(v, bf16x2_); return __builtin_bit_cast(unsigned, b); }
DEV bf16_t f2bf(float f) { return (bf16_t)(cvt_pk_bf16(f, 0.f) & 0xFFFFu); }
DEV float bf2f(bf16_t h) { return __uint_as_float(((unsigned)h) << 16); }
DEV unsigned pack2(float lo, float hi) { return cvt_pk_bf16(lo, hi); }
DEV float bflo(unsigned u) { return __uint_as_float(u << 16); }
DEV float bfhi(unsigned u) { return __uint_as_float(u & 0xFFFF0000u); }
DEV float sigmoidf_(float x) { return __builtin_amdgcn_rcpf(1.f + __expf(-x)); }
#define DPP_ADD(v, CTRL) ((v) + __int_as_float(__builtin_amdgcn_mov_dpp(__float_as_int(v), (CTRL), 0xf, 0xf, true)))
DEV float xrow16_sum(float v) { const auto r = __builtin_amdgcn_permlane16_swap(__float_as_uint(v), __float_as_uint(v), false, false); return __uint_as_float(r[0]) + __uint_as_float(r[1]); }
DEV float xhalf_sum(float v) { const auto r = __builtin_amdgcn_permlane32_swap(__float_as_uint(v), __float_as_uint(v), false, false); return __uint_as_float(r[0]) + __uint_as_float(r[1]); }
DEV float xhalf_max(float v) { const auto r = __builtin_amdgcn_permlane32_swap(__float_as_uint(v), __float_as_uint(v), false, false); return fmaxf(__uint_as_float(r[0]), __uint_as_float(r[1])); }
template <int W> DEV float group_sum(float v) {
    v = DPP_ADD(v, 0xB1);
    v = DPP_ADD(v, 0x4E);
    if (W >= 8) v = DPP_ADD(v, 0x141);
    if (W >= 16) v = DPP_ADD(v, 0x140);
    if (W >= 32) v = xrow16_sum(v);
    if (W >= 64) v = xhalf_sum(v);
    return v;
}
DEV float wave_sum(float v) { return group_sum<64>(v); }
DEV int mod_row(int t) { return t < TL ? (t >> 11) : 8; }
typedef const float* cfp_t;
DEV cfp_t inp(const Params&, int i) {
    const __attribute__((address_space(4))) cfp_t* ka = (const __attribute__((address_space(4))) cfp_t*)__builtin_amdgcn_kernarg_segment_ptr();
    asm volatile("" : "+s"(ka));
    return ka[i];
}
DEV char* wsp(const Params&) {
    char* const __attribute__((address_space(4)))* ka = (char* const __attribute__((address_space(4)))*)__builtin_amdgcn_kernarg_segment_ptr();
    asm volatile("" : "+s"(ka));
    return ka[49];
}
DEV bf16_t* wsb(const Params& p, size_t off) { return (bf16_t*)(wsp(p) + off); }
DEV float* wsf(const Params& p, size_t off) { return (float*)(wsp(p) + off); }
DEV const float* modp(const Params& p, int l, int row, int which) { return (const float*)(wsp(p) + OFF_MOD) + ((size_t)(l * 9 + row) * 6 + which) * 1024; }
#define XB_TMO      128
#define XB_XCNT(j)  (256  + 64 * (j))
#define XB_XSUB(j)  (1280 + 64 * (j))
#define XB_XGEN(j)  (2304 + 64 * (j))
#define XB_TOP      3328
#define XB_TOPGEN   3392
#define XCD_BAR_WORDS 3456
#define XB_SPIN_CAP (1u << 18)

__device__ __forceinline__ unsigned xb_ld(unsigned* p)              { return __hip_atomic_load(p, __ATOMIC_RELAXED, __HIP_MEMORY_SCOPE_AGENT); }
__device__ __forceinline__ unsigned xb_add(unsigned* p, unsigned v) { return __hip_atomic_fetch_add(p, v, __ATOMIC_RELAXED, __HIP_MEMORY_SCOPE_AGENT); }
__device__ __forceinline__ unsigned xb_xcc_id() { return (unsigned)__builtin_amdgcn_s_getreg((3 << 11) | 20) & 0xFu; }
#define XB_SPIN(cond, bar) do { unsigned _sp = 0; while (cond) { __builtin_amdgcn_s_sleep(1); \
    if ((++_sp & 255u) == 0u) { if (xb_ld(&(bar)[XB_TMO])) break; if (_sp > XB_SPIN_CAP) { atomicAdd(&(bar)[XB_TMO], 1u); break; } } } } while (0)

struct XcdBarrier {
    unsigned* bar; unsigned x;
    volatile LAS unsigned* st;
};

__device__ __forceinline__ XcdBarrier xcd_barrier_post(unsigned* bar, volatile LAS unsigned* st) {
    XcdBarrier b; b.bar = bar; b.x = xb_xcc_id(); b.st = st;
    if (threadIdx.x == 0) (void)xb_add(&bar[XB_XCNT(b.x)], 1u);
    return b;
}
__device__ __forceinline__ void xcd_barrier_complete(unsigned* bar, unsigned x, unsigned& nloc, unsigned& nx) {
    const unsigned G = gridDim.x * gridDim.y * gridDim.z;
    unsigned sum, cnt, mine, sp = 0u;
    for (;;) {
        sum = 0u; cnt = 0u; mine = 0u;
#pragma unroll
        for (unsigned j = 0; j < 16; ++j) { const unsigned c = xb_ld(&bar[XB_XCNT(j)]); sum += c; cnt += (c > 0u) ? 1u : 0u; mine = (j == x) ? c : mine; }
        if (sum == G) break;
        __builtin_amdgcn_s_sleep(1);
        if ((++sp & 255u) == 0u) { if (xb_ld(&bar[XB_TMO])) break; if (sp > XB_SPIN_CAP) { atomicAdd(&bar[XB_TMO], 1u); break; } }
    }
    nloc = mine > 0u ? mine : 1u; nx = cnt > 0u ? cnt : 1u;
}

__device__ __forceinline__ void xcd_barrier(const XcdBarrier& b) {
    asm volatile("s_waitcnt vmcnt(0)" ::: "memory");
    __syncthreads();
    if (threadIdx.x == 0) {
        unsigned* bar = b.bar;
        __builtin_amdgcn_s_waitcnt(0);
        unsigned nloc = b.st[0], nx = b.st[1];
        if (nloc == 0u) { xcd_barrier_complete(bar, b.x, nloc, nx); b.st[0] = nloc; b.st[1] = nx; }
        const unsigned old = xb_add(&bar[XB_XSUB(b.x)], 1u);
        const unsigned gen = old / nloc;
        if (old + 1u == (gen + 1u) * nloc) {
            __builtin_amdgcn_fence(__ATOMIC_RELEASE, "agent");
            asm volatile("s_waitcnt vmcnt(0)" ::: "memory");
            const unsigned og = xb_add(&bar[XB_TOP], 1u);
            const unsigned tg = og / nx;
            if (og + 1u == (tg + 1u) * nx) xb_add(&bar[XB_TOPGEN], 1u);
            else XB_SPIN(xb_ld(&bar[XB_TOPGEN]) == tg, bar);
            __builtin_amdgcn_fence(__ATOMIC_ACQUIRE, "agent");
            xb_add(&bar[XB_XGEN(b.x)], 1u);
            asm volatile("s_waitcnt vmcnt(0)" ::: "memory");
        } else {
            XB_SPIN(xb_ld(&bar[XB_XGEN(b.x)]) == gen, bar);
            __builtin_amdgcn_fence(__ATOMIC_ACQUIRE, "agent");
            asm volatile("s_waitcnt vmcnt(0)" ::: "memory");
        }
    }
    __syncthreads();
}

DEV void phase_mod_partial(const Params& p, char* smem) {
    float* sm = (float*)smem;
    const int tid = tidx();
    const int nitems = 2 * 24 * MOD_KS;
    for (int item = bidx(); item < nitems; item += gridDim.x) {
        const int l = item / (24 * MOD_KS), rem = item % (24 * MOD_KS), jc = rem / MOD_KS, ks = rem % MOD_KS;
        __syncthreads();
        for (int i = tid; i < 9 * 128; i += NT) {
            const int r = i >> 7, k = ks * 128 + (i & 127);
            const float cv = r < 8 ? inp(p, I_C)[r * 1024 + k] : inp(p, I_CCTX)[k];
            sm[i] = cv * sigmoidf_(cv);
        }
        __syncthreads();
        const int j = jc * 256 + tid;
        float acc[9];
#pragma unroll
        for (int r = 0; r < 9; ++r) acc[r] = 0.f;
        const float* w = inp(p, I_WADA) + (size_t)l * 1024 * 6144 + (size_t)(ks * 128) * 6144 + j;
#pragma unroll 8
        for (int k = 0; k < 128; ++k) {
            const float wv = w[(size_t)k * 6144];
#pragma unroll
            for (int r = 0; r < 9; ++r) acc[r] += sm[r * 128 + k] * wv;
        }
        float* dst = wsf(p, OFF_MODP);
#pragma unroll
        for (int r = 0; r < 9; ++r) dst[((size_t)(ks * 2 + l) * 9 + r) * 6144 + j] = acc[r];
    }
}
DEV void phase_mod_reduce(const Params& p) {
    const int n = 2 * 9 * 6144;
    float* mod = wsf(p, OFF_MOD);
    const float* part = wsf(p, OFF_MODP);
    for (int i = bidx() * NT + tidx(); i < n; i += gridDim.x * NT) {
        const int l = i / (9 * 6144), j = i % 6144;
        float s = inp(p, I_BADA)[l * 6144 + j];
#pragma unroll
        for (int ks = 0; ks < MOD_KS; ++ks) s += part[(size_t)ks * n + i];
        mod[i] = s;
    }
}

struct ConvRegs { float4 v[4]; };
DEV void conv_load(const float* src, int R, int C, int ld, int tr, int tc, ConvRegs& cr) {
    const int r0 = tr * 64, c0 = tc * 64, tid = tidx();
#pragma unroll
    for (int k = 0; k < 4; ++k) {
        const int i = tid + k * NT, r = i >> 4, c4 = (i & 15) * 4;
        float4 v = make_float4(0.f, 0.f, 0.f, 0.f);
        if (r0 + r < R) {
            const float* s = src + (size_t)(r0 + r) * ld + c0 + c4;
            if (c0 + c4 + 3 < C) v = *(const float4*)s;
            else { if (c0 + c4 < C) v.x = s[0]; if (c0 + c4 + 1 < C) v.y = s[1]; if (c0 + c4 + 2 < C) v.z = s[2]; }
        }
        cr.v[k] = v;
    }
}
template <int MODE>
DEV void conv_store(const ConvRegs& cr, int R, int C, bf16_t* dst, int ldd, int roff, int tr, int tc, float* sm) {
    const int r0 = tr * 64, c0 = tc * 64, tid = tidx();
    __syncthreads();
#pragma unroll
    for (int k = 0; k < 4; ++k) {
        const int i = tid + k * NT, r = i >> 4, c4 = (i & 15) * 4;
        float* d = sm + r * 65 + c4;
        d[0] = cr.v[k].x; d[1] = cr.v[k].y; d[2] = cr.v[k].z; d[3] = cr.v[k].w;
    }
    __syncthreads();
    for (int i = tid; i < 64 * 8; i += NT) {
        const int c = i >> 3, r8 = (i & 7) * 8;
        if (c0 + c < C && r0 + r8 < R) {
            const int cc = c0 + c;
            const int drow = (MODE == 0) ? (cc + roff) : ((cc >> 5) * 64 + (cc & 31) + roff);
            u32x4 o;
            o[0] = pack2(sm[(r8 + 0) * 65 + c], sm[(r8 + 1) * 65 + c]);
            o[1] = pack2(sm[(r8 + 2) * 65 + c], sm[(r8 + 3) * 65 + c]);
            o[2] = pack2(sm[(r8 + 4) * 65 + c], sm[(r8 + 5) * 65 + c]);
            o[3] = pack2(sm[(r8 + 6) * 65 + c], sm[(r8 + 7) * 65 + c]);
            *(u32x4*)(dst + (size_t)drow * ldd + r0 + r8) = o;
        }
    }
}
template <int MODE>
DEV void conv_job(const float* src, int R, int C, int ld, bf16_t* dst, int ldd, int roff, int& rot, float* sm) {
    const int ntr = (R + 63) >> 6, ntc = (C + 63) >> 6, nt = ntr * ntc, G = gridDim.x;
    const int first = (bidx() - (rot % G) + G) % G;
    ConvRegs cur;
    if (first < nt) conv_load(src, R, C, ld, first / ntc, first % ntc, cur);
    for (int t = first; t < nt; t += G) {
        ConvRegs nxt = cur;
        if (t + G < nt) conv_load(src, R, C, ld, (t + G) / ntc, (t + G) % ntc, nxt);
        conv_store<MODE>(cur, R, C, dst, ldd, roff, t / ntc, t % ntc, sm);
        cur = nxt;
    }
    rot += nt;
}
DEV void phase_conv_layer(const Params& p, int l, char* smem) {
    float* sm = (float*)smem;
    int rot = 0;
    const float* win = inp(p, I_WIN) + (size_t)l * 1024 * NIN;
    conv_job<0>(win, 1024, C_PEND, NIN, wsb(p, OFF_WIN), 1024, 0, rot, sm);
    conv_job<0>(win + C_PEND, 1024, 4096, NIN, wsb(p, OFF_WIN), 1024, NGATE0, rot, sm);
    {
        uint4* z = (uint4*)(wsb(p, OFF_WIN) + (size_t)C_PEND * 1024);
        const int n = (NGATE0 - C_PEND) * 1024 / 8;
        unsigned zz = 0u; asm volatile("" : "+v"(zz));
        for (int i = bidx() * NT + tidx(); i < n; i += gridDim.x * NT) z[i] = make_uint4(zz, zz, zz, zz);
    }
    for (int i = 0; i < 4; ++i)
        conv_job<0>(inp(p, I_WBR) + (size_t)(l * 4 + i) * 256 * 1024, 256, 1024, 1024, wsb(p, OFF_WBR) + (size_t)i * 1024 * 256, 256, 0, rot, sm);
    conv_job<0>(inp(p, I_WOUT) + (size_t)l * 1024 * 1024, 1024, 1024, 1024, wsb(p, OFF_WOUT), 1024, 0, rot, sm);
}
DEV void phase_conv_experts(const Params& p, int l, char* smem) {
    float* sm = (float*)smem;
    int rot = 0;
    for (int e = 0; e < NEXP; ++e) {
        conv_job<1>(inp(p, I_EWG) + (size_t)(l * NEXP + e) * 1024 * DFF, 1024, DFF, DFF, wsb(p, OFF_WG1) + (size_t)e * 1024 * 1024, 1024, 0, rot, sm);
        conv_job<1>(inp(p, I_EWU) + (size_t)(l * NEXP + e) * 1024 * DFF, 1024, DFF, DFF, wsb(p, OFF_WG1) + (size_t)e * 1024 * 1024, 1024, 32, rot, sm);
        conv_job<0>(inp(p, I_EWD) + (size_t)(l * NEXP + e) * DFF * 1024, DFF, 1024, 1024, wsb(p, OFF_WDN) + (size_t)e * 1024 * DFF, DFF, 0, rot, sm);
    }
}
DEV void phase_conv_small(const Params& p, char* smem) {
    float* sm = (float*)smem;
    int rot = 0;
    for (int l = 0; l < 2; ++l) {
        bf16_t* w = wsb(p, OFF_WSM) + (size_t)l * WS_PER_LAYER;
        for (int i = bidx() * NT + tidx(); i < 4 * 256 * 4; i += gridDim.x * NT)
            *(u32x4*)(w + WS_W2 + (size_t)(i >> 2) * 64 + 32 + (i & 3) * 8) = (u32x4){0u, 0u, 0u, 0u};
        conv_job<0>(inp(p, I_S5WGLU) + (size_t)l * 256 * 256, 256, 256, 256, w + WS_GLUT, 256, 0, rot, sm);
        conv_job<0>(inp(p, I_MWUQ) + (size_t)l * 192 * 192, 192, 192, 192, w + WS_UQT, 192, 0, rot, sm);
        conv_job<0>(inp(p, I_MWUKV) + (size_t)l * 128 * 384, 128, 384, 384, w + WS_UKVT, 128, 0, rot, sm);
        for (int d = 0; d < 2; ++d) {
            conv_job<0>(inp(p, I_RW1) + (size_t)(l * 2 + d) * 256 * 32, 256, 32, 32, w + WS_W1C, 256, d * 32, rot, sm);
            conv_job<0>(inp(p, I_RA1) + (size_t)(l * 2 + d) * 256 * 32, 256, 32, 32, w + WS_W1C, 256, 64 + d * 32, rot, sm);
            conv_job<0>(inp(p, I_RW2) + (size_t)(l * 2 + d) * 32 * 256, 32, 256, 256, w + WS_W2 + (size_t)d * 256 * 64, 64, 0, rot, sm);
            conv_job<0>(inp(p, I_RA2) + (size_t)(l * 2 + d) * 32 * 256, 32, 256, 256, w + WS_W2 + (size_t)(2 + d) * 256 * 64, 64, 0, rot, sm);
        }
        conv_job<0>(inp(p, I_RG1) + (size_t)l * 256 * 64, 256, 64, 64, w + WS_W1C, 256, 128, rot, sm);
        conv_job<0>(inp(p, I_RG2) + (size_t)l * 64 * 256, 64, 256, 256, w + WS_G2T, 64, 0, rot, sm);
    }
}

template <int WHICH>
DEV void phase_norm(const Params& p, int l, int nrows, char* smem, bool fuse_combine = false) {
    const int lane = tidx() & 63, wave = tidx() >> 6;
    const float* xs = (l == 0) ? inp(p, I_X) : p.out;
    const float* cs = (l == 0) ? inp(p, I_CTX) : wsf(p, OFF_CX);
    const float* g = inp(p, WHICH == 1 ? I_NMG : I_NFG) + l * 1024;
    bf16_t* H = wsb(p, OFF_H);
    if (WHICH == 2) { xs = p.out; cs = wsf(p, OFF_CX); }
    const int tpb = (nrows + (int)gridDim.x - 1) / (int)gridDim.x;
    const int rbeg = WHICH == 2 ? bidx() * tpb + wave : bidx() * 4 + wave;
    const int rend = WHICH == 2 ? min(nrows, (bidx() + 1) * tpb) : nrows;
    const int rstep = WHICH == 2 ? 4 : (int)gridDim.x * 4;
    int* sel = (int*)smem;
    const float4* rwl = (const float4*)(smem + 8192);
    if (WHICH == 2) {
        const float* rw = inp(p, I_ROUTW);
        float4* dstl = (float4*)(smem + 8192);
        __syncthreads();
#pragma unroll 4
        for (int k = 0; k < 16; ++k) {
            const int idx = tidx() + k * NT, combo = idx >> 6, ln = idx & 63;
            const int c = ln * 4 + (combo >> 4) * 256 + ((combo >> 2) & 3);
            dstl[idx] = *(const float4*)(rw + (size_t)c * 16 + (combo & 3) * 4);
        }
        __syncthreads();
    }
    float4 nv[4];
    if (rbeg < rend) {
        const float* src = rbeg < TL ? xs + (size_t)rbeg * 1024 : cs + (size_t)(rbeg - TL) * 1024;
#pragma unroll
        for (int i = 0; i < 4; ++i) nv[i] = *(const float4*)(src + lane * 4 + i * 256);
    }
    for (int row = rbeg; row < rend; row += rstep) {
        const int mr = mod_row(row);
        const float* sh = modp(p, l, mr, WHICH == 1 ? 0 : 3);
        const float* sc = modp(p, l, mr, WHICH == 1 ? 1 : 4);
        float4 v[4];
        float ss = 0.f;
#pragma unroll
        for (int i = 0; i < 4; ++i) v[i] = nv[i];
        {
            const int nrow = row + rstep < rend ? row + rstep : row;
            const float* nsrc = nrow < TL ? xs + (size_t)nrow * 1024 : cs + (size_t)(nrow - TL) * 1024;
#pragma unroll
            for (int i = 0; i < 4; ++i) nv[i] = *(const float4*)(nsrc + lane * 4 + i * 256);
        }
        if (WHICH == 1 && fuse_combine) {
            const bf16_t* Z = wsb(p, OFF_Z);
            const int* toki = (const int*)(wsp(p) + OFF_TOKI);
            const float* tokw = (const float*)(wsp(p) + OFF_TOKW);
            const float* g2 = modp(p, l - 1, mr, 5);
            const int r0 = toki[(size_t)row * 4 + 2], r1 = toki[(size_t)row * 4 + 3];
            const float w0 = tokw[(size_t)row * 2], w1 = tokw[(size_t)row * 2 + 1];
            float* dst = row < TL ? p.out + (size_t)row * 1024 : wsf(p, OFF_CX) + (size_t)(row - TL) * 1024;
#pragma unroll
            for (int i = 0; i < 4; ++i) {
                const int c = lane * 4 + i * 256;
                const u32x2 a = *(const u32x2*)(Z + (size_t)r0 * 1024 + c), b = *(const u32x2*)(Z + (size_t)r1 * 1024 + c);
                const float4 gg = *(const float4*)(g2 + c);
                v[i].x += gg.x * (w0 * bflo(a.x) + w1 * bflo(b.x));
                v[i].y += gg.y * (w0 * bfhi(a.x) + w1 * bfhi(b.x));
                v[i].z += gg.z * (w0 * bflo(a.y) + w1 * bflo(b.y));
                v[i].w += gg.w * (w0 * bfhi(a.y) + w1 * bfhi(b.y));
                *(float4*)(dst + c) = v[i];
            }
        }
#pragma unroll
        for (int i = 0; i < 4; ++i) ss += v[i].x * v[i].x + v[i].y * v[i].y + v[i].z * v[i].z + v[i].w * v[i].w;
        ss = wave_sum(ss);
        const float rstd = rsqrtf(ss * (1.f / 1024.f) + EPS);
        float hv[16];
        float4 g4[4], sh4[4], sc4[4];
#pragma unroll
        for (int i = 0; i < 4; ++i) { const int c = lane * 4 + i * 256; g4[i] = *(const float4*)(g + c); sh4[i] = *(const float4*)(sh + c); sc4[i] = *(const float4*)(sc + c); }
#pragma unroll
        for (int i = 0; i < 4; ++i) {
            const int c = lane * 4 + i * 256;
            const float4 gg = g4[i], s4 = sh4[i], c4 = sc4[i];
            hv[i * 4 + 0] = v[i].x * rstd * gg.x * (1.f + c4.x) + s4.x;
            hv[i * 4 + 1] = v[i].y * rstd * gg.y * (1.f + c4.y) + s4.y;
            hv[i * 4 + 2] = v[i].z * rstd * gg.z * (1.f + c4.z) + s4.z;
            hv[i * 4 + 3] = v[i].w * rstd * gg.w * (1.f + c4.w) + s4.w;
            u32x2 o; o.x = pack2(hv[i * 4 + 0], hv[i * 4 + 1]); o.y = pack2(hv[i * 4 + 2], hv[i * 4 + 3]);
            *(u32x2*)(H + (size_t)row * 1024 + c) = o;
        }
        if (WHICH == 2) {
            float lg[16];
#pragma unroll
            for (int e = 0; e < 16; ++e) lg[e] = 0.f;
#pragma unroll
            for (int i = 0; i < 4; ++i)
#pragma unroll
                for (int j = 0; j < 4; ++j) {
                    const float hvv = hv[i * 4 + j];
#pragma unroll
                    for (int q = 0; q < 4; ++q) {
                        const float4 w4 = rwl[((i * 4 + j) * 4 + q) * 64 + lane];
                        lg[q * 4 + 0] += hvv * w4.x; lg[q * 4 + 1] += hvv * w4.y; lg[q * 4 + 2] += hvv * w4.z; lg[q * 4 + 3] += hvv * w4.w;
                    }
                }
#pragma unroll
            for (int e = 0; e < 16; ++e) lg[e] = wave_sum(lg[e]);
            float sc16[16], bs[16];
#pragma unroll
            for (int e = 0; e < 16; ++e) { sc16[e] = sigmoidf_(lg[e]); bs[e] = sc16[e] + inp(p, I_ROUTB)[e]; }
            int bestg = 0; float bestv = -INFINITY;
#pragma unroll
            for (int gi = 0; gi < 4; ++gi) {
                float m1 = -INFINITY, m2 = -INFINITY;
#pragma unroll
                for (int k = 0; k < 4; ++k) { const float x = bs[gi * 4 + k]; if (x > m1) { m2 = m1; m1 = x; } else if (x > m2) m2 = x; }
                const float gs = m1 + m2;
                if (gs > bestv) { bestv = gs; bestg = gi; }
            }
            int i0 = 0, i1 = 0; float v0 = -INFINITY, v1 = -INFINITY, s0 = 0.f, s1 = 0.f;
#pragma unroll
            for (int e = 0; e < 16; ++e) { const bool in = (e >> 2) == bestg; if (in && bs[e] > v0) { v0 = bs[e]; i0 = e; s0 = sc16[e]; } }
#pragma unroll
            for (int e = 0; e < 16; ++e) { const bool in = (e >> 2) == bestg && e != i0; if (in && bs[e] > v1) { v1 = bs[e]; i1 = e; s1 = sc16[e]; } }
            const float inv = __builtin_amdgcn_rcpf(s0 + s1);
            if (lane == 0) {
                const int lt = row - bidx() * tpb;
                sel[lt * 2 + 0] = i0; sel[lt * 2 + 1] = i1;
                float* tw = (float*)(wsp(p) + OFF_TOKW) + (size_t)row * 2;
                tw[0] = s0 * inv; tw[1] = s1 * inv;
            }
        }
    }
    if (WHICH == 2) {
        __syncthreads();
        const int t0 = bidx() * tpb, nt = max(0, min(nrows, t0 + tpb) - t0);
        int* rank = sel + 2 * tpb;
        if (tidx() < 16) {
            const int e = tidx(); int c = 0;
            for (int i = 0; i < 2 * nt; ++i) if (sel[i] == e) { rank[i] = c; ++c; }
            ((int*)(wsp(p) + OFF_CNTB))[(size_t)bidx() * 16 + e] = c;
        }
        __syncthreads();
        int* toki = (int*)(wsp(p) + OFF_TOKI);
        for (int i = tidx(); i < nt; i += NT) {
            int4 r; r.x = sel[2 * i]; r.y = sel[2 * i + 1]; r.z = rank[2 * i]; r.w = rank[2 * i + 1];
            *(int4*)(toki + (size_t)(t0 + i) * 4) = r;
        }
        __syncthreads();
    }
}
DEV void phase_route(const Params& p, int l, int nrows, char* smem) {
    int* sm = (int*)smem;
    const int tid = tidx(), e = tid & 15, part = tid >> 4, G = gridDim.x, b = bidx();
    const int* cntb = (const int*)(wsp(p) + OFF_CNTB);
    int pre = 0, tot = 0;
    for (int bb = part; bb < G; bb += 16) { const int c = cntb[(size_t)bb * 16 + e]; tot += c; if (bb < b) pre += c; }
    __syncthreads();
    sm[part * 16 + e] = pre; sm[256 + part * 16 + e] = tot;
    __syncthreads();
    if (tid < 16) {
        int a = 0, t = 0;
        for (int q = 0; q < 16; ++q) { a += sm[q * 16 + tid]; t += sm[256 + q * 16 + tid]; }
        sm[512 + tid] = a; sm[528 + tid] = t;
    }
    __syncthreads();
    if (tid == 0) {
        int a = 0;
        for (int q = 0; q < 16; ++q) { sm[544 + q] = a; a += sm[528 + q]; }
    }
    __syncthreads();
    if (b == 0 && tid < 16) ((int*)(wsp(p) + OFF_CTR))[CTR_MOE + l * 16 + tid] = sm[528 + tid];
    const int tpb = (nrows + G - 1) / G, t0 = b * tpb, nt = max(0, min(nrows, t0 + tpb) - t0);
    int* toki = (int*)(wsp(p) + OFF_TOKI);
    const float* tokw = (const float*)(wsp(p) + OFF_TOKW);
    int* ltok = (int*)(wsp(p) + OFF_LTOK);
    float* lw = (float*)(wsp(p) + OFF_LW);
    for (int i = tid; i < 2 * nt; i += NT) {
        const int t = t0 + (i >> 1), j = i & 1;
        const int ee = toki[(size_t)t * 4 + j], rk = toki[(size_t)t * 4 + 2 + j];
        const int pos = sm[512 + ee] + rk;
        ltok[(size_t)ee * TT + pos] = t;
        lw[(size_t)ee * TT + pos] = tokw[(size_t)t * 2 + j];
        toki[(size_t)t * 4 + 2 + j] = sm[544 + ee] + pos;
    }
}
DEV void phase_combine(const Params& p, int l, int nrows) {
    const int lane = tidx() & 63, wave = tidx() >> 6;
    const bf16_t* Z = wsb(p, OFF_Z);
    const int* toki = (const int*)(wsp(p) + OFF_TOKI);
    const float* tokw = (const float*)(wsp(p) + OFF_TOKW);
    for (int row = bidx() * 4 + wave; row < nrows; row += gridDim.x * 4) {
        float* dst = row < TL ? p.out + (size_t)row * 1024 : wsf(p, OFF_CX) + (size_t)(row - TL) * 1024;
        const float* g2 = modp(p, l, mod_row(row), 5);
        const int r0 = toki[(size_t)row * 4 + 2], r1 = toki[(size_t)row * 4 + 3];
        const float w0 = tokw[(size_t)row * 2], w1 = tokw[(size_t)row * 2 + 1];
#pragma unroll
        for (int i = 0; i < 4; ++i) {
            const int c = lane * 4 + i * 256;
            const u32x2 a = *(const u32x2*)(Z + (size_t)r0 * 1024 + c), b = *(const u32x2*)(Z + (size_t)r1 * 1024 + c);
            const float4 gg = *(const float4*)(g2 + c);
            float4 x = *(float4*)(dst + c);
            x.x += gg.x * (w0 * bflo(a.x) + w1 * bflo(b.x));
            x.y += gg.y * (w0 * bfhi(a.x) + w1 * bfhi(b.x));
            x.z += gg.z * (w0 * bflo(a.y) + w1 * bflo(b.y));
            x.w += gg.w * (w0 * bfhi(a.y) + w1 * bfhi(b.y));
            *(float4*)(dst + c) = x;
        }
    }
}
constexpr int GLD = 72;
constexpr int GSTAGE = 128 * GLD;
template <bool DEEP = true, int TN = 2, class AF, class BF>
DEV void gemm_mainloop(f32x16 (&acc)[2][TN], AF arow, BF brow, int K, bf16_t* sm) {
    const int tid = tidx(), lane = tid & 63, wave = tid >> 6, wm = wave >> 1, wn = wave & 1;
    bf16_t* As = sm;
    bf16_t* Bs = sm + 2 * GSTAGE;
    constexpr int NB = 2 * TN;
    const bf16_t* ap[4]; const bf16_t* bp[NB];
#pragma unroll
    for (int i = 0; i < 4; ++i) { const int q = tid + i * NT; ap[i] = arow(q >> 3) + (q & 7) * 8; }
#pragma unroll
    for (int i = 0; i < NB; ++i) { const int q = tid + i * NT; bp[i] = brow(q >> 3) + (q & 7) * 8; }
    const int soff = (tid >> 3) * GLD + (tid & 7) * 8;
    u32x4 ra0[4], rb0[NB], ra1[4], rb1[NB];
    const int nk = K >> 6;
#pragma unroll
    for (int i = 0; i < 4; ++i) ra0[i] = *(const u32x4*)ap[i];
#pragma unroll
    for (int i = 0; i < NB; ++i) rb0[i] = *(const u32x4*)bp[i];
    if (DEEP && nk > 1) {
#pragma unroll
        for (int i = 0; i < 4; ++i) ra1[i] = *(const u32x4*)(ap[i] + 64);
#pragma unroll
        for (int i = 0; i < NB; ++i) rb1[i] = *(const u32x4*)(bp[i] + 64);
    }
    __syncthreads();
#pragma unroll
    for (int i = 0; i < 4; ++i) *(u32x4*)(As + soff + i * 32 * GLD) = ra0[i];
#pragma unroll
    for (int i = 0; i < NB; ++i) *(u32x4*)(Bs + soff + i * 32 * GLD) = rb0[i];
    __syncthreads();
    const int arow0 = (wm * 64 + (lane & 31)) * GLD + (lane >> 5) * 8;
    const int brow0 = (wn * 32 * TN + (lane & 31)) * GLD + (lane >> 5) * 8;
    auto compute = [&](int cur) {
        const bf16_t* a_s = As + cur * GSTAGE + arow0;
        const bf16_t* b_s = Bs + cur * GSTAGE + brow0;
#pragma unroll
        for (int ks = 0; ks < 4; ++ks) {
            const bf16x8 a0 = *(const bf16x8*)(a_s + ks * 16);
            const bf16x8 a1 = *(const bf16x8*)(a_s + 32 * GLD + ks * 16);
#pragma unroll
            for (int j = 0; j < TN; ++j) {
                const bf16x8 bj = *(const bf16x8*)(b_s + j * 32 * GLD + ks * 16);
                acc[0][j] = __builtin_amdgcn_mfma_f32_32x32x16_bf16(a0, bj, acc[0][j], 0, 0, 0);
                acc[1][j] = __builtin_amdgcn_mfma_f32_32x32x16_bf16(a1, bj, acc[1][j], 0, 0, 0);
            }
        }
    };
    auto gload = [&](u32x4 (&ra)[4], u32x4 (&rb)[NB], int kt) {
        const int k0 = kt * 64;
#pragma unroll
        for (int i = 0; i < 4; ++i) ra[i] = *(const u32x4*)(ap[i] + k0);
#pragma unroll
        for (int i = 0; i < NB; ++i) rb[i] = *(const u32x4*)(bp[i] + k0);
    };
    auto lstore = [&](const u32x4 (&ra)[4], const u32x4 (&rb)[NB], int st) {
#pragma unroll
        for (int i = 0; i < 4; ++i) *(u32x4*)(As + st * GSTAGE + soff + i * 32 * GLD) = ra[i];
#pragma unroll
        for (int i = 0; i < NB; ++i) *(u32x4*)(Bs + st * GSTAGE + soff + i * 32 * GLD) = rb[i];
    };
    for (int kt = 0; kt < nk; kt += 2) {
        if (!DEEP && kt + 1 < nk) gload(ra1, rb1, kt + 1);
        if (DEEP && kt + 2 < nk) gload(ra0, rb0, kt + 2);
        compute(0);
        if (kt + 1 < nk) lstore(ra1, rb1, 1);
        __syncthreads();
        if (kt + 1 >= nk) break;
        if (!DEEP && kt + 2 < nk) gload(ra0, rb0, kt + 2);
        if (DEEP && kt + 3 < nk) gload(ra1, rb1, kt + 3);
        compute(1);
        if (kt + 2 < nk) lstore(ra0, rb0, 0);
        __syncthreads();
    }
}
template <int TN>
DEV void acc_zero(f32x16 (&acc)[2][TN]) {
#pragma unroll
    for (int i = 0; i < 2; ++i)
#pragma unroll
        for (int j = 0; j < TN; ++j)
#pragma unroll
            for (int r = 0; r < 16; ++r) acc[i][j][r] = 0.f;
}
#define EPI_FOREACH(acc, ...)                                                                           \
    {                                                                                                    \
        const int _lane = tidx() & 63, _wave = tidx() >> 6, _wm = _wave >> 1, _wn = _wave & 1; \
        _Pragma("unroll") for (int _i = 0; _i < 2; ++_i)                                                 \
        _Pragma("unroll") for (int _j = 0; _j < 2; ++_j)                                                 \
        _Pragma("unroll") for (int _r = 0; _r < 16; ++_r) {                                              \
            const int er = _wm * 64 + _i * 32 + (_r & 3) + 8 * (_r >> 2) + 4 * (_lane >> 5);             \
            const int ec = _wn * 64 + _j * 32 + (_lane & 31);                                            \
            const float ev = acc[_i][_j][_r];                                                            \
            __VA_ARGS__                                                                                  \
        }                                                                                                \
    }

DEV void tile_mn(int item, int nMt, int nNt, int& mt, int& nt) {
    constexpr int GM = 16;
    const int per = GM * nNt, g = item / per, rem = item % per;
    const int m0 = g * GM, gsz = (nMt - m0) < GM ? (nMt - m0) : GM;
    mt = m0 + rem % gsz; nt = rem / gsz;
}

DEV void phase_inproj(const Params& p, int l, char* smem) {
    bf16_t* sm = (bf16_t*)smem;
    const bf16_t* H = wsb(p, OFF_H);
    const bf16_t* W = wsb(p, OFF_WIN);
    bf16_t* P = wsb(p, OFF_P);
    unsigned char* G = (unsigned char*)(wsp(p) + OFF_GATE);
    const int nMt = TT / 128, nNt = NINP / 128;
    for (int item = bidx(); item < nMt * nNt; item += gridDim.x) {
        int mt, nt; tile_mn(item, nMt, nNt, mt, nt);
        const int m0 = mt * 128, n0 = nt * 128;
        if (l == 1 && m0 >= TL && n0 >= NGATE0) continue;
        f32x16 acc[2][2]; acc_zero<2>(acc);
        gemm_mainloop(acc, [&](int r) { return H + (size_t)(m0 + r) * 1024; }, [&](int r) { return W + (size_t)(n0 + r) * 1024; }, 1024, sm);
        if (n0 < NGATE0) {
            EPI_FOREACH(acc, { const int col = n0 + ec; if (col < C_PEND) P[(size_t)(m0 + er) * LDP + col] = f2bf(ev); })
        } else {
            EPI_FOREACH(acc, { const int col = n0 + ec - NGATE0; const float s = sigmoidf_(ev); G[(size_t)(m0 + er) * 4096 + col] = (unsigned char)__float2int_rn(s * 255.f); })
        }
    }
}

template <class EF>
DEV void gemm_generic(const bf16_t* A, int lda, int M, const bf16_t* Bt, int ldb, int N, int K, EF ef, char* smem, int rot) {
    bf16_t* sm = (bf16_t*)smem;
    const int nMt = (M + 127) / 128, nNt = (N + 127) / 128, G = gridDim.x;
    const int first = (bidx() - (rot % G) + G) % G;
    for (int item = first; item < nMt * nNt; item += G) {
        const int mt = item / nNt, nt = item % nNt, m0 = mt * 128, n0 = nt * 128;
        f32x16 acc[2][2]; acc_zero<2>(acc);
        gemm_mainloop(acc, [&](int r) { int rr = m0 + r; rr = rr < M ? rr : M - 1; return A + (size_t)rr * lda; },
                      [&](int r) { int rr = n0 + r; rr = rr < N ? rr : N - 1; return Bt + (size_t)rr * ldb; }, K, sm);
        EPI_FOREACH(acc, { const int row = m0 + er, col = n0 + ec; if (row < M && col < N) ef(row, col, ev); })
    }
}


template <class CV, class SINK>
DEV void epi_stage_tile(f32x16 (&acc)[2][2], char* sm, CV cv, SINK sink) {
    constexpr int LDT = 136;
    const int tid = tidx(), lane = tid & 63, wave = tid >> 6, wm = wave >> 1, wn = wave & 1;
    bf16_t* T = (bf16_t*)sm;
    bf16_t* wb = T + (wm * 64 + 4 * (lane >> 5)) * LDT + wn * 64 + (lane & 31);
#pragma unroll
    for (int j = 0; j < 2; ++j) {
        const int ct = wn * 64 + j * 32 + (lane & 31);
#pragma unroll
        for (int i = 0; i < 2; ++i)
#pragma unroll
            for (int r = 0; r < 16; ++r) wb[(i * 32 + (r & 3) + 8 * (r >> 2)) * LDT + j * 32] = f2bf(cv(ct, acc[i][j][r]));
    }
    __syncthreads();
#pragma unroll
    for (int k = 0; k < 8; ++k) {
        const int q = tid + k * NT, row = q >> 4, ch = q & 15;
        const u32x4 v = *(const u32x4*)(T + row * LDT + ch * 8);
        sink(row, ch, v);
    }
}
template <class CV>
DEV void epi_store_tile(f32x16 (&acc)[2][2], char* sm, CV cv, bf16_t* out, size_t pitch, int ncols_valid) {
    epi_stage_tile(acc, sm, cv, [&](int row, int ch, const u32x4& v) { if (ch * 8 < ncols_valid) *(u32x4*)(out + (size_t)row * pitch + ch * 8) = v; });
}
template <class CV>
DEV void gemm_generic_st(const bf16_t* A, int lda, int M, const bf16_t* Bt, int ldb, int N, int K, CV cv, bf16_t* out, size_t pitch, char* smem, int rot) {
    bf16_t* sm = (bf16_t*)smem;
    const int nMt = M / 128, nNt = (N + 127) / 128, G = gridDim.x;
    const int first = (bidx() - (rot % G) + G) % G;
    for (int item = first; item < nMt * nNt; item += G) {
        const int mt = item / nNt, nt = item % nNt, m0 = mt * 128, n0 = nt * 128;
        f32x16 acc[2][2]; acc_zero<2>(acc);
        gemm_mainloop(acc, [&](int r) { return A + (size_t)(m0 + r) * lda; },
                      [&](int r) { int rr = n0 + r; rr = rr < N ? rr : N - 1; return Bt + (size_t)rr * ldb; }, K, sm);
        epi_store_tile(acc, smem, [&](int ct, float v) { return cv(n0 + ct, v); }, out + (size_t)m0 * pitch + n0, pitch, N - n0);
    }
}

DEV void phase_merge(const Params& p, int l, int M, char* smem) {
    bf16_t* sm = (bf16_t*)smem;
    const bf16_t* Y = wsb(p, OFF_Y);
    const bf16_t* W = wsb(p, OFF_WBR);
    const unsigned char* G = (const unsigned char*)(wsp(p) + OFF_GATE);
    bf16_t* MG = wsb(p, OFF_H);
    bf16_t* As = sm;
    bf16_t* Bs = sm + 2 * GSTAGE;
    unsigned char* Gs = (unsigned char*)(sm + 2 * GSTAGE + 2 * 64 * GLD);
    const int tid = tidx(), lane = tid & 63, wave = tid >> 6, wm = wave >> 1, wn = wave & 1;
    const int soff = (tid >> 3) * GLD + (tid & 7) * 8;
    const int arow0 = (wm * 64 + (lane & 31)) * GLD + (lane >> 5) * 8;
    const int brow0 = (wn * 32 + (lane & 31)) * GLD + (lane >> 5) * 8;
    const int nMt = M / 128, nNt = 16;
    for (int item = bidx(); item < nMt * nNt; item += gridDim.x) {
        const int mt = item / nNt, nt = item % nNt, m0 = mt * 128, n0 = nt * 64;
        const bf16_t* ap[4]; const bf16_t* bp[2]; const unsigned char* gp[2];
#pragma unroll
        for (int i = 0; i < 4; ++i) { const int q = tid + i * NT; ap[i] = Y + (size_t)(m0 + (q >> 3)) * 1024 + (q & 7) * 8; }
#pragma unroll
        for (int i = 0; i < 2; ++i) { const int q = tid + i * NT; bp[i] = W + (size_t)(n0 + (q >> 3)) * 256 + (q & 7) * 8;
                                      gp[i] = G + (size_t)(m0 + (q >> 2)) * 4096 + n0 + (q & 3) * 16; }
        f32x16 tot[2], acc[2];
#pragma unroll
        for (int a = 0; a < 2; ++a)
#pragma unroll
            for (int r = 0; r < 16; ++r) { tot[a][r] = 0.f; acc[a][r] = 0.f; }
        u32x4 ra[4], rb[2], rg[2];
#pragma unroll
        for (int i = 0; i < 4; ++i) ra[i] = *(const u32x4*)ap[i];
#pragma unroll
        for (int i = 0; i < 2; ++i) rb[i] = *(const u32x4*)bp[i];
        __syncthreads();
#pragma unroll
        for (int i = 0; i < 4; ++i) *(u32x4*)(As + soff + i * 32 * GLD) = ra[i];
#pragma unroll
        for (int i = 0; i < 2; ++i) *(u32x4*)(Bs + soff + i * 32 * GLD) = rb[i];
        __syncthreads();
#pragma unroll
        for (int kt = 0; kt < 16; ++kt) {
            const int cur = kt & 1, seg = kt >> 2;
            if (kt + 1 < 16) {
                const int k1 = kt + 1;
#pragma unroll
                for (int i = 0; i < 4; ++i) ra[i] = *(const u32x4*)(ap[i] + k1 * 64);
#pragma unroll
                for (int i = 0; i < 2; ++i) rb[i] = *(const u32x4*)(bp[i] + (size_t)(k1 >> 2) * (1024 * 256) + (k1 & 3) * 64);
            }
            if ((kt & 3) == 0) {
#pragma unroll
                for (int i = 0; i < 2; ++i) rg[i] = *(const u32x4*)(gp[i] + seg * 1024);
            }
            const bf16_t* a_s = As + cur * GSTAGE + arow0;
            const bf16_t* b_s = Bs + cur * (64 * GLD) + brow0;
#pragma unroll
            for (int ks = 0; ks < 4; ++ks) {
                const bf16x8 a0 = *(const bf16x8*)(a_s + ks * 16), a1 = *(const bf16x8*)(a_s + 32 * GLD + ks * 16), b0 = *(const bf16x8*)(b_s + ks * 16);
                acc[0] = __builtin_amdgcn_mfma_f32_32x32x16_bf16(a0, b0, acc[0], 0, 0, 0);
                acc[1] = __builtin_amdgcn_mfma_f32_32x32x16_bf16(a1, b0, acc[1], 0, 0, 0);
            }
            if (kt + 1 < 16) {
                const int nx = cur ^ 1;
#pragma unroll
                for (int i = 0; i < 4; ++i) *(u32x4*)(As + nx * GSTAGE + soff + i * 32 * GLD) = ra[i];
#pragma unroll
                for (int i = 0; i < 2; ++i) *(u32x4*)(Bs + nx * (64 * GLD) + soff + i * 32 * GLD) = rb[i];
            }
            if ((kt & 3) == 3) {
#pragma unroll
                for (int i = 0; i < 2; ++i) { const int q = tid + i * NT; *(u32x4*)(Gs + (q >> 2) * 64 + (q & 3) * 16) = rg[i]; }
            }
            __syncthreads();
            if ((kt & 3) == 3) {
#pragma unroll
                for (int a = 0; a < 2; ++a)
#pragma unroll
                    for (int r = 0; r < 16; ++r) {
                        const int er = wm * 64 + a * 32 + (r & 3) + 8 * (r >> 2) + 4 * (lane >> 5), ec = wn * 32 + (lane & 31);
                        tot[a][r] += (float)Gs[er * 64 + ec] * (1.f / 255.f) * acc[a][r];
                        acc[a][r] = 0.f;
                    }
            }
        }
#pragma unroll
        for (int a = 0; a < 2; ++a)
#pragma unroll
            for (int r = 0; r < 16; ++r) {
                const int er = wm * 64 + a * 32 + (r & 3) + 8 * (r >> 2) + 4 * (lane >> 5), ec = wn * 32 + (lane & 31);
                MG[(size_t)(m0 + er) * 1024 + n0 + ec] = f2bf(tot[a][r]);
            }
    }
}


DEV void phase_merge2(const Params& p, int l, int M, char* smem) {
    bf16_t* sm = (bf16_t*)smem;
    const bf16_t* Y = wsb(p, OFF_Y);
    const bf16_t* W = wsb(p, OFF_WBR);
    const unsigned char* G = (const unsigned char*)(wsp(p) + OFF_GATE);
    bf16_t* MG = wsb(p, OFF_H);
    bf16_t* As = sm;
    bf16_t* Bs = sm + 2 * GSTAGE;
    const int tid = tidx(), lane = tid & 63, wave = tid >> 6, wm = wave >> 1, wn = wave & 1;
    const int soff = (tid >> 3) * GLD + (tid & 7) * 8;
    const int arow0 = (wm * 64 + (lane & 31)) * GLD + (lane >> 5) * 8;
    const int brow0 = (wn * 64 + (lane & 31)) * GLD + (lane >> 5) * 8;
    const int nMt = M / 128, nNt = 8;
    for (int item = bidx(); item < nMt * nNt; item += gridDim.x) {
        const int mt = item / nNt, nt = item % nNt, m0 = mt * 128, n0 = nt * 128;
        const bf16_t* ap[4];
        const bf16_t* bp0 = W + (size_t)(n0 + (tid >> 3)) * 256 + (tid & 7) * 8;
        const unsigned char* gp0 = G + (size_t)(m0 + (tid >> 3)) * 4096 + n0 + (tid & 7) * 16;
#pragma unroll
        for (int i = 0; i < 4; ++i) {
            const int q = tid + i * NT;
            ap[i] = Y + (size_t)(m0 + (q >> 3)) * 1024 + (q & 7) * 8;
        }
        f32x16 tot[2][2], acc[2][2];
#pragma unroll
        for (int a = 0; a < 2; ++a)
#pragma unroll
            for (int j = 0; j < 2; ++j)
#pragma unroll
                for (int r = 0; r < 16; ++r) { tot[a][j][r] = 0.f; acc[a][j][r] = 0.f; }
        u32x4 ra[4], rb[4], rg[4];
#pragma unroll
        for (int i = 0; i < 4; ++i) { ra[i] = *(const u32x4*)ap[i]; rb[i] = *(const u32x4*)(bp0 + i * 32 * 256); }
        __syncthreads();
#pragma unroll
        for (int i = 0; i < 4; ++i) { *(u32x4*)(As + soff + i * 32 * GLD) = ra[i]; *(u32x4*)(Bs + soff + i * 32 * GLD) = rb[i]; }
        __syncthreads();
#pragma unroll
        for (int kt = 0; kt < 16; ++kt) {
            const int cur = kt & 1, seg = kt >> 2;
            if (kt + 1 < 16) {
                const int k1 = kt + 1;
#pragma unroll
                for (int i = 0; i < 4; ++i) { ra[i] = *(const u32x4*)(ap[i] + k1 * 64); rb[i] = *(const u32x4*)(bp0 + i * 32 * 256 + (size_t)(k1 >> 2) * (1024 * 256) + (k1 & 3) * 64); }
            }
            if ((kt & 3) == 0) {
#pragma unroll
                for (int i = 0; i < 4; ++i) rg[i] = *(const u32x4*)(gp0 + (size_t)i * 32 * 4096 + seg * 1024);
            }
            const bf16_t* a_s = As + cur * GSTAGE + arow0;
            const bf16_t* b_s = Bs + cur * GSTAGE + brow0;
#pragma unroll
            for (int ks = 0; ks < 4; ++ks) {
                const bf16x8 a0 = *(const bf16x8*)(a_s + ks * 16), a1 = *(const bf16x8*)(a_s + 32 * GLD + ks * 16);
                const bf16x8 b0 = *(const bf16x8*)(b_s + ks * 16), b1 = *(const bf16x8*)(b_s + 32 * GLD + ks * 16);
                acc[0][0] = __builtin_amdgcn_mfma_f32_32x32x16_bf16(a0, b0, acc[0][0], 0, 0, 0);
                acc[1][0] = __builtin_amdgcn_mfma_f32_32x32x16_bf16(a1, b0, acc[1][0], 0, 0, 0);
                acc[0][1] = __builtin_amdgcn_mfma_f32_32x32x16_bf16(a0, b1, acc[0][1], 0, 0, 0);
                acc[1][1] = __builtin_amdgcn_mfma_f32_32x32x16_bf16(a1, b1, acc[1][1], 0, 0, 0);
            }
            if (kt + 1 < 16) {
                const int nx = cur ^ 1;
#pragma unroll
                for (int i = 0; i < 4; ++i) { *(u32x4*)(As + nx * GSTAGE + soff + i * 32 * GLD) = ra[i]; *(u32x4*)(Bs + nx * GSTAGE + soff + i * 32 * GLD) = rb[i]; }
            }
            __syncthreads();
            if ((kt & 3) == 3) {
                unsigned char* Gs = (unsigned char*)(As + cur * GSTAGE);
#pragma unroll
                for (int i = 0; i < 4; ++i) { const int q = tid + i * NT; *(u32x4*)(Gs + (q >> 3) * 128 + (q & 7) * 16) = rg[i]; }
                __syncthreads();
#pragma unroll
                for (int a = 0; a < 2; ++a)
#pragma unroll
                    for (int j = 0; j < 2; ++j)
#pragma unroll
                        for (int r = 0; r < 16; ++r) {
                            const int er = wm * 64 + a * 32 + (r & 3) + 8 * (r >> 2) + 4 * (lane >> 5), ec = wn * 64 + j * 32 + (lane & 31);
                            tot[a][j][r] += (float)Gs[er * 128 + ec] * (1.f / 255.f) * acc[a][j][r];
                            acc[a][j][r] = 0.f;
                        }
                if (kt + 1 < 16) __syncthreads();
            }
        }
#pragma unroll
        for (int a = 0; a < 2; ++a)
#pragma unroll
            for (int j = 0; j < 2; ++j)
#pragma unroll
                for (int r = 0; r < 16; ++r) {
                    const int er = wm * 64 + a * 32 + (r & 3) + 8 * (r >> 2) + 4 * (lane >> 5), ec = wn * 64 + j * 32 + (lane & 31);
                    MG[(size_t)(m0 + er) * 1024 + n0 + ec] = f2bf(tot[a][j][r]);
                }
    }
}

DEV void phase_outproj(const Params& p, int l, int M, char* smem) {
    bf16_t* sm = (bf16_t*)smem;
    const bf16_t* MG = wsb(p, OFF_H);
    const bf16_t* W = wsb(p, OFF_WOUT);
    const float* xs = (l == 0) ? inp(p, I_X) : p.out;
    const float* cs = (l == 0) ? inp(p, I_CTX) : wsf(p, OFF_CX);
    float* cxd = wsf(p, OFF_CX);
    float* outd = p.out;
    const int nLat = (TL / 128) * 8, nCtx = M > TL ? ((M - TL) / 128) * 16 : 0;
    for (int item = bidx(); item < nLat + nCtx; item += gridDim.x) {
        if (item < nLat) {
            const int mt = item >> 3, nt = item & 7, m0 = mt * 128, n0 = nt * 128;
            f32x16 acc[2][2]; acc_zero<2>(acc);
            gemm_mainloop(acc, [&](int r) { return MG + (size_t)(m0 + r) * 1024; }, [&](int r) { return W + (size_t)(n0 + r) * 1024; }, 1024, sm);
            const float* g1 = modp(p, l, mod_row(m0), 2);
            {
                const int lane_ = tidx() & 63, wave_ = tidx() >> 6, wm_ = wave_ >> 1, wn_ = wave_ & 1;
#pragma unroll
                for (int i = 0; i < 2; ++i)
#pragma unroll
                    for (int j = 0; j < 2; ++j) {
                        const int ec = wn_ * 64 + j * 32 + (lane_ & 31);
                        const float gv = g1[n0 + ec];
                        const size_t o0 = (size_t)(m0 + wm_ * 64 + i * 32 + 4 * (lane_ >> 5)) * 1024 + n0 + ec;
                        float xv[16];
#pragma unroll
                        for (int r = 0; r < 16; ++r) xv[r] = xs[o0 + (size_t)((r & 3) + 8 * (r >> 2)) * 1024];
#pragma unroll
                        for (int r = 0; r < 16; ++r) outd[o0 + (size_t)((r & 3) + 8 * (r >> 2)) * 1024] = xv[r] + gv * acc[i][j][r];
                    }
            }
        } else {
            const int it = item - nLat, mt = it >> 4, nt = it & 15, m0 = TL + mt * 128, n0 = nt * 64;
            f32x16 acc[2][1]; acc_zero<1>(acc);
            gemm_mainloop<true, 1>(acc, [&](int r) { return MG + (size_t)(m0 + r) * 1024; }, [&](int r) { return W + (size_t)(n0 + r) * 1024; }, 1024, sm);
            const float* g1 = modp(p, l, mod_row(m0), 2);
            const int lane = tidx() & 63, wave = tidx() >> 6, wm = wave >> 1, wn = wave & 1;
#pragma unroll
            for (int a = 0; a < 2; ++a)
                {
                    const int ec = wn * 32 + (lane & 31);
                    const float gv = g1[n0 + ec];
                    const size_t o0 = (size_t)(m0 - TL + wm * 64 + a * 32 + 4 * (lane >> 5)) * 1024 + n0 + ec;
                    float xv[16];
#pragma unroll
                    for (int r = 0; r < 16; ++r) xv[r] = cs[o0 + (size_t)((r & 3) + 8 * (r >> 2)) * 1024];
#pragma unroll
                    for (int r = 0; r < 16; ++r) cxd[o0 + (size_t)((r & 3) + 8 * (r >> 2)) * 1024] = xv[r] + gv * acc[a][0][r];
                }
        }
    }
}

constexpr int MOE_MAP_OFF = 73728;
DEV void moe_map(const Params& p, int l, char* smem) {
    int* mm = (int*)(smem + MOE_MAP_OFF);
    __syncthreads();
    if (tidx() == 0) {
        const int* cnt = (const int*)(wsp(p) + OFF_CTR) + CTR_MOE + l * 16;
        int b = 0, t = 0;
        for (int e = 0; e < 16; ++e) { const int c = cnt[e]; mm[e] = c; mm[16 + e] = b; mm[32 + e] = t; b += c; t += (c + 127) >> 7; }
        mm[48] = t;
    }
    __syncthreads();
}
DEV void phase_moe1(const Params& p, int l, char* smem) {
    bf16_t* sm = (bf16_t*)smem;
    const bf16_t* F = wsb(p, OFF_H);
    const bf16_t* W = wsb(p, OFF_WG1);
    bf16_t* ACT = wsb(p, OFF_P);
    const int* ltok = (const int*)(wsp(p) + OFF_LTOK);
    moe_map(p, l, smem); const int* mm = (const int*)(smem + MOE_MAP_OFF);
    const int nNt = 8, total = mm[48] * nNt;
    for (int item = bidx(); item < total; item += gridDim.x) {
        const int mtg = item / nNt, nt = item % nNt;
        int e = 0;
        for (int q = 1; q < 16; ++q) if (mtg >= mm[32 + q]) e = q;
        const int m0 = (mtg - mm[32 + e]) * 128, n0 = nt * 128, ce = mm[e];
        const int* lt = ltok + (size_t)e * TT;
        f32x16 acc[2][2]; acc_zero<2>(acc);
        gemm_mainloop(acc, [&](int r) { int idx = m0 + r; idx = idx < ce ? idx : ce - 1; return F + (size_t)lt[idx] * 1024; },
                      [&](int r) { return W + ((size_t)e * 1024 + n0 + r) * 1024; }, 1024, sm);
        const int lane = tidx() & 63, wave = tidx() >> 6, wm = wave >> 1, wn = wave & 1;
        const int jcol = ((n0 >> 6) + wn) * 32 + (lane & 31);
#pragma unroll
        for (int a = 0; a < 2; ++a)
#pragma unroll
            for (int r = 0; r < 16; ++r) {
                const int idx = m0 + wm * 64 + a * 32 + (r & 3) + 8 * (r >> 2) + 4 * (lane >> 5);
                if (idx < ce) {
                    const float g = acc[a][0][r], u = acc[a][1][r];
                    ACT[(size_t)(mm[16 + e] + idx) * DFF + jcol] = f2bf(g * sigmoidf_(g) * u);
                }
            }
    }
}
DEV void phase_moe2(const Params& p, int l, char* smem) {
    bf16_t* sm = (bf16_t*)smem;
    const bf16_t* ACT = wsb(p, OFF_P);
    const bf16_t* W = wsb(p, OFF_WDN);
    bf16_t* Z = wsb(p, OFF_Z);
    moe_map(p, l, smem); const int* mm = (const int*)(smem + MOE_MAP_OFF);
    const int nNt = 8, total = mm[48] * nNt;
    for (int item = bidx(); item < total; item += gridDim.x) {
        const int mtg = item / nNt, nt = item % nNt;
        int e = 0;
        for (int q = 1; q < 16; ++q) if (mtg >= mm[32 + q]) e = q;
        const int m0 = (mtg - mm[32 + e]) * 128, n0 = nt * 128, ce = mm[e];
        f32x16 acc[2][2]; acc_zero<2>(acc);
        gemm_mainloop(acc, [&](int r) { int idx = m0 + r; idx = idx < ce ? idx : ce - 1; return ACT + (size_t)(mm[16 + e] + idx) * DFF; },
                      [&](int r) { return W + ((size_t)e * 1024 + n0 + r) * DFF; }, DFF, sm);
        bf16_t* zb = Z + (size_t)mm[16 + e] * 1024;
        EPI_FOREACH(acc, { const int idx = m0 + er; if (idx < ce) zb[(size_t)idx * 1024 + n0 + ec] = f2bf(ev); })
    }
}
DEV void tok_seq(int t, int& base, int& n, int& len) {
    if (t < TL) { base = t & ~(SEQ - 1); n = t & (SEQ - 1); len = SEQ; } else { const int u = t - TL; base = TL + (u & ~(CTXL - 1)); n = u & (CTXL - 1); len = CTXL; }
}
DEV void phase_prep1(const Params& p, int l) {
    const int lane = tidx() & 63, wave = tidx() >> 6;
    bf16_t* P = wsb(p, OFF_P);
    bf16_t* XL = wsb(p, OFF_XL);
    const float* qkg = inp(p, I_DAQKG) + l * 64;
    const float* cqg = inp(p, I_MCQG) + l * 192;
    const float* ckvg = inp(p, I_MCKVG) + l * 128;
    const float* mu3 = inp(p, I_RMU) + (l * 4 + 3) * 256;
    struct TokIn { u32x2 q, k, d0, dp, dn; unsigned short cq[3], ckv[2]; };
    auto load_tok = [&](int t, TokIn& in) {
        const bf16_t* row = P + (size_t)t * LDP;
        int base, n, len; tok_seq(t, base, n, len);
        in.q = *(const u32x2*)(row + C_DAQ + lane * 4); in.k = *(const u32x2*)(row + C_DAK + lane * 4);
#pragma unroll
        for (int j = 0; j < 3; ++j) in.cq[j] = (unsigned short)row[C_CQ + lane + j * 64];
#pragma unroll
        for (int j = 0; j < 2; ++j) in.ckv[j] = (unsigned short)row[C_CKV + lane + j * 64];
        const bf16_t* rp = n > 0 ? row - LDP : row; const bf16_t* rn = n + 1 < len ? row + LDP : row;
        in.d0 = *(const u32x2*)(row + C_RWD + lane * 4); in.dp = *(const u32x2*)(rp + C_RWD + lane * 4); in.dn = *(const u32x2*)(rn + C_RWD + lane * 4);
    };
    const int tstep = gridDim.x * 4;
    TokIn nxt;
    if (bidx() * 4 + wave < TT) load_tok(bidx() * 4 + wave, nxt);
    for (int t = bidx() * 4 + wave; t < TT; t += tstep) {
        bf16_t* row = P + (size_t)t * LDP;
        int base, n, len; tok_seq(t, base, n, len);
        const TokIn in = nxt;
        load_tok(t + tstep < TT ? t + tstep : t, nxt);
        {
            const int d0 = (lane & 7) * 4;
            float cs[4], sn[4];
            const bool rot = t < TL;
            if (rot) {
                const float fr = (float)(n >> 6), fc = (float)(n & 63);
#pragma unroll
                for (int j = 0; j < 4; ++j) {
                    const int i = (d0 + j) & 15;
                    const float inv = exp2f(-(float)(i & 7) * (13.287712379549449f / 8.f));
                    const float ang = (i < 8 ? fr : fc) * inv;
                    cs[j] = __cosf(ang); sn[j] = __sinf(ang);
                }
            }
#pragma unroll
            for (int which = 0; which < 2; ++which) {
                bf16_t* ptr = row + (which ? C_DAK : C_DAQ) + lane * 4;
                const u32x2 raw = which ? in.k : in.q;
                float v[4] = { bflo(raw.x), bfhi(raw.x), bflo(raw.y), bfhi(raw.y) };
                float ss = v[0] * v[0] + v[1] * v[1] + v[2] * v[2] + v[3] * v[3];
                ss = group_sum<8>(ss);
                const float rstd = rsqrtf(ss * (1.f / 32.f) + EPS);
                const float* g = qkg + which * 32 + d0;
#pragma unroll
                for (int j = 0; j < 4; ++j) v[j] = v[j] * rstd * g[j];
                if (rot) {
#pragma unroll
                    for (int j = 0; j < 4; ++j) {
                        const float oa = __int_as_float(__builtin_amdgcn_mov_dpp(__float_as_int(v[j]), 0x124, 0xf, 0xf, true));
                        const float ob = __int_as_float(__builtin_amdgcn_mov_dpp(__float_as_int(v[j]), 0x12C, 0xf, 0xf, true));
                        const float o = (lane & 4) ? oa : ob;
                        v[j] = (d0 < 16) ? (v[j] * cs[j] - o * sn[j]) : (v[j] * cs[j] + o * sn[j]);
                    }
                }
                if (which == 0) {
                    const float qs = 0.17677669529663687f * LOG2E;
#pragma unroll
                    for (int j = 0; j < 4; ++j) v[j] *= qs;
                }
                u32x2 o; o.x = pack2(v[0], v[1]); o.y = pack2(v[2], v[3]);
                *(u32x2*)ptr = o;
            }
        }
        {
            float v[3]; float ss = 0.f;
#pragma unroll
            for (int j = 0; j < 3; ++j) { v[j] = bf2f((bf16_t)in.cq[j]); ss += v[j] * v[j]; }
            ss = wave_sum(ss);
            const float rstd = rsqrtf(ss * (1.f / 192.f) + EPS);
#pragma unroll
            for (int j = 0; j < 3; ++j) row[C_CQ + lane + j * 64] = f2bf(v[j] * rstd * cqg[lane + j * 64]);
            float w[2]; float s2 = 0.f;
#pragma unroll
            for (int j = 0; j < 2; ++j) { w[j] = bf2f((bf16_t)in.ckv[j]); s2 += w[j] * w[j]; }
            s2 = wave_sum(s2);
            const float r2 = rsqrtf(s2 * (1.f / 128.f) + EPS);
#pragma unroll
            for (int j = 0; j < 2; ++j) row[C_CKV + lane + j * 64] = f2bf(w[j] * r2 * ckvg[lane + j * 64]);
        }
        {
            const int c = lane * 4;
            const u32x2 cur = in.d0;
            const u32x2 z2 = (u32x2){0u, 0u};
            const u32x2 pv = n > 0 ? in.dp : z2, nx = n + 1 < len ? in.dn : z2;
            const float4 m = *(const float4*)(mu3 + c);
            float o[4];
            { const float x = bflo(cur.x); o[0] = x + (0.5f * (bflo(pv.x) + bflo(nx.x)) - x) * m.x; }
            { const float x = bfhi(cur.x); o[1] = x + (0.5f * (bfhi(pv.x) + bfhi(nx.x)) - x) * m.y; }
            { const float x = bflo(cur.y); o[2] = x + (0.5f * (bflo(pv.y) + bflo(nx.y)) - x) * m.z; }
            { const float x = bfhi(cur.y); o[3] = x + (0.5f * (bfhi(pv.y) + bfhi(nx.y)) - x) * m.w; }
            u32x2 ov; ov.x = pack2(o[0], o[1]); ov.y = pack2(o[2], o[3]);
            *(u32x2*)(XL + (size_t)t * 256 + c) = ov;
        }
    }
}

DEV void phase_prep_gemm1(const Params& p, int l, char* smem) {
    const bf16_t* P = wsb(p, OFF_P);
    const bf16_t* w = wsb(p, OFF_WSM) + (size_t)l * WS_PER_LAYER;
    bf16_t* QRAW = wsb(p, OFF_QRAW); bf16_t* KVRAW = wsb(p, OFF_KVRAW); bf16_t* LR = wsb(p, OFF_LR);
    int rot = 0;
    gemm_generic_st(P + C_CQ, LDP, TT, w + WS_UQT, 192, 192, 192, [&](int c, float v) { return v; }, QRAW, 192, smem, rot);
    rot += (TT / 128) * 2;
    gemm_generic_st(P + C_CKV, LDP, TT, w + WS_UKVT, 128, 384, 128, [&](int c, float v) { return v; }, KVRAW, 384, smem, rot);
    rot += (TT / 128) * 3;
    gemm_generic_st(wsb(p, OFF_XL), 256, TT, w + WS_W1C, 256, 192, 256,
                    [&](int c, float v) { return c < 64 ? (1.f - 2.f * __builtin_amdgcn_rcpf(__expf(2.f * v) + 1.f)) : (c < 128 ? v : sigmoidf_(v)); }, LR, 192, smem, rot);
}
DEV void phase_prep_gemm2(const Params& p, int l, char* smem) {
    const bf16_t* w = wsb(p, OFF_WSM) + (size_t)l * WS_PER_LAYER;
    const bf16_t* LR = wsb(p, OFF_LR);
    bf16_t* RWX = wsb(p, OFF_RWX);
    bf16_t* P = wsb(p, OFF_P);
    int rot = 0;
    for (int d = 0; d < 2; ++d) {
        const float* w0 = inp(p, I_RW0) + (l * 2 + d) * 256;
        gemm_generic_st(LR + d * 32, 192, TT, w + WS_W2 + (size_t)d * 256 * 64, 64, 256, 64,
                        [&](int c, float v) { return 0.6065306597126334f * sigmoidf_(w0[c] + v); }, RWX + d * 256, 1024, smem, rot);
        rot += (TT / 128) * 2;
        const float* a0 = inp(p, I_RA0) + (l * 2 + d) * 256;
        gemm_generic_st(LR + 64 + d * 32, 192, TT, w + WS_W2 + (size_t)(2 + d) * 256 * 64, 64, 256, 64,
                        [&](int c, float v) { return sigmoidf_(a0[c] + v); }, RWX + 512 + d * 256, 1024, smem, rot);
        rot += (TT / 128) * 2;
    }
    gemm_generic_st(LR + 128, 192, TT, w + WS_G2T, 64, 256, 64, [&](int c, float v) { return v; }, P + C_RWD, LDP, smem, rot);
}

DEV void phase_prep2(const Params& p, int l) {
    const int lane = tidx() & 63, wave = tidx() >> 6;
    const bf16_t* P = wsb(p, OFF_P);
    const bf16_t* QRAW = wsb(p, OFF_QRAW); const bf16_t* KVRAW = wsb(p, OFF_KVRAW);
    bf16_t* MQ = wsb(p, OFF_MLAQ); bf16_t* MK = wsb(p, OFF_MLAK); bf16_t* MV = wsb(p, OFF_MLAV);
    const float* qkg = inp(p, I_MQKG) + l * 96;
    const int h = lane >> 4, j = lane & 15;
    struct TokIn { unsigned short q[3], k[3], v[4]; };
    auto load_tok = [&](int t, TokIn& in) {
#pragma unroll
        for (int k = 0; k < 3; ++k) in.q[k] = (unsigned short)QRAW[(size_t)t * 192 + h * 48 + j + k * 16];
        in.k[0] = (unsigned short)KVRAW[(size_t)t * 384 + h * 96 + j];
        in.k[1] = (unsigned short)KVRAW[(size_t)t * 384 + h * 96 + 16 + j];
        in.k[2] = (unsigned short)P[(size_t)t * LDP + C_KR + j];
#pragma unroll
        for (int k = 0; k < 4; ++k) in.v[k] = (unsigned short)KVRAW[(size_t)t * 384 + h * 96 + 32 + j + k * 16];
    };
    const int tstep = gridDim.x * 4;
    TokIn nxt;
    if (bidx() * 4 + wave < TT) load_tok(bidx() * 4 + wave, nxt);
    for (int t = bidx() * 4 + wave; t < TT; t += tstep) {
        int base, n, len; tok_seq(t, base, n, len);
        const TokIn in = nxt;
        load_tok(t + tstep < TT ? t + tstep : t, nxt);
        const bool rot = t < TL;
        float cs = 1.f, sn = 0.f;
        if (rot) {
            const int i = j & 7;
            const float inv = exp2f(-(float)(i & 3) * (13.287712379549449f / 4.f));
            const float ang = (i < 4 ? (float)(n >> 6) : (float)(n & 63)) * inv;
            cs = __cosf(ang); sn = __sinf(ang);
        }
        {
            float v[3]; float ss = 0.f;
#pragma unroll
            for (int k = 0; k < 3; ++k) { v[k] = bf2f((bf16_t)in.q[k]); ss += v[k] * v[k]; }
            ss = group_sum<16>(ss);
            const float rstd = rsqrtf(ss * (1.f / 48.f) + EPS);
#pragma unroll
            for (int k = 0; k < 3; ++k) v[k] = v[k] * rstd * qkg[j + k * 16];
            if (rot) { const float o = __int_as_float(__builtin_amdgcn_mov_dpp(__float_as_int(v[2]), 0x128, 0xf, 0xf, true)); v[2] = (j < 8) ? (v[2] * cs - o * sn) : (v[2] * cs + o * sn); }
            const float qs = 0.14433756729740643f * LOG2E;
#pragma unroll
            for (int k = 0; k < 3; ++k) MQ[(size_t)t * 192 + h * 48 + j + k * 16] = f2bf(v[k] * qs);
        }
        {
            float v[3]; float ss = 0.f;
            v[0] = bf2f((bf16_t)in.k[0]); v[1] = bf2f((bf16_t)in.k[1]); v[2] = bf2f((bf16_t)in.k[2]);
#pragma unroll
            for (int k = 0; k < 3; ++k) ss += v[k] * v[k];
            ss = group_sum<16>(ss);
            const float rstd = rsqrtf(ss * (1.f / 48.f) + EPS);
#pragma unroll
            for (int k = 0; k < 3; ++k) v[k] = v[k] * rstd * qkg[48 + j + k * 16];
            if (rot) { const float o = __int_as_float(__builtin_amdgcn_mov_dpp(__float_as_int(v[2]), 0x128, 0xf, 0xf, true)); v[2] = (j < 8) ? (v[2] * cs - o * sn) : (v[2] * cs + o * sn); }
#pragma unroll
            for (int k = 0; k < 3; ++k) MK[(size_t)t * 192 + h * 48 + j + k * 16] = f2bf(v[k]);
        }
#pragma unroll
        for (int k = 0; k < 4; ++k) MV[(size_t)t * 256 + h * 64 + j + k * 16] = (bf16_t)in.v[k];
    }
}
template <int NC, int DK>
struct AttnCfg {
    static constexpr int DKROW = NC * DK, KLD = DKROW + 8, VLD = 96;
    static constexpr int KSTAGE = 64 * KLD, VSTAGE = 64 * VLD;
    static constexpr int KCH = 64 * DKROW / 8;
};
template <int NC, int DK, class EPI>
DEV void attn_item(const bf16_t* Q, int ldq, const bf16_t* Kl, const bf16_t* Kc, int ldk, const bf16_t* Vl, const bf16_t* Vc, int ldv,
                   int q0, int nlat_tiles, int nctx_tiles, EPI epi, char* smem) {
    using C = AttnCfg<NC, DK>;
    constexpr int KS = DK / 16;
    const int tid = tidx(), lane = tid & 63, wave = tid >> 6, ql = lane & 31, hh = lane >> 5;
    bf16_t* Ks = (bf16_t*)smem;
    bf16_t* Vt = Ks + 2 * C::KSTAGE;
    bf16x8 qf[NC][KS];
    {
        const bf16_t* qp = Q + (size_t)(q0 + wave * 32 + ql) * ldq + hh * 8;
#pragma unroll
        for (int c = 0; c < NC; ++c)
#pragma unroll
            for (int ks = 0; ks < KS; ++ks) qf[c][ks] = *(const bf16x8*)(qp + c * DK + ks * 16);
    }
    bf16x8* qpark = (bf16x8*)(smem + 45056) + tid;
    if (NC > 1) {
#pragma unroll
        for (int c = 0; c < NC; ++c)
#pragma unroll
            for (int ks = 0; ks < KS; ++ks) qpark[(c * KS + ks) * NT] = qf[c][ks];
    }
    f32x16 O[NC][2];
    float mrun[NC], lrun[NC];
#pragma unroll
    for (int c = 0; c < NC; ++c) {
        mrun[c] = -1e30f; lrun[c] = 0.f;
#pragma unroll
        for (int d = 0; d < 2; ++d)
#pragma unroll
            for (int r = 0; r < 16; ++r) O[c][d][r] = 0.f;
    }
    const int ntiles = nlat_tiles + nctx_tiles;
    constexpr int KPT = (C::KCH + NT - 1) / NT;
    constexpr bool KFULL = (C::KCH % NT) == 0;
    u32x4 rk[KPT], rv[2];
    auto load_tile = [&](int tile) {
        const bf16_t* kb = tile < nlat_tiles ? Kl + (size_t)tile * 64 * ldk : Kc + (size_t)(tile - nlat_tiles) * 64 * ldk;
        const bf16_t* vb = tile < nlat_tiles ? Vl + (size_t)tile * 64 * ldv : Vc + (size_t)(tile - nlat_tiles) * 64 * ldv;
#pragma unroll
        for (int i = 0; i < KPT; ++i) {
            int q = tid + i * NT; q = (KFULL || q < C::KCH) ? q : C::KCH - 1;
            { const int key = q / (C::DKROW / 8), ch = q % (C::DKROW / 8); rk[i] = *(const u32x4*)(kb + (size_t)key * ldk + ch * 8); }
        }
#pragma unroll
        for (int i = 0; i < 2; ++i) { const int q = tid + i * NT; const int key = q >> 3, ch = q & 7; rv[i] = *(const u32x4*)(vb + (size_t)key * ldv + ch * 8); }
    };
    auto store_tile = [&](int st) {
#pragma unroll
        for (int i = 0; i < KPT; ++i) {
            const int q = tid + i * NT;
            if (KFULL || q < C::KCH) { const int key = q / (C::DKROW / 8), ch = q % (C::DKROW / 8); *(u32x4*)(Ks + st * C::KSTAGE + key * C::KLD + ch * 8) = rk[i]; }
        }
#pragma unroll
        for (int i = 0; i < 2; ++i) { const int q = tid + i * NT; const int key = q >> 3, ch = q & 7; *(u32x4*)(Vt + st * C::VSTAGE + key * C::VLD + ch * 8) = rv[i]; }
    };
    typedef short s16x4_ __attribute__((ext_vector_type(4)));
    typedef __attribute__((address_space(3))) s16x4_ lds_s16x4_;
    const int vrd_off = (4 * hh + ((lane & 15) >> 2)) * C::VLD + 16 * ((lane >> 4) & 1) + 4 * (lane & 3);
    load_tile(0);
    __syncthreads();
    store_tile(0);
    __syncthreads();
#pragma unroll 1
    for (int tile = 0; tile < ntiles; ++tile) {
        const int cur = tile & 1;
        if (tile + 1 < ntiles) load_tile(tile + 1);
        __builtin_amdgcn_sched_barrier(0);
        const bf16_t* ks_ = Ks + cur * C::KSTAGE;
        const bf16_t* vt_ = Vt + cur * C::VSTAGE;
#pragma unroll
        for (int c = 0; c < NC; ++c) {
            f32x16 S[2];
#pragma unroll
            for (int kb = 0; kb < 2; ++kb) {
#pragma unroll
                for (int r = 0; r < 16; ++r) S[kb][r] = 0.f;
#pragma unroll
                for (int ks = 0; ks < KS; ++ks) {
                    const bf16x8 kf = *(const bf16x8*)(ks_ + (kb * 32 + ql) * C::KLD + c * DK + ks * 16 + hh * 8);
                    const bf16x8 qv = (NC > 1) ? qpark[(c * KS + ks) * NT] : qf[c][ks];
                    S[kb] = __builtin_amdgcn_mfma_f32_32x32x16_bf16(kf, qv, S[kb], 0, 0, 0);
                }
            }
            float mx = S[0][0];
#pragma unroll
            for (int kb = 0; kb < 2; ++kb)
#pragma unroll
                for (int r = 0; r < 16; ++r) mx = fmaxf(mx, S[kb][r]);
            mx = xhalf_max(mx);
            if (__builtin_amdgcn_ballot_w64(mx > mrun[c] + 8.f) != 0ull) {
                const float mnew = fmaxf(mrun[c], mx);
                const float alpha = __builtin_amdgcn_exp2f(mrun[c] - mnew);
                mrun[c] = mnew;
                lrun[c] *= alpha;
#pragma unroll
                for (int d = 0; d < 2; ++d)
#pragma unroll
                    for (int r = 0; r < 16; ++r) O[c][d][r] *= alpha;
            }
            const float mcur = mrun[c];
            float ls = 0.f;
#pragma unroll
            for (int kb = 0; kb < 2; ++kb)
#pragma unroll
                for (int r = 0; r < 16; ++r) { const float e = __builtin_amdgcn_exp2f(S[kb][r] - mcur); S[kb][r] = e; ls += e; }
            lrun[c] += ls;
#pragma unroll
            for (int s = 0; s < 4; ++s) {
                const int kb = s >> 1, s2 = s & 1;
                const u32x4 pu = (u32x4){pack2(S[kb][8 * s2 + 0], S[kb][8 * s2 + 1]), pack2(S[kb][8 * s2 + 2], S[kb][8 * s2 + 3]),
                                         pack2(S[kb][8 * s2 + 4], S[kb][8 * s2 + 5]), pack2(S[kb][8 * s2 + 6], S[kb][8 * s2 + 7])};
                const bf16x8 pf = __builtin_bit_cast(bf16x8, pu);
#pragma unroll
                for (int d = 0; d < 2; ++d) {
                    const bf16_t* vp = vt_ + vrd_off + (kb * 32 + 16 * s2) * C::VLD + d * 32;
                    const s16x4_ lo = __builtin_amdgcn_ds_read_tr16_b64_v4i16((lds_s16x4_*)vp), hi = __builtin_amdgcn_ds_read_tr16_b64_v4i16((lds_s16x4_*)(vp + 8 * C::VLD));
                    const bf16x8 vf = __builtin_shufflevector(lo, hi, 0, 1, 2, 3, 4, 5, 6, 7);
                    O[c][d] = __builtin_amdgcn_mfma_f32_32x32x16_bf16(vf, pf, O[c][d], 0, 0, 0);
                }
            }
        }
        if (tile + 1 < ntiles) store_tile(cur ^ 1);
        __syncthreads();
    }
    float inv[NC];
#pragma unroll
    for (int c = 0; c < NC; ++c) { const float lt = xhalf_sum(lrun[c]); inv[c] = __builtin_amdgcn_rcpf(lt); }
    epi(O, inv, q0 + wave * 32 + ql, hh);
}

DEV void da_item(const Params& p, int l, int item, char* smem) {
    const bf16_t* P = wsb(p, OFF_P);
    bf16_t* Y = wsb(p, OFF_Y);
    const float linit = 0.8f - 0.6f * __expf(-0.3f * (float)l);
    float lam;
    {
        const float* la = inp(p, I_DALAM) + l * 128;
        const int lane = tidx() & 63;
        float a = lane < 32 ? la[lane] * la[32 + lane] : 0.f, b = lane < 32 ? la[64 + lane] * la[96 + lane] : 0.f;
        a = wave_sum(a); b = wave_sum(b);
        lam = __expf(a) - __expf(b) + linit;
    }
    const float* sg = inp(p, I_DASUB) + l * 64;
    int b, h, qt; bool isctx;
    if (item < 512) { isctx = false; b = item >> 6; h = (item >> 4) & 3; qt = item & 15; }
    else { const int it = item - 512; isctx = true; b = it >> 3; h = (it >> 1) & 3; qt = it & 1; }
    const size_t lat0 = (size_t)b * SEQ, ctx0 = (size_t)TL + (size_t)b * CTXL;
    const size_t qrow0 = isctx ? ctx0 : lat0;
    auto epi2 = [&](f32x16 (&O)[2][2], float (&inv)[2], int qrow, int hh) {
        float v[2][16]; float ss = 0.f;
        const float li1 = lam * inv[1];
#pragma unroll
        for (int d = 0; d < 2; ++d)
#pragma unroll
            for (int r = 0; r < 16; ++r) { const float o = O[0][d][r] * inv[0] - li1 * O[1][d][r]; v[d][r] = o; ss += o * o; }
        ss = xhalf_sum(ss);
        const float rstd = rsqrtf(ss * (1.f / 64.f) + EPS) * (1.f - linit);
        bf16_t* yo = Y + (qrow0 + qrow) * 1024 + h * 64;
        float4 sg4[2][4];
#pragma unroll
        for (int d = 0; d < 2; ++d)
#pragma unroll
            for (int g = 0; g < 4; ++g) sg4[d][g] = *(const float4*)(sg + d * 32 + 8 * g + 4 * hh);
#pragma unroll
        for (int d = 0; d < 2; ++d)
#pragma unroll
            for (int g = 0; g < 4; ++g) {
                const int dv = d * 32 + 8 * g + 4 * hh;
                u32x2 o;
                o.x = pack2(v[d][4 * g + 0] * rstd * sg4[d][g].x, v[d][4 * g + 1] * rstd * sg4[d][g].y);
                o.y = pack2(v[d][4 * g + 2] * rstd * sg4[d][g].z, v[d][4 * g + 3] * rstd * sg4[d][g].w);
                *(u32x2*)(yo + dv) = o;
            }
    };
    const bf16_t* Qp = P + qrow0 * LDP + C_DAQ + h * 64;
    const bf16_t* Kl = P + lat0 * LDP + C_DAK + h * 64;
    const bf16_t* Kc = P + ctx0 * LDP + C_DAK + h * 64;
    const bf16_t* Vl = P + lat0 * LDP + C_DAV + h * 64;
    const bf16_t* Vc = P + ctx0 * LDP + C_DAV + h * 64;
    const int nlat = isctx ? 0 : SEQ / 64;
    attn_item<2, 32>(Qp, LDP, Kl, Kc, LDP, Vl, Vc, LDP, qt * 128, nlat, CTXL / 64, epi2, smem);
}
DEV void mla_item(const Params& p, int l, int item, char* smem) {
    const bf16_t* MQ = wsb(p, OFF_MLAQ); const bf16_t* MK = wsb(p, OFF_MLAK); const bf16_t* MV = wsb(p, OFF_MLAV);
    bf16_t* Y = wsb(p, OFF_Y);
    int b, h, qt; bool isctx;
    if (item < 512) { isctx = false; b = item >> 6; h = (item >> 4) & 3; qt = item & 15; }
    else { const int it = item - 512; isctx = true; b = it >> 3; h = (it >> 1) & 3; qt = it & 1; }
    const size_t lat0 = (size_t)b * SEQ, ctx0 = (size_t)TL + (size_t)b * CTXL;
    const size_t qrow0 = isctx ? ctx0 : lat0;
    auto epi = [&](f32x16 (&O)[1][2], float (&inv)[1], int qrow, int hh) {
        bf16_t* yo = Y + (qrow0 + qrow) * 1024 + 512 + h * 64;
#pragma unroll
        for (int d = 0; d < 2; ++d)
#pragma unroll
            for (int g = 0; g < 4; ++g) {
                const int dv = d * 32 + 8 * g + 4 * hh;
                u32x2 o;
                o.x = pack2(O[0][d][4 * g + 0] * inv[0], O[0][d][4 * g + 1] * inv[0]);
                o.y = pack2(O[0][d][4 * g + 2] * inv[0], O[0][d][4 * g + 3] * inv[0]);
                *(u32x2*)(yo + dv) = o;
            }
    };
    const bf16_t* Qp = MQ + qrow0 * 192 + h * 48;
    const bf16_t* Kl = MK + lat0 * 192 + h * 48;
    const bf16_t* Kc = MK + ctx0 * 192 + h * 48;
    const bf16_t* Vl = MV + lat0 * 256 + h * 64;
    const bf16_t* Vc = MV + ctx0 * 256 + h * 64;
    attn_item<1, 48>(Qp, 192, Kl, Kc, 192, Vl, Vc, 256, qt * 128, isctx ? 0 : SEQ / 64, CTXL / 64, epi, smem);
}
DEV void wave_sync() { __builtin_amdgcn_fence(__ATOMIC_RELEASE, "wavefront"); __builtin_amdgcn_wave_barrier(); __builtin_amdgcn_fence(__ATOMIC_ACQUIRE, "wavefront"); }
DEV int s5_token(int b, int tb, int n) { return tb == 0 ? TL + b * CTXL + n : b * SEQ + (tb - 1) * 256 + n; }
struct S5M { float are, aim; bf16x8* bfl; };
DEV void s5_coef(const Params& p, int gi, int pl, float& are, float& aim, float& cr, float& ci) {
    const float lre = inp(p, I_S5LRE)[gi * 64 + pl], lim = inp(p, I_S5LIM)[gi * 64 + pl];
    const float dt = __expf(inp(p, I_S5LDT)[gi]);
    const float mag = __expf(lre * dt);
    are = mag * __cosf(lim * dt); aim = mag * __sinf(lim * dt);
    const float nr = are - 1.f, ni = aim, den = 1.f / (lre * lre + lim * lim);
    cr = (nr * lre + ni * lim) * den; ci = (ni * lre - nr * lim) * den;
}
DEV void s5_setup(const Params& p, int l, int d, int g, int lane, S5M& s, bf16x8* bfl) {
    s.bfl = bfl;
    const int gi = ((l * 2 + d) * 16 + g), c16 = lane & 15, kq = lane >> 4;
    float cr, ci;
    s5_coef(p, gi, lane, s.are, s.aim, cr, ci);
#pragma unroll
    for (int nt = 0; nt < 4; ++nt) {
        const int pp = nt * 16 + c16;
        float a0, a1; s5_coef(p, gi, pp, a0, a1, cr, ci);
        float re[8], im[8];
        const float* br = inp(p, I_S5BRE) + ((size_t)gi * 64 + pp) * 16 + (kq & 1) * 8;
        const float* bi = inp(p, I_S5BIM) + ((size_t)gi * 64 + pp) * 16 + (kq & 1) * 8;
#pragma unroll
        for (int j = 0; j < 8; ++j) { const float x = br[j], y = bi[j]; const bool on = kq < 2; re[j] = on ? cr * x - ci * y : 0.f; im[j] = on ? cr * y + ci * x : 0.f; }
        bfl[nt * 64 + lane] = __builtin_bit_cast(bf16x8, (u32x4){pack2(re[0], re[1]), pack2(re[2], re[3]), pack2(re[4], re[5]), pack2(re[6], re[7])});
        bfl[(nt + 4) * 64 + lane] = __builtin_bit_cast(bf16x8, (u32x4){pack2(im[0], im[1]), pack2(im[2], im[3]), pack2(im[4], im[5]), pack2(im[6], im[7])});
    }
}
DEV void s5_bu32(const S5M& s, const bf16_t* P, int b, int tb, int g, int sc, bf16_t* hb, int lane) {
    asm volatile("" : "+v"(sc));
    const int c16 = lane & 15, kq = lane >> 4;
    bf16x8 uf[2];
#pragma unroll
    for (int mt = 0; mt < 2; ++mt) {
        const int t = s5_token(b, tb, sc * 32 + mt * 16 + c16);
        const u32x4 raw = *(const u32x4*)(P + (size_t)t * LDP + C_S5 + g * 16 + (kq & 1) * 8);
        const u32x4 z = (u32x4){0u, 0u, 0u, 0u};
        uf[mt] = __builtin_bit_cast(bf16x8, kq < 2 ? raw : z);
    }
#pragma unroll
    for (int nt = 0; nt < 8; ++nt)
#pragma unroll
        for (int mt = 0; mt < 2; ++mt) {
            const f32x4 acc = __builtin_amdgcn_mfma_f32_16x16x32_bf16(s.bfl[nt * 64 + lane], uf[mt], (f32x4){0.f, 0.f, 0.f, 0.f}, 0, 0, 0);
            u32x2 o; o.x = pack2(acc[0], acc[1]); o.y = pack2(acc[2], acc[3]);
            *(u32x2*)(hb + (mt * 16 + c16) * 136 + nt * 16 + kq * 4) = o;
            if (mt == 1 && (nt & 1)) __builtin_amdgcn_sched_barrier(0);
        }
}
template <bool DUMP>
DEV void s5_scan32(const S5M& s, float& hre, float& him, bf16_t* hb, int pl, bool rev) {
#pragma unroll 4
    for (int j = 0; j < 32; ++j) {
        const int rowi = rev ? 31 - j : j;
        const float bur = bf2f(hb[rowi * 136 + pl]), bui = bf2f(hb[rowi * 136 + 64 + pl]);
        const float nre = s.are * hre - s.aim * him + bur;
        const float nim = s.are * him + s.aim * hre + bui;
        hre = nre; him = nim;
        if (DUMP) { hb[rowi * 136 + pl] = f2bf(hre); hb[rowi * 136 + 64 + pl] = f2bf(him); }
    }
}
DEV void phase_s5_pass1(const Params& p, int l, char* smem) {
    const int lane = tidx() & 63, wave = tidx() >> 6;
    bf16_t* hb = (bf16_t*)smem + wave * (32 * 136);
    const bf16_t* P = wsb(p, OFF_P);
    float* st = wsf(p, OFF_S5ST);
    const int nitems = 2 * 8 * 16 * 8;
    for (int it0 = bidx() * 4; it0 < nitems; it0 += gridDim.x * 4) {
        const int it = it0 + wave;
        const int seg = it & 7, g = (it >> 3) & 15, b = (it >> 7) & 7, d = it >> 10;
        const int tb = seg == 0 ? 0 : (d == 0 ? seg : 9 - seg);
        wave_sync();
        S5M s; s5_setup(p, l, d, g, lane, s, (bf16x8*)(smem + 36864) + wave * 512);
        float hre = 0.f, him = 0.f;
        for (int k = 0; k < 8; ++k) {
            const int sc = d == 0 ? k : 7 - k;
            wave_sync();
            s5_bu32(s, P, b, tb, g, sc, hb, lane);
            wave_sync();
            s5_scan32<false>(s, hre, him, hb, lane, d == 1);
        }
        float* o = st + ((((size_t)d * 8 + b) * 16 + g) * 8 + seg) * 128;
        o[lane] = hre; o[64 + lane] = him;
    }
}
DEV void s5_pass2_item(const Params& p, int l, int tb0, int bitem, char* smem) {
    const int lane = tidx() & 63, wave = tidx() >> 6;
    bf16_t* hb = (bf16_t*)smem + wave * (32 * 136);
    bf16_t* P = wsb(p, OFF_P);
    bf16_t* S5Y = wsb(p, OFF_S5Y);
    const float* st = wsf(p, OFF_S5ST);
    const int it = bitem * 4 + wave;
    const int g = it & 15, b = (it >> 4) & 7, tb = (it >> 7) + tb0;
    const int c = lane & 15;
    const float dd = inp(p, I_S5D)[(l * 16 + g) * 16 + c];
#pragma unroll 1
    for (int d = 0; d < 2; ++d) {
        wave_sync();
        S5M s; s5_setup(p, l, d, g, lane, s, (bf16x8*)(smem + 36864) + wave * 512);
        bf16x8 cf[4];
        {
            const float* cre = inp(p, I_S5CRE) + ((size_t)((l * 2 + d) * 16 + g) * 16 + c) * 64 + (lane >> 4) * 8;
            const float* cim = inp(p, I_S5CIM) + ((size_t)((l * 2 + d) * 16 + g) * 16 + c) * 64 + (lane >> 4) * 8;
#pragma unroll
            for (int ks = 0; ks < 4; ++ks) {
                const float* src = ks < 2 ? cre + ks * 32 : cim + (ks - 2) * 32;
                const float4 a = *(const float4*)src, b4 = *(const float4*)(src + 4);
                const float sg = ks < 2 ? 1.f : -1.f;
                cf[ks] = __builtin_bit_cast(bf16x8, (u32x4){pack2(sg * a.x, sg * a.y), pack2(sg * a.z, sg * a.w), pack2(sg * b4.x, sg * b4.y), pack2(sg * b4.z, sg * b4.w)});
            }
        }
        const int seg = tb == 0 ? 0 : (d == 0 ? tb : 9 - tb);
        float hre = 0.f, him = 0.f;
        {
            float pr = s.are, pi = s.aim;
#pragma unroll
            for (int q = 0; q < 8; ++q) { const float nr = pr * pr - pi * pi, ni = 2.f * pr * pi; pr = nr; pi = ni; }
            const float* hs = st + (((size_t)d * 8 + b) * 16 + g) * 8 * 128;
            for (int i = 0; i < seg; ++i) {
                const float er = hs[i * 128 + lane], ei = hs[i * 128 + 64 + lane];
                const float nr = pr * hre - pi * him + er, ni = pr * him + pi * hre + ei;
                hre = nr; him = ni;
            }
        }
#pragma unroll 1
        for (int k = 0; k < 8; ++k) {
            const int sc = d == 0 ? k : 7 - k;
            wave_sync();
            s5_bu32(s, P, b, tb, g, sc, hb, lane);
            wave_sync();
            s5_scan32<true>(s, hre, him, hb, lane, d == 1);
            wave_sync();
#pragma unroll
            for (int mt = 0; mt < 2; ++mt) {
                f32x4 y = (f32x4){0.f, 0.f, 0.f, 0.f};
#pragma unroll
                for (int ks = 0; ks < 4; ++ks) {
                    const bf16x8 af = *(const bf16x8*)(hb + (mt * 16 + (lane & 15)) * 136 + ks * 32 + (lane >> 4) * 8);
                    y = __builtin_amdgcn_mfma_f32_16x16x32_bf16(af, cf[ks], y, 0, 0, 0);
                }
#pragma unroll
                for (int r = 0; r < 4; ++r) {
                    const int n = sc * 32 + mt * 16 + (lane >> 4) * 4 + r;
                    const size_t t = (size_t)s5_token(b, tb, n);
                    if (d == 0) S5Y[t * 256 + g * 16 + c] = f2bf(y[r]);
                    else {
                        bf16_t* up = P + t * LDP + C_S5 + g * 16 + c;
                        const float yy = dd * bf2f(*up) + bf2f(S5Y[t * 256 + g * 16 + c]) + y[r];
                        *up = f2bf(yy * sigmoidf_(1.5957691216057308f * (yy + 0.044715f * yy * yy * yy)));
                    }
                }
            }
        }
    }
}

DEV float row16_sum(float v) {
    v += __int_as_float(__builtin_amdgcn_mov_dpp(__float_as_int(v), 0x128, 0xf, 0xf, true));
    v += __int_as_float(__builtin_amdgcn_mov_dpp(__float_as_int(v), 0x124, 0xf, 0xf, true));
    v += __int_as_float(__builtin_amdgcn_mov_dpp(__float_as_int(v), 0x122, 0xf, 0xf, true));
    v += __int_as_float(__builtin_amdgcn_mov_dpp(__float_as_int(v), 0x121, 0xf, 0xf, true));
    return v;
}
DEV float fmul_(float a, float b) { return a * b; }
DEV float fadd_(float a, float b) { return a + b; }
DEV float ffma_(float a, float b, float c) { return __builtin_fmaf(a, b, c); }
DEV float fnma_(float a, float b, float c) { return __builtin_fmaf(-a, b, c); }
DEV float row8_sum(float v) {
    v += __int_as_float(__builtin_amdgcn_mov_dpp(__float_as_int(v), 0x141, 0xf, 0xf, true));
    v += __int_as_float(__builtin_amdgcn_mov_dpp(__float_as_int(v), 0xB1, 0xf, 0xf, true));
    v += __int_as_float(__builtin_amdgcn_mov_dpp(__float_as_int(v), 0x4E, 0xf, 0xf, true));
    return v;
}
DEV float row16_sum1(float v) { v += __int_as_float(__builtin_amdgcn_mov_dpp(__float_as_int(v), 0x128, 0xf, 0xf, true)); return v; }
constexpr int RW_CT = 16;
struct RwRaw { u32x2 r[3], k[3], v[3], sd, a; float fp, fn; };
#ifndef RWVAR
#define RWVAR 0
#endif
template <int var>
DEV void rw_item_t(const Params& p, int l, int item, char* smem, int rep) {
    const int tid = tidx(), li = tid >> 4, lc = tid & 15;
    const int ch = item >> 2, rg = item & 3, dir = ch >> 5, b = (ch >> 2) & 7, head = ch & 3;
    float* buf = (float*)smem;
    float* ybuf = buf + 2 * RW_CT * 384;
    const bf16_t* P = wsb(p, OFF_P);
    const bf16_t* RWX = wsb(p, OFF_RWX);
    bf16_t* RWY = wsb(p, OFF_RWY) + (size_t)dir * TT * 256 + (rep > 0 ? (size_t)2 * TT * 256 : 0);
    const int hc = head * 64 + lc * 4;
    const float4 mur = *(const float4*)(inp(p, I_RMU) + (l * 4 + 0) * 256 + hc);
    const float4 muk = *(const float4*)(inp(p, I_RMU) + (l * 4 + 1) * 256 + hc);
    const float4 muv = *(const float4*)(inp(p, I_RMU) + (l * 4 + 2) * 256 + hc);
    const float4 kk4 = *(const float4*)(inp(p, I_RKK) + l * 256 + hc);
    const float4 ka4 = *(const float4*)(inp(p, I_RKA) + l * 256 + hc);
    const int NCH = (CTXL + SEQ) / RW_CT;
    auto tok_of = [&](int cidx, int i, int& n, int& len) -> int {
        if (cidx < CTXL / RW_CT) { const int pos = cidx * RW_CT + i; len = CTXL; n = dir == 0 ? pos : CTXL - 1 - pos; return TL + b * CTXL + n; }
        const int pos = (cidx - CTXL / RW_CT) * RW_CT + i; len = SEQ; n = dir == 0 ? pos : SEQ - 1 - pos; return b * SEQ + n;
    };
    const int sgn = dir == 0 ? 1 : -1;
    const bf16_t* Prow0 = P + (ptrdiff_t)(sgn * li) * LDP + hc;
    const bf16_t* Xrow0 = RWX + (ptrdiff_t)(sgn * li) * 1024 + dir * 256 + hc;
    auto load_raw = [&](int cidx, RwRaw& raw) {
        const bool isc = cidx < CTXL / RW_CT;
        const int len = isc ? CTXL : SEQ, c16 = (isc ? cidx : cidx - CTXL / RW_CT) * RW_CT, base = isc ? TL + b * CTXL : b * SEQ;
        const int T0 = base + (dir == 0 ? c16 : len - 1 - c16);
        const int n = (dir == 0 ? c16 : len - 1 - c16) + sgn * li;
        const bool hp = n > 0, hn = n + 1 < len;
        const bf16_t* row = Prow0 + (size_t)T0 * LDP;
        const bf16_t* rp = hp ? row - LDP : row;
        const bf16_t* rn = hn ? row + LDP : row;
        raw.fp = hp ? 0.5f : 0.f; raw.fn = hn ? 0.5f : 0.f;
        raw.r[1] = *(const u32x2*)(row + C_RWR); raw.k[1] = *(const u32x2*)(row + C_RWK); raw.v[1] = *(const u32x2*)(row + C_RWV);
        raw.r[0] = *(const u32x2*)(rp + C_RWR); raw.k[0] = *(const u32x2*)(rp + C_RWK); raw.v[0] = *(const u32x2*)(rp + C_RWV);
        raw.r[2] = *(const u32x2*)(rn + C_RWR); raw.k[2] = *(const u32x2*)(rn + C_RWK); raw.v[2] = *(const u32x2*)(rn + C_RWV);
        const bf16_t* xr = Xrow0 + (size_t)T0 * 1024;
        raw.sd = *(const u32x2*)(xr);
        raw.a = *(const u32x2*)(xr + 512);
    };
    auto mix4 = [&](const u32x2 (&s)[3], const float4& mu, float fp, float fn, float (&o)[4]) {
        { const float x = bflo(s[1].x); o[0] = x + ((fp * bflo(s[0].x) + fn * bflo(s[2].x)) - x) * mu.x; }
        { const float x = bfhi(s[1].x); o[1] = x + ((fp * bfhi(s[0].x) + fn * bfhi(s[2].x)) - x) * mu.y; }
        { const float x = bflo(s[1].y); o[2] = x + ((fp * bflo(s[0].y) + fn * bflo(s[2].y)) - x) * mu.z; }
        { const float x = bfhi(s[1].y); o[3] = x + ((fp * bfhi(s[0].y) + fn * bfhi(s[2].y)) - x) * mu.w; }
    };
    auto stage = [&](int st, const RwRaw& raw) {
        float r4[4], k4[4], v4[4];
        mix4(raw.r, mur, raw.fp, raw.fn, r4); mix4(raw.k, muk, raw.fp, raw.fn, k4); mix4(raw.v, muv, raw.fp, raw.fn, v4);
        const float kkr[4] = { k4[0] * kk4.x, k4[1] * kk4.y, k4[2] * kk4.z, k4[3] * kk4.w };
        float nn = kkr[0] * kkr[0] + kkr[1] * kkr[1] + kkr[2] * kkr[2] + kkr[3] * kkr[3];
        nn = row16_sum(nn);
        const float rn = __builtin_amdgcn_rsqf(fmaxf(nn, 1e-24f));
        const float a[4] = { bflo(raw.a.x), bfhi(raw.a.x), bflo(raw.a.y), bfhi(raw.a.y) };
        const float sd[4] = { bflo(raw.sd.x), bfhi(raw.sd.x), bflo(raw.sd.y), bfhi(raw.sd.y) };
        const float kav[4] = { ka4.x, ka4.y, ka4.z, ka4.w };
        float* d = buf + (st * RW_CT + li) * 384 + lc * 4;
        float wp[4], kp[4], bp[4], mp[4];
#pragma unroll
        for (int j = 0; j < 4; ++j) {
            wp[j] = __expf(-sd[j]);
            kp[j] = kkr[j] * rn;
            bp[j] = kp[j] * a[j];
            mp[j] = k4[j] * (1.f + (a[j] - 1.f) * kav[j]);
        }
        *(float4*)(d + 0) = make_float4(wp[0], wp[1], wp[2], wp[3]); *(float4*)(d + 64) = make_float4(kp[0], kp[1], kp[2], kp[3]);
        *(float4*)(d + 128) = make_float4(bp[0], bp[1], bp[2], bp[3]); *(float4*)(d + 192) = make_float4(mp[0], mp[1], mp[2], mp[3]);
        *(float4*)(d + 256) = make_float4(r4[0], r4[1], r4[2], r4[3]);
        *(float4*)(d + 320) = make_float4(v4[0], v4[1], v4[2], v4[3]);
    };
    f32x2_ Sa = (f32x2_){0.f, 0.f}, Sb = (f32x2_){0.f, 0.f};
    auto compute = [&](int cidx, int cur, const RwRaw& rs, bool do_stage) {
        float sr4[4], sk4[4], sv4[4], skkr[4], srn = 0.f;
        const float* cb = buf + cur * RW_CT * 384 + lc * 4;
        const float* vb = buf + cur * RW_CT * 384 + 320 + rg * 16 + li;
        const bool yb0 = (lc & 4) == 0, yb1 = (lc & 2) == 0, yb2 = (lc & 1) == 0, yb3 = (lc & 8) == 0;
        float yq0 = 0.f, yq1 = 0.f, yq2 = 0.f, yq3 = 0.f, ykeep = 0.f;
        f32x4 w[2], kk[2], bb[2], km[2], rr[2]; float vv[2];
        w[0] = *(const f32x4*)(cb); kk[0] = *(const f32x4*)(cb + 64); bb[0] = *(const f32x4*)(cb + 128); km[0] = *(const f32x4*)(cb + 192); rr[0] = *(const f32x4*)(cb + 256);
        vv[0] = vb[0];
#pragma unroll
        for (int j = 0; j < RW_CT; ++j) {
            const int c0 = j & 1, c2 = c0 ^ 1;
            if (j + 1 < RW_CT) {
                const float* nb = cb + (j + 1) * 384;
                w[c2] = *(const f32x4*)(nb); kk[c2] = *(const f32x4*)(nb + 64); bb[c2] = *(const f32x4*)(nb + 128); km[c2] = *(const f32x4*)(nb + 192); rr[c2] = *(const f32x4*)(nb + 256);
                vv[c2] = vb[(j + 1) * 384];
            }
            const f32x2_ v2 = (f32x2_){vv[c0], vv[c0]};
            const f32x2_ pa = __builtin_elementwise_fma(Sb, kk[c0].zw, Sa * kk[c0].xy);
            const f32x2_ ta = __builtin_elementwise_fma(Sa, w[c0].xy, v2 * km[c0].xy), tb = __builtin_elementwise_fma(Sb, w[c0].zw, v2 * km[c0].zw);
            const float sa = row16_sum(fadd_(pa.x, pa.y));
            const f32x2_ nsa = (f32x2_){-sa, -sa};
            Sa = __builtin_elementwise_fma(nsa, bb[c0].xy, ta); Sb = __builtin_elementwise_fma(nsa, bb[c0].zw, tb);
            const f32x2_ py = __builtin_elementwise_fma(Sb, rr[c0].zw, Sa * rr[c0].xy);
            {
                float c = fadd_(py.x, py.y);
                if (j & 1) {
                    { const float t = yb0 ? yq0 : c, u = yb0 ? c : yq0; c = t + __int_as_float(__builtin_amdgcn_mov_dpp(__float_as_int(u), 0x141, 0xf, 0xf, true)); }
                    if (j & 2) {
                        { const float t = yb1 ? yq1 : c, u = yb1 ? c : yq1; c = t + __int_as_float(__builtin_amdgcn_mov_dpp(__float_as_int(u), 0x4E, 0xf, 0xf, true)); }
                        if (j & 4) {
                            { const float t = yb2 ? yq2 : c, u = yb2 ? c : yq2; c = t + __int_as_float(__builtin_amdgcn_mov_dpp(__float_as_int(u), 0xB1, 0xf, 0xf, true)); }
                            if (j & 8) {
                                const float t = yb3 ? yq3 : c, u = yb3 ? c : yq3; ykeep = t + __int_as_float(__builtin_amdgcn_mov_dpp(__float_as_int(u), 0x128, 0xf, 0xf, true));
                            } else yq3 = c;
                        } else yq2 = c;
                    } else yq1 = c;
                } else yq0 = c;
            }
            if (j == 2) { mix4(rs.r, mur, rs.fp, rs.fn, sr4); }
            if (j == 5) { mix4(rs.k, muk, rs.fp, rs.fn, sk4); }
            if (j == 8) { mix4(rs.v, muv, rs.fp, rs.fn, sv4); }
            if (j == 11) {
                skkr[0] = sk4[0] * kk4.x; skkr[1] = sk4[1] * kk4.y; skkr[2] = sk4[2] * kk4.z; skkr[3] = sk4[3] * kk4.w;
                float nn = skkr[0] * skkr[0] + skkr[1] * skkr[1] + skkr[2] * skkr[2] + skkr[3] * skkr[3];
                nn = row16_sum(nn);
                srn = __builtin_amdgcn_rsqf(fmaxf(nn, 1e-24f));
            }
        }
        if (do_stage) {
            const float a[4] = { bflo(rs.a.x), bfhi(rs.a.x), bflo(rs.a.y), bfhi(rs.a.y) };
            const float sd[4] = { bflo(rs.sd.x), bfhi(rs.sd.x), bflo(rs.sd.y), bfhi(rs.sd.y) };
            const float kav[4] = { ka4.x, ka4.y, ka4.z, ka4.w };
            float* d = buf + ((cur ^ 1) * RW_CT + li) * 384 + lc * 4;
            float wp[4], kp[4], bp[4], mp[4];
#pragma unroll
            for (int q = 0; q < 4; ++q) {
                wp[q] = __expf(-sd[q]);
                kp[q] = skkr[q] * srn;
                bp[q] = kp[q] * a[q];
                mp[q] = sk4[q] * (1.f + (a[q] - 1.f) * kav[q]);
            }
            *(float4*)(d + 0) = make_float4(wp[0], wp[1], wp[2], wp[3]); *(float4*)(d + 64) = make_float4(kp[0], kp[1], kp[2], kp[3]);
            *(float4*)(d + 128) = make_float4(bp[0], bp[1], bp[2], bp[3]); *(float4*)(d + 192) = make_float4(mp[0], mp[1], mp[2], mp[3]);
            *(float4*)(d + 256) = make_float4(sr4[0], sr4[1], sr4[2], sr4[3]);
            *(float4*)(d + 320) = make_float4(sv4[0], sv4[1], sv4[2], sv4[3]);
        }
        {
            const int ys = ((lc >> 2) & 1) | (lc & 2) | ((lc & 1) << 2) | (lc & 8);
            int n, len; const int t = tok_of(cidx, ys, n, len);
            RWY[(size_t)t * 256 + head * 64 + rg * 16 + li] = f2bf(ykeep);
        }
    };
    RwRaw rawA, rawB;
    __syncthreads();
    load_raw(0, rawA);
    stage(0, rawA);
    load_raw(1, rawA);
    __syncthreads();
    for (int cidx = 0; cidx < NCH; cidx += 2) {
        load_raw(min(cidx + 2, NCH - 1), rawB);
        compute(cidx, 0, rawA, true);
        __syncthreads();
        load_raw(min(cidx + 3, NCH - 1), rawA);
        compute(cidx + 1, 1, rawB, cidx + 2 < NCH);
        __syncthreads();
    }
}

DEV void rw_item(const Params& p, int l, int item, char* smem, int rep = 0) {
    __builtin_amdgcn_s_setprio(3);
    rw_item_t<RWVAR>(p, l, item, smem, rep);
    __builtin_amdgcn_s_setprio(0);
}
constexpr int RC = 32, SK = 72, ST = 40;
constexpr int L_K1 = 0, L_R1 = L_K1 + RC * SK, L_B1 = L_R1 + RC * SK, L_M1 = L_B1 + RC * SK,
              L_VT = L_M1 + RC * SK, L_B2T = L_VT + 64 * ST, L_M2T = L_B2T + 64 * ST,
              L_X = L_M2T + 64 * ST, L_XT = L_X + RC * ST, L_PA = L_XT + RC * ST, L_BM = L_PA + RC * ST, L_AR = L_BM + RC * ST, L_BR = L_AR + RC * ST,
              L_ET = L_BR + RC * ST, L_ZT = L_ET + 64 * ST, L_S = L_ZT + 64 * ST, L_RWEND = L_S + 64 * SK;
static_assert(L_RWEND * 2 + 256 <= 73728, "RWKV chunk LDS");
DEV bf16x8 ldfrag(const bf16_t* m, int stride, int row0, int k0, int lane) { return *(const bf16x8*)(m + (row0 + (lane & 15)) * stride + k0 + (lane >> 4) * 8); }
DEV f32x4 mfma16(bf16x8 a, bf16x8 b, f32x4 c) { return __builtin_amdgcn_mfma_f32_16x16x32_bf16(a, b, c, 0, 0, 0); }
#ifndef RWC_CLAMP
#define RWC_CLAMP 0
#endif
DEV void st4(bf16_t* dst, f32x4 v) {
    if (RWC_CLAMP) { for (int i = 0; i < 4; ++i) v[i] = fminf(fmaxf(v[i], -8.f), 8.f); } u32x2 o; o.x = pack2(v[0], v[1]); o.y = pack2(v[2], v[3]); *(u32x2*)dst = o; }
DEV void unpack8(const u32x4 u, float (&o)[8]) {
    o[0] = bflo(u[0]); o[1] = bfhi(u[0]); o[2] = bflo(u[1]); o[3] = bfhi(u[1]); o[4] = bflo(u[2]); o[5] = bfhi(u[2]); o[6] = bflo(u[3]); o[7] = bfhi(u[3]);
}
DEV u32x4 pack8(const float (&v)[8]) { return (u32x4){pack2(v[0], v[1]), pack2(v[2], v[3]), pack2(v[4], v[5]), pack2(v[6], v[7])}; }
struct RwcRaw { u32x4 r[3], k[3], v[3], sd, a; float fp, fn; };
#ifndef RWC_STOP
#define RWC_STOP 99
#endif
#ifndef RWC_DUMMY
#define RWC_DUMMY 0
#endif
#ifdef RWC_NOINLINE
__device__ __attribute__((noinline)) void rwc_item(const Params& p, int l, int chain, char* smem) {
#else
DEV void rwc_item(const Params& p, int l, int chain, char* smem) {
#endif
    const int tid = tidx(), lane = tid & 63, wave = __builtin_amdgcn_readfirstlane(tid >> 6), c16 = lane & 15, q4 = lane >> 4;
    const int dir = chain >> 5, b = (chain >> 2) & 7, head = chain & 3;
    bf16_t* L = (bf16_t*)smem;
    float* PC = (float*)(smem + L_RWEND * 2);
    float* CS = (float*)(L + L_ET);
    const bf16_t* P = wsb(p, OFF_P);
    const bf16_t* RWX = wsb(p, OFF_RWX);
    bf16_t* RWY = wsb(p, OFF_RWY) + (size_t)dir * TT * 256 + (RWC_DUMMY ? (size_t)2 * TT * 256 : 0);
    const int li = tid >> 3, c8 = (tid & 7) * 8, hc = head * 64 + c8;
    const int NCHK = (CTXL + SEQ) / RC;
    auto tok_of = [&](int c, int i, int& n, int& len) -> int {
        if (c < CTXL / RC) { const int pos = c * RC + i; len = CTXL; n = dir == 0 ? pos : CTXL - 1 - pos; return TL + b * CTXL + n; }
        const int pos = (c - CTXL / RC) * RC + i; len = SEQ; n = dir == 0 ? pos : SEQ - 1 - pos; return b * SEQ + n;
    };
    RwcRaw raw;
    auto load_raw = [&](int c) {
        int n, len; const int t = tok_of(c, li, n, len);
        const bf16_t* row = P + (size_t)t * LDP;
        const bool hp = n > 0, hn = n + 1 < len;
        const bf16_t* rp = hp ? row - LDP : row;
        const bf16_t* rn = hn ? row + LDP : row;
        raw.fp = hp ? 0.5f : 0.f; raw.fn = hn ? 0.5f : 0.f;
        raw.r[1] = *(const u32x4*)(row + C_RWR + hc); raw.k[1] = *(const u32x4*)(row + C_RWK + hc); raw.v[1] = *(const u32x4*)(row + C_RWV + hc);
        raw.r[0] = *(const u32x4*)(rp + C_RWR + hc); raw.k[0] = *(const u32x4*)(rp + C_RWK + hc); raw.v[0] = *(const u32x4*)(rp + C_RWV + hc);
        raw.r[2] = *(const u32x4*)(rn + C_RWR + hc); raw.k[2] = *(const u32x4*)(rn + C_RWK + hc); raw.v[2] = *(const u32x4*)(rn + C_RWV + hc);
        raw.sd = *(const u32x4*)(RWX + (size_t)t * 1024 + dir * 256 + hc);
        raw.a = *(const u32x4*)(RWX + (size_t)t * 1024 + 512 + dir * 256 + hc);
    };
    auto mix8 = [&](const u32x4 (&s)[3], const float* mu, float (&o)[8]) {
        float x[8], pv[8], nx[8]; unpack8(s[1], x); unpack8(s[0], pv); unpack8(s[2], nx);
        const float4 m0 = *(const float4*)mu, m1 = *(const float4*)(mu + 4);
        const float m[8] = { m0.x, m0.y, m0.z, m0.w, m1.x, m1.y, m1.z, m1.w };
#pragma unroll
        for (int j = 0; j < 8; ++j) o[j] = x[j] + ((raw.fp * pv[j] + raw.fn * nx[j]) - x[j]) * m[j];
    };
    f32x4 Wt[4];
#pragma unroll
    for (int j = 0; j < 4; ++j) Wt[j] = (f32x4){0.f, 0.f, 0.f, 0.f};
    __syncthreads();
    for (int i = tid; i < 64 * SK / 2; i += NT) ((unsigned*)(L + L_S))[i] = 0u;
    load_raw(0);
    for (int c = 0; c < (RWC_STOP == 0 ? 0 : NCHK); ++c) {
        {
            float r8[8], k8[8], v8[8], a8[8], sd8[8];
            mix8(raw.r, inp(p, I_RMU) + (l * 4 + 0) * 256 + hc, r8);
            mix8(raw.k, inp(p, I_RMU) + (l * 4 + 1) * 256 + hc, k8);
            mix8(raw.v, inp(p, I_RMU) + (l * 4 + 2) * 256 + hc, v8);
            unpack8(raw.a, a8); unpack8(raw.sd, sd8);
            if (c + 1 < NCHK) load_raw(c + 1);
            const float4 kk0 = *(const float4*)(inp(p, I_RKK) + l * 256 + hc), kk1 = *(const float4*)(inp(p, I_RKK) + l * 256 + hc + 4);
            const float4 ka0 = *(const float4*)(inp(p, I_RKA) + l * 256 + hc), ka1 = *(const float4*)(inp(p, I_RKA) + l * 256 + hc + 4);
            const float kkc[8] = { kk0.x, kk0.y, kk0.z, kk0.w, kk1.x, kk1.y, kk1.z, kk1.w };
            const float kac[8] = { ka0.x, ka0.y, ka0.z, ka0.w, ka1.x, ka1.y, ka1.z, ka1.w };
            float kkv[8], bbv[8], kmv[8]; float n2 = 0.f;
#pragma unroll
            for (int j = 0; j < 8; ++j) { kkv[j] = k8[j] * kkc[j]; n2 += kkv[j] * kkv[j]; }
            n2 = row8_sum(n2);
            const float rn = 1.f / fmaxf(sqrtf(n2), 1e-12f);
#pragma unroll
            for (int j = 0; j < 8; ++j) { kkv[j] *= rn; bbv[j] = kkv[j] * a8[j]; kmv[j] = k8[j] * (1.f + (a8[j] - 1.f) * kac[j]); }
            *(float4*)(CS + li * 64 + c8) = make_float4(sd8[0], sd8[1], sd8[2], sd8[3]);
            *(float4*)(CS + li * 64 + c8 + 4) = make_float4(sd8[4], sd8[5], sd8[6], sd8[7]);
            __syncthreads();
            if (tid < 64) { float run = 0.f; for (int i = 0; i < RC; ++i) { run += CS[i * 64 + tid]; CS[i * 64 + tid] = run; } }
            __syncthreads();
            float cs[8], tot[8];
            { const float4 a0 = *(const float4*)(CS + li * 64 + c8), a1 = *(const float4*)(CS + li * 64 + c8 + 4);
              const float4 t0 = *(const float4*)(CS + (RC - 1) * 64 + c8), t1 = *(const float4*)(CS + (RC - 1) * 64 + c8 + 4);
              cs[0] = a0.x; cs[1] = a0.y; cs[2] = a0.z; cs[3] = a0.w; cs[4] = a1.x; cs[5] = a1.y; cs[6] = a1.z; cs[7] = a1.w;
              tot[0] = t0.x; tot[1] = t0.y; tot[2] = t0.z; tot[3] = t0.w; tot[4] = t1.x; tot[5] = t1.y; tot[6] = t1.z; tot[7] = t1.w; }
            float k1[8], r1[8], b1[8], m1[8], b2[8], m2[8];
#pragma unroll
            for (int j = 0; j < 8; ++j) {
                const float pinc = __expf(-cs[j]), pexc = __expf(sd8[j] - cs[j]), einv = __expf(cs[j]), ec = __expf(cs[j] - tot[j]);
                k1[j] = kkv[j] * pexc; r1[j] = r8[j] * pinc; b1[j] = bbv[j] * einv; m1[j] = kmv[j] * einv; b2[j] = bbv[j] * ec; m2[j] = kmv[j] * ec;
            }
            __syncthreads();
            *(u32x4*)(L + L_K1 + li * SK + c8) = pack8(k1); *(u32x4*)(L + L_R1 + li * SK + c8) = pack8(r1);
            *(u32x4*)(L + L_B1 + li * SK + c8) = pack8(b1); *(u32x4*)(L + L_M1 + li * SK + c8) = pack8(m1);
#pragma unroll
            for (int j = 0; j < 8; ++j) {
                L[L_VT + (c8 + j) * ST + li] = f2bf(v8[j]); L[L_B2T + (c8 + j) * ST + li] = f2bf(b2[j]); L[L_M2T + (c8 + j) * ST + li] = f2bf(m2[j]);
            }
            if (li == RC - 1) {
#pragma unroll
                for (int j = 0; j < 8; ++j) PC[c8 + j] = __expf(-tot[j]);
            }
            __syncthreads();
        }
        if (RWC_STOP <= 1) continue;
        {
            const int i0 = wave >> 1, j0 = wave & 1;
            const f32x4 z4 = (f32x4){0.f, 0.f, 0.f, 0.f};
            f32x4 aS = z4, aU = z4, bm = z4, ar = z4, br = z4;
#pragma unroll
            for (int kk2 = 0; kk2 < 2; ++kk2) {
                const bf16x8 k1i = ldfrag(L + L_K1, SK, i0 * 16, kk2 * 32, lane), k1j = ldfrag(L + L_K1, SK, j0 * 16, kk2 * 32, lane);
                const bf16x8 b1i = ldfrag(L + L_B1, SK, i0 * 16, kk2 * 32, lane), b1j = ldfrag(L + L_B1, SK, j0 * 16, kk2 * 32, lane);
                const bf16x8 m1i = ldfrag(L + L_M1, SK, i0 * 16, kk2 * 32, lane), r1j = ldfrag(L + L_R1, SK, j0 * 16, kk2 * 32, lane);
                aS = mfma16(b1i, k1j, aS);
                aU = mfma16(k1i, b1j, aU);
                bm = mfma16(m1i, k1j, bm);
                ar = mfma16(b1i, r1j, ar);
                br = mfma16(m1i, r1j, br);
            }
#ifdef RWC_WAIT
            __builtin_amdgcn_sched_barrier(0); __builtin_amdgcn_s_sleep(2); __builtin_amdgcn_sched_barrier(0);
#endif
            {
                const int t = j0 * 16 + c16, s0 = i0 * 16 + q4 * 4;
                f32x4 x, pa, o1, o2, o3;
#pragma unroll
                for (int r = 0; r < 4; ++r) {
                    const bool lt = s0 + r < t, le = s0 + r <= t;
                    x[r] = lt ? -aS[r] : 0.f; pa[r] = x[r] + ((s0 + r == t) ? 1.f : 0.f);
                    o1[r] = lt ? bm[r] : 0.f; o2[r] = le ? ar[r] : 0.f; o3[r] = le ? br[r] : 0.f;
                }
#ifdef RWC_GSTORE
                { bf16_t* gd = wsb(p, OFF_RWY) + (size_t)2 * TT * 256 + (size_t)(bidx() * 256 + tid) * 32;
                  st4(gd, x); st4(gd + 4, pa); st4(gd + 8, o1); st4(gd + 12, o2); st4(gd + 16, o3); }
#else
                st4(L + L_X + t * ST + s0, x); st4(L + L_PA + t * ST + s0, pa);
                st4(L + L_BM + t * ST + s0, o1); st4(L + L_AR + t * ST + s0, o2); st4(L + L_BR + t * ST + s0, o3);
#endif
            }
            {
                const int s = j0 * 16 + c16, t0 = i0 * 16 + q4 * 4;
                f32x4 o;
#pragma unroll
                for (int r = 0; r < 4; ++r) o[r] = (s < t0 + r) ? -aU[r] : 0.f;
#ifdef RWC_GSTORE
                st4(wsb(p, OFF_RWY) + (size_t)2 * TT * 256 + (size_t)(bidx() * 256 + tid) * 32 + 20, o);
#else
                st4(L + L_XT + s * ST + t0, o);
#endif
            }
            __syncthreads();
        }
        if (RWC_STOP <= 2) continue;
#pragma unroll 1
        for (int rd = 1; rd <= 5; ++rd) {
            const bool sq = rd <= 4, up = rd >= 2;
            const int i0 = wave >> 1, j0 = wave & 1;
            const bf16x8 xti = ldfrag(L + L_XT, ST, i0 * 16, 0, lane), xtj = ldfrag(L + L_XT, ST, j0 * 16, 0, lane);
            const bf16x8 xi = ldfrag(L + L_X, ST, i0 * 16, 0, lane), xj = ldfrag(L + L_X, ST, j0 * 16, 0, lane);
            const bf16x8 paj = ldfrag(L + L_PA, ST, j0 * 16, 0, lane);
            const u32x2 old = *(const u32x2*)(L + L_PA + (j0 * 16 + c16) * ST + i0 * 16 + q4 * 4);
            __syncthreads();
            const f32x4 z4 = (f32x4){0.f, 0.f, 0.f, 0.f};
            if (sq) {
                const f32x4 nx = mfma16(xti, xj, z4);
                const f32x4 nxt = mfma16(xi, xtj, z4);
                st4(L + L_X + (j0 * 16 + c16) * ST + i0 * 16 + q4 * 4, nx);
                st4(L + L_XT + (j0 * 16 + c16) * ST + i0 * 16 + q4 * 4, nxt);
            }
            if (up) {
                f32x4 acc = (f32x4){bflo(old.x), bfhi(old.x), bflo(old.y), bfhi(old.y)};
                acc = mfma16(xti, paj, acc);
                st4(L + L_PA + (j0 * 16 + c16) * ST + i0 * 16 + q4 * 4, acc);
            }
            __syncthreads();
        }
        if (RWC_STOP <= 3) continue;
        {
            const int vj = wave;
#pragma unroll
            for (int ti = 0; ti < 2; ++ti) {
                f32x4 acc = mfma16(ldfrag(L + L_BM, ST, ti * 16, 0, lane), ldfrag(L + L_VT, ST, vj * 16, 0, lane), (f32x4){0.f, 0.f, 0.f, 0.f});
#pragma unroll
                for (int kk2 = 0; kk2 < 2; ++kk2) acc = mfma16(ldfrag(L + L_K1, SK, ti * 16, kk2 * 32, lane), ldfrag(L + L_S, SK, vj * 16, kk2 * 32, lane), acc);
                st4(L + L_ET + (vj * 16 + c16) * ST + ti * 16 + q4 * 4, acc);
            }
            __syncthreads();
#pragma unroll
            for (int ti = 0; ti < 2; ++ti) {
                const f32x4 acc = mfma16(ldfrag(L + L_PA, ST, ti * 16, 0, lane), ldfrag(L + L_ET, ST, vj * 16, 0, lane), (f32x4){0.f, 0.f, 0.f, 0.f});
                st4(L + L_ZT + (vj * 16 + c16) * ST + ti * 16 + q4 * 4, -acc);
            }
            __syncthreads();
        }
        if (RWC_STOP <= 4) continue;
        {
            const int vi = wave;
#pragma unroll
            for (int tj = 0; tj < 2; ++tj) {
                f32x4 acc = (f32x4){0.f, 0.f, 0.f, 0.f};
#pragma unroll
                for (int kk2 = 0; kk2 < 2; ++kk2) acc = mfma16(ldfrag(L + L_S, SK, vi * 16, kk2 * 32, lane), ldfrag(L + L_R1, SK, tj * 16, kk2 * 32, lane), acc);
                acc = mfma16(ldfrag(L + L_ZT, ST, vi * 16, 0, lane), ldfrag(L + L_AR, ST, tj * 16, 0, lane), acc);
                acc = mfma16(ldfrag(L + L_VT, ST, vi * 16, 0, lane), ldfrag(L + L_BR, ST, tj * 16, 0, lane), acc);
                int n, len; const int t = tok_of(c, tj * 16 + c16, n, len);
                u32x2 o; o.x = pack2(acc[0], acc[1]); o.y = pack2(acc[2], acc[3]);
#ifndef RWC_NOYSTORE
                *(u32x2*)(RWY + (size_t)t * 256 + head * 64 + vi * 16 + q4 * 4) = o;
#else
                asm volatile("" :: "v"(o), "v"(t));
#endif
            }
            const float4 pc = *(const float4*)(PC + wave * 16 + q4 * 4);
            const bf16x8 fb2 = ldfrag(L + L_B2T, ST, wave * 16, 0, lane), fm2 = ldfrag(L + L_M2T, ST, wave * 16, 0, lane);
#pragma unroll
            for (int vj = 0; vj < 4; ++vj) {
                f32x4 acc = Wt[vj];
                acc[0] *= pc.x; acc[1] *= pc.y; acc[2] *= pc.z; acc[3] *= pc.w;
                acc = mfma16(fb2, ldfrag(L + L_ZT, ST, vj * 16, 0, lane), acc);
                acc = mfma16(fm2, ldfrag(L + L_VT, ST, vj * 16, 0, lane), acc);
                Wt[vj] = acc;
            }
            __syncthreads();
#pragma unroll
            for (int vj = 0; vj < 4; ++vj) st4(L + L_S + (vj * 16 + c16) * SK + wave * 16 + q4 * 4, Wt[vj]);
        }
    }
    __syncthreads();
#ifdef RWC_ZERO_LDS
    for (int i = tid; i < 73728 / 4; i += NT) ((unsigned*)smem)[i] = 0u;
    __syncthreads();
#endif
}
DEV void phase_s5_glu(const Params& p, int l, int M, char* smem) {
    const bf16_t* P = wsb(p, OFF_P);
    const bf16_t* w = wsb(p, OFF_WSM) + (size_t)l * WS_PER_LAYER + WS_GLUT;
    bf16_t* Y = wsb(p, OFF_Y);
    const float* bg = inp(p, I_S5BGLU) + l * 256;
    bf16_t* sm = (bf16_t*)smem;
    const int nMt = M / 128;
    for (int item = bidx(); item < nMt * 2; item += gridDim.x) {
        const int m0 = (item >> 1) * 128, n0 = (item & 1) * 128;
        f32x16 acc[2][2]; acc_zero<2>(acc);
        gemm_mainloop(acc, [&](int r) { return P + (size_t)(m0 + r) * LDP + C_S5; }, [&](int r) { return w + (size_t)(n0 + r) * 256; }, 256, sm);
        epi_stage_tile(acc, smem, [&](int ct, float v) { return sigmoidf_(v + bg[n0 + ct]); },
                       [&](int row, int ch, const u32x4& g) {
                           const u32x4 z = *(const u32x4*)(P + (size_t)(m0 + row) * LDP + C_S5 + n0 + ch * 8);
                           u32x4 o;
#pragma unroll
                           for (int k = 0; k < 4; ++k) o[k] = pack2(bflo(z[k]) * bflo(g[k]), bfhi(z[k]) * bfhi(g[k]));
                           *(u32x4*)(Y + (size_t)(m0 + row) * 1024 + 256 + n0 + ch * 8) = o;
                       });
    }
}
DEV void phase_rw_finish(const Params& p, int l, int M) {
    const int lane = tidx() & 63, wave = tidx() >> 6;
    const bf16_t* P = wsb(p, OFF_P);
    const bf16_t* RWX = wsb(p, OFF_RWX);
    const bf16_t* RWY = wsb(p, OFF_RWY);
    bf16_t* Y = wsb(p, OFF_Y);
    const int c = lane * 4;
    const float4 mur = *(const float4*)(inp(p, I_RMU) + (l * 4 + 0) * 256 + c);
    const float4 muk = *(const float4*)(inp(p, I_RMU) + (l * 4 + 1) * 256 + c);
    const float4 muv = *(const float4*)(inp(p, I_RMU) + (l * 4 + 2) * 256 + c);
    const float4 ka4 = *(const float4*)(inp(p, I_RKA) + l * 256 + c);
    const float4 rk4 = *(const float4*)(inp(p, I_RRK) + l * 256 + c);
    const float4 lg4 = *(const float4*)(inp(p, I_RLNG) + l * 256 + c);
    const float4 lb4 = *(const float4*)(inp(p, I_RLNB) + l * 256 + c);
    const float mr_[4] = { mur.x, mur.y, mur.z, mur.w }, mk_[4] = { muk.x, muk.y, muk.z, muk.w }, mv_[4] = { muv.x, muv.y, muv.z, muv.w };
    const float ka_[4] = { ka4.x, ka4.y, ka4.z, ka4.w }, rk_[4] = { rk4.x, rk4.y, rk4.z, rk4.w }, lg_[4] = { lg4.x, lg4.y, lg4.z, lg4.w }, lb_[4] = { lb4.x, lb4.y, lb4.z, lb4.w };
    struct FinIn { u32x2 r[3], k[3], v[3], af, ab, yf, yb, gg; };
    auto load_tok = [&](int t, FinIn& in) {
        int base, n, len; tok_seq(t, base, n, len);
        const bf16_t* row = P + (size_t)t * LDP;
        const bf16_t* rp = n > 0 ? row - LDP : row; const bf16_t* rn = n + 1 < len ? row + LDP : row;
        in.r[0] = *(const u32x2*)(row + C_RWR + c); in.r[1] = *(const u32x2*)(rp + C_RWR + c); in.r[2] = *(const u32x2*)(rn + C_RWR + c);
        in.k[0] = *(const u32x2*)(row + C_RWK + c); in.k[1] = *(const u32x2*)(rp + C_RWK + c); in.k[2] = *(const u32x2*)(rn + C_RWK + c);
        in.v[0] = *(const u32x2*)(row + C_RWV + c); in.v[1] = *(const u32x2*)(rp + C_RWV + c); in.v[2] = *(const u32x2*)(rn + C_RWV + c);
        in.af = *(const u32x2*)(RWX + (size_t)t * 1024 + 512 + c); in.ab = *(const u32x2*)(RWX + (size_t)t * 1024 + 768 + c);
        in.yf = *(const u32x2*)(RWY + (size_t)t * 256 + c); in.yb = *(const u32x2*)(RWY + (size_t)TT * 256 + (size_t)t * 256 + c);
        in.gg = *(const u32x2*)(row + C_RWD + c);
    };
    const int tstep = gridDim.x * 4;
    FinIn nxt;
    if (bidx() * 4 + wave < M) load_tok(bidx() * 4 + wave, nxt);
    for (int t = bidx() * 4 + wave; t < M; t += tstep) {
        int base, n, len; tok_seq(t, base, n, len);
        const FinIn in = nxt;
        load_tok(t + tstep < M ? t + tstep : t, nxt);
        const float fp = n > 0 ? 0.5f : 0.f, fn = n + 1 < len ? 0.5f : 0.f;
        float r4[4], k4[4], v4[4];
        {
            const u32x2 cu = in.r[0], pv = in.r[1], nx = in.r[2];
            const float x[4] = { bflo(cu.x), bfhi(cu.x), bflo(cu.y), bfhi(cu.y) }, a[4] = { bflo(pv.x), bfhi(pv.x), bflo(pv.y), bfhi(pv.y) }, b[4] = { bflo(nx.x), bfhi(nx.x), bflo(nx.y), bfhi(nx.y) };
#pragma unroll
            for (int j = 0; j < 4; ++j) r4[j] = x[j] + ((fp * a[j] + fn * b[j]) - x[j]) * mr_[j];
        }
        {
            const u32x2 cu = in.k[0], pv = in.k[1], nx = in.k[2];
            const float x[4] = { bflo(cu.x), bfhi(cu.x), bflo(cu.y), bfhi(cu.y) }, a[4] = { bflo(pv.x), bfhi(pv.x), bflo(pv.y), bfhi(pv.y) }, b[4] = { bflo(nx.x), bfhi(nx.x), bflo(nx.y), bfhi(nx.y) };
#pragma unroll
            for (int j = 0; j < 4; ++j) k4[j] = x[j] + ((fp * a[j] + fn * b[j]) - x[j]) * mk_[j];
        }
        {
            const u32x2 cu = in.v[0], pv = in.v[1], nx = in.v[2];
            const float x[4] = { bflo(cu.x), bfhi(cu.x), bflo(cu.y), bfhi(cu.y) }, a[4] = { bflo(pv.x), bfhi(pv.x), bflo(pv.y), bfhi(pv.y) }, b[4] = { bflo(nx.x), bfhi(nx.x), bflo(nx.y), bfhi(nx.y) };
#pragma unroll
            for (int j = 0; j < 4; ++j) v4[j] = x[j] + ((fp * a[j] + fn * b[j]) - x[j]) * mv_[j];
        }
        const u32x2 af = in.af, ab = in.ab;
        const float a0[4] = { bflo(af.x), bfhi(af.x), bflo(af.y), bfhi(af.y) }, a1[4] = { bflo(ab.x), bfhi(ab.x), bflo(ab.y), bfhi(ab.y) };
        const u32x2 yf = in.yf, yb = in.yb;
        float y[4] = { bflo(yf.x) + bflo(yb.x), bfhi(yf.x) + bfhi(yb.x), bflo(yf.y) + bflo(yb.y), bfhi(yf.y) + bfhi(yb.y) };
        float s = y[0] + y[1] + y[2] + y[3];
        s = group_sum<16>(s);
        const float mean = s * (1.f / 64.f);
        float q = 0.f, bon = 0.f;
#pragma unroll
        for (int j = 0; j < 4; ++j) {
            const float dlt = y[j] - mean; q += dlt * dlt;
            const float kmsum = k4[j] * (2.f + (a0[j] + a1[j] - 2.f) * ka_[j]);
            bon += r4[j] * kmsum * rk_[j];
        }
        q = group_sum<16>(q); bon = group_sum<16>(bon);
        const float rstd = rsqrtf(q * (1.f / 64.f) + 64e-5f);
        const u32x2 gg = in.gg;
        const float g[4] = { bflo(gg.x), bfhi(gg.x), bflo(gg.y), bfhi(gg.y) };
        float o[4];
#pragma unroll
        for (int j = 0; j < 4; ++j) o[j] = ((y[j] - mean) * rstd * lg_[j] + lb_[j] + bon * v4[j]) * g[j];
        u32x2 ov; ov.x = pack2(o[0], o[1]); ov.y = pack2(o[2], o[3]);
        *(u32x2*)(Y + (size_t)t * 1024 + 768 + c) = ov;
    }
}

DEV int queue_next(int* ctr, char* smem) {
    int* slot = (int*)(smem + MOE_MAP_OFF + 208);
    __syncthreads();
    if (tidx() == 0) *slot = atomicAdd(ctr, 1);
    __syncthreads();
    return __builtin_amdgcn_readfirstlane(*slot);
}
DEV void phase_mixers(const Params& p, int l, int rep, char* smem) {
    const bool need_ctx = (l == 0);
#ifndef RWMODE
#define RWMODE 2
#endif
    const int nrw = RWMODE == 0 ? 64 : (RWMODE == 1 ? 256 + 64 : 256), nda = need_ctx ? 576 : 512, ns5 = 32 * (need_ctx ? 9 : 8);
    const int total = nrw + 2 * nda + (rep == 0 ? ns5 : 0);
    int* ctr = (int*)(wsp(p) + OFF_CTR) + CTR_Q + l * 16 + rep * 4;
    for (;;) {
        const int item = queue_next(ctr, smem);
        if (item >= total) break;
#ifndef PROBE7
#define PROBE7 0
#endif
        if (rep > 0 && PROBE7 == 1 && item >= nrw) break;
        if (rep > 0 && PROBE7 == 2 && item < nrw) continue;
        if (rep > 0 && PROBE7 == 3 && (item < nrw || item >= nrw + nda)) continue;
#if RWMODE == 2
        if (item < nrw) rw_item(p, l, item, smem, 0);
#elif RWMODE == 0
        if (item < nrw) rwc_item(p, l, item, smem);
#else
        if (item < nrw) { if (item < 256) rw_item(p, l, item, smem, 0); else rwc_item(p, l, item - 256, smem); }
#endif
        else if (item < nrw + nda) da_item(p, l, item - nrw, smem);
        else if (item < nrw + 2 * nda) mla_item(p, l, item - nrw - nda, smem);
        else s5_pass2_item(p, l, need_ctx ? 0 : 1, item - nrw - 2 * nda, smem);
    }
}
#ifndef MEGA
#define MEGA 0
#endif
constexpr int NPHASE = 15;
template <int PH>
DEV void run_phase(const Params& p, int l, char* smem) {
    asm volatile("" : "+s"(l));
    const bool need_ctx = (l == 0);
    const int M = need_ctx ? TT : TL;
    if constexpr (PH == 0) { phase_mod_partial(p, smem); __syncthreads(); phase_conv_small(p, smem); phase_conv_layer(p, 0, smem); phase_conv_experts(p, 0, smem); }
    if constexpr (PH == 1) { phase_mod_reduce(p); }
    if constexpr (PH == 2) { phase_norm<1>(p, l, TT, smem, l == 1); if (l == 1) { phase_conv_layer(p, 1, smem); phase_conv_experts(p, 1, smem); } }
    if constexpr (PH == 3) { phase_inproj(p, l, smem); }
    if constexpr (PH == 4) { phase_prep1(p, l); phase_s5_pass1(p, l, smem); }
    if constexpr (PH == 5) { phase_prep_gemm1(p, l, smem); }
    if constexpr (PH == 6) { phase_prep_gemm2(p, l, smem); phase_prep2(p, l); }
    if constexpr (PH == 7) { phase_mixers(p, l, 0, smem); }
    if constexpr (PH == 8) { phase_s5_glu(p, l, M, smem); phase_rw_finish(p, l, M); }
    if constexpr (PH == 9) { phase_merge2(p, l, M, smem); }
    if constexpr (PH == 10) { phase_outproj(p, l, M, smem); }
    if constexpr (PH == 11) { phase_norm<2>(p, l, M, smem); }
    if constexpr (PH == 14) { phase_route(p, l, M, smem); }
    if constexpr (PH == 15) { phase_combine(p, l, M); }
    if constexpr (PH == 12) { phase_moe1(p, l, smem); }
    if constexpr (PH == 13) { phase_moe2(p, l, smem); }
}

#if !MEGA
template <int PH>
__global__ void __launch_bounds__(NT, 2) k_phase(Params p, int l) {
    extern __shared__ __attribute__((aligned(16))) char smem[];
    run_phase<PH>(p, l, smem);
}
#endif
#ifndef REP0
#define REP0 1
#endif
#ifndef REP2
#define REP2 1
#endif
#ifndef REP3
#define REP3 1
#endif
#ifndef REP5
#define REP5 1
#endif
#ifndef REP6
#define REP6 1
#endif
#ifndef REP7
#define REP7 1
#endif
#ifndef REP8
#define REP8 1
#endif
#ifndef REP9
#define REP9 1
#endif
#ifndef REP12
#define REP12 1
#endif
#if MEGA
__global__ void __launch_bounds__(NT, 2) k_mega(Params p) {
    extern __shared__ __attribute__((aligned(16))) char smem[];
    uint4* xbw = (uint4*)(smem + MOE_MAP_OFF + 240);
    if (threadIdx.x == 0) *xbw = make_uint4(0u, 0u, 0u, 0u);
    __syncthreads();
    XcdBarrier bar = xcd_barrier_post((unsigned*)(p.ws + OFF_BAR), (volatile LAS unsigned*)xbw);
    for (int r = 0; r < REP0; ++r) { run_phase<0>(p, 0, smem); xcd_barrier(bar); }
    run_phase<1>(p, 0, smem); xcd_barrier(bar);
    for (int l = 0; l < 2; ++l) {
        for (int r = 0; r < REP2; ++r) { run_phase<2>(p, l, smem); xcd_barrier(bar); }
        for (int r = 0; r < REP3; ++r) { run_phase<3>(p, l, smem); xcd_barrier(bar); }

        run_phase<4>(p, l, smem); xcd_barrier(bar);
#ifdef PROBE_S5P1
        phase_s5_pass1(p, l, smem); xcd_barrier(bar);
#endif
#ifdef PROBE_BAR
        for (int r = 0; r < PROBE_BAR; ++r) xcd_barrier(bar);
#endif
        for (int r = 0; r < REP5; ++r) { run_phase<5>(p, l, smem); xcd_barrier(bar); }
        for (int r = 0; r < REP6; ++r) { run_phase<6>(p, l, smem); xcd_barrier(bar); }
#ifdef RWC_PRE
        if (bidx() < 64) rwc_item(p, l, bidx(), smem);
#endif
        for (int r = 0; r < REP7; ++r) { int l7 = l; asm volatile("" : "+s"(l7)); phase_mixers(p, l7, r, smem); xcd_barrier(bar); }
#ifdef RWC_SEP
        for (int item = bidx(); item < 64; item += gridDim.x) rwc_item(p, l, item, smem);
        xcd_barrier(bar);
#endif
        for (int r = 0; r < REP8; ++r) { run_phase<8>(p, l, smem); xcd_barrier(bar); }
        for (int r = 0; r < REP9; ++r) { run_phase<9>(p, l, smem); xcd_barrier(bar); }
        run_phase<10>(p, l, smem); xcd_barrier(bar);
#ifdef PROBE_OUT2
        if (l == 0) { run_phase<10>(p, l, smem); xcd_barrier(bar); }
#endif

        run_phase<11>(p, l, smem); xcd_barrier(bar);
        run_phase<14>(p, l, smem); xcd_barrier(bar);
        for (int r = 0; r < REP12; ++r) { run_phase<12>(p, l, smem); xcd_barrier(bar); }
        run_phase<13>(p, l, smem); xcd_barrier(bar);
#ifdef PROBE_MOE2B
        run_phase<13>(p, l, smem); xcd_barrier(bar);
#endif
        if (l == 1) run_phase<15>(p, l, smem);
    }
}
#endif
__global__ void __launch_bounds__(NT) k_fail(float* out, int n) {
    for (int i = blockIdx.x * NT + threadIdx.x; i < n; i += gridDim.x * NT) out[i] = __int_as_float(0x7fc00000);
}

template <int PH>
static void launch_phase(const Params& p, int l, int grid, hipStream_t stream) {
#if !MEGA
    static bool attr = false;
    if (!attr) { (void)hipFuncSetAttribute((const void*)k_phase<PH>, hipFuncAttributeMaxDynamicSharedMemorySize, SMEM_BYTES); attr = true; }
    hipLaunchKernelGGL(k_phase<PH>, dim3(grid), dim3(NT), SMEM_BYTES, stream, p, l);
#endif
}

extern "C" void kernel_launch(void* const* d_in, const int* in_sizes, int n_in, void* d_out, int out_size, void* d_ws, size_t ws_size, hipStream_t stream) {
    if (n_in != 48 || out_size != TL * DM || ws_size < WS_END) {
        hipLaunchKernelGGL(k_fail, dim3(256), dim3(NT), 0, stream, (float*)d_out, out_size);
        return;
    }
    Params p{};
    for (int i = 0; i < 48; ++i) p.in[i] = (const float*)d_in[i];
    p.out = (float*)d_out; p.ws = (char*)d_ws;
    (void)hipMemsetAsync(d_ws, 0, ZERO_BYTES, stream);
#if MEGA
    static int grid = 0;
    if (grid == 0) {
        int dev = 0, cus = 0, per_cu = 0;
        (void)hipGetDevice(&dev);
        (void)hipDeviceGetAttribute(&cus, hipDeviceAttributeMultiprocessorCount, dev);
        (void)hipFuncSetAttribute((const void*)k_mega, hipFuncAttributeMaxDynamicSharedMemorySize, SMEM_BYTES);
        if (hipOccupancyMaxActiveBlocksPerMultiprocessor(&per_cu, (const void*)k_mega, NT, SMEM_BYTES) != hipSuccess || per_cu < 1) per_cu = 1;
        (void)hipGetLastError();
        if (cus <= 0) cus = 256;
        grid = cus * (per_cu < 2 ? per_cu : 2);
    }
    hipLaunchKernelGGL(k_mega, dim3(grid), dim3(NT), SMEM_BYTES, stream, p);
#else
    const int grid = 512;
    launch_phase<0>(p, 0, grid, stream);
    launch_phase<1>(p, 0, grid, stream);
    for (int l = 0; l < 2; ++l) {
        launch_phase<2>(p, l, grid, stream);
        launch_phase<3>(p, l, grid, stream);
        launch_phase<4>(p, l, grid, stream);
        launch_phase<5>(p, l, grid, stream);
        launch_phase<6>(p, l, grid, stream);
        launch_phase<7>(p, l, grid, stream);
        launch_phase<8>(p, l, grid, stream);
        launch_phase<9>(p, l, grid, stream);
        launch_phase<10>(p, l, grid, stream);
        launch_phase<11>(p, l, grid, stream);
        launch_phase<14>(p, l, grid, stream);
        launch_phase<12>(p, l, grid, stream);
        launch_phase<13>(p, l, grid, stream);
        launch_phase<15>(p, l, grid, stream);
    }
#endif
}
```
